# Optimizing an MI355X kernel written in HIP

```python
import math
import jax, jax.numpy as jnp
from jax import lax
import numpy as np

D_MODEL = 1024
BATCH = 4
SEQ = 4096
DEPTH = 1

CHUNK = 64
MEM_LEN = 256
Q_BLOCK = 128
ROPE_THETA = 10000.0
NORM_EPS = 1e-6

SB_HEADS = D_MODEL // 128
SB_HEAD_DIM = 64
SB_WIDTH = SB_HEADS * SB_HEAD_DIM
DIFF_HEADS = D_MODEL // 256
DIFF_HEAD_DIM = 64
DIFF_V_DIM = 2 * DIFF_HEAD_DIM
DIFF_QK_WIDTH = DIFF_HEADS * 2 * DIFF_HEAD_DIM
DIFF_WIDTH = DIFF_HEADS * DIFF_V_DIM
N_BRANCH = 2
N_IN = 3 * SB_WIDTH + 2 * DIFF_QK_WIDTH + DIFF_WIDTH + N_BRANCH * D_MODEL
MEM_HEADS = 4
MEM_HEAD_DIM = D_MODEL // MEM_HEADS
N_EXPERTS = 32
TOP_K = 4
D_FF = D_MODEL
SWIGLU_LIMIT = 7.0
SWIGLU_ALPHA = 1.702
MOE_BLOCK = 128

kernel_name = "hybrid_stickbreak_diffattn_moe_block"


def rms_norm(x, g):
    xf = x.astype(jnp.float32)
    y = xf * lax.rsqrt(jnp.mean(xf * xf, axis=-1, keepdims=True) + NORM_EPS)
    return (y * g.astype(jnp.float32)).astype(x.dtype)


def split_heads(t, n_heads):
    b, s, _ = t.shape
    return t.reshape(b, s, n_heads, -1).transpose(0, 2, 1, 3)


def merge_heads(t):
    b, n, s, d = t.shape
    return t.transpose(0, 2, 1, 3).reshape(b, s, n * d)


def rope(t, positions):
    half = t.shape[-1] // 2
    inv = ROPE_THETA ** (-jnp.arange(half, dtype=jnp.float32) / half)
    ang = positions.astype(jnp.float32)[:, None, :, None] * inv
    cos, sin = jnp.cos(ang), jnp.sin(ang)
    tf = t.astype(jnp.float32)
    t1, t2 = tf[..., :half], tf[..., half:]
    return jnp.concatenate([t1 * cos - t2 * sin, t2 * cos + t1 * sin], axis=-1).astype(t.dtype)


def to_blocks(t):
    b, h, s, d = t.shape
    return t.reshape(b, h, s // Q_BLOCK, Q_BLOCK, d).transpose(2, 0, 1, 3, 4)


def from_blocks(t):
    nb, b, h, qb, d = t.shape
    return t.transpose(1, 2, 0, 3, 4).reshape(b, h, nb * qb, d)


def stick_breaking_attention(q, k, v):
    s_len = q.shape[2]
    scale = 1.0 / math.sqrt(q.shape[-1])
    key_pos = jnp.arange(s_len)

    def block(args):
        qb, start = args
        z = jnp.einsum('bhqd,bhkd->bhqk', qb, k, preferred_element_type=jnp.float32) * scale
        q_pos = start + jnp.arange(Q_BLOCK)
        mask = key_pos[None, :] < q_pos[:, None]
        log_rem = jnp.where(mask, jax.nn.log_sigmoid(-z), 0.0)
        after = lax.cumsum(log_rem, axis=log_rem.ndim - 1, reverse=True) - log_rem
        w = jnp.where(mask, jnp.exp(jax.nn.log_sigmoid(z) + after), 0.0)
        return jnp.einsum('bhqk,bhkd->bhqd', w.astype(v.dtype), v)

    starts = jnp.arange(s_len // Q_BLOCK) * Q_BLOCK
    return from_blocks(lax.map(block, (to_blocks(q), starts)))


def differential_attention(q1, q2, k1, k2, v, lam):
    s_len = q1.shape[2]
    scale = 1.0 / math.sqrt(q1.shape[-1])
    key_chunk = jnp.arange(s_len) // CHUNK

    def block(args):
        q1b, q2b, start = args
        q_chunk = (start + jnp.arange(Q_BLOCK)) // CHUNK
        mask = key_chunk[None, :] <= q_chunk[:, None]

        def probs(qb, kk):
            z = jnp.einsum('bhqd,bhkd->bhqk', qb, kk, preferred_element_type=jnp.float32) * scale
            return jax.nn.softmax(jnp.where(mask, z, -jnp.inf), axis=-1)

        p = probs(q1b, k1) - lam * probs(q2b, k2)
        return jnp.einsum('bhqk,bhkd->bhqd', p.astype(v.dtype), v)

    starts = jnp.arange(s_len // Q_BLOCK) * Q_BLOCK
    return from_blocks(lax.map(block, (to_blocks(q1), to_blocks(q2), starts)))


def memory_cross_attention(h, hm, w_q, w_kv, w_o):
    q = split_heads(h @ w_q, MEM_HEADS)
    k, v = jnp.split(hm @ w_kv, 2, axis=-1)
    k, v = split_heads(k, MEM_HEADS), split_heads(v, MEM_HEADS)
    z = jnp.einsum('bhqd,bhkd->bhqk', q, k, preferred_element_type=jnp.float32) / math.sqrt(MEM_HEAD_DIM)
    p = jax.nn.softmax(z, axis=-1)
    o = jnp.einsum('bhqk,bhkd->bhqd', p.astype(v.dtype), v)
    return merge_heads(o) @ w_o


def moe_ffn(h, w_router, b_router, w_gu, b_gu, w_down, b_down):
    b, s, d = h.shape
    n_tok = b * s
    xf = h.reshape(n_tok, d)
    logits = (xf @ w_router).astype(jnp.float32) + b_router.astype(jnp.float32)
    top_val, top_idx = lax.top_k(logits, TOP_K)
    gate = jax.nn.softmax(top_val, axis=-1)

    n_assign = n_tok * TOP_K
    flat_e = top_idx.reshape(-1)
    order = jnp.argsort(flat_e)
    sorted_e = flat_e[order]
    sorted_tok = (order // TOP_K).astype(jnp.int32)
    sorted_gate = gate.reshape(-1)[order]
    counts = jnp.bincount(flat_e, length=N_EXPERTS)
    padded = (counts + MOE_BLOCK - 1) // MOE_BLOCK * MOE_BLOCK
    start = jnp.cumsum(counts) - counts
    pend = jnp.cumsum(padded)
    pstart = pend - padded
    dest = pstart[sorted_e] + jnp.arange(n_assign) - start[sorted_e]
    n_blocks = n_assign // MOE_BLOCK + N_EXPERTS
    n_rows = n_blocks * MOE_BLOCK
    row_tok = jnp.zeros((n_rows,), jnp.int32).at[dest].set(sorted_tok)
    row_gate = jnp.zeros((n_rows,), jnp.float32).at[dest].set(sorted_gate)
    block_expert = jnp.clip(jnp.searchsorted(pend, jnp.arange(n_blocks) * MOE_BLOCK, side='right'),
                            0, N_EXPERTS - 1)

    def run_block(args):
        tok, g, e = args
        xb = xf[tok]
        hgu = xb @ w_gu[e] + b_gu[e]
        glu, lin = jnp.split(hgu, 2, axis=-1)
        glu = jnp.minimum(glu, SWIGLU_LIMIT)
        lin = jnp.clip(lin, -SWIGLU_LIMIT, SWIGLU_LIMIT)
        act = glu * jax.nn.sigmoid(SWIGLU_ALPHA * glu) * (lin + 1.0)
        y = act @ w_down[e] + b_down[e]
        return y.astype(jnp.float32) * g[:, None]

    ys = lax.map(run_block, (row_tok.reshape(n_blocks, MOE_BLOCK),
                             row_gate.reshape(n_blocks, MOE_BLOCK), block_expert))
    out = jnp.zeros((n_tok, d), jnp.float32).at[row_tok].add(ys.reshape(n_rows, d))
    return out.astype(h.dtype).reshape(b, s, d)


def setup_inputs(seed: int = 0) -> dict:
    key = jax.random.key(seed)
    ks = jax.random.split(key, 28)
    f32 = jnp.float32

    def nrm(k, shape, scale):
        return jax.random.normal(k, shape, f32) * scale

    def gain(k, shape):
        return 1.0 + 0.05 * jax.random.normal(k, shape, f32)

    offset = jax.random.randint(ks[2], (BATCH, 1), 0, 4096, dtype=jnp.int32)
    positions = (offset + jnp.arange(SEQ, dtype=jnp.int32)[None, :]).astype(jnp.int32)
    return {
        "x": nrm(ks[0], (BATCH, SEQ, D_MODEL), 1.0),
        "mem": nrm(ks[1], (BATCH, MEM_LEN, D_MODEL), 1.0),
        "positions": positions,
        "norm_mix": gain(ks[3], (DEPTH, D_MODEL)),
        "w_in": nrm(ks[4], (DEPTH, D_MODEL, N_IN), D_MODEL ** -0.5),
        "lambda_q1": nrm(ks[5], (DEPTH, DIFF_HEAD_DIM), 0.1),
        "lambda_k1": nrm(ks[6], (DEPTH, DIFF_HEAD_DIM), 0.1),
        "lambda_q2": nrm(ks[7], (DEPTH, DIFF_HEAD_DIM), 0.1),
        "lambda_k2": nrm(ks[8], (DEPTH, DIFF_HEAD_DIM), 0.1),
        "diff_subln": gain(ks[9], (DEPTH, DIFF_V_DIM)),
        "w_up_sb": nrm(ks[10], (DEPTH, SB_WIDTH, D_MODEL), SB_WIDTH ** -0.5),
        "w_up_diff": nrm(ks[11], (DEPTH, DIFF_WIDTH, D_MODEL), DIFF_WIDTH ** -0.5),
        "w_out": nrm(ks[12], (DEPTH, D_MODEL, D_MODEL), D_MODEL ** -0.5),
        "norm_mem_q": gain(ks[13], (DEPTH, D_MODEL)),
        "norm_mem_kv": gain(ks[14], (DEPTH, D_MODEL)),
        "w_mem_q": nrm(ks[15], (DEPTH, D_MODEL, D_MODEL), D_MODEL ** -0.5),
        "w_mem_kv": nrm(ks[16], (DEPTH, D_MODEL, 2 * D_MODEL), D_MODEL ** -0.5),
        "w_mem_o": nrm(ks[17], (DEPTH, D_MODEL, D_MODEL), D_MODEL ** -0.5),
        "norm_ffn": gain(ks[18], (DEPTH, D_MODEL)),
        "w_router": nrm(ks[19], (DEPTH, D_MODEL, N_EXPERTS), D_MODEL ** -0.5),
        "b_router": nrm(ks[20], (DEPTH, N_EXPERTS), 0.01),
        "w_gate_up": nrm(ks[21], (DEPTH, N_EXPERTS, D_MODEL, 2 * D_FF), D_MODEL ** -0.5),
        "b_gate_up": nrm(ks[22], (DEPTH, N_EXPERTS, 2 * D_FF), 0.02),
        "w_down": nrm(ks[23], (DEPTH, N_EXPERTS, D_FF, D_MODEL), D_FF ** -0.5),
        "b_down": nrm(ks[24], (DEPTH, N_EXPERTS, D_MODEL), 0.02),
        "norm_final": gain(ks[25], (D_MODEL,)),
    }


def reference(x, mem, positions, norm_mix, w_in, lambda_q1, lambda_k1, lambda_q2, lambda_k2,
              diff_subln, w_up_sb, w_up_diff, w_out, norm_mem_q, norm_mem_kv, w_mem_q,
              w_mem_kv, w_mem_o, norm_ffn, w_router, b_router, w_gate_up, b_gate_up,
              w_down, b_down, norm_final):
    splits = [SB_WIDTH, 2 * SB_WIDTH, 3 * SB_WIDTH,
              3 * SB_WIDTH + DIFF_QK_WIDTH,
              3 * SB_WIDTH + 2 * DIFF_QK_WIDTH,
              3 * SB_WIDTH + 2 * DIFF_QK_WIDTH + DIFF_WIDTH,
              3 * SB_WIDTH + 2 * DIFF_QK_WIDTH + DIFF_WIDTH + D_MODEL]
    b, s, _ = x.shape
    for l in range(DEPTH):
        h = rms_norm(x, norm_mix[l])
        proj = h @ w_in[l]
        sb_q, sb_k, sb_v, d_q, d_k, d_v, g_sb, g_diff = jnp.split(proj, splits, axis=-1)

        o_sb = stick_breaking_attention(split_heads(sb_q, SB_HEADS),
                                        split_heads(sb_k, SB_HEADS),
                                        split_heads(sb_v, SB_HEADS))

        dq = d_q.reshape(b, s, DIFF_HEADS, 2, DIFF_HEAD_DIM).transpose(0, 2, 3, 1, 4)
        dk = d_k.reshape(b, s, DIFF_HEADS, 2, DIFF_HEAD_DIM).transpose(0, 2, 3, 1, 4)
        q1, q2 = rope(dq[:, :, 0], positions), rope(dq[:, :, 1], positions)
        k1, k2 = rope(dk[:, :, 0], positions), rope(dk[:, :, 1], positions)
        lambda_init = 0.8 - 0.6 * math.exp(-0.3 * l)
        lam = (jnp.exp(jnp.sum(lambda_q1[l].astype(jnp.float32) * lambda_k1[l].astype(jnp.float32)))
               - jnp.exp(jnp.sum(lambda_q2[l].astype(jnp.float32) * lambda_k2[l].astype(jnp.float32)))
               + lambda_init)
        o_diff = differential_attention(q1, q2, k1, k2, split_heads(d_v, DIFF_HEADS), lam)
        o_diff = rms_norm(o_diff, diff_subln[l]) * (1.0 - lambda_init)

        y_sb = merge_heads(o_sb) @ w_up_sb[l]
        y_diff = merge_heads(o_diff) @ w_up_diff[l]
        mixed = jax.nn.sigmoid(g_sb) * y_sb + jax.nn.sigmoid(g_diff) * y_diff
        x = x + mixed @ w_out[l]

        x = x + memory_cross_attention(rms_norm(x, norm_mem_q[l]), rms_norm(mem, norm_mem_kv[l]),
                                       w_mem_q[l], w_mem_kv[l], w_mem_o[l])

        x = x + moe_ffn(rms_norm(x, norm_ffn[l]), w_router[l], b_router[l], w_gate_up[l],
                        b_gate_up[l], w_down[l], b_down[l])
    return rms_norm(x, norm_final)
```

```cpp
#include <hip/hip_runtime.h>
#include <cstdio>
#include <cstdint>

#ifndef MK_PER_PHASE
#define MK_PER_PHASE 1
#endif

#define GAS __attribute__((address_space(1)))
#define LAS __attribute__((address_space(3)))
typedef unsigned short bf16_t;
typedef unsigned v4u __attribute__((ext_vector_type(4)));
typedef unsigned v2u __attribute__((ext_vector_type(2)));
typedef float f32x4 __attribute__((ext_vector_type(4)));
typedef short bf16x8 __attribute__((ext_vector_type(8)));

constexpr int BATCH = 4, SEQ = 4096, D = 1024, M = BATCH * SEQ, NIN = 5120;
constexpr int MEMLEN = 256, MM = BATCH * MEMLEN;
constexpr int NE = 32, TOPK = 4, DFF = 1024;
constexpr float NORM_EPS = 1e-6f;
constexpr int C_SBQ = 0, C_SBK = 512, C_SBV = 1024, C_DQ = 1536, C_DK = 2048, C_DV = 2560, C_GSB = 3072, C_GDF = 4096;
constexpr int LISTCAP = 16384;
constexpr int SLOTS = 65536 + NE * 256;
constexpr int NWAVES = 8, NTHR = 512;

constexpr size_t MiB = 1u << 20;
constexpr size_t WS_CTL = 0, CTL_ZERO_BYTES = 1 * MiB;
constexpr size_t WS_WIN = 2 * MiB;
constexpr size_t WS_WUPSB = 12 * MiB;
constexpr size_t WS_WUPDF = 13 * MiB;
constexpr size_t WS_WOUT = 14 * MiB;
constexpr size_t WS_WMQ = 16 * MiB;
constexpr size_t WS_WMKV = 18 * MiB;
constexpr size_t WS_WMO = 22 * MiB;
constexpr size_t WS_ROPE = 24 * MiB;
constexpr size_t WS_TK = 28 * MiB;
constexpr size_t WS_WGU = 32 * MiB;
constexpr size_t WS_WD = 160 * MiB;
constexpr size_t WS_XN = 224 * MiB;
constexpr size_t WS_PR = 256 * MiB;
constexpr size_t WS_OAT = 416 * MiB;
constexpr size_t WS_ODR = 448 * MiB;
constexpr size_t WS_MIX = 512 * MiB;
constexpr size_t WS_X1 = 544 * MiB;
constexpr size_t WS_X2 = 608 * MiB;
constexpr size_t WS_HM = 672 * MiB;
constexpr size_t WS_KVM = 674 * MiB;
constexpr size_t WS_TLIST = 678 * MiB;
constexpr size_t WS_GLIST = 680 * MiB;
constexpr size_t WS_QM = 682 * MiB;
constexpr size_t WS_OM = 714 * MiB;
constexpr size_t WS_ACT = 256 * MiB;
constexpr size_t WS_YB = 746 * MiB;
constexpr size_t WS_END = 890 * MiB;
static_assert(WS_ACT + (size_t)SLOTS * 1024 * 2 <= WS_OAT, "ACT overlay");
static_assert(WS_YB + (size_t)SLOTS * 1024 * 2 <= WS_END, "YB");
constexpr int CW_CNT = 1024;
constexpr int CW_BAR = 4096;

constexpr int LDS_BYTES = 147456;
constexpr int MISC_OFF = 131072 + 320;

__device__ __forceinline__ float bf2f(bf16_t b) { return __uint_as_float(((unsigned)b) << 16); }
__device__ __forceinline__ unsigned f2bf(float f) { unsigned u = __float_as_uint(f); return (u + 0x7fffu + ((u >> 16) & 1u)) >> 16; }
__device__ __forceinline__ unsigned pk2(float lo, float hi) { return f2bf(lo) | (f2bf(hi) << 16); }
__device__ __forceinline__ float lo16(unsigned w) { return __uint_as_float(w << 16); }
__device__ __forceinline__ float hi16(unsigned w) { return __uint_as_float(w & 0xffff0000u); }
#define LDS_WAIT() asm volatile("s_waitcnt lgkmcnt(0)" ::: "memory")
__device__ __forceinline__ float wave_sum(float v) {
#pragma unroll
    for (int o = 1; o < 64; o <<= 1) v += __shfl_xor(v, o);
    return v;
}
__device__ __forceinline__ float wave_max(float v) {
#pragma unroll
    for (int o = 1; o < 64; o <<= 1) v = fmaxf(v, __shfl_xor(v, o));
    return v;
}

#define XB_TMO      128
#define XB_XCNT(j)  (256  + 64 * (j))
#define XB_XSUB(j)  (1280 + 64 * (j))
#define XB_XGEN(j)  (2304 + 64 * (j))
#define XB_TOP      3328
#define XB_TOPGEN   3392
#define XCD_BAR_WORDS 3456
#define XB_SPIN_CAP (1u << 18)
__device__ __forceinline__ unsigned xb_ld(unsigned* p)              { return __hip_atomic_load(p, __ATOMIC_RELAXED, __HIP_MEMORY_SCOPE_AGENT); }
__device__ __forceinline__ unsigned xb_add(unsigned* p, unsigned v) { return __hip_atomic_fetch_add(p, v, __ATOMIC_RELAXED, __HIP_MEMORY_SCOPE_AGENT); }
__device__ __forceinline__ unsigned xb_xcc_id() { return (unsigned)__builtin_amdgcn_s_getreg((3 << 11) | 20) & 0xFu; }
#define XB_SPIN(cond, bar) do { unsigned _sp = 0; while (cond) { __builtin_amdgcn_s_sleep(1); \
    if ((++_sp & 255u) == 0u) { if (xb_ld(&(bar)[XB_TMO])) break; if (_sp > XB_SPIN_CAP) { atomicAdd(&(bar)[XB_TMO], 1u); break; } } } } while (0)
struct XcdBarrier { unsigned* bar; unsigned x; volatile LAS unsigned* st; };
__device__ __forceinline__ XcdBarrier xcd_barrier_post(unsigned* bar, volatile LAS unsigned* st) {
    XcdBarrier b; b.bar = bar; b.x = xb_xcc_id(); b.st = st;
    if (threadIdx.x == 0) (void)xb_add(&bar[XB_XCNT(b.x)], 1u);
    return b;
}
__device__ __forceinline__ void xcd_barrier_complete(unsigned* bar, unsigned x, unsigned& nloc, unsigned& nx) {
    const unsigned G = gridDim.x * gridDim.y * gridDim.z;
    unsigned sum, cnt, mine, sp = 0u;
    for (;;) {
        sum = 0u; cnt = 0u; mine = 0u;
#pragma unroll
        for (unsigned j = 0; j < 16; ++j) { const unsigned c = xb_ld(&bar[XB_XCNT(j)]); sum += c; cnt += (c > 0u) ? 1u : 0u; mine = (j == x) ? c : mine; }
        if (sum == G) break;
        __builtin_amdgcn_s_sleep(1);
        if ((++sp & 255u) == 0u) { if (xb_ld(&bar[XB_TMO])) break; if (sp > XB_SPIN_CAP) { atomicAdd(&bar[XB_TMO], 1u); break; } }
    }
    nloc = mine > 0u ? mine : 1u; nx = cnt > 0u ? cnt : 1u;
}
__device__ __forceinline__ void xcd_barrier(const XcdBarrier& b) {
    asm volatile("s_waitcnt vmcnt(0)" ::: "memory");
    __syncthreads();
    if (threadIdx.x == 0) {
        unsigned* bar = b.bar;
        __builtin_amdgcn_s_waitcnt(0);
        unsigned nloc = b.st[0], nx = b.st[1];
        if (nloc == 0u) { xcd_barrier_complete(bar, b.x, nloc, nx); b.st[0] = nloc; b.st[1] = nx; }
        const unsigned old = xb_add(&bar[XB_XSUB(b.x)], 1u);
        const unsigned gen = old / nloc;
        if (old + 1u == (gen + 1u) * nloc) {
            __builtin_amdgcn_fence(__ATOMIC_RELEASE, "agent");
            asm volatile("s_waitcnt vmcnt(0)" ::: "memory");
            const unsigned og = xb_add(&bar[XB_TOP], 1u);
            const unsigned tg = og / nx;
            if (og + 1u == (tg + 1u) * nx) xb_add(&bar[XB_TOPGEN], 1u);
            else XB_SPIN(xb_ld(&bar[XB_TOPGEN]) == tg, bar);
            __builtin_amdgcn_fence(__ATOMIC_ACQUIRE, "agent");
            xb_add(&bar[XB_XGEN(b.x)], 1u);
            asm volatile("s_waitcnt vmcnt(0)" ::: "memory");
        } else {
            XB_SPIN(xb_ld(&bar[XB_XGEN(b.x)]) == gen, bar);
            __builtin_amdgcn_fence(__ATOMIC_ACQUIRE, "agent");
            asm volatile("s_waitcnt vmcnt(0)" ::: "memory");
        }
    }
    __syncthreads();
}

__device__ __forceinline__ void p0_transpose_item(const float* W, int K, int N, bf16_t* WT, int drow0, int k0, int n0, LAS float* scr, int lane) {
#pragma unroll 8
    for (int i = 0; i < 32; ++i) { const int kk = 2 * i + (lane >> 5); scr[kk * 33 + (lane & 31)] = W[(size_t)(k0 + kk) * N + n0 + (lane & 31)]; }
    LDS_WAIT(); asm volatile("" ::: "memory");
    const int c = lane & 7;
#pragma unroll
    for (int j = 0; j < 4; ++j) { const int n = (lane >> 3) + 8 * j; const LAS float* s = scr + (8 * c) * 33 + n;
        v4u o; o.x = pk2(s[0 * 33], s[1 * 33]); o.y = pk2(s[2 * 33], s[3 * 33]); o.z = pk2(s[4 * 33], s[5 * 33]); o.w = pk2(s[6 * 33], s[7 * 33]);
        *(v4u*)(WT + (size_t)(drow0 + n) * K + k0 + 8 * c) = o; }
    LDS_WAIT(); asm volatile("" ::: "memory");
}
__device__ __forceinline__ void p0_plain(const float* W, int K, int N, bf16_t* WT, int item, LAS float* scr, int lane) {
    const int nblk = N / 32, kb = item / nblk, nb = item % nblk;
    p0_transpose_item(W, K, N, WT, 32 * nb, 64 * kb, 32 * nb, scr, lane);
}
__device__ __forceinline__ void rms_row_to_bf16(const float* xrow, const float* g, bf16_t* orow, int lane) {
    const f32x4* xr = (const f32x4*)xrow + lane; const f32x4* gr = (const f32x4*)g + lane;
    f32x4 v[4]; float s = 0.f;
#pragma unroll
    for (int j = 0; j < 4; ++j) { v[j] = xr[64 * j]; s += (v[j].x * v[j].x + v[j].y * v[j].y) + (v[j].z * v[j].z + v[j].w * v[j].w); }
    const float rinv = 1.0f / sqrtf(wave_sum(s) * (1.f / 1024.f) + NORM_EPS);
    v2u* o8 = (v2u*)orow + lane;
#pragma unroll
    for (int j = 0; j < 4; ++j) { const f32x4 gg = gr[64 * j]; v2u w; w.x = pk2(v[j].x * rinv * gg.x, v[j].y * rinv * gg.y); w.y = pk2(v[j].z * rinv * gg.z, v[j].w * rinv * gg.w); o8[64 * j] = w; }
}

template <int NB, class RowPtr, class Epi>
__device__ __forceinline__ void ngemm_tile(const RowPtr& rp, const bf16_t* Bt, int ldb, int b1off, int K, int m0, int n0, int mvalid, const Epi& epi, LAS float* sm) {
    const int t = threadIdx.x, r = t >> 2, kq = (t & 3) * 4, ty = t >> 5, tx = t & 31;
    LAS float* As = sm; LAS float* Bs0 = sm + 16 * 132; LAS float* Bs1 = sm + 32 * 132;
    float acc[NB][8][4];
#pragma unroll
    for (int b = 0; b < NB; ++b)
#pragma unroll
        for (int i = 0; i < 8; ++i)
#pragma unroll
            for (int j = 0; j < 4; ++j) acc[b][i][j] = 0.f;
    const bf16_t* arow = rp(m0 + r) + kq;
    const bf16_t* brow0 = Bt + (size_t)(n0 + r) * ldb + kq;
    const bf16_t* brow1 = Bt + (size_t)(n0 + b1off + r) * ldb + kq;
    for (int k0 = 0; k0 < K; k0 += 16) {
        const v2u av = *(const v2u*)(arow + k0);
        const v2u bv0 = *(const v2u*)(brow0 + k0);
        v2u bv1 = bv0; if (NB == 2) bv1 = *(const v2u*)(brow1 + k0);
        As[(kq + 0) * 132 + r] = lo16(av.x); As[(kq + 1) * 132 + r] = hi16(av.x); As[(kq + 2) * 132 + r] = lo16(av.y); As[(kq + 3) * 132 + r] = hi16(av.y);
        Bs0[(kq + 0) * 132 + r] = lo16(bv0.x); Bs0[(kq + 1) * 132 + r] = hi16(bv0.x); Bs0[(kq + 2) * 132 + r] = lo16(bv0.y); Bs0[(kq + 3) * 132 + r] = hi16(bv0.y);
        if (NB == 2) { Bs1[(kq + 0) * 132 + r] = lo16(bv1.x); Bs1[(kq + 1) * 132 + r] = hi16(bv1.x); Bs1[(kq + 2) * 132 + r] = lo16(bv1.y); Bs1[(kq + 3) * 132 + r] = hi16(bv1.y); }
        __syncthreads();
#pragma unroll 2
        for (int kk = 0; kk < 16; ++kk) {
            const f32x4 a0 = *(const LAS f32x4*)(As + kk * 132 + ty * 8), a1 = *(const LAS f32x4*)(As + kk * 132 + ty * 8 + 4);
            const f32x4 b0 = *(const LAS f32x4*)(Bs0 + kk * 132 + tx * 4);
            const float a[8] = {a0.x, a0.y, a0.z, a0.w, a1.x, a1.y, a1.z, a1.w};
#pragma unroll
            for (int i = 0; i < 8; ++i) { acc[0][i][0] += a[i] * b0.x; acc[0][i][1] += a[i] * b0.y; acc[0][i][2] += a[i] * b0.z; acc[0][i][3] += a[i] * b0.w; }
            if (NB == 2) { const f32x4 b1 = *(const LAS f32x4*)(Bs1 + kk * 132 + tx * 4);
#pragma unroll
                for (int i = 0; i < 8; ++i) { acc[NB - 1][i][0] += a[i] * b1.x; acc[NB - 1][i][1] += a[i] * b1.y; acc[NB - 1][i][2] += a[i] * b1.z; acc[NB - 1][i][3] += a[i] * b1.w; } }
        }
        __syncthreads();
    }
#pragma unroll
    for (int i = 0; i < 8; ++i) { const int m = m0 + ty * 8 + i;
        if (m < mvalid) {
#pragma unroll
            for (int j = 0; j < 4; ++j) epi(m, n0 + tx * 4 + j, acc[0][i][j], acc[NB - 1][i][j]); } }
}
struct RowPlain { const bf16_t* A; int lda; __device__ __forceinline__ const bf16_t* operator()(int m) const { return A + (size_t)m * lda; } };

template <class Epi>
__device__ __forceinline__ void ngemm_dense(const bf16_t* A, int lda, const bf16_t* Bt, int ldb, int Mr, int N, int K, const Epi& epi, LAS float* sm) {
    const int nn = N / 128, nunits = (Mr / 128) * nn; RowPlain rp{A, lda};
    for (int u = blockIdx.x; u < nunits; u += gridDim.x) ngemm_tile<1>(rp, Bt, ldb, 0, K, (u / nn) * 128, (u % nn) * 128, Mr, epi, sm);
}

struct EpiStoreBf16 { bf16_t* O; int ldc; __device__ __forceinline__ void operator()(int m, int n, float a, float) const { O[(size_t)m * ldc + n] = (bf16_t)f2bf(a); } };
struct EpiGate1 { const bf16_t* PR; float* T; __device__ __forceinline__ void operator()(int m, int n, float a, float) const { T[(size_t)m * D + n] = bf2f(PR[(size_t)m * NIN + C_GSB + n]) * a; } };
struct EpiGate2 { const bf16_t* PR; const float* T; bf16_t* MIX; __device__ __forceinline__ void operator()(int m, int n, float a, float) const {
    MIX[(size_t)m * D + n] = (bf16_t)f2bf(T[(size_t)m * D + n] + bf2f(PR[(size_t)m * NIN + C_GDF + n]) * a); } };
struct EpiResid { const float* base; float* out; __device__ __forceinline__ void operator()(int m, int n, float a, float) const { out[(size_t)m * D + n] = base[(size_t)m * D + n] + a; } };

struct Args { const void* in[26]; float* out; unsigned char* ws; int ph_lo, ph_hi; };
constexpr int NPHASE = 15;

__device__ __forceinline__ float softplus_f(float z) { return fmaxf(z, 0.f) + __logf(1.f + __expf(-fabsf(z))); }

__global__ void __launch_bounds__(NTHR, 2) fwd(Args args) {
    extern __shared__ __attribute__((aligned(16))) unsigned char lds[];
    LAS unsigned char* L = (LAS unsigned char*)lds;
    volatile LAS unsigned* MISC = (volatile LAS unsigned*)(L + MISC_OFF);
    const int tid = threadIdx.x, lane = tid & 63, wave = __builtin_amdgcn_readfirstlane(tid >> 6);
    const int G = gridDim.x;
    unsigned char* ws = args.ws;
    unsigned* ctl = (unsigned*)(ws + WS_CTL);
    const float* x = (const float*)args.in[0]; const float* mem = (const float*)args.in[1]; const int* positions = (const int*)args.in[2];
    const float* norm_mix = (const float*)args.in[3]; const float* w_in = (const float*)args.in[4];
    const float* lam_q1 = (const float*)args.in[5]; const float* lam_k1 = (const float*)args.in[6]; const float* lam_q2 = (const float*)args.in[7]; const float* lam_k2 = (const float*)args.in[8];
    const float* diff_subln = (const float*)args.in[9]; const float* w_up_sb = (const float*)args.in[10]; const float* w_up_diff = (const float*)args.in[11];
    const float* w_out = (const float*)args.in[12]; const float* norm_mem_q = (const float*)args.in[13]; const float* norm_mem_kv = (const float*)args.in[14];
    const float* w_mem_q = (const float*)args.in[15]; const float* w_mem_kv = (const float*)args.in[16]; const float* w_mem_o = (const float*)args.in[17];
    const float* norm_ffn = (const float*)args.in[18]; const float* w_router = (const float*)args.in[19]; const float* b_router = (const float*)args.in[20];
    const float* w_gate_up = (const float*)args.in[21]; const float* b_gate_up = (const float*)args.in[22]; const float* w_down = (const float*)args.in[23];
    const float* b_down = (const float*)args.in[24]; const float* norm_final = (const float*)args.in[25];
    bf16_t* WIN = (bf16_t*)(ws + WS_WIN); bf16_t* WUPSB = (bf16_t*)(ws + WS_WUPSB); bf16_t* WUPDF = (bf16_t*)(ws + WS_WUPDF); bf16_t* WOUT = (bf16_t*)(ws + WS_WOUT);
    bf16_t* WMQ = (bf16_t*)(ws + WS_WMQ); bf16_t* WMKV = (bf16_t*)(ws + WS_WMKV); bf16_t* WMO = (bf16_t*)(ws + WS_WMO);
    bf16_t* WGU = (bf16_t*)(ws + WS_WGU); bf16_t* WD = (bf16_t*)(ws + WS_WD);
    float* ROPEC = (float*)(ws + WS_ROPE); float* ROPES = ROPEC + (size_t)M * 32;
    int* TK_E = (int*)(ws + WS_TK); int* TK_POS = TK_E + (size_t)M * 4; float* TK_G = (float*)(TK_POS + (size_t)M * 4);
    bf16_t* XN = (bf16_t*)(ws + WS_XN); bf16_t* PR = (bf16_t*)(ws + WS_PR); bf16_t* OAT = (bf16_t*)(ws + WS_OAT); float* ODR = (float*)(ws + WS_ODR);
    bf16_t* MIX = (bf16_t*)(ws + WS_MIX); float* X1 = (float*)(ws + WS_X1); float* X2 = (float*)(ws + WS_X2);
    bf16_t* HM = (bf16_t*)(ws + WS_HM); bf16_t* KVM = (bf16_t*)(ws + WS_KVM); int* TLIST = (int*)(ws + WS_TLIST); float* GLIST = (float*)(ws + WS_GLIST);
    bf16_t* QM = (bf16_t*)(ws + WS_QM); bf16_t* OM = (bf16_t*)(ws + WS_OM); bf16_t* ACT = (bf16_t*)(ws + WS_ACT); bf16_t* YB = (bf16_t*)(ws + WS_YB);
    unsigned* CNT = ctl + CW_CNT;
    LAS float* smf = (LAS float*)L;
    LAS int* smi = (LAS int*)L;

    for (int u = tid; u < (LDS_BYTES - 131072) / 4; u += NTHR) ((LAS unsigned*)(L + 131072))[u] = 0u;
    __syncthreads();
#if !MK_PER_PHASE
    XcdBarrier bar = xcd_barrier_post(ctl + CW_BAR, MISC + 8);
#define GRID_BAR() xcd_barrier(bar)
#else
#define GRID_BAR() do {} while (0)
#endif
    const int lo = args.ph_lo, hi = args.ph_hi;
#define IN(k) (lo <= (k) && (k) < hi)
#define SEAM(k) do { if (IN(k) && IN((k) + 1)) GRID_BAR(); } while (0)
    const int gw = blockIdx.x * NWAVES + wave, NGW = G * NWAVES;

    if (IN(0)) {
        LAS float* scr = (LAS float*)(L + wave * 16384);
        constexpr int I_IN = 16 * 160, I_UP = 8 * 32, I_SQ = 16 * 32, I_KV = 16 * 64, I_GU1 = 16 * 64, I_GU = NE * I_GU1, I_D1 = 16 * 32, I_DN = NE * I_D1;
        constexpr int NITEMS = I_IN + 2 * I_UP + 3 * I_SQ + I_KV + I_GU + I_DN;
        for (int it = gw; it < NITEMS; it += NGW) {
            int r = it;
            if (r < I_IN) { p0_plain(w_in, 1024, NIN, WIN, r, scr, lane); continue; } r -= I_IN;
            if (r < I_UP) { p0_plain(w_up_sb, 512, 1024, WUPSB, r, scr, lane); continue; } r -= I_UP;
            if (r < I_UP) { p0_plain(w_up_diff, 512, 1024, WUPDF, r, scr, lane); continue; } r -= I_UP;
            if (r < I_SQ) { p0_plain(w_out, 1024, 1024, WOUT, r, scr, lane); continue; } r -= I_SQ;
            if (r < I_SQ) { p0_plain(w_mem_q, 1024, 1024, WMQ, r, scr, lane); continue; } r -= I_SQ;
            if (r < I_SQ) { p0_plain(w_mem_o, 1024, 1024, WMO, r, scr, lane); continue; } r -= I_SQ;
            if (r < I_KV) { p0_plain(w_mem_kv, 1024, 2048, WMKV, r, scr, lane); continue; } r -= I_KV;
            if (r < I_GU) { const int e = r / I_GU1, q = r % I_GU1, kb = q / 64, nb = q % 64, n0 = 32 * nb;
                const int half = n0 >> 10, j = n0 & 1023, drow0 = (j >> 7) * 256 + half * 128 + (j & 127);
                p0_transpose_item(w_gate_up + (size_t)e * 1024 * 2048, 1024, 2048, WGU + (size_t)e * 2048 * 1024, drow0, 64 * kb, n0, scr, lane); continue; } r -= I_GU;
            { const int e = r / I_D1, q = r % I_D1; p0_plain(w_down + (size_t)e * 1024 * 1024, 1024, 1024, WD + (size_t)e * 1024 * 1024, q, scr, lane); }
        }
        for (int m = gw; m < M; m += NGW) rms_row_to_bf16(x + (size_t)m * D, norm_mix, XN + (size_t)m * D, lane);
        for (int m = gw; m < MM; m += NGW) rms_row_to_bf16(mem + (size_t)m * D, norm_mem_kv, HM + (size_t)m * D, lane);
        for (int i = blockIdx.x * NTHR + tid; i < M * 32; i += G * NTHR) {
            const int m = i >> 5, f = i & 31;
            const double inv = exp2(-(double)f * (13.287712379549449 / 32.0));
            const double ang = (double)positions[m] * inv;
            const double kk = rint(ang * 0.15915494309189535);
            const float rf = (float)(ang - kk * 6.283185307179586);
            ROPEC[i] = __cosf(rf); ROPES[i] = __sinf(rf);
        }
    }
    SEAM(0);

    if (IN(1)) {
        ngemm_dense(XN, D, WIN, D, M, NIN, D, EpiStoreBf16{PR, NIN}, smf);
        ngemm_dense(HM, D, WMKV, D, MM, 2048, D, EpiStoreBf16{KVM, 2048}, smf);
    }
    SEAM(1);

    if (IN(2)) {
        for (int m = gw; m < M; m += NGW) {
            bf16_t* row = PR + (size_t)m * NIN;
            for (int c = lane; c < 512; c += 64) row[C_SBQ + c] = (bf16_t)f2bf(bf2f(row[C_SBQ + c]) * 0.125f);
            for (int p = lane; p < 512; p += 64) {
                const int blk = p >> 5, i = p & 31, c0 = C_DQ + blk * 64;
                const float cs = ROPEC[(size_t)m * 32 + i], sn = ROPES[(size_t)m * 32 + i];
                const float t1 = bf2f(row[c0 + i]), t2 = bf2f(row[c0 + i + 32]);
                const float sc = (blk < 8) ? 0.125f : 1.0f;
                row[c0 + i] = (bf16_t)f2bf((t1 * cs - t2 * sn) * sc); row[c0 + i + 32] = (bf16_t)f2bf((t2 * cs + t1 * sn) * sc);
            }
            for (int c = lane; c < 2048; c += 64) { const float g = bf2f(row[C_GSB + c]); row[C_GSB + c] = (bf16_t)f2bf(1.f / (1.f + __expf(-g))); }
        }
    }
    SEAM(2);

    if (IN(3)) {
        for (int g = blockIdx.x; g < 256; g += G) {
            const int rowid = g * 512 + tid, b = rowid >> 15, h = (rowid >> 12) & 7, t = rowid & 4095;
            const bf16_t* base = PR + (size_t)b * SEQ * NIN;
            v4u q[8]; float o[64];
            { const bf16_t* qp = base + (size_t)t * NIN + C_SBQ + h * 64;
#pragma unroll
              for (int c = 0; c < 8; ++c) q[c] = *(const v4u*)(qp + c * 8); }
#pragma unroll
            for (int d = 0; d < 64; ++d) o[d] = 0.f;
            float R = 0.f;
            for (int s = t - 1; s >= 0; --s) {
                const bf16_t* kp = base + (size_t)s * NIN + C_SBK + h * 64; const bf16_t* vp = base + (size_t)s * NIN + C_SBV + h * 64;
                float z = 0.f;
#pragma unroll
                for (int c = 0; c < 8; ++c) { const v4u w = *(const v4u*)(kp + c * 8);
                    z += lo16(q[c].x) * lo16(w.x) + hi16(q[c].x) * hi16(w.x) + lo16(q[c].y) * lo16(w.y) + hi16(q[c].y) * hi16(w.y) + lo16(q[c].z) * lo16(w.z) + hi16(q[c].z) * hi16(w.z) + lo16(q[c].w) * lo16(w.w) + hi16(q[c].w) * hi16(w.w); }
                const float sp = softplus_f(z);
                const float wgt = __expf(z - sp + R);
                R -= sp;
#pragma unroll
                for (int c = 0; c < 8; ++c) { const v4u w = *(const v4u*)(vp + c * 8);
                    o[c * 8 + 0] += wgt * lo16(w.x); o[c * 8 + 1] += wgt * hi16(w.x); o[c * 8 + 2] += wgt * lo16(w.y); o[c * 8 + 3] += wgt * hi16(w.y); o[c * 8 + 4] += wgt * lo16(w.z); o[c * 8 + 5] += wgt * hi16(w.z); o[c * 8 + 6] += wgt * lo16(w.w); o[c * 8 + 7] += wgt * hi16(w.w); }
            }
            bf16_t* op = OAT + (size_t)(b * SEQ + t) * D + h * 64;
#pragma unroll
            for (int c = 0; c < 8; ++c) { v4u w; w.x = pk2(o[c * 8 + 0], o[c * 8 + 1]); w.y = pk2(o[c * 8 + 2], o[c * 8 + 3]); w.z = pk2(o[c * 8 + 4], o[c * 8 + 5]); w.w = pk2(o[c * 8 + 6], o[c * 8 + 7]); *(v4u*)(op + c * 8) = w; }
        }
        for (int g = blockIdx.x; g < 512; g += G) {
            const int rowid = g * 512 + tid, t = rowid & 4095, vh = (rowid >> 12) & 1, j = (rowid >> 13) & 1, h = (rowid >> 14) & 3, b = rowid >> 16;
            const bf16_t* base = PR + (size_t)b * SEQ * NIN;
            v4u q[8]; float o[64];
            { const bf16_t* qp = base + (size_t)t * NIN + C_DQ + h * 128 + j * 64;
#pragma unroll
              for (int c = 0; c < 8; ++c) q[c] = *(const v4u*)(qp + c * 8); }
#pragma unroll
            for (int d = 0; d < 64; ++d) o[d] = 0.f;
            float mx = -INFINITY, l = 0.f;
            const int send = t | 63;
            for (int s = 0; s <= send; ++s) {
                const bf16_t* kp = base + (size_t)s * NIN + C_DK + h * 128 + j * 64; const bf16_t* vp = base + (size_t)s * NIN + C_DV + h * 128 + vh * 64;
                float z = 0.f;
#pragma unroll
                for (int c = 0; c < 8; ++c) { const v4u w = *(const v4u*)(kp + c * 8);
                    z += lo16(q[c].x) * lo16(w.x) + hi16(q[c].x) * hi16(w.x) + lo16(q[c].y) * lo16(w.y) + hi16(q[c].y) * hi16(w.y) + lo16(q[c].z) * lo16(w.z) + hi16(q[c].z) * hi16(w.z) + lo16(q[c].w) * lo16(w.w) + hi16(q[c].w) * hi16(w.w); }
                if (z > mx) { const float al = __expf(mx - z); l *= al;
#pragma unroll
                    for (int d = 0; d < 64; ++d) o[d] *= al;
                    mx = z; }
                const float p = __expf(z - mx); l += p;
#pragma unroll
                for (int c = 0; c < 8; ++c) { const v4u w = *(const v4u*)(vp + c * 8);
                    o[c * 8 + 0] += p * lo16(w.x); o[c * 8 + 1] += p * hi16(w.x); o[c * 8 + 2] += p * lo16(w.y); o[c * 8 + 3] += p * hi16(w.y); o[c * 8 + 4] += p * lo16(w.z); o[c * 8 + 5] += p * hi16(w.z); o[c * 8 + 6] += p * lo16(w.w); o[c * 8 + 7] += p * hi16(w.w); }
            }
            const float il = 1.f / l;
            float* op = ODR + ((size_t)j * M + (size_t)b * SEQ + t) * 512 + h * 128 + vh * 64;
#pragma unroll
            for (int c = 0; c < 16; ++c) *(f32x4*)(op + c * 4) = (f32x4){o[c * 4] * il, o[c * 4 + 1] * il, o[c * 4 + 2] * il, o[c * 4 + 3] * il};
        }
    }
    SEAM(3);

    if (IN(4)) {
        const float s1 = wave_sum(lam_q1[lane] * lam_k1[lane]), s2 = wave_sum(lam_q2[lane] * lam_k2[lane]);
        const float lam = expf(s1) - expf(s2) + 0.2f;
        for (int it = gw; it < M * 4; it += NGW) {
            const int m = it >> 2, h = it & 3;
            const float* p1 = ODR + (size_t)m * 512 + h * 128; const float* p2 = ODR + ((size_t)M + m) * 512 + h * 128;
            const float d0 = p1[lane] - lam * p2[lane], d1 = p1[lane + 64] - lam * p2[lane + 64];
            const float rinv = 1.0f / sqrtf(wave_sum(d0 * d0 + d1 * d1) * (1.f / 128.f) + NORM_EPS);
            bf16_t* op = OAT + (size_t)m * D + 512 + h * 128;
            op[lane] = (bf16_t)f2bf(d0 * rinv * diff_subln[lane] * 0.8f); op[lane + 64] = (bf16_t)f2bf(d1 * rinv * diff_subln[lane + 64] * 0.8f);
        }
    }
    SEAM(4);

    if (IN(5)) {
        ngemm_dense(OAT, D, WUPSB, 512, M, D, 512, EpiGate1{PR, X2}, smf);
        ngemm_dense(OAT + 512, D, WUPDF, 512, M, D, 512, EpiGate2{PR, X2, MIX}, smf);
    }
    SEAM(5);

    if (IN(6)) ngemm_dense(MIX, D, WOUT, D, M, D, D, EpiResid{x, X1}, smf);
    SEAM(6);

    if (IN(7)) for (int m = gw; m < M; m += NGW) rms_row_to_bf16(X1 + (size_t)m * D, norm_mem_q, XN + (size_t)m * D, lane);
    SEAM(7);

    if (IN(8)) ngemm_dense(XN, D, WMQ, D, M, D, D, EpiStoreBf16{QM, D}, smf);
    SEAM(8);

    if (IN(9)) {
        for (int it = gw; it < M * 4; it += NGW) {
            const int m = it >> 2, h = it & 3, b = m >> 12;
            const bf16_t* qp = QM + (size_t)m * D + h * 256;
            const bf16_t* kb = KVM + (size_t)(b * MEMLEN) * 2048 + h * 256;
            float z[4] = {0.f, 0.f, 0.f, 0.f};
            for (int c = 0; c < 32; ++c) {
                const v4u qw = *(const v4u*)(qp + c * 8);
                const float qf[8] = {lo16(qw.x), hi16(qw.x), lo16(qw.y), hi16(qw.y), lo16(qw.z), hi16(qw.z), lo16(qw.w), hi16(qw.w)};
#pragma unroll
                for (int i = 0; i < 4; ++i) { const v4u w = *(const v4u*)(kb + (size_t)(lane + 64 * i) * 2048 + c * 8);
                    z[i] += qf[0] * lo16(w.x) + qf[1] * hi16(w.x) + qf[2] * lo16(w.y) + qf[3] * hi16(w.y) + qf[4] * lo16(w.z) + qf[5] * hi16(w.z) + qf[6] * lo16(w.w) + qf[7] * hi16(w.w); }
            }
#pragma unroll
            for (int i = 0; i < 4; ++i) z[i] *= 0.0625f;
            const float mx = wave_max(fmaxf(fmaxf(z[0], z[1]), fmaxf(z[2], z[3])));
            float p[4]; float ls = 0.f;
#pragma unroll
            for (int i = 0; i < 4; ++i) { p[i] = __expf(z[i] - mx); ls += p[i]; }
            const float il = 1.f / wave_sum(ls);
            float o[4] = {0.f, 0.f, 0.f, 0.f};
            const bf16_t* vb = kb + 1024 + lane * 4;
#pragma unroll
            for (int i = 0; i < 4; ++i)
                for (int kk = 0; kk < 64; ++kk) { const float pk = __shfl(p[i], kk); const v2u w = *(const v2u*)(vb + (size_t)(kk + 64 * i) * 2048);
                    o[0] += pk * lo16(w.x); o[1] += pk * hi16(w.x); o[2] += pk * lo16(w.y); o[3] += pk * hi16(w.y); }
            v2u w; w.x = pk2(o[0] * il, o[1] * il); w.y = pk2(o[2] * il, o[3] * il);
            *(v2u*)(OM + (size_t)m * D + h * 256 + lane * 4) = w;
        }
    }
    SEAM(9);

    if (IN(10)) ngemm_dense(OM, D, WMO, D, M, D, D, EpiResid{X1, X2}, smf);
    SEAM(10);

    if (IN(11)) {
        LAS float* hrow = smf + wave * 1024;
        for (int m = gw; m < M; m += NGW) {
            const f32x4* xr = (const f32x4*)(X2 + (size_t)m * D) + lane; const f32x4* gr = (const f32x4*)norm_ffn + lane;
            f32x4 v[4]; float s = 0.f;
#pragma unroll
            for (int j = 0; j < 4; ++j) { v[j] = xr[64 * j]; s += (v[j].x * v[j].x + v[j].y * v[j].y) + (v[j].z * v[j].z + v[j].w * v[j].w); }
            const float rinv = 1.0f / sqrtf(wave_sum(s) * (1.f / 1024.f) + NORM_EPS);
            v2u* o8 = (v2u*)(XN + (size_t)m * D) + lane;
#pragma unroll
            for (int j = 0; j < 4; ++j) { const f32x4 gg = gr[64 * j]; const f32x4 hn = {v[j].x * rinv * gg.x, v[j].y * rinv * gg.y, v[j].z * rinv * gg.z, v[j].w * rinv * gg.w};
                v2u w; w.x = pk2(hn.x, hn.y); w.y = pk2(hn.z, hn.w); o8[64 * j] = w; *(LAS f32x4*)(hrow + (lane + 64 * j) * 4) = hn; }
            LDS_WAIT(); asm volatile("" ::: "memory");
            const int e = lane & 31, kh = lane >> 5;
            float acc = 0.f;
            const float* wr = w_router + (size_t)(kh * 512) * NE + e; const LAS float* hh = hrow + kh * 512;
#pragma unroll 8
            for (int k = 0; k < 512; ++k) acc += hh[k] * wr[(size_t)k * NE];
            acc += __shfl_xor(acc, 32);
            float logit = acc + b_router[e];
            LDS_WAIT(); asm volatile("" ::: "memory");
            float tv[4]; int ti[4]; float cur = logit;
#pragma unroll
            for (int k = 0; k < 4; ++k) {
                float bv = cur; int bi = e;
#pragma unroll
                for (int o = 1; o < 32; o <<= 1) { const float ov = __shfl_xor(bv, o); const int oi = __shfl_xor(bi, o); if (ov > bv || (ov == bv && oi < bi)) { bv = ov; bi = oi; } }
                tv[k] = bv; ti[k] = bi; if (e == bi) cur = -INFINITY;
            }
            const float e1 = __expf(tv[1] - tv[0]), e2 = __expf(tv[2] - tv[0]), e3 = __expf(tv[3] - tv[0]);
            const float isum = 1.f / (1.f + e1 + e2 + e3);
            if (lane < 4) {
                const int ek = lane == 0 ? ti[0] : lane == 1 ? ti[1] : lane == 2 ? ti[2] : ti[3];
                const float gk = (lane == 0 ? 1.f : lane == 1 ? e1 : lane == 2 ? e2 : e3) * isum;
                const int pos = (int)atomicAdd(&CNT[ek], 1u);
                TLIST[ek * LISTCAP + pos] = m; GLIST[ek * LISTCAP + pos] = gk;
                TK_E[m * 4 + lane] = ek; TK_POS[m * 4 + lane] = pos; TK_G[m * 4 + lane] = gk;
            }
        }
    }
    SEAM(11);

#define LOAD_BASES() do { __syncthreads(); if (tid == 0) { int b_ = 0; for (int e_ = 0; e_ < NE; ++e_) { const int c_ = (int)__hip_atomic_load(&CNT[e_], __ATOMIC_RELAXED, __HIP_MEMORY_SCOPE_AGENT); \
        smi[8192 + e_] = b_; smi[8256 + e_] = c_; b_ += (c_ + 255) & ~255; } } __syncthreads(); } while (0)

    if (IN(12)) {
        LOAD_BASES();
        int ubase = 0;
        for (int e = 0; e < NE; ++e) {
            const int cnt = smi[8256 + e], sb = smi[8192 + e], nrt = (cnt + 127) >> 7, nu = nrt * 8;
            const int* tl = TLIST + e * LISTCAP;
            auto rp = [=](int r) -> const bf16_t* { return XN + (size_t)(r < cnt ? tl[r] : 0) * D; };
            const float* bg = b_gate_up + (size_t)e * 2048; bf16_t* act = ACT + (size_t)sb * DFF;
            auto epi = [=](int r, int n, float a0, float a1) { const int j = (n >> 8) * 128 + (n & 127);
                float gl = fminf(a0 + bg[j], 7.0f); float li = fminf(fmaxf(a1 + bg[1024 + j], -7.0f), 7.0f);
                act[(size_t)r * DFF + j] = (bf16_t)f2bf(gl * (1.f / (1.f + __expf(-1.702f * gl))) * (li + 1.0f)); };
            int u = ((int)blockIdx.x - ubase) % G; if (u < 0) u += G;
            for (; u < nu; u += G) ngemm_tile<2>(rp, WGU + (size_t)e * 2048 * 1024, D, 128, D, (u >> 3) * 128, (u & 7) * 256, cnt, epi, smf);
            ubase = (ubase + nu) % G;
        }
    }
    SEAM(12);

    if (IN(13)) {
        LOAD_BASES();
        int ubase = 0;
        for (int e = 0; e < NE; ++e) {
            const int cnt = smi[8256 + e], sb = smi[8192 + e], nrt = (cnt + 127) >> 7, nu = nrt * 8;
            RowPlain rp{ACT + (size_t)sb * DFF, DFF};
            const float* bd = b_down + (size_t)e * D; const float* gl = GLIST + e * LISTCAP; bf16_t* yb = YB + (size_t)sb * D;
            auto epi = [=](int r, int n, float a0, float) { yb[(size_t)r * D + n] = (bf16_t)f2bf((a0 + bd[n]) * gl[r]); };
            int u = ((int)blockIdx.x - ubase) % G; if (u < 0) u += G;
            for (; u < nu; u += G) ngemm_tile<1>(rp, WD + (size_t)e * 1024 * 1024, DFF, 0, DFF, (u >> 3) * 128, (u & 7) * 128, cnt, epi, smf);
            ubase = (ubase + nu) % G;
        }
    }
    SEAM(13);

    if (IN(14)) {
        LOAD_BASES();
        for (int m = gw; m < M; m += NGW) {
            const f32x4* xr = (const f32x4*)(X2 + (size_t)m * D) + lane; const f32x4* gr = (const f32x4*)norm_final + lane;
            f32x4 v[4];
#pragma unroll
            for (int j = 0; j < 4; ++j) v[j] = xr[64 * j];
#pragma unroll
            for (int k = 0; k < 4; ++k) { const int slot = smi[8192 + TK_E[m * 4 + k]] + TK_POS[m * 4 + k]; const v2u* yr = (const v2u*)(YB + (size_t)slot * D) + lane;
#pragma unroll
                for (int j = 0; j < 4; ++j) { const v2u w = yr[64 * j]; v[j].x += lo16(w.x); v[j].y += hi16(w.x); v[j].z += lo16(w.y); v[j].w += hi16(w.y); } }
            float s = 0.f;
#pragma unroll
            for (int j = 0; j < 4; ++j) s += (v[j].x * v[j].x + v[j].y * v[j].y) + (v[j].z * v[j].z + v[j].w * v[j].w);
            const float rinv = 1.0f / sqrtf(wave_sum(s) * (1.f / 1024.f) + NORM_EPS);
            f32x4* orow = (f32x4*)(args.out + (size_t)m * D) + lane;
#pragma unroll
            for (int j = 0; j < 4; ++j) { const f32x4 gg = gr[64 * j]; orow[64 * j] = (f32x4){v[j].x * rinv * gg.x, v[j].y * rinv * gg.y, v[j].z * rinv * gg.z, v[j].w * rinv * gg.w}; }
        }
    }
#undef IN
#undef SEAM
}

extern "C" void kernel_launch(void* const* d_in, const int* in_sizes, int n_in, void* d_out, int out_size, void* d_ws, size_t ws_size, hipStream_t stream) {
    static int grid = 0;
    if (grid == 0) {
        if (n_in != 26 || out_size != M * D || ws_size < WS_END) { fprintf(stderr, "kernel_launch: unexpected sizes n_in %d out %d ws %zu\n", n_in, out_size, ws_size); grid = -1; return; }
        int dev = 0, cus = 0;
        if (hipGetDevice(&dev) != hipSuccess || hipDeviceGetAttribute(&cus, hipDeviceAttributeMultiprocessorCount, dev) != hipSuccess) { grid = -1; return; }
        if (hipFuncSetAttribute((const void*)fwd, hipFuncAttributeMaxDynamicSharedMemorySize, LDS_BYTES) != hipSuccess) { fprintf(stderr, "kernel_launch: hipFuncSetAttribute failed\n"); grid = -1; return; }
        int per_cu = 0;
        (void)hipOccupancyMaxActiveBlocksPerMultiprocessor(&per_cu, (const void*)fwd, NTHR, LDS_BYTES);
        (void)hipGetLastError();
        grid = cus;
    }
    if (grid < 0) return;
    (void)hipMemsetAsync((char*)d_ws + WS_CTL, 0, CTL_ZERO_BYTES, stream);
    Args a{};
    for (int i = 0; i < 26; ++i) a.in[i] = d_in[i];
    a.out = (float*)d_out; a.ws = (unsigned char*)d_ws;
#if MK_PER_PHASE
    for (int p = 0; p < NPHASE; ++p) { a.ph_lo = p; a.ph_hi = p + 1; hipLaunchKernelGGL(fwd, dim3(grid), dim3(NTHR), LDS_BYTES, stream, a); }
#else
    a.ph_lo = 0; a.ph_hi = NPHASE; hipLaunchKernelGGL(fwd, dim3(grid), dim3(NTHR), LDS_BYTES, stream, a);
#endif
}
```

```cpp
#include <hip/hip_runtime.h>
#include <cstdio>
#include <cstdint>

#ifndef MK_PER_PHASE
#define MK_PER_PHASE 0
#endif

#define GAS __attribute__((address_space(1)))
#define LAS __attribute__((address_space(3)))
typedef unsigned short bf16_t;
typedef unsigned v4u __attribute__((ext_vector_type(4)));
typedef unsigned v2u __attribute__((ext_vector_type(2)));
typedef float f32x4 __attribute__((ext_vector_type(4)));
typedef short bf16x8 __attribute__((ext_vector_type(8)));

constexpr int BATCH = 4, SEQ = 4096, D = 1024, M = BATCH * SEQ, NIN = 5120;
constexpr int MEMLEN = 256, MM = BATCH * MEMLEN;
constexpr int NE = 32, TOPK = 4, DFF = 1024;
constexpr float NORM_EPS = 1e-6f;
constexpr int C_SBQ = 0, C_SBK = 512, C_SBV = 1024, C_DQ = 1536, C_DK = 2048, C_DV = 2560, C_GSB = 3072, C_GDF = 4096;
constexpr int LISTCAP = 16384;
constexpr int SLOTS = 65536 + NE * 256;
constexpr int NWAVES = 8, NTHR = 512;

constexpr size_t MiB = 1u << 20;
constexpr size_t WS_CTL = 0, CTL_ZERO_BYTES = 1 * MiB;
constexpr size_t WS_WIN = 2 * MiB;
constexpr size_t WS_WUPSB = 12 * MiB;
constexpr size_t WS_WUPDF = 13 * MiB;
constexpr size_t WS_WOUT = 14 * MiB;
constexpr size_t WS_WMQ = 16 * MiB;
constexpr size_t WS_WMKV = 18 * MiB;
constexpr size_t WS_WMO = 22 * MiB;
constexpr size_t WS_ROPE = 24 * MiB;
constexpr size_t WS_TK = 28 * MiB;
constexpr size_t WS_WGU = 32 * MiB;
constexpr size_t WS_WD = 160 * MiB;
constexpr size_t WS_XN = 224 * MiB;
constexpr size_t WS_PR = 256 * MiB;
constexpr size_t WS_OAT = 416 * MiB;
constexpr size_t WS_ODR = 448 * MiB;
constexpr size_t WS_MIX = 512 * MiB;
constexpr size_t WS_X1 = 544 * MiB;
constexpr size_t WS_X2 = 608 * MiB;
constexpr size_t WS_HM = 672 * MiB;
constexpr size_t WS_KVM = 674 * MiB;
constexpr size_t WS_TLIST = 678 * MiB;
constexpr size_t WS_GLIST = 680 * MiB;
constexpr size_t WS_QM = 682 * MiB;
constexpr size_t WS_OM = 714 * MiB;
constexpr size_t WS_ACT = 256 * MiB;
constexpr size_t WS_YB = 746 * MiB;
constexpr size_t WS_END = 890 * MiB;
static_assert(WS_ACT + (size_t)SLOTS * 1024 * 2 <= WS_OAT, "ACT overlay");
static_assert(WS_YB + (size_t)SLOTS * 1024 * 2 <= WS_END, "YB");
constexpr int CW_CNT = 1024;
constexpr int CW_BAR = 4096;

constexpr int LDS_BYTES = 147456;
constexpr int MISC_OFF = 131072 + 320;

__device__ __forceinline__ float bf2f(bf16_t b) { return __uint_as_float(((unsigned)b) << 16); }
__device__ __forceinline__ unsigned f2bf(float f) { unsigned u = __float_as_uint(f); return (u + 0x7fffu + ((u >> 16) & 1u)) >> 16; }
__device__ __forceinline__ unsigned pk2(float lo, float hi) { return f2bf(lo) | (f2bf(hi) << 16); }
__device__ __forceinline__ float lo16(unsigned w) { return __uint_as_float(w << 16); }
__device__ __forceinline__ float hi16(unsigned w) { return __uint_as_float(w & 0xffff0000u); }
#define LDS_WAIT() asm volatile("s_waitcnt lgkmcnt(0)" ::: "memory")
__device__ __forceinline__ float wave_sum(float v) {
#pragma unroll
    for (int o = 1; o < 64; o <<= 1) v += __shfl_xor(v, o);
    return v;
}
__device__ __forceinline__ float wave_max(float v) {
#pragma unroll
    for (int o = 1; o < 64; o <<= 1) v = fmaxf(v, __shfl_xor(v, o));
    return v;
}

#define XB_TMO      128
#define XB_XCNT(j)  (256  + 64 * (j))
#define XB_XSUB(j)  (1280 + 64 * (j))
#define XB_XGEN(j)  (2304 + 64 * (j))
#define XB_TOP      3328
#define XB_TOPGEN   3392
#define XCD_BAR_WORDS 3456
#define XB_SPIN_CAP (1u << 18)
__device__ __forceinline__ unsigned xb_ld(unsigned* p)              { return __hip_atomic_load(p, __ATOMIC_RELAXED, __HIP_MEMORY_SCOPE_AGENT); }
__device__ __forceinline__ unsigned xb_add(unsigned* p, unsigned v) { return __hip_atomic_fetch_add(p, v, __ATOMIC_RELAXED, __HIP_MEMORY_SCOPE_AGENT); }
__device__ __forceinline__ unsigned xb_xcc_id() { return (unsigned)__builtin_amdgcn_s_getreg((3 << 11) | 20) & 0xFu; }
#define XB_SPIN(cond, bar) do { unsigned _sp = 0; while (cond) { __builtin_amdgcn_s_sleep(1); \
    if ((++_sp & 255u) == 0u) { if (xb_ld(&(bar)[XB_TMO])) break; if (_sp > XB_SPIN_CAP) { atomicAdd(&(bar)[XB_TMO], 1u); break; } } } } while (0)
struct XcdBarrier { unsigned* bar; unsigned x; volatile LAS unsigned* st; };
__device__ __forceinline__ XcdBarrier xcd_barrier_post(unsigned* bar, volatile LAS unsigned* st) {
    XcdBarrier b; b.bar = bar; b.x = xb_xcc_id(); b.st = st;
    if (threadIdx.x == 0) (void)xb_add(&bar[XB_XCNT(b.x)], 1u);
    return b;
}
__device__ __forceinline__ void xcd_barrier_complete(unsigned* bar, unsigned x, unsigned& nloc, unsigned& nx) {
    const unsigned G = gridDim.x * gridDim.y * gridDim.z;
    unsigned sum, cnt, mine, sp = 0u;
    for (;;) {
        sum = 0u; cnt = 0u; mine = 0u;
#pragma unroll
        for (unsigned j = 0; j < 16; ++j) { const unsigned c = xb_ld(&bar[XB_XCNT(j)]); sum += c; cnt += (c > 0u) ? 1u : 0u; mine = (j == x) ? c : mine; }
        if (sum == G) break;
        __builtin_amdgcn_s_sleep(1);
        if ((++sp & 255u) == 0u) { if (xb_ld(&bar[XB_TMO])) break; if (sp > XB_SPIN_CAP) { atomicAdd(&bar[XB_TMO], 1u); break; } }
    }
    nloc = mine > 0u ? mine : 1u; nx = cnt > 0u ? cnt : 1u;
}
__device__ __forceinline__ void xcd_barrier(const XcdBarrier& b) {
    asm volatile("s_waitcnt vmcnt(0)" ::: "memory");
    __syncthreads();
    if (threadIdx.x == 0) {
        unsigned* bar = b.bar;
        __builtin_amdgcn_s_waitcnt(0);
        unsigned nloc = b.st[0], nx = b.st[1];
        if (nloc == 0u) { xcd_barrier_complete(bar, b.x, nloc, nx); b.st[0] = nloc; b.st[1] = nx; }
        const unsigned old = xb_add(&bar[XB_XSUB(b.x)], 1u);
        const unsigned gen = old / nloc;
        if (old + 1u == (gen + 1u) * nloc) {
            __builtin_amdgcn_fence(__ATOMIC_RELEASE, "agent");
            asm volatile("s_waitcnt vmcnt(0)" ::: "memory");
            const unsigned og = xb_add(&bar[XB_TOP], 1u);
            const unsigned tg = og / nx;
            if (og + 1u == (tg + 1u) * nx) xb_add(&bar[XB_TOPGEN], 1u);
            else XB_SPIN(xb_ld(&bar[XB_TOPGEN]) == tg, bar);
            __builtin_amdgcn_fence(__ATOMIC_ACQUIRE, "agent");
            xb_add(&bar[XB_XGEN(b.x)], 1u);
            asm volatile("s_waitcnt vmcnt(0)" ::: "memory");
        } else {
            XB_SPIN(xb_ld(&bar[XB_XGEN(b.x)]) == gen, bar);
            __builtin_amdgcn_fence(__ATOMIC_ACQUIRE, "agent");
            asm volatile("s_waitcnt vmcnt(0)" ::: "memory");
        }
    }
    __syncthreads();
}

__device__ __forceinline__ void p0_transpose_item(const float* W, int K, int N, bf16_t* WT, int drow0, int k0, int n0, LAS float* scr, int lane) {
#pragma unroll 8
    for (int i = 0; i < 32; ++i) { const int kk = 2 * i + (lane >> 5); scr[kk * 33 + (lane & 31)] = W[(size_t)(k0 + kk) * N + n0 + (lane & 31)]; }
    LDS_WAIT(); asm volatile("" ::: "memory");
    const int c = lane & 7;
#pragma unroll
    for (int j = 0; j < 4; ++j) { const int n = (lane >> 3) + 8 * j; const LAS float* s = scr + (8 * c) * 33 + n;
        v4u o; o.x = pk2(s[0 * 33], s[1 * 33]); o.y = pk2(s[2 * 33], s[3 * 33]); o.z = pk2(s[4 * 33], s[5 * 33]); o.w = pk2(s[6 * 33], s[7 * 33]);
        *(v4u*)(WT + (size_t)(drow0 + n) * K + k0 + 8 * c) = o; }
    LDS_WAIT(); asm volatile("" ::: "memory");
}
__device__ __forceinline__ void p0_plain(const float* W, int K, int N, bf16_t* WT, int item, LAS float* scr, int lane) {
    const int nblk = N / 32, kb = item / nblk, nb = item % nblk;
    p0_transpose_item(W, K, N, WT, 32 * nb, 64 * kb, 32 * nb, scr, lane);
}
__device__ __forceinline__ void rms_row_to_bf16(const float* xrow, const float* g, bf16_t* orow, int lane) {
    const f32x4* xr = (const f32x4*)xrow + lane; const f32x4* gr = (const f32x4*)g + lane;
    f32x4 v[4]; float s = 0.f;
#pragma unroll
    for (int j = 0; j < 4; ++j) { v[j] = xr[64 * j]; s += (v[j].x * v[j].x + v[j].y * v[j].y) + (v[j].z * v[j].z + v[j].w * v[j].w); }
    const float rinv = 1.0f / sqrtf(wave_sum(s) * (1.f / 1024.f) + NORM_EPS);
    v2u* o8 = (v2u*)orow + lane;
#pragma unroll
    for (int j = 0; j < 4; ++j) { const f32x4 gg = gr[64 * j]; v2u w; w.x = pk2(v[j].x * rinv * gg.x, v[j].y * rinv * gg.y); w.y = pk2(v[j].z * rinv * gg.z, v[j].w * rinv * gg.w); o8[64 * j] = w; }
}

template <int NB, class RowPtr, class Epi>
__device__ __forceinline__ void ngemm_tile(const RowPtr& rp, const bf16_t* Bt, int ldb, int b1off, int K, int m0, int n0, int mvalid, const Epi& epi, LAS float* sm) {
    const int t = threadIdx.x, r = t >> 2, kq = (t & 3) * 4, ty = t >> 5, tx = t & 31;
    LAS float* As = sm; LAS float* Bs0 = sm + 16 * 132; LAS float* Bs1 = sm + 32 * 132;
    float acc[NB][8][4];
#pragma unroll
    for (int b = 0; b < NB; ++b)
#pragma unroll
        for (int i = 0; i < 8; ++i)
#pragma unroll
            for (int j = 0; j < 4; ++j) acc[b][i][j] = 0.f;
    const bf16_t* arow = rp(m0 + r) + kq;
    const bf16_t* brow0 = Bt + (size_t)(n0 + r) * ldb + kq;
    const bf16_t* brow1 = Bt + (size_t)(n0 + b1off + r) * ldb + kq;
    for (int k0 = 0; k0 < K; k0 += 16) {
        const v2u av = *(const v2u*)(arow + k0);
        const v2u bv0 = *(const v2u*)(brow0 + k0);
        v2u bv1 = bv0; if (NB == 2) bv1 = *(const v2u*)(brow1 + k0);
        As[(kq + 0) * 132 + r] = lo16(av.x); As[(kq + 1) * 132 + r] = hi16(av.x); As[(kq + 2) * 132 + r] = lo16(av.y); As[(kq + 3) * 132 + r] = hi16(av.y);
        Bs0[(kq + 0) * 132 + r] = lo16(bv0.x); Bs0[(kq + 1) * 132 + r] = hi16(bv0.x); Bs0[(kq + 2) * 132 + r] = lo16(bv0.y); Bs0[(kq + 3) * 132 + r] = hi16(bv0.y);
        if (NB == 2) { Bs1[(kq + 0) * 132 + r] = lo16(bv1.x); Bs1[(kq + 1) * 132 + r] = hi16(bv1.x); Bs1[(kq + 2) * 132 + r] = lo16(bv1.y); Bs1[(kq + 3) * 132 + r] = hi16(bv1.y); }
        __syncthreads();
#pragma unroll 2
        for (int kk = 0; kk < 16; ++kk) {
            const f32x4 a0 = *(const LAS f32x4*)(As + kk * 132 + ty * 8), a1 = *(const LAS f32x4*)(As + kk * 132 + ty * 8 + 4);
            const f32x4 b0 = *(const LAS f32x4*)(Bs0 + kk * 132 + tx * 4);
            const float a[8] = {a0.x, a0.y, a0.z, a0.w, a1.x, a1.y, a1.z, a1.w};
#pragma unroll
            for (int i = 0; i < 8; ++i) { acc[0][i][0] += a[i] * b0.x; acc[0][i][1] += a[i] * b0.y; acc[0][i][2] += a[i] * b0.z; acc[0][i][3] += a[i] * b0.w; }
            if (NB == 2) { const f32x4 b1 = *(const LAS f32x4*)(Bs1 + kk * 132 + tx * 4);
#pragma unroll
                for (int i = 0; i < 8; ++i) { acc[NB - 1][i][0] += a[i] * b1.x; acc[NB - 1][i][1] += a[i] * b1.y; acc[NB - 1][i][2] += a[i] * b1.z; acc[NB - 1][i][3] += a[i] * b1.w; } }
        }
        __syncthreads();
    }
#pragma unroll
    for (int i = 0; i < 8; ++i) { const int m = m0 + ty * 8 + i;
        if (m < mvalid) {
#pragma unroll
            for (int j = 0; j < 4; ++j) epi(m, n0 + tx * 4 + j, acc[0][i][j], acc[NB - 1][i][j]); } }
}
struct RowPlain { const bf16_t* A; int lda; __device__ __forceinline__ const bf16_t* operator()(int m) const { return A + (size_t)m * lda; } };

template <class Epi>
__device__ __forceinline__ void ngemm_dense(const bf16_t* A, int lda, const bf16_t* Bt, int ldb, int Mr, int N, int K, const Epi& epi, LAS float* sm) {
    const int nn = N / 128, nunits = (Mr / 128) * nn; RowPlain rp{A, lda};
    for (int u = blockIdx.x; u < nunits; u += gridDim.x) ngemm_tile<1>(rp, Bt, ldb, 0, K, (u / nn) * 128, (u % nn) * 128, Mr, epi, sm);
}

struct EpiStoreBf16 { bf16_t* O; int ldc; __device__ __forceinline__ void operator()(int m, int n, float a, float) const { O[(size_t)m * ldc + n] = (bf16_t)f2bf(a); } };
struct EpiGate1 { const bf16_t* PR; float* T; __device__ __forceinline__ void operator()(int m, int n, float a, float) const { T[(size_t)m * D + n] = bf2f(PR[(size_t)m * NIN + C_GSB + n]) * a; } };
struct EpiGate2 { const bf16_t* PR; const float* T; bf16_t* MIX; __device__ __forceinline__ void operator()(int m, int n, float a, float) const {
    MIX[(size_t)m * D + n] = (bf16_t)f2bf(T[(size_t)m * D + n] + bf2f(PR[(size_t)m * NIN + C_GDF + n]) * a); } };
struct EpiResid { const float* base; float* out; __device__ __forceinline__ void operator()(int m, int n, float a, float) const { out[(size_t)m * D + n] = base[(size_t)m * D + n] + a; } };

struct Args { const void* in[26]; float* out; unsigned char* ws; int ph_lo, ph_hi; };
constexpr int NPHASE = 15;

__device__ __forceinline__ float softplus_f(float z) { return fmaxf(z, 0.f) + __logf(1.f + __expf(-fabsf(z))); }

__global__ void __launch_bounds__(NTHR, 2) fwd(Args args) {
    extern __shared__ __attribute__((aligned(16))) unsigned char lds[];
    LAS unsigned char* L = (LAS unsigned char*)lds;
    volatile LAS unsigned* MISC = (volatile LAS unsigned*)(L + MISC_OFF);
    const int tid = threadIdx.x, lane = tid & 63, wave = __builtin_amdgcn_readfirstlane(tid >> 6);
    const int G = gridDim.x;
    unsigned char* ws = args.ws;
    unsigned* ctl = (unsigned*)(ws + WS_CTL);
    const float* x = (const float*)args.in[0]; const float* mem = (const float*)args.in[1]; const int* positions = (const int*)args.in[2];
    const float* norm_mix = (const float*)args.in[3]; const float* w_in = (const float*)args.in[4];
    const float* lam_q1 = (const float*)args.in[5]; const float* lam_k1 = (const float*)args.in[6]; const float* lam_q2 = (const float*)args.in[7]; const float* lam_k2 = (const float*)args.in[8];
    const float* diff_subln = (const float*)args.in[9]; const float* w_up_sb = (const float*)args.in[10]; const float* w_up_diff = (const float*)args.in[11];
    const float* w_out = (const float*)args.in[12]; const float* norm_mem_q = (const float*)args.in[13]; const float* norm_mem_kv = (const float*)args.in[14];
    const float* w_mem_q = (const float*)args.in[15]; const float* w_mem_kv = (const float*)args.in[16]; const float* w_mem_o = (const float*)args.in[17];
    const float* norm_ffn = (const float*)args.in[18]; const float* w_router = (const float*)args.in[19]; const float* b_router = (const float*)args.in[20];
    const float* w_gate_up = (const float*)args.in[21]; const float* b_gate_up = (const float*)args.in[22]; const float* w_down = (const float*)args.in[23];
    const float* b_down = (const float*)args.in[24]; const float* norm_final = (const float*)args.in[25];
    bf16_t* WIN = (bf16_t*)(ws + WS_WIN); bf16_t* WUPSB = (bf16_t*)(ws + WS_WUPSB); bf16_t* WUPDF = (bf16_t*)(ws + WS_WUPDF); bf16_t* WOUT = (bf16_t*)(ws + WS_WOUT);
    bf16_t* WMQ = (bf16_t*)(ws + WS_WMQ); bf16_t* WMKV = (bf16_t*)(ws + WS_WMKV); bf16_t* WMO = (bf16_t*)(ws + WS_WMO);
    bf16_t* WGU = (bf16_t*)(ws + WS_WGU); bf16_t* WD = (bf16_t*)(ws + WS_WD);
    float* ROPEC = (float*)(ws + WS_ROPE); float* ROPES = ROPEC + (size_t)M * 32;
    int* TK_E = (int*)(ws + WS_TK); int* TK_POS = TK_E + (size_t)M * 4; float* TK_G = (float*)(TK_POS + (size_t)M * 4);
    bf16_t* XN = (bf16_t*)(ws + WS_XN); bf16_t* PR = (bf16_t*)(ws + WS_PR); bf16_t* OAT = (bf16_t*)(ws + WS_OAT); float* ODR = (float*)(ws + WS_ODR);
    bf16_t* MIX = (bf16_t*)(ws + WS_MIX); float* X1 = (float*)(ws + WS_X1); float* X2 = (float*)(ws + WS_X2);
    bf16_t* HM = (bf16_t*)(ws + WS_HM); bf16_t* KVM = (bf16_t*)(ws + WS_KVM); int* TLIST = (int*)(ws + WS_TLIST); float* GLIST = (float*)(ws + WS_GLIST);
    bf16_t* QM = (bf16_t*)(ws + WS_QM); bf16_t* OM = (bf16_t*)(ws + WS_OM); bf16_t* ACT = (bf16_t*)(ws + WS_ACT); bf16_t* YB = (bf16_t*)(ws + WS_YB);
    unsigned* CNT = ctl + CW_CNT;
    LAS float* smf = (LAS float*)L;
    LAS int* smi = (LAS int*)L;

    for (int u = tid; u < (LDS_BYTES - 131072) / 4; u += NTHR) ((LAS unsigned*)(L + 131072))[u] = 0u;
    __syncthreads();
#if !MK_PER_PHASE
    XcdBarrier bar = xcd_barrier_post(ctl + CW_BAR, MISC + 8);
#define GRID_BAR() xcd_barrier(bar)
#else
#define GRID_BAR() do {} while (0)
#endif
    const int lo = args.ph_lo, hi = args.ph_hi;
#define IN(k) (lo <= (k) && (k) < hi)
#define SEAM(k) do { if (IN(k) && IN((k) + 1)) GRID_BAR(); } while (0)
    const int gw = blockIdx.x * NWAVES + wave, NGW = G * NWAVES;

    if (IN(0)) {
        LAS float* scr = (LAS float*)(L + wave * 16384);
        constexpr int I_IN = 16 * 160, I_UP = 8 * 32, I_SQ = 16 * 32, I_KV = 16 * 64, I_GU1 = 16 * 64, I_GU = NE * I_GU1, I_D1 = 16 * 32, I_DN = NE * I_D1;
        constexpr int NITEMS = I_IN + 2 * I_UP + 3 * I_SQ + I_KV + I_GU + I_DN;
        for (int it = gw; it < NITEMS; it += NGW) {
            int r = it;
            if (r < I_IN) { p0_plain(w_in, 1024, NIN, WIN, r, scr, lane); continue; } r -= I_IN;
            if (r < I_UP) { p0_plain(w_up_sb, 512, 1024, WUPSB, r, scr, lane); continue; } r -= I_UP;
            if (r < I_UP) { p0_plain(w_up_diff, 512, 1024, WUPDF, r, scr, lane); continue; } r -= I_UP;
            if (r < I_SQ) { p0_plain(w_out, 1024, 1024, WOUT, r, scr, lane); continue; } r -= I_SQ;
            if (r < I_SQ) { p0_plain(w_mem_q, 1024, 1024, WMQ, r, scr, lane); continue; } r -= I_SQ;
            if (r < I_SQ) { p0_plain(w_mem_o, 1024, 1024, WMO, r, scr, lane); continue; } r -= I_SQ;
            if (r < I_KV) { p0_plain(w_mem_kv, 1024, 2048, WMKV, r, scr, lane); continue; } r -= I_KV;
            if (r < I_GU) { const int e = r / I_GU1, q = r % I_GU1, kb = q / 64, nb = q % 64, n0 = 32 * nb;
                const int half = n0 >> 10, j = n0 & 1023, drow0 = (j >> 7) * 256 + half * 128 + (j & 127);
                p0_transpose_item(w_gate_up + (size_t)e * 1024 * 2048, 1024, 2048, WGU + (size_t)e * 2048 * 1024, drow0, 64 * kb, n0, scr, lane); continue; } r -= I_GU;
            { const int e = r / I_D1, q = r % I_D1; p0_plain(w_down + (size_t)e * 1024 * 1024, 1024, 1024, WD + (size_t)e * 1024 * 1024, q, scr, lane); }
        }
        for (int m = gw; m < M; m += NGW) rms_row_to_bf16(x + (size_t)m * D, norm_mix, XN + (size_t)m * D, lane);
        for (int m = gw; m < MM; m += NGW) rms_row_to_bf16(mem + (size_t)m * D, norm_mem_kv, HM + (size_t)m * D, lane);
        for (int i = blockIdx.x * NTHR + tid; i < M * 32; i += G * NTHR) {
            const int m = i >> 5, f = i & 31;
            const double inv = exp2(-(double)f * (13.287712379549449 / 32.0));
            const double ang = (double)positions[m] * inv;
            const double kk = rint(ang * 0.15915494309189535);
            const float rf = (float)(ang - kk * 6.283185307179586);
            ROPEC[i] = __cosf(rf); ROPES[i] = __sinf(rf);
        }
    }
    SEAM(0);

    if (IN(1)) {
        ngemm_dense(XN, D, WIN, D, M, NIN, D, EpiStoreBf16{PR, NIN}, smf);
        ngemm_dense(HM, D, WMKV, D, MM, 2048, D, EpiStoreBf16{KVM, 2048}, smf);
    }
    SEAM(1);

    if (IN(2)) {
        for (int m = gw; m < M; m += NGW) {
            bf16_t* row = PR + (size_t)m * NIN;
            for (int c = lane; c < 512; c += 64) row[C_SBQ + c] = (bf16_t)f2bf(bf2f(row[C_SBQ + c]) * 0.125f);
            for (int p = lane; p < 512; p += 64) {
                const int blk = p >> 5, i = p & 31, c0 = C_DQ + blk * 64;
                const float cs = ROPEC[(size_t)m * 32 + i], sn = ROPES[(size_t)m * 32 + i];
                const float t1 = bf2f(row[c0 + i]), t2 = bf2f(row[c0 + i + 32]);
                const float sc = (blk < 8) ? 0.125f : 1.0f;
                row[c0 + i] = (bf16_t)f2bf((t1 * cs - t2 * sn) * sc); row[c0 + i + 32] = (bf16_t)f2bf((t2 * cs + t1 * sn) * sc);
            }
            for (int c = lane; c < 2048; c += 64) { const float g = bf2f(row[C_GSB + c]); row[C_GSB + c] = (bf16_t)f2bf(1.f / (1.f + __expf(-g))); }
        }
    }
    SEAM(2);

    if (IN(3)) {
        for (int g = blockIdx.x; g < 256; g += G) {
            const int rowid = g * 512 + tid, b = rowid >> 15, h = (rowid >> 12) & 7, t = rowid & 4095;
            const bf16_t* base = PR + (size_t)b * SEQ * NIN;
            v4u q[8]; float o[64];
            { const bf16_t* qp = base + (size_t)t * NIN + C_SBQ + h * 64;
#pragma unroll
              for (int c = 0; c < 8; ++c) q[c] = *(const v4u*)(qp + c * 8); }
#pragma unroll
            for (int d = 0; d < 64; ++d) o[d] = 0.f;
            float R = 0.f;
            for (int s = t - 1; s >= 0; --s) {
                const bf16_t* kp = base + (size_t)s * NIN + C_SBK + h * 64; const bf16_t* vp = base + (size_t)s * NIN + C_SBV + h * 64;
                float z = 0.f;
#pragma unroll
                for (int c = 0; c < 8; ++c) { const v4u w = *(const v4u*)(kp + c * 8);
                    z += lo16(q[c].x) * lo16(w.x) + hi16(q[c].x) * hi16(w.x) + lo16(q[c].y) * lo16(w.y) + hi16(q[c].y) * hi16(w.y) + lo16(q[c].z) * lo16(w.z) + hi16(q[c].z) * hi16(w.z) + lo16(q[c].w) * lo16(w.w) + hi16(q[c].w) * hi16(w.w); }
                const float sp = softplus_f(z);
                const float wgt = __expf(z - sp + R);
                R -= sp;
#pragma unroll
                for (int c = 0; c < 8; ++c) { const v4u w = *(const v4u*)(vp + c * 8);
                    o[c * 8 + 0] += wgt * lo16(w.x); o[c * 8 + 1] += wgt * hi16(w.x); o[c * 8 + 2] += wgt * lo16(w.y); o[c * 8 + 3] += wgt * hi16(w.y); o[c * 8 + 4] += wgt * lo16(w.z); o[c * 8 + 5] += wgt * hi16(w.z); o[c * 8 + 6] += wgt * lo16(w.w); o[c * 8 + 7] += wgt * hi16(w.w); }
            }
            bf16_t* op = OAT + (size_t)(b * SEQ + t) * D + h * 64;
#pragma unroll
            for (int c = 0; c < 8; ++c) { v4u w; w.x = pk2(o[c * 8 + 0], o[c * 8 + 1]); w.y = pk2(o[c * 8 + 2], o[c * 8 + 3]); w.z = pk2(o[c * 8 + 4], o[c * 8 + 5]); w.w = pk2(o[c * 8 + 6], o[c * 8 + 7]); *(v4u*)(op + c * 8) = w; }
        }
        for (int g = blockIdx.x; g < 512; g += G) {
            const int rowid = g * 512 + tid, t = rowid & 4095, vh = (rowid >> 12) & 1, j = (rowid >> 13) & 1, h = (rowid >> 14) & 3, b = rowid >> 16;
            const bf16_t* base = PR + (size_t)b * SEQ * NIN;
            v4u q[8]; float o[64];
            { const bf16_t* qp = base + (size_t)t * NIN + C_DQ + h * 128 + j * 64;
#pragma unroll
              for (int c = 0; c < 8; ++c) q[c] = *(const v4u*)(qp + c * 8); }
#pragma unroll
            for (int d = 0; d < 64; ++d) o[d] = 0.f;
            float mx = -INFINITY, l = 0.f;
            const int send = t | 63;
            for (int s = 0; s <= send; ++s) {
                const bf16_t* kp = base + (size_t)s * NIN + C_DK + h * 128 + j * 64; const bf16_t* vp = base + (size_t)s * NIN + C_DV + h * 128 + vh * 64;
                float z = 0.f;
#pragma unroll
                for (int c = 0; c < 8; ++c) { const v4u w = *(const v4u*)(kp + c * 8);
                    z += lo16(q[c].x) * lo16(w.x) + hi16(q[c].x) * hi16(w.x) + lo16(q[c].y) * lo16(w.y) + hi16(q[c].y) * hi16(w.y) + lo16(q[c].z) * lo16(w.z) + hi16(q[c].z) * hi16(w.z) + lo16(q[c].w) * lo16(w.w) + hi16(q[c].w) * hi16(w.w); }
                if (z > mx) { const float al = __expf(mx - z); l *= al;
#pragma unroll
                    for (int d = 0; d < 64; ++d) o[d] *= al;
                    mx = z; }
                const float p = __expf(z - mx); l += p;
#pragma unroll
                for (int c = 0; c < 8; ++c) { const v4u w = *(const v4u*)(vp + c * 8);
                    o[c * 8 + 0] += p * lo16(w.x); o[c * 8 + 1] += p * hi16(w.x); o[c * 8 + 2] += p * lo16(w.y); o[c * 8 + 3] += p * hi16(w.y); o[c * 8 + 4] += p * lo16(w.z); o[c * 8 + 5] += p * hi16(w.z); o[c * 8 + 6] += p * lo16(w.w); o[c * 8 + 7] += p * hi16(w.w); }
            }
            const float il = 1.f / l;
            float* op = ODR + ((size_t)j * M + (size_t)b * SEQ + t) * 512 + h * 128 + vh * 64;
#pragma unroll
            for (int c = 0; c < 16; ++c) *(f32x4*)(op + c * 4) = (f32x4){o[c * 4] * il, o[c * 4 + 1] * il, o[c * 4 + 2] * il, o[c * 4 + 3] * il};
        }
    }
    SEAM(3);

    if (IN(4)) {
        const float s1 = wave_sum(lam_q1[lane] * lam_k1[lane]), s2 = wave_sum(lam_q2[lane] * lam_k2[lane]);
        const float lam = expf(s1) - expf(s2) + 0.2f;
        for (int it = gw; it < M * 4; it += NGW) {
            const int m = it >> 2, h = it & 3;
            const float* p1 = ODR + (size_t)m * 512 + h * 128; const float* p2 = ODR + ((size_t)M + m) * 512 + h * 128;
            const float d0 = p1[lane] - lam * p2[lane], d1 = p1[lane + 64] - lam * p2[lane + 64];
            const float rinv = 1.0f / sqrtf(wave_sum(d0 * d0 + d1 * d1) * (1.f / 128.f) + NORM_EPS);
            bf16_t* op = OAT + (size_t)m * D + 512 + h * 128;
            op[lane] = (bf16_t)f2bf(d0 * rinv * diff_subln[lane] * 0.8f); op[lane + 64] = (bf16_t)f2bf(d1 * rinv * diff_subln[lane + 64] * 0.8f);
        }
    }
    SEAM(4);

    if (IN(5)) {
        ngemm_dense(OAT, D, WUPSB, 512, M, D, 512, EpiGate1{PR, X2}, smf);
        ngemm_dense(OAT + 512, D, WUPDF, 512, M, D, 512, EpiGate2{PR, X2, MIX}, smf);
    }
    SEAM(5);

    if (IN(6)) ngemm_dense(MIX, D, WOUT, D, M, D, D, EpiResid{x, X1}, smf);
    SEAM(6);

    if (IN(7)) for (int m = gw; m < M; m += NGW) rms_row_to_bf16(X1 + (size_t)m * D, norm_mem_q, XN + (size_t)m * D, lane);
    SEAM(7);

    if (IN(8)) ngemm_dense(XN, D, WMQ, D, M, D, D, EpiStoreBf16{QM, D}, smf);
    SEAM(8);

    if (IN(9)) {
        for (int it = gw; it < M * 4; it += NGW) {
            const int m = it >> 2, h = it & 3, b = m >> 12;
            const bf16_t* qp = QM + (size_t)m * D + h * 256;
            const bf16_t* kb = KVM + (size_t)(b * MEMLEN) * 2048 + h * 256;
            float z[4] = {0.f, 0.f, 0.f, 0.f};
            for (int c = 0; c < 32; ++c) {
                const v4u qw = *(const v4u*)(qp + c * 8);
                const float qf[8] = {lo16(qw.x), hi16(qw.x), lo16(qw.y), hi16(qw.y), lo16(qw.z), hi16(qw.z), lo16(qw.w), hi16(qw.w)};
#pragma unroll
                for (int i = 0; i < 4; ++i) { const v4u w = *(const v4u*)(kb + (size_t)(lane + 64 * i) * 2048 + c * 8);
                    z[i] += qf[0] * lo16(w.x) + qf[1] * hi16(w.x) + qf[2] * lo16(w.y) + qf[3] * hi16(w.y) + qf[4] * lo16(w.z) + qf[5] * hi16(w.z) + qf[6] * lo16(w.w) + qf[7] * hi16(w.w); }
            }
#pragma unroll
            for (int i = 0; i < 4; ++i) z[i] *= 0.0625f;
            const float mx = wave_max(fmaxf(fmaxf(z[0], z[1]), fmaxf(z[2], z[3])));
            float p[4]; float ls = 0.f;
#pragma unroll
            for (int i = 0; i < 4; ++i) { p[i] = __expf(z[i] - mx); ls += p[i]; }
            const float il = 1.f / wave_sum(ls);
            float o[4] = {0.f, 0.f, 0.f, 0.f};
            const bf16_t* vb = kb + 1024 + lane * 4;
#pragma unroll
            for (int i = 0; i < 4; ++i)
                for (int kk = 0; kk < 64; ++kk) { const float pk = __shfl(p[i], kk); const v2u w = *(const v2u*)(vb + (size_t)(kk + 64 * i) * 2048);
                    o[0] += pk * lo16(w.x); o[1] += pk * hi16(w.x); o[2] += pk * lo16(w.y); o[3] += pk * hi16(w.y); }
            v2u w; w.x = pk2(o[0] * il, o[1] * il); w.y = pk2(o[2] * il, o[3] * il);
            *(v2u*)(OM + (size_t)m * D + h * 256 + lane * 4) = w;
        }
    }
    SEAM(9);

    if (IN(10)) ngemm_dense(OM, D, WMO, D, M, D, D, EpiResid{X1, X2}, smf);
    SEAM(10);

    if (IN(11)) {
        LAS float* hrow = smf + wave * 1024;
        for (int m = gw; m < M; m += NGW) {
            const f32x4* xr = (const f32x4*)(X2 + (size_t)m * D) + lane; const f32x4* gr = (const f32x4*)norm_ffn + lane;
            f32x4 v[4]; float s = 0.f;
#pragma unroll
            for (int j = 0; j < 4; ++j) { v[j] = xr[64 * j]; s += (v[j].x * v[j].x + v[j].y * v[j].y) + (v[j].z * v[j].z + v[j].w * v[j].w); }
            const float rinv = 1.0f / sqrtf(wave_sum(s) * (1.f / 1024.f) + NORM_EPS);
            v2u* o8 = (v2u*)(XN + (size_t)m * D) + lane;
#pragma unroll
            for (int j = 0; j < 4; ++j) { const f32x4 gg = gr[64 * j]; const f32x4 hn = {v[j].x * rinv * gg.x, v[j].y * rinv * gg.y, v[j].z * rinv * gg.z, v[j].w * rinv * gg.w};
                v2u w; w.x = pk2(hn.x, hn.y); w.y = pk2(hn.z, hn.w); o8[64 * j] = w; *(LAS f32x4*)(hrow + (lane + 64 * j) * 4) = hn; }
            LDS_WAIT(); asm volatile("" ::: "memory");
            const int e = lane & 31, kh = lane >> 5;
            float acc = 0.f;
            const float* wr = w_router + (size_t)(kh * 512) * NE + e; const LAS float* hh = hrow + kh * 512;
#pragma unroll 8
            for (int k = 0; k < 512; ++k) acc += hh[k] * wr[(size_t)k * NE];
            acc += __shfl_xor(acc, 32);
            float logit = acc + b_router[e];
            LDS_WAIT(); asm volatile("" ::: "memory");
            float tv[4]; int ti[4]; float cur = logit;
#pragma unroll
            for (int k = 0; k < 4; ++k) {
                float bv = cur; int bi = e;
#pragma unroll
                for (int o = 1; o < 32; o <<= 1) { const float ov = __shfl_xor(bv, o); const int oi = __shfl_xor(bi, o); if (ov > bv || (ov == bv && oi < bi)) { bv = ov; bi = oi; } }
                tv[k] = bv; ti[k] = bi; if (e == bi) cur = -INFINITY;
            }
            const float e1 = __expf(tv[1] - tv[0]), e2 = __expf(tv[2] - tv[0]), e3 = __expf(tv[3] - tv[0]);
            const float isum = 1.f / (1.f + e1 + e2 + e3);
            if (lane < 4) {
                const int ek = lane == 0 ? ti[0] : lane == 1 ? ti[1] : lane == 2 ? ti[2] : ti[3];
                const float gk = (lane == 0 ? 1.f : lane == 1 ? e1 : lane == 2 ? e2 : e3) * isum;
                const int pos = (int)atomicAdd(&CNT[ek], 1u);
                TLIST[ek * LISTCAP + pos] = m; GLIST[ek * LISTCAP + pos] = gk;
                TK_E[m * 4 + lane] = ek; TK_POS[m * 4 + lane] = pos; TK_G[m * 4 + lane] = gk;
            }
        }
    }
    SEAM(11);

#define LOAD_BASES() do { __syncthreads(); if (tid == 0) { int b_ = 0; for (int e_ = 0; e_ < NE; ++e_) { const int c_ = (int)__hip_atomic_load(&CNT[e_], __ATOMIC_RELAXED, __HIP_MEMORY_SCOPE_AGENT); \
        smi[8192 + e_] = b_; smi[8256 + e_] = c_; b_ += (c_ + 255) & ~255; } } __syncthreads(); } while (0)

    if (IN(12)) {
        LOAD_BASES();
        int ubase = 0;
        for (int e = 0; e < NE; ++e) {
            const int cnt = smi[8256 + e], sb = smi[8192 + e], nrt = (cnt + 127) >> 7, nu = nrt * 8;
            const int* tl = TLIST + e * LISTCAP;
            auto rp = [=](int r) -> const bf16_t* { return XN + (size_t)(r < cnt ? tl[r] : 0) * D; };
            const float* bg = b_gate_up + (size_t)e * 2048; bf16_t* act = ACT + (size_t)sb * DFF;
            auto epi = [=](int r, int n, float a0, float a1) { const int j = (n >> 8) * 128 + (n & 127);
                float gl = fminf(a0 + bg[j], 7.0f); float li = fminf(fmaxf(a1 + bg[1024 + j], -7.0f), 7.0f);
                act[(size_t)r * DFF + j] = (bf16_t)f2bf(gl * (1.f / (1.f + __expf(-1.702f * gl))) * (li + 1.0f)); };
            int u = ((int)blockIdx.x - ubase) % G; if (u < 0) u += G;
            for (; u < nu; u += G) ngemm_tile<2>(rp, WGU + (size_t)e * 2048 * 1024, D, 128, D, (u >> 3) * 128, (u & 7) * 256, cnt, epi, smf);
            ubase = (ubase + nu) % G;
        }
    }
    SEAM(12);

    if (IN(13)) {
        LOAD_BASES();
        int ubase = 0;
        for (int e = 0; e < NE; ++e) {
            const int cnt = smi[8256 + e], sb = smi[8192 + e], nrt = (cnt + 127) >> 7, nu = nrt * 8;
            RowPlain rp{ACT + (size_t)sb * DFF, DFF};
            const float* bd = b_down + (size_t)e * D; const float* gl = GLIST + e * LISTCAP; bf16_t* yb = YB + (size_t)sb * D;
            auto epi = [=](int r, int n, float a0, float) { yb[(size_t)r * D + n] = (bf16_t)f2bf((a0 + bd[n]) * gl[r]); };
            int u = ((int)blockIdx.x - ubase) % G; if (u < 0) u += G;
            for (; u < nu; u += G) ngemm_tile<1>(rp, WD + (size_t)e * 1024 * 1024, DFF, 0, DFF, (u >> 3) * 128, (u & 7) * 128, cnt, epi, smf);
            ubase = (ubase + nu) % G;
        }
    }
    SEAM(13);

    if (IN(14)) {
        LOAD_BASES();
        for (int m = gw; m < M; m += NGW) {
            const f32x4* xr = (const f32x4*)(X2 + (size_t)m * D) + lane; const f32x4* gr = (const f32x4*)norm_final + lane;
            f32x4 v[4];
#pragma unroll
            for (int j = 0; j < 4; ++j) v[j] = xr[64 * j];
#pragma unroll
            for (int k = 0; k < 4; ++k) { const int slot = smi[8192 + TK_E[m * 4 + k]] + TK_POS[m * 4 + k]; const v2u* yr = (const v2u*)(YB + (size_t)slot * D) + lane;
#pragma unroll
                for (int j = 0; j < 4; ++j) { const v2u w = yr[64 * j]; v[j].x += lo16(w.x); v[j].y += hi16(w.x); v[j].z += lo16(w.y); v[j].w += hi16(w.y); } }
            float s = 0.f;
#pragma unroll
            for (int j = 0; j < 4; ++j) s += (v[j].x * v[j].x + v[j].y * v[j].y) + (v[j].z * v[j].z + v[j].w * v[j].w);
            const float rinv = 1.0f / sqrtf(wave_sum(s) * (1.f / 1024.f) + NORM_EPS);
            f32x4* orow = (f32x4*)(args.out + (size_t)m * D) + lane;
#pragma unroll
            for (int j = 0; j < 4; ++j) { const f32x4 gg = gr[64 * j]; orow[64 * j] = (f32x4){v[j].x * rinv * gg.x, v[j].y * rinv * gg.y, v[j].z * rinv * gg.z, v[j].w * rinv * gg.w}; }
        }
    }
#undef IN
#undef SEAM
}

extern "C" void kernel_launch(void* const* d_in, const int* in_sizes, int n_in, void* d_out, int out_size, void* d_ws, size_t ws_size, hipStream_t stream) {
    static int grid = 0;
    if (grid == 0) {
        if (n_in != 26 || out_size != M * D || ws_size < WS_END) { fprintf(stderr, "kernel_launch: unexpected sizes n_in %d out %d ws %zu\n", n_in, out_size, ws_size); grid = -1; return; }
        int dev = 0, cus = 0;
        if (hipGetDevice(&dev) != hipSuccess || hipDeviceGetAttribute(&cus, hipDeviceAttributeMultiprocessorCount, dev) != hipSuccess) { grid = -1; return; }
        if (hipFuncSetAttribute((const void*)fwd, hipFuncAttributeMaxDynamicSharedMemorySize, LDS_BYTES) != hipSuccess) { fprintf(stderr, "kernel_launch: hipFuncSetAttribute failed\n"); grid = -1; return; }
        int per_cu = 0;
        (void)hipOccupancyMaxActiveBlocksPerMultiprocessor(&per_cu, (const void*)fwd, NTHR, LDS_BYTES);
        (void)hipGetLastError();
        grid = cus;
    }
    if (grid < 0) return;
    (void)hipMemsetAsync((char*)d_ws + WS_CTL, 0, CTL_ZERO_BYTES, stream);
    Args a{};
    for (int i = 0; i < 26; ++i) a.in[i] = d_in[i];
    a.out = (float*)d_out; a.ws = (unsigned char*)d_ws;
#if MK_PER_PHASE
    for (int p = 0; p < NPHASE; ++p) { a.ph_lo = p; a.ph_hi = p + 1; hipLaunchKernelGGL(fwd, dim3(grid), dim3(NTHR), LDS_BYTES, stream, a); }
#else
    a.ph_lo = 0; a.ph_hi = NPHASE; hipLaunchKernelGGL(fwd, dim3(grid), dim3(NTHR), LDS_BYTES, stream, a);
#endif
}
```

```cpp
#include <hip/hip_runtime.h>
#include <cstdio>
#include <cstdint>

#ifndef MK_PER_PHASE
#define MK_PER_PHASE 0
#endif

#ifndef FAST_P1
#define FAST_P1 1
#endif
#ifndef FAST_P5
#define FAST_P5 1
#endif
#ifndef FAST_P6
#define FAST_P6 1
#endif
#ifndef FAST_MOE
#define FAST_MOE 1
#endif
#define GAS __attribute__((address_space(1)))
#define LAS __attribute__((address_space(3)))
typedef unsigned short bf16_t;
typedef unsigned v4u __attribute__((ext_vector_type(4)));
typedef unsigned v2u __attribute__((ext_vector_type(2)));
typedef float f32x4 __attribute__((ext_vector_type(4)));
typedef short bf16x8 __attribute__((ext_vector_type(8)));

constexpr int BATCH = 4, SEQ = 4096, D = 1024, M = BATCH * SEQ, NIN = 5120;
constexpr int MEMLEN = 256, MM = BATCH * MEMLEN;
constexpr int NE = 32, TOPK = 4, DFF = 1024;
constexpr float NORM_EPS = 1e-6f;
constexpr int C_SBQ = 0, C_SBK = 512, C_SBV = 1024, C_DQ = 1536, C_DK = 2048, C_DV = 2560, C_GSB = 3072, C_GDF = 4096;
constexpr int LISTCAP = 16384;
constexpr int SLOTS = 65536 + NE * 256;
constexpr int NWAVES = 8, NTHR = 512;

constexpr size_t MiB = 1u << 20;
constexpr size_t WS_CTL = 0, CTL_ZERO_BYTES = 1 * MiB;
constexpr size_t WS_WIN = 2 * MiB;
constexpr size_t WS_WUPSB = 12 * MiB;
constexpr size_t WS_WUPDF = 13 * MiB;
constexpr size_t WS_WOUT = 14 * MiB;
constexpr size_t WS_WMQ = 16 * MiB;
constexpr size_t WS_WMKV = 18 * MiB;
constexpr size_t WS_WMO = 22 * MiB;
constexpr size_t WS_ROPE = 24 * MiB;
constexpr size_t WS_TK = 28 * MiB;
constexpr size_t WS_WGU = 32 * MiB;
constexpr size_t WS_WD = 160 * MiB;
constexpr size_t WS_XN = 224 * MiB;
constexpr size_t WS_PR = 256 * MiB;
constexpr size_t WS_OAT = 416 * MiB;
constexpr size_t WS_ODR = 448 * MiB;
constexpr size_t WS_MIX = 512 * MiB;
constexpr size_t WS_X1 = 544 * MiB;
constexpr size_t WS_X2 = 608 * MiB;
constexpr size_t WS_HM = 672 * MiB;
constexpr size_t WS_KVM = 674 * MiB;
constexpr size_t WS_TLIST = 678 * MiB;
constexpr size_t WS_GLIST = 680 * MiB;
constexpr size_t WS_QM = 682 * MiB;
constexpr size_t WS_OM = 714 * MiB;
constexpr size_t WS_ACT = 256 * MiB;
constexpr size_t WS_YB = 746 * MiB;
constexpr size_t WS_END = 890 * MiB;
static_assert(WS_ACT + (size_t)SLOTS * 1024 * 2 <= WS_OAT, "ACT overlay");
static_assert(WS_YB + (size_t)SLOTS * 1024 * 2 <= WS_END, "YB");
constexpr int CW_CNT = 1024;
constexpr int CW_BAR = 4096;

constexpr int LDS_BYTES = 147456;
constexpr int MISC_OFF = 131072 + 320;

__device__ __forceinline__ float bf2f(bf16_t b) { return __uint_as_float(((unsigned)b) << 16); }
__device__ __forceinline__ unsigned f2bf(float f) { unsigned u = __float_as_uint(f); return (u + 0x7fffu + ((u >> 16) & 1u)) >> 16; }
__device__ __forceinline__ unsigned pk2(float lo, float hi) { return f2bf(lo) | (f2bf(hi) << 16); }
__device__ __forceinline__ float lo16(unsigned w) { return __uint_as_float(w << 16); }
__device__ __forceinline__ float hi16(unsigned w) { return __uint_as_float(w & 0xffff0000u); }
#define LDS_WAIT() asm volatile("s_waitcnt lgkmcnt(0)" ::: "memory")
__device__ __forceinline__ float wave_sum(float v) {
#pragma unroll
    for (int o = 1; o < 64; o <<= 1) v += __shfl_xor(v, o);
    return v;
}
__device__ __forceinline__ float wave_max(float v) {
#pragma unroll
    for (int o = 1; o < 64; o <<= 1) v = fmaxf(v, __shfl_xor(v, o));
    return v;
}

#define XB_TMO      128
#define XB_XCNT(j)  (256  + 64 * (j))
#define XB_XSUB(j)  (1280 + 64 * (j))
#define XB_XGEN(j)  (2304 + 64 * (j))
#define XB_TOP      3328
#define XB_TOPGEN   3392
#define XCD_BAR_WORDS 3456
#define XB_SPIN_CAP (1u << 18)
__device__ __forceinline__ unsigned xb_ld(unsigned* p)              { return __hip_atomic_load(p, __ATOMIC_RELAXED, __HIP_MEMORY_SCOPE_AGENT); }
__device__ __forceinline__ unsigned xb_add(unsigned* p, unsigned v) { return __hip_atomic_fetch_add(p, v, __ATOMIC_RELAXED, __HIP_MEMORY_SCOPE_AGENT); }
__device__ __forceinline__ unsigned xb_xcc_id() { return (unsigned)__builtin_amdgcn_s_getreg((3 << 11) | 20) & 0xFu; }
#define XB_SPIN(cond, bar) do { unsigned _sp = 0; while (cond) { __builtin_amdgcn_s_sleep(1); \
    if ((++_sp & 255u) == 0u) { if (xb_ld(&(bar)[XB_TMO])) break; if (_sp > XB_SPIN_CAP) { atomicAdd(&(bar)[XB_TMO], 1u); break; } } } } while (0)
struct XcdBarrier { unsigned* bar; unsigned x; volatile LAS unsigned* st; };
__device__ __forceinline__ XcdBarrier xcd_barrier_post(unsigned* bar, volatile LAS unsigned* st) {
    XcdBarrier b; b.bar = bar; b.x = xb_xcc_id(); b.st = st;
    if (threadIdx.x == 0) (void)xb_add(&bar[XB_XCNT(b.x)], 1u);
    return b;
}
__device__ __forceinline__ void xcd_barrier_complete(unsigned* bar, unsigned x, unsigned& nloc, unsigned& nx) {
    const unsigned G = gridDim.x * gridDim.y * gridDim.z;
    unsigned sum, cnt, mine, sp = 0u;
    for (;;) {
        sum = 0u; cnt = 0u; mine = 0u;
#pragma unroll
        for (unsigned j = 0; j < 16; ++j) { const unsigned c = xb_ld(&bar[XB_XCNT(j)]); sum += c; cnt += (c > 0u) ? 1u : 0u; mine = (j == x) ? c : mine; }
        if (sum == G) break;
        __builtin_amdgcn_s_sleep(1);
        if ((++sp & 255u) == 0u) { if (xb_ld(&bar[XB_TMO])) break; if (sp > XB_SPIN_CAP) { atomicAdd(&bar[XB_TMO], 1u); break; } }
    }
    nloc = mine > 0u ? mine : 1u; nx = cnt > 0u ? cnt : 1u;
}
__device__ __forceinline__ void xcd_barrier(const XcdBarrier& b) {
    asm volatile("s_waitcnt vmcnt(0)" ::: "memory");
    __syncthreads();
    if (threadIdx.x == 0) {
        unsigned* bar = b.bar;
        __builtin_amdgcn_s_waitcnt(0);
        unsigned nloc = b.st[0], nx = b.st[1];
        if (nloc == 0u) { xcd_barrier_complete(bar, b.x, nloc, nx); b.st[0] = nloc; b.st[1] = nx; }
        const unsigned old = xb_add(&bar[XB_XSUB(b.x)], 1u);
        const unsigned gen = old / nloc;
        if (old + 1u == (gen + 1u) * nloc) {
            __builtin_amdgcn_fence(__ATOMIC_RELEASE, "agent");
            asm volatile("s_waitcnt vmcnt(0)" ::: "memory");
            const unsigned og = xb_add(&bar[XB_TOP], 1u);
            const unsigned tg = og / nx;
            if (og + 1u == (tg + 1u) * nx) xb_add(&bar[XB_TOPGEN], 1u);
            else XB_SPIN(xb_ld(&bar[XB_TOPGEN]) == tg, bar);
            __builtin_amdgcn_fence(__ATOMIC_ACQUIRE, "agent");
            xb_add(&bar[XB_XGEN(b.x)], 1u);
            asm volatile("s_waitcnt vmcnt(0)" ::: "memory");
        } else {
            XB_SPIN(xb_ld(&bar[XB_XGEN(b.x)]) == gen, bar);
            __builtin_amdgcn_fence(__ATOMIC_ACQUIRE, "agent");
            asm volatile("s_waitcnt vmcnt(0)" ::: "memory");
        }
    }
    __syncthreads();
}

__device__ __forceinline__ void p0_transpose_item(const float* W, int K, int N, bf16_t* WT, int drow0, int k0, int n0, LAS float* scr, int lane) {
#pragma unroll 8
    for (int i = 0; i < 32; ++i) { const int kk = 2 * i + (lane >> 5); scr[kk * 33 + (lane & 31)] = W[(size_t)(k0 + kk) * N + n0 + (lane & 31)]; }
    LDS_WAIT(); asm volatile("" ::: "memory");
    const int c = lane & 7;
#pragma unroll
    for (int j = 0; j < 4; ++j) { const int n = (lane >> 3) + 8 * j; const LAS float* s = scr + (8 * c) * 33 + n;
        v4u o; o.x = pk2(s[0 * 33], s[1 * 33]); o.y = pk2(s[2 * 33], s[3 * 33]); o.z = pk2(s[4 * 33], s[5 * 33]); o.w = pk2(s[6 * 33], s[7 * 33]);
        *(v4u*)(WT + (size_t)(drow0 + n) * K + k0 + 8 * c) = o; }
    LDS_WAIT(); asm volatile("" ::: "memory");
}
__device__ __forceinline__ void p0_plain(const float* W, int K, int N, bf16_t* WT, int item, LAS float* scr, int lane) {
    const int nblk = N / 32, kb = item / nblk, nb = item % nblk;
    p0_transpose_item(W, K, N, WT, 32 * nb, 64 * kb, 32 * nb, scr, lane);
}
__device__ __forceinline__ void p0_transpose_rope(const float* W, bf16_t* WT, int tilebase, int o, int k0, int n0, LAS float* scr, int lane) {
    const int K = 1024, N = NIN;
#pragma unroll 8
    for (int i = 0; i < 32; ++i) { const int kk = 2 * i + (lane >> 5); scr[kk * 33 + (lane & 31)] = W[(size_t)(k0 + kk) * N + n0 + (lane & 31)]; }
    LDS_WAIT(); asm volatile("" ::: "memory");
    const int c = lane & 7;
#pragma unroll
    for (int j = 0; j < 4; ++j) { const int n = (lane >> 3) + 8 * j; const LAS float* s = scr + (8 * c) * 33 + n;
        const int oo = o + n, v = ((oo >> 6) << 6) | (((oo >> 4) & 1) << 5) | (((oo >> 2) & 3) << 3) | (((oo >> 5) & 1) << 2) | (oo & 3);
        v4u w; w.x = pk2(s[0 * 33], s[1 * 33]); w.y = pk2(s[2 * 33], s[3 * 33]); w.z = pk2(s[4 * 33], s[5 * 33]); w.w = pk2(s[6 * 33], s[7 * 33]);
        *(v4u*)(WT + (size_t)(tilebase + v) * K + k0 + 8 * c) = w; }
    LDS_WAIT(); asm volatile("" ::: "memory");
}
__device__ __forceinline__ void rms_row_to_bf16(const float* xrow, const float* g, bf16_t* orow, int lane) {
    const f32x4* xr = (const f32x4*)xrow + lane; const f32x4* gr = (const f32x4*)g + lane;
    f32x4 v[4]; float s = 0.f;
#pragma unroll
    for (int j = 0; j < 4; ++j) { v[j] = xr[64 * j]; s += (v[j].x * v[j].x + v[j].y * v[j].y) + (v[j].z * v[j].z + v[j].w * v[j].w); }
    const float rinv = 1.0f / sqrtf(wave_sum(s) * (1.f / 1024.f) + NORM_EPS);
    v2u* o8 = (v2u*)orow + lane;
#pragma unroll
    for (int j = 0; j < 4; ++j) { const f32x4 gg = gr[64 * j]; v2u w; w.x = pk2(v[j].x * rinv * gg.x, v[j].y * rinv * gg.y); w.y = pk2(v[j].z * rinv * gg.z, v[j].w * rinv * gg.w); o8[64 * j] = w; }
}

template <int NB, class RowPtr, class Epi>
__device__ __forceinline__ void ngemm_tile(const RowPtr& rp, const bf16_t* Bt, int ldb, int b1off, int K, int m0, int n0, int mvalid, const Epi& epi, LAS float* sm) {
    const int t = threadIdx.x, r = t >> 2, kq = (t & 3) * 4, ty = t >> 5, tx = t & 31;
    LAS float* As = sm; LAS float* Bs0 = sm + 16 * 132; LAS float* Bs1 = sm + 32 * 132;
    float acc[NB][8][4];
#pragma unroll
    for (int b = 0; b < NB; ++b)
#pragma unroll
        for (int i = 0; i < 8; ++i)
#pragma unroll
            for (int j = 0; j < 4; ++j) acc[b][i][j] = 0.f;
    const bf16_t* arow = rp(m0 + r) + kq;
    const bf16_t* brow0 = Bt + (size_t)(n0 + r) * ldb + kq;
    const bf16_t* brow1 = Bt + (size_t)(n0 + b1off + r) * ldb + kq;
    for (int k0 = 0; k0 < K; k0 += 16) {
        const v2u av = *(const v2u*)(arow + k0);
        const v2u bv0 = *(const v2u*)(brow0 + k0);
        v2u bv1 = bv0; if (NB == 2) bv1 = *(const v2u*)(brow1 + k0);
        As[(kq + 0) * 132 + r] = lo16(av.x); As[(kq + 1) * 132 + r] = hi16(av.x); As[(kq + 2) * 132 + r] = lo16(av.y); As[(kq + 3) * 132 + r] = hi16(av.y);
        Bs0[(kq + 0) * 132 + r] = lo16(bv0.x); Bs0[(kq + 1) * 132 + r] = hi16(bv0.x); Bs0[(kq + 2) * 132 + r] = lo16(bv0.y); Bs0[(kq + 3) * 132 + r] = hi16(bv0.y);
        if (NB == 2) { Bs1[(kq + 0) * 132 + r] = lo16(bv1.x); Bs1[(kq + 1) * 132 + r] = hi16(bv1.x); Bs1[(kq + 2) * 132 + r] = lo16(bv1.y); Bs1[(kq + 3) * 132 + r] = hi16(bv1.y); }
        __syncthreads();
#pragma unroll 2
        for (int kk = 0; kk < 16; ++kk) {
            const f32x4 a0 = *(const LAS f32x4*)(As + kk * 132 + ty * 8), a1 = *(const LAS f32x4*)(As + kk * 132 + ty * 8 + 4);
            const f32x4 b0 = *(const LAS f32x4*)(Bs0 + kk * 132 + tx * 4);
            const float a[8] = {a0.x, a0.y, a0.z, a0.w, a1.x, a1.y, a1.z, a1.w};
#pragma unroll
            for (int i = 0; i < 8; ++i) { acc[0][i][0] += a[i] * b0.x; acc[0][i][1] += a[i] * b0.y; acc[0][i][2] += a[i] * b0.z; acc[0][i][3] += a[i] * b0.w; }
            if (NB == 2) { const f32x4 b1 = *(const LAS f32x4*)(Bs1 + kk * 132 + tx * 4);
#pragma unroll
                for (int i = 0; i < 8; ++i) { acc[NB - 1][i][0] += a[i] * b1.x; acc[NB - 1][i][1] += a[i] * b1.y; acc[NB - 1][i][2] += a[i] * b1.z; acc[NB - 1][i][3] += a[i] * b1.w; } }
        }
        __syncthreads();
    }
#pragma unroll
    for (int i = 0; i < 8; ++i) { const int m = m0 + ty * 8 + i;
        if (m < mvalid) {
#pragma unroll
            for (int j = 0; j < 4; ++j) epi(m, n0 + tx * 4 + j, acc[0][i][j], acc[NB - 1][i][j]); } }
}
struct RowPlain { const bf16_t* A; int lda; __device__ __forceinline__ const bf16_t* operator()(int m) const { return A + (size_t)m * lda; } };

template <class Epi>
__device__ __forceinline__ void ngemm_dense(const bf16_t* A, int lda, const bf16_t* Bt, int ldb, int Mr, int N, int K, const Epi& epi, LAS float* sm) {
    const int nn = N / 128, nunits = (Mr / 128) * nn; RowPlain rp{A, lda};
    for (int u = blockIdx.x; u < nunits; u += gridDim.x) ngemm_tile<1>(rp, Bt, ldb, 0, K, (u / nn) * 128, (u % nn) * 128, Mr, epi, sm);
}

struct EpiStoreBf16 { bf16_t* O; int ldc; __device__ __forceinline__ void operator()(int m, int n, float a, float) const { O[(size_t)m * ldc + n] = (bf16_t)f2bf(a); } };
struct EpiGate1 { const bf16_t* PR; float* T; __device__ __forceinline__ void operator()(int m, int n, float a, float) const { T[(size_t)m * D + n] = bf2f(PR[(size_t)m * NIN + C_GSB + n]) * a; } };
struct EpiGate2 { const bf16_t* PR; const float* T; bf16_t* MIX; __device__ __forceinline__ void operator()(int m, int n, float a, float) const {
    MIX[(size_t)m * D + n] = (bf16_t)f2bf(T[(size_t)m * D + n] + bf2f(PR[(size_t)m * NIN + C_GDF + n]) * a); } };
struct EpiResid { const float* base; float* out; __device__ __forceinline__ void operator()(int m, int n, float a, float) const { out[(size_t)m * D + n] = base[(size_t)m * D + n] + a; } };


namespace pg8 {
constexpr int BM = 256, BK = 64, HALF = 128, HTB = HALF * BK * 2, STAGE_BYTES = 8 * HTB;
__host__ __device__ __forceinline__ int lds_byte(int r, int c) { const int st = (r >> 4) * 2 + (c >> 5), rr = r & 15, cc = c & 31, ob = rr * 64 + cc * 2; return st * 1024 + (ob ^ (((ob >> 9) & 1) << 5)); }
__host__ __device__ __forceinline__ void stage_rc(int b, int& R, int& C) { const int st = b / 1024, sb = b % 1024, swz = sb ^ (((sb >> 9) & 1) << 5); R = (st >> 1) * 16 + swz / 64; C = (st & 1) * 32 + (swz % 64) / 2; }
__host__ __device__ __forceinline__ int perm32(int rho) { const int n = rho >> 4, i = rho & 15; return 8 * (i >> 2) + 4 * n + (i & 3); }
struct Unit { int pm, pn, e; };
struct Gemm { const bf16_t* A; const bf16_t* Bt; int lda, ldb, K; };
typedef float f32x2 __attribute__((ext_vector_type(2))); typedef __bf16 bf16x2_t __attribute__((ext_vector_type(2)));
__device__ __forceinline__ unsigned cvt_pk_bf16(float lo, float hi) { f32x2 v = {lo, hi}; bf16x2_t b = __builtin_convertvector(v, bf16x2_t); return __builtin_bit_cast(unsigned, b); }

template <class Epi, class Sched, bool GATHER>
__device__ __forceinline__ void gemm_phase(LAS unsigned char* lds, const Gemm g, const Sched& S, const Epi& E) {
    const int tid = threadIdx.x, wid = __builtin_amdgcn_readfirstlane(tid >> 6), lane = tid & 63, wr = wid >> 2, wc = wid & 3, fr = lane & 15, fq = lane >> 4;
    const int K = g.K, nt = K / BK;
    unsigned voffB[2], cva[2][2], nva[2][2]; int Rr[2], Cc[2];
#pragma unroll
    for (int i = 0; i < 2; ++i) { int R, C; stage_rc(tid * 16 + i * 8192, R, C); Rr[i] = R; Cc[i] = C; const int Rb = (R & ~31) + perm32(R & 31);
        voffB[i] = (unsigned)(Rb * g.ldb + C) * 2u;
#pragma unroll
        for (int h = 0; h < 2; ++h) { cva[h][i] = (unsigned)((h * HALF + R) * g.lda + C) * 2u; nva[h][i] = cva[h][i]; } }
    const size_t kstep = (size_t)(BK * 2);
    const size_t hstepB = (size_t)HALF * g.ldb * 2;
    const unsigned ldsw = (unsigned)wid * 1024u;
    const int aoff = lds_byte(wr * 64 + fr, fq * 8), boff = lds_byte(wc * 32 + fr, fq * 8);
#define PG8_SA(b, h) (((b) * 2 + (h)) * HTB)
#define PG8_SB(b, h) ((4 + (b) * 2 + (h)) * HTB)
#define PG8_STAGE(bufoff, gbase, voff) do { _Pragma("unroll") for (int _i = 0; _i < 2; ++_i) \
        __builtin_amdgcn_global_load_lds((const unsigned*)((const char*)(gbase) + (voff)[_i]), (LAS unsigned*)(lds + (bufoff) + ldsw + _i * 8192), 16, 0, 0); } while (0)
#define PG8_LDA(dst, b, h) do { _Pragma("unroll") for (int m = 0; m < 4; ++m) _Pragma("unroll") for (int k = 0; k < 2; ++k) dst[m][k] = *(const LAS bf16x8*)(lds + PG8_SA(b, h) + aoff + m * 2048 + k * 1024); } while (0)
#define PG8_LDB(dst, b, h) do { _Pragma("unroll") for (int n = 0; n < 2; ++n) _Pragma("unroll") for (int k = 0; k < 2; ++k) dst[n][k] = *(const LAS bf16x8*)(lds + PG8_SB(b, h) + boff + n * 2048 + k * 1024); } while (0)
#define PG8_MMA(ai, bj, At, Bt) do { __builtin_amdgcn_s_setprio(1); _Pragma("unroll") for (int m = 0; m < 4; ++m) _Pragma("unroll") for (int n = 0; n < 2; ++n) _Pragma("unroll") for (int k = 0; k < 2; ++k) \
        acc[ai][bj][m][n] = __builtin_amdgcn_mfma_f32_16x16x32_bf16(Bt[n][k], At[m][k], acc[ai][bj][m][n], 0, 0, 0); __builtin_amdgcn_s_setprio(0); } while (0)
#define PG8_WAIT_V(n) asm volatile("s_waitcnt vmcnt(" #n ")" ::: "memory")
#define PG8_WAIT_L(n) asm volatile("s_waitcnt lgkmcnt(" #n ")" ::: "memory")
#define PG8_BAR __builtin_amdgcn_s_barrier()
#define PG8_SCHED __builtin_amdgcn_sched_barrier(0)
    Unit cur, nxt; int ui = 0;
    if (!S.next(0, cur)) return;
    if constexpr (GATHER) {
#pragma unroll
        for (int i = 0; i < 2; ++i)
#pragma unroll
            for (int h = 0; h < 2; ++h) cva[h][i] = (unsigned)(S.tok(cur, h * HALF + Rr[i]) * g.lda + Cc[i]) * 2u;
    }
    f32x4 acc[2][2][4][2];
#pragma unroll
    for (int a = 0; a < 2; ++a)
#pragma unroll
        for (int b = 0; b < 2; ++b)
#pragma unroll
            for (int m = 0; m < 4; ++m)
#pragma unroll
                for (int n = 0; n < 2; ++n) acc[a][b][m][n] = (f32x4){0.f, 0.f, 0.f, 0.f};
    bf16x8 At[4][2], B0[2][2], B1[2][2];
    const char* cA = (const char*)g.A + (GATHER ? (size_t)0 : S.a_off(cur)); const char* cB = (const char*)g.Bt + S.b_off(cur);
    PG8_STAGE(PG8_SB(0, 0), cB, voffB); PG8_STAGE(PG8_SB(0, 1), cB + hstepB, voffB); PG8_STAGE(PG8_SA(0, 0), cA, cva[0]); PG8_STAGE(PG8_SA(0, 1), cA, cva[1]);
    if (wr == 1) PG8_BAR;
    PG8_WAIT_V(2); PG8_BAR;
    PG8_STAGE(PG8_SB(1, 0), cB + kstep, voffB); PG8_STAGE(PG8_SA(1, 0), cA + kstep, cva[0]); PG8_STAGE(PG8_SB(1, 1), cB + hstepB + kstep, voffB);
    PG8_WAIT_V(6); PG8_BAR;
    for (;;) {
        const bool has_next = S.next(ui + 1, nxt);
        const char* nA = (has_next && !GATHER) ? (const char*)g.A + S.a_off(nxt) : cA; const char* nB = has_next ? (const char*)g.Bt + S.b_off(nxt) : cB;
        if constexpr (GATHER) {
#pragma unroll
            for (int i = 0; i < 2; ++i)
#pragma unroll
                for (int h = 0; h < 2; ++h) nva[h][i] = has_next ? (unsigned)(S.tok(nxt, h * HALF + Rr[i]) * g.lda + Cc[i]) * 2u : cva[h][i];
        }
        for (int t = 0; t < nt; t += 2) {
            const bool last = (t == nt - 2);
            const char* a1 = cA + (size_t)(t + 1) * kstep;
            const char* a2 = last ? nA : cA + (size_t)(t + 2) * kstep; const char* b2 = last ? nB : cB + (size_t)(t + 2) * kstep;
            const char* a3 = a2 + kstep; const char* b3 = b2 + kstep;
            unsigned v2[2][2];
#pragma unroll
            for (int h = 0; h < 2; ++h)
#pragma unroll
                for (int i = 0; i < 2; ++i) v2[h][i] = (GATHER && last) ? nva[h][i] : cva[h][i];
            PG8_LDB(B0, 0, 0); PG8_LDB(B1, 0, 1); PG8_SCHED; PG8_LDA(At, 0, 0); PG8_STAGE(PG8_SA(1, 1), a1, cva[1]);
            PG8_WAIT_V(8); PG8_WAIT_L(0); PG8_BAR; PG8_MMA(0, 0, At, B0); PG8_MMA(0, 1, At, B1); PG8_BAR; PG8_SCHED;
            PG8_LDA(At, 0, 1); PG8_STAGE(PG8_SB(0, 0), b2, voffB); PG8_STAGE(PG8_SB(0, 1), b2 + hstepB, voffB); PG8_STAGE(PG8_SA(0, 0), a2, v2[0]);
            PG8_WAIT_V(8); PG8_WAIT_L(0); PG8_BAR; PG8_MMA(1, 0, At, B0); PG8_MMA(1, 1, At, B1); PG8_BAR; PG8_SCHED;
            PG8_LDB(B0, 1, 0); PG8_LDB(B1, 1, 1); PG8_SCHED; PG8_LDA(At, 1, 0); PG8_STAGE(PG8_SA(0, 1), a2, v2[1]);
            PG8_WAIT_V(8); PG8_WAIT_L(0); PG8_BAR; PG8_MMA(0, 0, At, B0); PG8_MMA(0, 1, At, B1); PG8_BAR; PG8_SCHED;
            PG8_LDA(At, 1, 1); PG8_STAGE(PG8_SB(1, 0), b3, voffB); PG8_STAGE(PG8_SB(1, 1), b3 + hstepB, voffB); PG8_STAGE(PG8_SA(1, 0), a3, v2[0]);
            PG8_WAIT_V(8); PG8_WAIT_L(0); PG8_BAR; PG8_MMA(1, 0, At, B0); PG8_MMA(1, 1, At, B1); PG8_BAR; PG8_SCHED;
        }
        if (wr == 0) PG8_BAR;
        E(acc, cur, wr, wc, fr, fq);
        if (!has_next) break;
#pragma unroll
        for (int a = 0; a < 2; ++a)
#pragma unroll
            for (int b = 0; b < 2; ++b)
#pragma unroll
                for (int m = 0; m < 4; ++m)
#pragma unroll
                    for (int n = 0; n < 2; ++n) acc[a][b][m][n] = (f32x4){0.f, 0.f, 0.f, 0.f};
        cur = nxt; cA = nA; cB = nB; ++ui;
        if constexpr (GATHER) {
#pragma unroll
            for (int i = 0; i < 2; ++i)
#pragma unroll
                for (int h = 0; h < 2; ++h) cva[h][i] = nva[h][i];
        }
        if (wr == 1) PG8_BAR;
    }
    PG8_WAIT_V(0);
    PG8_BAR;
#undef PG8_SA
#undef PG8_SB
#undef PG8_STAGE
#undef PG8_LDA
#undef PG8_LDB
#undef PG8_MMA
#undef PG8_WAIT_V
#undef PG8_WAIT_L
#undef PG8_BAR
#undef PG8_SCHED
}

struct DenseOrder {
    int nM, nN, nwg, G, c, lda, ldb;
    __device__ __forceinline__ void init(int M_, int N_, int G_, int c_, int lda_, int ldb_) { nM = M_ / BM; nN = N_ / BM; nwg = nM * nN; G = G_; c = c_; lda = lda_; ldb = ldb_; }
    __device__ __forceinline__ bool next(int i, Unit& u) const {
        const long L = (long)i * G + c; if (L >= nwg) return false;
        int wgid = (int)L; { const int q = nwg / 8, r = nwg % 8, xcd = wgid % 8, off = wgid / 8; wgid = (xcd < r ? xcd * (q + 1) : r * (q + 1) + (xcd - r) * q) + off; }
        const int nig = 8 * nN, gid = wgid / nig, fm = gid * 8, gsz = (nM - fm) < 8 ? (nM - fm) : 8;
        u.pm = fm + ((wgid % nig) % gsz); u.pn = (wgid % nig) / gsz; u.e = 0; return true;
    }
    __device__ __forceinline__ size_t a_off(const Unit& u) const { return (size_t)u.pm * BM * lda * 2; }
    __device__ __forceinline__ size_t b_off(const Unit& u) const { return (size_t)u.pn * BM * ldb * 2; }
    __device__ __forceinline__ int tok(const Unit&, int) const { return 0; }
};
struct TwoRoundOrder {
    int G, c, lda, ldb;
    __device__ __forceinline__ bool next(int i, Unit& u) const { const int L = i * G + c; if (L >= 512) return false; const int tile = L & 255; u.pm = tile >> 2; u.pn = tile & 3; u.e = L >> 8; return true; }
    __device__ __forceinline__ size_t a_off(const Unit& u) const { return (size_t)u.pm * BM * lda * 2 + (size_t)u.e * 1024; }
    __device__ __forceinline__ size_t b_off(const Unit& u) const { return (size_t)(u.e * 1024 + u.pn * BM) * ldb * 2; }
    __device__ __forceinline__ int tok(const Unit&, int) const { return 0; }
};
struct MoeOrder {
    const LAS int* tb; const int* tlist; int G, c, npn, lda, ldb, nexp;
    __device__ __forceinline__ bool next(int i, Unit& u) const {
        const int L = i * G + c; if (L >= tb[96]) return false;
        int e = 0; while (tb[65 + e] <= L) ++e;
        const int loc = L - tb[64 + e]; u.e = e; u.pn = loc % npn; u.pm = (tb[e] >> 8) + loc / npn; return true;
    }
    __device__ __forceinline__ size_t a_off(const Unit& u) const { return (size_t)u.pm * BM * lda * 2; }
    __device__ __forceinline__ size_t b_off(const Unit& u) const { return (size_t)(u.e * nexp + u.pn * BM) * ldb * 2; }
    __device__ __forceinline__ int tok(const Unit& u, int row) const { const int r = u.pm * BM - tb[u.e] + row; return r < tb[32 + u.e] ? tlist[u.e * LISTCAP + r] : 0; }
};

#define EPI_ARGS const f32x4 (&acc)[2][2][4][2], const Unit& u, int wr, int wc, int fr, int fq
#define EPI_FOR_ROWS for (int ai = 0; ai < 2; ++ai) _Pragma("unroll") for (int m = 0; m < 4; ++m)
__device__ __forceinline__ v4u pack8(const f32x4 a, const f32x4 b) { v4u w; w.x = cvt_pk_bf16(a[0], a[1]); w.y = cvt_pk_bf16(a[2], a[3]); w.z = cvt_pk_bf16(b[0], b[1]); w.w = cvt_pk_bf16(b[2], b[3]); return w; }
__device__ __forceinline__ void unpack8(const v4u w, f32x4& a, f32x4& b) { a = (f32x4){lo16(w.x), hi16(w.x), lo16(w.y), hi16(w.y)}; b = (f32x4){lo16(w.z), hi16(w.z), lo16(w.w), hi16(w.w)}; }
__device__ __forceinline__ float sigm(float v) { return __builtin_amdgcn_rcpf(1.f + __expf(-v)); }

struct EpiBf16Store { bf16_t* O; int ldc;
    __device__ __forceinline__ void operator()(EPI_ARGS) const {
        const int row0 = u.pm * BM + wr * 64 + fr, col0 = u.pn * BM + wc * 32 + 8 * fq;
#pragma unroll
        EPI_FOR_ROWS { bf16_t* rowp = O + (size_t)(row0 + ai * HALF + m * 16) * ldc + col0;
#pragma unroll
            for (int bj = 0; bj < 2; ++bj) *(v4u*)(rowp + bj * HALF) = pack8(acc[ai][bj][m][0], acc[ai][bj][m][1]); }
    } };
struct EpiResidF32 { const float* base; float* out;
    __device__ __forceinline__ void operator()(EPI_ARGS) const {
        const int row0 = u.pm * BM + wr * 64 + fr, col0 = u.pn * BM + wc * 32 + 8 * fq;
#pragma unroll
        EPI_FOR_ROWS { const size_t off = (size_t)(row0 + ai * HALF + m * 16) * D + col0;
#pragma unroll
            for (int bj = 0; bj < 2; ++bj)
#pragma unroll
                for (int n = 0; n < 2; ++n) { const f32x4 b = *(const f32x4*)(base + off + bj * HALF + 4 * n); *(f32x4*)(out + off + bj * HALF + 4 * n) = b + acc[ai][bj][m][n]; } }
    } };
struct EpiGate { const bf16_t* PR; float* T; bf16_t* MIX;
    __device__ __forceinline__ void operator()(EPI_ARGS) const {
        const int row0 = u.pm * BM + wr * 64 + fr, col0 = u.pn * BM + wc * 32 + 8 * fq;
#pragma unroll
        EPI_FOR_ROWS { const int row = row0 + ai * HALF + m * 16;
#pragma unroll
            for (int bj = 0; bj < 2; ++bj) { const int col = col0 + bj * HALF; f32x4 g0, g1;
                unpack8(*(const v4u*)(PR + (size_t)row * NIN + (u.e ? C_GDF : C_GSB) + col), g0, g1);
                float* tp = T + (size_t)row * D + col;
                if (u.e == 0) { *(f32x4*)tp = g0 * acc[ai][bj][m][0]; *(f32x4*)(tp + 4) = g1 * acc[ai][bj][m][1]; }
                else { const f32x4 t0 = *(const f32x4*)tp, t1 = *(const f32x4*)(tp + 4); *(v4u*)(MIX + (size_t)row * D + col) = pack8(t0 + g0 * acc[ai][bj][m][0], t1 + g1 * acc[ai][bj][m][1]); } } }
    } };
struct EpiInProj { bf16_t* PR; const float* rc; const float* rs;
    __device__ __forceinline__ void operator()(EPI_ARGS) const {
        const int row0 = u.pm * BM + wr * 64 + fr, pn = u.pn;
        if (pn >= 6 && pn < 10) {
            const float sc = pn < 8 ? 0.125f : 1.0f; const int i0 = 16 * (wc & 1) + 4 * fq;
#pragma unroll
            EPI_FOR_ROWS { const int row = row0 + ai * HALF + m * 16; const f32x4 cs = *(const f32x4*)(rc + (size_t)row * 32 + i0), sn = *(const f32x4*)(rs + (size_t)row * 32 + i0);
#pragma unroll
                for (int bj = 0; bj < 2; ++bj) { const f32x4 lo = acc[ai][bj][m][0], hi = acc[ai][bj][m][1];
                    const f32x4 olo = (lo * cs - hi * sn) * sc, ohi = (hi * cs + lo * sn) * sc;
                    bf16_t* p = PR + (size_t)row * NIN + pn * BM + 64 * (2 * bj + (wc >> 1)) + i0;
                    v2u a, b; a.x = cvt_pk_bf16(olo[0], olo[1]); a.y = cvt_pk_bf16(olo[2], olo[3]); b.x = cvt_pk_bf16(ohi[0], ohi[1]); b.y = cvt_pk_bf16(ohi[2], ohi[3]);
                    *(v2u*)p = a; *(v2u*)(p + 32) = b; } }
        } else {
            const int col0 = pn * BM + wc * 32 + 8 * fq; const float sc = pn < 2 ? 0.125f : 1.0f; const bool sg = pn >= 12;
#pragma unroll
            EPI_FOR_ROWS { bf16_t* rowp = PR + (size_t)(row0 + ai * HALF + m * 16) * NIN + col0;
#pragma unroll
                for (int bj = 0; bj < 2; ++bj) { f32x4 v0 = acc[ai][bj][m][0] * sc, v1 = acc[ai][bj][m][1] * sc;
                    if (sg) { v0 = (f32x4){sigm(v0[0]), sigm(v0[1]), sigm(v0[2]), sigm(v0[3])}; v1 = (f32x4){sigm(v1[0]), sigm(v1[1]), sigm(v1[2]), sigm(v1[3])}; }
                    *(v4u*)(rowp + bj * HALF) = pack8(v0, v1); } }
        }
    } };
struct EpiMoeGU { bf16_t* ACT; const float* bgu;
    __device__ __forceinline__ void operator()(EPI_ARGS) const {
        const int row0 = u.pm * BM + wr * 64 + fr, j0 = u.pn * 128 + wc * 32 + 8 * fq; const float* bg = bgu + (size_t)u.e * 2048 + j0;
        const f32x4 bg0 = *(const f32x4*)bg, bg1 = *(const f32x4*)(bg + 4), bl0 = *(const f32x4*)(bg + 1024), bl1 = *(const f32x4*)(bg + 1028);
#pragma unroll
        EPI_FOR_ROWS { f32x4 o[2];
#pragma unroll
            for (int n = 0; n < 2; ++n) { const f32x4 gv = acc[ai][0][m][n] + (n ? bg1 : bg0), lv = acc[ai][1][m][n] + (n ? bl1 : bl0);
#pragma unroll
                for (int c = 0; c < 4; ++c) { const float gl = fminf(gv[c], 7.0f), li = fminf(fmaxf(lv[c], -7.0f), 7.0f); o[n][c] = gl * sigm(1.702f * gl) * (li + 1.0f); } }
            *(v4u*)(ACT + (size_t)(row0 + ai * HALF + m * 16) * DFF + j0) = pack8(o[0], o[1]); }
    } };
struct EpiMoeDown { bf16_t* YB; const float* bd; const float* glist; const LAS int* tb;
    __device__ __forceinline__ void operator()(EPI_ARGS) const {
        const int row0 = u.pm * BM + wr * 64 + fr, col0 = u.pn * BM + wc * 32 + 8 * fq; const float* bp = bd + (size_t)u.e * D + col0;
        const float* gl = glist + (size_t)u.e * LISTCAP - tb[u.e];
        f32x4 bv[2][2];
#pragma unroll
        for (int bj = 0; bj < 2; ++bj)
#pragma unroll
            for (int n = 0; n < 2; ++n) bv[bj][n] = *(const f32x4*)(bp + bj * HALF + 4 * n);
#pragma unroll
        EPI_FOR_ROWS { const int row = row0 + ai * HALF + m * 16; const float gt = gl[row];
#pragma unroll
            for (int bj = 0; bj < 2; ++bj) *(v4u*)(YB + (size_t)row * D + col0 + bj * HALF) = pack8((acc[ai][bj][m][0] + bv[bj][0]) * gt, (acc[ai][bj][m][1] + bv[bj][1]) * gt); }
    } };
}

struct Args { const void* in[26]; float* out; unsigned char* ws; int ph_lo, ph_hi; };
constexpr int NPHASE = 15;

__device__ __forceinline__ float softplus_f(float z) { return fmaxf(z, 0.f) + __logf(1.f + __expf(-fabsf(z))); }

__global__ void __launch_bounds__(NTHR, 2) fwd(Args args) {
    extern __shared__ __attribute__((aligned(16))) unsigned char lds[];
    LAS unsigned char* L = (LAS unsigned char*)lds;
    volatile LAS unsigned* MISC = (volatile LAS unsigned*)(L + MISC_OFF);
    const int tid = threadIdx.x, lane = tid & 63, wave = __builtin_amdgcn_readfirstlane(tid >> 6);
    const int G = gridDim.x;
    unsigned char* ws = args.ws;
    unsigned* ctl = (unsigned*)(ws + WS_CTL);
    const float* x = (const float*)args.in[0]; const float* mem = (const float*)args.in[1]; const int* positions = (const int*)args.in[2];
    const float* norm_mix = (const float*)args.in[3]; const float* w_in = (const float*)args.in[4];
    const float* lam_q1 = (const float*)args.in[5]; const float* lam_k1 = (const float*)args.in[6]; const float* lam_q2 = (const float*)args.in[7]; const float* lam_k2 = (const float*)args.in[8];
    const float* diff_subln = (const float*)args.in[9]; const float* w_up_sb = (const float*)args.in[10]; const float* w_up_diff = (const float*)args.in[11];
    const float* w_out = (const float*)args.in[12]; const float* norm_mem_q = (const float*)args.in[13]; const float* norm_mem_kv = (const float*)args.in[14];
    const float* w_mem_q = (const float*)args.in[15]; const float* w_mem_kv = (const float*)args.in[16]; const float* w_mem_o = (const float*)args.in[17];
    const float* norm_ffn = (const float*)args.in[18]; const float* w_router = (const float*)args.in[19]; const float* b_router = (const float*)args.in[20];
    const float* w_gate_up = (const float*)args.in[21]; const float* b_gate_up = (const float*)args.in[22]; const float* w_down = (const float*)args.in[23];
    const float* b_down = (const float*)args.in[24]; const float* norm_final = (const float*)args.in[25];
    bf16_t* WIN = (bf16_t*)(ws + WS_WIN); bf16_t* WUPSB = (bf16_t*)(ws + WS_WUPSB); bf16_t* WUPDF = (bf16_t*)(ws + WS_WUPDF); bf16_t* WOUT = (bf16_t*)(ws + WS_WOUT);
    bf16_t* WMQ = (bf16_t*)(ws + WS_WMQ); bf16_t* WMKV = (bf16_t*)(ws + WS_WMKV); bf16_t* WMO = (bf16_t*)(ws + WS_WMO);
    bf16_t* WGU = (bf16_t*)(ws + WS_WGU); bf16_t* WD = (bf16_t*)(ws + WS_WD);
    float* ROPEC = (float*)(ws + WS_ROPE); float* ROPES = ROPEC + (size_t)M * 32;
    int* TK_E = (int*)(ws + WS_TK); int* TK_POS = TK_E + (size_t)M * 4; float* TK_G = (float*)(TK_POS + (size_t)M * 4);
    bf16_t* XN = (bf16_t*)(ws + WS_XN); bf16_t* PR = (bf16_t*)(ws + WS_PR); bf16_t* OAT = (bf16_t*)(ws + WS_OAT); float* ODR = (float*)(ws + WS_ODR);
    bf16_t* MIX = (bf16_t*)(ws + WS_MIX); float* X1 = (float*)(ws + WS_X1); float* X2 = (float*)(ws + WS_X2);
    bf16_t* HM = (bf16_t*)(ws + WS_HM); bf16_t* KVM = (bf16_t*)(ws + WS_KVM); int* TLIST = (int*)(ws + WS_TLIST); float* GLIST = (float*)(ws + WS_GLIST);
    bf16_t* QM = (bf16_t*)(ws + WS_QM); bf16_t* OM = (bf16_t*)(ws + WS_OM); bf16_t* ACT = (bf16_t*)(ws + WS_ACT); bf16_t* YB = (bf16_t*)(ws + WS_YB);
    unsigned* CNT = ctl + CW_CNT;
    LAS float* smf = (LAS float*)L;
    LAS int* smi = (LAS int*)L;

    for (int u = tid; u < (LDS_BYTES - 131072) / 4; u += NTHR) ((LAS unsigned*)(L + 131072))[u] = 0u;
    __syncthreads();
#if !MK_PER_PHASE
    XcdBarrier bar = xcd_barrier_post(ctl + CW_BAR, MISC + 8);
#define GRID_BAR() xcd_barrier(bar)
#else
#define GRID_BAR() do {} while (0)
#endif
    const int lo = args.ph_lo, hi = args.ph_hi;
#define IN(k) (lo <= (k) && (k) < hi)
#define SEAM(k) do { if (IN(k) && IN((k) + 1)) GRID_BAR(); } while (0)
    const int gw = blockIdx.x * NWAVES + wave, NGW = G * NWAVES;

    if (IN(0)) {
        LAS float* scr = (LAS float*)(L + wave * 16384);
        constexpr int I_IN = 16 * 160, I_UP = 8 * 32, I_SQ = 16 * 32, I_KV = 16 * 64, I_GU1 = 16 * 64, I_GU = NE * I_GU1, I_D1 = 16 * 32, I_DN = NE * I_D1;
        constexpr int NITEMS = I_IN + 2 * I_UP + 3 * I_SQ + I_KV + I_GU + I_DN;
        for (int it = gw; it < NITEMS; it += NGW) {
            int r = it;
            if (r < I_IN) {
#if FAST_P1
                const int kb = r / 160, nb = r % 160, n0 = 32 * nb;
                if (n0 >= C_DQ && n0 < C_DV) { const int o = n0 & 255;
                    p0_transpose_rope(w_in, WIN, (n0 & ~255), o, 64 * kb, n0, scr, lane); }
                else p0_transpose_item(w_in, 1024, NIN, WIN, n0, 64 * kb, n0, scr, lane);
#else
                p0_plain(w_in, 1024, NIN, WIN, r, scr, lane);
#endif
                continue; } r -= I_IN;
            if (r < I_UP) { p0_plain(w_up_sb, 512, 1024, WUPSB, r, scr, lane); continue; } r -= I_UP;
            if (r < I_UP) { p0_plain(w_up_diff, 512, 1024, WUPDF, r, scr, lane); continue; } r -= I_UP;
            if (r < I_SQ) { p0_plain(w_out, 1024, 1024, WOUT, r, scr, lane); continue; } r -= I_SQ;
            if (r < I_SQ) { p0_plain(w_mem_q, 1024, 1024, WMQ, r, scr, lane); continue; } r -= I_SQ;
            if (r < I_SQ) { p0_plain(w_mem_o, 1024, 1024, WMO, r, scr, lane); continue; } r -= I_SQ;
            if (r < I_KV) { p0_plain(w_mem_kv, 1024, 2048, WMKV, r, scr, lane); continue; } r -= I_KV;
            if (r < I_GU) { const int e = r / I_GU1, q = r % I_GU1, kb = q / 64, nb = q % 64, n0 = 32 * nb;
                const int half = n0 >> 10, j = n0 & 1023, drow0 = (j >> 7) * 256 + half * 128 + (j & 127);
                p0_transpose_item(w_gate_up + (size_t)e * 1024 * 2048, 1024, 2048, WGU + (size_t)e * 2048 * 1024, drow0, 64 * kb, n0, scr, lane); continue; } r -= I_GU;
            { const int e = r / I_D1, q = r % I_D1; p0_plain(w_down + (size_t)e * 1024 * 1024, 1024, 1024, WD + (size_t)e * 1024 * 1024, q, scr, lane); }
        }
        for (int m = gw; m < M; m += NGW) rms_row_to_bf16(x + (size_t)m * D, norm_mix, XN + (size_t)m * D, lane);
        for (int m = gw; m < MM; m += NGW) rms_row_to_bf16(mem + (size_t)m * D, norm_mem_kv, HM + (size_t)m * D, lane);
        for (int i = blockIdx.x * NTHR + tid; i < M * 32; i += G * NTHR) {
            const int m = i >> 5, f = i & 31;
            const double inv = exp2(-(double)f * (13.287712379549449 / 32.0));
            const double ang = (double)positions[m] * inv;
            const double kk = rint(ang * 0.15915494309189535);
            const float rf = (float)(ang - kk * 6.283185307179586);
            ROPEC[i] = __cosf(rf); ROPES[i] = __sinf(rf);
        }
    }
    SEAM(0);

    if (IN(1)) {
#if FAST_P1
        { pg8::Gemm g{XN, WIN, D, D, D}; pg8::DenseOrder S; S.init(M, NIN, G, (int)blockIdx.x, D, D);
          pg8::gemm_phase<pg8::EpiInProj, pg8::DenseOrder, false>(L, g, S, pg8::EpiInProj{PR, ROPEC, ROPES}); }
        { pg8::Gemm g{HM, WMKV, D, D, D}; pg8::DenseOrder S; S.init(MM, 2048, G, (int)blockIdx.x, D, D);
          pg8::gemm_phase<pg8::EpiBf16Store, pg8::DenseOrder, false>(L, g, S, pg8::EpiBf16Store{KVM, 2048}); }
#else
        ngemm_dense(XN, D, WIN, D, M, NIN, D, EpiStoreBf16{PR, NIN}, smf);
        ngemm_dense(HM, D, WMKV, D, MM, 2048, D, EpiStoreBf16{KVM, 2048}, smf);
#endif
    }
    SEAM(1);

    if (IN(2) && !FAST_P1) {
        for (int m = gw; m < M; m += NGW) {
            bf16_t* row = PR + (size_t)m * NIN;
            for (int c = lane; c < 512; c += 64) row[C_SBQ + c] = (bf16_t)f2bf(bf2f(row[C_SBQ + c]) * 0.125f);
            for (int p = lane; p < 512; p += 64) {
                const int blk = p >> 5, i = p & 31, c0 = C_DQ + blk * 64;
                const float cs = ROPEC[(size_t)m * 32 + i], sn = ROPES[(size_t)m * 32 + i];
                const float t1 = bf2f(row[c0 + i]), t2 = bf2f(row[c0 + i + 32]);
                const float sc = (blk < 8) ? 0.125f : 1.0f;
                row[c0 + i] = (bf16_t)f2bf((t1 * cs - t2 * sn) * sc); row[c0 + i + 32] = (bf16_t)f2bf((t2 * cs + t1 * sn) * sc);
            }
            for (int c = lane; c < 2048; c += 64) { const float g = bf2f(row[C_GSB + c]); row[C_GSB + c] = (bf16_t)f2bf(1.f / (1.f + __expf(-g))); }
        }
    }
    SEAM(2);

    if (IN(3)) {
        for (int g = blockIdx.x; g < 256; g += G) {
            const int rowid = g * 512 + tid, b = rowid >> 15, h = (rowid >> 12) & 7, t = rowid & 4095;
            const bf16_t* base = PR + (size_t)b * SEQ * NIN;
            v4u q[8]; float o[64];
            { const bf16_t* qp = base + (size_t)t * NIN + C_SBQ + h * 64;
#pragma unroll
              for (int c = 0; c < 8; ++c) q[c] = *(const v4u*)(qp + c * 8); }
#pragma unroll
            for (int d = 0; d < 64; ++d) o[d] = 0.f;
            float R = 0.f;
            for (int s = t - 1; s >= 0; --s) {
                const bf16_t* kp = base + (size_t)s * NIN + C_SBK + h * 64; const bf16_t* vp = base + (size_t)s * NIN + C_SBV + h * 64;
                float z = 0.f;
#pragma unroll
                for (int c = 0; c < 8; ++c) { const v4u w = *(const v4u*)(kp + c * 8);
                    z += lo16(q[c].x) * lo16(w.x) + hi16(q[c].x) * hi16(w.x) + lo16(q[c].y) * lo16(w.y) + hi16(q[c].y) * hi16(w.y) + lo16(q[c].z) * lo16(w.z) + hi16(q[c].z) * hi16(w.z) + lo16(q[c].w) * lo16(w.w) + hi16(q[c].w) * hi16(w.w); }
                const float sp = softplus_f(z);
                const float wgt = __expf(z - sp + R);
                R -= sp;
#pragma unroll
                for (int c = 0; c < 8; ++c) { const v4u w = *(const v4u*)(vp + c * 8);
                    o[c * 8 + 0] += wgt * lo16(w.x); o[c * 8 + 1] += wgt * hi16(w.x); o[c * 8 + 2] += wgt * lo16(w.y); o[c * 8 + 3] += wgt * hi16(w.y); o[c * 8 + 4] += wgt * lo16(w.z); o[c * 8 + 5] += wgt * hi16(w.z); o[c * 8 + 6] += wgt * lo16(w.w); o[c * 8 + 7] += wgt * hi16(w.w); }
            }
            bf16_t* op = OAT + (size_t)(b * SEQ + t) * D + h * 64;
#pragma unroll
            for (int c = 0; c < 8; ++c) { v4u w; w.x = pk2(o[c * 8 + 0], o[c * 8 + 1]); w.y = pk2(o[c * 8 + 2], o[c * 8 + 3]); w.z = pk2(o[c * 8 + 4], o[c * 8 + 5]); w.w = pk2(o[c * 8 + 6], o[c * 8 + 7]); *(v4u*)(op + c * 8) = w; }
        }
        for (int g = blockIdx.x; g < 512; g += G) {
            const int rowid = g * 512 + tid, t = rowid & 4095, vh = (rowid >> 12) & 1, j = (rowid >> 13) & 1, h = (rowid >> 14) & 3, b = rowid >> 16;
            const bf16_t* base = PR + (size_t)b * SEQ * NIN;
            v4u q[8]; float o[64];
            { const bf16_t* qp = base + (size_t)t * NIN + C_DQ + h * 128 + j * 64;
#pragma unroll
              for (int c = 0; c < 8; ++c) q[c] = *(const v4u*)(qp + c * 8); }
#pragma unroll
            for (int d = 0; d < 64; ++d) o[d] = 0.f;
            float mx = -INFINITY, l = 0.f;
            const int send = t | 63;
            for (int s = 0; s <= send; ++s) {
                const bf16_t* kp = base + (size_t)s * NIN + C_DK + h * 128 + j * 64; const bf16_t* vp = base + (size_t)s * NIN + C_DV + h * 128 + vh * 64;
                float z = 0.f;
#pragma unroll
                for (int c = 0; c < 8; ++c) { const v4u w = *(const v4u*)(kp + c * 8);
                    z += lo16(q[c].x) * lo16(w.x) + hi16(q[c].x) * hi16(w.x) + lo16(q[c].y) * lo16(w.y) + hi16(q[c].y) * hi16(w.y) + lo16(q[c].z) * lo16(w.z) + hi16(q[c].z) * hi16(w.z) + lo16(q[c].w) * lo16(w.w) + hi16(q[c].w) * hi16(w.w); }
                if (z > mx) { const float al = __expf(mx - z); l *= al;
#pragma unroll
                    for (int d = 0; d < 64; ++d) o[d] *= al;
                    mx = z; }
                const float p = __expf(z - mx); l += p;
#pragma unroll
                for (int c = 0; c < 8; ++c) { const v4u w = *(const v4u*)(vp + c * 8);
                    o[c * 8 + 0] += p * lo16(w.x); o[c * 8 + 1] += p * hi16(w.x); o[c * 8 + 2] += p * lo16(w.y); o[c * 8 + 3] += p * hi16(w.y); o[c * 8 + 4] += p * lo16(w.z); o[c * 8 + 5] += p * hi16(w.z); o[c * 8 + 6] += p * lo16(w.w); o[c * 8 + 7] += p * hi16(w.w); }
            }
            const float il = 1.f / l;
            float* op = ODR + ((size_t)j * M + (size_t)b * SEQ + t) * 512 + h * 128 + vh * 64;
#pragma unroll
            for (int c = 0; c < 16; ++c) *(f32x4*)(op + c * 4) = (f32x4){o[c * 4] * il, o[c * 4 + 1] * il, o[c * 4 + 2] * il, o[c * 4 + 3] * il};
        }
    }
    SEAM(3);

    if (IN(4)) {
        const float s1 = wave_sum(lam_q1[lane] * lam_k1[lane]), s2 = wave_sum(lam_q2[lane] * lam_k2[lane]);
        const float lam = expf(s1) - expf(s2) + 0.2f;
        for (int it = gw; it < M * 4; it += NGW) {
            const int m = it >> 2, h = it & 3;
            const float* p1 = ODR + (size_t)m * 512 + h * 128; const float* p2 = ODR + ((size_t)M + m) * 512 + h * 128;
            const float d0 = p1[lane] - lam * p2[lane], d1 = p1[lane + 64] - lam * p2[lane + 64];
            const float rinv = 1.0f / sqrtf(wave_sum(d0 * d0 + d1 * d1) * (1.f / 128.f) + NORM_EPS);
            bf16_t* op = OAT + (size_t)m * D + 512 + h * 128;
            op[lane] = (bf16_t)f2bf(d0 * rinv * diff_subln[lane] * 0.8f); op[lane + 64] = (bf16_t)f2bf(d1 * rinv * diff_subln[lane + 64] * 0.8f);
        }
    }
    SEAM(4);

    if (IN(5)) {
#if FAST_P5
        pg8::Gemm g{OAT, WUPSB, D, 512, 512}; pg8::TwoRoundOrder S{G, (int)blockIdx.x, D, 512};
        pg8::gemm_phase<pg8::EpiGate, pg8::TwoRoundOrder, false>(L, g, S, pg8::EpiGate{PR, X2, MIX});
#else
        ngemm_dense(OAT, D, WUPSB, 512, M, D, 512, EpiGate1{PR, X2}, smf);
        ngemm_dense(OAT + 512, D, WUPDF, 512, M, D, 512, EpiGate2{PR, X2, MIX}, smf);
#endif
    }
    SEAM(5);

    if (IN(6)) {
#if FAST_P6
        pg8::Gemm g{MIX, WOUT, D, D, D}; pg8::DenseOrder S; S.init(M, D, G, (int)blockIdx.x, D, D);
        pg8::gemm_phase<pg8::EpiResidF32, pg8::DenseOrder, false>(L, g, S, pg8::EpiResidF32{x, X1});
#else
        ngemm_dense(MIX, D, WOUT, D, M, D, D, EpiResid{x, X1}, smf);
#endif
    }
    SEAM(6);

    if (IN(7)) for (int m = gw; m < M; m += NGW) rms_row_to_bf16(X1 + (size_t)m * D, norm_mem_q, XN + (size_t)m * D, lane);
    SEAM(7);

    if (IN(8)) {
#if FAST_P6
        pg8::Gemm g{XN, WMQ, D, D, D}; pg8::DenseOrder S; S.init(M, D, G, (int)blockIdx.x, D, D);
        pg8::gemm_phase<pg8::EpiBf16Store, pg8::DenseOrder, false>(L, g, S, pg8::EpiBf16Store{QM, D});
#else
        ngemm_dense(XN, D, WMQ, D, M, D, D, EpiStoreBf16{QM, D}, smf);
#endif
    }
    SEAM(8);

    if (IN(9)) {
        for (int it = gw; it < M * 4; it += NGW) {
            const int m = it >> 2, h = it & 3, b = m >> 12;
            const bf16_t* qp = QM + (size_t)m * D + h * 256;
            const bf16_t* kb = KVM + (size_t)(b * MEMLEN) * 2048 + h * 256;
            float z[4] = {0.f, 0.f, 0.f, 0.f};
            for (int c = 0; c < 32; ++c) {
                const v4u qw = *(const v4u*)(qp + c * 8);
                const float qf[8] = {lo16(qw.x), hi16(qw.x), lo16(qw.y), hi16(qw.y), lo16(qw.z), hi16(qw.z), lo16(qw.w), hi16(qw.w)};
#pragma unroll
                for (int i = 0; i < 4; ++i) { const v4u w = *(const v4u*)(kb + (size_t)(lane + 64 * i) * 2048 + c * 8);
                    z[i] += qf[0] * lo16(w.x) + qf[1] * hi16(w.x) + qf[2] * lo16(w.y) + qf[3] * hi16(w.y) + qf[4] * lo16(w.z) + qf[5] * hi16(w.z) + qf[6] * lo16(w.w) + qf[7] * hi16(w.w); }
            }
#pragma unroll
            for (int i = 0; i < 4; ++i) z[i] *= 0.0625f;
            const float mx = wave_max(fmaxf(fmaxf(z[0], z[1]), fmaxf(z[2], z[3])));
            float p[4]; float ls = 0.f;
#pragma unroll
            for (int i = 0; i < 4; ++i) { p[i] = __expf(z[i] - mx); ls += p[i]; }
            const float il = 1.f / wave_sum(ls);
            float o[4] = {0.f, 0.f, 0.f, 0.f};
            const bf16_t* vb = kb + 1024 + lane * 4;
#pragma unroll
            for (int i = 0; i < 4; ++i)
                for (int kk = 0; kk < 64; ++kk) { const float pk = __shfl(p[i], kk); const v2u w = *(const v2u*)(vb + (size_t)(kk + 64 * i) * 2048);
                    o[0] += pk * lo16(w.x); o[1] += pk * hi16(w.x); o[2] += pk * lo16(w.y); o[3] += pk * hi16(w.y); }
            v2u w; w.x = pk2(o[0] * il, o[1] * il); w.y = pk2(o[2] * il, o[3] * il);
            *(v2u*)(OM + (size_t)m * D + h * 256 + lane * 4) = w;
        }
    }
    SEAM(9);

    if (IN(10)) {
#if FAST_P6
        pg8::Gemm g{OM, WMO, D, D, D}; pg8::DenseOrder S; S.init(M, D, G, (int)blockIdx.x, D, D);
        pg8::gemm_phase<pg8::EpiResidF32, pg8::DenseOrder, false>(L, g, S, pg8::EpiResidF32{X1, X2});
#else
        ngemm_dense(OM, D, WMO, D, M, D, D, EpiResid{X1, X2}, smf);
#endif
    }
    SEAM(10);

    if (IN(11)) {
        LAS float* hrow = smf + wave * 1024;
        for (int m = gw; m < M; m += NGW) {
            const f32x4* xr = (const f32x4*)(X2 + (size_t)m * D) + lane; const f32x4* gr = (const f32x4*)norm_ffn + lane;
            f32x4 v[4]; float s = 0.f;
#pragma unroll
            for (int j = 0; j < 4; ++j) { v[j] = xr[64 * j]; s += (v[j].x * v[j].x + v[j].y * v[j].y) + (v[j].z * v[j].z + v[j].w * v[j].w); }
            const float rinv = 1.0f / sqrtf(wave_sum(s) * (1.f / 1024.f) + NORM_EPS);
            v2u* o8 = (v2u*)(XN + (size_t)m * D) + lane;
#pragma unroll
            for (int j = 0; j < 4; ++j) { const f32x4 gg = gr[64 * j]; const f32x4 hn = {v[j].x * rinv * gg.x, v[j].y * rinv * gg.y, v[j].z * rinv * gg.z, v[j].w * rinv * gg.w};
                v2u w; w.x = pk2(hn.x, hn.y); w.y = pk2(hn.z, hn.w); o8[64 * j] = w; *(LAS f32x4*)(hrow + (lane + 64 * j) * 4) = hn; }
            LDS_WAIT(); asm volatile("" ::: "memory");
            const int e = lane & 31, kh = lane >> 5;
            float acc = 0.f;
            const float* wr = w_router + (size_t)(kh * 512) * NE + e; const LAS float* hh = hrow + kh * 512;
#pragma unroll 8
            for (int k = 0; k < 512; ++k) acc += hh[k] * wr[(size_t)k * NE];
            acc += __shfl_xor(acc, 32);
            float logit = acc + b_router[e];
            LDS_WAIT(); asm volatile("" ::: "memory");
            float tv[4]; int ti[4]; float cur = logit;
#pragma unroll
            for (int k = 0; k < 4; ++k) {
                float bv = cur; int bi = e;
#pragma unroll
                for (int o = 1; o < 32; o <<= 1) { const float ov = __shfl_xor(bv, o); const int oi = __shfl_xor(bi, o); if (ov > bv || (ov == bv && oi < bi)) { bv = ov; bi = oi; } }
                tv[k] = bv; ti[k] = bi; if (e == bi) cur = -INFINITY;
            }
            const float e1 = __expf(tv[1] - tv[0]), e2 = __expf(tv[2] - tv[0]), e3 = __expf(tv[3] - tv[0]);
            const float isum = 1.f / (1.f + e1 + e2 + e3);
            if (lane < 4) {
                const int ek = lane == 0 ? ti[0] : lane == 1 ? ti[1] : lane == 2 ? ti[2] : ti[3];
                const float gk = (lane == 0 ? 1.f : lane == 1 ? e1 : lane == 2 ? e2 : e3) * isum;
                const int pos = (int)atomicAdd(&CNT[ek], 1u);
                TLIST[ek * LISTCAP + pos] = m; GLIST[ek * LISTCAP + pos] = gk;
                TK_E[m * 4 + lane] = ek; TK_POS[m * 4 + lane] = pos; TK_G[m * 4 + lane] = gk;
            }
        }
    }
    SEAM(11);

#define LOAD_BASES() do { __syncthreads(); if (tid == 0) { int b_ = 0; for (int e_ = 0; e_ < NE; ++e_) { const int c_ = (int)__hip_atomic_load(&CNT[e_], __ATOMIC_RELAXED, __HIP_MEMORY_SCOPE_AGENT); \
        smi[8192 + e_] = b_; smi[8256 + e_] = c_; b_ += (c_ + 255) & ~255; } } __syncthreads(); } while (0)

    LAS int* tb = (LAS int*)(L + 131072 + 1024);
#define LOAD_TB(npn) do { __syncthreads(); if (tid == 0) { int b_ = 0, cu_ = 0; for (int e_ = 0; e_ < NE; ++e_) { const int c_ = (int)__hip_atomic_load(&CNT[e_], __ATOMIC_RELAXED, __HIP_MEMORY_SCOPE_AGENT); \
        tb[e_] = b_; tb[32 + e_] = c_; tb[64 + e_] = cu_; b_ += (c_ + 255) & ~255; cu_ += ((c_ + 255) >> 8) * (npn); } tb[96] = cu_; } __syncthreads(); } while (0)
#if FAST_MOE
    if (IN(12)) {
        LOAD_TB(8);
        pg8::Gemm g{XN, WGU, D, D, D}; pg8::MoeOrder S{tb, TLIST, G, (int)blockIdx.x, 8, D, D, 2048};
        pg8::gemm_phase<pg8::EpiMoeGU, pg8::MoeOrder, true>(L, g, S, pg8::EpiMoeGU{ACT, b_gate_up});
    }
    SEAM(12);
    if (IN(13)) {
        LOAD_TB(4);
        pg8::Gemm g{ACT, WD, DFF, DFF, DFF}; pg8::MoeOrder S{tb, TLIST, G, (int)blockIdx.x, 4, DFF, DFF, 1024};
        pg8::gemm_phase<pg8::EpiMoeDown, pg8::MoeOrder, false>(L, g, S, pg8::EpiMoeDown{YB, b_down, GLIST, tb});
    }
    SEAM(13);
#else
    if (IN(12)) {
        LOAD_BASES();
        int ubase = 0;
        for (int e = 0; e < NE; ++e) {
            const int cnt = smi[8256 + e], sb = smi[8192 + e], nrt = (cnt + 127) >> 7, nu = nrt * 8;
            const int* tl = TLIST + e * LISTCAP;
            auto rp = [=](int r) -> const bf16_t* { return XN + (size_t)(r < cnt ? tl[r] : 0) * D; };
            const float* bg = b_gate_up + (size_t)e * 2048; bf16_t* act = ACT + (size_t)sb * DFF;
            auto epi = [=](int r, int n, float a0, float a1) { const int j = (n >> 8) * 128 + (n & 127);
                float gl = fminf(a0 + bg[j], 7.0f); float li = fminf(fmaxf(a1 + bg[1024 + j], -7.0f), 7.0f);
                act[(size_t)r * DFF + j] = (bf16_t)f2bf(gl * (1.f / (1.f + __expf(-1.702f * gl))) * (li + 1.0f)); };
            int u = ((int)blockIdx.x - ubase) % G; if (u < 0) u += G;
            for (; u < nu; u += G) ngemm_tile<2>(rp, WGU + (size_t)e * 2048 * 1024, D, 128, D, (u >> 3) * 128, (u & 7) * 256, cnt, epi, smf);
            ubase = (ubase + nu) % G;
        }
    }
    SEAM(12);

    if (IN(13)) {
        LOAD_BASES();
        int ubase = 0;
        for (int e = 0; e < NE; ++e) {
            const int cnt = smi[8256 + e], sb = smi[8192 + e], nrt = (cnt + 127) >> 7, nu = nrt * 8;
            RowPlain rp{ACT + (size_t)sb * DFF, DFF};
            const float* bd = b_down + (size_t)e * D; const float* gl = GLIST + e * LISTCAP; bf16_t* yb = YB + (size_t)sb * D;
            auto epi = [=](int r, int n, float a0, float) { yb[(size_t)r * D + n] = (bf16_t)f2bf((a0 + bd[n]) * gl[r]); };
            int u = ((int)blockIdx.x - ubase) % G; if (u < 0) u += G;
            for (; u < nu; u += G) ngemm_tile<1>(rp, WD + (size_t)e * 1024 * 1024, DFF, 0, DFF, (u >> 3) * 128, (u & 7) * 128, cnt, epi, smf);
            ubase = (ubase + nu) % G;
        }
    }
    SEAM(13);
#endif

    if (IN(14)) {
        LOAD_BASES();
        for (int m = gw; m < M; m += NGW) {
            const f32x4* xr = (const f32x4*)(X2 + (size_t)m * D) + lane; const f32x4* gr = (const f32x4*)norm_final + lane;
            f32x4 v[4];
#pragma unroll
            for (int j = 0; j < 4; ++j) v[j] = xr[64 * j];
#pragma unroll
            for (int k = 0; k < 4; ++k) { const int slot = smi[8192 + TK_E[m * 4 + k]] + TK_POS[m * 4 + k]; const v2u* yr = (const v2u*)(YB + (size_t)slot * D) + lane;
#pragma unroll
                for (int j = 0; j < 4; ++j) { const v2u w = yr[64 * j]; v[j].x += lo16(w.x); v[j].y += hi16(w.x); v[j].z += lo16(w.y); v[j].w += hi16(w.y); } }
            float s = 0.f;
#pragma unroll
            for (int j = 0; j < 4; ++j) s += (v[j].x * v[j].x + v[j].y * v[j].y) + (v[j].z * v[j].z + v[j].w * v[j].w);
            const float rinv = 1.0f / sqrtf(wave_sum(s) * (1.f / 1024.f) + NORM_EPS);
            f32x4* orow = (f32x4*)(args.out + (size_t)m * D) + lane;
#pragma unroll
            for (int j = 0; j < 4; ++j) { const f32x4 gg = gr[64 * j]; orow[64 * j] = (f32x4){v[j].x * rinv * gg.x, v[j].y * rinv * gg.y, v[j].z * rinv * gg.z, v[j].w * rinv * gg.w}; }
        }
    }
#undef IN
#undef SEAM
}

extern "C" void kernel_launch(void* const* d_in, const int* in_sizes, int n_in, void* d_out, int out_size, void* d_ws, size_t ws_size, hipStream_t stream) {
    static int grid = 0;
    if (grid == 0) {
        if (n_in != 26 || out_size != M * D || ws_size < WS_END) { fprintf(stderr, "kernel_launch: unexpected sizes n_in %d out %d ws %zu\n", n_in, out_size, ws_size); grid = -1; return; }
        int dev = 0, cus = 0;
        if (hipGetDevice(&dev) != hipSuccess || hipDeviceGetAttribute(&cus, hipDeviceAttributeMultiprocessorCount, dev) != hipSuccess) { grid = -1; return; }
        if (hipFuncSetAttribute((const void*)fwd, hipFuncAttributeMaxDynamicSharedMemorySize, LDS_BYTES) != hipSuccess) { fprintf(stderr, "kernel_launch: hipFuncSetAttribute failed\n"); grid = -1; return; }
        int per_cu = 0;
        (void)hipOccupancyMaxActiveBlocksPerMultiprocessor(&per_cu, (const void*)fwd, NTHR, LDS_BYTES);
        (void)hipGetLastError();
        grid = cus;
    }
    if (grid < 0) return;
    (void)hipMemsetAsync((char*)d_ws + WS_CTL, 0, CTL_ZERO_BYTES, stream);
    Args a{};
    for (int i = 0; i < 26; ++i) a.in[i] = d_in[i];
    a.out = (float*)d_out; a.ws = (unsigned char*)d_ws;
#if MK_PER_PHASE
    for (int p = 0; p < NPHASE; ++p) { a.ph_lo = p; a.ph_hi = p + 1; hipLaunchKernelGGL(fwd, dim3(grid), dim3(NTHR), LDS_BYTES, stream, a); }
#else
    a.ph_lo = 0; a.ph_hi = NPHASE; hipLaunchKernelGGL(fwd, dim3(grid), dim3(NTHR), LDS_BYTES, stream, a);
#endif
}
```

```cpp
#include <hip/hip_runtime.h>
#include <cstdio>
#include <cstdint>

#ifndef MK_PER_PHASE
#define MK_PER_PHASE 0
#endif

#ifndef FAST_P1
#define FAST_P1 1
#endif
#ifndef FAST_P5
#define FAST_P5 1
#endif
#ifndef FAST_P6
#define FAST_P6 1
#endif
#ifndef FAST_MOE
#define FAST_MOE 1
#endif
#ifndef FAST_ATT
#define FAST_ATT 1
#endif
#ifndef FAST_MEMATT
#define FAST_MEMATT 1
#endif
#define GAS __attribute__((address_space(1)))
#define LAS __attribute__((address_space(3)))
typedef unsigned short bf16_t;
typedef unsigned v4u __attribute__((ext_vector_type(4)));
typedef unsigned v2u __attribute__((ext_vector_type(2)));
typedef float f32x4 __attribute__((ext_vector_type(4)));
typedef short bf16x8 __attribute__((ext_vector_type(8)));

constexpr int BATCH = 4, SEQ = 4096, D = 1024, M = BATCH * SEQ, NIN = 5120;
constexpr int MEMLEN = 256, MM = BATCH * MEMLEN;
constexpr int NE = 32, TOPK = 4, DFF = 1024;
constexpr float NORM_EPS = 1e-6f;
constexpr int C_SBQ = 0, C_SBK = 512, C_SBV = 1024, C_DQ = 1536, C_DK = 2048, C_DV = 2560, C_GSB = 3072, C_GDF = 4096;
constexpr int LISTCAP = 16384;
constexpr int SLOTS = 65536 + NE * 256;
constexpr int NWAVES = 8, NTHR = 512;

constexpr size_t MiB = 1u << 20;
constexpr size_t WS_CTL = 0, CTL_ZERO_BYTES = 1 * MiB;
constexpr size_t WS_WIN = 2 * MiB;
constexpr size_t WS_WUPSB = 12 * MiB;
constexpr size_t WS_WUPDF = 13 * MiB;
constexpr size_t WS_WOUT = 14 * MiB;
constexpr size_t WS_WMQ = 16 * MiB;
constexpr size_t WS_WMKV = 18 * MiB;
constexpr size_t WS_WMO = 22 * MiB;
constexpr size_t WS_ROPE = 24 * MiB;
constexpr size_t WS_TK = 28 * MiB;
constexpr size_t WS_WGU = 32 * MiB;
constexpr size_t WS_WD = 160 * MiB;
constexpr size_t WS_XN = 224 * MiB;
constexpr size_t WS_PR = 256 * MiB;
constexpr size_t WS_OAT = 416 * MiB;
constexpr size_t WS_ODR = 448 * MiB;
constexpr size_t WS_MIX = 512 * MiB;
constexpr size_t WS_X1 = 544 * MiB;
constexpr size_t WS_X2 = 608 * MiB;
constexpr size_t WS_HM = 672 * MiB;
constexpr size_t WS_KVM = 674 * MiB;
constexpr size_t WS_TLIST = 678 * MiB;
constexpr size_t WS_GLIST = 680 * MiB;
constexpr size_t WS_QM = 682 * MiB;
constexpr size_t WS_OM = 714 * MiB;
constexpr size_t WS_ACT = 256 * MiB;
constexpr size_t WS_YB = 746 * MiB;
constexpr size_t WS_VTSB = 890 * MiB;
constexpr size_t WS_VTDF = 906 * MiB;
constexpr size_t WS_VTM = 922 * MiB;
constexpr size_t WS_END = 924 * MiB;
static_assert(WS_ACT + (size_t)SLOTS * 1024 * 2 <= WS_OAT, "ACT overlay");
static_assert(WS_YB + (size_t)SLOTS * 1024 * 2 <= WS_VTSB, "YB");
constexpr int CW_CNT = 1024;
constexpr int CW_BAR = 4096;

constexpr int LDS_BYTES = 147456;
constexpr int MISC_OFF = 131072 + 320;

__device__ __forceinline__ float bf2f(bf16_t b) { return __uint_as_float(((unsigned)b) << 16); }
__device__ __forceinline__ unsigned f2bf(float f) { unsigned u = __float_as_uint(f); return (u + 0x7fffu + ((u >> 16) & 1u)) >> 16; }
__device__ __forceinline__ unsigned pk2(float lo, float hi) { return f2bf(lo) | (f2bf(hi) << 16); }
__device__ __forceinline__ float lo16(unsigned w) { return __uint_as_float(w << 16); }
__device__ __forceinline__ float hi16(unsigned w) { return __uint_as_float(w & 0xffff0000u); }
#define LDS_WAIT() asm volatile("s_waitcnt lgkmcnt(0)" ::: "memory")
__device__ __forceinline__ float wave_sum(float v) {
#pragma unroll
    for (int o = 1; o < 64; o <<= 1) v += __shfl_xor(v, o);
    return v;
}
__device__ __forceinline__ float wave_max(float v) {
#pragma unroll
    for (int o = 1; o < 64; o <<= 1) v = fmaxf(v, __shfl_xor(v, o));
    return v;
}

#define XB_TMO      128
#define XB_XCNT(j)  (256  + 64 * (j))
#define XB_XSUB(j)  (1280 + 64 * (j))
#define XB_XGEN(j)  (2304 + 64 * (j))
#define XB_TOP      3328
#define XB_TOPGEN   3392
#define XCD_BAR_WORDS 3456
#define XB_SPIN_CAP (1u << 18)
__device__ __forceinline__ unsigned xb_ld(unsigned* p)              { return __hip_atomic_load(p, __ATOMIC_RELAXED, __HIP_MEMORY_SCOPE_AGENT); }
__device__ __forceinline__ unsigned xb_add(unsigned* p, unsigned v) { return __hip_atomic_fetch_add(p, v, __ATOMIC_RELAXED, __HIP_MEMORY_SCOPE_AGENT); }
__device__ __forceinline__ unsigned xb_xcc_id() { return (unsigned)__builtin_amdgcn_s_getreg((3 << 11) | 20) & 0xFu; }
#define XB_SPIN(cond, bar) do { unsigned _sp = 0; while (cond) { __builtin_amdgcn_s_sleep(1); \
    if ((++_sp & 255u) == 0u) { if (xb_ld(&(bar)[XB_TMO])) break; if (_sp > XB_SPIN_CAP) { atomicAdd(&(bar)[XB_TMO], 1u); break; } } } } while (0)
struct XcdBarrier { unsigned* bar; unsigned x; volatile LAS unsigned* st; };
__device__ __forceinline__ XcdBarrier xcd_barrier_post(unsigned* bar, volatile LAS unsigned* st) {
    XcdBarrier b; b.bar = bar; b.x = xb_xcc_id(); b.st = st;
    if (threadIdx.x == 0) (void)xb_add(&bar[XB_XCNT(b.x)], 1u);
    return b;
}
__device__ __forceinline__ void xcd_barrier_complete(unsigned* bar, unsigned x, unsigned& nloc, unsigned& nx) {
    const unsigned G = gridDim.x * gridDim.y * gridDim.z;
    unsigned sum, cnt, mine, sp = 0u;
    for (;;) {
        sum = 0u; cnt = 0u; mine = 0u;
#pragma unroll
        for (unsigned j = 0; j < 16; ++j) { const unsigned c = xb_ld(&bar[XB_XCNT(j)]); sum += c; cnt += (c > 0u) ? 1u : 0u; mine = (j == x) ? c : mine; }
        if (sum == G) break;
        __builtin_amdgcn_s_sleep(1);
        if ((++sp & 255u) == 0u) { if (xb_ld(&bar[XB_TMO])) break; if (sp > XB_SPIN_CAP) { atomicAdd(&bar[XB_TMO], 1u); break; } }
    }
    nloc = mine > 0u ? mine : 1u; nx = cnt > 0u ? cnt : 1u;
}
__device__ __forceinline__ void xcd_barrier(const XcdBarrier& b) {
    asm volatile("s_waitcnt vmcnt(0)" ::: "memory");
    __syncthreads();
    if (threadIdx.x == 0) {
        unsigned* bar = b.bar;
        __builtin_amdgcn_s_waitcnt(0);
        unsigned nloc = b.st[0], nx = b.st[1];
        if (nloc == 0u) { xcd_barrier_complete(bar, b.x, nloc, nx); b.st[0] = nloc; b.st[1] = nx; }
        const unsigned old = xb_add(&bar[XB_XSUB(b.x)], 1u);
        const unsigned gen = old / nloc;
        if (old + 1u == (gen + 1u) * nloc) {
            __builtin_amdgcn_fence(__ATOMIC_RELEASE, "agent");
            asm volatile("s_waitcnt vmcnt(0)" ::: "memory");
            const unsigned og = xb_add(&bar[XB_TOP], 1u);
            const unsigned tg = og / nx;
            if (og + 1u == (tg + 1u) * nx) xb_add(&bar[XB_TOPGEN], 1u);
            else XB_SPIN(xb_ld(&bar[XB_TOPGEN]) == tg, bar);
            __builtin_amdgcn_fence(__ATOMIC_ACQUIRE, "agent");
            xb_add(&bar[XB_XGEN(b.x)], 1u);
            asm volatile("s_waitcnt vmcnt(0)" ::: "memory");
        } else {
            XB_SPIN(xb_ld(&bar[XB_XGEN(b.x)]) == gen, bar);
            __builtin_amdgcn_fence(__ATOMIC_ACQUIRE, "agent");
            asm volatile("s_waitcnt vmcnt(0)" ::: "memory");
        }
    }
    __syncthreads();
}

__device__ __forceinline__ void p0_transpose_item(const float* W, int K, int N, bf16_t* WT, int drow0, int k0, int n0, LAS float* scr, int lane) {
#pragma unroll 8
    for (int i = 0; i < 32; ++i) { const int kk = 2 * i + (lane >> 5); scr[kk * 33 + (lane & 31)] = W[(size_t)(k0 + kk) * N + n0 + (lane & 31)]; }
    LDS_WAIT(); asm volatile("" ::: "memory");
    const int c = lane & 7;
#pragma unroll
    for (int j = 0; j < 4; ++j) { const int n = (lane >> 3) + 8 * j; const LAS float* s = scr + (8 * c) * 33 + n;
        v4u o; o.x = pk2(s[0 * 33], s[1 * 33]); o.y = pk2(s[2 * 33], s[3 * 33]); o.z = pk2(s[4 * 33], s[5 * 33]); o.w = pk2(s[6 * 33], s[7 * 33]);
        *(v4u*)(WT + (size_t)(drow0 + n) * K + k0 + 8 * c) = o; }
    LDS_WAIT(); asm volatile("" ::: "memory");
}
__device__ __forceinline__ void p0_plain(const float* W, int K, int N, bf16_t* WT, int item, LAS float* scr, int lane) {
    const int nblk = N / 32, kb = item / nblk, nb = item % nblk;
    p0_transpose_item(W, K, N, WT, 32 * nb, 64 * kb, 32 * nb, scr, lane);
}
__device__ __forceinline__ void p0_transpose_rope(const float* W, bf16_t* WT, int tilebase, int o, int k0, int n0, LAS float* scr, int lane) {
    const int K = 1024, N = NIN;
#pragma unroll 8
    for (int i = 0; i < 32; ++i) { const int kk = 2 * i + (lane >> 5); scr[kk * 33 + (lane & 31)] = W[(size_t)(k0 + kk) * N + n0 + (lane & 31)]; }
    LDS_WAIT(); asm volatile("" ::: "memory");
    const int c = lane & 7;
#pragma unroll
    for (int j = 0; j < 4; ++j) { const int n = (lane >> 3) + 8 * j; const LAS float* s = scr + (8 * c) * 33 + n;
        const int oo = o + n, v = ((oo >> 6) << 6) | (((oo >> 4) & 1) << 5) | (((oo >> 2) & 3) << 3) | (((oo >> 5) & 1) << 2) | (oo & 3);
        v4u w; w.x = pk2(s[0 * 33], s[1 * 33]); w.y = pk2(s[2 * 33], s[3 * 33]); w.z = pk2(s[4 * 33], s[5 * 33]); w.w = pk2(s[6 * 33], s[7 * 33]);
        *(v4u*)(WT + (size_t)(tilebase + v) * K + k0 + 8 * c) = w; }
    LDS_WAIT(); asm volatile("" ::: "memory");
}
__device__ __forceinline__ void rms_row_to_bf16(const float* xrow, const float* g, bf16_t* orow, int lane) {
    const f32x4* xr = (const f32x4*)xrow + lane; const f32x4* gr = (const f32x4*)g + lane;
    f32x4 v[4]; float s = 0.f;
#pragma unroll
    for (int j = 0; j < 4; ++j) { v[j] = xr[64 * j]; s += (v[j].x * v[j].x + v[j].y * v[j].y) + (v[j].z * v[j].z + v[j].w * v[j].w); }
    const float rinv = 1.0f / sqrtf(wave_sum(s) * (1.f / 1024.f) + NORM_EPS);
    v2u* o8 = (v2u*)orow + lane;
#pragma unroll
    for (int j = 0; j < 4; ++j) { const f32x4 gg = gr[64 * j]; v2u w; w.x = pk2(v[j].x * rinv * gg.x, v[j].y * rinv * gg.y); w.y = pk2(v[j].z * rinv * gg.z, v[j].w * rinv * gg.w); o8[64 * j] = w; }
}

template <int NB, class RowPtr, class Epi>
__device__ __forceinline__ void ngemm_tile(const RowPtr& rp, const bf16_t* Bt, int ldb, int b1off, int K, int m0, int n0, int mvalid, const Epi& epi, LAS float* sm) {
    const int t = threadIdx.x, r = t >> 2, kq = (t & 3) * 4, ty = t >> 5, tx = t & 31;
    LAS float* As = sm; LAS float* Bs0 = sm + 16 * 132; LAS float* Bs1 = sm + 32 * 132;
    float acc[NB][8][4];
#pragma unroll
    for (int b = 0; b < NB; ++b)
#pragma unroll
        for (int i = 0; i < 8; ++i)
#pragma unroll
            for (int j = 0; j < 4; ++j) acc[b][i][j] = 0.f;
    const bf16_t* arow = rp(m0 + r) + kq;
    const bf16_t* brow0 = Bt + (size_t)(n0 + r) * ldb + kq;
    const bf16_t* brow1 = Bt + (size_t)(n0 + b1off + r) * ldb + kq;
    for (int k0 = 0; k0 < K; k0 += 16) {
        const v2u av = *(const v2u*)(arow + k0);
        const v2u bv0 = *(const v2u*)(brow0 + k0);
        v2u bv1 = bv0; if (NB == 2) bv1 = *(const v2u*)(brow1 + k0);
        As[(kq + 0) * 132 + r] = lo16(av.x); As[(kq + 1) * 132 + r] = hi16(av.x); As[(kq + 2) * 132 + r] = lo16(av.y); As[(kq + 3) * 132 + r] = hi16(av.y);
        Bs0[(kq + 0) * 132 + r] = lo16(bv0.x); Bs0[(kq + 1) * 132 + r] = hi16(bv0.x); Bs0[(kq + 2) * 132 + r] = lo16(bv0.y); Bs0[(kq + 3) * 132 + r] = hi16(bv0.y);
        if (NB == 2) { Bs1[(kq + 0) * 132 + r] = lo16(bv1.x); Bs1[(kq + 1) * 132 + r] = hi16(bv1.x); Bs1[(kq + 2) * 132 + r] = lo16(bv1.y); Bs1[(kq + 3) * 132 + r] = hi16(bv1.y); }
        __syncthreads();
#pragma unroll 2
        for (int kk = 0; kk < 16; ++kk) {
            const f32x4 a0 = *(const LAS f32x4*)(As + kk * 132 + ty * 8), a1 = *(const LAS f32x4*)(As + kk * 132 + ty * 8 + 4);
            const f32x4 b0 = *(const LAS f32x4*)(Bs0 + kk * 132 + tx * 4);
            const float a[8] = {a0.x, a0.y, a0.z, a0.w, a1.x, a1.y, a1.z, a1.w};
#pragma unroll
            for (int i = 0; i < 8; ++i) { acc[0][i][0] += a[i] * b0.x; acc[0][i][1] += a[i] * b0.y; acc[0][i][2] += a[i] * b0.z; acc[0][i][3] += a[i] * b0.w; }
            if (NB == 2) { const f32x4 b1 = *(const LAS f32x4*)(Bs1 + kk * 132 + tx * 4);
#pragma unroll
                for (int i = 0; i < 8; ++i) { acc[NB - 1][i][0] += a[i] * b1.x; acc[NB - 1][i][1] += a[i] * b1.y; acc[NB - 1][i][2] += a[i] * b1.z; acc[NB - 1][i][3] += a[i] * b1.w; } }
        }
        __syncthreads();
    }
#pragma unroll
    for (int i = 0; i < 8; ++i) { const int m = m0 + ty * 8 + i;
        if (m < mvalid) {
#pragma unroll
            for (int j = 0; j < 4; ++j) epi(m, n0 + tx * 4 + j, acc[0][i][j], acc[NB - 1][i][j]); } }
}
struct RowPlain { const bf16_t* A; int lda; __device__ __forceinline__ const bf16_t* operator()(int m) const { return A + (size_t)m * lda; } };

template <class Epi>
__device__ __forceinline__ void ngemm_dense(const bf16_t* A, int lda, const bf16_t* Bt, int ldb, int Mr, int N, int K, const Epi& epi, LAS float* sm) {
    const int nn = N / 128, nunits = (Mr / 128) * nn; RowPlain rp{A, lda};
    for (int u = blockIdx.x; u < nunits; u += gridDim.x) ngemm_tile<1>(rp, Bt, ldb, 0, K, (u / nn) * 128, (u % nn) * 128, Mr, epi, sm);
}

struct EpiStoreBf16 { bf16_t* O; int ldc; __device__ __forceinline__ void operator()(int m, int n, float a, float) const { O[(size_t)m * ldc + n] = (bf16_t)f2bf(a); } };
struct EpiGate1 { const bf16_t* PR; float* T; __device__ __forceinline__ void operator()(int m, int n, float a, float) const { T[(size_t)m * D + n] = bf2f(PR[(size_t)m * NIN + C_GSB + n]) * a; } };
struct EpiGate2 { const bf16_t* PR; const float* T; bf16_t* MIX; __device__ __forceinline__ void operator()(int m, int n, float a, float) const {
    MIX[(size_t)m * D + n] = (bf16_t)f2bf(T[(size_t)m * D + n] + bf2f(PR[(size_t)m * NIN + C_GDF + n]) * a); } };
struct EpiResid { const float* base; float* out; __device__ __forceinline__ void operator()(int m, int n, float a, float) const { out[(size_t)m * D + n] = base[(size_t)m * D + n] + a; } };


namespace pg8 {
constexpr int BM = 256, BK = 64, HALF = 128, HTB = HALF * BK * 2, STAGE_BYTES = 8 * HTB;
__host__ __device__ __forceinline__ int lds_byte(int r, int c) { const int st = (r >> 4) * 2 + (c >> 5), rr = r & 15, cc = c & 31, ob = rr * 64 + cc * 2; return st * 1024 + (ob ^ (((ob >> 9) & 1) << 5)); }
__host__ __device__ __forceinline__ void stage_rc(int b, int& R, int& C) { const int st = b / 1024, sb = b % 1024, swz = sb ^ (((sb >> 9) & 1) << 5); R = (st >> 1) * 16 + swz / 64; C = (st & 1) * 32 + (swz % 64) / 2; }
__host__ __device__ __forceinline__ int perm32(int rho) { const int n = rho >> 4, i = rho & 15; return 8 * (i >> 2) + 4 * n + (i & 3); }
struct Unit { int pm, pn, e; };
struct Gemm { const bf16_t* A; const bf16_t* Bt; int lda, ldb, K; };
typedef float f32x2 __attribute__((ext_vector_type(2))); typedef __bf16 bf16x2_t __attribute__((ext_vector_type(2)));
__device__ __forceinline__ unsigned cvt_pk_bf16(float lo, float hi) { f32x2 v = {lo, hi}; bf16x2_t b = __builtin_convertvector(v, bf16x2_t); return __builtin_bit_cast(unsigned, b); }

template <class Epi, class Sched, bool GATHER>
__device__ __forceinline__ void gemm_phase(LAS unsigned char* lds, const Gemm g, const Sched& S, const Epi& E) {
    const int tid = threadIdx.x, wid = __builtin_amdgcn_readfirstlane(tid >> 6), lane = tid & 63, wr = wid >> 2, wc = wid & 3, fr = lane & 15, fq = lane >> 4;
    const int K = g.K, nt = K / BK;
    unsigned voffB[2], cva[2][2], nva[2][2]; int Rr[2], Cc[2];
#pragma unroll
    for (int i = 0; i < 2; ++i) { int R, C; stage_rc(tid * 16 + i * 8192, R, C); Rr[i] = R; Cc[i] = C; const int Rb = (R & ~31) + perm32(R & 31);
        voffB[i] = (unsigned)(Rb * g.ldb + C) * 2u;
#pragma unroll
        for (int h = 0; h < 2; ++h) { cva[h][i] = (unsigned)((h * HALF + R) * g.lda + C) * 2u; nva[h][i] = cva[h][i]; } }
    const size_t kstep = (size_t)(BK * 2);
    const size_t hstepB = (size_t)HALF * g.ldb * 2;
    const unsigned ldsw = (unsigned)wid * 1024u;
    const int aoff = lds_byte(wr * 64 + fr, fq * 8), boff = lds_byte(wc * 32 + fr, fq * 8);
#define PG8_SA(b, h) (((b) * 2 + (h)) * HTB)
#define PG8_SB(b, h) ((4 + (b) * 2 + (h)) * HTB)
#define PG8_STAGE(bufoff, gbase, voff) do { _Pragma("unroll") for (int _i = 0; _i < 2; ++_i) \
        __builtin_amdgcn_global_load_lds((const unsigned*)((const char*)(gbase) + (voff)[_i]), (LAS unsigned*)(lds + (bufoff) + ldsw + _i * 8192), 16, 0, 0); } while (0)
#define PG8_LDA(dst, b, h) do { _Pragma("unroll") for (int m = 0; m < 4; ++m) _Pragma("unroll") for (int k = 0; k < 2; ++k) dst[m][k] = *(const LAS bf16x8*)(lds + PG8_SA(b, h) + aoff + m * 2048 + k * 1024); } while (0)
#define PG8_LDB(dst, b, h) do { _Pragma("unroll") for (int n = 0; n < 2; ++n) _Pragma("unroll") for (int k = 0; k < 2; ++k) dst[n][k] = *(const LAS bf16x8*)(lds + PG8_SB(b, h) + boff + n * 2048 + k * 1024); } while (0)
#define PG8_MMA(ai, bj, At, Bt) do { __builtin_amdgcn_s_setprio(1); _Pragma("unroll") for (int m = 0; m < 4; ++m) _Pragma("unroll") for (int n = 0; n < 2; ++n) _Pragma("unroll") for (int k = 0; k < 2; ++k) \
        acc[ai][bj][m][n] = __builtin_amdgcn_mfma_f32_16x16x32_bf16(Bt[n][k], At[m][k], acc[ai][bj][m][n], 0, 0, 0); __builtin_amdgcn_s_setprio(0); } while (0)
#define PG8_WAIT_V(n) asm volatile("s_waitcnt vmcnt(" #n ")" ::: "memory")
#define PG8_WAIT_L(n) asm volatile("s_waitcnt lgkmcnt(" #n ")" ::: "memory")
#define PG8_BAR __builtin_amdgcn_s_barrier()
#define PG8_SCHED __builtin_amdgcn_sched_barrier(0)
    Unit cur, nxt; int ui = 0;
    if (!S.next(0, cur)) return;
    if constexpr (GATHER) {
#pragma unroll
        for (int i = 0; i < 2; ++i)
#pragma unroll
            for (int h = 0; h < 2; ++h) cva[h][i] = (unsigned)(S.tok(cur, h * HALF + Rr[i]) * g.lda + Cc[i]) * 2u;
    }
    f32x4 acc[2][2][4][2];
#pragma unroll
    for (int a = 0; a < 2; ++a)
#pragma unroll
        for (int b = 0; b < 2; ++b)
#pragma unroll
            for (int m = 0; m < 4; ++m)
#pragma unroll
                for (int n = 0; n < 2; ++n) acc[a][b][m][n] = (f32x4){0.f, 0.f, 0.f, 0.f};
    bf16x8 At[4][2], B0[2][2], B1[2][2];
    const char* cA = (const char*)g.A + (GATHER ? (size_t)0 : S.a_off(cur)); const char* cB = (const char*)g.Bt + S.b_off(cur);
    PG8_STAGE(PG8_SB(0, 0), cB, voffB); PG8_STAGE(PG8_SB(0, 1), cB + hstepB, voffB); PG8_STAGE(PG8_SA(0, 0), cA, cva[0]); PG8_STAGE(PG8_SA(0, 1), cA, cva[1]);
    if (wr == 1) PG8_BAR;
    PG8_WAIT_V(2); PG8_BAR;
    PG8_STAGE(PG8_SB(1, 0), cB + kstep, voffB); PG8_STAGE(PG8_SA(1, 0), cA + kstep, cva[0]); PG8_STAGE(PG8_SB(1, 1), cB + hstepB + kstep, voffB);
    PG8_WAIT_V(6); PG8_BAR;
    for (;;) {
        const bool has_next = S.next(ui + 1, nxt);
        const char* nA = (has_next && !GATHER) ? (const char*)g.A + S.a_off(nxt) : cA; const char* nB = has_next ? (const char*)g.Bt + S.b_off(nxt) : cB;
        if constexpr (GATHER) {
#pragma unroll
            for (int i = 0; i < 2; ++i)
#pragma unroll
                for (int h = 0; h < 2; ++h) nva[h][i] = has_next ? (unsigned)(S.tok(nxt, h * HALF + Rr[i]) * g.lda + Cc[i]) * 2u : cva[h][i];
        }
        for (int t = 0; t < nt; t += 2) {
            const bool last = (t == nt - 2);
            const char* a1 = cA + (size_t)(t + 1) * kstep;
            const char* a2 = last ? nA : cA + (size_t)(t + 2) * kstep; const char* b2 = last ? nB : cB + (size_t)(t + 2) * kstep;
            const char* a3 = a2 + kstep; const char* b3 = b2 + kstep;
            unsigned v2[2][2];
#pragma unroll
            for (int h = 0; h < 2; ++h)
#pragma unroll
                for (int i = 0; i < 2; ++i) v2[h][i] = (GATHER && last) ? nva[h][i] : cva[h][i];
            PG8_LDB(B0, 0, 0); PG8_LDB(B1, 0, 1); PG8_SCHED; PG8_LDA(At, 0, 0); PG8_STAGE(PG8_SA(1, 1), a1, cva[1]);
            PG8_WAIT_V(8); PG8_WAIT_L(0); PG8_BAR; PG8_MMA(0, 0, At, B0); PG8_MMA(0, 1, At, B1); PG8_BAR; PG8_SCHED;
            PG8_LDA(At, 0, 1); PG8_STAGE(PG8_SB(0, 0), b2, voffB); PG8_STAGE(PG8_SB(0, 1), b2 + hstepB, voffB); PG8_STAGE(PG8_SA(0, 0), a2, v2[0]);
            PG8_WAIT_V(8); PG8_WAIT_L(0); PG8_BAR; PG8_MMA(1, 0, At, B0); PG8_MMA(1, 1, At, B1); PG8_BAR; PG8_SCHED;
            PG8_LDB(B0, 1, 0); PG8_LDB(B1, 1, 1); PG8_SCHED; PG8_LDA(At, 1, 0); PG8_STAGE(PG8_SA(0, 1), a2, v2[1]);
            PG8_WAIT_V(8); PG8_WAIT_L(0); PG8_BAR; PG8_MMA(0, 0, At, B0); PG8_MMA(0, 1, At, B1); PG8_BAR; PG8_SCHED;
            PG8_LDA(At, 1, 1); PG8_STAGE(PG8_SB(1, 0), b3, voffB); PG8_STAGE(PG8_SB(1, 1), b3 + hstepB, voffB); PG8_STAGE(PG8_SA(1, 0), a3, v2[0]);
            PG8_WAIT_V(8); PG8_WAIT_L(0); PG8_BAR; PG8_MMA(1, 0, At, B0); PG8_MMA(1, 1, At, B1); PG8_BAR; PG8_SCHED;
        }
        if (wr == 0) PG8_BAR;
        E(acc, cur, wr, wc, fr, fq);
        if (!has_next) break;
#pragma unroll
        for (int a = 0; a < 2; ++a)
#pragma unroll
            for (int b = 0; b < 2; ++b)
#pragma unroll
                for (int m = 0; m < 4; ++m)
#pragma unroll
                    for (int n = 0; n < 2; ++n) acc[a][b][m][n] = (f32x4){0.f, 0.f, 0.f, 0.f};
        cur = nxt; cA = nA; cB = nB; ++ui;
        if constexpr (GATHER) {
#pragma unroll
            for (int i = 0; i < 2; ++i)
#pragma unroll
                for (int h = 0; h < 2; ++h) cva[h][i] = nva[h][i];
        }
        if (wr == 1) PG8_BAR;
    }
    PG8_WAIT_V(0);
    PG8_BAR;
#undef PG8_SA
#undef PG8_SB
#undef PG8_STAGE
#undef PG8_LDA
#undef PG8_LDB
#undef PG8_MMA
#undef PG8_WAIT_V
#undef PG8_WAIT_L
#undef PG8_BAR
#undef PG8_SCHED
}

struct DenseOrder {
    int nM, nN, nwg, G, c, lda, ldb;
    __device__ __forceinline__ void init(int M_, int N_, int G_, int c_, int lda_, int ldb_) { nM = M_ / BM; nN = N_ / BM; nwg = nM * nN; G = G_; c = c_; lda = lda_; ldb = ldb_; }
    __device__ __forceinline__ bool next(int i, Unit& u) const {
        const long L = (long)i * G + c; if (L >= nwg) return false;
        int wgid = (int)L; { const int q = nwg / 8, r = nwg % 8, xcd = wgid % 8, off = wgid / 8; wgid = (xcd < r ? xcd * (q + 1) : r * (q + 1) + (xcd - r) * q) + off; }
        const int nig = 8 * nN, gid = wgid / nig, fm = gid * 8, gsz = (nM - fm) < 8 ? (nM - fm) : 8;
        u.pm = fm + ((wgid % nig) % gsz); u.pn = (wgid % nig) / gsz; u.e = 0; return true;
    }
    __device__ __forceinline__ size_t a_off(const Unit& u) const { return (size_t)u.pm * BM * lda * 2; }
    __device__ __forceinline__ size_t b_off(const Unit& u) const { return (size_t)u.pn * BM * ldb * 2; }
    __device__ __forceinline__ int tok(const Unit&, int) const { return 0; }
};
struct TwoRoundOrder {
    int G, c, lda, ldb;
    __device__ __forceinline__ bool next(int i, Unit& u) const { const int L = i * G + c; if (L >= 512) return false; const int tile = L & 255; u.pm = tile >> 2; u.pn = tile & 3; u.e = L >> 8; return true; }
    __device__ __forceinline__ size_t a_off(const Unit& u) const { return (size_t)u.pm * BM * lda * 2 + (size_t)u.e * 1024; }
    __device__ __forceinline__ size_t b_off(const Unit& u) const { return (size_t)(u.e * 1024 + u.pn * BM) * ldb * 2; }
    __device__ __forceinline__ int tok(const Unit&, int) const { return 0; }
};
struct MoeOrder {
    const LAS int* tb; const int* tlist; int G, c, npn, lda, ldb, nexp;
    __device__ __forceinline__ bool next(int i, Unit& u) const {
        const int L = i * G + c; if (L >= tb[96]) return false;
        int e = 0; while (tb[65 + e] <= L) ++e;
        const int loc = L - tb[64 + e]; u.e = e; u.pn = loc % npn; u.pm = (tb[e] >> 8) + loc / npn; return true;
    }
    __device__ __forceinline__ size_t a_off(const Unit& u) const { return (size_t)u.pm * BM * lda * 2; }
    __device__ __forceinline__ size_t b_off(const Unit& u) const { return (size_t)(u.e * nexp + u.pn * BM) * ldb * 2; }
    __device__ __forceinline__ int tok(const Unit& u, int row) const { const int r = u.pm * BM - tb[u.e] + row; return r < tb[32 + u.e] ? tlist[u.e * LISTCAP + r] : 0; }
};

#define EPI_ARGS const f32x4 (&acc)[2][2][4][2], const Unit& u, int wr, int wc, int fr, int fq
#define EPI_FOR_ROWS for (int ai = 0; ai < 2; ++ai) _Pragma("unroll") for (int m = 0; m < 4; ++m)
__device__ __forceinline__ v4u pack8(const f32x4 a, const f32x4 b) { v4u w; w.x = cvt_pk_bf16(a[0], a[1]); w.y = cvt_pk_bf16(a[2], a[3]); w.z = cvt_pk_bf16(b[0], b[1]); w.w = cvt_pk_bf16(b[2], b[3]); return w; }
__device__ __forceinline__ void unpack8(const v4u w, f32x4& a, f32x4& b) { a = (f32x4){lo16(w.x), hi16(w.x), lo16(w.y), hi16(w.y)}; b = (f32x4){lo16(w.z), hi16(w.z), lo16(w.w), hi16(w.w)}; }
__device__ __forceinline__ float sigm(float v) { return __builtin_amdgcn_rcpf(1.f + __expf(-v)); }

__device__ __forceinline__ void store_tile_T(const f32x4 (&acc)[2][2][4][2], bf16_t* VT, int vrow0, int s0, int pitch) {
#pragma unroll
    for (int bj = 0; bj < 2; ++bj)
#pragma unroll
        for (int n = 0; n < 2; ++n)
#pragma unroll
            for (int e = 0; e < 4; ++e) { bf16_t* vp = VT + (size_t)(vrow0 + 128 * bj + 4 * n + e) * pitch + s0;
#pragma unroll
                for (int ai = 0; ai < 2; ++ai)
#pragma unroll
                    for (int m = 0; m < 4; ++m) vp[128 * ai + 16 * m] = (bf16_t)(cvt_pk_bf16(acc[ai][bj][m][n][e], 0.f) & 0xffffu); }
}
struct EpiKV { bf16_t* KVM; bf16_t* VTM;
    __device__ __forceinline__ void operator()(EPI_ARGS) const {
        const int row0 = u.pm * BM + wr * 64 + fr, col0 = u.pn * BM + wc * 32 + 8 * fq;
#pragma unroll
        EPI_FOR_ROWS { bf16_t* rowp = KVM + (size_t)(row0 + ai * HALF + m * 16) * 2048 + col0;
#pragma unroll
            for (int bj = 0; bj < 2; ++bj) *(v4u*)(rowp + bj * HALF) = pack8(acc[ai][bj][m][0], acc[ai][bj][m][1]); }
        if (u.pn >= 4) store_tile_T(acc, VTM, u.pm * 1024 + (u.pn - 4) * BM + wc * 32 + 8 * fq, wr * 64 + fr, MEMLEN);
    } };
struct EpiBf16Store { bf16_t* O; int ldc;
    __device__ __forceinline__ void operator()(EPI_ARGS) const {
        const int row0 = u.pm * BM + wr * 64 + fr, col0 = u.pn * BM + wc * 32 + 8 * fq;
#pragma unroll
        EPI_FOR_ROWS { bf16_t* rowp = O + (size_t)(row0 + ai * HALF + m * 16) * ldc + col0;
#pragma unroll
            for (int bj = 0; bj < 2; ++bj) *(v4u*)(rowp + bj * HALF) = pack8(acc[ai][bj][m][0], acc[ai][bj][m][1]); }
    } };
struct EpiResidF32 { const float* base; float* out;
    __device__ __forceinline__ void operator()(EPI_ARGS) const {
        const int row0 = u.pm * BM + wr * 64 + fr, col0 = u.pn * BM + wc * 32 + 8 * fq;
#pragma unroll
        EPI_FOR_ROWS { const size_t off = (size_t)(row0 + ai * HALF + m * 16) * D + col0;
#pragma unroll
            for (int bj = 0; bj < 2; ++bj)
#pragma unroll
                for (int n = 0; n < 2; ++n) { const f32x4 b = *(const f32x4*)(base + off + bj * HALF + 4 * n); *(f32x4*)(out + off + bj * HALF + 4 * n) = b + acc[ai][bj][m][n]; } }
    } };
struct EpiGate { const bf16_t* PR; float* T; bf16_t* MIX;
    __device__ __forceinline__ void operator()(EPI_ARGS) const {
        const int row0 = u.pm * BM + wr * 64 + fr, col0 = u.pn * BM + wc * 32 + 8 * fq;
#pragma unroll
        EPI_FOR_ROWS { const int row = row0 + ai * HALF + m * 16;
#pragma unroll
            for (int bj = 0; bj < 2; ++bj) { const int col = col0 + bj * HALF; f32x4 g0, g1;
                unpack8(*(const v4u*)(PR + (size_t)row * NIN + (u.e ? C_GDF : C_GSB) + col), g0, g1);
                float* tp = T + (size_t)row * D + col;
                if (u.e == 0) { *(f32x4*)tp = g0 * acc[ai][bj][m][0]; *(f32x4*)(tp + 4) = g1 * acc[ai][bj][m][1]; }
                else { const f32x4 t0 = *(const f32x4*)tp, t1 = *(const f32x4*)(tp + 4); *(v4u*)(MIX + (size_t)row * D + col) = pack8(t0 + g0 * acc[ai][bj][m][0], t1 + g1 * acc[ai][bj][m][1]); } } }
    } };
struct EpiInProj { bf16_t* PR; const float* rc; const float* rs; bf16_t* VTSB; bf16_t* VTDF;
    __device__ __forceinline__ void operator()(EPI_ARGS) const {
        const int row0 = u.pm * BM + wr * 64 + fr, pn = u.pn;
        if (pn >= 6 && pn < 10) {
            const float sc = pn < 8 ? 0.125f : 1.0f; const int i0 = 16 * (wc & 1) + 4 * fq;
#pragma unroll
            EPI_FOR_ROWS { const int row = row0 + ai * HALF + m * 16; const f32x4 cs = *(const f32x4*)(rc + (size_t)row * 32 + i0), sn = *(const f32x4*)(rs + (size_t)row * 32 + i0);
#pragma unroll
                for (int bj = 0; bj < 2; ++bj) { const f32x4 lo = acc[ai][bj][m][0], hi = acc[ai][bj][m][1];
                    const f32x4 olo = (lo * cs - hi * sn) * sc, ohi = (hi * cs + lo * sn) * sc;
                    bf16_t* p = PR + (size_t)row * NIN + pn * BM + 64 * (2 * bj + (wc >> 1)) + i0;
                    v2u a, b; a.x = cvt_pk_bf16(olo[0], olo[1]); a.y = cvt_pk_bf16(olo[2], olo[3]); b.x = cvt_pk_bf16(ohi[0], ohi[1]); b.y = cvt_pk_bf16(ohi[2], ohi[3]);
                    *(v2u*)p = a; *(v2u*)(p + 32) = b; } }
        } else {
            const int col0 = pn * BM + wc * 32 + 8 * fq; const float sc = pn < 2 ? 0.125f : 1.0f; const bool sg = pn >= 12;
#pragma unroll
            EPI_FOR_ROWS { bf16_t* rowp = PR + (size_t)(row0 + ai * HALF + m * 16) * NIN + col0;
#pragma unroll
                for (int bj = 0; bj < 2; ++bj) { f32x4 v0 = acc[ai][bj][m][0] * sc, v1 = acc[ai][bj][m][1] * sc;
                    if (sg) { v0 = (f32x4){sigm(v0[0]), sigm(v0[1]), sigm(v0[2]), sigm(v0[3])}; v1 = (f32x4){sigm(v1[0]), sigm(v1[1]), sigm(v1[2]), sigm(v1[3])}; }
                    *(v4u*)(rowp + bj * HALF) = pack8(v0, v1); } }
            if (pn == 4 || pn == 5 || pn == 10 || pn == 11) {
                const int bb = u.pm >> 4, s0 = (u.pm & 15) * BM + wr * 64 + fr, hd0 = (pn < 6 ? (pn - 4) : (pn - 10)) * BM + wc * 32 + 8 * fq;
                store_tile_T(acc, pn < 6 ? VTSB : VTDF, bb * 512 + hd0, s0, SEQ);
            }
        }
    } };
struct EpiMoeGU { bf16_t* ACT; const float* bgu;
    __device__ __forceinline__ void operator()(EPI_ARGS) const {
        const int row0 = u.pm * BM + wr * 64 + fr, j0 = u.pn * 128 + wc * 32 + 8 * fq; const float* bg = bgu + (size_t)u.e * 2048 + j0;
        const f32x4 bg0 = *(const f32x4*)bg, bg1 = *(const f32x4*)(bg + 4), bl0 = *(const f32x4*)(bg + 1024), bl1 = *(const f32x4*)(bg + 1028);
#pragma unroll
        EPI_FOR_ROWS { f32x4 o[2];
#pragma unroll
            for (int n = 0; n < 2; ++n) { const f32x4 gv = acc[ai][0][m][n] + (n ? bg1 : bg0), lv = acc[ai][1][m][n] + (n ? bl1 : bl0);
#pragma unroll
                for (int c = 0; c < 4; ++c) { const float gl = fminf(gv[c], 7.0f), li = fminf(fmaxf(lv[c], -7.0f), 7.0f); o[n][c] = gl * sigm(1.702f * gl) * (li + 1.0f); } }
            *(v4u*)(ACT + (size_t)(row0 + ai * HALF + m * 16) * DFF + j0) = pack8(o[0], o[1]); }
    } };
struct EpiMoeDown { bf16_t* YB; const float* bd; const float* glist; const LAS int* tb;
    __device__ __forceinline__ void operator()(EPI_ARGS) const {
        const int row0 = u.pm * BM + wr * 64 + fr, col0 = u.pn * BM + wc * 32 + 8 * fq; const float* bp = bd + (size_t)u.e * D + col0;
        const float* gl = glist + (size_t)u.e * LISTCAP - tb[u.e];
        f32x4 bv[2][2];
#pragma unroll
        for (int bj = 0; bj < 2; ++bj)
#pragma unroll
            for (int n = 0; n < 2; ++n) bv[bj][n] = *(const f32x4*)(bp + bj * HALF + 4 * n);
#pragma unroll
        EPI_FOR_ROWS { const int row = row0 + ai * HALF + m * 16; const float gt = gl[row];
#pragma unroll
            for (int bj = 0; bj < 2; ++bj) *(v4u*)(YB + (size_t)row * D + col0 + bj * HALF) = pack8((acc[ai][bj][m][0] + bv[bj][0]) * gt, (acc[ai][bj][m][1] + bv[bj][1]) * gt); }
    } };
}


typedef float f32x16 __attribute__((ext_vector_type(16)));
typedef short s16x4 __attribute__((ext_vector_type(4)));
__device__ __forceinline__ f32x16 mfma32(bf16x8 a, bf16x8 b, f32x16 c) { return __builtin_amdgcn_mfma_f32_32x32x16_bf16(a, b, c, 0, 0, 0); }
__device__ __forceinline__ float xhalf(float v, int hh) { auto rr = __builtin_amdgcn_permlane32_swap(__float_as_uint(v), __float_as_uint(v), false, false); return __uint_as_float(hh ? rr[0] : rr[1]); }
__device__ __forceinline__ bf16x8 vt_frag(const bf16_t* p) { const s16x4 lo = *(const s16x4*)p, hi = *(const s16x4*)(p + 8); return (bf16x8){lo[0], lo[1], lo[2], lo[3], hi[0], hi[1], hi[2], hi[3]}; }
__device__ __forceinline__ bf16x8 pack_p(const f32x16& p, int s) { v4u w; w.x = pg8::cvt_pk_bf16(p[8 * s + 0], p[8 * s + 1]); w.y = pg8::cvt_pk_bf16(p[8 * s + 2], p[8 * s + 3]); w.z = pg8::cvt_pk_bf16(p[8 * s + 4], p[8 * s + 5]); w.w = pg8::cvt_pk_bf16(p[8 * s + 6], p[8 * s + 7]); return __builtin_bit_cast(bf16x8, w); }
constexpr float LOG2E = 1.4426950408889634f;

template <int NO>
__device__ __forceinline__ void softmax_step(f32x16& S, float C, float& m, float& l, f32x16 (&O)[NO], int hh) {
    float mx = fmaxf(fmaxf(S[0], S[1]), fmaxf(S[2], S[3]));
#pragma unroll
    for (int i = 4; i < 16; i += 4) mx = fmaxf(mx, fmaxf(fmaxf(S[i], S[i + 1]), fmaxf(S[i + 2], S[i + 3])));
    mx = fmaxf(mx, xhalf(mx, hh)) * C;
    const float mn = fmaxf(m, mx), al = __builtin_amdgcn_exp2f(m - mn);
    m = mn; l *= al;
#pragma unroll
    for (int o = 0; o < NO; ++o) O[o] = O[o] * al;
    float ps = 0.f;
#pragma unroll
    for (int i = 0; i < 16; ++i) { S[i] = __builtin_amdgcn_exp2f(S[i] * C - mn); ps += S[i]; }
    l += ps;
}

__device__ __forceinline__ void attn_diff_wave(const bf16_t* PR, const bf16_t* VT, float* ODR, int b, int h, int j, int q0, int lane) {
    const int r32 = lane & 31, hh = lane >> 5;
    const bf16_t* qrow = PR + (size_t)(b * SEQ + q0 + r32) * NIN + C_DQ + h * 128 + j * 64 + 8 * hh;
    bf16x8 qf[4];
#pragma unroll
    for (int d0 = 0; d0 < 4; ++d0) qf[d0] = *(const bf16x8*)(qrow + 16 * d0);
    const bf16_t* kbase = PR + (size_t)(b * SEQ + r32) * NIN + C_DK + h * 128 + j * 64 + 8 * hh;
    const bf16_t* vbase = VT + (size_t)(b * 512 + h * 128 + r32) * SEQ + 4 * hh;
    f32x16 O[4];
#pragma unroll
    for (int o = 0; o < 4; ++o)
#pragma unroll
        for (int i = 0; i < 16; ++i) O[o][i] = 0.f;
    float m = -INFINITY, l = 0.f;
    const int nt = 2 * (q0 / 64 + 1);
    for (int t = 0; t < nt; ++t) {
        const bf16_t* kp = kbase + (size_t)(32 * t) * NIN;
        f32x16 S;
#pragma unroll
        for (int i = 0; i < 16; ++i) S[i] = 0.f;
#pragma unroll
        for (int d0 = 0; d0 < 4; ++d0) S = mfma32(*(const bf16x8*)(kp + 16 * d0), qf[d0], S);
        softmax_step<4>(S, LOG2E, m, l, O, hh);
        const bf16x8 p0 = pack_p(S, 0), p1 = pack_p(S, 1);
        const bf16_t* vp = vbase + 32 * t;
#pragma unroll
        for (int o = 0; o < 4; ++o) { O[o] = mfma32(vt_frag(vp + (size_t)(32 * o) * SEQ), p0, O[o]); O[o] = mfma32(vt_frag(vp + (size_t)(32 * o) * SEQ + 16), p1, O[o]); }
    }
    l += xhalf(l, hh);
    const float il = 1.f / l;
    float* orow = ODR + ((size_t)j * M + (size_t)b * SEQ + q0 + r32) * 512 + h * 128 + 4 * hh;
#pragma unroll
    for (int o = 0; o < 4; ++o)
#pragma unroll
        for (int g = 0; g < 4; ++g) *(f32x4*)(orow + 32 * o + 8 * g) = (f32x4){O[o][4 * g] * il, O[o][4 * g + 1] * il, O[o][4 * g + 2] * il, O[o][4 * g + 3] * il};
}

__device__ __forceinline__ void attn_sb_wave(const bf16_t* PR, const bf16_t* VT, bf16_t* OAT, int b, int h, int q0, int lane) {
    const int r32 = lane & 31, hh = lane >> 5;
    const bf16_t* qrow = PR + (size_t)(b * SEQ + q0 + r32) * NIN + C_SBQ + h * 64 + 8 * hh;
    bf16x8 qf[4];
#pragma unroll
    for (int d0 = 0; d0 < 4; ++d0) qf[d0] = *(const bf16x8*)(qrow + 16 * d0);
    const bf16_t* kbase = PR + (size_t)(b * SEQ + r32) * NIN + C_SBK + h * 64 + 8 * hh;
    const bf16_t* vbase = VT + (size_t)(b * 512 + h * 64 + r32) * SEQ + 4 * hh;
    f32x16 O[2];
#pragma unroll
    for (int o = 0; o < 2; ++o)
#pragma unroll
        for (int i = 0; i < 16; ++i) O[o][i] = 0.f;
    float R = 0.f;
    const int td = q0 >> 5;
    for (int t = td; t >= 0; --t) {
        const bf16_t* kp = kbase + (size_t)(32 * t) * NIN;
        f32x16 S;
#pragma unroll
        for (int i = 0; i < 16; ++i) S[i] = 0.f;
#pragma unroll
        for (int d0 = 0; d0 < 4; ++d0) S = mfma32(*(const bf16x8*)(kp + 16 * d0), qf[d0], S);
        f32x16 lr;
#pragma unroll
        for (int i = 0; i < 16; ++i) { const float z2 = S[i] * LOG2E; const float sp = fmaxf(z2, 0.f) + __builtin_amdgcn_logf(1.f + __builtin_amdgcn_exp2f(-fabsf(z2)));
            lr[i] = -sp; S[i] = z2 - sp; }
        if (t == td) {
#pragma unroll
            for (int i = 0; i < 16; ++i) { const int kvl = (i & 3) + 8 * (i >> 2) + 4 * hh; if (kvl >= r32) { lr[i] = 0.f; S[i] = -INFINITY; } }
        }
        float tot[4], pt[4], off[4];
        f32x16 ex;
#pragma unroll
        for (int g = 0; g < 4; ++g) { ex[4 * g + 3] = 0.f; ex[4 * g + 2] = lr[4 * g + 3]; ex[4 * g + 1] = lr[4 * g + 3] + lr[4 * g + 2]; ex[4 * g] = ex[4 * g + 1] + lr[4 * g + 1]; tot[g] = ex[4 * g] + lr[4 * g]; }
#pragma unroll
        for (int g = 0; g < 4; ++g) pt[g] = xhalf(tot[g], hh);
        const float own0 = hh ? 0.f : 1.f;
        float sp_ = 0.f;
#pragma unroll
        for (int g = 3; g >= 0; --g) { off[g] = sp_ + own0 * pt[g] + R; sp_ += tot[g] + pt[g]; }
#pragma unroll
        for (int i = 0; i < 16; ++i) S[i] = __builtin_amdgcn_exp2f(S[i] + ex[i] + off[i >> 2]);
        R += sp_;
        const bf16x8 p0 = pack_p(S, 0), p1 = pack_p(S, 1);
        const bf16_t* vp = vbase + 32 * t;
#pragma unroll
        for (int o = 0; o < 2; ++o) { O[o] = mfma32(vt_frag(vp + (size_t)(32 * o) * SEQ), p0, O[o]); O[o] = mfma32(vt_frag(vp + (size_t)(32 * o) * SEQ + 16), p1, O[o]); }
        if (__all(R < -160.f)) break;
    }
    bf16_t* orow = OAT + (size_t)(b * SEQ + q0 + r32) * D + h * 64 + 4 * hh;
#pragma unroll
    for (int o = 0; o < 2; ++o)
#pragma unroll
        for (int g = 0; g < 4; ++g) { v2u w; w.x = pg8::cvt_pk_bf16(O[o][4 * g], O[o][4 * g + 1]); w.y = pg8::cvt_pk_bf16(O[o][4 * g + 2], O[o][4 * g + 3]); *(v2u*)(orow + 32 * o + 8 * g) = w; }
}

__device__ __forceinline__ void attn_mem_wave(const bf16_t* QM, const bf16_t* KVM, const bf16_t* VT, bf16_t* OM, int b, int h, int q0, int lane) {
    const int r32 = lane & 31, hh = lane >> 5;
    const bf16_t* qrow = QM + (size_t)(b * SEQ + q0 + r32) * D + h * 256 + 8 * hh;
    const bf16_t* kbase = KVM + (size_t)(b * MEMLEN + r32) * 2048 + h * 256 + 8 * hh;
    for (int dh = 0; dh < 2; ++dh) {
        const bf16_t* vbase = VT + (size_t)(b * 1024 + h * 256 + dh * 128 + r32) * MEMLEN + 4 * hh;
        f32x16 O[4];
#pragma unroll
        for (int o = 0; o < 4; ++o)
#pragma unroll
            for (int i = 0; i < 16; ++i) O[o][i] = 0.f;
        float m = -INFINITY, l = 0.f;
        for (int t = 0; t < 8; ++t) {
            const bf16_t* kp = kbase + (size_t)(32 * t) * 2048;
            f32x16 S;
#pragma unroll
            for (int i = 0; i < 16; ++i) S[i] = 0.f;
#pragma unroll
            for (int d0 = 0; d0 < 16; ++d0) S = mfma32(*(const bf16x8*)(kp + 16 * d0), *(const bf16x8*)(qrow + 16 * d0), S);
            softmax_step<4>(S, LOG2E * 0.0625f, m, l, O, hh);
            const bf16x8 p0 = pack_p(S, 0), p1 = pack_p(S, 1);
            const bf16_t* vp = vbase + 32 * t;
#pragma unroll
            for (int o = 0; o < 4; ++o) { O[o] = mfma32(vt_frag(vp + (size_t)(32 * o) * MEMLEN), p0, O[o]); O[o] = mfma32(vt_frag(vp + (size_t)(32 * o) * MEMLEN + 16), p1, O[o]); }
        }
        l += xhalf(l, hh);
        const float il = 1.f / l;
        bf16_t* orow = OM + (size_t)(b * SEQ + q0 + r32) * D + h * 256 + dh * 128 + 4 * hh;
#pragma unroll
        for (int o = 0; o < 4; ++o)
#pragma unroll
            for (int g = 0; g < 4; ++g) { v2u w; w.x = pg8::cvt_pk_bf16(O[o][4 * g] * il, O[o][4 * g + 1] * il); w.y = pg8::cvt_pk_bf16(O[o][4 * g + 2] * il, O[o][4 * g + 3] * il); *(v2u*)(orow + 32 * o + 8 * g) = w; }
    }
}

struct Args { const void* in[26]; float* out; unsigned char* ws; int ph_lo, ph_hi; };
constexpr int NPHASE = 15;

__device__ __forceinline__ float softplus_f(float z) { return fmaxf(z, 0.f) + __logf(1.f + __expf(-fabsf(z))); }

__global__ void __launch_bounds__(NTHR, 2) fwd(Args args) {
    extern __shared__ __attribute__((aligned(16))) unsigned char lds[];
    LAS unsigned char* L = (LAS unsigned char*)lds;
    volatile LAS unsigned* MISC = (volatile LAS unsigned*)(L + MISC_OFF);
    const int tid = threadIdx.x, lane = tid & 63, wave = __builtin_amdgcn_readfirstlane(tid >> 6);
    const int G = gridDim.x;
    unsigned char* ws = args.ws;
    unsigned* ctl = (unsigned*)(ws + WS_CTL);
    const float* x = (const float*)args.in[0]; const float* mem = (const float*)args.in[1]; const int* positions = (const int*)args.in[2];
    const float* norm_mix = (const float*)args.in[3]; const float* w_in = (const float*)args.in[4];
    const float* lam_q1 = (const float*)args.in[5]; const float* lam_k1 = (const float*)args.in[6]; const float* lam_q2 = (const float*)args.in[7]; const float* lam_k2 = (const float*)args.in[8];
    const float* diff_subln = (const float*)args.in[9]; const float* w_up_sb = (const float*)args.in[10]; const float* w_up_diff = (const float*)args.in[11];
    const float* w_out = (const float*)args.in[12]; const float* norm_mem_q = (const float*)args.in[13]; const float* norm_mem_kv = (const float*)args.in[14];
    const float* w_mem_q = (const float*)args.in[15]; const float* w_mem_kv = (const float*)args.in[16]; const float* w_mem_o = (const float*)args.in[17];
    const float* norm_ffn = (const float*)args.in[18]; const float* w_router = (const float*)args.in[19]; const float* b_router = (const float*)args.in[20];
    const float* w_gate_up = (const float*)args.in[21]; const float* b_gate_up = (const float*)args.in[22]; const float* w_down = (const float*)args.in[23];
    const float* b_down = (const float*)args.in[24]; const float* norm_final = (const float*)args.in[25];
    bf16_t* WIN = (bf16_t*)(ws + WS_WIN); bf16_t* WUPSB = (bf16_t*)(ws + WS_WUPSB); bf16_t* WUPDF = (bf16_t*)(ws + WS_WUPDF); bf16_t* WOUT = (bf16_t*)(ws + WS_WOUT);
    bf16_t* WMQ = (bf16_t*)(ws + WS_WMQ); bf16_t* WMKV = (bf16_t*)(ws + WS_WMKV); bf16_t* WMO = (bf16_t*)(ws + WS_WMO);
    bf16_t* WGU = (bf16_t*)(ws + WS_WGU); bf16_t* WD = (bf16_t*)(ws + WS_WD);
    float* ROPEC = (float*)(ws + WS_ROPE); float* ROPES = ROPEC + (size_t)M * 32;
    int* TK_E = (int*)(ws + WS_TK); int* TK_POS = TK_E + (size_t)M * 4; float* TK_G = (float*)(TK_POS + (size_t)M * 4);
    bf16_t* XN = (bf16_t*)(ws + WS_XN); bf16_t* PR = (bf16_t*)(ws + WS_PR); bf16_t* OAT = (bf16_t*)(ws + WS_OAT); float* ODR = (float*)(ws + WS_ODR);
    bf16_t* MIX = (bf16_t*)(ws + WS_MIX); float* X1 = (float*)(ws + WS_X1); float* X2 = (float*)(ws + WS_X2);
    bf16_t* HM = (bf16_t*)(ws + WS_HM); bf16_t* KVM = (bf16_t*)(ws + WS_KVM); int* TLIST = (int*)(ws + WS_TLIST); float* GLIST = (float*)(ws + WS_GLIST);
    bf16_t* QM = (bf16_t*)(ws + WS_QM); bf16_t* OM = (bf16_t*)(ws + WS_OM); bf16_t* ACT = (bf16_t*)(ws + WS_ACT); bf16_t* YB = (bf16_t*)(ws + WS_YB);
    bf16_t* VTSB = (bf16_t*)(ws + WS_VTSB); bf16_t* VTDF = (bf16_t*)(ws + WS_VTDF); bf16_t* VTM = (bf16_t*)(ws + WS_VTM);
    unsigned* CNT = ctl + CW_CNT;
    LAS float* smf = (LAS float*)L;
    LAS int* smi = (LAS int*)L;

    for (int u = tid; u < (LDS_BYTES - 131072) / 4; u += NTHR) ((LAS unsigned*)(L + 131072))[u] = 0u;
    __syncthreads();
#if !MK_PER_PHASE
    XcdBarrier bar = xcd_barrier_post(ctl + CW_BAR, MISC + 8);
#define GRID_BAR() xcd_barrier(bar)
#else
#define GRID_BAR() do {} while (0)
#endif
    const int lo = args.ph_lo, hi = args.ph_hi;
#define IN(k) (lo <= (k) && (k) < hi)
#define SEAM(k) do { if (IN(k) && IN((k) + 1)) GRID_BAR(); } while (0)
    const int gw = blockIdx.x * NWAVES + wave, NGW = G * NWAVES;

    if (IN(0)) {
        LAS float* scr = (LAS float*)(L + wave * 16384);
        constexpr int I_IN = 16 * 160, I_UP = 8 * 32, I_SQ = 16 * 32, I_KV = 16 * 64, I_GU1 = 16 * 64, I_GU = NE * I_GU1, I_D1 = 16 * 32, I_DN = NE * I_D1;
        constexpr int NITEMS = I_IN + 2 * I_UP + 3 * I_SQ + I_KV + I_GU + I_DN;
        for (int it = gw; it < NITEMS; it += NGW) {
            int r = it;
            if (r < I_IN) {
#if FAST_P1
                const int kb = r / 160, nb = r % 160, n0 = 32 * nb;
                if (n0 >= C_DQ && n0 < C_DV) { const int o = n0 & 255;
                    p0_transpose_rope(w_in, WIN, (n0 & ~255), o, 64 * kb, n0, scr, lane); }
                else p0_transpose_item(w_in, 1024, NIN, WIN, n0, 64 * kb, n0, scr, lane);
#else
                p0_plain(w_in, 1024, NIN, WIN, r, scr, lane);
#endif
                continue; } r -= I_IN;
            if (r < I_UP) { p0_plain(w_up_sb, 512, 1024, WUPSB, r, scr, lane); continue; } r -= I_UP;
            if (r < I_UP) { p0_plain(w_up_diff, 512, 1024, WUPDF, r, scr, lane); continue; } r -= I_UP;
            if (r < I_SQ) { p0_plain(w_out, 1024, 1024, WOUT, r, scr, lane); continue; } r -= I_SQ;
            if (r < I_SQ) { p0_plain(w_mem_q, 1024, 1024, WMQ, r, scr, lane); continue; } r -= I_SQ;
            if (r < I_SQ) { p0_plain(w_mem_o, 1024, 1024, WMO, r, scr, lane); continue; } r -= I_SQ;
            if (r < I_KV) { p0_plain(w_mem_kv, 1024, 2048, WMKV, r, scr, lane); continue; } r -= I_KV;
            if (r < I_GU) { const int e = r / I_GU1, q = r % I_GU1, kb = q / 64, nb = q % 64, n0 = 32 * nb;
                const int half = n0 >> 10, j = n0 & 1023, drow0 = (j >> 7) * 256 + half * 128 + (j & 127);
                p0_transpose_item(w_gate_up + (size_t)e * 1024 * 2048, 1024, 2048, WGU + (size_t)e * 2048 * 1024, drow0, 64 * kb, n0, scr, lane); continue; } r -= I_GU;
            { const int e = r / I_D1, q = r % I_D1; p0_plain(w_down + (size_t)e * 1024 * 1024, 1024, 1024, WD + (size_t)e * 1024 * 1024, q, scr, lane); }
        }
        for (int m = gw; m < M; m += NGW) rms_row_to_bf16(x + (size_t)m * D, norm_mix, XN + (size_t)m * D, lane);
        for (int m = gw; m < MM; m += NGW) rms_row_to_bf16(mem + (size_t)m * D, norm_mem_kv, HM + (size_t)m * D, lane);
        for (int i = blockIdx.x * NTHR + tid; i < M * 32; i += G * NTHR) {
            const int m = i >> 5, f = i & 31;
            const double inv = exp2(-(double)f * (13.287712379549449 / 32.0));
            const double ang = (double)positions[m] * inv;
            const double kk = rint(ang * 0.15915494309189535);
            const float rf = (float)(ang - kk * 6.283185307179586);
            ROPEC[i] = __cosf(rf); ROPES[i] = __sinf(rf);
        }
    }
    SEAM(0);

    if (IN(1)) {
#if FAST_P1
        { pg8::Gemm g{XN, WIN, D, D, D}; pg8::DenseOrder S; S.init(M, NIN, G, (int)blockIdx.x, D, D);
          pg8::gemm_phase<pg8::EpiInProj, pg8::DenseOrder, false>(L, g, S, pg8::EpiInProj{PR, ROPEC, ROPES, VTSB, VTDF}); }
        { pg8::Gemm g{HM, WMKV, D, D, D}; pg8::DenseOrder S; S.init(MM, 2048, G, (int)blockIdx.x, D, D);
          pg8::gemm_phase<pg8::EpiKV, pg8::DenseOrder, false>(L, g, S, pg8::EpiKV{KVM, VTM}); }
#else
        ngemm_dense(XN, D, WIN, D, M, NIN, D, EpiStoreBf16{PR, NIN}, smf);
        ngemm_dense(HM, D, WMKV, D, MM, 2048, D, EpiStoreBf16{KVM, 2048}, smf);
#endif
    }
    SEAM(1);

    if (IN(2) && !FAST_P1) {
        for (int m = gw; m < M; m += NGW) {
            bf16_t* row = PR + (size_t)m * NIN;
            for (int c = lane; c < 512; c += 64) row[C_SBQ + c] = (bf16_t)f2bf(bf2f(row[C_SBQ + c]) * 0.125f);
            for (int p = lane; p < 512; p += 64) {
                const int blk = p >> 5, i = p & 31, c0 = C_DQ + blk * 64;
                const float cs = ROPEC[(size_t)m * 32 + i], sn = ROPES[(size_t)m * 32 + i];
                const float t1 = bf2f(row[c0 + i]), t2 = bf2f(row[c0 + i + 32]);
                const float sc = (blk < 8) ? 0.125f : 1.0f;
                row[c0 + i] = (bf16_t)f2bf((t1 * cs - t2 * sn) * sc); row[c0 + i + 32] = (bf16_t)f2bf((t2 * cs + t1 * sn) * sc);
            }
            for (int c = lane; c < 2048; c += 64) { const float g = bf2f(row[C_GSB + c]); row[C_GSB + c] = (bf16_t)f2bf(1.f / (1.f + __expf(-g))); }
        }
    }
    SEAM(2);

#if FAST_ATT
    if (IN(3)) {
        for (int bu = blockIdx.x; bu < 512; bu += G) { const int qb = bu & 15, h = (bu >> 4) & 7, b = bu >> 7; attn_sb_wave(PR, VTSB, OAT, b, h, qb * 256 + wave * 32, lane); }
        for (int pr = blockIdx.x; pr < 256; pr += G) { const int sb_ = pr & 7, j = (pr >> 3) & 1, h = (pr >> 4) & 3, b = pr >> 6;
            attn_diff_wave(PR, VTDF, ODR, b, h, j, (15 - sb_) * 256 + wave * 32, lane); attn_diff_wave(PR, VTDF, ODR, b, h, j, sb_ * 256 + wave * 32, lane); }
    }
#else
    if (IN(3)) {
        for (int g = blockIdx.x; g < 256; g += G) {
            const int rowid = g * 512 + tid, b = rowid >> 15, h = (rowid >> 12) & 7, t = rowid & 4095;
            const bf16_t* base = PR + (size_t)b * SEQ * NIN;
            v4u q[8]; float o[64];
            { const bf16_t* qp = base + (size_t)t * NIN + C_SBQ + h * 64;
#pragma unroll
              for (int c = 0; c < 8; ++c) q[c] = *(const v4u*)(qp + c * 8); }
#pragma unroll
            for (int d = 0; d < 64; ++d) o[d] = 0.f;
            float R = 0.f;
            for (int s = t - 1; s >= 0; --s) {
                const bf16_t* kp = base + (size_t)s * NIN + C_SBK + h * 64; const bf16_t* vp = base + (size_t)s * NIN + C_SBV + h * 64;
                float z = 0.f;
#pragma unroll
                for (int c = 0; c < 8; ++c) { const v4u w = *(const v4u*)(kp + c * 8);
                    z += lo16(q[c].x) * lo16(w.x) + hi16(q[c].x) * hi16(w.x) + lo16(q[c].y) * lo16(w.y) + hi16(q[c].y) * hi16(w.y) + lo16(q[c].z) * lo16(w.z) + hi16(q[c].z) * hi16(w.z) + lo16(q[c].w) * lo16(w.w) + hi16(q[c].w) * hi16(w.w); }
                const float sp = softplus_f(z);
                const float wgt = __expf(z - sp + R);
                R -= sp;
#pragma unroll
                for (int c = 0; c < 8; ++c) { const v4u w = *(const v4u*)(vp + c * 8);
                    o[c * 8 + 0] += wgt * lo16(w.x); o[c * 8 + 1] += wgt * hi16(w.x); o[c * 8 + 2] += wgt * lo16(w.y); o[c * 8 + 3] += wgt * hi16(w.y); o[c * 8 + 4] += wgt * lo16(w.z); o[c * 8 + 5] += wgt * hi16(w.z); o[c * 8 + 6] += wgt * lo16(w.w); o[c * 8 + 7] += wgt * hi16(w.w); }
            }
            bf16_t* op = OAT + (size_t)(b * SEQ + t) * D + h * 64;
#pragma unroll
            for (int c = 0; c < 8; ++c) { v4u w; w.x = pk2(o[c * 8 + 0], o[c * 8 + 1]); w.y = pk2(o[c * 8 + 2], o[c * 8 + 3]); w.z = pk2(o[c * 8 + 4], o[c * 8 + 5]); w.w = pk2(o[c * 8 + 6], o[c * 8 + 7]); *(v4u*)(op + c * 8) = w; }
        }
        for (int g = blockIdx.x; g < 512; g += G) {
            const int rowid = g * 512 + tid, t = rowid & 4095, vh = (rowid >> 12) & 1, j = (rowid >> 13) & 1, h = (rowid >> 14) & 3, b = rowid >> 16;
            const bf16_t* base = PR + (size_t)b * SEQ * NIN;
            v4u q[8]; float o[64];
            { const bf16_t* qp = base + (size_t)t * NIN + C_DQ + h * 128 + j * 64;
#pragma unroll
              for (int c = 0; c < 8; ++c) q[c] = *(const v4u*)(qp + c * 8); }
#pragma unroll
            for (int d = 0; d < 64; ++d) o[d] = 0.f;
            float mx = -INFINITY, l = 0.f;
            const int send = t | 63;
            for (int s = 0; s <= send; ++s) {
                const bf16_t* kp = base + (size_t)s * NIN + C_DK + h * 128 + j * 64; const bf16_t* vp = base + (size_t)s * NIN + C_DV + h * 128 + vh * 64;
                float z = 0.f;
#pragma unroll
                for (int c = 0; c < 8; ++c) { const v4u w = *(const v4u*)(kp + c * 8);
                    z += lo16(q[c].x) * lo16(w.x) + hi16(q[c].x) * hi16(w.x) + lo16(q[c].y) * lo16(w.y) + hi16(q[c].y) * hi16(w.y) + lo16(q[c].z) * lo16(w.z) + hi16(q[c].z) * hi16(w.z) + lo16(q[c].w) * lo16(w.w) + hi16(q[c].w) * hi16(w.w); }
                if (z > mx) { const float al = __expf(mx - z); l *= al;
#pragma unroll
                    for (int d = 0; d < 64; ++d) o[d] *= al;
                    mx = z; }
                const float p = __expf(z - mx); l += p;
#pragma unroll
                for (int c = 0; c < 8; ++c) { const v4u w = *(const v4u*)(vp + c * 8);
                    o[c * 8 + 0] += p * lo16(w.x); o[c * 8 + 1] += p * hi16(w.x); o[c * 8 + 2] += p * lo16(w.y); o[c * 8 + 3] += p * hi16(w.y); o[c * 8 + 4] += p * lo16(w.z); o[c * 8 + 5] += p * hi16(w.z); o[c * 8 + 6] += p * lo16(w.w); o[c * 8 + 7] += p * hi16(w.w); }
            }
            const float il = 1.f / l;
            float* op = ODR + ((size_t)j * M + (size_t)b * SEQ + t) * 512 + h * 128 + vh * 64;
#pragma unroll
            for (int c = 0; c < 16; ++c) *(f32x4*)(op + c * 4) = (f32x4){o[c * 4] * il, o[c * 4 + 1] * il, o[c * 4 + 2] * il, o[c * 4 + 3] * il};
        }
    }
#endif
    SEAM(3);

    if (IN(4)) {
        const float s1 = wave_sum(lam_q1[lane] * lam_k1[lane]), s2 = wave_sum(lam_q2[lane] * lam_k2[lane]);
        const float lam = expf(s1) - expf(s2) + 0.2f;
        for (int it = gw; it < M * 4; it += NGW) {
            const int m = it >> 2, h = it & 3;
            const float* p1 = ODR + (size_t)m * 512 + h * 128; const float* p2 = ODR + ((size_t)M + m) * 512 + h * 128;
            const float d0 = p1[lane] - lam * p2[lane], d1 = p1[lane + 64] - lam * p2[lane + 64];
            const float rinv = 1.0f / sqrtf(wave_sum(d0 * d0 + d1 * d1) * (1.f / 128.f) + NORM_EPS);
            bf16_t* op = OAT + (size_t)m * D + 512 + h * 128;
            op[lane] = (bf16_t)f2bf(d0 * rinv * diff_subln[lane] * 0.8f); op[lane + 64] = (bf16_t)f2bf(d1 * rinv * diff_subln[lane + 64] * 0.8f);
        }
    }
    SEAM(4);

    if (IN(5)) {
#if FAST_P5
        pg8::Gemm g{OAT, WUPSB, D, 512, 512}; pg8::TwoRoundOrder S{G, (int)blockIdx.x, D, 512};
        pg8::gemm_phase<pg8::EpiGate, pg8::TwoRoundOrder, false>(L, g, S, pg8::EpiGate{PR, X2, MIX});
#else
        ngemm_dense(OAT, D, WUPSB, 512, M, D, 512, EpiGate1{PR, X2}, smf);
        ngemm_dense(OAT + 512, D, WUPDF, 512, M, D, 512, EpiGate2{PR, X2, MIX}, smf);
#endif
    }
    SEAM(5);

    if (IN(6)) {
#if FAST_P6
        pg8::Gemm g{MIX, WOUT, D, D, D}; pg8::DenseOrder S; S.init(M, D, G, (int)blockIdx.x, D, D);
        pg8::gemm_phase<pg8::EpiResidF32, pg8::DenseOrder, false>(L, g, S, pg8::EpiResidF32{x, X1});
#else
        ngemm_dense(MIX, D, WOUT, D, M, D, D, EpiResid{x, X1}, smf);
#endif
    }
    SEAM(6);

    if (IN(7)) for (int m = gw; m < M; m += NGW) rms_row_to_bf16(X1 + (size_t)m * D, norm_mem_q, XN + (size_t)m * D, lane);
    SEAM(7);

    if (IN(8)) {
#if FAST_P6
        pg8::Gemm g{XN, WMQ, D, D, D}; pg8::DenseOrder S; S.init(M, D, G, (int)blockIdx.x, D, D);
        pg8::gemm_phase<pg8::EpiBf16Store, pg8::DenseOrder, false>(L, g, S, pg8::EpiBf16Store{QM, D});
#else
        ngemm_dense(XN, D, WMQ, D, M, D, D, EpiStoreBf16{QM, D}, smf);
#endif
    }
    SEAM(8);

#if FAST_MEMATT
    if (IN(9)) { for (int bu = blockIdx.x; bu < 256; bu += G) { const int qb = bu & 15, h = (bu >> 4) & 3, b = bu >> 6; attn_mem_wave(QM, KVM, VTM, OM, b, h, qb * 256 + wave * 32, lane); } }
#else
    if (IN(9)) {
        for (int it = gw; it < M * 4; it += NGW) {
            const int m = it >> 2, h = it & 3, b = m >> 12;
            const bf16_t* qp = QM + (size_t)m * D + h * 256;
            const bf16_t* kb = KVM + (size_t)(b * MEMLEN) * 2048 + h * 256;
            float z[4] = {0.f, 0.f, 0.f, 0.f};
            for (int c = 0; c < 32; ++c) {
                const v4u qw = *(const v4u*)(qp + c * 8);
                const float qf[8] = {lo16(qw.x), hi16(qw.x), lo16(qw.y), hi16(qw.y), lo16(qw.z), hi16(qw.z), lo16(qw.w), hi16(qw.w)};
#pragma unroll
                for (int i = 0; i < 4; ++i) { const v4u w = *(const v4u*)(kb + (size_t)(lane + 64 * i) * 2048 + c * 8);
                    z[i] += qf[0] * lo16(w.x) + qf[1] * hi16(w.x) + qf[2] * lo16(w.y) + qf[3] * hi16(w.y) + qf[4] * lo16(w.z) + qf[5] * hi16(w.z) + qf[6] * lo16(w.w) + qf[7] * hi16(w.w); }
            }
#pragma unroll
            for (int i = 0; i < 4; ++i) z[i] *= 0.0625f;
            const float mx = wave_max(fmaxf(fmaxf(z[0], z[1]), fmaxf(z[2], z[3])));
            float p[4]; float ls = 0.f;
#pragma unroll
            for (int i = 0; i < 4; ++i) { p[i] = __expf(z[i] - mx); ls += p[i]; }
            const float il = 1.f / wave_sum(ls);
            float o[4] = {0.f, 0.f, 0.f, 0.f};
            const bf16_t* vb = kb + 1024 + lane * 4;
#pragma unroll
            for (int i = 0; i < 4; ++i)
                for (int kk = 0; kk < 64; ++kk) { const float pk = __shfl(p[i], kk); const v2u w = *(const v2u*)(vb + (size_t)(kk + 64 * i) * 2048);
                    o[0] += pk * lo16(w.x); o[1] += pk * hi16(w.x); o[2] += pk * lo16(w.y); o[3] += pk * hi16(w.y); }
            v2u w; w.x = pk2(o[0] * il, o[1] * il); w.y = pk2(o[2] * il, o[3] * il);
            *(v2u*)(OM + (size_t)m * D + h * 256 + lane * 4) = w;
        }
    }
#endif
    SEAM(9);

    if (IN(10)) {
#if FAST_P6
        pg8::Gemm g{OM, WMO, D, D, D}; pg8::DenseOrder S; S.init(M, D, G, (int)blockIdx.x, D, D);
        pg8::gemm_phase<pg8::EpiResidF32, pg8::DenseOrder, false>(L, g, S, pg8::EpiResidF32{X1, X2});
#else
        ngemm_dense(OM, D, WMO, D, M, D, D, EpiResid{X1, X2}, smf);
#endif
    }
    SEAM(10);

    if (IN(11)) {
        LAS float* hrow = smf + wave * 1024;
        for (int m = gw; m < M; m += NGW) {
            const f32x4* xr = (const f32x4*)(X2 + (size_t)m * D) + lane; const f32x4* gr = (const f32x4*)norm_ffn + lane;
            f32x4 v[4]; float s = 0.f;
#pragma unroll
            for (int j = 0; j < 4; ++j) { v[j] = xr[64 * j]; s += (v[j].x * v[j].x + v[j].y * v[j].y) + (v[j].z * v[j].z + v[j].w * v[j].w); }
            const float rinv = 1.0f / sqrtf(wave_sum(s) * (1.f / 1024.f) + NORM_EPS);
            v2u* o8 = (v2u*)(XN + (size_t)m * D) + lane;
#pragma unroll
            for (int j = 0; j < 4; ++j) { const f32x4 gg = gr[64 * j]; const f32x4 hn = {v[j].x * rinv * gg.x, v[j].y * rinv * gg.y, v[j].z * rinv * gg.z, v[j].w * rinv * gg.w};
                v2u w; w.x = pk2(hn.x, hn.y); w.y = pk2(hn.z, hn.w); o8[64 * j] = w; *(LAS f32x4*)(hrow + (lane + 64 * j) * 4) = hn; }
            LDS_WAIT(); asm volatile("" ::: "memory");
            const int e = lane & 31, kh = lane >> 5;
            float acc = 0.f;
            const float* wr = w_router + (size_t)(kh * 512) * NE + e; const LAS float* hh = hrow + kh * 512;
#pragma unroll 8
            for (int k = 0; k < 512; ++k) acc += hh[k] * wr[(size_t)k * NE];
            acc += __shfl_xor(acc, 32);
            float logit = acc + b_router[e];
            LDS_WAIT(); asm volatile("" ::: "memory");
            float tv[4]; int ti[4]; float cur = logit;
#pragma unroll
            for (int k = 0; k < 4; ++k) {
                float bv = cur; int bi = e;
#pragma unroll
                for (int o = 1; o < 32; o <<= 1) { const float ov = __shfl_xor(bv, o); const int oi = __shfl_xor(bi, o); if (ov > bv || (ov == bv && oi < bi)) { bv = ov; bi = oi; } }
                tv[k] = bv; ti[k] = bi; if (e == bi) cur = -INFINITY;
            }
            const float e1 = __expf(tv[1] - tv[0]), e2 = __expf(tv[2] - tv[0]), e3 = __expf(tv[3] - tv[0]);
            const float isum = 1.f / (1.f + e1 + e2 + e3);
            if (lane < 4) {
                const int ek = lane == 0 ? ti[0] : lane == 1 ? ti[1] : lane == 2 ? ti[2] : ti[3];
                const float gk = (lane == 0 ? 1.f : lane == 1 ? e1 : lane == 2 ? e2 : e3) * isum;
                const int pos = (int)atomicAdd(&CNT[ek], 1u);
                TLIST[ek * LISTCAP + pos] = m; GLIST[ek * LISTCAP + pos] = gk;
                TK_E[m * 4 + lane] = ek; TK_POS[m * 4 + lane] = pos; TK_G[m * 4 + lane] = gk;
            }
        }
    }
    SEAM(11);

#define LOAD_BASES() do { __syncthreads(); if (tid == 0) { int b_ = 0; for (int e_ = 0; e_ < NE; ++e_) { const int c_ = (int)__hip_atomic_load(&CNT[e_], __ATOMIC_RELAXED, __HIP_MEMORY_SCOPE_AGENT); \
        smi[8192 + e_] = b_; smi[8256 + e_] = c_; b_ += (c_ + 255) & ~255; } } __syncthreads(); } while (0)

    LAS int* tb = (LAS int*)(L + 131072 + 1024);
#define LOAD_TB(npn) do { __syncthreads(); if (tid == 0) { int b_ = 0, cu_ = 0; for (int e_ = 0; e_ < NE; ++e_) { const int c_ = (int)__hip_atomic_load(&CNT[e_], __ATOMIC_RELAXED, __HIP_MEMORY_SCOPE_AGENT); \
        tb[e_] = b_; tb[32 + e_] = c_; tb[64 + e_] = cu_; b_ += (c_ + 255) & ~255; cu_ += ((c_ + 255) >> 8) * (npn); } tb[96] = cu_; } __syncthreads(); } while (0)
#if FAST_MOE
    if (IN(12)) {
        LOAD_TB(8);
        pg8::Gemm g{XN, WGU, D, D, D}; pg8::MoeOrder S{tb, TLIST, G, (int)blockIdx.x, 8, D, D, 2048};
        pg8::gemm_phase<pg8::EpiMoeGU, pg8::MoeOrder, true>(L, g, S, pg8::EpiMoeGU{ACT, b_gate_up});
    }
    SEAM(12);
    if (IN(13)) {
        LOAD_TB(4);
        pg8::Gemm g{ACT, WD, DFF, DFF, DFF}; pg8::MoeOrder S{tb, TLIST, G, (int)blockIdx.x, 4, DFF, DFF, 1024};
        pg8::gemm_phase<pg8::EpiMoeDown, pg8::MoeOrder, false>(L, g, S, pg8::EpiMoeDown{YB, b_down, GLIST, tb});
    }
    SEAM(13);
#else
    if (IN(12)) {
        LOAD_BASES();
        int ubase = 0;
        for (int e = 0; e < NE; ++e) {
            const int cnt = smi[8256 + e], sb = smi[8192 + e], nrt = (cnt + 127) >> 7, nu = nrt * 8;
            const int* tl = TLIST + e * LISTCAP;
            auto rp = [=](int r) -> const bf16_t* { return XN + (size_t)(r < cnt ? tl[r] : 0) * D; };
            const float* bg = b_gate_up + (size_t)e * 2048; bf16_t* act = ACT + (size_t)sb * DFF;
            auto epi = [=](int r, int n, float a0, float a1) { const int j = (n >> 8) * 128 + (n & 127);
                float gl = fminf(a0 + bg[j], 7.0f); float li = fminf(fmaxf(a1 + bg[1024 + j], -7.0f), 7.0f);
                act[(size_t)r * DFF + j] = (bf16_t)f2bf(gl * (1.f / (1.f + __expf(-1.702f * gl))) * (li + 1.0f)); };
            int u = ((int)blockIdx.x - ubase) % G; if (u < 0) u += G;
            for (; u < nu; u += G) ngemm_tile<2>(rp, WGU + (size_t)e * 2048 * 1024, D, 128, D, (u >> 3) * 128, (u & 7) * 256, cnt, epi, smf);
            ubase = (ubase + nu) % G;
        }
    }
    SEAM(12);

    if (IN(13)) {
        LOAD_BASES();
        int ubase = 0;
        for (int e = 0; e < NE; ++e) {
            const int cnt = smi[8256 + e], sb = smi[8192 + e], nrt = (cnt + 127) >> 7, nu = nrt * 8;
            RowPlain rp{ACT + (size_t)sb * DFF, DFF};
            const float* bd = b_down + (size_t)e * D; const float* gl = GLIST + e * LISTCAP; bf16_t* yb = YB + (size_t)sb * D;
            auto epi = [=](int r, int n, float a0, float) { yb[(size_t)r * D + n] = (bf16_t)f2bf((a0 + bd[n]) * gl[r]); };
            int u = ((int)blockIdx.x - ubase) % G; if (u < 0) u += G;
            for (; u < nu; u += G) ngemm_tile<1>(rp, WD + (size_t)e * 1024 * 1024, DFF, 0, DFF, (u >> 3) * 128, (u & 7) * 128, cnt, epi, smf);
            ubase = (ubase + nu) % G;
        }
    }
    SEAM(13);
#endif

    if (IN(14)) {
        LOAD_BASES();
        for (int m = gw; m < M; m += NGW) {
            const f32x4* xr = (const f32x4*)(X2 + (size_t)m * D) + lane; const f32x4* gr = (const f32x4*)norm_final + lane;
            f32x4 v[4];
#pragma unroll
            for (int j = 0; j < 4; ++j) v[j] = xr[64 * j];
#pragma unroll
            for (int k = 0; k < 4; ++k) { const int slot = smi[8192 + TK_E[m * 4 + k]] + TK_POS[m * 4 + k]; const v2u* yr = (const v2u*)(YB + (size_t)slot * D) + lane;
#pragma unroll
                for (int j = 0; j < 4; ++j) { const v2u w = yr[64 * j]; v[j].x += lo16(w.x); v[j].y += hi16(w.x); v[j].z += lo16(w.y); v[j].w += hi16(w.y); } }
            float s = 0.f;
#pragma unroll
            for (int j = 0; j < 4; ++j) s += (v[j].x * v[j].x + v[j].y * v[j].y) + (v[j].z * v[j].z + v[j].w * v[j].w);
            const float rinv = 1.0f / sqrtf(wave_sum(s) * (1.f / 1024.f) + NORM_EPS);
            f32x4* orow = (f32x4*)(args.out + (size_t)m * D) + lane;
#pragma unroll
            for (int j = 0; j < 4; ++j) { const f32x4 gg = gr[64 * j]; orow[64 * j] = (f32x4){v[j].x * rinv * gg.x, v[j].y * rinv * gg.y, v[j].z * rinv * gg.z, v[j].w * rinv * gg.w}; }
        }
    }
#undef IN
#undef SEAM
}

extern "C" void kernel_launch(void* const* d_in, const int* in_sizes, int n_in, void* d_out, int out_size, void* d_ws, size_t ws_size, hipStream_t stream) {
    static int grid = 0;
    if (grid == 0) {
        if (n_in != 26 || out_size != M * D || ws_size < WS_END) { fprintf(stderr, "kernel_launch: unexpected sizes n_in %d out %d ws %zu\n", n_in, out_size, ws_size); grid = -1; return; }
        int dev = 0, cus = 0;
        if (hipGetDevice(&dev) != hipSuccess || hipDeviceGetAttribute(&cus, hipDeviceAttributeMultiprocessorCount, dev) != hipSuccess) { grid = -1; return; }
        if (hipFuncSetAttribute((const void*)fwd, hipFuncAttributeMaxDynamicSharedMemorySize, LDS_BYTES) != hipSuccess) { fprintf(stderr, "kernel_launch: hipFuncSetAttribute failed\n"); grid = -1; return; }
        int per_cu = 0;
        (void)hipOccupancyMaxActiveBlocksPerMultiprocessor(&per_cu, (const void*)fwd, NTHR, LDS_BYTES);
        (void)hipGetLastError();
        grid = cus;
    }
    if (grid < 0) return;
    (void)hipMemsetAsync((char*)d_ws + WS_CTL, 0, CTL_ZERO_BYTES, stream);
    Args a{};
    for (int i = 0; i < 26; ++i) a.in[i] = d_in[i];
    a.out = (float*)d_out; a.ws = (unsigned char*)d_ws;
#if MK_PER_PHASE
    for (int p = 0; p < NPHASE; ++p) { a.ph_lo = p; a.ph_hi = p + 1; hipLaunchKernelGGL(fwd, dim3(grid), dim3(NTHR), LDS_BYTES, stream, a); }
#else
    a.ph_lo = 0; a.ph_hi = NPHASE; hipLaunchKernelGGL(fwd, dim3(grid), dim3(NTHR), LDS_BYTES, stream, a);
#endif
}
```

```cpp
#include <hip/hip_runtime.h>
#include <cstdio>
#include <cstdint>

#ifndef MK_PER_PHASE
#define MK_PER_PHASE 0
#endif

#ifndef PROBE_REP
#define PROBE_REP 0
#endif
#define GAS __attribute__((address_space(1)))
#define LAS __attribute__((address_space(3)))
typedef unsigned short bf16_t;
typedef unsigned v4u __attribute__((ext_vector_type(4)));
typedef unsigned v2u __attribute__((ext_vector_type(2)));
typedef float f32x4 __attribute__((ext_vector_type(4)));
typedef short bf16x8 __attribute__((ext_vector_type(8)));

constexpr int BATCH = 4, SEQ = 4096, D = 1024, M = BATCH * SEQ, NIN = 5120;
constexpr int MEMLEN = 256, MM = BATCH * MEMLEN;
constexpr int NE = 32, TOPK = 4, DFF = 1024;
constexpr float NORM_EPS = 1e-6f;
constexpr int C_SBQ = 0, C_SBK = 512, C_SBV = 1024, C_DQ = 1536, C_DK = 2048, C_DV = 2560, C_GSB = 3072, C_GDF = 4096;
constexpr int LISTCAP = 16384;
constexpr int SLOTS = 65536 + NE * 256;
constexpr int NWAVES = 8, NTHR = 512;

constexpr size_t MiB = 1u << 20;
constexpr size_t WS_CTL = 0, CTL_ZERO_BYTES = 1 * MiB;
constexpr size_t WS_WIN = 2 * MiB;
constexpr size_t WS_WUPSB = 12 * MiB;
constexpr size_t WS_WUPDF = 13 * MiB;
constexpr size_t WS_WOUT = 14 * MiB;
constexpr size_t WS_WMQ = 16 * MiB;
constexpr size_t WS_WMKV = 18 * MiB;
constexpr size_t WS_WMO = 22 * MiB;
constexpr size_t WS_ROPE = 24 * MiB;
constexpr size_t WS_TK = 28 * MiB;
constexpr size_t WS_WGU = 32 * MiB;
constexpr size_t WS_WD = 160 * MiB;
constexpr size_t WS_XN = 224 * MiB;
constexpr size_t WS_PR = 256 * MiB;
constexpr size_t WS_OAT = 416 * MiB;
constexpr size_t WS_ODR = 448 * MiB;
constexpr size_t WS_MIX = 512 * MiB;
constexpr size_t WS_X1 = 544 * MiB;
constexpr size_t WS_X2 = 608 * MiB;
constexpr size_t WS_HM = 672 * MiB;
constexpr size_t WS_KVM = 674 * MiB;
constexpr size_t WS_TLIST = 678 * MiB;
constexpr size_t WS_GLIST = 680 * MiB;
constexpr size_t WS_QM = 682 * MiB;
constexpr size_t WS_OM = 714 * MiB;
constexpr size_t WS_ACT = 256 * MiB;
constexpr size_t WS_YB = 746 * MiB;
constexpr size_t WS_VTSB = 890 * MiB;
constexpr size_t WS_VTDF = 906 * MiB;
constexpr size_t WS_VTM = 922 * MiB;
constexpr size_t WS_END = 924 * MiB;
static_assert(WS_ACT + (size_t)SLOTS * 1024 * 2 <= WS_OAT, "ACT overlay");
static_assert(WS_YB + (size_t)SLOTS * 1024 * 2 <= WS_VTSB, "YB");
constexpr int CW_CNT = 1024;
constexpr int CW_BAR = 4096;

constexpr int LDS_BYTES = 147456;
constexpr int MISC_OFF = 131072 + 320;

__device__ __forceinline__ float bf2f(bf16_t b) { return __uint_as_float(((unsigned)b) << 16); }
__device__ __forceinline__ unsigned f2bf(float f) { unsigned u = __float_as_uint(f); return (u + 0x7fffu + ((u >> 16) & 1u)) >> 16; }
__device__ __forceinline__ unsigned pk2(float lo, float hi) { return f2bf(lo) | (f2bf(hi) << 16); }
__device__ __forceinline__ float lo16(unsigned w) { return __uint_as_float(w << 16); }
__device__ __forceinline__ float hi16(unsigned w) { return __uint_as_float(w & 0xffff0000u); }
#define LDS_WAIT() asm volatile("s_waitcnt lgkmcnt(0)" ::: "memory")
__device__ __forceinline__ float wave_sum(float v) {
#pragma unroll
    for (int o = 1; o < 64; o <<= 1) v += __shfl_xor(v, o);
    return v;
}
__device__ __forceinline__ float wave_max(float v) {
#pragma unroll
    for (int o = 1; o < 64; o <<= 1) v = fmaxf(v, __shfl_xor(v, o));
    return v;
}

#define XB_TMO      128
#define XB_XCNT(j)  (256  + 64 * (j))
#define XB_XSUB(j)  (1280 + 64 * (j))
#define XB_XGEN(j)  (2304 + 64 * (j))
#define XB_TOP      3328
#define XB_TOPGEN   3392
#define XCD_BAR_WORDS 3456
#define XB_SPIN_CAP (1u << 18)
__device__ __forceinline__ unsigned xb_ld(unsigned* p)              { return __hip_atomic_load(p, __ATOMIC_RELAXED, __HIP_MEMORY_SCOPE_AGENT); }
__device__ __forceinline__ unsigned xb_add(unsigned* p, unsigned v) { return __hip_atomic_fetch_add(p, v, __ATOMIC_RELAXED, __HIP_MEMORY_SCOPE_AGENT); }
__device__ __forceinline__ unsigned xb_xcc_id() { return (unsigned)__builtin_amdgcn_s_getreg((3 << 11) | 20) & 0xFu; }
#define XB_SPIN(cond, bar) do { unsigned _sp = 0; while (cond) { __builtin_amdgcn_s_sleep(1); \
    if ((++_sp & 255u) == 0u) { if (xb_ld(&(bar)[XB_TMO])) break; if (_sp > XB_SPIN_CAP) { atomicAdd(&(bar)[XB_TMO], 1u); break; } } } } while (0)
struct XcdBarrier { unsigned* bar; unsigned x; volatile LAS unsigned* st; };
__device__ __forceinline__ XcdBarrier xcd_barrier_post(unsigned* bar, volatile LAS unsigned* st) {
    XcdBarrier b; b.bar = bar; b.x = xb_xcc_id(); b.st = st;
    if (threadIdx.x == 0) (void)xb_add(&bar[XB_XCNT(b.x)], 1u);
    return b;
}
__device__ __forceinline__ void xcd_barrier_complete(unsigned* bar, unsigned x, unsigned& nloc, unsigned& nx) {
    const unsigned G = gridDim.x * gridDim.y * gridDim.z;
    unsigned sum, cnt, mine, sp = 0u;
    for (;;) {
        sum = 0u; cnt = 0u; mine = 0u;
#pragma unroll
        for (unsigned j = 0; j < 16; ++j) { const unsigned c = xb_ld(&bar[XB_XCNT(j)]); sum += c; cnt += (c > 0u) ? 1u : 0u; mine = (j == x) ? c : mine; }
        if (sum == G) break;
        __builtin_amdgcn_s_sleep(1);
        if ((++sp & 255u) == 0u) { if (xb_ld(&bar[XB_TMO])) break; if (sp > XB_SPIN_CAP) { atomicAdd(&bar[XB_TMO], 1u); break; } }
    }
    nloc = mine > 0u ? mine : 1u; nx = cnt > 0u ? cnt : 1u;
}
__device__ __forceinline__ void xcd_barrier(const XcdBarrier& b) {
    asm volatile("s_waitcnt vmcnt(0)" ::: "memory");
    __syncthreads();
    if (threadIdx.x == 0) {
        unsigned* bar = b.bar;
        __builtin_amdgcn_s_waitcnt(0);
        unsigned nloc = b.st[0], nx = b.st[1];
        if (nloc == 0u) { xcd_barrier_complete(bar, b.x, nloc, nx); b.st[0] = nloc; b.st[1] = nx; }
        const unsigned old = xb_add(&bar[XB_XSUB(b.x)], 1u);
        const unsigned gen = old / nloc;
        if (old + 1u == (gen + 1u) * nloc) {
            __builtin_amdgcn_fence(__ATOMIC_RELEASE, "agent");
            asm volatile("s_waitcnt vmcnt(0)" ::: "memory");
            const unsigned og = xb_add(&bar[XB_TOP], 1u);
            const unsigned tg = og / nx;
            if (og + 1u == (tg + 1u) * nx) xb_add(&bar[XB_TOPGEN], 1u);
            else XB_SPIN(xb_ld(&bar[XB_TOPGEN]) == tg, bar);
            __builtin_amdgcn_fence(__ATOMIC_ACQUIRE, "agent");
            xb_add(&bar[XB_XGEN(b.x)], 1u);
            asm volatile("s_waitcnt vmcnt(0)" ::: "memory");
        } else {
            XB_SPIN(xb_ld(&bar[XB_XGEN(b.x)]) == gen, bar);
            __builtin_amdgcn_fence(__ATOMIC_ACQUIRE, "agent");
            asm volatile("s_waitcnt vmcnt(0)" ::: "memory");
        }
    }
    __syncthreads();
}

__device__ __forceinline__ void p0_transpose_item(const float* W, int K, int N, bf16_t* WT, int drow0, int k0, int n0, LAS float* scr, int lane) {
#pragma unroll 8
    for (int i = 0; i < 32; ++i) { const int kk = 2 * i + (lane >> 5); scr[kk * 33 + (lane & 31)] = W[(size_t)(k0 + kk) * N + n0 + (lane & 31)]; }
    LDS_WAIT(); asm volatile("" ::: "memory");
    const int c = lane & 7;
#pragma unroll
    for (int j = 0; j < 4; ++j) { const int n = (lane >> 3) + 8 * j; const LAS float* s = scr + (8 * c) * 33 + n;
        v4u o; o.x = pk2(s[0 * 33], s[1 * 33]); o.y = pk2(s[2 * 33], s[3 * 33]); o.z = pk2(s[4 * 33], s[5 * 33]); o.w = pk2(s[6 * 33], s[7 * 33]);
        *(v4u*)(WT + (size_t)(drow0 + n) * K + k0 + 8 * c) = o; }
    LDS_WAIT(); asm volatile("" ::: "memory");
}
__device__ __forceinline__ void p0_plain(const float* W, int K, int N, bf16_t* WT, int item, LAS float* scr, int lane) {
    const int nblk = N / 32, kb = item / nblk, nb = item % nblk;
    p0_transpose_item(W, K, N, WT, 32 * nb, 64 * kb, 32 * nb, scr, lane);
}
__device__ __forceinline__ void p0_transpose_rope(const float* W, bf16_t* WT, int tilebase, int o, int k0, int n0, LAS float* scr, int lane) {
    const int K = 1024, N = NIN;
#pragma unroll 8
    for (int i = 0; i < 32; ++i) { const int kk = 2 * i + (lane >> 5); scr[kk * 33 + (lane & 31)] = W[(size_t)(k0 + kk) * N + n0 + (lane & 31)]; }
    LDS_WAIT(); asm volatile("" ::: "memory");
    const int c = lane & 7;
#pragma unroll
    for (int j = 0; j < 4; ++j) { const int n = (lane >> 3) + 8 * j; const LAS float* s = scr + (8 * c) * 33 + n;
        const int oo = o + n, v = ((oo >> 6) << 6) | (((oo >> 4) & 1) << 5) | (((oo >> 2) & 3) << 3) | (((oo >> 5) & 1) << 2) | (oo & 3);
        v4u w; w.x = pk2(s[0 * 33], s[1 * 33]); w.y = pk2(s[2 * 33], s[3 * 33]); w.z = pk2(s[4 * 33], s[5 * 33]); w.w = pk2(s[6 * 33], s[7 * 33]);
        *(v4u*)(WT + (size_t)(tilebase + v) * K + k0 + 8 * c) = w; }
    LDS_WAIT(); asm volatile("" ::: "memory");
}
__device__ __forceinline__ void rms_row_to_bf16(const float* xrow, const float* g, bf16_t* orow, int lane) {
    const f32x4* xr = (const f32x4*)xrow + lane; const f32x4* gr = (const f32x4*)g + lane;
    f32x4 v[4]; float s = 0.f;
#pragma unroll
    for (int j = 0; j < 4; ++j) { v[j] = xr[64 * j]; s += (v[j].x * v[j].x + v[j].y * v[j].y) + (v[j].z * v[j].z + v[j].w * v[j].w); }
    const float rinv = 1.0f / sqrtf(wave_sum(s) * (1.f / 1024.f) + NORM_EPS);
    v2u* o8 = (v2u*)orow + lane;
#pragma unroll
    for (int j = 0; j < 4; ++j) { const f32x4 gg = gr[64 * j]; v2u w; w.x = pk2(v[j].x * rinv * gg.x, v[j].y * rinv * gg.y); w.y = pk2(v[j].z * rinv * gg.z, v[j].w * rinv * gg.w); o8[64 * j] = w; }
}

template <int NB, class RowPtr, class Epi>
__device__ __forceinline__ void ngemm_tile(const RowPtr& rp, const bf16_t* Bt, int ldb, int b1off, int K, int m0, int n0, int mvalid, const Epi& epi, LAS float* sm) {
    const int t = threadIdx.x, r = t >> 2, kq = (t & 3) * 4, ty = t >> 5, tx = t & 31;
    LAS float* As = sm; LAS float* Bs0 = sm + 16 * 132; LAS float* Bs1 = sm + 32 * 132;
    float acc[NB][8][4];
#pragma unroll
    for (int b = 0; b < NB; ++b)
#pragma unroll
        for (int i = 0; i < 8; ++i)
#pragma unroll
            for (int j = 0; j < 4; ++j) acc[b][i][j] = 0.f;
    const bf16_t* arow = rp(m0 + r) + kq;
    const bf16_t* brow0 = Bt + (size_t)(n0 + r) * ldb + kq;
    const bf16_t* brow1 = Bt + (size_t)(n0 + b1off + r) * ldb + kq;
    for (int k0 = 0; k0 < K; k0 += 16) {
        const v2u av = *(const v2u*)(arow + k0);
        const v2u bv0 = *(const v2u*)(brow0 + k0);
        v2u bv1 = bv0; if (NB == 2) bv1 = *(const v2u*)(brow1 + k0);
        As[(kq + 0) * 132 + r] = lo16(av.x); As[(kq + 1) * 132 + r] = hi16(av.x); As[(kq + 2) * 132 + r] = lo16(av.y); As[(kq + 3) * 132 + r] = hi16(av.y);
        Bs0[(kq + 0) * 132 + r] = lo16(bv0.x); Bs0[(kq + 1) * 132 + r] = hi16(bv0.x); Bs0[(kq + 2) * 132 + r] = lo16(bv0.y); Bs0[(kq + 3) * 132 + r] = hi16(bv0.y);
        if (NB == 2) { Bs1[(kq + 0) * 132 + r] = lo16(bv1.x); Bs1[(kq + 1) * 132 + r] = hi16(bv1.x); Bs1[(kq + 2) * 132 + r] = lo16(bv1.y); Bs1[(kq + 3) * 132 + r] = hi16(bv1.y); }
        __syncthreads();
#pragma unroll 2
        for (int kk = 0; kk < 16; ++kk) {
            const f32x4 a0 = *(const LAS f32x4*)(As + kk * 132 + ty * 8), a1 = *(const LAS f32x4*)(As + kk * 132 + ty * 8 + 4);
            const f32x4 b0 = *(const LAS f32x4*)(Bs0 + kk * 132 + tx * 4);
            const float a[8] = {a0.x, a0.y, a0.z, a0.w, a1.x, a1.y, a1.z, a1.w};
#pragma unroll
            for (int i = 0; i < 8; ++i) { acc[0][i][0] += a[i] * b0.x; acc[0][i][1] += a[i] * b0.y; acc[0][i][2] += a[i] * b0.z; acc[0][i][3] += a[i] * b0.w; }
            if (NB == 2) { const f32x4 b1 = *(const LAS f32x4*)(Bs1 + kk * 132 + tx * 4);
#pragma unroll
                for (int i = 0; i < 8; ++i) { acc[NB - 1][i][0] += a[i] * b1.x; acc[NB - 1][i][1] += a[i] * b1.y; acc[NB - 1][i][2] += a[i] * b1.z; acc[NB - 1][i][3] += a[i] * b1.w; } }
        }
        __syncthreads();
    }
#pragma unroll
    for (int i = 0; i < 8; ++i) { const int m = m0 + ty * 8 + i;
        if (m < mvalid) {
#pragma unroll
            for (int j = 0; j < 4; ++j) epi(m, n0 + tx * 4 + j, acc[0][i][j], acc[NB - 1][i][j]); } }
}
struct RowPlain { const bf16_t* A; int lda; __device__ __forceinline__ const bf16_t* operator()(int m) const { return A + (size_t)m * lda; } };

template <class Epi>
__device__ __forceinline__ void ngemm_dense(const bf16_t* A, int lda, const bf16_t* Bt, int ldb, int Mr, int N, int K, const Epi& epi, LAS float* sm) {
    const int nn = N / 128, nunits = (Mr / 128) * nn; RowPlain rp{A, lda};
    for (int u = blockIdx.x; u < nunits; u += gridDim.x) ngemm_tile<1>(rp, Bt, ldb, 0, K, (u / nn) * 128, (u % nn) * 128, Mr, epi, sm);
}

struct EpiStoreBf16 { bf16_t* O; int ldc; __device__ __forceinline__ void operator()(int m, int n, float a, float) const { O[(size_t)m * ldc + n] = (bf16_t)f2bf(a); } };
struct EpiGate1 { const bf16_t* PR; float* T; __device__ __forceinline__ void operator()(int m, int n, float a, float) const { T[(size_t)m * D + n] = bf2f(PR[(size_t)m * NIN + C_GSB + n]) * a; } };
struct EpiGate2 { const bf16_t* PR; const float* T; bf16_t* MIX; __device__ __forceinline__ void operator()(int m, int n, float a, float) const {
    MIX[(size_t)m * D + n] = (bf16_t)f2bf(T[(size_t)m * D + n] + bf2f(PR[(size_t)m * NIN + C_GDF + n]) * a); } };
struct EpiResid { const float* base; float* out; __device__ __forceinline__ void operator()(int m, int n, float a, float) const { out[(size_t)m * D + n] = base[(size_t)m * D + n] + a; } };


namespace pg8 {
constexpr int BM = 256, BK = 64, HALF = 128, HTB = HALF * BK * 2, STAGE_BYTES = 8 * HTB;
__host__ __device__ __forceinline__ int lds_byte(int r, int c) { const int st = (r >> 4) * 2 + (c >> 5), rr = r & 15, cc = c & 31, ob = rr * 64 + cc * 2; return st * 1024 + (ob ^ (((ob >> 9) & 1) << 5)); }
__host__ __device__ __forceinline__ void stage_rc(int b, int& R, int& C) { const int st = b / 1024, sb = b % 1024, swz = sb ^ (((sb >> 9) & 1) << 5); R = (st >> 1) * 16 + swz / 64; C = (st & 1) * 32 + (swz % 64) / 2; }
__host__ __device__ __forceinline__ int perm32(int rho) { const int n = rho >> 4, i = rho & 15; return 8 * (i >> 2) + 4 * n + (i & 3); }
struct Unit { int pm, pn, e; };
struct Gemm { const bf16_t* A; const bf16_t* Bt; int lda, ldb, K; };
typedef float f32x2 __attribute__((ext_vector_type(2))); typedef __bf16 bf16x2_t __attribute__((ext_vector_type(2)));
__device__ __forceinline__ unsigned cvt_pk_bf16(float lo, float hi) { f32x2 v = {lo, hi}; bf16x2_t b = __builtin_convertvector(v, bf16x2_t); return __builtin_bit_cast(unsigned, b); }

template <class Epi, class Sched, bool GATHER>
__device__ __forceinline__ void gemm_phase(LAS unsigned char* lds, const Gemm g, const Sched& S, const Epi& E) {
    const int tid = threadIdx.x, wid = __builtin_amdgcn_readfirstlane(tid >> 6), lane = tid & 63, wr = wid >> 2, wc = wid & 3, fr = lane & 15, fq = lane >> 4;
    const int K = g.K, nt = K / BK;
    unsigned voffB[2], cva[2][2], nva[2][2]; int Rr[2], Cc[2];
#pragma unroll
    for (int i = 0; i < 2; ++i) { int R, C; stage_rc(tid * 16 + i * 8192, R, C); Rr[i] = R; Cc[i] = C; const int Rb = (R & ~31) + perm32(R & 31);
        voffB[i] = (unsigned)(Rb * g.ldb + C) * 2u;
#pragma unroll
        for (int h = 0; h < 2; ++h) { cva[h][i] = (unsigned)((h * HALF + R) * g.lda + C) * 2u; nva[h][i] = cva[h][i]; } }
    const size_t kstep = (size_t)(BK * 2);
    const size_t hstepB = (size_t)HALF * g.ldb * 2;
    const unsigned ldsw = (unsigned)wid * 1024u;
    const int aoff = lds_byte(wr * 64 + fr, fq * 8), boff = lds_byte(wc * 32 + fr, fq * 8);
#define PG8_SA(b, h) (((b) * 2 + (h)) * HTB)
#define PG8_SB(b, h) ((4 + (b) * 2 + (h)) * HTB)
#define PG8_STAGE(bufoff, gbase, voff) do { _Pragma("unroll") for (int _i = 0; _i < 2; ++_i) \
        __builtin_amdgcn_global_load_lds((const unsigned*)((const char*)(gbase) + (voff)[_i]), (LAS unsigned*)(lds + (bufoff) + ldsw + _i * 8192), 16, 0, 0); } while (0)
#define PG8_LDA(dst, b, h) do { _Pragma("unroll") for (int m = 0; m < 4; ++m) _Pragma("unroll") for (int k = 0; k < 2; ++k) dst[m][k] = *(const LAS bf16x8*)(lds + PG8_SA(b, h) + aoff + m * 2048 + k * 1024); } while (0)
#define PG8_LDB(dst, b, h) do { _Pragma("unroll") for (int n = 0; n < 2; ++n) _Pragma("unroll") for (int k = 0; k < 2; ++k) dst[n][k] = *(const LAS bf16x8*)(lds + PG8_SB(b, h) + boff + n * 2048 + k * 1024); } while (0)
#define PG8_MMA(ai, bj, At, Bt) do { __builtin_amdgcn_s_setprio(1); _Pragma("unroll") for (int m = 0; m < 4; ++m) _Pragma("unroll") for (int n = 0; n < 2; ++n) _Pragma("unroll") for (int k = 0; k < 2; ++k) \
        acc[ai][bj][m][n] = __builtin_amdgcn_mfma_f32_16x16x32_bf16(Bt[n][k], At[m][k], acc[ai][bj][m][n], 0, 0, 0); __builtin_amdgcn_s_setprio(0); } while (0)
#define PG8_WAIT_V(n) asm volatile("s_waitcnt vmcnt(" #n ")" ::: "memory")
#define PG8_WAIT_L(n) asm volatile("s_waitcnt lgkmcnt(" #n ")" ::: "memory")
#define PG8_BAR __builtin_amdgcn_s_barrier()
#define PG8_SCHED __builtin_amdgcn_sched_barrier(0)
    Unit cur, nxt; int ui = 0;
    if (!S.next(0, cur)) return;
    if constexpr (GATHER) {
#pragma unroll
        for (int i = 0; i < 2; ++i)
#pragma unroll
            for (int h = 0; h < 2; ++h) cva[h][i] = (unsigned)(S.tok(cur, h * HALF + Rr[i]) * g.lda + Cc[i]) * 2u;
    }
    f32x4 acc[2][2][4][2];
#pragma unroll
    for (int a = 0; a < 2; ++a)
#pragma unroll
        for (int b = 0; b < 2; ++b)
#pragma unroll
            for (int m = 0; m < 4; ++m)
#pragma unroll
                for (int n = 0; n < 2; ++n) acc[a][b][m][n] = (f32x4){0.f, 0.f, 0.f, 0.f};
    bf16x8 At[4][2], B0[2][2], B1[2][2];
    const char* cA = (const char*)g.A + (GATHER ? (size_t)0 : S.a_off(cur)); const char* cB = (const char*)g.Bt + S.b_off(cur);
    PG8_STAGE(PG8_SB(0, 0), cB, voffB); PG8_STAGE(PG8_SB(0, 1), cB + hstepB, voffB); PG8_STAGE(PG8_SA(0, 0), cA, cva[0]); PG8_STAGE(PG8_SA(0, 1), cA, cva[1]);
    if (wr == 1) PG8_BAR;
    PG8_WAIT_V(2); PG8_BAR;
    PG8_STAGE(PG8_SB(1, 0), cB + kstep, voffB); PG8_STAGE(PG8_SA(1, 0), cA + kstep, cva[0]); PG8_STAGE(PG8_SB(1, 1), cB + hstepB + kstep, voffB);
    PG8_WAIT_V(6); PG8_BAR;
    for (;;) {
        const bool has_next = S.next(ui + 1, nxt);
        const char* nA = (has_next && !GATHER) ? (const char*)g.A + S.a_off(nxt) : cA; const char* nB = has_next ? (const char*)g.Bt + S.b_off(nxt) : cB;
        if constexpr (GATHER) {
#pragma unroll
            for (int i = 0; i < 2; ++i)
#pragma unroll
                for (int h = 0; h < 2; ++h) nva[h][i] = has_next ? (unsigned)(S.tok(nxt, h * HALF + Rr[i]) * g.lda + Cc[i]) * 2u : cva[h][i];
        }
        for (int t = 0; t < nt; t += 2) {
            const bool last = (t == nt - 2);
            const char* a1 = cA + (size_t)(t + 1) * kstep;
            const char* a2 = last ? nA : cA + (size_t)(t + 2) * kstep; const char* b2 = last ? nB : cB + (size_t)(t + 2) * kstep;
            const char* a3 = a2 + kstep; const char* b3 = b2 + kstep;
            unsigned v2[2][2];
#pragma unroll
            for (int h = 0; h < 2; ++h)
#pragma unroll
                for (int i = 0; i < 2; ++i) v2[h][i] = (GATHER && last) ? nva[h][i] : cva[h][i];
            PG8_LDB(B0, 0, 0); PG8_LDB(B1, 0, 1); PG8_SCHED; PG8_LDA(At, 0, 0); PG8_STAGE(PG8_SA(1, 1), a1, cva[1]);
            PG8_WAIT_V(8); PG8_WAIT_L(0); PG8_BAR; PG8_MMA(0, 0, At, B0); PG8_MMA(0, 1, At, B1); PG8_BAR; PG8_SCHED;
            PG8_LDA(At, 0, 1); PG8_STAGE(PG8_SB(0, 0), b2, voffB); PG8_STAGE(PG8_SB(0, 1), b2 + hstepB, voffB); PG8_STAGE(PG8_SA(0, 0), a2, v2[0]);
            PG8_WAIT_V(8); PG8_WAIT_L(0); PG8_BAR; PG8_MMA(1, 0, At, B0); PG8_MMA(1, 1, At, B1); PG8_BAR; PG8_SCHED;
            PG8_LDB(B0, 1, 0); PG8_LDB(B1, 1, 1); PG8_SCHED; PG8_LDA(At, 1, 0); PG8_STAGE(PG8_SA(0, 1), a2, v2[1]);
            PG8_WAIT_V(8); PG8_WAIT_L(0); PG8_BAR; PG8_MMA(0, 0, At, B0); PG8_MMA(0, 1, At, B1); PG8_BAR; PG8_SCHED;
            PG8_LDA(At, 1, 1); PG8_STAGE(PG8_SB(1, 0), b3, voffB); PG8_STAGE(PG8_SB(1, 1), b3 + hstepB, voffB); PG8_STAGE(PG8_SA(1, 0), a3, v2[0]);
            PG8_WAIT_V(8); PG8_WAIT_L(0); PG8_BAR; PG8_MMA(1, 0, At, B0); PG8_MMA(1, 1, At, B1); PG8_BAR; PG8_SCHED;
        }
        if (wr == 0) PG8_BAR;
        E(acc, cur, wr, wc, fr, fq);
        if (!has_next) break;
#pragma unroll
        for (int a = 0; a < 2; ++a)
#pragma unroll
            for (int b = 0; b < 2; ++b)
#pragma unroll
                for (int m = 0; m < 4; ++m)
#pragma unroll
                    for (int n = 0; n < 2; ++n) acc[a][b][m][n] = (f32x4){0.f, 0.f, 0.f, 0.f};
        cur = nxt; cA = nA; cB = nB; ++ui;
        if constexpr (GATHER) {
#pragma unroll
            for (int i = 0; i < 2; ++i)
#pragma unroll
                for (int h = 0; h < 2; ++h) cva[h][i] = nva[h][i];
        }
        if (wr == 1) PG8_BAR;
    }
    PG8_WAIT_V(0);
    PG8_BAR;
#undef PG8_SA
#undef PG8_SB
#undef PG8_STAGE
#undef PG8_LDA
#undef PG8_LDB
#undef PG8_MMA
#undef PG8_WAIT_V
#undef PG8_WAIT_L
#undef PG8_BAR
#undef PG8_SCHED
}

struct DenseOrder {
    int nM, nN, nwg, G, c, lda, ldb;
    __device__ __forceinline__ void init(int M_, int N_, int G_, int c_, int lda_, int ldb_) { nM = M_ / BM; nN = N_ / BM; nwg = nM * nN; G = G_; c = c_; lda = lda_; ldb = ldb_; }
    __device__ __forceinline__ bool next(int i, Unit& u) const {
        const long L = (long)i * G + c; if (L >= nwg) return false;
        int wgid = (int)L; { const int q = nwg / 8, r = nwg % 8, xcd = wgid % 8, off = wgid / 8; wgid = (xcd < r ? xcd * (q + 1) : r * (q + 1) + (xcd - r) * q) + off; }
        const int nig = 8 * nN, gid = wgid / nig, fm = gid * 8, gsz = (nM - fm) < 8 ? (nM - fm) : 8;
        u.pm = fm + ((wgid % nig) % gsz); u.pn = (wgid % nig) / gsz; u.e = 0; return true;
    }
    __device__ __forceinline__ size_t a_off(const Unit& u) const { return (size_t)u.pm * BM * lda * 2; }
    __device__ __forceinline__ size_t b_off(const Unit& u) const { return (size_t)u.pn * BM * ldb * 2; }
    __device__ __forceinline__ int tok(const Unit&, int) const { return 0; }
};
struct TwoRoundOrder {
    int G, c, lda, ldb;
    __device__ __forceinline__ bool next(int i, Unit& u) const { const int L = i * G + c; if (L >= 512) return false; const int tile = L & 255; u.pm = tile >> 2; u.pn = tile & 3; u.e = L >> 8; return true; }
    __device__ __forceinline__ size_t a_off(const Unit& u) const { return (size_t)u.pm * BM * lda * 2 + (size_t)u.e * 1024; }
    __device__ __forceinline__ size_t b_off(const Unit& u) const { return (size_t)(u.e * 1024 + u.pn * BM) * ldb * 2; }
    __device__ __forceinline__ int tok(const Unit&, int) const { return 0; }
};
struct MoeOrder {
    const LAS int* tb; const int* tlist; int G, c, npn, lda, ldb, nexp;
    __device__ __forceinline__ bool next(int i, Unit& u) const {
        const int L = i * G + c; if (L >= tb[96]) return false;
        int e = 0; while (tb[65 + e] <= L) ++e;
        const int loc = L - tb[64 + e]; u.e = e; u.pn = loc % npn; u.pm = (tb[e] >> 8) + loc / npn; return true;
    }
    __device__ __forceinline__ size_t a_off(const Unit& u) const { return (size_t)u.pm * BM * lda * 2; }
    __device__ __forceinline__ size_t b_off(const Unit& u) const { return (size_t)(u.e * nexp + u.pn * BM) * ldb * 2; }
    __device__ __forceinline__ int tok(const Unit& u, int row) const { const int r = u.pm * BM - tb[u.e] + row; return r < tb[32 + u.e] ? tlist[u.e * LISTCAP + r] : 0; }
};

#define EPI_ARGS const f32x4 (&acc)[2][2][4][2], const Unit& u, int wr, int wc, int fr, int fq
#define EPI_FOR_ROWS for (int ai = 0; ai < 2; ++ai) _Pragma("unroll") for (int m = 0; m < 4; ++m)
__device__ __forceinline__ v4u pack8(const f32x4 a, const f32x4 b) { v4u w; w.x = cvt_pk_bf16(a[0], a[1]); w.y = cvt_pk_bf16(a[2], a[3]); w.z = cvt_pk_bf16(b[0], b[1]); w.w = cvt_pk_bf16(b[2], b[3]); return w; }
__device__ __forceinline__ void unpack8(const v4u w, f32x4& a, f32x4& b) { a = (f32x4){lo16(w.x), hi16(w.x), lo16(w.y), hi16(w.y)}; b = (f32x4){lo16(w.z), hi16(w.z), lo16(w.w), hi16(w.w)}; }
__device__ __forceinline__ float sigm(float v) { return __builtin_amdgcn_rcpf(1.f + __expf(-v)); }

__device__ __forceinline__ void store_tile_T(const f32x4 (&acc)[2][2][4][2], bf16_t* VT, int vrow0, int s0, int pitch) {
#pragma unroll
    for (int bj = 0; bj < 2; ++bj)
#pragma unroll
        for (int n = 0; n < 2; ++n)
#pragma unroll
            for (int e = 0; e < 4; ++e) { bf16_t* vp = VT + (size_t)(vrow0 + 128 * bj + 4 * n + e) * pitch + s0;
#pragma unroll
                for (int ai = 0; ai < 2; ++ai)
#pragma unroll
                    for (int m = 0; m < 4; ++m) vp[128 * ai + 16 * m] = (bf16_t)(cvt_pk_bf16(acc[ai][bj][m][n][e], 0.f) & 0xffffu); }
}
struct EpiKV { bf16_t* KVM; bf16_t* VTM;
    __device__ __forceinline__ void operator()(EPI_ARGS) const {
        const int row0 = u.pm * BM + wr * 64 + fr, col0 = u.pn * BM + wc * 32 + 8 * fq;
#pragma unroll
        EPI_FOR_ROWS { bf16_t* rowp = KVM + (size_t)(row0 + ai * HALF + m * 16) * 2048 + col0;
#pragma unroll
            for (int bj = 0; bj < 2; ++bj) *(v4u*)(rowp + bj * HALF) = pack8(acc[ai][bj][m][0], acc[ai][bj][m][1]); }
        if (u.pn >= 4) store_tile_T(acc, VTM, u.pm * 1024 + (u.pn - 4) * BM + wc * 32 + 8 * fq, wr * 64 + fr, MEMLEN);
    } };
struct EpiBf16Store { bf16_t* O; int ldc;
    __device__ __forceinline__ void operator()(EPI_ARGS) const {
        const int row0 = u.pm * BM + wr * 64 + fr, col0 = u.pn * BM + wc * 32 + 8 * fq;
#pragma unroll
        EPI_FOR_ROWS { bf16_t* rowp = O + (size_t)(row0 + ai * HALF + m * 16) * ldc + col0;
#pragma unroll
            for (int bj = 0; bj < 2; ++bj) *(v4u*)(rowp + bj * HALF) = pack8(acc[ai][bj][m][0], acc[ai][bj][m][1]); }
    } };
struct EpiResidF32 { const float* base; float* out;
    __device__ __forceinline__ void operator()(EPI_ARGS) const {
        const int row0 = u.pm * BM + wr * 64 + fr, col0 = u.pn * BM + wc * 32 + 8 * fq;
#pragma unroll
        EPI_FOR_ROWS { const size_t off = (size_t)(row0 + ai * HALF + m * 16) * D + col0;
#pragma unroll
            for (int bj = 0; bj < 2; ++bj)
#pragma unroll
                for (int n = 0; n < 2; ++n) { const f32x4 b = *(const f32x4*)(base + off + bj * HALF + 4 * n); *(f32x4*)(out + off + bj * HALF + 4 * n) = b + acc[ai][bj][m][n]; } }
    } };
struct EpiGate { const bf16_t* PR; float* T; bf16_t* MIX;
    __device__ __forceinline__ void operator()(EPI_ARGS) const {
        const int row0 = u.pm * BM + wr * 64 + fr, col0 = u.pn * BM + wc * 32 + 8 * fq;
#pragma unroll
        EPI_FOR_ROWS { const int row = row0 + ai * HALF + m * 16;
#pragma unroll
            for (int bj = 0; bj < 2; ++bj) { const int col = col0 + bj * HALF; f32x4 g0, g1;
                unpack8(*(const v4u*)(PR + (size_t)row * NIN + (u.e ? C_GDF : C_GSB) + col), g0, g1);
                float* tp = T + (size_t)row * D + col;
                if (u.e == 0) { *(f32x4*)tp = g0 * acc[ai][bj][m][0]; *(f32x4*)(tp + 4) = g1 * acc[ai][bj][m][1]; }
                else { const f32x4 t0 = *(const f32x4*)tp, t1 = *(const f32x4*)(tp + 4); *(v4u*)(MIX + (size_t)row * D + col) = pack8(t0 + g0 * acc[ai][bj][m][0], t1 + g1 * acc[ai][bj][m][1]); } } }
    } };
struct EpiInProj { bf16_t* PR; const float* rc; const float* rs; bf16_t* VTSB; bf16_t* VTDF;
    __device__ __forceinline__ void operator()(EPI_ARGS) const {
        const int row0 = u.pm * BM + wr * 64 + fr, pn = u.pn;
        if (pn >= 6 && pn < 10) {
            const float sc = pn < 8 ? 0.125f : 1.0f; const int i0 = 16 * (wc & 1) + 4 * fq;
#pragma unroll
            EPI_FOR_ROWS { const int row = row0 + ai * HALF + m * 16; const f32x4 cs = *(const f32x4*)(rc + (size_t)row * 32 + i0), sn = *(const f32x4*)(rs + (size_t)row * 32 + i0);
#pragma unroll
                for (int bj = 0; bj < 2; ++bj) { const f32x4 lo = acc[ai][bj][m][0], hi = acc[ai][bj][m][1];
                    const f32x4 olo = (lo * cs - hi * sn) * sc, ohi = (hi * cs + lo * sn) * sc;
                    bf16_t* p = PR + (size_t)row * NIN + pn * BM + 64 * (2 * bj + (wc >> 1)) + i0;
                    v2u a, b; a.x = cvt_pk_bf16(olo[0], olo[1]); a.y = cvt_pk_bf16(olo[2], olo[3]); b.x = cvt_pk_bf16(ohi[0], ohi[1]); b.y = cvt_pk_bf16(ohi[2], ohi[3]);
                    *(v2u*)p = a; *(v2u*)(p + 32) = b; } }
        } else {
            const int col0 = pn * BM + wc * 32 + 8 * fq; const float sc = pn < 2 ? 0.125f : 1.0f; const bool sg = pn >= 12;
#pragma unroll
            EPI_FOR_ROWS { bf16_t* rowp = PR + (size_t)(row0 + ai * HALF + m * 16) * NIN + col0;
#pragma unroll
                for (int bj = 0; bj < 2; ++bj) { f32x4 v0 = acc[ai][bj][m][0] * sc, v1 = acc[ai][bj][m][1] * sc;
                    if (sg) { v0 = (f32x4){sigm(v0[0]), sigm(v0[1]), sigm(v0[2]), sigm(v0[3])}; v1 = (f32x4){sigm(v1[0]), sigm(v1[1]), sigm(v1[2]), sigm(v1[3])}; }
                    *(v4u*)(rowp + bj * HALF) = pack8(v0, v1); } }
            if (pn == 4 || pn == 5 || pn == 10 || pn == 11) {
                const int bb = u.pm >> 4, s0 = (u.pm & 15) * BM + wr * 64 + fr, hd0 = (pn < 6 ? (pn - 4) : (pn - 10)) * BM + wc * 32 + 8 * fq;
                store_tile_T(acc, pn < 6 ? VTSB : VTDF, bb * 512 + hd0, s0, SEQ);
            }
        }
    } };
struct EpiMoeGU { bf16_t* ACT; const float* bgu;
    __device__ __forceinline__ void operator()(EPI_ARGS) const {
        const int row0 = u.pm * BM + wr * 64 + fr, j0 = u.pn * 128 + wc * 32 + 8 * fq; const float* bg = bgu + (size_t)u.e * 2048 + j0;
        const f32x4 bg0 = *(const f32x4*)bg, bg1 = *(const f32x4*)(bg + 4), bl0 = *(const f32x4*)(bg + 1024), bl1 = *(const f32x4*)(bg + 1028);
#pragma unroll
        EPI_FOR_ROWS { f32x4 o[2];
#pragma unroll
            for (int n = 0; n < 2; ++n) { const f32x4 gv = acc[ai][0][m][n] + (n ? bg1 : bg0), lv = acc[ai][1][m][n] + (n ? bl1 : bl0);
#pragma unroll
                for (int c = 0; c < 4; ++c) { const float gl = fminf(gv[c], 7.0f), li = fminf(fmaxf(lv[c], -7.0f), 7.0f); o[n][c] = gl * sigm(1.702f * gl) * (li + 1.0f); } }
            *(v4u*)(ACT + (size_t)(row0 + ai * HALF + m * 16) * DFF + j0) = pack8(o[0], o[1]); }
    } };
struct EpiMoeDown { bf16_t* YB; const float* bd; const float* glist; const LAS int* tb;
    __device__ __forceinline__ void operator()(EPI_ARGS) const {
        const int row0 = u.pm * BM + wr * 64 + fr, col0 = u.pn * BM + wc * 32 + 8 * fq; const float* bp = bd + (size_t)u.e * D + col0;
        const float* gl = glist + (size_t)u.e * LISTCAP - tb[u.e];
        f32x4 bv[2][2];
#pragma unroll
        for (int bj = 0; bj < 2; ++bj)
#pragma unroll
            for (int n = 0; n < 2; ++n) bv[bj][n] = *(const f32x4*)(bp + bj * HALF + 4 * n);
#pragma unroll
        EPI_FOR_ROWS { const int row = row0 + ai * HALF + m * 16; const float gt = gl[row];
#pragma unroll
            for (int bj = 0; bj < 2; ++bj) *(v4u*)(YB + (size_t)row * D + col0 + bj * HALF) = pack8((acc[ai][bj][m][0] + bv[bj][0]) * gt, (acc[ai][bj][m][1] + bv[bj][1]) * gt); }
    } };
}


typedef float f32x16 __attribute__((ext_vector_type(16)));
typedef short s16x4 __attribute__((ext_vector_type(4)));
__device__ __forceinline__ f32x16 mfma32(bf16x8 a, bf16x8 b, f32x16 c) { return __builtin_amdgcn_mfma_f32_32x32x16_bf16(a, b, c, 0, 0, 0); }
__device__ __forceinline__ float xhalf(float v, int hh) { auto rr = __builtin_amdgcn_permlane32_swap(__float_as_uint(v), __float_as_uint(v), false, false); return __uint_as_float(hh ? rr[0] : rr[1]); }
__device__ __forceinline__ bf16x8 vt_frag(const bf16_t* p) { const s16x4 lo = *(const s16x4*)p, hi = *(const s16x4*)(p + 8); return (bf16x8){lo[0], lo[1], lo[2], lo[3], hi[0], hi[1], hi[2], hi[3]}; }
__device__ __forceinline__ bf16x8 pack_p(const f32x16& p, int s) { v4u w; w.x = pg8::cvt_pk_bf16(p[8 * s + 0], p[8 * s + 1]); w.y = pg8::cvt_pk_bf16(p[8 * s + 2], p[8 * s + 3]); w.z = pg8::cvt_pk_bf16(p[8 * s + 4], p[8 * s + 5]); w.w = pg8::cvt_pk_bf16(p[8 * s + 6], p[8 * s + 7]); return __builtin_bit_cast(bf16x8, w); }
constexpr float LOG2E = 1.4426950408889634f;

template <int NO>
__device__ __forceinline__ void softmax_step(f32x16& S, float C, float& m, float& l, f32x16 (&O)[NO], int hh) {
    float mx = fmaxf(fmaxf(S[0], S[1]), fmaxf(S[2], S[3]));
#pragma unroll
    for (int i = 4; i < 16; i += 4) mx = fmaxf(mx, fmaxf(fmaxf(S[i], S[i + 1]), fmaxf(S[i + 2], S[i + 3])));
    mx = fmaxf(mx, xhalf(mx, hh)) * C;
    const float mn = fmaxf(m, mx), al = __builtin_amdgcn_exp2f(m - mn);
    m = mn; l *= al;
#pragma unroll
    for (int o = 0; o < NO; ++o) O[o] = O[o] * al;
    float ps = 0.f;
#pragma unroll
    for (int i = 0; i < 16; ++i) { S[i] = __builtin_amdgcn_exp2f(S[i] * C - mn); ps += S[i]; }
    l += ps;
}

__device__ __forceinline__ void attn_diff_wave(const bf16_t* PR, const bf16_t* VT, float* ODR, int b, int h, int j, int q0, int lane) {
    const int r32 = lane & 31, hh = lane >> 5;
    const bf16_t* qrow = PR + (size_t)(b * SEQ + q0 + r32) * NIN + C_DQ + h * 128 + j * 64 + 8 * hh;
    bf16x8 qf[4];
#pragma unroll
    for (int d0 = 0; d0 < 4; ++d0) qf[d0] = *(const bf16x8*)(qrow + 16 * d0);
    const bf16_t* kbase = PR + (size_t)(b * SEQ + r32) * NIN + C_DK + h * 128 + j * 64 + 8 * hh;
    const bf16_t* vbase = VT + (size_t)(b * 512 + h * 128 + r32) * SEQ + 4 * hh;
    f32x16 O[4];
#pragma unroll
    for (int o = 0; o < 4; ++o)
#pragma unroll
        for (int i = 0; i < 16; ++i) O[o][i] = 0.f;
    float m = -INFINITY, l = 0.f;
    const int nt = 2 * (q0 / 64 + 1);
    for (int t = 0; t < nt; ++t) {
        const bf16_t* kp = kbase + (size_t)(32 * t) * NIN;
        f32x16 S;
#pragma unroll
        for (int i = 0; i < 16; ++i) S[i] = 0.f;
#pragma unroll
        for (int d0 = 0; d0 < 4; ++d0) S = mfma32(*(const bf16x8*)(kp + 16 * d0), qf[d0], S);
        softmax_step<4>(S, LOG2E, m, l, O, hh);
        const bf16x8 p0 = pack_p(S, 0), p1 = pack_p(S, 1);
        const bf16_t* vp = vbase + 32 * t;
#pragma unroll
        for (int o = 0; o < 4; ++o) { O[o] = mfma32(vt_frag(vp + (size_t)(32 * o) * SEQ), p0, O[o]); O[o] = mfma32(vt_frag(vp + (size_t)(32 * o) * SEQ + 16), p1, O[o]); }
    }
    l += xhalf(l, hh);
    const float il = 1.f / l;
    float* orow = ODR + ((size_t)j * M + (size_t)b * SEQ + q0 + r32) * 512 + h * 128 + 4 * hh;
#pragma unroll
    for (int o = 0; o < 4; ++o)
#pragma unroll
        for (int g = 0; g < 4; ++g) *(f32x4*)(orow + 32 * o + 8 * g) = (f32x4){O[o][4 * g] * il, O[o][4 * g + 1] * il, O[o][4 * g + 2] * il, O[o][4 * g + 3] * il};
}

__device__ __forceinline__ void attn_sb_wave(const bf16_t* PR, const bf16_t* VT, bf16_t* OAT, int b, int h, int q0, int lane) {
    const int r32 = lane & 31, hh = lane >> 5;
    const bf16_t* qrow = PR + (size_t)(b * SEQ + q0 + r32) * NIN + C_SBQ + h * 64 + 8 * hh;
    bf16x8 qf[4];
#pragma unroll
    for (int d0 = 0; d0 < 4; ++d0) qf[d0] = *(const bf16x8*)(qrow + 16 * d0);
    const bf16_t* kbase = PR + (size_t)(b * SEQ + r32) * NIN + C_SBK + h * 64 + 8 * hh;
    const bf16_t* vbase = VT + (size_t)(b * 512 + h * 64 + r32) * SEQ + 4 * hh;
    f32x16 O[2];
#pragma unroll
    for (int o = 0; o < 2; ++o)
#pragma unroll
        for (int i = 0; i < 16; ++i) O[o][i] = 0.f;
    float R = 0.f;
    const int td = q0 >> 5;
    for (int t = td; t >= 0; --t) {
        const bf16_t* kp = kbase + (size_t)(32 * t) * NIN;
        f32x16 S;
#pragma unroll
        for (int i = 0; i < 16; ++i) S[i] = 0.f;
#pragma unroll
        for (int d0 = 0; d0 < 4; ++d0) S = mfma32(*(const bf16x8*)(kp + 16 * d0), qf[d0], S);
        f32x16 lr;
#pragma unroll
        for (int i = 0; i < 16; ++i) { const float z2 = S[i] * LOG2E; const float sp = fmaxf(z2, 0.f) + __builtin_amdgcn_logf(1.f + __builtin_amdgcn_exp2f(-fabsf(z2)));
            lr[i] = -sp; S[i] = z2 - sp; }
        if (t == td) {
#pragma unroll
            for (int i = 0; i < 16; ++i) { const int kvl = (i & 3) + 8 * (i >> 2) + 4 * hh; if (kvl >= r32) { lr[i] = 0.f; S[i] = -INFINITY; } }
        }
        float tot[4], pt[4], off[4];
        f32x16 ex;
#pragma unroll
        for (int g = 0; g < 4; ++g) { ex[4 * g + 3] = 0.f; ex[4 * g + 2] = lr[4 * g + 3]; ex[4 * g + 1] = lr[4 * g + 3] + lr[4 * g + 2]; ex[4 * g] = ex[4 * g + 1] + lr[4 * g + 1]; tot[g] = ex[4 * g] + lr[4 * g]; }
#pragma unroll
        for (int g = 0; g < 4; ++g) pt[g] = xhalf(tot[g], hh);
        const float own0 = hh ? 0.f : 1.f;
        float sp_ = 0.f;
#pragma unroll
        for (int g = 3; g >= 0; --g) { off[g] = sp_ + own0 * pt[g] + R; sp_ += tot[g] + pt[g]; }
#pragma unroll
        for (int i = 0; i < 16; ++i) S[i] = __builtin_amdgcn_exp2f(S[i] + ex[i] + off[i >> 2]);
        R += sp_;
        const bf16x8 p0 = pack_p(S, 0), p1 = pack_p(S, 1);
        const bf16_t* vp = vbase + 32 * t;
#pragma unroll
        for (int o = 0; o < 2; ++o) { O[o] = mfma32(vt_frag(vp + (size_t)(32 * o) * SEQ), p0, O[o]); O[o] = mfma32(vt_frag(vp + (size_t)(32 * o) * SEQ + 16), p1, O[o]); }
        if (__all(R < -160.f)) break;
    }
    bf16_t* orow = OAT + (size_t)(b * SEQ + q0 + r32) * D + h * 64 + 4 * hh;
#pragma unroll
    for (int o = 0; o < 2; ++o)
#pragma unroll
        for (int g = 0; g < 4; ++g) { v2u w; w.x = pg8::cvt_pk_bf16(O[o][4 * g], O[o][4 * g + 1]); w.y = pg8::cvt_pk_bf16(O[o][4 * g + 2], O[o][4 * g + 3]); *(v2u*)(orow + 32 * o + 8 * g) = w; }
}

__device__ __forceinline__ void attn_mem_wave(const bf16_t* QM, const bf16_t* KVM, const bf16_t* VT, bf16_t* OM, int b, int h, int q0, int lane) {
    const int r32 = lane & 31, hh = lane >> 5;
    const bf16_t* qrow = QM + (size_t)(b * SEQ + q0 + r32) * D + h * 256 + 8 * hh;
    const bf16_t* kbase = KVM + (size_t)(b * MEMLEN + r32) * 2048 + h * 256 + 8 * hh;
    for (int dh = 0; dh < 2; ++dh) {
        const bf16_t* vbase = VT + (size_t)(b * 1024 + h * 256 + dh * 128 + r32) * MEMLEN + 4 * hh;
        f32x16 O[4];
#pragma unroll
        for (int o = 0; o < 4; ++o)
#pragma unroll
            for (int i = 0; i < 16; ++i) O[o][i] = 0.f;
        float m = -INFINITY, l = 0.f;
        for (int t = 0; t < 8; ++t) {
            const bf16_t* kp = kbase + (size_t)(32 * t) * 2048;
            f32x16 S;
#pragma unroll
            for (int i = 0; i < 16; ++i) S[i] = 0.f;
#pragma unroll
            for (int d0 = 0; d0 < 16; ++d0) S = mfma32(*(const bf16x8*)(kp + 16 * d0), *(const bf16x8*)(qrow + 16 * d0), S);
            softmax_step<4>(S, LOG2E * 0.0625f, m, l, O, hh);
            const bf16x8 p0 = pack_p(S, 0), p1 = pack_p(S, 1);
            const bf16_t* vp = vbase + 32 * t;
#pragma unroll
            for (int o = 0; o < 4; ++o) { O[o] = mfma32(vt_frag(vp + (size_t)(32 * o) * MEMLEN), p0, O[o]); O[o] = mfma32(vt_frag(vp + (size_t)(32 * o) * MEMLEN + 16), p1, O[o]); }
        }
        l += xhalf(l, hh);
        const float il = 1.f / l;
        bf16_t* orow = OM + (size_t)(b * SEQ + q0 + r32) * D + h * 256 + dh * 128 + 4 * hh;
#pragma unroll
        for (int o = 0; o < 4; ++o)
#pragma unroll
            for (int g = 0; g < 4; ++g) { v2u w; w.x = pg8::cvt_pk_bf16(O[o][4 * g] * il, O[o][4 * g + 1] * il); w.y = pg8::cvt_pk_bf16(O[o][4 * g + 2] * il, O[o][4 * g + 3] * il); *(v2u*)(orow + 32 * o + 8 * g) = w; }
    }
}


constexpr int VSTR = 136;
template <int NCH> __device__ __forceinline__ void stage_load(v4u (&r)[NCH], const bf16_t* g0, int chunks_per_row, size_t gpitch, int tid) {
#pragma unroll
    for (int i = 0; i < NCH; ++i) { const int c = tid + NTHR * i, row = c / chunks_per_row, ch = c % chunks_per_row; r[i] = *(const v4u*)(g0 + (size_t)row * gpitch + ch * 8); }
}
template <int NCH> __device__ __forceinline__ void stage_store_k(const v4u (&r)[NCH], LAS unsigned char* dst, int chunks_per_row, int lstride, int tid) {
#pragma unroll
    for (int i = 0; i < NCH; ++i) { const int c = tid + NTHR * i, row = c / chunks_per_row, ch = c % chunks_per_row; *(LAS v4u*)(dst + row * lstride + ch * 16) = r[i]; }
}
template <int NCH> __device__ __forceinline__ void stage_store_v(const v4u (&r)[NCH], LAS unsigned char* dst, int tid) {
#pragma unroll
    for (int i = 0; i < NCH; ++i) { const int c = tid + NTHR * i, row = c >> 3, ch = c & 7; LAS v2u* d = (LAS v2u*)(dst + row * VSTR + ch * 16); d[0] = (v2u){r[i].x, r[i].y}; d[1] = (v2u){r[i].z, r[i].w}; }
}
__device__ __forceinline__ bf16x8 lds_vfrag(const LAS unsigned char* p) { const v2u lo = *(const LAS v2u*)p, hi = *(const LAS v2u*)(p + 16); return __builtin_bit_cast(bf16x8, (v4u){lo.x, lo.y, hi.x, hi.y}); }

template <int NO>
__device__ __forceinline__ void softmax_step2(f32x16& S0, f32x16& S1, float C, float& m, float& l, f32x16 (&O)[NO], int hh) {
    float mx = fmaxf(fmaxf(S0[0], S0[1]), fmaxf(S1[0], S1[1]));
#pragma unroll
    for (int i = 2; i < 16; i += 2) mx = fmaxf(mx, fmaxf(fmaxf(S0[i], S0[i + 1]), fmaxf(S1[i], S1[i + 1])));
    mx = fmaxf(mx, xhalf(mx, hh)) * C;
    const float mn = fmaxf(m, mx), al = __builtin_amdgcn_exp2f(m - mn);
    m = mn; l *= al;
#pragma unroll
    for (int o = 0; o < NO; ++o) O[o] = O[o] * al;
    float ps = 0.f;
#pragma unroll
    for (int i = 0; i < 16; ++i) { S0[i] = __builtin_amdgcn_exp2f(S0[i] * C - mn); S1[i] = __builtin_amdgcn_exp2f(S1[i] * C - mn); ps += S0[i] + S1[i]; }
    l += ps;
}

__device__ __forceinline__ void attn_diff_block(const bf16_t* PR, const bf16_t* VT, float* ODR, int b, int h, int j, int qb, LAS unsigned char* lds, int tid, int wave, int lane) {
    constexpr int KSTR = 144, KB = 64 * KSTR, BUF = KB + 128 * VSTR;
    const int r32 = lane & 31, hh = lane >> 5, q0 = qb * 256 + wave * 32;
    const bf16_t* qrow = PR + (size_t)(b * SEQ + q0 + r32) * NIN + C_DQ + h * 128 + j * 64 + 8 * hh;
    bf16x8 qf[4];
#pragma unroll
    for (int d0 = 0; d0 < 4; ++d0) qf[d0] = *(const bf16x8*)(qrow + 16 * d0);
    const bf16_t* kg = PR + (size_t)(b * SEQ) * NIN + C_DK + h * 128 + j * 64;
    const bf16_t* vg = VT + (size_t)(b * 512 + h * 128) * SEQ;
    f32x16 O[4];
#pragma unroll
    for (int o = 0; o < 4; ++o)
#pragma unroll
        for (int i = 0; i < 16; ++i) O[o][i] = 0.f;
    float m = -INFINITY, l = 0.f;
    const int nsteps = 4 * qb + 4, my_last = 4 * qb + (wave >> 1);
    v4u kr[1], vr[2];
    stage_load<1>(kr, kg, 8, NIN, tid); stage_load<2>(vr, vg, 8, SEQ, tid);
    stage_store_k<1>(kr, lds, 8, KSTR, tid); stage_store_v<2>(vr, lds + KB, tid);
    __syncthreads();
    for (int t = 0; t < nsteps; ++t) {
        const bool more = t + 1 < nsteps;
        if (more) { stage_load<1>(kr, kg + (size_t)(64 * (t + 1)) * NIN, 8, NIN, tid); stage_load<2>(vr, vg + 64 * (t + 1), 8, SEQ, tid); }
        if (t <= my_last) {
            const LAS unsigned char* kb = lds + (t & 1) * BUF + r32 * KSTR + 16 * hh; const LAS unsigned char* vb = kb - r32 * KSTR - 16 * hh + KB + r32 * VSTR + 8 * hh;
            f32x16 S0, S1;
#pragma unroll
            for (int i = 0; i < 16; ++i) { S0[i] = 0.f; S1[i] = 0.f; }
#pragma unroll
            for (int d0 = 0; d0 < 4; ++d0) { S0 = mfma32(*(const LAS bf16x8*)(kb + 32 * d0), qf[d0], S0); S1 = mfma32(*(const LAS bf16x8*)(kb + 32 * KSTR + 32 * d0), qf[d0], S1); }
            softmax_step2<4>(S0, S1, LOG2E, m, l, O, hh);
            const bf16x8 p00 = pack_p(S0, 0), p01 = pack_p(S0, 1), p10 = pack_p(S1, 0), p11 = pack_p(S1, 1);
#pragma unroll
            for (int o = 0; o < 4; ++o) { const LAS unsigned char* vp = vb + 32 * o * VSTR;
                O[o] = mfma32(lds_vfrag(vp), p00, O[o]); O[o] = mfma32(lds_vfrag(vp + 32), p01, O[o]); O[o] = mfma32(lds_vfrag(vp + 64), p10, O[o]); O[o] = mfma32(lds_vfrag(vp + 96), p11, O[o]); }
        }
        if (more) { LAS unsigned char* nb = lds + ((t + 1) & 1) * BUF; stage_store_k<1>(kr, nb, 8, KSTR, tid); stage_store_v<2>(vr, nb + KB, tid); }
        __syncthreads();
    }
    l += xhalf(l, hh);
    const float il = 1.f / l;
    float* orow = ODR + ((size_t)j * M + (size_t)b * SEQ + q0 + r32) * 512 + h * 128 + 4 * hh;
#pragma unroll
    for (int o = 0; o < 4; ++o)
#pragma unroll
        for (int g = 0; g < 4; ++g) *(f32x4*)(orow + 32 * o + 8 * g) = (f32x4){O[o][4 * g] * il, O[o][4 * g + 1] * il, O[o][4 * g + 2] * il, O[o][4 * g + 3] * il};
}

__device__ __forceinline__ void sb_subtile(f32x16& S, bool diag, float& R, f32x16 (&O)[2], const LAS unsigned char* vp, int r32, int hh) {
    f32x16 lr;
#pragma unroll
    for (int i = 0; i < 16; ++i) { const float z2 = S[i] * LOG2E; const float sp = fmaxf(z2, 0.f) + __builtin_amdgcn_logf(1.f + __builtin_amdgcn_exp2f(-fabsf(z2))); lr[i] = -sp; S[i] = z2 - sp; }
    if (diag) {
#pragma unroll
        for (int i = 0; i < 16; ++i) { const int kvl = (i & 3) + 8 * (i >> 2) + 4 * hh; if (kvl >= r32) { lr[i] = 0.f; S[i] = -INFINITY; } }
    }
    float tot[4], pt[4], off[4]; f32x16 ex;
#pragma unroll
    for (int g = 0; g < 4; ++g) { ex[4 * g + 3] = 0.f; ex[4 * g + 2] = lr[4 * g + 3]; ex[4 * g + 1] = lr[4 * g + 3] + lr[4 * g + 2]; ex[4 * g] = ex[4 * g + 1] + lr[4 * g + 1]; tot[g] = ex[4 * g] + lr[4 * g]; }
#pragma unroll
    for (int g = 0; g < 4; ++g) pt[g] = xhalf(tot[g], hh);
    const float own0 = hh ? 0.f : 1.f;
    float sp_ = 0.f;
#pragma unroll
    for (int g = 3; g >= 0; --g) { off[g] = sp_ + own0 * pt[g] + R; sp_ += tot[g] + pt[g]; }
#pragma unroll
    for (int i = 0; i < 16; ++i) S[i] = __builtin_amdgcn_exp2f(S[i] + ex[i] + off[i >> 2]);
    R += sp_;
    const bf16x8 p0 = pack_p(S, 0), p1 = pack_p(S, 1);
#pragma unroll
    for (int o = 0; o < 2; ++o) { O[o] = mfma32(lds_vfrag(vp + 32 * o * VSTR), p0, O[o]); O[o] = mfma32(lds_vfrag(vp + 32 * o * VSTR + 32), p1, O[o]); }
}
__device__ __forceinline__ void attn_sb_block(const bf16_t* PR, const bf16_t* VT, bf16_t* OAT, int b, int h, int qb, LAS unsigned char* lds, volatile LAS unsigned* fl, int tid, int wave, int lane) {
    constexpr int KSTR = 144, KB = 64 * KSTR, BUF = KB + 64 * VSTR;
    const int r32 = lane & 31, hh = lane >> 5, q0 = qb * 256 + wave * 32;
    const bf16_t* qrow = PR + (size_t)(b * SEQ + q0 + r32) * NIN + C_SBQ + h * 64 + 8 * hh;
    bf16x8 qf[4];
#pragma unroll
    for (int d0 = 0; d0 < 4; ++d0) qf[d0] = *(const bf16x8*)(qrow + 16 * d0);
    const bf16_t* kg = PR + (size_t)(b * SEQ) * NIN + C_SBK + h * 64;
    const bf16_t* vg = VT + (size_t)(b * 512 + h * 64) * SEQ;
    f32x16 O[2];
#pragma unroll
    for (int o = 0; o < 2; ++o)
#pragma unroll
        for (int i = 0; i < 16; ++i) O[o][i] = 0.f;
    float R = 0.f; bool done = false;
    const int ttop = 4 * qb + 3, my_diag = 4 * qb + (wave >> 1), odd = wave & 1;
    v4u kr[1], vr[1];
    if (tid < 3) fl[tid] = 0u;
    stage_load<1>(kr, kg + (size_t)(64 * ttop) * NIN, 8, NIN, tid); stage_load<1>(vr, vg + 64 * ttop, 8, SEQ, tid);
    stage_store_k<1>(kr, lds, 8, KSTR, tid); stage_store_v<1>(vr, lds + KB, tid);
    __syncthreads();
    int it = 0;
    for (int t = ttop; t >= 0; --t, ++it) {
        const bool more = t > 0;
        if (more) { stage_load<1>(kr, kg + (size_t)(64 * (t - 1)) * NIN, 8, NIN, tid); stage_load<1>(vr, vg + 64 * (t - 1), 8, SEQ, tid); }
        const int fcur = it % 3;
        if (tid == 0) fl[(it + 1) % 3] = 0u;
        if (t <= my_diag && !done) {
            const LAS unsigned char* kb = lds + (it & 1) * BUF + r32 * KSTR + 16 * hh; const LAS unsigned char* vb = lds + (it & 1) * BUF + KB + r32 * VSTR + 8 * hh;
            const bool isd = (t == my_diag);
            if (!isd || odd) {
                f32x16 S;
#pragma unroll
                for (int i = 0; i < 16; ++i) S[i] = 0.f;
#pragma unroll
                for (int d0 = 0; d0 < 4; ++d0) S = mfma32(*(const LAS bf16x8*)(kb + 32 * KSTR + 32 * d0), qf[d0], S);
                sb_subtile(S, isd, R, O, vb + 64, r32, hh);
            }
            {
                f32x16 S;
#pragma unroll
                for (int i = 0; i < 16; ++i) S[i] = 0.f;
#pragma unroll
                for (int d0 = 0; d0 < 4; ++d0) S = mfma32(*(const LAS bf16x8*)(kb + 32 * d0), qf[d0], S);
                sb_subtile(S, isd && !odd, R, O, vb, r32, hh);
            }
            done = __all(R < -160.f);
        }
        if (done && lane == 0) __hip_atomic_fetch_or((LAS unsigned*)(fl + fcur), 1u << wave, __ATOMIC_RELAXED, __HIP_MEMORY_SCOPE_WORKGROUP);
        if (more) { LAS unsigned char* nb = lds + ((it + 1) & 1) * BUF; stage_store_k<1>(kr, nb, 8, KSTR, tid); stage_store_v<1>(vr, nb + KB, tid); }
        __syncthreads();
        if (fl[fcur] == 0xffu) break;
    }
    bf16_t* orow = OAT + (size_t)(b * SEQ + q0 + r32) * D + h * 64 + 4 * hh;
#pragma unroll
    for (int o = 0; o < 2; ++o)
#pragma unroll
        for (int g = 0; g < 4; ++g) { v2u w; w.x = pg8::cvt_pk_bf16(O[o][4 * g], O[o][4 * g + 1]); w.y = pg8::cvt_pk_bf16(O[o][4 * g + 2], O[o][4 * g + 3]); *(v2u*)(orow + 32 * o + 8 * g) = w; }
    __syncthreads();
}

__device__ __forceinline__ void attn_mem_block(const bf16_t* QM, const bf16_t* KVM, const bf16_t* VT, bf16_t* OM, int b, int h, int qb, LAS unsigned char* lds, int tid, int wave, int lane) {
    constexpr int KSTR = 528, KB = 32 * KSTR, VS = 72, BUF = KB + 128 * VS;
    const int r32 = lane & 31, hh = lane >> 5, q0 = qb * 256 + wave * 32;
    const bf16_t* qrow = QM + (size_t)(b * SEQ + q0 + r32) * D + h * 256 + 8 * hh;
    bf16x8 qf[16];
#pragma unroll
    for (int d0 = 0; d0 < 16; ++d0) qf[d0] = *(const bf16x8*)(qrow + 16 * d0);
    const bf16_t* kg = KVM + (size_t)(b * MEMLEN) * 2048 + h * 256;
    const int vrow = tid >> 2, vch = tid & 3;
    for (int dh = 0; dh < 2; ++dh) {
        const bf16_t* vg = VT + (size_t)(b * 1024 + h * 256 + dh * 128 + vrow) * MEMLEN + vch * 8;
        f32x16 O[4];
#pragma unroll
        for (int o = 0; o < 4; ++o)
#pragma unroll
            for (int i = 0; i < 16; ++i) O[o][i] = 0.f;
        float m = -INFINITY, l = 0.f;
        v4u kr[2], vr;
        stage_load<2>(kr, kg, 32, 2048, tid); vr = *(const v4u*)vg;
        stage_store_k<2>(kr, lds, 32, KSTR, tid); { LAS v2u* d = (LAS v2u*)(lds + KB + vrow * VS + vch * 16); d[0] = (v2u){vr.x, vr.y}; d[1] = (v2u){vr.z, vr.w}; }
        __syncthreads();
        for (int t = 0; t < 8; ++t) {
            const bool more = t < 7;
            if (more) { stage_load<2>(kr, kg + (size_t)(32 * (t + 1)) * 2048, 32, 2048, tid); vr = *(const v4u*)(vg + 32 * (t + 1)); }
            {
                const LAS unsigned char* kb = lds + (t & 1) * BUF + r32 * KSTR + 16 * hh; const LAS unsigned char* vb = lds + (t & 1) * BUF + KB + r32 * VS + 8 * hh;
                f32x16 S;
#pragma unroll
                for (int i = 0; i < 16; ++i) S[i] = 0.f;
#pragma unroll
                for (int d0 = 0; d0 < 16; ++d0) S = mfma32(*(const LAS bf16x8*)(kb + 32 * d0), qf[d0], S);
                softmax_step<4>(S, LOG2E * 0.0625f, m, l, O, hh);
                const bf16x8 p0 = pack_p(S, 0), p1 = pack_p(S, 1);
#pragma unroll
                for (int o = 0; o < 4; ++o) { const LAS unsigned char* vp = vb + 32 * o * VS; O[o] = mfma32(lds_vfrag(vp), p0, O[o]); O[o] = mfma32(lds_vfrag(vp + 32), p1, O[o]); }
            }
            if (more) { LAS unsigned char* nb = lds + ((t + 1) & 1) * BUF; stage_store_k<2>(kr, nb, 32, KSTR, tid); LAS v2u* d = (LAS v2u*)(nb + KB + vrow * VS + vch * 16); d[0] = (v2u){vr.x, vr.y}; d[1] = (v2u){vr.z, vr.w}; }
            __syncthreads();
        }
        l += xhalf(l, hh);
        const float il = 1.f / l;
        bf16_t* orow = OM + (size_t)(b * SEQ + q0 + r32) * D + h * 256 + dh * 128 + 4 * hh;
#pragma unroll
        for (int o = 0; o < 4; ++o)
#pragma unroll
            for (int g = 0; g < 4; ++g) { v2u w; w.x = pg8::cvt_pk_bf16(O[o][4 * g] * il, O[o][4 * g + 1] * il); w.y = pg8::cvt_pk_bf16(O[o][4 * g + 2] * il, O[o][4 * g + 3] * il); *(v2u*)(orow + 32 * o + 8 * g) = w; }
    }
}

struct Args { const void* in[26]; float* out; unsigned char* ws; int ph_lo, ph_hi; };
constexpr int NPHASE = 15;

__device__ __forceinline__ float softplus_f(float z) { return fmaxf(z, 0.f) + __logf(1.f + __expf(-fabsf(z))); }

__global__ void __launch_bounds__(NTHR, 2) fwd(Args args) {
    extern __shared__ __attribute__((aligned(16))) unsigned char lds[];
    LAS unsigned char* L = (LAS unsigned char*)lds;
    volatile LAS unsigned* MISC = (volatile LAS unsigned*)(L + MISC_OFF);
    const int tid = threadIdx.x, lane = tid & 63, wave = __builtin_amdgcn_readfirstlane(tid >> 6);
    const int G = gridDim.x;
    unsigned char* ws = args.ws;
    unsigned* ctl = (unsigned*)(ws + WS_CTL);
    const float* x = (const float*)args.in[0]; const float* mem = (const float*)args.in[1]; const int* positions = (const int*)args.in[2];
    const float* norm_mix = (const float*)args.in[3]; const float* w_in = (const float*)args.in[4];
    const float* lam_q1 = (const float*)args.in[5]; const float* lam_k1 = (const float*)args.in[6]; const float* lam_q2 = (const float*)args.in[7]; const float* lam_k2 = (const float*)args.in[8];
    const float* diff_subln = (const float*)args.in[9]; const float* w_up_sb = (const float*)args.in[10]; const float* w_up_diff = (const float*)args.in[11];
    const float* w_out = (const float*)args.in[12]; const float* norm_mem_q = (const float*)args.in[13]; const float* norm_mem_kv = (const float*)args.in[14];
    const float* w_mem_q = (const float*)args.in[15]; const float* w_mem_kv = (const float*)args.in[16]; const float* w_mem_o = (const float*)args.in[17];
    const float* norm_ffn = (const float*)args.in[18]; const float* w_router = (const float*)args.in[19]; const float* b_router = (const float*)args.in[20];
    const float* w_gate_up = (const float*)args.in[21]; const float* b_gate_up = (const float*)args.in[22]; const float* w_down = (const float*)args.in[23];
    const float* b_down = (const float*)args.in[24]; const float* norm_final = (const float*)args.in[25];
    bf16_t* WIN = (bf16_t*)(ws + WS_WIN); bf16_t* WUPSB = (bf16_t*)(ws + WS_WUPSB); bf16_t* WUPDF = (bf16_t*)(ws + WS_WUPDF); bf16_t* WOUT = (bf16_t*)(ws + WS_WOUT);
    bf16_t* WMQ = (bf16_t*)(ws + WS_WMQ); bf16_t* WMKV = (bf16_t*)(ws + WS_WMKV); bf16_t* WMO = (bf16_t*)(ws + WS_WMO);
    bf16_t* WGU = (bf16_t*)(ws + WS_WGU); bf16_t* WD = (bf16_t*)(ws + WS_WD);
    float* ROPEC = (float*)(ws + WS_ROPE); float* ROPES = ROPEC + (size_t)M * 32;
    int* TK_E = (int*)(ws + WS_TK); int* TK_POS = TK_E + (size_t)M * 4; float* TK_G = (float*)(TK_POS + (size_t)M * 4);
    bf16_t* XN = (bf16_t*)(ws + WS_XN); bf16_t* PR = (bf16_t*)(ws + WS_PR); bf16_t* OAT = (bf16_t*)(ws + WS_OAT); float* ODR = (float*)(ws + WS_ODR);
    bf16_t* MIX = (bf16_t*)(ws + WS_MIX); float* X1 = (float*)(ws + WS_X1); float* X2 = (float*)(ws + WS_X2);
    bf16_t* HM = (bf16_t*)(ws + WS_HM); bf16_t* KVM = (bf16_t*)(ws + WS_KVM); int* TLIST = (int*)(ws + WS_TLIST); float* GLIST = (float*)(ws + WS_GLIST);
    bf16_t* QM = (bf16_t*)(ws + WS_QM); bf16_t* OM = (bf16_t*)(ws + WS_OM); bf16_t* ACT = (bf16_t*)(ws + WS_ACT); bf16_t* YB = (bf16_t*)(ws + WS_YB);
    bf16_t* VTSB = (bf16_t*)(ws + WS_VTSB); bf16_t* VTDF = (bf16_t*)(ws + WS_VTDF); bf16_t* VTM = (bf16_t*)(ws + WS_VTM);
    unsigned* CNT = ctl + CW_CNT;
    LAS float* smf = (LAS float*)L;
    LAS int* smi = (LAS int*)L;

    for (int u = tid; u < (LDS_BYTES - 131072) / 4; u += NTHR) ((LAS unsigned*)(L + 131072))[u] = 0u;
    __syncthreads();
#if !MK_PER_PHASE
    XcdBarrier bar = xcd_barrier_post(ctl + CW_BAR, MISC + 8);
#define GRID_BAR() xcd_barrier(bar)
#else
#define GRID_BAR() do {} while (0)
#endif
    const int lo = args.ph_lo, hi = args.ph_hi;
#define IN(k) (lo <= (k) && (k) < hi)
#define PHASE_L(k, ...) do { if (IN(k)) { auto body_ = [&]() __attribute__((always_inline)) __VA_ARGS__; body_(); if ((PROBE_REP >> (k)) & 1) { GRID_BAR(); body_(); } } } while (0)
#if !MK_PER_PHASE
#define PHASE(k) for (int rep_ = 0, nrep_ = IN(k) ? 1 + ((PROBE_REP >> (k)) & 1) : 0; rep_ < nrep_; ++rep_, (rep_ < nrep_ ? (xcd_barrier(bar), 0) : 0))
#else
#define PHASE(k) if (IN(k))
#endif
#define SEAM(k) do { if (IN(k) && IN((k) + 1)) GRID_BAR(); } while (0)
    const int gw = blockIdx.x * NWAVES + wave, NGW = G * NWAVES;

    PHASE(0) {
        LAS float* scr = (LAS float*)(L + wave * 16384);
        constexpr int I_IN = 16 * 160, I_UP = 8 * 32, I_SQ = 16 * 32, I_KV = 16 * 64, I_GU1 = 16 * 64, I_GU = NE * I_GU1, I_D1 = 16 * 32, I_DN = NE * I_D1;
        constexpr int NITEMS = I_IN + 2 * I_UP + 3 * I_SQ + I_KV + I_GU + I_DN;
        for (int it = gw; it < NITEMS; it += NGW) {
            int r = it;
            if (r < I_IN) {
                const int kb = r / 160, nb = r % 160, n0 = 32 * nb;
                if (n0 >= C_DQ && n0 < C_DV) { const int o = n0 & 255;
                    p0_transpose_rope(w_in, WIN, (n0 & ~255), o, 64 * kb, n0, scr, lane); }
                else p0_transpose_item(w_in, 1024, NIN, WIN, n0, 64 * kb, n0, scr, lane);
                continue; } r -= I_IN;
            if (r < I_UP) { p0_plain(w_up_sb, 512, 1024, WUPSB, r, scr, lane); continue; } r -= I_UP;
            if (r < I_UP) { p0_plain(w_up_diff, 512, 1024, WUPDF, r, scr, lane); continue; } r -= I_UP;
            if (r < I_SQ) { p0_plain(w_out, 1024, 1024, WOUT, r, scr, lane); continue; } r -= I_SQ;
            if (r < I_SQ) { p0_plain(w_mem_q, 1024, 1024, WMQ, r, scr, lane); continue; } r -= I_SQ;
            if (r < I_SQ) { p0_plain(w_mem_o, 1024, 1024, WMO, r, scr, lane); continue; } r -= I_SQ;
            if (r < I_KV) { p0_plain(w_mem_kv, 1024, 2048, WMKV, r, scr, lane); continue; } r -= I_KV;
            if (r < I_GU) { const int e = r / I_GU1, q = r % I_GU1, kb = q / 64, nb = q % 64, n0 = 32 * nb;
                const int half = n0 >> 10, j = n0 & 1023, drow0 = (j >> 7) * 256 + half * 128 + (j & 127);
                p0_transpose_item(w_gate_up + (size_t)e * 1024 * 2048, 1024, 2048, WGU + (size_t)e * 2048 * 1024, drow0, 64 * kb, n0, scr, lane); continue; } r -= I_GU;
            { const int e = r / I_D1, q = r % I_D1; p0_plain(w_down + (size_t)e * 1024 * 1024, 1024, 1024, WD + (size_t)e * 1024 * 1024, q, scr, lane); }
        }
        for (int m = gw; m < M; m += NGW) rms_row_to_bf16(x + (size_t)m * D, norm_mix, XN + (size_t)m * D, lane);
        for (int m = gw; m < MM; m += NGW) rms_row_to_bf16(mem + (size_t)m * D, norm_mem_kv, HM + (size_t)m * D, lane);
        for (int i = blockIdx.x * NTHR + tid; i < M * 32; i += G * NTHR) {
            const int m = i >> 5, f = i & 31;
            const double inv = exp2(-(double)f * (13.287712379549449 / 32.0));
            const double ang = (double)positions[m] * inv;
            const double kk = rint(ang * 0.15915494309189535);
            const float rf = (float)(ang - kk * 6.283185307179586);
            ROPEC[i] = __cosf(rf); ROPES[i] = __sinf(rf);
        }
    }
    SEAM(0);

    PHASE_L(1, {
        { pg8::Gemm g{XN, WIN, D, D, D}; pg8::DenseOrder S; S.init(M, NIN, G, (int)blockIdx.x, D, D);
          pg8::gemm_phase<pg8::EpiInProj, pg8::DenseOrder, false>(L, g, S, pg8::EpiInProj{PR, ROPEC, ROPES, VTSB, VTDF}); }
        { pg8::Gemm g{HM, WMKV, D, D, D}; pg8::DenseOrder S; S.init(MM, 2048, G, (int)blockIdx.x, D, D);
          pg8::gemm_phase<pg8::EpiKV, pg8::DenseOrder, false>(L, g, S, pg8::EpiKV{KVM, VTM}); }
    });
    SEAM(1);

    PHASE(3) {
        volatile LAS unsigned* fl = (volatile LAS unsigned*)(L + 131072 + 2048);
        for (int bu = blockIdx.x; bu < 512; bu += G) { const int qb = bu & 15, h = (bu >> 4) & 7, b = bu >> 7; attn_sb_block(PR, VTSB, OAT, b, h, qb, L, fl, tid, wave, lane); }
        for (int pr = blockIdx.x; pr < 256; pr += G) { const int sb_ = pr & 7, j = (pr >> 3) & 1, h = (pr >> 4) & 3, b = pr >> 6;
            attn_diff_block(PR, VTDF, ODR, b, h, j, 15 - sb_, L, tid, wave, lane); attn_diff_block(PR, VTDF, ODR, b, h, j, sb_, L, tid, wave, lane); }
    }
    SEAM(3);

    PHASE(4) {
        const float s1 = wave_sum(lam_q1[lane] * lam_k1[lane]), s2 = wave_sum(lam_q2[lane] * lam_k2[lane]);
        const float lam = expf(s1) - expf(s2) + 0.2f;
        for (int it = gw; it < M * 4; it += NGW) {
            const int m = it >> 2, h = it & 3;
            const float* p1 = ODR + (size_t)m * 512 + h * 128; const float* p2 = ODR + ((size_t)M + m) * 512 + h * 128;
            const float d0 = p1[lane] - lam * p2[lane], d1 = p1[lane + 64] - lam * p2[lane + 64];
            const float rinv = 1.0f / sqrtf(wave_sum(d0 * d0 + d1 * d1) * (1.f / 128.f) + NORM_EPS);
            bf16_t* op = OAT + (size_t)m * D + 512 + h * 128;
            op[lane] = (bf16_t)f2bf(d0 * rinv * diff_subln[lane] * 0.8f); op[lane + 64] = (bf16_t)f2bf(d1 * rinv * diff_subln[lane + 64] * 0.8f);
        }
    }
    SEAM(4);

    PHASE_L(5, {
        pg8::Gemm g{OAT, WUPSB, D, 512, 512}; pg8::TwoRoundOrder S{G, (int)blockIdx.x, D, 512};
        pg8::gemm_phase<pg8::EpiGate, pg8::TwoRoundOrder, false>(L, g, S, pg8::EpiGate{PR, X2, MIX});
    });
    SEAM(5);

    PHASE_L(6, {
        pg8::Gemm g{MIX, WOUT, D, D, D}; pg8::DenseOrder S; S.init(M, D, G, (int)blockIdx.x, D, D);
        pg8::gemm_phase<pg8::EpiResidF32, pg8::DenseOrder, false>(L, g, S, pg8::EpiResidF32{x, X1});
    });
    SEAM(6);

    PHASE(7) for (int m = gw; m < M; m += NGW) rms_row_to_bf16(X1 + (size_t)m * D, norm_mem_q, XN + (size_t)m * D, lane);
    SEAM(7);

    PHASE_L(8, {
        pg8::Gemm g{XN, WMQ, D, D, D}; pg8::DenseOrder S; S.init(M, D, G, (int)blockIdx.x, D, D);
        pg8::gemm_phase<pg8::EpiBf16Store, pg8::DenseOrder, false>(L, g, S, pg8::EpiBf16Store{QM, D});
    });
    SEAM(8);

    PHASE(9) { for (int bu = blockIdx.x; bu < 256; bu += G) { const int qb = bu & 15, h = (bu >> 4) & 3, b = bu >> 6; attn_mem_block(QM, KVM, VTM, OM, b, h, qb, L, tid, wave, lane); } }
    SEAM(9);

    PHASE_L(10, {
        pg8::Gemm g{OM, WMO, D, D, D}; pg8::DenseOrder S; S.init(M, D, G, (int)blockIdx.x, D, D);
        pg8::gemm_phase<pg8::EpiResidF32, pg8::DenseOrder, false>(L, g, S, pg8::EpiResidF32{X1, X2});
    });
    SEAM(10);

    if (IN(11)) {
        LAS float* hrow = smf + wave * 1024;
        for (int m = gw; m < M; m += NGW) {
            const f32x4* xr = (const f32x4*)(X2 + (size_t)m * D) + lane; const f32x4* gr = (const f32x4*)norm_ffn + lane;
            f32x4 v[4]; float s = 0.f;
#pragma unroll
            for (int j = 0; j < 4; ++j) { v[j] = xr[64 * j]; s += (v[j].x * v[j].x + v[j].y * v[j].y) + (v[j].z * v[j].z + v[j].w * v[j].w); }
            const float rinv = 1.0f / sqrtf(wave_sum(s) * (1.f / 1024.f) + NORM_EPS);
            v2u* o8 = (v2u*)(XN + (size_t)m * D) + lane;
#pragma unroll
            for (int j = 0; j < 4; ++j) { const f32x4 gg = gr[64 * j]; const f32x4 hn = {v[j].x * rinv * gg.x, v[j].y * rinv * gg.y, v[j].z * rinv * gg.z, v[j].w * rinv * gg.w};
                v2u w; w.x = pk2(hn.x, hn.y); w.y = pk2(hn.z, hn.w); o8[64 * j] = w; *(LAS f32x4*)(hrow + (lane + 64 * j) * 4) = hn; }
            LDS_WAIT(); asm volatile("" ::: "memory");
            const int e = lane & 31, kh = lane >> 5;
            float acc = 0.f;
            const float* wr = w_router + (size_t)(kh * 512) * NE + e; const LAS float* hh = hrow + kh * 512;
#pragma unroll 8
            for (int k = 0; k < 512; ++k) acc += hh[k] * wr[(size_t)k * NE];
            acc += __shfl_xor(acc, 32);
            float logit = acc + b_router[e];
            LDS_WAIT(); asm volatile("" ::: "memory");
            float tv[4]; int ti[4]; float cur = logit;
#pragma unroll
            for (int k = 0; k < 4; ++k) {
                float bv = cur; int bi = e;
#pragma unroll
                for (int o = 1; o < 32; o <<= 1) { const float ov = __shfl_xor(bv, o); const int oi = __shfl_xor(bi, o); if (ov > bv || (ov == bv && oi < bi)) { bv = ov; bi = oi; } }
                tv[k] = bv; ti[k] = bi; if (e == bi) cur = -INFINITY;
            }
            const float e1 = __expf(tv[1] - tv[0]), e2 = __expf(tv[2] - tv[0]), e3 = __expf(tv[3] - tv[0]);
            const float isum = 1.f / (1.f + e1 + e2 + e3);
            if (lane < 4) {
                const int ek = lane == 0 ? ti[0] : lane == 1 ? ti[1] : lane == 2 ? ti[2] : ti[3];
                const float gk = (lane == 0 ? 1.f : lane == 1 ? e1 : lane == 2 ? e2 : e3) * isum;
                const int pos = (int)atomicAdd(&CNT[ek], 1u);
                TLIST[ek * LISTCAP + pos] = m; GLIST[ek * LISTCAP + pos] = gk;
                TK_E[m * 4 + lane] = ek; TK_POS[m * 4 + lane] = pos; TK_G[m * 4 + lane] = gk;
            }
        }
    }
    SEAM(11);

#define LOAD_BASES() do { __syncthreads(); if (tid == 0) { int b_ = 0; for (int e_ = 0; e_ < NE; ++e_) { const int c_ = (int)__hip_atomic_load(&CNT[e_], __ATOMIC_RELAXED, __HIP_MEMORY_SCOPE_AGENT); \
        smi[8192 + e_] = b_; smi[8256 + e_] = c_; b_ += (c_ + 255) & ~255; } } __syncthreads(); } while (0)

    LAS int* tb = (LAS int*)(L + 131072 + 1024);
#define LOAD_TB(npn) do { __syncthreads(); if (tid == 0) { int b_ = 0, cu_ = 0; for (int e_ = 0; e_ < NE; ++e_) { const int c_ = (int)__hip_atomic_load(&CNT[e_], __ATOMIC_RELAXED, __HIP_MEMORY_SCOPE_AGENT); \
        tb[e_] = b_; tb[32 + e_] = c_; tb[64 + e_] = cu_; b_ += (c_ + 255) & ~255; cu_ += ((c_ + 255) >> 8) * (npn); } tb[96] = cu_; } __syncthreads(); } while (0)
    PHASE(12) {
        LOAD_TB(8);
        pg8::Gemm g{XN, WGU, D, D, D}; pg8::MoeOrder S{tb, TLIST, G, (int)blockIdx.x, 8, D, D, 2048};
        pg8::gemm_phase<pg8::EpiMoeGU, pg8::MoeOrder, true>(L, g, S, pg8::EpiMoeGU{ACT, b_gate_up});
    }
    SEAM(12);
    PHASE(13) {
        LOAD_TB(4);
        pg8::Gemm g{ACT, WD, DFF, DFF, DFF}; pg8::MoeOrder S{tb, TLIST, G, (int)blockIdx.x, 4, DFF, DFF, 1024};
        pg8::gemm_phase<pg8::EpiMoeDown, pg8::MoeOrder, false>(L, g, S, pg8::EpiMoeDown{YB, b_down, GLIST, tb});
    }
    SEAM(13);

    PHASE(14) {
        LOAD_BASES();
        for (int m = gw; m < M; m += NGW) {
            const f32x4* xr = (const f32x4*)(X2 + (size_t)m * D) + lane; const f32x4* gr = (const f32x4*)norm_final + lane;
            f32x4 v[4];
#pragma unroll
            for (int j = 0; j < 4; ++j) v[j] = xr[64 * j];
#pragma unroll
            for (int k = 0; k < 4; ++k) { const int slot = smi[8192 + TK_E[m * 4 + k]] + TK_POS[m * 4 + k]; const v2u* yr = (const v2u*)(YB + (size_t)slot * D) + lane;
#pragma unroll
                for (int j = 0; j < 4; ++j) { const v2u w = yr[64 * j]; v[j].x += lo16(w.x); v[j].y += hi16(w.x); v[j].z += lo16(w.y); v[j].w += hi16(w.y); } }
            float s = 0.f;
#pragma unroll
            for (int j = 0; j < 4; ++j) s += (v[j].x * v[j].x + v[j].y * v[j].y) + (v[j].z * v[j].z + v[j].w * v[j].w);
            const float rinv = 1.0f / sqrtf(wave_sum(s) * (1.f / 1024.f) + NORM_EPS);
            f32x4* orow = (f32x4*)(args.out + (size_t)m * D) + lane;
#pragma unroll
            for (int j = 0; j < 4; ++j) { const f32x4 gg = gr[64 * j]; orow[64 * j] = (f32x4){v[j].x * rinv * gg.x, v[j].y * rinv * gg.y, v[j].z * rinv * gg.z, v[j].w * rinv * gg.w}; }
        }
    }
#undef IN
#undef SEAM
}

extern "C" void kernel_launch(void* const* d_in, const int* in_sizes, int n_in, void* d_out, int out_size, void* d_ws, size_t ws_size, hipStream_t stream) {
    static int grid = 0;
    if (grid == 0) {
        if (n_in != 26 || out_size != M * D || ws_size < WS_END) { fprintf(stderr, "kernel_launch: unexpected sizes n_in %d out %d ws %zu\n", n_in, out_size, ws_size); grid = -1; return; }
        int dev = 0, cus = 0;
        if (hipGetDevice(&dev) != hipSuccess || hipDeviceGetAttribute(&cus, hipDeviceAttributeMultiprocessorCount, dev) != hipSuccess) { grid = -1; return; }
        if (hipFuncSetAttribute((const void*)fwd, hipFuncAttributeMaxDynamicSharedMemorySize, LDS_BYTES) != hipSuccess) { fprintf(stderr, "kernel_launch: hipFuncSetAttribute failed\n"); grid = -1; return; }
        int per_cu = 0;
        (void)hipOccupancyMaxActiveBlocksPerMultiprocessor(&per_cu, (const void*)fwd, NTHR, LDS_BYTES);
        (void)hipGetLastError();
        grid = cus;
    }
    if (grid < 0) return;
    (void)hipMemsetAsync((char*)d_ws + WS_CTL, 0, CTL_ZERO_BYTES, stream);
    Args a{};
    for (int i = 0; i < 26; ++i) a.in[i] = d_in[i];
    a.out = (float*)d_out; a.ws = (unsigned char*)d_ws;
#if MK_PER_PHASE
    for (int p = 0; p < NPHASE; ++p) { a.ph_lo = p; a.ph_hi = p + 1; hipLaunchKernelGGL(fwd, dim3(grid), dim3(NTHR), LDS_BYTES, stream, a); }
#else
    a.ph_lo = 0; a.ph_hi = NPHASE; hipLaunchKernelGGL(fwd, dim3(grid), dim3(NTHR), LDS_BYTES, stream, a);
#endif
}
```

```cpp
#include <hip/hip_runtime.h>
#include <cstdio>
#include <cstdint>

#ifndef MK_PER_PHASE
#define MK_PER_PHASE 0
#endif

#ifndef PROBE_REP
#define PROBE_REP 0
#endif
#define GAS __attribute__((address_space(1)))
#define LAS __attribute__((address_space(3)))
typedef unsigned short bf16_t;
typedef unsigned v4u __attribute__((ext_vector_type(4)));
typedef unsigned v2u __attribute__((ext_vector_type(2)));
typedef float f32x4 __attribute__((ext_vector_type(4)));
typedef short bf16x8 __attribute__((ext_vector_type(8)));

constexpr int BATCH = 4, SEQ = 4096, D = 1024, M = BATCH * SEQ, NIN = 5120;
constexpr int MEMLEN = 256, MM = BATCH * MEMLEN;
constexpr int NE = 32, TOPK = 4, DFF = 1024;
constexpr float NORM_EPS = 1e-6f;
constexpr int C_SBQ = 0, C_SBK = 512, C_SBV = 1024, C_DQ = 1536, C_DK = 2048, C_DV = 2560, C_GSB = 3072, C_GDF = 4096;
constexpr int LISTCAP = 16384;
constexpr int SLOTS = 65536 + NE * 256;
constexpr int NWAVES = 8, NTHR = 512;

constexpr size_t MiB = 1u << 20;
constexpr size_t WS_CTL = 0, CTL_ZERO_BYTES = 1 * MiB;
constexpr size_t WS_WIN = 2 * MiB;
constexpr size_t WS_WUPSB = 12 * MiB;
constexpr size_t WS_WUPDF = 13 * MiB;
constexpr size_t WS_WOUT = 14 * MiB;
constexpr size_t WS_WMQ = 16 * MiB;
constexpr size_t WS_WMKV = 18 * MiB;
constexpr size_t WS_WMO = 22 * MiB;
constexpr size_t WS_ROPE = 24 * MiB;
constexpr size_t WS_TK = 28 * MiB;
constexpr size_t WS_WR = 29 * MiB;
constexpr size_t WS_WGU = 32 * MiB;
constexpr size_t WS_WD = 160 * MiB;
constexpr size_t WS_XN = 224 * MiB;
constexpr size_t WS_PR = 256 * MiB;
constexpr size_t WS_OAT = 416 * MiB;
constexpr size_t WS_ODR = 448 * MiB;
constexpr size_t WS_MIX = 512 * MiB;
constexpr size_t WS_X1 = 544 * MiB;
constexpr size_t WS_X2 = 608 * MiB;
constexpr size_t WS_HM = 672 * MiB;
constexpr size_t WS_KVM = 674 * MiB;
constexpr size_t WS_TLIST = 678 * MiB;
constexpr size_t WS_GLIST = 680 * MiB;
constexpr size_t WS_QM = 682 * MiB;
constexpr size_t WS_OM = 714 * MiB;
constexpr size_t WS_ACT = 256 * MiB;
constexpr size_t WS_YB = 746 * MiB;
constexpr size_t WS_VTSB = 890 * MiB;
constexpr size_t WS_VTDF = 906 * MiB;
constexpr size_t WS_VTM = 922 * MiB;
constexpr size_t WS_END = 924 * MiB;
static_assert(WS_ACT + (size_t)SLOTS * 1024 * 2 <= WS_OAT, "ACT overlay");
static_assert(WS_YB + (size_t)SLOTS * 1024 * 2 <= WS_VTSB, "YB");
constexpr int CW_CNT = 8192;
constexpr int CW_BAR = 1024;

constexpr int LDS_BYTES = 147456;
constexpr int MISC_OFF = 131072 + 320;

__device__ __forceinline__ float bf2f(bf16_t b) { return __uint_as_float(((unsigned)b) << 16); }
__device__ __forceinline__ unsigned f2bf(float f) { unsigned u = __float_as_uint(f); return (u + 0x7fffu + ((u >> 16) & 1u)) >> 16; }
__device__ __forceinline__ unsigned pk2(float lo, float hi) { return f2bf(lo) | (f2bf(hi) << 16); }
__device__ __forceinline__ float lo16(unsigned w) { return __uint_as_float(w << 16); }
__device__ __forceinline__ float hi16(unsigned w) { return __uint_as_float(w & 0xffff0000u); }
#define LDS_WAIT() asm volatile("s_waitcnt lgkmcnt(0)" ::: "memory")
__device__ __forceinline__ float wave_sum(float v) {
#pragma unroll
    for (int o = 1; o < 64; o <<= 1) v += __shfl_xor(v, o);
    return v;
}
__device__ __forceinline__ float wave_max(float v) {
#pragma unroll
    for (int o = 1; o < 64; o <<= 1) v = fmaxf(v, __shfl_xor(v, o));
    return v;
}

#define XB_TMO      128
#define XB_XCNT(j)  (256  + 64 * (j))
#define XB_XSUB(j)  (1280 + 64 * (j))
#define XB_XGEN(j)  (2304 + 64 * (j))
#define XB_TOP      3328
#define XB_TOPGEN   3392
#define XCD_BAR_WORDS 3456
#define XB_SPIN_CAP (1u << 18)
__device__ __forceinline__ unsigned xb_ld(unsigned* p)              { return __hip_atomic_load(p, __ATOMIC_RELAXED, __HIP_MEMORY_SCOPE_AGENT); }
__device__ __forceinline__ unsigned xb_add(unsigned* p, unsigned v) { return __hip_atomic_fetch_add(p, v, __ATOMIC_RELAXED, __HIP_MEMORY_SCOPE_AGENT); }
__device__ __forceinline__ unsigned xb_xcc_id() { return (unsigned)__builtin_amdgcn_s_getreg((3 << 11) | 20) & 0xFu; }
#define XB_SPIN(cond, bar) do { unsigned _sp = 0; while (cond) { __builtin_amdgcn_s_sleep(1); \
    if ((++_sp & 255u) == 0u) { if (xb_ld(&(bar)[XB_TMO])) break; if (_sp > XB_SPIN_CAP) { atomicAdd(&(bar)[XB_TMO], 1u); break; } } } } while (0)
struct XcdBarrier { unsigned* bar; unsigned x; volatile LAS unsigned* st; };
__device__ __forceinline__ XcdBarrier xcd_barrier_post(unsigned* bar, volatile LAS unsigned* st) {
    XcdBarrier b; b.bar = bar; b.x = xb_xcc_id(); b.st = st;
    if (threadIdx.x == 0) (void)xb_add(&bar[XB_XCNT(b.x)], 1u);
    return b;
}
__device__ __forceinline__ void xcd_barrier_complete(unsigned* bar, unsigned x, unsigned& nloc, unsigned& nx) {
    const unsigned G = gridDim.x * gridDim.y * gridDim.z;
    unsigned sum, cnt, mine, sp = 0u;
    for (;;) {
        sum = 0u; cnt = 0u; mine = 0u;
#pragma unroll
        for (unsigned j = 0; j < 16; ++j) { const unsigned c = xb_ld(&bar[XB_XCNT(j)]); sum += c; cnt += (c > 0u) ? 1u : 0u; mine = (j == x) ? c : mine; }
        if (sum == G) break;
        __builtin_amdgcn_s_sleep(1);
        if ((++sp & 255u) == 0u) { if (xb_ld(&bar[XB_TMO])) break; if (sp > XB_SPIN_CAP) { atomicAdd(&bar[XB_TMO], 1u); break; } }
    }
    nloc = mine > 0u ? mine : 1u; nx = cnt > 0u ? cnt : 1u;
}
__device__ __forceinline__ void xcd_barrier(const XcdBarrier& b) {
    asm volatile("s_waitcnt vmcnt(0)" ::: "memory");
    __syncthreads();
    if (threadIdx.x == 0) {
        unsigned* bar = b.bar;
        __builtin_amdgcn_s_waitcnt(0);
        unsigned nloc = b.st[0], nx = b.st[1];
        if (nloc == 0u) { xcd_barrier_complete(bar, b.x, nloc, nx); b.st[0] = nloc; b.st[1] = nx; }
        const unsigned old = xb_add(&bar[XB_XSUB(b.x)], 1u);
        const unsigned gen = old / nloc;
        if (old + 1u == (gen + 1u) * nloc) {
            __builtin_amdgcn_fence(__ATOMIC_RELEASE, "agent");
            asm volatile("s_waitcnt vmcnt(0)" ::: "memory");
            const unsigned og = xb_add(&bar[XB_TOP], 1u);
            const unsigned tg = og / nx;
            if (og + 1u == (tg + 1u) * nx) xb_add(&bar[XB_TOPGEN], 1u);
            else XB_SPIN(xb_ld(&bar[XB_TOPGEN]) == tg, bar);
            __builtin_amdgcn_fence(__ATOMIC_ACQUIRE, "agent");
            xb_add(&bar[XB_XGEN(b.x)], 1u);
            asm volatile("s_waitcnt vmcnt(0)" ::: "memory");
        } else {
            XB_SPIN(xb_ld(&bar[XB_XGEN(b.x)]) == gen, bar);
            __builtin_amdgcn_fence(__ATOMIC_ACQUIRE, "agent");
            asm volatile("s_waitcnt vmcnt(0)" ::: "memory");
        }
    }
    __syncthreads();
}

__device__ __forceinline__ void p0_transpose_item(const float* W, int K, int N, bf16_t* WT, int drow0, int k0, int n0, LAS float* scr, int lane) {
#pragma unroll 8
    for (int i = 0; i < 32; ++i) { const int kk = 2 * i + (lane >> 5); scr[kk * 33 + (lane & 31)] = W[(size_t)(k0 + kk) * N + n0 + (lane & 31)]; }
    LDS_WAIT(); asm volatile("" ::: "memory");
    const int c = lane & 7;
#pragma unroll
    for (int j = 0; j < 4; ++j) { const int n = (lane >> 3) + 8 * j; const LAS float* s = scr + (8 * c) * 33 + n;
        v4u o; o.x = pk2(s[0 * 33], s[1 * 33]); o.y = pk2(s[2 * 33], s[3 * 33]); o.z = pk2(s[4 * 33], s[5 * 33]); o.w = pk2(s[6 * 33], s[7 * 33]);
        *(v4u*)(WT + (size_t)(drow0 + n) * K + k0 + 8 * c) = o; }
    LDS_WAIT(); asm volatile("" ::: "memory");
}
__device__ __forceinline__ void p0_plain(const float* W, int K, int N, bf16_t* WT, int item, LAS float* scr, int lane) {
    const int nblk = N / 32, kb = item / nblk, nb = item % nblk;
    p0_transpose_item(W, K, N, WT, 32 * nb, 64 * kb, 32 * nb, scr, lane);
}
__device__ __forceinline__ void p0_transpose_rope(const float* W, bf16_t* WT, int tilebase, int o, int k0, int n0, LAS float* scr, int lane) {
    const int K = 1024, N = NIN;
#pragma unroll 8
    for (int i = 0; i < 32; ++i) { const int kk = 2 * i + (lane >> 5); scr[kk * 33 + (lane & 31)] = W[(size_t)(k0 + kk) * N + n0 + (lane & 31)]; }
    LDS_WAIT(); asm volatile("" ::: "memory");
    const int c = lane & 7;
#pragma unroll
    for (int j = 0; j < 4; ++j) { const int n = (lane >> 3) + 8 * j; const LAS float* s = scr + (8 * c) * 33 + n;
        const int oo = o + n, v = ((oo >> 6) << 6) | (((oo >> 4) & 1) << 5) | (((oo >> 2) & 3) << 3) | (((oo >> 5) & 1) << 2) | (oo & 3);
        v4u w; w.x = pk2(s[0 * 33], s[1 * 33]); w.y = pk2(s[2 * 33], s[3 * 33]); w.z = pk2(s[4 * 33], s[5 * 33]); w.w = pk2(s[6 * 33], s[7 * 33]);
        *(v4u*)(WT + (size_t)(tilebase + v) * K + k0 + 8 * c) = w; }
    LDS_WAIT(); asm volatile("" ::: "memory");
}
__device__ __forceinline__ void rms_row_to_bf16(const float* xrow, const float* g, bf16_t* orow, int lane) {
    const f32x4* xr = (const f32x4*)xrow + lane; const f32x4* gr = (const f32x4*)g + lane;
    f32x4 v[4]; float s = 0.f;
#pragma unroll
    for (int j = 0; j < 4; ++j) { v[j] = xr[64 * j]; s += (v[j].x * v[j].x + v[j].y * v[j].y) + (v[j].z * v[j].z + v[j].w * v[j].w); }
    const float rinv = 1.0f / sqrtf(wave_sum(s) * (1.f / 1024.f) + NORM_EPS);
    v2u* o8 = (v2u*)orow + lane;
#pragma unroll
    for (int j = 0; j < 4; ++j) { const f32x4 gg = gr[64 * j]; v2u w; w.x = pk2(v[j].x * rinv * gg.x, v[j].y * rinv * gg.y); w.y = pk2(v[j].z * rinv * gg.z, v[j].w * rinv * gg.w); o8[64 * j] = w; }
}

template <int NB, class RowPtr, class Epi>
__device__ __forceinline__ void ngemm_tile(const RowPtr& rp, const bf16_t* Bt, int ldb, int b1off, int K, int m0, int n0, int mvalid, const Epi& epi, LAS float* sm) {
    const int t = threadIdx.x, r = t >> 2, kq = (t & 3) * 4, ty = t >> 5, tx = t & 31;
    LAS float* As = sm; LAS float* Bs0 = sm + 16 * 132; LAS float* Bs1 = sm + 32 * 132;
    float acc[NB][8][4];
#pragma unroll
    for (int b = 0; b < NB; ++b)
#pragma unroll
        for (int i = 0; i < 8; ++i)
#pragma unroll
            for (int j = 0; j < 4; ++j) acc[b][i][j] = 0.f;
    const bf16_t* arow = rp(m0 + r) + kq;
    const bf16_t* brow0 = Bt + (size_t)(n0 + r) * ldb + kq;
    const bf16_t* brow1 = Bt + (size_t)(n0 + b1off + r) * ldb + kq;
    for (int k0 = 0; k0 < K; k0 += 16) {
        const v2u av = *(const v2u*)(arow + k0);
        const v2u bv0 = *(const v2u*)(brow0 + k0);
        v2u bv1 = bv0; if (NB == 2) bv1 = *(const v2u*)(brow1 + k0);
        As[(kq + 0) * 132 + r] = lo16(av.x); As[(kq + 1) * 132 + r] = hi16(av.x); As[(kq + 2) * 132 + r] = lo16(av.y); As[(kq + 3) * 132 + r] = hi16(av.y);
        Bs0[(kq + 0) * 132 + r] = lo16(bv0.x); Bs0[(kq + 1) * 132 + r] = hi16(bv0.x); Bs0[(kq + 2) * 132 + r] = lo16(bv0.y); Bs0[(kq + 3) * 132 + r] = hi16(bv0.y);
        if (NB == 2) { Bs1[(kq + 0) * 132 + r] = lo16(bv1.x); Bs1[(kq + 1) * 132 + r] = hi16(bv1.x); Bs1[(kq + 2) * 132 + r] = lo16(bv1.y); Bs1[(kq + 3) * 132 + r] = hi16(bv1.y); }
        __syncthreads();
#pragma unroll 2
        for (int kk = 0; kk < 16; ++kk) {
            const f32x4 a0 = *(const LAS f32x4*)(As + kk * 132 + ty * 8), a1 = *(const LAS f32x4*)(As + kk * 132 + ty * 8 + 4);
            const f32x4 b0 = *(const LAS f32x4*)(Bs0 + kk * 132 + tx * 4);
            const float a[8] = {a0.x, a0.y, a0.z, a0.w, a1.x, a1.y, a1.z, a1.w};
#pragma unroll
            for (int i = 0; i < 8; ++i) { acc[0][i][0] += a[i] * b0.x; acc[0][i][1] += a[i] * b0.y; acc[0][i][2] += a[i] * b0.z; acc[0][i][3] += a[i] * b0.w; }
            if (NB == 2) { const f32x4 b1 = *(const LAS f32x4*)(Bs1 + kk * 132 + tx * 4);
#pragma unroll
                for (int i = 0; i < 8; ++i) { acc[NB - 1][i][0] += a[i] * b1.x; acc[NB - 1][i][1] += a[i] * b1.y; acc[NB - 1][i][2] += a[i] * b1.z; acc[NB - 1][i][3] += a[i] * b1.w; } }
        }
        __syncthreads();
    }
#pragma unroll
    for (int i = 0; i < 8; ++i) { const int m = m0 + ty * 8 + i;
        if (m < mvalid) {
#pragma unroll
            for (int j = 0; j < 4; ++j) epi(m, n0 + tx * 4 + j, acc[0][i][j], acc[NB - 1][i][j]); } }
}
struct RowPlain { const bf16_t* A; int lda; __device__ __forceinline__ const bf16_t* operator()(int m) const { return A + (size_t)m * lda; } };

template <class Epi>
__device__ __forceinline__ void ngemm_dense(const bf16_t* A, int lda, const bf16_t* Bt, int ldb, int Mr, int N, int K, const Epi& epi, LAS float* sm) {
    const int nn = N / 128, nunits = (Mr / 128) * nn; RowPlain rp{A, lda};
    for (int u = blockIdx.x; u < nunits; u += gridDim.x) ngemm_tile<1>(rp, Bt, ldb, 0, K, (u / nn) * 128, (u % nn) * 128, Mr, epi, sm);
}

struct EpiStoreBf16 { bf16_t* O; int ldc; __device__ __forceinline__ void operator()(int m, int n, float a, float) const { O[(size_t)m * ldc + n] = (bf16_t)f2bf(a); } };
struct EpiGate1 { const bf16_t* PR; float* T; __device__ __forceinline__ void operator()(int m, int n, float a, float) const { T[(size_t)m * D + n] = bf2f(PR[(size_t)m * NIN + C_GSB + n]) * a; } };
struct EpiGate2 { const bf16_t* PR; const float* T; bf16_t* MIX; __device__ __forceinline__ void operator()(int m, int n, float a, float) const {
    MIX[(size_t)m * D + n] = (bf16_t)f2bf(T[(size_t)m * D + n] + bf2f(PR[(size_t)m * NIN + C_GDF + n]) * a); } };
struct EpiResid { const float* base; float* out; __device__ __forceinline__ void operator()(int m, int n, float a, float) const { out[(size_t)m * D + n] = base[(size_t)m * D + n] + a; } };


namespace pg8 {
constexpr int BM = 256, BK = 64, HALF = 128, HTB = HALF * BK * 2, STAGE_BYTES = 8 * HTB;
__host__ __device__ __forceinline__ int lds_byte(int r, int c) { const int st = (r >> 4) * 2 + (c >> 5), rr = r & 15, cc = c & 31, ob = rr * 64 + cc * 2; return st * 1024 + (ob ^ (((ob >> 9) & 1) << 5)); }
__host__ __device__ __forceinline__ void stage_rc(int b, int& R, int& C) { const int st = b / 1024, sb = b % 1024, swz = sb ^ (((sb >> 9) & 1) << 5); R = (st >> 1) * 16 + swz / 64; C = (st & 1) * 32 + (swz % 64) / 2; }
__host__ __device__ __forceinline__ int perm32(int rho) { const int n = rho >> 4, i = rho & 15; return 8 * (i >> 2) + 4 * n + (i & 3); }
struct Unit { int pm, pn, e; };
struct Gemm { const bf16_t* A; const bf16_t* Bt; int lda, ldb, K; };
typedef float f32x2 __attribute__((ext_vector_type(2))); typedef __bf16 bf16x2_t __attribute__((ext_vector_type(2)));
__device__ __forceinline__ unsigned cvt_pk_bf16(float lo, float hi) { f32x2 v = {lo, hi}; bf16x2_t b = __builtin_convertvector(v, bf16x2_t); return __builtin_bit_cast(unsigned, b); }

template <class Epi, class Sched, bool GATHER>
__device__ __forceinline__ void gemm_phase(LAS unsigned char* lds, const Gemm g, const Sched& S, const Epi& E) {
    const int tid = threadIdx.x, wid = __builtin_amdgcn_readfirstlane(tid >> 6), lane = tid & 63, wr = wid >> 2, wc = wid & 3, fr = lane & 15, fq = lane >> 4;
    const int K = g.K, nt = K / BK;
    unsigned voffB[2], cva[2][2], nva[2][2]; int Rr[2], Cc[2];
#pragma unroll
    for (int i = 0; i < 2; ++i) { int R, C; stage_rc(tid * 16 + i * 8192, R, C); Rr[i] = R; Cc[i] = C; const int Rb = (R & ~31) + perm32(R & 31);
        voffB[i] = (unsigned)(Rb * g.ldb + C) * 2u;
#pragma unroll
        for (int h = 0; h < 2; ++h) { cva[h][i] = (unsigned)((h * HALF + R) * g.lda + C) * 2u; nva[h][i] = cva[h][i]; } }
    const size_t kstep = (size_t)(BK * 2);
    const size_t hstepB = (size_t)HALF * g.ldb * 2;
    const unsigned ldsw = (unsigned)wid * 1024u;
    const int aoff = lds_byte(wr * 64 + fr, fq * 8), boff = lds_byte(wc * 32 + fr, fq * 8);
#define PG8_SA(b, h) (((b) * 2 + (h)) * HTB)
#define PG8_SB(b, h) ((4 + (b) * 2 + (h)) * HTB)
#define PG8_STAGE(bufoff, gbase, voff) do { _Pragma("unroll") for (int _i = 0; _i < 2; ++_i) \
        __builtin_amdgcn_global_load_lds((const unsigned*)((const char*)(gbase) + (voff)[_i]), (LAS unsigned*)(lds + (bufoff) + ldsw + _i * 8192), 16, 0, 0); } while (0)
#define PG8_LDA(dst, b, h) do { _Pragma("unroll") for (int m = 0; m < 4; ++m) _Pragma("unroll") for (int k = 0; k < 2; ++k) dst[m][k] = *(const LAS bf16x8*)(lds + PG8_SA(b, h) + aoff + m * 2048 + k * 1024); } while (0)
#define PG8_LDB(dst, b, h) do { _Pragma("unroll") for (int n = 0; n < 2; ++n) _Pragma("unroll") for (int k = 0; k < 2; ++k) dst[n][k] = *(const LAS bf16x8*)(lds + PG8_SB(b, h) + boff + n * 2048 + k * 1024); } while (0)
#define PG8_MMA(ai, bj, At, Bt) do { __builtin_amdgcn_s_setprio(1); _Pragma("unroll") for (int m = 0; m < 4; ++m) _Pragma("unroll") for (int n = 0; n < 2; ++n) _Pragma("unroll") for (int k = 0; k < 2; ++k) \
        acc[ai][bj][m][n] = __builtin_amdgcn_mfma_f32_16x16x32_bf16(Bt[n][k], At[m][k], acc[ai][bj][m][n], 0, 0, 0); __builtin_amdgcn_s_setprio(0); } while (0)
#define PG8_WAIT_V(n) asm volatile("s_waitcnt vmcnt(" #n ")" ::: "memory")
#define PG8_WAIT_L(n) asm volatile("s_waitcnt lgkmcnt(" #n ")" ::: "memory")
#define PG8_BAR __builtin_amdgcn_s_barrier()
#define PG8_SCHED __builtin_amdgcn_sched_barrier(0)
    Unit cur, nxt; int ui = 0;
    if (!S.next(0, cur)) return;
    if constexpr (GATHER) {
#pragma unroll
        for (int i = 0; i < 2; ++i)
#pragma unroll
            for (int h = 0; h < 2; ++h) cva[h][i] = (unsigned)(S.tok(cur, h * HALF + Rr[i]) * g.lda + Cc[i]) * 2u;
    }
    f32x4 acc[2][2][4][2];
#pragma unroll
    for (int a = 0; a < 2; ++a)
#pragma unroll
        for (int b = 0; b < 2; ++b)
#pragma unroll
            for (int m = 0; m < 4; ++m)
#pragma unroll
                for (int n = 0; n < 2; ++n) acc[a][b][m][n] = (f32x4){0.f, 0.f, 0.f, 0.f};
    bf16x8 At[4][2], B0[2][2], B1[2][2];
    const char* cA = (const char*)g.A + (GATHER ? (size_t)0 : S.a_off(cur)); const char* cB = (const char*)g.Bt + S.b_off(cur);
    PG8_STAGE(PG8_SB(0, 0), cB, voffB); PG8_STAGE(PG8_SB(0, 1), cB + hstepB, voffB); PG8_STAGE(PG8_SA(0, 0), cA, cva[0]); PG8_STAGE(PG8_SA(0, 1), cA, cva[1]);
    if (wr == 1) PG8_BAR;
    PG8_WAIT_V(2); PG8_BAR;
    PG8_STAGE(PG8_SB(1, 0), cB + kstep, voffB); PG8_STAGE(PG8_SA(1, 0), cA + kstep, cva[0]); PG8_STAGE(PG8_SB(1, 1), cB + hstepB + kstep, voffB);
    PG8_WAIT_V(6); PG8_BAR;
    for (;;) {
        const bool has_next = S.next(ui + 1, nxt);
        const char* nA = (has_next && !GATHER) ? (const char*)g.A + S.a_off(nxt) : cA; const char* nB = has_next ? (const char*)g.Bt + S.b_off(nxt) : cB;
        if constexpr (GATHER) {
#pragma unroll
            for (int i = 0; i < 2; ++i)
#pragma unroll
                for (int h = 0; h < 2; ++h) nva[h][i] = has_next ? (unsigned)(S.tok(nxt, h * HALF + Rr[i]) * g.lda + Cc[i]) * 2u : cva[h][i];
        }
        for (int t = 0; t < nt; t += 2) {
            const bool last = (t == nt - 2);
            const char* a1 = cA + (size_t)(t + 1) * kstep;
            const char* a2 = last ? nA : cA + (size_t)(t + 2) * kstep; const char* b2 = last ? nB : cB + (size_t)(t + 2) * kstep;
            const char* a3 = a2 + kstep; const char* b3 = b2 + kstep;
            unsigned v2[2][2];
#pragma unroll
            for (int h = 0; h < 2; ++h)
#pragma unroll
                for (int i = 0; i < 2; ++i) v2[h][i] = (GATHER && last) ? nva[h][i] : cva[h][i];
            PG8_LDB(B0, 0, 0); PG8_LDB(B1, 0, 1); PG8_SCHED; PG8_LDA(At, 0, 0); PG8_STAGE(PG8_SA(1, 1), a1, cva[1]);
            PG8_WAIT_V(8); PG8_WAIT_L(0); PG8_BAR; PG8_MMA(0, 0, At, B0); PG8_MMA(0, 1, At, B1); PG8_BAR; PG8_SCHED;
            PG8_LDA(At, 0, 1); PG8_STAGE(PG8_SB(0, 0), b2, voffB); PG8_STAGE(PG8_SB(0, 1), b2 + hstepB, voffB); PG8_STAGE(PG8_SA(0, 0), a2, v2[0]);
            PG8_WAIT_V(8); PG8_WAIT_L(0); PG8_BAR; PG8_MMA(1, 0, At, B0); PG8_MMA(1, 1, At, B1); PG8_BAR; PG8_SCHED;
            PG8_LDB(B0, 1, 0); PG8_LDB(B1, 1, 1); PG8_SCHED; PG8_LDA(At, 1, 0); PG8_STAGE(PG8_SA(0, 1), a2, v2[1]);
            PG8_WAIT_V(8); PG8_WAIT_L(0); PG8_BAR; PG8_MMA(0, 0, At, B0); PG8_MMA(0, 1, At, B1); PG8_BAR; PG8_SCHED;
            PG8_LDA(At, 1, 1); PG8_STAGE(PG8_SB(1, 0), b3, voffB); PG8_STAGE(PG8_SB(1, 1), b3 + hstepB, voffB); PG8_STAGE(PG8_SA(1, 0), a3, v2[0]);
            PG8_WAIT_V(8); PG8_WAIT_L(0); PG8_BAR; PG8_MMA(1, 0, At, B0); PG8_MMA(1, 1, At, B1); PG8_BAR; PG8_SCHED;
        }
        if (wr == 0) PG8_BAR;
        E(acc, cur, wr, wc, fr, fq);
        if (!has_next) break;
#pragma unroll
        for (int a = 0; a < 2; ++a)
#pragma unroll
            for (int b = 0; b < 2; ++b)
#pragma unroll
                for (int m = 0; m < 4; ++m)
#pragma unroll
                    for (int n = 0; n < 2; ++n) acc[a][b][m][n] = (f32x4){0.f, 0.f, 0.f, 0.f};
        cur = nxt; cA = nA; cB = nB; ++ui;
        if constexpr (GATHER) {
#pragma unroll
            for (int i = 0; i < 2; ++i)
#pragma unroll
                for (int h = 0; h < 2; ++h) cva[h][i] = nva[h][i];
        }
        if (wr == 1) PG8_BAR;
    }
    PG8_WAIT_V(0);
    PG8_BAR;
#undef PG8_SA
#undef PG8_SB
#undef PG8_STAGE
#undef PG8_LDA
#undef PG8_LDB
#undef PG8_MMA
#undef PG8_WAIT_V
#undef PG8_WAIT_L
#undef PG8_BAR
#undef PG8_SCHED
}

struct DenseOrder {
    int nM, nN, nwg, G, c, lda, ldb;
    __device__ __forceinline__ void init(int M_, int N_, int G_, int c_, int lda_, int ldb_) { nM = M_ / BM; nN = N_ / BM; nwg = nM * nN; G = G_; c = c_; lda = lda_; ldb = ldb_; }
    __device__ __forceinline__ bool next(int i, Unit& u) const {
        const long L = (long)i * G + c; if (L >= nwg) return false;
        int wgid = (int)L; { const int q = nwg / 8, r = nwg % 8, xcd = wgid % 8, off = wgid / 8; wgid = (xcd < r ? xcd * (q + 1) : r * (q + 1) + (xcd - r) * q) + off; }
        const int nig = 8 * nN, gid = wgid / nig, fm = gid * 8, gsz = (nM - fm) < 8 ? (nM - fm) : 8;
        u.pm = fm + ((wgid % nig) % gsz); u.pn = (wgid % nig) / gsz; u.e = 0; return true;
    }
    __device__ __forceinline__ size_t a_off(const Unit& u) const { return (size_t)u.pm * BM * lda * 2; }
    __device__ __forceinline__ size_t b_off(const Unit& u) const { return (size_t)u.pn * BM * ldb * 2; }
    __device__ __forceinline__ int tok(const Unit&, int) const { return 0; }
};
struct TwoRoundOrder {
    int G, c, lda, ldb;
    __device__ __forceinline__ bool next(int i, Unit& u) const { const int L = i * G + c; if (L >= 512) return false; const int tile = L & 255; u.pm = tile >> 2; u.pn = tile & 3; u.e = L >> 8; return true; }
    __device__ __forceinline__ size_t a_off(const Unit& u) const { return (size_t)u.pm * BM * lda * 2 + (size_t)u.e * 1024; }
    __device__ __forceinline__ size_t b_off(const Unit& u) const { return (size_t)(u.e * 1024 + u.pn * BM) * ldb * 2; }
    __device__ __forceinline__ int tok(const Unit&, int) const { return 0; }
};
struct MoeOrder {
    const LAS int* tb; const int* tlist; int G, c, npn, lda, ldb, nexp;
    __device__ __forceinline__ bool next(int i, Unit& u) const {
        const int L = i * G + c; if (L >= tb[96]) return false;
        int e = 0; while (tb[65 + e] <= L) ++e;
        const int loc = L - tb[64 + e]; u.e = e; u.pn = loc % npn; u.pm = (tb[e] >> 8) + loc / npn; return true;
    }
    __device__ __forceinline__ size_t a_off(const Unit& u) const { return (size_t)u.pm * BM * lda * 2; }
    __device__ __forceinline__ size_t b_off(const Unit& u) const { return (size_t)(u.e * nexp + u.pn * BM) * ldb * 2; }
    __device__ __forceinline__ int tok(const Unit& u, int row) const { const int r = u.pm * BM - tb[u.e] + row; return r < tb[32 + u.e] ? tlist[u.e * LISTCAP + r] : 0; }
};

#define EPI_ARGS const f32x4 (&acc)[2][2][4][2], const Unit& u, int wr, int wc, int fr, int fq
#define EPI_FOR_ROWS for (int ai = 0; ai < 2; ++ai) _Pragma("unroll") for (int m = 0; m < 4; ++m)
__device__ __forceinline__ v4u pack8(const f32x4 a, const f32x4 b) { v4u w; w.x = cvt_pk_bf16(a[0], a[1]); w.y = cvt_pk_bf16(a[2], a[3]); w.z = cvt_pk_bf16(b[0], b[1]); w.w = cvt_pk_bf16(b[2], b[3]); return w; }
__device__ __forceinline__ void unpack8(const v4u w, f32x4& a, f32x4& b) { a = (f32x4){lo16(w.x), hi16(w.x), lo16(w.y), hi16(w.y)}; b = (f32x4){lo16(w.z), hi16(w.z), lo16(w.w), hi16(w.w)}; }
__device__ __forceinline__ float sigm(float v) { return __builtin_amdgcn_rcpf(1.f + __expf(-v)); }

__device__ __forceinline__ void store_tile_T(const f32x4 (&acc)[2][2][4][2], bf16_t* VT, int vrow0, int s0, int pitch) {
#pragma unroll
    for (int bj = 0; bj < 2; ++bj)
#pragma unroll
        for (int n = 0; n < 2; ++n)
#pragma unroll
            for (int e = 0; e < 4; ++e) { bf16_t* vp = VT + (size_t)(vrow0 + 128 * bj + 4 * n + e) * pitch + s0;
#pragma unroll
                for (int ai = 0; ai < 2; ++ai)
#pragma unroll
                    for (int m = 0; m < 4; ++m) vp[128 * ai + 16 * m] = (bf16_t)(cvt_pk_bf16(acc[ai][bj][m][n][e], 0.f) & 0xffffu); }
}
struct EpiKV { bf16_t* KVM; bf16_t* VTM;
    __device__ __forceinline__ void operator()(EPI_ARGS) const {
        const int row0 = u.pm * BM + wr * 64 + fr, col0 = u.pn * BM + wc * 32 + 8 * fq;
#pragma unroll
        EPI_FOR_ROWS { bf16_t* rowp = KVM + (size_t)(row0 + ai * HALF + m * 16) * 2048 + col0;
#pragma unroll
            for (int bj = 0; bj < 2; ++bj) *(v4u*)(rowp + bj * HALF) = pack8(acc[ai][bj][m][0], acc[ai][bj][m][1]); }
        if (u.pn >= 4) store_tile_T(acc, VTM, u.pm * 1024 + (u.pn - 4) * BM + wc * 32 + 8 * fq, wr * 64 + fr, MEMLEN);
    } };
struct EpiBf16Store { bf16_t* O; int ldc;
    __device__ __forceinline__ void operator()(EPI_ARGS) const {
        const int row0 = u.pm * BM + wr * 64 + fr, col0 = u.pn * BM + wc * 32 + 8 * fq;
#pragma unroll
        EPI_FOR_ROWS { bf16_t* rowp = O + (size_t)(row0 + ai * HALF + m * 16) * ldc + col0;
#pragma unroll
            for (int bj = 0; bj < 2; ++bj) *(v4u*)(rowp + bj * HALF) = pack8(acc[ai][bj][m][0], acc[ai][bj][m][1]); }
    } };
struct EpiResidF32 { const float* base; float* out;
    __device__ __forceinline__ void operator()(EPI_ARGS) const {
        const int row0 = u.pm * BM + wr * 64 + fr, col0 = u.pn * BM + wc * 32 + 8 * fq;
#pragma unroll
        EPI_FOR_ROWS { const size_t off = (size_t)(row0 + ai * HALF + m * 16) * D + col0;
#pragma unroll
            for (int bj = 0; bj < 2; ++bj)
#pragma unroll
                for (int n = 0; n < 2; ++n) { const f32x4 b = *(const f32x4*)(base + off + bj * HALF + 4 * n); *(f32x4*)(out + off + bj * HALF + 4 * n) = b + acc[ai][bj][m][n]; } }
    } };
struct EpiGate { const bf16_t* PR; float* T; bf16_t* MIX;
    __device__ __forceinline__ void operator()(EPI_ARGS) const {
        const int row0 = u.pm * BM + wr * 64 + fr, col0 = u.pn * BM + wc * 32 + 8 * fq;
#pragma unroll
        EPI_FOR_ROWS { const int row = row0 + ai * HALF + m * 16;
#pragma unroll
            for (int bj = 0; bj < 2; ++bj) { const int col = col0 + bj * HALF; f32x4 g0, g1;
                unpack8(*(const v4u*)(PR + (size_t)row * NIN + (u.e ? C_GDF : C_GSB) + col), g0, g1);
                float* tp = T + (size_t)row * D + col;
                if (u.e == 0) { *(f32x4*)tp = g0 * acc[ai][bj][m][0]; *(f32x4*)(tp + 4) = g1 * acc[ai][bj][m][1]; }
                else { const f32x4 t0 = *(const f32x4*)tp, t1 = *(const f32x4*)(tp + 4); *(v4u*)(MIX + (size_t)row * D + col) = pack8(t0 + g0 * acc[ai][bj][m][0], t1 + g1 * acc[ai][bj][m][1]); } } }
    } };
struct EpiInProj { bf16_t* PR; const float* rc; const float* rs; bf16_t* VTSB; bf16_t* VTDF;
    __device__ __forceinline__ void operator()(EPI_ARGS) const {
        const int row0 = u.pm * BM + wr * 64 + fr, pn = u.pn;
        if (pn >= 6 && pn < 10) {
            const float sc = pn < 8 ? 0.125f : 1.0f; const int i0 = 16 * (wc & 1) + 4 * fq;
#pragma unroll
            EPI_FOR_ROWS { const int row = row0 + ai * HALF + m * 16; const f32x4 cs = *(const f32x4*)(rc + (size_t)row * 32 + i0), sn = *(const f32x4*)(rs + (size_t)row * 32 + i0);
#pragma unroll
                for (int bj = 0; bj < 2; ++bj) { const f32x4 lo = acc[ai][bj][m][0], hi = acc[ai][bj][m][1];
                    const f32x4 olo = (lo * cs - hi * sn) * sc, ohi = (hi * cs + lo * sn) * sc;
                    bf16_t* p = PR + (size_t)row * NIN + pn * BM + 64 * (2 * bj + (wc >> 1)) + i0;
                    v2u a, b; a.x = cvt_pk_bf16(olo[0], olo[1]); a.y = cvt_pk_bf16(olo[2], olo[3]); b.x = cvt_pk_bf16(ohi[0], ohi[1]); b.y = cvt_pk_bf16(ohi[2], ohi[3]);
                    *(v2u*)p = a; *(v2u*)(p + 32) = b; } }
        } else {
            const int col0 = pn * BM + wc * 32 + 8 * fq; const float sc = pn < 2 ? 0.125f : 1.0f; const bool sg = pn >= 12;
#pragma unroll
            EPI_FOR_ROWS { bf16_t* rowp = PR + (size_t)(row0 + ai * HALF + m * 16) * NIN + col0;
#pragma unroll
                for (int bj = 0; bj < 2; ++bj) { f32x4 v0 = acc[ai][bj][m][0] * sc, v1 = acc[ai][bj][m][1] * sc;
                    if (sg) { v0 = (f32x4){sigm(v0[0]), sigm(v0[1]), sigm(v0[2]), sigm(v0[3])}; v1 = (f32x4){sigm(v1[0]), sigm(v1[1]), sigm(v1[2]), sigm(v1[3])}; }
                    *(v4u*)(rowp + bj * HALF) = pack8(v0, v1); } }
            if (pn == 4 || pn == 5 || pn == 10 || pn == 11) {
                const int bb = u.pm >> 4, s0 = (u.pm & 15) * BM + wr * 64 + fr, hd0 = (pn < 6 ? (pn - 4) : (pn - 10)) * BM + wc * 32 + 8 * fq;
                store_tile_T(acc, pn < 6 ? VTSB : VTDF, bb * 512 + hd0, s0, SEQ);
            }
        }
    } };
struct EpiMoeGU { bf16_t* ACT; const float* bgu;
    __device__ __forceinline__ void operator()(EPI_ARGS) const {
        const int row0 = u.pm * BM + wr * 64 + fr, j0 = u.pn * 128 + wc * 32 + 8 * fq; const float* bg = bgu + (size_t)u.e * 2048 + j0;
        const f32x4 bg0 = *(const f32x4*)bg, bg1 = *(const f32x4*)(bg + 4), bl0 = *(const f32x4*)(bg + 1024), bl1 = *(const f32x4*)(bg + 1028);
#pragma unroll
        EPI_FOR_ROWS { f32x4 o[2];
#pragma unroll
            for (int n = 0; n < 2; ++n) { const f32x4 gv = acc[ai][0][m][n] + (n ? bg1 : bg0), lv = acc[ai][1][m][n] + (n ? bl1 : bl0);
#pragma unroll
                for (int c = 0; c < 4; ++c) { const float gl = fminf(gv[c], 7.0f), li = fminf(fmaxf(lv[c], -7.0f), 7.0f); o[n][c] = gl * sigm(1.702f * gl) * (li + 1.0f); } }
            *(v4u*)(ACT + (size_t)(row0 + ai * HALF + m * 16) * DFF + j0) = pack8(o[0], o[1]); }
    } };
struct EpiMoeDown { bf16_t* YB; const float* bd; const float* glist; const LAS int* tb;
    __device__ __forceinline__ void operator()(EPI_ARGS) const {
        const int row0 = u.pm * BM + wr * 64 + fr, col0 = u.pn * BM + wc * 32 + 8 * fq; const float* bp = bd + (size_t)u.e * D + col0;
        const float* gl = glist + (size_t)u.e * LISTCAP - tb[u.e];
        f32x4 bv[2][2];
#pragma unroll
        for (int bj = 0; bj < 2; ++bj)
#pragma unroll
            for (int n = 0; n < 2; ++n) bv[bj][n] = *(const f32x4*)(bp + bj * HALF + 4 * n);
#pragma unroll
        EPI_FOR_ROWS { const int row = row0 + ai * HALF + m * 16; const float gt = gl[row];
#pragma unroll
            for (int bj = 0; bj < 2; ++bj) *(v4u*)(YB + (size_t)row * D + col0 + bj * HALF) = pack8((acc[ai][bj][m][0] + bv[bj][0]) * gt, (acc[ai][bj][m][1] + bv[bj][1]) * gt); }
    } };
}


typedef float f32x16 __attribute__((ext_vector_type(16)));
typedef short s16x4 __attribute__((ext_vector_type(4)));
__device__ __forceinline__ f32x16 mfma32(bf16x8 a, bf16x8 b, f32x16 c) { return __builtin_amdgcn_mfma_f32_32x32x16_bf16(a, b, c, 0, 0, 0); }
__device__ __forceinline__ float xhalf(float v, int hh) { auto rr = __builtin_amdgcn_permlane32_swap(__float_as_uint(v), __float_as_uint(v), false, false); return __uint_as_float(hh ? rr[0] : rr[1]); }
__device__ __forceinline__ bf16x8 vt_frag(const bf16_t* p) { const s16x4 lo = *(const s16x4*)p, hi = *(const s16x4*)(p + 8); return (bf16x8){lo[0], lo[1], lo[2], lo[3], hi[0], hi[1], hi[2], hi[3]}; }
__device__ __forceinline__ bf16x8 pack_p(const f32x16& p, int s) { v4u w; w.x = pg8::cvt_pk_bf16(p[8 * s + 0], p[8 * s + 1]); w.y = pg8::cvt_pk_bf16(p[8 * s + 2], p[8 * s + 3]); w.z = pg8::cvt_pk_bf16(p[8 * s + 4], p[8 * s + 5]); w.w = pg8::cvt_pk_bf16(p[8 * s + 6], p[8 * s + 7]); return __builtin_bit_cast(bf16x8, w); }
constexpr float LOG2E = 1.4426950408889634f;

template <int NO>
__device__ __forceinline__ void softmax_step(f32x16& S, float C, float& m, float& l, f32x16 (&O)[NO], int hh) {
    float mx = fmaxf(fmaxf(S[0], S[1]), fmaxf(S[2], S[3]));
#pragma unroll
    for (int i = 4; i < 16; i += 4) mx = fmaxf(mx, fmaxf(fmaxf(S[i], S[i + 1]), fmaxf(S[i + 2], S[i + 3])));
    mx = fmaxf(mx, xhalf(mx, hh)) * C;
    const float mn = fmaxf(m, mx), al = __builtin_amdgcn_exp2f(m - mn);
    m = mn; l *= al;
#pragma unroll
    for (int o = 0; o < NO; ++o) O[o] = O[o] * al;
    float ps = 0.f;
#pragma unroll
    for (int i = 0; i < 16; ++i) { S[i] = __builtin_amdgcn_exp2f(S[i] * C - mn); ps += S[i]; }
    l += ps;
}

__device__ __forceinline__ void attn_diff_wave(const bf16_t* PR, const bf16_t* VT, float* ODR, int b, int h, int j, int q0, int lane) {
    const int r32 = lane & 31, hh = lane >> 5;
    const bf16_t* qrow = PR + (size_t)(b * SEQ + q0 + r32) * NIN + C_DQ + h * 128 + j * 64 + 8 * hh;
    bf16x8 qf[4];
#pragma unroll
    for (int d0 = 0; d0 < 4; ++d0) qf[d0] = *(const bf16x8*)(qrow + 16 * d0);
    const bf16_t* kbase = PR + (size_t)(b * SEQ + r32) * NIN + C_DK + h * 128 + j * 64 + 8 * hh;
    const bf16_t* vbase = VT + (size_t)(b * 512 + h * 128 + r32) * SEQ + 4 * hh;
    f32x16 O[4];
#pragma unroll
    for (int o = 0; o < 4; ++o)
#pragma unroll
        for (int i = 0; i < 16; ++i) O[o][i] = 0.f;
    float m = -INFINITY, l = 0.f;
    const int nt = 2 * (q0 / 64 + 1);
    for (int t = 0; t < nt; ++t) {
        const bf16_t* kp = kbase + (size_t)(32 * t) * NIN;
        f32x16 S;
#pragma unroll
        for (int i = 0; i < 16; ++i) S[i] = 0.f;
#pragma unroll
        for (int d0 = 0; d0 < 4; ++d0) S = mfma32(*(const bf16x8*)(kp + 16 * d0), qf[d0], S);
        softmax_step<4>(S, LOG2E, m, l, O, hh);
        const bf16x8 p0 = pack_p(S, 0), p1 = pack_p(S, 1);
        const bf16_t* vp = vbase + 32 * t;
#pragma unroll
        for (int o = 0; o < 4; ++o) { O[o] = mfma32(vt_frag(vp + (size_t)(32 * o) * SEQ), p0, O[o]); O[o] = mfma32(vt_frag(vp + (size_t)(32 * o) * SEQ + 16), p1, O[o]); }
    }
    l += xhalf(l, hh);
    const float il = 1.f / l;
    float* orow = ODR + ((size_t)j * M + (size_t)b * SEQ + q0 + r32) * 512 + h * 128 + 4 * hh;
#pragma unroll
    for (int o = 0; o < 4; ++o)
#pragma unroll
        for (int g = 0; g < 4; ++g) *(f32x4*)(orow + 32 * o + 8 * g) = (f32x4){O[o][4 * g] * il, O[o][4 * g + 1] * il, O[o][4 * g + 2] * il, O[o][4 * g + 3] * il};
}

__device__ __forceinline__ void attn_sb_wave(const bf16_t* PR, const bf16_t* VT, bf16_t* OAT, int b, int h, int q0, int lane) {
    const int r32 = lane & 31, hh = lane >> 5;
    const bf16_t* qrow = PR + (size_t)(b * SEQ + q0 + r32) * NIN + C_SBQ + h * 64 + 8 * hh;
    bf16x8 qf[4];
#pragma unroll
    for (int d0 = 0; d0 < 4; ++d0) qf[d0] = *(const bf16x8*)(qrow + 16 * d0);
    const bf16_t* kbase = PR + (size_t)(b * SEQ + r32) * NIN + C_SBK + h * 64 + 8 * hh;
    const bf16_t* vbase = VT + (size_t)(b * 512 + h * 64 + r32) * SEQ + 4 * hh;
    f32x16 O[2];
#pragma unroll
    for (int o = 0; o < 2; ++o)
#pragma unroll
        for (int i = 0; i < 16; ++i) O[o][i] = 0.f;
    float R = 0.f;
    const int td = q0 >> 5;
    for (int t = td; t >= 0; --t) {
        const bf16_t* kp = kbase + (size_t)(32 * t) * NIN;
        f32x16 S;
#pragma unroll
        for (int i = 0; i < 16; ++i) S[i] = 0.f;
#pragma unroll
        for (int d0 = 0; d0 < 4; ++d0) S = mfma32(*(const bf16x8*)(kp + 16 * d0), qf[d0], S);
        f32x16 lr;
#pragma unroll
        for (int i = 0; i < 16; ++i) { const float z2 = S[i] * LOG2E; const float sp = fmaxf(z2, 0.f) + __builtin_amdgcn_logf(1.f + __builtin_amdgcn_exp2f(-fabsf(z2)));
            lr[i] = -sp; S[i] = z2 - sp; }
        if (t == td) {
#pragma unroll
            for (int i = 0; i < 16; ++i) { const int kvl = (i & 3) + 8 * (i >> 2) + 4 * hh; if (kvl >= r32) { lr[i] = 0.f; S[i] = -INFINITY; } }
        }
        float tot[4], pt[4], off[4];
        f32x16 ex;
#pragma unroll
        for (int g = 0; g < 4; ++g) { ex[4 * g + 3] = 0.f; ex[4 * g + 2] = lr[4 * g + 3]; ex[4 * g + 1] = lr[4 * g + 3] + lr[4 * g + 2]; ex[4 * g] = ex[4 * g + 1] + lr[4 * g + 1]; tot[g] = ex[4 * g] + lr[4 * g]; }
#pragma unroll
        for (int g = 0; g < 4; ++g) pt[g] = xhalf(tot[g], hh);
        const float own0 = hh ? 0.f : 1.f;
        float sp_ = 0.f;
#pragma unroll
        for (int g = 3; g >= 0; --g) { off[g] = sp_ + own0 * pt[g] + R; sp_ += tot[g] + pt[g]; }
#pragma unroll
        for (int i = 0; i < 16; ++i) S[i] = __builtin_amdgcn_exp2f(S[i] + ex[i] + off[i >> 2]);
        R += sp_;
        const bf16x8 p0 = pack_p(S, 0), p1 = pack_p(S, 1);
        const bf16_t* vp = vbase + 32 * t;
#pragma unroll
        for (int o = 0; o < 2; ++o) { O[o] = mfma32(vt_frag(vp + (size_t)(32 * o) * SEQ), p0, O[o]); O[o] = mfma32(vt_frag(vp + (size_t)(32 * o) * SEQ + 16), p1, O[o]); }
        if (__all(R < -160.f)) break;
    }
    bf16_t* orow = OAT + (size_t)(b * SEQ + q0 + r32) * D + h * 64 + 4 * hh;
#pragma unroll
    for (int o = 0; o < 2; ++o)
#pragma unroll
        for (int g = 0; g < 4; ++g) { v2u w; w.x = pg8::cvt_pk_bf16(O[o][4 * g], O[o][4 * g + 1]); w.y = pg8::cvt_pk_bf16(O[o][4 * g + 2], O[o][4 * g + 3]); *(v2u*)(orow + 32 * o + 8 * g) = w; }
}

__device__ __forceinline__ void attn_mem_wave(const bf16_t* QM, const bf16_t* KVM, const bf16_t* VT, bf16_t* OM, int b, int h, int q0, int lane) {
    const int r32 = lane & 31, hh = lane >> 5;
    const bf16_t* qrow = QM + (size_t)(b * SEQ + q0 + r32) * D + h * 256 + 8 * hh;
    const bf16_t* kbase = KVM + (size_t)(b * MEMLEN + r32) * 2048 + h * 256 + 8 * hh;
    for (int dh = 0; dh < 2; ++dh) {
        const bf16_t* vbase = VT + (size_t)(b * 1024 + h * 256 + dh * 128 + r32) * MEMLEN + 4 * hh;
        f32x16 O[4];
#pragma unroll
        for (int o = 0; o < 4; ++o)
#pragma unroll
            for (int i = 0; i < 16; ++i) O[o][i] = 0.f;
        float m = -INFINITY, l = 0.f;
        for (int t = 0; t < 8; ++t) {
            const bf16_t* kp = kbase + (size_t)(32 * t) * 2048;
            f32x16 S;
#pragma unroll
            for (int i = 0; i < 16; ++i) S[i] = 0.f;
#pragma unroll
            for (int d0 = 0; d0 < 16; ++d0) S = mfma32(*(const bf16x8*)(kp + 16 * d0), *(const bf16x8*)(qrow + 16 * d0), S);
            softmax_step<4>(S, LOG2E * 0.0625f, m, l, O, hh);
            const bf16x8 p0 = pack_p(S, 0), p1 = pack_p(S, 1);
            const bf16_t* vp = vbase + 32 * t;
#pragma unroll
            for (int o = 0; o < 4; ++o) { O[o] = mfma32(vt_frag(vp + (size_t)(32 * o) * MEMLEN), p0, O[o]); O[o] = mfma32(vt_frag(vp + (size_t)(32 * o) * MEMLEN + 16), p1, O[o]); }
        }
        l += xhalf(l, hh);
        const float il = 1.f / l;
        bf16_t* orow = OM + (size_t)(b * SEQ + q0 + r32) * D + h * 256 + dh * 128 + 4 * hh;
#pragma unroll
        for (int o = 0; o < 4; ++o)
#pragma unroll
            for (int g = 0; g < 4; ++g) { v2u w; w.x = pg8::cvt_pk_bf16(O[o][4 * g] * il, O[o][4 * g + 1] * il); w.y = pg8::cvt_pk_bf16(O[o][4 * g + 2] * il, O[o][4 * g + 3] * il); *(v2u*)(orow + 32 * o + 8 * g) = w; }
    }
}


constexpr int VSTR = 136;
template <int NCH> __device__ __forceinline__ void stage_load(v4u (&r)[NCH], const bf16_t* g0, int chunks_per_row, size_t gpitch, int tid) {
#pragma unroll
    for (int i = 0; i < NCH; ++i) { const int c = tid + NTHR * i, row = c / chunks_per_row, ch = c % chunks_per_row; r[i] = *(const v4u*)(g0 + (size_t)row * gpitch + ch * 8); }
}
template <int NCH> __device__ __forceinline__ void stage_store_k(const v4u (&r)[NCH], LAS unsigned char* dst, int chunks_per_row, int lstride, int tid) {
#pragma unroll
    for (int i = 0; i < NCH; ++i) { const int c = tid + NTHR * i, row = c / chunks_per_row, ch = c % chunks_per_row; *(LAS v4u*)(dst + row * lstride + ch * 16) = r[i]; }
}
template <int NCH> __device__ __forceinline__ void stage_store_v(const v4u (&r)[NCH], LAS unsigned char* dst, int tid) {
#pragma unroll
    for (int i = 0; i < NCH; ++i) { const int c = tid + NTHR * i, row = c >> 3, ch = c & 7; LAS v2u* d = (LAS v2u*)(dst + row * VSTR + ch * 16); d[0] = (v2u){r[i].x, r[i].y}; d[1] = (v2u){r[i].z, r[i].w}; }
}
__device__ __forceinline__ bf16x8 lds_vfrag(const LAS unsigned char* p) { const v2u lo = *(const LAS v2u*)p, hi = *(const LAS v2u*)(p + 16); return __builtin_bit_cast(bf16x8, (v4u){lo.x, lo.y, hi.x, hi.y}); }

template <int NO>
__device__ __forceinline__ void softmax_step2(f32x16& S0, f32x16& S1, float C, float& m, float& l, f32x16 (&O)[NO], int hh) {
    float mx = fmaxf(fmaxf(S0[0], S0[1]), fmaxf(S1[0], S1[1]));
#pragma unroll
    for (int i = 2; i < 16; i += 2) mx = fmaxf(mx, fmaxf(fmaxf(S0[i], S0[i + 1]), fmaxf(S1[i], S1[i + 1])));
    mx = fmaxf(mx, xhalf(mx, hh)) * C;
    const float mn = fmaxf(m, mx), al = __builtin_amdgcn_exp2f(m - mn);
    m = mn; l *= al;
#pragma unroll
    for (int o = 0; o < NO; ++o) O[o] = O[o] * al;
    float ps = 0.f;
#pragma unroll
    for (int i = 0; i < 16; ++i) { S0[i] = __builtin_amdgcn_exp2f(S0[i] * C - mn); S1[i] = __builtin_amdgcn_exp2f(S1[i] * C - mn); ps += S0[i] + S1[i]; }
    l += ps;
}

__device__ __forceinline__ void attn_diff_block(const bf16_t* PR, const bf16_t* VT, float* ODR, int b, int h, int j, int qb, LAS unsigned char* lds, int tid, int wave, int lane) {
    constexpr int KSTR = 144, KB = 64 * KSTR, BUF = KB + 128 * VSTR;
    const int r32 = lane & 31, hh = lane >> 5, q0 = qb * 256 + wave * 32;
    const bf16_t* qrow = PR + (size_t)(b * SEQ + q0 + r32) * NIN + C_DQ + h * 128 + j * 64 + 8 * hh;
    bf16x8 qf[4];
#pragma unroll
    for (int d0 = 0; d0 < 4; ++d0) qf[d0] = *(const bf16x8*)(qrow + 16 * d0);
    const bf16_t* kg = PR + (size_t)(b * SEQ) * NIN + C_DK + h * 128 + j * 64;
    const bf16_t* vg = VT + (size_t)(b * 512 + h * 128) * SEQ;
    f32x16 O[4];
#pragma unroll
    for (int o = 0; o < 4; ++o)
#pragma unroll
        for (int i = 0; i < 16; ++i) O[o][i] = 0.f;
    float m = -INFINITY, l = 0.f;
    const int nsteps = 4 * qb + 4, my_last = 4 * qb + (wave >> 1);
    v4u kr[1], vr[2];
    stage_load<1>(kr, kg, 8, NIN, tid); stage_load<2>(vr, vg, 8, SEQ, tid);
    stage_store_k<1>(kr, lds, 8, KSTR, tid); stage_store_v<2>(vr, lds + KB, tid);
    __syncthreads();
    for (int t = 0; t < nsteps; ++t) {
        const bool more = t + 1 < nsteps;
        if (more) { stage_load<1>(kr, kg + (size_t)(64 * (t + 1)) * NIN, 8, NIN, tid); stage_load<2>(vr, vg + 64 * (t + 1), 8, SEQ, tid); }
        if (t <= my_last) {
            const LAS unsigned char* kb = lds + (t & 1) * BUF + r32 * KSTR + 16 * hh; const LAS unsigned char* vb = kb - r32 * KSTR - 16 * hh + KB + r32 * VSTR + 8 * hh;
            f32x16 S0, S1;
#pragma unroll
            for (int i = 0; i < 16; ++i) { S0[i] = 0.f; S1[i] = 0.f; }
#pragma unroll
            for (int d0 = 0; d0 < 4; ++d0) { S0 = mfma32(*(const LAS bf16x8*)(kb + 32 * d0), qf[d0], S0); S1 = mfma32(*(const LAS bf16x8*)(kb + 32 * KSTR + 32 * d0), qf[d0], S1); }
            softmax_step2<4>(S0, S1, LOG2E, m, l, O, hh);
            const bf16x8 p00 = pack_p(S0, 0), p01 = pack_p(S0, 1), p10 = pack_p(S1, 0), p11 = pack_p(S1, 1);
#pragma unroll
            for (int o = 0; o < 4; ++o) { const LAS unsigned char* vp = vb + 32 * o * VSTR;
                O[o] = mfma32(lds_vfrag(vp), p00, O[o]); O[o] = mfma32(lds_vfrag(vp + 32), p01, O[o]); O[o] = mfma32(lds_vfrag(vp + 64), p10, O[o]); O[o] = mfma32(lds_vfrag(vp + 96), p11, O[o]); }
        }
        if (more) { LAS unsigned char* nb = lds + ((t + 1) & 1) * BUF; stage_store_k<1>(kr, nb, 8, KSTR, tid); stage_store_v<2>(vr, nb + KB, tid); }
        __syncthreads();
    }
    l += xhalf(l, hh);
    const float il = 1.f / l;
    float* orow = ODR + ((size_t)j * M + (size_t)b * SEQ + q0 + r32) * 512 + h * 128 + 4 * hh;
#pragma unroll
    for (int o = 0; o < 4; ++o)
#pragma unroll
        for (int g = 0; g < 4; ++g) *(f32x4*)(orow + 32 * o + 8 * g) = (f32x4){O[o][4 * g] * il, O[o][4 * g + 1] * il, O[o][4 * g + 2] * il, O[o][4 * g + 3] * il};
}

__device__ __forceinline__ void sb_subtile(f32x16& S, bool diag, float& R, f32x16 (&O)[2], const LAS unsigned char* vp, int r32, int hh) {
    f32x16 lr;
#pragma unroll
    for (int i = 0; i < 16; ++i) { const float z2 = S[i] * LOG2E; const float sp = fmaxf(z2, 0.f) + __builtin_amdgcn_logf(1.f + __builtin_amdgcn_exp2f(-fabsf(z2))); lr[i] = -sp; S[i] = z2 - sp; }
    if (diag) {
#pragma unroll
        for (int i = 0; i < 16; ++i) { const int kvl = (i & 3) + 8 * (i >> 2) + 4 * hh; if (kvl >= r32) { lr[i] = 0.f; S[i] = -INFINITY; } }
    }
    float tot[4], pt[4], off[4]; f32x16 ex;
#pragma unroll
    for (int g = 0; g < 4; ++g) { ex[4 * g + 3] = 0.f; ex[4 * g + 2] = lr[4 * g + 3]; ex[4 * g + 1] = lr[4 * g + 3] + lr[4 * g + 2]; ex[4 * g] = ex[4 * g + 1] + lr[4 * g + 1]; tot[g] = ex[4 * g] + lr[4 * g]; }
#pragma unroll
    for (int g = 0; g < 4; ++g) pt[g] = xhalf(tot[g], hh);
    const float own0 = hh ? 0.f : 1.f;
    float sp_ = 0.f;
#pragma unroll
    for (int g = 3; g >= 0; --g) { off[g] = sp_ + own0 * pt[g] + R; sp_ += tot[g] + pt[g]; }
#pragma unroll
    for (int i = 0; i < 16; ++i) S[i] = __builtin_amdgcn_exp2f(S[i] + ex[i] + off[i >> 2]);
    R += sp_;
    const bf16x8 p0 = pack_p(S, 0), p1 = pack_p(S, 1);
#pragma unroll
    for (int o = 0; o < 2; ++o) { O[o] = mfma32(lds_vfrag(vp + 32 * o * VSTR), p0, O[o]); O[o] = mfma32(lds_vfrag(vp + 32 * o * VSTR + 32), p1, O[o]); }
}
__device__ __forceinline__ void attn_sb_block(const bf16_t* PR, const bf16_t* VT, bf16_t* OAT, int b, int h, int qb, LAS unsigned char* lds, volatile LAS unsigned* fl, int tid, int wave, int lane) {
    constexpr int KSTR = 144, KB = 64 * KSTR, BUF = KB + 64 * VSTR;
    const int r32 = lane & 31, hh = lane >> 5, q0 = qb * 256 + wave * 32;
    const bf16_t* qrow = PR + (size_t)(b * SEQ + q0 + r32) * NIN + C_SBQ + h * 64 + 8 * hh;
    bf16x8 qf[4];
#pragma unroll
    for (int d0 = 0; d0 < 4; ++d0) qf[d0] = *(const bf16x8*)(qrow + 16 * d0);
    const bf16_t* kg = PR + (size_t)(b * SEQ) * NIN + C_SBK + h * 64;
    const bf16_t* vg = VT + (size_t)(b * 512 + h * 64) * SEQ;
    f32x16 O[2];
#pragma unroll
    for (int o = 0; o < 2; ++o)
#pragma unroll
        for (int i = 0; i < 16; ++i) O[o][i] = 0.f;
    float R = 0.f; bool done = false;
    const int ttop = 4 * qb + 3, my_diag = 4 * qb + (wave >> 1), odd = wave & 1;
    v4u kr[1], vr[1];
    if (tid < 3) fl[tid] = 0u;
    stage_load<1>(kr, kg + (size_t)(64 * ttop) * NIN, 8, NIN, tid); stage_load<1>(vr, vg + 64 * ttop, 8, SEQ, tid);
    stage_store_k<1>(kr, lds, 8, KSTR, tid); stage_store_v<1>(vr, lds + KB, tid);
    __syncthreads();
    int it = 0;
    for (int t = ttop; t >= 0; --t, ++it) {
        const bool more = t > 0;
        if (more) { stage_load<1>(kr, kg + (size_t)(64 * (t - 1)) * NIN, 8, NIN, tid); stage_load<1>(vr, vg + 64 * (t - 1), 8, SEQ, tid); }
        const int fcur = it % 3;
        if (tid == 0) fl[(it + 1) % 3] = 0u;
        if (t <= my_diag && !done) {
            const LAS unsigned char* kb = lds + (it & 1) * BUF + r32 * KSTR + 16 * hh; const LAS unsigned char* vb = lds + (it & 1) * BUF + KB + r32 * VSTR + 8 * hh;
            const bool isd = (t == my_diag);
            if (!isd || odd) {
                f32x16 S;
#pragma unroll
                for (int i = 0; i < 16; ++i) S[i] = 0.f;
#pragma unroll
                for (int d0 = 0; d0 < 4; ++d0) S = mfma32(*(const LAS bf16x8*)(kb + 32 * KSTR + 32 * d0), qf[d0], S);
                sb_subtile(S, isd, R, O, vb + 64, r32, hh);
            }
            {
                f32x16 S;
#pragma unroll
                for (int i = 0; i < 16; ++i) S[i] = 0.f;
#pragma unroll
                for (int d0 = 0; d0 < 4; ++d0) S = mfma32(*(const LAS bf16x8*)(kb + 32 * d0), qf[d0], S);
                sb_subtile(S, isd && !odd, R, O, vb, r32, hh);
            }
            done = __all(R < -160.f);
        }
        if (done && lane == 0) __hip_atomic_fetch_or((LAS unsigned*)(fl + fcur), 1u << wave, __ATOMIC_RELAXED, __HIP_MEMORY_SCOPE_WORKGROUP);
        if (more) { LAS unsigned char* nb = lds + ((it + 1) & 1) * BUF; stage_store_k<1>(kr, nb, 8, KSTR, tid); stage_store_v<1>(vr, nb + KB, tid); }
        __syncthreads();
        if (fl[fcur] == 0xffu) break;
    }
    bf16_t* orow = OAT + (size_t)(b * SEQ + q0 + r32) * D + h * 64 + 4 * hh;
#pragma unroll
    for (int o = 0; o < 2; ++o)
#pragma unroll
        for (int g = 0; g < 4; ++g) { v2u w; w.x = pg8::cvt_pk_bf16(O[o][4 * g], O[o][4 * g + 1]); w.y = pg8::cvt_pk_bf16(O[o][4 * g + 2], O[o][4 * g + 3]); *(v2u*)(orow + 32 * o + 8 * g) = w; }
    __syncthreads();
}

__device__ __forceinline__ void attn_mem_block(const bf16_t* QM, const bf16_t* KVM, const bf16_t* VT, bf16_t* OM, int b, int h, int qb, LAS unsigned char* lds, int tid, int wave, int lane) {
    constexpr int KSTR = 528, KB = 32 * KSTR, VS = 72, BUF = KB + 128 * VS;
    const int r32 = lane & 31, hh = lane >> 5, q0 = qb * 256 + wave * 32;
    const bf16_t* qrow = QM + (size_t)(b * SEQ + q0 + r32) * D + h * 256 + 8 * hh;
    bf16x8 qf[16];
#pragma unroll
    for (int d0 = 0; d0 < 16; ++d0) qf[d0] = *(const bf16x8*)(qrow + 16 * d0);
    const bf16_t* kg = KVM + (size_t)(b * MEMLEN) * 2048 + h * 256;
    const int vrow = tid >> 2, vch = tid & 3;
    for (int dh = 0; dh < 2; ++dh) {
        const bf16_t* vg = VT + (size_t)(b * 1024 + h * 256 + dh * 128 + vrow) * MEMLEN + vch * 8;
        f32x16 O[4];
#pragma unroll
        for (int o = 0; o < 4; ++o)
#pragma unroll
            for (int i = 0; i < 16; ++i) O[o][i] = 0.f;
        float m = -INFINITY, l = 0.f;
        v4u kr[2], vr;
        stage_load<2>(kr, kg, 32, 2048, tid); vr = *(const v4u*)vg;
        stage_store_k<2>(kr, lds, 32, KSTR, tid); { LAS v2u* d = (LAS v2u*)(lds + KB + vrow * VS + vch * 16); d[0] = (v2u){vr.x, vr.y}; d[1] = (v2u){vr.z, vr.w}; }
        __syncthreads();
        for (int t = 0; t < 8; ++t) {
            const bool more = t < 7;
            if (more) { stage_load<2>(kr, kg + (size_t)(32 * (t + 1)) * 2048, 32, 2048, tid); vr = *(const v4u*)(vg + 32 * (t + 1)); }
            {
                const LAS unsigned char* kb = lds + (t & 1) * BUF + r32 * KSTR + 16 * hh; const LAS unsigned char* vb = lds + (t & 1) * BUF + KB + r32 * VS + 8 * hh;
                f32x16 S;
#pragma unroll
                for (int i = 0; i < 16; ++i) S[i] = 0.f;
#pragma unroll
                for (int d0 = 0; d0 < 16; ++d0) S = mfma32(*(const LAS bf16x8*)(kb + 32 * d0), qf[d0], S);
                softmax_step<4>(S, LOG2E * 0.0625f, m, l, O, hh);
                const bf16x8 p0 = pack_p(S, 0), p1 = pack_p(S, 1);
#pragma unroll
                for (int o = 0; o < 4; ++o) { const LAS unsigned char* vp = vb + 32 * o * VS; O[o] = mfma32(lds_vfrag(vp), p0, O[o]); O[o] = mfma32(lds_vfrag(vp + 32), p1, O[o]); }
            }
            if (more) { LAS unsigned char* nb = lds + ((t + 1) & 1) * BUF; stage_store_k<2>(kr, nb, 32, KSTR, tid); LAS v2u* d = (LAS v2u*)(nb + KB + vrow * VS + vch * 16); d[0] = (v2u){vr.x, vr.y}; d[1] = (v2u){vr.z, vr.w}; }
            __syncthreads();
        }
        l += xhalf(l, hh);
        const float il = 1.f / l;
        bf16_t* orow = OM + (size_t)(b * SEQ + q0 + r32) * D + h * 256 + dh * 128 + 4 * hh;
#pragma unroll
        for (int o = 0; o < 4; ++o)
#pragma unroll
            for (int g = 0; g < 4; ++g) { v2u w; w.x = pg8::cvt_pk_bf16(O[o][4 * g] * il, O[o][4 * g + 1] * il); w.y = pg8::cvt_pk_bf16(O[o][4 * g + 2] * il, O[o][4 * g + 3] * il); *(v2u*)(orow + 32 * o + 8 * g) = w; }
    }
}

struct Args { const void* in[26]; float* out; unsigned char* ws; int ph_lo, ph_hi; };
constexpr int NPHASE = 15;

__device__ __forceinline__ float softplus_f(float z) { return fmaxf(z, 0.f) + __logf(1.f + __expf(-fabsf(z))); }

__global__ void __launch_bounds__(NTHR, 2) fwd(Args args) {
    extern __shared__ __attribute__((aligned(16))) unsigned char lds[];
    LAS unsigned char* L = (LAS unsigned char*)lds;
    volatile LAS unsigned* MISC = (volatile LAS unsigned*)(L + MISC_OFF);
    const int tid = threadIdx.x, lane = tid & 63, wave = __builtin_amdgcn_readfirstlane(tid >> 6);
    const int G = gridDim.x;
    unsigned char* ws = args.ws;
    unsigned* ctl = (unsigned*)(ws + WS_CTL);
    const float* x = (const float*)args.in[0]; const float* mem = (const float*)args.in[1]; const int* positions = (const int*)args.in[2];
    const float* norm_mix = (const float*)args.in[3]; const float* w_in = (const float*)args.in[4];
    const float* lam_q1 = (const float*)args.in[5]; const float* lam_k1 = (const float*)args.in[6]; const float* lam_q2 = (const float*)args.in[7]; const float* lam_k2 = (const float*)args.in[8];
    const float* diff_subln = (const float*)args.in[9]; const float* w_up_sb = (const float*)args.in[10]; const float* w_up_diff = (const float*)args.in[11];
    const float* w_out = (const float*)args.in[12]; const float* norm_mem_q = (const float*)args.in[13]; const float* norm_mem_kv = (const float*)args.in[14];
    const float* w_mem_q = (const float*)args.in[15]; const float* w_mem_kv = (const float*)args.in[16]; const float* w_mem_o = (const float*)args.in[17];
    const float* norm_ffn = (const float*)args.in[18]; const float* w_router = (const float*)args.in[19]; const float* b_router = (const float*)args.in[20];
    const float* w_gate_up = (const float*)args.in[21]; const float* b_gate_up = (const float*)args.in[22]; const float* w_down = (const float*)args.in[23];
    const float* b_down = (const float*)args.in[24]; const float* norm_final = (const float*)args.in[25];
    bf16_t* WIN = (bf16_t*)(ws + WS_WIN); bf16_t* WUPSB = (bf16_t*)(ws + WS_WUPSB); bf16_t* WUPDF = (bf16_t*)(ws + WS_WUPDF); bf16_t* WOUT = (bf16_t*)(ws + WS_WOUT);
    bf16_t* WMQ = (bf16_t*)(ws + WS_WMQ); bf16_t* WMKV = (bf16_t*)(ws + WS_WMKV); bf16_t* WMO = (bf16_t*)(ws + WS_WMO);
    bf16_t* WGU = (bf16_t*)(ws + WS_WGU); bf16_t* WD = (bf16_t*)(ws + WS_WD);
    float* ROPEC = (float*)(ws + WS_ROPE); float* ROPES = ROPEC + (size_t)M * 32;
    int* TK_E = (int*)(ws + WS_TK); int* TK_POS = TK_E + (size_t)M * 4; float* TK_G = (float*)(TK_POS + (size_t)M * 4);
    bf16_t* XN = (bf16_t*)(ws + WS_XN); bf16_t* PR = (bf16_t*)(ws + WS_PR); bf16_t* OAT = (bf16_t*)(ws + WS_OAT); float* ODR = (float*)(ws + WS_ODR);
    bf16_t* MIX = (bf16_t*)(ws + WS_MIX); float* X1 = (float*)(ws + WS_X1); float* X2 = (float*)(ws + WS_X2);
    bf16_t* HM = (bf16_t*)(ws + WS_HM); bf16_t* KVM = (bf16_t*)(ws + WS_KVM); int* TLIST = (int*)(ws + WS_TLIST); float* GLIST = (float*)(ws + WS_GLIST);
    bf16_t* QM = (bf16_t*)(ws + WS_QM); bf16_t* OM = (bf16_t*)(ws + WS_OM); bf16_t* ACT = (bf16_t*)(ws + WS_ACT); bf16_t* YB = (bf16_t*)(ws + WS_YB);
    bf16_t* VTSB = (bf16_t*)(ws + WS_VTSB); bf16_t* VTDF = (bf16_t*)(ws + WS_VTDF); bf16_t* VTM = (bf16_t*)(ws + WS_VTM);
    float* WR = (float*)(ws + WS_WR);
    unsigned* CNT = ctl + CW_CNT;
    LAS float* smf = (LAS float*)L;
    LAS int* smi = (LAS int*)L;

    for (int u = tid; u < (LDS_BYTES - 131072) / 4; u += NTHR) ((LAS unsigned*)(L + 131072))[u] = 0u;
    __syncthreads();
#if !MK_PER_PHASE
    XcdBarrier bar = xcd_barrier_post(ctl + CW_BAR, MISC + 8);
#define GRID_BAR() xcd_barrier(bar)
#else
#define GRID_BAR() do {} while (0)
#endif
    const int lo = args.ph_lo, hi = args.ph_hi;
#define IN(k) (lo <= (k) && (k) < hi)
#define PHASE_L(k, ...) do { if (IN(k)) { auto body_ = [&]() __attribute__((always_inline)) __VA_ARGS__; body_(); if ((PROBE_REP >> (k)) & 1) { GRID_BAR(); body_(); } } } while (0)
#if !MK_PER_PHASE
#define PHASE(k) for (int rep_ = 0, nrep_ = IN(k) ? 1 + ((PROBE_REP >> (k)) & 1) : 0; rep_ < nrep_; ++rep_, (rep_ < nrep_ ? (xcd_barrier(bar), 0) : 0))
#else
#define PHASE(k) if (IN(k))
#endif
#define SEAM(k) do { if (IN(k) && IN((k) + 1)) GRID_BAR(); } while (0)
    const int gw = blockIdx.x * NWAVES + wave, NGW = G * NWAVES;

    PHASE(0) {
        LAS float* scr = (LAS float*)(L + wave * 16384);
        constexpr int I_IN = 16 * 160, I_UP = 8 * 32, I_SQ = 16 * 32, I_KV = 16 * 64, I_GU1 = 16 * 64, I_GU = NE * I_GU1, I_D1 = 16 * 32, I_DN = NE * I_D1;
        constexpr int NITEMS = I_IN + 2 * I_UP + 3 * I_SQ + I_KV + I_GU + I_DN;
        for (int it = gw; it < NITEMS; it += NGW) {
            int r = it;
            if (r < I_IN) {
                const int kb = r / 160, nb = r % 160, n0 = 32 * nb;
                if (n0 >= C_DQ && n0 < C_DV) { const int o = n0 & 255;
                    p0_transpose_rope(w_in, WIN, (n0 & ~255), o, 64 * kb, n0, scr, lane); }
                else p0_transpose_item(w_in, 1024, NIN, WIN, n0, 64 * kb, n0, scr, lane);
                continue; } r -= I_IN;
            if (r < I_UP) { p0_plain(w_up_sb, 512, 1024, WUPSB, r, scr, lane); continue; } r -= I_UP;
            if (r < I_UP) { p0_plain(w_up_diff, 512, 1024, WUPDF, r, scr, lane); continue; } r -= I_UP;
            if (r < I_SQ) { p0_plain(w_out, 1024, 1024, WOUT, r, scr, lane); continue; } r -= I_SQ;
            if (r < I_SQ) { p0_plain(w_mem_q, 1024, 1024, WMQ, r, scr, lane); continue; } r -= I_SQ;
            if (r < I_SQ) { p0_plain(w_mem_o, 1024, 1024, WMO, r, scr, lane); continue; } r -= I_SQ;
            if (r < I_KV) { p0_plain(w_mem_kv, 1024, 2048, WMKV, r, scr, lane); continue; } r -= I_KV;
            if (r < I_GU) { const int e = r / I_GU1, q = r % I_GU1, kb = q / 64, nb = q % 64, n0 = 32 * nb;
                const int half = n0 >> 10, j = n0 & 1023, drow0 = (j >> 7) * 256 + half * 128 + (j & 127);
                p0_transpose_item(w_gate_up + (size_t)e * 1024 * 2048, 1024, 2048, WGU + (size_t)e * 2048 * 1024, drow0, 64 * kb, n0, scr, lane); continue; } r -= I_GU;
            { const int e = r / I_D1, q = r % I_D1; p0_plain(w_down + (size_t)e * 1024 * 1024, 1024, 1024, WD + (size_t)e * 1024 * 1024, q, scr, lane); }
        }
        for (int i = blockIdx.x * NTHR + tid; i < D * NE; i += G * NTHR) WR[i] = w_router[i] * norm_ffn[i >> 5];
        for (int m = gw; m < M; m += NGW) rms_row_to_bf16(x + (size_t)m * D, norm_mix, XN + (size_t)m * D, lane);
        for (int m = gw; m < MM; m += NGW) rms_row_to_bf16(mem + (size_t)m * D, norm_mem_kv, HM + (size_t)m * D, lane);
        for (int i = blockIdx.x * NTHR + tid; i < M * 32; i += G * NTHR) {
            const int m = i >> 5, f = i & 31;
            const double inv = exp2(-(double)f * (13.287712379549449 / 32.0));
            const double ang = (double)positions[m] * inv;
            const double kk = rint(ang * 0.15915494309189535);
            const float rf = (float)(ang - kk * 6.283185307179586);
            ROPEC[i] = __cosf(rf); ROPES[i] = __sinf(rf);
        }
    }
    SEAM(0);

    PHASE_L(1, {
        { pg8::Gemm g{XN, WIN, D, D, D}; pg8::DenseOrder S; S.init(M, NIN, G, (int)blockIdx.x, D, D);
          pg8::gemm_phase<pg8::EpiInProj, pg8::DenseOrder, false>(L, g, S, pg8::EpiInProj{PR, ROPEC, ROPES, VTSB, VTDF}); }
        { pg8::Gemm g{HM, WMKV, D, D, D}; pg8::DenseOrder S; S.init(MM, 2048, G, (int)blockIdx.x, D, D);
          pg8::gemm_phase<pg8::EpiKV, pg8::DenseOrder, false>(L, g, S, pg8::EpiKV{KVM, VTM}); }
    });
    SEAM(1);

    PHASE(3) {
        volatile LAS unsigned* fl = (volatile LAS unsigned*)(L + 131072 + 2048);
        for (int bu = blockIdx.x; bu < 512; bu += G) { const int qb = bu & 15, h = (bu >> 4) & 7, b = bu >> 7; attn_sb_block(PR, VTSB, OAT, b, h, qb, L, fl, tid, wave, lane); }
        for (int pr = blockIdx.x; pr < 256; pr += G) { const int sb_ = pr & 7, j = (pr >> 3) & 1, h = (pr >> 4) & 3, b = pr >> 6;
            attn_diff_block(PR, VTDF, ODR, b, h, j, 15 - sb_, L, tid, wave, lane); attn_diff_block(PR, VTDF, ODR, b, h, j, sb_, L, tid, wave, lane); }
    }
    SEAM(3);

    PHASE(4) {
        const float s1 = wave_sum(lam_q1[lane] * lam_k1[lane]), s2 = wave_sum(lam_q2[lane] * lam_k2[lane]);
        const float lam = expf(s1) - expf(s2) + 0.2f;
        for (int it = gw; it < M * 4; it += NGW) {
            const int m = it >> 2, h = it & 3;
            const float* p1 = ODR + (size_t)m * 512 + h * 128; const float* p2 = ODR + ((size_t)M + m) * 512 + h * 128;
            const float d0 = p1[lane] - lam * p2[lane], d1 = p1[lane + 64] - lam * p2[lane + 64];
            const float rinv = 1.0f / sqrtf(wave_sum(d0 * d0 + d1 * d1) * (1.f / 128.f) + NORM_EPS);
            bf16_t* op = OAT + (size_t)m * D + 512 + h * 128;
            op[lane] = (bf16_t)f2bf(d0 * rinv * diff_subln[lane] * 0.8f); op[lane + 64] = (bf16_t)f2bf(d1 * rinv * diff_subln[lane + 64] * 0.8f);
        }
    }
    SEAM(4);

    PHASE_L(5, {
        pg8::Gemm g{OAT, WUPSB, D, 512, 512}; pg8::TwoRoundOrder S{G, (int)blockIdx.x, D, 512};
        pg8::gemm_phase<pg8::EpiGate, pg8::TwoRoundOrder, false>(L, g, S, pg8::EpiGate{PR, X2, MIX});
    });
    SEAM(5);

    PHASE_L(6, {
        pg8::Gemm g{MIX, WOUT, D, D, D}; pg8::DenseOrder S; S.init(M, D, G, (int)blockIdx.x, D, D);
        pg8::gemm_phase<pg8::EpiResidF32, pg8::DenseOrder, false>(L, g, S, pg8::EpiResidF32{x, X1});
    });
    SEAM(6);

    PHASE(7) for (int m = gw; m < M; m += NGW) rms_row_to_bf16(X1 + (size_t)m * D, norm_mem_q, XN + (size_t)m * D, lane);
    SEAM(7);

    PHASE_L(8, {
        pg8::Gemm g{XN, WMQ, D, D, D}; pg8::DenseOrder S; S.init(M, D, G, (int)blockIdx.x, D, D);
        pg8::gemm_phase<pg8::EpiBf16Store, pg8::DenseOrder, false>(L, g, S, pg8::EpiBf16Store{QM, D});
    });
    SEAM(8);

    PHASE(9) { for (int bu = blockIdx.x; bu < 256; bu += G) { const int qb = bu & 15, h = (bu >> 4) & 3, b = bu >> 6; attn_mem_block(QM, KVM, VTM, OM, b, h, qb, L, tid, wave, lane); } }
    SEAM(9);

    PHASE_L(10, {
        pg8::Gemm g{OM, WMO, D, D, D}; pg8::DenseOrder S; S.init(M, D, G, (int)blockIdx.x, D, D);
        pg8::gemm_phase<pg8::EpiResidF32, pg8::DenseOrder, false>(L, g, S, pg8::EpiResidF32{X1, X2});
    });
    SEAM(10);

    if (IN(11)) {
        auto body11_ = [&]() __attribute__((always_inline)) {
        if (wave < 2) {
            for (int tile = wave * G + blockIdx.x; tile < M / 32; tile += 2 * G) {
                const int i32 = lane & 31, kk = lane >> 5, m0 = tile * 32;
                const float* xr = X2 + (size_t)(m0 + i32) * D + 4 * kk; const float* wp = WR + (4 * kk) * NE + i32;
                f32x16 acc;
#pragma unroll
                for (int r = 0; r < 16; ++r) acc[r] = 0.f;
                float ss = 0.f;
#pragma unroll 4
                for (int u = 0; u < 128; ++u) {
                    const f32x4 a = *(const f32x4*)(xr + 8 * u);
                    const float b0 = wp[(8 * u + 0) * NE], b1 = wp[(8 * u + 1) * NE], b2 = wp[(8 * u + 2) * NE], b3 = wp[(8 * u + 3) * NE];
                    acc = __builtin_amdgcn_mfma_f32_32x32x2f32(a.x, b0, acc, 0, 0, 0); acc = __builtin_amdgcn_mfma_f32_32x32x2f32(a.y, b1, acc, 0, 0, 0);
                    acc = __builtin_amdgcn_mfma_f32_32x32x2f32(a.z, b2, acc, 0, 0, 0); acc = __builtin_amdgcn_mfma_f32_32x32x2f32(a.w, b3, acc, 0, 0, 0);
                    ss += (a.x * a.x + a.y * a.y) + (a.z * a.z + a.w * a.w);
                }
                ss += xhalf(ss, kk);
                const float rinv = 1.0f / sqrtf(ss * (1.f / 1024.f) + NORM_EPS);
                LAS float* T = smf + wave * 1152;
#pragma unroll
                for (int r = 0; r < 16; ++r) T[((r & 3) + 8 * (r >> 2) + 4 * kk) * 33 + i32] = acc[r];
                LDS_WAIT(); asm volatile("" ::: "memory");
                if (lane < 32) {
                    float lg[32];
#pragma unroll
                    for (int j = 0; j < 32; ++j) lg[j] = T[lane * 33 + j] * rinv + b_router[j];
                    float tv[4]; int ti[4];
#pragma unroll
                    for (int k = 0; k < 4; ++k) { float bv = lg[0]; int bi = 0;
#pragma unroll
                        for (int j = 1; j < 32; ++j) if (lg[j] > bv) { bv = lg[j]; bi = j; }
                        tv[k] = bv; ti[k] = bi;
#pragma unroll
                        for (int j = 0; j < 32; ++j) if (j == bi) lg[j] = -INFINITY; }
                    const float e1 = __expf(tv[1] - tv[0]), e2 = __expf(tv[2] - tv[0]), e3 = __expf(tv[3] - tv[0]);
                    const float isum = 1.f / (1.f + e1 + e2 + e3);
                    const float gk[4] = {isum, e1 * isum, e2 * isum, e3 * isum};
                    LAS unsigned* H = (LAS unsigned*)(T + 32 * 33);
                    H[lane] = 0u;
                    LDS_WAIT(); asm volatile("" ::: "memory");
                    int rk[4];
#pragma unroll
                    for (int k = 0; k < 4; ++k) rk[k] = (int)__hip_atomic_fetch_add(H + ti[k], 1u, __ATOMIC_RELAXED, __HIP_MEMORY_SCOPE_WAVEFRONT);
                    LDS_WAIT(); asm volatile("" ::: "memory");
                    const unsigned cnt_e = H[lane];
                    unsigned base_e = 0u; if (cnt_e) base_e = atomicAdd(&CNT[64 * lane], cnt_e);
                    H[32 + lane] = base_e;
                    LDS_WAIT(); asm volatile("" ::: "memory");
                    const int m = m0 + lane;
#pragma unroll
                    for (int k = 0; k < 4; ++k) { const int ek = ti[k]; const int pos = (int)H[32 + ek] + rk[k];
                        TLIST[ek * LISTCAP + pos] = m; GLIST[ek * LISTCAP + pos] = gk[k]; TK_E[m * 4 + k] = ek; TK_POS[m * 4 + k] = pos; TK_G[m * 4 + k] = gk[k]; }
                }
                LDS_WAIT(); asm volatile("" ::: "memory");
            }
        } else {
            for (int m = blockIdx.x * 6 + (wave - 2); m < M; m += G * 6) rms_row_to_bf16(X2 + (size_t)m * D, norm_ffn, XN + (size_t)m * D, lane);
        }
            };
        body11_();
        if ((PROBE_REP >> 11) & 1) { GRID_BAR(); if (blockIdx.x == 0 && tid < NE) CNT[64 * tid] = 0u; GRID_BAR(); body11_(); }
    }
    SEAM(11);

#define LOAD_BASES() do { __syncthreads(); if (tid == 0) { int b_ = 0; for (int e_ = 0; e_ < NE; ++e_) { const int c_ = (int)__hip_atomic_load(&CNT[64 * e_], __ATOMIC_RELAXED, __HIP_MEMORY_SCOPE_AGENT); \
        smi[8192 + e_] = b_; smi[8256 + e_] = c_; b_ += (c_ + 255) & ~255; } } __syncthreads(); } while (0)

    LAS int* tb = (LAS int*)(L + 131072 + 1024);
#define LOAD_TB(npn) do { __syncthreads(); if (tid == 0) { int b_ = 0, cu_ = 0; for (int e_ = 0; e_ < NE; ++e_) { const int c_ = (int)__hip_atomic_load(&CNT[64 * e_], __ATOMIC_RELAXED, __HIP_MEMORY_SCOPE_AGENT); \
        tb[e_] = b_; tb[32 + e_] = c_; tb[64 + e_] = cu_; b_ += (c_ + 255) & ~255; cu_ += ((c_ + 255) >> 8) * (npn); } tb[96] = cu_; } __syncthreads(); } while (0)
    PHASE(12) {
        LOAD_TB(8);
        pg8::Gemm g{XN, WGU, D, D, D}; pg8::MoeOrder S{tb, TLIST, G, (int)blockIdx.x, 8, D, D, 2048};
        pg8::gemm_phase<pg8::EpiMoeGU, pg8::MoeOrder, true>(L, g, S, pg8::EpiMoeGU{ACT, b_gate_up});
    }
    SEAM(12);
    PHASE(13) {
        LOAD_TB(4);
        pg8::Gemm g{ACT, WD, DFF, DFF, DFF}; pg8::MoeOrder S{tb, TLIST, G, (int)blockIdx.x, 4, DFF, DFF, 1024};
        pg8::gemm_phase<pg8::EpiMoeDown, pg8::MoeOrder, false>(L, g, S, pg8::EpiMoeDown{YB, b_down, GLIST, tb});
    }
    SEAM(13);

    PHASE(14) {
        LOAD_BASES();
        for (int m = gw; m < M; m += NGW) {
            const f32x4* xr = (const f32x4*)(X2 + (size_t)m * D) + lane; const f32x4* gr = (const f32x4*)norm_final + lane;
            f32x4 v[4];
#pragma unroll
            for (int j = 0; j < 4; ++j) v[j] = xr[64 * j];
#pragma unroll
            for (int k = 0; k < 4; ++k) { const int slot = smi[8192 + TK_E[m * 4 + k]] + TK_POS[m * 4 + k]; const v2u* yr = (const v2u*)(YB + (size_t)slot * D) + lane;
#pragma unroll
                for (int j = 0; j < 4; ++j) { const v2u w = yr[64 * j]; v[j].x += lo16(w.x); v[j].y += hi16(w.x); v[j].z += lo16(w.y); v[j].w += hi16(w.y); } }
            float s = 0.f;
#pragma unroll
            for (int j = 0; j < 4; ++j) s += (v[j].x * v[j].x + v[j].y * v[j].y) + (v[j].z * v[j].z + v[j].w * v[j].w);
            const float rinv = 1.0f / sqrtf(wave_sum(s) * (1.f / 1024.f) + NORM_EPS);
            f32x4* orow = (f32x4*)(args.out + (size_t)m * D) + lane;
#pragma unroll
            for (int j = 0; j < 4; ++j) { const f32x4 gg = gr[64 * j]; orow[64 * j] = (f32x4){v[j].x * rinv * gg.x, v[j].y * rinv * gg.y, v[j].z * rinv * gg.z, v[j].w * rinv * gg.w}; }
        }
    }
#undef IN
#undef SEAM
}

extern "C" void kernel_launch(void* const* d_in, const int* in_sizes, int n_in, void* d_out, int out_size, void* d_ws, size_t ws_size, hipStream_t stream) {
    static int grid = 0;
    if (grid == 0) {
        if (n_in != 26 || out_size != M * D || ws_size < WS_END) { fprintf(stderr, "kernel_launch: unexpected sizes n_in %d out %d ws %zu\n", n_in, out_size, ws_size); grid = -1; return; }
        int dev = 0, cus = 0;
        if (hipGetDevice(&dev) != hipSuccess || hipDeviceGetAttribute(&cus, hipDeviceAttributeMultiprocessorCount, dev) != hipSuccess) { grid = -1; return; }
        if (hipFuncSetAttribute((const void*)fwd, hipFuncAttributeMaxDynamicSharedMemorySize, LDS_BYTES) != hipSuccess) { fprintf(stderr, "kernel_launch: hipFuncSetAttribute failed\n"); grid = -1; return; }
        int per_cu = 0;
        (void)hipOccupancyMaxActiveBlocksPerMultiprocessor(&per_cu, (const void*)fwd, NTHR, LDS_BYTES);
        (void)hipGetLastError();
        grid = cus;
    }
    if (grid < 0) return;
    (void)hipMemsetAsync((char*)d_ws + WS_CTL, 0, CTL_ZERO_BYTES, stream);
    Args a{};
    for (int i = 0; i < 26; ++i) a.in[i] = d_in[i];
    a.out = (float*)d_out; a.ws = (unsigned char*)d_ws;
#if MK_PER_PHASE
    for (int p = 0; p < NPHASE; ++p) { a.ph_lo = p; a.ph_hi = p + 1; hipLaunchKernelGGL(fwd, dim3(grid), dim3(NTHR), LDS_BYTES, stream, a); }
#else
    a.ph_lo = 0; a.ph_hi = NPHASE; hipLaunchKernelGGL(fwd, dim3(grid), dim3(NTHR), LDS_BYTES, stream, a);
#endif
}
```

```cpp
#include <hip/hip_runtime.h>
#include <cstdio>
#include <cstdint>

#ifndef MK_PER_PHASE
#define MK_PER_PHASE 0
#endif

#ifndef PROBE_REP
#define PROBE_REP 0
#endif
#define GAS __attribute__((address_space(1)))
#define LAS __attribute__((address_space(3)))
typedef unsigned short bf16_t;
typedef unsigned v4u __attribute__((ext_vector_type(4)));
typedef unsigned v2u __attribute__((ext_vector_type(2)));
typedef float f32x4 __attribute__((ext_vector_type(4)));
typedef short bf16x8 __attribute__((ext_vector_type(8)));

constexpr int BATCH = 4, SEQ = 4096, D = 1024, M = BATCH * SEQ, NIN = 5120;
constexpr int MEMLEN = 256, MM = BATCH * MEMLEN;
constexpr int NE = 32, TOPK = 4, DFF = 1024;
constexpr float NORM_EPS = 1e-6f;
constexpr int C_SBQ = 0, C_SBK = 512, C_SBV = 1024, C_DQ = 1536, C_DK = 2048, C_DV = 2560, C_GSB = 3072, C_GDF = 4096;
constexpr int LISTCAP = 16384;
constexpr int SLOTS = 65536 + NE * 256;
constexpr int NWAVES = 8, NTHR = 512;

constexpr size_t MiB = 1u << 20;
constexpr size_t WS_CTL = 0, CTL_ZERO_BYTES = 1 * MiB;
constexpr size_t WS_WIN = 2 * MiB;
constexpr size_t WS_WUPSB = 12 * MiB;
constexpr size_t WS_WUPDF = 13 * MiB;
constexpr size_t WS_WOUT = 14 * MiB;
constexpr size_t WS_WMQ = 16 * MiB;
constexpr size_t WS_WMKV = 18 * MiB;
constexpr size_t WS_WMO = 22 * MiB;
constexpr size_t WS_ROPE = 24 * MiB;
constexpr size_t WS_TK = 28 * MiB;
constexpr size_t WS_WR = 29 * MiB;
constexpr size_t WS_WGU = 32 * MiB;
constexpr size_t WS_WD = 160 * MiB;
constexpr size_t WS_XN = 224 * MiB;
constexpr size_t WS_PR = 256 * MiB;
constexpr size_t WS_OAT = 416 * MiB;
constexpr size_t WS_ODR = 448 * MiB;
constexpr size_t WS_MIX = 512 * MiB;
constexpr size_t WS_X1 = 544 * MiB;
constexpr size_t WS_X2 = 608 * MiB;
constexpr size_t WS_HM = 672 * MiB;
constexpr size_t WS_KVM = 674 * MiB;
constexpr size_t WS_TLIST = 678 * MiB;
constexpr size_t WS_GLIST = 680 * MiB;
constexpr size_t WS_QM = 682 * MiB;
constexpr size_t WS_OM = 714 * MiB;
constexpr size_t WS_ACT = 256 * MiB;
constexpr size_t WS_YB = 746 * MiB;
constexpr size_t WS_VTSB = 890 * MiB;
constexpr size_t WS_VTDF = 906 * MiB;
constexpr size_t WS_VTM = 922 * MiB;
constexpr size_t WS_END = 924 * MiB;
static_assert(WS_ACT + (size_t)SLOTS * 1024 * 2 <= WS_OAT, "ACT overlay");
static_assert(WS_YB + (size_t)SLOTS * 1024 * 2 <= WS_VTSB, "YB");
constexpr int CW_CNT = 8192;
constexpr int CW_BAR = 1024;

constexpr int LDS_BYTES = 147456;
constexpr int MISC_OFF = 131072 + 320;

__device__ __forceinline__ float bf2f(bf16_t b) { return __uint_as_float(((unsigned)b) << 16); }
__device__ __forceinline__ unsigned f2bf(float f) { unsigned u = __float_as_uint(f); return (u + 0x7fffu + ((u >> 16) & 1u)) >> 16; }
__device__ __forceinline__ unsigned pk2(float lo, float hi) { return f2bf(lo) | (f2bf(hi) << 16); }
__device__ __forceinline__ float lo16(unsigned w) { return __uint_as_float(w << 16); }
__device__ __forceinline__ float hi16(unsigned w) { return __uint_as_float(w & 0xffff0000u); }
#define LDS_WAIT() asm volatile("s_waitcnt lgkmcnt(0)" ::: "memory")
__device__ __forceinline__ float wave_sum(float v) {
#pragma unroll
    for (int o = 1; o < 64; o <<= 1) v += __shfl_xor(v, o);
    return v;
}
__device__ __forceinline__ float wave_max(float v) {
#pragma unroll
    for (int o = 1; o < 64; o <<= 1) v = fmaxf(v, __shfl_xor(v, o));
    return v;
}

#define XB_TMO      128
#define XB_XCNT(j)  (256  + 64 * (j))
#define XB_XSUB(j)  (1280 + 64 * (j))
#define XB_XGEN(j)  (2304 + 64 * (j))
#define XB_TOP      3328
#define XB_TOPGEN   3392
#define XCD_BAR_WORDS 3456
#define XB_SPIN_CAP (1u << 18)
__device__ __forceinline__ unsigned xb_ld(unsigned* p)              { return __hip_atomic_load(p, __ATOMIC_RELAXED, __HIP_MEMORY_SCOPE_AGENT); }
__device__ __forceinline__ unsigned xb_add(unsigned* p, unsigned v) { return __hip_atomic_fetch_add(p, v, __ATOMIC_RELAXED, __HIP_MEMORY_SCOPE_AGENT); }
__device__ __forceinline__ unsigned xb_xcc_id() { return (unsigned)__builtin_amdgcn_s_getreg((3 << 11) | 20) & 0xFu; }
#define XB_SPIN(cond, bar) do { unsigned _sp = 0; while (cond) { __builtin_amdgcn_s_sleep(1); \
    if ((++_sp & 255u) == 0u) { if (xb_ld(&(bar)[XB_TMO])) break; if (_sp > XB_SPIN_CAP) { atomicAdd(&(bar)[XB_TMO], 1u); break; } } } } while (0)
struct XcdBarrier { unsigned* bar; unsigned x; volatile LAS unsigned* st; };
__device__ __forceinline__ XcdBarrier xcd_barrier_post(unsigned* bar, volatile LAS unsigned* st) {
    XcdBarrier b; b.bar = bar; b.x = xb_xcc_id(); b.st = st;
    if (threadIdx.x == 0) (void)xb_add(&bar[XB_XCNT(b.x)], 1u);
    return b;
}
__device__ __forceinline__ void xcd_barrier_complete(unsigned* bar, unsigned x, unsigned& nloc, unsigned& nx) {
    const unsigned G = gridDim.x * gridDim.y * gridDim.z;
    unsigned sum, cnt, mine, sp = 0u;
    for (;;) {
        sum = 0u; cnt = 0u; mine = 0u;
#pragma unroll
        for (unsigned j = 0; j < 16; ++j) { const unsigned c = xb_ld(&bar[XB_XCNT(j)]); sum += c; cnt += (c > 0u) ? 1u : 0u; mine = (j == x) ? c : mine; }
        if (sum == G) break;
        __builtin_amdgcn_s_sleep(1);
        if ((++sp & 255u) == 0u) { if (xb_ld(&bar[XB_TMO])) break; if (sp > XB_SPIN_CAP) { atomicAdd(&bar[XB_TMO], 1u); break; } }
    }
    nloc = mine > 0u ? mine : 1u; nx = cnt > 0u ? cnt : 1u;
}
__device__ __forceinline__ void xcd_barrier(const XcdBarrier& b) {
    asm volatile("s_waitcnt vmcnt(0)" ::: "memory");
    __syncthreads();
    if (threadIdx.x == 0) {
        unsigned* bar = b.bar;
        __builtin_amdgcn_s_waitcnt(0);
        unsigned nloc = b.st[0], nx = b.st[1];
        if (nloc == 0u) { xcd_barrier_complete(bar, b.x, nloc, nx); b.st[0] = nloc; b.st[1] = nx; }
        const unsigned old = xb_add(&bar[XB_XSUB(b.x)], 1u);
        const unsigned gen = old / nloc;
        if (old + 1u == (gen + 1u) * nloc) {
            __builtin_amdgcn_fence(__ATOMIC_RELEASE, "agent");
            asm volatile("s_waitcnt vmcnt(0)" ::: "memory");
            const unsigned og = xb_add(&bar[XB_TOP], 1u);
            const unsigned tg = og / nx;
            if (og + 1u == (tg + 1u) * nx) xb_add(&bar[XB_TOPGEN], 1u);
            else XB_SPIN(xb_ld(&bar[XB_TOPGEN]) == tg, bar);
            __builtin_amdgcn_fence(__ATOMIC_ACQUIRE, "agent");
            xb_add(&bar[XB_XGEN(b.x)], 1u);
            asm volatile("s_waitcnt vmcnt(0)" ::: "memory");
        } else {
            XB_SPIN(xb_ld(&bar[XB_XGEN(b.x)]) == gen, bar);
            __builtin_amdgcn_fence(__ATOMIC_ACQUIRE, "agent");
            asm volatile("s_waitcnt vmcnt(0)" ::: "memory");
        }
    }
    __syncthreads();
}

__device__ __forceinline__ void p0_transpose_item(const float* W, int K, int N, bf16_t* WT, int drow0, int k0, int n0, LAS float* scr, int lane, const float* gain = nullptr) {
#pragma unroll 8
    for (int i = 0; i < 32; ++i) { const int kk = 2 * i + (lane >> 5); float v = W[(size_t)(k0 + kk) * N + n0 + (lane & 31)]; if (gain) v *= gain[k0 + kk]; scr[kk * 33 + (lane & 31)] = v; }
    LDS_WAIT(); asm volatile("" ::: "memory");
    const int c = lane & 7;
#pragma unroll
    for (int j = 0; j < 4; ++j) { const int n = (lane >> 3) + 8 * j; const LAS float* s = scr + (8 * c) * 33 + n;
        v4u o; o.x = pk2(s[0 * 33], s[1 * 33]); o.y = pk2(s[2 * 33], s[3 * 33]); o.z = pk2(s[4 * 33], s[5 * 33]); o.w = pk2(s[6 * 33], s[7 * 33]);
        *(v4u*)(WT + (size_t)(drow0 + n) * K + k0 + 8 * c) = o; }
    LDS_WAIT(); asm volatile("" ::: "memory");
}
__device__ __forceinline__ void p0_plain(const float* W, int K, int N, bf16_t* WT, int item, LAS float* scr, int lane, const float* gain = nullptr) {
    const int nblk = N / 32, kb = item / nblk, nb = item % nblk;
    p0_transpose_item(W, K, N, WT, 32 * nb, 64 * kb, 32 * nb, scr, lane, gain);
}
__device__ __forceinline__ void p0_transpose_rope(const float* W, bf16_t* WT, int tilebase, int o, int k0, int n0, LAS float* scr, int lane) {
    const int K = 1024, N = NIN;
#pragma unroll 8
    for (int i = 0; i < 32; ++i) { const int kk = 2 * i + (lane >> 5); scr[kk * 33 + (lane & 31)] = W[(size_t)(k0 + kk) * N + n0 + (lane & 31)]; }
    LDS_WAIT(); asm volatile("" ::: "memory");
    const int c = lane & 7;
#pragma unroll
    for (int j = 0; j < 4; ++j) { const int n = (lane >> 3) + 8 * j; const LAS float* s = scr + (8 * c) * 33 + n;
        const int oo = o + n, v = ((oo >> 6) << 6) | (((oo >> 4) & 1) << 5) | (((oo >> 2) & 3) << 3) | (((oo >> 5) & 1) << 2) | (oo & 3);
        v4u w; w.x = pk2(s[0 * 33], s[1 * 33]); w.y = pk2(s[2 * 33], s[3 * 33]); w.z = pk2(s[4 * 33], s[5 * 33]); w.w = pk2(s[6 * 33], s[7 * 33]);
        *(v4u*)(WT + (size_t)(tilebase + v) * K + k0 + 8 * c) = w; }
    LDS_WAIT(); asm volatile("" ::: "memory");
}
__device__ __forceinline__ void rms_row_to_bf16(const float* xrow, const float* g, bf16_t* orow, int lane) {
    const f32x4* xr = (const f32x4*)xrow + lane; const f32x4* gr = (const f32x4*)g + lane;
    f32x4 v[4]; float s = 0.f;
#pragma unroll
    for (int j = 0; j < 4; ++j) { v[j] = xr[64 * j]; s += (v[j].x * v[j].x + v[j].y * v[j].y) + (v[j].z * v[j].z + v[j].w * v[j].w); }
    const float rinv = 1.0f / sqrtf(wave_sum(s) * (1.f / 1024.f) + NORM_EPS);
    v2u* o8 = (v2u*)orow + lane;
#pragma unroll
    for (int j = 0; j < 4; ++j) { const f32x4 gg = gr[64 * j]; v2u w; w.x = pk2(v[j].x * rinv * gg.x, v[j].y * rinv * gg.y); w.y = pk2(v[j].z * rinv * gg.z, v[j].w * rinv * gg.w); o8[64 * j] = w; }
}

template <int NB, class RowPtr, class Epi>
__device__ __forceinline__ void ngemm_tile(const RowPtr& rp, const bf16_t* Bt, int ldb, int b1off, int K, int m0, int n0, int mvalid, const Epi& epi, LAS float* sm) {
    const int t = threadIdx.x, r = t >> 2, kq = (t & 3) * 4, ty = t >> 5, tx = t & 31;
    LAS float* As = sm; LAS float* Bs0 = sm + 16 * 132; LAS float* Bs1 = sm + 32 * 132;
    float acc[NB][8][4];
#pragma unroll
    for (int b = 0; b < NB; ++b)
#pragma unroll
        for (int i = 0; i < 8; ++i)
#pragma unroll
            for (int j = 0; j < 4; ++j) acc[b][i][j] = 0.f;
    const bf16_t* arow = rp(m0 + r) + kq;
    const bf16_t* brow0 = Bt + (size_t)(n0 + r) * ldb + kq;
    const bf16_t* brow1 = Bt + (size_t)(n0 + b1off + r) * ldb + kq;
    for (int k0 = 0; k0 < K; k0 += 16) {
        const v2u av = *(const v2u*)(arow + k0);
        const v2u bv0 = *(const v2u*)(brow0 + k0);
        v2u bv1 = bv0; if (NB == 2) bv1 = *(const v2u*)(brow1 + k0);
        As[(kq + 0) * 132 + r] = lo16(av.x); As[(kq + 1) * 132 + r] = hi16(av.x); As[(kq + 2) * 132 + r] = lo16(av.y); As[(kq + 3) * 132 + r] = hi16(av.y);
        Bs0[(kq + 0) * 132 + r] = lo16(bv0.x); Bs0[(kq + 1) * 132 + r] = hi16(bv0.x); Bs0[(kq + 2) * 132 + r] = lo16(bv0.y); Bs0[(kq + 3) * 132 + r] = hi16(bv0.y);
        if (NB == 2) { Bs1[(kq + 0) * 132 + r] = lo16(bv1.x); Bs1[(kq + 1) * 132 + r] = hi16(bv1.x); Bs1[(kq + 2) * 132 + r] = lo16(bv1.y); Bs1[(kq + 3) * 132 + r] = hi16(bv1.y); }
        __syncthreads();
#pragma unroll 2
        for (int kk = 0; kk < 16; ++kk) {
            const f32x4 a0 = *(const LAS f32x4*)(As + kk * 132 + ty * 8), a1 = *(const LAS f32x4*)(As + kk * 132 + ty * 8 + 4);
            const f32x4 b0 = *(const LAS f32x4*)(Bs0 + kk * 132 + tx * 4);
            const float a[8] = {a0.x, a0.y, a0.z, a0.w, a1.x, a1.y, a1.z, a1.w};
#pragma unroll
            for (int i = 0; i < 8; ++i) { acc[0][i][0] += a[i] * b0.x; acc[0][i][1] += a[i] * b0.y; acc[0][i][2] += a[i] * b0.z; acc[0][i][3] += a[i] * b0.w; }
            if (NB == 2) { const f32x4 b1 = *(const LAS f32x4*)(Bs1 + kk * 132 + tx * 4);
#pragma unroll
                for (int i = 0; i < 8; ++i) { acc[NB - 1][i][0] += a[i] * b1.x; acc[NB - 1][i][1] += a[i] * b1.y; acc[NB - 1][i][2] += a[i] * b1.z; acc[NB - 1][i][3] += a[i] * b1.w; } }
        }
        __syncthreads();
    }
#pragma unroll
    for (int i = 0; i < 8; ++i) { const int m = m0 + ty * 8 + i;
        if (m < mvalid) {
#pragma unroll
            for (int j = 0; j < 4; ++j) epi(m, n0 + tx * 4 + j, acc[0][i][j], acc[NB - 1][i][j]); } }
}
struct RowPlain { const bf16_t* A; int lda; __device__ __forceinline__ const bf16_t* operator()(int m) const { return A + (size_t)m * lda; } };

template <class Epi>
__device__ __forceinline__ void ngemm_dense(const bf16_t* A, int lda, const bf16_t* Bt, int ldb, int Mr, int N, int K, const Epi& epi, LAS float* sm) {
    const int nn = N / 128, nunits = (Mr / 128) * nn; RowPlain rp{A, lda};
    for (int u = blockIdx.x; u < nunits; u += gridDim.x) ngemm_tile<1>(rp, Bt, ldb, 0, K, (u / nn) * 128, (u % nn) * 128, Mr, epi, sm);
}

struct EpiStoreBf16 { bf16_t* O; int ldc; __device__ __forceinline__ void operator()(int m, int n, float a, float) const { O[(size_t)m * ldc + n] = (bf16_t)f2bf(a); } };
struct EpiGate1 { const bf16_t* PR; float* T; __device__ __forceinline__ void operator()(int m, int n, float a, float) const { T[(size_t)m * D + n] = bf2f(PR[(size_t)m * NIN + C_GSB + n]) * a; } };
struct EpiGate2 { const bf16_t* PR; const float* T; bf16_t* MIX; __device__ __forceinline__ void operator()(int m, int n, float a, float) const {
    MIX[(size_t)m * D + n] = (bf16_t)f2bf(T[(size_t)m * D + n] + bf2f(PR[(size_t)m * NIN + C_GDF + n]) * a); } };
struct EpiResid { const float* base; float* out; __device__ __forceinline__ void operator()(int m, int n, float a, float) const { out[(size_t)m * D + n] = base[(size_t)m * D + n] + a; } };


namespace pg8 {
constexpr int BM = 256, BK = 64, HALF = 128, HTB = HALF * BK * 2, STAGE_BYTES = 8 * HTB;
__host__ __device__ __forceinline__ int lds_byte(int r, int c) { const int st = (r >> 4) * 2 + (c >> 5), rr = r & 15, cc = c & 31, ob = rr * 64 + cc * 2; return st * 1024 + (ob ^ (((ob >> 9) & 1) << 5)); }
__host__ __device__ __forceinline__ void stage_rc(int b, int& R, int& C) { const int st = b / 1024, sb = b % 1024, swz = sb ^ (((sb >> 9) & 1) << 5); R = (st >> 1) * 16 + swz / 64; C = (st & 1) * 32 + (swz % 64) / 2; }
__host__ __device__ __forceinline__ int perm32(int rho) { const int n = rho >> 4, i = rho & 15; return 8 * (i >> 2) + 4 * n + (i & 3); }
struct Unit { int pm, pn, e; };
struct Gemm { const bf16_t* A; const bf16_t* Bt; int lda, ldb, K; };
typedef float f32x2 __attribute__((ext_vector_type(2))); typedef __bf16 bf16x2_t __attribute__((ext_vector_type(2)));
__device__ __forceinline__ unsigned cvt_pk_bf16(float lo, float hi) { f32x2 v = {lo, hi}; bf16x2_t b = __builtin_convertvector(v, bf16x2_t); return __builtin_bit_cast(unsigned, b); }

template <class Epi, class Sched, bool GATHER>
__device__ __forceinline__ void gemm_phase(LAS unsigned char* lds, const Gemm g, const Sched& S, const Epi& E) {
    const int tid = threadIdx.x, wid = __builtin_amdgcn_readfirstlane(tid >> 6), lane = tid & 63, wr = wid >> 2, wc = wid & 3, fr = lane & 15, fq = lane >> 4;
    const int K = g.K, nt = K / BK;
    unsigned voffB[2], cva[2][2], nva[2][2]; int Rr[2], Cc[2];
#pragma unroll
    for (int i = 0; i < 2; ++i) { int R, C; stage_rc(tid * 16 + i * 8192, R, C); Rr[i] = R; Cc[i] = C; const int Rb = (R & ~31) + perm32(R & 31);
        voffB[i] = (unsigned)(Rb * g.ldb + C) * 2u;
#pragma unroll
        for (int h = 0; h < 2; ++h) { cva[h][i] = (unsigned)((h * HALF + R) * g.lda + C) * 2u; nva[h][i] = cva[h][i]; } }
    const size_t kstep = (size_t)(BK * 2);
    const size_t hstepB = (size_t)HALF * g.ldb * 2;
    const unsigned ldsw = (unsigned)wid * 1024u;
    const int aoff = lds_byte(wr * 64 + fr, fq * 8), boff = lds_byte(wc * 32 + fr, fq * 8);
#define PG8_SA(b, h) (((b) * 2 + (h)) * HTB)
#define PG8_SB(b, h) ((4 + (b) * 2 + (h)) * HTB)
#define PG8_STAGE(bufoff, gbase, voff) do { _Pragma("unroll") for (int _i = 0; _i < 2; ++_i) \
        __builtin_amdgcn_global_load_lds((const unsigned*)((const char*)(gbase) + (voff)[_i]), (LAS unsigned*)(lds + (bufoff) + ldsw + _i * 8192), 16, 0, 0); } while (0)
#define PG8_LDA(dst, b, h) do { _Pragma("unroll") for (int m = 0; m < 4; ++m) _Pragma("unroll") for (int k = 0; k < 2; ++k) dst[m][k] = *(const LAS bf16x8*)(lds + PG8_SA(b, h) + aoff + m * 2048 + k * 1024); } while (0)
#define PG8_LDB(dst, b, h) do { _Pragma("unroll") for (int n = 0; n < 2; ++n) _Pragma("unroll") for (int k = 0; k < 2; ++k) dst[n][k] = *(const LAS bf16x8*)(lds + PG8_SB(b, h) + boff + n * 2048 + k * 1024); } while (0)
#define PG8_MMA(ai, bj, At, Bt) do { __builtin_amdgcn_s_setprio(1); _Pragma("unroll") for (int m = 0; m < 4; ++m) _Pragma("unroll") for (int n = 0; n < 2; ++n) _Pragma("unroll") for (int k = 0; k < 2; ++k) \
        acc[ai][bj][m][n] = __builtin_amdgcn_mfma_f32_16x16x32_bf16(Bt[n][k], At[m][k], acc[ai][bj][m][n], 0, 0, 0); __builtin_amdgcn_s_setprio(0); } while (0)
#define PG8_WAIT_V(n) asm volatile("s_waitcnt vmcnt(" #n ")" ::: "memory")
#define PG8_WAIT_L(n) asm volatile("s_waitcnt lgkmcnt(" #n ")" ::: "memory")
#define PG8_BAR __builtin_amdgcn_s_barrier()
#define PG8_SCHED __builtin_amdgcn_sched_barrier(0)
    Unit cur, nxt; int ui = 0;
    if (!S.next(0, cur)) return;
    if constexpr (GATHER) {
#pragma unroll
        for (int i = 0; i < 2; ++i)
#pragma unroll
            for (int h = 0; h < 2; ++h) cva[h][i] = (unsigned)(S.tok(cur, h * HALF + Rr[i]) * g.lda + Cc[i]) * 2u;
    }
    f32x4 acc[2][2][4][2];
#pragma unroll
    for (int a = 0; a < 2; ++a)
#pragma unroll
        for (int b = 0; b < 2; ++b)
#pragma unroll
            for (int m = 0; m < 4; ++m)
#pragma unroll
                for (int n = 0; n < 2; ++n) acc[a][b][m][n] = (f32x4){0.f, 0.f, 0.f, 0.f};
    bf16x8 At[4][2], B0[2][2], B1[2][2];
    const char* cA = (const char*)g.A + (GATHER ? (size_t)0 : S.a_off(cur)); const char* cB = (const char*)g.Bt + S.b_off(cur);
    PG8_STAGE(PG8_SB(0, 0), cB, voffB); PG8_STAGE(PG8_SB(0, 1), cB + hstepB, voffB); PG8_STAGE(PG8_SA(0, 0), cA, cva[0]); PG8_STAGE(PG8_SA(0, 1), cA, cva[1]);
    if (wr == 1) PG8_BAR;
    PG8_WAIT_V(2); PG8_BAR;
    PG8_STAGE(PG8_SB(1, 0), cB + kstep, voffB); PG8_STAGE(PG8_SA(1, 0), cA + kstep, cva[0]); PG8_STAGE(PG8_SB(1, 1), cB + hstepB + kstep, voffB);
    PG8_WAIT_V(6); PG8_BAR;
    for (;;) {
        const bool has_next = S.next(ui + 1, nxt);
        const char* nA = (has_next && !GATHER) ? (const char*)g.A + S.a_off(nxt) : cA; const char* nB = has_next ? (const char*)g.Bt + S.b_off(nxt) : cB;
        if constexpr (GATHER) {
#pragma unroll
            for (int i = 0; i < 2; ++i)
#pragma unroll
                for (int h = 0; h < 2; ++h) nva[h][i] = has_next ? (unsigned)(S.tok(nxt, h * HALF + Rr[i]) * g.lda + Cc[i]) * 2u : cva[h][i];
        }
        for (int t = 0; t < nt; t += 2) {
            const bool last = (t == nt - 2);
            const char* a1 = cA + (size_t)(t + 1) * kstep;
            const char* a2 = last ? nA : cA + (size_t)(t + 2) * kstep; const char* b2 = last ? nB : cB + (size_t)(t + 2) * kstep;
            const char* a3 = a2 + kstep; const char* b3 = b2 + kstep;
            unsigned v2[2][2];
#pragma unroll
            for (int h = 0; h < 2; ++h)
#pragma unroll
                for (int i = 0; i < 2; ++i) v2[h][i] = (GATHER && last) ? nva[h][i] : cva[h][i];
            PG8_LDB(B0, 0, 0); PG8_LDB(B1, 0, 1); PG8_SCHED; PG8_LDA(At, 0, 0); PG8_STAGE(PG8_SA(1, 1), a1, cva[1]);
            PG8_WAIT_V(8); PG8_WAIT_L(0); PG8_BAR; PG8_MMA(0, 0, At, B0); PG8_MMA(0, 1, At, B1); PG8_BAR; PG8_SCHED;
            PG8_LDA(At, 0, 1); PG8_STAGE(PG8_SB(0, 0), b2, voffB); PG8_STAGE(PG8_SB(0, 1), b2 + hstepB, voffB); PG8_STAGE(PG8_SA(0, 0), a2, v2[0]);
            PG8_WAIT_V(8); PG8_WAIT_L(0); PG8_BAR; PG8_MMA(1, 0, At, B0); PG8_MMA(1, 1, At, B1); PG8_BAR; PG8_SCHED;
            PG8_LDB(B0, 1, 0); PG8_LDB(B1, 1, 1); PG8_SCHED; PG8_LDA(At, 1, 0); PG8_STAGE(PG8_SA(0, 1), a2, v2[1]);
            PG8_WAIT_V(8); PG8_WAIT_L(0); PG8_BAR; PG8_MMA(0, 0, At, B0); PG8_MMA(0, 1, At, B1); PG8_BAR; PG8_SCHED;
            PG8_LDA(At, 1, 1); PG8_STAGE(PG8_SB(1, 0), b3, voffB); PG8_STAGE(PG8_SB(1, 1), b3 + hstepB, voffB); PG8_STAGE(PG8_SA(1, 0), a3, v2[0]);
            PG8_WAIT_V(8); PG8_WAIT_L(0); PG8_BAR; PG8_MMA(1, 0, At, B0); PG8_MMA(1, 1, At, B1); PG8_BAR; PG8_SCHED;
        }
        if (wr == 0) PG8_BAR;
        E(acc, cur, wr, wc, fr, fq);
        if (!has_next) break;
#pragma unroll
        for (int a = 0; a < 2; ++a)
#pragma unroll
            for (int b = 0; b < 2; ++b)
#pragma unroll
                for (int m = 0; m < 4; ++m)
#pragma unroll
                    for (int n = 0; n < 2; ++n) acc[a][b][m][n] = (f32x4){0.f, 0.f, 0.f, 0.f};
        cur = nxt; cA = nA; cB = nB; ++ui;
        if constexpr (GATHER) {
#pragma unroll
            for (int i = 0; i < 2; ++i)
#pragma unroll
                for (int h = 0; h < 2; ++h) cva[h][i] = nva[h][i];
        }
        if (wr == 1) PG8_BAR;
    }
    PG8_WAIT_V(0);
    PG8_BAR;
#undef PG8_SA
#undef PG8_SB
#undef PG8_STAGE
#undef PG8_LDA
#undef PG8_LDB
#undef PG8_MMA
#undef PG8_WAIT_V
#undef PG8_WAIT_L
#undef PG8_BAR
#undef PG8_SCHED
}

struct DenseOrder {
    int nM, nN, nwg, G, c, lda, ldb;
    __device__ __forceinline__ void init(int M_, int N_, int G_, int c_, int lda_, int ldb_) { nM = M_ / BM; nN = N_ / BM; nwg = nM * nN; G = G_; c = c_; lda = lda_; ldb = ldb_; }
    __device__ __forceinline__ bool next(int i, Unit& u) const {
        const long L = (long)i * G + c; if (L >= nwg) return false;
        int wgid = (int)L; { const int q = nwg / 8, r = nwg % 8, xcd = wgid % 8, off = wgid / 8; wgid = (xcd < r ? xcd * (q + 1) : r * (q + 1) + (xcd - r) * q) + off; }
        const int nig = 8 * nN, gid = wgid / nig, fm = gid * 8, gsz = (nM - fm) < 8 ? (nM - fm) : 8;
        u.pm = fm + ((wgid % nig) % gsz); u.pn = (wgid % nig) / gsz; u.e = 0; return true;
    }
    __device__ __forceinline__ size_t a_off(const Unit& u) const { return (size_t)u.pm * BM * lda * 2; }
    __device__ __forceinline__ size_t b_off(const Unit& u) const { return (size_t)u.pn * BM * ldb * 2; }
    __device__ __forceinline__ int tok(const Unit&, int) const { return 0; }
};
struct TwoRoundOrder {
    int G, c, lda, ldb;
    __device__ __forceinline__ bool next(int i, Unit& u) const { const int L = i * G + c; if (L >= 512) return false; const int tile = L & 255; u.pm = tile >> 2; u.pn = tile & 3; u.e = L >> 8; return true; }
    __device__ __forceinline__ size_t a_off(const Unit& u) const { return (size_t)u.pm * BM * lda * 2 + (size_t)u.e * 1024; }
    __device__ __forceinline__ size_t b_off(const Unit& u) const { return (size_t)(u.e * 1024 + u.pn * BM) * ldb * 2; }
    __device__ __forceinline__ int tok(const Unit&, int) const { return 0; }
};
struct MoeOrder {
    const LAS int* tb; const int* tlist; int G, c, npn, lda, ldb, nexp;
    __device__ __forceinline__ bool next(int i, Unit& u) const {
        const int L = i * G + c; if (L >= tb[96]) return false;
        int e = 0; while (tb[65 + e] <= L) ++e;
        const int loc = L - tb[64 + e]; u.e = e; u.pn = loc % npn; u.pm = (tb[e] >> 8) + loc / npn; return true;
    }
    __device__ __forceinline__ size_t a_off(const Unit& u) const { return (size_t)u.pm * BM * lda * 2; }
    __device__ __forceinline__ size_t b_off(const Unit& u) const { return (size_t)(u.e * nexp + u.pn * BM) * ldb * 2; }
    __device__ __forceinline__ int tok(const Unit& u, int row) const { const int r = u.pm * BM - tb[u.e] + row; return r < tb[32 + u.e] ? tlist[u.e * LISTCAP + r] : 0; }
};

#define EPI_ARGS const f32x4 (&acc)[2][2][4][2], const Unit& u, int wr, int wc, int fr, int fq
#define EPI_FOR_ROWS for (int ai = 0; ai < 2; ++ai) _Pragma("unroll") for (int m = 0; m < 4; ++m)
__device__ __forceinline__ v4u pack8(const f32x4 a, const f32x4 b) { v4u w; w.x = cvt_pk_bf16(a[0], a[1]); w.y = cvt_pk_bf16(a[2], a[3]); w.z = cvt_pk_bf16(b[0], b[1]); w.w = cvt_pk_bf16(b[2], b[3]); return w; }
__device__ __forceinline__ void unpack8(const v4u w, f32x4& a, f32x4& b) { a = (f32x4){lo16(w.x), hi16(w.x), lo16(w.y), hi16(w.y)}; b = (f32x4){lo16(w.z), hi16(w.z), lo16(w.w), hi16(w.w)}; }
__device__ __forceinline__ float sigm(float v) { return __builtin_amdgcn_rcpf(1.f + __expf(-v)); }

__device__ __forceinline__ void store_tile_T(const f32x4 (&acc)[2][2][4][2], bf16_t* VT, int vrow0, int s0, int pitch) {
#pragma unroll
    for (int bj = 0; bj < 2; ++bj)
#pragma unroll
        for (int n = 0; n < 2; ++n)
#pragma unroll
            for (int e = 0; e < 4; ++e) { bf16_t* vp = VT + (size_t)(vrow0 + 128 * bj + 4 * n + e) * pitch + s0;
#pragma unroll
                for (int ai = 0; ai < 2; ++ai)
#pragma unroll
                    for (int m = 0; m < 4; ++m) vp[128 * ai + 16 * m] = (bf16_t)(cvt_pk_bf16(acc[ai][bj][m][n][e], 0.f) & 0xffffu); }
}
struct EpiKV { bf16_t* KVM; bf16_t* VTM;
    __device__ __forceinline__ void operator()(EPI_ARGS) const {
        const int row0 = u.pm * BM + wr * 64 + fr, col0 = u.pn * BM + wc * 32 + 8 * fq;
#pragma unroll
        EPI_FOR_ROWS { bf16_t* rowp = KVM + (size_t)(row0 + ai * HALF + m * 16) * 2048 + col0;
#pragma unroll
            for (int bj = 0; bj < 2; ++bj) *(v4u*)(rowp + bj * HALF) = pack8(acc[ai][bj][m][0], acc[ai][bj][m][1]); }
        if (u.pn >= 4) store_tile_T(acc, VTM, u.pm * 1024 + (u.pn - 4) * BM + wc * 32 + 8 * fq, wr * 64 + fr, MEMLEN);
    } };
struct EpiBf16Store { bf16_t* O; int ldc;
    __device__ __forceinline__ void operator()(EPI_ARGS) const {
        const int row0 = u.pm * BM + wr * 64 + fr, col0 = u.pn * BM + wc * 32 + 8 * fq;
#pragma unroll
        EPI_FOR_ROWS { bf16_t* rowp = O + (size_t)(row0 + ai * HALF + m * 16) * ldc + col0;
#pragma unroll
            for (int bj = 0; bj < 2; ++bj) *(v4u*)(rowp + bj * HALF) = pack8(acc[ai][bj][m][0], acc[ai][bj][m][1]); }
    } };
struct EpiResidF32 { const float* base; float* out;
    __device__ __forceinline__ void operator()(EPI_ARGS) const {
        const int row0 = u.pm * BM + wr * 64 + fr, col0 = u.pn * BM + wc * 32 + 8 * fq;
#pragma unroll
        EPI_FOR_ROWS { const size_t off = (size_t)(row0 + ai * HALF + m * 16) * D + col0;
#pragma unroll
            for (int bj = 0; bj < 2; ++bj)
#pragma unroll
                for (int n = 0; n < 2; ++n) { const f32x4 b = *(const f32x4*)(base + off + bj * HALF + 4 * n); *(f32x4*)(out + off + bj * HALF + 4 * n) = b + acc[ai][bj][m][n]; } }
    } };
struct EpiResidNorm { const float* base; float* out; bf16_t* XB; float* SSQ;
    __device__ __forceinline__ void operator()(EPI_ARGS) const {
        const int row0 = u.pm * BM + wr * 64 + fr, col0 = u.pn * BM + wc * 32 + 8 * fq;
#pragma unroll
        EPI_FOR_ROWS { const int row = row0 + ai * HALF + m * 16; const size_t off = (size_t)row * D + col0; float ss = 0.f;
#pragma unroll
            for (int bj = 0; bj < 2; ++bj) { f32x4 v[2];
#pragma unroll
                for (int n = 0; n < 2; ++n) { v[n] = *(const f32x4*)(base + off + bj * HALF + 4 * n) + acc[ai][bj][m][n]; *(f32x4*)(out + off + bj * HALF + 4 * n) = v[n];
                    ss += (v[n][0] * v[n][0] + v[n][1] * v[n][1]) + (v[n][2] * v[n][2] + v[n][3] * v[n][3]); }
                *(v4u*)(XB + off + bj * HALF) = pack8(v[0], v[1]); }
            ss += __shfl_xor(ss, 16); ss += __shfl_xor(ss, 32);
            if (fq == 0) SSQ[(size_t)row * 16 + u.pn * 4 + wc] = ss; }
    } };
struct EpiBf16Rinv { bf16_t* O; const float* SSQ;
    __device__ __forceinline__ void operator()(EPI_ARGS) const {
        const int row0 = u.pm * BM + wr * 64 + fr, col0 = u.pn * BM + wc * 32 + 8 * fq;
#pragma unroll
        EPI_FOR_ROWS { const int row = row0 + ai * HALF + m * 16; const f32x4* sp = (const f32x4*)(SSQ + (size_t)row * 16);
            const f32x4 s0 = sp[0], s1 = sp[1], s2 = sp[2], s3 = sp[3];
            const float tot = (((s0[0] + s0[1]) + (s0[2] + s0[3])) + ((s1[0] + s1[1]) + (s1[2] + s1[3]))) + (((s2[0] + s2[1]) + (s2[2] + s2[3])) + ((s3[0] + s3[1]) + (s3[2] + s3[3])));
            const float rinv = 1.0f / sqrtf(tot * (1.f / 1024.f) + NORM_EPS);
            bf16_t* rowp = O + (size_t)row * D + col0;
#pragma unroll
            for (int bj = 0; bj < 2; ++bj) *(v4u*)(rowp + bj * HALF) = pack8(acc[ai][bj][m][0] * rinv, acc[ai][bj][m][1] * rinv); }
    } };
struct OneUnitOrder {
    int idx, lda, ldb;
    __device__ __forceinline__ bool next(int i, Unit& u) const { if (i > 0) return false; u.pm = idx >> 3; u.pn = idx & 7; u.e = 0; return true; }
    __device__ __forceinline__ size_t a_off(const Unit& u) const { return (size_t)u.pm * BM * lda * 2; }
    __device__ __forceinline__ size_t b_off(const Unit& u) const { return (size_t)u.pn * BM * ldb * 2; }
    __device__ __forceinline__ int tok(const Unit&, int) const { return 0; }
};
struct EpiGate { const bf16_t* PR; float* T; bf16_t* MIX;
    __device__ __forceinline__ void operator()(EPI_ARGS) const {
        const int row0 = u.pm * BM + wr * 64 + fr, col0 = u.pn * BM + wc * 32 + 8 * fq;
#pragma unroll
        EPI_FOR_ROWS { const int row = row0 + ai * HALF + m * 16;
#pragma unroll
            for (int bj = 0; bj < 2; ++bj) { const int col = col0 + bj * HALF; f32x4 g0, g1;
                unpack8(*(const v4u*)(PR + (size_t)row * NIN + (u.e ? C_GDF : C_GSB) + col), g0, g1);
                float* tp = T + (size_t)row * D + col;
                if (u.e == 0) { *(f32x4*)tp = g0 * acc[ai][bj][m][0]; *(f32x4*)(tp + 4) = g1 * acc[ai][bj][m][1]; }
                else { const f32x4 t0 = *(const f32x4*)tp, t1 = *(const f32x4*)(tp + 4); *(v4u*)(MIX + (size_t)row * D + col) = pack8(t0 + g0 * acc[ai][bj][m][0], t1 + g1 * acc[ai][bj][m][1]); } } }
    } };
struct EpiInProj { bf16_t* PR; const float* rc; const float* rs; bf16_t* VTSB; bf16_t* VTDF;
    __device__ __forceinline__ void operator()(EPI_ARGS) const {
        const int row0 = u.pm * BM + wr * 64 + fr, pn = u.pn;
        if (pn >= 6 && pn < 10) {
            const float sc = pn < 8 ? 0.125f : 1.0f; const int i0 = 16 * (wc & 1) + 4 * fq;
#pragma unroll
            EPI_FOR_ROWS { const int row = row0 + ai * HALF + m * 16; const f32x4 cs = *(const f32x4*)(rc + (size_t)row * 32 + i0), sn = *(const f32x4*)(rs + (size_t)row * 32 + i0);
#pragma unroll
                for (int bj = 0; bj < 2; ++bj) { const f32x4 lo = acc[ai][bj][m][0], hi = acc[ai][bj][m][1];
                    const f32x4 olo = (lo * cs - hi * sn) * sc, ohi = (hi * cs + lo * sn) * sc;
                    bf16_t* p = PR + (size_t)row * NIN + pn * BM + 64 * (2 * bj + (wc >> 1)) + i0;
                    v2u a, b; a.x = cvt_pk_bf16(olo[0], olo[1]); a.y = cvt_pk_bf16(olo[2], olo[3]); b.x = cvt_pk_bf16(ohi[0], ohi[1]); b.y = cvt_pk_bf16(ohi[2], ohi[3]);
                    *(v2u*)p = a; *(v2u*)(p + 32) = b; } }
        } else {
            const int col0 = pn * BM + wc * 32 + 8 * fq; const float sc = pn < 2 ? 0.125f : 1.0f; const bool sg = pn >= 12;
#pragma unroll
            EPI_FOR_ROWS { bf16_t* rowp = PR + (size_t)(row0 + ai * HALF + m * 16) * NIN + col0;
#pragma unroll
                for (int bj = 0; bj < 2; ++bj) { f32x4 v0 = acc[ai][bj][m][0] * sc, v1 = acc[ai][bj][m][1] * sc;
                    if (sg) { v0 = (f32x4){sigm(v0[0]), sigm(v0[1]), sigm(v0[2]), sigm(v0[3])}; v1 = (f32x4){sigm(v1[0]), sigm(v1[1]), sigm(v1[2]), sigm(v1[3])}; }
                    *(v4u*)(rowp + bj * HALF) = pack8(v0, v1); } }
            if (pn == 4 || pn == 5 || pn == 10 || pn == 11) {
                const int bb = u.pm >> 4, s0 = (u.pm & 15) * BM + wr * 64 + fr, hd0 = (pn < 6 ? (pn - 4) : (pn - 10)) * BM + wc * 32 + 8 * fq;
                store_tile_T(acc, pn < 6 ? VTSB : VTDF, bb * 512 + hd0, s0, SEQ);
            }
        }
    } };
struct EpiMoeGU { bf16_t* ACT; const float* bgu;
    __device__ __forceinline__ void operator()(EPI_ARGS) const {
        const int row0 = u.pm * BM + wr * 64 + fr, j0 = u.pn * 128 + wc * 32 + 8 * fq; const float* bg = bgu + (size_t)u.e * 2048 + j0;
        const f32x4 bg0 = *(const f32x4*)bg, bg1 = *(const f32x4*)(bg + 4), bl0 = *(const f32x4*)(bg + 1024), bl1 = *(const f32x4*)(bg + 1028);
#pragma unroll
        EPI_FOR_ROWS { f32x4 o[2];
#pragma unroll
            for (int n = 0; n < 2; ++n) { const f32x4 gv = acc[ai][0][m][n] + (n ? bg1 : bg0), lv = acc[ai][1][m][n] + (n ? bl1 : bl0);
#pragma unroll
                for (int c = 0; c < 4; ++c) { const float gl = fminf(gv[c], 7.0f), li = fminf(fmaxf(lv[c], -7.0f), 7.0f); o[n][c] = gl * sigm(1.702f * gl) * (li + 1.0f); } }
            *(v4u*)(ACT + (size_t)(row0 + ai * HALF + m * 16) * DFF + j0) = pack8(o[0], o[1]); }
    } };
struct EpiMoeDown { bf16_t* YB; const float* bd; const float* glist; const LAS int* tb;
    __device__ __forceinline__ void operator()(EPI_ARGS) const {
        const int row0 = u.pm * BM + wr * 64 + fr, col0 = u.pn * BM + wc * 32 + 8 * fq; const float* bp = bd + (size_t)u.e * D + col0;
        const float* gl = glist + (size_t)u.e * LISTCAP - tb[u.e];
        f32x4 bv[2][2];
#pragma unroll
        for (int bj = 0; bj < 2; ++bj)
#pragma unroll
            for (int n = 0; n < 2; ++n) bv[bj][n] = *(const f32x4*)(bp + bj * HALF + 4 * n);
#pragma unroll
        EPI_FOR_ROWS { const int row = row0 + ai * HALF + m * 16; const float gt = gl[row];
#pragma unroll
            for (int bj = 0; bj < 2; ++bj) *(v4u*)(YB + (size_t)row * D + col0 + bj * HALF) = pack8((acc[ai][bj][m][0] + bv[bj][0]) * gt, (acc[ai][bj][m][1] + bv[bj][1]) * gt); }
    } };
}


typedef float f32x16 __attribute__((ext_vector_type(16)));
typedef short s16x4 __attribute__((ext_vector_type(4)));
__device__ __forceinline__ f32x16 mfma32(bf16x8 a, bf16x8 b, f32x16 c) { return __builtin_amdgcn_mfma_f32_32x32x16_bf16(a, b, c, 0, 0, 0); }
__device__ __forceinline__ float xhalf(float v, int hh) { auto rr = __builtin_amdgcn_permlane32_swap(__float_as_uint(v), __float_as_uint(v), false, false); return __uint_as_float(hh ? rr[0] : rr[1]); }
__device__ __forceinline__ bf16x8 vt_frag(const bf16_t* p) { const s16x4 lo = *(const s16x4*)p, hi = *(const s16x4*)(p + 8); return (bf16x8){lo[0], lo[1], lo[2], lo[3], hi[0], hi[1], hi[2], hi[3]}; }
__device__ __forceinline__ bf16x8 pack_p(const f32x16& p, int s) { v4u w; w.x = pg8::cvt_pk_bf16(p[8 * s + 0], p[8 * s + 1]); w.y = pg8::cvt_pk_bf16(p[8 * s + 2], p[8 * s + 3]); w.z = pg8::cvt_pk_bf16(p[8 * s + 4], p[8 * s + 5]); w.w = pg8::cvt_pk_bf16(p[8 * s + 6], p[8 * s + 7]); return __builtin_bit_cast(bf16x8, w); }
constexpr float LOG2E = 1.4426950408889634f;

template <int NO>
__device__ __forceinline__ void softmax_step(f32x16& S, float C, float& m, float& l, f32x16 (&O)[NO], int hh) {
    float mx = fmaxf(fmaxf(S[0], S[1]), fmaxf(S[2], S[3]));
#pragma unroll
    for (int i = 4; i < 16; i += 4) mx = fmaxf(mx, fmaxf(fmaxf(S[i], S[i + 1]), fmaxf(S[i + 2], S[i + 3])));
    mx = fmaxf(mx, xhalf(mx, hh)) * C;
    const float mn = fmaxf(m, mx), al = __builtin_amdgcn_exp2f(m - mn);
    m = mn; l *= al;
#pragma unroll
    for (int o = 0; o < NO; ++o) O[o] = O[o] * al;
    float ps = 0.f;
#pragma unroll
    for (int i = 0; i < 16; ++i) { S[i] = __builtin_amdgcn_exp2f(S[i] * C - mn); ps += S[i]; }
    l += ps;
}

__device__ __forceinline__ void attn_diff_wave(const bf16_t* PR, const bf16_t* VT, float* ODR, int b, int h, int j, int q0, int lane) {
    const int r32 = lane & 31, hh = lane >> 5;
    const bf16_t* qrow = PR + (size_t)(b * SEQ + q0 + r32) * NIN + C_DQ + h * 128 + j * 64 + 8 * hh;
    bf16x8 qf[4];
#pragma unroll
    for (int d0 = 0; d0 < 4; ++d0) qf[d0] = *(const bf16x8*)(qrow + 16 * d0);
    const bf16_t* kbase = PR + (size_t)(b * SEQ + r32) * NIN + C_DK + h * 128 + j * 64 + 8 * hh;
    const bf16_t* vbase = VT + (size_t)(b * 512 + h * 128 + r32) * SEQ + 4 * hh;
    f32x16 O[4];
#pragma unroll
    for (int o = 0; o < 4; ++o)
#pragma unroll
        for (int i = 0; i < 16; ++i) O[o][i] = 0.f;
    float m = -INFINITY, l = 0.f;
    const int nt = 2 * (q0 / 64 + 1);
    for (int t = 0; t < nt; ++t) {
        const bf16_t* kp = kbase + (size_t)(32 * t) * NIN;
        f32x16 S;
#pragma unroll
        for (int i = 0; i < 16; ++i) S[i] = 0.f;
#pragma unroll
        for (int d0 = 0; d0 < 4; ++d0) S = mfma32(*(const bf16x8*)(kp + 16 * d0), qf[d0], S);
        softmax_step<4>(S, LOG2E, m, l, O, hh);
        const bf16x8 p0 = pack_p(S, 0), p1 = pack_p(S, 1);
        const bf16_t* vp = vbase + 32 * t;
#pragma unroll
        for (int o = 0; o < 4; ++o) { O[o] = mfma32(vt_frag(vp + (size_t)(32 * o) * SEQ), p0, O[o]); O[o] = mfma32(vt_frag(vp + (size_t)(32 * o) * SEQ + 16), p1, O[o]); }
    }
    l += xhalf(l, hh);
    const float il = 1.f / l;
    float* orow = ODR + ((size_t)j * M + (size_t)b * SEQ + q0 + r32) * 512 + h * 128 + 4 * hh;
#pragma unroll
    for (int o = 0; o < 4; ++o)
#pragma unroll
        for (int g = 0; g < 4; ++g) *(f32x4*)(orow + 32 * o + 8 * g) = (f32x4){O[o][4 * g] * il, O[o][4 * g + 1] * il, O[o][4 * g + 2] * il, O[o][4 * g + 3] * il};
}

__device__ __forceinline__ void attn_sb_wave(const bf16_t* PR, const bf16_t* VT, bf16_t* OAT, int b, int h, int q0, int lane) {
    const int r32 = lane & 31, hh = lane >> 5;
    const bf16_t* qrow = PR + (size_t)(b * SEQ + q0 + r32) * NIN + C_SBQ + h * 64 + 8 * hh;
    bf16x8 qf[4];
#pragma unroll
    for (int d0 = 0; d0 < 4; ++d0) qf[d0] = *(const bf16x8*)(qrow + 16 * d0);
    const bf16_t* kbase = PR + (size_t)(b * SEQ + r32) * NIN + C_SBK + h * 64 + 8 * hh;
    const bf16_t* vbase = VT + (size_t)(b * 512 + h * 64 + r32) * SEQ + 4 * hh;
    f32x16 O[2];
#pragma unroll
    for (int o = 0; o < 2; ++o)
#pragma unroll
        for (int i = 0; i < 16; ++i) O[o][i] = 0.f;
    float R = 0.f;
    const int td = q0 >> 5;
    for (int t = td; t >= 0; --t) {
        const bf16_t* kp = kbase + (size_t)(32 * t) * NIN;
        f32x16 S;
#pragma unroll
        for (int i = 0; i < 16; ++i) S[i] = 0.f;
#pragma unroll
        for (int d0 = 0; d0 < 4; ++d0) S = mfma32(*(const bf16x8*)(kp + 16 * d0), qf[d0], S);
        f32x16 lr;
#pragma unroll
        for (int i = 0; i < 16; ++i) { const float z2 = S[i] * LOG2E; const float sp = fmaxf(z2, 0.f) + __builtin_amdgcn_logf(1.f + __builtin_amdgcn_exp2f(-fabsf(z2)));
            lr[i] = -sp; S[i] = z2 - sp; }
        if (t == td) {
#pragma unroll
            for (int i = 0; i < 16; ++i) { const int kvl = (i & 3) + 8 * (i >> 2) + 4 * hh; if (kvl >= r32) { lr[i] = 0.f; S[i] = -INFINITY; } }
        }
        float tot[4], pt[4], off[4];
        f32x16 ex;
#pragma unroll
        for (int g = 0; g < 4; ++g) { ex[4 * g + 3] = 0.f; ex[4 * g + 2] = lr[4 * g + 3]; ex[4 * g + 1] = lr[4 * g + 3] + lr[4 * g + 2]; ex[4 * g] = ex[4 * g + 1] + lr[4 * g + 1]; tot[g] = ex[4 * g] + lr[4 * g]; }
#pragma unroll
        for (int g = 0; g < 4; ++g) pt[g] = xhalf(tot[g], hh);
        const float own0 = hh ? 0.f : 1.f;
        float sp_ = 0.f;
#pragma unroll
        for (int g = 3; g >= 0; --g) { off[g] = sp_ + own0 * pt[g] + R; sp_ += tot[g] + pt[g]; }
#pragma unroll
        for (int i = 0; i < 16; ++i) S[i] = __builtin_amdgcn_exp2f(S[i] + ex[i] + off[i >> 2]);
        R += sp_;
        const bf16x8 p0 = pack_p(S, 0), p1 = pack_p(S, 1);
        const bf16_t* vp = vbase + 32 * t;
#pragma unroll
        for (int o = 0; o < 2; ++o) { O[o] = mfma32(vt_frag(vp + (size_t)(32 * o) * SEQ), p0, O[o]); O[o] = mfma32(vt_frag(vp + (size_t)(32 * o) * SEQ + 16), p1, O[o]); }
        if (__all(R < -160.f)) break;
    }
    bf16_t* orow = OAT + (size_t)(b * SEQ + q0 + r32) * D + h * 64 + 4 * hh;
#pragma unroll
    for (int o = 0; o < 2; ++o)
#pragma unroll
        for (int g = 0; g < 4; ++g) { v2u w; w.x = pg8::cvt_pk_bf16(O[o][4 * g], O[o][4 * g + 1]); w.y = pg8::cvt_pk_bf16(O[o][4 * g + 2], O[o][4 * g + 3]); *(v2u*)(orow + 32 * o + 8 * g) = w; }
}

__device__ __forceinline__ void attn_mem_wave(const bf16_t* QM, const bf16_t* KVM, const bf16_t* VT, bf16_t* OM, int b, int h, int q0, int lane) {
    const int r32 = lane & 31, hh = lane >> 5;
    const bf16_t* qrow = QM + (size_t)(b * SEQ + q0 + r32) * D + h * 256 + 8 * hh;
    const bf16_t* kbase = KVM + (size_t)(b * MEMLEN + r32) * 2048 + h * 256 + 8 * hh;
    for (int dh = 0; dh < 2; ++dh) {
        const bf16_t* vbase = VT + (size_t)(b * 1024 + h * 256 + dh * 128 + r32) * MEMLEN + 4 * hh;
        f32x16 O[4];
#pragma unroll
        for (int o = 0; o < 4; ++o)
#pragma unroll
            for (int i = 0; i < 16; ++i) O[o][i] = 0.f;
        float m = -INFINITY, l = 0.f;
        for (int t = 0; t < 8; ++t) {
            const bf16_t* kp = kbase + (size_t)(32 * t) * 2048;
            f32x16 S;
#pragma unroll
            for (int i = 0; i < 16; ++i) S[i] = 0.f;
#pragma unroll
            for (int d0 = 0; d0 < 16; ++d0) S = mfma32(*(const bf16x8*)(kp + 16 * d0), *(const bf16x8*)(qrow + 16 * d0), S);
            softmax_step<4>(S, LOG2E * 0.0625f, m, l, O, hh);
            const bf16x8 p0 = pack_p(S, 0), p1 = pack_p(S, 1);
            const bf16_t* vp = vbase + 32 * t;
#pragma unroll
            for (int o = 0; o < 4; ++o) { O[o] = mfma32(vt_frag(vp + (size_t)(32 * o) * MEMLEN), p0, O[o]); O[o] = mfma32(vt_frag(vp + (size_t)(32 * o) * MEMLEN + 16), p1, O[o]); }
        }
        l += xhalf(l, hh);
        const float il = 1.f / l;
        bf16_t* orow = OM + (size_t)(b * SEQ + q0 + r32) * D + h * 256 + dh * 128 + 4 * hh;
#pragma unroll
        for (int o = 0; o < 4; ++o)
#pragma unroll
            for (int g = 0; g < 4; ++g) { v2u w; w.x = pg8::cvt_pk_bf16(O[o][4 * g] * il, O[o][4 * g + 1] * il); w.y = pg8::cvt_pk_bf16(O[o][4 * g + 2] * il, O[o][4 * g + 3] * il); *(v2u*)(orow + 32 * o + 8 * g) = w; }
    }
}


constexpr int VSTR = 136;
template <int NCH> __device__ __forceinline__ void stage_load(v4u (&r)[NCH], const bf16_t* g0, int chunks_per_row, size_t gpitch, int tid) {
#pragma unroll
    for (int i = 0; i < NCH; ++i) { const int c = tid + NTHR * i, row = c / chunks_per_row, ch = c % chunks_per_row; r[i] = *(const v4u*)(g0 + (size_t)row * gpitch + ch * 8); }
}
template <int NCH> __device__ __forceinline__ void stage_store_k(const v4u (&r)[NCH], LAS unsigned char* dst, int chunks_per_row, int lstride, int tid) {
#pragma unroll
    for (int i = 0; i < NCH; ++i) { const int c = tid + NTHR * i, row = c / chunks_per_row, ch = c % chunks_per_row; *(LAS v4u*)(dst + row * lstride + ch * 16) = r[i]; }
}
template <int NCH> __device__ __forceinline__ void stage_store_v(const v4u (&r)[NCH], LAS unsigned char* dst, int tid) {
#pragma unroll
    for (int i = 0; i < NCH; ++i) { const int c = tid + NTHR * i, row = c >> 3, ch = c & 7; LAS v2u* d = (LAS v2u*)(dst + row * VSTR + ch * 16); d[0] = (v2u){r[i].x, r[i].y}; d[1] = (v2u){r[i].z, r[i].w}; }
}
__device__ __forceinline__ bf16x8 lds_vfrag(const LAS unsigned char* p) { const v2u lo = *(const LAS v2u*)p, hi = *(const LAS v2u*)(p + 16); return __builtin_bit_cast(bf16x8, (v4u){lo.x, lo.y, hi.x, hi.y}); }

template <int NO>
__device__ __forceinline__ void softmax_step2(f32x16& S0, f32x16& S1, float C, float& m, float& l, f32x16 (&O)[NO], int hh) {
    float mx = fmaxf(fmaxf(S0[0], S0[1]), fmaxf(S1[0], S1[1]));
#pragma unroll
    for (int i = 2; i < 16; i += 2) mx = fmaxf(mx, fmaxf(fmaxf(S0[i], S0[i + 1]), fmaxf(S1[i], S1[i + 1])));
    mx = fmaxf(mx, xhalf(mx, hh)) * C;
    const float mn = fmaxf(m, mx), al = __builtin_amdgcn_exp2f(m - mn);
    m = mn; l *= al;
#pragma unroll
    for (int o = 0; o < NO; ++o) O[o] = O[o] * al;
    float ps = 0.f;
#pragma unroll
    for (int i = 0; i < 16; ++i) { S0[i] = __builtin_amdgcn_exp2f(S0[i] * C - mn); S1[i] = __builtin_amdgcn_exp2f(S1[i] * C - mn); ps += S0[i] + S1[i]; }
    l += ps;
}

__device__ __forceinline__ void attn_diff_block(const bf16_t* PR, const bf16_t* VT, bf16_t* OAT, const float* subln, float lam, int b, int h, int qb, LAS unsigned char* lds, int tid, int wave, int lane) {
    constexpr int KSTR = 144, KB = 64 * KSTR, BUF = 2 * KB + 128 * VSTR;
    const int r32 = lane & 31, hh = lane >> 5, j = wave >> 2, w4 = wave & 3, q0 = qb * 128 + w4 * 32;
    const bf16_t* qrow = PR + (size_t)(b * SEQ + q0 + r32) * NIN + C_DQ + h * 128 + j * 64 + 8 * hh;
    bf16x8 qf[4];
#pragma unroll
    for (int d0 = 0; d0 < 4; ++d0) qf[d0] = *(const bf16x8*)(qrow + 16 * d0);
    const bf16_t* kg = PR + (size_t)(b * SEQ) * NIN + C_DK + h * 128;
    const bf16_t* vg = VT + (size_t)(b * 512 + h * 128) * SEQ;
    f32x16 O[4];
#pragma unroll
    for (int o = 0; o < 4; ++o)
#pragma unroll
        for (int i = 0; i < 16; ++i) O[o][i] = 0.f;
    float m = -INFINITY, l = 0.f;
    const int nsteps = 2 * qb + 2, my_last = 2 * qb + (w4 >> 1);
    v4u k1r[1], k2r[1], vr[2];
    stage_load<1>(k1r, kg, 8, NIN, tid); stage_load<1>(k2r, kg + 64, 8, NIN, tid); stage_load<2>(vr, vg, 8, SEQ, tid);
    stage_store_k<1>(k1r, lds, 8, KSTR, tid); stage_store_k<1>(k2r, lds + KB, 8, KSTR, tid); stage_store_v<2>(vr, lds + 2 * KB, tid);
    __syncthreads();
    for (int t = 0; t < nsteps; ++t) {
        const bool more = t + 1 < nsteps;
        if (more) { const bf16_t* kn = kg + (size_t)(64 * (t + 1)) * NIN; stage_load<1>(k1r, kn, 8, NIN, tid); stage_load<1>(k2r, kn + 64, 8, NIN, tid); stage_load<2>(vr, vg + 64 * (t + 1), 8, SEQ, tid); }
        if (t <= my_last) {
            const LAS unsigned char* kb = lds + (t & 1) * BUF + j * KB + r32 * KSTR + 16 * hh; const LAS unsigned char* vb = lds + (t & 1) * BUF + 2 * KB + r32 * VSTR + 8 * hh;
            f32x16 S0, S1;
#pragma unroll
            for (int i = 0; i < 16; ++i) { S0[i] = 0.f; S1[i] = 0.f; }
#pragma unroll
            for (int d0 = 0; d0 < 4; ++d0) { S0 = mfma32(*(const LAS bf16x8*)(kb + 32 * d0), qf[d0], S0); S1 = mfma32(*(const LAS bf16x8*)(kb + 32 * KSTR + 32 * d0), qf[d0], S1); }
            softmax_step2<4>(S0, S1, LOG2E, m, l, O, hh);
            const bf16x8 p00 = pack_p(S0, 0), p01 = pack_p(S0, 1), p10 = pack_p(S1, 0), p11 = pack_p(S1, 1);
#pragma unroll
            for (int o = 0; o < 4; ++o) { const LAS unsigned char* vp = vb + 32 * o * VSTR;
                O[o] = mfma32(lds_vfrag(vp), p00, O[o]); O[o] = mfma32(lds_vfrag(vp + 32), p01, O[o]); O[o] = mfma32(lds_vfrag(vp + 64), p10, O[o]); O[o] = mfma32(lds_vfrag(vp + 96), p11, O[o]); }
        }
        if (more) { LAS unsigned char* nb = lds + ((t + 1) & 1) * BUF; stage_store_k<1>(k1r, nb, 8, KSTR, tid); stage_store_k<1>(k2r, nb + KB, 8, KSTR, tid); stage_store_v<2>(vr, nb + 2 * KB, tid); }
        __syncthreads();
    }
    l += xhalf(l, hh);
    const float il = 1.f / l;
    LAS float* X = (LAS float*)lds + (size_t)(w4 * 32 + r32) * 132 + 4 * hh;
    if (j == 1) {
#pragma unroll
        for (int o = 0; o < 4; ++o)
#pragma unroll
            for (int g = 0; g < 4; ++g) *(LAS f32x4*)(X + 32 * o + 8 * g) = (f32x4){O[o][4 * g] * il, O[o][4 * g + 1] * il, O[o][4 * g + 2] * il, O[o][4 * g + 3] * il};
    }
    __syncthreads();
    if (j == 0) {
        float ss = 0.f;
#pragma unroll
        for (int o = 0; o < 4; ++o)
#pragma unroll
            for (int g = 0; g < 4; ++g) { const f32x4 o2 = *(const LAS f32x4*)(X + 32 * o + 8 * g);
#pragma unroll
                for (int c = 0; c < 4; ++c) { const float d = O[o][4 * g + c] * il - lam * o2[c]; O[o][4 * g + c] = d; ss += d * d; } }
        ss += xhalf(ss, hh);
        const float rinv = 0.8f / sqrtf(ss * (1.f / 128.f) + NORM_EPS);
        bf16_t* orow = OAT + (size_t)(b * SEQ + q0 + r32) * D + 512 + h * 128 + 4 * hh; const float* sl = subln + 4 * hh;
#pragma unroll
        for (int o = 0; o < 4; ++o)
#pragma unroll
            for (int g = 0; g < 4; ++g) { const f32x4 sg_ = *(const f32x4*)(sl + 32 * o + 8 * g); v2u w;
                w.x = pg8::cvt_pk_bf16(O[o][4 * g] * rinv * sg_[0], O[o][4 * g + 1] * rinv * sg_[1]); w.y = pg8::cvt_pk_bf16(O[o][4 * g + 2] * rinv * sg_[2], O[o][4 * g + 3] * rinv * sg_[3]); *(v2u*)(orow + 32 * o + 8 * g) = w; }
    }
    __syncthreads();
}

__device__ __forceinline__ void sb_subtile(f32x16& S, bool diag, float& R, f32x16 (&O)[2], const LAS unsigned char* vp, int r32, int hh) {
    f32x16 lr;
#pragma unroll
    for (int i = 0; i < 16; ++i) { const float z2 = S[i] * LOG2E; const float sp = fmaxf(z2, 0.f) + __builtin_amdgcn_logf(1.f + __builtin_amdgcn_exp2f(-fabsf(z2))); lr[i] = -sp; S[i] = z2 - sp; }
    if (diag) {
#pragma unroll
        for (int i = 0; i < 16; ++i) { const int kvl = (i & 3) + 8 * (i >> 2) + 4 * hh; if (kvl >= r32) { lr[i] = 0.f; S[i] = -INFINITY; } }
    }
    float tot[4], pt[4], off[4]; f32x16 ex;
#pragma unroll
    for (int g = 0; g < 4; ++g) { ex[4 * g + 3] = 0.f; ex[4 * g + 2] = lr[4 * g + 3]; ex[4 * g + 1] = lr[4 * g + 3] + lr[4 * g + 2]; ex[4 * g] = ex[4 * g + 1] + lr[4 * g + 1]; tot[g] = ex[4 * g] + lr[4 * g]; }
#pragma unroll
    for (int g = 0; g < 4; ++g) pt[g] = xhalf(tot[g], hh);
    const float own0 = hh ? 0.f : 1.f;
    float sp_ = 0.f;
#pragma unroll
    for (int g = 3; g >= 0; --g) { off[g] = sp_ + own0 * pt[g] + R; sp_ += tot[g] + pt[g]; }
#pragma unroll
    for (int i = 0; i < 16; ++i) S[i] = __builtin_amdgcn_exp2f(S[i] + ex[i] + off[i >> 2]);
    R += sp_;
    const bf16x8 p0 = pack_p(S, 0), p1 = pack_p(S, 1);
#pragma unroll
    for (int o = 0; o < 2; ++o) { O[o] = mfma32(lds_vfrag(vp + 32 * o * VSTR), p0, O[o]); O[o] = mfma32(lds_vfrag(vp + 32 * o * VSTR + 32), p1, O[o]); }
}
__device__ __forceinline__ void attn_sb_block(const bf16_t* PR, const bf16_t* VT, bf16_t* OAT, int b, int h, int qb, LAS unsigned char* lds, volatile LAS unsigned* fl, int tid, int wave, int lane) {
    constexpr int KSTR = 144, KB = 64 * KSTR, BUF = KB + 64 * VSTR;
    const int r32 = lane & 31, hh = lane >> 5, q0 = qb * 256 + wave * 32;
    const bf16_t* qrow = PR + (size_t)(b * SEQ + q0 + r32) * NIN + C_SBQ + h * 64 + 8 * hh;
    bf16x8 qf[4];
#pragma unroll
    for (int d0 = 0; d0 < 4; ++d0) qf[d0] = *(const bf16x8*)(qrow + 16 * d0);
    const bf16_t* kg = PR + (size_t)(b * SEQ) * NIN + C_SBK + h * 64;
    const bf16_t* vg = VT + (size_t)(b * 512 + h * 64) * SEQ;
    f32x16 O[2];
#pragma unroll
    for (int o = 0; o < 2; ++o)
#pragma unroll
        for (int i = 0; i < 16; ++i) O[o][i] = 0.f;
    float R = 0.f; bool done = false;
    const int ttop = 4 * qb + 3, my_diag = 4 * qb + (wave >> 1), odd = wave & 1;
    v4u kr[1], vr[1];
    if (tid < 3) fl[tid] = 0u;
    stage_load<1>(kr, kg + (size_t)(64 * ttop) * NIN, 8, NIN, tid); stage_load<1>(vr, vg + 64 * ttop, 8, SEQ, tid);
    stage_store_k<1>(kr, lds, 8, KSTR, tid); stage_store_v<1>(vr, lds + KB, tid);
    __syncthreads();
    int it = 0;
    for (int t = ttop; t >= 0; --t, ++it) {
        const bool more = t > 0;
        if (more) { stage_load<1>(kr, kg + (size_t)(64 * (t - 1)) * NIN, 8, NIN, tid); stage_load<1>(vr, vg + 64 * (t - 1), 8, SEQ, tid); }
        const int fcur = it % 3;
        if (tid == 0) fl[(it + 1) % 3] = 0u;
        if (t <= my_diag && !done) {
            const LAS unsigned char* kb = lds + (it & 1) * BUF + r32 * KSTR + 16 * hh; const LAS unsigned char* vb = lds + (it & 1) * BUF + KB + r32 * VSTR + 8 * hh;
            const bool isd = (t == my_diag);
            if (!isd || odd) {
                f32x16 S;
#pragma unroll
                for (int i = 0; i < 16; ++i) S[i] = 0.f;
#pragma unroll
                for (int d0 = 0; d0 < 4; ++d0) S = mfma32(*(const LAS bf16x8*)(kb + 32 * KSTR + 32 * d0), qf[d0], S);
                sb_subtile(S, isd, R, O, vb + 64, r32, hh);
            }
            {
                f32x16 S;
#pragma unroll
                for (int i = 0; i < 16; ++i) S[i] = 0.f;
#pragma unroll
                for (int d0 = 0; d0 < 4; ++d0) S = mfma32(*(const LAS bf16x8*)(kb + 32 * d0), qf[d0], S);
                sb_subtile(S, isd && !odd, R, O, vb, r32, hh);
            }
            done = __all(R < -160.f);
        }
        if (done && lane == 0) __hip_atomic_fetch_or((LAS unsigned*)(fl + fcur), 1u << wave, __ATOMIC_RELAXED, __HIP_MEMORY_SCOPE_WORKGROUP);
        if (more) { LAS unsigned char* nb = lds + ((it + 1) & 1) * BUF; stage_store_k<1>(kr, nb, 8, KSTR, tid); stage_store_v<1>(vr, nb + KB, tid); }
        __syncthreads();
        if (fl[fcur] == 0xffu) break;
    }
    bf16_t* orow = OAT + (size_t)(b * SEQ + q0 + r32) * D + h * 64 + 4 * hh;
#pragma unroll
    for (int o = 0; o < 2; ++o)
#pragma unroll
        for (int g = 0; g < 4; ++g) { v2u w; w.x = pg8::cvt_pk_bf16(O[o][4 * g], O[o][4 * g + 1]); w.y = pg8::cvt_pk_bf16(O[o][4 * g + 2], O[o][4 * g + 3]); *(v2u*)(orow + 32 * o + 8 * g) = w; }
    __syncthreads();
}

__device__ __forceinline__ void attn_mem_block(const bf16_t* QM, const bf16_t* KVM, const bf16_t* VT, bf16_t* OM, int b, int h, int qb, LAS unsigned char* lds, int tid, int wave, int lane) {
    constexpr int KSTR = 528, KB = 32 * KSTR, VS = 72, BUF = KB + 128 * VS;
    const int r32 = lane & 31, hh = lane >> 5, q0 = qb * 256 + wave * 32;
    const bf16_t* qrow = QM + (size_t)(b * SEQ + q0 + r32) * D + h * 256 + 8 * hh;
    bf16x8 qf[16];
#pragma unroll
    for (int d0 = 0; d0 < 16; ++d0) qf[d0] = *(const bf16x8*)(qrow + 16 * d0);
    const bf16_t* kg = KVM + (size_t)(b * MEMLEN) * 2048 + h * 256;
    const int vrow = tid >> 2, vch = tid & 3;
    for (int dh = 0; dh < 2; ++dh) {
        const bf16_t* vg = VT + (size_t)(b * 1024 + h * 256 + dh * 128 + vrow) * MEMLEN + vch * 8;
        f32x16 O[4];
#pragma unroll
        for (int o = 0; o < 4; ++o)
#pragma unroll
            for (int i = 0; i < 16; ++i) O[o][i] = 0.f;
        float m = -INFINITY, l = 0.f;
        v4u kr[2], vr;
        stage_load<2>(kr, kg, 32, 2048, tid); vr = *(const v4u*)vg;
        stage_store_k<2>(kr, lds, 32, KSTR, tid); { LAS v2u* d = (LAS v2u*)(lds + KB + vrow * VS + vch * 16); d[0] = (v2u){vr.x, vr.y}; d[1] = (v2u){vr.z, vr.w}; }
        __syncthreads();
        for (int t = 0; t < 8; ++t) {
            const bool more = t < 7;
            if (more) { stage_load<2>(kr, kg + (size_t)(32 * (t + 1)) * 2048, 32, 2048, tid); vr = *(const v4u*)(vg + 32 * (t + 1)); }
            {
                const LAS unsigned char* kb = lds + (t & 1) * BUF + r32 * KSTR + 16 * hh; const LAS unsigned char* vb = lds + (t & 1) * BUF + KB + r32 * VS + 8 * hh;
                f32x16 S;
#pragma unroll
                for (int i = 0; i < 16; ++i) S[i] = 0.f;
#pragma unroll
                for (int d0 = 0; d0 < 16; ++d0) S = mfma32(*(const LAS bf16x8*)(kb + 32 * d0), qf[d0], S);
                softmax_step<4>(S, LOG2E * 0.0625f, m, l, O, hh);
                const bf16x8 p0 = pack_p(S, 0), p1 = pack_p(S, 1);
#pragma unroll
                for (int o = 0; o < 4; ++o) { const LAS unsigned char* vp = vb + 32 * o * VS; O[o] = mfma32(lds_vfrag(vp), p0, O[o]); O[o] = mfma32(lds_vfrag(vp + 32), p1, O[o]); }
            }
            if (more) { LAS unsigned char* nb = lds + ((t + 1) & 1) * BUF; stage_store_k<2>(kr, nb, 32, KSTR, tid); LAS v2u* d = (LAS v2u*)(nb + KB + vrow * VS + vch * 16); d[0] = (v2u){vr.x, vr.y}; d[1] = (v2u){vr.z, vr.w}; }
            __syncthreads();
        }
        l += xhalf(l, hh);
        const float il = 1.f / l;
        bf16_t* orow = OM + (size_t)(b * SEQ + q0 + r32) * D + h * 256 + dh * 128 + 4 * hh;
#pragma unroll
        for (int o = 0; o < 4; ++o)
#pragma unroll
            for (int g = 0; g < 4; ++g) { v2u w; w.x = pg8::cvt_pk_bf16(O[o][4 * g] * il, O[o][4 * g + 1] * il); w.y = pg8::cvt_pk_bf16(O[o][4 * g + 2] * il, O[o][4 * g + 3] * il); *(v2u*)(orow + 32 * o + 8 * g) = w; }
    }
}

struct Args { const void* in[26]; float* out; unsigned char* ws; int ph_lo, ph_hi; };
constexpr int NPHASE = 15;

__device__ __forceinline__ float softplus_f(float z) { return fmaxf(z, 0.f) + __logf(1.f + __expf(-fabsf(z))); }

__global__ void __launch_bounds__(NTHR, 2) fwd(Args args) {
    extern __shared__ __attribute__((aligned(16))) unsigned char lds[];
    LAS unsigned char* L = (LAS unsigned char*)lds;
    volatile LAS unsigned* MISC = (volatile LAS unsigned*)(L + MISC_OFF);
    const int tid = threadIdx.x, lane = tid & 63, wave = __builtin_amdgcn_readfirstlane(tid >> 6);
    const int G = gridDim.x;
    unsigned char* ws = args.ws;
    unsigned* ctl = (unsigned*)(ws + WS_CTL);
    const float* x = (const float*)args.in[0]; const float* mem = (const float*)args.in[1]; const int* positions = (const int*)args.in[2];
    const float* norm_mix = (const float*)args.in[3]; const float* w_in = (const float*)args.in[4];
    const float* lam_q1 = (const float*)args.in[5]; const float* lam_k1 = (const float*)args.in[6]; const float* lam_q2 = (const float*)args.in[7]; const float* lam_k2 = (const float*)args.in[8];
    const float* diff_subln = (const float*)args.in[9]; const float* w_up_sb = (const float*)args.in[10]; const float* w_up_diff = (const float*)args.in[11];
    const float* w_out = (const float*)args.in[12]; const float* norm_mem_q = (const float*)args.in[13]; const float* norm_mem_kv = (const float*)args.in[14];
    const float* w_mem_q = (const float*)args.in[15]; const float* w_mem_kv = (const float*)args.in[16]; const float* w_mem_o = (const float*)args.in[17];
    const float* norm_ffn = (const float*)args.in[18]; const float* w_router = (const float*)args.in[19]; const float* b_router = (const float*)args.in[20];
    const float* w_gate_up = (const float*)args.in[21]; const float* b_gate_up = (const float*)args.in[22]; const float* w_down = (const float*)args.in[23];
    const float* b_down = (const float*)args.in[24]; const float* norm_final = (const float*)args.in[25];
    bf16_t* WIN = (bf16_t*)(ws + WS_WIN); bf16_t* WUPSB = (bf16_t*)(ws + WS_WUPSB); bf16_t* WUPDF = (bf16_t*)(ws + WS_WUPDF); bf16_t* WOUT = (bf16_t*)(ws + WS_WOUT);
    bf16_t* WMQ = (bf16_t*)(ws + WS_WMQ); bf16_t* WMKV = (bf16_t*)(ws + WS_WMKV); bf16_t* WMO = (bf16_t*)(ws + WS_WMO);
    bf16_t* WGU = (bf16_t*)(ws + WS_WGU); bf16_t* WD = (bf16_t*)(ws + WS_WD);
    float* ROPEC = (float*)(ws + WS_ROPE); float* ROPES = ROPEC + (size_t)M * 32;
    int* TK_E = (int*)(ws + WS_TK); int* TK_POS = TK_E + (size_t)M * 4; float* TK_G = (float*)(TK_POS + (size_t)M * 4);
    bf16_t* XN = (bf16_t*)(ws + WS_XN); bf16_t* PR = (bf16_t*)(ws + WS_PR); bf16_t* OAT = (bf16_t*)(ws + WS_OAT); float* SSQ = (float*)(ws + WS_ODR);
    bf16_t* MIX = (bf16_t*)(ws + WS_MIX); float* X1 = (float*)(ws + WS_X1); float* X2 = (float*)(ws + WS_X2);
    bf16_t* HM = (bf16_t*)(ws + WS_HM); bf16_t* KVM = (bf16_t*)(ws + WS_KVM); int* TLIST = (int*)(ws + WS_TLIST); float* GLIST = (float*)(ws + WS_GLIST);
    bf16_t* QM = (bf16_t*)(ws + WS_QM); bf16_t* OM = (bf16_t*)(ws + WS_OM); bf16_t* ACT = (bf16_t*)(ws + WS_ACT); bf16_t* YB = (bf16_t*)(ws + WS_YB);
    bf16_t* VTSB = (bf16_t*)(ws + WS_VTSB); bf16_t* VTDF = (bf16_t*)(ws + WS_VTDF); bf16_t* VTM = (bf16_t*)(ws + WS_VTM);
    float* WR = (float*)(ws + WS_WR);
    unsigned* CNT = ctl + CW_CNT;
    LAS float* smf = (LAS float*)L;
    LAS int* smi = (LAS int*)L;

    for (int u = tid; u < (LDS_BYTES - 131072) / 4; u += NTHR) ((LAS unsigned*)(L + 131072))[u] = 0u;
    __syncthreads();
#if !MK_PER_PHASE
    XcdBarrier bar = xcd_barrier_post(ctl + CW_BAR, MISC + 8);
#define GRID_BAR() xcd_barrier(bar)
#else
#define GRID_BAR() do {} while (0)
#endif
    const int lo = args.ph_lo, hi = args.ph_hi;
#define IN(k) (lo <= (k) && (k) < hi)
#define PHASE_L(k, ...) do { if (IN(k)) { auto body_ = [&]() __attribute__((always_inline)) __VA_ARGS__; body_(); if ((PROBE_REP >> (k)) & 1) { GRID_BAR(); body_(); } } } while (0)
#if !MK_PER_PHASE
#define PHASE(k) for (int rep_ = 0, nrep_ = IN(k) ? 1 + ((PROBE_REP >> (k)) & 1) : 0; rep_ < nrep_; ++rep_, (rep_ < nrep_ ? (xcd_barrier(bar), 0) : 0))
#else
#define PHASE(k) if (IN(k))
#endif
#define SEAM(k) do { if (IN(k) && IN((k) + 1)) GRID_BAR(); } while (0)
    const int gw = blockIdx.x * NWAVES + wave, NGW = G * NWAVES;
    const int xcu = (G % 8 == 0) ? ((int)blockIdx.x % 8) * (G / 8) + (int)blockIdx.x / 8 : (int)blockIdx.x;

    PHASE(0) {
        LAS float* scr = (LAS float*)(L + wave * 16384);
        constexpr int I_IN = 16 * 160, I_UP = 8 * 32, I_SQ = 16 * 32, I_KV = 16 * 64, I_GU1 = 16 * 64, I_GU = NE * I_GU1, I_D1 = 16 * 32, I_DN = NE * I_D1;
        constexpr int NITEMS = I_IN + 2 * I_UP + 3 * I_SQ + I_KV + I_GU + I_DN;
        for (int it = gw; it < NITEMS; it += NGW) {
            int r = it;
            if (r < I_IN) {
                const int kb = r / 160, nb = r % 160, n0 = 32 * nb;
                if (n0 >= C_DQ && n0 < C_DV) { const int o = n0 & 255;
                    p0_transpose_rope(w_in, WIN, (n0 & ~255), o, 64 * kb, n0, scr, lane); }
                else p0_transpose_item(w_in, 1024, NIN, WIN, n0, 64 * kb, n0, scr, lane);
                continue; } r -= I_IN;
            if (r < I_UP) { p0_plain(w_up_sb, 512, 1024, WUPSB, r, scr, lane); continue; } r -= I_UP;
            if (r < I_UP) { p0_plain(w_up_diff, 512, 1024, WUPDF, r, scr, lane); continue; } r -= I_UP;
            if (r < I_SQ) { p0_plain(w_out, 1024, 1024, WOUT, r, scr, lane); continue; } r -= I_SQ;
            if (r < I_SQ) { p0_plain(w_mem_q, 1024, 1024, WMQ, r, scr, lane, norm_mem_q); continue; } r -= I_SQ;
            if (r < I_SQ) { p0_plain(w_mem_o, 1024, 1024, WMO, r, scr, lane); continue; } r -= I_SQ;
            if (r < I_KV) { p0_plain(w_mem_kv, 1024, 2048, WMKV, r, scr, lane); continue; } r -= I_KV;
            if (r < I_GU) { const int e = r / I_GU1, q = r % I_GU1, kb = q / 64, nb = q % 64, n0 = 32 * nb;
                const int half = n0 >> 10, j = n0 & 1023, drow0 = (j >> 7) * 256 + half * 128 + (j & 127);
                p0_transpose_item(w_gate_up + (size_t)e * 1024 * 2048, 1024, 2048, WGU + (size_t)e * 2048 * 1024, drow0, 64 * kb, n0, scr, lane); continue; } r -= I_GU;
            { const int e = r / I_D1, q = r % I_D1; p0_plain(w_down + (size_t)e * 1024 * 1024, 1024, 1024, WD + (size_t)e * 1024 * 1024, q, scr, lane); }
        }
        for (int i = blockIdx.x * NTHR + tid; i < D * NE; i += G * NTHR) WR[i] = w_router[i] * norm_ffn[i >> 5];
        for (int m = gw; m < M; m += NGW) rms_row_to_bf16(x + (size_t)m * D, norm_mix, XN + (size_t)m * D, lane);
        for (int m = gw; m < MM; m += NGW) rms_row_to_bf16(mem + (size_t)m * D, norm_mem_kv, HM + (size_t)m * D, lane);
        for (int i = blockIdx.x * NTHR + tid; i < M * 32; i += G * NTHR) {
            const int m = i >> 5, f = i & 31;
            const double inv = exp2(-(double)f * (13.287712379549449 / 32.0));
            const double ang = (double)positions[m] * inv;
            const double kk = rint(ang * 0.15915494309189535);
            const float rf = (float)(ang - kk * 6.283185307179586);
            ROPEC[i] = __cosf(rf); ROPES[i] = __sinf(rf);
        }
    }
    SEAM(0);

    PHASE_L(1, {
        { pg8::Gemm g{XN, WIN, D, D, D}; pg8::DenseOrder S; S.init(M, NIN, G, (int)blockIdx.x, D, D);
          pg8::gemm_phase<pg8::EpiInProj, pg8::DenseOrder, false>(L, g, S, pg8::EpiInProj{PR, ROPEC, ROPES, VTSB, VTDF}); }
    });
    SEAM(1);

    PHASE(3) {
        volatile LAS unsigned* fl = (volatile LAS unsigned*)(L + 131072 + 2048);
        const int nkv = (G >= 64) ? 32 : 0;
        if ((int)blockIdx.x < nkv) { pg8::Gemm g{HM, WMKV, D, D, D}; pg8::OneUnitOrder S{(int)blockIdx.x, D, D};
            pg8::gemm_phase<pg8::EpiKV, pg8::OneUnitOrder, false>(L, g, S, pg8::EpiKV{KVM, VTM}); }
        else for (int bu = (int)blockIdx.x - nkv; bu < 512; bu += G - nkv) { const int qb = bu & 15, h = (bu >> 4) & 7, b = bu >> 7; attn_sb_block(PR, VTSB, OAT, b, h, qb, L, fl, tid, wave, lane); }
        if (nkv == 0) { pg8::Gemm g{HM, WMKV, D, D, D}; pg8::DenseOrder S; S.init(MM, 2048, G, (int)blockIdx.x, D, D); pg8::gemm_phase<pg8::EpiKV, pg8::DenseOrder, false>(L, g, S, pg8::EpiKV{KVM, VTM}); }
        const float lam = expf(wave_sum(lam_q1[lane] * lam_k1[lane])) - expf(wave_sum(lam_q2[lane] * lam_k2[lane])) + 0.2f;
        for (int pr = blockIdx.x; pr < 256; pr += G) { const int sb_ = pr & 15, h = (pr >> 4) & 3, b = pr >> 6;
            attn_diff_block(PR, VTDF, OAT, diff_subln, lam, b, h, 31 - sb_, L, tid, wave, lane); attn_diff_block(PR, VTDF, OAT, diff_subln, lam, b, h, sb_, L, tid, wave, lane); }
    }
    SEAM(3);

    PHASE_L(5, {
        pg8::Gemm g{OAT, WUPSB, D, 512, 512}; pg8::TwoRoundOrder S{G, xcu, D, 512};
        pg8::gemm_phase<pg8::EpiGate, pg8::TwoRoundOrder, false>(L, g, S, pg8::EpiGate{PR, X2, MIX});
    });
    SEAM(5);

    PHASE_L(6, {
        pg8::Gemm g{MIX, WOUT, D, D, D}; pg8::DenseOrder S; S.init(M, D, G, (int)blockIdx.x, D, D);
        pg8::gemm_phase<pg8::EpiResidNorm, pg8::DenseOrder, false>(L, g, S, pg8::EpiResidNorm{x, X1, XN, SSQ});
    });
    if (IN(6) && IN(8)) GRID_BAR();

    PHASE_L(8, {
        pg8::Gemm g{XN, WMQ, D, D, D}; pg8::DenseOrder S; S.init(M, D, G, (int)blockIdx.x, D, D);
        pg8::gemm_phase<pg8::EpiBf16Rinv, pg8::DenseOrder, false>(L, g, S, pg8::EpiBf16Rinv{QM, SSQ});
    });
    SEAM(8);

    PHASE(9) { for (int bu = blockIdx.x; bu < 256; bu += G) { const int qb = bu & 15, h = (bu >> 4) & 3, b = bu >> 6; attn_mem_block(QM, KVM, VTM, OM, b, h, qb, L, tid, wave, lane); } }
    SEAM(9);

    PHASE_L(10, {
        pg8::Gemm g{OM, WMO, D, D, D}; pg8::DenseOrder S; S.init(M, D, G, (int)blockIdx.x, D, D);
        pg8::gemm_phase<pg8::EpiResidF32, pg8::DenseOrder, false>(L, g, S, pg8::EpiResidF32{X1, X2});
    });
    SEAM(10);

    if (IN(11)) {
        auto body11_ = [&]() __attribute__((always_inline)) {
        if (wave < 2) {
            for (int tile = wave * G + blockIdx.x; tile < M / 32; tile += 2 * G) {
                const int i32 = lane & 31, kk = lane >> 5, m0 = tile * 32;
                const float* xr = X2 + (size_t)(m0 + i32) * D + 4 * kk; const float* wp = WR + (4 * kk) * NE + i32;
                f32x16 acc;
#pragma unroll
                for (int r = 0; r < 16; ++r) acc[r] = 0.f;
                float ss = 0.f;
#pragma unroll 4
                for (int u = 0; u < 128; ++u) {
                    const f32x4 a = *(const f32x4*)(xr + 8 * u);
                    const float b0 = wp[(8 * u + 0) * NE], b1 = wp[(8 * u + 1) * NE], b2 = wp[(8 * u + 2) * NE], b3 = wp[(8 * u + 3) * NE];
                    acc = __builtin_amdgcn_mfma_f32_32x32x2f32(a.x, b0, acc, 0, 0, 0); acc = __builtin_amdgcn_mfma_f32_32x32x2f32(a.y, b1, acc, 0, 0, 0);
                    acc = __builtin_amdgcn_mfma_f32_32x32x2f32(a.z, b2, acc, 0, 0, 0); acc = __builtin_amdgcn_mfma_f32_32x32x2f32(a.w, b3, acc, 0, 0, 0);
                    ss += (a.x * a.x + a.y * a.y) + (a.z * a.z + a.w * a.w);
                }
                ss += xhalf(ss, kk);
                const float rinv = 1.0f / sqrtf(ss * (1.f / 1024.f) + NORM_EPS);
                LAS float* T = smf + wave * 1152;
#pragma unroll
                for (int r = 0; r < 16; ++r) T[((r & 3) + 8 * (r >> 2) + 4 * kk) * 33 + i32] = acc[r];
                LDS_WAIT(); asm volatile("" ::: "memory");
                if (lane < 32) {
                    float lg[32];
#pragma unroll
                    for (int j = 0; j < 32; ++j) lg[j] = T[lane * 33 + j] * rinv + b_router[j];
                    float tv[4]; int ti[4];
#pragma unroll
                    for (int k = 0; k < 4; ++k) { float bv = lg[0]; int bi = 0;
#pragma unroll
                        for (int j = 1; j < 32; ++j) if (lg[j] > bv) { bv = lg[j]; bi = j; }
                        tv[k] = bv; ti[k] = bi;
#pragma unroll
                        for (int j = 0; j < 32; ++j) if (j == bi) lg[j] = -INFINITY; }
                    const float e1 = __expf(tv[1] - tv[0]), e2 = __expf(tv[2] - tv[0]), e3 = __expf(tv[3] - tv[0]);
                    const float isum = 1.f / (1.f + e1 + e2 + e3);
                    const float gk[4] = {isum, e1 * isum, e2 * isum, e3 * isum};
                    LAS unsigned* H = (LAS unsigned*)(T + 32 * 33);
                    H[lane] = 0u;
                    LDS_WAIT(); asm volatile("" ::: "memory");
                    int rk[4];
#pragma unroll
                    for (int k = 0; k < 4; ++k) rk[k] = (int)__hip_atomic_fetch_add(H + ti[k], 1u, __ATOMIC_RELAXED, __HIP_MEMORY_SCOPE_WAVEFRONT);
                    LDS_WAIT(); asm volatile("" ::: "memory");
                    const unsigned cnt_e = H[lane];
                    unsigned base_e = 0u; if (cnt_e) base_e = atomicAdd(&CNT[64 * lane], cnt_e);
                    H[32 + lane] = base_e;
                    LDS_WAIT(); asm volatile("" ::: "memory");
                    const int m = m0 + lane;
#pragma unroll
                    for (int k = 0; k < 4; ++k) { const int ek = ti[k]; const int pos = (int)H[32 + ek] + rk[k];
                        TLIST[ek * LISTCAP + pos] = m; GLIST[ek * LISTCAP + pos] = gk[k]; TK_E[m * 4 + k] = ek; TK_POS[m * 4 + k] = pos; TK_G[m * 4 + k] = gk[k]; }
                }
                LDS_WAIT(); asm volatile("" ::: "memory");
            }
        } else {
            for (int m = blockIdx.x * 6 + (wave - 2); m < M; m += G * 6) rms_row_to_bf16(X2 + (size_t)m * D, norm_ffn, XN + (size_t)m * D, lane);
        }
            };
        body11_();
        if ((PROBE_REP >> 11) & 1) { GRID_BAR(); if (blockIdx.x == 0 && tid < NE) CNT[64 * tid] = 0u; GRID_BAR(); body11_(); }
    }
    SEAM(11);

#define LOAD_BASES() do { __syncthreads(); if (tid == 0) { int b_ = 0; for (int e_ = 0; e_ < NE; ++e_) { const int c_ = (int)__hip_atomic_load(&CNT[64 * e_], __ATOMIC_RELAXED, __HIP_MEMORY_SCOPE_AGENT); \
        smi[8192 + e_] = b_; smi[8256 + e_] = c_; b_ += (c_ + 255) & ~255; } } __syncthreads(); } while (0)

    LAS int* tb = (LAS int*)(L + 131072 + 1024);
#define LOAD_TB(npn) do { __syncthreads(); if (tid == 0) { int b_ = 0, cu_ = 0; for (int e_ = 0; e_ < NE; ++e_) { const int c_ = (int)__hip_atomic_load(&CNT[64 * e_], __ATOMIC_RELAXED, __HIP_MEMORY_SCOPE_AGENT); \
        tb[e_] = b_; tb[32 + e_] = c_; tb[64 + e_] = cu_; b_ += (c_ + 255) & ~255; cu_ += ((c_ + 255) >> 8) * (npn); } tb[96] = cu_; } __syncthreads(); } while (0)
    PHASE(12) {
        LOAD_TB(8);
        pg8::Gemm g{XN, WGU, D, D, D}; pg8::MoeOrder S{tb, TLIST, G, xcu, 8, D, D, 2048};
        pg8::gemm_phase<pg8::EpiMoeGU, pg8::MoeOrder, true>(L, g, S, pg8::EpiMoeGU{ACT, b_gate_up});
    }
    SEAM(12);
    PHASE(13) {
        LOAD_TB(4);
        pg8::Gemm g{ACT, WD, DFF, DFF, DFF}; pg8::MoeOrder S{tb, TLIST, G, xcu, 4, DFF, DFF, 1024};
        pg8::gemm_phase<pg8::EpiMoeDown, pg8::MoeOrder, false>(L, g, S, pg8::EpiMoeDown{YB, b_down, GLIST, tb});
    }
    SEAM(13);

    PHASE(14) {
        LOAD_BASES();
        for (int mb = gw; mb < M; mb += 8 * NGW) {
            int slotv = 0;
            { const int i = lane >> 2, k = lane & 3, m = mb + NGW * i; if (lane < 32 && m < M) slotv = smi[8192 + TK_E[m * 4 + k]] + TK_POS[m * 4 + k]; }
#pragma unroll 2
            for (int i = 0; i < 8; ++i) {
                const int m = mb + NGW * i; if (m >= M) break;
                const f32x4* xr = (const f32x4*)(X2 + (size_t)m * D) + lane; const f32x4* gr = (const f32x4*)norm_final + lane;
                f32x4 v[4];
#pragma unroll
                for (int j = 0; j < 4; ++j) v[j] = xr[64 * j];
#pragma unroll
                for (int k = 0; k < 4; ++k) { const int slot = __builtin_amdgcn_readlane(slotv, 4 * i + k); const v2u* yr = (const v2u*)(YB + (size_t)slot * D) + lane;
#pragma unroll
                    for (int j = 0; j < 4; ++j) { const v2u w = yr[64 * j]; v[j].x += lo16(w.x); v[j].y += hi16(w.x); v[j].z += lo16(w.y); v[j].w += hi16(w.y); } }
                float ss = 0.f;
#pragma unroll
                for (int j = 0; j < 4; ++j) ss += (v[j].x * v[j].x + v[j].y * v[j].y) + (v[j].z * v[j].z + v[j].w * v[j].w);
                const float rinv = 1.0f / sqrtf(wave_sum(ss) * (1.f / 1024.f) + NORM_EPS);
                f32x4* orow = (f32x4*)(args.out + (size_t)m * D) + lane;
#pragma unroll
                for (int j = 0; j < 4; ++j) { const f32x4 gg = gr[64 * j]; orow[64 * j] = (f32x4){v[j].x * rinv * gg.x, v[j].y * rinv * gg.y, v[j].z * rinv * gg.z, v[j].w * rinv * gg.w}; }
            }
        }
    }
#undef IN
#undef SEAM
}

extern "C" void kernel_launch(void* const* d_in, const int* in_sizes, int n_in, void* d_out, int out_size, void* d_ws, size_t ws_size, hipStream_t stream) {
    static int grid = 0;
    if (grid == 0) {
        if (n_in != 26 || out_size != M * D || ws_size < WS_END) { fprintf(stderr, "kernel_launch: unexpected sizes n_in %d out %d ws %zu\n", n_in, out_size, ws_size); grid = -1; return; }
        int dev = 0, cus = 0;
        if (hipGetDevice(&dev) != hipSuccess || hipDeviceGetAttribute(&cus, hipDeviceAttributeMultiprocessorCount, dev) != hipSuccess) { grid = -1; return; }
        if (hipFuncSetAttribute((const void*)fwd, hipFuncAttributeMaxDynamicSharedMemorySize, LDS_BYTES) != hipSuccess) { fprintf(stderr, "kernel_launch: hipFuncSetAttribute failed\n"); grid = -1; return; }
        int per_cu = 0;
        (void)hipOccupancyMaxActiveBlocksPerMultiprocessor(&per_cu, (const void*)fwd, NTHR, LDS_BYTES);
        (void)hipGetLastError();
        grid = cus;
    }
    if (grid < 0) return;
    (void)hipMemsetAsync((char*)d_ws + WS_CTL, 0, CTL_ZERO_BYTES, stream);
    Args a{};
    for (int i = 0; i < 26; ++i) a.in[i] = d_in[i];
    a.out = (float*)d_out; a.ws = (unsigned char*)d_ws;
#if MK_PER_PHASE
    for (int p = 0; p < NPHASE; ++p) { a.ph_lo = p; a.ph_hi = p + 1; hipLaunchKernelGGL(fwd, dim3(grid), dim3(NTHR), LDS_BYTES, stream, a); }
#else
    a.ph_lo = 0; a.ph_hi = NPHASE; hipLaunchKernelGGL(fwd, dim3(grid), dim3(NTHR), LDS_BYTES, stream, a);
#endif
}
```

```cpp
#include <hip/hip_runtime.h>
#include <cstdio>
#include <cstdint>

#ifndef MK_PER_PHASE
#define MK_PER_PHASE 0
#endif

#ifndef PROBE_REP
#define PROBE_REP 0
#endif
#define GAS __attribute__((address_space(1)))
#define LAS __attribute__((address_space(3)))
typedef unsigned short bf16_t;
typedef unsigned v4u __attribute__((ext_vector_type(4)));
typedef unsigned v2u __attribute__((ext_vector_type(2)));
typedef float f32x4 __attribute__((ext_vector_type(4)));
typedef short bf16x8 __attribute__((ext_vector_type(8)));

constexpr int BATCH = 4, SEQ = 4096, D = 1024, M = BATCH * SEQ, NIN = 5120;
constexpr int MEMLEN = 256, MM = BATCH * MEMLEN;
constexpr int NE = 32, TOPK = 4, DFF = 1024;
constexpr float NORM_EPS = 1e-6f;
constexpr int C_SBQ = 0, C_SBK = 512, C_SBV = 1024, C_DQ = 1536, C_DK = 2048, C_DV = 2560, C_GSB = 3072, C_GDF = 4096;
constexpr int LISTCAP = 16384;
constexpr int SLOTS = 65536 + NE * 256;
constexpr int NWAVES = 8, NTHR = 512;

constexpr size_t MiB = 1u << 20;
constexpr size_t WS_CTL = 0, CTL_ZERO_BYTES = 1 * MiB;
constexpr size_t WS_WIN = 2 * MiB;
constexpr size_t WS_WUPSB = 12 * MiB;
constexpr size_t WS_WUPDF = 13 * MiB;
constexpr size_t WS_WOUT = 14 * MiB;
constexpr size_t WS_WMQ = 16 * MiB;
constexpr size_t WS_WMKV = 18 * MiB;
constexpr size_t WS_WMO = 22 * MiB;
constexpr size_t WS_ROPE = 24 * MiB;
constexpr size_t WS_TK = 28 * MiB;
constexpr size_t WS_WR = 29 * MiB;
constexpr size_t WS_WSC = 30 * MiB;
constexpr size_t WS_WGU = 32 * MiB;
constexpr size_t WS_WD = 160 * MiB;
constexpr size_t WS_XN = 224 * MiB;
constexpr size_t WS_PR = 256 * MiB;
constexpr size_t WS_OAT = 416 * MiB;
constexpr size_t WS_ODR = 448 * MiB;
constexpr size_t WS_MIX = 512 * MiB;
constexpr size_t WS_X1 = 544 * MiB;
constexpr size_t WS_X2 = 608 * MiB;
constexpr size_t WS_HM = 672 * MiB;
constexpr size_t WS_KVM = 674 * MiB;
constexpr size_t WS_TLIST = 678 * MiB;
constexpr size_t WS_GLIST = 680 * MiB;
constexpr size_t WS_QM = 682 * MiB;
constexpr size_t WS_OM = 714 * MiB;
constexpr size_t WS_ACT = 256 * MiB;
constexpr size_t WS_YB = 746 * MiB;
constexpr size_t WS_VTSB = 890 * MiB;
constexpr size_t WS_VTDF = 906 * MiB;
constexpr size_t WS_VTM = 922 * MiB;
constexpr size_t WS_END = 924 * MiB;
static_assert(WS_ACT + (size_t)SLOTS * 1024 * 2 <= WS_OAT, "ACT overlay");
static_assert(WS_YB + (size_t)SLOTS * 1024 * 2 <= WS_VTSB, "YB");
constexpr int CW_CNT = 8192;
constexpr int CW_BAR = 1024;

constexpr int LDS_BYTES = 147456;
constexpr int MISC_OFF = 131072 + 320;

__device__ __forceinline__ float bf2f(bf16_t b) { return __uint_as_float(((unsigned)b) << 16); }
__device__ __forceinline__ unsigned f2bf(float f) { unsigned u = __float_as_uint(f); return (u + 0x7fffu + ((u >> 16) & 1u)) >> 16; }
__device__ __forceinline__ unsigned pk2(float lo, float hi) { return f2bf(lo) | (f2bf(hi) << 16); }
__device__ __forceinline__ unsigned pk4_fp8(float a, float b, float c, float d) { int w = 0; w = __builtin_amdgcn_cvt_pk_fp8_f32(a, b, w, false); w = __builtin_amdgcn_cvt_pk_fp8_f32(c, d, w, true); return (unsigned)w; }
__device__ __forceinline__ float lo16(unsigned w) { return __uint_as_float(w << 16); }
__device__ __forceinline__ float hi16(unsigned w) { return __uint_as_float(w & 0xffff0000u); }
#define LDS_WAIT() asm volatile("s_waitcnt lgkmcnt(0)" ::: "memory")
__device__ __forceinline__ float wave_sum(float v) {
#pragma unroll
    for (int o = 1; o < 64; o <<= 1) v += __shfl_xor(v, o);
    return v;
}
__device__ __forceinline__ float wave_max(float v) {
#pragma unroll
    for (int o = 1; o < 64; o <<= 1) v = fmaxf(v, __shfl_xor(v, o));
    return v;
}

#define XB_TMO      128
#define XB_XCNT(j)  (256  + 64 * (j))
#define XB_XSUB(j)  (1280 + 64 * (j))
#define XB_XGEN(j)  (2304 + 64 * (j))
#define XB_TOP      3328
#define XB_TOPGEN   3392
#define XCD_BAR_WORDS 3456
#define XB_SPIN_CAP (1u << 18)
__device__ __forceinline__ unsigned xb_ld(unsigned* p)              { return __hip_atomic_load(p, __ATOMIC_RELAXED, __HIP_MEMORY_SCOPE_AGENT); }
__device__ __forceinline__ unsigned xb_add(unsigned* p, unsigned v) { return __hip_atomic_fetch_add(p, v, __ATOMIC_RELAXED, __HIP_MEMORY_SCOPE_AGENT); }
__device__ __forceinline__ unsigned xb_xcc_id() { return (unsigned)__builtin_amdgcn_s_getreg((3 << 11) | 20) & 0xFu; }
#define XB_SPIN(cond, bar) do { unsigned _sp = 0; while (cond) { __builtin_amdgcn_s_sleep(1); \
    if ((++_sp & 255u) == 0u) { if (xb_ld(&(bar)[XB_TMO])) break; if (_sp > XB_SPIN_CAP) { atomicAdd(&(bar)[XB_TMO], 1u); break; } } } } while (0)
struct XcdBarrier { unsigned* bar; unsigned x; volatile LAS unsigned* st; };
__device__ __forceinline__ XcdBarrier xcd_barrier_post(unsigned* bar, volatile LAS unsigned* st) {
    XcdBarrier b; b.bar = bar; b.x = xb_xcc_id(); b.st = st;
    if (threadIdx.x == 0) (void)xb_add(&bar[XB_XCNT(b.x)], 1u);
    return b;
}
__device__ __forceinline__ void xcd_barrier_complete(unsigned* bar, unsigned x, unsigned& nloc, unsigned& nx) {
    const unsigned G = gridDim.x * gridDim.y * gridDim.z;
    unsigned sum, cnt, mine, sp = 0u;
    for (;;) {
        sum = 0u; cnt = 0u; mine = 0u;
#pragma unroll
        for (unsigned j = 0; j < 16; ++j) { const unsigned c = xb_ld(&bar[XB_XCNT(j)]); sum += c; cnt += (c > 0u) ? 1u : 0u; mine = (j == x) ? c : mine; }
        if (sum == G) break;
        __builtin_amdgcn_s_sleep(1);
        if ((++sp & 255u) == 0u) { if (xb_ld(&bar[XB_TMO])) break; if (sp > XB_SPIN_CAP) { atomicAdd(&bar[XB_TMO], 1u); break; } }
    }
    nloc = mine > 0u ? mine : 1u; nx = cnt > 0u ? cnt : 1u;
}
__device__ __forceinline__ void xcd_barrier(const XcdBarrier& b) {
    asm volatile("s_waitcnt vmcnt(0)" ::: "memory");
    __syncthreads();
    if (threadIdx.x == 0) {
        unsigned* bar = b.bar;
        __builtin_amdgcn_s_waitcnt(0);
        unsigned nloc = b.st[0], nx = b.st[1];
        if (nloc == 0u) { xcd_barrier_complete(bar, b.x, nloc, nx); b.st[0] = nloc; b.st[1] = nx; }
        const unsigned old = xb_add(&bar[XB_XSUB(b.x)], 1u);
        const unsigned gen = old / nloc;
        if (old + 1u == (gen + 1u) * nloc) {
            __builtin_amdgcn_fence(__ATOMIC_RELEASE, "agent");
            asm volatile("s_waitcnt vmcnt(0)" ::: "memory");
            const unsigned og = xb_add(&bar[XB_TOP], 1u);
            const unsigned tg = og / nx;
            if (og + 1u == (tg + 1u) * nx) xb_add(&bar[XB_TOPGEN], 1u);
            else XB_SPIN(xb_ld(&bar[XB_TOPGEN]) == tg, bar);
            __builtin_amdgcn_fence(__ATOMIC_ACQUIRE, "agent");
            xb_add(&bar[XB_XGEN(b.x)], 1u);
            asm volatile("s_waitcnt vmcnt(0)" ::: "memory");
        } else {
            XB_SPIN(xb_ld(&bar[XB_XGEN(b.x)]) == gen, bar);
            __builtin_amdgcn_fence(__ATOMIC_ACQUIRE, "agent");
            asm volatile("s_waitcnt vmcnt(0)" ::: "memory");
        }
    }
    __syncthreads();
}

__device__ __forceinline__ void p0_transpose_item(const float* W, int K, int N, bf16_t* WT, int drow0, int k0, int n0, LAS float* scr, int lane, const float* gain = nullptr) {
#pragma unroll 8
    for (int i = 0; i < 32; ++i) { const int kk = 2 * i + (lane >> 5); float v = W[(size_t)(k0 + kk) * N + n0 + (lane & 31)]; if (gain) v *= gain[k0 + kk]; scr[kk * 33 + (lane & 31)] = v; }
    LDS_WAIT(); asm volatile("" ::: "memory");
    const int c = lane & 7;
#pragma unroll
    for (int j = 0; j < 4; ++j) { const int n = (lane >> 3) + 8 * j; const LAS float* s = scr + (8 * c) * 33 + n;
        v4u o; o.x = pk2(s[0 * 33], s[1 * 33]); o.y = pk2(s[2 * 33], s[3 * 33]); o.z = pk2(s[4 * 33], s[5 * 33]); o.w = pk2(s[6 * 33], s[7 * 33]);
        *(v4u*)(WT + (size_t)(drow0 + n) * K + k0 + 8 * c) = o; }
    LDS_WAIT(); asm volatile("" ::: "memory");
}
__device__ __forceinline__ void p0_plain(const float* W, int K, int N, bf16_t* WT, int item, LAS float* scr, int lane, const float* gain = nullptr) {
    const int nblk = N / 32, kb = item / nblk, nb = item % nblk;
    p0_transpose_item(W, K, N, WT, 32 * nb, 64 * kb, 32 * nb, scr, lane, gain);
}
__device__ __forceinline__ void p0_transpose_rope(const float* W, bf16_t* WT, int tilebase, int o, int k0, int n0, LAS float* scr, int lane) {
    const int K = 1024, N = NIN;
#pragma unroll 8
    for (int i = 0; i < 32; ++i) { const int kk = 2 * i + (lane >> 5); scr[kk * 33 + (lane & 31)] = W[(size_t)(k0 + kk) * N + n0 + (lane & 31)]; }
    LDS_WAIT(); asm volatile("" ::: "memory");
    const int c = lane & 7;
#pragma unroll
    for (int j = 0; j < 4; ++j) { const int n = (lane >> 3) + 8 * j; const LAS float* s = scr + (8 * c) * 33 + n;
        const int oo = o + n, v = ((oo >> 6) << 6) | (((oo >> 4) & 1) << 5) | (((oo >> 2) & 3) << 3) | (((oo >> 5) & 1) << 2) | (oo & 3);
        v4u w; w.x = pk2(s[0 * 33], s[1 * 33]); w.y = pk2(s[2 * 33], s[3 * 33]); w.z = pk2(s[4 * 33], s[5 * 33]); w.w = pk2(s[6 * 33], s[7 * 33]);
        *(v4u*)(WT + (size_t)(tilebase + v) * K + k0 + 8 * c) = w; }
    LDS_WAIT(); asm volatile("" ::: "memory");
}
__device__ __forceinline__ void rms_row_to_bf16(const float* xrow, const float* g, bf16_t* orow, int lane) {
    const f32x4* xr = (const f32x4*)xrow + lane; const f32x4* gr = (const f32x4*)g + lane;
    f32x4 v[4]; float s = 0.f;
#pragma unroll
    for (int j = 0; j < 4; ++j) { v[j] = xr[64 * j]; s += (v[j].x * v[j].x + v[j].y * v[j].y) + (v[j].z * v[j].z + v[j].w * v[j].w); }
    const float rinv = 1.0f / sqrtf(wave_sum(s) * (1.f / 1024.f) + NORM_EPS);
    v2u* o8 = (v2u*)orow + lane;
#pragma unroll
    for (int j = 0; j < 4; ++j) { const f32x4 gg = gr[64 * j]; v2u w; w.x = pk2(v[j].x * rinv * gg.x, v[j].y * rinv * gg.y); w.y = pk2(v[j].z * rinv * gg.z, v[j].w * rinv * gg.w); o8[64 * j] = w; }
}

__device__ __forceinline__ void rms_row_to_fp8(const float* xrow, const float* g, unsigned char* orow, int lane) {
    const f32x4* xr = (const f32x4*)xrow + lane; const f32x4* gr = (const f32x4*)g + lane;
    f32x4 v[4]; float s = 0.f;
#pragma unroll
    for (int j = 0; j < 4; ++j) { v[j] = xr[64 * j]; s += (v[j].x * v[j].x + v[j].y * v[j].y) + (v[j].z * v[j].z + v[j].w * v[j].w); }
    const float rinv = 1.0f / sqrtf(wave_sum(s) * (1.f / 1024.f) + NORM_EPS);
    unsigned* o4 = (unsigned*)orow + lane;
#pragma unroll
    for (int j = 0; j < 4; ++j) { const f32x4 gg = gr[64 * j]; o4[64 * j] = pk4_fp8(v[j].x * rinv * gg.x, v[j].y * rinv * gg.y, v[j].z * rinv * gg.z, v[j].w * rinv * gg.w); }
}
template <int NB, class RowPtr, class Epi>
__device__ __forceinline__ void ngemm_tile(const RowPtr& rp, const bf16_t* Bt, int ldb, int b1off, int K, int m0, int n0, int mvalid, const Epi& epi, LAS float* sm) {
    const int t = threadIdx.x, r = t >> 2, kq = (t & 3) * 4, ty = t >> 5, tx = t & 31;
    LAS float* As = sm; LAS float* Bs0 = sm + 16 * 132; LAS float* Bs1 = sm + 32 * 132;
    float acc[NB][8][4];
#pragma unroll
    for (int b = 0; b < NB; ++b)
#pragma unroll
        for (int i = 0; i < 8; ++i)
#pragma unroll
            for (int j = 0; j < 4; ++j) acc[b][i][j] = 0.f;
    const bf16_t* arow = rp(m0 + r) + kq;
    const bf16_t* brow0 = Bt + (size_t)(n0 + r) * ldb + kq;
    const bf16_t* brow1 = Bt + (size_t)(n0 + b1off + r) * ldb + kq;
    for (int k0 = 0; k0 < K; k0 += 16) {
        const v2u av = *(const v2u*)(arow + k0);
        const v2u bv0 = *(const v2u*)(brow0 + k0);
        v2u bv1 = bv0; if (NB == 2) bv1 = *(const v2u*)(brow1 + k0);
        As[(kq + 0) * 132 + r] = lo16(av.x); As[(kq + 1) * 132 + r] = hi16(av.x); As[(kq + 2) * 132 + r] = lo16(av.y); As[(kq + 3) * 132 + r] = hi16(av.y);
        Bs0[(kq + 0) * 132 + r] = lo16(bv0.x); Bs0[(kq + 1) * 132 + r] = hi16(bv0.x); Bs0[(kq + 2) * 132 + r] = lo16(bv0.y); Bs0[(kq + 3) * 132 + r] = hi16(bv0.y);
        if (NB == 2) { Bs1[(kq + 0) * 132 + r] = lo16(bv1.x); Bs1[(kq + 1) * 132 + r] = hi16(bv1.x); Bs1[(kq + 2) * 132 + r] = lo16(bv1.y); Bs1[(kq + 3) * 132 + r] = hi16(bv1.y); }
        __syncthreads();
#pragma unroll 2
        for (int kk = 0; kk < 16; ++kk) {
            const f32x4 a0 = *(const LAS f32x4*)(As + kk * 132 + ty * 8), a1 = *(const LAS f32x4*)(As + kk * 132 + ty * 8 + 4);
            const f32x4 b0 = *(const LAS f32x4*)(Bs0 + kk * 132 + tx * 4);
            const float a[8] = {a0.x, a0.y, a0.z, a0.w, a1.x, a1.y, a1.z, a1.w};
#pragma unroll
            for (int i = 0; i < 8; ++i) { acc[0][i][0] += a[i] * b0.x; acc[0][i][1] += a[i] * b0.y; acc[0][i][2] += a[i] * b0.z; acc[0][i][3] += a[i] * b0.w; }
            if (NB == 2) { const f32x4 b1 = *(const LAS f32x4*)(Bs1 + kk * 132 + tx * 4);
#pragma unroll
                for (int i = 0; i < 8; ++i) { acc[NB - 1][i][0] += a[i] * b1.x; acc[NB - 1][i][1] += a[i] * b1.y; acc[NB - 1][i][2] += a[i] * b1.z; acc[NB - 1][i][3] += a[i] * b1.w; } }
        }
        __syncthreads();
    }
#pragma unroll
    for (int i = 0; i < 8; ++i) { const int m = m0 + ty * 8 + i;
        if (m < mvalid) {
#pragma unroll
            for (int j = 0; j < 4; ++j) epi(m, n0 + tx * 4 + j, acc[0][i][j], acc[NB - 1][i][j]); } }
}
struct RowPlain { const bf16_t* A; int lda; __device__ __forceinline__ const bf16_t* operator()(int m) const { return A + (size_t)m * lda; } };

template <class Epi>
__device__ __forceinline__ void ngemm_dense(const bf16_t* A, int lda, const bf16_t* Bt, int ldb, int Mr, int N, int K, const Epi& epi, LAS float* sm) {
    const int nn = N / 128, nunits = (Mr / 128) * nn; RowPlain rp{A, lda};
    for (int u = blockIdx.x; u < nunits; u += gridDim.x) ngemm_tile<1>(rp, Bt, ldb, 0, K, (u / nn) * 128, (u % nn) * 128, Mr, epi, sm);
}

struct EpiStoreBf16 { bf16_t* O; int ldc; __device__ __forceinline__ void operator()(int m, int n, float a, float) const { O[(size_t)m * ldc + n] = (bf16_t)f2bf(a); } };
struct EpiGate1 { const bf16_t* PR; float* T; __device__ __forceinline__ void operator()(int m, int n, float a, float) const { T[(size_t)m * D + n] = bf2f(PR[(size_t)m * NIN + C_GSB + n]) * a; } };
struct EpiGate2 { const bf16_t* PR; const float* T; bf16_t* MIX; __device__ __forceinline__ void operator()(int m, int n, float a, float) const {
    MIX[(size_t)m * D + n] = (bf16_t)f2bf(T[(size_t)m * D + n] + bf2f(PR[(size_t)m * NIN + C_GDF + n]) * a); } };
struct EpiResid { const float* base; float* out; __device__ __forceinline__ void operator()(int m, int n, float a, float) const { out[(size_t)m * D + n] = base[(size_t)m * D + n] + a; } };


namespace pg8 {
constexpr int BM = 256, BK = 64, HALF = 128, HTB = HALF * BK * 2, STAGE_BYTES = 8 * HTB;
__host__ __device__ __forceinline__ int lds_byte(int r, int c) { const int st = (r >> 4) * 2 + (c >> 5), rr = r & 15, cc = c & 31, ob = rr * 64 + cc * 2; return st * 1024 + (ob ^ (((ob >> 9) & 1) << 5)); }
__host__ __device__ __forceinline__ void stage_rc(int b, int& R, int& C) { const int st = b / 1024, sb = b % 1024, swz = sb ^ (((sb >> 9) & 1) << 5); R = (st >> 1) * 16 + swz / 64; C = (st & 1) * 32 + (swz % 64) / 2; }
__host__ __device__ __forceinline__ int perm32(int rho) { const int n = rho >> 4, i = rho & 15; return 8 * (i >> 2) + 4 * n + (i & 3); }
struct Unit { int pm, pn, e; };
struct Gemm { const bf16_t* A; const bf16_t* Bt; int lda, ldb, K; };
typedef float f32x2 __attribute__((ext_vector_type(2))); typedef __bf16 bf16x2_t __attribute__((ext_vector_type(2)));
__device__ __forceinline__ unsigned cvt_pk_bf16(float lo, float hi) { f32x2 v = {lo, hi}; bf16x2_t b = __builtin_convertvector(v, bf16x2_t); return __builtin_bit_cast(unsigned, b); }

typedef int v8i __attribute__((ext_vector_type(8))); typedef int v4i __attribute__((ext_vector_type(4)));
__device__ __forceinline__ v8i cat8(bf16x8 a, bf16x8 b) { return __builtin_shufflevector(__builtin_bit_cast(v4i, a), __builtin_bit_cast(v4i, b), 0, 1, 2, 3, 4, 5, 6, 7); }
template <class Epi, class Sched, bool GATHER, bool FP8 = false>
__device__ __forceinline__ void gemm_phase(LAS unsigned char* lds, const Gemm g, const Sched& S, const Epi& E) {
    const int tid = threadIdx.x, wid = __builtin_amdgcn_readfirstlane(tid >> 6), lane = tid & 63, wr = wid >> 2, wc = wid & 3, fr = lane & 15, fq = lane >> 4;
    const int K = g.K, nt = K / BK;
    unsigned voffB[2], cva[2][2], nva[2][2];
#pragma unroll
    for (int i = 0; i < 2; ++i) { int R, C; stage_rc(tid * 16 + i * 8192, R, C); const int Rb = (R & ~31) + perm32(R & 31);
        voffB[i] = (unsigned)(Rb * g.ldb + C) * 2u;
#pragma unroll
        for (int h = 0; h < 2; ++h) { cva[h][i] = (unsigned)((h * HALF + R) * g.lda + C) * 2u; nva[h][i] = cva[h][i]; } }
    const unsigned kstep = (unsigned)(BK * 2);
    const unsigned hstepB = (unsigned)(HALF * g.ldb * 2);
    auto uni_ptr = [](const void* p_) { const unsigned long long v_ = (unsigned long long)p_; return (void*)(((unsigned long long)(unsigned)__builtin_amdgcn_readfirstlane((int)(v_ >> 32)) << 32) | (unsigned)__builtin_amdgcn_readfirstlane((int)v_)); };
    const auto rA = __builtin_amdgcn_make_buffer_rsrc(uni_ptr(g.A), 0, 0x7fffffff, 0x00020000), rB = __builtin_amdgcn_make_buffer_rsrc(uni_ptr(g.Bt), 0, 0x7fffffff, 0x00020000);
    const unsigned ldsw = (unsigned)wid * 1024u;
    const int aoff = lds_byte(wr * 64 + fr, fq * 8), boff = lds_byte(wc * 32 + fr, fq * 8);
#define PG8_SA(b, h) (((b) * 2 + (h)) * HTB)
#define PG8_SB(b, h) ((4 + (b) * 2 + (h)) * HTB)
#define PG8_STAGE(bufoff, rs, soff, voff) do { _Pragma("unroll") for (int _i = 0; _i < 2; ++_i) \
        __builtin_amdgcn_raw_ptr_buffer_load_lds(rs, (LAS unsigned*)(lds + (bufoff) + ldsw + _i * 8192), 16, (int)(voff)[_i], (int)(soff), 0, 0); } while (0)
#define PG8_LDA(dst, b, h) do { _Pragma("unroll") for (int m = 0; m < 4; ++m) _Pragma("unroll") for (int k = 0; k < 2; ++k) dst[m][k] = *(const LAS bf16x8*)(lds + PG8_SA(b, h) + aoff + m * 2048 + k * 1024); } while (0)
#define PG8_LDB(dst, b, h) do { _Pragma("unroll") for (int n = 0; n < 2; ++n) _Pragma("unroll") for (int k = 0; k < 2; ++k) dst[n][k] = *(const LAS bf16x8*)(lds + PG8_SB(b, h) + boff + n * 2048 + k * 1024); } while (0)
#define PG8_MMA(ai, bj, At, Bt) do { __builtin_amdgcn_s_setprio(1); _Pragma("unroll") for (int m = 0; m < 4; ++m) _Pragma("unroll") for (int n = 0; n < 2; ++n) { \
        if constexpr (FP8) { const v8i b8_ = cat8(Bt[n][0], Bt[n][1]), a8_ = cat8(At[m][0], At[m][1]); \
            asm volatile("s_nop 1\n\tv_mfma_scale_f32_16x16x128_f8f6f4 %0, %1, %2, %0, %3, %3 op_sel_hi:[0,0,0]" : "+v"(acc[ai][bj][m][n]) : "v"(b8_), "v"(a8_), "v"(one_scale)); } \
        else { _Pragma("unroll") for (int k = 0; k < 2; ++k) acc[ai][bj][m][n] = __builtin_amdgcn_mfma_f32_16x16x32_bf16(Bt[n][k], At[m][k], acc[ai][bj][m][n], 0, 0, 0); } } __builtin_amdgcn_s_setprio(0); } while (0)
#define PG8_WAIT_V(n) asm volatile("s_waitcnt vmcnt(" #n ")" ::: "memory")
#define PG8_WAIT_L(n) asm volatile("s_waitcnt lgkmcnt(" #n ")" ::: "memory")
#define PG8_BAR __builtin_amdgcn_s_barrier()
#define PG8_SCHED __builtin_amdgcn_sched_barrier(0)
    Unit cur, nxt; int ui = 0;
    if (!S.next(0, cur)) return;
    if constexpr (GATHER) {
#pragma unroll
        for (int i = 0; i < 2; ++i) { int R, C; stage_rc(tid * 16 + i * 8192, R, C);
#pragma unroll
            for (int h = 0; h < 2; ++h) cva[h][i] = (unsigned)(S.tok(cur, h * HALF + R) * g.lda + C) * 2u; }
    }
    const int one_scale = 0x7f7f7f7f;
    (void)one_scale;
    f32x4 acc[2][2][4][2];
#pragma unroll
    for (int a = 0; a < 2; ++a)
#pragma unroll
        for (int b = 0; b < 2; ++b)
#pragma unroll
            for (int m = 0; m < 4; ++m)
#pragma unroll
                for (int n = 0; n < 2; ++n) acc[a][b][m][n] = (f32x4){0.f, 0.f, 0.f, 0.f};
    bf16x8 At[4][2], B0[2][2], B1[2][2];
    unsigned cA = GATHER ? 0u : (unsigned)S.a_off(cur), cB = (unsigned)S.b_off(cur);
    PG8_STAGE(PG8_SB(0, 0), rB, cB, voffB); PG8_STAGE(PG8_SB(0, 1), rB, cB + hstepB, voffB); PG8_STAGE(PG8_SA(0, 0), rA, cA, cva[0]); PG8_STAGE(PG8_SA(0, 1), rA, cA, cva[1]);
    if (wr == 1) PG8_BAR;
    PG8_WAIT_V(2); PG8_BAR;
    PG8_STAGE(PG8_SB(1, 0), rB, cB + kstep, voffB); PG8_STAGE(PG8_SA(1, 0), rA, cA + kstep, cva[0]); PG8_STAGE(PG8_SB(1, 1), rB, cB + hstepB + kstep, voffB);
    PG8_WAIT_V(6); PG8_BAR;
    for (;;) {
        const bool has_next = S.next(ui + 1, nxt);
        const unsigned nA = (has_next && !GATHER) ? (unsigned)S.a_off(nxt) : cA, nB = has_next ? (unsigned)S.b_off(nxt) : cB;
        if constexpr (GATHER) {
#pragma unroll
            for (int i = 0; i < 2; ++i) { int R, C; stage_rc(tid * 16 + i * 8192, R, C);
#pragma unroll
                for (int h = 0; h < 2; ++h) nva[h][i] = has_next ? (unsigned)(S.tok(nxt, h * HALF + R) * g.lda + C) * 2u : cva[h][i]; }
        }
#pragma nounroll
        for (int t = 0; t < nt; t += 2) {
            const bool last = (t == nt - 2);
            const unsigned a1 = cA + (unsigned)(t + 1) * kstep;
            const unsigned a2 = last ? nA : cA + (unsigned)(t + 2) * kstep, b2 = last ? nB : cB + (unsigned)(t + 2) * kstep;
            const unsigned a3 = a2 + kstep, b3 = b2 + kstep;
            unsigned v2[2][2];
#pragma unroll
            for (int h = 0; h < 2; ++h)
#pragma unroll
                for (int i = 0; i < 2; ++i) v2[h][i] = (GATHER && last) ? nva[h][i] : cva[h][i];
            PG8_LDB(B0, 0, 0); PG8_LDB(B1, 0, 1); PG8_SCHED; PG8_LDA(At, 0, 0); PG8_STAGE(PG8_SA(1, 1), rA, a1, cva[1]);
            PG8_WAIT_V(8); PG8_WAIT_L(0); PG8_BAR; PG8_MMA(0, 0, At, B0); PG8_MMA(0, 1, At, B1); PG8_BAR; PG8_SCHED;
            PG8_LDA(At, 0, 1); PG8_STAGE(PG8_SB(0, 0), rB, b2, voffB); PG8_STAGE(PG8_SB(0, 1), rB, b2 + hstepB, voffB); PG8_STAGE(PG8_SA(0, 0), rA, a2, v2[0]);
            PG8_WAIT_V(8); PG8_WAIT_L(0); PG8_BAR; PG8_MMA(1, 0, At, B0); PG8_MMA(1, 1, At, B1); PG8_BAR; PG8_SCHED;
            PG8_LDB(B0, 1, 0); PG8_LDB(B1, 1, 1); PG8_SCHED; PG8_LDA(At, 1, 0); PG8_STAGE(PG8_SA(0, 1), rA, a2, v2[1]);
            PG8_WAIT_V(8); PG8_WAIT_L(0); PG8_BAR; PG8_MMA(0, 0, At, B0); PG8_MMA(0, 1, At, B1); PG8_BAR; PG8_SCHED;
            PG8_LDA(At, 1, 1); PG8_STAGE(PG8_SB(1, 0), rB, b3, voffB); PG8_STAGE(PG8_SB(1, 1), rB, b3 + hstepB, voffB); PG8_STAGE(PG8_SA(1, 0), rA, a3, v2[0]);
            PG8_WAIT_V(8); PG8_WAIT_L(0); PG8_BAR; PG8_MMA(1, 0, At, B0); PG8_MMA(1, 1, At, B1); PG8_BAR; PG8_SCHED;
        }
        if (wr == 0) PG8_BAR;
        if constexpr (FP8) asm volatile("s_nop 15\n\ts_nop 7" ::: "memory");
        E(acc, cur, wr, wc, fr, fq);
        if (!has_next) break;
#pragma unroll
        for (int a = 0; a < 2; ++a)
#pragma unroll
            for (int b = 0; b < 2; ++b)
#pragma unroll
                for (int m = 0; m < 4; ++m)
#pragma unroll
                    for (int n = 0; n < 2; ++n) acc[a][b][m][n] = (f32x4){0.f, 0.f, 0.f, 0.f};
        cur = nxt; cA = nA; cB = nB; ++ui;
        if constexpr (GATHER) {
#pragma unroll
            for (int i = 0; i < 2; ++i)
#pragma unroll
                for (int h = 0; h < 2; ++h) cva[h][i] = nva[h][i];
        }
        if (wr == 1) PG8_BAR;
    }
    PG8_WAIT_V(0);
    PG8_BAR;
#undef PG8_SA
#undef PG8_SB
#undef PG8_STAGE
#undef PG8_LDA
#undef PG8_LDB
#undef PG8_MMA
#undef PG8_WAIT_V
#undef PG8_WAIT_L
#undef PG8_BAR
#undef PG8_SCHED
}

struct DenseOrder {
    int nM, nN, nwg, G, c, lda, ldb;
    __device__ __forceinline__ void init(int M_, int N_, int G_, int c_, int lda_, int ldb_) { nM = M_ / BM; nN = N_ / BM; nwg = nM * nN; G = G_; c = c_; lda = lda_; ldb = ldb_; }
    __device__ __forceinline__ bool next(int i, Unit& u) const {
        const long L = (long)i * G + c; if (L >= nwg) return false;
        int wgid = (int)L; { const int q = nwg / 8, r = nwg % 8, xcd = wgid % 8, off = wgid / 8; wgid = (xcd < r ? xcd * (q + 1) : r * (q + 1) + (xcd - r) * q) + off; }
        const int nig = 8 * nN, gid = wgid / nig, fm = gid * 8, gsz = (nM - fm) < 8 ? (nM - fm) : 8;
        u.pm = fm + ((wgid % nig) % gsz); u.pn = (wgid % nig) / gsz; u.e = 0; return true;
    }
    __device__ __forceinline__ size_t a_off(const Unit& u) const { return (size_t)u.pm * BM * lda * 2; }
    __device__ __forceinline__ size_t b_off(const Unit& u) const { return (size_t)u.pn * BM * ldb * 2; }
    __device__ __forceinline__ int tok(const Unit&, int) const { return 0; }
};
struct TwoRoundOrder {
    int G, c, lda, ldb;
    __device__ __forceinline__ bool next(int i, Unit& u) const { const int L = i * G + c; if (L >= 512) return false; const int tile = L & 255; u.pm = tile >> 2; u.pn = tile & 3; u.e = L >> 8; return true; }
    __device__ __forceinline__ size_t a_off(const Unit& u) const { return (size_t)u.pm * BM * lda * 2 + (size_t)u.e * 1024; }
    __device__ __forceinline__ size_t b_off(const Unit& u) const { return (size_t)(u.e * 1024 + u.pn * BM) * ldb * 2; }
    __device__ __forceinline__ int tok(const Unit&, int) const { return 0; }
};
struct MoeOrder {
    const LAS int* tb; const int* tlist; int G, c, npn, lda, ldb, nexp;
    __device__ __forceinline__ bool next(int i, Unit& u) const {
        const int L = i * G + c; if (L >= tb[96]) return false;
        int e = 0; while (tb[65 + e] <= L) ++e;
        const int loc = L - tb[64 + e]; u.e = __builtin_amdgcn_readfirstlane(e); u.pn = __builtin_amdgcn_readfirstlane(loc % npn); u.pm = __builtin_amdgcn_readfirstlane((tb[e] >> 8) + loc / npn); return true;
    }
    __device__ __forceinline__ size_t a_off(const Unit& u) const { return (size_t)u.pm * BM * lda * 2; }
    __device__ __forceinline__ size_t b_off(const Unit& u) const { return (size_t)(u.e * nexp + u.pn * BM) * ldb * 2; }
    __device__ __forceinline__ int tok(const Unit& u, int row) const { const int r = u.pm * BM - tb[u.e] + row; return r < tb[32 + u.e] ? tlist[u.e * LISTCAP + r] : 0; }
};

#define EPI_ARGS const f32x4 (&acc)[2][2][4][2], const Unit& u, int wr, int wc, int fr, int fq
#define EPI_FOR_ROWS for (int ai = 0; ai < 2; ++ai) _Pragma("unroll") for (int m = 0; m < 4; ++m)
__device__ __forceinline__ v4u pack8(const f32x4 a, const f32x4 b) { v4u w; w.x = cvt_pk_bf16(a[0], a[1]); w.y = cvt_pk_bf16(a[2], a[3]); w.z = cvt_pk_bf16(b[0], b[1]); w.w = cvt_pk_bf16(b[2], b[3]); return w; }
__device__ __forceinline__ void unpack8(const v4u w, f32x4& a, f32x4& b) { a = (f32x4){lo16(w.x), hi16(w.x), lo16(w.y), hi16(w.y)}; b = (f32x4){lo16(w.z), hi16(w.z), lo16(w.w), hi16(w.w)}; }
__device__ __forceinline__ float sigm(float v) { return __builtin_amdgcn_rcpf(1.f + __expf(-v)); }

__device__ __forceinline__ void store_tile_T(const f32x4 (&acc)[2][2][4][2], bf16_t* VT, int vrow0, int s0, int pitch) {
#pragma unroll
    for (int bj = 0; bj < 2; ++bj)
#pragma unroll
        for (int n = 0; n < 2; ++n)
#pragma unroll
            for (int e = 0; e < 4; ++e) { bf16_t* vp = VT + (size_t)(vrow0 + 128 * bj + 4 * n + e) * pitch + s0;
#pragma unroll
                for (int ai = 0; ai < 2; ++ai)
#pragma unroll
                    for (int m = 0; m < 4; ++m) vp[128 * ai + 16 * m] = (bf16_t)(cvt_pk_bf16(acc[ai][bj][m][n][e], 0.f) & 0xffffu); }
}
struct EpiKV { bf16_t* KVM; bf16_t* VTM;
    __device__ __forceinline__ void operator()(EPI_ARGS) const {
        const int row0 = u.pm * BM + wr * 64 + fr, col0 = u.pn * BM + wc * 32 + 8 * fq;
#pragma unroll
        EPI_FOR_ROWS { bf16_t* rowp = KVM + (size_t)(row0 + ai * HALF + m * 16) * 2048 + col0;
#pragma unroll
            for (int bj = 0; bj < 2; ++bj) *(v4u*)(rowp + bj * HALF) = pack8(acc[ai][bj][m][0], acc[ai][bj][m][1]); }
        if (u.pn >= 4) store_tile_T(acc, VTM, u.pm * 1024 + (u.pn - 4) * BM + wc * 32 + 8 * fq, wr * 64 + fr, MEMLEN);
    } };
struct EpiBf16Store { bf16_t* O; int ldc;
    __device__ __forceinline__ void operator()(EPI_ARGS) const {
        const int row0 = u.pm * BM + wr * 64 + fr, col0 = u.pn * BM + wc * 32 + 8 * fq;
#pragma unroll
        EPI_FOR_ROWS { bf16_t* rowp = O + (size_t)(row0 + ai * HALF + m * 16) * ldc + col0;
#pragma unroll
            for (int bj = 0; bj < 2; ++bj) *(v4u*)(rowp + bj * HALF) = pack8(acc[ai][bj][m][0], acc[ai][bj][m][1]); }
    } };
struct EpiResidF32 { const float* base; float* out;
    __device__ __forceinline__ void operator()(EPI_ARGS) const {
        const int row0 = u.pm * BM + wr * 64 + fr, col0 = u.pn * BM + wc * 32 + 8 * fq;
#pragma unroll
        EPI_FOR_ROWS { const size_t off = (size_t)(row0 + ai * HALF + m * 16) * D + col0;
#pragma unroll
            for (int bj = 0; bj < 2; ++bj)
#pragma unroll
                for (int n = 0; n < 2; ++n) { const f32x4 b = *(const f32x4*)(base + off + bj * HALF + 4 * n); *(f32x4*)(out + off + bj * HALF + 4 * n) = b + acc[ai][bj][m][n]; } }
    } };
struct EpiResidNorm { const float* base; float* out; bf16_t* XB; float* SSQ;
    __device__ __forceinline__ void operator()(EPI_ARGS) const {
        const int row0 = u.pm * BM + wr * 64 + fr, col0 = u.pn * BM + wc * 32 + 8 * fq;
#pragma unroll
        EPI_FOR_ROWS { const int row = row0 + ai * HALF + m * 16; const size_t off = (size_t)row * D + col0; float ss = 0.f;
#pragma unroll
            for (int bj = 0; bj < 2; ++bj) { f32x4 v[2];
#pragma unroll
                for (int n = 0; n < 2; ++n) { v[n] = *(const f32x4*)(base + off + bj * HALF + 4 * n) + acc[ai][bj][m][n]; *(f32x4*)(out + off + bj * HALF + 4 * n) = v[n];
                    ss += (v[n][0] * v[n][0] + v[n][1] * v[n][1]) + (v[n][2] * v[n][2] + v[n][3] * v[n][3]); }
                *(v4u*)(XB + off + bj * HALF) = pack8(v[0], v[1]); }
            ss += __shfl_xor(ss, 16); ss += __shfl_xor(ss, 32);
            if (fq == 0) SSQ[(size_t)row * 16 + u.pn * 4 + wc] = ss; }
    } };
struct EpiBf16Rinv { bf16_t* O; const float* SSQ;
    __device__ __forceinline__ void operator()(EPI_ARGS) const {
        const int row0 = u.pm * BM + wr * 64 + fr, col0 = u.pn * BM + wc * 32 + 8 * fq;
#pragma unroll
        EPI_FOR_ROWS { const int row = row0 + ai * HALF + m * 16; const f32x4* sp = (const f32x4*)(SSQ + (size_t)row * 16);
            const f32x4 s0 = sp[0], s1 = sp[1], s2 = sp[2], s3 = sp[3];
            const float tot = (((s0[0] + s0[1]) + (s0[2] + s0[3])) + ((s1[0] + s1[1]) + (s1[2] + s1[3]))) + (((s2[0] + s2[1]) + (s2[2] + s2[3])) + ((s3[0] + s3[1]) + (s3[2] + s3[3])));
            const float rinv = 1.0f / sqrtf(tot * (1.f / 1024.f) + NORM_EPS);
            bf16_t* rowp = O + (size_t)row * D + col0;
#pragma unroll
            for (int bj = 0; bj < 2; ++bj) *(v4u*)(rowp + bj * HALF) = pack8(acc[ai][bj][m][0] * rinv, acc[ai][bj][m][1] * rinv); }
    } };
struct OneUnitOrder {
    int idx, lda, ldb;
    __device__ __forceinline__ bool next(int i, Unit& u) const { if (i > 0) return false; u.pm = idx >> 3; u.pn = idx & 7; u.e = 0; return true; }
    __device__ __forceinline__ size_t a_off(const Unit& u) const { return (size_t)u.pm * BM * lda * 2; }
    __device__ __forceinline__ size_t b_off(const Unit& u) const { return (size_t)u.pn * BM * ldb * 2; }
    __device__ __forceinline__ int tok(const Unit&, int) const { return 0; }
};
struct EpiGate { const bf16_t* PR; float* T; bf16_t* MIX;
    __device__ __forceinline__ void operator()(EPI_ARGS) const {
        const int row0 = u.pm * BM + wr * 64 + fr, col0 = u.pn * BM + wc * 32 + 8 * fq;
#pragma unroll
        EPI_FOR_ROWS { const int row = row0 + ai * HALF + m * 16;
#pragma unroll
            for (int bj = 0; bj < 2; ++bj) { const int col = col0 + bj * HALF; f32x4 g0, g1;
                unpack8(*(const v4u*)(PR + (size_t)row * NIN + (u.e ? C_GDF : C_GSB) + col), g0, g1);
                float* tp = T + (size_t)row * D + col;
                if (u.e == 0) { *(f32x4*)tp = g0 * acc[ai][bj][m][0]; *(f32x4*)(tp + 4) = g1 * acc[ai][bj][m][1]; }
                else { const f32x4 t0 = *(const f32x4*)tp, t1 = *(const f32x4*)(tp + 4); *(v4u*)(MIX + (size_t)row * D + col) = pack8(t0 + g0 * acc[ai][bj][m][0], t1 + g1 * acc[ai][bj][m][1]); } } }
    } };
struct EpiInProj { bf16_t* PR; const float* rc; const float* rs; bf16_t* VTSB; bf16_t* VTDF;
    __device__ __forceinline__ void operator()(EPI_ARGS) const {
        const int row0 = u.pm * BM + wr * 64 + fr, pn = u.pn;
        if (pn >= 6 && pn < 10) {
            const float sc = pn < 8 ? 0.125f : 1.0f; const int i0 = 16 * (wc & 1) + 4 * fq;
#pragma unroll
            EPI_FOR_ROWS { const int row = row0 + ai * HALF + m * 16; const f32x4 cs = *(const f32x4*)(rc + (size_t)row * 32 + i0), sn = *(const f32x4*)(rs + (size_t)row * 32 + i0);
#pragma unroll
                for (int bj = 0; bj < 2; ++bj) { const f32x4 lo = acc[ai][bj][m][0], hi = acc[ai][bj][m][1];
                    const f32x4 olo = (lo * cs - hi * sn) * sc, ohi = (hi * cs + lo * sn) * sc;
                    bf16_t* p = PR + (size_t)row * NIN + pn * BM + 64 * (2 * bj + (wc >> 1)) + i0;
                    v2u a, b; a.x = cvt_pk_bf16(olo[0], olo[1]); a.y = cvt_pk_bf16(olo[2], olo[3]); b.x = cvt_pk_bf16(ohi[0], ohi[1]); b.y = cvt_pk_bf16(ohi[2], ohi[3]);
                    *(v2u*)p = a; *(v2u*)(p + 32) = b; } }
        } else {
            const int col0 = pn * BM + wc * 32 + 8 * fq; const float sc = pn < 2 ? 0.125f : 1.0f; const bool sg = pn >= 12;
#pragma unroll
            EPI_FOR_ROWS { bf16_t* rowp = PR + (size_t)(row0 + ai * HALF + m * 16) * NIN + col0;
#pragma unroll
                for (int bj = 0; bj < 2; ++bj) { f32x4 v0 = acc[ai][bj][m][0] * sc, v1 = acc[ai][bj][m][1] * sc;
                    if (sg) { v0 = (f32x4){sigm(v0[0]), sigm(v0[1]), sigm(v0[2]), sigm(v0[3])}; v1 = (f32x4){sigm(v1[0]), sigm(v1[1]), sigm(v1[2]), sigm(v1[3])}; }
                    *(v4u*)(rowp + bj * HALF) = pack8(v0, v1); } }
            if (pn == 4 || pn == 5 || pn == 10 || pn == 11) {
                const int bb = u.pm >> 4, s0 = (u.pm & 15) * BM + wr * 64 + fr, hd0 = (pn < 6 ? (pn - 4) : (pn - 10)) * BM + wc * 32 + 8 * fq;
                store_tile_T(acc, pn < 6 ? VTSB : VTDF, bb * 512 + hd0, s0, SEQ);
            }
        }
    } };
struct EpiMoeGU { unsigned char* ACT8; const float* bgu; const float* wsc;
    __device__ __forceinline__ void operator()(EPI_ARGS) const {
        const int row0 = u.pm * BM + wr * 64 + fr, j0 = u.pn * 128 + wc * 32 + 8 * fq; const float* bg = bgu + (size_t)u.e * 2048 + j0; const float* sg = wsc + (size_t)u.e * 2048 + j0;
#pragma unroll
        EPI_FOR_ROWS { f32x4 o[2];
#pragma unroll
            for (int n = 0; n < 2; ++n) { const f32x4 gv = acc[ai][0][m][n] * *(const f32x4*)(sg + 4 * n) + *(const f32x4*)(bg + 4 * n), lv = acc[ai][1][m][n] * *(const f32x4*)(sg + 1024 + 4 * n) + *(const f32x4*)(bg + 1024 + 4 * n);
#pragma unroll
                for (int c = 0; c < 4; ++c) { const float gl = fminf(gv[c], 7.0f), li = fminf(fmaxf(lv[c], -7.0f), 7.0f); o[n][c] = gl * sigm(1.702f * gl) * (li + 1.0f); } }
            v2u w; w.x = pk4_fp8(o[0][0], o[0][1], o[0][2], o[0][3]); w.y = pk4_fp8(o[1][0], o[1][1], o[1][2], o[1][3]);
            *(v2u*)(ACT8 + (size_t)(row0 + ai * HALF + m * 16) * DFF + j0) = w; }
    } };
struct EpiMoeDown { bf16_t* YB; const float* bd; const float* glist; const LAS int* tb; const float* wsc;
    __device__ __forceinline__ void operator()(EPI_ARGS) const {
        const int row0 = u.pm * BM + wr * 64 + fr, col0 = u.pn * BM + wc * 32 + 8 * fq; const float* bp = bd + (size_t)u.e * D + col0; const float* sp = wsc + (size_t)u.e * D + col0;
        const float* gl = glist + (size_t)u.e * LISTCAP - tb[u.e];
        f32x4 bv[2][2], sv[2][2];
#pragma unroll
        for (int bj = 0; bj < 2; ++bj)
#pragma unroll
            for (int n = 0; n < 2; ++n) { bv[bj][n] = *(const f32x4*)(bp + bj * HALF + 4 * n); sv[bj][n] = *(const f32x4*)(sp + bj * HALF + 4 * n); }
#pragma unroll
        EPI_FOR_ROWS { const int row = row0 + ai * HALF + m * 16; const float gt = gl[row];
#pragma unroll
            for (int bj = 0; bj < 2; ++bj) *(v4u*)(YB + (size_t)row * D + col0 + bj * HALF) = pack8((acc[ai][bj][m][0] * sv[bj][0] + bv[bj][0]) * gt, (acc[ai][bj][m][1] * sv[bj][1] + bv[bj][1]) * gt); }
    } };
}


typedef float f32x16 __attribute__((ext_vector_type(16)));
typedef short s16x4 __attribute__((ext_vector_type(4)));
__device__ __forceinline__ f32x16 mfma32(bf16x8 a, bf16x8 b, f32x16 c) { return __builtin_amdgcn_mfma_f32_32x32x16_bf16(a, b, c, 0, 0, 0); }
__device__ __forceinline__ float xhalf(float v, int hh) { auto rr = __builtin_amdgcn_permlane32_swap(__float_as_uint(v), __float_as_uint(v), false, false); return __uint_as_float(hh ? rr[0] : rr[1]); }
__device__ __forceinline__ bf16x8 vt_frag(const bf16_t* p) { const s16x4 lo = *(const s16x4*)p, hi = *(const s16x4*)(p + 8); return (bf16x8){lo[0], lo[1], lo[2], lo[3], hi[0], hi[1], hi[2], hi[3]}; }
__device__ __forceinline__ bf16x8 pack_p(const f32x16& p, int s) { v4u w; w.x = pg8::cvt_pk_bf16(p[8 * s + 0], p[8 * s + 1]); w.y = pg8::cvt_pk_bf16(p[8 * s + 2], p[8 * s + 3]); w.z = pg8::cvt_pk_bf16(p[8 * s + 4], p[8 * s + 5]); w.w = pg8::cvt_pk_bf16(p[8 * s + 6], p[8 * s + 7]); return __builtin_bit_cast(bf16x8, w); }
constexpr float LOG2E = 1.4426950408889634f;

template <int NO>
__device__ __forceinline__ void softmax_step(f32x16& S, float C, float& m, float& l, f32x16 (&O)[NO], int hh) {
    float mx = fmaxf(fmaxf(S[0], S[1]), fmaxf(S[2], S[3]));
#pragma unroll
    for (int i = 4; i < 16; i += 4) mx = fmaxf(mx, fmaxf(fmaxf(S[i], S[i + 1]), fmaxf(S[i + 2], S[i + 3])));
    mx = fmaxf(mx, xhalf(mx, hh)) * C;
    const float mn = fmaxf(m, mx), al = __builtin_amdgcn_exp2f(m - mn);
    m = mn; l *= al;
#pragma unroll
    for (int o = 0; o < NO; ++o) O[o] = O[o] * al;
    float ps = 0.f;
#pragma unroll
    for (int i = 0; i < 16; ++i) { S[i] = __builtin_amdgcn_exp2f(S[i] * C - mn); ps += S[i]; }
    l += ps;
}

__device__ __forceinline__ void attn_diff_wave(const bf16_t* PR, const bf16_t* VT, float* ODR, int b, int h, int j, int q0, int lane) {
    const int r32 = lane & 31, hh = lane >> 5;
    const bf16_t* qrow = PR + (size_t)(b * SEQ + q0 + r32) * NIN + C_DQ + h * 128 + j * 64 + 8 * hh;
    bf16x8 qf[4];
#pragma unroll
    for (int d0 = 0; d0 < 4; ++d0) qf[d0] = *(const bf16x8*)(qrow + 16 * d0);
    const bf16_t* kbase = PR + (size_t)(b * SEQ + r32) * NIN + C_DK + h * 128 + j * 64 + 8 * hh;
    const bf16_t* vbase = VT + (size_t)(b * 512 + h * 128 + r32) * SEQ + 4 * hh;
    f32x16 O[4];
#pragma unroll
    for (int o = 0; o < 4; ++o)
#pragma unroll
        for (int i = 0; i < 16; ++i) O[o][i] = 0.f;
    float m = -INFINITY, l = 0.f;
    const int nt = 2 * (q0 / 64 + 1);
    for (int t = 0; t < nt; ++t) {
        const bf16_t* kp = kbase + (size_t)(32 * t) * NIN;
        f32x16 S;
#pragma unroll
        for (int i = 0; i < 16; ++i) S[i] = 0.f;
#pragma unroll
        for (int d0 = 0; d0 < 4; ++d0) S = mfma32(*(const bf16x8*)(kp + 16 * d0), qf[d0], S);
        softmax_step<4>(S, LOG2E, m, l, O, hh);
        const bf16x8 p0 = pack_p(S, 0), p1 = pack_p(S, 1);
        const bf16_t* vp = vbase + 32 * t;
#pragma unroll
        for (int o = 0; o < 4; ++o) { O[o] = mfma32(vt_frag(vp + (size_t)(32 * o) * SEQ), p0, O[o]); O[o] = mfma32(vt_frag(vp + (size_t)(32 * o) * SEQ + 16), p1, O[o]); }
    }
    l += xhalf(l, hh);
    const float il = 1.f / l;
    float* orow = ODR + ((size_t)j * M + (size_t)b * SEQ + q0 + r32) * 512 + h * 128 + 4 * hh;
#pragma unroll
    for (int o = 0; o < 4; ++o)
#pragma unroll
        for (int g = 0; g < 4; ++g) *(f32x4*)(orow + 32 * o + 8 * g) = (f32x4){O[o][4 * g] * il, O[o][4 * g + 1] * il, O[o][4 * g + 2] * il, O[o][4 * g + 3] * il};
}

__device__ __forceinline__ void attn_sb_wave(const bf16_t* PR, const bf16_t* VT, bf16_t* OAT, int b, int h, int q0, int lane) {
    const int r32 = lane & 31, hh = lane >> 5;
    const bf16_t* qrow = PR + (size_t)(b * SEQ + q0 + r32) * NIN + C_SBQ + h * 64 + 8 * hh;
    bf16x8 qf[4];
#pragma unroll
    for (int d0 = 0; d0 < 4; ++d0) qf[d0] = *(const bf16x8*)(qrow + 16 * d0);
    const bf16_t* kbase = PR + (size_t)(b * SEQ + r32) * NIN + C_SBK + h * 64 + 8 * hh;
    const bf16_t* vbase = VT + (size_t)(b * 512 + h * 64 + r32) * SEQ + 4 * hh;
    f32x16 O[2];
#pragma unroll
    for (int o = 0; o < 2; ++o)
#pragma unroll
        for (int i = 0; i < 16; ++i) O[o][i] = 0.f;
    float R = 0.f;
    const int td = q0 >> 5;
    for (int t = td; t >= 0; --t) {
        const bf16_t* kp = kbase + (size_t)(32 * t) * NIN;
        f32x16 S;
#pragma unroll
        for (int i = 0; i < 16; ++i) S[i] = 0.f;
#pragma unroll
        for (int d0 = 0; d0 < 4; ++d0) S = mfma32(*(const bf16x8*)(kp + 16 * d0), qf[d0], S);
        f32x16 lr;
#pragma unroll
        for (int i = 0; i < 16; ++i) { const float z2 = S[i] * LOG2E; const float sp = fmaxf(z2, 0.f) + __builtin_amdgcn_logf(1.f + __builtin_amdgcn_exp2f(-fabsf(z2)));
            lr[i] = -sp; S[i] = z2 - sp; }
        if (t == td) {
#pragma unroll
            for (int i = 0; i < 16; ++i) { const int kvl = (i & 3) + 8 * (i >> 2) + 4 * hh; if (kvl >= r32) { lr[i] = 0.f; S[i] = -INFINITY; } }
        }
        float tot[4], pt[4], off[4];
        f32x16 ex;
#pragma unroll
        for (int g = 0; g < 4; ++g) { ex[4 * g + 3] = 0.f; ex[4 * g + 2] = lr[4 * g + 3]; ex[4 * g + 1] = lr[4 * g + 3] + lr[4 * g + 2]; ex[4 * g] = ex[4 * g + 1] + lr[4 * g + 1]; tot[g] = ex[4 * g] + lr[4 * g]; }
#pragma unroll
        for (int g = 0; g < 4; ++g) pt[g] = xhalf(tot[g], hh);
        const float own0 = hh ? 0.f : 1.f;
        float sp_ = 0.f;
#pragma unroll
        for (int g = 3; g >= 0; --g) { off[g] = sp_ + own0 * pt[g] + R; sp_ += tot[g] + pt[g]; }
#pragma unroll
        for (int i = 0; i < 16; ++i) S[i] = __builtin_amdgcn_exp2f(S[i] + ex[i] + off[i >> 2]);
        R += sp_;
        const bf16x8 p0 = pack_p(S, 0), p1 = pack_p(S, 1);
        const bf16_t* vp = vbase + 32 * t;
#pragma unroll
        for (int o = 0; o < 2; ++o) { O[o] = mfma32(vt_frag(vp + (size_t)(32 * o) * SEQ), p0, O[o]); O[o] = mfma32(vt_frag(vp + (size_t)(32 * o) * SEQ + 16), p1, O[o]); }
        if (__all(R < -160.f)) break;
    }
    bf16_t* orow = OAT + (size_t)(b * SEQ + q0 + r32) * D + h * 64 + 4 * hh;
#pragma unroll
    for (int o = 0; o < 2; ++o)
#pragma unroll
        for (int g = 0; g < 4; ++g) { v2u w; w.x = pg8::cvt_pk_bf16(O[o][4 * g], O[o][4 * g + 1]); w.y = pg8::cvt_pk_bf16(O[o][4 * g + 2], O[o][4 * g + 3]); *(v2u*)(orow + 32 * o + 8 * g) = w; }
}

__device__ __forceinline__ void attn_mem_wave(const bf16_t* QM, const bf16_t* KVM, const bf16_t* VT, bf16_t* OM, int b, int h, int q0, int lane) {
    const int r32 = lane & 31, hh = lane >> 5;
    const bf16_t* qrow = QM + (size_t)(b * SEQ + q0 + r32) * D + h * 256 + 8 * hh;
    const bf16_t* kbase = KVM + (size_t)(b * MEMLEN + r32) * 2048 + h * 256 + 8 * hh;
    for (int dh = 0; dh < 2; ++dh) {
        const bf16_t* vbase = VT + (size_t)(b * 1024 + h * 256 + dh * 128 + r32) * MEMLEN + 4 * hh;
        f32x16 O[4];
#pragma unroll
        for (int o = 0; o < 4; ++o)
#pragma unroll
            for (int i = 0; i < 16; ++i) O[o][i] = 0.f;
        float m = -INFINITY, l = 0.f;
        for (int t = 0; t < 8; ++t) {
            const bf16_t* kp = kbase + (size_t)(32 * t) * 2048;
            f32x16 S;
#pragma unroll
            for (int i = 0; i < 16; ++i) S[i] = 0.f;
#pragma unroll
            for (int d0 = 0; d0 < 16; ++d0) S = mfma32(*(const bf16x8*)(kp + 16 * d0), *(const bf16x8*)(qrow + 16 * d0), S);
            softmax_step<4>(S, LOG2E * 0.0625f, m, l, O, hh);
            const bf16x8 p0 = pack_p(S, 0), p1 = pack_p(S, 1);
            const bf16_t* vp = vbase + 32 * t;
#pragma unroll
            for (int o = 0; o < 4; ++o) { O[o] = mfma32(vt_frag(vp + (size_t)(32 * o) * MEMLEN), p0, O[o]); O[o] = mfma32(vt_frag(vp + (size_t)(32 * o) * MEMLEN + 16), p1, O[o]); }
        }
        l += xhalf(l, hh);
        const float il = 1.f / l;
        bf16_t* orow = OM + (size_t)(b * SEQ + q0 + r32) * D + h * 256 + dh * 128 + 4 * hh;
#pragma unroll
        for (int o = 0; o < 4; ++o)
#pragma unroll
            for (int g = 0; g < 4; ++g) { v2u w; w.x = pg8::cvt_pk_bf16(O[o][4 * g] * il, O[o][4 * g + 1] * il); w.y = pg8::cvt_pk_bf16(O[o][4 * g + 2] * il, O[o][4 * g + 3] * il); *(v2u*)(orow + 32 * o + 8 * g) = w; }
    }
}


constexpr int VSTR = 136;
template <int NCH> __device__ __forceinline__ void stage_load(v4u (&r)[NCH], const bf16_t* g0, int chunks_per_row, size_t gpitch, int tid) {
#pragma unroll
    for (int i = 0; i < NCH; ++i) { const int c = tid + NTHR * i, row = c / chunks_per_row, ch = c % chunks_per_row; r[i] = *(const v4u*)(g0 + (size_t)row * gpitch + ch * 8); }
}
template <int NCH> __device__ __forceinline__ void stage_store_k(const v4u (&r)[NCH], LAS unsigned char* dst, int chunks_per_row, int lstride, int tid) {
#pragma unroll
    for (int i = 0; i < NCH; ++i) { const int c = tid + NTHR * i, row = c / chunks_per_row, ch = c % chunks_per_row; *(LAS v4u*)(dst + row * lstride + ch * 16) = r[i]; }
}
template <int NCH> __device__ __forceinline__ void stage_store_v(const v4u (&r)[NCH], LAS unsigned char* dst, int tid) {
#pragma unroll
    for (int i = 0; i < NCH; ++i) { const int c = tid + NTHR * i, row = c >> 3, ch = c & 7; LAS v2u* d = (LAS v2u*)(dst + row * VSTR + ch * 16); d[0] = (v2u){r[i].x, r[i].y}; d[1] = (v2u){r[i].z, r[i].w}; }
}
__device__ __forceinline__ bf16x8 lds_vfrag(const LAS unsigned char* p) { const v2u lo = *(const LAS v2u*)p, hi = *(const LAS v2u*)(p + 16); return __builtin_bit_cast(bf16x8, (v4u){lo.x, lo.y, hi.x, hi.y}); }

template <int NO>
__device__ __forceinline__ void softmax_step2(f32x16& S0, f32x16& S1, float C, float& m, float& l, f32x16 (&O)[NO], int hh) {
    float mx = fmaxf(fmaxf(S0[0], S0[1]), fmaxf(S1[0], S1[1]));
#pragma unroll
    for (int i = 2; i < 16; i += 2) mx = fmaxf(mx, fmaxf(fmaxf(S0[i], S0[i + 1]), fmaxf(S1[i], S1[i + 1])));
    mx = fmaxf(mx, xhalf(mx, hh)) * C;
    const float mn = fmaxf(m, mx), al = __builtin_amdgcn_exp2f(m - mn);
    m = mn; l *= al;
#pragma unroll
    for (int o = 0; o < NO; ++o) O[o] = O[o] * al;
    float ps = 0.f;
#pragma unroll
    for (int i = 0; i < 16; ++i) { S0[i] = __builtin_amdgcn_exp2f(S0[i] * C - mn); S1[i] = __builtin_amdgcn_exp2f(S1[i] * C - mn); ps += S0[i] + S1[i]; }
    l += ps;
}

__device__ __forceinline__ void attn_diff_block(const bf16_t* PR, const bf16_t* VT, bf16_t* OAT, const float* subln, float lam, int b, int h, int qb, LAS unsigned char* lds, int tid, int wave, int lane) {
    constexpr int KSTR = 144, KB = 64 * KSTR, BUF = 2 * KB + 128 * VSTR;
    const int r32 = lane & 31, hh = lane >> 5, j = wave >> 2, w4 = wave & 3, q0 = qb * 128 + w4 * 32;
    const bf16_t* qrow = PR + (size_t)(b * SEQ + q0 + r32) * NIN + C_DQ + h * 128 + j * 64 + 8 * hh;
    bf16x8 qf[4];
#pragma unroll
    for (int d0 = 0; d0 < 4; ++d0) qf[d0] = *(const bf16x8*)(qrow + 16 * d0);
    const bf16_t* kg = PR + (size_t)(b * SEQ) * NIN + C_DK + h * 128;
    const bf16_t* vg = VT + (size_t)(b * 512 + h * 128) * SEQ;
    f32x16 O[4];
#pragma unroll
    for (int o = 0; o < 4; ++o)
#pragma unroll
        for (int i = 0; i < 16; ++i) O[o][i] = 0.f;
    float m = -INFINITY, l = 0.f;
    const int nsteps = 2 * qb + 2, my_last = 2 * qb + (w4 >> 1);
    v4u k1r[1], k2r[1], vr[2];
    stage_load<1>(k1r, kg, 8, NIN, tid); stage_load<1>(k2r, kg + 64, 8, NIN, tid); stage_load<2>(vr, vg, 8, SEQ, tid);
    stage_store_k<1>(k1r, lds, 8, KSTR, tid); stage_store_k<1>(k2r, lds + KB, 8, KSTR, tid); stage_store_v<2>(vr, lds + 2 * KB, tid);
    __syncthreads();
    for (int t = 0; t < nsteps; ++t) {
        const bool more = t + 1 < nsteps;
        if (more) { const bf16_t* kn = kg + (size_t)(64 * (t + 1)) * NIN; stage_load<1>(k1r, kn, 8, NIN, tid); stage_load<1>(k2r, kn + 64, 8, NIN, tid); stage_load<2>(vr, vg + 64 * (t + 1), 8, SEQ, tid); }
        if (t <= my_last) {
            const LAS unsigned char* kb = lds + (t & 1) * BUF + j * KB + r32 * KSTR + 16 * hh; const LAS unsigned char* vb = lds + (t & 1) * BUF + 2 * KB + r32 * VSTR + 8 * hh;
            f32x16 S0, S1;
#pragma unroll
            for (int i = 0; i < 16; ++i) { S0[i] = 0.f; S1[i] = 0.f; }
#pragma unroll
            for (int d0 = 0; d0 < 4; ++d0) { S0 = mfma32(*(const LAS bf16x8*)(kb + 32 * d0), qf[d0], S0); S1 = mfma32(*(const LAS bf16x8*)(kb + 32 * KSTR + 32 * d0), qf[d0], S1); }
            softmax_step2<4>(S0, S1, LOG2E, m, l, O, hh);
            const bf16x8 p00 = pack_p(S0, 0), p01 = pack_p(S0, 1), p10 = pack_p(S1, 0), p11 = pack_p(S1, 1);
#pragma unroll
            for (int o = 0; o < 4; ++o) { const LAS unsigned char* vp = vb + 32 * o * VSTR;
                O[o] = mfma32(lds_vfrag(vp), p00, O[o]); O[o] = mfma32(lds_vfrag(vp + 32), p01, O[o]); O[o] = mfma32(lds_vfrag(vp + 64), p10, O[o]); O[o] = mfma32(lds_vfrag(vp + 96), p11, O[o]); }
        }
        if (more) { LAS unsigned char* nb = lds + ((t + 1) & 1) * BUF; stage_store_k<1>(k1r, nb, 8, KSTR, tid); stage_store_k<1>(k2r, nb + KB, 8, KSTR, tid); stage_store_v<2>(vr, nb + 2 * KB, tid); }
        __syncthreads();
    }
    l += xhalf(l, hh);
    const float il = 1.f / l;
    LAS float* X = (LAS float*)lds + (size_t)(w4 * 32 + r32) * 132 + 4 * hh;
    if (j == 1) {
#pragma unroll
        for (int o = 0; o < 4; ++o)
#pragma unroll
            for (int g = 0; g < 4; ++g) *(LAS f32x4*)(X + 32 * o + 8 * g) = (f32x4){O[o][4 * g] * il, O[o][4 * g + 1] * il, O[o][4 * g + 2] * il, O[o][4 * g + 3] * il};
    }
    __syncthreads();
    if (j == 0) {
        float ss = 0.f;
#pragma unroll
        for (int o = 0; o < 4; ++o)
#pragma unroll
            for (int g = 0; g < 4; ++g) { const f32x4 o2 = *(const LAS f32x4*)(X + 32 * o + 8 * g);
#pragma unroll
                for (int c = 0; c < 4; ++c) { const float d = O[o][4 * g + c] * il - lam * o2[c]; O[o][4 * g + c] = d; ss += d * d; } }
        ss += xhalf(ss, hh);
        const float rinv = 0.8f / sqrtf(ss * (1.f / 128.f) + NORM_EPS);
        bf16_t* orow = OAT + (size_t)(b * SEQ + q0 + r32) * D + 512 + h * 128 + 4 * hh; const float* sl = subln + 4 * hh;
#pragma unroll
        for (int o = 0; o < 4; ++o)
#pragma unroll
            for (int g = 0; g < 4; ++g) { const f32x4 sg_ = *(const f32x4*)(sl + 32 * o + 8 * g); v2u w;
                w.x = pg8::cvt_pk_bf16(O[o][4 * g] * rinv * sg_[0], O[o][4 * g + 1] * rinv * sg_[1]); w.y = pg8::cvt_pk_bf16(O[o][4 * g + 2] * rinv * sg_[2], O[o][4 * g + 3] * rinv * sg_[3]); *(v2u*)(orow + 32 * o + 8 * g) = w; }
    }
    __syncthreads();
}

__device__ __forceinline__ void sb_subtile(f32x16& S, bool diag, float& R, f32x16 (&O)[2], const LAS unsigned char* vp, int r32, int hh) {
    f32x16 lr;
#pragma unroll
    for (int i = 0; i < 16; ++i) { const float z2 = S[i] * LOG2E; const float sp = fmaxf(z2, 0.f) + __builtin_amdgcn_logf(1.f + __builtin_amdgcn_exp2f(-fabsf(z2))); lr[i] = -sp; S[i] = z2 - sp; }
    if (diag) {
#pragma unroll
        for (int i = 0; i < 16; ++i) { const int kvl = (i & 3) + 8 * (i >> 2) + 4 * hh; if (kvl >= r32) { lr[i] = 0.f; S[i] = -INFINITY; } }
    }
    float tot[4], pt[4], off[4]; f32x16 ex;
#pragma unroll
    for (int g = 0; g < 4; ++g) { ex[4 * g + 3] = 0.f; ex[4 * g + 2] = lr[4 * g + 3]; ex[4 * g + 1] = lr[4 * g + 3] + lr[4 * g + 2]; ex[4 * g] = ex[4 * g + 1] + lr[4 * g + 1]; tot[g] = ex[4 * g] + lr[4 * g]; }
#pragma unroll
    for (int g = 0; g < 4; ++g) pt[g] = xhalf(tot[g], hh);
    const float own0 = hh ? 0.f : 1.f;
    float sp_ = 0.f;
#pragma unroll
    for (int g = 3; g >= 0; --g) { off[g] = sp_ + own0 * pt[g] + R; sp_ += tot[g] + pt[g]; }
#pragma unroll
    for (int i = 0; i < 16; ++i) S[i] = __builtin_amdgcn_exp2f(S[i] + ex[i] + off[i >> 2]);
    R += sp_;
    const bf16x8 p0 = pack_p(S, 0), p1 = pack_p(S, 1);
#pragma unroll
    for (int o = 0; o < 2; ++o) { O[o] = mfma32(lds_vfrag(vp + 32 * o * VSTR), p0, O[o]); O[o] = mfma32(lds_vfrag(vp + 32 * o * VSTR + 32), p1, O[o]); }
}
__device__ __forceinline__ void attn_sb_block(const bf16_t* PR, const bf16_t* VT, bf16_t* OAT, int b, int h, int qb, LAS unsigned char* lds, volatile LAS unsigned* fl, int tid, int wave, int lane) {
    constexpr int KSTR = 144, KB = 64 * KSTR, BUF = KB + 64 * VSTR;
    const int r32 = lane & 31, hh = lane >> 5, q0 = qb * 256 + wave * 32;
    const bf16_t* qrow = PR + (size_t)(b * SEQ + q0 + r32) * NIN + C_SBQ + h * 64 + 8 * hh;
    bf16x8 qf[4];
#pragma unroll
    for (int d0 = 0; d0 < 4; ++d0) qf[d0] = *(const bf16x8*)(qrow + 16 * d0);
    const bf16_t* kg = PR + (size_t)(b * SEQ) * NIN + C_SBK + h * 64;
    const bf16_t* vg = VT + (size_t)(b * 512 + h * 64) * SEQ;
    f32x16 O[2];
#pragma unroll
    for (int o = 0; o < 2; ++o)
#pragma unroll
        for (int i = 0; i < 16; ++i) O[o][i] = 0.f;
    float R = 0.f; bool done = false;
    const int ttop = 4 * qb + 3, my_diag = 4 * qb + (wave >> 1), odd = wave & 1;
    v4u kr[1], vr[1];
    if (tid < 3) fl[tid] = 0u;
    stage_load<1>(kr, kg + (size_t)(64 * ttop) * NIN, 8, NIN, tid); stage_load<1>(vr, vg + 64 * ttop, 8, SEQ, tid);
    stage_store_k<1>(kr, lds, 8, KSTR, tid); stage_store_v<1>(vr, lds + KB, tid);
    __syncthreads();
    int it = 0;
    for (int t = ttop; t >= 0; --t, ++it) {
        const bool more = t > 0;
        if (more) { stage_load<1>(kr, kg + (size_t)(64 * (t - 1)) * NIN, 8, NIN, tid); stage_load<1>(vr, vg + 64 * (t - 1), 8, SEQ, tid); }
        const int fcur = it % 3;
        if (tid == 0) fl[(it + 1) % 3] = 0u;
        if (t <= my_diag && !done) {
            const LAS unsigned char* kb = lds + (it & 1) * BUF + r32 * KSTR + 16 * hh; const LAS unsigned char* vb = lds + (it & 1) * BUF + KB + r32 * VSTR + 8 * hh;
            const bool isd = (t == my_diag);
            if (!isd || odd) {
                f32x16 S;
#pragma unroll
                for (int i = 0; i < 16; ++i) S[i] = 0.f;
#pragma unroll
                for (int d0 = 0; d0 < 4; ++d0) S = mfma32(*(const LAS bf16x8*)(kb + 32 * KSTR + 32 * d0), qf[d0], S);
                sb_subtile(S, isd, R, O, vb + 64, r32, hh);
            }
            {
                f32x16 S;
#pragma unroll
                for (int i = 0; i < 16; ++i) S[i] = 0.f;
#pragma unroll
                for (int d0 = 0; d0 < 4; ++d0) S = mfma32(*(const LAS bf16x8*)(kb + 32 * d0), qf[d0], S);
                sb_subtile(S, isd && !odd, R, O, vb, r32, hh);
            }
            done = __all(R < -160.f);
        }
        if (done && lane == 0) __hip_atomic_fetch_or((LAS unsigned*)(fl + fcur), 1u << wave, __ATOMIC_RELAXED, __HIP_MEMORY_SCOPE_WORKGROUP);
        if (more) { LAS unsigned char* nb = lds + ((it + 1) & 1) * BUF; stage_store_k<1>(kr, nb, 8, KSTR, tid); stage_store_v<1>(vr, nb + KB, tid); }
        __syncthreads();
        if (fl[fcur] == 0xffu) break;
    }
    bf16_t* orow = OAT + (size_t)(b * SEQ + q0 + r32) * D + h * 64 + 4 * hh;
#pragma unroll
    for (int o = 0; o < 2; ++o)
#pragma unroll
        for (int g = 0; g < 4; ++g) { v2u w; w.x = pg8::cvt_pk_bf16(O[o][4 * g], O[o][4 * g + 1]); w.y = pg8::cvt_pk_bf16(O[o][4 * g + 2], O[o][4 * g + 3]); *(v2u*)(orow + 32 * o + 8 * g) = w; }
    __syncthreads();
}

__device__ __forceinline__ void attn_mem_block(const bf16_t* QM, const bf16_t* KVM, const bf16_t* VT, bf16_t* OM, int b, int h, int qb, LAS unsigned char* lds, int tid, int wave, int lane) {
    constexpr int KSTR = 528, KB = 32 * KSTR, VS = 72, BUF = KB + 128 * VS;
    const int r32 = lane & 31, hh = lane >> 5, q0 = qb * 256 + wave * 32;
    const bf16_t* qrow = QM + (size_t)(b * SEQ + q0 + r32) * D + h * 256 + 8 * hh;
    bf16x8 qf[16];
#pragma unroll
    for (int d0 = 0; d0 < 16; ++d0) qf[d0] = *(const bf16x8*)(qrow + 16 * d0);
    const bf16_t* kg = KVM + (size_t)(b * MEMLEN) * 2048 + h * 256;
    const int vrow = tid >> 2, vch = tid & 3;
    for (int dh = 0; dh < 2; ++dh) {
        const bf16_t* vg = VT + (size_t)(b * 1024 + h * 256 + dh * 128 + vrow) * MEMLEN + vch * 8;
        f32x16 O[4];
#pragma unroll
        for (int o = 0; o < 4; ++o)
#pragma unroll
            for (int i = 0; i < 16; ++i) O[o][i] = 0.f;
        float m = -INFINITY, l = 0.f;
        v4u kr[2], vr;
        stage_load<2>(kr, kg, 32, 2048, tid); vr = *(const v4u*)vg;
        stage_store_k<2>(kr, lds, 32, KSTR, tid); { LAS v2u* d = (LAS v2u*)(lds + KB + vrow * VS + vch * 16); d[0] = (v2u){vr.x, vr.y}; d[1] = (v2u){vr.z, vr.w}; }
        __syncthreads();
        for (int t = 0; t < 8; ++t) {
            const bool more = t < 7;
            if (more) { stage_load<2>(kr, kg + (size_t)(32 * (t + 1)) * 2048, 32, 2048, tid); vr = *(const v4u*)(vg + 32 * (t + 1)); }
            {
                const LAS unsigned char* kb = lds + (t & 1) * BUF + r32 * KSTR + 16 * hh; const LAS unsigned char* vb = lds + (t & 1) * BUF + KB + r32 * VS + 8 * hh;
                f32x16 S;
#pragma unroll
                for (int i = 0; i < 16; ++i) S[i] = 0.f;
#pragma unroll
                for (int d0 = 0; d0 < 16; ++d0) S = mfma32(*(const LAS bf16x8*)(kb + 32 * d0), qf[d0], S);
                softmax_step<4>(S, LOG2E * 0.0625f, m, l, O, hh);
                const bf16x8 p0 = pack_p(S, 0), p1 = pack_p(S, 1);
#pragma unroll
                for (int o = 0; o < 4; ++o) { const LAS unsigned char* vp = vb + 32 * o * VS; O[o] = mfma32(lds_vfrag(vp), p0, O[o]); O[o] = mfma32(lds_vfrag(vp + 32), p1, O[o]); }
            }
            if (more) { LAS unsigned char* nb = lds + ((t + 1) & 1) * BUF; stage_store_k<2>(kr, nb, 32, KSTR, tid); LAS v2u* d = (LAS v2u*)(nb + KB + vrow * VS + vch * 16); d[0] = (v2u){vr.x, vr.y}; d[1] = (v2u){vr.z, vr.w}; }
            __syncthreads();
        }
        l += xhalf(l, hh);
        const float il = 1.f / l;
        bf16_t* orow = OM + (size_t)(b * SEQ + q0 + r32) * D + h * 256 + dh * 128 + 4 * hh;
#pragma unroll
        for (int o = 0; o < 4; ++o)
#pragma unroll
            for (int g = 0; g < 4; ++g) { v2u w; w.x = pg8::cvt_pk_bf16(O[o][4 * g] * il, O[o][4 * g + 1] * il); w.y = pg8::cvt_pk_bf16(O[o][4 * g + 2] * il, O[o][4 * g + 3] * il); *(v2u*)(orow + 32 * o + 8 * g) = w; }
    }
}

struct Args { const void* in[26]; float* out; unsigned char* ws; int ph_lo, ph_hi; };
constexpr int NPHASE = 15;

__device__ __forceinline__ float softplus_f(float z) { return fmaxf(z, 0.f) + __logf(1.f + __expf(-fabsf(z))); }

__global__ void __launch_bounds__(NTHR, 2) fwd(Args args) {
    extern __shared__ __attribute__((aligned(16))) unsigned char lds[];
    LAS unsigned char* L = (LAS unsigned char*)lds;
    volatile LAS unsigned* MISC = (volatile LAS unsigned*)(L + MISC_OFF);
    const int tid = threadIdx.x, lane = tid & 63, wave = __builtin_amdgcn_readfirstlane(tid >> 6);
    const int G = gridDim.x;
    unsigned char* ws = args.ws;
    unsigned* ctl = (unsigned*)(ws + WS_CTL);
    const float* x = (const float*)args.in[0]; const float* mem = (const float*)args.in[1]; const int* positions = (const int*)args.in[2];
    const float* norm_mix = (const float*)args.in[3]; const float* w_in = (const float*)args.in[4];
    const float* lam_q1 = (const float*)args.in[5]; const float* lam_k1 = (const float*)args.in[6]; const float* lam_q2 = (const float*)args.in[7]; const float* lam_k2 = (const float*)args.in[8];
    const float* diff_subln = (const float*)args.in[9]; const float* w_up_sb = (const float*)args.in[10]; const float* w_up_diff = (const float*)args.in[11];
    const float* w_out = (const float*)args.in[12]; const float* norm_mem_q = (const float*)args.in[13]; const float* norm_mem_kv = (const float*)args.in[14];
    const float* w_mem_q = (const float*)args.in[15]; const float* w_mem_kv = (const float*)args.in[16]; const float* w_mem_o = (const float*)args.in[17];
    const float* norm_ffn = (const float*)args.in[18]; const float* w_router = (const float*)args.in[19]; const float* b_router = (const float*)args.in[20];
    const float* w_gate_up = (const float*)args.in[21]; const float* b_gate_up = (const float*)args.in[22]; const float* w_down = (const float*)args.in[23];
    const float* b_down = (const float*)args.in[24]; const float* norm_final = (const float*)args.in[25];
    bf16_t* WIN = (bf16_t*)(ws + WS_WIN); bf16_t* WUPSB = (bf16_t*)(ws + WS_WUPSB); bf16_t* WUPDF = (bf16_t*)(ws + WS_WUPDF); bf16_t* WOUT = (bf16_t*)(ws + WS_WOUT);
    bf16_t* WMQ = (bf16_t*)(ws + WS_WMQ); bf16_t* WMKV = (bf16_t*)(ws + WS_WMKV); bf16_t* WMO = (bf16_t*)(ws + WS_WMO);
    bf16_t* WGU = (bf16_t*)(ws + WS_WGU); bf16_t* WD = (bf16_t*)(ws + WS_WD);
    float* ROPEC = (float*)(ws + WS_ROPE); float* ROPES = ROPEC + (size_t)M * 32;
    int* TK_E = (int*)(ws + WS_TK); int* TK_POS = TK_E + (size_t)M * 4; float* TK_G = (float*)(TK_POS + (size_t)M * 4);
    bf16_t* XN = (bf16_t*)(ws + WS_XN); bf16_t* PR = (bf16_t*)(ws + WS_PR); bf16_t* OAT = (bf16_t*)(ws + WS_OAT); float* SSQ = (float*)(ws + WS_ODR);
    bf16_t* MIX = (bf16_t*)(ws + WS_MIX); float* X1 = (float*)(ws + WS_X1); float* X2 = (float*)(ws + WS_X2);
    bf16_t* HM = (bf16_t*)(ws + WS_HM); bf16_t* KVM = (bf16_t*)(ws + WS_KVM); int* TLIST = (int*)(ws + WS_TLIST); float* GLIST = (float*)(ws + WS_GLIST);
    bf16_t* QM = (bf16_t*)(ws + WS_QM); bf16_t* OM = (bf16_t*)(ws + WS_OM); bf16_t* ACT = (bf16_t*)(ws + WS_ACT); bf16_t* YB = (bf16_t*)(ws + WS_YB);
    bf16_t* VTSB = (bf16_t*)(ws + WS_VTSB); bf16_t* VTDF = (bf16_t*)(ws + WS_VTDF); bf16_t* VTM = (bf16_t*)(ws + WS_VTM);
    float* WR = (float*)(ws + WS_WR); float* WSCGU = (float*)(ws + WS_WSC); float* WSCD = WSCGU + NE * 2048;
    unsigned char* WGU8 = ws + WS_WGU; unsigned char* WD8 = ws + WS_WD; unsigned char* XN8 = ws + WS_XN; unsigned char* ACT8 = ws + WS_ACT;
    unsigned* CNT = ctl + CW_CNT;
    LAS float* smf = (LAS float*)L;
    LAS int* smi = (LAS int*)L;

    for (int u = tid; u < (LDS_BYTES - 131072) / 4; u += NTHR) ((LAS unsigned*)(L + 131072))[u] = 0u;
    __syncthreads();
#if !MK_PER_PHASE
    XcdBarrier bar = xcd_barrier_post(ctl + CW_BAR, MISC + 8);
#define GRID_BAR() xcd_barrier(bar)
#else
#define GRID_BAR() do {} while (0)
#endif
    const int lo = args.ph_lo, hi = args.ph_hi;
#define IN(k) (lo <= (k) && (k) < hi)
#define PHASE_L(k, ...) do { if (IN(k)) { auto body_ = [&]() __attribute__((always_inline)) __VA_ARGS__; body_(); if ((PROBE_REP >> (k)) & 1) { GRID_BAR(); body_(); } } } while (0)
#if !MK_PER_PHASE
#define PHASE(k) for (int rep_ = 0, nrep_ = IN(k) ? 1 + ((PROBE_REP >> (k)) & 1) : 0; rep_ < nrep_; ++rep_, (rep_ < nrep_ ? (xcd_barrier(bar), 0) : 0))
#else
#define PHASE(k) if (IN(k))
#endif
#define SEAM(k) do { if (IN(k) && IN((k) + 1)) GRID_BAR(); } while (0)
    const int gw = blockIdx.x * NWAVES + wave, NGW = G * NWAVES;
    const int xcu = (G % 8 == 0) ? ((int)blockIdx.x % 8) * (G / 8) + (int)blockIdx.x / 8 : (int)blockIdx.x;

    PHASE(0) {
        LAS float* scr = (LAS float*)(L + wave * 16384);
        constexpr int I_IN = 16 * 160, I_UP = 8 * 32, I_SQ = 16 * 32, I_KV = 16 * 64, I_GU1 = 16 * 64, I_GU = NE * I_GU1, I_D1 = 16 * 32, I_DN = NE * I_D1;
        constexpr int NITEMS = I_IN + 2 * I_UP + 3 * I_SQ + I_KV;
        for (int it = gw; it < NITEMS; it += NGW) {
            int r = it;
            if (r < I_IN) {
                const int kb = r / 160, nb = r % 160, n0 = 32 * nb;
                if (n0 >= C_DQ && n0 < C_DV) { const int o = n0 & 255;
                    p0_transpose_rope(w_in, WIN, (n0 & ~255), o, 64 * kb, n0, scr, lane); }
                else p0_transpose_item(w_in, 1024, NIN, WIN, n0, 64 * kb, n0, scr, lane);
                continue; } r -= I_IN;
            if (r < I_UP) { p0_plain(w_up_sb, 512, 1024, WUPSB, r, scr, lane); continue; } r -= I_UP;
            if (r < I_UP) { p0_plain(w_up_diff, 512, 1024, WUPDF, r, scr, lane); continue; } r -= I_UP;
            if (r < I_SQ) { p0_plain(w_out, 1024, 1024, WOUT, r, scr, lane); continue; } r -= I_SQ;
            if (r < I_SQ) { p0_plain(w_mem_q, 1024, 1024, WMQ, r, scr, lane, norm_mem_q); continue; } r -= I_SQ;
            if (r < I_SQ) { p0_plain(w_mem_o, 1024, 1024, WMO, r, scr, lane); continue; } r -= I_SQ;
            p0_plain(w_mem_kv, 1024, 2048, WMKV, r, scr, lane);
        }
        for (int i = blockIdx.x * NTHR + tid; i < D * NE; i += G * NTHR) WR[i] = w_router[i] * norm_ffn[i >> 5];
        {
            __syncthreads();
            LAS float* sw = (LAS float*)L; LAS float* red = (LAS float*)(L + 131072 + 4096);
            const int n = tid & 31, part = tid >> 5;
            for (int it = blockIdx.x; it < NE * 96; it += G) {
                const bool gu = it < NE * 64; const int q = gu ? it : it - NE * 64, e = gu ? q >> 6 : q >> 5, n0 = (gu ? q & 63 : q & 31) * 32, N = gu ? 2048 : 1024;
                const float* W = (gu ? w_gate_up + (size_t)e * 1024 * 2048 : w_down + (size_t)e * 1024 * 1024) + n0 + n;
#pragma unroll 16
                for (int i = 0; i < 64; ++i) { const int k = part + 16 * i; sw[k * 32 + n] = W[(size_t)k * N]; }
                __syncthreads();
                float am = 0.f;
#pragma unroll 16
                for (int i = 0; i < 64; ++i) am = fmaxf(am, fabsf(sw[(64 * part + i) * 32 + n]));
                red[part * 32 + n] = am;
                __syncthreads();
                if (tid < 32) { float a = red[tid];
#pragma unroll
                    for (int pp = 1; pp < 16; ++pp) a = fmaxf(a, red[pp * 32 + tid]);
                    unsigned eb = (__float_as_uint(a) >> 23) & 0xffu; eb = eb < 8u ? 8u : eb;
                    const float sc = __uint_as_float((eb - 7u) << 23), inv = __uint_as_float((261u - eb) << 23);
                    red[512 + tid] = inv; (gu ? WSCGU + (size_t)e * 2048 : WSCD + (size_t)e * 1024)[n0 + tid] = sc; }
                __syncthreads();
                { const float inv = red[512 + n]; const int c = n0 + n;
                  const int drow = gu ? (((c & 1023) >> 7) * 256 + (c >> 10) * 128 + (c & 127)) : c;
                  unsigned char* dst = (gu ? WGU8 + ((size_t)e * 2048 + drow) * 1024 : WD8 + ((size_t)e * 1024 + drow) * 1024) + 64 * part;
#pragma unroll
                  for (int qd = 0; qd < 4; ++qd) { v4u w;
                      const LAS float* sp = sw + (64 * part + 16 * qd) * 32 + n;
                      w.x = pk4_fp8(sp[0] * inv, sp[32] * inv, sp[64] * inv, sp[96] * inv); w.y = pk4_fp8(sp[128] * inv, sp[160] * inv, sp[192] * inv, sp[224] * inv);
                      w.z = pk4_fp8(sp[256] * inv, sp[288] * inv, sp[320] * inv, sp[352] * inv); w.w = pk4_fp8(sp[384] * inv, sp[416] * inv, sp[448] * inv, sp[480] * inv);
                      *(v4u*)(dst + 16 * qd) = w; } }
                __syncthreads();
            }
        }
        for (int m = gw; m < M; m += NGW) rms_row_to_bf16(x + (size_t)m * D, norm_mix, XN + (size_t)m * D, lane);
        for (int m = gw; m < MM; m += NGW) rms_row_to_bf16(mem + (size_t)m * D, norm_mem_kv, HM + (size_t)m * D, lane);
        for (int i = blockIdx.x * NTHR + tid; i < M * 32; i += G * NTHR) {
            const int m = i >> 5, f = i & 31;
            const double inv = exp2(-(double)f * (13.287712379549449 / 32.0));
            const double ang = (double)positions[m] * inv;
            const double kk = rint(ang * 0.15915494309189535);
            const float rf = (float)(ang - kk * 6.283185307179586);
            ROPEC[i] = __cosf(rf); ROPES[i] = __sinf(rf);
        }
    }
    SEAM(0);

    PHASE_L(1, {
        { pg8::Gemm g{XN, WIN, D, D, D}; pg8::DenseOrder S; S.init(M, NIN, G, (int)blockIdx.x, D, D);
          pg8::gemm_phase<pg8::EpiInProj, pg8::DenseOrder, false>(L, g, S, pg8::EpiInProj{PR, ROPEC, ROPES, VTSB, VTDF}); }
    });
    SEAM(1);

    PHASE(3) {
        volatile LAS unsigned* fl = (volatile LAS unsigned*)(L + 131072 + 2048);
        const int nkv = (G >= 64) ? 32 : 0;
        if ((int)blockIdx.x < nkv) { pg8::Gemm g{HM, WMKV, D, D, D}; pg8::OneUnitOrder S{(int)blockIdx.x, D, D};
            pg8::gemm_phase<pg8::EpiKV, pg8::OneUnitOrder, false>(L, g, S, pg8::EpiKV{KVM, VTM}); }
        else for (int bu = (int)blockIdx.x - nkv; bu < 512; bu += G - nkv) { const int qb = bu & 15, h = (bu >> 4) & 7, b = bu >> 7; attn_sb_block(PR, VTSB, OAT, b, h, qb, L, fl, tid, wave, lane); }
        if (nkv == 0) { pg8::Gemm g{HM, WMKV, D, D, D}; pg8::DenseOrder S; S.init(MM, 2048, G, (int)blockIdx.x, D, D); pg8::gemm_phase<pg8::EpiKV, pg8::DenseOrder, false>(L, g, S, pg8::EpiKV{KVM, VTM}); }
        const float lam = expf(wave_sum(lam_q1[lane] * lam_k1[lane])) - expf(wave_sum(lam_q2[lane] * lam_k2[lane])) + 0.2f;
        for (int pr = blockIdx.x; pr < 256; pr += G) { const int sb_ = pr & 15, h = (pr >> 4) & 3, b = pr >> 6;
            attn_diff_block(PR, VTDF, OAT, diff_subln, lam, b, h, 31 - sb_, L, tid, wave, lane); attn_diff_block(PR, VTDF, OAT, diff_subln, lam, b, h, sb_, L, tid, wave, lane); }
    }
    SEAM(3);

    PHASE_L(5, {
        pg8::Gemm g{OAT, WUPSB, D, 512, 512}; pg8::TwoRoundOrder S{G, xcu, D, 512};
        pg8::gemm_phase<pg8::EpiGate, pg8::TwoRoundOrder, false>(L, g, S, pg8::EpiGate{PR, X2, MIX});
    });
    SEAM(5);

    PHASE_L(6, {
        pg8::Gemm g{MIX, WOUT, D, D, D}; pg8::DenseOrder S; S.init(M, D, G, (int)blockIdx.x, D, D);
        pg8::gemm_phase<pg8::EpiResidNorm, pg8::DenseOrder, false>(L, g, S, pg8::EpiResidNorm{x, X1, XN, SSQ});
    });
    if (IN(6) && IN(8)) GRID_BAR();

    PHASE_L(8, {
        pg8::Gemm g{XN, WMQ, D, D, D}; pg8::DenseOrder S; S.init(M, D, G, (int)blockIdx.x, D, D);
        pg8::gemm_phase<pg8::EpiBf16Rinv, pg8::DenseOrder, false>(L, g, S, pg8::EpiBf16Rinv{QM, SSQ});
    });
    SEAM(8);

    PHASE(9) { for (int bu = blockIdx.x; bu < 256; bu += G) { const int qb = bu & 15, h = (bu >> 4) & 3, b = bu >> 6; attn_mem_block(QM, KVM, VTM, OM, b, h, qb, L, tid, wave, lane); } }
    SEAM(9);

    PHASE_L(10, {
        pg8::Gemm g{OM, WMO, D, D, D}; pg8::DenseOrder S; S.init(M, D, G, (int)blockIdx.x, D, D);
        pg8::gemm_phase<pg8::EpiResidF32, pg8::DenseOrder, false>(L, g, S, pg8::EpiResidF32{X1, X2});
    });
    SEAM(10);

    if (IN(11)) {
        auto body11_ = [&]() __attribute__((always_inline)) {
        if (wave < 2) {
            for (int tile = wave * G + blockIdx.x; tile < M / 32; tile += 2 * G) {
                const int i32 = lane & 31, kk = lane >> 5, m0 = tile * 32;
                const float* xr = X2 + (size_t)(m0 + i32) * D + 4 * kk; const float* wp = WR + (4 * kk) * NE + i32;
                f32x16 acc;
#pragma unroll
                for (int r = 0; r < 16; ++r) acc[r] = 0.f;
                float ss = 0.f;
#pragma unroll 4
                for (int u = 0; u < 128; ++u) {
                    const f32x4 a = *(const f32x4*)(xr + 8 * u);
                    const float b0 = wp[(8 * u + 0) * NE], b1 = wp[(8 * u + 1) * NE], b2 = wp[(8 * u + 2) * NE], b3 = wp[(8 * u + 3) * NE];
                    acc = __builtin_amdgcn_mfma_f32_32x32x2f32(a.x, b0, acc, 0, 0, 0); acc = __builtin_amdgcn_mfma_f32_32x32x2f32(a.y, b1, acc, 0, 0, 0);
                    acc = __builtin_amdgcn_mfma_f32_32x32x2f32(a.z, b2, acc, 0, 0, 0); acc = __builtin_amdgcn_mfma_f32_32x32x2f32(a.w, b3, acc, 0, 0, 0);
                    ss += (a.x * a.x + a.y * a.y) + (a.z * a.z + a.w * a.w);
                }
                ss += xhalf(ss, kk);
                const float rinv = 1.0f / sqrtf(ss * (1.f / 1024.f) + NORM_EPS);
                LAS float* T = smf + wave * 1152;
#pragma unroll
                for (int r = 0; r < 16; ++r) T[((r & 3) + 8 * (r >> 2) + 4 * kk) * 33 + i32] = acc[r];
                LDS_WAIT(); asm volatile("" ::: "memory");
                if (lane < 32) {
                    float lg[32];
#pragma unroll
                    for (int j = 0; j < 32; ++j) lg[j] = T[lane * 33 + j] * rinv + b_router[j];
                    float tv[4]; int ti[4];
#pragma unroll
                    for (int k = 0; k < 4; ++k) { float bv = lg[0]; int bi = 0;
#pragma unroll
                        for (int j = 1; j < 32; ++j) if (lg[j] > bv) { bv = lg[j]; bi = j; }
                        tv[k] = bv; ti[k] = bi;
#pragma unroll
                        for (int j = 0; j < 32; ++j) if (j == bi) lg[j] = -INFINITY; }
                    const float e1 = __expf(tv[1] - tv[0]), e2 = __expf(tv[2] - tv[0]), e3 = __expf(tv[3] - tv[0]);
                    const float isum = 1.f / (1.f + e1 + e2 + e3);
                    const float gk[4] = {isum, e1 * isum, e2 * isum, e3 * isum};
                    LAS unsigned* H = (LAS unsigned*)(T + 32 * 33);
                    H[lane] = 0u;
                    LDS_WAIT(); asm volatile("" ::: "memory");
                    int rk[4];
#pragma unroll
                    for (int k = 0; k < 4; ++k) rk[k] = (int)__hip_atomic_fetch_add(H + ti[k], 1u, __ATOMIC_RELAXED, __HIP_MEMORY_SCOPE_WAVEFRONT);
                    LDS_WAIT(); asm volatile("" ::: "memory");
                    const unsigned cnt_e = H[lane];
                    unsigned base_e = 0u; if (cnt_e) base_e = atomicAdd(&CNT[64 * lane], cnt_e);
                    H[32 + lane] = base_e;
                    LDS_WAIT(); asm volatile("" ::: "memory");
                    const int m = m0 + lane;
#pragma unroll
                    for (int k = 0; k < 4; ++k) { const int ek = ti[k]; const int pos = (int)H[32 + ek] + rk[k];
                        TLIST[ek * LISTCAP + pos] = m; GLIST[ek * LISTCAP + pos] = gk[k]; TK_E[m * 4 + k] = ek; TK_POS[m * 4 + k] = pos; TK_G[m * 4 + k] = gk[k]; }
                }
                LDS_WAIT(); asm volatile("" ::: "memory");
            }
        } else {
            for (int m = blockIdx.x * 6 + (wave - 2); m < M; m += G * 6) rms_row_to_fp8(X2 + (size_t)m * D, norm_ffn, XN8 + (size_t)m * D, lane);
        }
            };
        body11_();
        if ((PROBE_REP >> 11) & 1) { GRID_BAR(); if (blockIdx.x == 0 && tid < NE) CNT[64 * tid] = 0u; GRID_BAR(); body11_(); }
    }
    SEAM(11);

#define LOAD_BASES() do { __syncthreads(); if (tid == 0) { int b_ = 0; for (int e_ = 0; e_ < NE; ++e_) { const int c_ = (int)__hip_atomic_load(&CNT[64 * e_], __ATOMIC_RELAXED, __HIP_MEMORY_SCOPE_AGENT); \
        smi[8192 + e_] = b_; smi[8256 + e_] = c_; b_ += (c_ + 255) & ~255; } } __syncthreads(); } while (0)

    LAS int* tb = (LAS int*)(L + 131072 + 1024);
#define LOAD_TB(npn) do { __syncthreads(); if (tid == 0) { int b_ = 0, cu_ = 0; for (int e_ = 0; e_ < NE; ++e_) { const int c_ = (int)__hip_atomic_load(&CNT[64 * e_], __ATOMIC_RELAXED, __HIP_MEMORY_SCOPE_AGENT); \
        tb[e_] = b_; tb[32 + e_] = c_; tb[64 + e_] = cu_; b_ += (c_ + 255) & ~255; cu_ += ((c_ + 255) >> 8) * (npn); } tb[96] = cu_; } __syncthreads(); } while (0)
    PHASE(12) {
        LOAD_TB(8);
        pg8::Gemm g{(const bf16_t*)XN8, (const bf16_t*)WGU8, 512, 512, 512}; pg8::MoeOrder S{tb, TLIST, G, xcu, 8, 512, 512, 2048};
        pg8::gemm_phase<pg8::EpiMoeGU, pg8::MoeOrder, true, true>(L, g, S, pg8::EpiMoeGU{ACT8, b_gate_up, WSCGU});
    }
    SEAM(12);
    PHASE(13) {
        LOAD_TB(4);
        pg8::Gemm g{(const bf16_t*)ACT8, (const bf16_t*)WD8, 512, 512, 512}; pg8::MoeOrder S{tb, TLIST, G, xcu, 4, 512, 512, 1024};
        pg8::gemm_phase<pg8::EpiMoeDown, pg8::MoeOrder, false, true>(L, g, S, pg8::EpiMoeDown{YB, b_down, GLIST, tb, WSCD});
    }
    SEAM(13);

    PHASE(14) {
        LOAD_BASES();
        for (int mb = gw; mb < M; mb += 8 * NGW) {
            int slotv = 0;
            { const int i = lane >> 2, k = lane & 3, m = mb + NGW * i; if (lane < 32 && m < M) slotv = smi[8192 + TK_E[m * 4 + k]] + TK_POS[m * 4 + k]; }
#pragma unroll 2
            for (int i = 0; i < 8; ++i) {
                const int m = mb + NGW * i; if (m >= M) break;
                const f32x4* xr = (const f32x4*)(X2 + (size_t)m * D) + lane; const f32x4* gr = (const f32x4*)norm_final + lane;
                f32x4 v[4];
#pragma unroll
                for (int j = 0; j < 4; ++j) v[j] = xr[64 * j];
#pragma unroll
                for (int k = 0; k < 4; ++k) { const int slot = __builtin_amdgcn_readlane(slotv, 4 * i + k); const v2u* yr = (const v2u*)(YB + (size_t)slot * D) + lane;
#pragma unroll
                    for (int j = 0; j < 4; ++j) { const v2u w = yr[64 * j]; v[j].x += lo16(w.x); v[j].y += hi16(w.x); v[j].z += lo16(w.y); v[j].w += hi16(w.y); } }
                float ss = 0.f;
#pragma unroll
                for (int j = 0; j < 4; ++j) ss += (v[j].x * v[j].x + v[j].y * v[j].y) + (v[j].z * v[j].z + v[j].w * v[j].w);
                const float rinv = 1.0f / sqrtf(wave_sum(ss) * (1.f / 1024.f) + NORM_EPS);
                f32x4* orow = (f32x4*)(args.out + (size_t)m * D) + lane;
#pragma unroll
                for (int j = 0; j < 4; ++j) { const f32x4 gg = gr[64 * j]; orow[64 * j] = (f32x4){v[j].x * rinv * gg.x, v[j].y * rinv * gg.y, v[j].z * rinv * gg.z, v[j].w * rinv * gg.w}; }
            }
        }
    }
#undef IN
#undef SEAM
}

extern "C" void kernel_launch(void* const* d_in, const int* in_sizes, int n_in, void* d_out, int out_size, void* d_ws, size_t ws_size, hipStream_t stream) {
    static int grid = 0;
    if (grid == 0) {
        if (n_in != 26 || out_size != M * D || ws_size < WS_END) { fprintf(stderr, "kernel_launch: unexpected sizes n_in %d out %d ws %zu\n", n_in, out_size, ws_size); grid = -1; return; }
        int dev = 0, cus = 0;
        if (hipGetDevice(&dev) != hipSuccess || hipDeviceGetAttribute(&cus, hipDeviceAttributeMultiprocessorCount, dev) != hipSuccess) { grid = -1; return; }
        if (hipFuncSetAttribute((const void*)fwd, hipFuncAttributeMaxDynamicSharedMemorySize, LDS_BYTES) != hipSuccess) { fprintf(stderr, "kernel_launch: hipFuncSetAttribute failed\n"); grid = -1; return; }
        int per_cu = 0;
        (void)hipOccupancyMaxActiveBlocksPerMultiprocessor(&per_cu, (const void*)fwd, NTHR, LDS_BYTES);
        (void)hipGetLastError();
        grid = cus;
    }
    if (grid < 0) return;
    (void)hipMemsetAsync((char*)d_ws + WS_CTL, 0, CTL_ZERO_BYTES, stream);
    Args a{};
    for (int i = 0; i < 26; ++i) a.in[i] = d_in[i];
    a.out = (float*)d_out; a.ws = (unsigned char*)d_ws;
#if MK_PER_PHASE
    for (int p = 0; p < NPHASE; ++p) { a.ph_lo = p; a.ph_hi = p + 1; hipLaunchKernelGGL(fwd, dim3(grid), dim3(NTHR), LDS_BYTES, stream, a); }
#else
    a.ph_lo = 0; a.ph_hi = NPHASE; hipLaunchKernelGGL(fwd, dim3(grid), dim3(NTHR), LDS_BYTES, stream, a);
#endif
}
```

```cpp
#include <hip/hip_runtime.h>
#include <cstdio>
#include <cstdint>

#ifndef MK_PER_PHASE
#define MK_PER_PHASE 0
#endif

#ifndef PROBE_STAMP
#define PROBE_STAMP -1
#endif
#ifndef PROBE_REP
#define PROBE_REP 0
#endif
#define GAS __attribute__((address_space(1)))
#define LAS __attribute__((address_space(3)))
typedef unsigned short bf16_t;
typedef unsigned v4u __attribute__((ext_vector_type(4)));
typedef unsigned v2u __attribute__((ext_vector_type(2)));
typedef float f32x4 __attribute__((ext_vector_type(4)));
typedef short bf16x8 __attribute__((ext_vector_type(8)));

constexpr int BATCH = 4, SEQ = 4096, D = 1024, M = BATCH * SEQ, NIN = 5120;
constexpr int MEMLEN = 256, MM = BATCH * MEMLEN;
constexpr int NE = 32, TOPK = 4, DFF = 1024;
constexpr float NORM_EPS = 1e-6f;
constexpr int C_SBQ = 0, C_SBK = 512, C_SBV = 1024, C_DQ = 1536, C_DK = 2048, C_DV = 2560, C_GSB = 3072, C_GDF = 4096;
constexpr int LISTCAP = 16384;
constexpr int SLOTS = 65536 + NE * 256;
constexpr int NWAVES = 8, NTHR = 512;

constexpr size_t MiB = 1u << 20;
constexpr size_t WS_CTL = 0, CTL_ZERO_BYTES = 1 * MiB;
constexpr size_t WS_WIN = 2 * MiB;
constexpr size_t WS_WUPSB = 12 * MiB;
constexpr size_t WS_WUPDF = 13 * MiB;
constexpr size_t WS_WOUT = 14 * MiB;
constexpr size_t WS_WMQ = 16 * MiB;
constexpr size_t WS_WMKV = 18 * MiB;
constexpr size_t WS_WMO = 22 * MiB;
constexpr size_t WS_ROPE = 24 * MiB;
constexpr size_t WS_TK = 28 * MiB;
constexpr size_t WS_WR = 29 * MiB;
constexpr size_t WS_WSC = 30 * MiB;
constexpr size_t WS_WGU = 32 * MiB;
constexpr size_t WS_WD = 160 * MiB;
constexpr size_t WS_XN = 224 * MiB;
constexpr size_t WS_PR = 256 * MiB;
constexpr size_t WS_OAT = 416 * MiB;
constexpr size_t WS_ODR = 448 * MiB;
constexpr size_t WS_MIX = 512 * MiB;
constexpr size_t WS_X1 = 544 * MiB;
constexpr size_t WS_X2 = 608 * MiB;
constexpr size_t WS_HM = 672 * MiB;
constexpr size_t WS_KVM = 674 * MiB;
constexpr size_t WS_TLIST = 678 * MiB;
constexpr size_t WS_GLIST = 680 * MiB;
constexpr size_t WS_QM = 682 * MiB;
constexpr size_t WS_OM = 714 * MiB;
constexpr size_t WS_ACT = 256 * MiB;
constexpr size_t WS_YB = 746 * MiB;
constexpr size_t WS_VTSB = 890 * MiB;
constexpr size_t WS_VTDF = 906 * MiB;
constexpr size_t WS_VTM = 922 * MiB;
constexpr size_t WS_END = 924 * MiB;
static_assert(WS_ACT + (size_t)SLOTS * 1024 * 2 <= WS_OAT, "ACT overlay");
static_assert(WS_YB + (size_t)SLOTS * 1024 * 2 <= WS_VTSB, "YB");
constexpr int CW_REDO = 16384;
constexpr int CW_CNT = 8192;
constexpr int CW_BAR = 1024;

constexpr int LDS_BYTES = 147456;
constexpr int MISC_OFF = 131072 + 320;

__device__ __forceinline__ float bf2f(bf16_t b) { return __uint_as_float(((unsigned)b) << 16); }
__device__ __forceinline__ unsigned f2bf(float f) { unsigned u = __float_as_uint(f); return (u + 0x7fffu + ((u >> 16) & 1u)) >> 16; }
__device__ __forceinline__ unsigned pk2(float lo, float hi) { return f2bf(lo) | (f2bf(hi) << 16); }
__device__ __forceinline__ unsigned pk4_fp8(float a, float b, float c, float d) { int w = 0; w = __builtin_amdgcn_cvt_pk_fp8_f32(a, b, w, false); w = __builtin_amdgcn_cvt_pk_fp8_f32(c, d, w, true); return (unsigned)w; }
__device__ __forceinline__ float lo16(unsigned w) { return __uint_as_float(w << 16); }
__device__ __forceinline__ float hi16(unsigned w) { return __uint_as_float(w & 0xffff0000u); }
#define LDS_WAIT() asm volatile("s_waitcnt lgkmcnt(0)" ::: "memory")
__device__ __forceinline__ float wave_sum(float v) {
#pragma unroll
    for (int o = 1; o < 64; o <<= 1) v += __shfl_xor(v, o);
    return v;
}
__device__ __forceinline__ float wave_max(float v) {
#pragma unroll
    for (int o = 1; o < 64; o <<= 1) v = fmaxf(v, __shfl_xor(v, o));
    return v;
}

#define XB_TMO      128
#define XB_XCNT(j)  (256  + 64 * (j))
#define XB_XSUB(j)  (1280 + 64 * (j))
#define XB_XGEN(j)  (2304 + 64 * (j))
#define XB_TOP      3328
#define XB_TOPGEN   3392
#define XCD_BAR_WORDS 3456
#define XB_SPIN_CAP (1u << 18)
__device__ __forceinline__ unsigned xb_ld(unsigned* p)              { return __hip_atomic_load(p, __ATOMIC_RELAXED, __HIP_MEMORY_SCOPE_AGENT); }
__device__ __forceinline__ unsigned xb_add(unsigned* p, unsigned v) { return __hip_atomic_fetch_add(p, v, __ATOMIC_RELAXED, __HIP_MEMORY_SCOPE_AGENT); }
__device__ __forceinline__ unsigned xb_xcc_id() { return (unsigned)__builtin_amdgcn_s_getreg((3 << 11) | 20) & 0xFu; }
#define XB_SPIN(cond, bar) do { unsigned _sp = 0; while (cond) { __builtin_amdgcn_s_sleep(1); \
    if ((++_sp & 255u) == 0u) { if (xb_ld(&(bar)[XB_TMO])) break; if (_sp > XB_SPIN_CAP) { atomicAdd(&(bar)[XB_TMO], 1u); break; } } } } while (0)
struct XcdBarrier { unsigned* bar; unsigned x; volatile LAS unsigned* st; };
__device__ __forceinline__ XcdBarrier xcd_barrier_post(unsigned* bar, volatile LAS unsigned* st) {
    XcdBarrier b; b.bar = bar; b.x = xb_xcc_id(); b.st = st;
    if (threadIdx.x == 0) (void)xb_add(&bar[XB_XCNT(b.x)], 1u);
    return b;
}
__device__ __forceinline__ void xcd_barrier_complete(unsigned* bar, unsigned x, unsigned& nloc, unsigned& nx) {
    const unsigned G = gridDim.x * gridDim.y * gridDim.z;
    unsigned sum, cnt, mine, sp = 0u;
    for (;;) {
        sum = 0u; cnt = 0u; mine = 0u;
#pragma unroll
        for (unsigned j = 0; j < 16; ++j) { const unsigned c = xb_ld(&bar[XB_XCNT(j)]); sum += c; cnt += (c > 0u) ? 1u : 0u; mine = (j == x) ? c : mine; }
        if (sum == G) break;
        __builtin_amdgcn_s_sleep(1);
        if ((++sp & 255u) == 0u) { if (xb_ld(&bar[XB_TMO])) break; if (sp > XB_SPIN_CAP) { atomicAdd(&bar[XB_TMO], 1u); break; } }
    }
    nloc = mine > 0u ? mine : 1u; nx = cnt > 0u ? cnt : 1u;
}
__device__ __forceinline__ void xcd_barrier(const XcdBarrier& b) {
    asm volatile("s_waitcnt vmcnt(0)" ::: "memory");
    __syncthreads();
    if (threadIdx.x == 0) {
        unsigned* bar = b.bar;
        __builtin_amdgcn_s_waitcnt(0);
        unsigned nloc = b.st[0], nx = b.st[1];
        if (nloc == 0u) { xcd_barrier_complete(bar, b.x, nloc, nx); b.st[0] = nloc; b.st[1] = nx; }
        const unsigned old = xb_add(&bar[XB_XSUB(b.x)], 1u);
        const unsigned gen = old / nloc;
        if (old + 1u == (gen + 1u) * nloc) {
            __builtin_amdgcn_fence(__ATOMIC_RELEASE, "agent");
            asm volatile("s_waitcnt vmcnt(0)" ::: "memory");
            const unsigned og = xb_add(&bar[XB_TOP], 1u);
            const unsigned tg = og / nx;
            if (og + 1u == (tg + 1u) * nx) xb_add(&bar[XB_TOPGEN], 1u);
            else XB_SPIN(xb_ld(&bar[XB_TOPGEN]) == tg, bar);
            __builtin_amdgcn_fence(__ATOMIC_ACQUIRE, "agent");
            xb_add(&bar[XB_XGEN(b.x)], 1u);
            asm volatile("s_waitcnt vmcnt(0)" ::: "memory");
        } else {
            XB_SPIN(xb_ld(&bar[XB_XGEN(b.x)]) == gen, bar);
            __builtin_amdgcn_fence(__ATOMIC_ACQUIRE, "agent");
            asm volatile("s_waitcnt vmcnt(0)" ::: "memory");
        }
    }
    __syncthreads();
}

__device__ __forceinline__ void p0_transpose_item(const float* W, int K, int N, bf16_t* WT, int drow0, int k0, int n0, LAS float* scr, int lane, const float* gain = nullptr) {
#pragma unroll 8
    for (int i = 0; i < 32; ++i) { const int kk = 2 * i + (lane >> 5); float v = W[(size_t)(k0 + kk) * N + n0 + (lane & 31)]; if (gain) v *= gain[k0 + kk]; scr[kk * 33 + (lane & 31)] = v; }
    LDS_WAIT(); asm volatile("" ::: "memory");
    const int c = lane & 7;
#pragma unroll
    for (int j = 0; j < 4; ++j) { const int n = (lane >> 3) + 8 * j; const LAS float* s = scr + (8 * c) * 33 + n;
        v4u o; o.x = pk2(s[0 * 33], s[1 * 33]); o.y = pk2(s[2 * 33], s[3 * 33]); o.z = pk2(s[4 * 33], s[5 * 33]); o.w = pk2(s[6 * 33], s[7 * 33]);
        *(v4u*)(WT + (size_t)(drow0 + n) * K + k0 + 8 * c) = o; }
    LDS_WAIT(); asm volatile("" ::: "memory");
}
__device__ __forceinline__ void p0_plain(const float* W, int K, int N, bf16_t* WT, int item, LAS float* scr, int lane, const float* gain = nullptr) {
    const int nblk = N / 32, kb = item / nblk, nb = item % nblk;
    p0_transpose_item(W, K, N, WT, 32 * nb, 64 * kb, 32 * nb, scr, lane, gain);
}
__device__ __forceinline__ void p0_transpose_rope(const float* W, bf16_t* WT, int tilebase, int o, int k0, int n0, LAS float* scr, int lane) {
    const int K = 1024, N = NIN;
#pragma unroll 8
    for (int i = 0; i < 32; ++i) { const int kk = 2 * i + (lane >> 5); scr[kk * 33 + (lane & 31)] = W[(size_t)(k0 + kk) * N + n0 + (lane & 31)]; }
    LDS_WAIT(); asm volatile("" ::: "memory");
    const int c = lane & 7;
#pragma unroll
    for (int j = 0; j < 4; ++j) { const int n = (lane >> 3) + 8 * j; const LAS float* s = scr + (8 * c) * 33 + n;
        const int oo = o + n, v = ((oo >> 6) << 6) | (((oo >> 4) & 1) << 5) | (((oo >> 2) & 3) << 3) | (((oo >> 5) & 1) << 2) | (oo & 3);
        v4u w; w.x = pk2(s[0 * 33], s[1 * 33]); w.y = pk2(s[2 * 33], s[3 * 33]); w.z = pk2(s[4 * 33], s[5 * 33]); w.w = pk2(s[6 * 33], s[7 * 33]);
        *(v4u*)(WT + (size_t)(tilebase + v) * K + k0 + 8 * c) = w; }
    LDS_WAIT(); asm volatile("" ::: "memory");
}
__device__ __forceinline__ void rms_row_to_bf16(const float* xrow, const float* g, bf16_t* orow, int lane) {
    const f32x4* xr = (const f32x4*)xrow + lane; const f32x4* gr = (const f32x4*)g + lane;
    f32x4 v[4]; float s = 0.f;
#pragma unroll
    for (int j = 0; j < 4; ++j) { v[j] = xr[64 * j]; s += (v[j].x * v[j].x + v[j].y * v[j].y) + (v[j].z * v[j].z + v[j].w * v[j].w); }
    const float rinv = 1.0f / sqrtf(wave_sum(s) * (1.f / 1024.f) + NORM_EPS);
    v2u* o8 = (v2u*)orow + lane;
#pragma unroll
    for (int j = 0; j < 4; ++j) { const f32x4 gg = gr[64 * j]; v2u w; w.x = pk2(v[j].x * rinv * gg.x, v[j].y * rinv * gg.y); w.y = pk2(v[j].z * rinv * gg.z, v[j].w * rinv * gg.w); o8[64 * j] = w; }
}

__device__ __forceinline__ void rms_row_to_fp8(const float* xrow, const float* g, unsigned char* orow, int lane) {
    const f32x4* xr = (const f32x4*)xrow + lane; const f32x4* gr = (const f32x4*)g + lane;
    f32x4 v[4]; float s = 0.f;
#pragma unroll
    for (int j = 0; j < 4; ++j) { v[j] = xr[64 * j]; s += (v[j].x * v[j].x + v[j].y * v[j].y) + (v[j].z * v[j].z + v[j].w * v[j].w); }
    const float rinv = 1.0f / sqrtf(wave_sum(s) * (1.f / 1024.f) + NORM_EPS);
    unsigned* o4 = (unsigned*)orow + lane;
#pragma unroll
    for (int j = 0; j < 4; ++j) { const f32x4 gg = gr[64 * j]; o4[64 * j] = pk4_fp8(v[j].x * rinv * gg.x, v[j].y * rinv * gg.y, v[j].z * rinv * gg.z, v[j].w * rinv * gg.w); }
}
template <int NB, class RowPtr, class Epi>
__device__ __forceinline__ void ngemm_tile(const RowPtr& rp, const bf16_t* Bt, int ldb, int b1off, int K, int m0, int n0, int mvalid, const Epi& epi, LAS float* sm) {
    const int t = threadIdx.x, r = t >> 2, kq = (t & 3) * 4, ty = t >> 5, tx = t & 31;
    LAS float* As = sm; LAS float* Bs0 = sm + 16 * 132; LAS float* Bs1 = sm + 32 * 132;
    float acc[NB][8][4];
#pragma unroll
    for (int b = 0; b < NB; ++b)
#pragma unroll
        for (int i = 0; i < 8; ++i)
#pragma unroll
            for (int j = 0; j < 4; ++j) acc[b][i][j] = 0.f;
    const bf16_t* arow = rp(m0 + r) + kq;
    const bf16_t* brow0 = Bt + (size_t)(n0 + r) * ldb + kq;
    const bf16_t* brow1 = Bt + (size_t)(n0 + b1off + r) * ldb + kq;
    for (int k0 = 0; k0 < K; k0 += 16) {
        const v2u av = *(const v2u*)(arow + k0);
        const v2u bv0 = *(const v2u*)(brow0 + k0);
        v2u bv1 = bv0; if (NB == 2) bv1 = *(const v2u*)(brow1 + k0);
        As[(kq + 0) * 132 + r] = lo16(av.x); As[(kq + 1) * 132 + r] = hi16(av.x); As[(kq + 2) * 132 + r] = lo16(av.y); As[(kq + 3) * 132 + r] = hi16(av.y);
        Bs0[(kq + 0) * 132 + r] = lo16(bv0.x); Bs0[(kq + 1) * 132 + r] = hi16(bv0.x); Bs0[(kq + 2) * 132 + r] = lo16(bv0.y); Bs0[(kq + 3) * 132 + r] = hi16(bv0.y);
        if (NB == 2) { Bs1[(kq + 0) * 132 + r] = lo16(bv1.x); Bs1[(kq + 1) * 132 + r] = hi16(bv1.x); Bs1[(kq + 2) * 132 + r] = lo16(bv1.y); Bs1[(kq + 3) * 132 + r] = hi16(bv1.y); }
        __syncthreads();
#pragma unroll 2
        for (int kk = 0; kk < 16; ++kk) {
            const f32x4 a0 = *(const LAS f32x4*)(As + kk * 132 + ty * 8), a1 = *(const LAS f32x4*)(As + kk * 132 + ty * 8 + 4);
            const f32x4 b0 = *(const LAS f32x4*)(Bs0 + kk * 132 + tx * 4);
            const float a[8] = {a0.x, a0.y, a0.z, a0.w, a1.x, a1.y, a1.z, a1.w};
#pragma unroll
            for (int i = 0; i < 8; ++i) { acc[0][i][0] += a[i] * b0.x; acc[0][i][1] += a[i] * b0.y; acc[0][i][2] += a[i] * b0.z; acc[0][i][3] += a[i] * b0.w; }
            if (NB == 2) { const f32x4 b1 = *(const LAS f32x4*)(Bs1 + kk * 132 + tx * 4);
#pragma unroll
                for (int i = 0; i < 8; ++i) { acc[NB - 1][i][0] += a[i] * b1.x; acc[NB - 1][i][1] += a[i] * b1.y; acc[NB - 1][i][2] += a[i] * b1.z; acc[NB - 1][i][3] += a[i] * b1.w; } }
        }
        __syncthreads();
    }
#pragma unroll
    for (int i = 0; i < 8; ++i) { const int m = m0 + ty * 8 + i;
        if (m < mvalid) {
#pragma unroll
            for (int j = 0; j < 4; ++j) epi(m, n0 + tx * 4 + j, acc[0][i][j], acc[NB - 1][i][j]); } }
}
struct RowPlain { const bf16_t* A; int lda; __device__ __forceinline__ const bf16_t* operator()(int m) const { return A + (size_t)m * lda; } };

template <class Epi>
__device__ __forceinline__ void ngemm_dense(const bf16_t* A, int lda, const bf16_t* Bt, int ldb, int Mr, int N, int K, const Epi& epi, LAS float* sm) {
    const int nn = N / 128, nunits = (Mr / 128) * nn; RowPlain rp{A, lda};
    for (int u = blockIdx.x; u < nunits; u += gridDim.x) ngemm_tile<1>(rp, Bt, ldb, 0, K, (u / nn) * 128, (u % nn) * 128, Mr, epi, sm);
}

struct EpiStoreBf16 { bf16_t* O; int ldc; __device__ __forceinline__ void operator()(int m, int n, float a, float) const { O[(size_t)m * ldc + n] = (bf16_t)f2bf(a); } };
struct EpiGate1 { const bf16_t* PR; float* T; __device__ __forceinline__ void operator()(int m, int n, float a, float) const { T[(size_t)m * D + n] = bf2f(PR[(size_t)m * NIN + C_GSB + n]) * a; } };
struct EpiGate2 { const bf16_t* PR; const float* T; bf16_t* MIX; __device__ __forceinline__ void operator()(int m, int n, float a, float) const {
    MIX[(size_t)m * D + n] = (bf16_t)f2bf(T[(size_t)m * D + n] + bf2f(PR[(size_t)m * NIN + C_GDF + n]) * a); } };
struct EpiResid { const float* base; float* out; __device__ __forceinline__ void operator()(int m, int n, float a, float) const { out[(size_t)m * D + n] = base[(size_t)m * D + n] + a; } };


namespace pg8 {
constexpr int BM = 256, BK = 64, HALF = 128, HTB = HALF * BK * 2, STAGE_BYTES = 8 * HTB;
__host__ __device__ __forceinline__ int lds_byte(int r, int c) { const int st = (r >> 4) * 2 + (c >> 5), rr = r & 15, cc = c & 31, ob = rr * 64 + cc * 2; return st * 1024 + (ob ^ (((ob >> 9) & 1) << 5)); }
__host__ __device__ __forceinline__ void stage_rc(int b, int& R, int& C) { const int st = b / 1024, sb = b % 1024, swz = sb ^ (((sb >> 9) & 1) << 5); R = (st >> 1) * 16 + swz / 64; C = (st & 1) * 32 + (swz % 64) / 2; }
__host__ __device__ __forceinline__ int perm32(int rho) { const int n = rho >> 4, i = rho & 15; return 8 * (i >> 2) + 4 * n + (i & 3); }
struct Unit { int pm, pn, e; };
struct Gemm { const bf16_t* A; const bf16_t* Bt; int lda, ldb, K; };
typedef float f32x2 __attribute__((ext_vector_type(2))); typedef __bf16 bf16x2_t __attribute__((ext_vector_type(2)));
__device__ __forceinline__ unsigned cvt_pk_bf16(float lo, float hi) { f32x2 v = {lo, hi}; bf16x2_t b = __builtin_convertvector(v, bf16x2_t); return __builtin_bit_cast(unsigned, b); }

typedef int v8i __attribute__((ext_vector_type(8))); typedef int v4i __attribute__((ext_vector_type(4)));
__device__ __forceinline__ v8i cat8(bf16x8 a, bf16x8 b) { return __builtin_shufflevector(__builtin_bit_cast(v4i, a), __builtin_bit_cast(v4i, b), 0, 1, 2, 3, 4, 5, 6, 7); }
template <class Epi, class Sched, bool GATHER, bool FP8 = false>
__device__ __forceinline__ void gemm_phase(LAS unsigned char* lds, const Gemm g, const Sched& S, const Epi& E) {
    const int tid = threadIdx.x, wid = __builtin_amdgcn_readfirstlane(tid >> 6), lane = tid & 63, wr = wid >> 2, wc = wid & 3, fr = lane & 15, fq = lane >> 4;
    const int K = g.K, nt = K / BK;
    unsigned voffB[2], cva[2][2], nva[2][2];
#pragma unroll
    for (int i = 0; i < 2; ++i) { int R, C; stage_rc(tid * 16 + i * 8192, R, C); const int Rb = (R & ~31) + perm32(R & 31);
        voffB[i] = (unsigned)(Rb * g.ldb + C) * 2u;
#pragma unroll
        for (int h = 0; h < 2; ++h) { cva[h][i] = (unsigned)((h * HALF + R) * g.lda + C) * 2u; nva[h][i] = cva[h][i]; } }
    const unsigned kstep = (unsigned)(BK * 2);
    const unsigned hstepB = (unsigned)(HALF * g.ldb * 2);
    auto uni_ptr = [](const void* p_) { const unsigned long long v_ = (unsigned long long)p_; return (void*)(((unsigned long long)(unsigned)__builtin_amdgcn_readfirstlane((int)(v_ >> 32)) << 32) | (unsigned)__builtin_amdgcn_readfirstlane((int)v_)); };
    const auto rA = __builtin_amdgcn_make_buffer_rsrc(uni_ptr(g.A), 0, 0x7fffffff, 0x00020000), rB = __builtin_amdgcn_make_buffer_rsrc(uni_ptr(g.Bt), 0, 0x7fffffff, 0x00020000);
    const unsigned ldsw = (unsigned)wid * 1024u;
    const int aoff = lds_byte(wr * 64 + fr, fq * 8), boff = lds_byte(wc * 32 + fr, fq * 8);
#define PG8_SA(b, h) (((b) * 2 + (h)) * HTB)
#define PG8_SB(b, h) ((4 + (b) * 2 + (h)) * HTB)
#define PG8_STAGE(bufoff, rs, soff, voff) do { _Pragma("unroll") for (int _i = 0; _i < 2; ++_i) \
        __builtin_amdgcn_raw_ptr_buffer_load_lds(rs, (LAS unsigned*)(lds + (bufoff) + ldsw + _i * 8192), 16, (int)(voff)[_i], (int)(soff), 0, 0); } while (0)
#define PG8_LDA(dst, b, h) do { _Pragma("unroll") for (int m = 0; m < 4; ++m) _Pragma("unroll") for (int k = 0; k < 2; ++k) dst[m][k] = *(const LAS bf16x8*)(lds + PG8_SA(b, h) + aoff + m * 2048 + k * 1024); } while (0)
#define PG8_LDB(dst, b, h) do { _Pragma("unroll") for (int n = 0; n < 2; ++n) _Pragma("unroll") for (int k = 0; k < 2; ++k) dst[n][k] = *(const LAS bf16x8*)(lds + PG8_SB(b, h) + boff + n * 2048 + k * 1024); } while (0)
#define PG8_MMA(ai, bj, At, Bt) do { __builtin_amdgcn_s_setprio(1); _Pragma("unroll") for (int m = 0; m < 4; ++m) _Pragma("unroll") for (int n = 0; n < 2; ++n) { \
        if constexpr (FP8) { const v8i b8_ = cat8(Bt[n][0], Bt[n][1]), a8_ = cat8(At[m][0], At[m][1]); \
            asm volatile("s_nop 1\n\tv_mfma_scale_f32_16x16x128_f8f6f4 %0, %1, %2, %0, %3, %3 op_sel_hi:[0,0,0]" : "+v"(acc[ai][bj][m][n]) : "v"(b8_), "v"(a8_), "v"(one_scale)); } \
        else { _Pragma("unroll") for (int k = 0; k < 2; ++k) acc[ai][bj][m][n] = __builtin_amdgcn_mfma_f32_16x16x32_bf16(Bt[n][k], At[m][k], acc[ai][bj][m][n], 0, 0, 0); } } __builtin_amdgcn_s_setprio(0); } while (0)
#define PG8_WAIT_V(n) asm volatile("s_waitcnt vmcnt(" #n ")" ::: "memory")
#define PG8_WAIT_L(n) asm volatile("s_waitcnt lgkmcnt(" #n ")" ::: "memory")
#define PG8_BAR __builtin_amdgcn_s_barrier()
#define PG8_SCHED __builtin_amdgcn_sched_barrier(0)
    Unit cur, nxt; int ui = 0;
    if (!S.next(0, cur)) return;
    if constexpr (GATHER) {
#pragma unroll
        for (int i = 0; i < 2; ++i) { int R, C; stage_rc(tid * 16 + i * 8192, R, C);
#pragma unroll
            for (int h = 0; h < 2; ++h) cva[h][i] = (unsigned)(S.tok(cur, h * HALF + R) * g.lda + C) * 2u; }
    }
    const int one_scale = 0x7f7f7f7f;
    (void)one_scale;
    f32x4 acc[2][2][4][2];
#pragma unroll
    for (int a = 0; a < 2; ++a)
#pragma unroll
        for (int b = 0; b < 2; ++b)
#pragma unroll
            for (int m = 0; m < 4; ++m)
#pragma unroll
                for (int n = 0; n < 2; ++n) acc[a][b][m][n] = (f32x4){0.f, 0.f, 0.f, 0.f};
    bf16x8 At[4][2], B0[2][2], B1[2][2];
    unsigned cA = GATHER ? 0u : (unsigned)S.a_off(cur), cB = (unsigned)S.b_off(cur);
    PG8_STAGE(PG8_SB(0, 0), rB, cB, voffB); PG8_STAGE(PG8_SB(0, 1), rB, cB + hstepB, voffB); PG8_STAGE(PG8_SA(0, 0), rA, cA, cva[0]); PG8_STAGE(PG8_SA(0, 1), rA, cA, cva[1]);
    if (wr == 1) PG8_BAR;
    PG8_WAIT_V(2); PG8_BAR;
    PG8_STAGE(PG8_SB(1, 0), rB, cB + kstep, voffB); PG8_STAGE(PG8_SA(1, 0), rA, cA + kstep, cva[0]); PG8_STAGE(PG8_SB(1, 1), rB, cB + hstepB + kstep, voffB);
    PG8_WAIT_V(6); PG8_BAR;
    for (;;) {
        const bool has_next = S.next(ui + 1, nxt);
        const unsigned nA = (has_next && !GATHER) ? (unsigned)S.a_off(nxt) : cA, nB = has_next ? (unsigned)S.b_off(nxt) : cB;
        if constexpr (GATHER) {
#pragma unroll
            for (int i = 0; i < 2; ++i) { int R, C; stage_rc(tid * 16 + i * 8192, R, C);
#pragma unroll
                for (int h = 0; h < 2; ++h) nva[h][i] = has_next ? (unsigned)(S.tok(nxt, h * HALF + R) * g.lda + C) * 2u : cva[h][i]; }
        }
#pragma nounroll
        for (int t = 0; t < nt; t += 2) {
            const bool last = (t == nt - 2);
            const unsigned a1 = cA + (unsigned)(t + 1) * kstep;
            const unsigned a2 = last ? nA : cA + (unsigned)(t + 2) * kstep, b2 = last ? nB : cB + (unsigned)(t + 2) * kstep;
            const unsigned a3 = a2 + kstep, b3 = b2 + kstep;
            PG8_LDB(B0, 0, 0); PG8_LDB(B1, 0, 1); PG8_SCHED; PG8_LDA(At, 0, 0); PG8_STAGE(PG8_SA(1, 1), rA, a1, cva[1]);
            if constexpr (GATHER) { if (last) {
#pragma unroll
                for (int h = 0; h < 2; ++h)
#pragma unroll
                    for (int i = 0; i < 2; ++i) cva[h][i] = nva[h][i]; } }
            PG8_WAIT_V(8); PG8_WAIT_L(0); PG8_BAR; PG8_MMA(0, 0, At, B0); PG8_MMA(0, 1, At, B1); PG8_BAR; PG8_SCHED;
            PG8_LDA(At, 0, 1); PG8_STAGE(PG8_SB(0, 0), rB, b2, voffB); PG8_STAGE(PG8_SB(0, 1), rB, b2 + hstepB, voffB); PG8_STAGE(PG8_SA(0, 0), rA, a2, cva[0]);
            PG8_WAIT_V(8); PG8_WAIT_L(0); PG8_BAR; PG8_MMA(1, 0, At, B0); PG8_MMA(1, 1, At, B1); PG8_BAR; PG8_SCHED;
            PG8_LDB(B0, 1, 0); PG8_LDB(B1, 1, 1); PG8_SCHED; PG8_LDA(At, 1, 0); PG8_STAGE(PG8_SA(0, 1), rA, a2, cva[1]);
            PG8_WAIT_V(8); PG8_WAIT_L(0); PG8_BAR; PG8_MMA(0, 0, At, B0); PG8_MMA(0, 1, At, B1); PG8_BAR; PG8_SCHED;
            PG8_LDA(At, 1, 1); PG8_STAGE(PG8_SB(1, 0), rB, b3, voffB); PG8_STAGE(PG8_SB(1, 1), rB, b3 + hstepB, voffB); PG8_STAGE(PG8_SA(1, 0), rA, a3, cva[0]);
            PG8_WAIT_V(8); PG8_WAIT_L(0); PG8_BAR; PG8_MMA(1, 0, At, B0); PG8_MMA(1, 1, At, B1); PG8_BAR; PG8_SCHED;
        }
        if (wr == 0) PG8_BAR;
        if constexpr (FP8) asm volatile("s_nop 15\n\ts_nop 7" ::: "memory");
        E(acc, cur, wr, wc, fr, fq);
        if (!has_next) break;
#pragma unroll
        for (int a = 0; a < 2; ++a)
#pragma unroll
            for (int b = 0; b < 2; ++b)
#pragma unroll
                for (int m = 0; m < 4; ++m)
#pragma unroll
                    for (int n = 0; n < 2; ++n) acc[a][b][m][n] = (f32x4){0.f, 0.f, 0.f, 0.f};
        cur = nxt; cA = nA; cB = nB; ++ui;
        if constexpr (GATHER) {
#pragma unroll
            for (int i = 0; i < 2; ++i)
#pragma unroll
                for (int h = 0; h < 2; ++h) cva[h][i] = nva[h][i];
        }
        if (wr == 1) PG8_BAR;
    }
    PG8_WAIT_V(0);
    PG8_BAR;
#undef PG8_SA
#undef PG8_SB
#undef PG8_STAGE
#undef PG8_LDA
#undef PG8_LDB
#undef PG8_MMA
#undef PG8_WAIT_V
#undef PG8_WAIT_L
#undef PG8_BAR
#undef PG8_SCHED
}

struct DenseOrder {
    int nM, nN, nwg, G, c, lda, ldb;
    __device__ __forceinline__ void init(int M_, int N_, int G_, int c_, int lda_, int ldb_) { nM = M_ / BM; nN = N_ / BM; nwg = nM * nN; G = G_; c = c_; lda = lda_; ldb = ldb_; }
    __device__ __forceinline__ bool next(int i, Unit& u) const {
        const long L = (long)i * G + c; if (L >= nwg) return false;
        int wgid = (int)L; { const int q = nwg / 8, r = nwg % 8, xcd = wgid % 8, off = wgid / 8; wgid = (xcd < r ? xcd * (q + 1) : r * (q + 1) + (xcd - r) * q) + off; }
        const int nig = 8 * nN, gid = wgid / nig, fm = gid * 8, gsz = (nM - fm) < 8 ? (nM - fm) : 8;
        u.pm = fm + ((wgid % nig) % gsz); u.pn = (wgid % nig) / gsz; u.e = 0; return true;
    }
    __device__ __forceinline__ size_t a_off(const Unit& u) const { return (size_t)u.pm * BM * lda * 2; }
    __device__ __forceinline__ size_t b_off(const Unit& u) const { return (size_t)u.pn * BM * ldb * 2; }
    __device__ __forceinline__ int tok(const Unit&, int) const { return 0; }
};
struct TwoRoundOrder {
    int G, c, lda, ldb;
    __device__ __forceinline__ bool next(int i, Unit& u) const { const int L = i * G + c; if (L >= 512) return false; const int tile = L & 255; u.pm = tile >> 2; u.pn = tile & 3; u.e = L >> 8; return true; }
    __device__ __forceinline__ size_t a_off(const Unit& u) const { return (size_t)u.pm * BM * lda * 2 + (size_t)u.e * 1024; }
    __device__ __forceinline__ size_t b_off(const Unit& u) const { return (size_t)(u.e * 1024 + u.pn * BM) * ldb * 2; }
    __device__ __forceinline__ int tok(const Unit&, int) const { return 0; }
};
struct MoeOrder {
    const LAS int* tb; const int* tlist; int G, c, npn, lda, ldb, nexp;
    __device__ __forceinline__ bool next(int i, Unit& u) const {
        const int L = i * G + c; if (L >= tb[96]) return false;
        int e = 0; while (tb[65 + e] <= L) ++e;
        const int loc = L - tb[64 + e]; u.e = __builtin_amdgcn_readfirstlane(e); u.pn = __builtin_amdgcn_readfirstlane(loc % npn); u.pm = __builtin_amdgcn_readfirstlane((tb[e] >> 8) + loc / npn); return true;
    }
    __device__ __forceinline__ size_t a_off(const Unit& u) const { return (size_t)u.pm * BM * lda * 2; }
    __device__ __forceinline__ size_t b_off(const Unit& u) const { return (size_t)(u.e * nexp + u.pn * BM) * ldb * 2; }
    __device__ __forceinline__ int tok(const Unit& u, int row) const { const int r = u.pm * BM - tb[u.e] + row; return r < tb[32 + u.e] ? tlist[u.e * LISTCAP + r] : 0; }
};

#define EPI_ARGS const f32x4 (&acc)[2][2][4][2], const Unit& u, int wr, int wc, int fr, int fq
#define EPI_FOR_ROWS for (int ai = 0; ai < 2; ++ai) _Pragma("unroll") for (int m = 0; m < 4; ++m)
__device__ __forceinline__ v4u pack8(const f32x4 a, const f32x4 b) { v4u w; w.x = cvt_pk_bf16(a[0], a[1]); w.y = cvt_pk_bf16(a[2], a[3]); w.z = cvt_pk_bf16(b[0], b[1]); w.w = cvt_pk_bf16(b[2], b[3]); return w; }
__device__ __forceinline__ void unpack8(const v4u w, f32x4& a, f32x4& b) { a = (f32x4){lo16(w.x), hi16(w.x), lo16(w.y), hi16(w.y)}; b = (f32x4){lo16(w.z), hi16(w.z), lo16(w.w), hi16(w.w)}; }
__device__ __forceinline__ float sigm(float v) { return __builtin_amdgcn_rcpf(1.f + __expf(-v)); }

__device__ __forceinline__ void store_tile_T(const f32x4 (&acc)[2][2][4][2], bf16_t* VT, int vrow0, int s0, int pitch) {
#pragma unroll
    for (int bj = 0; bj < 2; ++bj)
#pragma unroll
        for (int n = 0; n < 2; ++n)
#pragma unroll
            for (int e = 0; e < 4; ++e) { bf16_t* vp = VT + (size_t)(vrow0 + 128 * bj + 4 * n + e) * pitch + s0;
#pragma unroll
                for (int ai = 0; ai < 2; ++ai)
#pragma unroll
                    for (int m = 0; m < 4; ++m) vp[128 * ai + 16 * m] = (bf16_t)(cvt_pk_bf16(acc[ai][bj][m][n][e], 0.f) & 0xffffu); }
}
struct EpiKV { bf16_t* KVM; bf16_t* VTM;
    __device__ __forceinline__ void operator()(EPI_ARGS) const {
        const int row0 = u.pm * BM + wr * 64 + fr, col0 = u.pn * BM + wc * 32 + 8 * fq;
#pragma unroll
        EPI_FOR_ROWS { bf16_t* rowp = KVM + (size_t)(row0 + ai * HALF + m * 16) * 2048 + col0;
#pragma unroll
            for (int bj = 0; bj < 2; ++bj) *(v4u*)(rowp + bj * HALF) = pack8(acc[ai][bj][m][0], acc[ai][bj][m][1]); }
        if (u.pn >= 4) store_tile_T(acc, VTM, u.pm * 1024 + (u.pn - 4) * BM + wc * 32 + 8 * fq, wr * 64 + fr, MEMLEN);
    } };
struct EpiBf16Store { bf16_t* O; int ldc;
    __device__ __forceinline__ void operator()(EPI_ARGS) const {
        const int row0 = u.pm * BM + wr * 64 + fr, col0 = u.pn * BM + wc * 32 + 8 * fq;
#pragma unroll
        EPI_FOR_ROWS { bf16_t* rowp = O + (size_t)(row0 + ai * HALF + m * 16) * ldc + col0;
#pragma unroll
            for (int bj = 0; bj < 2; ++bj) *(v4u*)(rowp + bj * HALF) = pack8(acc[ai][bj][m][0], acc[ai][bj][m][1]); }
    } };
struct EpiResidF32 { const float* base; float* out;
    __device__ __forceinline__ void operator()(EPI_ARGS) const {
        const int row0 = u.pm * BM + wr * 64 + fr, col0 = u.pn * BM + wc * 32 + 8 * fq;
#pragma unroll
        EPI_FOR_ROWS { const size_t off = (size_t)(row0 + ai * HALF + m * 16) * D + col0;
#pragma unroll
            for (int bj = 0; bj < 2; ++bj)
#pragma unroll
                for (int n = 0; n < 2; ++n) { const f32x4 b = *(const f32x4*)(base + off + bj * HALF + 4 * n); *(f32x4*)(out + off + bj * HALF + 4 * n) = b + acc[ai][bj][m][n]; } }
    } };
struct EpiResidNorm { const float* base; float* out; bf16_t* XB; float* SSQ;
    __device__ __forceinline__ void operator()(EPI_ARGS) const {
        const int row0 = u.pm * BM + wr * 64 + fr, col0 = u.pn * BM + wc * 32 + 8 * fq;
#pragma unroll
        EPI_FOR_ROWS { const int row = row0 + ai * HALF + m * 16; const size_t off = (size_t)row * D + col0; float ss = 0.f;
#pragma unroll
            for (int bj = 0; bj < 2; ++bj) { f32x4 v[2];
#pragma unroll
                for (int n = 0; n < 2; ++n) { v[n] = *(const f32x4*)(base + off + bj * HALF + 4 * n) + acc[ai][bj][m][n]; *(f32x4*)(out + off + bj * HALF + 4 * n) = v[n];
                    ss += (v[n][0] * v[n][0] + v[n][1] * v[n][1]) + (v[n][2] * v[n][2] + v[n][3] * v[n][3]); }
                *(v4u*)(XB + off + bj * HALF) = pack8(v[0], v[1]); }
            ss += __shfl_xor(ss, 16); ss += __shfl_xor(ss, 32);
            if (fq == 0) SSQ[(size_t)row * 16 + u.pn * 4 + wc] = ss; }
    } };
struct EpiBf16Rinv { bf16_t* O; const float* SSQ;
    __device__ __forceinline__ void operator()(EPI_ARGS) const {
        const int row0 = u.pm * BM + wr * 64 + fr, col0 = u.pn * BM + wc * 32 + 8 * fq;
#pragma unroll
        EPI_FOR_ROWS { const int row = row0 + ai * HALF + m * 16; const f32x4* sp = (const f32x4*)(SSQ + (size_t)row * 16);
            const f32x4 s0 = sp[0], s1 = sp[1], s2 = sp[2], s3 = sp[3];
            const float tot = (((s0[0] + s0[1]) + (s0[2] + s0[3])) + ((s1[0] + s1[1]) + (s1[2] + s1[3]))) + (((s2[0] + s2[1]) + (s2[2] + s2[3])) + ((s3[0] + s3[1]) + (s3[2] + s3[3])));
            const float rinv = 1.0f / sqrtf(tot * (1.f / 1024.f) + NORM_EPS);
            bf16_t* rowp = O + (size_t)row * D + col0;
#pragma unroll
            for (int bj = 0; bj < 2; ++bj) *(v4u*)(rowp + bj * HALF) = pack8(acc[ai][bj][m][0] * rinv, acc[ai][bj][m][1] * rinv); }
    } };
struct OneUnitOrder {
    int idx, lda, ldb;
    __device__ __forceinline__ bool next(int i, Unit& u) const { if (i > 0) return false; u.pm = idx >> 3; u.pn = idx & 7; u.e = 0; return true; }
    __device__ __forceinline__ size_t a_off(const Unit& u) const { return (size_t)u.pm * BM * lda * 2; }
    __device__ __forceinline__ size_t b_off(const Unit& u) const { return (size_t)u.pn * BM * ldb * 2; }
    __device__ __forceinline__ int tok(const Unit&, int) const { return 0; }
};
struct EpiGate { const bf16_t* PR; float* T; bf16_t* MIX;
    __device__ __forceinline__ void operator()(EPI_ARGS) const {
        const int row0 = u.pm * BM + wr * 64 + fr, col0 = u.pn * BM + wc * 32 + 8 * fq;
#pragma unroll
        EPI_FOR_ROWS { const int row = row0 + ai * HALF + m * 16;
#pragma unroll
            for (int bj = 0; bj < 2; ++bj) { const int col = col0 + bj * HALF; f32x4 g0, g1;
                unpack8(*(const v4u*)(PR + (size_t)row * NIN + (u.e ? C_GDF : C_GSB) + col), g0, g1);
                float* tp = T + (size_t)row * D + col;
                if (u.e == 0) { *(f32x4*)tp = g0 * acc[ai][bj][m][0]; *(f32x4*)(tp + 4) = g1 * acc[ai][bj][m][1]; }
                else { const f32x4 t0 = *(const f32x4*)tp, t1 = *(const f32x4*)(tp + 4); *(v4u*)(MIX + (size_t)row * D + col) = pack8(t0 + g0 * acc[ai][bj][m][0], t1 + g1 * acc[ai][bj][m][1]); } } }
    } };
struct EpiInProj { bf16_t* PR; const float* rc; const float* rs; bf16_t* VTSB; bf16_t* VTDF;
    __device__ __forceinline__ void operator()(EPI_ARGS) const {
        const int row0 = u.pm * BM + wr * 64 + fr, pn = u.pn;
        if (pn >= 6 && pn < 10) {
            const float sc = pn < 8 ? 0.125f : 1.0f; const int i0 = 16 * (wc & 1) + 4 * fq;
#pragma unroll
            EPI_FOR_ROWS { const int row = row0 + ai * HALF + m * 16; const f32x4 cs = *(const f32x4*)(rc + (size_t)row * 32 + i0), sn = *(const f32x4*)(rs + (size_t)row * 32 + i0);
#pragma unroll
                for (int bj = 0; bj < 2; ++bj) { const f32x4 lo = acc[ai][bj][m][0], hi = acc[ai][bj][m][1];
                    const f32x4 olo = (lo * cs - hi * sn) * sc, ohi = (hi * cs + lo * sn) * sc;
                    bf16_t* p = PR + (size_t)row * NIN + pn * BM + 64 * (2 * bj + (wc >> 1)) + i0;
                    v2u a, b; a.x = cvt_pk_bf16(olo[0], olo[1]); a.y = cvt_pk_bf16(olo[2], olo[3]); b.x = cvt_pk_bf16(ohi[0], ohi[1]); b.y = cvt_pk_bf16(ohi[2], ohi[3]);
                    *(v2u*)p = a; *(v2u*)(p + 32) = b; } }
        } else {
            const int col0 = pn * BM + wc * 32 + 8 * fq; const float sc = pn < 2 ? 0.125f : 1.0f; const bool sg = pn >= 12;
#pragma unroll
            EPI_FOR_ROWS { bf16_t* rowp = PR + (size_t)(row0 + ai * HALF + m * 16) * NIN + col0;
#pragma unroll
                for (int bj = 0; bj < 2; ++bj) { f32x4 v0 = acc[ai][bj][m][0] * sc, v1 = acc[ai][bj][m][1] * sc;
                    if (sg) { v0 = (f32x4){sigm(v0[0]), sigm(v0[1]), sigm(v0[2]), sigm(v0[3])}; v1 = (f32x4){sigm(v1[0]), sigm(v1[1]), sigm(v1[2]), sigm(v1[3])}; }
                    *(v4u*)(rowp + bj * HALF) = pack8(v0, v1); } }
            if (pn == 4 || pn == 5 || pn == 10 || pn == 11) {
                const int bb = u.pm >> 4, s0 = (u.pm & 15) * BM + wr * 64 + fr, hd0 = (pn < 6 ? (pn - 4) : (pn - 10)) * BM + wc * 32 + 8 * fq;
                store_tile_T(acc, pn < 6 ? VTSB : VTDF, bb * 512 + hd0, s0, SEQ);
            }
        }
    } };
struct EpiMoeGU { unsigned char* ACT8; const float* bgu; const float* wsc;
    __device__ __forceinline__ void operator()(EPI_ARGS) const {
        const int row0 = u.pm * BM + wr * 64 + fr, j0 = u.pn * 128 + wc * 32 + 8 * fq; const float* bg = bgu + (size_t)u.e * 2048 + j0; const float* sg = wsc + (size_t)u.e * 2048 + j0;
#pragma unroll
        EPI_FOR_ROWS { f32x4 o[2];
#pragma unroll
            for (int n = 0; n < 2; ++n) { const f32x4 gv = acc[ai][0][m][n] * *(const f32x4*)(sg + 4 * n) + *(const f32x4*)(bg + 4 * n), lv = acc[ai][1][m][n] * *(const f32x4*)(sg + 1024 + 4 * n) + *(const f32x4*)(bg + 1024 + 4 * n);
#pragma unroll
                for (int c = 0; c < 4; ++c) { const float gl = fminf(gv[c], 7.0f), li = fminf(fmaxf(lv[c], -7.0f), 7.0f); o[n][c] = gl * sigm(1.702f * gl) * (li + 1.0f); } }
            v2u w; w.x = pk4_fp8(o[0][0], o[0][1], o[0][2], o[0][3]); w.y = pk4_fp8(o[1][0], o[1][1], o[1][2], o[1][3]);
            *(v2u*)(ACT8 + (size_t)(row0 + ai * HALF + m * 16) * DFF + j0) = w; }
    } };
struct EpiMoeDown { bf16_t* YB; const float* bd; const float* glist; const LAS int* tb; const float* wsc;
    __device__ __forceinline__ void operator()(EPI_ARGS) const {
        const int row0 = u.pm * BM + wr * 64 + fr, col0 = u.pn * BM + wc * 32 + 8 * fq; const float* bp = bd + (size_t)u.e * D + col0; const float* sp = wsc + (size_t)u.e * D + col0;
        const float* gl = glist + (size_t)u.e * LISTCAP - tb[u.e];
        f32x4 bv[2][2], sv[2][2];
#pragma unroll
        for (int bj = 0; bj < 2; ++bj)
#pragma unroll
            for (int n = 0; n < 2; ++n) { bv[bj][n] = *(const f32x4*)(bp + bj * HALF + 4 * n); sv[bj][n] = *(const f32x4*)(sp + bj * HALF + 4 * n); }
#pragma unroll
        EPI_FOR_ROWS { const int row = row0 + ai * HALF + m * 16; const float gt = gl[row];
#pragma unroll
            for (int bj = 0; bj < 2; ++bj) *(v4u*)(YB + (size_t)row * D + col0 + bj * HALF) = pack8((acc[ai][bj][m][0] * sv[bj][0] + bv[bj][0]) * gt, (acc[ai][bj][m][1] * sv[bj][1] + bv[bj][1]) * gt); }
    } };
}


typedef float f32x16 __attribute__((ext_vector_type(16)));
typedef short s16x4 __attribute__((ext_vector_type(4)));
__device__ __forceinline__ f32x16 mfma32(bf16x8 a, bf16x8 b, f32x16 c) { return __builtin_amdgcn_mfma_f32_32x32x16_bf16(a, b, c, 0, 0, 0); }
__device__ __forceinline__ float xhalf(float v, int hh) { auto rr = __builtin_amdgcn_permlane32_swap(__float_as_uint(v), __float_as_uint(v), false, false); return __uint_as_float(hh ? rr[0] : rr[1]); }
__device__ __forceinline__ bf16x8 vt_frag(const bf16_t* p) { const s16x4 lo = *(const s16x4*)p, hi = *(const s16x4*)(p + 8); return (bf16x8){lo[0], lo[1], lo[2], lo[3], hi[0], hi[1], hi[2], hi[3]}; }
__device__ __forceinline__ bf16x8 pack_p(const f32x16& p, int s) { v4u w; w.x = pg8::cvt_pk_bf16(p[8 * s + 0], p[8 * s + 1]); w.y = pg8::cvt_pk_bf16(p[8 * s + 2], p[8 * s + 3]); w.z = pg8::cvt_pk_bf16(p[8 * s + 4], p[8 * s + 5]); w.w = pg8::cvt_pk_bf16(p[8 * s + 6], p[8 * s + 7]); return __builtin_bit_cast(bf16x8, w); }
constexpr float LOG2E = 1.4426950408889634f;

template <int NO>
__device__ __forceinline__ void softmax_step(f32x16& S, float C, float& m, float& l, f32x16 (&O)[NO], int hh) {
    float mx = fmaxf(fmaxf(S[0], S[1]), fmaxf(S[2], S[3]));
#pragma unroll
    for (int i = 4; i < 16; i += 4) mx = fmaxf(mx, fmaxf(fmaxf(S[i], S[i + 1]), fmaxf(S[i + 2], S[i + 3])));
    mx = fmaxf(mx, xhalf(mx, hh)) * C;
    const float mn = fmaxf(m, mx), al = __builtin_amdgcn_exp2f(m - mn);
    m = mn; l *= al;
#pragma unroll
    for (int o = 0; o < NO; ++o) O[o] = O[o] * al;
    float ps = 0.f;
#pragma unroll
    for (int i = 0; i < 16; ++i) { S[i] = __builtin_amdgcn_exp2f(S[i] * C - mn); ps += S[i]; }
    l += ps;
}

__device__ __forceinline__ void attn_diff_wave(const bf16_t* PR, const bf16_t* VT, float* ODR, int b, int h, int j, int q0, int lane) {
    const int r32 = lane & 31, hh = lane >> 5;
    const bf16_t* qrow = PR + (size_t)(b * SEQ + q0 + r32) * NIN + C_DQ + h * 128 + j * 64 + 8 * hh;
    bf16x8 qf[4];
#pragma unroll
    for (int d0 = 0; d0 < 4; ++d0) qf[d0] = *(const bf16x8*)(qrow + 16 * d0);
    const bf16_t* kbase = PR + (size_t)(b * SEQ + r32) * NIN + C_DK + h * 128 + j * 64 + 8 * hh;
    const bf16_t* vbase = VT + (size_t)(b * 512 + h * 128 + r32) * SEQ + 4 * hh;
    f32x16 O[4];
#pragma unroll
    for (int o = 0; o < 4; ++o)
#pragma unroll
        for (int i = 0; i < 16; ++i) O[o][i] = 0.f;
    float m = -INFINITY, l = 0.f;
    const int nt = 2 * (q0 / 64 + 1);
    for (int t = 0; t < nt; ++t) {
        const bf16_t* kp = kbase + (size_t)(32 * t) * NIN;
        f32x16 S;
#pragma unroll
        for (int i = 0; i < 16; ++i) S[i] = 0.f;
#pragma unroll
        for (int d0 = 0; d0 < 4; ++d0) S = mfma32(*(const bf16x8*)(kp + 16 * d0), qf[d0], S);
        softmax_step<4>(S, LOG2E, m, l, O, hh);
        const bf16x8 p0 = pack_p(S, 0), p1 = pack_p(S, 1);
        const bf16_t* vp = vbase + 32 * t;
#pragma unroll
        for (int o = 0; o < 4; ++o) { O[o] = mfma32(vt_frag(vp + (size_t)(32 * o) * SEQ), p0, O[o]); O[o] = mfma32(vt_frag(vp + (size_t)(32 * o) * SEQ + 16), p1, O[o]); }
    }
    l += xhalf(l, hh);
    const float il = 1.f / l;
    float* orow = ODR + ((size_t)j * M + (size_t)b * SEQ + q0 + r32) * 512 + h * 128 + 4 * hh;
#pragma unroll
    for (int o = 0; o < 4; ++o)
#pragma unroll
        for (int g = 0; g < 4; ++g) *(f32x4*)(orow + 32 * o + 8 * g) = (f32x4){O[o][4 * g] * il, O[o][4 * g + 1] * il, O[o][4 * g + 2] * il, O[o][4 * g + 3] * il};
}

__device__ __forceinline__ void attn_sb_wave(const bf16_t* PR, const bf16_t* VT, bf16_t* OAT, int b, int h, int q0, int lane) {
    const int r32 = lane & 31, hh = lane >> 5;
    const bf16_t* qrow = PR + (size_t)(b * SEQ + q0 + r32) * NIN + C_SBQ + h * 64 + 8 * hh;
    bf16x8 qf[4];
#pragma unroll
    for (int d0 = 0; d0 < 4; ++d0) qf[d0] = *(const bf16x8*)(qrow + 16 * d0);
    const bf16_t* kbase = PR + (size_t)(b * SEQ + r32) * NIN + C_SBK + h * 64 + 8 * hh;
    const bf16_t* vbase = VT + (size_t)(b * 512 + h * 64 + r32) * SEQ + 4 * hh;
    f32x16 O[2];
#pragma unroll
    for (int o = 0; o < 2; ++o)
#pragma unroll
        for (int i = 0; i < 16; ++i) O[o][i] = 0.f;
    float R = 0.f;
    const int td = q0 >> 5;
    for (int t = td; t >= 0; --t) {
        const bf16_t* kp = kbase + (size_t)(32 * t) * NIN;
        f32x16 S;
#pragma unroll
        for (int i = 0; i < 16; ++i) S[i] = 0.f;
#pragma unroll
        for (int d0 = 0; d0 < 4; ++d0) S = mfma32(*(const bf16x8*)(kp + 16 * d0), qf[d0], S);
        f32x16 lr;
#pragma unroll
        for (int i = 0; i < 16; ++i) { const float z2 = S[i] * LOG2E; const float sp = fmaxf(z2, 0.f) + __builtin_amdgcn_logf(1.f + __builtin_amdgcn_exp2f(-fabsf(z2)));
            lr[i] = -sp; S[i] = z2 - sp; }
        if (t == td) {
#pragma unroll
            for (int i = 0; i < 16; ++i) { const int kvl = (i & 3) + 8 * (i >> 2) + 4 * hh; if (kvl >= r32) { lr[i] = 0.f; S[i] = -INFINITY; } }
        }
        float tot[4], pt[4], off[4];
        f32x16 ex;
#pragma unroll
        for (int g = 0; g < 4; ++g) { ex[4 * g + 3] = 0.f; ex[4 * g + 2] = lr[4 * g + 3]; ex[4 * g + 1] = lr[4 * g + 3] + lr[4 * g + 2]; ex[4 * g] = ex[4 * g + 1] + lr[4 * g + 1]; tot[g] = ex[4 * g] + lr[4 * g]; }
#pragma unroll
        for (int g = 0; g < 4; ++g) pt[g] = xhalf(tot[g], hh);
        const float own0 = hh ? 0.f : 1.f;
        float sp_ = 0.f;
#pragma unroll
        for (int g = 3; g >= 0; --g) { off[g] = sp_ + own0 * pt[g] + R; sp_ += tot[g] + pt[g]; }
#pragma unroll
        for (int i = 0; i < 16; ++i) S[i] = __builtin_amdgcn_exp2f(S[i] + ex[i] + off[i >> 2]);
        R += sp_;
        const bf16x8 p0 = pack_p(S, 0), p1 = pack_p(S, 1);
        const bf16_t* vp = vbase + 32 * t;
#pragma unroll
        for (int o = 0; o < 2; ++o) { O[o] = mfma32(vt_frag(vp + (size_t)(32 * o) * SEQ), p0, O[o]); O[o] = mfma32(vt_frag(vp + (size_t)(32 * o) * SEQ + 16), p1, O[o]); }
        if (__all(R < -160.f)) break;
    }
    bf16_t* orow = OAT + (size_t)(b * SEQ + q0 + r32) * D + h * 64 + 4 * hh;
#pragma unroll
    for (int o = 0; o < 2; ++o)
#pragma unroll
        for (int g = 0; g < 4; ++g) { v2u w; w.x = pg8::cvt_pk_bf16(O[o][4 * g], O[o][4 * g + 1]); w.y = pg8::cvt_pk_bf16(O[o][4 * g + 2], O[o][4 * g + 3]); *(v2u*)(orow + 32 * o + 8 * g) = w; }
}

__device__ __forceinline__ void attn_mem_wave(const bf16_t* QM, const bf16_t* KVM, const bf16_t* VT, bf16_t* OM, int b, int h, int q0, int lane) {
    const int r32 = lane & 31, hh = lane >> 5;
    const bf16_t* qrow = QM + (size_t)(b * SEQ + q0 + r32) * D + h * 256 + 8 * hh;
    const bf16_t* kbase = KVM + (size_t)(b * MEMLEN + r32) * 2048 + h * 256 + 8 * hh;
    for (int dh = 0; dh < 2; ++dh) {
        const bf16_t* vbase = VT + (size_t)(b * 1024 + h * 256 + dh * 128 + r32) * MEMLEN + 4 * hh;
        f32x16 O[4];
#pragma unroll
        for (int o = 0; o < 4; ++o)
#pragma unroll
            for (int i = 0; i < 16; ++i) O[o][i] = 0.f;
        float m = -INFINITY, l = 0.f;
        for (int t = 0; t < 8; ++t) {
            const bf16_t* kp = kbase + (size_t)(32 * t) * 2048;
            f32x16 S;
#pragma unroll
            for (int i = 0; i < 16; ++i) S[i] = 0.f;
#pragma unroll
            for (int d0 = 0; d0 < 16; ++d0) S = mfma32(*(const bf16x8*)(kp + 16 * d0), *(const bf16x8*)(qrow + 16 * d0), S);
            softmax_step<4>(S, LOG2E * 0.0625f, m, l, O, hh);
            const bf16x8 p0 = pack_p(S, 0), p1 = pack_p(S, 1);
            const bf16_t* vp = vbase + 32 * t;
#pragma unroll
            for (int o = 0; o < 4; ++o) { O[o] = mfma32(vt_frag(vp + (size_t)(32 * o) * MEMLEN), p0, O[o]); O[o] = mfma32(vt_frag(vp + (size_t)(32 * o) * MEMLEN + 16), p1, O[o]); }
        }
        l += xhalf(l, hh);
        const float il = 1.f / l;
        bf16_t* orow = OM + (size_t)(b * SEQ + q0 + r32) * D + h * 256 + dh * 128 + 4 * hh;
#pragma unroll
        for (int o = 0; o < 4; ++o)
#pragma unroll
            for (int g = 0; g < 4; ++g) { v2u w; w.x = pg8::cvt_pk_bf16(O[o][4 * g] * il, O[o][4 * g + 1] * il); w.y = pg8::cvt_pk_bf16(O[o][4 * g + 2] * il, O[o][4 * g + 3] * il); *(v2u*)(orow + 32 * o + 8 * g) = w; }
    }
}


constexpr int VSTR = 136;
template <int NCH> __device__ __forceinline__ void stage_load(v4u (&r)[NCH], const bf16_t* g0, int chunks_per_row, size_t gpitch, int tid) {
#pragma unroll
    for (int i = 0; i < NCH; ++i) { const int c = tid + NTHR * i, row = c / chunks_per_row, ch = c % chunks_per_row; r[i] = *(const v4u*)(g0 + (size_t)row * gpitch + ch * 8); }
}
template <int NCH> __device__ __forceinline__ void stage_store_k(const v4u (&r)[NCH], LAS unsigned char* dst, int chunks_per_row, int lstride, int tid) {
#pragma unroll
    for (int i = 0; i < NCH; ++i) { const int c = tid + NTHR * i, row = c / chunks_per_row, ch = c % chunks_per_row; *(LAS v4u*)(dst + row * lstride + ch * 16) = r[i]; }
}
template <int NCH> __device__ __forceinline__ void stage_store_v(const v4u (&r)[NCH], LAS unsigned char* dst, int tid) {
#pragma unroll
    for (int i = 0; i < NCH; ++i) { const int c = tid + NTHR * i, row = c >> 3, ch = c & 7; LAS v2u* d = (LAS v2u*)(dst + row * VSTR + ch * 16); d[0] = (v2u){r[i].x, r[i].y}; d[1] = (v2u){r[i].z, r[i].w}; }
}
__device__ __forceinline__ bf16x8 lds_vfrag(const LAS unsigned char* p) { const v2u lo = *(const LAS v2u*)p, hi = *(const LAS v2u*)(p + 16); return __builtin_bit_cast(bf16x8, (v4u){lo.x, lo.y, hi.x, hi.y}); }

template <int NO>
__device__ __forceinline__ void softmax_step2(f32x16& S0, f32x16& S1, float C, float& m, float& l, f32x16 (&O)[NO], int hh) {
    float mx = fmaxf(fmaxf(S0[0], S0[1]), fmaxf(S1[0], S1[1]));
#pragma unroll
    for (int i = 2; i < 16; i += 2) mx = fmaxf(mx, fmaxf(fmaxf(S0[i], S0[i + 1]), fmaxf(S1[i], S1[i + 1])));
    mx = fmaxf(mx, xhalf(mx, hh)) * C;
    const float mn = fmaxf(m, mx), al = __builtin_amdgcn_exp2f(m - mn);
    m = mn; l *= al;
#pragma unroll
    for (int o = 0; o < NO; ++o) O[o] = O[o] * al;
    float ps = 0.f;
#pragma unroll
    for (int i = 0; i < 16; ++i) { S0[i] = __builtin_amdgcn_exp2f(S0[i] * C - mn); S1[i] = __builtin_amdgcn_exp2f(S1[i] * C - mn); ps += S0[i] + S1[i]; }
    l += ps;
}

__device__ __forceinline__ void attn_diff_block(const bf16_t* PR, const bf16_t* VT, bf16_t* OAT, const float* subln, float lam, int b, int h, int qb, LAS unsigned char* lds, int tid, int wave, int lane) {
    constexpr int KSTR = 144, KB = 64 * KSTR, BUF = 2 * KB + 128 * VSTR;
    const int r32 = lane & 31, hh = lane >> 5, j = wave >> 2, w4 = wave & 3, q0 = qb * 128 + w4 * 32;
    const bf16_t* qrow = PR + (size_t)(b * SEQ + q0 + r32) * NIN + C_DQ + h * 128 + j * 64 + 8 * hh;
    bf16x8 qf[4];
#pragma unroll
    for (int d0 = 0; d0 < 4; ++d0) qf[d0] = *(const bf16x8*)(qrow + 16 * d0);
    const bf16_t* kg = PR + (size_t)(b * SEQ) * NIN + C_DK + h * 128;
    const bf16_t* vg = VT + (size_t)(b * 512 + h * 128) * SEQ;
    f32x16 O[4];
#pragma unroll
    for (int o = 0; o < 4; ++o)
#pragma unroll
        for (int i = 0; i < 16; ++i) O[o][i] = 0.f;
    float m = -INFINITY, l = 0.f;
    const int nsteps = 2 * qb + 2, my_last = 2 * qb + (w4 >> 1);
    v4u k1r[1], k2r[1], vr[2];
    stage_load<1>(k1r, kg, 8, NIN, tid); stage_load<1>(k2r, kg + 64, 8, NIN, tid); stage_load<2>(vr, vg, 8, SEQ, tid);
    stage_store_k<1>(k1r, lds, 8, KSTR, tid); stage_store_k<1>(k2r, lds + KB, 8, KSTR, tid); stage_store_v<2>(vr, lds + 2 * KB, tid);
    __syncthreads();
    for (int t = 0; t < nsteps; ++t) {
        const bool more = t + 1 < nsteps;
        if (more) { const bf16_t* kn = kg + (size_t)(64 * (t + 1)) * NIN; stage_load<1>(k1r, kn, 8, NIN, tid); stage_load<1>(k2r, kn + 64, 8, NIN, tid); stage_load<2>(vr, vg + 64 * (t + 1), 8, SEQ, tid); }
        if (t <= my_last) {
            const LAS unsigned char* kb = lds + (t & 1) * BUF + j * KB + r32 * KSTR + 16 * hh; const LAS unsigned char* vb = lds + (t & 1) * BUF + 2 * KB + r32 * VSTR + 8 * hh;
            f32x16 S0, S1;
#pragma unroll
            for (int i = 0; i < 16; ++i) { S0[i] = 0.f; S1[i] = 0.f; }
#pragma unroll
            for (int d0 = 0; d0 < 4; ++d0) { S0 = mfma32(*(const LAS bf16x8*)(kb + 32 * d0), qf[d0], S0); S1 = mfma32(*(const LAS bf16x8*)(kb + 32 * KSTR + 32 * d0), qf[d0], S1); }
            softmax_step2<4>(S0, S1, LOG2E, m, l, O, hh);
            const bf16x8 p00 = pack_p(S0, 0), p01 = pack_p(S0, 1), p10 = pack_p(S1, 0), p11 = pack_p(S1, 1);
#pragma unroll
            for (int o = 0; o < 4; ++o) { const LAS unsigned char* vp = vb + 32 * o * VSTR;
                O[o] = mfma32(lds_vfrag(vp), p00, O[o]); O[o] = mfma32(lds_vfrag(vp + 32), p01, O[o]); O[o] = mfma32(lds_vfrag(vp + 64), p10, O[o]); O[o] = mfma32(lds_vfrag(vp + 96), p11, O[o]); }
        }
        if (more) { LAS unsigned char* nb = lds + ((t + 1) & 1) * BUF; stage_store_k<1>(k1r, nb, 8, KSTR, tid); stage_store_k<1>(k2r, nb + KB, 8, KSTR, tid); stage_store_v<2>(vr, nb + 2 * KB, tid); }
        __syncthreads();
    }
    l += xhalf(l, hh);
    const float il = 1.f / l;
    LAS float* X = (LAS float*)lds + (size_t)(w4 * 32 + r32) * 132 + 4 * hh;
    if (j == 1) {
#pragma unroll
        for (int o = 0; o < 4; ++o)
#pragma unroll
            for (int g = 0; g < 4; ++g) *(LAS f32x4*)(X + 32 * o + 8 * g) = (f32x4){O[o][4 * g] * il, O[o][4 * g + 1] * il, O[o][4 * g + 2] * il, O[o][4 * g + 3] * il};
    }
    __syncthreads();
    if (j == 0) {
        float ss = 0.f;
#pragma unroll
        for (int o = 0; o < 4; ++o)
#pragma unroll
            for (int g = 0; g < 4; ++g) { const f32x4 o2 = *(const LAS f32x4*)(X + 32 * o + 8 * g);
#pragma unroll
                for (int c = 0; c < 4; ++c) { const float d = O[o][4 * g + c] * il - lam * o2[c]; O[o][4 * g + c] = d; ss += d * d; } }
        ss += xhalf(ss, hh);
        const float rinv = 0.8f / sqrtf(ss * (1.f / 128.f) + NORM_EPS);
        bf16_t* orow = OAT + (size_t)(b * SEQ + q0 + r32) * D + 512 + h * 128 + 4 * hh; const float* sl = subln + 4 * hh;
#pragma unroll
        for (int o = 0; o < 4; ++o)
#pragma unroll
            for (int g = 0; g < 4; ++g) { const f32x4 sg_ = *(const f32x4*)(sl + 32 * o + 8 * g); v2u w;
                w.x = pg8::cvt_pk_bf16(O[o][4 * g] * rinv * sg_[0], O[o][4 * g + 1] * rinv * sg_[1]); w.y = pg8::cvt_pk_bf16(O[o][4 * g + 2] * rinv * sg_[2], O[o][4 * g + 3] * rinv * sg_[3]); *(v2u*)(orow + 32 * o + 8 * g) = w; }
    }
    __syncthreads();
}

__device__ __forceinline__ void sb_subtile(f32x16& S, bool diag, float& R, f32x16 (&O)[2], const LAS unsigned char* vp, int r32, int hh) {
    f32x16 lr;
#pragma unroll
    for (int i = 0; i < 16; ++i) { const float z2 = S[i] * LOG2E; const float sp = fmaxf(z2, 0.f) + __builtin_amdgcn_logf(1.f + __builtin_amdgcn_exp2f(-fabsf(z2))); lr[i] = -sp; S[i] = z2 - sp; }
    if (diag) {
#pragma unroll
        for (int i = 0; i < 16; ++i) { const int kvl = (i & 3) + 8 * (i >> 2) + 4 * hh; if (kvl >= r32) { lr[i] = 0.f; S[i] = -INFINITY; } }
    }
    float tot[4], pt[4], off[4]; f32x16 ex;
#pragma unroll
    for (int g = 0; g < 4; ++g) { ex[4 * g + 3] = 0.f; ex[4 * g + 2] = lr[4 * g + 3]; ex[4 * g + 1] = lr[4 * g + 3] + lr[4 * g + 2]; ex[4 * g] = ex[4 * g + 1] + lr[4 * g + 1]; tot[g] = ex[4 * g] + lr[4 * g]; }
#pragma unroll
    for (int g = 0; g < 4; ++g) pt[g] = xhalf(tot[g], hh);
    const float own0 = hh ? 0.f : 1.f;
    float sp_ = 0.f;
#pragma unroll
    for (int g = 3; g >= 0; --g) { off[g] = sp_ + own0 * pt[g] + R; sp_ += tot[g] + pt[g]; }
#pragma unroll
    for (int i = 0; i < 16; ++i) S[i] = __builtin_amdgcn_exp2f(S[i] + ex[i] + off[i >> 2]);
    R += sp_;
    const bf16x8 p0 = pack_p(S, 0), p1 = pack_p(S, 1);
#pragma unroll
    for (int o = 0; o < 2; ++o) { O[o] = mfma32(lds_vfrag(vp + 32 * o * VSTR), p0, O[o]); O[o] = mfma32(lds_vfrag(vp + 32 * o * VSTR + 32), p1, O[o]); }
}
__device__ __forceinline__ void attn_sb_block(const bf16_t* PR, const bf16_t* VT, bf16_t* OAT, int b, int h, int qb, LAS unsigned char* lds, volatile LAS unsigned* fl, int tid, int wave, int lane) {
    constexpr int KSTR = 144, KB = 64 * KSTR, BUF = KB + 64 * VSTR;
    const int r32 = lane & 31, hh = lane >> 5, q0 = qb * 256 + wave * 32;
    const bf16_t* qrow = PR + (size_t)(b * SEQ + q0 + r32) * NIN + C_SBQ + h * 64 + 8 * hh;
    bf16x8 qf[4];
#pragma unroll
    for (int d0 = 0; d0 < 4; ++d0) qf[d0] = *(const bf16x8*)(qrow + 16 * d0);
    const bf16_t* kg = PR + (size_t)(b * SEQ) * NIN + C_SBK + h * 64;
    const bf16_t* vg = VT + (size_t)(b * 512 + h * 64) * SEQ;
    f32x16 O[2];
#pragma unroll
    for (int o = 0; o < 2; ++o)
#pragma unroll
        for (int i = 0; i < 16; ++i) O[o][i] = 0.f;
    float R = 0.f; bool done = false;
    const int ttop = 4 * qb + 3, my_diag = 4 * qb + (wave >> 1), odd = wave & 1;
    v4u kr[1], vr[1];
    if (tid < 3) fl[tid] = 0u;
    stage_load<1>(kr, kg + (size_t)(64 * ttop) * NIN, 8, NIN, tid); stage_load<1>(vr, vg + 64 * ttop, 8, SEQ, tid);
    stage_store_k<1>(kr, lds, 8, KSTR, tid); stage_store_v<1>(vr, lds + KB, tid);
    __syncthreads();
    int it = 0;
    for (int t = ttop; t >= 0; --t, ++it) {
        const bool more = t > 0;
        if (more) { stage_load<1>(kr, kg + (size_t)(64 * (t - 1)) * NIN, 8, NIN, tid); stage_load<1>(vr, vg + 64 * (t - 1), 8, SEQ, tid); }
        const int fcur = it % 3;
        if (tid == 0) fl[(it + 1) % 3] = 0u;
        if (t <= my_diag && !done) {
            const LAS unsigned char* kb = lds + (it & 1) * BUF + r32 * KSTR + 16 * hh; const LAS unsigned char* vb = lds + (it & 1) * BUF + KB + r32 * VSTR + 8 * hh;
            const bool isd = (t == my_diag);
            if (!isd || odd) {
                f32x16 S;
#pragma unroll
                for (int i = 0; i < 16; ++i) S[i] = 0.f;
#pragma unroll
                for (int d0 = 0; d0 < 4; ++d0) S = mfma32(*(const LAS bf16x8*)(kb + 32 * KSTR + 32 * d0), qf[d0], S);
                sb_subtile(S, isd, R, O, vb + 64, r32, hh);
            }
            {
                f32x16 S;
#pragma unroll
                for (int i = 0; i < 16; ++i) S[i] = 0.f;
#pragma unroll
                for (int d0 = 0; d0 < 4; ++d0) S = mfma32(*(const LAS bf16x8*)(kb + 32 * d0), qf[d0], S);
                sb_subtile(S, isd && !odd, R, O, vb, r32, hh);
            }
            done = __all(R < -160.f);
        }
        if (done && lane == 0) __hip_atomic_fetch_or((LAS unsigned*)(fl + fcur), 1u << wave, __ATOMIC_RELAXED, __HIP_MEMORY_SCOPE_WORKGROUP);
        if (more) { LAS unsigned char* nb = lds + ((it + 1) & 1) * BUF; stage_store_k<1>(kr, nb, 8, KSTR, tid); stage_store_v<1>(vr, nb + KB, tid); }
        __syncthreads();
        if (fl[fcur] == 0xffu) break;
    }
    bf16_t* orow = OAT + (size_t)(b * SEQ + q0 + r32) * D + h * 64 + 4 * hh;
#pragma unroll
    for (int o = 0; o < 2; ++o)
#pragma unroll
        for (int g = 0; g < 4; ++g) { v2u w; w.x = pg8::cvt_pk_bf16(O[o][4 * g], O[o][4 * g + 1]); w.y = pg8::cvt_pk_bf16(O[o][4 * g + 2], O[o][4 * g + 3]); *(v2u*)(orow + 32 * o + 8 * g) = w; }
    __syncthreads();
}

__device__ __forceinline__ void attn_mem_block(const bf16_t* QM, const bf16_t* KVM, const bf16_t* VT, bf16_t* OM, int b, int h, int qb, LAS unsigned char* lds, int tid, int wave, int lane) {
    constexpr int KSTR = 528, KB = 32 * KSTR, VS = 72, BUF = KB + 128 * VS;
    const int r32 = lane & 31, hh = lane >> 5, q0 = qb * 256 + wave * 32;
    const bf16_t* qrow = QM + (size_t)(b * SEQ + q0 + r32) * D + h * 256 + 8 * hh;
    bf16x8 qf[8];
    LAS unsigned char* qs = lds + 53248 + wave * 8192 + lane * 16;
#pragma unroll
    for (int d0 = 0; d0 < 8; ++d0) { qf[d0] = *(const bf16x8*)(qrow + 16 * d0); *(LAS bf16x8*)(qs + d0 * 1024) = *(const bf16x8*)(qrow + 128 + 16 * d0); }
    const bf16_t* kg = KVM + (size_t)(b * MEMLEN) * 2048 + h * 256;
    const int vrow = tid >> 2, vch = tid & 3;
    for (int dh = 0; dh < 2; ++dh) {
        const bf16_t* vg = VT + (size_t)(b * 1024 + h * 256 + dh * 128 + vrow) * MEMLEN + vch * 8;
        f32x16 O[4];
#pragma unroll
        for (int o = 0; o < 4; ++o)
#pragma unroll
            for (int i = 0; i < 16; ++i) O[o][i] = 0.f;
        float m = -INFINITY, l = 0.f;
        v4u kr[2], vr;
        stage_load<2>(kr, kg, 32, 2048, tid); vr = *(const v4u*)vg;
        stage_store_k<2>(kr, lds, 32, KSTR, tid); { LAS v2u* d = (LAS v2u*)(lds + KB + vrow * VS + vch * 16); d[0] = (v2u){vr.x, vr.y}; d[1] = (v2u){vr.z, vr.w}; }
        __syncthreads();
        for (int t = 0; t < 8; ++t) {
            const bool more = t < 7;
            if (more) { stage_load<2>(kr, kg + (size_t)(32 * (t + 1)) * 2048, 32, 2048, tid); vr = *(const v4u*)(vg + 32 * (t + 1)); }
            {
                const LAS unsigned char* kb = lds + (t & 1) * BUF + r32 * KSTR + 16 * hh; const LAS unsigned char* vb = lds + (t & 1) * BUF + KB + r32 * VS + 8 * hh;
                f32x16 S;
#pragma unroll
                for (int i = 0; i < 16; ++i) S[i] = 0.f;
#pragma unroll
                for (int d0 = 0; d0 < 8; ++d0) S = mfma32(*(const LAS bf16x8*)(kb + 32 * d0), qf[d0], S);
#pragma unroll
                for (int d0 = 0; d0 < 8; ++d0) S = mfma32(*(const LAS bf16x8*)(kb + 256 + 32 * d0), *(const LAS bf16x8*)(qs + d0 * 1024), S);
                softmax_step<4>(S, LOG2E * 0.0625f, m, l, O, hh);
                const bf16x8 p0 = pack_p(S, 0), p1 = pack_p(S, 1);
#pragma unroll
                for (int o = 0; o < 4; ++o) { const LAS unsigned char* vp = vb + 32 * o * VS; O[o] = mfma32(lds_vfrag(vp), p0, O[o]); O[o] = mfma32(lds_vfrag(vp + 32), p1, O[o]); }
            }
            if (more) { LAS unsigned char* nb = lds + ((t + 1) & 1) * BUF; stage_store_k<2>(kr, nb, 32, KSTR, tid); LAS v2u* d = (LAS v2u*)(nb + KB + vrow * VS + vch * 16); d[0] = (v2u){vr.x, vr.y}; d[1] = (v2u){vr.z, vr.w}; }
            __syncthreads();
        }
        l += xhalf(l, hh);
        const float il = 1.f / l;
        bf16_t* orow = OM + (size_t)(b * SEQ + q0 + r32) * D + h * 256 + dh * 128 + 4 * hh;
#pragma unroll
        for (int o = 0; o < 4; ++o)
#pragma unroll
            for (int g = 0; g < 4; ++g) { v2u w; w.x = pg8::cvt_pk_bf16(O[o][4 * g] * il, O[o][4 * g + 1] * il); w.y = pg8::cvt_pk_bf16(O[o][4 * g + 2] * il, O[o][4 * g + 3] * il); *(v2u*)(orow + 32 * o + 8 * g) = w; }
    }
}

struct Args { const void* in[26]; float* out; unsigned char* ws; int ph_lo, ph_hi; };
constexpr int NPHASE = 15;

__device__ __forceinline__ float softplus_f(float z) { return fmaxf(z, 0.f) + __logf(1.f + __expf(-fabsf(z))); }

__global__ void __launch_bounds__(NTHR, 2) fwd(Args args) {
    extern __shared__ __attribute__((aligned(16))) unsigned char lds[];
    LAS unsigned char* L = (LAS unsigned char*)lds;
    volatile LAS unsigned* MISC = (volatile LAS unsigned*)(L + MISC_OFF);
    const int tid = threadIdx.x, lane = tid & 63, wave = __builtin_amdgcn_readfirstlane(tid >> 6);
    const int G = gridDim.x;
    unsigned char* ws = args.ws;
    unsigned* ctl = (unsigned*)(ws + WS_CTL);
#define x_in ((const float*)args.in[0])
#define mem_in ((const float*)args.in[1])
#define positions ((const int*)args.in[2])
#define norm_mix ((const float*)args.in[3])
#define w_in ((const float*)args.in[4])
#define lam_q1 ((const float*)args.in[5])
#define lam_k1 ((const float*)args.in[6])
#define lam_q2 ((const float*)args.in[7])
#define lam_k2 ((const float*)args.in[8])
#define diff_subln ((const float*)args.in[9])
#define w_up_sb ((const float*)args.in[10])
#define w_up_diff ((const float*)args.in[11])
#define w_out ((const float*)args.in[12])
#define norm_mem_q ((const float*)args.in[13])
#define norm_mem_kv ((const float*)args.in[14])
#define w_mem_q ((const float*)args.in[15])
#define w_mem_kv ((const float*)args.in[16])
#define w_mem_o ((const float*)args.in[17])
#define norm_ffn ((const float*)args.in[18])
#define w_router ((const float*)args.in[19])
#define b_router ((const float*)args.in[20])
#define w_gate_up ((const float*)args.in[21])
#define b_gate_up ((const float*)args.in[22])
#define w_down ((const float*)args.in[23])
#define b_down ((const float*)args.in[24])
#define norm_final ((const float*)args.in[25])
    bf16_t* WIN = (bf16_t*)(ws + WS_WIN); bf16_t* WUPSB = (bf16_t*)(ws + WS_WUPSB); bf16_t* WUPDF = (bf16_t*)(ws + WS_WUPDF); bf16_t* WOUT = (bf16_t*)(ws + WS_WOUT);
    bf16_t* WMQ = (bf16_t*)(ws + WS_WMQ); bf16_t* WMKV = (bf16_t*)(ws + WS_WMKV); bf16_t* WMO = (bf16_t*)(ws + WS_WMO);
    bf16_t* WGU = (bf16_t*)(ws + WS_WGU); bf16_t* WD = (bf16_t*)(ws + WS_WD);
    float* ROPEC = (float*)(ws + WS_ROPE); float* ROPES = ROPEC + (size_t)M * 32;
    int* TK_E = (int*)(ws + WS_TK); int* TK_POS = TK_E + (size_t)M * 4; float* TK_G = (float*)(TK_POS + (size_t)M * 4);
    bf16_t* XN = (bf16_t*)(ws + WS_XN); bf16_t* PR = (bf16_t*)(ws + WS_PR); bf16_t* OAT = (bf16_t*)(ws + WS_OAT); float* SSQ = (float*)(ws + WS_ODR);
    bf16_t* MIX = (bf16_t*)(ws + WS_MIX); float* X1 = (float*)(ws + WS_X1); float* X2 = (float*)(ws + WS_X2);
    bf16_t* HM = (bf16_t*)(ws + WS_HM); bf16_t* KVM = (bf16_t*)(ws + WS_KVM); int* TLIST = (int*)(ws + WS_TLIST); float* GLIST = (float*)(ws + WS_GLIST);
    bf16_t* QM = (bf16_t*)(ws + WS_QM); bf16_t* OM = (bf16_t*)(ws + WS_OM); bf16_t* ACT = (bf16_t*)(ws + WS_ACT); bf16_t* YB = (bf16_t*)(ws + WS_YB);
    bf16_t* VTSB = (bf16_t*)(ws + WS_VTSB); bf16_t* VTDF = (bf16_t*)(ws + WS_VTDF); bf16_t* VTM = (bf16_t*)(ws + WS_VTM);
    float* WR = (float*)(ws + WS_WR); float* WSCGU = (float*)(ws + WS_WSC); float* WSCD = WSCGU + NE * 2048;
    unsigned char* WGU8 = ws + WS_WGU; unsigned char* WD8 = ws + WS_WD; unsigned char* XN8 = ws + WS_XN; unsigned char* ACT8 = ws + WS_ACT;
    unsigned* CNT = ctl + CW_CNT;
    LAS float* smf = (LAS float*)L;
    LAS int* smi = (LAS int*)L;

    for (int u = tid; u < (LDS_BYTES - 131072) / 4; u += NTHR) ((LAS unsigned*)(L + 131072))[u] = 0u;
    __syncthreads();
#if !MK_PER_PHASE
    XcdBarrier bar = xcd_barrier_post(ctl + CW_BAR, MISC + 8);
#define GRID_BAR() xcd_barrier(bar)
#else
#define GRID_BAR() do {} while (0)
#endif
    const int lo = args.ph_lo, hi = args.ph_hi;
#define IN(k) (lo <= (k) && (k) < hi)
#define PHASE_L(k, ...) do { if (IN(k)) { auto body_ = [&]() __attribute__((always_inline)) __VA_ARGS__; body_(); if ((PROBE_REP >> (k)) & 1) { GRID_BAR(); body_(); } } } while (0)
#if !MK_PER_PHASE
#define PHASE(k) for (int rep_ = 0, nrep_ = IN(k) ? 1 + ((PROBE_REP >> (k)) & 1) : 0; rep_ < nrep_; ++rep_, (rep_ < nrep_ ? (xcd_barrier(bar), 0) : 0))
#else
#define PHASE(k) if (IN(k))
#endif
    unsigned long long st_t0_ = 0ull, st_dt_ = 0ull;
#define STAMP_AT(k) do { if (PROBE_STAMP >= 0) { const unsigned long long now_ = __builtin_amdgcn_s_memrealtime(); if ((k) == PROBE_STAMP || (PROBE_STAMP == 100 && (k) == 0)) st_t0_ = now_; if ((k) == PROBE_STAMP + 1 || (PROBE_STAMP == 100 && (k) == 15)) st_dt_ = now_ - st_t0_; } } while (0)
#define SEAM(k) do { if (IN(k) && IN((k) + 1)) GRID_BAR(); STAMP_AT((k) + 1); } while (0)
    const int gw = blockIdx.x * NWAVES + wave, NGW = G * NWAVES;
    const int xcu = (G % 8 == 0) ? ((int)blockIdx.x % 8) * (G / 8) + (int)blockIdx.x / 8 : (int)blockIdx.x;

    STAMP_AT(0);
    PHASE(0) {
        STAMP_AT(20);
        LAS float* scr = (LAS float*)(L + wave * 16384);
        constexpr int I_IN = 16 * 160, I_UP = 8 * 32, I_SQ = 16 * 32, I_KV = 16 * 64, I_GU1 = 16 * 64, I_GU = NE * I_GU1, I_D1 = 16 * 32, I_DN = NE * I_D1;
        constexpr int NITEMS = I_IN + 2 * I_UP + 3 * I_SQ + I_KV;
        for (int it = gw; it < NITEMS; it += NGW) {
            int r = it;
            if (r < I_IN) {
                const int kb = r / 160, nb = r % 160, n0 = 32 * nb;
                if (n0 >= C_DQ && n0 < C_DV) { const int o = n0 & 255;
                    p0_transpose_rope(w_in, WIN, (n0 & ~255), o, 64 * kb, n0, scr, lane); }
                else p0_transpose_item(w_in, 1024, NIN, WIN, n0, 64 * kb, n0, scr, lane);
                continue; } r -= I_IN;
            if (r < I_UP) { p0_plain(w_up_sb, 512, 1024, WUPSB, r, scr, lane); continue; } r -= I_UP;
            if (r < I_UP) { p0_plain(w_up_diff, 512, 1024, WUPDF, r, scr, lane); continue; } r -= I_UP;
            if (r < I_SQ) { p0_plain(w_out, 1024, 1024, WOUT, r, scr, lane); continue; } r -= I_SQ;
            if (r < I_SQ) { p0_plain(w_mem_q, 1024, 1024, WMQ, r, scr, lane, norm_mem_q); continue; } r -= I_SQ;
            if (r < I_SQ) { p0_plain(w_mem_o, 1024, 1024, WMO, r, scr, lane); continue; } r -= I_SQ;
            p0_plain(w_mem_kv, 1024, 2048, WMKV, r, scr, lane);
        }
        for (int i = blockIdx.x * NTHR + tid; i < D * NE; i += G * NTHR) WR[i] = w_router[i] * norm_ffn[i >> 5];
        STAMP_AT(21);
        {
            LAS float* sinv = scr + 64 * 33;
            const int n_ = lane & 31, hf = lane >> 5, cc = lane & 7;
            float ra[32], rb[32];
            auto sub_load = [&](const float* Wn, int N, int k0, float (&r)[32]) __attribute__((always_inline)) {
#pragma unroll
                for (int i = 0; i < 32; ++i) r[i] = Wn[(size_t)(k0 + 2 * i + hf) * N]; };
            auto to_lds = [&](const float (&r)[32]) __attribute__((always_inline)) {
#pragma unroll
                for (int i = 0; i < 32; ++i) scr[(2 * i + hf) * 33 + n_] = r[i];
                LDS_WAIT(); asm volatile("" ::: "memory"); };
            auto col_amax = [&]() __attribute__((always_inline)) -> float { float a = 0.f;
#pragma unroll
                for (int i = 0; i < 32; ++i) a = fmaxf(a, fabsf(scr[(32 * hf + i) * 33 + n_]));
                return fmaxf(a, xhalf(a, hf)); };
            for (int it = gw; it < NE * 96 * 4; it += NGW) {
                const int strip = it % (NE * 96), qt = it / (NE * 96);
                const bool gu = strip < NE * 64; const int q = gu ? strip : strip - NE * 64, e = gu ? q >> 6 : q >> 5, n0 = (gu ? q & 63 : q & 31) * 32, N = gu ? 2048 : 1024;
                const float* Wn = (gu ? w_gate_up + (size_t)e * 1024 * 2048 : w_down + (size_t)e * 1024 * 1024) + n0 + n_;
                sub_load(Wn, N, 0, ra); sub_load(Wn, N, 256 * qt, rb);
                to_lds(ra);
                { const float a0 = col_amax();
                  unsigned eb = ((__float_as_uint(a0) >> 23) & 0xffu) + 4u; eb = eb < 8u ? 8u : (eb > 250u ? 250u : eb);
                  const float sc = __uint_as_float((eb - 7u) << 23), inv = __uint_as_float((261u - eb) << 23);
                  if (hf == 0) { sinv[n_] = inv; if (qt == 0) (gu ? WSCGU + (size_t)e * 2048 : WSCD + (size_t)e * 1024)[n0 + n_] = sc; }
                  LDS_WAIT(); asm volatile("" ::: "memory"); }
                float amax_run = 0.f;
                unsigned char* dstb = gu ? WGU8 + (size_t)e * 2048 * 1024 : WD8 + (size_t)e * 1024 * 1024;
#pragma unroll
                for (int st = 0; st < 4; ++st) {
                    const int k0 = 256 * qt + 64 * st;
                    if (st & 1) { if (st < 3) sub_load(Wn, N, k0 + 64, rb); to_lds(ra); } else { if (st < 3) sub_load(Wn, N, k0 + 64, ra); to_lds(rb); }
                    amax_run = fmaxf(amax_run, col_amax());
#pragma unroll
                    for (int j = 0; j < 4; ++j) { const int n = (lane >> 3) + 8 * j, c = n0 + n; const LAS float* sp = scr + (8 * cc) * 33 + n; const float inv = sinv[n];
                        const int drow = gu ? (((c & 1023) >> 7) * 256 + (c >> 10) * 128 + (c & 127)) : c;
                        v2u w; w.x = pk4_fp8(sp[0] * inv, sp[33] * inv, sp[66] * inv, sp[99] * inv); w.y = pk4_fp8(sp[132] * inv, sp[165] * inv, sp[198] * inv, sp[231] * inv);
                        *(v2u*)(dstb + (size_t)drow * 1024 + k0 + 8 * cc) = w; }
                    LDS_WAIT(); asm volatile("" ::: "memory");
                }
                const bool ov = amax_run * sinv[n_] >= 448.0f;
                if (__any(ov) && lane == 0) __hip_atomic_store(ctl + CW_REDO + strip, 1u, __ATOMIC_RELAXED, __HIP_MEMORY_SCOPE_AGENT);
                LDS_WAIT(); asm volatile("" ::: "memory");
            }
        }
        STAMP_AT(22);
        for (int m = gw; m < M; m += NGW) rms_row_to_bf16(x_in + (size_t)m * D, norm_mix, XN + (size_t)m * D, lane);
        for (int m = gw; m < MM; m += NGW) rms_row_to_bf16(mem_in + (size_t)m * D, norm_mem_kv, HM + (size_t)m * D, lane);
        for (int i = blockIdx.x * NTHR + tid; i < M * 32; i += G * NTHR) {
            const int m = i >> 5, f = i & 31;
            const double inv = exp2(-(double)f * (13.287712379549449 / 32.0));
            const double ang = (double)positions[m] * inv;
            const double kk = rint(ang * 0.15915494309189535);
            const float rf = (float)(ang - kk * 6.283185307179586);
            ROPEC[i] = __cosf(rf); ROPES[i] = __sinf(rf);
        }
        STAMP_AT(23);
    }
    SEAM(0); STAMP_AT(24);

    if (IN(1)) {
        {
            LAS float* sw = (LAS float*)L; LAS float* red = (LAS float*)(L + 131072 + 4096);
            const int n = tid & 31, part = tid >> 5;
            for (int it = blockIdx.x; it < NE * 96; it += G) {
                if (__hip_atomic_load(ctl + CW_REDO + it, __ATOMIC_RELAXED, __HIP_MEMORY_SCOPE_AGENT) == 0u) continue;
                const bool gu = it < NE * 64; const int q = gu ? it : it - NE * 64, e = gu ? q >> 6 : q >> 5, n0 = (gu ? q & 63 : q & 31) * 32, N = gu ? 2048 : 1024;
                const float* W = (gu ? w_gate_up + (size_t)e * 1024 * 2048 : w_down + (size_t)e * 1024 * 1024) + n0 + n;
                __syncthreads();
#pragma unroll 16
                for (int i = 0; i < 64; ++i) { const int k = part + 16 * i; sw[k * 32 + n] = W[(size_t)k * N]; }
                __syncthreads();
                float am = 0.f;
#pragma unroll 16
                for (int i = 0; i < 64; ++i) am = fmaxf(am, fabsf(sw[(64 * part + i) * 32 + n]));
                red[part * 32 + n] = am;
                __syncthreads();
                if (tid < 32) { float a = red[tid];
#pragma unroll
                    for (int pp = 1; pp < 16; ++pp) a = fmaxf(a, red[pp * 32 + tid]);
                    unsigned eb = (__float_as_uint(a) >> 23) & 0xffu; eb = eb < 8u ? 8u : eb;
                    const float sc = __uint_as_float((eb - 7u) << 23), inv = __uint_as_float((261u - eb) << 23);
                    red[512 + tid] = inv; (gu ? WSCGU + (size_t)e * 2048 : WSCD + (size_t)e * 1024)[n0 + tid] = sc; }
                __syncthreads();
                { const float inv = red[512 + n]; const int c = n0 + n;
                  const int drow = gu ? (((c & 1023) >> 7) * 256 + (c >> 10) * 128 + (c & 127)) : c;
                  unsigned char* dst = (gu ? WGU8 + ((size_t)e * 2048 + drow) * 1024 : WD8 + ((size_t)e * 1024 + drow) * 1024) + 64 * part;
#pragma unroll
                  for (int qd = 0; qd < 4; ++qd) { v4u w;
                      const LAS float* sp = sw + (64 * part + 16 * qd) * 32 + n;
                      w.x = pk4_fp8(sp[0] * inv, sp[32] * inv, sp[64] * inv, sp[96] * inv); w.y = pk4_fp8(sp[128] * inv, sp[160] * inv, sp[192] * inv, sp[224] * inv);
                      w.z = pk4_fp8(sp[256] * inv, sp[288] * inv, sp[320] * inv, sp[352] * inv); w.w = pk4_fp8(sp[384] * inv, sp[416] * inv, sp[448] * inv, sp[480] * inv);
                      *(v4u*)(dst + 16 * qd) = w; } }
            }
            __syncthreads();
        }
    }
    PHASE_L(1, {
        { pg8::Gemm g{XN, WIN, D, D, D}; pg8::DenseOrder S; S.init(M, NIN, G, (int)blockIdx.x, D, D);
          pg8::gemm_phase<pg8::EpiInProj, pg8::DenseOrder, false>(L, g, S, pg8::EpiInProj{PR, ROPEC, ROPES, VTSB, VTDF}); }
    });
    SEAM(1);

    PHASE(3) {
        volatile LAS unsigned* fl = (volatile LAS unsigned*)(L + 131072 + 2048);
        const int nkv = (G >= 64) ? 32 : 0;
        if ((int)blockIdx.x < nkv) { pg8::Gemm g{HM, WMKV, D, D, D}; pg8::OneUnitOrder S{(int)blockIdx.x, D, D};
            pg8::gemm_phase<pg8::EpiKV, pg8::OneUnitOrder, false>(L, g, S, pg8::EpiKV{KVM, VTM}); }
        else for (int bu = (int)blockIdx.x - nkv; bu < 512; bu += G - nkv) { const int qb = bu & 15, h = (bu >> 4) & 7, b = bu >> 7; attn_sb_block(PR, VTSB, OAT, b, h, qb, L, fl, tid, wave, lane); }
        if (nkv == 0) { pg8::Gemm g{HM, WMKV, D, D, D}; pg8::DenseOrder S; S.init(MM, 2048, G, (int)blockIdx.x, D, D); pg8::gemm_phase<pg8::EpiKV, pg8::DenseOrder, false>(L, g, S, pg8::EpiKV{KVM, VTM}); }
        const float lam = expf(wave_sum(lam_q1[lane] * lam_k1[lane])) - expf(wave_sum(lam_q2[lane] * lam_k2[lane])) + 0.2f;
        for (int pr = blockIdx.x; pr < 256; pr += G) { const int sb_ = pr & 15, h = (pr >> 4) & 3, b = pr >> 6;
            attn_diff_block(PR, VTDF, OAT, diff_subln, lam, b, h, 31 - sb_, L, tid, wave, lane); attn_diff_block(PR, VTDF, OAT, diff_subln, lam, b, h, sb_, L, tid, wave, lane); }
    }
    SEAM(3); STAMP_AT(3);

    PHASE_L(5, {
        pg8::Gemm g{OAT, WUPSB, D, 512, 512}; pg8::TwoRoundOrder S{G, xcu, D, 512};
        pg8::gemm_phase<pg8::EpiGate, pg8::TwoRoundOrder, false>(L, g, S, pg8::EpiGate{PR, X2, MIX});
    });
    SEAM(5); STAMP_AT(5);

    PHASE_L(6, {
        pg8::Gemm g{MIX, WOUT, D, D, D}; pg8::DenseOrder S; S.init(M, D, G, (int)blockIdx.x, D, D);
        pg8::gemm_phase<pg8::EpiResidNorm, pg8::DenseOrder, false>(L, g, S, pg8::EpiResidNorm{x_in, X1, XN, SSQ});
    });
    if (IN(6) && IN(8)) GRID_BAR();
    STAMP_AT(7); STAMP_AT(8);

    PHASE_L(8, {
        pg8::Gemm g{XN, WMQ, D, D, D}; pg8::DenseOrder S; S.init(M, D, G, (int)blockIdx.x, D, D);
        pg8::gemm_phase<pg8::EpiBf16Rinv, pg8::DenseOrder, false>(L, g, S, pg8::EpiBf16Rinv{QM, SSQ});
    });
    SEAM(8);

    PHASE(9) { for (int bu = blockIdx.x; bu < 256; bu += G) { const int qb = bu & 15, h = (bu >> 4) & 3, b = bu >> 6; attn_mem_block(QM, KVM, VTM, OM, b, h, qb, L, tid, wave, lane); } }
    SEAM(9);

    PHASE_L(10, {
        pg8::Gemm g{OM, WMO, D, D, D}; pg8::DenseOrder S; S.init(M, D, G, (int)blockIdx.x, D, D);
        pg8::gemm_phase<pg8::EpiResidF32, pg8::DenseOrder, false>(L, g, S, pg8::EpiResidF32{X1, X2});
    });
    SEAM(10);

    if (IN(11)) {
        auto body11_ = [&]() __attribute__((always_inline)) {
        {
            const int i32 = lane & 31, kk = lane >> 5;
#pragma unroll
            for (int t2 = 0; t2 < 2; ++t2) {
                const int tile = t2 * G + (int)blockIdx.x, m0 = tile * 32;
                LAS float* P = smf + (t2 * 8 + wave) * 1056; LAS float* SSQ_ = smf + 16 * 1056 + (t2 * 8 + wave) * 32;
                f32x16 acc;
#pragma unroll
                for (int r = 0; r < 16; ++r) acc[r] = 0.f;
                float ss = 0.f;
                if (tile < M / 32) {
                    const float* xr = X2 + (size_t)(m0 + i32) * D + 128 * wave + 4 * kk; const float* wp = WR + (128 * wave + 4 * kk) * NE + i32;
#pragma unroll 8
                    for (int u = 0; u < 16; ++u) {
                        const f32x4 a = *(const f32x4*)(xr + 8 * u);
                        const float b0 = wp[(8 * u + 0) * NE], b1 = wp[(8 * u + 1) * NE], b2 = wp[(8 * u + 2) * NE], b3 = wp[(8 * u + 3) * NE];
                        acc = __builtin_amdgcn_mfma_f32_32x32x2f32(a.x, b0, acc, 0, 0, 0); acc = __builtin_amdgcn_mfma_f32_32x32x2f32(a.y, b1, acc, 0, 0, 0);
                        acc = __builtin_amdgcn_mfma_f32_32x32x2f32(a.z, b2, acc, 0, 0, 0); acc = __builtin_amdgcn_mfma_f32_32x32x2f32(a.w, b3, acc, 0, 0, 0);
                        ss += (a.x * a.x + a.y * a.y) + (a.z * a.z + a.w * a.w);
                    }
                }
                ss += xhalf(ss, kk);
#pragma unroll
                for (int r = 0; r < 16; ++r) P[((r & 3) + 8 * (r >> 2) + 4 * kk) * 33 + i32] = acc[r];
                if (kk == 0) SSQ_[i32] = ss;
            }
        }
        __syncthreads();
        if (wave < 2) {
            const int tile = wave * G + (int)blockIdx.x;
            if (tile < M / 32) {
                const int m0 = tile * 32;
                LAS float* T = smf + (wave * 8) * 1056;
#pragma unroll
                for (int r = 0; r < 16; ++r) { const int idx = lane + 64 * r, e_ = (idx >> 5) * 33 + (idx & 31); float v = T[e_];
#pragma unroll
                    for (int w2 = 1; w2 < 8; ++w2) v += T[w2 * 1056 + e_];
                    T[e_] = v; }
                float ss = 0.f;
#pragma unroll
                for (int w2 = 0; w2 < 8; ++w2) ss += smf[16 * 1056 + (wave * 8 + w2) * 32 + (lane & 31)];
                LDS_WAIT(); asm volatile("" ::: "memory");
                const float rinv = 1.0f / sqrtf(ss * (1.f / 1024.f) + NORM_EPS);
                if (lane < 32) {
                    float lg[32];
#pragma unroll
                    for (int j = 0; j < 32; ++j) lg[j] = T[lane * 33 + j] * rinv + b_router[j];
                    float tv[4]; int ti[4];
#pragma unroll
                    for (int k = 0; k < 4; ++k) { float bv = lg[0]; int bi = 0;
#pragma unroll
                        for (int j = 1; j < 32; ++j) if (lg[j] > bv) { bv = lg[j]; bi = j; }
                        tv[k] = bv; ti[k] = bi;
#pragma unroll
                        for (int j = 0; j < 32; ++j) if (j == bi) lg[j] = -INFINITY; }
                    const float e1 = __expf(tv[1] - tv[0]), e2 = __expf(tv[2] - tv[0]), e3 = __expf(tv[3] - tv[0]);
                    const float isum = 1.f / (1.f + e1 + e2 + e3);
                    const float gk[4] = {isum, e1 * isum, e2 * isum, e3 * isum};
                    LAS unsigned* H = (LAS unsigned*)(smf + 16 * 1056 + 512 + wave * 64);
                    H[lane] = 0u;
                    LDS_WAIT(); asm volatile("" ::: "memory");
                    int rk[4];
#pragma unroll
                    for (int k = 0; k < 4; ++k) rk[k] = (int)__hip_atomic_fetch_add(H + ti[k], 1u, __ATOMIC_RELAXED, __HIP_MEMORY_SCOPE_WAVEFRONT);
                    LDS_WAIT(); asm volatile("" ::: "memory");
                    const unsigned cnt_e = H[lane];
                    unsigned base_e = 0u; if (cnt_e) base_e = atomicAdd(&CNT[64 * lane], cnt_e);
                    H[32 + lane] = base_e;
                    LDS_WAIT(); asm volatile("" ::: "memory");
                    const int m = m0 + lane;
#pragma unroll
                    for (int k = 0; k < 4; ++k) { const int ek = ti[k]; const int pos = (int)H[32 + ek] + rk[k];
                        TLIST[ek * LISTCAP + pos] = m; GLIST[ek * LISTCAP + pos] = gk[k]; TK_E[m * 4 + k] = ek; TK_POS[m * 4 + k] = pos; TK_G[m * 4 + k] = gk[k]; }
                }
            }
        } else {
            for (int m = blockIdx.x * 6 + (wave - 2); m < M; m += G * 6) rms_row_to_fp8(X2 + (size_t)m * D, norm_ffn, XN8 + (size_t)m * D, lane);
        }
            };
        body11_();
        if ((PROBE_REP >> 11) & 1) { GRID_BAR(); if (blockIdx.x == 0 && tid < NE) CNT[64 * tid] = 0u; GRID_BAR(); body11_(); }
    }
    SEAM(11);

#define LOAD_BASES() do { __syncthreads(); if (tid == 0) { int b_ = 0; for (int e_ = 0; e_ < NE; ++e_) { const int c_ = (int)__hip_atomic_load(&CNT[64 * e_], __ATOMIC_RELAXED, __HIP_MEMORY_SCOPE_AGENT); \
        smi[8192 + e_] = b_; smi[8256 + e_] = c_; b_ += (c_ + 255) & ~255; } } __syncthreads(); } while (0)

    LAS int* tb = (LAS int*)(L + 131072 + 1024);
#define LOAD_TB(npn) do { __syncthreads(); if (tid == 0) { int b_ = 0, cu_ = 0; for (int e_ = 0; e_ < NE; ++e_) { const int c_ = (int)__hip_atomic_load(&CNT[64 * e_], __ATOMIC_RELAXED, __HIP_MEMORY_SCOPE_AGENT); \
        tb[e_] = b_; tb[32 + e_] = c_; tb[64 + e_] = cu_; b_ += (c_ + 255) & ~255; cu_ += ((c_ + 255) >> 8) * (npn); } tb[96] = cu_; } __syncthreads(); } while (0)
    PHASE_L(12, {
        LOAD_TB(8);
        pg8::Gemm g{(const bf16_t*)XN8, (const bf16_t*)WGU8, 512, 512, 512}; pg8::MoeOrder S{tb, TLIST, G, xcu, 8, 512, 512, 2048};
        pg8::gemm_phase<pg8::EpiMoeGU, pg8::MoeOrder, true, true>(L, g, S, pg8::EpiMoeGU{ACT8, b_gate_up, WSCGU});
    });
    SEAM(12);
    PHASE_L(13, {
        LOAD_TB(4);
        pg8::Gemm g{(const bf16_t*)ACT8, (const bf16_t*)WD8, 512, 512, 512}; pg8::MoeOrder S{tb, TLIST, G, xcu, 4, 512, 512, 1024};
        pg8::gemm_phase<pg8::EpiMoeDown, pg8::MoeOrder, false, true>(L, g, S, pg8::EpiMoeDown{YB, b_down, GLIST, tb, WSCD});
    });
    SEAM(13);

    PHASE(14) {
        LOAD_BASES();
        for (int mb = gw; mb < M; mb += 8 * NGW) {
            int slotv = 0;
            { const int i = lane >> 2, k = lane & 3, m = mb + NGW * i; if (lane < 32 && m < M) slotv = smi[8192 + TK_E[m * 4 + k]] + TK_POS[m * 4 + k]; }
#pragma unroll 2
            for (int i = 0; i < 8; ++i) {
                const int m = mb + NGW * i; if (m >= M) break;
                const f32x4* xr = (const f32x4*)(X2 + (size_t)m * D) + lane; const f32x4* gr = (const f32x4*)norm_final + lane;
                f32x4 v[4];
#pragma unroll
                for (int j = 0; j < 4; ++j) v[j] = xr[64 * j];
#pragma unroll
                for (int k = 0; k < 4; ++k) { const int slot = __builtin_amdgcn_readlane(slotv, 4 * i + k); const v2u* yr = (const v2u*)(YB + (size_t)slot * D) + lane;
#pragma unroll
                    for (int j = 0; j < 4; ++j) { const v2u w = yr[64 * j]; v[j].x += lo16(w.x); v[j].y += hi16(w.x); v[j].z += lo16(w.y); v[j].w += hi16(w.y); } }
                float ss = 0.f;
#pragma unroll
                for (int j = 0; j < 4; ++j) ss += (v[j].x * v[j].x + v[j].y * v[j].y) + (v[j].z * v[j].z + v[j].w * v[j].w);
                const float rinv = 1.0f / sqrtf(wave_sum(ss) * (1.f / 1024.f) + NORM_EPS);
                f32x4* orow = (f32x4*)(args.out + (size_t)m * D) + lane;
#pragma unroll
                for (int j = 0; j < 4; ++j) { const f32x4 gg = gr[64 * j]; orow[64 * j] = (f32x4){v[j].x * rinv * gg.x, v[j].y * rinv * gg.y, v[j].z * rinv * gg.z, v[j].w * rinv * gg.w}; }
            }
        }
    }
    if (PROBE_STAMP >= 0) { STAMP_AT(15); if (blockIdx.x == 0) { const unsigned long long t1_ = __builtin_amdgcn_s_memrealtime(); while (__builtin_amdgcn_s_memrealtime() - t1_ < st_dt_) __builtin_amdgcn_s_sleep(8); } }
#undef IN
#undef SEAM
}

extern "C" void kernel_launch(void* const* d_in, const int* in_sizes, int n_in, void* d_out, int out_size, void* d_ws, size_t ws_size, hipStream_t stream) {
    static int grid = 0;
    if (grid == 0) {
        if (n_in != 26 || out_size != M * D || ws_size < WS_END) { fprintf(stderr, "kernel_launch: unexpected sizes n_in %d out %d ws %zu\n", n_in, out_size, ws_size); grid = -1; return; }
        int dev = 0, cus = 0;
        if (hipGetDevice(&dev) != hipSuccess || hipDeviceGetAttribute(&cus, hipDeviceAttributeMultiprocessorCount, dev) != hipSuccess) { grid = -1; return; }
        if (hipFuncSetAttribute((const void*)fwd, hipFuncAttributeMaxDynamicSharedMemorySize, LDS_BYTES) != hipSuccess) { fprintf(stderr, "kernel_launch: hipFuncSetAttribute failed\n"); grid = -1; return; }
        int per_cu = 0;
        (void)hipOccupancyMaxActiveBlocksPerMultiprocessor(&per_cu, (const void*)fwd, NTHR, LDS_BYTES);
        (void)hipGetLastError();
        grid = cus;
    }
    if (grid < 0) return;
    (void)hipMemsetAsync((char*)d_ws + WS_CTL, 0, CTL_ZERO_BYTES, stream);
    Args a{};
    for (int i = 0; i < 26; ++i) a.in[i] = d_in[i];
    a.out = (float*)d_out; a.ws = (unsigned char*)d_ws;
#if MK_PER_PHASE
    for (int p = 0; p < NPHASE; ++p) { a.ph_lo = p; a.ph_hi = p + 1; hipLaunchKernelGGL(fwd, dim3(grid), dim3(NTHR), LDS_BYTES, stream, a); }
#else
    a.ph_lo = 0; a.ph_hi = NPHASE; hipLaunchKernelGGL(fwd, dim3(grid), dim3(NTHR), LDS_BYTES, stream, a);
#endif
}
```

```cpp
#include <hip/hip_runtime.h>
#include <cstdio>
#include <cstdint>

#ifndef MK_PER_PHASE
#define MK_PER_PHASE 0
#endif

#ifndef PROBE_STAMP
#define PROBE_STAMP -1
#endif
#ifndef PROBE_BLOCK
#define PROBE_BLOCK 0
#endif
#ifndef PROBE_REP
#define PROBE_REP 0
#endif
#define GAS __attribute__((address_space(1)))
#define LAS __attribute__((address_space(3)))
typedef unsigned short bf16_t;
typedef unsigned v4u __attribute__((ext_vector_type(4)));
typedef unsigned v2u __attribute__((ext_vector_type(2)));
typedef float f32x4 __attribute__((ext_vector_type(4)));
typedef short bf16x8 __attribute__((ext_vector_type(8)));

constexpr int BATCH = 4, SEQ = 4096, D = 1024, M = BATCH * SEQ, NIN = 5120;
constexpr int MEMLEN = 256, MM = BATCH * MEMLEN;
constexpr int NE = 32, TOPK = 4, DFF = 1024;
constexpr float NORM_EPS = 1e-6f;
constexpr int C_SBQ = 0, C_SBK = 512, C_SBV = 1024, C_DQ = 1536, C_DK = 2048, C_DV = 2560, C_GSB = 3072, C_GDF = 4096;
constexpr int LISTCAP = 16384;
constexpr int SLOTS = 65536 + NE * 256;
constexpr int NWAVES = 8, NTHR = 512;

constexpr size_t MiB = 1u << 20;
constexpr size_t WS_CTL = 0, CTL_ZERO_BYTES = 1 * MiB;
constexpr size_t WS_WIN = 2 * MiB;
constexpr size_t WS_WUPSB = 12 * MiB;
constexpr size_t WS_WUPDF = 13 * MiB;
constexpr size_t WS_WOUT = 14 * MiB;
constexpr size_t WS_WMQ = 16 * MiB;
constexpr size_t WS_WMKV = 18 * MiB;
constexpr size_t WS_WMO = 22 * MiB;
constexpr size_t WS_ROPE = 24 * MiB;
constexpr size_t WS_TK = 28 * MiB;
constexpr size_t WS_WR = 29 * MiB;
constexpr size_t WS_WSC = 30 * MiB;
constexpr size_t WS_WGU = 32 * MiB;
constexpr size_t WS_WD = 160 * MiB;
constexpr size_t WS_XN = 224 * MiB;
constexpr size_t WS_PR = 256 * MiB;
constexpr size_t WS_OAT = 416 * MiB;
constexpr size_t WS_ODR = 448 * MiB;
constexpr size_t WS_MIX = 512 * MiB;
constexpr size_t WS_X1 = 544 * MiB;
constexpr size_t WS_X2 = 608 * MiB;
constexpr size_t WS_HM = 672 * MiB;
constexpr size_t WS_KVM = 674 * MiB;
constexpr size_t WS_TLIST = 678 * MiB;
constexpr size_t WS_GLIST = 680 * MiB;
constexpr size_t WS_QM = 682 * MiB;
constexpr size_t WS_OM = 714 * MiB;
constexpr size_t WS_ACT = 256 * MiB;
constexpr size_t WS_YB = 746 * MiB;
constexpr size_t WS_VTSB = 890 * MiB;
constexpr size_t WS_VTDF = 906 * MiB;
constexpr size_t WS_VTM = 922 * MiB;
constexpr size_t WS_END = 924 * MiB;
static_assert(WS_ACT + (size_t)SLOTS * 1024 * 2 <= WS_OAT, "ACT overlay");
static_assert(WS_YB + (size_t)SLOTS * 1024 * 2 <= WS_VTSB, "YB");
constexpr int CW_REDO = 16384;
constexpr int CW_CNT = 8192;
constexpr int CW_BAR = 1024;

constexpr int LDS_BYTES = 147456;
constexpr int MISC_OFF = 131072 + 320;

__device__ __forceinline__ float bf2f(bf16_t b) { return __uint_as_float(((unsigned)b) << 16); }
__device__ __forceinline__ unsigned f2bf(float f) { unsigned u = __float_as_uint(f); return (u + 0x7fffu + ((u >> 16) & 1u)) >> 16; }
__device__ __forceinline__ unsigned pk2(float lo, float hi) { return f2bf(lo) | (f2bf(hi) << 16); }
__device__ __forceinline__ unsigned pk4_fp8(float a, float b, float c, float d) { int w = 0; w = __builtin_amdgcn_cvt_pk_fp8_f32(a, b, w, false); w = __builtin_amdgcn_cvt_pk_fp8_f32(c, d, w, true); return (unsigned)w; }
__device__ __forceinline__ float lo16(unsigned w) { return __uint_as_float(w << 16); }
__device__ __forceinline__ float hi16(unsigned w) { return __uint_as_float(w & 0xffff0000u); }
#define LDS_WAIT() asm volatile("s_waitcnt lgkmcnt(0)" ::: "memory")
__device__ __forceinline__ float wave_sum(float v) {
#pragma unroll
    for (int o = 1; o < 64; o <<= 1) v += __shfl_xor(v, o);
    return v;
}
__device__ __forceinline__ float wave_max(float v) {
#pragma unroll
    for (int o = 1; o < 64; o <<= 1) v = fmaxf(v, __shfl_xor(v, o));
    return v;
}

#define XB_TMO      128
#define XB_XCNT(j)  (256  + 64 * (j))
#define XB_XSUB(j)  (1280 + 64 * (j))
#define XB_XGEN(j)  (2304 + 64 * (j))
#define XB_TOP      3328
#define XB_TOPGEN   3392
#define XCD_BAR_WORDS 3456
#define XB_SPIN_CAP (1u << 18)
__device__ __forceinline__ unsigned xb_ld(unsigned* p)              { return __hip_atomic_load(p, __ATOMIC_RELAXED, __HIP_MEMORY_SCOPE_AGENT); }
__device__ __forceinline__ unsigned xb_add(unsigned* p, unsigned v) { return __hip_atomic_fetch_add(p, v, __ATOMIC_RELAXED, __HIP_MEMORY_SCOPE_AGENT); }
__device__ __forceinline__ unsigned xb_xcc_id() { return (unsigned)__builtin_amdgcn_s_getreg((3 << 11) | 20) & 0xFu; }
#define XB_SPIN(cond, bar) do { unsigned _sp = 0; while (cond) { __builtin_amdgcn_s_sleep(1); \
    if ((++_sp & 255u) == 0u) { if (xb_ld(&(bar)[XB_TMO])) break; if (_sp > XB_SPIN_CAP) { atomicAdd(&(bar)[XB_TMO], 1u); break; } } } } while (0)
struct XcdBarrier { unsigned* bar; unsigned x; volatile LAS unsigned* st; };
__device__ __forceinline__ XcdBarrier xcd_barrier_post(unsigned* bar, volatile LAS unsigned* st) {
    XcdBarrier b; b.bar = bar; b.x = xb_xcc_id(); b.st = st;
    if (threadIdx.x == 0) (void)xb_add(&bar[XB_XCNT(b.x)], 1u);
    return b;
}
__device__ __forceinline__ void xcd_barrier_complete(unsigned* bar, unsigned x, unsigned& nloc, unsigned& nx) {
    const unsigned G = gridDim.x * gridDim.y * gridDim.z;
    unsigned sum, cnt, mine, sp = 0u;
    for (;;) {
        sum = 0u; cnt = 0u; mine = 0u;
#pragma unroll
        for (unsigned j = 0; j < 16; ++j) { const unsigned c = xb_ld(&bar[XB_XCNT(j)]); sum += c; cnt += (c > 0u) ? 1u : 0u; mine = (j == x) ? c : mine; }
        if (sum == G) break;
        __builtin_amdgcn_s_sleep(1);
        if ((++sp & 255u) == 0u) { if (xb_ld(&bar[XB_TMO])) break; if (sp > XB_SPIN_CAP) { atomicAdd(&bar[XB_TMO], 1u); break; } }
    }
    nloc = mine > 0u ? mine : 1u; nx = cnt > 0u ? cnt : 1u;
}
__device__ __forceinline__ void xcd_barrier(const XcdBarrier& b) {
    asm volatile("s_waitcnt vmcnt(0)" ::: "memory");
    __syncthreads();
    if (threadIdx.x == 0) {
        unsigned* bar = b.bar;
        __builtin_amdgcn_s_waitcnt(0);
        unsigned nloc = b.st[0], nx = b.st[1];
        if (nloc == 0u) { xcd_barrier_complete(bar, b.x, nloc, nx); b.st[0] = nloc; b.st[1] = nx; }
        const unsigned old = xb_add(&bar[XB_XSUB(b.x)], 1u);
        const unsigned gen = old / nloc;
        if (old + 1u == (gen + 1u) * nloc) {
            __builtin_amdgcn_fence(__ATOMIC_RELEASE, "agent");
            asm volatile("s_waitcnt vmcnt(0)" ::: "memory");
            const unsigned og = xb_add(&bar[XB_TOP], 1u);
            const unsigned tg = og / nx;
            if (og + 1u == (tg + 1u) * nx) xb_add(&bar[XB_TOPGEN], 1u);
            else XB_SPIN(xb_ld(&bar[XB_TOPGEN]) == tg, bar);
            __builtin_amdgcn_fence(__ATOMIC_ACQUIRE, "agent");
            xb_add(&bar[XB_XGEN(b.x)], 1u);
            asm volatile("s_waitcnt vmcnt(0)" ::: "memory");
        } else {
            XB_SPIN(xb_ld(&bar[XB_XGEN(b.x)]) == gen, bar);
            __builtin_amdgcn_fence(__ATOMIC_ACQUIRE, "agent");
            asm volatile("s_waitcnt vmcnt(0)" ::: "memory");
        }
    }
    __syncthreads();
}

__device__ __forceinline__ void p0_transpose_item(const float* W, int K, int N, bf16_t* WT, int drow0, int k0, int n0, LAS float* scr, int lane, const float* gain = nullptr) {
#pragma unroll 8
    for (int i = 0; i < 32; ++i) { const int kk = 2 * i + (lane >> 5); float v = W[(size_t)(k0 + kk) * N + n0 + (lane & 31)]; if (gain) v *= gain[k0 + kk]; scr[kk * 33 + (lane & 31)] = v; }
    LDS_WAIT(); asm volatile("" ::: "memory");
    const int c = lane & 7;
#pragma unroll
    for (int j = 0; j < 4; ++j) { const int n = (lane >> 3) + 8 * j; const LAS float* s = scr + (8 * c) * 33 + n;
        v4u o; o.x = pk2(s[0 * 33], s[1 * 33]); o.y = pk2(s[2 * 33], s[3 * 33]); o.z = pk2(s[4 * 33], s[5 * 33]); o.w = pk2(s[6 * 33], s[7 * 33]);
        *(v4u*)(WT + (size_t)(drow0 + n) * K + k0 + 8 * c) = o; }
    LDS_WAIT(); asm volatile("" ::: "memory");
}
__device__ __forceinline__ void p0_plain(const float* W, int K, int N, bf16_t* WT, int item, LAS float* scr, int lane, const float* gain = nullptr) {
    const int nblk = N / 32, kb = item / nblk, nb = item % nblk;
    p0_transpose_item(W, K, N, WT, 32 * nb, 64 * kb, 32 * nb, scr, lane, gain);
}
__device__ __forceinline__ void p0_transpose_rope(const float* W, bf16_t* WT, int tilebase, int o, int k0, int n0, LAS float* scr, int lane) {
    const int K = 1024, N = NIN;
#pragma unroll 8
    for (int i = 0; i < 32; ++i) { const int kk = 2 * i + (lane >> 5); scr[kk * 33 + (lane & 31)] = W[(size_t)(k0 + kk) * N + n0 + (lane & 31)]; }
    LDS_WAIT(); asm volatile("" ::: "memory");
    const int c = lane & 7;
#pragma unroll
    for (int j = 0; j < 4; ++j) { const int n = (lane >> 3) + 8 * j; const LAS float* s = scr + (8 * c) * 33 + n;
        const int oo = o + n, v = ((oo >> 6) << 6) | (((oo >> 4) & 1) << 5) | (((oo >> 2) & 3) << 3) | (((oo >> 5) & 1) << 2) | (oo & 3);
        v4u w; w.x = pk2(s[0 * 33], s[1 * 33]); w.y = pk2(s[2 * 33], s[3 * 33]); w.z = pk2(s[4 * 33], s[5 * 33]); w.w = pk2(s[6 * 33], s[7 * 33]);
        *(v4u*)(WT + (size_t)(tilebase + v) * K + k0 + 8 * c) = w; }
    LDS_WAIT(); asm volatile("" ::: "memory");
}
__device__ __forceinline__ void rms_row_to_bf16(const float* xrow, const float* g, bf16_t* orow, int lane) {
    const f32x4* xr = (const f32x4*)xrow + lane; const f32x4* gr = (const f32x4*)g + lane;
    f32x4 v[4]; float s = 0.f;
#pragma unroll
    for (int j = 0; j < 4; ++j) { v[j] = xr[64 * j]; s += (v[j].x * v[j].x + v[j].y * v[j].y) + (v[j].z * v[j].z + v[j].w * v[j].w); }
    const float rinv = 1.0f / sqrtf(wave_sum(s) * (1.f / 1024.f) + NORM_EPS);
    v2u* o8 = (v2u*)orow + lane;
#pragma unroll
    for (int j = 0; j < 4; ++j) { const f32x4 gg = gr[64 * j]; v2u w; w.x = pk2(v[j].x * rinv * gg.x, v[j].y * rinv * gg.y); w.y = pk2(v[j].z * rinv * gg.z, v[j].w * rinv * gg.w); o8[64 * j] = w; }
}

__device__ __forceinline__ void rms_row_to_fp8(const float* xrow, const float* g, unsigned char* orow, int lane) {
    const f32x4* xr = (const f32x4*)xrow + lane; const f32x4* gr = (const f32x4*)g + lane;
    f32x4 v[4]; float s = 0.f;
#pragma unroll
    for (int j = 0; j < 4; ++j) { v[j] = xr[64 * j]; s += (v[j].x * v[j].x + v[j].y * v[j].y) + (v[j].z * v[j].z + v[j].w * v[j].w); }
    const float rinv = 1.0f / sqrtf(wave_sum(s) * (1.f / 1024.f) + NORM_EPS);
    unsigned* o4 = (unsigned*)orow + lane;
#pragma unroll
    for (int j = 0; j < 4; ++j) { const f32x4 gg = gr[64 * j]; o4[64 * j] = pk4_fp8(v[j].x * rinv * gg.x, v[j].y * rinv * gg.y, v[j].z * rinv * gg.z, v[j].w * rinv * gg.w); }
}
template <int NB, class RowPtr, class Epi>
__device__ __forceinline__ void ngemm_tile(const RowPtr& rp, const bf16_t* Bt, int ldb, int b1off, int K, int m0, int n0, int mvalid, const Epi& epi, LAS float* sm) {
    const int t = threadIdx.x, r = t >> 2, kq = (t & 3) * 4, ty = t >> 5, tx = t & 31;
    LAS float* As = sm; LAS float* Bs0 = sm + 16 * 132; LAS float* Bs1 = sm + 32 * 132;
    float acc[NB][8][4];
#pragma unroll
    for (int b = 0; b < NB; ++b)
#pragma unroll
        for (int i = 0; i < 8; ++i)
#pragma unroll
            for (int j = 0; j < 4; ++j) acc[b][i][j] = 0.f;
    const bf16_t* arow = rp(m0 + r) + kq;
    const bf16_t* brow0 = Bt + (size_t)(n0 + r) * ldb + kq;
    const bf16_t* brow1 = Bt + (size_t)(n0 + b1off + r) * ldb + kq;
    for (int k0 = 0; k0 < K; k0 += 16) {
        const v2u av = *(const v2u*)(arow + k0);
        const v2u bv0 = *(const v2u*)(brow0 + k0);
        v2u bv1 = bv0; if (NB == 2) bv1 = *(const v2u*)(brow1 + k0);
        As[(kq + 0) * 132 + r] = lo16(av.x); As[(kq + 1) * 132 + r] = hi16(av.x); As[(kq + 2) * 132 + r] = lo16(av.y); As[(kq + 3) * 132 + r] = hi16(av.y);
        Bs0[(kq + 0) * 132 + r] = lo16(bv0.x); Bs0[(kq + 1) * 132 + r] = hi16(bv0.x); Bs0[(kq + 2) * 132 + r] = lo16(bv0.y); Bs0[(kq + 3) * 132 + r] = hi16(bv0.y);
        if (NB == 2) { Bs1[(kq + 0) * 132 + r] = lo16(bv1.x); Bs1[(kq + 1) * 132 + r] = hi16(bv1.x); Bs1[(kq + 2) * 132 + r] = lo16(bv1.y); Bs1[(kq + 3) * 132 + r] = hi16(bv1.y); }
        __syncthreads();
#pragma unroll 2
        for (int kk = 0; kk < 16; ++kk) {
            const f32x4 a0 = *(const LAS f32x4*)(As + kk * 132 + ty * 8), a1 = *(const LAS f32x4*)(As + kk * 132 + ty * 8 + 4);
            const f32x4 b0 = *(const LAS f32x4*)(Bs0 + kk * 132 + tx * 4);
            const float a[8] = {a0.x, a0.y, a0.z, a0.w, a1.x, a1.y, a1.z, a1.w};
#pragma unroll
            for (int i = 0; i < 8; ++i) { acc[0][i][0] += a[i] * b0.x; acc[0][i][1] += a[i] * b0.y; acc[0][i][2] += a[i] * b0.z; acc[0][i][3] += a[i] * b0.w; }
            if (NB == 2) { const f32x4 b1 = *(const LAS f32x4*)(Bs1 + kk * 132 + tx * 4);
#pragma unroll
                for (int i = 0; i < 8; ++i) { acc[NB - 1][i][0] += a[i] * b1.x; acc[NB - 1][i][1] += a[i] * b1.y; acc[NB - 1][i][2] += a[i] * b1.z; acc[NB - 1][i][3] += a[i] * b1.w; } }
        }
        __syncthreads();
    }
#pragma unroll
    for (int i = 0; i < 8; ++i) { const int m = m0 + ty * 8 + i;
        if (m < mvalid) {
#pragma unroll
            for (int j = 0; j < 4; ++j) epi(m, n0 + tx * 4 + j, acc[0][i][j], acc[NB - 1][i][j]); } }
}
struct RowPlain { const bf16_t* A; int lda; __device__ __forceinline__ const bf16_t* operator()(int m) const { return A + (size_t)m * lda; } };

template <class Epi>
__device__ __forceinline__ void ngemm_dense(const bf16_t* A, int lda, const bf16_t* Bt, int ldb, int Mr, int N, int K, const Epi& epi, LAS float* sm) {
    const int nn = N / 128, nunits = (Mr / 128) * nn; RowPlain rp{A, lda};
    for (int u = blockIdx.x; u < nunits; u += gridDim.x) ngemm_tile<1>(rp, Bt, ldb, 0, K, (u / nn) * 128, (u % nn) * 128, Mr, epi, sm);
}

struct EpiStoreBf16 { bf16_t* O; int ldc; __device__ __forceinline__ void operator()(int m, int n, float a, float) const { O[(size_t)m * ldc + n] = (bf16_t)f2bf(a); } };
struct EpiGate1 { const bf16_t* PR; float* T; __device__ __forceinline__ void operator()(int m, int n, float a, float) const { T[(size_t)m * D + n] = bf2f(PR[(size_t)m * NIN + C_GSB + n]) * a; } };
struct EpiGate2 { const bf16_t* PR; const float* T; bf16_t* MIX; __device__ __forceinline__ void operator()(int m, int n, float a, float) const {
    MIX[(size_t)m * D + n] = (bf16_t)f2bf(T[(size_t)m * D + n] + bf2f(PR[(size_t)m * NIN + C_GDF + n]) * a); } };
struct EpiResid { const float* base; float* out; __device__ __forceinline__ void operator()(int m, int n, float a, float) const { out[(size_t)m * D + n] = base[(size_t)m * D + n] + a; } };


namespace pg8 {
constexpr int BM = 256, BK = 64, HALF = 128, HTB = HALF * BK * 2, STAGE_BYTES = 8 * HTB;
__host__ __device__ __forceinline__ int lds_byte(int r, int c) { const int st = (r >> 4) * 2 + (c >> 5), rr = r & 15, cc = c & 31, ob = rr * 64 + cc * 2; return st * 1024 + (ob ^ (((ob >> 9) & 1) << 5)); }
__host__ __device__ __forceinline__ void stage_rc(int b, int& R, int& C) { const int st = b / 1024, sb = b % 1024, swz = sb ^ (((sb >> 9) & 1) << 5); R = (st >> 1) * 16 + swz / 64; C = (st & 1) * 32 + (swz % 64) / 2; }
__host__ __device__ __forceinline__ int perm32(int rho) { const int n = rho >> 4, i = rho & 15; return 8 * (i >> 2) + 4 * n + (i & 3); }
struct Unit { int pm, pn, e; };
struct Gemm { const bf16_t* A; const bf16_t* Bt; int lda, ldb, K; };
typedef float f32x2 __attribute__((ext_vector_type(2))); typedef __bf16 bf16x2_t __attribute__((ext_vector_type(2)));
__device__ __forceinline__ unsigned cvt_pk_bf16(float lo, float hi) { f32x2 v = {lo, hi}; bf16x2_t b = __builtin_convertvector(v, bf16x2_t); return __builtin_bit_cast(unsigned, b); }

typedef int v8i __attribute__((ext_vector_type(8))); typedef int v4i __attribute__((ext_vector_type(4)));
__device__ __forceinline__ v8i cat8(bf16x8 a, bf16x8 b) { return __builtin_shufflevector(__builtin_bit_cast(v4i, a), __builtin_bit_cast(v4i, b), 0, 1, 2, 3, 4, 5, 6, 7); }
template <class Epi, class Sched, bool GATHER, bool FP8 = false>
__device__ __forceinline__ void gemm_phase(LAS unsigned char* lds, const Gemm g, const Sched& S, const Epi& E) {
    const int tid = threadIdx.x, wid = __builtin_amdgcn_readfirstlane(tid >> 6), lane = tid & 63, wr = wid >> 2, wc = wid & 3, fr = lane & 15, fq = lane >> 4;
    const int K = g.K, nt = K / BK;
    unsigned voffB[2], cva[2][2], nva[2][2];
#pragma unroll
    for (int i = 0; i < 2; ++i) { int R, C; stage_rc(tid * 16 + i * 8192, R, C); const int Rb = (R & ~31) + perm32(R & 31);
        voffB[i] = (unsigned)(Rb * g.ldb + C) * 2u;
#pragma unroll
        for (int h = 0; h < 2; ++h) { cva[h][i] = (unsigned)((h * HALF + R) * g.lda + C) * 2u; nva[h][i] = cva[h][i]; } }
    const unsigned kstep = (unsigned)(BK * 2);
    const unsigned hstepB = (unsigned)(HALF * g.ldb * 2);
    auto uni_ptr = [](const void* p_) { const unsigned long long v_ = (unsigned long long)p_; return (void*)(((unsigned long long)(unsigned)__builtin_amdgcn_readfirstlane((int)(v_ >> 32)) << 32) | (unsigned)__builtin_amdgcn_readfirstlane((int)v_)); };
    const auto rA = __builtin_amdgcn_make_buffer_rsrc(uni_ptr(g.A), 0, 0x7fffffff, 0x00020000), rB = __builtin_amdgcn_make_buffer_rsrc(uni_ptr(g.Bt), 0, 0x7fffffff, 0x00020000);
    const unsigned ldsw = (unsigned)wid * 1024u;
    const int aoff = lds_byte(wr * 64 + fr, fq * 8), boff = lds_byte(wc * 32 + fr, fq * 8);
#define PG8_SA(b, h) (((b) * 2 + (h)) * HTB)
#define PG8_SB(b, h) ((4 + (b) * 2 + (h)) * HTB)
#define PG8_STAGE(bufoff, rs, soff, voff) do { _Pragma("unroll") for (int _i = 0; _i < 2; ++_i) \
        __builtin_amdgcn_raw_ptr_buffer_load_lds(rs, (LAS unsigned*)(lds + (bufoff) + ldsw + _i * 8192), 16, (int)(voff)[_i], (int)(soff), 0, 0); } while (0)
#define PG8_LDA(dst, b, h) do { _Pragma("unroll") for (int m = 0; m < 4; ++m) _Pragma("unroll") for (int k = 0; k < 2; ++k) dst[m][k] = *(const LAS bf16x8*)(lds + PG8_SA(b, h) + aoff + m * 2048 + k * 1024); } while (0)
#define PG8_LDB(dst, b, h) do { _Pragma("unroll") for (int n = 0; n < 2; ++n) _Pragma("unroll") for (int k = 0; k < 2; ++k) dst[n][k] = *(const LAS bf16x8*)(lds + PG8_SB(b, h) + boff + n * 2048 + k * 1024); } while (0)
#define PG8_MMA(ai, bj, At, Bt) do { __builtin_amdgcn_s_setprio(1); _Pragma("unroll") for (int m = 0; m < 4; ++m) _Pragma("unroll") for (int n = 0; n < 2; ++n) { \
        if constexpr (FP8) { const v8i b8_ = cat8(Bt[n][0], Bt[n][1]), a8_ = cat8(At[m][0], At[m][1]); \
            asm volatile("s_nop 1\n\tv_mfma_scale_f32_16x16x128_f8f6f4 %0, %1, %2, %0, %3, %3 op_sel_hi:[0,0,0]" : "+v"(acc[ai][bj][m][n]) : "v"(b8_), "v"(a8_), "v"(one_scale)); } \
        else { _Pragma("unroll") for (int k = 0; k < 2; ++k) acc[ai][bj][m][n] = __builtin_amdgcn_mfma_f32_16x16x32_bf16(Bt[n][k], At[m][k], acc[ai][bj][m][n], 0, 0, 0); } } __builtin_amdgcn_s_setprio(0); } while (0)
#define PG8_WAIT_V(n) asm volatile("s_waitcnt vmcnt(" #n ")" ::: "memory")
#define PG8_WAIT_L(n) asm volatile("s_waitcnt lgkmcnt(" #n ")" ::: "memory")
#define PG8_BAR __builtin_amdgcn_s_barrier()
#define PG8_SCHED __builtin_amdgcn_sched_barrier(0)
    Unit cur, nxt; int ui = 0;
    if (!S.next(0, cur)) return;
    if constexpr (GATHER) {
#pragma unroll
        for (int i = 0; i < 2; ++i) { int R, C; stage_rc(tid * 16 + i * 8192, R, C);
#pragma unroll
            for (int h = 0; h < 2; ++h) cva[h][i] = (unsigned)(S.tok(cur, h * HALF + R) * g.lda + C) * 2u; }
    }
    const int one_scale = 0x7f7f7f7f;
    (void)one_scale;
    f32x4 acc[2][2][4][2];
#pragma unroll
    for (int a = 0; a < 2; ++a)
#pragma unroll
        for (int b = 0; b < 2; ++b)
#pragma unroll
            for (int m = 0; m < 4; ++m)
#pragma unroll
                for (int n = 0; n < 2; ++n) acc[a][b][m][n] = (f32x4){0.f, 0.f, 0.f, 0.f};
    bf16x8 At[4][2], B0[2][2], B1[2][2];
    unsigned cA = GATHER ? 0u : (unsigned)S.a_off(cur), cB = (unsigned)S.b_off(cur);
    PG8_STAGE(PG8_SB(0, 0), rB, cB, voffB); PG8_STAGE(PG8_SB(0, 1), rB, cB + hstepB, voffB); PG8_STAGE(PG8_SA(0, 0), rA, cA, cva[0]); PG8_STAGE(PG8_SA(0, 1), rA, cA, cva[1]);
    if (wr == 1) PG8_BAR;
    PG8_WAIT_V(2); PG8_BAR;
    PG8_STAGE(PG8_SB(1, 0), rB, cB + kstep, voffB); PG8_STAGE(PG8_SA(1, 0), rA, cA + kstep, cva[0]); PG8_STAGE(PG8_SB(1, 1), rB, cB + hstepB + kstep, voffB);
    PG8_WAIT_V(6); PG8_BAR;
    for (;;) {
        const bool has_next = S.next(ui + 1, nxt);
        const unsigned nA = (has_next && !GATHER) ? (unsigned)S.a_off(nxt) : cA, nB = has_next ? (unsigned)S.b_off(nxt) : cB;
        if constexpr (GATHER) {
#pragma unroll
            for (int i = 0; i < 2; ++i) { int R, C; stage_rc(tid * 16 + i * 8192, R, C);
#pragma unroll
                for (int h = 0; h < 2; ++h) nva[h][i] = has_next ? (unsigned)(S.tok(nxt, h * HALF + R) * g.lda + C) * 2u : cva[h][i]; }
        }
#pragma nounroll
        for (int t = 0; t < nt; t += 2) {
            const bool last = (t == nt - 2);
            const unsigned a1 = cA + (unsigned)(t + 1) * kstep;
            const unsigned a2 = last ? nA : cA + (unsigned)(t + 2) * kstep, b2 = last ? nB : cB + (unsigned)(t + 2) * kstep;
            const unsigned a3 = a2 + kstep, b3 = b2 + kstep;
            PG8_LDB(B0, 0, 0); PG8_LDB(B1, 0, 1); PG8_SCHED; PG8_LDA(At, 0, 0); PG8_STAGE(PG8_SA(1, 1), rA, a1, cva[1]);
            if constexpr (GATHER) { if (last) {
#pragma unroll
                for (int h = 0; h < 2; ++h)
#pragma unroll
                    for (int i = 0; i < 2; ++i) cva[h][i] = nva[h][i]; } }
            PG8_WAIT_V(8); PG8_WAIT_L(0); PG8_BAR; PG8_MMA(0, 0, At, B0); PG8_MMA(0, 1, At, B1); PG8_BAR; PG8_SCHED;
            PG8_LDA(At, 0, 1); PG8_STAGE(PG8_SB(0, 0), rB, b2, voffB); PG8_STAGE(PG8_SB(0, 1), rB, b2 + hstepB, voffB); PG8_STAGE(PG8_SA(0, 0), rA, a2, cva[0]);
            PG8_WAIT_V(8); PG8_WAIT_L(0); PG8_BAR; PG8_MMA(1, 0, At, B0); PG8_MMA(1, 1, At, B1); PG8_BAR; PG8_SCHED;
            PG8_LDB(B0, 1, 0); PG8_LDB(B1, 1, 1); PG8_SCHED; PG8_LDA(At, 1, 0); PG8_STAGE(PG8_SA(0, 1), rA, a2, cva[1]);
            PG8_WAIT_V(8); PG8_WAIT_L(0); PG8_BAR; PG8_MMA(0, 0, At, B0); PG8_MMA(0, 1, At, B1); PG8_BAR; PG8_SCHED;
            PG8_LDA(At, 1, 1); PG8_STAGE(PG8_SB(1, 0), rB, b3, voffB); PG8_STAGE(PG8_SB(1, 1), rB, b3 + hstepB, voffB); PG8_STAGE(PG8_SA(1, 0), rA, a3, cva[0]);
            PG8_WAIT_V(8); PG8_WAIT_L(0); PG8_BAR; PG8_MMA(1, 0, At, B0); PG8_MMA(1, 1, At, B1); PG8_BAR; PG8_SCHED;
        }
        if (wr == 0) PG8_BAR;
        if constexpr (FP8) asm volatile("s_nop 15\n\ts_nop 7" ::: "memory");
        E(acc, cur, wr, wc, fr, fq);
        if (!has_next) break;
#pragma unroll
        for (int a = 0; a < 2; ++a)
#pragma unroll
            for (int b = 0; b < 2; ++b)
#pragma unroll
                for (int m = 0; m < 4; ++m)
#pragma unroll
                    for (int n = 0; n < 2; ++n) acc[a][b][m][n] = (f32x4){0.f, 0.f, 0.f, 0.f};
        cur = nxt; cA = nA; cB = nB; ++ui;
        if constexpr (GATHER) {
#pragma unroll
            for (int i = 0; i < 2; ++i)
#pragma unroll
                for (int h = 0; h < 2; ++h) cva[h][i] = nva[h][i];
        }
        if (wr == 1) PG8_BAR;
    }
    PG8_WAIT_V(0);
    PG8_BAR;
#undef PG8_SA
#undef PG8_SB
#undef PG8_STAGE
#undef PG8_LDA
#undef PG8_LDB
#undef PG8_MMA
#undef PG8_WAIT_V
#undef PG8_WAIT_L
#undef PG8_BAR
#undef PG8_SCHED
}

struct DenseOrder {
    int nM, nN, nwg, G, c, lda, ldb, i0 = 0, i1 = 1 << 30;
    __device__ __forceinline__ void init(int M_, int N_, int G_, int c_, int lda_, int ldb_) { nM = M_ / BM; nN = N_ / BM; nwg = nM * nN; G = G_; c = c_; lda = lda_; ldb = ldb_; }
    __device__ __forceinline__ bool next(int i, Unit& u) const {
        if (i + i0 >= i1) return false;
        const long L = (long)(i + i0) * G + c; if (L >= nwg) return false;
        int wgid = (int)L; { const int q = nwg / 8, r = nwg % 8, xcd = wgid % 8, off = wgid / 8; wgid = (xcd < r ? xcd * (q + 1) : r * (q + 1) + (xcd - r) * q) + off; }
        const int nig = 8 * nN, gid = wgid / nig, fm = gid * 8, gsz = (nM - fm) < 8 ? (nM - fm) : 8;
        u.pm = fm + ((wgid % nig) % gsz); u.pn = (wgid % nig) / gsz; u.e = 0; return true;
    }
    __device__ __forceinline__ size_t a_off(const Unit& u) const { return (size_t)u.pm * BM * lda * 2; }
    __device__ __forceinline__ size_t b_off(const Unit& u) const { return (size_t)u.pn * BM * ldb * 2; }
    __device__ __forceinline__ int tok(const Unit&, int) const { return 0; }
};
struct TwoRoundOrder {
    int G, c, lda, ldb;
    __device__ __forceinline__ bool next(int i, Unit& u) const { const int L = i * G + c; if (L >= 512) return false; const int tile = L & 255; u.pm = tile >> 2; u.pn = tile & 3; u.e = L >> 8; return true; }
    __device__ __forceinline__ size_t a_off(const Unit& u) const { return (size_t)u.pm * BM * lda * 2 + (size_t)u.e * 1024; }
    __device__ __forceinline__ size_t b_off(const Unit& u) const { return (size_t)(u.e * 1024 + u.pn * BM) * ldb * 2; }
    __device__ __forceinline__ int tok(const Unit&, int) const { return 0; }
};
struct MoeOrder {
    const LAS int* tb; const int* tlist; int G, c, npn, lda, ldb, nexp;
    __device__ __forceinline__ bool next(int i, Unit& u) const {
        const int L = i * G + c; if (L >= tb[96]) return false;
        int e = 0; while (tb[65 + e] <= L) ++e;
        const int loc = L - tb[64 + e]; u.e = __builtin_amdgcn_readfirstlane(e); u.pn = __builtin_amdgcn_readfirstlane(loc % npn); u.pm = __builtin_amdgcn_readfirstlane((tb[e] >> 8) + loc / npn); return true;
    }
    __device__ __forceinline__ size_t a_off(const Unit& u) const { return (size_t)u.pm * BM * lda * 2; }
    __device__ __forceinline__ size_t b_off(const Unit& u) const { return (size_t)(u.e * nexp + u.pn * BM) * ldb * 2; }
    __device__ __forceinline__ int tok(const Unit& u, int row) const { const int r = u.pm * BM - tb[u.e] + row; return r < tb[32 + u.e] ? tlist[u.e * LISTCAP + r] : 0; }
};

#define EPI_ARGS const f32x4 (&acc)[2][2][4][2], const Unit& u, int wr, int wc, int fr, int fq
#define EPI_FOR_ROWS for (int ai = 0; ai < 2; ++ai) _Pragma("unroll") for (int m = 0; m < 4; ++m)
__device__ __forceinline__ v4u pack8(const f32x4 a, const f32x4 b) { v4u w; w.x = cvt_pk_bf16(a[0], a[1]); w.y = cvt_pk_bf16(a[2], a[3]); w.z = cvt_pk_bf16(b[0], b[1]); w.w = cvt_pk_bf16(b[2], b[3]); return w; }
__device__ __forceinline__ void unpack8(const v4u w, f32x4& a, f32x4& b) { a = (f32x4){lo16(w.x), hi16(w.x), lo16(w.y), hi16(w.y)}; b = (f32x4){lo16(w.z), hi16(w.z), lo16(w.w), hi16(w.w)}; }
__device__ __forceinline__ float sigm(float v) { return __builtin_amdgcn_rcpf(1.f + __expf(-v)); }

__device__ __forceinline__ void store_tile_T(const f32x4 (&acc)[2][2][4][2], bf16_t* VT, int vrow0, int s0, int pitch) {
#pragma unroll
    for (int bj = 0; bj < 2; ++bj)
#pragma unroll
        for (int n = 0; n < 2; ++n)
#pragma unroll
            for (int e = 0; e < 4; ++e) { bf16_t* vp = VT + (size_t)(vrow0 + 128 * bj + 4 * n + e) * pitch + s0;
#pragma unroll
                for (int ai = 0; ai < 2; ++ai)
#pragma unroll
                    for (int m = 0; m < 4; ++m) vp[128 * ai + 16 * m] = (bf16_t)(cvt_pk_bf16(acc[ai][bj][m][n][e], 0.f) & 0xffffu); }
}
struct EpiKV { bf16_t* KVM; bf16_t* VTM;
    __device__ __forceinline__ void operator()(EPI_ARGS) const {
        const int row0 = u.pm * BM + wr * 64 + fr, col0 = u.pn * BM + wc * 32 + 8 * fq;
#pragma unroll
        EPI_FOR_ROWS { bf16_t* rowp = KVM + (size_t)(row0 + ai * HALF + m * 16) * 2048 + col0;
#pragma unroll
            for (int bj = 0; bj < 2; ++bj) *(v4u*)(rowp + bj * HALF) = pack8(acc[ai][bj][m][0], acc[ai][bj][m][1]); }
        if (u.pn >= 4) store_tile_T(acc, VTM, u.pm * 1024 + (u.pn - 4) * BM + wc * 32 + 8 * fq, wr * 64 + fr, MEMLEN);
    } };
struct EpiBf16Store { bf16_t* O; int ldc;
    __device__ __forceinline__ void operator()(EPI_ARGS) const {
        const int row0 = u.pm * BM + wr * 64 + fr, col0 = u.pn * BM + wc * 32 + 8 * fq;
#pragma unroll
        EPI_FOR_ROWS { bf16_t* rowp = O + (size_t)(row0 + ai * HALF + m * 16) * ldc + col0;
#pragma unroll
            for (int bj = 0; bj < 2; ++bj) *(v4u*)(rowp + bj * HALF) = pack8(acc[ai][bj][m][0], acc[ai][bj][m][1]); }
    } };
struct EpiResidF32 { const float* base; float* out;
    __device__ __forceinline__ void operator()(EPI_ARGS) const {
        const int row0 = u.pm * BM + wr * 64 + fr, col0 = u.pn * BM + wc * 32 + 8 * fq;
#pragma unroll
        EPI_FOR_ROWS { const size_t off = (size_t)(row0 + ai * HALF + m * 16) * D + col0;
#pragma unroll
            for (int bj = 0; bj < 2; ++bj)
#pragma unroll
                for (int n = 0; n < 2; ++n) { const f32x4 b = *(const f32x4*)(base + off + bj * HALF + 4 * n); *(f32x4*)(out + off + bj * HALF + 4 * n) = b + acc[ai][bj][m][n]; } }
    } };
struct EpiResidNorm { const float* base; float* out; bf16_t* XB; float* SSQ;
    __device__ __forceinline__ void operator()(EPI_ARGS) const {
        const int row0 = u.pm * BM + wr * 64 + fr, col0 = u.pn * BM + wc * 32 + 8 * fq;
#pragma unroll
        EPI_FOR_ROWS { const int row = row0 + ai * HALF + m * 16; const size_t off = (size_t)row * D + col0; float ss = 0.f;
#pragma unroll
            for (int bj = 0; bj < 2; ++bj) { f32x4 v[2];
#pragma unroll
                for (int n = 0; n < 2; ++n) { v[n] = *(const f32x4*)(base + off + bj * HALF + 4 * n) + acc[ai][bj][m][n]; *(f32x4*)(out + off + bj * HALF + 4 * n) = v[n];
                    ss += (v[n][0] * v[n][0] + v[n][1] * v[n][1]) + (v[n][2] * v[n][2] + v[n][3] * v[n][3]); }
                *(v4u*)(XB + off + bj * HALF) = pack8(v[0], v[1]); }
            ss += __shfl_xor(ss, 16); ss += __shfl_xor(ss, 32);
            if (fq == 0) SSQ[(size_t)row * 16 + u.pn * 4 + wc] = ss; }
    } };
struct EpiBf16Rinv { bf16_t* O; const float* SSQ; float qscale;
    __device__ __forceinline__ void operator()(EPI_ARGS) const {
        const int row0 = u.pm * BM + wr * 64 + fr, col0 = u.pn * BM + wc * 32 + 8 * fq;
#pragma unroll
        EPI_FOR_ROWS { const int row = row0 + ai * HALF + m * 16; const f32x4* sp = (const f32x4*)(SSQ + (size_t)row * 16);
            const f32x4 s0 = sp[0], s1 = sp[1], s2 = sp[2], s3 = sp[3];
            const float tot = (((s0[0] + s0[1]) + (s0[2] + s0[3])) + ((s1[0] + s1[1]) + (s1[2] + s1[3]))) + (((s2[0] + s2[1]) + (s2[2] + s2[3])) + ((s3[0] + s3[1]) + (s3[2] + s3[3])));
            const float rinv = qscale / sqrtf(tot * (1.f / 1024.f) + NORM_EPS);
            bf16_t* rowp = O + (size_t)row * D + col0;
#pragma unroll
            for (int bj = 0; bj < 2; ++bj) *(v4u*)(rowp + bj * HALF) = pack8(acc[ai][bj][m][0] * rinv, acc[ai][bj][m][1] * rinv); }
    } };
struct OneUnitOrder {
    int idx, lda, ldb;
    __device__ __forceinline__ bool next(int i, Unit& u) const { if (i > 0) return false; u.pm = idx >> 3; u.pn = idx & 7; u.e = 0; return true; }
    __device__ __forceinline__ size_t a_off(const Unit& u) const { return (size_t)u.pm * BM * lda * 2; }
    __device__ __forceinline__ size_t b_off(const Unit& u) const { return (size_t)u.pn * BM * ldb * 2; }
    __device__ __forceinline__ int tok(const Unit&, int) const { return 0; }
};
struct EpiGate { const bf16_t* PR; float* T; bf16_t* MIX;
    __device__ __forceinline__ void operator()(EPI_ARGS) const {
        const int row0 = u.pm * BM + wr * 64 + fr, col0 = u.pn * BM + wc * 32 + 8 * fq;
#pragma unroll
        EPI_FOR_ROWS { const int row = row0 + ai * HALF + m * 16;
#pragma unroll
            for (int bj = 0; bj < 2; ++bj) { const int col = col0 + bj * HALF; f32x4 g0, g1;
                unpack8(*(const v4u*)(PR + (size_t)row * NIN + (u.e ? C_GDF : C_GSB) + col), g0, g1);
                float* tp = T + (size_t)row * D + col;
                if (u.e == 0) { *(f32x4*)tp = g0 * acc[ai][bj][m][0]; *(f32x4*)(tp + 4) = g1 * acc[ai][bj][m][1]; }
                else { const f32x4 t0 = *(const f32x4*)tp, t1 = *(const f32x4*)(tp + 4); *(v4u*)(MIX + (size_t)row * D + col) = pack8(t0 + g0 * acc[ai][bj][m][0], t1 + g1 * acc[ai][bj][m][1]); } } }
    } };
struct EpiInProj { bf16_t* PR; const float* rc; const float* rs; bf16_t* VTSB; bf16_t* VTDF;
    __device__ __forceinline__ void operator()(EPI_ARGS) const {
        const int row0 = u.pm * BM + wr * 64 + fr, pn = u.pn;
        if (pn >= 6 && pn < 10) {
            const float sc = pn < 8 ? 0.125f * 1.4426950408889634f : 1.0f; const int i0 = 16 * (wc & 1) + 4 * fq;
#pragma unroll
            EPI_FOR_ROWS { const int row = row0 + ai * HALF + m * 16; const f32x4 cs = *(const f32x4*)(rc + (size_t)row * 32 + i0), sn = *(const f32x4*)(rs + (size_t)row * 32 + i0);
#pragma unroll
                for (int bj = 0; bj < 2; ++bj) { const f32x4 lo = acc[ai][bj][m][0], hi = acc[ai][bj][m][1];
                    const f32x4 olo = (lo * cs - hi * sn) * sc, ohi = (hi * cs + lo * sn) * sc;
                    bf16_t* p = PR + (size_t)row * NIN + pn * BM + 64 * (2 * bj + (wc >> 1)) + i0;
                    v2u a, b; a.x = cvt_pk_bf16(olo[0], olo[1]); a.y = cvt_pk_bf16(olo[2], olo[3]); b.x = cvt_pk_bf16(ohi[0], ohi[1]); b.y = cvt_pk_bf16(ohi[2], ohi[3]);
                    *(v2u*)p = a; *(v2u*)(p + 32) = b; } }
        } else {
            const int col0 = pn * BM + wc * 32 + 8 * fq; const float sc = pn < 2 ? 0.125f * 1.4426950408889634f : 1.0f; const bool sg = pn >= 12;
#pragma unroll
            EPI_FOR_ROWS { bf16_t* rowp = PR + (size_t)(row0 + ai * HALF + m * 16) * NIN + col0;
#pragma unroll
                for (int bj = 0; bj < 2; ++bj) { f32x4 v0 = acc[ai][bj][m][0] * sc, v1 = acc[ai][bj][m][1] * sc;
                    if (sg) { v0 = (f32x4){sigm(v0[0]), sigm(v0[1]), sigm(v0[2]), sigm(v0[3])}; v1 = (f32x4){sigm(v1[0]), sigm(v1[1]), sigm(v1[2]), sigm(v1[3])}; }
                    *(v4u*)(rowp + bj * HALF) = pack8(v0, v1); } }
            if (pn == 4 || pn == 5 || pn == 10 || pn == 11) {
                const int bb = u.pm >> 4, s0 = (u.pm & 15) * BM + wr * 64 + fr, hd0 = (pn < 6 ? (pn - 4) : (pn - 10)) * BM + wc * 32 + 8 * fq;
                store_tile_T(acc, pn < 6 ? VTSB : VTDF, bb * 512 + hd0, s0, SEQ);
            }
        }
    } };
struct EpiMoeGU { unsigned char* ACT8; const float* bgu; const float* wsc;
    __device__ __forceinline__ void operator()(EPI_ARGS) const {
        const int row0 = u.pm * BM + wr * 64 + fr, j0 = u.pn * 128 + wc * 32 + 8 * fq; const float* bg = bgu + (size_t)u.e * 2048 + j0; const float* sg = wsc + (size_t)u.e * 2048 + j0;
#pragma unroll
        EPI_FOR_ROWS { f32x4 o[2];
#pragma unroll
            for (int n = 0; n < 2; ++n) { const f32x4 gv = acc[ai][0][m][n] * *(const f32x4*)(sg + 4 * n) + *(const f32x4*)(bg + 4 * n), lv = acc[ai][1][m][n] * *(const f32x4*)(sg + 1024 + 4 * n) + *(const f32x4*)(bg + 1024 + 4 * n);
#pragma unroll
                for (int c = 0; c < 4; ++c) { const float gl = fminf(gv[c], 7.0f), li = fminf(fmaxf(lv[c], -7.0f), 7.0f); o[n][c] = gl * sigm(1.702f * gl) * (li + 1.0f); } }
            v2u w; w.x = pk4_fp8(o[0][0], o[0][1], o[0][2], o[0][3]); w.y = pk4_fp8(o[1][0], o[1][1], o[1][2], o[1][3]);
            *(v2u*)(ACT8 + (size_t)(row0 + ai * HALF + m * 16) * DFF + j0) = w; }
    } };
struct EpiMoeDown { bf16_t* YB; const float* bd; const float* glist; const LAS int* tb; const float* wsc;
    __device__ __forceinline__ void operator()(EPI_ARGS) const {
        const int row0 = u.pm * BM + wr * 64 + fr, col0 = u.pn * BM + wc * 32 + 8 * fq; const float* bp = bd + (size_t)u.e * D + col0; const float* sp = wsc + (size_t)u.e * D + col0;
        const float* gl = glist + (size_t)u.e * LISTCAP - tb[u.e];
        f32x4 bv[2][2], sv[2][2];
#pragma unroll
        for (int bj = 0; bj < 2; ++bj)
#pragma unroll
            for (int n = 0; n < 2; ++n) { bv[bj][n] = *(const f32x4*)(bp + bj * HALF + 4 * n); sv[bj][n] = *(const f32x4*)(sp + bj * HALF + 4 * n); }
#pragma unroll
        EPI_FOR_ROWS { const int row = row0 + ai * HALF + m * 16; const float gt = gl[row];
#pragma unroll
            for (int bj = 0; bj < 2; ++bj) *(v4u*)(YB + (size_t)row * D + col0 + bj * HALF) = pack8((acc[ai][bj][m][0] * sv[bj][0] + bv[bj][0]) * gt, (acc[ai][bj][m][1] * sv[bj][1] + bv[bj][1]) * gt); }
    } };
}


typedef float f32x16 __attribute__((ext_vector_type(16)));
typedef short s16x4 __attribute__((ext_vector_type(4)));
__device__ __forceinline__ f32x16 mfma32(bf16x8 a, bf16x8 b, f32x16 c) { return __builtin_amdgcn_mfma_f32_32x32x16_bf16(a, b, c, 0, 0, 0); }
__device__ __forceinline__ float xhalf(float v, int hh) { auto rr = __builtin_amdgcn_permlane32_swap(__float_as_uint(v), __float_as_uint(v), false, false); return __uint_as_float(hh ? rr[0] : rr[1]); }
__device__ __forceinline__ bf16x8 vt_frag(const bf16_t* p) { const s16x4 lo = *(const s16x4*)p, hi = *(const s16x4*)(p + 8); return (bf16x8){lo[0], lo[1], lo[2], lo[3], hi[0], hi[1], hi[2], hi[3]}; }
__device__ __forceinline__ bf16x8 pack_p(const f32x16& p, int s) { v4u w; w.x = pg8::cvt_pk_bf16(p[8 * s + 0], p[8 * s + 1]); w.y = pg8::cvt_pk_bf16(p[8 * s + 2], p[8 * s + 3]); w.z = pg8::cvt_pk_bf16(p[8 * s + 4], p[8 * s + 5]); w.w = pg8::cvt_pk_bf16(p[8 * s + 6], p[8 * s + 7]); return __builtin_bit_cast(bf16x8, w); }
constexpr float LOG2E = 1.4426950408889634f;

template <int NO>
__device__ __forceinline__ void softmax_step(f32x16& S, float C, float& m, float& l, f32x16 (&O)[NO], int hh) {
    float mx = fmaxf(fmaxf(S[0], S[1]), fmaxf(S[2], S[3]));
#pragma unroll
    for (int i = 4; i < 16; i += 4) mx = fmaxf(mx, fmaxf(fmaxf(S[i], S[i + 1]), fmaxf(S[i + 2], S[i + 3])));
    mx = fmaxf(mx, xhalf(mx, hh)) * C;
    const float mn = fmaxf(m, mx), al = __builtin_amdgcn_exp2f(m - mn);
    m = mn; l *= al;
#pragma unroll
    for (int o = 0; o < NO; ++o) O[o] = O[o] * al;
    float ps = 0.f;
#pragma unroll
    for (int i = 0; i < 16; ++i) { S[i] = __builtin_amdgcn_exp2f(S[i] * C - mn); ps += S[i]; }
    l += ps;
}

__device__ __forceinline__ void attn_diff_wave(const bf16_t* PR, const bf16_t* VT, float* ODR, int b, int h, int j, int q0, int lane) {
    const int r32 = lane & 31, hh = lane >> 5;
    const bf16_t* qrow = PR + (size_t)(b * SEQ + q0 + r32) * NIN + C_DQ + h * 128 + j * 64 + 8 * hh;
    bf16x8 qf[4];
#pragma unroll
    for (int d0 = 0; d0 < 4; ++d0) qf[d0] = *(const bf16x8*)(qrow + 16 * d0);
    const bf16_t* kbase = PR + (size_t)(b * SEQ + r32) * NIN + C_DK + h * 128 + j * 64 + 8 * hh;
    const bf16_t* vbase = VT + (size_t)(b * 512 + h * 128 + r32) * SEQ + 4 * hh;
    f32x16 O[4];
#pragma unroll
    for (int o = 0; o < 4; ++o)
#pragma unroll
        for (int i = 0; i < 16; ++i) O[o][i] = 0.f;
    float m = -INFINITY, l = 0.f;
    const int nt = 2 * (q0 / 64 + 1);
    for (int t = 0; t < nt; ++t) {
        const bf16_t* kp = kbase + (size_t)(32 * t) * NIN;
        f32x16 S;
#pragma unroll
        for (int i = 0; i < 16; ++i) S[i] = 0.f;
#pragma unroll
        for (int d0 = 0; d0 < 4; ++d0) S = mfma32(*(const bf16x8*)(kp + 16 * d0), qf[d0], S);
        softmax_step<4>(S, LOG2E, m, l, O, hh);
        const bf16x8 p0 = pack_p(S, 0), p1 = pack_p(S, 1);
        const bf16_t* vp = vbase + 32 * t;
#pragma unroll
        for (int o = 0; o < 4; ++o) { O[o] = mfma32(vt_frag(vp + (size_t)(32 * o) * SEQ), p0, O[o]); O[o] = mfma32(vt_frag(vp + (size_t)(32 * o) * SEQ + 16), p1, O[o]); }
    }
    l += xhalf(l, hh);
    const float il = 1.f / l;
    float* orow = ODR + ((size_t)j * M + (size_t)b * SEQ + q0 + r32) * 512 + h * 128 + 4 * hh;
#pragma unroll
    for (int o = 0; o < 4; ++o)
#pragma unroll
        for (int g = 0; g < 4; ++g) *(f32x4*)(orow + 32 * o + 8 * g) = (f32x4){O[o][4 * g] * il, O[o][4 * g + 1] * il, O[o][4 * g + 2] * il, O[o][4 * g + 3] * il};
}

__device__ __forceinline__ void attn_sb_wave(const bf16_t* PR, const bf16_t* VT, bf16_t* OAT, int b, int h, int q0, int lane) {
    const int r32 = lane & 31, hh = lane >> 5;
    const bf16_t* qrow = PR + (size_t)(b * SEQ + q0 + r32) * NIN + C_SBQ + h * 64 + 8 * hh;
    bf16x8 qf[4];
#pragma unroll
    for (int d0 = 0; d0 < 4; ++d0) qf[d0] = *(const bf16x8*)(qrow + 16 * d0);
    const bf16_t* kbase = PR + (size_t)(b * SEQ + r32) * NIN + C_SBK + h * 64 + 8 * hh;
    const bf16_t* vbase = VT + (size_t)(b * 512 + h * 64 + r32) * SEQ + 4 * hh;
    f32x16 O[2];
#pragma unroll
    for (int o = 0; o < 2; ++o)
#pragma unroll
        for (int i = 0; i < 16; ++i) O[o][i] = 0.f;
    float R = 0.f;
    const int td = q0 >> 5;
    for (int t = td; t >= 0; --t) {
        const bf16_t* kp = kbase + (size_t)(32 * t) * NIN;
        f32x16 S;
#pragma unroll
        for (int i = 0; i < 16; ++i) S[i] = 0.f;
#pragma unroll
        for (int d0 = 0; d0 < 4; ++d0) S = mfma32(*(const bf16x8*)(kp + 16 * d0), qf[d0], S);
        f32x16 lr;
#pragma unroll
        for (int i = 0; i < 16; ++i) { const float z2 = S[i] * LOG2E; const float sp = fmaxf(z2, 0.f) + __builtin_amdgcn_logf(1.f + __builtin_amdgcn_exp2f(-fabsf(z2)));
            lr[i] = -sp; S[i] = z2 - sp; }
        if (t == td) {
#pragma unroll
            for (int i = 0; i < 16; ++i) { const int kvl = (i & 3) + 8 * (i >> 2) + 4 * hh; if (kvl >= r32) { lr[i] = 0.f; S[i] = -INFINITY; } }
        }
        float tot[4], pt[4], off[4];
        f32x16 ex;
#pragma unroll
        for (int g = 0; g < 4; ++g) { ex[4 * g + 3] = 0.f; ex[4 * g + 2] = lr[4 * g + 3]; ex[4 * g + 1] = lr[4 * g + 3] + lr[4 * g + 2]; ex[4 * g] = ex[4 * g + 1] + lr[4 * g + 1]; tot[g] = ex[4 * g] + lr[4 * g]; }
#pragma unroll
        for (int g = 0; g < 4; ++g) pt[g] = xhalf(tot[g], hh);
        const float own0 = hh ? 0.f : 1.f;
        float sp_ = 0.f;
#pragma unroll
        for (int g = 3; g >= 0; --g) { off[g] = sp_ + own0 * pt[g] + R; sp_ += tot[g] + pt[g]; }
#pragma unroll
        for (int i = 0; i < 16; ++i) S[i] = __builtin_amdgcn_exp2f(S[i] + ex[i] + off[i >> 2]);
        R += sp_;
        const bf16x8 p0 = pack_p(S, 0), p1 = pack_p(S, 1);
        const bf16_t* vp = vbase + 32 * t;
#pragma unroll
        for (int o = 0; o < 2; ++o) { O[o] = mfma32(vt_frag(vp + (size_t)(32 * o) * SEQ), p0, O[o]); O[o] = mfma32(vt_frag(vp + (size_t)(32 * o) * SEQ + 16), p1, O[o]); }
        if (__all(R < -160.f)) break;
    }
    bf16_t* orow = OAT + (size_t)(b * SEQ + q0 + r32) * D + h * 64 + 4 * hh;
#pragma unroll
    for (int o = 0; o < 2; ++o)
#pragma unroll
        for (int g = 0; g < 4; ++g) { v2u w; w.x = pg8::cvt_pk_bf16(O[o][4 * g], O[o][4 * g + 1]); w.y = pg8::cvt_pk_bf16(O[o][4 * g + 2], O[o][4 * g + 3]); *(v2u*)(orow + 32 * o + 8 * g) = w; }
}

__device__ __forceinline__ void attn_mem_wave(const bf16_t* QM, const bf16_t* KVM, const bf16_t* VT, bf16_t* OM, int b, int h, int q0, int lane) {
    const int r32 = lane & 31, hh = lane >> 5;
    const bf16_t* qrow = QM + (size_t)(b * SEQ + q0 + r32) * D + h * 256 + 8 * hh;
    const bf16_t* kbase = KVM + (size_t)(b * MEMLEN + r32) * 2048 + h * 256 + 8 * hh;
    for (int dh = 0; dh < 2; ++dh) {
        const bf16_t* vbase = VT + (size_t)(b * 1024 + h * 256 + dh * 128 + r32) * MEMLEN + 4 * hh;
        f32x16 O[4];
#pragma unroll
        for (int o = 0; o < 4; ++o)
#pragma unroll
            for (int i = 0; i < 16; ++i) O[o][i] = 0.f;
        float m = -INFINITY, l = 0.f;
        for (int t = 0; t < 8; ++t) {
            const bf16_t* kp = kbase + (size_t)(32 * t) * 2048;
            f32x16 S;
#pragma unroll
            for (int i = 0; i < 16; ++i) S[i] = 0.f;
#pragma unroll
            for (int d0 = 0; d0 < 16; ++d0) S = mfma32(*(const bf16x8*)(kp + 16 * d0), *(const bf16x8*)(qrow + 16 * d0), S);
            softmax_step<4>(S, LOG2E * 0.0625f, m, l, O, hh);
            const bf16x8 p0 = pack_p(S, 0), p1 = pack_p(S, 1);
            const bf16_t* vp = vbase + 32 * t;
#pragma unroll
            for (int o = 0; o < 4; ++o) { O[o] = mfma32(vt_frag(vp + (size_t)(32 * o) * MEMLEN), p0, O[o]); O[o] = mfma32(vt_frag(vp + (size_t)(32 * o) * MEMLEN + 16), p1, O[o]); }
        }
        l += xhalf(l, hh);
        const float il = 1.f / l;
        bf16_t* orow = OM + (size_t)(b * SEQ + q0 + r32) * D + h * 256 + dh * 128 + 4 * hh;
#pragma unroll
        for (int o = 0; o < 4; ++o)
#pragma unroll
            for (int g = 0; g < 4; ++g) { v2u w; w.x = pg8::cvt_pk_bf16(O[o][4 * g] * il, O[o][4 * g + 1] * il); w.y = pg8::cvt_pk_bf16(O[o][4 * g + 2] * il, O[o][4 * g + 3] * il); *(v2u*)(orow + 32 * o + 8 * g) = w; }
    }
}


constexpr int VSTR = 136;
template <int NCH> __device__ __forceinline__ void stage_load(v4u (&r)[NCH], const bf16_t* g0, int chunks_per_row, size_t gpitch, int tid) {
#pragma unroll
    for (int i = 0; i < NCH; ++i) { const int c = tid + NTHR * i, row = c / chunks_per_row, ch = c % chunks_per_row; r[i] = *(const v4u*)(g0 + (size_t)row * gpitch + ch * 8); }
}
template <int NCH> __device__ __forceinline__ void stage_store_k(const v4u (&r)[NCH], LAS unsigned char* dst, int chunks_per_row, int lstride, int tid) {
#pragma unroll
    for (int i = 0; i < NCH; ++i) { const int c = tid + NTHR * i, row = c / chunks_per_row, ch = c % chunks_per_row; *(LAS v4u*)(dst + row * lstride + ch * 16) = r[i]; }
}
template <int NCH> __device__ __forceinline__ void stage_store_v(const v4u (&r)[NCH], LAS unsigned char* dst, int tid) {
#pragma unroll
    for (int i = 0; i < NCH; ++i) { const int c = tid + NTHR * i, row = c >> 3, ch = c & 7; LAS v2u* d = (LAS v2u*)(dst + row * VSTR + ch * 16); d[0] = (v2u){r[i].x, r[i].y}; d[1] = (v2u){r[i].z, r[i].w}; }
}
__device__ __forceinline__ bf16x8 lds_vfrag(const LAS unsigned char* p) { const v2u lo = *(const LAS v2u*)p, hi = *(const LAS v2u*)(p + 16); return __builtin_bit_cast(bf16x8, (v4u){lo.x, lo.y, hi.x, hi.y}); }

constexpr float SM_THR = 8.0f;
template <int NO>
__device__ __forceinline__ void softmax_def2(f32x16& S0, f32x16& S1, bool first, float& mref, float& l, f32x16 (&O)[NO], int hh) {
    float mx = fmaxf(fmaxf(S0[0], S0[1]), fmaxf(S1[0], S1[1]));
#pragma unroll
    for (int i = 2; i < 16; i += 2) mx = fmaxf(mx, fmaxf(fmaxf(S0[i], S0[i + 1]), fmaxf(S1[i], S1[i + 1])));
    mx = fmaxf(mx, xhalf(mx, hh));
    if (first || __any(mx > SM_THR)) {
        const float dl = first ? mx : fmaxf(mx, 0.f), f = first ? 0.f : __builtin_amdgcn_exp2f(-dl);
        mref += dl; l *= f;
#pragma unroll
        for (int o = 0; o < NO; ++o) O[o] = O[o] * f;
#pragma unroll
        for (int i = 0; i < 16; ++i) { S0[i] -= dl; S1[i] -= dl; }
    }
    float ps = 0.f;
#pragma unroll
    for (int i = 0; i < 16; ++i) { S0[i] = __builtin_amdgcn_exp2f(S0[i]); S1[i] = __builtin_amdgcn_exp2f(S1[i]); ps += S0[i] + S1[i]; }
    l += ps;
}
template <int NO>
__device__ __forceinline__ void softmax_def1(f32x16& S, bool first, float& mref, float& l, f32x16 (&O)[NO], int hh) {
    float mx = fmaxf(fmaxf(S[0], S[1]), fmaxf(S[2], S[3]));
#pragma unroll
    for (int i = 4; i < 16; i += 4) mx = fmaxf(mx, fmaxf(fmaxf(S[i], S[i + 1]), fmaxf(S[i + 2], S[i + 3])));
    mx = fmaxf(mx, xhalf(mx, hh));
    if (first || __any(mx > SM_THR)) {
        const float dl = first ? mx : fmaxf(mx, 0.f), f = first ? 0.f : __builtin_amdgcn_exp2f(-dl);
        mref += dl; l *= f;
#pragma unroll
        for (int o = 0; o < NO; ++o) O[o] = O[o] * f;
#pragma unroll
        for (int i = 0; i < 16; ++i) S[i] -= dl;
    }
    float ps = 0.f;
#pragma unroll
    for (int i = 0; i < 16; ++i) { S[i] = __builtin_amdgcn_exp2f(S[i]); ps += S[i]; }
    l += ps;
}
template <int NO>
__device__ __forceinline__ void softmax_step2(f32x16& S0, f32x16& S1, float C, float& m, float& l, f32x16 (&O)[NO], int hh) {
    float mx = fmaxf(fmaxf(S0[0], S0[1]), fmaxf(S1[0], S1[1]));
#pragma unroll
    for (int i = 2; i < 16; i += 2) mx = fmaxf(mx, fmaxf(fmaxf(S0[i], S0[i + 1]), fmaxf(S1[i], S1[i + 1])));
    mx = fmaxf(mx, xhalf(mx, hh)) * C;
    const float mn = fmaxf(m, mx), al = __builtin_amdgcn_exp2f(m - mn);
    m = mn; l *= al;
#pragma unroll
    for (int o = 0; o < NO; ++o) O[o] = O[o] * al;
    float ps = 0.f;
#pragma unroll
    for (int i = 0; i < 16; ++i) { S0[i] = __builtin_amdgcn_exp2f(S0[i] * C - mn); S1[i] = __builtin_amdgcn_exp2f(S1[i] * C - mn); ps += S0[i] + S1[i]; }
    l += ps;
}

__device__ __forceinline__ void attn_diff_block(const bf16_t* PR, const bf16_t* VT, bf16_t* OAT, const float* subln, float lam, int b, int h, int qb, LAS unsigned char* lds, int tid, int wave, int lane) {
    constexpr int KSTR = 144, KB = 64 * KSTR, BUF = 2 * KB + 128 * VSTR;
    const int r32 = lane & 31, hh = lane >> 5, j = wave >> 2, w4 = wave & 3, q0 = qb * 128 + w4 * 32;
    const bf16_t* qrow = PR + (size_t)(b * SEQ + q0 + r32) * NIN + C_DQ + h * 128 + j * 64 + 8 * hh;
    bf16x8 qf[4];
#pragma unroll
    for (int d0 = 0; d0 < 4; ++d0) qf[d0] = *(const bf16x8*)(qrow + 16 * d0);
    const bf16_t* kg = PR + (size_t)(b * SEQ) * NIN + C_DK + h * 128;
    const bf16_t* vg = VT + (size_t)(b * 512 + h * 128) * SEQ;
    f32x16 O[4];
#pragma unroll
    for (int o = 0; o < 4; ++o)
#pragma unroll
        for (int i = 0; i < 16; ++i) O[o][i] = 0.f;
    float m = 0.f, l = 0.f;
    const int nsteps = 2 * qb + 2, my_last = 2 * qb + (w4 >> 1);
    v4u ra1[1], ra2[1], rav[2], rb1[1], rb2[1], rbv[2];
    auto ld = [&](int t_, v4u (&r1)[1], v4u (&r2)[1], v4u (&rv)[2]) __attribute__((always_inline)) { const bf16_t* kn = kg + (size_t)(64 * t_) * NIN; stage_load<1>(r1, kn, 8, NIN, tid); stage_load<1>(r2, kn + 64, 8, NIN, tid); stage_load<2>(rv, vg + 64 * t_, 8, SEQ, tid); };
    auto st = [&](int t_, const v4u (&r1)[1], const v4u (&r2)[1], const v4u (&rv)[2]) __attribute__((always_inline)) { LAS unsigned char* nb = lds + (t_ & 1) * BUF; stage_store_k<1>(r1, nb, 8, KSTR, tid); stage_store_k<1>(r2, nb + KB, 8, KSTR, tid); stage_store_v<2>(rv, nb + 2 * KB, tid); };
    auto compute = [&](int t) __attribute__((always_inline)) {
        if (t <= my_last) {
            const LAS unsigned char* kb = lds + (t & 1) * BUF + j * KB + r32 * KSTR + 16 * hh; const LAS unsigned char* vb = lds + (t & 1) * BUF + 2 * KB + r32 * VSTR + 8 * hh;
            f32x16 S0, S1;
#pragma unroll
            for (int i = 0; i < 16; ++i) { S0[i] = -m; S1[i] = -m; }
#pragma unroll
            for (int d0 = 0; d0 < 4; ++d0) { S0 = mfma32(*(const LAS bf16x8*)(kb + 32 * d0), qf[d0], S0); S1 = mfma32(*(const LAS bf16x8*)(kb + 32 * KSTR + 32 * d0), qf[d0], S1); }
            softmax_def2<4>(S0, S1, t == 0, m, l, O, hh);
            const bf16x8 p00 = pack_p(S0, 0), p01 = pack_p(S0, 1), p10 = pack_p(S1, 0), p11 = pack_p(S1, 1);
#pragma unroll
            for (int o = 0; o < 4; ++o) { const LAS unsigned char* vp = vb + 32 * o * VSTR;
                O[o] = mfma32(lds_vfrag(vp), p00, O[o]); O[o] = mfma32(lds_vfrag(vp + 32), p01, O[o]); O[o] = mfma32(lds_vfrag(vp + 64), p10, O[o]); O[o] = mfma32(lds_vfrag(vp + 96), p11, O[o]); }
        } };
    ld(0, ra1, ra2, rav); st(0, ra1, ra2, rav);
    if (nsteps > 1) ld(1, rb1, rb2, rbv);
    __syncthreads();
    for (int t = 0; t < nsteps; t += 2) {
        if (t + 2 < nsteps) ld(t + 2, ra1, ra2, rav);
        compute(t);
        st(t + 1, rb1, rb2, rbv);
        __syncthreads();
        if (t + 3 < nsteps) ld(t + 3, rb1, rb2, rbv);
        compute(t + 1);
        if (t + 2 < nsteps) st(t + 2, ra1, ra2, rav);
        __syncthreads();
    }
    l += xhalf(l, hh);
    const float il = 1.f / l;
    LAS float* X = (LAS float*)lds + (size_t)(w4 * 32 + r32) * 132 + 4 * hh;
    if (j == 1) {
#pragma unroll
        for (int o = 0; o < 4; ++o)
#pragma unroll
            for (int g = 0; g < 4; ++g) *(LAS f32x4*)(X + 32 * o + 8 * g) = (f32x4){O[o][4 * g] * il, O[o][4 * g + 1] * il, O[o][4 * g + 2] * il, O[o][4 * g + 3] * il};
    }
    __syncthreads();
    if (j == 0) {
        float ss = 0.f;
#pragma unroll
        for (int o = 0; o < 4; ++o)
#pragma unroll
            for (int g = 0; g < 4; ++g) { const f32x4 o2 = *(const LAS f32x4*)(X + 32 * o + 8 * g);
#pragma unroll
                for (int c = 0; c < 4; ++c) { const float d = O[o][4 * g + c] * il - lam * o2[c]; O[o][4 * g + c] = d; ss += d * d; } }
        ss += xhalf(ss, hh);
        const float rinv = 0.8f / sqrtf(ss * (1.f / 128.f) + NORM_EPS);
        bf16_t* orow = OAT + (size_t)(b * SEQ + q0 + r32) * D + 512 + h * 128 + 4 * hh; const float* sl = subln + 4 * hh;
#pragma unroll
        for (int o = 0; o < 4; ++o)
#pragma unroll
            for (int g = 0; g < 4; ++g) { const f32x4 sg_ = *(const f32x4*)(sl + 32 * o + 8 * g); v2u w;
                w.x = pg8::cvt_pk_bf16(O[o][4 * g] * rinv * sg_[0], O[o][4 * g + 1] * rinv * sg_[1]); w.y = pg8::cvt_pk_bf16(O[o][4 * g + 2] * rinv * sg_[2], O[o][4 * g + 3] * rinv * sg_[3]); *(v2u*)(orow + 32 * o + 8 * g) = w; }
    }
    __syncthreads();
}

__device__ __forceinline__ void sb_subtile(f32x16& S, bool diag, float& R, f32x16 (&O)[2], const LAS unsigned char* vp, int r32, int hh) {
    f32x16 lr;
#pragma unroll
    for (int i = 0; i < 16; ++i) { const float z2 = S[i]; const float sp = fmaxf(z2, 0.f) + __builtin_amdgcn_logf(1.f + __builtin_amdgcn_exp2f(-fabsf(z2))); lr[i] = -sp; S[i] = z2 - sp; }
    if (diag) {
#pragma unroll
        for (int i = 0; i < 16; ++i) { const int kvl = (i & 3) + 8 * (i >> 2) + 4 * hh; if (kvl >= r32) { lr[i] = 0.f; S[i] = -INFINITY; } }
    }
    float tot[4], pt[4], off[4]; f32x16 ex;
#pragma unroll
    for (int g = 0; g < 4; ++g) { ex[4 * g + 3] = 0.f; ex[4 * g + 2] = lr[4 * g + 3]; ex[4 * g + 1] = lr[4 * g + 3] + lr[4 * g + 2]; ex[4 * g] = ex[4 * g + 1] + lr[4 * g + 1]; tot[g] = ex[4 * g] + lr[4 * g]; }
#pragma unroll
    for (int g = 0; g < 4; ++g) pt[g] = xhalf(tot[g], hh);
    const float own0 = hh ? 0.f : 1.f;
    float sp_ = 0.f;
#pragma unroll
    for (int g = 3; g >= 0; --g) { off[g] = sp_ + own0 * pt[g] + R; sp_ += tot[g] + pt[g]; }
#pragma unroll
    for (int i = 0; i < 16; ++i) S[i] = __builtin_amdgcn_exp2f(S[i] + ex[i] + off[i >> 2]);
    R += sp_;
    const bf16x8 p0 = pack_p(S, 0), p1 = pack_p(S, 1);
#pragma unroll
    for (int o = 0; o < 2; ++o) { O[o] = mfma32(lds_vfrag(vp + 32 * o * VSTR), p0, O[o]); O[o] = mfma32(lds_vfrag(vp + 32 * o * VSTR + 32), p1, O[o]); }
}
__device__ __forceinline__ void attn_sb_block(const bf16_t* PR, const bf16_t* VT, bf16_t* OAT, int b, int h, int qb, LAS unsigned char* lds, volatile LAS unsigned* fl, int tid, int wave, int lane) {
    constexpr int KSTR = 144, KB = 64 * KSTR, BUF = KB + 64 * VSTR;
    const int r32 = lane & 31, hh = lane >> 5, q0 = qb * 256 + wave * 32;
    const bf16_t* qrow = PR + (size_t)(b * SEQ + q0 + r32) * NIN + C_SBQ + h * 64 + 8 * hh;
    bf16x8 qf[4];
#pragma unroll
    for (int d0 = 0; d0 < 4; ++d0) qf[d0] = *(const bf16x8*)(qrow + 16 * d0);
    const bf16_t* kg = PR + (size_t)(b * SEQ) * NIN + C_SBK + h * 64;
    const bf16_t* vg = VT + (size_t)(b * 512 + h * 64) * SEQ;
    f32x16 O[2];
#pragma unroll
    for (int o = 0; o < 2; ++o)
#pragma unroll
        for (int i = 0; i < 16; ++i) O[o][i] = 0.f;
    float R = 0.f; bool done = false;
    const int ttop = 4 * qb + 3, my_diag = 4 * qb + (wave >> 1), odd = wave & 1;
    v4u kr[1], vr[1];
    if (tid < 3) fl[tid] = 0u;
    stage_load<1>(kr, kg + (size_t)(64 * ttop) * NIN, 8, NIN, tid); stage_load<1>(vr, vg + 64 * ttop, 8, SEQ, tid);
    stage_store_k<1>(kr, lds, 8, KSTR, tid); stage_store_v<1>(vr, lds + KB, tid);
    __syncthreads();
    int it = 0;
    for (int t = ttop; t >= 0; --t, ++it) {
        const bool more = t > 0;
        if (more) { stage_load<1>(kr, kg + (size_t)(64 * (t - 1)) * NIN, 8, NIN, tid); stage_load<1>(vr, vg + 64 * (t - 1), 8, SEQ, tid); }
        const int fcur = it % 3;
        if (tid == 0) fl[(it + 1) % 3] = 0u;
        if (t <= my_diag && !done) {
            const LAS unsigned char* kb = lds + (it & 1) * BUF + r32 * KSTR + 16 * hh; const LAS unsigned char* vb = lds + (it & 1) * BUF + KB + r32 * VSTR + 8 * hh;
            const bool isd = (t == my_diag);
            if (!isd || odd) {
                f32x16 S;
#pragma unroll
                for (int i = 0; i < 16; ++i) S[i] = 0.f;
#pragma unroll
                for (int d0 = 0; d0 < 4; ++d0) S = mfma32(*(const LAS bf16x8*)(kb + 32 * KSTR + 32 * d0), qf[d0], S);
                sb_subtile(S, isd, R, O, vb + 64, r32, hh);
            }
            {
                f32x16 S;
#pragma unroll
                for (int i = 0; i < 16; ++i) S[i] = 0.f;
#pragma unroll
                for (int d0 = 0; d0 < 4; ++d0) S = mfma32(*(const LAS bf16x8*)(kb + 32 * d0), qf[d0], S);
                sb_subtile(S, isd && !odd, R, O, vb, r32, hh);
            }
            done = __all(R < -160.f);
        }
        if (done && lane == 0) __hip_atomic_fetch_or((LAS unsigned*)(fl + fcur), 1u << wave, __ATOMIC_RELAXED, __HIP_MEMORY_SCOPE_WORKGROUP);
        if (more) { LAS unsigned char* nb = lds + ((it + 1) & 1) * BUF; stage_store_k<1>(kr, nb, 8, KSTR, tid); stage_store_v<1>(vr, nb + KB, tid); }
        __syncthreads();
        if (fl[fcur] == 0xffu) break;
    }
    bf16_t* orow = OAT + (size_t)(b * SEQ + q0 + r32) * D + h * 64 + 4 * hh;
#pragma unroll
    for (int o = 0; o < 2; ++o)
#pragma unroll
        for (int g = 0; g < 4; ++g) { v2u w; w.x = pg8::cvt_pk_bf16(O[o][4 * g], O[o][4 * g + 1]); w.y = pg8::cvt_pk_bf16(O[o][4 * g + 2], O[o][4 * g + 3]); *(v2u*)(orow + 32 * o + 8 * g) = w; }
    __syncthreads();
}

__device__ __forceinline__ void attn_mem_block(const bf16_t* QM, const bf16_t* KVM, const bf16_t* VT, bf16_t* OM, int b, int h, int qb, LAS unsigned char* lds, int tid, int wave, int lane) {
    constexpr int KSTR = 528, KB = 32 * KSTR, VS = 72, BUF = KB + 128 * VS;
    const int r32 = lane & 31, hh = lane >> 5, q0 = qb * 256 + wave * 32;
    const bf16_t* qrow = QM + (size_t)(b * SEQ + q0 + r32) * D + h * 256 + 8 * hh;
    bf16x8 qf[8];
    LAS unsigned char* qs = lds + 53248 + wave * 8192 + lane * 16;
#pragma unroll
    for (int d0 = 0; d0 < 8; ++d0) { qf[d0] = *(const bf16x8*)(qrow + 16 * d0); *(LAS bf16x8*)(qs + d0 * 1024) = *(const bf16x8*)(qrow + 128 + 16 * d0); }
    const bf16_t* kg = KVM + (size_t)(b * MEMLEN) * 2048 + h * 256;
    const int vrow = tid >> 2, vch = tid & 3;
    for (int dh = 0; dh < 2; ++dh) {
        const bf16_t* vg = VT + (size_t)(b * 1024 + h * 256 + dh * 128 + vrow) * MEMLEN + vch * 8;
        f32x16 O[4];
#pragma unroll
        for (int o = 0; o < 4; ++o)
#pragma unroll
            for (int i = 0; i < 16; ++i) O[o][i] = 0.f;
        float m = 0.f, l = 0.f;
        v4u kr[2], vr;
        stage_load<2>(kr, kg, 32, 2048, tid); vr = *(const v4u*)vg;
        stage_store_k<2>(kr, lds, 32, KSTR, tid); { LAS v2u* d = (LAS v2u*)(lds + KB + vrow * VS + vch * 16); d[0] = (v2u){vr.x, vr.y}; d[1] = (v2u){vr.z, vr.w}; }
        __syncthreads();
        for (int t = 0; t < 8; ++t) {
            const bool more = t < 7;
            if (more) { stage_load<2>(kr, kg + (size_t)(32 * (t + 1)) * 2048, 32, 2048, tid); vr = *(const v4u*)(vg + 32 * (t + 1)); }
            {
                const LAS unsigned char* kb = lds + (t & 1) * BUF + r32 * KSTR + 16 * hh; const LAS unsigned char* vb = lds + (t & 1) * BUF + KB + r32 * VS + 8 * hh;
                f32x16 S;
#pragma unroll
                for (int i = 0; i < 16; ++i) S[i] = -m;
#pragma unroll
                for (int d0 = 0; d0 < 8; ++d0) S = mfma32(*(const LAS bf16x8*)(kb + 32 * d0), qf[d0], S);
#pragma unroll
                for (int d0 = 0; d0 < 8; ++d0) S = mfma32(*(const LAS bf16x8*)(kb + 256 + 32 * d0), *(const LAS bf16x8*)(qs + d0 * 1024), S);
                softmax_def1<4>(S, t == 0, m, l, O, hh);
                const bf16x8 p0 = pack_p(S, 0), p1 = pack_p(S, 1);
#pragma unroll
                for (int o = 0; o < 4; ++o) { const LAS unsigned char* vp = vb + 32 * o * VS; O[o] = mfma32(lds_vfrag(vp), p0, O[o]); O[o] = mfma32(lds_vfrag(vp + 32), p1, O[o]); }
            }
            if (more) { LAS unsigned char* nb = lds + ((t + 1) & 1) * BUF; stage_store_k<2>(kr, nb, 32, KSTR, tid); LAS v2u* d = (LAS v2u*)(nb + KB + vrow * VS + vch * 16); d[0] = (v2u){vr.x, vr.y}; d[1] = (v2u){vr.z, vr.w}; }
            __syncthreads();
        }
        l += xhalf(l, hh);
        const float il = 1.f / l;
        bf16_t* orow = OM + (size_t)(b * SEQ + q0 + r32) * D + h * 256 + dh * 128 + 4 * hh;
#pragma unroll
        for (int o = 0; o < 4; ++o)
#pragma unroll
            for (int g = 0; g < 4; ++g) { v2u w; w.x = pg8::cvt_pk_bf16(O[o][4 * g] * il, O[o][4 * g + 1] * il); w.y = pg8::cvt_pk_bf16(O[o][4 * g + 2] * il, O[o][4 * g + 3] * il); *(v2u*)(orow + 32 * o + 8 * g) = w; }
    }
}

struct Args { const void* in[26]; float* out; unsigned char* ws; int ph_lo, ph_hi; };
constexpr int NPHASE = 15;

__device__ __forceinline__ float softplus_f(float z) { return fmaxf(z, 0.f) + __logf(1.f + __expf(-fabsf(z))); }

__global__ void __launch_bounds__(NTHR, 2) fwd(Args args) {
    extern __shared__ __attribute__((aligned(16))) unsigned char lds[];
    LAS unsigned char* L = (LAS unsigned char*)lds;
    volatile LAS unsigned* MISC = (volatile LAS unsigned*)(L + MISC_OFF);
    const int tid = threadIdx.x, lane = tid & 63, wave = __builtin_amdgcn_readfirstlane(tid >> 6);
    const int G = gridDim.x;
    unsigned char* ws = args.ws;
    unsigned* ctl = (unsigned*)(ws + WS_CTL);
#define x_in ((const float*)args.in[0])
#define mem_in ((const float*)args.in[1])
#define positions ((const int*)args.in[2])
#define norm_mix ((const float*)args.in[3])
#define w_in ((const float*)args.in[4])
#define lam_q1 ((const float*)args.in[5])
#define lam_k1 ((const float*)args.in[6])
#define lam_q2 ((const float*)args.in[7])
#define lam_k2 ((const float*)args.in[8])
#define diff_subln ((const float*)args.in[9])
#define w_up_sb ((const float*)args.in[10])
#define w_up_diff ((const float*)args.in[11])
#define w_out ((const float*)args.in[12])
#define norm_mem_q ((const float*)args.in[13])
#define norm_mem_kv ((const float*)args.in[14])
#define w_mem_q ((const float*)args.in[15])
#define w_mem_kv ((const float*)args.in[16])
#define w_mem_o ((const float*)args.in[17])
#define norm_ffn ((const float*)args.in[18])
#define w_router ((const float*)args.in[19])
#define b_router ((const float*)args.in[20])
#define w_gate_up ((const float*)args.in[21])
#define b_gate_up ((const float*)args.in[22])
#define w_down ((const float*)args.in[23])
#define b_down ((const float*)args.in[24])
#define norm_final ((const float*)args.in[25])
    bf16_t* WIN = (bf16_t*)(ws + WS_WIN); bf16_t* WUPSB = (bf16_t*)(ws + WS_WUPSB); bf16_t* WUPDF = (bf16_t*)(ws + WS_WUPDF); bf16_t* WOUT = (bf16_t*)(ws + WS_WOUT);
    bf16_t* WMQ = (bf16_t*)(ws + WS_WMQ); bf16_t* WMKV = (bf16_t*)(ws + WS_WMKV); bf16_t* WMO = (bf16_t*)(ws + WS_WMO);
    bf16_t* WGU = (bf16_t*)(ws + WS_WGU); bf16_t* WD = (bf16_t*)(ws + WS_WD);
    float* ROPEC = (float*)(ws + WS_ROPE); float* ROPES = ROPEC + (size_t)M * 32;
    int* TK_E = (int*)(ws + WS_TK); int* TK_POS = TK_E + (size_t)M * 4; float* TK_G = (float*)(TK_POS + (size_t)M * 4);
    bf16_t* XN = (bf16_t*)(ws + WS_XN); bf16_t* PR = (bf16_t*)(ws + WS_PR); bf16_t* OAT = (bf16_t*)(ws + WS_OAT); float* SSQ = (float*)(ws + WS_ODR);
    bf16_t* MIX = (bf16_t*)(ws + WS_MIX); float* X1 = (float*)(ws + WS_X1); float* X2 = (float*)(ws + WS_X2);
    bf16_t* HM = (bf16_t*)(ws + WS_HM); bf16_t* KVM = (bf16_t*)(ws + WS_KVM); int* TLIST = (int*)(ws + WS_TLIST); float* GLIST = (float*)(ws + WS_GLIST);
    bf16_t* QM = (bf16_t*)(ws + WS_QM); bf16_t* OM = (bf16_t*)(ws + WS_OM); bf16_t* ACT = (bf16_t*)(ws + WS_ACT); bf16_t* YB = (bf16_t*)(ws + WS_YB);
    bf16_t* VTSB = (bf16_t*)(ws + WS_VTSB); bf16_t* VTDF = (bf16_t*)(ws + WS_VTDF); bf16_t* VTM = (bf16_t*)(ws + WS_VTM);
    float* WR = (float*)(ws + WS_WR); float* WSCGU = (float*)(ws + WS_WSC); float* WSCD = WSCGU + NE * 2048;
    unsigned char* WGU8 = ws + WS_WGU; unsigned char* WD8 = ws + WS_WD; unsigned char* XN8 = ws + WS_XN; unsigned char* ACT8 = ws + WS_ACT;
    unsigned* CNT = ctl + CW_CNT;
    LAS float* smf = (LAS float*)L;
    LAS int* smi = (LAS int*)L;

    for (int u = tid; u < (LDS_BYTES - 131072) / 4; u += NTHR) ((LAS unsigned*)(L + 131072))[u] = 0u;
    __syncthreads();
#if !MK_PER_PHASE
    XcdBarrier bar = xcd_barrier_post(ctl + CW_BAR, MISC + 8);
#define GRID_BAR() xcd_barrier(bar)
#else
#define GRID_BAR() do {} while (0)
#endif
    const int lo = args.ph_lo, hi = args.ph_hi;
#define IN(k) (lo <= (k) && (k) < hi)
#define PHASE_L(k, ...) do { if (IN(k)) { auto body_ = [&]() __attribute__((always_inline)) __VA_ARGS__; body_(); if ((PROBE_REP >> (k)) & 1) { GRID_BAR(); body_(); } } } while (0)
#if !MK_PER_PHASE
#define PHASE(k) for (int rep_ = 0, nrep_ = IN(k) ? 1 + ((PROBE_REP >> (k)) & 1) : 0; rep_ < nrep_; ++rep_, (rep_ < nrep_ ? (xcd_barrier(bar), 0) : 0))
#else
#define PHASE(k) if (IN(k))
#endif
    unsigned long long st_t0_ = 0ull, st_dt_ = 0ull;
#define STAMP_AT(k) do { if (PROBE_STAMP >= 0) { const unsigned long long now_ = __builtin_amdgcn_s_memrealtime(); if ((k) == PROBE_STAMP || (PROBE_STAMP == 100 && (k) == 0)) st_t0_ = now_; if ((k) == PROBE_STAMP + 1 || (PROBE_STAMP == 100 && (k) == 15)) st_dt_ = now_ - st_t0_; } } while (0)
#define SEAM(k) do { if (IN(k) && IN((k) + 1)) GRID_BAR(); STAMP_AT((k) + 1); } while (0)
    const int gw = blockIdx.x * NWAVES + wave, NGW = G * NWAVES;
    const int xcu = (G % 8 == 0) ? ((int)blockIdx.x % 8) * (G / 8) + (int)blockIdx.x / 8 : (int)blockIdx.x;

    auto convert_experts = [&]() __attribute__((always_inline)) {
        LAS float* scr = (LAS float*)(L + wave * 16384);
        {
            LAS float* sinv = scr + 64 * 33;
            const int n_ = lane & 31, hf = lane >> 5, cc = lane & 7;
            float ra[32], rb[32];
            auto sub_load = [&](const float* Wn, int N, int k0, float (&r)[32]) __attribute__((always_inline)) {
#pragma unroll
                for (int i = 0; i < 32; ++i) r[i] = Wn[(size_t)(k0 + 2 * i + hf) * N]; };
            auto to_lds = [&](const float (&r)[32]) __attribute__((always_inline)) {
#pragma unroll
                for (int i = 0; i < 32; ++i) scr[(2 * i + hf) * 33 + n_] = r[i];
                LDS_WAIT(); asm volatile("" ::: "memory"); };
            auto col_amax = [&]() __attribute__((always_inline)) -> float { float a = 0.f;
#pragma unroll
                for (int i = 0; i < 32; ++i) a = fmaxf(a, fabsf(scr[(32 * hf + i) * 33 + n_]));
                return fmaxf(a, xhalf(a, hf)); };
            for (int it = gw; it < NE * 96 * 4; it += NGW) {
                const int strip = it % (NE * 96), qt = it / (NE * 96);
                const bool gu = strip < NE * 64; const int q = gu ? strip : strip - NE * 64, e = gu ? q >> 6 : q >> 5, n0 = (gu ? q & 63 : q & 31) * 32, N = gu ? 2048 : 1024;
                const float* Wn = (gu ? w_gate_up + (size_t)e * 1024 * 2048 : w_down + (size_t)e * 1024 * 1024) + n0 + n_;
                sub_load(Wn, N, 0, ra); sub_load(Wn, N, 256 * qt, rb);
                to_lds(ra);
                { const float a0 = col_amax();
                  unsigned eb = ((__float_as_uint(a0) >> 23) & 0xffu) + 4u; eb = eb < 8u ? 8u : (eb > 250u ? 250u : eb);
                  const float sc = __uint_as_float((eb - 7u) << 23), inv = __uint_as_float((261u - eb) << 23);
                  if (hf == 0) { sinv[n_] = inv; if (qt == 0) (gu ? WSCGU + (size_t)e * 2048 : WSCD + (size_t)e * 1024)[n0 + n_] = sc; }
                  LDS_WAIT(); asm volatile("" ::: "memory"); }
                float amax_run = 0.f;
                unsigned char* dstb = gu ? WGU8 + (size_t)e * 2048 * 1024 : WD8 + (size_t)e * 1024 * 1024;
#pragma unroll
                for (int st = 0; st < 4; ++st) {
                    const int k0 = 256 * qt + 64 * st;
                    if (st & 1) { if (st < 3) sub_load(Wn, N, k0 + 64, rb); to_lds(ra); } else { if (st < 3) sub_load(Wn, N, k0 + 64, ra); to_lds(rb); }
                    amax_run = fmaxf(amax_run, col_amax());
#pragma unroll
                    for (int j = 0; j < 4; ++j) { const int n = (lane >> 3) + 8 * j, c = n0 + n; const LAS float* sp = scr + (8 * cc) * 33 + n; const float inv = sinv[n];
                        const int drow = gu ? (((c & 1023) >> 7) * 256 + (c >> 10) * 128 + (c & 127)) : c;
                        v2u w; w.x = pk4_fp8(sp[0] * inv, sp[33] * inv, sp[66] * inv, sp[99] * inv); w.y = pk4_fp8(sp[132] * inv, sp[165] * inv, sp[198] * inv, sp[231] * inv);
                        *(v2u*)(dstb + (size_t)drow * 1024 + k0 + 8 * cc) = w; }
                    LDS_WAIT(); asm volatile("" ::: "memory");
                }
                const bool ov = amax_run * sinv[n_] >= 448.0f;
                if (__any(ov) && lane == 0) __hip_atomic_store(ctl + CW_REDO + strip, 1u, __ATOMIC_RELAXED, __HIP_MEMORY_SCOPE_AGENT);
                LDS_WAIT(); asm volatile("" ::: "memory");
            }
        }
    };
    STAMP_AT(0);
    PHASE(0) {
        STAMP_AT(20);
        LAS float* scr = (LAS float*)(L + wave * 16384);
        constexpr int I_IN = 16 * 160, I_UP = 8 * 32, I_SQ = 16 * 32, I_KV = 16 * 64, I_GU1 = 16 * 64, I_GU = NE * I_GU1, I_D1 = 16 * 32, I_DN = NE * I_D1;
        constexpr int NITEMS = I_IN + 2 * I_UP + 3 * I_SQ + I_KV;
        for (int it = gw; it < NITEMS; it += NGW) {
            int r = it;
            if (r < I_IN) {
                const int kb = r / 160, nb = r % 160, n0 = 32 * nb;
                if (n0 >= C_DQ && n0 < C_DV) { const int o = n0 & 255;
                    p0_transpose_rope(w_in, WIN, (n0 & ~255), o, 64 * kb, n0, scr, lane); }
                else p0_transpose_item(w_in, 1024, NIN, WIN, n0, 64 * kb, n0, scr, lane);
                continue; } r -= I_IN;
            if (r < I_UP) { p0_plain(w_up_sb, 512, 1024, WUPSB, r, scr, lane); continue; } r -= I_UP;
            if (r < I_UP) { p0_plain(w_up_diff, 512, 1024, WUPDF, r, scr, lane); continue; } r -= I_UP;
            if (r < I_SQ) { p0_plain(w_out, 1024, 1024, WOUT, r, scr, lane); continue; } r -= I_SQ;
            if (r < I_SQ) { p0_plain(w_mem_q, 1024, 1024, WMQ, r, scr, lane, norm_mem_q); continue; } r -= I_SQ;
            if (r < I_SQ) { p0_plain(w_mem_o, 1024, 1024, WMO, r, scr, lane); continue; } r -= I_SQ;
            p0_plain(w_mem_kv, 1024, 2048, WMKV, r, scr, lane);
        }
        for (int i = blockIdx.x * NTHR + tid; i < D * NE; i += G * NTHR) WR[i] = w_router[i] * norm_ffn[i >> 5];
        STAMP_AT(21);
        STAMP_AT(22);
        for (int m = gw; m < M; m += NGW) rms_row_to_bf16(x_in + (size_t)m * D, norm_mix, XN + (size_t)m * D, lane);
        for (int m = gw; m < MM; m += NGW) rms_row_to_bf16(mem_in + (size_t)m * D, norm_mem_kv, HM + (size_t)m * D, lane);
        for (int i = blockIdx.x * NTHR + tid; i < M * 32; i += G * NTHR) {
            const int m = i >> 5, f = i & 31;
            const double inv = exp2(-(double)f * (13.287712379549449 / 32.0));
            const double ang = (double)positions[m] * inv;
            const double kk = rint(ang * 0.15915494309189535);
            const float rf = (float)(ang - kk * 6.283185307179586);
            ROPEC[i] = __cosf(rf); ROPES[i] = __sinf(rf);
        }
        STAMP_AT(23);
    }
    SEAM(0); STAMP_AT(24);

    if (IN(1)) {
        const int grp = (int)blockIdx.x % 3;
        pg8::Gemm g{XN, WIN, D, D, D}; pg8::DenseOrder S; S.init(M, NIN, G, (int)blockIdx.x, D, D);
        const pg8::EpiInProj E{PR, ROPEC, ROPES, VTSB, VTDF};
        if (grp == 0) { convert_experts(); __syncthreads(); }
        if (grp == 1) { S.i0 = 0; S.i1 = 2; pg8::gemm_phase<pg8::EpiInProj, pg8::DenseOrder, false>(L, g, S, E); convert_experts(); __syncthreads(); S.i0 = 2; S.i1 = 1 << 30; }
        pg8::gemm_phase<pg8::EpiInProj, pg8::DenseOrder, false>(L, g, S, E);
        if (grp == 2) convert_experts();
    }
    SEAM(1);

    if (IN(3)) {
        {
            LAS float* sw = (LAS float*)L; LAS float* red = (LAS float*)(L + 131072 + 4096);
            const int n = tid & 31, part = tid >> 5;
            for (int it = blockIdx.x; it < NE * 96; it += G) {
                if (__hip_atomic_load(ctl + CW_REDO + it, __ATOMIC_RELAXED, __HIP_MEMORY_SCOPE_AGENT) == 0u) continue;
                const bool gu = it < NE * 64; const int q = gu ? it : it - NE * 64, e = gu ? q >> 6 : q >> 5, n0 = (gu ? q & 63 : q & 31) * 32, N = gu ? 2048 : 1024;
                const float* W = (gu ? w_gate_up + (size_t)e * 1024 * 2048 : w_down + (size_t)e * 1024 * 1024) + n0 + n;
                __syncthreads();
#pragma unroll 16
                for (int i = 0; i < 64; ++i) { const int k = part + 16 * i; sw[k * 32 + n] = W[(size_t)k * N]; }
                __syncthreads();
                float am = 0.f;
#pragma unroll 16
                for (int i = 0; i < 64; ++i) am = fmaxf(am, fabsf(sw[(64 * part + i) * 32 + n]));
                red[part * 32 + n] = am;
                __syncthreads();
                if (tid < 32) { float a = red[tid];
#pragma unroll
                    for (int pp = 1; pp < 16; ++pp) a = fmaxf(a, red[pp * 32 + tid]);
                    unsigned eb = (__float_as_uint(a) >> 23) & 0xffu; eb = eb < 8u ? 8u : eb;
                    const float sc = __uint_as_float((eb - 7u) << 23), inv = __uint_as_float((261u - eb) << 23);
                    red[512 + tid] = inv; (gu ? WSCGU + (size_t)e * 2048 : WSCD + (size_t)e * 1024)[n0 + tid] = sc; }
                __syncthreads();
                { const float inv = red[512 + n]; const int c = n0 + n;
                  const int drow = gu ? (((c & 1023) >> 7) * 256 + (c >> 10) * 128 + (c & 127)) : c;
                  unsigned char* dst = (gu ? WGU8 + ((size_t)e * 2048 + drow) * 1024 : WD8 + ((size_t)e * 1024 + drow) * 1024) + 64 * part;
#pragma unroll
                  for (int qd = 0; qd < 4; ++qd) { v4u w;
                      const LAS float* sp = sw + (64 * part + 16 * qd) * 32 + n;
                      w.x = pk4_fp8(sp[0] * inv, sp[32] * inv, sp[64] * inv, sp[96] * inv); w.y = pk4_fp8(sp[128] * inv, sp[160] * inv, sp[192] * inv, sp[224] * inv);
                      w.z = pk4_fp8(sp[256] * inv, sp[288] * inv, sp[320] * inv, sp[352] * inv); w.w = pk4_fp8(sp[384] * inv, sp[416] * inv, sp[448] * inv, sp[480] * inv);
                      *(v4u*)(dst + 16 * qd) = w; } }
            }
            __syncthreads();
        }
    }
    PHASE(3) {
        volatile LAS unsigned* fl = (volatile LAS unsigned*)(L + 131072 + 2048);
        STAMP_AT(30);
        const int nkv = (G >= 64) ? 32 : 0;
        if ((int)blockIdx.x < nkv) { pg8::Gemm g{HM, WMKV, D, D, D}; pg8::OneUnitOrder S{(int)blockIdx.x, D, D};
            pg8::gemm_phase<pg8::EpiKV, pg8::OneUnitOrder, false>(L, g, S, pg8::EpiKV{KVM, VTM}); }
        else for (int bu = (int)blockIdx.x - nkv; bu < 512; bu += G - nkv) { const int qb = bu & 15, h = (bu >> 4) & 7, b = bu >> 7; attn_sb_block(PR, VTSB, OAT, b, h, qb, L, fl, tid, wave, lane); }
        if (nkv == 0) { pg8::Gemm g{HM, WMKV, D, D, D}; pg8::DenseOrder S; S.init(MM, 2048, G, (int)blockIdx.x, D, D); pg8::gemm_phase<pg8::EpiKV, pg8::DenseOrder, false>(L, g, S, pg8::EpiKV{KVM, VTM}); }
        STAMP_AT(31);
        const float lam = expf(wave_sum(lam_q1[lane] * lam_k1[lane])) - expf(wave_sum(lam_q2[lane] * lam_k2[lane])) + 0.2f;
        for (int pr = blockIdx.x; pr < 256; pr += G) { const int sb_ = pr & 15, h = (pr >> 4) & 3, b = pr >> 6;
            attn_diff_block(PR, VTDF, OAT, diff_subln, lam, b, h, 31 - sb_, L, tid, wave, lane); attn_diff_block(PR, VTDF, OAT, diff_subln, lam, b, h, sb_, L, tid, wave, lane); }
        STAMP_AT(32);
    }
    SEAM(3); STAMP_AT(3); STAMP_AT(33);

    PHASE_L(5, {
        pg8::Gemm g{OAT, WUPSB, D, 512, 512}; pg8::TwoRoundOrder S{G, xcu, D, 512};
        pg8::gemm_phase<pg8::EpiGate, pg8::TwoRoundOrder, false>(L, g, S, pg8::EpiGate{PR, X2, MIX});
    });
    SEAM(5); STAMP_AT(5);

    PHASE_L(6, {
        pg8::Gemm g{MIX, WOUT, D, D, D}; pg8::DenseOrder S; S.init(M, D, G, (int)blockIdx.x, D, D);
        pg8::gemm_phase<pg8::EpiResidNorm, pg8::DenseOrder, false>(L, g, S, pg8::EpiResidNorm{x_in, X1, XN, SSQ});
    });
    if (IN(6) && IN(8)) GRID_BAR();
    STAMP_AT(7); STAMP_AT(8);

    PHASE_L(8, {
        pg8::Gemm g{XN, WMQ, D, D, D}; pg8::DenseOrder S; S.init(M, D, G, (int)blockIdx.x, D, D);
        pg8::gemm_phase<pg8::EpiBf16Rinv, pg8::DenseOrder, false>(L, g, S, pg8::EpiBf16Rinv{QM, SSQ, 0.0625f * 1.4426950408889634f});
    });
    SEAM(8);

    PHASE(9) { for (int bu = blockIdx.x; bu < 256; bu += G) { const int qb = bu & 15, h = (bu >> 4) & 3, b = bu >> 6; attn_mem_block(QM, KVM, VTM, OM, b, h, qb, L, tid, wave, lane); } }
    SEAM(9);

    PHASE_L(10, {
        pg8::Gemm g{OM, WMO, D, D, D}; pg8::DenseOrder S; S.init(M, D, G, (int)blockIdx.x, D, D);
        pg8::gemm_phase<pg8::EpiResidF32, pg8::DenseOrder, false>(L, g, S, pg8::EpiResidF32{X1, X2});
    });
    SEAM(10);

    if (IN(11)) {
        auto body11_ = [&]() __attribute__((always_inline)) {
        {
            const int i32 = lane & 31, kk = lane >> 5;
#pragma unroll
            for (int t2 = 0; t2 < 2; ++t2) {
                const int tile = t2 * G + (int)blockIdx.x, m0 = tile * 32;
                LAS float* P = smf + (t2 * 8 + wave) * 1056; LAS float* SSQ_ = smf + 16 * 1056 + (t2 * 8 + wave) * 32;
                f32x16 acc;
#pragma unroll
                for (int r = 0; r < 16; ++r) acc[r] = 0.f;
                float ss = 0.f;
                if (tile < M / 32) {
                    const float* xr = X2 + (size_t)(m0 + i32) * D + 128 * wave + 4 * kk; const float* wp = WR + (128 * wave + 4 * kk) * NE + i32;
#pragma unroll 8
                    for (int u = 0; u < 16; ++u) {
                        const f32x4 a = *(const f32x4*)(xr + 8 * u);
                        const float b0 = wp[(8 * u + 0) * NE], b1 = wp[(8 * u + 1) * NE], b2 = wp[(8 * u + 2) * NE], b3 = wp[(8 * u + 3) * NE];
                        acc = __builtin_amdgcn_mfma_f32_32x32x2f32(a.x, b0, acc, 0, 0, 0); acc = __builtin_amdgcn_mfma_f32_32x32x2f32(a.y, b1, acc, 0, 0, 0);
                        acc = __builtin_amdgcn_mfma_f32_32x32x2f32(a.z, b2, acc, 0, 0, 0); acc = __builtin_amdgcn_mfma_f32_32x32x2f32(a.w, b3, acc, 0, 0, 0);
                        ss += (a.x * a.x + a.y * a.y) + (a.z * a.z + a.w * a.w);
                    }
                }
                ss += xhalf(ss, kk);
#pragma unroll
                for (int r = 0; r < 16; ++r) P[((r & 3) + 8 * (r >> 2) + 4 * kk) * 33 + i32] = acc[r];
                if (kk == 0) SSQ_[i32] = ss;
            }
        }
        __syncthreads();
        if (wave < 2) {
            const int tile = wave * G + (int)blockIdx.x;
            if (tile < M / 32) {
                const int m0 = tile * 32;
                LAS float* T = smf + (wave * 8) * 1056;
#pragma unroll
                for (int r = 0; r < 16; ++r) { const int idx = lane + 64 * r, e_ = (idx >> 5) * 33 + (idx & 31); float v = T[e_];
#pragma unroll
                    for (int w2 = 1; w2 < 8; ++w2) v += T[w2 * 1056 + e_];
                    T[e_] = v; }
                float ss = 0.f;
#pragma unroll
                for (int w2 = 0; w2 < 8; ++w2) ss += smf[16 * 1056 + (wave * 8 + w2) * 32 + (lane & 31)];
                LDS_WAIT(); asm volatile("" ::: "memory");
                const float rinv = 1.0f / sqrtf(ss * (1.f / 1024.f) + NORM_EPS);
                if (lane < 32) {
                    float lg[32];
#pragma unroll
                    for (int j = 0; j < 32; ++j) lg[j] = T[lane * 33 + j] * rinv + b_router[j];
                    float tv[4]; int ti[4];
#pragma unroll
                    for (int k = 0; k < 4; ++k) { float bv = lg[0]; int bi = 0;
#pragma unroll
                        for (int j = 1; j < 32; ++j) if (lg[j] > bv) { bv = lg[j]; bi = j; }
                        tv[k] = bv; ti[k] = bi;
#pragma unroll
                        for (int j = 0; j < 32; ++j) if (j == bi) lg[j] = -INFINITY; }
                    const float e1 = __expf(tv[1] - tv[0]), e2 = __expf(tv[2] - tv[0]), e3 = __expf(tv[3] - tv[0]);
                    const float isum = 1.f / (1.f + e1 + e2 + e3);
                    const float gk[4] = {isum, e1 * isum, e2 * isum, e3 * isum};
                    LAS unsigned* H = (LAS unsigned*)(smf + 16 * 1056 + 512 + wave * 64);
                    H[lane] = 0u;
                    LDS_WAIT(); asm volatile("" ::: "memory");
                    int rk[4];
#pragma unroll
                    for (int k = 0; k < 4; ++k) rk[k] = (int)__hip_atomic_fetch_add(H + ti[k], 1u, __ATOMIC_RELAXED, __HIP_MEMORY_SCOPE_WAVEFRONT);
                    LDS_WAIT(); asm volatile("" ::: "memory");
                    const unsigned cnt_e = H[lane];
                    unsigned base_e = 0u; if (cnt_e) base_e = atomicAdd(&CNT[64 * lane], cnt_e);
                    H[32 + lane] = base_e;
                    LDS_WAIT(); asm volatile("" ::: "memory");
                    const int m = m0 + lane;
#pragma unroll
                    for (int k = 0; k < 4; ++k) { const int ek = ti[k]; const int pos = (int)H[32 + ek] + rk[k];
                        TLIST[ek * LISTCAP + pos] = m; GLIST[ek * LISTCAP + pos] = gk[k]; TK_E[m * 4 + k] = ek; TK_POS[m * 4 + k] = pos; TK_G[m * 4 + k] = gk[k]; }
                }
            }
        } else {
            for (int m = blockIdx.x * 6 + (wave - 2); m < M; m += G * 6) rms_row_to_fp8(X2 + (size_t)m * D, norm_ffn, XN8 + (size_t)m * D, lane);
        }
            };
        body11_();
        if ((PROBE_REP >> 11) & 1) { GRID_BAR(); if (blockIdx.x == 0 && tid < NE) CNT[64 * tid] = 0u; GRID_BAR(); body11_(); }
    }
    SEAM(11);

#define LOAD_BASES() do { __syncthreads(); if (tid == 0) { int b_ = 0; for (int e_ = 0; e_ < NE; ++e_) { const int c_ = (int)__hip_atomic_load(&CNT[64 * e_], __ATOMIC_RELAXED, __HIP_MEMORY_SCOPE_AGENT); \
        smi[8192 + e_] = b_; smi[8256 + e_] = c_; b_ += (c_ + 255) & ~255; } } __syncthreads(); } while (0)

    LAS int* tb = (LAS int*)(L + 131072 + 1024);
#define LOAD_TB(npn) do { __syncthreads(); if (tid == 0) { int b_ = 0, cu_ = 0; for (int e_ = 0; e_ < NE; ++e_) { const int c_ = (int)__hip_atomic_load(&CNT[64 * e_], __ATOMIC_RELAXED, __HIP_MEMORY_SCOPE_AGENT); \
        tb[e_] = b_; tb[32 + e_] = c_; tb[64 + e_] = cu_; b_ += (c_ + 255) & ~255; cu_ += ((c_ + 255) >> 8) * (npn); } tb[96] = cu_; } __syncthreads(); } while (0)
    PHASE_L(12, {
        LOAD_TB(8);
        pg8::Gemm g{(const bf16_t*)XN8, (const bf16_t*)WGU8, 512, 512, 512}; pg8::MoeOrder S{tb, TLIST, G, xcu, 8, 512, 512, 2048};
        pg8::gemm_phase<pg8::EpiMoeGU, pg8::MoeOrder, true, true>(L, g, S, pg8::EpiMoeGU{ACT8, b_gate_up, WSCGU});
    });
    SEAM(12);
    PHASE_L(13, {
        LOAD_TB(4);
        pg8::Gemm g{(const bf16_t*)ACT8, (const bf16_t*)WD8, 512, 512, 512}; pg8::MoeOrder S{tb, TLIST, G, xcu, 4, 512, 512, 1024};
        pg8::gemm_phase<pg8::EpiMoeDown, pg8::MoeOrder, false, true>(L, g, S, pg8::EpiMoeDown{YB, b_down, GLIST, tb, WSCD});
    });
    SEAM(13);

    PHASE(14) {
        LOAD_BASES();
        for (int mb = gw; mb < M; mb += 8 * NGW) {
            int slotv = 0;
            { const int i = lane >> 2, k = lane & 3, m = mb + NGW * i; if (lane < 32 && m < M) slotv = smi[8192 + TK_E[m * 4 + k]] + TK_POS[m * 4 + k]; }
#pragma unroll 2
            for (int i = 0; i < 8; ++i) {
                const int m = mb + NGW * i; if (m >= M) break;
                const f32x4* xr = (const f32x4*)(X2 + (size_t)m * D) + lane; const f32x4* gr = (const f32x4*)norm_final + lane;
                f32x4 v[4];
#pragma unroll
                for (int j = 0; j < 4; ++j) v[j] = xr[64 * j];
#pragma unroll
                for (int k = 0; k < 4; ++k) { const int slot = __builtin_amdgcn_readlane(slotv, 4 * i + k); const v2u* yr = (const v2u*)(YB + (size_t)slot * D) + lane;
#pragma unroll
                    for (int j = 0; j < 4; ++j) { const v2u w = yr[64 * j]; v[j].x += lo16(w.x); v[j].y += hi16(w.x); v[j].z += lo16(w.y); v[j].w += hi16(w.y); } }
                float ss = 0.f;
#pragma unroll
                for (int j = 0; j < 4; ++j) ss += (v[j].x * v[j].x + v[j].y * v[j].y) + (v[j].z * v[j].z + v[j].w * v[j].w);
                const float rinv = 1.0f / sqrtf(wave_sum(ss) * (1.f / 1024.f) + NORM_EPS);
                f32x4* orow = (f32x4*)(args.out + (size_t)m * D) + lane;
#pragma unroll
                for (int j = 0; j < 4; ++j) { const f32x4 gg = gr[64 * j]; orow[64 * j] = (f32x4){v[j].x * rinv * gg.x, v[j].y * rinv * gg.y, v[j].z * rinv * gg.z, v[j].w * rinv * gg.w}; }
            }
        }
    }
    if (PROBE_STAMP >= 0) { STAMP_AT(15); if (blockIdx.x == PROBE_BLOCK) { const unsigned long long t1_ = __builtin_amdgcn_s_memrealtime(); while (__builtin_amdgcn_s_memrealtime() - t1_ < st_dt_) __builtin_amdgcn_s_sleep(8); } }
#undef IN
#undef SEAM
}

extern "C" void kernel_launch(void* const* d_in, const int* in_sizes, int n_in, void* d_out, int out_size, void* d_ws, size_t ws_size, hipStream_t stream) {
    static int grid = 0;
    if (grid == 0) {
        if (n_in != 26 || out_size != M * D || ws_size < WS_END) { fprintf(stderr, "kernel_launch: unexpected sizes n_in %d out %d ws %zu\n", n_in, out_size, ws_size); grid = -1; return; }
        int dev = 0, cus = 0;
        if (hipGetDevice(&dev) != hipSuccess || hipDeviceGetAttribute(&cus, hipDeviceAttributeMultiprocessorCount, dev) != hipSuccess) { grid = -1; return; }
        if (hipFuncSetAttribute((const void*)fwd, hipFuncAttributeMaxDynamicSharedMemorySize, LDS_BYTES) != hipSuccess) { fprintf(stderr, "kernel_launch: hipFuncSetAttribute failed\n"); grid = -1; return; }
        int per_cu = 0;
        (void)hipOccupancyMaxActiveBlocksPerMultiprocessor(&per_cu, (const void*)fwd, NTHR, LDS_BYTES);
        (void)hipGetLastError();
        grid = cus;
    }
    if (grid < 0) return;
    (void)hipMemsetAsync((char*)d_ws + WS_CTL, 0, CTL_ZERO_BYTES, stream);
    Args a{};
    for (int i = 0; i < 26; ++i) a.in[i] = d_in[i];
    a.out = (float*)d_out; a.ws = (unsigned char*)d_ws;
#if MK_PER_PHASE
    for (int p = 0; p < NPHASE; ++p) { a.ph_lo = p; a.ph_hi = p + 1; hipLaunchKernelGGL(fwd, dim3(grid), dim3(NTHR), LDS_BYTES, stream, a); }
#else
    a.ph_lo = 0; a.ph_hi = NPHASE; hipLaunchKernelGGL(fwd, dim3(grid), dim3(NTHR), LDS_BYTES, stream, a);
#endif
}
```

```cpp
#include <hip/hip_runtime.h>
#include <cstdio>
#include <cstdint>

#ifndef MK_PER_PHASE
#define MK_PER_PHASE 0
#endif

#ifndef PROBE_STAMP
#define PROBE_STAMP -1
#endif
#ifndef PROBE_BLOCK
#define PROBE_BLOCK 0
#endif
#ifndef PROBE_REP
#define PROBE_REP 0
#endif
#define GAS __attribute__((address_space(1)))
#define LAS __attribute__((address_space(3)))
typedef unsigned short bf16_t;
typedef unsigned v4u __attribute__((ext_vector_type(4)));
typedef unsigned v2u __attribute__((ext_vector_type(2)));
typedef float f32x4 __attribute__((ext_vector_type(4)));
typedef short bf16x8 __attribute__((ext_vector_type(8)));

constexpr int BATCH = 4, SEQ = 4096, D = 1024, M = BATCH * SEQ, NIN = 5120;
constexpr int MEMLEN = 256, MM = BATCH * MEMLEN;
constexpr int NE = 32, TOPK = 4, DFF = 1024;
constexpr float NORM_EPS = 1e-6f;
constexpr int C_SBQ = 0, C_SBK = 512, C_SBV = 1024, C_DQ = 1536, C_DK = 2048, C_DV = 2560, C_GSB = 3072, C_GDF = 4096;
constexpr int LISTCAP = 16384;
constexpr int SLOTS = 65536 + NE * 256;
constexpr int NWAVES = 8, NTHR = 512;

constexpr size_t MiB = 1u << 20;
constexpr size_t WS_CTL = 0, CTL_ZERO_BYTES = 1 * MiB;
constexpr size_t WS_WIN = 2 * MiB;
constexpr size_t WS_WUPSB = 12 * MiB;
constexpr size_t WS_WUPDF = 13 * MiB;
constexpr size_t WS_WOUT = 14 * MiB;
constexpr size_t WS_WMQ = 16 * MiB;
constexpr size_t WS_WMKV = 18 * MiB;
constexpr size_t WS_WMO = 22 * MiB;
constexpr size_t WS_ROPE = 24 * MiB;
constexpr size_t WS_TK = 28 * MiB;
constexpr size_t WS_WR = 29 * MiB;
constexpr size_t WS_WSC = 30 * MiB;
constexpr size_t WS_WGU = 32 * MiB;
constexpr size_t WS_WD = 160 * MiB;
constexpr size_t WS_XN = 224 * MiB;
constexpr size_t WS_PR = 256 * MiB;
constexpr size_t WS_OAT = 416 * MiB;
constexpr size_t WS_ODR = 448 * MiB;
constexpr size_t WS_MIX = 512 * MiB;
constexpr size_t WS_X1 = 544 * MiB;
constexpr size_t WS_X2 = 608 * MiB;
constexpr size_t WS_HM = 672 * MiB;
constexpr size_t WS_KVM = 674 * MiB;
constexpr size_t WS_TLIST = 678 * MiB;
constexpr size_t WS_GLIST = 680 * MiB;
constexpr size_t WS_QM = 682 * MiB;
constexpr size_t WS_OM = 714 * MiB;
constexpr size_t WS_ACT = 256 * MiB;
constexpr size_t WS_YB = 746 * MiB;
constexpr size_t WS_VTSB = 890 * MiB;
constexpr size_t WS_VTDF = 906 * MiB;
constexpr size_t WS_VTM = 922 * MiB;
constexpr size_t WS_END = 924 * MiB;
static_assert(WS_ACT + (size_t)SLOTS * 1024 * 2 <= WS_OAT, "ACT overlay");
static_assert(WS_YB + (size_t)SLOTS * 1024 * 2 <= WS_VTSB, "YB");
constexpr int CW_REDO = 16384;
constexpr int CW_CNT = 8192;
constexpr int CW_BAR = 1024;

constexpr int LDS_BYTES = 147456;
constexpr int MISC_OFF = 131072 + 320;

__device__ __forceinline__ float bf2f(bf16_t b) { return __uint_as_float(((unsigned)b) << 16); }
__device__ __forceinline__ unsigned f2bf(float f) { unsigned u = __float_as_uint(f); return (u + 0x7fffu + ((u >> 16) & 1u)) >> 16; }
__device__ __forceinline__ unsigned pk2(float lo, float hi) { return f2bf(lo) | (f2bf(hi) << 16); }
__device__ __forceinline__ unsigned pk4_fp8(float a, float b, float c, float d) { int w = 0; w = __builtin_amdgcn_cvt_pk_fp8_f32(a, b, w, false); w = __builtin_amdgcn_cvt_pk_fp8_f32(c, d, w, true); return (unsigned)w; }
__device__ __forceinline__ float lo16(unsigned w) { return __uint_as_float(w << 16); }
__device__ __forceinline__ float hi16(unsigned w) { return __uint_as_float(w & 0xffff0000u); }
#define LDS_WAIT() asm volatile("s_waitcnt lgkmcnt(0)" ::: "memory")
__device__ __forceinline__ float wave_sum(float v) {
#pragma unroll
    for (int o = 1; o < 64; o <<= 1) v += __shfl_xor(v, o);
    return v;
}
__device__ __forceinline__ float wave_max(float v) {
#pragma unroll
    for (int o = 1; o < 64; o <<= 1) v = fmaxf(v, __shfl_xor(v, o));
    return v;
}

#define XB_TMO      128
#define XB_XCNT(j)  (256  + 64 * (j))
#define XB_XSUB(j)  (1280 + 64 * (j))
#define XB_XGEN(j)  (2304 + 64 * (j))
#define XB_TOP      3328
#define XB_TOPGEN   3392
#define XCD_BAR_WORDS 3456
#define XB_SPIN_CAP (1u << 18)
__device__ __forceinline__ unsigned xb_ld(unsigned* p)              { return __hip_atomic_load(p, __ATOMIC_RELAXED, __HIP_MEMORY_SCOPE_AGENT); }
__device__ __forceinline__ unsigned xb_add(unsigned* p, unsigned v) { return __hip_atomic_fetch_add(p, v, __ATOMIC_RELAXED, __HIP_MEMORY_SCOPE_AGENT); }
__device__ __forceinline__ unsigned xb_xcc_id() { return (unsigned)__builtin_amdgcn_s_getreg((3 << 11) | 20) & 0xFu; }
#define XB_SPIN(cond, bar) do { unsigned _sp = 0; while (cond) { __builtin_amdgcn_s_sleep(1); \
    if ((++_sp & 255u) == 0u) { if (xb_ld(&(bar)[XB_TMO])) break; if (_sp > XB_SPIN_CAP) { atomicAdd(&(bar)[XB_TMO], 1u); break; } } } } while (0)
struct XcdBarrier { unsigned* bar; unsigned x; volatile LAS unsigned* st; };
__device__ __forceinline__ XcdBarrier xcd_barrier_post(unsigned* bar, volatile LAS unsigned* st) {
    XcdBarrier b; b.bar = bar; b.x = xb_xcc_id(); b.st = st;
    if (threadIdx.x == 0) (void)xb_add(&bar[XB_XCNT(b.x)], 1u);
    return b;
}
__device__ __forceinline__ void xcd_barrier_complete(unsigned* bar, unsigned x, unsigned& nloc, unsigned& nx) {
    const unsigned G = gridDim.x * gridDim.y * gridDim.z;
    unsigned sum, cnt, mine, sp = 0u;
    for (;;) {
        sum = 0u; cnt = 0u; mine = 0u;
#pragma unroll
        for (unsigned j = 0; j < 16; ++j) { const unsigned c = xb_ld(&bar[XB_XCNT(j)]); sum += c; cnt += (c > 0u) ? 1u : 0u; mine = (j == x) ? c : mine; }
        if (sum == G) break;
        __builtin_amdgcn_s_sleep(1);
        if ((++sp & 255u) == 0u) { if (xb_ld(&bar[XB_TMO])) break; if (sp > XB_SPIN_CAP) { atomicAdd(&bar[XB_TMO], 1u); break; } }
    }
    nloc = mine > 0u ? mine : 1u; nx = cnt > 0u ? cnt : 1u;
}
__device__ __forceinline__ void xcd_barrier(const XcdBarrier& b) {
    asm volatile("s_waitcnt vmcnt(0)" ::: "memory");
    __syncthreads();
    if (threadIdx.x == 0) {
        unsigned* bar = b.bar;
        __builtin_amdgcn_s_waitcnt(0);
        unsigned nloc = b.st[0], nx = b.st[1];
        if (nloc == 0u) { xcd_barrier_complete(bar, b.x, nloc, nx); b.st[0] = nloc; b.st[1] = nx; }
        const unsigned old = xb_add(&bar[XB_XSUB(b.x)], 1u);
        const unsigned gen = old / nloc;
        if (old + 1u == (gen + 1u) * nloc) {
            __builtin_amdgcn_fence(__ATOMIC_RELEASE, "agent");
            asm volatile("s_waitcnt vmcnt(0)" ::: "memory");
            const unsigned og = xb_add(&bar[XB_TOP], 1u);
            const unsigned tg = og / nx;
            if (og + 1u == (tg + 1u) * nx) xb_add(&bar[XB_TOPGEN], 1u);
            else XB_SPIN(xb_ld(&bar[XB_TOPGEN]) == tg, bar);
            __builtin_amdgcn_fence(__ATOMIC_ACQUIRE, "agent");
            xb_add(&bar[XB_XGEN(b.x)], 1u);
            asm volatile("s_waitcnt vmcnt(0)" ::: "memory");
        } else {
            XB_SPIN(xb_ld(&bar[XB_XGEN(b.x)]) == gen, bar);
            __builtin_amdgcn_fence(__ATOMIC_ACQUIRE, "agent");
            asm volatile("s_waitcnt vmcnt(0)" ::: "memory");
        }
    }
    __syncthreads();
}

__device__ __forceinline__ void p0_transpose_item(const float* W, int K, int N, bf16_t* WT, int drow0, int k0, int n0, LAS float* scr, int lane, const float* gain = nullptr) {
#pragma unroll 8
    for (int i = 0; i < 32; ++i) { const int kk = 2 * i + (lane >> 5); float v = W[(size_t)(k0 + kk) * N + n0 + (lane & 31)]; if (gain) v *= gain[k0 + kk]; scr[kk * 33 + (lane & 31)] = v; }
    LDS_WAIT(); asm volatile("" ::: "memory");
    const int c = lane & 7;
#pragma unroll
    for (int j = 0; j < 4; ++j) { const int n = (lane >> 3) + 8 * j; const LAS float* s = scr + (8 * c) * 33 + n;
        v4u o; o.x = pk2(s[0 * 33], s[1 * 33]); o.y = pk2(s[2 * 33], s[3 * 33]); o.z = pk2(s[4 * 33], s[5 * 33]); o.w = pk2(s[6 * 33], s[7 * 33]);
        *(v4u*)(WT + (size_t)(drow0 + n) * K + k0 + 8 * c) = o; }
    LDS_WAIT(); asm volatile("" ::: "memory");
}
__device__ __forceinline__ void p0_plain(const float* W, int K, int N, bf16_t* WT, int item, LAS float* scr, int lane, const float* gain = nullptr) {
    const int nblk = N / 32, kb = item / nblk, nb = item % nblk;
    p0_transpose_item(W, K, N, WT, 32 * nb, 64 * kb, 32 * nb, scr, lane, gain);
}
__device__ __forceinline__ void p0_transpose_rope(const float* W, bf16_t* WT, int tilebase, int o, int k0, int n0, LAS float* scr, int lane) {
    const int K = 1024, N = NIN;
#pragma unroll 8
    for (int i = 0; i < 32; ++i) { const int kk = 2 * i + (lane >> 5); scr[kk * 33 + (lane & 31)] = W[(size_t)(k0 + kk) * N + n0 + (lane & 31)]; }
    LDS_WAIT(); asm volatile("" ::: "memory");
    const int c = lane & 7;
#pragma unroll
    for (int j = 0; j < 4; ++j) { const int n = (lane >> 3) + 8 * j; const LAS float* s = scr + (8 * c) * 33 + n;
        const int oo = o + n, v = ((oo >> 6) << 6) | (((oo >> 4) & 1) << 5) | (((oo >> 2) & 3) << 3) | (((oo >> 5) & 1) << 2) | (oo & 3);
        v4u w; w.x = pk2(s[0 * 33], s[1 * 33]); w.y = pk2(s[2 * 33], s[3 * 33]); w.z = pk2(s[4 * 33], s[5 * 33]); w.w = pk2(s[6 * 33], s[7 * 33]);
        *(v4u*)(WT + (size_t)(tilebase + v) * K + k0 + 8 * c) = w; }
    LDS_WAIT(); asm volatile("" ::: "memory");
}
__device__ __forceinline__ void rms_row_to_bf16(const float* xrow, const float* g, bf16_t* orow, int lane) {
    const f32x4* xr = (const f32x4*)xrow + lane; const f32x4* gr = (const f32x4*)g + lane;
    f32x4 v[4]; float s = 0.f;
#pragma unroll
    for (int j = 0; j < 4; ++j) { v[j] = xr[64 * j]; s += (v[j].x * v[j].x + v[j].y * v[j].y) + (v[j].z * v[j].z + v[j].w * v[j].w); }
    const float rinv = 1.0f / sqrtf(wave_sum(s) * (1.f / 1024.f) + NORM_EPS);
    v2u* o8 = (v2u*)orow + lane;
#pragma unroll
    for (int j = 0; j < 4; ++j) { const f32x4 gg = gr[64 * j]; v2u w; w.x = pk2(v[j].x * rinv * gg.x, v[j].y * rinv * gg.y); w.y = pk2(v[j].z * rinv * gg.z, v[j].w * rinv * gg.w); o8[64 * j] = w; }
}

__device__ __forceinline__ void rms_row_to_fp8(const float* xrow, const float* g, unsigned char* orow, int lane) {
    const f32x4* xr = (const f32x4*)xrow + lane; const f32x4* gr = (const f32x4*)g + lane;
    f32x4 v[4]; float s = 0.f;
#pragma unroll
    for (int j = 0; j < 4; ++j) { v[j] = xr[64 * j]; s += (v[j].x * v[j].x + v[j].y * v[j].y) + (v[j].z * v[j].z + v[j].w * v[j].w); }
    const float rinv = 1.0f / sqrtf(wave_sum(s) * (1.f / 1024.f) + NORM_EPS);
    unsigned* o4 = (unsigned*)orow + lane;
#pragma unroll
    for (int j = 0; j < 4; ++j) { const f32x4 gg = gr[64 * j]; o4[64 * j] = pk4_fp8(v[j].x * rinv * gg.x, v[j].y * rinv * gg.y, v[j].z * rinv * gg.z, v[j].w * rinv * gg.w); }
}
template <int NB, class RowPtr, class Epi>
__device__ __forceinline__ void ngemm_tile(const RowPtr& rp, const bf16_t* Bt, int ldb, int b1off, int K, int m0, int n0, int mvalid, const Epi& epi, LAS float* sm) {
    const int t = threadIdx.x, r = t >> 2, kq = (t & 3) * 4, ty = t >> 5, tx = t & 31;
    LAS float* As = sm; LAS float* Bs0 = sm + 16 * 132; LAS float* Bs1 = sm + 32 * 132;
    float acc[NB][8][4];
#pragma unroll
    for (int b = 0; b < NB; ++b)
#pragma unroll
        for (int i = 0; i < 8; ++i)
#pragma unroll
            for (int j = 0; j < 4; ++j) acc[b][i][j] = 0.f;
    const bf16_t* arow = rp(m0 + r) + kq;
    const bf16_t* brow0 = Bt + (size_t)(n0 + r) * ldb + kq;
    const bf16_t* brow1 = Bt + (size_t)(n0 + b1off + r) * ldb + kq;
    for (int k0 = 0; k0 < K; k0 += 16) {
        const v2u av = *(const v2u*)(arow + k0);
        const v2u bv0 = *(const v2u*)(brow0 + k0);
        v2u bv1 = bv0; if (NB == 2) bv1 = *(const v2u*)(brow1 + k0);
        As[(kq + 0) * 132 + r] = lo16(av.x); As[(kq + 1) * 132 + r] = hi16(av.x); As[(kq + 2) * 132 + r] = lo16(av.y); As[(kq + 3) * 132 + r] = hi16(av.y);
        Bs0[(kq + 0) * 132 + r] = lo16(bv0.x); Bs0[(kq + 1) * 132 + r] = hi16(bv0.x); Bs0[(kq + 2) * 132 + r] = lo16(bv0.y); Bs0[(kq + 3) * 132 + r] = hi16(bv0.y);
        if (NB == 2) { Bs1[(kq + 0) * 132 + r] = lo16(bv1.x); Bs1[(kq + 1) * 132 + r] = hi16(bv1.x); Bs1[(kq + 2) * 132 + r] = lo16(bv1.y); Bs1[(kq + 3) * 132 + r] = hi16(bv1.y); }
        __syncthreads();
#pragma unroll 2
        for (int kk = 0; kk < 16; ++kk) {
            const f32x4 a0 = *(const LAS f32x4*)(As + kk * 132 + ty * 8), a1 = *(const LAS f32x4*)(As + kk * 132 + ty * 8 + 4);
            const f32x4 b0 = *(const LAS f32x4*)(Bs0 + kk * 132 + tx * 4);
            const float a[8] = {a0.x, a0.y, a0.z, a0.w, a1.x, a1.y, a1.z, a1.w};
#pragma unroll
            for (int i = 0; i < 8; ++i) { acc[0][i][0] += a[i] * b0.x; acc[0][i][1] += a[i] * b0.y; acc[0][i][2] += a[i] * b0.z; acc[0][i][3] += a[i] * b0.w; }
            if (NB == 2) { const f32x4 b1 = *(const LAS f32x4*)(Bs1 + kk * 132 + tx * 4);
#pragma unroll
                for (int i = 0; i < 8; ++i) { acc[NB - 1][i][0] += a[i] * b1.x; acc[NB - 1][i][1] += a[i] * b1.y; acc[NB - 1][i][2] += a[i] * b1.z; acc[NB - 1][i][3] += a[i] * b1.w; } }
        }
        __syncthreads();
    }
#pragma unroll
    for (int i = 0; i < 8; ++i) { const int m = m0 + ty * 8 + i;
        if (m < mvalid) {
#pragma unroll
            for (int j = 0; j < 4; ++j) epi(m, n0 + tx * 4 + j, acc[0][i][j], acc[NB - 1][i][j]); } }
}
struct RowPlain { const bf16_t* A; int lda; __device__ __forceinline__ const bf16_t* operator()(int m) const { return A + (size_t)m * lda; } };

template <class Epi>
__device__ __forceinline__ void ngemm_dense(const bf16_t* A, int lda, const bf16_t* Bt, int ldb, int Mr, int N, int K, const Epi& epi, LAS float* sm) {
    const int nn = N / 128, nunits = (Mr / 128) * nn; RowPlain rp{A, lda};
    for (int u = blockIdx.x; u < nunits; u += gridDim.x) ngemm_tile<1>(rp, Bt, ldb, 0, K, (u / nn) * 128, (u % nn) * 128, Mr, epi, sm);
}

struct EpiStoreBf16 { bf16_t* O; int ldc; __device__ __forceinline__ void operator()(int m, int n, float a, float) const { O[(size_t)m * ldc + n] = (bf16_t)f2bf(a); } };
struct EpiGate1 { const bf16_t* PR; float* T; __device__ __forceinline__ void operator()(int m, int n, float a, float) const { T[(size_t)m * D + n] = bf2f(PR[(size_t)m * NIN + C_GSB + n]) * a; } };
struct EpiGate2 { const bf16_t* PR; const float* T; bf16_t* MIX; __device__ __forceinline__ void operator()(int m, int n, float a, float) const {
    MIX[(size_t)m * D + n] = (bf16_t)f2bf(T[(size_t)m * D + n] + bf2f(PR[(size_t)m * NIN + C_GDF + n]) * a); } };
struct EpiResid { const float* base; float* out; __device__ __forceinline__ void operator()(int m, int n, float a, float) const { out[(size_t)m * D + n] = base[(size_t)m * D + n] + a; } };


namespace pg8 {
constexpr int BM = 256, BK = 64, HALF = 128, HTB = HALF * BK * 2, STAGE_BYTES = 8 * HTB;
__host__ __device__ __forceinline__ int lds_byte(int r, int c) { const int st = (r >> 4) * 2 + (c >> 5), rr = r & 15, cc = c & 31, ob = rr * 64 + cc * 2; return st * 1024 + (ob ^ (((ob >> 9) & 1) << 5)); }
__host__ __device__ __forceinline__ void stage_rc(int b, int& R, int& C) { const int st = b / 1024, sb = b % 1024, swz = sb ^ (((sb >> 9) & 1) << 5); R = (st >> 1) * 16 + swz / 64; C = (st & 1) * 32 + (swz % 64) / 2; }
__host__ __device__ __forceinline__ int perm32(int rho) { const int n = rho >> 4, i = rho & 15; return 8 * (i >> 2) + 4 * n + (i & 3); }
struct Unit { int pm, pn, e; };
struct Gemm { const bf16_t* A; const bf16_t* Bt; int lda, ldb, K; };
typedef float f32x2 __attribute__((ext_vector_type(2))); typedef __bf16 bf16x2_t __attribute__((ext_vector_type(2)));
__device__ __forceinline__ unsigned cvt_pk_bf16(float lo, float hi) { f32x2 v = {lo, hi}; bf16x2_t b = __builtin_convertvector(v, bf16x2_t); return __builtin_bit_cast(unsigned, b); }

typedef int v8i __attribute__((ext_vector_type(8))); typedef int v4i __attribute__((ext_vector_type(4)));
__device__ __forceinline__ v8i cat8(bf16x8 a, bf16x8 b) { return __builtin_shufflevector(__builtin_bit_cast(v4i, a), __builtin_bit_cast(v4i, b), 0, 1, 2, 3, 4, 5, 6, 7); }
template <class Epi, class Sched, bool GATHER, bool FP8 = false>
__device__ __forceinline__ void gemm_phase(LAS unsigned char* lds, const Gemm g, const Sched& S, const Epi& E) {
    const int tid = threadIdx.x, wid = __builtin_amdgcn_readfirstlane(tid >> 6), lane = tid & 63, wr = wid >> 2, wc = wid & 3, fr = lane & 15, fq = lane >> 4;
    const int K = g.K, nt = K / BK;
    unsigned voffB[2], cva[2][2], nva[2][2];
#pragma unroll
    for (int i = 0; i < 2; ++i) { int R, C; stage_rc(tid * 16 + i * 8192, R, C); const int Rb = (R & ~31) + perm32(R & 31);
        voffB[i] = (unsigned)(Rb * g.ldb + C) * 2u;
#pragma unroll
        for (int h = 0; h < 2; ++h) { cva[h][i] = (unsigned)((h * HALF + R) * g.lda + C) * 2u; nva[h][i] = cva[h][i]; } }
    const unsigned kstep = (unsigned)(BK * 2);
    const unsigned hstepB = (unsigned)(HALF * g.ldb * 2);
    auto uni_ptr = [](const void* p_) { const unsigned long long v_ = (unsigned long long)p_; return (void*)(((unsigned long long)(unsigned)__builtin_amdgcn_readfirstlane((int)(v_ >> 32)) << 32) | (unsigned)__builtin_amdgcn_readfirstlane((int)v_)); };
    const auto rA = __builtin_amdgcn_make_buffer_rsrc(uni_ptr(g.A), 0, 0x7fffffff, 0x00020000), rB = __builtin_amdgcn_make_buffer_rsrc(uni_ptr(g.Bt), 0, 0x7fffffff, 0x00020000);
    const unsigned ldsw = (unsigned)wid * 1024u;
    const int aoff = lds_byte(wr * 64 + fr, fq * 8), boff = lds_byte(wc * 32 + fr, fq * 8);
#define PG8_SA(b, h) (((b) * 2 + (h)) * HTB)
#define PG8_SB(b, h) ((4 + (b) * 2 + (h)) * HTB)
#define PG8_STAGE(bufoff, rs, soff, voff) do { _Pragma("unroll") for (int _i = 0; _i < 2; ++_i) \
        __builtin_amdgcn_raw_ptr_buffer_load_lds(rs, (LAS unsigned*)(lds + (bufoff) + ldsw + _i * 8192), 16, (int)(voff)[_i], (int)(soff), 0, 0); } while (0)
#define PG8_LDA(dst, b, h) do { _Pragma("unroll") for (int m = 0; m < 4; ++m) _Pragma("unroll") for (int k = 0; k < 2; ++k) dst[m][k] = *(const LAS bf16x8*)(lds + PG8_SA(b, h) + aoff + m * 2048 + k * 1024); } while (0)
#define PG8_LDB(dst, b, h) do { _Pragma("unroll") for (int n = 0; n < 2; ++n) _Pragma("unroll") for (int k = 0; k < 2; ++k) dst[n][k] = *(const LAS bf16x8*)(lds + PG8_SB(b, h) + boff + n * 2048 + k * 1024); } while (0)
#define PG8_MMA(ai, bj, At, Bt) do { __builtin_amdgcn_s_setprio(1); _Pragma("unroll") for (int m = 0; m < 4; ++m) _Pragma("unroll") for (int n = 0; n < 2; ++n) { \
        if constexpr (FP8) { const v8i b8_ = cat8(Bt[n][0], Bt[n][1]), a8_ = cat8(At[m][0], At[m][1]); \
            asm volatile("s_nop 1\n\tv_mfma_scale_f32_16x16x128_f8f6f4 %0, %1, %2, %0, %3, %3 op_sel_hi:[0,0,0]" : "+v"(acc[ai][bj][m][n]) : "v"(b8_), "v"(a8_), "v"(one_scale)); } \
        else { _Pragma("unroll") for (int k = 0; k < 2; ++k) acc[ai][bj][m][n] = __builtin_amdgcn_mfma_f32_16x16x32_bf16(Bt[n][k], At[m][k], acc[ai][bj][m][n], 0, 0, 0); } } __builtin_amdgcn_s_setprio(0); } while (0)
#define PG8_WAIT_V(n) asm volatile("s_waitcnt vmcnt(" #n ")" ::: "memory")
#define PG8_WAIT_L(n) asm volatile("s_waitcnt lgkmcnt(" #n ")" ::: "memory")
#define PG8_BAR __builtin_amdgcn_s_barrier()
#define PG8_SCHED __builtin_amdgcn_sched_barrier(0)
    Unit cur, nxt; int ui = 0;
    if (!S.next(0, cur)) return;
    if constexpr (GATHER) {
#pragma unroll
        for (int i = 0; i < 2; ++i) { int R, C; stage_rc(tid * 16 + i * 8192, R, C);
#pragma unroll
            for (int h = 0; h < 2; ++h) cva[h][i] = (unsigned)(S.tok(cur, h * HALF + R) * g.lda + C) * 2u; }
    }
    const int one_scale = 0x7f7f7f7f;
    (void)one_scale;
    f32x4 acc[2][2][4][2];
#pragma unroll
    for (int a = 0; a < 2; ++a)
#pragma unroll
        for (int b = 0; b < 2; ++b)
#pragma unroll
            for (int m = 0; m < 4; ++m)
#pragma unroll
                for (int n = 0; n < 2; ++n) acc[a][b][m][n] = (f32x4){0.f, 0.f, 0.f, 0.f};
    bf16x8 At[4][2], B0[2][2], B1[2][2];
    unsigned cA = GATHER ? 0u : (unsigned)S.a_off(cur), cB = (unsigned)S.b_off(cur);
    PG8_STAGE(PG8_SB(0, 0), rB, cB, voffB); PG8_STAGE(PG8_SB(0, 1), rB, cB + hstepB, voffB); PG8_STAGE(PG8_SA(0, 0), rA, cA, cva[0]); PG8_STAGE(PG8_SA(0, 1), rA, cA, cva[1]);
    if (wr == 1) PG8_BAR;
    PG8_WAIT_V(2); PG8_BAR;
    PG8_STAGE(PG8_SB(1, 0), rB, cB + kstep, voffB); PG8_STAGE(PG8_SA(1, 0), rA, cA + kstep, cva[0]); PG8_STAGE(PG8_SB(1, 1), rB, cB + hstepB + kstep, voffB);
    PG8_WAIT_V(6); PG8_BAR;
    for (;;) {
        const bool has_next = S.next(ui + 1, nxt);
        const unsigned nA = (has_next && !GATHER) ? (unsigned)S.a_off(nxt) : cA, nB = has_next ? (unsigned)S.b_off(nxt) : cB;
        if constexpr (GATHER) {
#pragma unroll
            for (int i = 0; i < 2; ++i) { int R, C; stage_rc(tid * 16 + i * 8192, R, C);
#pragma unroll
                for (int h = 0; h < 2; ++h) nva[h][i] = has_next ? (unsigned)(S.tok(nxt, h * HALF + R) * g.lda + C) * 2u : cva[h][i]; }
        }
#pragma nounroll
        for (int t = 0; t < nt; t += 2) {
            const bool last = (t == nt - 2);
            const unsigned a1 = cA + (unsigned)(t + 1) * kstep;
            const unsigned a2 = last ? nA : cA + (unsigned)(t + 2) * kstep, b2 = last ? nB : cB + (unsigned)(t + 2) * kstep;
            const unsigned a3 = a2 + kstep, b3 = b2 + kstep;
            PG8_LDB(B0, 0, 0); PG8_LDB(B1, 0, 1); PG8_SCHED; PG8_LDA(At, 0, 0); PG8_STAGE(PG8_SA(1, 1), rA, a1, cva[1]);
            if constexpr (GATHER) { if (last) {
#pragma unroll
                for (int h = 0; h < 2; ++h)
#pragma unroll
                    for (int i = 0; i < 2; ++i) cva[h][i] = nva[h][i]; } }
            PG8_WAIT_V(8); PG8_WAIT_L(0); PG8_BAR; PG8_MMA(0, 0, At, B0); PG8_MMA(0, 1, At, B1); PG8_BAR; PG8_SCHED;
            PG8_LDA(At, 0, 1); PG8_STAGE(PG8_SB(0, 0), rB, b2, voffB); PG8_STAGE(PG8_SB(0, 1), rB, b2 + hstepB, voffB); PG8_STAGE(PG8_SA(0, 0), rA, a2, cva[0]);
            PG8_WAIT_V(8); PG8_WAIT_L(0); PG8_BAR; PG8_MMA(1, 0, At, B0); PG8_MMA(1, 1, At, B1); PG8_BAR; PG8_SCHED;
            PG8_LDB(B0, 1, 0); PG8_LDB(B1, 1, 1); PG8_SCHED; PG8_LDA(At, 1, 0); PG8_STAGE(PG8_SA(0, 1), rA, a2, cva[1]);
            PG8_WAIT_V(8); PG8_WAIT_L(0); PG8_BAR; PG8_MMA(0, 0, At, B0); PG8_MMA(0, 1, At, B1); PG8_BAR; PG8_SCHED;
            PG8_LDA(At, 1, 1); PG8_STAGE(PG8_SB(1, 0), rB, b3, voffB); PG8_STAGE(PG8_SB(1, 1), rB, b3 + hstepB, voffB); PG8_STAGE(PG8_SA(1, 0), rA, a3, cva[0]);
            PG8_WAIT_V(8); PG8_WAIT_L(0); PG8_BAR; PG8_MMA(1, 0, At, B0); PG8_MMA(1, 1, At, B1); PG8_BAR; PG8_SCHED;
        }
        if (wr == 0) PG8_BAR;
        if constexpr (FP8) asm volatile("s_nop 15\n\ts_nop 7" ::: "memory");
        E(acc, cur, wr, wc, fr, fq);
        if (!has_next) break;
#pragma unroll
        for (int a = 0; a < 2; ++a)
#pragma unroll
            for (int b = 0; b < 2; ++b)
#pragma unroll
                for (int m = 0; m < 4; ++m)
#pragma unroll
                    for (int n = 0; n < 2; ++n) acc[a][b][m][n] = (f32x4){0.f, 0.f, 0.f, 0.f};
        cur = nxt; cA = nA; cB = nB; ++ui;
        if constexpr (GATHER) {
#pragma unroll
            for (int i = 0; i < 2; ++i)
#pragma unroll
                for (int h = 0; h < 2; ++h) cva[h][i] = nva[h][i];
        }
        if (wr == 1) PG8_BAR;
    }
    PG8_WAIT_V(0);
    PG8_BAR;
#undef PG8_SA
#undef PG8_SB
#undef PG8_STAGE
#undef PG8_LDA
#undef PG8_LDB
#undef PG8_MMA
#undef PG8_WAIT_V
#undef PG8_WAIT_L
#undef PG8_BAR
#undef PG8_SCHED
}

struct DenseOrder {
    int nM, nN, nwg, G, c, lda, ldb, i0 = 0, i1 = 1 << 30;
    __device__ __forceinline__ void init(int M_, int N_, int G_, int c_, int lda_, int ldb_) { nM = M_ / BM; nN = N_ / BM; nwg = nM * nN; G = G_; c = c_; lda = lda_; ldb = ldb_; }
    __device__ __forceinline__ bool next(int i, Unit& u) const {
        if (i + i0 >= i1) return false;
        const long L = (long)(i + i0) * G + c; if (L >= nwg) return false;
        int wgid = (int)L; { const int q = nwg / 8, r = nwg % 8, xcd = wgid % 8, off = wgid / 8; wgid = (xcd < r ? xcd * (q + 1) : r * (q + 1) + (xcd - r) * q) + off; }
        const int nig = 8 * nN, gid = wgid / nig, fm = gid * 8, gsz = (nM - fm) < 8 ? (nM - fm) : 8;
        u.pm = fm + ((wgid % nig) % gsz); u.pn = (wgid % nig) / gsz; u.e = 0; return true;
    }
    __device__ __forceinline__ size_t a_off(const Unit& u) const { return (size_t)u.pm * BM * lda * 2; }
    __device__ __forceinline__ size_t b_off(const Unit& u) const { return (size_t)u.pn * BM * ldb * 2; }
    __device__ __forceinline__ int tok(const Unit&, int) const { return 0; }
};
struct TwoRoundOrder {
    int G, c, lda, ldb;
    __device__ __forceinline__ bool next(int i, Unit& u) const { const int L = i * G + c; if (L >= 512) return false; const int tile = L & 255; u.pm = tile >> 2; u.pn = tile & 3; u.e = L >> 8; return true; }
    __device__ __forceinline__ size_t a_off(const Unit& u) const { return (size_t)u.pm * BM * lda * 2 + (size_t)u.e * 1024; }
    __device__ __forceinline__ size_t b_off(const Unit& u) const { return (size_t)(u.e * 1024 + u.pn * BM) * ldb * 2; }
    __device__ __forceinline__ int tok(const Unit&, int) const { return 0; }
};
struct MoeOrder {
    const LAS int* tb; const int* tlist; int G, c, npn, lda, ldb, nexp;
    __device__ __forceinline__ bool next(int i, Unit& u) const {
        const int L = i * G + c; if (L >= tb[96]) return false;
        int e = 0; while (tb[65 + e] <= L) ++e;
        const int loc = L - tb[64 + e]; u.e = __builtin_amdgcn_readfirstlane(e); u.pn = __builtin_amdgcn_readfirstlane(loc % npn); u.pm = __builtin_amdgcn_readfirstlane((tb[e] >> 8) + loc / npn); return true;
    }
    __device__ __forceinline__ size_t a_off(const Unit& u) const { return (size_t)u.pm * BM * lda * 2; }
    __device__ __forceinline__ size_t b_off(const Unit& u) const { return (size_t)(u.e * nexp + u.pn * BM) * ldb * 2; }
    __device__ __forceinline__ int tok(const Unit& u, int row) const { const int r = u.pm * BM - tb[u.e] + row; return r < tb[32 + u.e] ? tlist[u.e * LISTCAP + r] : 0; }
};

#define EPI_ARGS const f32x4 (&acc)[2][2][4][2], const Unit& u, int wr, int wc, int fr, int fq
#define EPI_FOR_ROWS for (int ai = 0; ai < 2; ++ai) _Pragma("unroll") for (int m = 0; m < 4; ++m)
__device__ __forceinline__ v4u pack8(const f32x4 a, const f32x4 b) { v4u w; w.x = cvt_pk_bf16(a[0], a[1]); w.y = cvt_pk_bf16(a[2], a[3]); w.z = cvt_pk_bf16(b[0], b[1]); w.w = cvt_pk_bf16(b[2], b[3]); return w; }
__device__ __forceinline__ void unpack8(const v4u w, f32x4& a, f32x4& b) { a = (f32x4){lo16(w.x), hi16(w.x), lo16(w.y), hi16(w.y)}; b = (f32x4){lo16(w.z), hi16(w.z), lo16(w.w), hi16(w.w)}; }
__device__ __forceinline__ float sigm(float v) { return __builtin_amdgcn_rcpf(1.f + __expf(-v)); }

__device__ __forceinline__ void store_tile_T(const f32x4 (&acc)[2][2][4][2], bf16_t* VT, int vrow0, int s0, int pitch) {
#pragma unroll
    for (int bj = 0; bj < 2; ++bj)
#pragma unroll
        for (int n = 0; n < 2; ++n)
#pragma unroll
            for (int e = 0; e < 4; ++e) { bf16_t* vp = VT + (size_t)(vrow0 + 128 * bj + 4 * n + e) * pitch + s0;
#pragma unroll
                for (int ai = 0; ai < 2; ++ai)
#pragma unroll
                    for (int m = 0; m < 4; ++m) vp[128 * ai + 16 * m] = (bf16_t)(cvt_pk_bf16(acc[ai][bj][m][n][e], 0.f) & 0xffffu); }
}
struct EpiKV { bf16_t* KVM; bf16_t* VTM;
    __device__ __forceinline__ void operator()(EPI_ARGS) const {
        const int row0 = u.pm * BM + wr * 64 + fr, col0 = u.pn * BM + wc * 32 + 8 * fq;
#pragma unroll
        EPI_FOR_ROWS { bf16_t* rowp = KVM + (size_t)(row0 + ai * HALF + m * 16) * 2048 + col0;
#pragma unroll
            for (int bj = 0; bj < 2; ++bj) *(v4u*)(rowp + bj * HALF) = pack8(acc[ai][bj][m][0], acc[ai][bj][m][1]); }
        if (u.pn >= 4) store_tile_T(acc, VTM, u.pm * 1024 + (u.pn - 4) * BM + wc * 32 + 8 * fq, wr * 64 + fr, MEMLEN);
    } };
struct EpiBf16Store { bf16_t* O; int ldc;
    __device__ __forceinline__ void operator()(EPI_ARGS) const {
        const int row0 = u.pm * BM + wr * 64 + fr, col0 = u.pn * BM + wc * 32 + 8 * fq;
#pragma unroll
        EPI_FOR_ROWS { bf16_t* rowp = O + (size_t)(row0 + ai * HALF + m * 16) * ldc + col0;
#pragma unroll
            for (int bj = 0; bj < 2; ++bj) *(v4u*)(rowp + bj * HALF) = pack8(acc[ai][bj][m][0], acc[ai][bj][m][1]); }
    } };
struct EpiResidF32 { const float* base; float* out;
    __device__ __forceinline__ void operator()(EPI_ARGS) const {
        const int row0 = u.pm * BM + wr * 64 + fr, col0 = u.pn * BM + wc * 32 + 8 * fq;
#pragma unroll
        EPI_FOR_ROWS { const size_t off = (size_t)(row0 + ai * HALF + m * 16) * D + col0;
#pragma unroll
            for (int bj = 0; bj < 2; ++bj)
#pragma unroll
                for (int n = 0; n < 2; ++n) { const f32x4 b = *(const f32x4*)(base + off + bj * HALF + 4 * n); *(f32x4*)(out + off + bj * HALF + 4 * n) = b + acc[ai][bj][m][n]; } }
    } };
struct EpiResidNorm { const float* base; float* out; bf16_t* XB; float* SSQ;
    __device__ __forceinline__ void operator()(EPI_ARGS) const {
        const int row0 = u.pm * BM + wr * 64 + fr, col0 = u.pn * BM + wc * 32 + 8 * fq;
#pragma unroll
        EPI_FOR_ROWS { const int row = row0 + ai * HALF + m * 16; const size_t off = (size_t)row * D + col0; float ss = 0.f;
#pragma unroll
            for (int bj = 0; bj < 2; ++bj) { f32x4 v[2];
#pragma unroll
                for (int n = 0; n < 2; ++n) { v[n] = *(const f32x4*)(base + off + bj * HALF + 4 * n) + acc[ai][bj][m][n]; *(f32x4*)(out + off + bj * HALF + 4 * n) = v[n];
                    ss += (v[n][0] * v[n][0] + v[n][1] * v[n][1]) + (v[n][2] * v[n][2] + v[n][3] * v[n][3]); }
                *(v4u*)(XB + off + bj * HALF) = pack8(v[0], v[1]); }
            ss += __shfl_xor(ss, 16); ss += __shfl_xor(ss, 32);
            if (fq == 0) SSQ[(size_t)row * 16 + u.pn * 4 + wc] = ss; }
    } };
struct EpiBf16Rinv { bf16_t* O; const float* SSQ; float qscale;
    __device__ __forceinline__ void operator()(EPI_ARGS) const {
        const int row0 = u.pm * BM + wr * 64 + fr, col0 = u.pn * BM + wc * 32 + 8 * fq;
#pragma unroll
        EPI_FOR_ROWS { const int row = row0 + ai * HALF + m * 16; const f32x4* sp = (const f32x4*)(SSQ + (size_t)row * 16);
            const f32x4 s0 = sp[0], s1 = sp[1], s2 = sp[2], s3 = sp[3];
            const float tot = (((s0[0] + s0[1]) + (s0[2] + s0[3])) + ((s1[0] + s1[1]) + (s1[2] + s1[3]))) + (((s2[0] + s2[1]) + (s2[2] + s2[3])) + ((s3[0] + s3[1]) + (s3[2] + s3[3])));
            const float rinv = qscale / sqrtf(tot * (1.f / 1024.f) + NORM_EPS);
            bf16_t* rowp = O + (size_t)row * D + col0;
#pragma unroll
            for (int bj = 0; bj < 2; ++bj) *(v4u*)(rowp + bj * HALF) = pack8(acc[ai][bj][m][0] * rinv, acc[ai][bj][m][1] * rinv); }
    } };
struct OneUnitOrder {
    int idx, lda, ldb;
    __device__ __forceinline__ bool next(int i, Unit& u) const { if (i > 0) return false; u.pm = idx >> 3; u.pn = idx & 7; u.e = 0; return true; }
    __device__ __forceinline__ size_t a_off(const Unit& u) const { return (size_t)u.pm * BM * lda * 2; }
    __device__ __forceinline__ size_t b_off(const Unit& u) const { return (size_t)u.pn * BM * ldb * 2; }
    __device__ __forceinline__ int tok(const Unit&, int) const { return 0; }
};
struct EpiGate { const bf16_t* PR; float* T; bf16_t* MIX;
    __device__ __forceinline__ void operator()(EPI_ARGS) const {
        const int row0 = u.pm * BM + wr * 64 + fr, col0 = u.pn * BM + wc * 32 + 8 * fq;
#pragma unroll
        EPI_FOR_ROWS { const int row = row0 + ai * HALF + m * 16;
#pragma unroll
            for (int bj = 0; bj < 2; ++bj) { const int col = col0 + bj * HALF; f32x4 g0, g1;
                unpack8(*(const v4u*)(PR + (size_t)row * NIN + (u.e ? C_GDF : C_GSB) + col), g0, g1);
                float* tp = T + (size_t)row * D + col;
                if (u.e == 0) { *(f32x4*)tp = g0 * acc[ai][bj][m][0]; *(f32x4*)(tp + 4) = g1 * acc[ai][bj][m][1]; }
                else { const f32x4 t0 = *(const f32x4*)tp, t1 = *(const f32x4*)(tp + 4); *(v4u*)(MIX + (size_t)row * D + col) = pack8(t0 + g0 * acc[ai][bj][m][0], t1 + g1 * acc[ai][bj][m][1]); } } }
    } };
struct EpiInProj { bf16_t* PR; const float* rc; const float* rs; bf16_t* VTSB; bf16_t* VTDF;
    __device__ __forceinline__ void operator()(EPI_ARGS) const {
        const int row0 = u.pm * BM + wr * 64 + fr, pn = u.pn;
        if (pn >= 6 && pn < 10) {
            const float sc = pn < 8 ? 0.125f * 1.4426950408889634f : 1.0f; const int i0 = 16 * (wc & 1) + 4 * fq;
#pragma unroll
            EPI_FOR_ROWS { const int row = row0 + ai * HALF + m * 16; const f32x4 cs = *(const f32x4*)(rc + (size_t)row * 32 + i0), sn = *(const f32x4*)(rs + (size_t)row * 32 + i0);
#pragma unroll
                for (int bj = 0; bj < 2; ++bj) { const f32x4 lo = acc[ai][bj][m][0], hi = acc[ai][bj][m][1];
                    const f32x4 olo = (lo * cs - hi * sn) * sc, ohi = (hi * cs + lo * sn) * sc;
                    bf16_t* p = PR + (size_t)row * NIN + pn * BM + 64 * (2 * bj + (wc >> 1)) + i0;
                    v2u a, b; a.x = cvt_pk_bf16(olo[0], olo[1]); a.y = cvt_pk_bf16(olo[2], olo[3]); b.x = cvt_pk_bf16(ohi[0], ohi[1]); b.y = cvt_pk_bf16(ohi[2], ohi[3]);
                    *(v2u*)p = a; *(v2u*)(p + 32) = b; } }
        } else {
            const int col0 = pn * BM + wc * 32 + 8 * fq; const float sc = pn < 2 ? 0.125f * 1.4426950408889634f : 1.0f; const bool sg = pn >= 12;
#pragma unroll
            EPI_FOR_ROWS { bf16_t* rowp = PR + (size_t)(row0 + ai * HALF + m * 16) * NIN + col0;
#pragma unroll
                for (int bj = 0; bj < 2; ++bj) { f32x4 v0 = acc[ai][bj][m][0] * sc, v1 = acc[ai][bj][m][1] * sc;
                    if (sg) { v0 = (f32x4){sigm(v0[0]), sigm(v0[1]), sigm(v0[2]), sigm(v0[3])}; v1 = (f32x4){sigm(v1[0]), sigm(v1[1]), sigm(v1[2]), sigm(v1[3])}; }
                    *(v4u*)(rowp + bj * HALF) = pack8(v0, v1); } }
            if (pn == 4 || pn == 5 || pn == 10 || pn == 11) {
                const int bb = u.pm >> 4, s0 = (u.pm & 15) * BM + wr * 64 + fr, hd0 = (pn < 6 ? (pn - 4) : (pn - 10)) * BM + wc * 32 + 8 * fq;
                store_tile_T(acc, pn < 6 ? VTSB : VTDF, bb * 512 + hd0, s0, SEQ);
            }
        }
    } };
struct EpiMoeGU { unsigned char* ACT8; const float* bgu; const float* wsc;
    __device__ __forceinline__ void operator()(EPI_ARGS) const {
        const int row0 = u.pm * BM + wr * 64 + fr, j0 = u.pn * 128 + wc * 32 + 8 * fq; const float* bg = bgu + (size_t)u.e * 2048 + j0; const float* sg = wsc + (size_t)u.e * 2048 + j0;
#pragma unroll
        EPI_FOR_ROWS { f32x4 o[2];
#pragma unroll
            for (int n = 0; n < 2; ++n) { const f32x4 gv = acc[ai][0][m][n] * *(const f32x4*)(sg + 4 * n) + *(const f32x4*)(bg + 4 * n), lv = acc[ai][1][m][n] * *(const f32x4*)(sg + 1024 + 4 * n) + *(const f32x4*)(bg + 1024 + 4 * n);
#pragma unroll
                for (int c = 0; c < 4; ++c) { const float gl = fminf(gv[c], 7.0f), li = fminf(fmaxf(lv[c], -7.0f), 7.0f); o[n][c] = gl * sigm(1.702f * gl) * (li + 1.0f); } }
            v2u w; w.x = pk4_fp8(o[0][0], o[0][1], o[0][2], o[0][3]); w.y = pk4_fp8(o[1][0], o[1][1], o[1][2], o[1][3]);
            *(v2u*)(ACT8 + (size_t)(row0 + ai * HALF + m * 16) * DFF + j0) = w; }
    } };
struct EpiMoeDown { bf16_t* YB; const float* bd; const float* glist; const LAS int* tb; const float* wsc;
    __device__ __forceinline__ void operator()(EPI_ARGS) const {
        const int row0 = u.pm * BM + wr * 64 + fr, col0 = u.pn * BM + wc * 32 + 8 * fq; const float* bp = bd + (size_t)u.e * D + col0; const float* sp = wsc + (size_t)u.e * D + col0;
        const float* gl = glist + (size_t)u.e * LISTCAP - tb[u.e];
        f32x4 bv[2][2], sv[2][2];
#pragma unroll
        for (int bj = 0; bj < 2; ++bj)
#pragma unroll
            for (int n = 0; n < 2; ++n) { bv[bj][n] = *(const f32x4*)(bp + bj * HALF + 4 * n); sv[bj][n] = *(const f32x4*)(sp + bj * HALF + 4 * n); }
#pragma unroll
        EPI_FOR_ROWS { const int row = row0 + ai * HALF + m * 16; const float gt = gl[row];
#pragma unroll
            for (int bj = 0; bj < 2; ++bj) *(v4u*)(YB + (size_t)row * D + col0 + bj * HALF) = pack8((acc[ai][bj][m][0] * sv[bj][0] + bv[bj][0]) * gt, (acc[ai][bj][m][1] * sv[bj][1] + bv[bj][1]) * gt); }
    } };
}


typedef float f32x16 __attribute__((ext_vector_type(16)));
typedef short s16x4 __attribute__((ext_vector_type(4)));
__device__ __forceinline__ f32x16 mfma32(bf16x8 a, bf16x8 b, f32x16 c) { return __builtin_amdgcn_mfma_f32_32x32x16_bf16(a, b, c, 0, 0, 0); }
__device__ __forceinline__ float xhalf(float v, int hh) { auto rr = __builtin_amdgcn_permlane32_swap(__float_as_uint(v), __float_as_uint(v), false, false); return __uint_as_float(hh ? rr[0] : rr[1]); }
__device__ __forceinline__ bf16x8 vt_frag(const bf16_t* p) { const s16x4 lo = *(const s16x4*)p, hi = *(const s16x4*)(p + 8); return (bf16x8){lo[0], lo[1], lo[2], lo[3], hi[0], hi[1], hi[2], hi[3]}; }
__device__ __forceinline__ bf16x8 pack_p(const f32x16& p, int s) { v4u w; w.x = pg8::cvt_pk_bf16(p[8 * s + 0], p[8 * s + 1]); w.y = pg8::cvt_pk_bf16(p[8 * s + 2], p[8 * s + 3]); w.z = pg8::cvt_pk_bf16(p[8 * s + 4], p[8 * s + 5]); w.w = pg8::cvt_pk_bf16(p[8 * s + 6], p[8 * s + 7]); return __builtin_bit_cast(bf16x8, w); }
constexpr float LOG2E = 1.4426950408889634f;

template <int NO>
__device__ __forceinline__ void softmax_step(f32x16& S, float C, float& m, float& l, f32x16 (&O)[NO], int hh) {
    float mx = fmaxf(fmaxf(S[0], S[1]), fmaxf(S[2], S[3]));
#pragma unroll
    for (int i = 4; i < 16; i += 4) mx = fmaxf(mx, fmaxf(fmaxf(S[i], S[i + 1]), fmaxf(S[i + 2], S[i + 3])));
    mx = fmaxf(mx, xhalf(mx, hh)) * C;
    const float mn = fmaxf(m, mx), al = __builtin_amdgcn_exp2f(m - mn);
    m = mn; l *= al;
#pragma unroll
    for (int o = 0; o < NO; ++o) O[o] = O[o] * al;
    float ps = 0.f;
#pragma unroll
    for (int i = 0; i < 16; ++i) { S[i] = __builtin_amdgcn_exp2f(S[i] * C - mn); ps += S[i]; }
    l += ps;
}

__device__ __forceinline__ void attn_diff_wave(const bf16_t* PR, const bf16_t* VT, float* ODR, int b, int h, int j, int q0, int lane) {
    const int r32 = lane & 31, hh = lane >> 5;
    const bf16_t* qrow = PR + (size_t)(b * SEQ + q0 + r32) * NIN + C_DQ + h * 128 + j * 64 + 8 * hh;
    bf16x8 qf[4];
#pragma unroll
    for (int d0 = 0; d0 < 4; ++d0) qf[d0] = *(const bf16x8*)(qrow + 16 * d0);
    const bf16_t* kbase = PR + (size_t)(b * SEQ + r32) * NIN + C_DK + h * 128 + j * 64 + 8 * hh;
    const bf16_t* vbase = VT + (size_t)(b * 512 + h * 128 + r32) * SEQ + 4 * hh;
    f32x16 O[4];
#pragma unroll
    for (int o = 0; o < 4; ++o)
#pragma unroll
        for (int i = 0; i < 16; ++i) O[o][i] = 0.f;
    float m = -INFINITY, l = 0.f;
    const int nt = 2 * (q0 / 64 + 1);
    for (int t = 0; t < nt; ++t) {
        const bf16_t* kp = kbase + (size_t)(32 * t) * NIN;
        f32x16 S;
#pragma unroll
        for (int i = 0; i < 16; ++i) S[i] = 0.f;
#pragma unroll
        for (int d0 = 0; d0 < 4; ++d0) S = mfma32(*(const bf16x8*)(kp + 16 * d0), qf[d0], S);
        softmax_step<4>(S, LOG2E, m, l, O, hh);
        const bf16x8 p0 = pack_p(S, 0), p1 = pack_p(S, 1);
        const bf16_t* vp = vbase + 32 * t;
#pragma unroll
        for (int o = 0; o < 4; ++o) { O[o] = mfma32(vt_frag(vp + (size_t)(32 * o) * SEQ), p0, O[o]); O[o] = mfma32(vt_frag(vp + (size_t)(32 * o) * SEQ + 16), p1, O[o]); }
    }
    l += xhalf(l, hh);
    const float il = 1.f / l;
    float* orow = ODR + ((size_t)j * M + (size_t)b * SEQ + q0 + r32) * 512 + h * 128 + 4 * hh;
#pragma unroll
    for (int o = 0; o < 4; ++o)
#pragma unroll
        for (int g = 0; g < 4; ++g) *(f32x4*)(orow + 32 * o + 8 * g) = (f32x4){O[o][4 * g] * il, O[o][4 * g + 1] * il, O[o][4 * g + 2] * il, O[o][4 * g + 3] * il};
}

__device__ __forceinline__ void attn_sb_wave(const bf16_t* PR, const bf16_t* VT, bf16_t* OAT, int b, int h, int q0, int lane) {
    const int r32 = lane & 31, hh = lane >> 5;
    const bf16_t* qrow = PR + (size_t)(b * SEQ + q0 + r32) * NIN + C_SBQ + h * 64 + 8 * hh;
    bf16x8 qf[4];
#pragma unroll
    for (int d0 = 0; d0 < 4; ++d0) qf[d0] = *(const bf16x8*)(qrow + 16 * d0);
    const bf16_t* kbase = PR + (size_t)(b * SEQ + r32) * NIN + C_SBK + h * 64 + 8 * hh;
    const bf16_t* vbase = VT + (size_t)(b * 512 + h * 64 + r32) * SEQ + 4 * hh;
    f32x16 O[2];
#pragma unroll
    for (int o = 0; o < 2; ++o)
#pragma unroll
        for (int i = 0; i < 16; ++i) O[o][i] = 0.f;
    float R = 0.f;
    const int td = q0 >> 5;
    for (int t = td; t >= 0; --t) {
        const bf16_t* kp = kbase + (size_t)(32 * t) * NIN;
        f32x16 S;
#pragma unroll
        for (int i = 0; i < 16; ++i) S[i] = 0.f;
#pragma unroll
        for (int d0 = 0; d0 < 4; ++d0) S = mfma32(*(const bf16x8*)(kp + 16 * d0), qf[d0], S);
        f32x16 lr;
#pragma unroll
        for (int i = 0; i < 16; ++i) { const float z2 = S[i] * LOG2E; const float sp = fmaxf(z2, 0.f) + __builtin_amdgcn_logf(1.f + __builtin_amdgcn_exp2f(-fabsf(z2)));
            lr[i] = -sp; S[i] = z2 - sp; }
        if (t == td) {
#pragma unroll
            for (int i = 0; i < 16; ++i) { const int kvl = (i & 3) + 8 * (i >> 2) + 4 * hh; if (kvl >= r32) { lr[i] = 0.f; S[i] = -INFINITY; } }
        }
        float tot[4], pt[4], off[4];
        f32x16 ex;
#pragma unroll
        for (int g = 0; g < 4; ++g) { ex[4 * g + 3] = 0.f; ex[4 * g + 2] = lr[4 * g + 3]; ex[4 * g + 1] = lr[4 * g + 3] + lr[4 * g + 2]; ex[4 * g] = ex[4 * g + 1] + lr[4 * g + 1]; tot[g] = ex[4 * g] + lr[4 * g]; }
#pragma unroll
        for (int g = 0; g < 4; ++g) pt[g] = xhalf(tot[g], hh);
        const float own0 = hh ? 0.f : 1.f;
        float sp_ = 0.f;
#pragma unroll
        for (int g = 3; g >= 0; --g) { off[g] = sp_ + own0 * pt[g] + R; sp_ += tot[g] + pt[g]; }
#pragma unroll
        for (int i = 0; i < 16; ++i) S[i] = __builtin_amdgcn_exp2f(S[i] + ex[i] + off[i >> 2]);
        R += sp_;
        const bf16x8 p0 = pack_p(S, 0), p1 = pack_p(S, 1);
        const bf16_t* vp = vbase + 32 * t;
#pragma unroll
        for (int o = 0; o < 2; ++o) { O[o] = mfma32(vt_frag(vp + (size_t)(32 * o) * SEQ), p0, O[o]); O[o] = mfma32(vt_frag(vp + (size_t)(32 * o) * SEQ + 16), p1, O[o]); }
        if (__all(R < -160.f)) break;
    }
    bf16_t* orow = OAT + (size_t)(b * SEQ + q0 + r32) * D + h * 64 + 4 * hh;
#pragma unroll
    for (int o = 0; o < 2; ++o)
#pragma unroll
        for (int g = 0; g < 4; ++g) { v2u w; w.x = pg8::cvt_pk_bf16(O[o][4 * g], O[o][4 * g + 1]); w.y = pg8::cvt_pk_bf16(O[o][4 * g + 2], O[o][4 * g + 3]); *(v2u*)(orow + 32 * o + 8 * g) = w; }
}

__device__ __forceinline__ void attn_mem_wave(const bf16_t* QM, const bf16_t* KVM, const bf16_t* VT, bf16_t* OM, int b, int h, int q0, int lane) {
    const int r32 = lane & 31, hh = lane >> 5;
    const bf16_t* qrow = QM + (size_t)(b * SEQ + q0 + r32) * D + h * 256 + 8 * hh;
    const bf16_t* kbase = KVM + (size_t)(b * MEMLEN + r32) * 2048 + h * 256 + 8 * hh;
    for (int dh = 0; dh < 2; ++dh) {
        const bf16_t* vbase = VT + (size_t)(b * 1024 + h * 256 + dh * 128 + r32) * MEMLEN + 4 * hh;
        f32x16 O[4];
#pragma unroll
        for (int o = 0; o < 4; ++o)
#pragma unroll
            for (int i = 0; i < 16; ++i) O[o][i] = 0.f;
        float m = -INFINITY, l = 0.f;
        for (int t = 0; t < 8; ++t) {
            const bf16_t* kp = kbase + (size_t)(32 * t) * 2048;
            f32x16 S;
#pragma unroll
            for (int i = 0; i < 16; ++i) S[i] = 0.f;
#pragma unroll
            for (int d0 = 0; d0 < 16; ++d0) S = mfma32(*(const bf16x8*)(kp + 16 * d0), *(const bf16x8*)(qrow + 16 * d0), S);
            softmax_step<4>(S, LOG2E * 0.0625f, m, l, O, hh);
            const bf16x8 p0 = pack_p(S, 0), p1 = pack_p(S, 1);
            const bf16_t* vp = vbase + 32 * t;
#pragma unroll
            for (int o = 0; o < 4; ++o) { O[o] = mfma32(vt_frag(vp + (size_t)(32 * o) * MEMLEN), p0, O[o]); O[o] = mfma32(vt_frag(vp + (size_t)(32 * o) * MEMLEN + 16), p1, O[o]); }
        }
        l += xhalf(l, hh);
        const float il = 1.f / l;
        bf16_t* orow = OM + (size_t)(b * SEQ + q0 + r32) * D + h * 256 + dh * 128 + 4 * hh;
#pragma unroll
        for (int o = 0; o < 4; ++o)
#pragma unroll
            for (int g = 0; g < 4; ++g) { v2u w; w.x = pg8::cvt_pk_bf16(O[o][4 * g] * il, O[o][4 * g + 1] * il); w.y = pg8::cvt_pk_bf16(O[o][4 * g + 2] * il, O[o][4 * g + 3] * il); *(v2u*)(orow + 32 * o + 8 * g) = w; }
    }
}


constexpr int VSTR = 136;
template <int NCH> __device__ __forceinline__ void stage_load(v4u (&r)[NCH], const bf16_t* g0, int chunks_per_row, size_t gpitch, int tid) {
#pragma unroll
    for (int i = 0; i < NCH; ++i) { const int c = tid + NTHR * i, row = c / chunks_per_row, ch = c % chunks_per_row; r[i] = *(const v4u*)(g0 + (size_t)row * gpitch + ch * 8); }
}
template <int NCH> __device__ __forceinline__ void stage_store_k(const v4u (&r)[NCH], LAS unsigned char* dst, int chunks_per_row, int lstride, int tid) {
#pragma unroll
    for (int i = 0; i < NCH; ++i) { const int c = tid + NTHR * i, row = c / chunks_per_row, ch = c % chunks_per_row; *(LAS v4u*)(dst + row * lstride + ch * 16) = r[i]; }
}
template <int NCH> __device__ __forceinline__ void stage_store_v(const v4u (&r)[NCH], LAS unsigned char* dst, int tid) {
#pragma unroll
    for (int i = 0; i < NCH; ++i) { const int c = tid + NTHR * i, row = c >> 3, ch = c & 7; LAS v2u* d = (LAS v2u*)(dst + row * VSTR + ch * 16); d[0] = (v2u){r[i].x, r[i].y}; d[1] = (v2u){r[i].z, r[i].w}; }
}
__device__ __forceinline__ bf16x8 lds_vfrag(const LAS unsigned char* p) { const v2u lo = *(const LAS v2u*)p, hi = *(const LAS v2u*)(p + 16); return __builtin_bit_cast(bf16x8, (v4u){lo.x, lo.y, hi.x, hi.y}); }

constexpr float SM_THR = 8.0f;
template <int NO>
__device__ __forceinline__ void softmax_def2(f32x16& S0, f32x16& S1, bool first, float& mref, float& l, f32x16 (&O)[NO], int hh) {
    float mx = fmaxf(fmaxf(S0[0], S0[1]), fmaxf(S1[0], S1[1]));
#pragma unroll
    for (int i = 2; i < 16; i += 2) mx = fmaxf(mx, fmaxf(fmaxf(S0[i], S0[i + 1]), fmaxf(S1[i], S1[i + 1])));
    mx = fmaxf(mx, xhalf(mx, hh));
    if (first || __any(mx > SM_THR)) {
        const float dl = first ? mx : fmaxf(mx, 0.f), f = first ? 0.f : __builtin_amdgcn_exp2f(-dl);
        mref += dl; l *= f;
#pragma unroll
        for (int o = 0; o < NO; ++o) O[o] = O[o] * f;
#pragma unroll
        for (int i = 0; i < 16; ++i) { S0[i] -= dl; S1[i] -= dl; }
    }
    float ps = 0.f;
#pragma unroll
    for (int i = 0; i < 16; ++i) { S0[i] = __builtin_amdgcn_exp2f(S0[i]); S1[i] = __builtin_amdgcn_exp2f(S1[i]); ps += S0[i] + S1[i]; }
    l += ps;
}
template <int NO>
__device__ __forceinline__ void softmax_def1(f32x16& S, bool first, float& mref, float& l, f32x16 (&O)[NO], int hh) {
    float mx = fmaxf(fmaxf(S[0], S[1]), fmaxf(S[2], S[3]));
#pragma unroll
    for (int i = 4; i < 16; i += 4) mx = fmaxf(mx, fmaxf(fmaxf(S[i], S[i + 1]), fmaxf(S[i + 2], S[i + 3])));
    mx = fmaxf(mx, xhalf(mx, hh));
    if (first || __any(mx > SM_THR)) {
        const float dl = first ? mx : fmaxf(mx, 0.f), f = first ? 0.f : __builtin_amdgcn_exp2f(-dl);
        mref += dl; l *= f;
#pragma unroll
        for (int o = 0; o < NO; ++o) O[o] = O[o] * f;
#pragma unroll
        for (int i = 0; i < 16; ++i) S[i] -= dl;
    }
    float ps = 0.f;
#pragma unroll
    for (int i = 0; i < 16; ++i) { S[i] = __builtin_amdgcn_exp2f(S[i]); ps += S[i]; }
    l += ps;
}
template <int NO>
__device__ __forceinline__ void softmax_step2(f32x16& S0, f32x16& S1, float C, float& m, float& l, f32x16 (&O)[NO], int hh) {
    float mx = fmaxf(fmaxf(S0[0], S0[1]), fmaxf(S1[0], S1[1]));
#pragma unroll
    for (int i = 2; i < 16; i += 2) mx = fmaxf(mx, fmaxf(fmaxf(S0[i], S0[i + 1]), fmaxf(S1[i], S1[i + 1])));
    mx = fmaxf(mx, xhalf(mx, hh)) * C;
    const float mn = fmaxf(m, mx), al = __builtin_amdgcn_exp2f(m - mn);
    m = mn; l *= al;
#pragma unroll
    for (int o = 0; o < NO; ++o) O[o] = O[o] * al;
    float ps = 0.f;
#pragma unroll
    for (int i = 0; i < 16; ++i) { S0[i] = __builtin_amdgcn_exp2f(S0[i] * C - mn); S1[i] = __builtin_amdgcn_exp2f(S1[i] * C - mn); ps += S0[i] + S1[i]; }
    l += ps;
}

__device__ __forceinline__ void attn_diff_block(const bf16_t* PR, const bf16_t* VT, bf16_t* OAT, const float* subln, float lam, int b, int h, int qb, LAS unsigned char* lds, int tid, int wave, int lane) {
    constexpr int KSTR = 144, KB = 64 * KSTR, BUF = 2 * KB + 128 * VSTR;
    const int r32 = lane & 31, hh = lane >> 5, j = wave >> 2, w4 = wave & 3, q0 = qb * 128 + w4 * 32;
    const bf16_t* qrow = PR + (size_t)(b * SEQ + q0 + r32) * NIN + C_DQ + h * 128 + j * 64 + 8 * hh;
    bf16x8 qf[4];
#pragma unroll
    for (int d0 = 0; d0 < 4; ++d0) qf[d0] = *(const bf16x8*)(qrow + 16 * d0);
    const bf16_t* kg = PR + (size_t)(b * SEQ) * NIN + C_DK + h * 128;
    const bf16_t* vg = VT + (size_t)(b * 512 + h * 128) * SEQ;
    f32x16 O[4];
#pragma unroll
    for (int o = 0; o < 4; ++o)
#pragma unroll
        for (int i = 0; i < 16; ++i) O[o][i] = 0.f;
    float m = 0.f, l = 0.f;
    const int nsteps = 2 * qb + 2, my_last = 2 * qb + (w4 >> 1);
    v4u ra1[1], ra2[1], rav[2], rb1[1], rb2[1], rbv[2];
    auto ld = [&](int t_, v4u (&r1)[1], v4u (&r2)[1], v4u (&rv)[2]) __attribute__((always_inline)) { const bf16_t* kn = kg + (size_t)(64 * t_) * NIN; stage_load<1>(r1, kn, 8, NIN, tid); stage_load<1>(r2, kn + 64, 8, NIN, tid); stage_load<2>(rv, vg + 64 * t_, 8, SEQ, tid); };
    auto st = [&](int t_, const v4u (&r1)[1], const v4u (&r2)[1], const v4u (&rv)[2]) __attribute__((always_inline)) { LAS unsigned char* nb = lds + (t_ & 1) * BUF; stage_store_k<1>(r1, nb, 8, KSTR, tid); stage_store_k<1>(r2, nb + KB, 8, KSTR, tid); stage_store_v<2>(rv, nb + 2 * KB, tid); };
    auto compute = [&](int t) __attribute__((always_inline)) {
        if (t <= my_last) {
            const LAS unsigned char* kb = lds + (t & 1) * BUF + j * KB + r32 * KSTR + 16 * hh; const LAS unsigned char* vb = lds + (t & 1) * BUF + 2 * KB + r32 * VSTR + 8 * hh;
            f32x16 S0, S1;
#pragma unroll
            for (int i = 0; i < 16; ++i) { S0[i] = -m; S1[i] = -m; }
#pragma unroll
            for (int d0 = 0; d0 < 4; ++d0) { S0 = mfma32(*(const LAS bf16x8*)(kb + 32 * d0), qf[d0], S0); S1 = mfma32(*(const LAS bf16x8*)(kb + 32 * KSTR + 32 * d0), qf[d0], S1); }
            softmax_def2<4>(S0, S1, t == 0, m, l, O, hh);
            const bf16x8 p00 = pack_p(S0, 0), p01 = pack_p(S0, 1), p10 = pack_p(S1, 0), p11 = pack_p(S1, 1);
#pragma unroll
            for (int o = 0; o < 4; ++o) { const LAS unsigned char* vp = vb + 32 * o * VSTR;
                O[o] = mfma32(lds_vfrag(vp), p00, O[o]); O[o] = mfma32(lds_vfrag(vp + 32), p01, O[o]); O[o] = mfma32(lds_vfrag(vp + 64), p10, O[o]); O[o] = mfma32(lds_vfrag(vp + 96), p11, O[o]); }
        } };
    ld(0, ra1, ra2, rav); st(0, ra1, ra2, rav);
    if (nsteps > 1) ld(1, rb1, rb2, rbv);
    __syncthreads();
    for (int t = 0; t < nsteps; t += 2) {
        if (t + 2 < nsteps) ld(t + 2, ra1, ra2, rav);
        compute(t);
        st(t + 1, rb1, rb2, rbv);
        __syncthreads();
        if (t + 3 < nsteps) ld(t + 3, rb1, rb2, rbv);
        compute(t + 1);
        if (t + 2 < nsteps) st(t + 2, ra1, ra2, rav);
        __syncthreads();
    }
    l += xhalf(l, hh);
    const float il = 1.f / l;
    LAS float* X = (LAS float*)lds + (size_t)(w4 * 32 + r32) * 132 + 4 * hh;
    if (j == 1) {
#pragma unroll
        for (int o = 0; o < 4; ++o)
#pragma unroll
            for (int g = 0; g < 4; ++g) *(LAS f32x4*)(X + 32 * o + 8 * g) = (f32x4){O[o][4 * g] * il, O[o][4 * g + 1] * il, O[o][4 * g + 2] * il, O[o][4 * g + 3] * il};
    }
    __syncthreads();
    if (j == 0) {
        float ss = 0.f;
#pragma unroll
        for (int o = 0; o < 4; ++o)
#pragma unroll
            for (int g = 0; g < 4; ++g) { const f32x4 o2 = *(const LAS f32x4*)(X + 32 * o + 8 * g);
#pragma unroll
                for (int c = 0; c < 4; ++c) { const float d = O[o][4 * g + c] * il - lam * o2[c]; O[o][4 * g + c] = d; ss += d * d; } }
        ss += xhalf(ss, hh);
        const float rinv = 0.8f / sqrtf(ss * (1.f / 128.f) + NORM_EPS);
        bf16_t* orow = OAT + (size_t)(b * SEQ + q0 + r32) * D + 512 + h * 128 + 4 * hh; const float* sl = subln + 4 * hh;
#pragma unroll
        for (int o = 0; o < 4; ++o)
#pragma unroll
            for (int g = 0; g < 4; ++g) { const f32x4 sg_ = *(const f32x4*)(sl + 32 * o + 8 * g); v2u w;
                w.x = pg8::cvt_pk_bf16(O[o][4 * g] * rinv * sg_[0], O[o][4 * g + 1] * rinv * sg_[1]); w.y = pg8::cvt_pk_bf16(O[o][4 * g + 2] * rinv * sg_[2], O[o][4 * g + 3] * rinv * sg_[3]); *(v2u*)(orow + 32 * o + 8 * g) = w; }
    }
    __syncthreads();
}

__device__ __forceinline__ void sb_subtile(f32x16& S, bool diag, float& R, f32x16 (&O)[2], const LAS unsigned char* vp, int r32, int hh) {
    f32x16 lr;
#pragma unroll
    for (int i = 0; i < 16; ++i) { const float z2 = S[i]; const float sp = fmaxf(z2, 0.f) + __builtin_amdgcn_logf(1.f + __builtin_amdgcn_exp2f(-fabsf(z2))); lr[i] = -sp; S[i] = z2 - sp; }
    if (diag) {
#pragma unroll
        for (int i = 0; i < 16; ++i) { const int kvl = (i & 3) + 8 * (i >> 2) + 4 * hh; if (kvl >= r32) { lr[i] = 0.f; S[i] = -INFINITY; } }
    }
    float tot[4], pt[4], off[4]; f32x16 ex;
#pragma unroll
    for (int g = 0; g < 4; ++g) { ex[4 * g + 3] = 0.f; ex[4 * g + 2] = lr[4 * g + 3]; ex[4 * g + 1] = lr[4 * g + 3] + lr[4 * g + 2]; ex[4 * g] = ex[4 * g + 1] + lr[4 * g + 1]; tot[g] = ex[4 * g] + lr[4 * g]; }
#pragma unroll
    for (int g = 0; g < 4; ++g) pt[g] = xhalf(tot[g], hh);
    const float own0 = hh ? 0.f : 1.f;
    float sp_ = 0.f;
#pragma unroll
    for (int g = 3; g >= 0; --g) { off[g] = sp_ + own0 * pt[g] + R; sp_ += tot[g] + pt[g]; }
#pragma unroll
    for (int i = 0; i < 16; ++i) S[i] = __builtin_amdgcn_exp2f(S[i] + ex[i] + off[i >> 2]);
    R += sp_;
    const bf16x8 p0 = pack_p(S, 0), p1 = pack_p(S, 1);
#pragma unroll
    for (int o = 0; o < 2; ++o) { O[o] = mfma32(lds_vfrag(vp + 32 * o * VSTR), p0, O[o]); O[o] = mfma32(lds_vfrag(vp + 32 * o * VSTR + 32), p1, O[o]); }
}
__device__ __forceinline__ void attn_sb_block(const bf16_t* PR, const bf16_t* VT, bf16_t* OAT, int b, int h, int qb, LAS unsigned char* lds, volatile LAS unsigned* fl, int tid, int wave, int lane) {
    constexpr int KSTR = 144, KB = 64 * KSTR, BUF = KB + 64 * VSTR;
    const int r32 = lane & 31, hh = lane >> 5, q0 = qb * 256 + wave * 32;
    const bf16_t* qrow = PR + (size_t)(b * SEQ + q0 + r32) * NIN + C_SBQ + h * 64 + 8 * hh;
    bf16x8 qf[4];
#pragma unroll
    for (int d0 = 0; d0 < 4; ++d0) qf[d0] = *(const bf16x8*)(qrow + 16 * d0);
    const bf16_t* kg = PR + (size_t)(b * SEQ) * NIN + C_SBK + h * 64;
    const bf16_t* vg = VT + (size_t)(b * 512 + h * 64) * SEQ;
    f32x16 O[2];
#pragma unroll
    for (int o = 0; o < 2; ++o)
#pragma unroll
        for (int i = 0; i < 16; ++i) O[o][i] = 0.f;
    float R = 0.f; bool done = false;
    const int ttop = 4 * qb + 3, my_diag = 4 * qb + (wave >> 1), odd = wave & 1;
    v4u kr[1], vr[1];
    if (tid < 3) fl[tid] = 0u;
    stage_load<1>(kr, kg + (size_t)(64 * ttop) * NIN, 8, NIN, tid); stage_load<1>(vr, vg + 64 * ttop, 8, SEQ, tid);
    stage_store_k<1>(kr, lds, 8, KSTR, tid); stage_store_v<1>(vr, lds + KB, tid);
    __syncthreads();
    int it = 0;
    for (int t = ttop; t >= 0; --t, ++it) {
        const bool more = t > 0;
        if (more) { stage_load<1>(kr, kg + (size_t)(64 * (t - 1)) * NIN, 8, NIN, tid); stage_load<1>(vr, vg + 64 * (t - 1), 8, SEQ, tid); }
        const int fcur = it % 3;
        if (tid == 0) fl[(it + 1) % 3] = 0u;
        if (t <= my_diag && !done) {
            const LAS unsigned char* kb = lds + (it & 1) * BUF + r32 * KSTR + 16 * hh; const LAS unsigned char* vb = lds + (it & 1) * BUF + KB + r32 * VSTR + 8 * hh;
            const bool isd = (t == my_diag);
            if (!isd || odd) {
                f32x16 S;
#pragma unroll
                for (int i = 0; i < 16; ++i) S[i] = 0.f;
#pragma unroll
                for (int d0 = 0; d0 < 4; ++d0) S = mfma32(*(const LAS bf16x8*)(kb + 32 * KSTR + 32 * d0), qf[d0], S);
                sb_subtile(S, isd, R, O, vb + 64, r32, hh);
            }
            {
                f32x16 S;
#pragma unroll
                for (int i = 0; i < 16; ++i) S[i] = 0.f;
#pragma unroll
                for (int d0 = 0; d0 < 4; ++d0) S = mfma32(*(const LAS bf16x8*)(kb + 32 * d0), qf[d0], S);
                sb_subtile(S, isd && !odd, R, O, vb, r32, hh);
            }
            done = __all(R < -160.f);
        }
        if (done && lane == 0) __hip_atomic_fetch_or((LAS unsigned*)(fl + fcur), 1u << wave, __ATOMIC_RELAXED, __HIP_MEMORY_SCOPE_WORKGROUP);
        if (more) { LAS unsigned char* nb = lds + ((it + 1) & 1) * BUF; stage_store_k<1>(kr, nb, 8, KSTR, tid); stage_store_v<1>(vr, nb + KB, tid); }
        __syncthreads();
        if (fl[fcur] == 0xffu) break;
    }
    bf16_t* orow = OAT + (size_t)(b * SEQ + q0 + r32) * D + h * 64 + 4 * hh;
#pragma unroll
    for (int o = 0; o < 2; ++o)
#pragma unroll
        for (int g = 0; g < 4; ++g) { v2u w; w.x = pg8::cvt_pk_bf16(O[o][4 * g], O[o][4 * g + 1]); w.y = pg8::cvt_pk_bf16(O[o][4 * g + 2], O[o][4 * g + 3]); *(v2u*)(orow + 32 * o + 8 * g) = w; }
    __syncthreads();
}

__device__ __forceinline__ void attn_mem_block(const bf16_t* QM, const bf16_t* KVM, const bf16_t* VT, bf16_t* OM, int b, int h, int qb, LAS unsigned char* lds, int tid, int wave, int lane) {
    constexpr int KSTR = 528, KB = 32 * KSTR, VS = 72, BUF = KB + 128 * VS;
    const int r32 = lane & 31, hh = lane >> 5, q0 = qb * 256 + wave * 32;
    const bf16_t* qrow = QM + (size_t)(b * SEQ + q0 + r32) * D + h * 256 + 8 * hh;
    bf16x8 qf[8];
    LAS unsigned char* qs = lds + 53248 + wave * 8192 + lane * 16;
#pragma unroll
    for (int d0 = 0; d0 < 8; ++d0) { qf[d0] = *(const bf16x8*)(qrow + 16 * d0); *(LAS bf16x8*)(qs + d0 * 1024) = *(const bf16x8*)(qrow + 128 + 16 * d0); }
    const bf16_t* kg = KVM + (size_t)(b * MEMLEN) * 2048 + h * 256;
    const int vrow = tid >> 2, vch = tid & 3;
    for (int dh = 0; dh < 2; ++dh) {
        const bf16_t* vg = VT + (size_t)(b * 1024 + h * 256 + dh * 128 + vrow) * MEMLEN + vch * 8;
        f32x16 O[4];
#pragma unroll
        for (int o = 0; o < 4; ++o)
#pragma unroll
            for (int i = 0; i < 16; ++i) O[o][i] = 0.f;
        float m = 0.f, l = 0.f;
        v4u kr[2], vr;
        stage_load<2>(kr, kg, 32, 2048, tid); vr = *(const v4u*)vg;
        stage_store_k<2>(kr, lds, 32, KSTR, tid); { LAS v2u* d = (LAS v2u*)(lds + KB + vrow * VS + vch * 16); d[0] = (v2u){vr.x, vr.y}; d[1] = (v2u){vr.z, vr.w}; }
        __syncthreads();
        for (int t = 0; t < 8; ++t) {
            const bool more = t < 7;
            if (more) { stage_load<2>(kr, kg + (size_t)(32 * (t + 1)) * 2048, 32, 2048, tid); vr = *(const v4u*)(vg + 32 * (t + 1)); }
            {
                const LAS unsigned char* kb = lds + (t & 1) * BUF + r32 * KSTR + 16 * hh; const LAS unsigned char* vb = lds + (t & 1) * BUF + KB + r32 * VS + 8 * hh;
                f32x16 S;
#pragma unroll
                for (int i = 0; i < 16; ++i) S[i] = -m;
#pragma unroll
                for (int d0 = 0; d0 < 8; ++d0) S = mfma32(*(const LAS bf16x8*)(kb + 32 * d0), qf[d0], S);
#pragma unroll
                for (int d0 = 0; d0 < 8; ++d0) S = mfma32(*(const LAS bf16x8*)(kb + 256 + 32 * d0), *(const LAS bf16x8*)(qs + d0 * 1024), S);
                softmax_def1<4>(S, t == 0, m, l, O, hh);
                const bf16x8 p0 = pack_p(S, 0), p1 = pack_p(S, 1);
#pragma unroll
                for (int o = 0; o < 4; ++o) { const LAS unsigned char* vp = vb + 32 * o * VS; O[o] = mfma32(lds_vfrag(vp), p0, O[o]); O[o] = mfma32(lds_vfrag(vp + 32), p1, O[o]); }
            }
            if (more) { LAS unsigned char* nb = lds + ((t + 1) & 1) * BUF; stage_store_k<2>(kr, nb, 32, KSTR, tid); LAS v2u* d = (LAS v2u*)(nb + KB + vrow * VS + vch * 16); d[0] = (v2u){vr.x, vr.y}; d[1] = (v2u){vr.z, vr.w}; }
            __syncthreads();
        }
        l += xhalf(l, hh);
        const float il = 1.f / l;
        bf16_t* orow = OM + (size_t)(b * SEQ + q0 + r32) * D + h * 256 + dh * 128 + 4 * hh;
#pragma unroll
        for (int o = 0; o < 4; ++o)
#pragma unroll
            for (int g = 0; g < 4; ++g) { v2u w; w.x = pg8::cvt_pk_bf16(O[o][4 * g] * il, O[o][4 * g + 1] * il); w.y = pg8::cvt_pk_bf16(O[o][4 * g + 2] * il, O[o][4 * g + 3] * il); *(v2u*)(orow + 32 * o + 8 * g) = w; }
    }
}

struct Args { const void* in[26]; float* out; unsigned char* ws; int ph_lo, ph_hi; };
constexpr int NPHASE = 15;

__device__ __forceinline__ float softplus_f(float z) { return fmaxf(z, 0.f) + __logf(1.f + __expf(-fabsf(z))); }

__global__ void __launch_bounds__(NTHR, 2) fwd(Args args) {
    extern __shared__ __attribute__((aligned(16))) unsigned char lds[];
    LAS unsigned char* L = (LAS unsigned char*)lds;
    volatile LAS unsigned* MISC = (volatile LAS unsigned*)(L + MISC_OFF);
    const int tid = threadIdx.x, lane = tid & 63, wave = __builtin_amdgcn_readfirstlane(tid >> 6);
    const int G = gridDim.x;
    unsigned char* ws = args.ws;
    unsigned* ctl = (unsigned*)(ws + WS_CTL);
#define x_in ((const float*)args.in[0])
#define mem_in ((const float*)args.in[1])
#define positions ((const int*)args.in[2])
#define norm_mix ((const float*)args.in[3])
#define w_in ((const float*)args.in[4])
#define lam_q1 ((const float*)args.in[5])
#define lam_k1 ((const float*)args.in[6])
#define lam_q2 ((const float*)args.in[7])
#define lam_k2 ((const float*)args.in[8])
#define diff_subln ((const float*)args.in[9])
#define w_up_sb ((const float*)args.in[10])
#define w_up_diff ((const float*)args.in[11])
#define w_out ((const float*)args.in[12])
#define norm_mem_q ((const float*)args.in[13])
#define norm_mem_kv ((const float*)args.in[14])
#define w_mem_q ((const float*)args.in[15])
#define w_mem_kv ((const float*)args.in[16])
#define w_mem_o ((const float*)args.in[17])
#define norm_ffn ((const float*)args.in[18])
#define w_router ((const float*)args.in[19])
#define b_router ((const float*)args.in[20])
#define w_gate_up ((const float*)args.in[21])
#define b_gate_up ((const float*)args.in[22])
#define w_down ((const float*)args.in[23])
#define b_down ((const float*)args.in[24])
#define norm_final ((const float*)args.in[25])
    bf16_t* WIN = (bf16_t*)(ws + WS_WIN); bf16_t* WUPSB = (bf16_t*)(ws + WS_WUPSB); bf16_t* WUPDF = (bf16_t*)(ws + WS_WUPDF); bf16_t* WOUT = (bf16_t*)(ws + WS_WOUT);
    bf16_t* WMQ = (bf16_t*)(ws + WS_WMQ); bf16_t* WMKV = (bf16_t*)(ws + WS_WMKV); bf16_t* WMO = (bf16_t*)(ws + WS_WMO);
    bf16_t* WGU = (bf16_t*)(ws + WS_WGU); bf16_t* WD = (bf16_t*)(ws + WS_WD);
    float* ROPEC = (float*)(ws + WS_ROPE); float* ROPES = ROPEC + (size_t)M * 32;
    int* TK_E = (int*)(ws + WS_TK); int* TK_POS = TK_E + (size_t)M * 4; float* TK_G = (float*)(TK_POS + (size_t)M * 4);
    bf16_t* XN = (bf16_t*)(ws + WS_XN); bf16_t* PR = (bf16_t*)(ws + WS_PR); bf16_t* OAT = (bf16_t*)(ws + WS_OAT); float* SSQ = (float*)(ws + WS_ODR);
    bf16_t* MIX = (bf16_t*)(ws + WS_MIX); float* X1 = (float*)(ws + WS_X1); float* X2 = (float*)(ws + WS_X2);
    bf16_t* HM = (bf16_t*)(ws + WS_HM); bf16_t* KVM = (bf16_t*)(ws + WS_KVM); int* TLIST = (int*)(ws + WS_TLIST); float* GLIST = (float*)(ws + WS_GLIST);
    bf16_t* QM = (bf16_t*)(ws + WS_QM); bf16_t* OM = (bf16_t*)(ws + WS_OM); bf16_t* ACT = (bf16_t*)(ws + WS_ACT); bf16_t* YB = (bf16_t*)(ws + WS_YB);
    bf16_t* VTSB = (bf16_t*)(ws + WS_VTSB); bf16_t* VTDF = (bf16_t*)(ws + WS_VTDF); bf16_t* VTM = (bf16_t*)(ws + WS_VTM);
    float* WR = (float*)(ws + WS_WR); float* WSCGU = (float*)(ws + WS_WSC); float* WSCD = WSCGU + NE * 2048;
    unsigned char* WGU8 = ws + WS_WGU; unsigned char* WD8 = ws + WS_WD; unsigned char* XN8 = ws + WS_XN; unsigned char* ACT8 = ws + WS_ACT;
    unsigned* CNT = ctl + CW_CNT;
    LAS float* smf = (LAS float*)L;
    LAS int* smi = (LAS int*)L;

    for (int u = tid; u < (LDS_BYTES - 131072) / 4; u += NTHR) ((LAS unsigned*)(L + 131072))[u] = 0u;
    __syncthreads();
#if !MK_PER_PHASE
    XcdBarrier bar = xcd_barrier_post(ctl + CW_BAR, MISC + 8);
#define GRID_BAR() xcd_barrier(bar)
#else
#define GRID_BAR() do {} while (0)
#endif
    const int lo = args.ph_lo, hi = args.ph_hi;
#define IN(k) (lo <= (k) && (k) < hi)
#define PHASE_L(k, ...) do { if (IN(k)) { auto body_ = [&]() __attribute__((always_inline)) __VA_ARGS__; body_(); if ((PROBE_REP >> (k)) & 1) { GRID_BAR(); body_(); } } } while (0)
#if !MK_PER_PHASE
#define PHASE(k) for (int rep_ = 0, nrep_ = IN(k) ? 1 + ((PROBE_REP >> (k)) & 1) : 0; rep_ < nrep_; ++rep_, (rep_ < nrep_ ? (xcd_barrier(bar), 0) : 0))
#else
#define PHASE(k) if (IN(k))
#endif
    unsigned long long st_t0_ = 0ull, st_dt_ = 0ull;
#define STAMP_AT(k) do { if (PROBE_STAMP >= 0) { const unsigned long long now_ = __builtin_amdgcn_s_memrealtime(); if ((k) == PROBE_STAMP || (PROBE_STAMP == 100 && (k) == 0)) st_t0_ = now_; if ((k) == PROBE_STAMP + 1 || (PROBE_STAMP == 100 && (k) == 15)) st_dt_ = now_ - st_t0_; } } while (0)
#define SEAM(k) do { if (IN(k) && IN((k) + 1)) GRID_BAR(); STAMP_AT((k) + 1); } while (0)
    const int gw = blockIdx.x * NWAVES + wave, NGW = G * NWAVES;
    const int xcu = (G % 8 == 0) ? ((int)blockIdx.x % 8) * (G / 8) + (int)blockIdx.x / 8 : (int)blockIdx.x;

    auto convert_experts = [&]() __attribute__((always_inline)) {
        LAS float* scr = (LAS float*)(L + wave * 16384);
        {
            const int c8 = lane & 7, r8 = lane >> 3;
            f32x4 ra[8], rb[8], rc[8], rd[8], re[8];
            auto sub_load = [&](const float* Wc, int N, int k0, f32x4 (&r)[8]) __attribute__((always_inline)) {
#pragma unroll
                for (int i = 0; i < 8; ++i) r[i] = *(const f32x4*)(Wc + (size_t)(k0 + 8 * i + r8) * N); };
            auto to_lds = [&](const f32x4 (&r)[8]) __attribute__((always_inline)) {
#pragma unroll
                for (int i = 0; i < 8; ++i) *(LAS f32x4*)(scr + (8 * i + r8) * 32 + ((4 * c8) ^ (4 * i))) = r[i];
                LDS_WAIT(); asm volatile("" ::: "memory"); };
            auto max8 = [&](float v) __attribute__((always_inline)) -> float {
                v = fmaxf(v, __uint_as_float(__builtin_amdgcn_update_dpp(0, __float_as_uint(v), 0xB1, 0xf, 0xf, false)));
                v = fmaxf(v, __uint_as_float(__builtin_amdgcn_update_dpp(0, __float_as_uint(v), 0x4E, 0xf, 0xf, false)));
                v = fmaxf(v, __uint_as_float(__builtin_amdgcn_update_dpp(0, __float_as_uint(v), 0x141, 0xf, 0xf, false)));
                return v; };
            for (int it = gw; it < NE * 96 * 4; it += NGW) {
                const int strip = it % (NE * 96), qt = it / (NE * 96);
                const bool gu = strip < NE * 64; const int q = gu ? strip : strip - NE * 64, e = gu ? q >> 6 : q >> 5, n0 = (gu ? q & 63 : q & 31) * 32, N = gu ? 2048 : 1024;
                const float* Wc = (gu ? w_gate_up + (size_t)e * 1024 * 2048 : w_down + (size_t)e * 1024 * 1024) + n0 + 4 * c8;
                sub_load(Wc, N, 0, ra); sub_load(Wc, N, 256 * qt, rb); sub_load(Wc, N, 256 * qt + 64, rc); sub_load(Wc, N, 256 * qt + 128, rd); sub_load(Wc, N, 256 * qt + 192, re);
                to_lds(ra);
                float inv[4], am[4];
#pragma unroll
                for (int j = 0; j < 4; ++j) { const int n = r8 + 8 * j; float a0 = 0.f;
#pragma unroll
                    for (int i = 0; i < 8; ++i) a0 = fmaxf(a0, fabsf(scr[(8 * c8 + i) * 32 + (n ^ (4 * c8))]));
                    a0 = max8(a0);
                    unsigned eb = ((__float_as_uint(a0) >> 23) & 0xffu) + 4u; eb = eb < 8u ? 8u : (eb > 250u ? 250u : eb);
                    inv[j] = __uint_as_float((261u - eb) << 23); am[j] = 0.f;
                    if (qt == 0 && c8 == 0) (gu ? WSCGU + (size_t)e * 2048 : WSCD + (size_t)e * 1024)[n0 + n] = __uint_as_float((eb - 7u) << 23); }
                LDS_WAIT(); asm volatile("" ::: "memory");
                unsigned char* dstb = gu ? WGU8 + (size_t)e * 2048 * 1024 : WD8 + (size_t)e * 1024 * 1024;
#pragma unroll
                for (int st = 0; st < 4; ++st) {
                    const int k0 = 256 * qt + 64 * st;
                    if (st == 0) to_lds(rb); else if (st == 1) to_lds(rc); else if (st == 2) to_lds(rd); else to_lds(re);
#pragma unroll
                    for (int j = 0; j < 4; ++j) { const int n = r8 + 8 * j, c = n0 + n; const LAS float* sp = scr + (8 * c8) * 32 + (n ^ (4 * c8)); float v[8];
#pragma unroll
                        for (int i = 0; i < 8; ++i) { v[i] = sp[i * 32]; am[j] = fmaxf(am[j], fabsf(v[i])); v[i] *= inv[j]; }
                        const int drow = gu ? (((c & 1023) >> 7) * 256 + (c >> 10) * 128 + (c & 127)) : c;
                        v2u w; w.x = pk4_fp8(v[0], v[1], v[2], v[3]); w.y = pk4_fp8(v[4], v[5], v[6], v[7]);
                        *(v2u*)(dstb + (size_t)drow * 1024 + k0 + 8 * c8) = w; }
                    LDS_WAIT(); asm volatile("" ::: "memory");
                }
                bool ov = false;
#pragma unroll
                for (int j = 0; j < 4; ++j) ov = ov || (am[j] * inv[j] >= 448.0f);
                if (__any(ov) && lane == 0) __hip_atomic_store(ctl + CW_REDO + strip, 1u, __ATOMIC_RELAXED, __HIP_MEMORY_SCOPE_AGENT);
            }
        }
    };
    STAMP_AT(0);
    PHASE(0) {
        STAMP_AT(20);
        LAS float* scr = (LAS float*)(L + wave * 16384);
        constexpr int I_IN = 16 * 160, I_UP = 8 * 32, I_SQ = 16 * 32, I_KV = 16 * 64, I_GU1 = 16 * 64, I_GU = NE * I_GU1, I_D1 = 16 * 32, I_DN = NE * I_D1;
        constexpr int NITEMS = I_IN + 2 * I_UP + 3 * I_SQ + I_KV;
        for (int it = gw; it < NITEMS; it += NGW) {
            int r = it;
            if (r < I_IN) {
                const int kb = r / 160, nb = r % 160, n0 = 32 * nb;
                if (n0 >= C_DQ && n0 < C_DV) { const int o = n0 & 255;
                    p0_transpose_rope(w_in, WIN, (n0 & ~255), o, 64 * kb, n0, scr, lane); }
                else p0_transpose_item(w_in, 1024, NIN, WIN, n0, 64 * kb, n0, scr, lane);
                continue; } r -= I_IN;
            if (r < I_UP) { p0_plain(w_up_sb, 512, 1024, WUPSB, r, scr, lane); continue; } r -= I_UP;
            if (r < I_UP) { p0_plain(w_up_diff, 512, 1024, WUPDF, r, scr, lane); continue; } r -= I_UP;
            if (r < I_SQ) { p0_plain(w_out, 1024, 1024, WOUT, r, scr, lane); continue; } r -= I_SQ;
            if (r < I_SQ) { p0_plain(w_mem_q, 1024, 1024, WMQ, r, scr, lane, norm_mem_q); continue; } r -= I_SQ;
            if (r < I_SQ) { p0_plain(w_mem_o, 1024, 1024, WMO, r, scr, lane); continue; } r -= I_SQ;
            p0_plain(w_mem_kv, 1024, 2048, WMKV, r, scr, lane);
        }
        for (int i = blockIdx.x * NTHR + tid; i < D * NE; i += G * NTHR) WR[i] = w_router[i] * norm_ffn[i >> 5];
        STAMP_AT(21);
        STAMP_AT(22);
        for (int m = gw; m < M; m += NGW) rms_row_to_bf16(x_in + (size_t)m * D, norm_mix, XN + (size_t)m * D, lane);
        for (int m = gw; m < MM; m += NGW) rms_row_to_bf16(mem_in + (size_t)m * D, norm_mem_kv, HM + (size_t)m * D, lane);
        for (int i = blockIdx.x * NTHR + tid; i < M * 32; i += G * NTHR) {
            const int m = i >> 5, f = i & 31;
            const double inv = exp2(-(double)f * (13.287712379549449 / 32.0));
            const double ang = (double)positions[m] * inv;
            const double kk = rint(ang * 0.15915494309189535);
            const float rf = (float)(ang - kk * 6.283185307179586);
            ROPEC[i] = __cosf(rf); ROPES[i] = __sinf(rf);
        }
        STAMP_AT(23);
    }
    SEAM(0); STAMP_AT(24);

    if (IN(1)) {
        const int grp = (int)blockIdx.x % 3;
        pg8::Gemm g{XN, WIN, D, D, D}; pg8::DenseOrder S; S.init(M, NIN, G, (int)blockIdx.x, D, D);
        const pg8::EpiInProj E{PR, ROPEC, ROPES, VTSB, VTDF};
        if (grp == 0) { convert_experts(); __syncthreads(); }
        if (grp == 1) { S.i0 = 0; S.i1 = 2; pg8::gemm_phase<pg8::EpiInProj, pg8::DenseOrder, false>(L, g, S, E); convert_experts(); __syncthreads(); S.i0 = 2; S.i1 = 1 << 30; }
        pg8::gemm_phase<pg8::EpiInProj, pg8::DenseOrder, false>(L, g, S, E);
        if (grp == 2) convert_experts();
    }
    SEAM(1);

    if (IN(3)) {
        {
            LAS float* sw = (LAS float*)L; LAS float* red = (LAS float*)(L + 131072 + 4096);
            const int n = tid & 31, part = tid >> 5;
            for (int it = blockIdx.x; it < NE * 96; it += G) {
                if (__hip_atomic_load(ctl + CW_REDO + it, __ATOMIC_RELAXED, __HIP_MEMORY_SCOPE_AGENT) == 0u) continue;
                const bool gu = it < NE * 64; const int q = gu ? it : it - NE * 64, e = gu ? q >> 6 : q >> 5, n0 = (gu ? q & 63 : q & 31) * 32, N = gu ? 2048 : 1024;
                const float* W = (gu ? w_gate_up + (size_t)e * 1024 * 2048 : w_down + (size_t)e * 1024 * 1024) + n0 + n;
                __syncthreads();
#pragma unroll 16
                for (int i = 0; i < 64; ++i) { const int k = part + 16 * i; sw[k * 32 + n] = W[(size_t)k * N]; }
                __syncthreads();
                float am = 0.f;
#pragma unroll 16
                for (int i = 0; i < 64; ++i) am = fmaxf(am, fabsf(sw[(64 * part + i) * 32 + n]));
                red[part * 32 + n] = am;
                __syncthreads();
                if (tid < 32) { float a = red[tid];
#pragma unroll
                    for (int pp = 1; pp < 16; ++pp) a = fmaxf(a, red[pp * 32 + tid]);
                    unsigned eb = (__float_as_uint(a) >> 23) & 0xffu; eb = eb < 8u ? 8u : eb;
                    const float sc = __uint_as_float((eb - 7u) << 23), inv = __uint_as_float((261u - eb) << 23);
                    red[512 + tid] = inv; (gu ? WSCGU + (size_t)e * 2048 : WSCD + (size_t)e * 1024)[n0 + tid] = sc; }
                __syncthreads();
                { const float inv = red[512 + n]; const int c = n0 + n;
                  const int drow = gu ? (((c & 1023) >> 7) * 256 + (c >> 10) * 128 + (c & 127)) : c;
                  unsigned char* dst = (gu ? WGU8 + ((size_t)e * 2048 + drow) * 1024 : WD8 + ((size_t)e * 1024 + drow) * 1024) + 64 * part;
#pragma unroll
                  for (int qd = 0; qd < 4; ++qd) { v4u w;
                      const LAS float* sp = sw + (64 * part + 16 * qd) * 32 + n;
                      w.x = pk4_fp8(sp[0] * inv, sp[32] * inv, sp[64] * inv, sp[96] * inv); w.y = pk4_fp8(sp[128] * inv, sp[160] * inv, sp[192] * inv, sp[224] * inv);
                      w.z = pk4_fp8(sp[256] * inv, sp[288] * inv, sp[320] * inv, sp[352] * inv); w.w = pk4_fp8(sp[384] * inv, sp[416] * inv, sp[448] * inv, sp[480] * inv);
                      *(v4u*)(dst + 16 * qd) = w; } }
            }
            __syncthreads();
        }
    }
    PHASE(3) {
        volatile LAS unsigned* fl = (volatile LAS unsigned*)(L + 131072 + 2048);
        STAMP_AT(30);
        const int nkv = (G >= 64) ? 32 : 0;
        if ((int)blockIdx.x < nkv) { pg8::Gemm g{HM, WMKV, D, D, D}; pg8::OneUnitOrder S{(int)blockIdx.x, D, D};
            pg8::gemm_phase<pg8::EpiKV, pg8::OneUnitOrder, false>(L, g, S, pg8::EpiKV{KVM, VTM}); }
        else for (int bu = (int)blockIdx.x - nkv; bu < 512; bu += G - nkv) { const int qb = bu & 15, h = (bu >> 4) & 7, b = bu >> 7; attn_sb_block(PR, VTSB, OAT, b, h, qb, L, fl, tid, wave, lane); }
        if (nkv == 0) { pg8::Gemm g{HM, WMKV, D, D, D}; pg8::DenseOrder S; S.init(MM, 2048, G, (int)blockIdx.x, D, D); pg8::gemm_phase<pg8::EpiKV, pg8::DenseOrder, false>(L, g, S, pg8::EpiKV{KVM, VTM}); }
        STAMP_AT(31);
        const float lam = expf(wave_sum(lam_q1[lane] * lam_k1[lane])) - expf(wave_sum(lam_q2[lane] * lam_k2[lane])) + 0.2f;
        for (int pr = blockIdx.x; pr < 256; pr += G) { const int sb_ = pr & 15, h = (pr >> 4) & 3, b = pr >> 6;
            attn_diff_block(PR, VTDF, OAT, diff_subln, lam, b, h, 31 - sb_, L, tid, wave, lane); attn_diff_block(PR, VTDF, OAT, diff_subln, lam, b, h, sb_, L, tid, wave, lane); }
        STAMP_AT(32);
    }
    SEAM(3); STAMP_AT(3); STAMP_AT(33);

    PHASE_L(5, {
        pg8::Gemm g{OAT, WUPSB, D, 512, 512}; pg8::TwoRoundOrder S{G, xcu, D, 512};
        pg8::gemm_phase<pg8::EpiGate, pg8::TwoRoundOrder, false>(L, g, S, pg8::EpiGate{PR, X2, MIX});
    });
    SEAM(5); STAMP_AT(5);

    PHASE_L(6, {
        pg8::Gemm g{MIX, WOUT, D, D, D}; pg8::DenseOrder S; S.init(M, D, G, (int)blockIdx.x, D, D);
        pg8::gemm_phase<pg8::EpiResidNorm, pg8::DenseOrder, false>(L, g, S, pg8::EpiResidNorm{x_in, X1, XN, SSQ});
    });
    if (IN(6) && IN(8)) GRID_BAR();
    STAMP_AT(7); STAMP_AT(8);

    PHASE_L(8, {
        pg8::Gemm g{XN, WMQ, D, D, D}; pg8::DenseOrder S; S.init(M, D, G, (int)blockIdx.x, D, D);
        pg8::gemm_phase<pg8::EpiBf16Rinv, pg8::DenseOrder, false>(L, g, S, pg8::EpiBf16Rinv{QM, SSQ, 0.0625f * 1.4426950408889634f});
    });
    SEAM(8);

    PHASE(9) { for (int bu = blockIdx.x; bu < 256; bu += G) { const int qb = bu & 15, h = (bu >> 4) & 3, b = bu >> 6; attn_mem_block(QM, KVM, VTM, OM, b, h, qb, L, tid, wave, lane); } }
    SEAM(9);

    PHASE_L(10, {
        pg8::Gemm g{OM, WMO, D, D, D}; pg8::DenseOrder S; S.init(M, D, G, (int)blockIdx.x, D, D);
        pg8::gemm_phase<pg8::EpiResidF32, pg8::DenseOrder, false>(L, g, S, pg8::EpiResidF32{X1, X2});
    });
    SEAM(10);

    if (IN(11)) {
        auto body11_ = [&]() __attribute__((always_inline)) {
        {
            const int i32 = lane & 31, kk = lane >> 5;
#pragma unroll
            for (int t2 = 0; t2 < 2; ++t2) {
                const int tile = t2 * G + (int)blockIdx.x, m0 = tile * 32;
                LAS float* P = smf + (t2 * 8 + wave) * 1056; LAS float* SSQ_ = smf + 16 * 1056 + (t2 * 8 + wave) * 32;
                f32x16 acc;
#pragma unroll
                for (int r = 0; r < 16; ++r) acc[r] = 0.f;
                float ss = 0.f;
                if (tile < M / 32) {
                    const float* xr = X2 + (size_t)(m0 + i32) * D + 128 * wave + 4 * kk; const float* wp = WR + (128 * wave + 4 * kk) * NE + i32;
#pragma unroll 8
                    for (int u = 0; u < 16; ++u) {
                        const f32x4 a = *(const f32x4*)(xr + 8 * u);
                        const float b0 = wp[(8 * u + 0) * NE], b1 = wp[(8 * u + 1) * NE], b2 = wp[(8 * u + 2) * NE], b3 = wp[(8 * u + 3) * NE];
                        acc = __builtin_amdgcn_mfma_f32_32x32x2f32(a.x, b0, acc, 0, 0, 0); acc = __builtin_amdgcn_mfma_f32_32x32x2f32(a.y, b1, acc, 0, 0, 0);
                        acc = __builtin_amdgcn_mfma_f32_32x32x2f32(a.z, b2, acc, 0, 0, 0); acc = __builtin_amdgcn_mfma_f32_32x32x2f32(a.w, b3, acc, 0, 0, 0);
                        ss += (a.x * a.x + a.y * a.y) + (a.z * a.z + a.w * a.w);
                    }
                }
                ss += xhalf(ss, kk);
#pragma unroll
                for (int r = 0; r < 16; ++r) P[((r & 3) + 8 * (r >> 2) + 4 * kk) * 33 + i32] = acc[r];
                if (kk == 0) SSQ_[i32] = ss;
            }
        }
        __syncthreads();
        if (wave < 2) {
            const int tile = wave * G + (int)blockIdx.x;
            if (tile < M / 32) {
                const int m0 = tile * 32;
                LAS float* T = smf + (wave * 8) * 1056;
#pragma unroll
                for (int r = 0; r < 16; ++r) { const int idx = lane + 64 * r, e_ = (idx >> 5) * 33 + (idx & 31); float v = T[e_];
#pragma unroll
                    for (int w2 = 1; w2 < 8; ++w2) v += T[w2 * 1056 + e_];
                    T[e_] = v; }
                float ss = 0.f;
#pragma unroll
                for (int w2 = 0; w2 < 8; ++w2) ss += smf[16 * 1056 + (wave * 8 + w2) * 32 + (lane & 31)];
                LDS_WAIT(); asm volatile("" ::: "memory");
                const float rinv = 1.0f / sqrtf(ss * (1.f / 1024.f) + NORM_EPS);
                if (lane < 32) {
                    float lg[32];
#pragma unroll
                    for (int j = 0; j < 32; ++j) lg[j] = T[lane * 33 + j] * rinv + b_router[j];
                    float tv[4]; int ti[4];
#pragma unroll
                    for (int k = 0; k < 4; ++k) { float bv = lg[0]; int bi = 0;
#pragma unroll
                        for (int j = 1; j < 32; ++j) if (lg[j] > bv) { bv = lg[j]; bi = j; }
                        tv[k] = bv; ti[k] = bi;
#pragma unroll
                        for (int j = 0; j < 32; ++j) if (j == bi) lg[j] = -INFINITY; }
                    const float e1 = __expf(tv[1] - tv[0]), e2 = __expf(tv[2] - tv[0]), e3 = __expf(tv[3] - tv[0]);
                    const float isum = 1.f / (1.f + e1 + e2 + e3);
                    const float gk[4] = {isum, e1 * isum, e2 * isum, e3 * isum};
                    LAS unsigned* H = (LAS unsigned*)(smf + 16 * 1056 + 512 + wave * 64);
                    H[lane] = 0u;
                    LDS_WAIT(); asm volatile("" ::: "memory");
                    int rk[4];
#pragma unroll
                    for (int k = 0; k < 4; ++k) rk[k] = (int)__hip_atomic_fetch_add(H + ti[k], 1u, __ATOMIC_RELAXED, __HIP_MEMORY_SCOPE_WAVEFRONT);
                    LDS_WAIT(); asm volatile("" ::: "memory");
                    const unsigned cnt_e = H[lane];
                    unsigned base_e = 0u; if (cnt_e) base_e = atomicAdd(&CNT[64 * lane], cnt_e);
                    H[32 + lane] = base_e;
                    LDS_WAIT(); asm volatile("" ::: "memory");
                    const int m = m0 + lane;
#pragma unroll
                    for (int k = 0; k < 4; ++k) { const int ek = ti[k]; const int pos = (int)H[32 + ek] + rk[k];
                        TLIST[ek * LISTCAP + pos] = m; GLIST[ek * LISTCAP + pos] = gk[k]; TK_E[m * 4 + k] = ek; TK_POS[m * 4 + k] = pos; TK_G[m * 4 + k] = gk[k]; }
                }
            }
        } else {
            for (int m = blockIdx.x * 6 + (wave - 2); m < M; m += G * 6) rms_row_to_fp8(X2 + (size_t)m * D, norm_ffn, XN8 + (size_t)m * D, lane);
        }
            };
        body11_();
        if ((PROBE_REP >> 11) & 1) { GRID_BAR(); if (blockIdx.x == 0 && tid < NE) CNT[64 * tid] = 0u; GRID_BAR(); body11_(); }
    }
    SEAM(11);

#define LOAD_BASES() do { __syncthreads(); if (tid == 0) { int b_ = 0; for (int e_ = 0; e_ < NE; ++e_) { const int c_ = (int)__hip_atomic_load(&CNT[64 * e_], __ATOMIC_RELAXED, __HIP_MEMORY_SCOPE_AGENT); \
        smi[8192 + e_] = b_; smi[8256 + e_] = c_; b_ += (c_ + 255) & ~255; } } __syncthreads(); } while (0)

    LAS int* tb = (LAS int*)(L + 131072 + 1024);
#define LOAD_TB(npn) do { __syncthreads(); if (tid == 0) { int b_ = 0, cu_ = 0; for (int e_ = 0; e_ < NE; ++e_) { const int c_ = (int)__hip_atomic_load(&CNT[64 * e_], __ATOMIC_RELAXED, __HIP_MEMORY_SCOPE_AGENT); \
        tb[e_] = b_; tb[32 + e_] = c_; tb[64 + e_] = cu_; b_ += (c_ + 255) & ~255; cu_ += ((c_ + 255) >> 8) * (npn); } tb[96] = cu_; } __syncthreads(); } while (0)
    PHASE_L(12, {
        LOAD_TB(8);
        pg8::Gemm g{(const bf16_t*)XN8, (const bf16_t*)WGU8, 512, 512, 512}; pg8::MoeOrder S{tb, TLIST, G, xcu, 8, 512, 512, 2048};
        pg8::gemm_phase<pg8::EpiMoeGU, pg8::MoeOrder, true, true>(L, g, S, pg8::EpiMoeGU{ACT8, b_gate_up, WSCGU});
    });
    SEAM(12);
    PHASE_L(13, {
        LOAD_TB(4);
        pg8::Gemm g{(const bf16_t*)ACT8, (const bf16_t*)WD8, 512, 512, 512}; pg8::MoeOrder S{tb, TLIST, G, xcu, 4, 512, 512, 1024};
        pg8::gemm_phase<pg8::EpiMoeDown, pg8::MoeOrder, false, true>(L, g, S, pg8::EpiMoeDown{YB, b_down, GLIST, tb, WSCD});
    });
    SEAM(13);

    PHASE(14) {
        LOAD_BASES();
        for (int mb = gw; mb < M; mb += 8 * NGW) {
            int slotv = 0;
            { const int i = lane >> 2, k = lane & 3, m = mb + NGW * i; if (lane < 32 && m < M) slotv = smi[8192 + TK_E[m * 4 + k]] + TK_POS[m * 4 + k]; }
#pragma unroll 2
            for (int i = 0; i < 8; ++i) {
                const int m = mb + NGW * i; if (m >= M) break;
                const f32x4* xr = (const f32x4*)(X2 + (size_t)m * D) + lane; const f32x4* gr = (const f32x4*)norm_final + lane;
                f32x4 v[4];
#pragma unroll
                for (int j = 0; j < 4; ++j) v[j] = xr[64 * j];
#pragma unroll
                for (int k = 0; k < 4; ++k) { const int slot = __builtin_amdgcn_readlane(slotv, 4 * i + k); const v2u* yr = (const v2u*)(YB + (size_t)slot * D) + lane;
#pragma unroll
                    for (int j = 0; j < 4; ++j) { const v2u w = yr[64 * j]; v[j].x += lo16(w.x); v[j].y += hi16(w.x); v[j].z += lo16(w.y); v[j].w += hi16(w.y); } }
                float ss = 0.f;
#pragma unroll
                for (int j = 0; j < 4; ++j) ss += (v[j].x * v[j].x + v[j].y * v[j].y) + (v[j].z * v[j].z + v[j].w * v[j].w);
                const float rinv = 1.0f / sqrtf(wave_sum(ss) * (1.f / 1024.f) + NORM_EPS);
                f32x4* orow = (f32x4*)(args.out + (size_t)m * D) + lane;
#pragma unroll
                for (int j = 0; j < 4; ++j) { const f32x4 gg = gr[64 * j]; orow[64 * j] = (f32x4){v[j].x * rinv * gg.x, v[j].y * rinv * gg.y, v[j].z * rinv * gg.z, v[j].w * rinv * gg.w}; }
            }
        }
    }
    if (PROBE_STAMP >= 0) { STAMP_AT(15); if (blockIdx.x == PROBE_BLOCK) { const unsigned long long t1_ = __builtin_amdgcn_s_memrealtime(); while (__builtin_amdgcn_s_memrealtime() - t1_ < st_dt_) __builtin_amdgcn_s_sleep(8); } }
#undef IN
#undef SEAM
}

extern "C" void kernel_launch(void* const* d_in, const int* in_sizes, int n_in, void* d_out, int out_size, void* d_ws, size_t ws_size, hipStream_t stream) {
    static int grid = 0;
    if (grid == 0) {
        if (n_in != 26 || out_size != M * D || ws_size < WS_END) { fprintf(stderr, "kernel_launch: unexpected sizes n_in %d out %d ws %zu\n", n_in, out_size, ws_size); grid = -1; return; }
        int dev = 0, cus = 0;
        if (hipGetDevice(&dev) != hipSuccess || hipDeviceGetAttribute(&cus, hipDeviceAttributeMultiprocessorCount, dev) != hipSuccess) { grid = -1; return; }
        if (hipFuncSetAttribute((const void*)fwd, hipFuncAttributeMaxDynamicSharedMemorySize, LDS_BYTES) != hipSuccess) { fprintf(stderr, "kernel_launch: hipFuncSetAttribute failed\n"); grid = -1; return; }
        int per_cu = 0;
        (void)hipOccupancyMaxActiveBlocksPerMultiprocessor(&per_cu, (const void*)fwd, NTHR, LDS_BYTES);
        (void)hipGetLastError();
        grid = cus;
    }
    if (grid < 0) return;
    (void)hipMemsetAsync((char*)d_ws + WS_CTL, 0, CTL_ZERO_BYTES, stream);
    Args a{};
    for (int i = 0; i < 26; ++i) a.in[i] = d_in[i];
    a.out = (float*)d_out; a.ws = (unsigned char*)d_ws;
#if MK_PER_PHASE
    for (int p = 0; p < NPHASE; ++p) { a.ph_lo = p; a.ph_hi = p + 1; hipLaunchKernelGGL(fwd, dim3(grid), dim3(NTHR), LDS_BYTES, stream, a); }
#else
    a.ph_lo = 0; a.ph_hi = NPHASE; hipLaunchKernelGGL(fwd, dim3(grid), dim3(NTHR), LDS_BYTES, stream, a);
#endif
}
```

```cpp
#include <hip/hip_runtime.h>
#include <cstdio>
#include <cstdint>

#ifndef MK_PER_PHASE
#define MK_PER_PHASE 0
#endif

#ifndef PROBE_STAMP
#define PROBE_STAMP -1
#endif
#ifndef PROBE_BLOCK
#define PROBE_BLOCK 0
#endif
#ifndef PROBE_REP
#define PROBE_REP 0
#endif
#define GAS __attribute__((address_space(1)))
#define LAS __attribute__((address_space(3)))
typedef unsigned short bf16_t;
typedef unsigned v4u __attribute__((ext_vector_type(4)));
typedef unsigned v2u __attribute__((ext_vector_type(2)));
typedef float f32x4 __attribute__((ext_vector_type(4)));
typedef short bf16x8 __attribute__((ext_vector_type(8)));

constexpr int BATCH = 4, SEQ = 4096, D = 1024, M = BATCH * SEQ, NIN = 5120;
constexpr int MEMLEN = 256, MM = BATCH * MEMLEN;
constexpr int NE = 32, TOPK = 4, DFF = 1024;
constexpr float NORM_EPS = 1e-6f;
constexpr int C_SBQ = 0, C_SBK = 512, C_SBV = 1024, C_DQ = 1536, C_DK = 2048, C_DV = 2560, C_GSB = 3072, C_GDF = 4096;
constexpr int LISTCAP = 16384;
constexpr int SLOTS = 65536 + NE * 256;
constexpr int NWAVES = 8, NTHR = 512;

constexpr size_t MiB = 1u << 20;
constexpr size_t WS_CTL = 0, CTL_ZERO_BYTES = 1 * MiB;
constexpr size_t WS_WIN = 2 * MiB;
constexpr size_t WS_WUPSB = 12 * MiB;
constexpr size_t WS_WUPDF = 13 * MiB;
constexpr size_t WS_WOUT = 14 * MiB;
constexpr size_t WS_WMQ = 16 * MiB;
constexpr size_t WS_WMKV = 18 * MiB;
constexpr size_t WS_WMO = 22 * MiB;
constexpr size_t WS_ROPE = 24 * MiB;
constexpr size_t WS_TK = 28 * MiB;
constexpr size_t WS_WR = 29 * MiB;
constexpr size_t WS_WSC = 30 * MiB;
constexpr size_t WS_WGU = 32 * MiB;
constexpr size_t WS_WD = 160 * MiB;
constexpr size_t WS_XN = 224 * MiB;
constexpr size_t WS_PR = 256 * MiB;
constexpr size_t WS_OAT = 416 * MiB;
constexpr size_t WS_ODR = 448 * MiB;
constexpr size_t WS_MIX = 512 * MiB;
constexpr size_t WS_X1 = 544 * MiB;
constexpr size_t WS_X2 = 608 * MiB;
constexpr size_t WS_HM = 672 * MiB;
constexpr size_t WS_KVM = 674 * MiB;
constexpr size_t WS_TLIST = 678 * MiB;
constexpr size_t WS_GLIST = 680 * MiB;
constexpr size_t WS_QM = 682 * MiB;
constexpr size_t WS_OM = 714 * MiB;
constexpr size_t WS_ACT = 256 * MiB;
constexpr size_t WS_YB = 746 * MiB;
constexpr size_t WS_VTSB = 890 * MiB;
constexpr size_t WS_VTDF = 906 * MiB;
constexpr size_t WS_VTM = 922 * MiB;
constexpr size_t WS_END = 924 * MiB;
static_assert(WS_ACT + (size_t)SLOTS * 1024 * 2 <= WS_OAT, "ACT overlay");
static_assert(WS_YB + (size_t)SLOTS * 1024 * 2 <= WS_VTSB, "YB");
constexpr int CW_REDO = 16384;
constexpr int CW_SBQ = 6144;
constexpr int CW_CNT = 8192;
constexpr int CW_BAR = 1024;

constexpr int LDS_BYTES = 147456;
constexpr int MISC_OFF = 131072 + 320;

__device__ __forceinline__ float bf2f(bf16_t b) { return __uint_as_float(((unsigned)b) << 16); }
__device__ __forceinline__ unsigned f2bf(float f) { unsigned u = __float_as_uint(f); return (u + 0x7fffu + ((u >> 16) & 1u)) >> 16; }
__device__ __forceinline__ unsigned pk2(float lo, float hi) { return f2bf(lo) | (f2bf(hi) << 16); }
__device__ __forceinline__ unsigned pk4_fp8(float a, float b, float c, float d) { int w = 0; w = __builtin_amdgcn_cvt_pk_fp8_f32(a, b, w, false); w = __builtin_amdgcn_cvt_pk_fp8_f32(c, d, w, true); return (unsigned)w; }
__device__ __forceinline__ float lo16(unsigned w) { return __uint_as_float(w << 16); }
__device__ __forceinline__ float hi16(unsigned w) { return __uint_as_float(w & 0xffff0000u); }
#define LDS_WAIT() asm volatile("s_waitcnt lgkmcnt(0)" ::: "memory")
__device__ __forceinline__ float wave_sum(float v) {
#pragma unroll
    for (int o = 1; o < 64; o <<= 1) v += __shfl_xor(v, o);
    return v;
}
__device__ __forceinline__ float wave_max(float v) {
#pragma unroll
    for (int o = 1; o < 64; o <<= 1) v = fmaxf(v, __shfl_xor(v, o));
    return v;
}

#define XB_TMO      128
#define XB_XCNT(j)  (256  + 64 * (j))
#define XB_XSUB(j)  (1280 + 64 * (j))
#define XB_XGEN(j)  (2304 + 64 * (j))
#define XB_TOP      3328
#define XB_TOPGEN   3392
#define XCD_BAR_WORDS 3456
#define XB_SPIN_CAP (1u << 18)
__device__ __forceinline__ unsigned xb_ld(unsigned* p)              { return __hip_atomic_load(p, __ATOMIC_RELAXED, __HIP_MEMORY_SCOPE_AGENT); }
__device__ __forceinline__ unsigned xb_add(unsigned* p, unsigned v) { return __hip_atomic_fetch_add(p, v, __ATOMIC_RELAXED, __HIP_MEMORY_SCOPE_AGENT); }
__device__ __forceinline__ unsigned xb_xcc_id() { return (unsigned)__builtin_amdgcn_s_getreg((3 << 11) | 20) & 0xFu; }
#define XB_SPIN(cond, bar) do { unsigned _sp = 0; while (cond) { __builtin_amdgcn_s_sleep(1); \
    if ((++_sp & 255u) == 0u) { if (xb_ld(&(bar)[XB_TMO])) break; if (_sp > XB_SPIN_CAP) { atomicAdd(&(bar)[XB_TMO], 1u); break; } } } } while (0)
struct XcdBarrier { unsigned* bar; unsigned x; volatile LAS unsigned* st; };
__device__ __forceinline__ XcdBarrier xcd_barrier_post(unsigned* bar, volatile LAS unsigned* st) {
    XcdBarrier b; b.bar = bar; b.x = xb_xcc_id(); b.st = st;
    if (threadIdx.x == 0) (void)xb_add(&bar[XB_XCNT(b.x)], 1u);
    return b;
}
__device__ __forceinline__ void xcd_barrier_complete(unsigned* bar, unsigned x, unsigned& nloc, unsigned& nx) {
    const unsigned G = gridDim.x * gridDim.y * gridDim.z;
    unsigned sum, cnt, mine, sp = 0u;
    for (;;) {
        sum = 0u; cnt = 0u; mine = 0u;
#pragma unroll
        for (unsigned j = 0; j < 16; ++j) { const unsigned c = xb_ld(&bar[XB_XCNT(j)]); sum += c; cnt += (c > 0u) ? 1u : 0u; mine = (j == x) ? c : mine; }
        if (sum == G) break;
        __builtin_amdgcn_s_sleep(1);
        if ((++sp & 255u) == 0u) { if (xb_ld(&bar[XB_TMO])) break; if (sp > XB_SPIN_CAP) { atomicAdd(&bar[XB_TMO], 1u); break; } }
    }
    nloc = mine > 0u ? mine : 1u; nx = cnt > 0u ? cnt : 1u;
}
__device__ __forceinline__ void xcd_barrier(const XcdBarrier& b) {
    asm volatile("s_waitcnt vmcnt(0)" ::: "memory");
    __syncthreads();
    if (threadIdx.x == 0) {
        unsigned* bar = b.bar;
        __builtin_amdgcn_s_waitcnt(0);
        unsigned nloc = b.st[0], nx = b.st[1];
        if (nloc == 0u) { xcd_barrier_complete(bar, b.x, nloc, nx); b.st[0] = nloc; b.st[1] = nx; }
        const unsigned old = xb_add(&bar[XB_XSUB(b.x)], 1u);
        const unsigned gen = old / nloc;
        if (old + 1u == (gen + 1u) * nloc) {
            __builtin_amdgcn_fence(__ATOMIC_RELEASE, "agent");
            asm volatile("s_waitcnt vmcnt(0)" ::: "memory");
            const unsigned og = xb_add(&bar[XB_TOP], 1u);
            const unsigned tg = og / nx;
            if (og + 1u == (tg + 1u) * nx) xb_add(&bar[XB_TOPGEN], 1u);
            else XB_SPIN(xb_ld(&bar[XB_TOPGEN]) == tg, bar);
            __builtin_amdgcn_fence(__ATOMIC_ACQUIRE, "agent");
            xb_add(&bar[XB_XGEN(b.x)], 1u);
            asm volatile("s_waitcnt vmcnt(0)" ::: "memory");
        } else {
            XB_SPIN(xb_ld(&bar[XB_XGEN(b.x)]) == gen, bar);
            __builtin_amdgcn_fence(__ATOMIC_ACQUIRE, "agent");
            asm volatile("s_waitcnt vmcnt(0)" ::: "memory");
        }
    }
    __syncthreads();
}

__device__ __forceinline__ void p0_transpose_item(const float* W, int K, int N, bf16_t* WT, int drow0, int k0, int n0, LAS float* scr, int lane, const float* gain = nullptr, int ldw = 0, int koff = 0) {
    if (ldw == 0) ldw = K;
#pragma unroll 8
    for (int i = 0; i < 32; ++i) { const int kk = 2 * i + (lane >> 5); float v = W[(size_t)(k0 + kk) * N + n0 + (lane & 31)]; if (gain) v *= gain[k0 + kk]; scr[kk * 33 + (lane & 31)] = v; }
    LDS_WAIT(); asm volatile("" ::: "memory");
    const int c = lane & 7;
#pragma unroll
    for (int j = 0; j < 4; ++j) { const int n = (lane >> 3) + 8 * j; const LAS float* s = scr + (8 * c) * 33 + n;
        v4u o; o.x = pk2(s[0 * 33], s[1 * 33]); o.y = pk2(s[2 * 33], s[3 * 33]); o.z = pk2(s[4 * 33], s[5 * 33]); o.w = pk2(s[6 * 33], s[7 * 33]);
        *(v4u*)(WT + (size_t)(drow0 + n) * ldw + koff + k0 + 8 * c) = o; }
    LDS_WAIT(); asm volatile("" ::: "memory");
}
__device__ __forceinline__ void p0_plain(const float* W, int K, int N, bf16_t* WT, int item, LAS float* scr, int lane, const float* gain = nullptr, int ldw = 0, int koff = 0) {
    const int nblk = N / 32, kb = item / nblk, nb = item % nblk;
    p0_transpose_item(W, K, N, WT, 32 * nb, 64 * kb, 32 * nb, scr, lane, gain, ldw, koff);
}
__device__ __forceinline__ void p0_transpose_rope(const float* W, bf16_t* WT, int tilebase, int o, int k0, int n0, LAS float* scr, int lane) {
    const int K = 1024, N = NIN;
#pragma unroll 8
    for (int i = 0; i < 32; ++i) { const int kk = 2 * i + (lane >> 5); scr[kk * 33 + (lane & 31)] = W[(size_t)(k0 + kk) * N + n0 + (lane & 31)]; }
    LDS_WAIT(); asm volatile("" ::: "memory");
    const int c = lane & 7;
#pragma unroll
    for (int j = 0; j < 4; ++j) { const int n = (lane >> 3) + 8 * j; const LAS float* s = scr + (8 * c) * 33 + n;
        const int oo = o + n, v = ((oo >> 6) << 6) | (((oo >> 4) & 1) << 5) | (((oo >> 2) & 3) << 3) | (((oo >> 5) & 1) << 2) | (oo & 3);
        v4u w; w.x = pk2(s[0 * 33], s[1 * 33]); w.y = pk2(s[2 * 33], s[3 * 33]); w.z = pk2(s[4 * 33], s[5 * 33]); w.w = pk2(s[6 * 33], s[7 * 33]);
        *(v4u*)(WT + (size_t)(tilebase + v) * K + k0 + 8 * c) = w; }
    LDS_WAIT(); asm volatile("" ::: "memory");
}
__device__ __forceinline__ void rms_row_to_bf16(const float* xrow, const float* g, bf16_t* orow, int lane) {
    const f32x4* xr = (const f32x4*)xrow + lane; const f32x4* gr = (const f32x4*)g + lane;
    f32x4 v[4]; float s = 0.f;
#pragma unroll
    for (int j = 0; j < 4; ++j) { v[j] = xr[64 * j]; s += (v[j].x * v[j].x + v[j].y * v[j].y) + (v[j].z * v[j].z + v[j].w * v[j].w); }
    const float rinv = 1.0f / sqrtf(wave_sum(s) * (1.f / 1024.f) + NORM_EPS);
    v2u* o8 = (v2u*)orow + lane;
#pragma unroll
    for (int j = 0; j < 4; ++j) { const f32x4 gg = gr[64 * j]; v2u w; w.x = pk2(v[j].x * rinv * gg.x, v[j].y * rinv * gg.y); w.y = pk2(v[j].z * rinv * gg.z, v[j].w * rinv * gg.w); o8[64 * j] = w; }
}

__device__ __forceinline__ void rms_row_to_fp8(const float* xrow, const float* g, unsigned char* orow, int lane) {
    const f32x4* xr = (const f32x4*)xrow + lane; const f32x4* gr = (const f32x4*)g + lane;
    f32x4 v[4]; float s = 0.f;
#pragma unroll
    for (int j = 0; j < 4; ++j) { v[j] = xr[64 * j]; s += (v[j].x * v[j].x + v[j].y * v[j].y) + (v[j].z * v[j].z + v[j].w * v[j].w); }
    const float rinv = 1.0f / sqrtf(wave_sum(s) * (1.f / 1024.f) + NORM_EPS);
    unsigned* o4 = (unsigned*)orow + lane;
#pragma unroll
    for (int j = 0; j < 4; ++j) { const f32x4 gg = gr[64 * j]; o4[64 * j] = pk4_fp8(v[j].x * rinv * gg.x, v[j].y * rinv * gg.y, v[j].z * rinv * gg.z, v[j].w * rinv * gg.w); }
}
template <int NB, class RowPtr, class Epi>
__device__ __forceinline__ void ngemm_tile(const RowPtr& rp, const bf16_t* Bt, int ldb, int b1off, int K, int m0, int n0, int mvalid, const Epi& epi, LAS float* sm) {
    const int t = threadIdx.x, r = t >> 2, kq = (t & 3) * 4, ty = t >> 5, tx = t & 31;
    LAS float* As = sm; LAS float* Bs0 = sm + 16 * 132; LAS float* Bs1 = sm + 32 * 132;
    float acc[NB][8][4];
#pragma unroll
    for (int b = 0; b < NB; ++b)
#pragma unroll
        for (int i = 0; i < 8; ++i)
#pragma unroll
            for (int j = 0; j < 4; ++j) acc[b][i][j] = 0.f;
    const bf16_t* arow = rp(m0 + r) + kq;
    const bf16_t* brow0 = Bt + (size_t)(n0 + r) * ldb + kq;
    const bf16_t* brow1 = Bt + (size_t)(n0 + b1off + r) * ldb + kq;
    for (int k0 = 0; k0 < K; k0 += 16) {
        const v2u av = *(const v2u*)(arow + k0);
        const v2u bv0 = *(const v2u*)(brow0 + k0);
        v2u bv1 = bv0; if (NB == 2) bv1 = *(const v2u*)(brow1 + k0);
        As[(kq + 0) * 132 + r] = lo16(av.x); As[(kq + 1) * 132 + r] = hi16(av.x); As[(kq + 2) * 132 + r] = lo16(av.y); As[(kq + 3) * 132 + r] = hi16(av.y);
        Bs0[(kq + 0) * 132 + r] = lo16(bv0.x); Bs0[(kq + 1) * 132 + r] = hi16(bv0.x); Bs0[(kq + 2) * 132 + r] = lo16(bv0.y); Bs0[(kq + 3) * 132 + r] = hi16(bv0.y);
        if (NB == 2) { Bs1[(kq + 0) * 132 + r] = lo16(bv1.x); Bs1[(kq + 1) * 132 + r] = hi16(bv1.x); Bs1[(kq + 2) * 132 + r] = lo16(bv1.y); Bs1[(kq + 3) * 132 + r] = hi16(bv1.y); }
        __syncthreads();
#pragma unroll 2
        for (int kk = 0; kk < 16; ++kk) {
            const f32x4 a0 = *(const LAS f32x4*)(As + kk * 132 + ty * 8), a1 = *(const LAS f32x4*)(As + kk * 132 + ty * 8 + 4);
            const f32x4 b0 = *(const LAS f32x4*)(Bs0 + kk * 132 + tx * 4);
            const float a[8] = {a0.x, a0.y, a0.z, a0.w, a1.x, a1.y, a1.z, a1.w};
#pragma unroll
            for (int i = 0; i < 8; ++i) { acc[0][i][0] += a[i] * b0.x; acc[0][i][1] += a[i] * b0.y; acc[0][i][2] += a[i] * b0.z; acc[0][i][3] += a[i] * b0.w; }
            if (NB == 2) { const f32x4 b1 = *(const LAS f32x4*)(Bs1 + kk * 132 + tx * 4);
#pragma unroll
                for (int i = 0; i < 8; ++i) { acc[NB - 1][i][0] += a[i] * b1.x; acc[NB - 1][i][1] += a[i] * b1.y; acc[NB - 1][i][2] += a[i] * b1.z; acc[NB - 1][i][3] += a[i] * b1.w; } }
        }
        __syncthreads();
    }
#pragma unroll
    for (int i = 0; i < 8; ++i) { const int m = m0 + ty * 8 + i;
        if (m < mvalid) {
#pragma unroll
            for (int j = 0; j < 4; ++j) epi(m, n0 + tx * 4 + j, acc[0][i][j], acc[NB - 1][i][j]); } }
}
struct RowPlain { const bf16_t* A; int lda; __device__ __forceinline__ const bf16_t* operator()(int m) const { return A + (size_t)m * lda; } };

template <class Epi>
__device__ __forceinline__ void ngemm_dense(const bf16_t* A, int lda, const bf16_t* Bt, int ldb, int Mr, int N, int K, const Epi& epi, LAS float* sm) {
    const int nn = N / 128, nunits = (Mr / 128) * nn; RowPlain rp{A, lda};
    for (int u = blockIdx.x; u < nunits; u += gridDim.x) ngemm_tile<1>(rp, Bt, ldb, 0, K, (u / nn) * 128, (u % nn) * 128, Mr, epi, sm);
}

struct EpiStoreBf16 { bf16_t* O; int ldc; __device__ __forceinline__ void operator()(int m, int n, float a, float) const { O[(size_t)m * ldc + n] = (bf16_t)f2bf(a); } };
struct EpiGate1 { const bf16_t* PR; float* T; __device__ __forceinline__ void operator()(int m, int n, float a, float) const { T[(size_t)m * D + n] = bf2f(PR[(size_t)m * NIN + C_GSB + n]) * a; } };
struct EpiGate2 { const bf16_t* PR; const float* T; bf16_t* MIX; __device__ __forceinline__ void operator()(int m, int n, float a, float) const {
    MIX[(size_t)m * D + n] = (bf16_t)f2bf(T[(size_t)m * D + n] + bf2f(PR[(size_t)m * NIN + C_GDF + n]) * a); } };
struct EpiResid { const float* base; float* out; __device__ __forceinline__ void operator()(int m, int n, float a, float) const { out[(size_t)m * D + n] = base[(size_t)m * D + n] + a; } };


namespace pg8 {
constexpr int BM = 256, BK = 64, HALF = 128, HTB = HALF * BK * 2, STAGE_BYTES = 8 * HTB;
__host__ __device__ __forceinline__ int lds_byte(int r, int c) { const int st = (r >> 4) * 2 + (c >> 5), rr = r & 15, cc = c & 31, ob = rr * 64 + cc * 2; return st * 1024 + (ob ^ (((ob >> 9) & 1) << 5)); }
__host__ __device__ __forceinline__ void stage_rc(int b, int& R, int& C) { const int st = b / 1024, sb = b % 1024, swz = sb ^ (((sb >> 9) & 1) << 5); R = (st >> 1) * 16 + swz / 64; C = (st & 1) * 32 + (swz % 64) / 2; }
__host__ __device__ __forceinline__ int perm32(int rho) { const int n = rho >> 4, i = rho & 15; return 8 * (i >> 2) + 4 * n + (i & 3); }
struct Unit { int pm, pn, e; };
struct Gemm { const bf16_t* A; const bf16_t* Bt; int lda, ldb, K; };
typedef float f32x2 __attribute__((ext_vector_type(2))); typedef __bf16 bf16x2_t __attribute__((ext_vector_type(2)));
__device__ __forceinline__ unsigned cvt_pk_bf16(float lo, float hi) { f32x2 v = {lo, hi}; bf16x2_t b = __builtin_convertvector(v, bf16x2_t); return __builtin_bit_cast(unsigned, b); }

typedef int v8i __attribute__((ext_vector_type(8))); typedef int v4i __attribute__((ext_vector_type(4)));
__device__ __forceinline__ v8i cat8(bf16x8 a, bf16x8 b) { return __builtin_shufflevector(__builtin_bit_cast(v4i, a), __builtin_bit_cast(v4i, b), 0, 1, 2, 3, 4, 5, 6, 7); }
template <class Epi, class Sched, bool GATHER, bool FP8 = false>
__device__ __forceinline__ void gemm_phase(LAS unsigned char* lds, const Gemm g, const Sched& S, const Epi& E) {
    const int tid = threadIdx.x, wid = __builtin_amdgcn_readfirstlane(tid >> 6), lane = tid & 63, wr = wid >> 2, wc = wid & 3, fr = lane & 15, fq = lane >> 4;
    const int K = g.K, nt = K / BK;
    unsigned voffB[2], cva[2][2], nva[2][2];
#pragma unroll
    for (int i = 0; i < 2; ++i) { int R, C; stage_rc(tid * 16 + i * 8192, R, C); const int Rb = (R & ~31) + perm32(R & 31);
        voffB[i] = (unsigned)(Rb * g.ldb + C) * 2u;
#pragma unroll
        for (int h = 0; h < 2; ++h) { cva[h][i] = (unsigned)((h * HALF + R) * g.lda + C) * 2u; nva[h][i] = cva[h][i]; } }
    const unsigned kstep = (unsigned)(BK * 2);
    const unsigned hstepB = (unsigned)(HALF * g.ldb * 2);
    auto uni_ptr = [](const void* p_) { const unsigned long long v_ = (unsigned long long)p_; return (void*)(((unsigned long long)(unsigned)__builtin_amdgcn_readfirstlane((int)(v_ >> 32)) << 32) | (unsigned)__builtin_amdgcn_readfirstlane((int)v_)); };
    const auto rA = __builtin_amdgcn_make_buffer_rsrc(uni_ptr(g.A), 0, 0x7fffffff, 0x00020000), rB = __builtin_amdgcn_make_buffer_rsrc(uni_ptr(g.Bt), 0, 0x7fffffff, 0x00020000);
    const unsigned ldsw = (unsigned)wid * 1024u;
    const int aoff = lds_byte(wr * 64 + fr, fq * 8), boff = lds_byte(wc * 32 + fr, fq * 8);
#define PG8_SA(b, h) (((b) * 2 + (h)) * HTB)
#define PG8_SB(b, h) ((4 + (b) * 2 + (h)) * HTB)
#define PG8_STAGE(bufoff, rs, soff, voff) do { _Pragma("unroll") for (int _i = 0; _i < 2; ++_i) \
        __builtin_amdgcn_raw_ptr_buffer_load_lds(rs, (LAS unsigned*)(lds + (bufoff) + ldsw + _i * 8192), 16, (int)(voff)[_i], (int)(soff), 0, 0); } while (0)
#define PG8_LDA(dst, b, h) do { _Pragma("unroll") for (int m = 0; m < 4; ++m) _Pragma("unroll") for (int k = 0; k < 2; ++k) dst[m][k] = *(const LAS bf16x8*)(lds + PG8_SA(b, h) + aoff + m * 2048 + k * 1024); } while (0)
#define PG8_LDB(dst, b, h) do { _Pragma("unroll") for (int n = 0; n < 2; ++n) _Pragma("unroll") for (int k = 0; k < 2; ++k) dst[n][k] = *(const LAS bf16x8*)(lds + PG8_SB(b, h) + boff + n * 2048 + k * 1024); } while (0)
#define PG8_MMA(ai, bj, At, Bt) do { __builtin_amdgcn_s_setprio(1); _Pragma("unroll") for (int m = 0; m < 4; ++m) _Pragma("unroll") for (int n = 0; n < 2; ++n) { \
        if constexpr (FP8) { const v8i b8_ = cat8(Bt[n][0], Bt[n][1]), a8_ = cat8(At[m][0], At[m][1]); \
            asm volatile("s_nop 1\n\tv_mfma_scale_f32_16x16x128_f8f6f4 %0, %1, %2, %0, %3, %3 op_sel_hi:[0,0,0]" : "+v"(acc[ai][bj][m][n]) : "v"(b8_), "v"(a8_), "v"(one_scale)); } \
        else { _Pragma("unroll") for (int k = 0; k < 2; ++k) acc[ai][bj][m][n] = __builtin_amdgcn_mfma_f32_16x16x32_bf16(Bt[n][k], At[m][k], acc[ai][bj][m][n], 0, 0, 0); } } __builtin_amdgcn_s_setprio(0); } while (0)
#define PG8_WAIT_V(n) asm volatile("s_waitcnt vmcnt(" #n ")" ::: "memory")
#define PG8_WAIT_L(n) asm volatile("s_waitcnt lgkmcnt(" #n ")" ::: "memory")
#define PG8_BAR __builtin_amdgcn_s_barrier()
#define PG8_SCHED __builtin_amdgcn_sched_barrier(0)
    Unit cur, nxt; int ui = 0;
    if (!S.next(0, cur)) return;
    if constexpr (GATHER) {
#pragma unroll
        for (int i = 0; i < 2; ++i) { int R, C; stage_rc(tid * 16 + i * 8192, R, C);
#pragma unroll
            for (int h = 0; h < 2; ++h) cva[h][i] = (unsigned)(S.tok(cur, h * HALF + R) * g.lda + C) * 2u; }
    }
    const int one_scale = 0x7f7f7f7f;
    (void)one_scale;
    f32x4 acc[2][2][4][2];
#pragma unroll
    for (int a = 0; a < 2; ++a)
#pragma unroll
        for (int b = 0; b < 2; ++b)
#pragma unroll
            for (int m = 0; m < 4; ++m)
#pragma unroll
                for (int n = 0; n < 2; ++n) acc[a][b][m][n] = (f32x4){0.f, 0.f, 0.f, 0.f};
    bf16x8 At[4][2], B0[2][2], B1[2][2];
    unsigned cA = GATHER ? 0u : (unsigned)S.a_off(cur), cB = (unsigned)S.b_off(cur);
    PG8_STAGE(PG8_SB(0, 0), rB, cB, voffB); PG8_STAGE(PG8_SB(0, 1), rB, cB + hstepB, voffB); PG8_STAGE(PG8_SA(0, 0), rA, cA, cva[0]); PG8_STAGE(PG8_SA(0, 1), rA, cA, cva[1]);
    if (wr == 1) PG8_BAR;
    PG8_WAIT_V(2); PG8_BAR;
    PG8_STAGE(PG8_SB(1, 0), rB, cB + kstep, voffB); PG8_STAGE(PG8_SA(1, 0), rA, cA + kstep, cva[0]); PG8_STAGE(PG8_SB(1, 1), rB, cB + hstepB + kstep, voffB);
    PG8_WAIT_V(6); PG8_BAR;
    for (;;) {
        const bool has_next = S.next(ui + 1, nxt);
        const unsigned nA = (has_next && !GATHER) ? (unsigned)S.a_off(nxt) : cA, nB = has_next ? (unsigned)S.b_off(nxt) : cB;
        if constexpr (GATHER) {
#pragma unroll
            for (int i = 0; i < 2; ++i) { int R, C; stage_rc(tid * 16 + i * 8192, R, C);
#pragma unroll
                for (int h = 0; h < 2; ++h) nva[h][i] = has_next ? (unsigned)(S.tok(nxt, h * HALF + R) * g.lda + C) * 2u : cva[h][i]; }
        }
#pragma nounroll
        for (int t = 0; t < nt; t += 2) {
            const bool last = (t == nt - 2);
            const unsigned a1 = cA + (unsigned)(t + 1) * kstep;
            const unsigned a2 = last ? nA : cA + (unsigned)(t + 2) * kstep, b2 = last ? nB : cB + (unsigned)(t + 2) * kstep;
            const unsigned a3 = a2 + kstep, b3 = b2 + kstep;
            PG8_LDB(B0, 0, 0); PG8_LDB(B1, 0, 1); PG8_SCHED; PG8_LDA(At, 0, 0); PG8_STAGE(PG8_SA(1, 1), rA, a1, cva[1]);
            if constexpr (GATHER) { if (last) {
#pragma unroll
                for (int h = 0; h < 2; ++h)
#pragma unroll
                    for (int i = 0; i < 2; ++i) cva[h][i] = nva[h][i]; } }
            PG8_WAIT_V(8); PG8_WAIT_L(0); PG8_BAR; PG8_MMA(0, 0, At, B0); PG8_MMA(0, 1, At, B1); PG8_BAR; PG8_SCHED;
            PG8_LDA(At, 0, 1); PG8_STAGE(PG8_SB(0, 0), rB, b2, voffB); PG8_STAGE(PG8_SB(0, 1), rB, b2 + hstepB, voffB); PG8_STAGE(PG8_SA(0, 0), rA, a2, cva[0]);
            PG8_WAIT_V(8); PG8_WAIT_L(0); PG8_BAR; PG8_MMA(1, 0, At, B0); PG8_MMA(1, 1, At, B1); PG8_BAR; PG8_SCHED;
            PG8_LDB(B0, 1, 0); PG8_LDB(B1, 1, 1); PG8_SCHED; PG8_LDA(At, 1, 0); PG8_STAGE(PG8_SA(0, 1), rA, a2, cva[1]);
            PG8_WAIT_V(8); PG8_WAIT_L(0); PG8_BAR; PG8_MMA(0, 0, At, B0); PG8_MMA(0, 1, At, B1); PG8_BAR; PG8_SCHED;
            PG8_LDA(At, 1, 1); PG8_STAGE(PG8_SB(1, 0), rB, b3, voffB); PG8_STAGE(PG8_SB(1, 1), rB, b3 + hstepB, voffB); PG8_STAGE(PG8_SA(1, 0), rA, a3, cva[0]);
            PG8_WAIT_V(8); PG8_WAIT_L(0); PG8_BAR; PG8_MMA(1, 0, At, B0); PG8_MMA(1, 1, At, B1); PG8_BAR; PG8_SCHED;
        }
        if (wr == 0) PG8_BAR;
        if constexpr (FP8) asm volatile("s_nop 15\n\ts_nop 7" ::: "memory");
        E(acc, cur, wr, wc, fr, fq);
        if (!has_next) break;
#pragma unroll
        for (int a = 0; a < 2; ++a)
#pragma unroll
            for (int b = 0; b < 2; ++b)
#pragma unroll
                for (int m = 0; m < 4; ++m)
#pragma unroll
                    for (int n = 0; n < 2; ++n) acc[a][b][m][n] = (f32x4){0.f, 0.f, 0.f, 0.f};
        cur = nxt; cA = nA; cB = nB; ++ui;
        if constexpr (GATHER) {
#pragma unroll
            for (int i = 0; i < 2; ++i)
#pragma unroll
                for (int h = 0; h < 2; ++h) cva[h][i] = nva[h][i];
        }
        if (wr == 1) PG8_BAR;
    }
    PG8_WAIT_V(0);
    PG8_BAR;
#undef PG8_SA
#undef PG8_SB
#undef PG8_STAGE
#undef PG8_LDA
#undef PG8_LDB
#undef PG8_MMA
#undef PG8_WAIT_V
#undef PG8_WAIT_L
#undef PG8_BAR
#undef PG8_SCHED
}

struct DenseOrder {
    int nM, nN, nwg, G, c, lda, ldb, i0 = 0, i1 = 1 << 30;
    __device__ __forceinline__ void init(int M_, int N_, int G_, int c_, int lda_, int ldb_) { nM = M_ / BM; nN = N_ / BM; nwg = nM * nN; G = G_; c = c_; lda = lda_; ldb = ldb_; }
    __device__ __forceinline__ bool next(int i, Unit& u) const {
        if (i + i0 >= i1) return false;
        const long L = (long)(i + i0) * G + c; if (L >= nwg) return false;
        int wgid = (int)L; { const int q = nwg / 8, r = nwg % 8, xcd = wgid % 8, off = wgid / 8; wgid = (xcd < r ? xcd * (q + 1) : r * (q + 1) + (xcd - r) * q) + off; }
        const int nig = 8 * nN, gid = wgid / nig, fm = gid * 8, gsz = (nM - fm) < 8 ? (nM - fm) : 8;
        u.pm = fm + ((wgid % nig) % gsz); u.pn = (wgid % nig) / gsz; u.e = 0; return true;
    }
    __device__ __forceinline__ size_t a_off(const Unit& u) const { return (size_t)u.pm * BM * lda * 2; }
    __device__ __forceinline__ size_t b_off(const Unit& u) const { return (size_t)u.pn * BM * ldb * 2; }
    __device__ __forceinline__ int tok(const Unit&, int) const { return 0; }
};
struct TwoRoundOrder {
    int G, c, lda, ldb;
    __device__ __forceinline__ bool next(int i, Unit& u) const { const int L = i * G + c; if (L >= 512) return false; const int tile = L & 255; u.pm = tile >> 2; u.pn = tile & 3; u.e = L >> 8; return true; }
    __device__ __forceinline__ size_t a_off(const Unit& u) const { return (size_t)u.pm * BM * lda * 2 + (size_t)u.e * 1024; }
    __device__ __forceinline__ size_t b_off(const Unit& u) const { return (size_t)(u.e * 1024 + u.pn * BM) * ldb * 2; }
    __device__ __forceinline__ int tok(const Unit&, int) const { return 0; }
};
struct MoeOrder {
    const LAS int* tb; const int* tlist; int G, c, npn, lda, ldb, nexp;
    __device__ __forceinline__ bool next(int i, Unit& u) const {
        const int L = i * G + c; if (L >= tb[96]) return false;
        int e = 0; while (tb[65 + e] <= L) ++e;
        const int loc = L - tb[64 + e]; u.e = __builtin_amdgcn_readfirstlane(e); u.pn = __builtin_amdgcn_readfirstlane(loc % npn); u.pm = __builtin_amdgcn_readfirstlane((tb[e] >> 8) + loc / npn); return true;
    }
    __device__ __forceinline__ size_t a_off(const Unit& u) const { return (size_t)u.pm * BM * lda * 2; }
    __device__ __forceinline__ size_t b_off(const Unit& u) const { return (size_t)(u.e * nexp + u.pn * BM) * ldb * 2; }
    __device__ __forceinline__ int tok(const Unit& u, int row) const { const int r = u.pm * BM - tb[u.e] + row; return r < tb[32 + u.e] ? tlist[u.e * LISTCAP + r] : 0; }
};

#define EPI_ARGS const f32x4 (&acc)[2][2][4][2], const Unit& u, int wr, int wc, int fr, int fq
#define EPI_FOR_ROWS for (int ai = 0; ai < 2; ++ai) _Pragma("unroll") for (int m = 0; m < 4; ++m)
__device__ __forceinline__ v4u pack8(const f32x4 a, const f32x4 b) { v4u w; w.x = cvt_pk_bf16(a[0], a[1]); w.y = cvt_pk_bf16(a[2], a[3]); w.z = cvt_pk_bf16(b[0], b[1]); w.w = cvt_pk_bf16(b[2], b[3]); return w; }
__device__ __forceinline__ void unpack8(const v4u w, f32x4& a, f32x4& b) { a = (f32x4){lo16(w.x), hi16(w.x), lo16(w.y), hi16(w.y)}; b = (f32x4){lo16(w.z), hi16(w.z), lo16(w.w), hi16(w.w)}; }
__device__ __forceinline__ float sigm(float v) { return __builtin_amdgcn_rcpf(1.f + __expf(-v)); }

__device__ __forceinline__ void store_tile_T(const f32x4 (&acc)[2][2][4][2], bf16_t* VT, int vrow0, int s0, int pitch) {
#pragma unroll
    for (int bj = 0; bj < 2; ++bj)
#pragma unroll
        for (int n = 0; n < 2; ++n)
#pragma unroll
            for (int e = 0; e < 4; ++e) { bf16_t* vp = VT + (size_t)(vrow0 + 128 * bj + 4 * n + e) * pitch + s0;
#pragma unroll
                for (int ai = 0; ai < 2; ++ai)
#pragma unroll
                    for (int m = 0; m < 4; ++m) vp[128 * ai + 16 * m] = (bf16_t)(cvt_pk_bf16(acc[ai][bj][m][n][e], 0.f) & 0xffffu); }
}
struct EpiKV { static constexpr bool MIDHOOK = false; bf16_t* KVM; bf16_t* VTM;
    __device__ __forceinline__ void operator()(EPI_ARGS) const {
        const int row0 = u.pm * BM + wr * 64 + fr, col0 = u.pn * BM + wc * 32 + 8 * fq;
#pragma unroll
        EPI_FOR_ROWS { bf16_t* rowp = KVM + (size_t)(row0 + ai * HALF + m * 16) * 2048 + col0;
#pragma unroll
            for (int bj = 0; bj < 2; ++bj) *(v4u*)(rowp + bj * HALF) = pack8(acc[ai][bj][m][0], acc[ai][bj][m][1]); }
        if (u.pn >= 4) store_tile_T(acc, VTM, u.pm * 1024 + (u.pn - 4) * BM + wc * 32 + 8 * fq, wr * 64 + fr, MEMLEN);
    } };
struct EpiBf16Store { static constexpr bool MIDHOOK = false; bf16_t* O; int ldc;
    __device__ __forceinline__ void operator()(EPI_ARGS) const {
        const int row0 = u.pm * BM + wr * 64 + fr, col0 = u.pn * BM + wc * 32 + 8 * fq;
#pragma unroll
        EPI_FOR_ROWS { bf16_t* rowp = O + (size_t)(row0 + ai * HALF + m * 16) * ldc + col0;
#pragma unroll
            for (int bj = 0; bj < 2; ++bj) *(v4u*)(rowp + bj * HALF) = pack8(acc[ai][bj][m][0], acc[ai][bj][m][1]); }
    } };
struct EpiResidF32 { static constexpr bool MIDHOOK = false; const float* base; float* out;
    __device__ __forceinline__ void operator()(EPI_ARGS) const {
        const int row0 = u.pm * BM + wr * 64 + fr, col0 = u.pn * BM + wc * 32 + 8 * fq;
#pragma unroll
        EPI_FOR_ROWS { const size_t off = (size_t)(row0 + ai * HALF + m * 16) * D + col0;
#pragma unroll
            for (int bj = 0; bj < 2; ++bj)
#pragma unroll
                for (int n = 0; n < 2; ++n) { const f32x4 b = *(const f32x4*)(base + off + bj * HALF + 4 * n); *(f32x4*)(out + off + bj * HALF + 4 * n) = b + acc[ai][bj][m][n]; } }
    } };
struct EpiResidNorm { static constexpr bool MIDHOOK = false; const float* base; float* out; bf16_t* XB; float* SSQ;
    __device__ __forceinline__ void operator()(EPI_ARGS) const {
        const int row0 = u.pm * BM + wr * 64 + fr, col0 = u.pn * BM + wc * 32 + 8 * fq;
#pragma unroll
        EPI_FOR_ROWS { const int row = row0 + ai * HALF + m * 16; const size_t off = (size_t)row * D + col0; float ss = 0.f;
#pragma unroll
            for (int bj = 0; bj < 2; ++bj) { f32x4 v[2];
#pragma unroll
                for (int n = 0; n < 2; ++n) { v[n] = *(const f32x4*)(base + off + bj * HALF + 4 * n) + acc[ai][bj][m][n];
                    ss += (v[n][0] * v[n][0] + v[n][1] * v[n][1]) + (v[n][2] * v[n][2] + v[n][3] * v[n][3]); }
                *(v4u*)(XB + off + bj * HALF) = pack8(v[0], v[1]); }
            ss += __shfl_xor(ss, 16); ss += __shfl_xor(ss, 32);
            if (fq == 0) SSQ[(size_t)row * 16 + u.pn * 4 + wc] = ss; }
    } };
struct EpiBf16Rinv { static constexpr bool MIDHOOK = false; bf16_t* O; const float* SSQ; float qscale;
    __device__ __forceinline__ void operator()(EPI_ARGS) const {
        const int row0 = u.pm * BM + wr * 64 + fr, col0 = u.pn * BM + wc * 32 + 8 * fq;
#pragma unroll
        EPI_FOR_ROWS { const int row = row0 + ai * HALF + m * 16; const f32x4* sp = (const f32x4*)(SSQ + (size_t)row * 16);
            const f32x4 s0 = sp[0], s1 = sp[1], s2 = sp[2], s3 = sp[3];
            const float tot = (((s0[0] + s0[1]) + (s0[2] + s0[3])) + ((s1[0] + s1[1]) + (s1[2] + s1[3]))) + (((s2[0] + s2[1]) + (s2[2] + s2[3])) + ((s3[0] + s3[1]) + (s3[2] + s3[3])));
            const float rinv = qscale / sqrtf(tot * (1.f / 1024.f) + NORM_EPS);
            bf16_t* rowp = O + (size_t)row * D + col0;
#pragma unroll
            for (int bj = 0; bj < 2; ++bj) *(v4u*)(rowp + bj * HALF) = pack8(acc[ai][bj][m][0] * rinv, acc[ai][bj][m][1] * rinv); }
    } };
struct OneUnitOrder {
    int idx, lda, ldb;
    __device__ __forceinline__ bool next(int i, Unit& u) const { if (i > 0) return false; u.pm = idx >> 3; u.pn = idx & 7; u.e = 0; return true; }
    __device__ __forceinline__ size_t a_off(const Unit& u) const { return (size_t)u.pm * BM * lda * 2; }
    __device__ __forceinline__ size_t b_off(const Unit& u) const { return (size_t)u.pn * BM * ldb * 2; }
    __device__ __forceinline__ int tok(const Unit&, int) const { return 0; }
};
struct EpiGateK { static constexpr bool MIDHOOK = true; const bf16_t* PR; bf16_t* MIX;
    __device__ __forceinline__ void mid(f32x4 (&acc)[2][2][4][2], const Unit& u, int wr, int wc, int fr, int fq) const {
        const int row0 = u.pm * BM + wr * 64 + fr, col0 = u.pn * BM + wc * 32 + 8 * fq;
#pragma unroll
        EPI_FOR_ROWS { const bf16_t* gp = PR + (size_t)(row0 + ai * HALF + m * 16) * NIN + col0;
#pragma unroll
            for (int bj = 0; bj < 2; ++bj) { f32x4 a0, a1, d0, d1; unpack8(*(const v4u*)(gp + C_GSB + bj * HALF), a0, a1); unpack8(*(const v4u*)(gp + C_GDF + bj * HALF), d0, d1);
#pragma unroll
                for (int c = 0; c < 4; ++c) { acc[ai][bj][m][0][c] *= a0[c] * __builtin_amdgcn_rcpf(fmaxf(d0[c], 1e-30f)); acc[ai][bj][m][1][c] *= a1[c] * __builtin_amdgcn_rcpf(fmaxf(d1[c], 1e-30f)); }
                asm volatile("" : "+v"(acc[ai][bj][m][0]), "+v"(acc[ai][bj][m][1]) :: "memory"); } }
    }
    __device__ __forceinline__ void operator()(EPI_ARGS) const {
        const int row0 = u.pm * BM + wr * 64 + fr, col0 = u.pn * BM + wc * 32 + 8 * fq;
#pragma unroll
        EPI_FOR_ROWS { const int row = row0 + ai * HALF + m * 16;
#pragma unroll
            for (int bj = 0; bj < 2; ++bj) { f32x4 d0, d1; unpack8(*(const v4u*)(PR + (size_t)row * NIN + C_GDF + col0 + bj * HALF), d0, d1);
#pragma unroll
                for (int c = 0; c < 4; ++c) { d0[c] = fmaxf(d0[c], 1e-30f); d1[c] = fmaxf(d1[c], 1e-30f); }
                *(v4u*)(MIX + (size_t)row * D + col0 + bj * HALF) = pack8(acc[ai][bj][m][0] * d0, acc[ai][bj][m][1] * d1); } }
    } };
struct EpiResidB { static constexpr bool MIDHOOK = false; const bf16_t* base; float* out;
    __device__ __forceinline__ void operator()(EPI_ARGS) const {
        const int row0 = u.pm * BM + wr * 64 + fr, col0 = u.pn * BM + wc * 32 + 8 * fq;
#pragma unroll
        EPI_FOR_ROWS { const size_t off = (size_t)(row0 + ai * HALF + m * 16) * D + col0;
#pragma unroll
            for (int bj = 0; bj < 2; ++bj) { f32x4 b0, b1; unpack8(*(const v4u*)(base + off + bj * HALF), b0, b1);
                *(f32x4*)(out + off + bj * HALF) = b0 + acc[ai][bj][m][0]; *(f32x4*)(out + off + bj * HALF + 4) = b1 + acc[ai][bj][m][1]; } }
    } };
struct EpiGate { static constexpr bool MIDHOOK = false; const bf16_t* PR; bf16_t* T; bf16_t* MIX;
    __device__ __forceinline__ void operator()(EPI_ARGS) const {
        const int row0 = u.pm * BM + wr * 64 + fr, col0 = u.pn * BM + wc * 32 + 8 * fq;
#pragma unroll
        EPI_FOR_ROWS { const int row = row0 + ai * HALF + m * 16;
#pragma unroll
            for (int bj = 0; bj < 2; ++bj) { const int col = col0 + bj * HALF; f32x4 g0, g1;
                unpack8(*(const v4u*)(PR + (size_t)row * NIN + (u.e ? C_GDF : C_GSB) + col), g0, g1);
                bf16_t* tp = T + (size_t)row * D + col;
                if (u.e == 0) *(v4u*)tp = pack8(g0 * acc[ai][bj][m][0], g1 * acc[ai][bj][m][1]);
                else { f32x4 t0, t1; unpack8(*(const v4u*)tp, t0, t1); *(v4u*)(MIX + (size_t)row * D + col) = pack8(t0 + g0 * acc[ai][bj][m][0], t1 + g1 * acc[ai][bj][m][1]); } } }
    } };
struct EpiInProj { static constexpr bool MIDHOOK = false; bf16_t* PR; const float* rc; const float* rs; bf16_t* VTSB; bf16_t* VTDF;
    __device__ __forceinline__ void operator()(EPI_ARGS) const {
        const int row0 = u.pm * BM + wr * 64 + fr, pn = u.pn;
        if (pn >= 6 && pn < 10) {
            const float sc = pn < 8 ? 0.125f * 1.4426950408889634f : 1.0f; const int i0 = 16 * (wc & 1) + 4 * fq;
#pragma unroll
            EPI_FOR_ROWS { const int row = row0 + ai * HALF + m * 16; const f32x4 cs = *(const f32x4*)(rc + (size_t)row * 32 + i0), sn = *(const f32x4*)(rs + (size_t)row * 32 + i0);
#pragma unroll
                for (int bj = 0; bj < 2; ++bj) { const f32x4 lo = acc[ai][bj][m][0], hi = acc[ai][bj][m][1];
                    const f32x4 olo = (lo * cs - hi * sn) * sc, ohi = (hi * cs + lo * sn) * sc;
                    bf16_t* p = PR + (size_t)row * NIN + pn * BM + 64 * (2 * bj + (wc >> 1)) + i0;
                    v2u a, b; a.x = cvt_pk_bf16(olo[0], olo[1]); a.y = cvt_pk_bf16(olo[2], olo[3]); b.x = cvt_pk_bf16(ohi[0], ohi[1]); b.y = cvt_pk_bf16(ohi[2], ohi[3]);
                    *(v2u*)p = a; *(v2u*)(p + 32) = b; } }
        } else {
            const int col0 = pn * BM + wc * 32 + 8 * fq; const float sc = pn < 2 ? 0.125f * 1.4426950408889634f : 1.0f; const bool sg = pn >= 12;
            const bool vt = (pn == 4 || pn == 5 || pn == 10 || pn == 11);
            if (!vt) {
#pragma unroll
            EPI_FOR_ROWS { bf16_t* rowp = PR + (size_t)(row0 + ai * HALF + m * 16) * NIN + col0;
#pragma unroll
                for (int bj = 0; bj < 2; ++bj) { f32x4 v0 = acc[ai][bj][m][0] * sc, v1 = acc[ai][bj][m][1] * sc;
                    if (sg) { v0 = (f32x4){sigm(v0[0]), sigm(v0[1]), sigm(v0[2]), sigm(v0[3])}; v1 = (f32x4){sigm(v1[0]), sigm(v1[1]), sigm(v1[2]), sigm(v1[3])}; }
                    *(v4u*)(rowp + bj * HALF) = pack8(v0, v1); } }
            } else {
                const int bb = u.pm >> 4, s0 = (u.pm & 15) * BM + wr * 64 + fr, hd0 = (pn < 6 ? (pn - 4) : (pn - 10)) * BM + wc * 32 + 8 * fq;
                store_tile_T(acc, pn < 6 ? VTSB : VTDF, bb * 512 + hd0, s0, SEQ);
            }
        }
    } };
struct EpiMoeGU { static constexpr bool MIDHOOK = false; unsigned char* ACT8; const float* bgu; const float* wsc;
    __device__ __forceinline__ void operator()(EPI_ARGS) const {
        const int row0 = u.pm * BM + wr * 64 + fr, j0 = u.pn * 128 + wc * 32 + 8 * fq; const float* bg = bgu + (size_t)u.e * 2048 + j0; const float* sg = wsc + (size_t)u.e * 2048 + j0;
#pragma unroll
        EPI_FOR_ROWS { f32x4 o[2];
#pragma unroll
            for (int n = 0; n < 2; ++n) { const f32x4 gv = acc[ai][0][m][n] * *(const f32x4*)(sg + 4 * n) + *(const f32x4*)(bg + 4 * n), lv = acc[ai][1][m][n] * *(const f32x4*)(sg + 1024 + 4 * n) + *(const f32x4*)(bg + 1024 + 4 * n);
#pragma unroll
                for (int c = 0; c < 4; ++c) { const float gl = fminf(gv[c], 7.0f), li = fminf(fmaxf(lv[c], -7.0f), 7.0f); o[n][c] = gl * sigm(1.702f * gl) * (li + 1.0f); } }
            v2u w; w.x = pk4_fp8(o[0][0], o[0][1], o[0][2], o[0][3]); w.y = pk4_fp8(o[1][0], o[1][1], o[1][2], o[1][3]);
            *(v2u*)(ACT8 + (size_t)(row0 + ai * HALF + m * 16) * DFF + j0) = w; }
    } };
struct EpiMoeDown { static constexpr bool MIDHOOK = false; bf16_t* YB; const float* bd; const float* glist; const LAS int* tb; const float* wsc;
    __device__ __forceinline__ void operator()(EPI_ARGS) const {
        const int row0 = u.pm * BM + wr * 64 + fr, col0 = u.pn * BM + wc * 32 + 8 * fq; const float* bp = bd + (size_t)u.e * D + col0; const float* sp = wsc + (size_t)u.e * D + col0;
        const float* gl = glist + (size_t)u.e * LISTCAP - tb[u.e];
        f32x4 bv[2][2], sv[2][2];
#pragma unroll
        for (int bj = 0; bj < 2; ++bj)
#pragma unroll
            for (int n = 0; n < 2; ++n) { bv[bj][n] = *(const f32x4*)(bp + bj * HALF + 4 * n); sv[bj][n] = *(const f32x4*)(sp + bj * HALF + 4 * n); }
#pragma unroll
        EPI_FOR_ROWS { const int row = row0 + ai * HALF + m * 16; const float gt = gl[row];
#pragma unroll
            for (int bj = 0; bj < 2; ++bj) *(v4u*)(YB + (size_t)row * D + col0 + bj * HALF) = pack8((acc[ai][bj][m][0] * sv[bj][0] + bv[bj][0]) * gt, (acc[ai][bj][m][1] * sv[bj][1] + bv[bj][1]) * gt); }
    } };
}


typedef float f32x16 __attribute__((ext_vector_type(16)));
typedef short s16x4 __attribute__((ext_vector_type(4)));
__device__ __forceinline__ f32x16 mfma32(bf16x8 a, bf16x8 b, f32x16 c) { return __builtin_amdgcn_mfma_f32_32x32x16_bf16(a, b, c, 0, 0, 0); }
__device__ __forceinline__ float xhalf(float v, int hh) { auto rr = __builtin_amdgcn_permlane32_swap(__float_as_uint(v), __float_as_uint(v), false, false); return __uint_as_float(hh ? rr[0] : rr[1]); }
__device__ __forceinline__ bf16x8 vt_frag(const bf16_t* p) { const s16x4 lo = *(const s16x4*)p, hi = *(const s16x4*)(p + 8); return (bf16x8){lo[0], lo[1], lo[2], lo[3], hi[0], hi[1], hi[2], hi[3]}; }
__device__ __forceinline__ bf16x8 pack_p(const f32x16& p, int s) { v4u w; w.x = pg8::cvt_pk_bf16(p[8 * s + 0], p[8 * s + 1]); w.y = pg8::cvt_pk_bf16(p[8 * s + 2], p[8 * s + 3]); w.z = pg8::cvt_pk_bf16(p[8 * s + 4], p[8 * s + 5]); w.w = pg8::cvt_pk_bf16(p[8 * s + 6], p[8 * s + 7]); return __builtin_bit_cast(bf16x8, w); }
constexpr float LOG2E = 1.4426950408889634f;

template <int NO>
__device__ __forceinline__ void softmax_step(f32x16& S, float C, float& m, float& l, f32x16 (&O)[NO], int hh) {
    float mx = fmaxf(fmaxf(S[0], S[1]), fmaxf(S[2], S[3]));
#pragma unroll
    for (int i = 4; i < 16; i += 4) mx = fmaxf(mx, fmaxf(fmaxf(S[i], S[i + 1]), fmaxf(S[i + 2], S[i + 3])));
    mx = fmaxf(mx, xhalf(mx, hh)) * C;
    const float mn = fmaxf(m, mx), al = __builtin_amdgcn_exp2f(m - mn);
    m = mn; l *= al;
#pragma unroll
    for (int o = 0; o < NO; ++o) O[o] = O[o] * al;
    float ps = 0.f;
#pragma unroll
    for (int i = 0; i < 16; ++i) { S[i] = __builtin_amdgcn_exp2f(S[i] * C - mn); ps += S[i]; }
    l += ps;
}

__device__ __forceinline__ void attn_diff_wave(const bf16_t* PR, const bf16_t* VT, float* ODR, int b, int h, int j, int q0, int lane) {
    const int r32 = lane & 31, hh = lane >> 5;
    const bf16_t* qrow = PR + (size_t)(b * SEQ + q0 + r32) * NIN + C_DQ + h * 128 + j * 64 + 8 * hh;
    bf16x8 qf[4];
#pragma unroll
    for (int d0 = 0; d0 < 4; ++d0) qf[d0] = *(const bf16x8*)(qrow + 16 * d0);
    const bf16_t* kbase = PR + (size_t)(b * SEQ + r32) * NIN + C_DK + h * 128 + j * 64 + 8 * hh;
    const bf16_t* vbase = VT + (size_t)(b * 512 + h * 128 + r32) * SEQ + 4 * hh;
    f32x16 O[4];
#pragma unroll
    for (int o = 0; o < 4; ++o)
#pragma unroll
        for (int i = 0; i < 16; ++i) O[o][i] = 0.f;
    float m = -INFINITY, l = 0.f;
    const int nt = 2 * (q0 / 64 + 1);
    for (int t = 0; t < nt; ++t) {
        const bf16_t* kp = kbase + (size_t)(32 * t) * NIN;
        f32x16 S;
#pragma unroll
        for (int i = 0; i < 16; ++i) S[i] = 0.f;
#pragma unroll
        for (int d0 = 0; d0 < 4; ++d0) S = mfma32(*(const bf16x8*)(kp + 16 * d0), qf[d0], S);
        softmax_step<4>(S, LOG2E, m, l, O, hh);
        const bf16x8 p0 = pack_p(S, 0), p1 = pack_p(S, 1);
        const bf16_t* vp = vbase + 32 * t;
#pragma unroll
        for (int o = 0; o < 4; ++o) { O[o] = mfma32(vt_frag(vp + (size_t)(32 * o) * SEQ), p0, O[o]); O[o] = mfma32(vt_frag(vp + (size_t)(32 * o) * SEQ + 16), p1, O[o]); }
    }
    l += xhalf(l, hh);
    const float il = 1.f / l;
    float* orow = ODR + ((size_t)j * M + (size_t)b * SEQ + q0 + r32) * 512 + h * 128 + 4 * hh;
#pragma unroll
    for (int o = 0; o < 4; ++o)
#pragma unroll
        for (int g = 0; g < 4; ++g) *(f32x4*)(orow + 32 * o + 8 * g) = (f32x4){O[o][4 * g] * il, O[o][4 * g + 1] * il, O[o][4 * g + 2] * il, O[o][4 * g + 3] * il};
}

__device__ __forceinline__ void attn_sb_wave(const bf16_t* PR, const bf16_t* VT, bf16_t* OAT, int b, int h, int q0, int lane) {
    const int r32 = lane & 31, hh = lane >> 5;
    const bf16_t* qrow = PR + (size_t)(b * SEQ + q0 + r32) * NIN + C_SBQ + h * 64 + 8 * hh;
    bf16x8 qf[4];
#pragma unroll
    for (int d0 = 0; d0 < 4; ++d0) qf[d0] = *(const bf16x8*)(qrow + 16 * d0);
    const bf16_t* kbase = PR + (size_t)(b * SEQ + r32) * NIN + C_SBK + h * 64 + 8 * hh;
    const bf16_t* vbase = VT + (size_t)(b * 512 + h * 64 + r32) * SEQ + 4 * hh;
    f32x16 O[2];
#pragma unroll
    for (int o = 0; o < 2; ++o)
#pragma unroll
        for (int i = 0; i < 16; ++i) O[o][i] = 0.f;
    float R = 0.f;
    const int td = q0 >> 5;
    for (int t = td; t >= 0; --t) {
        const bf16_t* kp = kbase + (size_t)(32 * t) * NIN;
        f32x16 S;
#pragma unroll
        for (int i = 0; i < 16; ++i) S[i] = 0.f;
#pragma unroll
        for (int d0 = 0; d0 < 4; ++d0) S = mfma32(*(const bf16x8*)(kp + 16 * d0), qf[d0], S);
        f32x16 lr;
#pragma unroll
        for (int i = 0; i < 16; ++i) { const float z2 = S[i] * LOG2E; const float sp = fmaxf(z2, 0.f) + __builtin_amdgcn_logf(1.f + __builtin_amdgcn_exp2f(-fabsf(z2)));
            lr[i] = -sp; S[i] = z2 - sp; }
        if (t == td) {
#pragma unroll
            for (int i = 0; i < 16; ++i) { const int kvl = (i & 3) + 8 * (i >> 2) + 4 * hh; if (kvl >= r32) { lr[i] = 0.f; S[i] = -INFINITY; } }
        }
        float tot[4], pt[4], off[4];
        f32x16 ex;
#pragma unroll
        for (int g = 0; g < 4; ++g) { ex[4 * g + 3] = 0.f; ex[4 * g + 2] = lr[4 * g + 3]; ex[4 * g + 1] = lr[4 * g + 3] + lr[4 * g + 2]; ex[4 * g] = ex[4 * g + 1] + lr[4 * g + 1]; tot[g] = ex[4 * g] + lr[4 * g]; }
#pragma unroll
        for (int g = 0; g < 4; ++g) pt[g] = xhalf(tot[g], hh);
        const float own0 = hh ? 0.f : 1.f;
        float sp_ = 0.f;
#pragma unroll
        for (int g = 3; g >= 0; --g) { off[g] = sp_ + own0 * pt[g] + R; sp_ += tot[g] + pt[g]; }
#pragma unroll
        for (int i = 0; i < 16; ++i) S[i] = __builtin_amdgcn_exp2f(S[i] + ex[i] + off[i >> 2]);
        R += sp_;
        const bf16x8 p0 = pack_p(S, 0), p1 = pack_p(S, 1);
        const bf16_t* vp = vbase + 32 * t;
#pragma unroll
        for (int o = 0; o < 2; ++o) { O[o] = mfma32(vt_frag(vp + (size_t)(32 * o) * SEQ), p0, O[o]); O[o] = mfma32(vt_frag(vp + (size_t)(32 * o) * SEQ + 16), p1, O[o]); }
        if (__all(R < -160.f)) break;
    }
    bf16_t* orow = OAT + (size_t)(b * SEQ + q0 + r32) * D + h * 64 + 4 * hh;
#pragma unroll
    for (int o = 0; o < 2; ++o)
#pragma unroll
        for (int g = 0; g < 4; ++g) { v2u w; w.x = pg8::cvt_pk_bf16(O[o][4 * g], O[o][4 * g + 1]); w.y = pg8::cvt_pk_bf16(O[o][4 * g + 2], O[o][4 * g + 3]); *(v2u*)(orow + 32 * o + 8 * g) = w; }
}

__device__ __forceinline__ void attn_mem_wave(const bf16_t* QM, const bf16_t* KVM, const bf16_t* VT, bf16_t* OM, int b, int h, int q0, int lane) {
    const int r32 = lane & 31, hh = lane >> 5;
    const bf16_t* qrow = QM + (size_t)(b * SEQ + q0 + r32) * D + h * 256 + 8 * hh;
    const bf16_t* kbase = KVM + (size_t)(b * MEMLEN + r32) * 2048 + h * 256 + 8 * hh;
    for (int dh = 0; dh < 2; ++dh) {
        const bf16_t* vbase = VT + (size_t)(b * 1024 + h * 256 + dh * 128 + r32) * MEMLEN + 4 * hh;
        f32x16 O[4];
#pragma unroll
        for (int o = 0; o < 4; ++o)
#pragma unroll
            for (int i = 0; i < 16; ++i) O[o][i] = 0.f;
        float m = -INFINITY, l = 0.f;
        for (int t = 0; t < 8; ++t) {
            const bf16_t* kp = kbase + (size_t)(32 * t) * 2048;
            f32x16 S;
#pragma unroll
            for (int i = 0; i < 16; ++i) S[i] = 0.f;
#pragma unroll
            for (int d0 = 0; d0 < 16; ++d0) S = mfma32(*(const bf16x8*)(kp + 16 * d0), *(const bf16x8*)(qrow + 16 * d0), S);
            softmax_step<4>(S, LOG2E * 0.0625f, m, l, O, hh);
            const bf16x8 p0 = pack_p(S, 0), p1 = pack_p(S, 1);
            const bf16_t* vp = vbase + 32 * t;
#pragma unroll
            for (int o = 0; o < 4; ++o) { O[o] = mfma32(vt_frag(vp + (size_t)(32 * o) * MEMLEN), p0, O[o]); O[o] = mfma32(vt_frag(vp + (size_t)(32 * o) * MEMLEN + 16), p1, O[o]); }
        }
        l += xhalf(l, hh);
        const float il = 1.f / l;
        bf16_t* orow = OM + (size_t)(b * SEQ + q0 + r32) * D + h * 256 + dh * 128 + 4 * hh;
#pragma unroll
        for (int o = 0; o < 4; ++o)
#pragma unroll
            for (int g = 0; g < 4; ++g) { v2u w; w.x = pg8::cvt_pk_bf16(O[o][4 * g] * il, O[o][4 * g + 1] * il); w.y = pg8::cvt_pk_bf16(O[o][4 * g + 2] * il, O[o][4 * g + 3] * il); *(v2u*)(orow + 32 * o + 8 * g) = w; }
    }
}


constexpr int VSTR = 136;
template <int NCH> __device__ __forceinline__ void stage_load(v4u (&r)[NCH], const bf16_t* g0, int chunks_per_row, size_t gpitch, int tid) {
#pragma unroll
    for (int i = 0; i < NCH; ++i) { const int c = tid + NTHR * i, row = c / chunks_per_row, ch = c % chunks_per_row; r[i] = *(const v4u*)(g0 + (size_t)row * gpitch + ch * 8); }
}
template <int NCH> __device__ __forceinline__ void stage_store_k(const v4u (&r)[NCH], LAS unsigned char* dst, int chunks_per_row, int lstride, int tid) {
#pragma unroll
    for (int i = 0; i < NCH; ++i) { const int c = tid + NTHR * i, row = c / chunks_per_row, ch = c % chunks_per_row; *(LAS v4u*)(dst + row * lstride + ch * 16) = r[i]; }
}
template <int NCH> __device__ __forceinline__ void stage_store_v(const v4u (&r)[NCH], LAS unsigned char* dst, int tid) {
#pragma unroll
    for (int i = 0; i < NCH; ++i) { const int c = tid + NTHR * i, row = c >> 3, ch = c & 7; LAS v2u* d = (LAS v2u*)(dst + row * VSTR + ch * 16); d[0] = (v2u){r[i].x, r[i].y}; d[1] = (v2u){r[i].z, r[i].w}; }
}
__device__ __forceinline__ bf16x8 lds_vfrag(const LAS unsigned char* p) { const v2u lo = *(const LAS v2u*)p, hi = *(const LAS v2u*)(p + 16); return __builtin_bit_cast(bf16x8, (v4u){lo.x, lo.y, hi.x, hi.y}); }

constexpr float SM_THR = 8.0f;
template <int NO>
__device__ __forceinline__ void softmax_def2(f32x16& S0, f32x16& S1, bool first, float& mref, float& l, f32x16 (&O)[NO], int hh) {
    float mx = fmaxf(fmaxf(S0[0], S0[1]), fmaxf(S1[0], S1[1]));
#pragma unroll
    for (int i = 2; i < 16; i += 2) mx = fmaxf(mx, fmaxf(fmaxf(S0[i], S0[i + 1]), fmaxf(S1[i], S1[i + 1])));
    mx = fmaxf(mx, xhalf(mx, hh));
    if (first || __any(mx > SM_THR)) {
        const float dl = first ? mx : fmaxf(mx, 0.f), f = first ? 0.f : __builtin_amdgcn_exp2f(-dl);
        mref += dl; l *= f;
#pragma unroll
        for (int o = 0; o < NO; ++o) O[o] = O[o] * f;
#pragma unroll
        for (int i = 0; i < 16; ++i) { S0[i] -= dl; S1[i] -= dl; }
    }
    float ps = 0.f;
#pragma unroll
    for (int i = 0; i < 16; ++i) { S0[i] = __builtin_amdgcn_exp2f(S0[i]); S1[i] = __builtin_amdgcn_exp2f(S1[i]); ps += S0[i] + S1[i]; }
    l += ps;
}
template <int NO>
__device__ __forceinline__ void softmax_def1(f32x16& S, bool first, float& mref, float& l, f32x16 (&O)[NO], int hh) {
    float mx = fmaxf(fmaxf(S[0], S[1]), fmaxf(S[2], S[3]));
#pragma unroll
    for (int i = 4; i < 16; i += 4) mx = fmaxf(mx, fmaxf(fmaxf(S[i], S[i + 1]), fmaxf(S[i + 2], S[i + 3])));
    mx = fmaxf(mx, xhalf(mx, hh));
    if (first || __any(mx > SM_THR)) {
        const float dl = first ? mx : fmaxf(mx, 0.f), f = first ? 0.f : __builtin_amdgcn_exp2f(-dl);
        mref += dl; l *= f;
#pragma unroll
        for (int o = 0; o < NO; ++o) O[o] = O[o] * f;
#pragma unroll
        for (int i = 0; i < 16; ++i) S[i] -= dl;
    }
    float ps = 0.f;
#pragma unroll
    for (int i = 0; i < 16; ++i) { S[i] = __builtin_amdgcn_exp2f(S[i]); ps += S[i]; }
    l += ps;
}
template <int NO>
__device__ __forceinline__ void softmax_step2(f32x16& S0, f32x16& S1, float C, float& m, float& l, f32x16 (&O)[NO], int hh) {
    float mx = fmaxf(fmaxf(S0[0], S0[1]), fmaxf(S1[0], S1[1]));
#pragma unroll
    for (int i = 2; i < 16; i += 2) mx = fmaxf(mx, fmaxf(fmaxf(S0[i], S0[i + 1]), fmaxf(S1[i], S1[i + 1])));
    mx = fmaxf(mx, xhalf(mx, hh)) * C;
    const float mn = fmaxf(m, mx), al = __builtin_amdgcn_exp2f(m - mn);
    m = mn; l *= al;
#pragma unroll
    for (int o = 0; o < NO; ++o) O[o] = O[o] * al;
    float ps = 0.f;
#pragma unroll
    for (int i = 0; i < 16; ++i) { S0[i] = __builtin_amdgcn_exp2f(S0[i] * C - mn); S1[i] = __builtin_amdgcn_exp2f(S1[i] * C - mn); ps += S0[i] + S1[i]; }
    l += ps;
}

__device__ __forceinline__ void attn_diff_block(const bf16_t* PR, const bf16_t* VT, bf16_t* OAT, const float* subln, float lam, int b, int h, int qb, LAS unsigned char* lds, int tid, int wave, int lane) {
    constexpr int KSTR = 144, KB = 64 * KSTR, BUF = 2 * KB + 128 * VSTR;
    const int r32 = lane & 31, hh = lane >> 5, j = wave >> 2, w4 = wave & 3, q0 = qb * 128 + w4 * 32;
    const bf16_t* qrow = PR + (size_t)(b * SEQ + q0 + r32) * NIN + C_DQ + h * 128 + j * 64 + 8 * hh;
    bf16x8 qf[4];
#pragma unroll
    for (int d0 = 0; d0 < 4; ++d0) qf[d0] = *(const bf16x8*)(qrow + 16 * d0);
    const bf16_t* kg = PR + (size_t)(b * SEQ) * NIN + C_DK + h * 128;
    const bf16_t* vg = VT + (size_t)(b * 512 + h * 128) * SEQ;
    f32x16 O[4];
#pragma unroll
    for (int o = 0; o < 4; ++o)
#pragma unroll
        for (int i = 0; i < 16; ++i) O[o][i] = 0.f;
    float m = 0.f, l = 0.f;
    const int nsteps = 2 * qb + 2, my_last = 2 * qb + (w4 >> 1);
    v4u ra1[1], ra2[1], rav[2], rb1[1], rb2[1], rbv[2];
    auto ld = [&](int t_, v4u (&r1)[1], v4u (&r2)[1], v4u (&rv)[2]) __attribute__((always_inline)) { const bf16_t* kn = kg + (size_t)(64 * t_) * NIN; stage_load<1>(r1, kn, 8, NIN, tid); stage_load<1>(r2, kn + 64, 8, NIN, tid); stage_load<2>(rv, vg + 64 * t_, 8, SEQ, tid); };
    auto st = [&](int t_, const v4u (&r1)[1], const v4u (&r2)[1], const v4u (&rv)[2]) __attribute__((always_inline)) { LAS unsigned char* nb = lds + (t_ & 1) * BUF; stage_store_k<1>(r1, nb, 8, KSTR, tid); stage_store_k<1>(r2, nb + KB, 8, KSTR, tid); stage_store_v<2>(rv, nb + 2 * KB, tid); };
    auto compute = [&](int t) __attribute__((always_inline)) {
        if (t <= my_last) {
            const LAS unsigned char* kb = lds + (t & 1) * BUF + j * KB + r32 * KSTR + 16 * hh; const LAS unsigned char* vb = lds + (t & 1) * BUF + 2 * KB + r32 * VSTR + 8 * hh;
            f32x16 S0, S1;
#pragma unroll
            for (int i = 0; i < 16; ++i) { S0[i] = -m; S1[i] = -m; }
#pragma unroll
            for (int d0 = 0; d0 < 4; ++d0) { S0 = mfma32(*(const LAS bf16x8*)(kb + 32 * d0), qf[d0], S0); S1 = mfma32(*(const LAS bf16x8*)(kb + 32 * KSTR + 32 * d0), qf[d0], S1); }
            softmax_def2<4>(S0, S1, t == 0, m, l, O, hh);
            const bf16x8 p00 = pack_p(S0, 0), p01 = pack_p(S0, 1), p10 = pack_p(S1, 0), p11 = pack_p(S1, 1);
#pragma unroll
            for (int o = 0; o < 4; ++o) { const LAS unsigned char* vp = vb + 32 * o * VSTR;
                O[o] = mfma32(lds_vfrag(vp), p00, O[o]); O[o] = mfma32(lds_vfrag(vp + 32), p01, O[o]); O[o] = mfma32(lds_vfrag(vp + 64), p10, O[o]); O[o] = mfma32(lds_vfrag(vp + 96), p11, O[o]); }
        } };
    ld(0, ra1, ra2, rav); st(0, ra1, ra2, rav);
    if (nsteps > 1) ld(1, rb1, rb2, rbv);
    __syncthreads();
    for (int t = 0; t < nsteps; t += 2) {
        if (t + 2 < nsteps) ld(t + 2, ra1, ra2, rav);
        compute(t);
        st(t + 1, rb1, rb2, rbv);
        __syncthreads();
        if (t + 3 < nsteps) ld(t + 3, rb1, rb2, rbv);
        compute(t + 1);
        if (t + 2 < nsteps) st(t + 2, ra1, ra2, rav);
        __syncthreads();
    }
    l += xhalf(l, hh);
    const float il = 1.f / l;
    LAS float* X = (LAS float*)lds + (size_t)(w4 * 32 + r32) * 132 + 4 * hh;
    if (j == 1) {
#pragma unroll
        for (int o = 0; o < 4; ++o)
#pragma unroll
            for (int g = 0; g < 4; ++g) *(LAS f32x4*)(X + 32 * o + 8 * g) = (f32x4){O[o][4 * g] * il, O[o][4 * g + 1] * il, O[o][4 * g + 2] * il, O[o][4 * g + 3] * il};
    }
    __syncthreads();
    if (j == 0) {
        float ss = 0.f;
#pragma unroll
        for (int o = 0; o < 4; ++o)
#pragma unroll
            for (int g = 0; g < 4; ++g) { const f32x4 o2 = *(const LAS f32x4*)(X + 32 * o + 8 * g);
#pragma unroll
                for (int c = 0; c < 4; ++c) { const float d = O[o][4 * g + c] * il - lam * o2[c]; O[o][4 * g + c] = d; ss += d * d; } }
        ss += xhalf(ss, hh);
        const float rinv = 0.8f / sqrtf(ss * (1.f / 128.f) + NORM_EPS);
        bf16_t* orow = OAT + (size_t)(b * SEQ + q0 + r32) * D + 512 + h * 128 + 4 * hh; const float* sl = subln + 4 * hh;
#pragma unroll
        for (int o = 0; o < 4; ++o)
#pragma unroll
            for (int g = 0; g < 4; ++g) { const f32x4 sg_ = *(const f32x4*)(sl + 32 * o + 8 * g); v2u w;
                w.x = pg8::cvt_pk_bf16(O[o][4 * g] * rinv * sg_[0], O[o][4 * g + 1] * rinv * sg_[1]); w.y = pg8::cvt_pk_bf16(O[o][4 * g + 2] * rinv * sg_[2], O[o][4 * g + 3] * rinv * sg_[3]); *(v2u*)(orow + 32 * o + 8 * g) = w; }
    }
    __syncthreads();
}

__device__ __forceinline__ void sb_subtile(f32x16& S, bool diag, float& R, f32x16 (&O)[2], const LAS unsigned char* vp, int r32, int hh) {
    f32x16 lr;
#pragma unroll
    for (int i = 0; i < 16; ++i) { const float z2 = S[i]; const float sp = fmaxf(z2, 0.f) + __builtin_amdgcn_logf(1.f + __builtin_amdgcn_exp2f(-fabsf(z2))); lr[i] = -sp; S[i] = z2 - sp; }
    if (diag) {
#pragma unroll
        for (int i = 0; i < 16; ++i) { const int kvl = (i & 3) + 8 * (i >> 2) + 4 * hh; if (kvl >= r32) { lr[i] = 0.f; S[i] = -INFINITY; } }
    }
    float tot[4], pt[4], off[4]; f32x16 ex;
#pragma unroll
    for (int g = 0; g < 4; ++g) { ex[4 * g + 3] = 0.f; ex[4 * g + 2] = lr[4 * g + 3]; ex[4 * g + 1] = lr[4 * g + 3] + lr[4 * g + 2]; ex[4 * g] = ex[4 * g + 1] + lr[4 * g + 1]; tot[g] = ex[4 * g] + lr[4 * g]; }
#pragma unroll
    for (int g = 0; g < 4; ++g) pt[g] = xhalf(tot[g], hh);
    const float own0 = hh ? 0.f : 1.f;
    float sp_ = 0.f;
#pragma unroll
    for (int g = 3; g >= 0; --g) { off[g] = sp_ + own0 * pt[g] + R; sp_ += tot[g] + pt[g]; }
#pragma unroll
    for (int i = 0; i < 16; ++i) S[i] = __builtin_amdgcn_exp2f(S[i] + ex[i] + off[i >> 2]);
    R += sp_;
    const bf16x8 p0 = pack_p(S, 0), p1 = pack_p(S, 1);
#pragma unroll
    for (int o = 0; o < 2; ++o) { O[o] = mfma32(lds_vfrag(vp + 32 * o * VSTR), p0, O[o]); O[o] = mfma32(lds_vfrag(vp + 32 * o * VSTR + 32), p1, O[o]); }
}
__device__ __forceinline__ void attn_sb_block(const bf16_t* PR, const bf16_t* VT, bf16_t* OAT, int b, int h, int qb, LAS unsigned char* lds, volatile LAS unsigned* fl, int tid, int wave, int lane) {
    constexpr int KSTR = 144, KB = 64 * KSTR, BUF = KB + 64 * VSTR;
    const int r32 = lane & 31, hh = lane >> 5, q0 = qb * 256 + wave * 32;
    const bf16_t* qrow = PR + (size_t)(b * SEQ + q0 + r32) * NIN + C_SBQ + h * 64 + 8 * hh;
    bf16x8 qf[4];
#pragma unroll
    for (int d0 = 0; d0 < 4; ++d0) qf[d0] = *(const bf16x8*)(qrow + 16 * d0);
    const bf16_t* kg = PR + (size_t)(b * SEQ) * NIN + C_SBK + h * 64;
    const bf16_t* vg = VT + (size_t)(b * 512 + h * 64) * SEQ;
    f32x16 O[2];
#pragma unroll
    for (int o = 0; o < 2; ++o)
#pragma unroll
        for (int i = 0; i < 16; ++i) O[o][i] = 0.f;
    float R = 0.f; bool done = false;
    const int ttop = 4 * qb + 3, my_diag = 4 * qb + (wave >> 1), odd = wave & 1;
    v4u kr[1], vr[1];
    if (tid < 3) fl[tid] = 0u;
    stage_load<1>(kr, kg + (size_t)(64 * ttop) * NIN, 8, NIN, tid); stage_load<1>(vr, vg + 64 * ttop, 8, SEQ, tid);
    stage_store_k<1>(kr, lds, 8, KSTR, tid); stage_store_v<1>(vr, lds + KB, tid);
    __syncthreads();
    int it = 0;
    for (int t = ttop; t >= 0; --t, ++it) {
        const bool more = t > 0;
        if (more) { stage_load<1>(kr, kg + (size_t)(64 * (t - 1)) * NIN, 8, NIN, tid); stage_load<1>(vr, vg + 64 * (t - 1), 8, SEQ, tid); }
        const int fcur = it % 3;
        if (tid == 0) fl[(it + 1) % 3] = 0u;
        if (t <= my_diag && !done) {
            const LAS unsigned char* kb = lds + (it & 1) * BUF + r32 * KSTR + 16 * hh; const LAS unsigned char* vb = lds + (it & 1) * BUF + KB + r32 * VSTR + 8 * hh;
            const bool isd = (t == my_diag);
            if (!isd || odd) {
                f32x16 S;
#pragma unroll
                for (int i = 0; i < 16; ++i) S[i] = 0.f;
#pragma unroll
                for (int d0 = 0; d0 < 4; ++d0) S = mfma32(*(const LAS bf16x8*)(kb + 32 * KSTR + 32 * d0), qf[d0], S);
                sb_subtile(S, isd, R, O, vb + 64, r32, hh);
            }
            {
                f32x16 S;
#pragma unroll
                for (int i = 0; i < 16; ++i) S[i] = 0.f;
#pragma unroll
                for (int d0 = 0; d0 < 4; ++d0) S = mfma32(*(const LAS bf16x8*)(kb + 32 * d0), qf[d0], S);
                sb_subtile(S, isd && !odd, R, O, vb, r32, hh);
            }
            done = __all(R < -160.f);
        }
        if (done && lane == 0) __hip_atomic_fetch_or((LAS unsigned*)(fl + fcur), 1u << wave, __ATOMIC_RELAXED, __HIP_MEMORY_SCOPE_WORKGROUP);
        if (more) { LAS unsigned char* nb = lds + ((it + 1) & 1) * BUF; stage_store_k<1>(kr, nb, 8, KSTR, tid); stage_store_v<1>(vr, nb + KB, tid); }
        __syncthreads();
        if (fl[fcur] == 0xffu) break;
    }
    bf16_t* orow = OAT + (size_t)(b * SEQ + q0 + r32) * D + h * 64 + 4 * hh;
#pragma unroll
    for (int o = 0; o < 2; ++o)
#pragma unroll
        for (int g = 0; g < 4; ++g) { v2u w; w.x = pg8::cvt_pk_bf16(O[o][4 * g], O[o][4 * g + 1]); w.y = pg8::cvt_pk_bf16(O[o][4 * g + 2], O[o][4 * g + 3]); *(v2u*)(orow + 32 * o + 8 * g) = w; }
    __syncthreads();
}

__device__ __forceinline__ void attn_mem_block(const bf16_t* QM, const bf16_t* KVM, const bf16_t* VT, bf16_t* OM, int b, int h, int qb, LAS unsigned char* lds, int tid, int wave, int lane) {
    constexpr int KSTR = 528, KB = 32 * KSTR, VS = 72, BUF = KB + 128 * VS;
    const int r32 = lane & 31, hh = lane >> 5, q0 = qb * 256 + wave * 32;
    const bf16_t* qrow = QM + (size_t)(b * SEQ + q0 + r32) * D + h * 256 + 8 * hh;
    bf16x8 qf[8];
    LAS unsigned char* qs = lds + 53248 + wave * 8192 + lane * 16;
#pragma unroll
    for (int d0 = 0; d0 < 8; ++d0) { qf[d0] = *(const bf16x8*)(qrow + 16 * d0); *(LAS bf16x8*)(qs + d0 * 1024) = *(const bf16x8*)(qrow + 128 + 16 * d0); }
    const bf16_t* kg = KVM + (size_t)(b * MEMLEN) * 2048 + h * 256;
    const int vrow = tid >> 2, vch = tid & 3;
    for (int dh = 0; dh < 2; ++dh) {
        const bf16_t* vg = VT + (size_t)(b * 1024 + h * 256 + dh * 128 + vrow) * MEMLEN + vch * 8;
        f32x16 O[4];
#pragma unroll
        for (int o = 0; o < 4; ++o)
#pragma unroll
            for (int i = 0; i < 16; ++i) O[o][i] = 0.f;
        float m = 0.f, l = 0.f;
        v4u kr[2], vr;
        stage_load<2>(kr, kg, 32, 2048, tid); vr = *(const v4u*)vg;
        stage_store_k<2>(kr, lds, 32, KSTR, tid); { LAS v2u* d = (LAS v2u*)(lds + KB + vrow * VS + vch * 16); d[0] = (v2u){vr.x, vr.y}; d[1] = (v2u){vr.z, vr.w}; }
        __syncthreads();
        for (int t = 0; t < 8; ++t) {
            const bool more = t < 7;
            if (more) { stage_load<2>(kr, kg + (size_t)(32 * (t + 1)) * 2048, 32, 2048, tid); vr = *(const v4u*)(vg + 32 * (t + 1)); }
            {
                const LAS unsigned char* kb = lds + (t & 1) * BUF + r32 * KSTR + 16 * hh; const LAS unsigned char* vb = lds + (t & 1) * BUF + KB + r32 * VS + 8 * hh;
                f32x16 S;
#pragma unroll
                for (int i = 0; i < 16; ++i) S[i] = -m;
#pragma unroll
                for (int d0 = 0; d0 < 8; ++d0) S = mfma32(*(const LAS bf16x8*)(kb + 32 * d0), qf[d0], S);
#pragma unroll
                for (int d0 = 0; d0 < 8; ++d0) S = mfma32(*(const LAS bf16x8*)(kb + 256 + 32 * d0), *(const LAS bf16x8*)(qs + d0 * 1024), S);
                softmax_def1<4>(S, t == 0, m, l, O, hh);
                const bf16x8 p0 = pack_p(S, 0), p1 = pack_p(S, 1);
#pragma unroll
                for (int o = 0; o < 4; ++o) { const LAS unsigned char* vp = vb + 32 * o * VS; O[o] = mfma32(lds_vfrag(vp), p0, O[o]); O[o] = mfma32(lds_vfrag(vp + 32), p1, O[o]); }
            }
            if (more) { LAS unsigned char* nb = lds + ((t + 1) & 1) * BUF; stage_store_k<2>(kr, nb, 32, KSTR, tid); LAS v2u* d = (LAS v2u*)(nb + KB + vrow * VS + vch * 16); d[0] = (v2u){vr.x, vr.y}; d[1] = (v2u){vr.z, vr.w}; }
            __syncthreads();
        }
        l += xhalf(l, hh);
        const float il = 1.f / l;
        bf16_t* orow = OM + (size_t)(b * SEQ + q0 + r32) * D + h * 256 + dh * 128 + 4 * hh;
#pragma unroll
        for (int o = 0; o < 4; ++o)
#pragma unroll
            for (int g = 0; g < 4; ++g) { v2u w; w.x = pg8::cvt_pk_bf16(O[o][4 * g] * il, O[o][4 * g + 1] * il); w.y = pg8::cvt_pk_bf16(O[o][4 * g + 2] * il, O[o][4 * g + 3] * il); *(v2u*)(orow + 32 * o + 8 * g) = w; }
    }
}

struct Args { const void* in[26]; float* out; unsigned char* ws; int ph_lo, ph_hi; };
constexpr int NPHASE = 15;

__device__ __forceinline__ float softplus_f(float z) { return fmaxf(z, 0.f) + __logf(1.f + __expf(-fabsf(z))); }

__global__ void __launch_bounds__(NTHR, 2) fwd(Args args) {
    extern __shared__ __attribute__((aligned(16))) unsigned char lds[];
    LAS unsigned char* L = (LAS unsigned char*)lds;
    volatile LAS unsigned* MISC = (volatile LAS unsigned*)(L + MISC_OFF);
    const int tid = threadIdx.x, lane = tid & 63, wave = __builtin_amdgcn_readfirstlane(tid >> 6);
    const int G = gridDim.x;
    unsigned char* ws = args.ws;
    unsigned* ctl = (unsigned*)(ws + WS_CTL);
#define x_in ((const float*)args.in[0])
#define mem_in ((const float*)args.in[1])
#define positions ((const int*)args.in[2])
#define norm_mix ((const float*)args.in[3])
#define w_in ((const float*)args.in[4])
#define lam_q1 ((const float*)args.in[5])
#define lam_k1 ((const float*)args.in[6])
#define lam_q2 ((const float*)args.in[7])
#define lam_k2 ((const float*)args.in[8])
#define diff_subln ((const float*)args.in[9])
#define w_up_sb ((const float*)args.in[10])
#define w_up_diff ((const float*)args.in[11])
#define w_out ((const float*)args.in[12])
#define norm_mem_q ((const float*)args.in[13])
#define norm_mem_kv ((const float*)args.in[14])
#define w_mem_q ((const float*)args.in[15])
#define w_mem_kv ((const float*)args.in[16])
#define w_mem_o ((const float*)args.in[17])
#define norm_ffn ((const float*)args.in[18])
#define w_router ((const float*)args.in[19])
#define b_router ((const float*)args.in[20])
#define w_gate_up ((const float*)args.in[21])
#define b_gate_up ((const float*)args.in[22])
#define w_down ((const float*)args.in[23])
#define b_down ((const float*)args.in[24])
#define norm_final ((const float*)args.in[25])
    bf16_t* WIN = (bf16_t*)(ws + WS_WIN); bf16_t* WUPSB = (bf16_t*)(ws + WS_WUPSB); bf16_t* WUPDF = (bf16_t*)(ws + WS_WUPDF); bf16_t* WOUT = (bf16_t*)(ws + WS_WOUT);
    bf16_t* WMQ = (bf16_t*)(ws + WS_WMQ); bf16_t* WMKV = (bf16_t*)(ws + WS_WMKV); bf16_t* WMO = (bf16_t*)(ws + WS_WMO);
    bf16_t* WGU = (bf16_t*)(ws + WS_WGU); bf16_t* WD = (bf16_t*)(ws + WS_WD);
    float* ROPEC = (float*)(ws + WS_ROPE); float* ROPES = ROPEC + (size_t)M * 32;
    int* TK_E = (int*)(ws + WS_TK); int* TK_POS = TK_E + (size_t)M * 4; float* TK_G = (float*)(TK_POS + (size_t)M * 4);
    bf16_t* XN = (bf16_t*)(ws + WS_XN); bf16_t* PR = (bf16_t*)(ws + WS_PR); bf16_t* OAT = (bf16_t*)(ws + WS_OAT); float* SSQ = (float*)(ws + WS_ODR);
    bf16_t* MIX = (bf16_t*)(ws + WS_MIX); float* X1 = (float*)(ws + WS_X1); float* X2 = (float*)(ws + WS_X2);
    bf16_t* HM = (bf16_t*)(ws + WS_HM); bf16_t* KVM = (bf16_t*)(ws + WS_KVM); int* TLIST = (int*)(ws + WS_TLIST); float* GLIST = (float*)(ws + WS_GLIST);
    bf16_t* QM = (bf16_t*)(ws + WS_QM); bf16_t* OM = (bf16_t*)(ws + WS_OM); bf16_t* ACT = (bf16_t*)(ws + WS_ACT); bf16_t* YB = (bf16_t*)(ws + WS_YB);
    bf16_t* VTSB = (bf16_t*)(ws + WS_VTSB); bf16_t* VTDF = (bf16_t*)(ws + WS_VTDF); bf16_t* VTM = (bf16_t*)(ws + WS_VTM);
    float* WR = (float*)(ws + WS_WR); float* WSCGU = (float*)(ws + WS_WSC); float* WSCD = WSCGU + NE * 2048;
    unsigned char* WGU8 = ws + WS_WGU; unsigned char* WD8 = ws + WS_WD; unsigned char* XN8 = ws + WS_XN; unsigned char* ACT8 = ws + WS_ACT;
    unsigned* CNT = ctl + CW_CNT;
    LAS float* smf = (LAS float*)L;
    LAS int* smi = (LAS int*)L;

    for (int u = tid; u < (LDS_BYTES - 131072) / 4; u += NTHR) ((LAS unsigned*)(L + 131072))[u] = 0u;
    __syncthreads();
#if !MK_PER_PHASE
    XcdBarrier bar = xcd_barrier_post(ctl + CW_BAR, MISC + 8);
#define GRID_BAR() xcd_barrier(bar)
#else
#define GRID_BAR() do {} while (0)
#endif
    const int lo = args.ph_lo, hi = args.ph_hi;
#define IN(k) (lo <= (k) && (k) < hi)
#define PHASE_L(k, ...) do { if (IN(k)) { auto body_ = [&]() __attribute__((always_inline)) __VA_ARGS__; body_(); if ((PROBE_REP >> (k)) & 1) { GRID_BAR(); body_(); } } } while (0)
#if !MK_PER_PHASE
#define PHASE(k) for (int rep_ = 0, nrep_ = IN(k) ? 1 + ((PROBE_REP >> (k)) & 1) : 0; rep_ < nrep_; ++rep_, (rep_ < nrep_ ? (xcd_barrier(bar), 0) : 0))
#else
#define PHASE(k) if (IN(k))
#endif
    unsigned long long st_t0_ = 0ull, st_dt_ = 0ull;
#define STAMP_AT(k) do { if (PROBE_STAMP >= 0) { const unsigned long long now_ = __builtin_amdgcn_s_memrealtime(); if ((k) == PROBE_STAMP || (PROBE_STAMP == 100 && (k) == 0)) st_t0_ = now_; if ((k) == PROBE_STAMP + 1 || (PROBE_STAMP == 100 && (k) == 15)) st_dt_ = now_ - st_t0_; } } while (0)
#define SEAM(k) do { if (IN(k) && IN((k) + 1)) GRID_BAR(); STAMP_AT((k) + 1); } while (0)
    const int gw = blockIdx.x * NWAVES + wave, NGW = G * NWAVES;
    const int xcu = (G % 8 == 0) ? ((int)blockIdx.x % 8) * (G / 8) + (int)blockIdx.x / 8 : (int)blockIdx.x;

    auto convert_experts = [&]() __attribute__((always_inline)) {
        LAS float* scr = (LAS float*)(L + wave * 16384);
        {
            const int c8 = lane & 7, r8 = lane >> 3;
            f32x4 ra[8], rb[8], rc[8], rd[8], re[8];
            auto sub_load = [&](const float* Wc, int N, int k0, f32x4 (&r)[8]) __attribute__((always_inline)) {
#pragma unroll
                for (int i = 0; i < 8; ++i) r[i] = *(const f32x4*)(Wc + (size_t)(k0 + 8 * i + r8) * N); };
            auto to_lds = [&](const f32x4 (&r)[8]) __attribute__((always_inline)) {
#pragma unroll
                for (int i = 0; i < 8; ++i) *(LAS f32x4*)(scr + (8 * i + r8) * 32 + ((4 * c8) ^ (4 * i))) = r[i];
                LDS_WAIT(); asm volatile("" ::: "memory"); };
            auto max8 = [&](float v) __attribute__((always_inline)) -> float {
                v = fmaxf(v, __uint_as_float(__builtin_amdgcn_update_dpp(0, __float_as_uint(v), 0xB1, 0xf, 0xf, false)));
                v = fmaxf(v, __uint_as_float(__builtin_amdgcn_update_dpp(0, __float_as_uint(v), 0x4E, 0xf, 0xf, false)));
                v = fmaxf(v, __uint_as_float(__builtin_amdgcn_update_dpp(0, __float_as_uint(v), 0x141, 0xf, 0xf, false)));
                return v; };
            for (int it = gw; it < NE * 96 * 4; it += NGW) {
                const int strip = it % (NE * 96), qt = it / (NE * 96);
                const bool gu = strip < NE * 64; const int q = gu ? strip : strip - NE * 64, e = gu ? q >> 6 : q >> 5, n0 = (gu ? q & 63 : q & 31) * 32, N = gu ? 2048 : 1024;
                const float* Wc = (gu ? w_gate_up + (size_t)e * 1024 * 2048 : w_down + (size_t)e * 1024 * 1024) + n0 + 4 * c8;
                sub_load(Wc, N, 0, ra); sub_load(Wc, N, 256 * qt, rb); sub_load(Wc, N, 256 * qt + 64, rc); sub_load(Wc, N, 256 * qt + 128, rd); sub_load(Wc, N, 256 * qt + 192, re);
                to_lds(ra);
                float inv[4], am[4];
#pragma unroll
                for (int j = 0; j < 4; ++j) { const int n = r8 + 8 * j; float a0 = 0.f;
#pragma unroll
                    for (int i = 0; i < 8; ++i) a0 = fmaxf(a0, fabsf(scr[(8 * c8 + i) * 32 + (n ^ (4 * c8))]));
                    a0 = max8(a0);
                    unsigned eb = ((__float_as_uint(a0) >> 23) & 0xffu) + 4u; eb = eb < 8u ? 8u : (eb > 250u ? 250u : eb);
                    inv[j] = __uint_as_float((261u - eb) << 23); am[j] = 0.f;
                    if (qt == 0 && c8 == 0) (gu ? WSCGU + (size_t)e * 2048 : WSCD + (size_t)e * 1024)[n0 + n] = __uint_as_float((eb - 7u) << 23); }
                LDS_WAIT(); asm volatile("" ::: "memory");
                unsigned char* dstb = gu ? WGU8 + (size_t)e * 2048 * 1024 : WD8 + (size_t)e * 1024 * 1024;
#pragma unroll
                for (int st = 0; st < 4; ++st) {
                    const int k0 = 256 * qt + 64 * st;
                    if (st == 0) to_lds(rb); else if (st == 1) to_lds(rc); else if (st == 2) to_lds(rd); else to_lds(re);
#pragma unroll
                    for (int j = 0; j < 4; ++j) { const int n = r8 + 8 * j, c = n0 + n; const LAS float* sp = scr + (8 * c8) * 32 + (n ^ (4 * c8)); float v[8];
#pragma unroll
                        for (int i = 0; i < 8; ++i) { v[i] = sp[i * 32]; am[j] = fmaxf(am[j], fabsf(v[i])); v[i] *= inv[j]; }
                        const int drow = gu ? (((c & 1023) >> 7) * 256 + (c >> 10) * 128 + (c & 127)) : c;
                        v2u w; w.x = pk4_fp8(v[0], v[1], v[2], v[3]); w.y = pk4_fp8(v[4], v[5], v[6], v[7]);
                        *(v2u*)(dstb + (size_t)drow * 1024 + k0 + 8 * c8) = w; }
                    LDS_WAIT(); asm volatile("" ::: "memory");
                }
                bool ov = false;
#pragma unroll
                for (int j = 0; j < 4; ++j) ov = ov || (am[j] * inv[j] >= 448.0f);
                if (__any(ov) && lane == 0) __hip_atomic_store(ctl + CW_REDO + strip, 1u, __ATOMIC_RELAXED, __HIP_MEMORY_SCOPE_AGENT);
            }
        }
    };
    STAMP_AT(0);
    PHASE(0) {
        STAMP_AT(20);
        LAS float* scr = (LAS float*)(L + wave * 16384);
        constexpr int I_IN = 16 * 160, I_UP = 8 * 32, I_SQ = 16 * 32, I_KV = 16 * 64, I_GU1 = 16 * 64, I_GU = NE * I_GU1, I_D1 = 16 * 32, I_DN = NE * I_D1;
        constexpr int NITEMS = I_IN + 2 * I_UP + 3 * I_SQ + I_KV;
        for (int it = gw; it < NITEMS; it += NGW) {
            int r = it;
            if (r < I_IN) {
                const int kb = r / 160, nb = r % 160, n0 = 32 * nb;
                if (n0 >= C_DQ && n0 < C_DV) { const int o = n0 & 255;
                    p0_transpose_rope(w_in, WIN, (n0 & ~255), o, 64 * kb, n0, scr, lane); }
                else p0_transpose_item(w_in, 1024, NIN, WIN, n0, 64 * kb, n0, scr, lane);
                continue; } r -= I_IN;
            if (r < I_UP) { p0_plain(w_up_sb, 512, 1024, WUPSB, r, scr, lane); continue; } r -= I_UP;
            if (r < I_UP) { p0_plain(w_up_diff, 512, 1024, WUPDF, r, scr, lane); continue; } r -= I_UP;
            if (r < I_SQ) { p0_plain(w_out, 1024, 1024, WOUT, r, scr, lane); continue; } r -= I_SQ;
            if (r < I_SQ) { p0_plain(w_mem_q, 1024, 1024, WMQ, r, scr, lane, norm_mem_q); continue; } r -= I_SQ;
            if (r < I_SQ) { p0_plain(w_mem_o, 1024, 1024, WMO, r, scr, lane); continue; } r -= I_SQ;
            p0_plain(w_mem_kv, 1024, 2048, WMKV, r, scr, lane);
        }
        for (int i = blockIdx.x * NTHR + tid; i < D * NE; i += G * NTHR) WR[i] = w_router[i] * norm_ffn[i >> 5];
        STAMP_AT(21);
        STAMP_AT(22);
        for (int m = gw; m < M; m += NGW) rms_row_to_bf16(x_in + (size_t)m * D, norm_mix, XN + (size_t)m * D, lane);
        for (int m = gw; m < MM; m += NGW) rms_row_to_bf16(mem_in + (size_t)m * D, norm_mem_kv, HM + (size_t)m * D, lane);
        for (int i = blockIdx.x * NTHR + tid; i < M * 32; i += G * NTHR) {
            const int m = i >> 5, f = i & 31;
            const double inv = exp2(-(double)f * (13.287712379549449 / 32.0));
            const double ang = (double)positions[m] * inv;
            const double kk = rint(ang * 0.15915494309189535);
            const float rf = (float)(ang - kk * 6.283185307179586);
            ROPEC[i] = __cosf(rf); ROPES[i] = __sinf(rf);
        }
        STAMP_AT(23);
    }
    SEAM(0); STAMP_AT(24);

    if (IN(1)) {
        const int grp = (int)blockIdx.x % 3;
        pg8::Gemm g{XN, WIN, D, D, D}; pg8::DenseOrder S; S.init(M, NIN, G, (int)blockIdx.x, D, D);
        const pg8::EpiInProj E{PR, ROPEC, ROPES, VTSB, VTDF};
        if (grp == 0) { convert_experts(); __syncthreads(); }
        if (grp == 1) { S.i0 = 0; S.i1 = 2; pg8::gemm_phase<pg8::EpiInProj, pg8::DenseOrder, false>(L, g, S, E); convert_experts(); __syncthreads(); S.i0 = 2; S.i1 = 1 << 30; }
        pg8::gemm_phase<pg8::EpiInProj, pg8::DenseOrder, false>(L, g, S, E);
        if (grp == 2) convert_experts();
    }
    SEAM(1);

    if (IN(3)) {
        {
            LAS float* sw = (LAS float*)L; LAS float* red = (LAS float*)(L + 131072 + 4096);
            const int n = tid & 31, part = tid >> 5;
            for (int it = blockIdx.x; it < NE * 96; it += G) {
                if (__hip_atomic_load(ctl + CW_REDO + it, __ATOMIC_RELAXED, __HIP_MEMORY_SCOPE_AGENT) == 0u) continue;
                const bool gu = it < NE * 64; const int q = gu ? it : it - NE * 64, e = gu ? q >> 6 : q >> 5, n0 = (gu ? q & 63 : q & 31) * 32, N = gu ? 2048 : 1024;
                const float* W = (gu ? w_gate_up + (size_t)e * 1024 * 2048 : w_down + (size_t)e * 1024 * 1024) + n0 + n;
                __syncthreads();
#pragma unroll 16
                for (int i = 0; i < 64; ++i) { const int k = part + 16 * i; sw[k * 32 + n] = W[(size_t)k * N]; }
                __syncthreads();
                float am = 0.f;
#pragma unroll 16
                for (int i = 0; i < 64; ++i) am = fmaxf(am, fabsf(sw[(64 * part + i) * 32 + n]));
                red[part * 32 + n] = am;
                __syncthreads();
                if (tid < 32) { float a = red[tid];
#pragma unroll
                    for (int pp = 1; pp < 16; ++pp) a = fmaxf(a, red[pp * 32 + tid]);
                    unsigned eb = (__float_as_uint(a) >> 23) & 0xffu; eb = eb < 8u ? 8u : eb;
                    const float sc = __uint_as_float((eb - 7u) << 23), inv = __uint_as_float((261u - eb) << 23);
                    red[512 + tid] = inv; (gu ? WSCGU + (size_t)e * 2048 : WSCD + (size_t)e * 1024)[n0 + tid] = sc; }
                __syncthreads();
                { const float inv = red[512 + n]; const int c = n0 + n;
                  const int drow = gu ? (((c & 1023) >> 7) * 256 + (c >> 10) * 128 + (c & 127)) : c;
                  unsigned char* dst = (gu ? WGU8 + ((size_t)e * 2048 + drow) * 1024 : WD8 + ((size_t)e * 1024 + drow) * 1024) + 64 * part;
#pragma unroll
                  for (int qd = 0; qd < 4; ++qd) { v4u w;
                      const LAS float* sp = sw + (64 * part + 16 * qd) * 32 + n;
                      w.x = pk4_fp8(sp[0] * inv, sp[32] * inv, sp[64] * inv, sp[96] * inv); w.y = pk4_fp8(sp[128] * inv, sp[160] * inv, sp[192] * inv, sp[224] * inv);
                      w.z = pk4_fp8(sp[256] * inv, sp[288] * inv, sp[320] * inv, sp[352] * inv); w.w = pk4_fp8(sp[384] * inv, sp[416] * inv, sp[448] * inv, sp[480] * inv);
                      *(v4u*)(dst + 16 * qd) = w; } }
            }
            __syncthreads();
        }
    }
    PHASE(3) {
        volatile LAS unsigned* fl = (volatile LAS unsigned*)(L + 131072 + 2048);
        STAMP_AT(30);
        const float lam = expf(wave_sum(lam_q1[lane] * lam_k1[lane])) - expf(wave_sum(lam_q2[lane] * lam_k2[lane])) + 0.2f;
        const int nkv = (G >= 64) ? 32 : 0;
        if ((int)blockIdx.x < nkv) { pg8::Gemm g{HM, WMKV, D, D, D}; pg8::OneUnitOrder S{(int)blockIdx.x, D, D};
            pg8::gemm_phase<pg8::EpiKV, pg8::OneUnitOrder, false>(L, g, S, pg8::EpiKV{KVM, VTM}); }
        if (nkv == 0) { pg8::Gemm g{HM, WMKV, D, D, D}; pg8::DenseOrder S; S.init(MM, 2048, G, (int)blockIdx.x, D, D); pg8::gemm_phase<pg8::EpiKV, pg8::DenseOrder, false>(L, g, S, pg8::EpiKV{KVM, VTM}); }
        for (int pr = blockIdx.x; pr < 256; pr += G) { const int sb_ = pr & 15, h = (pr >> 4) & 3, b = pr >> 6;
            attn_diff_block(PR, VTDF, OAT, diff_subln, lam, b, h, 31 - sb_, L, tid, wave, lane); attn_diff_block(PR, VTDF, OAT, diff_subln, lam, b, h, sb_, L, tid, wave, lane); }
        STAMP_AT(31);
        for (;;) {
            if (tid == 0) fl[4] = __hip_atomic_fetch_add(ctl + CW_SBQ, 1u, __ATOMIC_RELAXED, __HIP_MEMORY_SCOPE_AGENT);
            __syncthreads();
            const int bu = (int)fl[4];
            __syncthreads();
            if (bu >= 512) break;
            const int qb = 15 - (bu & 15), h = (bu >> 4) & 7, b = bu >> 7;
            attn_sb_block(PR, VTSB, OAT, b, h, qb, L, fl, tid, wave, lane);
        }
        STAMP_AT(32);
    }
    SEAM(3); STAMP_AT(3); STAMP_AT(33);

    PHASE_L(5, {
        pg8::Gemm g{OAT, WUPSB, D, 512, 512}; pg8::TwoRoundOrder S{G, xcu, D, 512};
        pg8::gemm_phase<pg8::EpiGate, pg8::TwoRoundOrder, false>(L, g, S, pg8::EpiGate{PR, (bf16_t*)X1, MIX});
    });
    SEAM(5); STAMP_AT(5);

    PHASE_L(6, {
        pg8::Gemm g{MIX, WOUT, D, D, D}; pg8::DenseOrder S; S.init(M, D, G, (int)blockIdx.x, D, D);
        pg8::gemm_phase<pg8::EpiResidNorm, pg8::DenseOrder, false>(L, g, S, pg8::EpiResidNorm{x_in, X1, XN, SSQ});
    });
    if (IN(6) && IN(8)) GRID_BAR();
    STAMP_AT(7); STAMP_AT(8);

    PHASE_L(8, {
        pg8::Gemm g{XN, WMQ, D, D, D}; pg8::DenseOrder S; S.init(M, D, G, (int)blockIdx.x, D, D);
        pg8::gemm_phase<pg8::EpiBf16Rinv, pg8::DenseOrder, false>(L, g, S, pg8::EpiBf16Rinv{QM, SSQ, 0.0625f * 1.4426950408889634f});
    });
    SEAM(8);

    PHASE(9) { for (int bu = blockIdx.x; bu < 256; bu += G) { const int qb = bu & 15, h = (bu >> 4) & 3, b = bu >> 6; attn_mem_block(QM, KVM, VTM, OM, b, h, qb, L, tid, wave, lane); } }
    SEAM(9);

    PHASE_L(10, {
        pg8::Gemm g{OM, WMO, D, D, D}; pg8::DenseOrder S; S.init(M, D, G, (int)blockIdx.x, D, D);
        pg8::gemm_phase<pg8::EpiResidB, pg8::DenseOrder, false>(L, g, S, pg8::EpiResidB{XN, X2});
    });
    SEAM(10);

    if (IN(11)) {
        auto body11_ = [&]() __attribute__((always_inline)) {
        {
            const int i32 = lane & 31, kk = lane >> 5;
#pragma unroll
            for (int t2 = 0; t2 < 2; ++t2) {
                const int tile = t2 * G + (int)blockIdx.x, m0 = tile * 32;
                LAS float* P = smf + (t2 * 8 + wave) * 1056; LAS float* SSQ_ = smf + 16 * 1056 + (t2 * 8 + wave) * 32;
                f32x16 acc;
#pragma unroll
                for (int r = 0; r < 16; ++r) acc[r] = 0.f;
                float ss = 0.f;
                if (tile < M / 32) {
                    const float* xr = X2 + (size_t)(m0 + i32) * D + 128 * wave + 4 * kk; const float* wp = WR + (128 * wave + 4 * kk) * NE + i32;
#pragma unroll 8
                    for (int u = 0; u < 16; ++u) {
                        const f32x4 a = *(const f32x4*)(xr + 8 * u);
                        const float b0 = wp[(8 * u + 0) * NE], b1 = wp[(8 * u + 1) * NE], b2 = wp[(8 * u + 2) * NE], b3 = wp[(8 * u + 3) * NE];
                        acc = __builtin_amdgcn_mfma_f32_32x32x2f32(a.x, b0, acc, 0, 0, 0); acc = __builtin_amdgcn_mfma_f32_32x32x2f32(a.y, b1, acc, 0, 0, 0);
                        acc = __builtin_amdgcn_mfma_f32_32x32x2f32(a.z, b2, acc, 0, 0, 0); acc = __builtin_amdgcn_mfma_f32_32x32x2f32(a.w, b3, acc, 0, 0, 0);
                        ss += (a.x * a.x + a.y * a.y) + (a.z * a.z + a.w * a.w);
                    }
                }
                ss += xhalf(ss, kk);
#pragma unroll
                for (int r = 0; r < 16; ++r) P[((r & 3) + 8 * (r >> 2) + 4 * kk) * 33 + i32] = acc[r];
                if (kk == 0) SSQ_[i32] = ss;
            }
        }
        __syncthreads();
        if (wave < 2) {
            const int tile = wave * G + (int)blockIdx.x;
            if (tile < M / 32) {
                const int m0 = tile * 32;
                LAS float* T = smf + (wave * 8) * 1056;
#pragma unroll
                for (int r = 0; r < 16; ++r) { const int idx = lane + 64 * r, e_ = (idx >> 5) * 33 + (idx & 31); float v = T[e_];
#pragma unroll
                    for (int w2 = 1; w2 < 8; ++w2) v += T[w2 * 1056 + e_];
                    T[e_] = v; }
                float ss = 0.f;
#pragma unroll
                for (int w2 = 0; w2 < 8; ++w2) ss += smf[16 * 1056 + (wave * 8 + w2) * 32 + (lane & 31)];
                LDS_WAIT(); asm volatile("" ::: "memory");
                const float rinv = 1.0f / sqrtf(ss * (1.f / 1024.f) + NORM_EPS);
                if (lane < 32) {
                    float lg[32];
#pragma unroll
                    for (int j = 0; j < 32; ++j) lg[j] = T[lane * 33 + j] * rinv + b_router[j];
                    float tv[4]; int ti[4];
#pragma unroll
                    for (int k = 0; k < 4; ++k) { float bv = lg[0]; int bi = 0;
#pragma unroll
                        for (int j = 1; j < 32; ++j) if (lg[j] > bv) { bv = lg[j]; bi = j; }
                        tv[k] = bv; ti[k] = bi;
#pragma unroll
                        for (int j = 0; j < 32; ++j) if (j == bi) lg[j] = -INFINITY; }
                    const float e1 = __expf(tv[1] - tv[0]), e2 = __expf(tv[2] - tv[0]), e3 = __expf(tv[3] - tv[0]);
                    const float isum = 1.f / (1.f + e1 + e2 + e3);
                    const float gk[4] = {isum, e1 * isum, e2 * isum, e3 * isum};
                    LAS unsigned* H = (LAS unsigned*)(smf + 16 * 1056 + 512 + wave * 64);
                    H[lane] = 0u;
                    LDS_WAIT(); asm volatile("" ::: "memory");
                    int rk[4];
#pragma unroll
                    for (int k = 0; k < 4; ++k) rk[k] = (int)__hip_atomic_fetch_add(H + ti[k], 1u, __ATOMIC_RELAXED, __HIP_MEMORY_SCOPE_WAVEFRONT);
                    LDS_WAIT(); asm volatile("" ::: "memory");
                    const unsigned cnt_e = H[lane];
                    unsigned base_e = 0u; if (cnt_e) base_e = atomicAdd(&CNT[64 * lane], cnt_e);
                    H[32 + lane] = base_e;
                    LDS_WAIT(); asm volatile("" ::: "memory");
                    const int m = m0 + lane;
#pragma unroll
                    for (int k = 0; k < 4; ++k) { const int ek = ti[k]; const int pos = (int)H[32 + ek] + rk[k];
                        TLIST[ek * LISTCAP + pos] = m; GLIST[ek * LISTCAP + pos] = gk[k]; TK_E[m * 4 + k] = ek; TK_POS[m * 4 + k] = pos; TK_G[m * 4 + k] = gk[k]; }
                }
            }
        } else {
            for (int m = blockIdx.x * 6 + (wave - 2); m < M; m += G * 6) rms_row_to_fp8(X2 + (size_t)m * D, norm_ffn, XN8 + (size_t)m * D, lane);
        }
            };
        body11_();
        if ((PROBE_REP >> 11) & 1) { GRID_BAR(); if (blockIdx.x == 0 && tid < NE) CNT[64 * tid] = 0u; GRID_BAR(); body11_(); }
    }
    SEAM(11);

#define LOAD_BASES() do { __syncthreads(); if (tid == 0) { int b_ = 0; for (int e_ = 0; e_ < NE; ++e_) { const int c_ = (int)__hip_atomic_load(&CNT[64 * e_], __ATOMIC_RELAXED, __HIP_MEMORY_SCOPE_AGENT); \
        smi[8192 + e_] = b_; smi[8256 + e_] = c_; b_ += (c_ + 255) & ~255; } } __syncthreads(); } while (0)

    LAS int* tb = (LAS int*)(L + 131072 + 1024);
#define LOAD_TB(npn) do { __syncthreads(); if (tid == 0) { int b_ = 0, cu_ = 0; for (int e_ = 0; e_ < NE; ++e_) { const int c_ = (int)__hip_atomic_load(&CNT[64 * e_], __ATOMIC_RELAXED, __HIP_MEMORY_SCOPE_AGENT); \
        tb[e_] = b_; tb[32 + e_] = c_; tb[64 + e_] = cu_; b_ += (c_ + 255) & ~255; cu_ += ((c_ + 255) >> 8) * (npn); } tb[96] = cu_; } __syncthreads(); } while (0)
    PHASE_L(12, {
        LOAD_TB(8);
        pg8::Gemm g{(const bf16_t*)XN8, (const bf16_t*)WGU8, 512, 512, 512}; pg8::MoeOrder S{tb, TLIST, G, xcu, 8, 512, 512, 2048};
        pg8::gemm_phase<pg8::EpiMoeGU, pg8::MoeOrder, true, true>(L, g, S, pg8::EpiMoeGU{ACT8, b_gate_up, WSCGU});
    });
    SEAM(12);
    PHASE_L(13, {
        LOAD_TB(4);
        pg8::Gemm g{(const bf16_t*)ACT8, (const bf16_t*)WD8, 512, 512, 512}; pg8::MoeOrder S{tb, TLIST, G, xcu, 4, 512, 512, 1024};
        pg8::gemm_phase<pg8::EpiMoeDown, pg8::MoeOrder, false, true>(L, g, S, pg8::EpiMoeDown{YB, b_down, GLIST, tb, WSCD});
    });
    SEAM(13);

    PHASE(14) {
        LOAD_BASES();
        for (int mb = gw; mb < M; mb += 8 * NGW) {
            int slotv = 0;
            { const int i = lane >> 2, k = lane & 3, m = mb + NGW * i; if (lane < 32 && m < M) slotv = smi[8192 + TK_E[m * 4 + k]] + TK_POS[m * 4 + k]; }
#pragma unroll 2
            for (int i = 0; i < 8; ++i) {
                const int m = mb + NGW * i; if (m >= M) break;
                const f32x4* xr = (const f32x4*)(X2 + (size_t)m * D) + lane; const f32x4* gr = (const f32x4*)norm_final + lane;
                f32x4 v[4];
#pragma unroll
                for (int j = 0; j < 4; ++j) v[j] = xr[64 * j];
#pragma unroll
                for (int k = 0; k < 4; ++k) { const int slot = __builtin_amdgcn_readlane(slotv, 4 * i + k); const v2u* yr = (const v2u*)(YB + (size_t)slot * D) + lane;
#pragma unroll
                    for (int j = 0; j < 4; ++j) { const v2u w = yr[64 * j]; v[j].x += lo16(w.x); v[j].y += hi16(w.x); v[j].z += lo16(w.y); v[j].w += hi16(w.y); } }
                float ss = 0.f;
#pragma unroll
                for (int j = 0; j < 4; ++j) ss += (v[j].x * v[j].x + v[j].y * v[j].y) + (v[j].z * v[j].z + v[j].w * v[j].w);
                const float rinv = 1.0f / sqrtf(wave_sum(ss) * (1.f / 1024.f) + NORM_EPS);
                f32x4* orow = (f32x4*)(args.out + (size_t)m * D) + lane;
#pragma unroll
                for (int j = 0; j < 4; ++j) { const f32x4 gg = gr[64 * j]; orow[64 * j] = (f32x4){v[j].x * rinv * gg.x, v[j].y * rinv * gg.y, v[j].z * rinv * gg.z, v[j].w * rinv * gg.w}; }
            }
        }
    }
    if (PROBE_STAMP >= 0) { STAMP_AT(15); if (blockIdx.x == PROBE_BLOCK) { const unsigned long long t1_ = __builtin_amdgcn_s_memrealtime(); while (__builtin_amdgcn_s_memrealtime() - t1_ < st_dt_) __builtin_amdgcn_s_sleep(8); } }
#undef IN
#undef SEAM
}

extern "C" void kernel_launch(void* const* d_in, const int* in_sizes, int n_in, void* d_out, int out_size, void* d_ws, size_t ws_size, hipStream_t stream) {
    static int grid = 0;
    if (grid == 0) {
        if (n_in != 26 || out_size != M * D || ws_size < WS_END) { fprintf(stderr, "kernel_launch: unexpected sizes n_in %d out %d ws %zu\n", n_in, out_size, ws_size); grid = -1; return; }
        int dev = 0, cus = 0;
        if (hipGetDevice(&dev) != hipSuccess || hipDeviceGetAttribute(&cus, hipDeviceAttributeMultiprocessorCount, dev) != hipSuccess) { grid = -1; return; }
        if (hipFuncSetAttribute((const void*)fwd, hipFuncAttributeMaxDynamicSharedMemorySize, LDS_BYTES) != hipSuccess) { fprintf(stderr, "kernel_launch: hipFuncSetAttribute failed\n"); grid = -1; return; }
        int per_cu = 0;
        (void)hipOccupancyMaxActiveBlocksPerMultiprocessor(&per_cu, (const void*)fwd, NTHR, LDS_BYTES);
        (void)hipGetLastError();
        grid = cus;
    }
    if (grid < 0) return;
    (void)hipMemsetAsync((char*)d_ws + WS_CTL, 0, CTL_ZERO_BYTES, stream);
    Args a{};
    for (int i = 0; i < 26; ++i) a.in[i] = d_in[i];
    a.out = (float*)d_out; a.ws = (unsigned char*)d_ws;
#if MK_PER_PHASE
    for (int p = 0; p < NPHASE; ++p) { a.ph_lo = p; a.ph_hi = p + 1; hipLaunchKernelGGL(fwd, dim3(grid), dim3(NTHR), LDS_BYTES, stream, a); }
#else
    a.ph_lo = 0; a.ph_hi = NPHASE; hipLaunchKernelGGL(fwd, dim3(grid), dim3(NTHR), LDS_BYTES, stream, a);
#endif
}
```

```cpp
#include <hip/hip_runtime.h>
#include <cstdio>
#include <cstdint>

#ifndef MK_PER_PHASE
#define MK_PER_PHASE 0
#endif

#ifndef PROBE_STAMP
#define PROBE_STAMP -1
#endif
#ifndef PROBE_BLOCK
#define PROBE_BLOCK 0
#endif
#ifndef PROBE_REP
#define PROBE_REP 0
#endif
#define GAS __attribute__((address_space(1)))
#define LAS __attribute__((address_space(3)))
typedef unsigned short bf16_t;
typedef unsigned v4u __attribute__((ext_vector_type(4)));
typedef unsigned v2u __attribute__((ext_vector_type(2)));
typedef float f32x4 __attribute__((ext_vector_type(4)));
typedef short bf16x8 __attribute__((ext_vector_type(8)));

constexpr int BATCH = 4, SEQ = 4096, D = 1024, M = BATCH * SEQ, NIN = 5120;
constexpr int MEMLEN = 256, MM = BATCH * MEMLEN;
constexpr int NE = 32, TOPK = 4, DFF = 1024;
constexpr float NORM_EPS = 1e-6f;
constexpr int C_SBQ = 0, C_SBK = 512, C_SBV = 1024, C_DQ = 1536, C_DK = 2048, C_DV = 2560, C_GSB = 3072, C_GDF = 4096;
constexpr int LISTCAP = 16384;
constexpr int SLOTS = 65536 + NE * 256;
constexpr int NWAVES = 8, NTHR = 512;

constexpr size_t MiB = 1u << 20;
constexpr size_t WS_CTL = 0, CTL_ZERO_BYTES = 1 * MiB;
constexpr size_t WS_WIN = 2 * MiB;
constexpr size_t WS_WUPSB = 12 * MiB;
constexpr size_t WS_WUPDF = 13 * MiB;
constexpr size_t WS_WOUT = 14 * MiB;
constexpr size_t WS_WMQ = 16 * MiB;
constexpr size_t WS_WMKV = 18 * MiB;
constexpr size_t WS_WMO = 22 * MiB;
constexpr size_t WS_ROPE = 24 * MiB;
constexpr size_t WS_TK = 28 * MiB;
constexpr size_t WS_WR = 29 * MiB;
constexpr size_t WS_WSC = 30 * MiB;
constexpr size_t WS_WGU = 32 * MiB;
constexpr size_t WS_WD = 160 * MiB;
constexpr size_t WS_XN = 224 * MiB;
constexpr size_t WS_PR = 256 * MiB;
constexpr size_t WS_OAT = 416 * MiB;
constexpr size_t WS_ODR = 448 * MiB;
constexpr size_t WS_MIX = 512 * MiB;
constexpr size_t WS_X1 = 544 * MiB;
constexpr size_t WS_X2 = 608 * MiB;
constexpr size_t WS_HM = 672 * MiB;
constexpr size_t WS_KVM = 674 * MiB;
constexpr size_t WS_TLIST = 678 * MiB;
constexpr size_t WS_GLIST = 680 * MiB;
constexpr size_t WS_QM = 682 * MiB;
constexpr size_t WS_OM = 714 * MiB;
constexpr size_t WS_ACT = 256 * MiB;
constexpr size_t WS_YB = 746 * MiB;
constexpr size_t WS_VTSB = 890 * MiB;
constexpr size_t WS_VTDF = 906 * MiB;
constexpr size_t WS_VTM = 922 * MiB;
constexpr size_t WS_END = 924 * MiB;
static_assert(WS_ACT + (size_t)SLOTS * 1024 * 2 <= WS_OAT, "ACT overlay");
static_assert(WS_YB + (size_t)SLOTS * 1024 * 2 <= WS_VTSB, "YB");
constexpr int CW_REDO = 16384;
constexpr int CW_SBQ = 6144;
constexpr int CW_CNT = 8192;
constexpr int CW_BAR = 1024;

constexpr int LDS_BYTES = 147456;
constexpr int MISC_OFF = 131072 + 320;

__device__ __forceinline__ float bf2f(bf16_t b) { return __uint_as_float(((unsigned)b) << 16); }
__device__ __forceinline__ unsigned f2bf(float f) { unsigned u = __float_as_uint(f); return (u + 0x7fffu + ((u >> 16) & 1u)) >> 16; }
__device__ __forceinline__ unsigned pk2(float lo, float hi) { return f2bf(lo) | (f2bf(hi) << 16); }
__device__ __forceinline__ unsigned pk4_fp8(float a, float b, float c, float d) { int w = 0; w = __builtin_amdgcn_cvt_pk_fp8_f32(a, b, w, false); w = __builtin_amdgcn_cvt_pk_fp8_f32(c, d, w, true); return (unsigned)w; }
__device__ __forceinline__ float lo16(unsigned w) { return __uint_as_float(w << 16); }
__device__ __forceinline__ float hi16(unsigned w) { return __uint_as_float(w & 0xffff0000u); }
#define LDS_WAIT() asm volatile("s_waitcnt lgkmcnt(0)" ::: "memory")
__device__ __forceinline__ float wave_sum(float v) {
#pragma unroll
    for (int o = 1; o < 64; o <<= 1) v += __shfl_xor(v, o);
    return v;
}
__device__ __forceinline__ float wave_max(float v) {
#pragma unroll
    for (int o = 1; o < 64; o <<= 1) v = fmaxf(v, __shfl_xor(v, o));
    return v;
}

#define XB_TMO      128
#define XB_XCNT(j)  (256  + 64 * (j))
#define XB_XSUB(j)  (1280 + 64 * (j))
#define XB_XGEN(j)  (2304 + 64 * (j))
#define XB_TOP      3328
#define XB_TOPGEN   3392
#define XCD_BAR_WORDS 3456
#define XB_SPIN_CAP (1u << 18)
__device__ __forceinline__ unsigned xb_ld(unsigned* p)              { return __hip_atomic_load(p, __ATOMIC_RELAXED, __HIP_MEMORY_SCOPE_AGENT); }
__device__ __forceinline__ unsigned xb_add(unsigned* p, unsigned v) { return __hip_atomic_fetch_add(p, v, __ATOMIC_RELAXED, __HIP_MEMORY_SCOPE_AGENT); }
__device__ __forceinline__ unsigned xb_xcc_id() { return (unsigned)__builtin_amdgcn_s_getreg((3 << 11) | 20) & 0xFu; }
#define XB_SPIN(cond, bar) do { unsigned _sp = 0; while (cond) { __builtin_amdgcn_s_sleep(1); \
    if ((++_sp & 255u) == 0u) { if (xb_ld(&(bar)[XB_TMO])) break; if (_sp > XB_SPIN_CAP) { atomicAdd(&(bar)[XB_TMO], 1u); break; } } } } while (0)
struct XcdBarrier { unsigned* bar; unsigned x; volatile LAS unsigned* st; };
__device__ __forceinline__ XcdBarrier xcd_barrier_post(unsigned* bar, volatile LAS unsigned* st) {
    XcdBarrier b; b.bar = bar; b.x = xb_xcc_id(); b.st = st;
    if (threadIdx.x == 0) (void)xb_add(&bar[XB_XCNT(b.x)], 1u);
    return b;
}
__device__ __forceinline__ void xcd_barrier_complete(unsigned* bar, unsigned x, unsigned& nloc, unsigned& nx) {
    const unsigned G = gridDim.x * gridDim.y * gridDim.z;
    unsigned sum, cnt, mine, sp = 0u;
    for (;;) {
        sum = 0u; cnt = 0u; mine = 0u;
#pragma unroll
        for (unsigned j = 0; j < 16; ++j) { const unsigned c = xb_ld(&bar[XB_XCNT(j)]); sum += c; cnt += (c > 0u) ? 1u : 0u; mine = (j == x) ? c : mine; }
        if (sum == G) break;
        __builtin_amdgcn_s_sleep(1);
        if ((++sp & 255u) == 0u) { if (xb_ld(&bar[XB_TMO])) break; if (sp > XB_SPIN_CAP) { atomicAdd(&bar[XB_TMO], 1u); break; } }
    }
    nloc = mine > 0u ? mine : 1u; nx = cnt > 0u ? cnt : 1u;
}
__device__ __forceinline__ void xcd_barrier(const XcdBarrier& b) {
    asm volatile("s_waitcnt vmcnt(0)" ::: "memory");
    __syncthreads();
    if (threadIdx.x == 0) {
        unsigned* bar = b.bar;
        __builtin_amdgcn_s_waitcnt(0);
        unsigned nloc = b.st[0], nx = b.st[1];
        if (nloc == 0u) { xcd_barrier_complete(bar, b.x, nloc, nx); b.st[0] = nloc; b.st[1] = nx; }
        const unsigned old = xb_add(&bar[XB_XSUB(b.x)], 1u);
        const unsigned gen = old / nloc;
        if (old + 1u == (gen + 1u) * nloc) {
            __builtin_amdgcn_fence(__ATOMIC_RELEASE, "agent");
            asm volatile("s_waitcnt vmcnt(0)" ::: "memory");
            const unsigned og = xb_add(&bar[XB_TOP], 1u);
            const unsigned tg = og / nx;
            if (og + 1u == (tg + 1u) * nx) xb_add(&bar[XB_TOPGEN], 1u);
            else XB_SPIN(xb_ld(&bar[XB_TOPGEN]) == tg, bar);
            __builtin_amdgcn_fence(__ATOMIC_ACQUIRE, "agent");
            xb_add(&bar[XB_XGEN(b.x)], 1u);
            asm volatile("s_waitcnt vmcnt(0)" ::: "memory");
        } else {
            XB_SPIN(xb_ld(&bar[XB_XGEN(b.x)]) == gen, bar);
            __builtin_amdgcn_fence(__ATOMIC_ACQUIRE, "agent");
            asm volatile("s_waitcnt vmcnt(0)" ::: "memory");
        }
    }
    __syncthreads();
}

__device__ __forceinline__ void p0_transpose_item(const float* W, int K, int N, bf16_t* WT, int drow0, int k0, int n0, LAS float* scr, int lane, const float* gain = nullptr, int ldw = 0, int koff = 0) {
    if (ldw == 0) ldw = K;
#pragma unroll 8
    for (int i = 0; i < 32; ++i) { const int kk = 2 * i + (lane >> 5); float v = W[(size_t)(k0 + kk) * N + n0 + (lane & 31)]; if (gain) v *= gain[k0 + kk]; scr[kk * 33 + (lane & 31)] = v; }
    LDS_WAIT(); asm volatile("" ::: "memory");
    const int c = lane & 7;
#pragma unroll
    for (int j = 0; j < 4; ++j) { const int n = (lane >> 3) + 8 * j; const LAS float* s = scr + (8 * c) * 33 + n;
        v4u o; o.x = pk2(s[0 * 33], s[1 * 33]); o.y = pk2(s[2 * 33], s[3 * 33]); o.z = pk2(s[4 * 33], s[5 * 33]); o.w = pk2(s[6 * 33], s[7 * 33]);
        *(v4u*)(WT + (size_t)(drow0 + n) * ldw + koff + k0 + 8 * c) = o; }
    LDS_WAIT(); asm volatile("" ::: "memory");
}
__device__ __forceinline__ void p0_plain(const float* W, int K, int N, bf16_t* WT, int item, LAS float* scr, int lane, const float* gain = nullptr, int ldw = 0, int koff = 0) {
    const int nblk = N / 32, kb = item / nblk, nb = item % nblk;
    p0_transpose_item(W, K, N, WT, 32 * nb, 64 * kb, 32 * nb, scr, lane, gain, ldw, koff);
}
__device__ __forceinline__ void p0_transpose_rope(const float* W, bf16_t* WT, int tilebase, int o, int k0, int n0, LAS float* scr, int lane) {
    const int K = 1024, N = NIN;
#pragma unroll 8
    for (int i = 0; i < 32; ++i) { const int kk = 2 * i + (lane >> 5); scr[kk * 33 + (lane & 31)] = W[(size_t)(k0 + kk) * N + n0 + (lane & 31)]; }
    LDS_WAIT(); asm volatile("" ::: "memory");
    const int c = lane & 7;
#pragma unroll
    for (int j = 0; j < 4; ++j) { const int n = (lane >> 3) + 8 * j; const LAS float* s = scr + (8 * c) * 33 + n;
        const int oo = o + n, v = ((oo >> 6) << 6) | (((oo >> 4) & 1) << 5) | (((oo >> 2) & 3) << 3) | (((oo >> 5) & 1) << 2) | (oo & 3);
        v4u w; w.x = pk2(s[0 * 33], s[1 * 33]); w.y = pk2(s[2 * 33], s[3 * 33]); w.z = pk2(s[4 * 33], s[5 * 33]); w.w = pk2(s[6 * 33], s[7 * 33]);
        *(v4u*)(WT + (size_t)(tilebase + v) * K + k0 + 8 * c) = w; }
    LDS_WAIT(); asm volatile("" ::: "memory");
}
__device__ __forceinline__ void rms_row_to_bf16(const float* xrow, const float* g, bf16_t* orow, int lane) {
    const f32x4* xr = (const f32x4*)xrow + lane; const f32x4* gr = (const f32x4*)g + lane;
    f32x4 v[4]; float s = 0.f;
#pragma unroll
    for (int j = 0; j < 4; ++j) { v[j] = xr[64 * j]; s += (v[j].x * v[j].x + v[j].y * v[j].y) + (v[j].z * v[j].z + v[j].w * v[j].w); }
    const float rinv = 1.0f / sqrtf(wave_sum(s) * (1.f / 1024.f) + NORM_EPS);
    v2u* o8 = (v2u*)orow + lane;
#pragma unroll
    for (int j = 0; j < 4; ++j) { const f32x4 gg = gr[64 * j]; v2u w; w.x = pk2(v[j].x * rinv * gg.x, v[j].y * rinv * gg.y); w.y = pk2(v[j].z * rinv * gg.z, v[j].w * rinv * gg.w); o8[64 * j] = w; }
}

__device__ __forceinline__ void rms_row_to_fp8(const float* xrow, const float* g, unsigned char* orow, int lane) {
    const f32x4* xr = (const f32x4*)xrow + lane; const f32x4* gr = (const f32x4*)g + lane;
    f32x4 v[4]; float s = 0.f;
#pragma unroll
    for (int j = 0; j < 4; ++j) { v[j] = xr[64 * j]; s += (v[j].x * v[j].x + v[j].y * v[j].y) + (v[j].z * v[j].z + v[j].w * v[j].w); }
    const float rinv = 1.0f / sqrtf(wave_sum(s) * (1.f / 1024.f) + NORM_EPS);
    unsigned* o4 = (unsigned*)orow + lane;
#pragma unroll
    for (int j = 0; j < 4; ++j) { const f32x4 gg = gr[64 * j]; o4[64 * j] = pk4_fp8(v[j].x * rinv * gg.x, v[j].y * rinv * gg.y, v[j].z * rinv * gg.z, v[j].w * rinv * gg.w); }
}
template <int NB, class RowPtr, class Epi>
__device__ __forceinline__ void ngemm_tile(const RowPtr& rp, const bf16_t* Bt, int ldb, int b1off, int K, int m0, int n0, int mvalid, const Epi& epi, LAS float* sm) {
    const int t = threadIdx.x, r = t >> 2, kq = (t & 3) * 4, ty = t >> 5, tx = t & 31;
    LAS float* As = sm; LAS float* Bs0 = sm + 16 * 132; LAS float* Bs1 = sm + 32 * 132;
    float acc[NB][8][4];
#pragma unroll
    for (int b = 0; b < NB; ++b)
#pragma unroll
        for (int i = 0; i < 8; ++i)
#pragma unroll
            for (int j = 0; j < 4; ++j) acc[b][i][j] = 0.f;
    const bf16_t* arow = rp(m0 + r) + kq;
    const bf16_t* brow0 = Bt + (size_t)(n0 + r) * ldb + kq;
    const bf16_t* brow1 = Bt + (size_t)(n0 + b1off + r) * ldb + kq;
    for (int k0 = 0; k0 < K; k0 += 16) {
        const v2u av = *(const v2u*)(arow + k0);
        const v2u bv0 = *(const v2u*)(brow0 + k0);
        v2u bv1 = bv0; if (NB == 2) bv1 = *(const v2u*)(brow1 + k0);
        As[(kq + 0) * 132 + r] = lo16(av.x); As[(kq + 1) * 132 + r] = hi16(av.x); As[(kq + 2) * 132 + r] = lo16(av.y); As[(kq + 3) * 132 + r] = hi16(av.y);
        Bs0[(kq + 0) * 132 + r] = lo16(bv0.x); Bs0[(kq + 1) * 132 + r] = hi16(bv0.x); Bs0[(kq + 2) * 132 + r] = lo16(bv0.y); Bs0[(kq + 3) * 132 + r] = hi16(bv0.y);
        if (NB == 2) { Bs1[(kq + 0) * 132 + r] = lo16(bv1.x); Bs1[(kq + 1) * 132 + r] = hi16(bv1.x); Bs1[(kq + 2) * 132 + r] = lo16(bv1.y); Bs1[(kq + 3) * 132 + r] = hi16(bv1.y); }
        __syncthreads();
#pragma unroll 2
        for (int kk = 0; kk < 16; ++kk) {
            const f32x4 a0 = *(const LAS f32x4*)(As + kk * 132 + ty * 8), a1 = *(const LAS f32x4*)(As + kk * 132 + ty * 8 + 4);
            const f32x4 b0 = *(const LAS f32x4*)(Bs0 + kk * 132 + tx * 4);
            const float a[8] = {a0.x, a0.y, a0.z, a0.w, a1.x, a1.y, a1.z, a1.w};
#pragma unroll
            for (int i = 0; i < 8; ++i) { acc[0][i][0] += a[i] * b0.x; acc[0][i][1] += a[i] * b0.y; acc[0][i][2] += a[i] * b0.z; acc[0][i][3] += a[i] * b0.w; }
            if (NB == 2) { const f32x4 b1 = *(const LAS f32x4*)(Bs1 + kk * 132 + tx * 4);
#pragma unroll
                for (int i = 0; i < 8; ++i) { acc[NB - 1][i][0] += a[i] * b1.x; acc[NB - 1][i][1] += a[i] * b1.y; acc[NB - 1][i][2] += a[i] * b1.z; acc[NB - 1][i][3] += a[i] * b1.w; } }
        }
        __syncthreads();
    }
#pragma unroll
    for (int i = 0; i < 8; ++i) { const int m = m0 + ty * 8 + i;
        if (m < mvalid) {
#pragma unroll
            for (int j = 0; j < 4; ++j) epi(m, n0 + tx * 4 + j, acc[0][i][j], acc[NB - 1][i][j]); } }
}
struct RowPlain { const bf16_t* A; int lda; __device__ __forceinline__ const bf16_t* operator()(int m) const { return A + (size_t)m * lda; } };

template <class Epi>
__device__ __forceinline__ void ngemm_dense(const bf16_t* A, int lda, const bf16_t* Bt, int ldb, int Mr, int N, int K, const Epi& epi, LAS float* sm) {
    const int nn = N / 128, nunits = (Mr / 128) * nn; RowPlain rp{A, lda};
    for (int u = blockIdx.x; u < nunits; u += gridDim.x) ngemm_tile<1>(rp, Bt, ldb, 0, K, (u / nn) * 128, (u % nn) * 128, Mr, epi, sm);
}

struct EpiStoreBf16 { bf16_t* O; int ldc; __device__ __forceinline__ void operator()(int m, int n, float a, float) const { O[(size_t)m * ldc + n] = (bf16_t)f2bf(a); } };
struct EpiGate1 { const bf16_t* PR; float* T; __device__ __forceinline__ void operator()(int m, int n, float a, float) const { T[(size_t)m * D + n] = bf2f(PR[(size_t)m * NIN + C_GSB + n]) * a; } };
struct EpiGate2 { const bf16_t* PR; const float* T; bf16_t* MIX; __device__ __forceinline__ void operator()(int m, int n, float a, float) const {
    MIX[(size_t)m * D + n] = (bf16_t)f2bf(T[(size_t)m * D + n] + bf2f(PR[(size_t)m * NIN + C_GDF + n]) * a); } };
struct EpiResid { const float* base; float* out; __device__ __forceinline__ void operator()(int m, int n, float a, float) const { out[(size_t)m * D + n] = base[(size_t)m * D + n] + a; } };


namespace pg8 {
constexpr int BM = 256, BK = 64, HALF = 128, HTB = HALF * BK * 2, STAGE_BYTES = 8 * HTB;
__host__ __device__ __forceinline__ int lds_byte(int r, int c) { const int st = (r >> 4) * 2 + (c >> 5), rr = r & 15, cc = c & 31, ob = rr * 64 + cc * 2; return st * 1024 + (ob ^ (((ob >> 9) & 1) << 5)); }
__host__ __device__ __forceinline__ void stage_rc(int b, int& R, int& C) { const int st = b / 1024, sb = b % 1024, swz = sb ^ (((sb >> 9) & 1) << 5); R = (st >> 1) * 16 + swz / 64; C = (st & 1) * 32 + (swz % 64) / 2; }
__host__ __device__ __forceinline__ int perm32(int rho) { const int n = rho >> 4, i = rho & 15; return 8 * (i >> 2) + 4 * n + (i & 3); }
struct Unit { int pm, pn, e; };
struct Gemm { const bf16_t* A; const bf16_t* Bt; int lda, ldb, K; };
typedef float f32x2 __attribute__((ext_vector_type(2))); typedef __bf16 bf16x2_t __attribute__((ext_vector_type(2)));
__device__ __forceinline__ unsigned cvt_pk_bf16(float lo, float hi) { f32x2 v = {lo, hi}; bf16x2_t b = __builtin_convertvector(v, bf16x2_t); return __builtin_bit_cast(unsigned, b); }

typedef int v8i __attribute__((ext_vector_type(8))); typedef int v4i __attribute__((ext_vector_type(4)));
__device__ __forceinline__ v8i cat8(bf16x8 a, bf16x8 b) { return __builtin_shufflevector(__builtin_bit_cast(v4i, a), __builtin_bit_cast(v4i, b), 0, 1, 2, 3, 4, 5, 6, 7); }
template <class Epi, class Sched, bool GATHER, bool FP8 = false>
__device__ __forceinline__ void gemm_phase(LAS unsigned char* lds, const Gemm g, const Sched& S, const Epi& E) {
    const int tid = threadIdx.x, wid = __builtin_amdgcn_readfirstlane(tid >> 6), lane = tid & 63, wr = wid >> 2, wc = wid & 3, fr = lane & 15, fq = lane >> 4;
    const int K = g.K, nt = K / BK;
    unsigned voffB[2], cva[2][2], nva[2][2];
#pragma unroll
    for (int i = 0; i < 2; ++i) { int R, C; stage_rc(tid * 16 + i * 8192, R, C); const int Rb = (R & ~31) + perm32(R & 31);
        voffB[i] = (unsigned)(Rb * g.ldb + C) * 2u;
#pragma unroll
        for (int h = 0; h < 2; ++h) { cva[h][i] = (unsigned)((h * HALF + R) * g.lda + C) * 2u; nva[h][i] = cva[h][i]; } }
    const unsigned kstep = (unsigned)(BK * 2);
    const unsigned hstepB = (unsigned)(HALF * g.ldb * 2);
    auto uni_ptr = [](const void* p_) { const unsigned long long v_ = (unsigned long long)p_; return (void*)(((unsigned long long)(unsigned)__builtin_amdgcn_readfirstlane((int)(v_ >> 32)) << 32) | (unsigned)__builtin_amdgcn_readfirstlane((int)v_)); };
    const auto rA = __builtin_amdgcn_make_buffer_rsrc(uni_ptr(g.A), 0, 0x7fffffff, 0x00020000), rB = __builtin_amdgcn_make_buffer_rsrc(uni_ptr(g.Bt), 0, 0x7fffffff, 0x00020000);
    const unsigned ldsw = (unsigned)wid * 1024u;
    const int aoff = lds_byte(wr * 64 + fr, fq * 8), boff = lds_byte(wc * 32 + fr, fq * 8);
#define PG8_SA(b, h) (((b) * 2 + (h)) * HTB)
#define PG8_SB(b, h) ((4 + (b) * 2 + (h)) * HTB)
#define PG8_STAGE(bufoff, rs, soff, voff) do { _Pragma("unroll") for (int _i = 0; _i < 2; ++_i) \
        __builtin_amdgcn_raw_ptr_buffer_load_lds(rs, (LAS unsigned*)(lds + (bufoff) + ldsw + _i * 8192), 16, (int)(voff)[_i], (int)(soff), 0, 0); } while (0)
#define PG8_LDA(dst, b, h) do { _Pragma("unroll") for (int m = 0; m < 4; ++m) _Pragma("unroll") for (int k = 0; k < 2; ++k) dst[m][k] = *(const LAS bf16x8*)(lds + PG8_SA(b, h) + aoff + m * 2048 + k * 1024); } while (0)
#define PG8_LDB(dst, b, h) do { _Pragma("unroll") for (int n = 0; n < 2; ++n) _Pragma("unroll") for (int k = 0; k < 2; ++k) dst[n][k] = *(const LAS bf16x8*)(lds + PG8_SB(b, h) + boff + n * 2048 + k * 1024); } while (0)
#define PG8_MMA(ai, bj, At, Bt) do { __builtin_amdgcn_s_setprio(1); _Pragma("unroll") for (int m = 0; m < 4; ++m) _Pragma("unroll") for (int n = 0; n < 2; ++n) { \
        if constexpr (FP8) { const v8i b8_ = cat8(Bt[n][0], Bt[n][1]), a8_ = cat8(At[m][0], At[m][1]); \
            asm volatile("s_nop 1\n\tv_mfma_scale_f32_16x16x128_f8f6f4 %0, %1, %2, %0, %3, %3 op_sel_hi:[0,0,0]" : "+v"(acc[ai][bj][m][n]) : "v"(b8_), "v"(a8_), "v"(one_scale)); } \
        else { _Pragma("unroll") for (int k = 0; k < 2; ++k) acc[ai][bj][m][n] = __builtin_amdgcn_mfma_f32_16x16x32_bf16(Bt[n][k], At[m][k], acc[ai][bj][m][n], 0, 0, 0); } } __builtin_amdgcn_s_setprio(0); } while (0)
#define PG8_WAIT_V(n) asm volatile("s_waitcnt vmcnt(" #n ")" ::: "memory")
#define PG8_WAIT_L(n) asm volatile("s_waitcnt lgkmcnt(" #n ")" ::: "memory")
#define PG8_BAR __builtin_amdgcn_s_barrier()
#define PG8_SCHED __builtin_amdgcn_sched_barrier(0)
    Unit cur, nxt; int ui = 0;
    if (!S.next(0, cur)) return;
    if constexpr (GATHER) {
#pragma unroll
        for (int i = 0; i < 2; ++i) { int R, C; stage_rc(tid * 16 + i * 8192, R, C);
#pragma unroll
            for (int h = 0; h < 2; ++h) cva[h][i] = (unsigned)(S.tok(cur, h * HALF + R) * g.lda + C) * 2u; }
    }
    const int one_scale = 0x7f7f7f7f;
    (void)one_scale;
    f32x4 acc[2][2][4][2];
#pragma unroll
    for (int a = 0; a < 2; ++a)
#pragma unroll
        for (int b = 0; b < 2; ++b)
#pragma unroll
            for (int m = 0; m < 4; ++m)
#pragma unroll
                for (int n = 0; n < 2; ++n) acc[a][b][m][n] = (f32x4){0.f, 0.f, 0.f, 0.f};
    bf16x8 At[4][2], B0[2][2], B1[2][2];
    unsigned cA = GATHER ? 0u : (unsigned)S.a_off(cur), cB = (unsigned)S.b_off(cur);
    PG8_STAGE(PG8_SB(0, 0), rB, cB, voffB); PG8_STAGE(PG8_SB(0, 1), rB, cB + hstepB, voffB); PG8_STAGE(PG8_SA(0, 0), rA, cA, cva[0]); PG8_STAGE(PG8_SA(0, 1), rA, cA, cva[1]);
    if (wr == 1) PG8_BAR;
    PG8_WAIT_V(2); PG8_BAR;
    PG8_STAGE(PG8_SB(1, 0), rB, cB + kstep, voffB); PG8_STAGE(PG8_SA(1, 0), rA, cA + kstep, cva[0]); PG8_STAGE(PG8_SB(1, 1), rB, cB + hstepB + kstep, voffB);
    PG8_WAIT_V(6); PG8_BAR;
    for (;;) {
        const bool has_next = S.next(ui + 1, nxt);
        const unsigned nA = (has_next && !GATHER) ? (unsigned)S.a_off(nxt) : cA, nB = has_next ? (unsigned)S.b_off(nxt) : cB;
        if constexpr (GATHER) {
#pragma unroll
            for (int i = 0; i < 2; ++i) { int R, C; stage_rc(tid * 16 + i * 8192, R, C);
#pragma unroll
                for (int h = 0; h < 2; ++h) nva[h][i] = has_next ? (unsigned)(S.tok(nxt, h * HALF + R) * g.lda + C) * 2u : cva[h][i]; }
        }
#pragma nounroll
        for (int t = 0; t < nt; t += 2) {
            const bool last = (t == nt - 2);
            const unsigned a1 = cA + (unsigned)(t + 1) * kstep;
            const unsigned a2 = last ? nA : cA + (unsigned)(t + 2) * kstep, b2 = last ? nB : cB + (unsigned)(t + 2) * kstep;
            const unsigned a3 = a2 + kstep, b3 = b2 + kstep;
            PG8_LDB(B0, 0, 0); PG8_LDB(B1, 0, 1); PG8_SCHED; PG8_LDA(At, 0, 0); PG8_STAGE(PG8_SA(1, 1), rA, a1, cva[1]);
            if constexpr (GATHER) { if (last) {
#pragma unroll
                for (int h = 0; h < 2; ++h)
#pragma unroll
                    for (int i = 0; i < 2; ++i) cva[h][i] = nva[h][i]; } }
            PG8_WAIT_V(8); PG8_WAIT_L(0); PG8_BAR; PG8_MMA(0, 0, At, B0); PG8_MMA(0, 1, At, B1); PG8_BAR; PG8_SCHED;
            PG8_LDA(At, 0, 1); PG8_STAGE(PG8_SB(0, 0), rB, b2, voffB); PG8_STAGE(PG8_SB(0, 1), rB, b2 + hstepB, voffB); PG8_STAGE(PG8_SA(0, 0), rA, a2, cva[0]);
            PG8_WAIT_V(8); PG8_WAIT_L(0); PG8_BAR; PG8_MMA(1, 0, At, B0); PG8_MMA(1, 1, At, B1); PG8_BAR; PG8_SCHED;
            PG8_LDB(B0, 1, 0); PG8_LDB(B1, 1, 1); PG8_SCHED; PG8_LDA(At, 1, 0); PG8_STAGE(PG8_SA(0, 1), rA, a2, cva[1]);
            PG8_WAIT_V(8); PG8_WAIT_L(0); PG8_BAR; PG8_MMA(0, 0, At, B0); PG8_MMA(0, 1, At, B1); PG8_BAR; PG8_SCHED;
            PG8_LDA(At, 1, 1); PG8_STAGE(PG8_SB(1, 0), rB, b3, voffB); PG8_STAGE(PG8_SB(1, 1), rB, b3 + hstepB, voffB); PG8_STAGE(PG8_SA(1, 0), rA, a3, cva[0]);
            PG8_WAIT_V(8); PG8_WAIT_L(0); PG8_BAR; PG8_MMA(1, 0, At, B0); PG8_MMA(1, 1, At, B1); PG8_BAR; PG8_SCHED;
        }
        if (wr == 0) PG8_BAR;
        if constexpr (FP8) asm volatile("s_nop 15\n\ts_nop 7" ::: "memory");
        E(acc, cur, wr, wc, fr, fq);
        if (!has_next) break;
#pragma unroll
        for (int a = 0; a < 2; ++a)
#pragma unroll
            for (int b = 0; b < 2; ++b)
#pragma unroll
                for (int m = 0; m < 4; ++m)
#pragma unroll
                    for (int n = 0; n < 2; ++n) acc[a][b][m][n] = (f32x4){0.f, 0.f, 0.f, 0.f};
        cur = nxt; cA = nA; cB = nB; ++ui;
        if constexpr (GATHER) {
#pragma unroll
            for (int i = 0; i < 2; ++i)
#pragma unroll
                for (int h = 0; h < 2; ++h) cva[h][i] = nva[h][i];
        }
        if (wr == 1) PG8_BAR;
    }
    PG8_WAIT_V(0);
    PG8_BAR;
#undef PG8_SA
#undef PG8_SB
#undef PG8_STAGE
#undef PG8_LDA
#undef PG8_LDB
#undef PG8_MMA
#undef PG8_WAIT_V
#undef PG8_WAIT_L
#undef PG8_BAR
#undef PG8_SCHED
}

struct DenseOrder {
    int nM, nN, nwg, G, c, lda, ldb, i0 = 0, i1 = 1 << 30;
    __device__ __forceinline__ void init(int M_, int N_, int G_, int c_, int lda_, int ldb_) { nM = M_ / BM; nN = N_ / BM; nwg = nM * nN; G = G_; c = c_; lda = lda_; ldb = ldb_; }
    __device__ __forceinline__ bool next(int i, Unit& u) const {
        if (i + i0 >= i1) return false;
        const long L = (long)(i + i0) * G + c; if (L >= nwg) return false;
        int wgid = (int)L; { const int q = nwg / 8, r = nwg % 8, xcd = wgid % 8, off = wgid / 8; wgid = (xcd < r ? xcd * (q + 1) : r * (q + 1) + (xcd - r) * q) + off; }
        const int nig = 8 * nN, gid = wgid / nig, fm = gid * 8, gsz = (nM - fm) < 8 ? (nM - fm) : 8;
        u.pm = fm + ((wgid % nig) % gsz); u.pn = (wgid % nig) / gsz; u.e = 0; return true;
    }
    __device__ __forceinline__ size_t a_off(const Unit& u) const { return (size_t)u.pm * BM * lda * 2; }
    __device__ __forceinline__ size_t b_off(const Unit& u) const { return (size_t)u.pn * BM * ldb * 2; }
    __device__ __forceinline__ int tok(const Unit&, int) const { return 0; }
};
struct TwoRoundOrder {
    int G, c, lda, ldb;
    __device__ __forceinline__ bool next(int i, Unit& u) const { const int L = i * G + c; if (L >= 512) return false; const int tile = L & 255; u.pm = tile >> 2; u.pn = tile & 3; u.e = L >> 8; return true; }
    __device__ __forceinline__ size_t a_off(const Unit& u) const { return (size_t)u.pm * BM * lda * 2 + (size_t)u.e * 1024; }
    __device__ __forceinline__ size_t b_off(const Unit& u) const { return (size_t)(u.e * 1024 + u.pn * BM) * ldb * 2; }
    __device__ __forceinline__ int tok(const Unit&, int) const { return 0; }
};
struct MoeOrder {
    const LAS int* tb; const int* tlist; int G, c, npn, lda, ldb, nexp;
    __device__ __forceinline__ bool next(int i, Unit& u) const {
        const int L = i * G + c; if (L >= tb[96]) return false;
        int e = 0; while (tb[65 + e] <= L) ++e;
        const int loc = L - tb[64 + e]; u.e = __builtin_amdgcn_readfirstlane(e); u.pn = __builtin_amdgcn_readfirstlane(loc % npn); u.pm = __builtin_amdgcn_readfirstlane((tb[e] >> 8) + loc / npn); return true;
    }
    __device__ __forceinline__ size_t a_off(const Unit& u) const { return (size_t)u.pm * BM * lda * 2; }
    __device__ __forceinline__ size_t b_off(const Unit& u) const { return (size_t)(u.e * nexp + u.pn * BM) * ldb * 2; }
    __device__ __forceinline__ int tok(const Unit& u, int row) const { const int r = u.pm * BM - tb[u.e] + row; return r < tb[32 + u.e] ? tlist[u.e * LISTCAP + r] : 0; }
};

#define EPI_ARGS const f32x4 (&acc)[2][2][4][2], const Unit& u, int wr, int wc, int fr, int fq
#define EPI_FOR_ROWS for (int ai = 0; ai < 2; ++ai) _Pragma("unroll") for (int m = 0; m < 4; ++m)
__device__ __forceinline__ v4u pack8(const f32x4 a, const f32x4 b) { v4u w; w.x = cvt_pk_bf16(a[0], a[1]); w.y = cvt_pk_bf16(a[2], a[3]); w.z = cvt_pk_bf16(b[0], b[1]); w.w = cvt_pk_bf16(b[2], b[3]); return w; }
__device__ __forceinline__ void unpack8(const v4u w, f32x4& a, f32x4& b) { a = (f32x4){lo16(w.x), hi16(w.x), lo16(w.y), hi16(w.y)}; b = (f32x4){lo16(w.z), hi16(w.z), lo16(w.w), hi16(w.w)}; }
__device__ __forceinline__ float sigm(float v) { return __builtin_amdgcn_rcpf(1.f + __expf(-v)); }

__device__ __forceinline__ void store_tile_T(const f32x4 (&acc)[2][2][4][2], bf16_t* VT, int vrow0, int s0, int pitch) {
#pragma unroll
    for (int bj = 0; bj < 2; ++bj)
#pragma unroll
        for (int n = 0; n < 2; ++n)
#pragma unroll
            for (int e = 0; e < 4; ++e) { bf16_t* vp = VT + (size_t)(vrow0 + 128 * bj + 4 * n + e) * pitch + ((s0 & ~12) | ((s0 & 8) >> 1) | ((s0 & 4) << 1));
#pragma unroll
                for (int ai = 0; ai < 2; ++ai)
#pragma unroll
                    for (int m = 0; m < 4; ++m) vp[128 * ai + 16 * m] = (bf16_t)(cvt_pk_bf16(acc[ai][bj][m][n][e], 0.f) & 0xffffu); }
}
struct EpiKV { static constexpr bool MIDHOOK = false; bf16_t* KVM; bf16_t* VTM;
    __device__ __forceinline__ void operator()(EPI_ARGS) const {
        const int row0 = u.pm * BM + wr * 64 + fr, col0 = u.pn * BM + wc * 32 + 8 * fq;
#pragma unroll
        EPI_FOR_ROWS { bf16_t* rowp = KVM + (size_t)(row0 + ai * HALF + m * 16) * 2048 + col0;
#pragma unroll
            for (int bj = 0; bj < 2; ++bj) *(v4u*)(rowp + bj * HALF) = pack8(acc[ai][bj][m][0], acc[ai][bj][m][1]); }
        if (u.pn >= 4) store_tile_T(acc, VTM, u.pm * 1024 + (u.pn - 4) * BM + wc * 32 + 8 * fq, wr * 64 + fr, MEMLEN);
    } };
struct EpiBf16Store { static constexpr bool MIDHOOK = false; bf16_t* O; int ldc;
    __device__ __forceinline__ void operator()(EPI_ARGS) const {
        const int row0 = u.pm * BM + wr * 64 + fr, col0 = u.pn * BM + wc * 32 + 8 * fq;
#pragma unroll
        EPI_FOR_ROWS { bf16_t* rowp = O + (size_t)(row0 + ai * HALF + m * 16) * ldc + col0;
#pragma unroll
            for (int bj = 0; bj < 2; ++bj) *(v4u*)(rowp + bj * HALF) = pack8(acc[ai][bj][m][0], acc[ai][bj][m][1]); }
    } };
struct EpiResidF32 { static constexpr bool MIDHOOK = false; const float* base; float* out;
    __device__ __forceinline__ void operator()(EPI_ARGS) const {
        const int row0 = u.pm * BM + wr * 64 + fr, col0 = u.pn * BM + wc * 32 + 8 * fq;
#pragma unroll
        EPI_FOR_ROWS { const size_t off = (size_t)(row0 + ai * HALF + m * 16) * D + col0;
#pragma unroll
            for (int bj = 0; bj < 2; ++bj)
#pragma unroll
                for (int n = 0; n < 2; ++n) { const f32x4 b = *(const f32x4*)(base + off + bj * HALF + 4 * n); *(f32x4*)(out + off + bj * HALF + 4 * n) = b + acc[ai][bj][m][n]; } }
    } };
struct EpiResidNorm { static constexpr bool MIDHOOK = false; const float* base; float* out; bf16_t* XB; float* SSQ;
    __device__ __forceinline__ void operator()(EPI_ARGS) const {
        const int row0 = u.pm * BM + wr * 64 + fr, col0 = u.pn * BM + wc * 32 + 8 * fq;
#pragma unroll
        EPI_FOR_ROWS { const int row = row0 + ai * HALF + m * 16; const size_t off = (size_t)row * D + col0; float ss = 0.f;
#pragma unroll
            for (int bj = 0; bj < 2; ++bj) { f32x4 v[2];
#pragma unroll
                for (int n = 0; n < 2; ++n) { v[n] = *(const f32x4*)(base + off + bj * HALF + 4 * n) + acc[ai][bj][m][n];
                    ss += (v[n][0] * v[n][0] + v[n][1] * v[n][1]) + (v[n][2] * v[n][2] + v[n][3] * v[n][3]); }
                *(v4u*)(XB + off + bj * HALF) = pack8(v[0], v[1]); }
            ss += __shfl_xor(ss, 16); ss += __shfl_xor(ss, 32);
            if (fq == 0) SSQ[(size_t)row * 16 + u.pn * 4 + wc] = ss; }
    } };
struct EpiBf16Rinv { static constexpr bool MIDHOOK = false; bf16_t* O; const float* SSQ; float qscale;
    __device__ __forceinline__ void operator()(EPI_ARGS) const {
        const int row0 = u.pm * BM + wr * 64 + fr, col0 = u.pn * BM + wc * 32 + 8 * fq;
#pragma unroll
        EPI_FOR_ROWS { const int row = row0 + ai * HALF + m * 16; const f32x4* sp = (const f32x4*)(SSQ + (size_t)row * 16);
            const f32x4 s0 = sp[0], s1 = sp[1], s2 = sp[2], s3 = sp[3];
            const float tot = (((s0[0] + s0[1]) + (s0[2] + s0[3])) + ((s1[0] + s1[1]) + (s1[2] + s1[3]))) + (((s2[0] + s2[1]) + (s2[2] + s2[3])) + ((s3[0] + s3[1]) + (s3[2] + s3[3])));
            const float rinv = qscale / sqrtf(tot * (1.f / 1024.f) + NORM_EPS);
            bf16_t* rowp = O + (size_t)row * D + col0;
#pragma unroll
            for (int bj = 0; bj < 2; ++bj) *(v4u*)(rowp + bj * HALF) = pack8(acc[ai][bj][m][0] * rinv, acc[ai][bj][m][1] * rinv); }
    } };
struct OneUnitOrder {
    int idx, lda, ldb;
    __device__ __forceinline__ bool next(int i, Unit& u) const { if (i > 0) return false; u.pm = idx >> 3; u.pn = idx & 7; u.e = 0; return true; }
    __device__ __forceinline__ size_t a_off(const Unit& u) const { return (size_t)u.pm * BM * lda * 2; }
    __device__ __forceinline__ size_t b_off(const Unit& u) const { return (size_t)u.pn * BM * ldb * 2; }
    __device__ __forceinline__ int tok(const Unit&, int) const { return 0; }
};
struct EpiGateK { static constexpr bool MIDHOOK = true; const bf16_t* PR; bf16_t* MIX;
    __device__ __forceinline__ void mid(f32x4 (&acc)[2][2][4][2], const Unit& u, int wr, int wc, int fr, int fq) const {
        const int row0 = u.pm * BM + wr * 64 + fr, col0 = u.pn * BM + wc * 32 + 8 * fq;
#pragma unroll
        EPI_FOR_ROWS { const bf16_t* gp = PR + (size_t)(row0 + ai * HALF + m * 16) * NIN + col0;
#pragma unroll
            for (int bj = 0; bj < 2; ++bj) { f32x4 a0, a1, d0, d1; unpack8(*(const v4u*)(gp + C_GSB + bj * HALF), a0, a1); unpack8(*(const v4u*)(gp + C_GDF + bj * HALF), d0, d1);
#pragma unroll
                for (int c = 0; c < 4; ++c) { acc[ai][bj][m][0][c] *= a0[c] * __builtin_amdgcn_rcpf(fmaxf(d0[c], 1e-30f)); acc[ai][bj][m][1][c] *= a1[c] * __builtin_amdgcn_rcpf(fmaxf(d1[c], 1e-30f)); }
                asm volatile("" : "+v"(acc[ai][bj][m][0]), "+v"(acc[ai][bj][m][1]) :: "memory"); } }
    }
    __device__ __forceinline__ void operator()(EPI_ARGS) const {
        const int row0 = u.pm * BM + wr * 64 + fr, col0 = u.pn * BM + wc * 32 + 8 * fq;
#pragma unroll
        EPI_FOR_ROWS { const int row = row0 + ai * HALF + m * 16;
#pragma unroll
            for (int bj = 0; bj < 2; ++bj) { f32x4 d0, d1; unpack8(*(const v4u*)(PR + (size_t)row * NIN + C_GDF + col0 + bj * HALF), d0, d1);
#pragma unroll
                for (int c = 0; c < 4; ++c) { d0[c] = fmaxf(d0[c], 1e-30f); d1[c] = fmaxf(d1[c], 1e-30f); }
                *(v4u*)(MIX + (size_t)row * D + col0 + bj * HALF) = pack8(acc[ai][bj][m][0] * d0, acc[ai][bj][m][1] * d1); } }
    } };
struct EpiResidB { static constexpr bool MIDHOOK = false; const bf16_t* base; float* out;
    __device__ __forceinline__ void operator()(EPI_ARGS) const {
        const int row0 = u.pm * BM + wr * 64 + fr, col0 = u.pn * BM + wc * 32 + 8 * fq;
#pragma unroll
        EPI_FOR_ROWS { const size_t off = (size_t)(row0 + ai * HALF + m * 16) * D + col0;
#pragma unroll
            for (int bj = 0; bj < 2; ++bj) { f32x4 b0, b1; unpack8(*(const v4u*)(base + off + bj * HALF), b0, b1);
                *(f32x4*)(out + off + bj * HALF) = b0 + acc[ai][bj][m][0]; *(f32x4*)(out + off + bj * HALF + 4) = b1 + acc[ai][bj][m][1]; } }
    } };
struct EpiGate { static constexpr bool MIDHOOK = false; const bf16_t* PR; bf16_t* T; bf16_t* MIX;
    __device__ __forceinline__ void operator()(EPI_ARGS) const {
        const int row0 = u.pm * BM + wr * 64 + fr, col0 = u.pn * BM + wc * 32 + 8 * fq;
#pragma unroll
        EPI_FOR_ROWS { const int row = row0 + ai * HALF + m * 16;
#pragma unroll
            for (int bj = 0; bj < 2; ++bj) { const int col = col0 + bj * HALF; f32x4 g0, g1;
                unpack8(*(const v4u*)(PR + (size_t)row * NIN + (u.e ? C_GDF : C_GSB) + col), g0, g1);
                bf16_t* tp = T + (size_t)row * D + col;
                if (u.e == 0) *(v4u*)tp = pack8(g0 * acc[ai][bj][m][0], g1 * acc[ai][bj][m][1]);
                else { f32x4 t0, t1; unpack8(*(const v4u*)tp, t0, t1); *(v4u*)(MIX + (size_t)row * D + col) = pack8(t0 + g0 * acc[ai][bj][m][0], t1 + g1 * acc[ai][bj][m][1]); } } }
    } };
struct EpiInProj { static constexpr bool MIDHOOK = false; bf16_t* PR; const float* rc; const float* rs; bf16_t* VTSB; bf16_t* VTDF;
    __device__ __forceinline__ void operator()(EPI_ARGS) const {
        const int row0 = u.pm * BM + wr * 64 + fr, pn = u.pn;
        if (pn >= 6 && pn < 10) {
            const float sc = pn < 8 ? 0.125f * 1.4426950408889634f : 1.0f; const int i0 = 16 * (wc & 1) + 4 * fq;
#pragma unroll
            EPI_FOR_ROWS { const int row = row0 + ai * HALF + m * 16; const f32x4 cs = *(const f32x4*)(rc + (size_t)row * 32 + i0), sn = *(const f32x4*)(rs + (size_t)row * 32 + i0);
#pragma unroll
                for (int bj = 0; bj < 2; ++bj) { const f32x4 lo = acc[ai][bj][m][0], hi = acc[ai][bj][m][1];
                    const f32x4 olo = (lo * cs - hi * sn) * sc, ohi = (hi * cs + lo * sn) * sc;
                    bf16_t* p = PR + (size_t)row * NIN + pn * BM + 64 * (2 * bj + (wc >> 1)) + i0;
                    v2u a, b; a.x = cvt_pk_bf16(olo[0], olo[1]); a.y = cvt_pk_bf16(olo[2], olo[3]); b.x = cvt_pk_bf16(ohi[0], ohi[1]); b.y = cvt_pk_bf16(ohi[2], ohi[3]);
                    *(v2u*)p = a; *(v2u*)(p + 32) = b; } }
        } else {
            const int col0 = pn * BM + wc * 32 + 8 * fq; const float sc = pn < 2 ? 0.125f * 1.4426950408889634f : 1.0f; const bool sg = pn >= 12;
            const bool vt = (pn == 4 || pn == 5 || pn == 10 || pn == 11);
            if (!vt) {
#pragma unroll
            EPI_FOR_ROWS { bf16_t* rowp = PR + (size_t)(row0 + ai * HALF + m * 16) * NIN + col0;
#pragma unroll
                for (int bj = 0; bj < 2; ++bj) { f32x4 v0 = acc[ai][bj][m][0] * sc, v1 = acc[ai][bj][m][1] * sc;
                    if (sg) { v0 = (f32x4){sigm(v0[0]), sigm(v0[1]), sigm(v0[2]), sigm(v0[3])}; v1 = (f32x4){sigm(v1[0]), sigm(v1[1]), sigm(v1[2]), sigm(v1[3])}; }
                    *(v4u*)(rowp + bj * HALF) = pack8(v0, v1); } }
            } else {
                const int bb = u.pm >> 4, s0 = (u.pm & 15) * BM + wr * 64 + fr, hd0 = (pn < 6 ? (pn - 4) : (pn - 10)) * BM + wc * 32 + 8 * fq;
                store_tile_T(acc, pn < 6 ? VTSB : VTDF, bb * 512 + hd0, s0, SEQ);
            }
        }
    } };
struct EpiMoeGU { static constexpr bool MIDHOOK = false; unsigned char* ACT8; const float* bgu; const float* wsc;
    __device__ __forceinline__ void operator()(EPI_ARGS) const {
        const int row0 = u.pm * BM + wr * 64 + fr, j0 = u.pn * 128 + wc * 32 + 8 * fq; const float* bg = bgu + (size_t)u.e * 2048 + j0; const float* sg = wsc + (size_t)u.e * 2048 + j0;
#pragma unroll
        EPI_FOR_ROWS { f32x4 o[2];
#pragma unroll
            for (int n = 0; n < 2; ++n) { const f32x4 gv = acc[ai][0][m][n] * *(const f32x4*)(sg + 4 * n) + *(const f32x4*)(bg + 4 * n), lv = acc[ai][1][m][n] * *(const f32x4*)(sg + 1024 + 4 * n) + *(const f32x4*)(bg + 1024 + 4 * n);
#pragma unroll
                for (int c = 0; c < 4; ++c) { const float gl = fminf(gv[c], 7.0f), li = fminf(fmaxf(lv[c], -7.0f), 7.0f); o[n][c] = gl * sigm(1.702f * gl) * (li + 1.0f); } }
            v2u w; w.x = pk4_fp8(o[0][0], o[0][1], o[0][2], o[0][3]); w.y = pk4_fp8(o[1][0], o[1][1], o[1][2], o[1][3]);
            *(v2u*)(ACT8 + (size_t)(row0 + ai * HALF + m * 16) * DFF + j0) = w; }
    } };
struct EpiMoeDown { static constexpr bool MIDHOOK = false; bf16_t* YB; const float* bd; const float* glist; const LAS int* tb; const float* wsc;
    __device__ __forceinline__ void operator()(EPI_ARGS) const {
        const int row0 = u.pm * BM + wr * 64 + fr, col0 = u.pn * BM + wc * 32 + 8 * fq; const float* bp = bd + (size_t)u.e * D + col0; const float* sp = wsc + (size_t)u.e * D + col0;
        const float* gl = glist + (size_t)u.e * LISTCAP - tb[u.e];
        f32x4 bv[2][2], sv[2][2];
#pragma unroll
        for (int bj = 0; bj < 2; ++bj)
#pragma unroll
            for (int n = 0; n < 2; ++n) { bv[bj][n] = *(const f32x4*)(bp + bj * HALF + 4 * n); sv[bj][n] = *(const f32x4*)(sp + bj * HALF + 4 * n); }
#pragma unroll
        EPI_FOR_ROWS { const int row = row0 + ai * HALF + m * 16; const float gt = gl[row];
#pragma unroll
            for (int bj = 0; bj < 2; ++bj) *(v4u*)(YB + (size_t)row * D + col0 + bj * HALF) = pack8((acc[ai][bj][m][0] * sv[bj][0] + bv[bj][0]) * gt, (acc[ai][bj][m][1] * sv[bj][1] + bv[bj][1]) * gt); }
    } };
}


typedef float f32x16 __attribute__((ext_vector_type(16)));
typedef short s16x4 __attribute__((ext_vector_type(4)));
__device__ __forceinline__ f32x16 mfma32(bf16x8 a, bf16x8 b, f32x16 c) { return __builtin_amdgcn_mfma_f32_32x32x16_bf16(a, b, c, 0, 0, 0); }
__device__ __forceinline__ float xhalf(float v, int hh) { auto rr = __builtin_amdgcn_permlane32_swap(__float_as_uint(v), __float_as_uint(v), false, false); return __uint_as_float(hh ? rr[0] : rr[1]); }
__device__ __forceinline__ bf16x8 vt_frag(const bf16_t* p) { const s16x4 lo = *(const s16x4*)p, hi = *(const s16x4*)(p + 8); return (bf16x8){lo[0], lo[1], lo[2], lo[3], hi[0], hi[1], hi[2], hi[3]}; }
__device__ __forceinline__ bf16x8 pack_p(const f32x16& p, int s) { v4u w; w.x = pg8::cvt_pk_bf16(p[8 * s + 0], p[8 * s + 1]); w.y = pg8::cvt_pk_bf16(p[8 * s + 2], p[8 * s + 3]); w.z = pg8::cvt_pk_bf16(p[8 * s + 4], p[8 * s + 5]); w.w = pg8::cvt_pk_bf16(p[8 * s + 6], p[8 * s + 7]); return __builtin_bit_cast(bf16x8, w); }
constexpr float LOG2E = 1.4426950408889634f;

template <int NO>
__device__ __forceinline__ void softmax_step(f32x16& S, float C, float& m, float& l, f32x16 (&O)[NO], int hh) {
    float mx = fmaxf(fmaxf(S[0], S[1]), fmaxf(S[2], S[3]));
#pragma unroll
    for (int i = 4; i < 16; i += 4) mx = fmaxf(mx, fmaxf(fmaxf(S[i], S[i + 1]), fmaxf(S[i + 2], S[i + 3])));
    mx = fmaxf(mx, xhalf(mx, hh)) * C;
    const float mn = fmaxf(m, mx), al = __builtin_amdgcn_exp2f(m - mn);
    m = mn; l *= al;
#pragma unroll
    for (int o = 0; o < NO; ++o) O[o] = O[o] * al;
    float ps = 0.f;
#pragma unroll
    for (int i = 0; i < 16; ++i) { S[i] = __builtin_amdgcn_exp2f(S[i] * C - mn); ps += S[i]; }
    l += ps;
}

__device__ __forceinline__ void attn_diff_wave(const bf16_t* PR, const bf16_t* VT, float* ODR, int b, int h, int j, int q0, int lane) {
    const int r32 = lane & 31, hh = lane >> 5;
    const bf16_t* qrow = PR + (size_t)(b * SEQ + q0 + r32) * NIN + C_DQ + h * 128 + j * 64 + 8 * hh;
    bf16x8 qf[4];
#pragma unroll
    for (int d0 = 0; d0 < 4; ++d0) qf[d0] = *(const bf16x8*)(qrow + 16 * d0);
    const bf16_t* kbase = PR + (size_t)(b * SEQ + r32) * NIN + C_DK + h * 128 + j * 64 + 8 * hh;
    const bf16_t* vbase = VT + (size_t)(b * 512 + h * 128 + r32) * SEQ + 4 * hh;
    f32x16 O[4];
#pragma unroll
    for (int o = 0; o < 4; ++o)
#pragma unroll
        for (int i = 0; i < 16; ++i) O[o][i] = 0.f;
    float m = -INFINITY, l = 0.f;
    const int nt = 2 * (q0 / 64 + 1);
    for (int t = 0; t < nt; ++t) {
        const bf16_t* kp = kbase + (size_t)(32 * t) * NIN;
        f32x16 S;
#pragma unroll
        for (int i = 0; i < 16; ++i) S[i] = 0.f;
#pragma unroll
        for (int d0 = 0; d0 < 4; ++d0) S = mfma32(*(const bf16x8*)(kp + 16 * d0), qf[d0], S);
        softmax_step<4>(S, LOG2E, m, l, O, hh);
        const bf16x8 p0 = pack_p(S, 0), p1 = pack_p(S, 1);
        const bf16_t* vp = vbase + 32 * t;
#pragma unroll
        for (int o = 0; o < 4; ++o) { O[o] = mfma32(vt_frag(vp + (size_t)(32 * o) * SEQ), p0, O[o]); O[o] = mfma32(vt_frag(vp + (size_t)(32 * o) * SEQ + 16), p1, O[o]); }
    }
    l += xhalf(l, hh);
    const float il = 1.f / l;
    float* orow = ODR + ((size_t)j * M + (size_t)b * SEQ + q0 + r32) * 512 + h * 128 + 4 * hh;
#pragma unroll
    for (int o = 0; o < 4; ++o)
#pragma unroll
        for (int g = 0; g < 4; ++g) *(f32x4*)(orow + 32 * o + 8 * g) = (f32x4){O[o][4 * g] * il, O[o][4 * g + 1] * il, O[o][4 * g + 2] * il, O[o][4 * g + 3] * il};
}

__device__ __forceinline__ void attn_sb_wave(const bf16_t* PR, const bf16_t* VT, bf16_t* OAT, int b, int h, int q0, int lane) {
    const int r32 = lane & 31, hh = lane >> 5;
    const bf16_t* qrow = PR + (size_t)(b * SEQ + q0 + r32) * NIN + C_SBQ + h * 64 + 8 * hh;
    bf16x8 qf[4];
#pragma unroll
    for (int d0 = 0; d0 < 4; ++d0) qf[d0] = *(const bf16x8*)(qrow + 16 * d0);
    const bf16_t* kbase = PR + (size_t)(b * SEQ + r32) * NIN + C_SBK + h * 64 + 8 * hh;
    const bf16_t* vbase = VT + (size_t)(b * 512 + h * 64 + r32) * SEQ + 4 * hh;
    f32x16 O[2];
#pragma unroll
    for (int o = 0; o < 2; ++o)
#pragma unroll
        for (int i = 0; i < 16; ++i) O[o][i] = 0.f;
    float R = 0.f;
    const int td = q0 >> 5;
    for (int t = td; t >= 0; --t) {
        const bf16_t* kp = kbase + (size_t)(32 * t) * NIN;
        f32x16 S;
#pragma unroll
        for (int i = 0; i < 16; ++i) S[i] = 0.f;
#pragma unroll
        for (int d0 = 0; d0 < 4; ++d0) S = mfma32(*(const bf16x8*)(kp + 16 * d0), qf[d0], S);
        f32x16 lr;
#pragma unroll
        for (int i = 0; i < 16; ++i) { const float z2 = S[i] * LOG2E; const float sp = fmaxf(z2, 0.f) + __builtin_amdgcn_logf(1.f + __builtin_amdgcn_exp2f(-fabsf(z2)));
            lr[i] = -sp; S[i] = z2 - sp; }
        if (t == td) {
#pragma unroll
            for (int i = 0; i < 16; ++i) { const int kvl = (i & 3) + 8 * (i >> 2) + 4 * hh; if (kvl >= r32) { lr[i] = 0.f; S[i] = -INFINITY; } }
        }
        float tot[4], pt[4], off[4];
        f32x16 ex;
#pragma unroll
        for (int g = 0; g < 4; ++g) { ex[4 * g + 3] = 0.f; ex[4 * g + 2] = lr[4 * g + 3]; ex[4 * g + 1] = lr[4 * g + 3] + lr[4 * g + 2]; ex[4 * g] = ex[4 * g + 1] + lr[4 * g + 1]; tot[g] = ex[4 * g] + lr[4 * g]; }
#pragma unroll
        for (int g = 0; g < 4; ++g) pt[g] = xhalf(tot[g], hh);
        const float own0 = hh ? 0.f : 1.f;
        float sp_ = 0.f;
#pragma unroll
        for (int g = 3; g >= 0; --g) { off[g] = sp_ + own0 * pt[g] + R; sp_ += tot[g] + pt[g]; }
#pragma unroll
        for (int i = 0; i < 16; ++i) S[i] = __builtin_amdgcn_exp2f(S[i] + ex[i] + off[i >> 2]);
        R += sp_;
        const bf16x8 p0 = pack_p(S, 0), p1 = pack_p(S, 1);
        const bf16_t* vp = vbase + 32 * t;
#pragma unroll
        for (int o = 0; o < 2; ++o) { O[o] = mfma32(vt_frag(vp + (size_t)(32 * o) * SEQ), p0, O[o]); O[o] = mfma32(vt_frag(vp + (size_t)(32 * o) * SEQ + 16), p1, O[o]); }
        if (__all(R < -160.f)) break;
    }
    bf16_t* orow = OAT + (size_t)(b * SEQ + q0 + r32) * D + h * 64 + 4 * hh;
#pragma unroll
    for (int o = 0; o < 2; ++o)
#pragma unroll
        for (int g = 0; g < 4; ++g) { v2u w; w.x = pg8::cvt_pk_bf16(O[o][4 * g], O[o][4 * g + 1]); w.y = pg8::cvt_pk_bf16(O[o][4 * g + 2], O[o][4 * g + 3]); *(v2u*)(orow + 32 * o + 8 * g) = w; }
}

__device__ __forceinline__ void attn_mem_wave(const bf16_t* QM, const bf16_t* KVM, const bf16_t* VT, bf16_t* OM, int b, int h, int q0, int lane) {
    const int r32 = lane & 31, hh = lane >> 5;
    const bf16_t* qrow = QM + (size_t)(b * SEQ + q0 + r32) * D + h * 256 + 8 * hh;
    const bf16_t* kbase = KVM + (size_t)(b * MEMLEN + r32) * 2048 + h * 256 + 8 * hh;
    for (int dh = 0; dh < 2; ++dh) {
        const bf16_t* vbase = VT + (size_t)(b * 1024 + h * 256 + dh * 128 + r32) * MEMLEN + 4 * hh;
        f32x16 O[4];
#pragma unroll
        for (int o = 0; o < 4; ++o)
#pragma unroll
            for (int i = 0; i < 16; ++i) O[o][i] = 0.f;
        float m = -INFINITY, l = 0.f;
        for (int t = 0; t < 8; ++t) {
            const bf16_t* kp = kbase + (size_t)(32 * t) * 2048;
            f32x16 S;
#pragma unroll
            for (int i = 0; i < 16; ++i) S[i] = 0.f;
#pragma unroll
            for (int d0 = 0; d0 < 16; ++d0) S = mfma32(*(const bf16x8*)(kp + 16 * d0), *(const bf16x8*)(qrow + 16 * d0), S);
            softmax_step<4>(S, LOG2E * 0.0625f, m, l, O, hh);
            const bf16x8 p0 = pack_p(S, 0), p1 = pack_p(S, 1);
            const bf16_t* vp = vbase + 32 * t;
#pragma unroll
            for (int o = 0; o < 4; ++o) { O[o] = mfma32(vt_frag(vp + (size_t)(32 * o) * MEMLEN), p0, O[o]); O[o] = mfma32(vt_frag(vp + (size_t)(32 * o) * MEMLEN + 16), p1, O[o]); }
        }
        l += xhalf(l, hh);
        const float il = 1.f / l;
        bf16_t* orow = OM + (size_t)(b * SEQ + q0 + r32) * D + h * 256 + dh * 128 + 4 * hh;
#pragma unroll
        for (int o = 0; o < 4; ++o)
#pragma unroll
            for (int g = 0; g < 4; ++g) { v2u w; w.x = pg8::cvt_pk_bf16(O[o][4 * g] * il, O[o][4 * g + 1] * il); w.y = pg8::cvt_pk_bf16(O[o][4 * g + 2] * il, O[o][4 * g + 3] * il); *(v2u*)(orow + 32 * o + 8 * g) = w; }
    }
}


constexpr int VSTR = 136;
template <int NCH> __device__ __forceinline__ void stage_load(v4u (&r)[NCH], const bf16_t* g0, int chunks_per_row, size_t gpitch, int tid) {
#pragma unroll
    for (int i = 0; i < NCH; ++i) { const int c = tid + NTHR * i, row = c / chunks_per_row, ch = c % chunks_per_row; r[i] = *(const v4u*)(g0 + (size_t)row * gpitch + ch * 8); }
}
template <int NCH> __device__ __forceinline__ void stage_store_k(const v4u (&r)[NCH], LAS unsigned char* dst, int chunks_per_row, int lstride, int tid) {
#pragma unroll
    for (int i = 0; i < NCH; ++i) { const int c = tid + NTHR * i, row = c / chunks_per_row, ch = c % chunks_per_row; *(LAS v4u*)(dst + row * lstride + ch * 16) = r[i]; }
}
template <int NCH> __device__ __forceinline__ void stage_store_v(const v4u (&r)[NCH], LAS unsigned char* dst, int tid) {
#pragma unroll
    for (int i = 0; i < NCH; ++i) { const int c = tid + NTHR * i, row = c >> 3, ch = c & 7; LAS v2u* d = (LAS v2u*)(dst + row * VSTR + ch * 16); d[0] = (v2u){r[i].x, r[i].y}; d[1] = (v2u){r[i].z, r[i].w}; }
}
__device__ __forceinline__ bf16x8 lds_vfrag16(const LAS unsigned char* p) { return *(const LAS bf16x8*)p; }
__device__ __forceinline__ bf16x8 lds_vfrag(const LAS unsigned char* p) { const v2u lo = *(const LAS v2u*)p, hi = *(const LAS v2u*)(p + 16); return __builtin_bit_cast(bf16x8, (v4u){lo.x, lo.y, hi.x, hi.y}); }

constexpr float SM_THR = 8.0f;
template <int NO>
__device__ __forceinline__ void softmax_def2(f32x16& S0, f32x16& S1, bool first, float& mref, float& l, f32x16 (&O)[NO], int hh) {
    float mx = fmaxf(fmaxf(S0[0], S0[1]), fmaxf(S1[0], S1[1]));
#pragma unroll
    for (int i = 2; i < 16; i += 2) mx = fmaxf(mx, fmaxf(fmaxf(S0[i], S0[i + 1]), fmaxf(S1[i], S1[i + 1])));
    mx = fmaxf(mx, xhalf(mx, hh));
    if (first || __any(mx > SM_THR)) {
        const float dl = first ? mx : fmaxf(mx, 0.f), f = first ? 0.f : __builtin_amdgcn_exp2f(-dl);
        mref += dl; l *= f;
#pragma unroll
        for (int o = 0; o < NO; ++o) O[o] = O[o] * f;
#pragma unroll
        for (int i = 0; i < 16; ++i) { S0[i] -= dl; S1[i] -= dl; }
    }
    float ps = 0.f;
#pragma unroll
    for (int i = 0; i < 16; ++i) { S0[i] = __builtin_amdgcn_exp2f(S0[i]); S1[i] = __builtin_amdgcn_exp2f(S1[i]); ps += S0[i] + S1[i]; }
    l += ps;
}
template <int NO>
__device__ __forceinline__ void softmax_def1(f32x16& S, bool first, float& mref, float& l, f32x16 (&O)[NO], int hh) {
    float mx = fmaxf(fmaxf(S[0], S[1]), fmaxf(S[2], S[3]));
#pragma unroll
    for (int i = 4; i < 16; i += 4) mx = fmaxf(mx, fmaxf(fmaxf(S[i], S[i + 1]), fmaxf(S[i + 2], S[i + 3])));
    mx = fmaxf(mx, xhalf(mx, hh));
    if (first || __any(mx > SM_THR)) {
        const float dl = first ? mx : fmaxf(mx, 0.f), f = first ? 0.f : __builtin_amdgcn_exp2f(-dl);
        mref += dl; l *= f;
#pragma unroll
        for (int o = 0; o < NO; ++o) O[o] = O[o] * f;
#pragma unroll
        for (int i = 0; i < 16; ++i) S[i] -= dl;
    }
    float ps = 0.f;
#pragma unroll
    for (int i = 0; i < 16; ++i) { S[i] = __builtin_amdgcn_exp2f(S[i]); ps += S[i]; }
    l += ps;
}
template <int NO>
__device__ __forceinline__ void softmax_step2(f32x16& S0, f32x16& S1, float C, float& m, float& l, f32x16 (&O)[NO], int hh) {
    float mx = fmaxf(fmaxf(S0[0], S0[1]), fmaxf(S1[0], S1[1]));
#pragma unroll
    for (int i = 2; i < 16; i += 2) mx = fmaxf(mx, fmaxf(fmaxf(S0[i], S0[i + 1]), fmaxf(S1[i], S1[i + 1])));
    mx = fmaxf(mx, xhalf(mx, hh)) * C;
    const float mn = fmaxf(m, mx), al = __builtin_amdgcn_exp2f(m - mn);
    m = mn; l *= al;
#pragma unroll
    for (int o = 0; o < NO; ++o) O[o] = O[o] * al;
    float ps = 0.f;
#pragma unroll
    for (int i = 0; i < 16; ++i) { S0[i] = __builtin_amdgcn_exp2f(S0[i] * C - mn); S1[i] = __builtin_amdgcn_exp2f(S1[i] * C - mn); ps += S0[i] + S1[i]; }
    l += ps;
}

__device__ __forceinline__ void attn_diff_block(const bf16_t* PR, const bf16_t* VT, bf16_t* OAT, const float* subln, float lam, int b, int h, int qb, LAS unsigned char* lds, int tid, int wave, int lane) {
    constexpr int KB = 8192, BUF = 2 * KB + 16384, QOFF = 3 * BUF;
    const int r32 = lane & 31, hh = lane >> 5, j = wave >> 2, w4 = wave & 3, q0 = qb * 128 + w4 * 32;
    const bf16_t* qrow = PR + (size_t)(b * SEQ + q0 + r32) * NIN + C_DQ + h * 128 + j * 64 + 8 * hh;
    LAS unsigned char* qs = lds + QOFF + wave * 4096 + lane * 16;
#pragma unroll
    for (int d0 = 0; d0 < 4; ++d0) *(LAS bf16x8*)(qs + d0 * 1024) = *(const bf16x8*)(qrow + 16 * d0);
    asm volatile("s_waitcnt vmcnt(0) lgkmcnt(0)" ::: "memory");
    const bf16_t* kg = PR + (size_t)(b * SEQ) * NIN + C_DK + h * 128;
    const bf16_t* vg = VT + (size_t)(b * 512 + h * 128) * SEQ;
    auto uni_ptr = [](const void* p_) __attribute__((always_inline)) { const unsigned long long v_ = (unsigned long long)p_; return (void*)(((unsigned long long)(unsigned)__builtin_amdgcn_readfirstlane((int)(v_ >> 32)) << 32) | (unsigned)__builtin_amdgcn_readfirstlane((int)v_)); };
    const auto rK = __builtin_amdgcn_make_buffer_rsrc(uni_ptr(kg), 0, 0x7fffffff, 0x00020000), rV = __builtin_amdgcn_make_buffer_rsrc(uni_ptr(vg), 0, 0x7fffffff, 0x00020000);
    const int prow = lane >> 3, pch = lane & 7;
    const int krow = 8 * wave + prow;
    const int kvoff = (krow * NIN + ((pch ^ (krow & 7)) << 3)) * 2;
    int vvoff[2];
#pragma unroll
    for (int pp = 0; pp < 2; ++pp) { const int vrow = 16 * wave + 8 * pp + prow; vvoff[pp] = (vrow * SEQ + ((pch ^ ((vrow ^ (vrow >> 3)) & 7)) << 3)) * 2; }
    auto dma = [&](int t_, int slot) __attribute__((always_inline)) {
        LAS unsigned char* sb_ = lds + slot;
        __builtin_amdgcn_raw_ptr_buffer_load_lds(rK, (LAS unsigned*)(sb_ + wave * 1024), 16, kvoff, t_ * (64 * NIN * 2), 0, 0);
        __builtin_amdgcn_raw_ptr_buffer_load_lds(rK, (LAS unsigned*)(sb_ + KB + wave * 1024), 16, kvoff + 128, t_ * (64 * NIN * 2), 0, 0);
        __builtin_amdgcn_raw_ptr_buffer_load_lds(rV, (LAS unsigned*)(sb_ + 2 * KB + wave * 2048), 16, vvoff[0], t_ * 128, 0, 0);
        __builtin_amdgcn_raw_ptr_buffer_load_lds(rV, (LAS unsigned*)(sb_ + 2 * KB + wave * 2048 + 1024), 16, vvoff[1], t_ * 128, 0, 0); };
    f32x16 O[4];
#pragma unroll
    for (int o = 0; o < 4; ++o)
#pragma unroll
        for (int i = 0; i < 16; ++i) O[o][i] = 0.f;
    float m = 0.f, l = 0.f;
    const int nsteps = 2 * qb + 2, my_last = 2 * qb + (w4 >> 1);
    const int xr = r32 & 7;
    bf16x8 p00, p01, p10, p11;
    auto qk_softmax = [&](int t, int slot) __attribute__((always_inline)) {
        if (t <= my_last) {
            const LAS unsigned char* kb = lds + slot + j * KB + r32 * 128;
            f32x16 S0, S1;
#pragma unroll
            for (int i = 0; i < 16; ++i) { S0[i] = -m; S1[i] = -m; }
#pragma unroll
            for (int d0 = 0; d0 < 4; ++d0) { const int co = ((2 * d0 + hh) ^ xr) << 4; const bf16x8 qd = *(const LAS bf16x8*)(qs + d0 * 1024);
                S0 = mfma32(*(const LAS bf16x8*)(kb + co), qd, S0); S1 = mfma32(*(const LAS bf16x8*)(kb + 32 * 128 + co), qd, S1); }
            softmax_def2<4>(S0, S1, t == 0, m, l, O, hh);
            p00 = pack_p(S0, 0); p01 = pack_p(S0, 1); p10 = pack_p(S1, 0); p11 = pack_p(S1, 1);
        } };
    auto vfrag = [&](const LAS unsigned char* rowp, int c16, int sw) __attribute__((always_inline)) -> bf16x8 {
        return *(const LAS bf16x8*)(rowp + (((c16 + hh) ^ sw) << 4)); };
    auto pv = [&](int t, int slot) __attribute__((always_inline)) {
        if (t <= my_last) {
#pragma unroll
            for (int o = 0; o < 4; ++o) { const int d = 32 * o + r32, sw = (d ^ (d >> 3)) & 7; const LAS unsigned char* rowp = lds + slot + 2 * KB + d * 128;
                O[o] = mfma32(vfrag(rowp, 0, sw), p00, O[o]); O[o] = mfma32(vfrag(rowp, 2, sw), p01, O[o]); O[o] = mfma32(vfrag(rowp, 4, sw), p10, O[o]); O[o] = mfma32(vfrag(rowp, 6, sw), p11, O[o]); }
        } };
#define DIFF_BAR() do { asm volatile("s_waitcnt lgkmcnt(0)" ::: "memory"); __builtin_amdgcn_s_barrier(); asm volatile("" ::: "memory"); } while (0)
    dma(0, 0); dma(1, BUF);
    asm volatile("s_waitcnt vmcnt(4)" ::: "memory");
    DIFF_BAR();
#define DIFF_STEPS(H1, H2) { int sl = 0, slp = 2 * BUF, sln = BUF; \
    for (int t = 0; t < nsteps; ++t) { \
        H1(t, sl, slp); DIFF_BAR(); \
        const bool more = t + 2 < nsteps; \
        if (more) dma(t + 2, slp); \
        H2(t, sl); \
        if (more) asm volatile("s_waitcnt vmcnt(4)" ::: "memory"); else asm volatile("s_waitcnt vmcnt(0)" ::: "memory"); \
        DIFF_BAR(); \
        const int tmp_ = slp; slp = sl; sl = sln; sln = tmp_; } }
#define LEAD_H1(t, sl, slp) qk_softmax(t, sl)
#define LEAD_H2(t, sl) pv(t, sl)
#define LAG_H1(t, sl, slp) do { if ((t) > 0) pv((t) - 1, slp); } while (0)
#define LAG_H2(t, sl) qk_softmax(t, sl)
    if (j == 0) { DIFF_STEPS(LEAD_H1, LEAD_H2) } else { DIFF_STEPS(LAG_H1, LAG_H2) }
#undef DIFF_STEPS
#undef LEAD_H1
#undef LEAD_H2
#undef LAG_H1
#undef LAG_H2
    if (j == 1) pv(nsteps - 1, ((nsteps - 1) % 3) * BUF);
    DIFF_BAR();
#undef DIFF_BAR
    l += xhalf(l, hh);
    const float il = 1.f / l;
    LAS float* X = (LAS float*)lds + (size_t)(w4 * 32 + r32) * 132 + 4 * hh;
    if (j == 1) {
#pragma unroll
        for (int o = 0; o < 4; ++o)
#pragma unroll
            for (int g = 0; g < 4; ++g) *(LAS f32x4*)(X + 32 * o + 8 * g) = (f32x4){O[o][4 * g] * il, O[o][4 * g + 1] * il, O[o][4 * g + 2] * il, O[o][4 * g + 3] * il};
    }
    __syncthreads();
    if (j == 0) {
        float ss = 0.f;
#pragma unroll
        for (int o = 0; o < 4; ++o)
#pragma unroll
            for (int g = 0; g < 4; ++g) { const f32x4 o2 = *(const LAS f32x4*)(X + 32 * o + 8 * g);
#pragma unroll
                for (int c = 0; c < 4; ++c) { const float d = O[o][4 * g + c] * il - lam * o2[c]; O[o][4 * g + c] = d; ss += d * d; } }
        ss += xhalf(ss, hh);
        const float rinv = 0.8f / sqrtf(ss * (1.f / 128.f) + NORM_EPS);
        bf16_t* orow = OAT + (size_t)(b * SEQ + q0 + r32) * D + 512 + h * 128 + 4 * hh; const float* sl = subln + 4 * hh;
#pragma unroll
        for (int o = 0; o < 4; ++o)
#pragma unroll
            for (int g = 0; g < 4; ++g) { const f32x4 sg_ = *(const f32x4*)(sl + 32 * o + 8 * g); v2u w;
                w.x = pg8::cvt_pk_bf16(O[o][4 * g] * rinv * sg_[0], O[o][4 * g + 1] * rinv * sg_[1]); w.y = pg8::cvt_pk_bf16(O[o][4 * g + 2] * rinv * sg_[2], O[o][4 * g + 3] * rinv * sg_[3]); *(v2u*)(orow + 32 * o + 8 * g) = w; }
    }
    __syncthreads();
}

__device__ __forceinline__ void sb_subtile(f32x16& S, bool diag, float& R, f32x16 (&O)[2], const LAS unsigned char* vp, int r32, int hh) {
    f32x16 lr;
#pragma unroll
    for (int i = 0; i < 16; ++i) { const float z2 = S[i]; const float sp = fmaxf(z2, 0.f) + __builtin_amdgcn_logf(1.f + __builtin_amdgcn_exp2f(-fabsf(z2))); lr[i] = -sp; S[i] = z2 - sp; }
    if (diag) {
#pragma unroll
        for (int i = 0; i < 16; ++i) { const int kvl = (i & 3) + 8 * (i >> 2) + 4 * hh; if (kvl >= r32) { lr[i] = 0.f; S[i] = -INFINITY; } }
    }
    float tot[4], pt[4], off[4]; f32x16 ex;
#pragma unroll
    for (int g = 0; g < 4; ++g) { ex[4 * g + 3] = 0.f; ex[4 * g + 2] = lr[4 * g + 3]; ex[4 * g + 1] = lr[4 * g + 3] + lr[4 * g + 2]; ex[4 * g] = ex[4 * g + 1] + lr[4 * g + 1]; tot[g] = ex[4 * g] + lr[4 * g]; }
#pragma unroll
    for (int g = 0; g < 4; ++g) pt[g] = xhalf(tot[g], hh);
    const float own0 = hh ? 0.f : 1.f;
    float sp_ = 0.f;
#pragma unroll
    for (int g = 3; g >= 0; --g) { off[g] = sp_ + own0 * pt[g] + R; sp_ += tot[g] + pt[g]; }
#pragma unroll
    for (int i = 0; i < 16; ++i) S[i] = __builtin_amdgcn_exp2f(S[i] + ex[i] + off[i >> 2]);
    R += sp_;
    const bf16x8 p0 = pack_p(S, 0), p1 = pack_p(S, 1);
#pragma unroll
    for (int o = 0; o < 2; ++o) { O[o] = mfma32(lds_vfrag16(vp + 32 * o * 144), p0, O[o]); O[o] = mfma32(lds_vfrag16(vp + 32 * o * 144 + 32), p1, O[o]); }
}
__device__ __forceinline__ void attn_sb_block(const bf16_t* PR, const bf16_t* VT, bf16_t* OAT, int b, int h, int qb, LAS unsigned char* lds, volatile LAS unsigned* fl, int tid, int wave, int lane) {
    constexpr int KSTR = 144, KB = 64 * KSTR, BUF = KB + 64 * 144;
    const int r32 = lane & 31, hh = lane >> 5, q0 = qb * 256 + wave * 32;
    const bf16_t* qrow = PR + (size_t)(b * SEQ + q0 + r32) * NIN + C_SBQ + h * 64 + 8 * hh;
    bf16x8 qf[4];
#pragma unroll
    for (int d0 = 0; d0 < 4; ++d0) qf[d0] = *(const bf16x8*)(qrow + 16 * d0);
    const bf16_t* kg = PR + (size_t)(b * SEQ) * NIN + C_SBK + h * 64;
    const bf16_t* vg = VT + (size_t)(b * 512 + h * 64) * SEQ;
    f32x16 O[2];
#pragma unroll
    for (int o = 0; o < 2; ++o)
#pragma unroll
        for (int i = 0; i < 16; ++i) O[o][i] = 0.f;
    float R = 0.f; bool done = false;
    const int ttop = 4 * qb + 3, my_diag = 4 * qb + (wave >> 1), odd = wave & 1;
    v4u kr[1], vr[1];
    if (tid < 3) fl[tid] = 0u;
    stage_load<1>(kr, kg + (size_t)(64 * ttop) * NIN, 8, NIN, tid); stage_load<1>(vr, vg + 64 * ttop, 8, SEQ, tid);
    stage_store_k<1>(kr, lds, 8, KSTR, tid); stage_store_k<1>(vr, lds + KB, 8, 144, tid);
    __syncthreads();
    int it = 0;
    for (int t = ttop; t >= 0; --t, ++it) {
        const bool more = t > 0;
        if (more) { stage_load<1>(kr, kg + (size_t)(64 * (t - 1)) * NIN, 8, NIN, tid); stage_load<1>(vr, vg + 64 * (t - 1), 8, SEQ, tid); }
        const int fcur = it % 3;
        if (tid == 0) fl[(it + 1) % 3] = 0u;
        if (t <= my_diag && !done) {
            const LAS unsigned char* kb = lds + (it & 1) * BUF + r32 * KSTR + 16 * hh; const LAS unsigned char* vb = lds + (it & 1) * BUF + KB + r32 * 144 + 16 * hh;
            const bool isd = (t == my_diag);
            if (!isd || odd) {
                f32x16 S;
#pragma unroll
                for (int i = 0; i < 16; ++i) S[i] = 0.f;
#pragma unroll
                for (int d0 = 0; d0 < 4; ++d0) S = mfma32(*(const LAS bf16x8*)(kb + 32 * KSTR + 32 * d0), qf[d0], S);
                sb_subtile(S, isd, R, O, vb + 64, r32, hh);
            }
            {
                f32x16 S;
#pragma unroll
                for (int i = 0; i < 16; ++i) S[i] = 0.f;
#pragma unroll
                for (int d0 = 0; d0 < 4; ++d0) S = mfma32(*(const LAS bf16x8*)(kb + 32 * d0), qf[d0], S);
                sb_subtile(S, isd && !odd, R, O, vb, r32, hh);
            }
            done = __all(R < -160.f);
        }
        if (done && lane == 0) __hip_atomic_fetch_or((LAS unsigned*)(fl + fcur), 1u << wave, __ATOMIC_RELAXED, __HIP_MEMORY_SCOPE_WORKGROUP);
        if (more) { LAS unsigned char* nb = lds + ((it + 1) & 1) * BUF; stage_store_k<1>(kr, nb, 8, KSTR, tid); stage_store_k<1>(vr, nb + KB, 8, 144, tid); }
        __syncthreads();
        if (fl[fcur] == 0xffu) break;
    }
    bf16_t* orow = OAT + (size_t)(b * SEQ + q0 + r32) * D + h * 64 + 4 * hh;
#pragma unroll
    for (int o = 0; o < 2; ++o)
#pragma unroll
        for (int g = 0; g < 4; ++g) { v2u w; w.x = pg8::cvt_pk_bf16(O[o][4 * g], O[o][4 * g + 1]); w.y = pg8::cvt_pk_bf16(O[o][4 * g + 2], O[o][4 * g + 3]); *(v2u*)(orow + 32 * o + 8 * g) = w; }
    __syncthreads();
}

__device__ __forceinline__ void attn_mem_block(const bf16_t* QM, const bf16_t* KVM, const bf16_t* VT, bf16_t* OM, int b, int h, int qb, LAS unsigned char* lds, int tid, int wave, int lane) {
    constexpr int KSTR = 528, KB = 32 * KSTR, VS = 80, BUF = KB + 128 * VS;
    const int r32 = lane & 31, hh = lane >> 5, q0 = qb * 256 + wave * 32;
    const bf16_t* qrow = QM + (size_t)(b * SEQ + q0 + r32) * D + h * 256 + 8 * hh;
    bf16x8 qf[8];
    LAS unsigned char* qs = lds + 57344 + wave * 8192 + lane * 16;
#pragma unroll
    for (int d0 = 0; d0 < 8; ++d0) { qf[d0] = *(const bf16x8*)(qrow + 16 * d0); *(LAS bf16x8*)(qs + d0 * 1024) = *(const bf16x8*)(qrow + 128 + 16 * d0); }
    const bf16_t* kg = KVM + (size_t)(b * MEMLEN) * 2048 + h * 256;
    const int vrow = tid >> 2, vch = tid & 3;
    for (int dh = 0; dh < 2; ++dh) {
        const bf16_t* vg = VT + (size_t)(b * 1024 + h * 256 + dh * 128 + vrow) * MEMLEN + vch * 8;
        f32x16 O[4];
#pragma unroll
        for (int o = 0; o < 4; ++o)
#pragma unroll
            for (int i = 0; i < 16; ++i) O[o][i] = 0.f;
        float m = 0.f, l = 0.f;
        v4u kr[2], vr;
        stage_load<2>(kr, kg, 32, 2048, tid); vr = *(const v4u*)vg;
        stage_store_k<2>(kr, lds, 32, KSTR, tid); *(LAS v4u*)(lds + KB + vrow * VS + vch * 16) = vr;
        __syncthreads();
        for (int t = 0; t < 8; ++t) {
            const bool more = t < 7;
            if (more) { stage_load<2>(kr, kg + (size_t)(32 * (t + 1)) * 2048, 32, 2048, tid); vr = *(const v4u*)(vg + 32 * (t + 1)); }
            {
                const LAS unsigned char* kb = lds + (t & 1) * BUF + r32 * KSTR + 16 * hh; const LAS unsigned char* vb = lds + (t & 1) * BUF + KB + r32 * VS + 16 * hh;
                f32x16 S;
#pragma unroll
                for (int i = 0; i < 16; ++i) S[i] = -m;
#pragma unroll
                for (int d0 = 0; d0 < 8; ++d0) S = mfma32(*(const LAS bf16x8*)(kb + 32 * d0), qf[d0], S);
#pragma unroll
                for (int d0 = 0; d0 < 8; ++d0) S = mfma32(*(const LAS bf16x8*)(kb + 256 + 32 * d0), *(const LAS bf16x8*)(qs + d0 * 1024), S);
                softmax_def1<4>(S, t == 0, m, l, O, hh);
                const bf16x8 p0 = pack_p(S, 0), p1 = pack_p(S, 1);
#pragma unroll
                for (int o = 0; o < 4; ++o) { const LAS unsigned char* vp = vb + 32 * o * VS; O[o] = mfma32(lds_vfrag16(vp), p0, O[o]); O[o] = mfma32(lds_vfrag16(vp + 32), p1, O[o]); }
            }
            if (more) { LAS unsigned char* nb = lds + ((t + 1) & 1) * BUF; stage_store_k<2>(kr, nb, 32, KSTR, tid); *(LAS v4u*)(nb + KB + vrow * VS + vch * 16) = vr; }
            __syncthreads();
        }
        l += xhalf(l, hh);
        const float il = 1.f / l;
        bf16_t* orow = OM + (size_t)(b * SEQ + q0 + r32) * D + h * 256 + dh * 128 + 4 * hh;
#pragma unroll
        for (int o = 0; o < 4; ++o)
#pragma unroll
            for (int g = 0; g < 4; ++g) { v2u w; w.x = pg8::cvt_pk_bf16(O[o][4 * g] * il, O[o][4 * g + 1] * il); w.y = pg8::cvt_pk_bf16(O[o][4 * g + 2] * il, O[o][4 * g + 3] * il); *(v2u*)(orow + 32 * o + 8 * g) = w; }
    }
}

struct Args { const void* in[26]; float* out; unsigned char* ws; int ph_lo, ph_hi; };
constexpr int NPHASE = 15;

__device__ __forceinline__ float softplus_f(float z) { return fmaxf(z, 0.f) + __logf(1.f + __expf(-fabsf(z))); }

__global__ void __launch_bounds__(NTHR, 2) fwd(Args args) {
    extern __shared__ __attribute__((aligned(16))) unsigned char lds[];
    LAS unsigned char* L = (LAS unsigned char*)lds;
    volatile LAS unsigned* MISC = (volatile LAS unsigned*)(L + MISC_OFF);
    const int tid = threadIdx.x, lane = tid & 63, wave = __builtin_amdgcn_readfirstlane(tid >> 6);
    const int G = gridDim.x;
    unsigned char* ws = args.ws;
    unsigned* ctl = (unsigned*)(ws + WS_CTL);
#define x_in ((const float*)args.in[0])
#define mem_in ((const float*)args.in[1])
#define positions ((const int*)args.in[2])
#define norm_mix ((const float*)args.in[3])
#define w_in ((const float*)args.in[4])
#define lam_q1 ((const float*)args.in[5])
#define lam_k1 ((const float*)args.in[6])
#define lam_q2 ((const float*)args.in[7])
#define lam_k2 ((const float*)args.in[8])
#define diff_subln ((const float*)args.in[9])
#define w_up_sb ((const float*)args.in[10])
#define w_up_diff ((const float*)args.in[11])
#define w_out ((const float*)args.in[12])
#define norm_mem_q ((const float*)args.in[13])
#define norm_mem_kv ((const float*)args.in[14])
#define w_mem_q ((const float*)args.in[15])
#define w_mem_kv ((const float*)args.in[16])
#define w_mem_o ((const float*)args.in[17])
#define norm_ffn ((const float*)args.in[18])
#define w_router ((const float*)args.in[19])
#define b_router ((const float*)args.in[20])
#define w_gate_up ((const float*)args.in[21])
#define b_gate_up ((const float*)args.in[22])
#define w_down ((const float*)args.in[23])
#define b_down ((const float*)args.in[24])
#define norm_final ((const float*)args.in[25])
    bf16_t* WIN = (bf16_t*)(ws + WS_WIN); bf16_t* WUPSB = (bf16_t*)(ws + WS_WUPSB); bf16_t* WUPDF = (bf16_t*)(ws + WS_WUPDF); bf16_t* WOUT = (bf16_t*)(ws + WS_WOUT);
    bf16_t* WMQ = (bf16_t*)(ws + WS_WMQ); bf16_t* WMKV = (bf16_t*)(ws + WS_WMKV); bf16_t* WMO = (bf16_t*)(ws + WS_WMO);
    bf16_t* WGU = (bf16_t*)(ws + WS_WGU); bf16_t* WD = (bf16_t*)(ws + WS_WD);
    float* ROPEC = (float*)(ws + WS_ROPE); float* ROPES = ROPEC + (size_t)M * 32;
    int* TK_E = (int*)(ws + WS_TK); int* TK_POS = TK_E + (size_t)M * 4; float* TK_G = (float*)(TK_POS + (size_t)M * 4);
    bf16_t* XN = (bf16_t*)(ws + WS_XN); bf16_t* PR = (bf16_t*)(ws + WS_PR); bf16_t* OAT = (bf16_t*)(ws + WS_OAT); float* SSQ = (float*)(ws + WS_ODR);
    bf16_t* MIX = (bf16_t*)(ws + WS_MIX); float* X1 = (float*)(ws + WS_X1); float* X2 = (float*)(ws + WS_X2);
    bf16_t* HM = (bf16_t*)(ws + WS_HM); bf16_t* KVM = (bf16_t*)(ws + WS_KVM); int* TLIST = (int*)(ws + WS_TLIST); float* GLIST = (float*)(ws + WS_GLIST);
    bf16_t* QM = (bf16_t*)(ws + WS_QM); bf16_t* OM = (bf16_t*)(ws + WS_OM); bf16_t* ACT = (bf16_t*)(ws + WS_ACT); bf16_t* YB = (bf16_t*)(ws + WS_YB);
    bf16_t* VTSB = (bf16_t*)(ws + WS_VTSB); bf16_t* VTDF = (bf16_t*)(ws + WS_VTDF); bf16_t* VTM = (bf16_t*)(ws + WS_VTM);
    float* WR = (float*)(ws + WS_WR); float* WSCGU = (float*)(ws + WS_WSC); float* WSCD = WSCGU + NE * 2048;
    unsigned char* WGU8 = ws + WS_WGU; unsigned char* WD8 = ws + WS_WD; unsigned char* XN8 = ws + WS_XN; unsigned char* ACT8 = ws + WS_ACT;
    unsigned* CNT = ctl + CW_CNT;
    LAS float* smf = (LAS float*)L;
    LAS int* smi = (LAS int*)L;

    for (int u = tid; u < (LDS_BYTES - 131072) / 4; u += NTHR) ((LAS unsigned*)(L + 131072))[u] = 0u;
    __syncthreads();
#if !MK_PER_PHASE
    XcdBarrier bar = xcd_barrier_post(ctl + CW_BAR, MISC + 8);
#define GRID_BAR() xcd_barrier(bar)
#else
#define GRID_BAR() do {} while (0)
#endif
    const int lo = args.ph_lo, hi = args.ph_hi;
#define IN(k) (lo <= (k) && (k) < hi)
#define PHASE_L(k, ...) do { if (IN(k)) { auto body_ = [&]() __attribute__((always_inline)) __VA_ARGS__; body_(); if ((PROBE_REP >> (k)) & 1) { GRID_BAR(); body_(); } } } while (0)
#if !MK_PER_PHASE
#define PHASE(k) for (int rep_ = 0, nrep_ = IN(k) ? 1 + ((PROBE_REP >> (k)) & 1) : 0; rep_ < nrep_; ++rep_, (rep_ < nrep_ ? (xcd_barrier(bar), 0) : 0))
#else
#define PHASE(k) if (IN(k))
#endif
    unsigned long long st_t0_ = 0ull, st_dt_ = 0ull;
#define STAMP_AT(k) do { if (PROBE_STAMP >= 0) { const unsigned long long now_ = __builtin_amdgcn_s_memrealtime(); if ((k) == PROBE_STAMP || (PROBE_STAMP == 100 && (k) == 0)) st_t0_ = now_; if ((k) == PROBE_STAMP + 1 || (PROBE_STAMP == 100 && (k) == 15)) st_dt_ = now_ - st_t0_; } } while (0)
#define SEAM(k) do { if (IN(k) && IN((k) + 1)) GRID_BAR(); STAMP_AT((k) + 1); } while (0)
    const int gw = blockIdx.x * NWAVES + wave, NGW = G * NWAVES;
    const int xcu = (G % 8 == 0) ? ((int)blockIdx.x % 8) * (G / 8) + (int)blockIdx.x / 8 : (int)blockIdx.x;

    auto convert_experts = [&]() __attribute__((always_inline)) {
        LAS float* scr = (LAS float*)(L + wave * 16384);
        {
            const int c8 = lane & 7, r8 = lane >> 3;
            f32x4 ra[8], rb[8], rc[8], rd[8], re[8];
            auto sub_load = [&](const float* Wc, int N, int k0, f32x4 (&r)[8]) __attribute__((always_inline)) {
#pragma unroll
                for (int i = 0; i < 8; ++i) r[i] = *(const f32x4*)(Wc + (size_t)(k0 + 8 * i + r8) * N); };
            auto to_lds = [&](const f32x4 (&r)[8]) __attribute__((always_inline)) {
#pragma unroll
                for (int i = 0; i < 8; ++i) *(LAS f32x4*)(scr + (8 * i + r8) * 32 + ((4 * c8) ^ (4 * i))) = r[i];
                LDS_WAIT(); asm volatile("" ::: "memory"); };
            auto max8 = [&](float v) __attribute__((always_inline)) -> float {
                v = fmaxf(v, __uint_as_float(__builtin_amdgcn_update_dpp(0, __float_as_uint(v), 0xB1, 0xf, 0xf, false)));
                v = fmaxf(v, __uint_as_float(__builtin_amdgcn_update_dpp(0, __float_as_uint(v), 0x4E, 0xf, 0xf, false)));
                v = fmaxf(v, __uint_as_float(__builtin_amdgcn_update_dpp(0, __float_as_uint(v), 0x141, 0xf, 0xf, false)));
                return v; };
            for (int it = gw; it < NE * 96 * 4; it += NGW) {
                const int strip = it % (NE * 96), qt = it / (NE * 96);
                const bool gu = strip < NE * 64; const int q = gu ? strip : strip - NE * 64, e = gu ? q >> 6 : q >> 5, n0 = (gu ? q & 63 : q & 31) * 32, N = gu ? 2048 : 1024;
                const float* Wc = (gu ? w_gate_up + (size_t)e * 1024 * 2048 : w_down + (size_t)e * 1024 * 1024) + n0 + 4 * c8;
                sub_load(Wc, N, 0, ra); sub_load(Wc, N, 256 * qt, rb); sub_load(Wc, N, 256 * qt + 64, rc); sub_load(Wc, N, 256 * qt + 128, rd); sub_load(Wc, N, 256 * qt + 192, re);
                to_lds(ra);
                float inv[4], am[4];
#pragma unroll
                for (int j = 0; j < 4; ++j) { const int n = r8 + 8 * j; float a0 = 0.f;
#pragma unroll
                    for (int i = 0; i < 8; ++i) a0 = fmaxf(a0, fabsf(scr[(8 * c8 + i) * 32 + (n ^ (4 * c8))]));
                    a0 = max8(a0);
                    unsigned eb = ((__float_as_uint(a0) >> 23) & 0xffu) + 4u; eb = eb < 8u ? 8u : (eb > 250u ? 250u : eb);
                    inv[j] = __uint_as_float((261u - eb) << 23); am[j] = 0.f;
                    if (qt == 0 && c8 == 0) (gu ? WSCGU + (size_t)e * 2048 : WSCD + (size_t)e * 1024)[n0 + n] = __uint_as_float((eb - 7u) << 23); }
                LDS_WAIT(); asm volatile("" ::: "memory");
                unsigned char* dstb = gu ? WGU8 + (size_t)e * 2048 * 1024 : WD8 + (size_t)e * 1024 * 1024;
#pragma unroll
                for (int st = 0; st < 4; ++st) {
                    const int k0 = 256 * qt + 64 * st;
                    if (st == 0) to_lds(rb); else if (st == 1) to_lds(rc); else if (st == 2) to_lds(rd); else to_lds(re);
#pragma unroll
                    for (int j = 0; j < 4; ++j) { const int n = r8 + 8 * j, c = n0 + n; const LAS float* sp = scr + (8 * c8) * 32 + (n ^ (4 * c8)); float v[8];
#pragma unroll
                        for (int i = 0; i < 8; ++i) { v[i] = sp[i * 32]; am[j] = fmaxf(am[j], fabsf(v[i])); v[i] *= inv[j]; }
                        const int drow = gu ? (((c & 1023) >> 7) * 256 + (c >> 10) * 128 + (c & 127)) : c;
                        v2u w; w.x = pk4_fp8(v[0], v[1], v[2], v[3]); w.y = pk4_fp8(v[4], v[5], v[6], v[7]);
                        *(v2u*)(dstb + (size_t)drow * 1024 + k0 + 8 * c8) = w; }
                    LDS_WAIT(); asm volatile("" ::: "memory");
                }
                bool ov = false;
#pragma unroll
                for (int j = 0; j < 4; ++j) ov = ov || (am[j] * inv[j] >= 448.0f);
                if (__any(ov) && lane == 0) __hip_atomic_store(ctl + CW_REDO + strip, 1u, __ATOMIC_RELAXED, __HIP_MEMORY_SCOPE_AGENT);
            }
        }
    };
    STAMP_AT(0);
    PHASE(0) {
        STAMP_AT(20);
        LAS float* scr = (LAS float*)(L + wave * 16384);
        constexpr int I_IN = 16 * 160, I_UP = 8 * 32, I_SQ = 16 * 32, I_KV = 16 * 64, I_GU1 = 16 * 64, I_GU = NE * I_GU1, I_D1 = 16 * 32, I_DN = NE * I_D1;
        constexpr int NITEMS = I_IN + 2 * I_UP + 3 * I_SQ + I_KV;
        for (int it = gw; it < NITEMS; it += NGW) {
            int r = it;
            if (r < I_IN) {
                const int kb = r / 160, nb = r % 160, n0 = 32 * nb;
                if (n0 >= C_DQ && n0 < C_DV) { const int o = n0 & 255;
                    p0_transpose_rope(w_in, WIN, (n0 & ~255), o, 64 * kb, n0, scr, lane); }
                else p0_transpose_item(w_in, 1024, NIN, WIN, n0, 64 * kb, n0, scr, lane);
                continue; } r -= I_IN;
            if (r < I_UP) { p0_plain(w_up_sb, 512, 1024, WUPSB, r, scr, lane); continue; } r -= I_UP;
            if (r < I_UP) { p0_plain(w_up_diff, 512, 1024, WUPDF, r, scr, lane); continue; } r -= I_UP;
            if (r < I_SQ) { p0_plain(w_out, 1024, 1024, WOUT, r, scr, lane); continue; } r -= I_SQ;
            if (r < I_SQ) { p0_plain(w_mem_q, 1024, 1024, WMQ, r, scr, lane, norm_mem_q); continue; } r -= I_SQ;
            if (r < I_SQ) { p0_plain(w_mem_o, 1024, 1024, WMO, r, scr, lane); continue; } r -= I_SQ;
            p0_plain(w_mem_kv, 1024, 2048, WMKV, r, scr, lane);
        }
        for (int i = blockIdx.x * NTHR + tid; i < D * NE; i += G * NTHR) WR[i] = w_router[i] * norm_ffn[i >> 5];
        STAMP_AT(21);
        STAMP_AT(22);
        for (int m = gw; m < M; m += NGW) rms_row_to_bf16(x_in + (size_t)m * D, norm_mix, XN + (size_t)m * D, lane);
        for (int m = gw; m < MM; m += NGW) rms_row_to_bf16(mem_in + (size_t)m * D, norm_mem_kv, HM + (size_t)m * D, lane);
        for (int i = blockIdx.x * NTHR + tid; i < M * 32; i += G * NTHR) {
            const int m = i >> 5, f = i & 31;
            const double inv = exp2(-(double)f * (13.287712379549449 / 32.0));
            const double ang = (double)positions[m] * inv;
            const double kk = rint(ang * 0.15915494309189535);
            const float rf = (float)(ang - kk * 6.283185307179586);
            ROPEC[i] = __cosf(rf); ROPES[i] = __sinf(rf);
        }
        STAMP_AT(23);
    }
    SEAM(0); STAMP_AT(24);

    if (IN(1)) {
        const int grp = (int)blockIdx.x % 3;
        pg8::Gemm g{XN, WIN, D, D, D}; pg8::DenseOrder S; S.init(M, NIN, G, (int)blockIdx.x, D, D);
        const pg8::EpiInProj E{PR, ROPEC, ROPES, VTSB, VTDF};
        if (grp == 0) { convert_experts(); __syncthreads(); }
        if (grp == 1) { S.i0 = 0; S.i1 = 2; pg8::gemm_phase<pg8::EpiInProj, pg8::DenseOrder, false>(L, g, S, E); convert_experts(); __syncthreads(); S.i0 = 2; S.i1 = 1 << 30; }
        pg8::gemm_phase<pg8::EpiInProj, pg8::DenseOrder, false>(L, g, S, E);
        if (grp == 2) convert_experts();
    }
    SEAM(1);

    if (IN(3)) {
        {
            LAS float* sw = (LAS float*)L; LAS float* red = (LAS float*)(L + 131072 + 4096);
            const int n = tid & 31, part = tid >> 5;
            for (int it = blockIdx.x; it < NE * 96; it += G) {
                if (__hip_atomic_load(ctl + CW_REDO + it, __ATOMIC_RELAXED, __HIP_MEMORY_SCOPE_AGENT) == 0u) continue;
                const bool gu = it < NE * 64; const int q = gu ? it : it - NE * 64, e = gu ? q >> 6 : q >> 5, n0 = (gu ? q & 63 : q & 31) * 32, N = gu ? 2048 : 1024;
                const float* W = (gu ? w_gate_up + (size_t)e * 1024 * 2048 : w_down + (size_t)e * 1024 * 1024) + n0 + n;
                __syncthreads();
#pragma unroll 16
                for (int i = 0; i < 64; ++i) { const int k = part + 16 * i; sw[k * 32 + n] = W[(size_t)k * N]; }
                __syncthreads();
                float am = 0.f;
#pragma unroll 16
                for (int i = 0; i < 64; ++i) am = fmaxf(am, fabsf(sw[(64 * part + i) * 32 + n]));
                red[part * 32 + n] = am;
                __syncthreads();
                if (tid < 32) { float a = red[tid];
#pragma unroll
                    for (int pp = 1; pp < 16; ++pp) a = fmaxf(a, red[pp * 32 + tid]);
                    unsigned eb = (__float_as_uint(a) >> 23) & 0xffu; eb = eb < 8u ? 8u : eb;
                    const float sc = __uint_as_float((eb - 7u) << 23), inv = __uint_as_float((261u - eb) << 23);
                    red[512 + tid] = inv; (gu ? WSCGU + (size_t)e * 2048 : WSCD + (size_t)e * 1024)[n0 + tid] = sc; }
                __syncthreads();
                { const float inv = red[512 + n]; const int c = n0 + n;
                  const int drow = gu ? (((c & 1023) >> 7) * 256 + (c >> 10) * 128 + (c & 127)) : c;
                  unsigned char* dst = (gu ? WGU8 + ((size_t)e * 2048 + drow) * 1024 : WD8 + ((size_t)e * 1024 + drow) * 1024) + 64 * part;
#pragma unroll
                  for (int qd = 0; qd < 4; ++qd) { v4u w;
                      const LAS float* sp = sw + (64 * part + 16 * qd) * 32 + n;
                      w.x = pk4_fp8(sp[0] * inv, sp[32] * inv, sp[64] * inv, sp[96] * inv); w.y = pk4_fp8(sp[128] * inv, sp[160] * inv, sp[192] * inv, sp[224] * inv);
                      w.z = pk4_fp8(sp[256] * inv, sp[288] * inv, sp[320] * inv, sp[352] * inv); w.w = pk4_fp8(sp[384] * inv, sp[416] * inv, sp[448] * inv, sp[480] * inv);
                      *(v4u*)(dst + 16 * qd) = w; } }
            }
            __syncthreads();
        }
    }
    PHASE(3) {
        volatile LAS unsigned* fl = (volatile LAS unsigned*)(L + 131072 + 2048);
        STAMP_AT(30);
        const float lam = expf(wave_sum(lam_q1[lane] * lam_k1[lane])) - expf(wave_sum(lam_q2[lane] * lam_k2[lane])) + 0.2f;
        const int nkv = (G >= 64) ? 32 : 0;
        if ((int)blockIdx.x < nkv) { pg8::Gemm g{HM, WMKV, D, D, D}; pg8::OneUnitOrder S{(int)blockIdx.x, D, D};
            pg8::gemm_phase<pg8::EpiKV, pg8::OneUnitOrder, false>(L, g, S, pg8::EpiKV{KVM, VTM}); }
        if (nkv == 0) { pg8::Gemm g{HM, WMKV, D, D, D}; pg8::DenseOrder S; S.init(MM, 2048, G, (int)blockIdx.x, D, D); pg8::gemm_phase<pg8::EpiKV, pg8::DenseOrder, false>(L, g, S, pg8::EpiKV{KVM, VTM}); }
        for (int pr = blockIdx.x; pr < 256; pr += G) { const int sb_ = pr & 15, h = (pr >> 4) & 3, b = pr >> 6;
            attn_diff_block(PR, VTDF, OAT, diff_subln, lam, b, h, 31 - sb_, L, tid, wave, lane); attn_diff_block(PR, VTDF, OAT, diff_subln, lam, b, h, sb_, L, tid, wave, lane); }
        STAMP_AT(31);
        for (;;) {
            if (tid == 0) fl[4] = __hip_atomic_fetch_add(ctl + CW_SBQ, 1u, __ATOMIC_RELAXED, __HIP_MEMORY_SCOPE_AGENT);
            __syncthreads();
            const int bu = (int)fl[4];
            __syncthreads();
            if (bu >= 512) break;
            const int qb = 15 - (bu & 15), h = (bu >> 4) & 7, b = bu >> 7;
            attn_sb_block(PR, VTSB, OAT, b, h, qb, L, fl, tid, wave, lane);
        }
        STAMP_AT(32);
    }
    SEAM(3); STAMP_AT(3); STAMP_AT(33);

    PHASE_L(5, {
        pg8::Gemm g{OAT, WUPSB, D, 512, 512}; pg8::TwoRoundOrder S{G, xcu, D, 512};
        pg8::gemm_phase<pg8::EpiGate, pg8::TwoRoundOrder, false>(L, g, S, pg8::EpiGate{PR, (bf16_t*)X1, MIX});
    });
    SEAM(5); STAMP_AT(5);

    PHASE_L(6, {
        pg8::Gemm g{MIX, WOUT, D, D, D}; pg8::DenseOrder S; S.init(M, D, G, (int)blockIdx.x, D, D);
        pg8::gemm_phase<pg8::EpiResidNorm, pg8::DenseOrder, false>(L, g, S, pg8::EpiResidNorm{x_in, X1, XN, SSQ});
    });
    if (IN(6) && IN(8)) GRID_BAR();
    STAMP_AT(7); STAMP_AT(8);

    PHASE_L(8, {
        pg8::Gemm g{XN, WMQ, D, D, D}; pg8::DenseOrder S; S.init(M, D, G, (int)blockIdx.x, D, D);
        pg8::gemm_phase<pg8::EpiBf16Rinv, pg8::DenseOrder, false>(L, g, S, pg8::EpiBf16Rinv{QM, SSQ, 0.0625f * 1.4426950408889634f});
    });
    SEAM(8);

    PHASE(9) { for (int bu = blockIdx.x; bu < 256; bu += G) { const int qb = bu & 15, h = (bu >> 4) & 3, b = bu >> 6; attn_mem_block(QM, KVM, VTM, OM, b, h, qb, L, tid, wave, lane); } }
    SEAM(9);

    PHASE_L(10, {
        pg8::Gemm g{OM, WMO, D, D, D}; pg8::DenseOrder S; S.init(M, D, G, (int)blockIdx.x, D, D);
        pg8::gemm_phase<pg8::EpiResidB, pg8::DenseOrder, false>(L, g, S, pg8::EpiResidB{XN, X2});
    });
    SEAM(10);

    if (IN(11)) {
        auto body11_ = [&]() __attribute__((always_inline)) {
        {
            const int i32 = lane & 31, kk = lane >> 5;
#pragma unroll
            for (int t2 = 0; t2 < 2; ++t2) {
                const int tile = t2 * G + (int)blockIdx.x, m0 = tile * 32;
                LAS float* P = smf + (t2 * 8 + wave) * 1056; LAS float* SSQ_ = smf + 16 * 1056 + (t2 * 8 + wave) * 32;
                f32x16 acc;
#pragma unroll
                for (int r = 0; r < 16; ++r) acc[r] = 0.f;
                float ss = 0.f;
                if (tile < M / 32) {
                    const float* xr = X2 + (size_t)(m0 + i32) * D + 128 * wave + 4 * kk; const float* wp = WR + (128 * wave + 4 * kk) * NE + i32;
#pragma unroll 8
                    for (int u = 0; u < 16; ++u) {
                        const f32x4 a = *(const f32x4*)(xr + 8 * u);
                        const float b0 = wp[(8 * u + 0) * NE], b1 = wp[(8 * u + 1) * NE], b2 = wp[(8 * u + 2) * NE], b3 = wp[(8 * u + 3) * NE];
                        acc = __builtin_amdgcn_mfma_f32_32x32x2f32(a.x, b0, acc, 0, 0, 0); acc = __builtin_amdgcn_mfma_f32_32x32x2f32(a.y, b1, acc, 0, 0, 0);
                        acc = __builtin_amdgcn_mfma_f32_32x32x2f32(a.z, b2, acc, 0, 0, 0); acc = __builtin_amdgcn_mfma_f32_32x32x2f32(a.w, b3, acc, 0, 0, 0);
                        ss += (a.x * a.x + a.y * a.y) + (a.z * a.z + a.w * a.w);
                    }
                }
                ss += xhalf(ss, kk);
#pragma unroll
                for (int r = 0; r < 16; ++r) P[((r & 3) + 8 * (r >> 2) + 4 * kk) * 33 + i32] = acc[r];
                if (kk == 0) SSQ_[i32] = ss;
            }
        }
        __syncthreads();
        if (wave < 2) {
            const int tile = wave * G + (int)blockIdx.x;
            if (tile < M / 32) {
                const int m0 = tile * 32;
                LAS float* T = smf + (wave * 8) * 1056;
#pragma unroll
                for (int r = 0; r < 16; ++r) { const int idx = lane + 64 * r, e_ = (idx >> 5) * 33 + (idx & 31); float v = T[e_];
#pragma unroll
                    for (int w2 = 1; w2 < 8; ++w2) v += T[w2 * 1056 + e_];
                    T[e_] = v; }
                float ss = 0.f;
#pragma unroll
                for (int w2 = 0; w2 < 8; ++w2) ss += smf[16 * 1056 + (wave * 8 + w2) * 32 + (lane & 31)];
                LDS_WAIT(); asm volatile("" ::: "memory");
                const float rinv = 1.0f / sqrtf(ss * (1.f / 1024.f) + NORM_EPS);
                if (lane < 32) {
                    float lg[32];
#pragma unroll
                    for (int j = 0; j < 32; ++j) lg[j] = T[lane * 33 + j] * rinv + b_router[j];
                    float tv[4]; int ti[4];
#pragma unroll
                    for (int k = 0; k < 4; ++k) { float bv = lg[0]; int bi = 0;
#pragma unroll
                        for (int j = 1; j < 32; ++j) if (lg[j] > bv) { bv = lg[j]; bi = j; }
                        tv[k] = bv; ti[k] = bi;
#pragma unroll
                        for (int j = 0; j < 32; ++j) if (j == bi) lg[j] = -INFINITY; }
                    const float e1 = __expf(tv[1] - tv[0]), e2 = __expf(tv[2] - tv[0]), e3 = __expf(tv[3] - tv[0]);
                    const float isum = 1.f / (1.f + e1 + e2 + e3);
                    const float gk[4] = {isum, e1 * isum, e2 * isum, e3 * isum};
                    LAS unsigned* H = (LAS unsigned*)(smf + 16 * 1056 + 512 + wave * 64);
                    H[lane] = 0u;
                    LDS_WAIT(); asm volatile("" ::: "memory");
                    int rk[4];
#pragma unroll
                    for (int k = 0; k < 4; ++k) rk[k] = (int)__hip_atomic_fetch_add(H + ti[k], 1u, __ATOMIC_RELAXED, __HIP_MEMORY_SCOPE_WAVEFRONT);
                    LDS_WAIT(); asm volatile("" ::: "memory");
                    const unsigned cnt_e = H[lane];
                    unsigned base_e = 0u; if (cnt_e) base_e = atomicAdd(&CNT[64 * lane], cnt_e);
                    H[32 + lane] = base_e;
                    LDS_WAIT(); asm volatile("" ::: "memory");
                    const int m = m0 + lane;
#pragma unroll
                    for (int k = 0; k < 4; ++k) { const int ek = ti[k]; const int pos = (int)H[32 + ek] + rk[k];
                        TLIST[ek * LISTCAP + pos] = m; GLIST[ek * LISTCAP + pos] = gk[k]; TK_E[m * 4 + k] = ek; TK_POS[m * 4 + k] = pos; TK_G[m * 4 + k] = gk[k]; }
                }
            }
        } else {
            for (int m = blockIdx.x * 6 + (wave - 2); m < M; m += G * 6) rms_row_to_fp8(X2 + (size_t)m * D, norm_ffn, XN8 + (size_t)m * D, lane);
        }
            };
        body11_();
        if ((PROBE_REP >> 11) & 1) { GRID_BAR(); if (blockIdx.x == 0 && tid < NE) CNT[64 * tid] = 0u; GRID_BAR(); body11_(); }
    }
    SEAM(11);

#define LOAD_BASES() do { __syncthreads(); if (tid == 0) { int b_ = 0; for (int e_ = 0; e_ < NE; ++e_) { const int c_ = (int)__hip_atomic_load(&CNT[64 * e_], __ATOMIC_RELAXED, __HIP_MEMORY_SCOPE_AGENT); \
        smi[8192 + e_] = b_; smi[8256 + e_] = c_; b_ += (c_ + 255) & ~255; } } __syncthreads(); } while (0)

    LAS int* tb = (LAS int*)(L + 131072 + 1024);
#define LOAD_TB(npn) do { __syncthreads(); if (tid == 0) { int b_ = 0, cu_ = 0; for (int e_ = 0; e_ < NE; ++e_) { const int c_ = (int)__hip_atomic_load(&CNT[64 * e_], __ATOMIC_RELAXED, __HIP_MEMORY_SCOPE_AGENT); \
        tb[e_] = b_; tb[32 + e_] = c_; tb[64 + e_] = cu_; b_ += (c_ + 255) & ~255; cu_ += ((c_ + 255) >> 8) * (npn); } tb[96] = cu_; } __syncthreads(); } while (0)
    PHASE_L(12, {
        LOAD_TB(8);
        pg8::Gemm g{(const bf16_t*)XN8, (const bf16_t*)WGU8, 512, 512, 512}; pg8::MoeOrder S{tb, TLIST, G, xcu, 8, 512, 512, 2048};
        pg8::gemm_phase<pg8::EpiMoeGU, pg8::MoeOrder, true, true>(L, g, S, pg8::EpiMoeGU{ACT8, b_gate_up, WSCGU});
    });
    SEAM(12);
    PHASE_L(13, {
        LOAD_TB(4);
        pg8::Gemm g{(const bf16_t*)ACT8, (const bf16_t*)WD8, 512, 512, 512}; pg8::MoeOrder S{tb, TLIST, G, xcu, 4, 512, 512, 1024};
        pg8::gemm_phase<pg8::EpiMoeDown, pg8::MoeOrder, false, true>(L, g, S, pg8::EpiMoeDown{YB, b_down, GLIST, tb, WSCD});
    });
    SEAM(13);

    PHASE(14) {
        LOAD_BASES();
        for (int mb = gw; mb < M; mb += 8 * NGW) {
            int slotv = 0;
            { const int i = lane >> 2, k = lane & 3, m = mb + NGW * i; if (lane < 32 && m < M) slotv = smi[8192 + TK_E[m * 4 + k]] + TK_POS[m * 4 + k]; }
#pragma unroll 2
            for (int i = 0; i < 8; ++i) {
                const int m = mb + NGW * i; if (m >= M) break;
                const f32x4* xr = (const f32x4*)(X2 + (size_t)m * D) + lane; const f32x4* gr = (const f32x4*)norm_final + lane;
                f32x4 v[4];
#pragma unroll
                for (int j = 0; j < 4; ++j) v[j] = xr[64 * j];
#pragma unroll
                for (int k = 0; k < 4; ++k) { const int slot = __builtin_amdgcn_readlane(slotv, 4 * i + k); const v2u* yr = (const v2u*)(YB + (size_t)slot * D) + lane;
#pragma unroll
                    for (int j = 0; j < 4; ++j) { const v2u w = yr[64 * j]; v[j].x += lo16(w.x); v[j].y += hi16(w.x); v[j].z += lo16(w.y); v[j].w += hi16(w.y); } }
                float ss = 0.f;
#pragma unroll
                for (int j = 0; j < 4; ++j) ss += (v[j].x * v[j].x + v[j].y * v[j].y) + (v[j].z * v[j].z + v[j].w * v[j].w);
                const float rinv = 1.0f / sqrtf(wave_sum(ss) * (1.f / 1024.f) + NORM_EPS);
                f32x4* orow = (f32x4*)(args.out + (size_t)m * D) + lane;
#pragma unroll
                for (int j = 0; j < 4; ++j) { const f32x4 gg = gr[64 * j]; orow[64 * j] = (f32x4){v[j].x * rinv * gg.x, v[j].y * rinv * gg.y, v[j].z * rinv * gg.z, v[j].w * rinv * gg.w}; }
            }
        }
    }
    if (PROBE_STAMP >= 0) { STAMP_AT(15); if (blockIdx.x == PROBE_BLOCK) { const unsigned long long t1_ = __builtin_amdgcn_s_memrealtime(); while (__builtin_amdgcn_s_memrealtime() - t1_ < st_dt_) __builtin_amdgcn_s_sleep(8); } }
#undef IN
#undef SEAM
}

extern "C" void kernel_launch(void* const* d_in, const int* in_sizes, int n_in, void* d_out, int out_size, void* d_ws, size_t ws_size, hipStream_t stream) {
    static int grid = 0;
    if (grid == 0) {
        if (n_in != 26 || out_size != M * D || ws_size < WS_END) { fprintf(stderr, "kernel_launch: unexpected sizes n_in %d out %d ws %zu\n", n_in, out_size, ws_size); grid = -1; return; }
        int dev = 0, cus = 0;
        if (hipGetDevice(&dev) != hipSuccess || hipDeviceGetAttribute(&cus, hipDeviceAttributeMultiprocessorCount, dev) != hipSuccess) { grid = -1; return; }
        if (hipFuncSetAttribute((const void*)fwd, hipFuncAttributeMaxDynamicSharedMemorySize, LDS_BYTES) != hipSuccess) { fprintf(stderr, "kernel_launch: hipFuncSetAttribute failed\n"); grid = -1; return; }
        int per_cu = 0;
        (void)hipOccupancyMaxActiveBlocksPerMultiprocessor(&per_cu, (const void*)fwd, NTHR, LDS_BYTES);
        (void)hipGetLastError();
        grid = cus;
    }
    if (grid < 0) return;
    (void)hipMemsetAsync((char*)d_ws + WS_CTL, 0, CTL_ZERO_BYTES, stream);
    Args a{};
    for (int i = 0; i < 26; ++i) a.in[i] = d_in[i];
    a.out = (float*)d_out; a.ws = (unsigned char*)d_ws;
#if MK_PER_PHASE
    for (int p = 0; p < NPHASE; ++p) { a.ph_lo = p; a.ph_hi = p + 1; hipLaunchKernelGGL(fwd, dim3(grid), dim3(NTHR), LDS_BYTES, stream, a); }
#else
    a.ph_lo = 0; a.ph_hi = NPHASE; hipLaunchKernelGGL(fwd, dim3(grid), dim3(NTHR), LDS_BYTES, stream, a);
#endif
}
```

```cpp
#include <hip/hip_runtime.h>
#include <cstdio>
#include <cstdint>

#ifndef MK_PER_PHASE
#define MK_PER_PHASE 0
#endif

#ifndef PROBE_STAMP
#define PROBE_STAMP -1
#endif
#ifndef PROBE_BLOCK
#define PROBE_BLOCK 0
#endif
#ifndef PROBE_REP
#define PROBE_REP 0
#endif
#define GAS __attribute__((address_space(1)))
#define LAS __attribute__((address_space(3)))
typedef unsigned short bf16_t;
typedef unsigned v4u __attribute__((ext_vector_type(4)));
typedef unsigned v2u __attribute__((ext_vector_type(2)));
typedef float f32x4 __attribute__((ext_vector_type(4)));
typedef short bf16x8 __attribute__((ext_vector_type(8)));

constexpr int BATCH = 4, SEQ = 4096, D = 1024, M = BATCH * SEQ, NIN = 5120;
constexpr int MEMLEN = 256, MM = BATCH * MEMLEN;
constexpr int NE = 32, TOPK = 4, DFF = 1024;
constexpr float NORM_EPS = 1e-6f;
constexpr int C_SBQ = 0, C_SBK = 512, C_SBV = 1024, C_DQ = 1536, C_DK = 2048, C_DV = 2560, C_GSB = 3072, C_GDF = 4096;
constexpr int LISTCAP = 16384;
constexpr int SLOTS = 65536 + NE * 256;
constexpr int NWAVES = 8, NTHR = 512;

constexpr size_t MiB = 1u << 20;
constexpr size_t WS_CTL = 0, CTL_ZERO_BYTES = 1 * MiB;
constexpr size_t WS_WIN = 2 * MiB;
constexpr size_t WS_WUPSB = 12 * MiB;
constexpr size_t WS_WUPDF = 13 * MiB;
constexpr size_t WS_WOUT = 14 * MiB;
constexpr size_t WS_WMQ = 16 * MiB;
constexpr size_t WS_WMKV = 18 * MiB;
constexpr size_t WS_WMO = 22 * MiB;
constexpr size_t WS_ROPE = 24 * MiB;
constexpr size_t WS_TK = 28 * MiB;
constexpr size_t WS_WR = 29 * MiB;
constexpr size_t WS_WSC = 30 * MiB;
constexpr size_t WS_WGU = 32 * MiB;
constexpr size_t WS_WD = 160 * MiB;
constexpr size_t WS_XN = 224 * MiB;
constexpr size_t WS_PR = 256 * MiB;
constexpr size_t WS_OAT = 416 * MiB;
constexpr size_t WS_ODR = 448 * MiB;
constexpr size_t WS_MIX = 512 * MiB;
constexpr size_t WS_X1 = 544 * MiB;
constexpr size_t WS_X2 = 608 * MiB;
constexpr size_t WS_HM = 672 * MiB;
constexpr size_t WS_KVM = 674 * MiB;
constexpr size_t WS_TLIST = 678 * MiB;
constexpr size_t WS_GLIST = 680 * MiB;
constexpr size_t WS_QM = 682 * MiB;
constexpr size_t WS_OM = 714 * MiB;
constexpr size_t WS_ACT = 256 * MiB;
constexpr size_t WS_YB = 746 * MiB;
constexpr size_t WS_VTSB = 890 * MiB;
constexpr size_t WS_VTDF = 906 * MiB;
constexpr size_t WS_VTM = 922 * MiB;
constexpr size_t WS_END = 924 * MiB;
static_assert(WS_ACT + (size_t)SLOTS * 1024 * 2 <= WS_OAT, "ACT overlay");
static_assert(WS_YB + (size_t)SLOTS * 1024 * 2 <= WS_VTSB, "YB");
constexpr int CW_REDO = 16384;
constexpr int CW_SBQ = 6144;
constexpr int CW_CNT = 8192;
constexpr int CW_BAR = 1024;

constexpr int LDS_BYTES = 147456;
constexpr int MISC_OFF = 131072 + 320;

__device__ __forceinline__ float bf2f(bf16_t b) { return __uint_as_float(((unsigned)b) << 16); }
__device__ __forceinline__ unsigned f2bf(float f) { unsigned u = __float_as_uint(f); return (u + 0x7fffu + ((u >> 16) & 1u)) >> 16; }
__device__ __forceinline__ unsigned pk2(float lo, float hi) { return f2bf(lo) | (f2bf(hi) << 16); }
__device__ __forceinline__ unsigned pk4_fp8(float a, float b, float c, float d) { int w = 0; w = __builtin_amdgcn_cvt_pk_fp8_f32(a, b, w, false); w = __builtin_amdgcn_cvt_pk_fp8_f32(c, d, w, true); return (unsigned)w; }
__device__ __forceinline__ float lo16(unsigned w) { return __uint_as_float(w << 16); }
__device__ __forceinline__ float hi16(unsigned w) { return __uint_as_float(w & 0xffff0000u); }
#define LDS_WAIT() asm volatile("s_waitcnt lgkmcnt(0)" ::: "memory")
__device__ __forceinline__ float wave_sum(float v) {
#pragma unroll
    for (int o = 1; o < 64; o <<= 1) v += __shfl_xor(v, o);
    return v;
}
__device__ __forceinline__ float wave_max(float v) {
#pragma unroll
    for (int o = 1; o < 64; o <<= 1) v = fmaxf(v, __shfl_xor(v, o));
    return v;
}

#define XB_TMO      128
#define XB_XCNT(j)  (256  + 64 * (j))
#define XB_XSUB(j)  (1280 + 64 * (j))
#define XB_XGEN(j)  (2304 + 64 * (j))
#define XB_TOP      3328
#define XB_TOPGEN   3392
#define XCD_BAR_WORDS 3456
#define XB_SPIN_CAP (1u << 18)
__device__ __forceinline__ unsigned xb_ld(unsigned* p)              { return __hip_atomic_load(p, __ATOMIC_RELAXED, __HIP_MEMORY_SCOPE_AGENT); }
__device__ __forceinline__ unsigned xb_add(unsigned* p, unsigned v) { return __hip_atomic_fetch_add(p, v, __ATOMIC_RELAXED, __HIP_MEMORY_SCOPE_AGENT); }
__device__ __forceinline__ unsigned xb_xcc_id() { return (unsigned)__builtin_amdgcn_s_getreg((3 << 11) | 20) & 0xFu; }
#define XB_SPIN(cond, bar) do { unsigned _sp = 0; while (cond) { __builtin_amdgcn_s_sleep(1); \
    if ((++_sp & 255u) == 0u) { if (xb_ld(&(bar)[XB_TMO])) break; if (_sp > XB_SPIN_CAP) { atomicAdd(&(bar)[XB_TMO], 1u); break; } } } } while (0)
struct XcdBarrier { unsigned* bar; unsigned x; volatile LAS unsigned* st; };
__device__ __forceinline__ XcdBarrier xcd_barrier_post(unsigned* bar, volatile LAS unsigned* st) {
    XcdBarrier b; b.bar = bar; b.x = xb_xcc_id(); b.st = st;
    if (threadIdx.x == 0) (void)xb_add(&bar[XB_XCNT(b.x)], 1u);
    return b;
}
__device__ __forceinline__ void xcd_barrier_complete(unsigned* bar, unsigned x, unsigned& nloc, unsigned& nx) {
    const unsigned G = gridDim.x * gridDim.y * gridDim.z;
    unsigned sum, cnt, mine, sp = 0u;
    for (;;) {
        sum = 0u; cnt = 0u; mine = 0u;
#pragma unroll
        for (unsigned j = 0; j < 16; ++j) { const unsigned c = xb_ld(&bar[XB_XCNT(j)]); sum += c; cnt += (c > 0u) ? 1u : 0u; mine = (j == x) ? c : mine; }
        if (sum == G) break;
        __builtin_amdgcn_s_sleep(1);
        if ((++sp & 255u) == 0u) { if (xb_ld(&bar[XB_TMO])) break; if (sp > XB_SPIN_CAP) { atomicAdd(&bar[XB_TMO], 1u); break; } }
    }
    nloc = mine > 0u ? mine : 1u; nx = cnt > 0u ? cnt : 1u;
}
__device__ __forceinline__ void xcd_barrier(const XcdBarrier& b) {
    asm volatile("s_waitcnt vmcnt(0)" ::: "memory");
    __syncthreads();
    if (threadIdx.x == 0) {
        unsigned* bar = b.bar;
        __builtin_amdgcn_s_waitcnt(0);
        unsigned nloc = b.st[0], nx = b.st[1];
        if (nloc == 0u) { xcd_barrier_complete(bar, b.x, nloc, nx); b.st[0] = nloc; b.st[1] = nx; }
        const unsigned old = xb_add(&bar[XB_XSUB(b.x)], 1u);
        const unsigned gen = old / nloc;
        if (old + 1u == (gen + 1u) * nloc) {
            __builtin_amdgcn_fence(__ATOMIC_RELEASE, "agent");
            asm volatile("s_waitcnt vmcnt(0)" ::: "memory");
            const unsigned og = xb_add(&bar[XB_TOP], 1u);
            const unsigned tg = og / nx;
            if (og + 1u == (tg + 1u) * nx) xb_add(&bar[XB_TOPGEN], 1u);
            else XB_SPIN(xb_ld(&bar[XB_TOPGEN]) == tg, bar);
            __builtin_amdgcn_fence(__ATOMIC_ACQUIRE, "agent");
            xb_add(&bar[XB_XGEN(b.x)], 1u);
            asm volatile("s_waitcnt vmcnt(0)" ::: "memory");
        } else {
            XB_SPIN(xb_ld(&bar[XB_XGEN(b.x)]) == gen, bar);
            __builtin_amdgcn_fence(__ATOMIC_ACQUIRE, "agent");
            asm volatile("s_waitcnt vmcnt(0)" ::: "memory");
        }
    }
    __syncthreads();
}

__device__ __forceinline__ void p0_transpose_item(const float* W, int K, int N, bf16_t* WT, int drow0, int k0, int n0, LAS float* scr, int lane, const float* gain = nullptr, int ldw = 0, int koff = 0) {
    if (ldw == 0) ldw = K;
#pragma unroll 8
    for (int i = 0; i < 32; ++i) { const int kk = 2 * i + (lane >> 5); float v = W[(size_t)(k0 + kk) * N + n0 + (lane & 31)]; if (gain) v *= gain[k0 + kk]; scr[kk * 33 + (lane & 31)] = v; }
    LDS_WAIT(); asm volatile("" ::: "memory");
    const int c = lane & 7;
#pragma unroll
    for (int j = 0; j < 4; ++j) { const int n = (lane >> 3) + 8 * j; const LAS float* s = scr + (8 * c) * 33 + n;
        v4u o; o.x = pk2(s[0 * 33], s[1 * 33]); o.y = pk2(s[2 * 33], s[3 * 33]); o.z = pk2(s[4 * 33], s[5 * 33]); o.w = pk2(s[6 * 33], s[7 * 33]);
        *(v4u*)(WT + (size_t)(drow0 + n) * ldw + koff + k0 + 8 * c) = o; }
    LDS_WAIT(); asm volatile("" ::: "memory");
}
__device__ __forceinline__ void p0_plain(const float* W, int K, int N, bf16_t* WT, int item, LAS float* scr, int lane, const float* gain = nullptr, int ldw = 0, int koff = 0) {
    const int nblk = N / 32, kb = item / nblk, nb = item % nblk;
    p0_transpose_item(W, K, N, WT, 32 * nb, 64 * kb, 32 * nb, scr, lane, gain, ldw, koff);
}
__device__ __forceinline__ void p0_transpose_rope(const float* W, bf16_t* WT, int tilebase, int o, int k0, int n0, LAS float* scr, int lane) {
    const int K = 1024, N = NIN;
#pragma unroll 8
    for (int i = 0; i < 32; ++i) { const int kk = 2 * i + (lane >> 5); scr[kk * 33 + (lane & 31)] = W[(size_t)(k0 + kk) * N + n0 + (lane & 31)]; }
    LDS_WAIT(); asm volatile("" ::: "memory");
    const int c = lane & 7;
#pragma unroll
    for (int j = 0; j < 4; ++j) { const int n = (lane >> 3) + 8 * j; const LAS float* s = scr + (8 * c) * 33 + n;
        const int oo = o + n, v = ((oo >> 6) << 6) | (((oo >> 4) & 1) << 5) | (((oo >> 2) & 3) << 3) | (((oo >> 5) & 1) << 2) | (oo & 3);
        v4u w; w.x = pk2(s[0 * 33], s[1 * 33]); w.y = pk2(s[2 * 33], s[3 * 33]); w.z = pk2(s[4 * 33], s[5 * 33]); w.w = pk2(s[6 * 33], s[7 * 33]);
        *(v4u*)(WT + (size_t)(tilebase + v) * K + k0 + 8 * c) = w; }
    LDS_WAIT(); asm volatile("" ::: "memory");
}
__device__ __forceinline__ void rms_row_to_bf16(const float* xrow, const float* g, bf16_t* orow, int lane) {
    const f32x4* xr = (const f32x4*)xrow + lane; const f32x4* gr = (const f32x4*)g + lane;
    f32x4 v[4]; float s = 0.f;
#pragma unroll
    for (int j = 0; j < 4; ++j) { v[j] = xr[64 * j]; s += (v[j].x * v[j].x + v[j].y * v[j].y) + (v[j].z * v[j].z + v[j].w * v[j].w); }
    const float rinv = 1.0f / sqrtf(wave_sum(s) * (1.f / 1024.f) + NORM_EPS);
    v2u* o8 = (v2u*)orow + lane;
#pragma unroll
    for (int j = 0; j < 4; ++j) { const f32x4 gg = gr[64 * j]; v2u w; w.x = pk2(v[j].x * rinv * gg.x, v[j].y * rinv * gg.y); w.y = pk2(v[j].z * rinv * gg.z, v[j].w * rinv * gg.w); o8[64 * j] = w; }
}

__device__ __forceinline__ void rms_row_to_fp8(const float* xrow, const float* g, unsigned char* orow, int lane) {
    const f32x4* xr = (const f32x4*)xrow + lane; const f32x4* gr = (const f32x4*)g + lane;
    f32x4 v[4]; float s = 0.f;
#pragma unroll
    for (int j = 0; j < 4; ++j) { v[j] = xr[64 * j]; s += (v[j].x * v[j].x + v[j].y * v[j].y) + (v[j].z * v[j].z + v[j].w * v[j].w); }
    const float rinv = 1.0f / sqrtf(wave_sum(s) * (1.f / 1024.f) + NORM_EPS);
    unsigned* o4 = (unsigned*)orow + lane;
#pragma unroll
    for (int j = 0; j < 4; ++j) { const f32x4 gg = gr[64 * j]; o4[64 * j] = pk4_fp8(v[j].x * rinv * gg.x, v[j].y * rinv * gg.y, v[j].z * rinv * gg.z, v[j].w * rinv * gg.w); }
}
namespace pg8 {
constexpr int BM = 256, BK = 64, HALF = 128, HTB = HALF * BK * 2, STAGE_BYTES = 8 * HTB;
__host__ __device__ __forceinline__ int lds_byte(int r, int c) { const int st = (r >> 4) * 2 + (c >> 5), rr = r & 15, cc = c & 31, ob = rr * 64 + cc * 2; return st * 1024 + (ob ^ (((ob >> 9) & 1) << 5)); }
__host__ __device__ __forceinline__ void stage_rc(int b, int& R, int& C) { const int st = b / 1024, sb = b % 1024, swz = sb ^ (((sb >> 9) & 1) << 5); R = (st >> 1) * 16 + swz / 64; C = (st & 1) * 32 + (swz % 64) / 2; }
__host__ __device__ __forceinline__ int perm32(int rho) { const int n = rho >> 4, i = rho & 15; return 8 * (i >> 2) + 4 * n + (i & 3); }
struct Unit { int pm, pn, e; };
struct Gemm { const bf16_t* A; const bf16_t* Bt; int lda, ldb, K; };
typedef float f32x2 __attribute__((ext_vector_type(2))); typedef __bf16 bf16x2_t __attribute__((ext_vector_type(2)));
__device__ __forceinline__ unsigned cvt_pk_bf16(float lo, float hi) { f32x2 v = {lo, hi}; bf16x2_t b = __builtin_convertvector(v, bf16x2_t); return __builtin_bit_cast(unsigned, b); }

typedef int v8i __attribute__((ext_vector_type(8))); typedef int v4i __attribute__((ext_vector_type(4)));
__device__ __forceinline__ v8i cat8(bf16x8 a, bf16x8 b) { return __builtin_shufflevector(__builtin_bit_cast(v4i, a), __builtin_bit_cast(v4i, b), 0, 1, 2, 3, 4, 5, 6, 7); }
template <class Epi, class Sched, bool GATHER, bool FP8 = false>
__device__ __forceinline__ void gemm_phase(LAS unsigned char* lds, const Gemm g, const Sched& S, const Epi& E) {
    const int tid = threadIdx.x, wid = __builtin_amdgcn_readfirstlane(tid >> 6), lane = tid & 63, wr = wid >> 2, wc = wid & 3, fr = lane & 15, fq = lane >> 4;
    const int K = g.K, nt = K / BK;
    unsigned voffB[2], cva[2][2], nva[2][2];
#pragma unroll
    for (int i = 0; i < 2; ++i) { int R, C; stage_rc(tid * 16 + i * 8192, R, C); const int Rb = (R & ~31) + perm32(R & 31);
        voffB[i] = (unsigned)(Rb * g.ldb + C) * 2u;
#pragma unroll
        for (int h = 0; h < 2; ++h) { cva[h][i] = (unsigned)((h * HALF + R) * g.lda + C) * 2u; nva[h][i] = cva[h][i]; } }
    const unsigned kstep = (unsigned)(BK * 2);
    const unsigned hstepB = (unsigned)(HALF * g.ldb * 2);
    auto uni_ptr = [](const void* p_) { const unsigned long long v_ = (unsigned long long)p_; return (void*)(((unsigned long long)(unsigned)__builtin_amdgcn_readfirstlane((int)(v_ >> 32)) << 32) | (unsigned)__builtin_amdgcn_readfirstlane((int)v_)); };
    const auto rA = __builtin_amdgcn_make_buffer_rsrc(uni_ptr(g.A), 0, 0x7fffffff, 0x00020000), rB = __builtin_amdgcn_make_buffer_rsrc(uni_ptr(g.Bt), 0, 0x7fffffff, 0x00020000);
    const unsigned ldsw = (unsigned)wid * 1024u;
    const int aoff = lds_byte(wr * 64 + fr, fq * 8), boff = lds_byte(wc * 32 + fr, fq * 8);
#define PG8_SA(b, h) (((b) * 2 + (h)) * HTB)
#define PG8_SB(b, h) ((4 + (b) * 2 + (h)) * HTB)
#define PG8_STAGE(bufoff, rs, soff, voff) do { _Pragma("unroll") for (int _i = 0; _i < 2; ++_i) \
        __builtin_amdgcn_raw_ptr_buffer_load_lds(rs, (LAS unsigned*)(lds + (bufoff) + ldsw + _i * 8192), 16, (int)(voff)[_i], (int)(soff), 0, 0); } while (0)
#define PG8_LDA(dst, b, h) do { _Pragma("unroll") for (int m = 0; m < 4; ++m) _Pragma("unroll") for (int k = 0; k < 2; ++k) dst[m][k] = *(const LAS bf16x8*)(lds + PG8_SA(b, h) + aoff + m * 2048 + k * 1024); } while (0)
#define PG8_LDB(dst, b, h) do { _Pragma("unroll") for (int n = 0; n < 2; ++n) _Pragma("unroll") for (int k = 0; k < 2; ++k) dst[n][k] = *(const LAS bf16x8*)(lds + PG8_SB(b, h) + boff + n * 2048 + k * 1024); } while (0)
#define PG8_MMA(ai, bj, At, Bt) do { __builtin_amdgcn_s_setprio(1); _Pragma("unroll") for (int m = 0; m < 4; ++m) _Pragma("unroll") for (int n = 0; n < 2; ++n) { \
        if constexpr (FP8) { const v8i b8_ = cat8(Bt[n][0], Bt[n][1]), a8_ = cat8(At[m][0], At[m][1]); \
            asm volatile("s_nop 1\n\tv_mfma_scale_f32_16x16x128_f8f6f4 %0, %1, %2, %0, %3, %3 op_sel_hi:[0,0,0]" : "+v"(acc[ai][bj][m][n]) : "v"(b8_), "v"(a8_), "v"(one_scale)); } \
        else { _Pragma("unroll") for (int k = 0; k < 2; ++k) acc[ai][bj][m][n] = __builtin_amdgcn_mfma_f32_16x16x32_bf16(Bt[n][k], At[m][k], acc[ai][bj][m][n], 0, 0, 0); } } __builtin_amdgcn_s_setprio(0); } while (0)
#define PG8_WAIT_V(n) asm volatile("s_waitcnt vmcnt(" #n ")" ::: "memory")
#define PG8_WAIT_L(n) asm volatile("s_waitcnt lgkmcnt(" #n ")" ::: "memory")
#define PG8_BAR __builtin_amdgcn_s_barrier()
#define PG8_SCHED __builtin_amdgcn_sched_barrier(0)
    Unit cur, nxt; int ui = 0;
    if (!S.next(0, cur)) return;
    if constexpr (GATHER) {
#pragma unroll
        for (int i = 0; i < 2; ++i) { int R, C; stage_rc(tid * 16 + i * 8192, R, C);
#pragma unroll
            for (int h = 0; h < 2; ++h) cva[h][i] = (unsigned)(S.tok(cur, h * HALF + R) * g.lda + C) * 2u; }
    }
    const int one_scale = 0x7f7f7f7f;
    (void)one_scale;
    f32x4 acc[2][2][4][2];
#pragma unroll
    for (int a = 0; a < 2; ++a)
#pragma unroll
        for (int b = 0; b < 2; ++b)
#pragma unroll
            for (int m = 0; m < 4; ++m)
#pragma unroll
                for (int n = 0; n < 2; ++n) acc[a][b][m][n] = (f32x4){0.f, 0.f, 0.f, 0.f};
    bf16x8 At[4][2], B0[2][2], B1[2][2];
    unsigned cA = GATHER ? 0u : (unsigned)S.a_off(cur), cB = (unsigned)S.b_off(cur);
    PG8_STAGE(PG8_SB(0, 0), rB, cB, voffB); PG8_STAGE(PG8_SB(0, 1), rB, cB + hstepB, voffB); PG8_STAGE(PG8_SA(0, 0), rA, cA, cva[0]); PG8_STAGE(PG8_SA(0, 1), rA, cA, cva[1]);
    if (wr == 1) PG8_BAR;
    PG8_WAIT_V(2); PG8_BAR;
    PG8_STAGE(PG8_SB(1, 0), rB, cB + kstep, voffB); PG8_STAGE(PG8_SA(1, 0), rA, cA + kstep, cva[0]); PG8_STAGE(PG8_SB(1, 1), rB, cB + hstepB + kstep, voffB);
    PG8_WAIT_V(6); PG8_BAR;
    for (;;) {
        const bool has_next = S.next(ui + 1, nxt);
        const unsigned nA = (has_next && !GATHER) ? (unsigned)S.a_off(nxt) : cA, nB = has_next ? (unsigned)S.b_off(nxt) : cB;
        if constexpr (GATHER) {
#pragma unroll
            for (int i = 0; i < 2; ++i) { int R, C; stage_rc(tid * 16 + i * 8192, R, C);
#pragma unroll
                for (int h = 0; h < 2; ++h) nva[h][i] = has_next ? (unsigned)(S.tok(nxt, h * HALF + R) * g.lda + C) * 2u : cva[h][i]; }
        }
#pragma nounroll
        for (int t = 0; t < nt; t += 2) {
            const bool last = (t == nt - 2);
            const unsigned a1 = cA + (unsigned)(t + 1) * kstep;
            const unsigned a2 = last ? nA : cA + (unsigned)(t + 2) * kstep, b2 = last ? nB : cB + (unsigned)(t + 2) * kstep;
            const unsigned a3 = a2 + kstep, b3 = b2 + kstep;
            PG8_LDB(B0, 0, 0); PG8_LDB(B1, 0, 1); PG8_SCHED; PG8_LDA(At, 0, 0); PG8_STAGE(PG8_SA(1, 1), rA, a1, cva[1]);
            if constexpr (GATHER) { if (last) {
#pragma unroll
                for (int h = 0; h < 2; ++h)
#pragma unroll
                    for (int i = 0; i < 2; ++i) cva[h][i] = nva[h][i]; } }
            PG8_WAIT_V(8); PG8_WAIT_L(0); PG8_BAR; PG8_MMA(0, 0, At, B0); PG8_MMA(0, 1, At, B1); PG8_BAR; PG8_SCHED;
            PG8_LDA(At, 0, 1); PG8_STAGE(PG8_SB(0, 0), rB, b2, voffB); PG8_STAGE(PG8_SB(0, 1), rB, b2 + hstepB, voffB); PG8_STAGE(PG8_SA(0, 0), rA, a2, cva[0]);
            PG8_WAIT_V(8); PG8_WAIT_L(0); PG8_BAR; PG8_MMA(1, 0, At, B0); PG8_MMA(1, 1, At, B1); PG8_BAR; PG8_SCHED;
            PG8_LDB(B0, 1, 0); PG8_LDB(B1, 1, 1); PG8_SCHED; PG8_LDA(At, 1, 0); PG8_STAGE(PG8_SA(0, 1), rA, a2, cva[1]);
            PG8_WAIT_V(8); PG8_WAIT_L(0); PG8_BAR; PG8_MMA(0, 0, At, B0); PG8_MMA(0, 1, At, B1); PG8_BAR; PG8_SCHED;
            PG8_LDA(At, 1, 1); PG8_STAGE(PG8_SB(1, 0), rB, b3, voffB); PG8_STAGE(PG8_SB(1, 1), rB, b3 + hstepB, voffB); PG8_STAGE(PG8_SA(1, 0), rA, a3, cva[0]);
            PG8_WAIT_V(8); PG8_WAIT_L(0); PG8_BAR; PG8_MMA(1, 0, At, B0); PG8_MMA(1, 1, At, B1); PG8_BAR; PG8_SCHED;
        }
        if (wr == 0) PG8_BAR;
        if constexpr (FP8) asm volatile("s_nop 15\n\ts_nop 7" ::: "memory");
        E(acc, cur, wr, wc, fr, fq);
        if (!has_next) break;
#pragma unroll
        for (int a = 0; a < 2; ++a)
#pragma unroll
            for (int b = 0; b < 2; ++b)
#pragma unroll
                for (int m = 0; m < 4; ++m)
#pragma unroll
                    for (int n = 0; n < 2; ++n) acc[a][b][m][n] = (f32x4){0.f, 0.f, 0.f, 0.f};
        cur = nxt; cA = nA; cB = nB; ++ui;
        if constexpr (GATHER) {
#pragma unroll
            for (int i = 0; i < 2; ++i)
#pragma unroll
                for (int h = 0; h < 2; ++h) cva[h][i] = nva[h][i];
        }
        if (wr == 1) PG8_BAR;
    }
    PG8_WAIT_V(0);
    PG8_BAR;
#undef PG8_SA
#undef PG8_SB
#undef PG8_STAGE
#undef PG8_LDA
#undef PG8_LDB
#undef PG8_MMA
#undef PG8_WAIT_V
#undef PG8_WAIT_L
#undef PG8_BAR
#undef PG8_SCHED
}

struct DenseOrder {
    int nM, nN, nwg, G, c, lda, ldb, i0 = 0, i1 = 1 << 30;
    __device__ __forceinline__ void init(int M_, int N_, int G_, int c_, int lda_, int ldb_) { nM = M_ / BM; nN = N_ / BM; nwg = nM * nN; G = G_; c = c_; lda = lda_; ldb = ldb_; }
    __device__ __forceinline__ bool next(int i, Unit& u) const {
        if (i + i0 >= i1) return false;
        const long L = (long)(i + i0) * G + c; if (L >= nwg) return false;
        int wgid = (int)L; { const int q = nwg / 8, r = nwg % 8, xcd = wgid % 8, off = wgid / 8; wgid = (xcd < r ? xcd * (q + 1) : r * (q + 1) + (xcd - r) * q) + off; }
        const int nig = 8 * nN, gid = wgid / nig, fm = gid * 8, gsz = (nM - fm) < 8 ? (nM - fm) : 8;
        u.pm = fm + ((wgid % nig) % gsz); u.pn = (wgid % nig) / gsz; u.e = 0; return true;
    }
    __device__ __forceinline__ size_t a_off(const Unit& u) const { return (size_t)u.pm * BM * lda * 2; }
    __device__ __forceinline__ size_t b_off(const Unit& u) const { return (size_t)u.pn * BM * ldb * 2; }
    __device__ __forceinline__ int tok(const Unit&, int) const { return 0; }
};
struct TwoRoundOrder {
    int G, c, lda, ldb;
    __device__ __forceinline__ bool next(int i, Unit& u) const { const int L = i * G + c; if (L >= 512) return false; const int tile = L & 255; u.pm = tile >> 2; u.pn = tile & 3; u.e = L >> 8; return true; }
    __device__ __forceinline__ size_t a_off(const Unit& u) const { return (size_t)u.pm * BM * lda * 2 + (size_t)u.e * 1024; }
    __device__ __forceinline__ size_t b_off(const Unit& u) const { return (size_t)(u.e * 1024 + u.pn * BM) * ldb * 2; }
    __device__ __forceinline__ int tok(const Unit&, int) const { return 0; }
};
struct MoeOrder {
    const LAS int* tb; const int* tlist; int G, c, npn, lda, ldb, nexp;
    __device__ __forceinline__ bool next(int i, Unit& u) const {
        const int L = i * G + c; if (L >= tb[96]) return false;
        int e = 0; while (tb[65 + e] <= L) ++e;
        const int loc = L - tb[64 + e]; u.e = __builtin_amdgcn_readfirstlane(e); u.pn = __builtin_amdgcn_readfirstlane(loc % npn); u.pm = __builtin_amdgcn_readfirstlane((tb[e] >> 8) + loc / npn); return true;
    }
    __device__ __forceinline__ size_t a_off(const Unit& u) const { return (size_t)u.pm * BM * lda * 2; }
    __device__ __forceinline__ size_t b_off(const Unit& u) const { return (size_t)(u.e * nexp + u.pn * BM) * ldb * 2; }
    __device__ __forceinline__ int tok(const Unit& u, int row) const { const int r = u.pm * BM - tb[u.e] + row; return r < tb[32 + u.e] ? tlist[u.e * LISTCAP + r] : 0; }
};

#define EPI_ARGS const f32x4 (&acc)[2][2][4][2], const Unit& u, int wr, int wc, int fr, int fq
#define EPI_FOR_ROWS for (int ai = 0; ai < 2; ++ai) _Pragma("unroll") for (int m = 0; m < 4; ++m)
__device__ __forceinline__ v4u pack8(const f32x4 a, const f32x4 b) { v4u w; w.x = cvt_pk_bf16(a[0], a[1]); w.y = cvt_pk_bf16(a[2], a[3]); w.z = cvt_pk_bf16(b[0], b[1]); w.w = cvt_pk_bf16(b[2], b[3]); return w; }
__device__ __forceinline__ void unpack8(const v4u w, f32x4& a, f32x4& b) { a = (f32x4){lo16(w.x), hi16(w.x), lo16(w.y), hi16(w.y)}; b = (f32x4){lo16(w.z), hi16(w.z), lo16(w.w), hi16(w.w)}; }
__device__ __forceinline__ float sigm(float v) { return __builtin_amdgcn_rcpf(1.f + __expf(-v)); }

__device__ __forceinline__ void store_tile_T(const f32x4 (&acc)[2][2][4][2], bf16_t* VT, int vrow0, int s0, int pitch) {
#pragma unroll
    for (int bj = 0; bj < 2; ++bj)
#pragma unroll
        for (int n = 0; n < 2; ++n)
#pragma unroll
            for (int e = 0; e < 4; ++e) { bf16_t* vp = VT + (size_t)(vrow0 + 128 * bj + 4 * n + e) * pitch + ((s0 & ~12) | ((s0 & 8) >> 1) | ((s0 & 4) << 1));
#pragma unroll
                for (int ai = 0; ai < 2; ++ai)
#pragma unroll
                    for (int m = 0; m < 4; ++m) vp[128 * ai + 16 * m] = (bf16_t)(cvt_pk_bf16(acc[ai][bj][m][n][e], 0.f) & 0xffffu); }
}
struct EpiKV { static constexpr bool MIDHOOK = false; bf16_t* KVM; bf16_t* VTM;
    __device__ __forceinline__ void operator()(EPI_ARGS) const {
        const int row0 = u.pm * BM + wr * 64 + fr, col0 = u.pn * BM + wc * 32 + 8 * fq;
#pragma unroll
        EPI_FOR_ROWS { bf16_t* rowp = KVM + (size_t)(row0 + ai * HALF + m * 16) * 2048 + col0;
#pragma unroll
            for (int bj = 0; bj < 2; ++bj) *(v4u*)(rowp + bj * HALF) = pack8(acc[ai][bj][m][0], acc[ai][bj][m][1]); }
        if (u.pn >= 4) store_tile_T(acc, VTM, u.pm * 1024 + (u.pn - 4) * BM + wc * 32 + 8 * fq, wr * 64 + fr, MEMLEN);
    } };
struct EpiResidNorm { static constexpr bool MIDHOOK = false; const float* base; float* out; bf16_t* XB; float* SSQ;
    __device__ __forceinline__ void operator()(EPI_ARGS) const {
        const int row0 = u.pm * BM + wr * 64 + fr, col0 = u.pn * BM + wc * 32 + 8 * fq;
#pragma unroll
        EPI_FOR_ROWS { const int row = row0 + ai * HALF + m * 16; const size_t off = (size_t)row * D + col0; float ss = 0.f;
#pragma unroll
            for (int bj = 0; bj < 2; ++bj) { f32x4 v[2];
#pragma unroll
                for (int n = 0; n < 2; ++n) { v[n] = *(const f32x4*)(base + off + bj * HALF + 4 * n) + acc[ai][bj][m][n];
                    ss += (v[n][0] * v[n][0] + v[n][1] * v[n][1]) + (v[n][2] * v[n][2] + v[n][3] * v[n][3]); }
                *(v4u*)(XB + off + bj * HALF) = pack8(v[0], v[1]); }
            ss += __shfl_xor(ss, 16); ss += __shfl_xor(ss, 32);
            if (fq == 0) SSQ[(size_t)row * 16 + u.pn * 4 + wc] = ss; }
    } };
struct EpiBf16Rinv { static constexpr bool MIDHOOK = false; bf16_t* O; const float* SSQ; float qscale;
    __device__ __forceinline__ void operator()(EPI_ARGS) const {
        const int row0 = u.pm * BM + wr * 64 + fr, col0 = u.pn * BM + wc * 32 + 8 * fq;
#pragma unroll
        EPI_FOR_ROWS { const int row = row0 + ai * HALF + m * 16; const f32x4* sp = (const f32x4*)(SSQ + (size_t)row * 16);
            const f32x4 s0 = sp[0], s1 = sp[1], s2 = sp[2], s3 = sp[3];
            const float tot = (((s0[0] + s0[1]) + (s0[2] + s0[3])) + ((s1[0] + s1[1]) + (s1[2] + s1[3]))) + (((s2[0] + s2[1]) + (s2[2] + s2[3])) + ((s3[0] + s3[1]) + (s3[2] + s3[3])));
            const float rinv = qscale / sqrtf(tot * (1.f / 1024.f) + NORM_EPS);
            bf16_t* rowp = O + (size_t)row * D + col0;
#pragma unroll
            for (int bj = 0; bj < 2; ++bj) *(v4u*)(rowp + bj * HALF) = pack8(acc[ai][bj][m][0] * rinv, acc[ai][bj][m][1] * rinv); }
    } };
struct OneUnitOrder {
    int idx, lda, ldb;
    __device__ __forceinline__ bool next(int i, Unit& u) const { if (i > 0) return false; u.pm = idx >> 3; u.pn = idx & 7; u.e = 0; return true; }
    __device__ __forceinline__ size_t a_off(const Unit& u) const { return (size_t)u.pm * BM * lda * 2; }
    __device__ __forceinline__ size_t b_off(const Unit& u) const { return (size_t)u.pn * BM * ldb * 2; }
    __device__ __forceinline__ int tok(const Unit&, int) const { return 0; }
};
struct EpiResidB { static constexpr bool MIDHOOK = false; const bf16_t* base; float* out;
    __device__ __forceinline__ void operator()(EPI_ARGS) const {
        const int row0 = u.pm * BM + wr * 64 + fr, col0 = u.pn * BM + wc * 32 + 8 * fq;
#pragma unroll
        EPI_FOR_ROWS { const size_t off = (size_t)(row0 + ai * HALF + m * 16) * D + col0;
#pragma unroll
            for (int bj = 0; bj < 2; ++bj) { f32x4 b0, b1; unpack8(*(const v4u*)(base + off + bj * HALF), b0, b1);
                *(f32x4*)(out + off + bj * HALF) = b0 + acc[ai][bj][m][0]; *(f32x4*)(out + off + bj * HALF + 4) = b1 + acc[ai][bj][m][1]; } }
    } };
struct EpiGate { static constexpr bool MIDHOOK = false; const bf16_t* PR; bf16_t* T; bf16_t* MIX;
    __device__ __forceinline__ void operator()(EPI_ARGS) const {
        const int row0 = u.pm * BM + wr * 64 + fr, col0 = u.pn * BM + wc * 32 + 8 * fq;
#pragma unroll
        EPI_FOR_ROWS { const int row = row0 + ai * HALF + m * 16;
#pragma unroll
            for (int bj = 0; bj < 2; ++bj) { const int col = col0 + bj * HALF; f32x4 g0, g1;
                unpack8(*(const v4u*)(PR + (size_t)row * NIN + (u.e ? C_GDF : C_GSB) + col), g0, g1);
                bf16_t* tp = T + (size_t)row * D + col;
                if (u.e == 0) *(v4u*)tp = pack8(g0 * acc[ai][bj][m][0], g1 * acc[ai][bj][m][1]);
                else { f32x4 t0, t1; unpack8(*(const v4u*)tp, t0, t1); *(v4u*)(MIX + (size_t)row * D + col) = pack8(t0 + g0 * acc[ai][bj][m][0], t1 + g1 * acc[ai][bj][m][1]); } } }
    } };
struct EpiInProj { static constexpr bool MIDHOOK = false; bf16_t* PR; const float* rc; const float* rs; bf16_t* VTSB; bf16_t* VTDF;
    __device__ __forceinline__ void operator()(EPI_ARGS) const {
        const int row0 = u.pm * BM + wr * 64 + fr, pn = u.pn;
        if (pn >= 6 && pn < 10) {
            const float sc = pn < 8 ? 0.125f * 1.4426950408889634f : 1.0f; const int i0 = 16 * (wc & 1) + 4 * fq;
#pragma unroll
            EPI_FOR_ROWS { const int row = row0 + ai * HALF + m * 16; const f32x4 cs = *(const f32x4*)(rc + (size_t)row * 32 + i0), sn = *(const f32x4*)(rs + (size_t)row * 32 + i0);
#pragma unroll
                for (int bj = 0; bj < 2; ++bj) { const f32x4 lo = acc[ai][bj][m][0], hi = acc[ai][bj][m][1];
                    const f32x4 olo = (lo * cs - hi * sn) * sc, ohi = (hi * cs + lo * sn) * sc;
                    bf16_t* p = PR + (size_t)row * NIN + pn * BM + 64 * (2 * bj + (wc >> 1)) + i0;
                    v2u a, b; a.x = cvt_pk_bf16(olo[0], olo[1]); a.y = cvt_pk_bf16(olo[2], olo[3]); b.x = cvt_pk_bf16(ohi[0], ohi[1]); b.y = cvt_pk_bf16(ohi[2], ohi[3]);
                    *(v2u*)p = a; *(v2u*)(p + 32) = b; } }
        } else {
            const int col0 = pn * BM + wc * 32 + 8 * fq; const float sc = pn < 2 ? 0.125f * 1.4426950408889634f : 1.0f; const bool sg = pn >= 12;
            const bool vt = (pn == 4 || pn == 5 || pn == 10 || pn == 11);
            if (!vt) {
#pragma unroll
            EPI_FOR_ROWS { bf16_t* rowp = PR + (size_t)(row0 + ai * HALF + m * 16) * NIN + col0;
#pragma unroll
                for (int bj = 0; bj < 2; ++bj) { f32x4 v0 = acc[ai][bj][m][0] * sc, v1 = acc[ai][bj][m][1] * sc;
                    if (sg) { v0 = (f32x4){sigm(v0[0]), sigm(v0[1]), sigm(v0[2]), sigm(v0[3])}; v1 = (f32x4){sigm(v1[0]), sigm(v1[1]), sigm(v1[2]), sigm(v1[3])}; }
                    *(v4u*)(rowp + bj * HALF) = pack8(v0, v1); } }
            } else {
                const int bb = u.pm >> 4, s0 = (u.pm & 15) * BM + wr * 64 + fr, hd0 = (pn < 6 ? (pn - 4) : (pn - 10)) * BM + wc * 32 + 8 * fq;
                store_tile_T(acc, pn < 6 ? VTSB : VTDF, bb * 512 + hd0, s0, SEQ);
            }
        }
    } };
struct EpiMoeGU { static constexpr bool MIDHOOK = false; unsigned char* ACT8; const float* bgu; const float* wsc;
    __device__ __forceinline__ void operator()(EPI_ARGS) const {
        const int row0 = u.pm * BM + wr * 64 + fr, j0 = u.pn * 128 + wc * 32 + 8 * fq; const float* bg = bgu + (size_t)u.e * 2048 + j0; const float* sg = wsc + (size_t)u.e * 2048 + j0;
#pragma unroll
        EPI_FOR_ROWS { f32x4 o[2];
#pragma unroll
            for (int n = 0; n < 2; ++n) { const f32x4 gv = acc[ai][0][m][n] * *(const f32x4*)(sg + 4 * n) + *(const f32x4*)(bg + 4 * n), lv = acc[ai][1][m][n] * *(const f32x4*)(sg + 1024 + 4 * n) + *(const f32x4*)(bg + 1024 + 4 * n);
#pragma unroll
                for (int c = 0; c < 4; ++c) { const float gl = fminf(gv[c], 7.0f), li = fminf(fmaxf(lv[c], -7.0f), 7.0f); o[n][c] = gl * sigm(1.702f * gl) * (li + 1.0f); } }
            v2u w; w.x = pk4_fp8(o[0][0], o[0][1], o[0][2], o[0][3]); w.y = pk4_fp8(o[1][0], o[1][1], o[1][2], o[1][3]);
            *(v2u*)(ACT8 + (size_t)(row0 + ai * HALF + m * 16) * DFF + j0) = w; }
    } };
struct EpiMoeDown { static constexpr bool MIDHOOK = false; bf16_t* YB; const float* bd; const float* glist; const LAS int* tb; const float* wsc;
    __device__ __forceinline__ void operator()(EPI_ARGS) const {
        const int row0 = u.pm * BM + wr * 64 + fr, col0 = u.pn * BM + wc * 32 + 8 * fq; const float* bp = bd + (size_t)u.e * D + col0; const float* sp = wsc + (size_t)u.e * D + col0;
        const float* gl = glist + (size_t)u.e * LISTCAP - tb[u.e];
        f32x4 bv[2][2], sv[2][2];
#pragma unroll
        for (int bj = 0; bj < 2; ++bj)
#pragma unroll
            for (int n = 0; n < 2; ++n) { bv[bj][n] = *(const f32x4*)(bp + bj * HALF + 4 * n); sv[bj][n] = *(const f32x4*)(sp + bj * HALF + 4 * n); }
#pragma unroll
        EPI_FOR_ROWS { const int row = row0 + ai * HALF + m * 16; const float gt = gl[row];
#pragma unroll
            for (int bj = 0; bj < 2; ++bj) *(v4u*)(YB + (size_t)row * D + col0 + bj * HALF) = pack8((acc[ai][bj][m][0] * sv[bj][0] + bv[bj][0]) * gt, (acc[ai][bj][m][1] * sv[bj][1] + bv[bj][1]) * gt); }
    } };
}


typedef float f32x16 __attribute__((ext_vector_type(16)));
typedef short s16x4 __attribute__((ext_vector_type(4)));
__device__ __forceinline__ f32x16 mfma32(bf16x8 a, bf16x8 b, f32x16 c) { return __builtin_amdgcn_mfma_f32_32x32x16_bf16(a, b, c, 0, 0, 0); }
__device__ __forceinline__ float xhalf(float v, int hh) { auto rr = __builtin_amdgcn_permlane32_swap(__float_as_uint(v), __float_as_uint(v), false, false); return __uint_as_float(hh ? rr[0] : rr[1]); }
__device__ __forceinline__ bf16x8 pack_p(const f32x16& p, int s) { v4u w; w.x = pg8::cvt_pk_bf16(p[8 * s + 0], p[8 * s + 1]); w.y = pg8::cvt_pk_bf16(p[8 * s + 2], p[8 * s + 3]); w.z = pg8::cvt_pk_bf16(p[8 * s + 4], p[8 * s + 5]); w.w = pg8::cvt_pk_bf16(p[8 * s + 6], p[8 * s + 7]); return __builtin_bit_cast(bf16x8, w); }
constexpr float LOG2E = 1.4426950408889634f;

constexpr int VSTR = 136;
template <int NCH> __device__ __forceinline__ void stage_load(v4u (&r)[NCH], const bf16_t* g0, int chunks_per_row, size_t gpitch, int tid) {
#pragma unroll
    for (int i = 0; i < NCH; ++i) { const int c = tid + NTHR * i, row = c / chunks_per_row, ch = c % chunks_per_row; r[i] = *(const v4u*)(g0 + (size_t)row * gpitch + ch * 8); }
}
template <int NCH> __device__ __forceinline__ void stage_store_k(const v4u (&r)[NCH], LAS unsigned char* dst, int chunks_per_row, int lstride, int tid) {
#pragma unroll
    for (int i = 0; i < NCH; ++i) { const int c = tid + NTHR * i, row = c / chunks_per_row, ch = c % chunks_per_row; *(LAS v4u*)(dst + row * lstride + ch * 16) = r[i]; }
}
__device__ __forceinline__ bf16x8 lds_vfrag16(const LAS unsigned char* p) { return *(const LAS bf16x8*)p; }

constexpr float SM_THR = 8.0f;
template <int NO>
__device__ __forceinline__ void softmax_def2(f32x16& S0, f32x16& S1, bool first, float& mref, float& l, f32x16 (&O)[NO], int hh) {
    float mx = fmaxf(fmaxf(S0[0], S0[1]), fmaxf(S1[0], S1[1]));
#pragma unroll
    for (int i = 2; i < 16; i += 2) mx = fmaxf(mx, fmaxf(fmaxf(S0[i], S0[i + 1]), fmaxf(S1[i], S1[i + 1])));
    mx = fmaxf(mx, xhalf(mx, hh));
    if (first || __any(mx > SM_THR)) {
        const float dl = first ? mx : fmaxf(mx, 0.f), f = first ? 0.f : __builtin_amdgcn_exp2f(-dl);
        mref += dl; l *= f;
#pragma unroll
        for (int o = 0; o < NO; ++o) O[o] = O[o] * f;
#pragma unroll
        for (int i = 0; i < 16; ++i) { S0[i] -= dl; S1[i] -= dl; }
    }
    float ps = 0.f;
#pragma unroll
    for (int i = 0; i < 16; ++i) { S0[i] = __builtin_amdgcn_exp2f(S0[i]); S1[i] = __builtin_amdgcn_exp2f(S1[i]); ps += S0[i] + S1[i]; }
    l += ps;
}
template <int NO>
__device__ __forceinline__ void softmax_def1(f32x16& S, bool first, float& mref, float& l, f32x16 (&O)[NO], int hh) {
    float mx = fmaxf(fmaxf(S[0], S[1]), fmaxf(S[2], S[3]));
#pragma unroll
    for (int i = 4; i < 16; i += 4) mx = fmaxf(mx, fmaxf(fmaxf(S[i], S[i + 1]), fmaxf(S[i + 2], S[i + 3])));
    mx = fmaxf(mx, xhalf(mx, hh));
    if (first || __any(mx > SM_THR)) {
        const float dl = first ? mx : fmaxf(mx, 0.f), f = first ? 0.f : __builtin_amdgcn_exp2f(-dl);
        mref += dl; l *= f;
#pragma unroll
        for (int o = 0; o < NO; ++o) O[o] = O[o] * f;
#pragma unroll
        for (int i = 0; i < 16; ++i) S[i] -= dl;
    }
    float ps = 0.f;
#pragma unroll
    for (int i = 0; i < 16; ++i) { S[i] = __builtin_amdgcn_exp2f(S[i]); ps += S[i]; }
    l += ps;
}
__device__ __forceinline__ void attn_diff_block(const bf16_t* PR, const bf16_t* VT, bf16_t* OAT, const float* subln, float lam, int b, int h, int qb, LAS unsigned char* lds, int tid, int wave, int lane) {
    constexpr int KB = 8192, BUF = 2 * KB + 16384, QOFF = 3 * BUF;
    const int r32 = lane & 31, hh = lane >> 5, j = wave >> 2, w4 = wave & 3, q0 = qb * 128 + w4 * 32;
    const bf16_t* qrow = PR + (size_t)(b * SEQ + q0 + r32) * NIN + C_DQ + h * 128 + j * 64 + 8 * hh;
    LAS unsigned char* qs = lds + QOFF + wave * 4096 + lane * 16;
#pragma unroll
    for (int d0 = 0; d0 < 4; ++d0) *(LAS bf16x8*)(qs + d0 * 1024) = *(const bf16x8*)(qrow + 16 * d0);
    asm volatile("s_waitcnt vmcnt(0) lgkmcnt(0)" ::: "memory");
    const bf16_t* kg = PR + (size_t)(b * SEQ) * NIN + C_DK + h * 128;
    const bf16_t* vg = VT + (size_t)(b * 512 + h * 128) * SEQ;
    auto uni_ptr = [](const void* p_) __attribute__((always_inline)) { const unsigned long long v_ = (unsigned long long)p_; return (void*)(((unsigned long long)(unsigned)__builtin_amdgcn_readfirstlane((int)(v_ >> 32)) << 32) | (unsigned)__builtin_amdgcn_readfirstlane((int)v_)); };
    const auto rK = __builtin_amdgcn_make_buffer_rsrc(uni_ptr(kg), 0, 0x7fffffff, 0x00020000), rV = __builtin_amdgcn_make_buffer_rsrc(uni_ptr(vg), 0, 0x7fffffff, 0x00020000);
    const int prow = lane >> 3, pch = lane & 7;
    const int krow = 8 * wave + prow;
    const int kvoff = (krow * NIN + ((pch ^ (krow & 7)) << 3)) * 2;
    int vvoff[2];
#pragma unroll
    for (int pp = 0; pp < 2; ++pp) { const int vrow = 16 * wave + 8 * pp + prow; vvoff[pp] = (vrow * SEQ + ((pch ^ ((vrow ^ (vrow >> 3)) & 7)) << 3)) * 2; }
    auto dma = [&](int t_, int slot) __attribute__((always_inline)) {
        LAS unsigned char* sb_ = lds + slot;
        __builtin_amdgcn_raw_ptr_buffer_load_lds(rK, (LAS unsigned*)(sb_ + wave * 1024), 16, kvoff, t_ * (64 * NIN * 2), 0, 0);
        __builtin_amdgcn_raw_ptr_buffer_load_lds(rK, (LAS unsigned*)(sb_ + KB + wave * 1024), 16, kvoff + 128, t_ * (64 * NIN * 2), 0, 0);
        __builtin_amdgcn_raw_ptr_buffer_load_lds(rV, (LAS unsigned*)(sb_ + 2 * KB + wave * 2048), 16, vvoff[0], t_ * 128, 0, 0);
        __builtin_amdgcn_raw_ptr_buffer_load_lds(rV, (LAS unsigned*)(sb_ + 2 * KB + wave * 2048 + 1024), 16, vvoff[1], t_ * 128, 0, 0); };
    f32x16 O[4];
#pragma unroll
    for (int o = 0; o < 4; ++o)
#pragma unroll
        for (int i = 0; i < 16; ++i) O[o][i] = 0.f;
    float m = 0.f, l = 0.f;
    const int nsteps = 2 * qb + 2, my_last = 2 * qb + (w4 >> 1);
    const int xr = r32 & 7;
    bf16x8 p00, p01, p10, p11;
    f32x16 negm;
#pragma unroll
    for (int i = 0; i < 16; ++i) negm[i] = 0.f;
    auto qk_softmax = [&](int t, int slot) __attribute__((always_inline)) {
        if (t <= my_last) {
            const LAS unsigned char* kb = lds + slot + j * KB + r32 * 128;
            f32x16 S0, S1;
#pragma unroll
            for (int d0 = 0; d0 < 4; ++d0) { const int co = ((2 * d0 + hh) ^ xr) << 4; const bf16x8 qd = *(const LAS bf16x8*)(qs + d0 * 1024);
                S0 = mfma32(*(const LAS bf16x8*)(kb + co), qd, d0 == 0 ? negm : S0); S1 = mfma32(*(const LAS bf16x8*)(kb + 32 * 128 + co), qd, d0 == 0 ? negm : S1); }
            const float m_before = m;
            softmax_def2<4>(S0, S1, t == 0, m, l, O, hh);
            if (m != m_before) {
#pragma unroll
                for (int i = 0; i < 16; ++i) negm[i] = -m; }
            p00 = pack_p(S0, 0); p01 = pack_p(S0, 1); p10 = pack_p(S1, 0); p11 = pack_p(S1, 1);
        } };
    auto vfrag = [&](const LAS unsigned char* rowp, int c16, int sw) __attribute__((always_inline)) -> bf16x8 {
        return *(const LAS bf16x8*)(rowp + (((c16 + hh) ^ sw) << 4)); };
    auto pv = [&](int t, int slot) __attribute__((always_inline)) {
        if (t <= my_last) {
#pragma unroll
            for (int o = 0; o < 4; ++o) { const int d = 32 * o + r32, sw = (d ^ (d >> 3)) & 7; const LAS unsigned char* rowp = lds + slot + 2 * KB + d * 128;
                O[o] = mfma32(vfrag(rowp, 0, sw), p00, O[o]); O[o] = mfma32(vfrag(rowp, 2, sw), p01, O[o]); O[o] = mfma32(vfrag(rowp, 4, sw), p10, O[o]); O[o] = mfma32(vfrag(rowp, 6, sw), p11, O[o]); }
        } };
#define DIFF_BAR() do { asm volatile("s_waitcnt lgkmcnt(0)" ::: "memory"); __builtin_amdgcn_s_barrier(); asm volatile("" ::: "memory"); } while (0)
    dma(0, 0); dma(1, BUF);
    asm volatile("s_waitcnt vmcnt(4)" ::: "memory");
    DIFF_BAR();
#define DIFF_STEPS(H1, H2) { int sl = 0, slp = 2 * BUF, sln = BUF; \
    for (int t = 0; t < nsteps; ++t) { \
        H1(t, sl, slp); DIFF_BAR(); \
        const bool more = t + 2 < nsteps; \
        if (more) dma(t + 2, slp); \
        H2(t, sl); \
        if (more) asm volatile("s_waitcnt vmcnt(4)" ::: "memory"); else asm volatile("s_waitcnt vmcnt(0)" ::: "memory"); \
        DIFF_BAR(); \
        const int tmp_ = slp; slp = sl; sl = sln; sln = tmp_; } }
#define LEAD_H1(t, sl, slp) qk_softmax(t, sl)
#define LEAD_H2(t, sl) pv(t, sl)
#define LAG_H1(t, sl, slp) do { if ((t) > 0) pv((t) - 1, slp); } while (0)
#define LAG_H2(t, sl) qk_softmax(t, sl)
    if (j == 0) { DIFF_STEPS(LEAD_H1, LEAD_H2) } else { DIFF_STEPS(LAG_H1, LAG_H2) }
#undef DIFF_STEPS
#undef LEAD_H1
#undef LEAD_H2
#undef LAG_H1
#undef LAG_H2
    if (j == 1) pv(nsteps - 1, ((nsteps - 1) % 3) * BUF);
    DIFF_BAR();
#undef DIFF_BAR
    l += xhalf(l, hh);
    const float il = 1.f / l;
    LAS float* X = (LAS float*)lds + (size_t)(w4 * 32 + r32) * 132 + 4 * hh;
    if (j == 1) {
#pragma unroll
        for (int o = 0; o < 4; ++o)
#pragma unroll
            for (int g = 0; g < 4; ++g) *(LAS f32x4*)(X + 32 * o + 8 * g) = (f32x4){O[o][4 * g] * il, O[o][4 * g + 1] * il, O[o][4 * g + 2] * il, O[o][4 * g + 3] * il};
    }
    __syncthreads();
    if (j == 0) {
        float ss = 0.f;
#pragma unroll
        for (int o = 0; o < 4; ++o)
#pragma unroll
            for (int g = 0; g < 4; ++g) { const f32x4 o2 = *(const LAS f32x4*)(X + 32 * o + 8 * g);
#pragma unroll
                for (int c = 0; c < 4; ++c) { const float d = O[o][4 * g + c] * il - lam * o2[c]; O[o][4 * g + c] = d; ss += d * d; } }
        ss += xhalf(ss, hh);
        const float rinv = 0.8f / sqrtf(ss * (1.f / 128.f) + NORM_EPS);
        bf16_t* orow = OAT + (size_t)(b * SEQ + q0 + r32) * D + 512 + h * 128 + 4 * hh; const float* sl = subln + 4 * hh;
#pragma unroll
        for (int o = 0; o < 4; ++o)
#pragma unroll
            for (int g = 0; g < 4; ++g) { const f32x4 sg_ = *(const f32x4*)(sl + 32 * o + 8 * g); v2u w;
                w.x = pg8::cvt_pk_bf16(O[o][4 * g] * rinv * sg_[0], O[o][4 * g + 1] * rinv * sg_[1]); w.y = pg8::cvt_pk_bf16(O[o][4 * g + 2] * rinv * sg_[2], O[o][4 * g + 3] * rinv * sg_[3]); *(v2u*)(orow + 32 * o + 8 * g) = w; }
    }
    __syncthreads();
}

__device__ __forceinline__ void sb_subtile(f32x16& S, bool diag, float& R, f32x16 (&O)[2], const LAS unsigned char* vp, int r32, int hh) {
    f32x16 lr;
#pragma unroll
    for (int i = 0; i < 16; ++i) { const float z2 = S[i]; const float sp = fmaxf(z2, 0.f) + __builtin_amdgcn_logf(1.f + __builtin_amdgcn_exp2f(-fabsf(z2))); lr[i] = -sp; S[i] = z2 - sp; }
    if (diag) {
#pragma unroll
        for (int i = 0; i < 16; ++i) { const int kvl = (i & 3) + 8 * (i >> 2) + 4 * hh; if (kvl >= r32) { lr[i] = 0.f; S[i] = -INFINITY; } }
    }
    float tot[4], pt[4], off[4]; f32x16 ex;
#pragma unroll
    for (int g = 0; g < 4; ++g) { ex[4 * g + 3] = 0.f; ex[4 * g + 2] = lr[4 * g + 3]; ex[4 * g + 1] = lr[4 * g + 3] + lr[4 * g + 2]; ex[4 * g] = ex[4 * g + 1] + lr[4 * g + 1]; tot[g] = ex[4 * g] + lr[4 * g]; }
#pragma unroll
    for (int g = 0; g < 4; ++g) pt[g] = xhalf(tot[g], hh);
    const float own0 = hh ? 0.f : 1.f;
    float sp_ = 0.f;
#pragma unroll
    for (int g = 3; g >= 0; --g) { off[g] = sp_ + own0 * pt[g] + R; sp_ += tot[g] + pt[g]; }
#pragma unroll
    for (int i = 0; i < 16; ++i) S[i] = __builtin_amdgcn_exp2f(S[i] + ex[i] + off[i >> 2]);
    R += sp_;
    const bf16x8 p0 = pack_p(S, 0), p1 = pack_p(S, 1);
#pragma unroll
    for (int o = 0; o < 2; ++o) { O[o] = mfma32(lds_vfrag16(vp + 32 * o * 144), p0, O[o]); O[o] = mfma32(lds_vfrag16(vp + 32 * o * 144 + 32), p1, O[o]); }
}
__device__ __forceinline__ void attn_sb_block(const bf16_t* PR, const bf16_t* VT, bf16_t* OAT, int b, int h, int qb, LAS unsigned char* lds, volatile LAS unsigned* fl, int tid, int wave, int lane) {
    constexpr int KSTR = 144, KB = 64 * KSTR, BUF = KB + 64 * 144;
    const int r32 = lane & 31, hh = lane >> 5, q0 = qb * 256 + wave * 32;
    const bf16_t* qrow = PR + (size_t)(b * SEQ + q0 + r32) * NIN + C_SBQ + h * 64 + 8 * hh;
    bf16x8 qf[4];
#pragma unroll
    for (int d0 = 0; d0 < 4; ++d0) qf[d0] = *(const bf16x8*)(qrow + 16 * d0);
    const bf16_t* kg = PR + (size_t)(b * SEQ) * NIN + C_SBK + h * 64;
    const bf16_t* vg = VT + (size_t)(b * 512 + h * 64) * SEQ;
    f32x16 O[2];
#pragma unroll
    for (int o = 0; o < 2; ++o)
#pragma unroll
        for (int i = 0; i < 16; ++i) O[o][i] = 0.f;
    float R = 0.f; bool done = false;
    const int ttop = 4 * qb + 3, my_diag = 4 * qb + (wave >> 1), odd = wave & 1;
    v4u kr[1], vr[1];
    if (tid < 3) fl[tid] = 0u;
    stage_load<1>(kr, kg + (size_t)(64 * ttop) * NIN, 8, NIN, tid); stage_load<1>(vr, vg + 64 * ttop, 8, SEQ, tid);
    stage_store_k<1>(kr, lds, 8, KSTR, tid); stage_store_k<1>(vr, lds + KB, 8, 144, tid);
    __syncthreads();
    int it = 0;
    for (int t = ttop; t >= 0; --t, ++it) {
        const bool more = t > 0;
        if (more) { stage_load<1>(kr, kg + (size_t)(64 * (t - 1)) * NIN, 8, NIN, tid); stage_load<1>(vr, vg + 64 * (t - 1), 8, SEQ, tid); }
        const int fcur = it % 3;
        if (tid == 0) fl[(it + 1) % 3] = 0u;
        if (t <= my_diag && !done) {
            const LAS unsigned char* kb = lds + (it & 1) * BUF + r32 * KSTR + 16 * hh; const LAS unsigned char* vb = lds + (it & 1) * BUF + KB + r32 * 144 + 16 * hh;
            const bool isd = (t == my_diag);
            if (!isd || odd) {
                f32x16 S;
#pragma unroll
                for (int i = 0; i < 16; ++i) S[i] = 0.f;
#pragma unroll
                for (int d0 = 0; d0 < 4; ++d0) S = mfma32(*(const LAS bf16x8*)(kb + 32 * KSTR + 32 * d0), qf[d0], S);
                sb_subtile(S, isd, R, O, vb + 64, r32, hh);
            }
            {
                f32x16 S;
#pragma unroll
                for (int i = 0; i < 16; ++i) S[i] = 0.f;
#pragma unroll
                for (int d0 = 0; d0 < 4; ++d0) S = mfma32(*(const LAS bf16x8*)(kb + 32 * d0), qf[d0], S);
                sb_subtile(S, isd && !odd, R, O, vb, r32, hh);
            }
            done = __all(R < -160.f);
        }
        if (done && lane == 0) __hip_atomic_fetch_or((LAS unsigned*)(fl + fcur), 1u << wave, __ATOMIC_RELAXED, __HIP_MEMORY_SCOPE_WORKGROUP);
        if (more) { LAS unsigned char* nb = lds + ((it + 1) & 1) * BUF; stage_store_k<1>(kr, nb, 8, KSTR, tid); stage_store_k<1>(vr, nb + KB, 8, 144, tid); }
        __syncthreads();
        if (fl[fcur] == 0xffu) break;
    }
    bf16_t* orow = OAT + (size_t)(b * SEQ + q0 + r32) * D + h * 64 + 4 * hh;
#pragma unroll
    for (int o = 0; o < 2; ++o)
#pragma unroll
        for (int g = 0; g < 4; ++g) { v2u w; w.x = pg8::cvt_pk_bf16(O[o][4 * g], O[o][4 * g + 1]); w.y = pg8::cvt_pk_bf16(O[o][4 * g + 2], O[o][4 * g + 3]); *(v2u*)(orow + 32 * o + 8 * g) = w; }
    __syncthreads();
}

__device__ __forceinline__ void attn_mem_block(const bf16_t* QM, const bf16_t* KVM, const bf16_t* VT, bf16_t* OM, int b, int h, int qb, LAS unsigned char* lds, int tid, int wave, int lane) {
    constexpr int KSTR = 528, KB = 32 * KSTR, VS = 80, BUF = KB + 128 * VS;
    const int r32 = lane & 31, hh = lane >> 5, q0 = qb * 256 + wave * 32;
    const bf16_t* qrow = QM + (size_t)(b * SEQ + q0 + r32) * D + h * 256 + 8 * hh;
    bf16x8 qf[8];
    LAS unsigned char* qs = lds + 57344 + wave * 8192 + lane * 16;
#pragma unroll
    for (int d0 = 0; d0 < 8; ++d0) { qf[d0] = *(const bf16x8*)(qrow + 16 * d0); *(LAS bf16x8*)(qs + d0 * 1024) = *(const bf16x8*)(qrow + 128 + 16 * d0); }
    const bf16_t* kg = KVM + (size_t)(b * MEMLEN) * 2048 + h * 256;
    const int vrow = tid >> 2, vch = tid & 3;
    for (int dh = 0; dh < 2; ++dh) {
        const bf16_t* vg = VT + (size_t)(b * 1024 + h * 256 + dh * 128 + vrow) * MEMLEN + vch * 8;
        f32x16 O[4];
#pragma unroll
        for (int o = 0; o < 4; ++o)
#pragma unroll
            for (int i = 0; i < 16; ++i) O[o][i] = 0.f;
        float m = 0.f, l = 0.f;
        v4u kr[2], vr;
        stage_load<2>(kr, kg, 32, 2048, tid); vr = *(const v4u*)vg;
        stage_store_k<2>(kr, lds, 32, KSTR, tid); *(LAS v4u*)(lds + KB + vrow * VS + vch * 16) = vr;
        __syncthreads();
        for (int t = 0; t < 8; ++t) {
            const bool more = t < 7;
            if (more) { stage_load<2>(kr, kg + (size_t)(32 * (t + 1)) * 2048, 32, 2048, tid); vr = *(const v4u*)(vg + 32 * (t + 1)); }
            {
                const LAS unsigned char* kb = lds + (t & 1) * BUF + r32 * KSTR + 16 * hh; const LAS unsigned char* vb = lds + (t & 1) * BUF + KB + r32 * VS + 16 * hh;
                f32x16 S;
#pragma unroll
                for (int i = 0; i < 16; ++i) S[i] = -m;
#pragma unroll
                for (int d0 = 0; d0 < 8; ++d0) S = mfma32(*(const LAS bf16x8*)(kb + 32 * d0), qf[d0], S);
#pragma unroll
                for (int d0 = 0; d0 < 8; ++d0) S = mfma32(*(const LAS bf16x8*)(kb + 256 + 32 * d0), *(const LAS bf16x8*)(qs + d0 * 1024), S);
                softmax_def1<4>(S, t == 0, m, l, O, hh);
                const bf16x8 p0 = pack_p(S, 0), p1 = pack_p(S, 1);
#pragma unroll
                for (int o = 0; o < 4; ++o) { const LAS unsigned char* vp = vb + 32 * o * VS; O[o] = mfma32(lds_vfrag16(vp), p0, O[o]); O[o] = mfma32(lds_vfrag16(vp + 32), p1, O[o]); }
            }
            if (more) { LAS unsigned char* nb = lds + ((t + 1) & 1) * BUF; stage_store_k<2>(kr, nb, 32, KSTR, tid); *(LAS v4u*)(nb + KB + vrow * VS + vch * 16) = vr; }
            __syncthreads();
        }
        l += xhalf(l, hh);
        const float il = 1.f / l;
        bf16_t* orow = OM + (size_t)(b * SEQ + q0 + r32) * D + h * 256 + dh * 128 + 4 * hh;
#pragma unroll
        for (int o = 0; o < 4; ++o)
#pragma unroll
            for (int g = 0; g < 4; ++g) { v2u w; w.x = pg8::cvt_pk_bf16(O[o][4 * g] * il, O[o][4 * g + 1] * il); w.y = pg8::cvt_pk_bf16(O[o][4 * g + 2] * il, O[o][4 * g + 3] * il); *(v2u*)(orow + 32 * o + 8 * g) = w; }
    }
}

struct Args { const void* in[26]; float* out; unsigned char* ws; int ph_lo, ph_hi; };
constexpr int NPHASE = 15;

__global__ void __launch_bounds__(NTHR, 2) fwd(Args args) {
    extern __shared__ __attribute__((aligned(16))) unsigned char lds[];
    LAS unsigned char* L = (LAS unsigned char*)lds;
    volatile LAS unsigned* MISC = (volatile LAS unsigned*)(L + MISC_OFF);
    const int tid = threadIdx.x, lane = tid & 63, wave = __builtin_amdgcn_readfirstlane(tid >> 6);
    const int G = gridDim.x;
    unsigned char* ws = args.ws;
    unsigned* ctl = (unsigned*)(ws + WS_CTL);
#define x_in ((const float*)args.in[0])
#define mem_in ((const float*)args.in[1])
#define positions ((const int*)args.in[2])
#define norm_mix ((const float*)args.in[3])
#define w_in ((const float*)args.in[4])
#define lam_q1 ((const float*)args.in[5])
#define lam_k1 ((const float*)args.in[6])
#define lam_q2 ((const float*)args.in[7])
#define lam_k2 ((const float*)args.in[8])
#define diff_subln ((const float*)args.in[9])
#define w_up_sb ((const float*)args.in[10])
#define w_up_diff ((const float*)args.in[11])
#define w_out ((const float*)args.in[12])
#define norm_mem_q ((const float*)args.in[13])
#define norm_mem_kv ((const float*)args.in[14])
#define w_mem_q ((const float*)args.in[15])
#define w_mem_kv ((const float*)args.in[16])
#define w_mem_o ((const float*)args.in[17])
#define norm_ffn ((const float*)args.in[18])
#define w_router ((const float*)args.in[19])
#define b_router ((const float*)args.in[20])
#define w_gate_up ((const float*)args.in[21])
#define b_gate_up ((const float*)args.in[22])
#define w_down ((const float*)args.in[23])
#define b_down ((const float*)args.in[24])
#define norm_final ((const float*)args.in[25])
    bf16_t* WIN = (bf16_t*)(ws + WS_WIN); bf16_t* WUPSB = (bf16_t*)(ws + WS_WUPSB); bf16_t* WUPDF = (bf16_t*)(ws + WS_WUPDF); bf16_t* WOUT = (bf16_t*)(ws + WS_WOUT);
    bf16_t* WMQ = (bf16_t*)(ws + WS_WMQ); bf16_t* WMKV = (bf16_t*)(ws + WS_WMKV); bf16_t* WMO = (bf16_t*)(ws + WS_WMO);
    bf16_t* WGU = (bf16_t*)(ws + WS_WGU); bf16_t* WD = (bf16_t*)(ws + WS_WD);
    float* ROPEC = (float*)(ws + WS_ROPE); float* ROPES = ROPEC + (size_t)M * 32;
    int* TK_E = (int*)(ws + WS_TK); int* TK_POS = TK_E + (size_t)M * 4; float* TK_G = (float*)(TK_POS + (size_t)M * 4);
    bf16_t* XN = (bf16_t*)(ws + WS_XN); bf16_t* PR = (bf16_t*)(ws + WS_PR); bf16_t* OAT = (bf16_t*)(ws + WS_OAT); float* SSQ = (float*)(ws + WS_ODR);
    bf16_t* MIX = (bf16_t*)(ws + WS_MIX); float* X1 = (float*)(ws + WS_X1); float* X2 = (float*)(ws + WS_X2);
    bf16_t* HM = (bf16_t*)(ws + WS_HM); bf16_t* KVM = (bf16_t*)(ws + WS_KVM); int* TLIST = (int*)(ws + WS_TLIST); float* GLIST = (float*)(ws + WS_GLIST);
    bf16_t* QM = (bf16_t*)(ws + WS_QM); bf16_t* OM = (bf16_t*)(ws + WS_OM); bf16_t* ACT = (bf16_t*)(ws + WS_ACT); bf16_t* YB = (bf16_t*)(ws + WS_YB);
    bf16_t* VTSB = (bf16_t*)(ws + WS_VTSB); bf16_t* VTDF = (bf16_t*)(ws + WS_VTDF); bf16_t* VTM = (bf16_t*)(ws + WS_VTM);
    float* WR = (float*)(ws + WS_WR); float* WSCGU = (float*)(ws + WS_WSC); float* WSCD = WSCGU + NE * 2048;
    unsigned char* WGU8 = ws + WS_WGU; unsigned char* WD8 = ws + WS_WD; unsigned char* XN8 = ws + WS_XN; unsigned char* ACT8 = ws + WS_ACT;
    unsigned* CNT = ctl + CW_CNT;
    LAS float* smf = (LAS float*)L;
    LAS int* smi = (LAS int*)L;

    for (int u = tid; u < (LDS_BYTES - 131072) / 4; u += NTHR) ((LAS unsigned*)(L + 131072))[u] = 0u;
    __syncthreads();
#if !MK_PER_PHASE
    XcdBarrier bar = xcd_barrier_post(ctl + CW_BAR, MISC + 8);
#define GRID_BAR() xcd_barrier(bar)
#else
#define GRID_BAR() do {} while (0)
#endif
    const int lo = args.ph_lo, hi = args.ph_hi;
#define IN(k) (lo <= (k) && (k) < hi)
#define PHASE_L(k, ...) do { if (IN(k)) { auto body_ = [&]() __attribute__((always_inline)) __VA_ARGS__; body_(); if ((PROBE_REP >> (k)) & 1) { GRID_BAR(); body_(); } } } while (0)
#if !MK_PER_PHASE
#define PHASE(k) for (int rep_ = 0, nrep_ = IN(k) ? 1 + ((PROBE_REP >> (k)) & 1) : 0; rep_ < nrep_; ++rep_, (rep_ < nrep_ ? (xcd_barrier(bar), 0) : 0))
#else
#define PHASE(k) if (IN(k))
#endif
    unsigned long long st_t0_ = 0ull, st_dt_ = 0ull;
#define STAMP_AT(k) do { if (PROBE_STAMP >= 0) { const unsigned long long now_ = __builtin_amdgcn_s_memrealtime(); if ((k) == PROBE_STAMP || (PROBE_STAMP == 100 && (k) == 0)) st_t0_ = now_; if ((k) == PROBE_STAMP + 1 || (PROBE_STAMP == 100 && (k) == 15)) st_dt_ = now_ - st_t0_; } } while (0)
#define SEAM(k) do { if (IN(k) && IN((k) + 1)) GRID_BAR(); STAMP_AT((k) + 1); } while (0)
    const int gw = blockIdx.x * NWAVES + wave, NGW = G * NWAVES;
    const int xcu = (G % 8 == 0) ? ((int)blockIdx.x % 8) * (G / 8) + (int)blockIdx.x / 8 : (int)blockIdx.x;

    auto convert_experts = [&]() __attribute__((always_inline)) {
        LAS float* scr = (LAS float*)(L + wave * 16384);
        {
            const int c8 = lane & 7, r8 = lane >> 3;
            f32x4 ra[8], rb[8], rc[8], rd[8], re[8];
            auto sub_load = [&](const float* Wc, int N, int k0, f32x4 (&r)[8]) __attribute__((always_inline)) {
#pragma unroll
                for (int i = 0; i < 8; ++i) r[i] = *(const f32x4*)(Wc + (size_t)(k0 + 8 * i + r8) * N); };
            auto to_lds = [&](const f32x4 (&r)[8]) __attribute__((always_inline)) {
#pragma unroll
                for (int i = 0; i < 8; ++i) *(LAS f32x4*)(scr + (8 * i + r8) * 32 + ((4 * c8) ^ (4 * i))) = r[i];
                LDS_WAIT(); asm volatile("" ::: "memory"); };
            auto max8 = [&](float v) __attribute__((always_inline)) -> float {
                v = fmaxf(v, __uint_as_float(__builtin_amdgcn_update_dpp(0, __float_as_uint(v), 0xB1, 0xf, 0xf, false)));
                v = fmaxf(v, __uint_as_float(__builtin_amdgcn_update_dpp(0, __float_as_uint(v), 0x4E, 0xf, 0xf, false)));
                v = fmaxf(v, __uint_as_float(__builtin_amdgcn_update_dpp(0, __float_as_uint(v), 0x141, 0xf, 0xf, false)));
                return v; };
            for (int it = gw; it < NE * 96 * 4; it += NGW) {
                const int strip = it % (NE * 96), qt = it / (NE * 96);
                const bool gu = strip < NE * 64; const int q = gu ? strip : strip - NE * 64, e = gu ? q >> 6 : q >> 5, n0 = (gu ? q & 63 : q & 31) * 32, N = gu ? 2048 : 1024;
                const float* Wc = (gu ? w_gate_up + (size_t)e * 1024 * 2048 : w_down + (size_t)e * 1024 * 1024) + n0 + 4 * c8;
                sub_load(Wc, N, 0, ra); sub_load(Wc, N, 256 * qt, rb); sub_load(Wc, N, 256 * qt + 64, rc); sub_load(Wc, N, 256 * qt + 128, rd); sub_load(Wc, N, 256 * qt + 192, re);
                to_lds(ra);
                float inv[4], am[4];
#pragma unroll
                for (int j = 0; j < 4; ++j) { const int n = r8 + 8 * j; float a0 = 0.f;
#pragma unroll
                    for (int i = 0; i < 8; ++i) a0 = fmaxf(a0, fabsf(scr[(8 * c8 + i) * 32 + (n ^ (4 * c8))]));
                    a0 = max8(a0);
                    unsigned eb = ((__float_as_uint(a0) >> 23) & 0xffu) + 4u; eb = eb < 8u ? 8u : (eb > 250u ? 250u : eb);
                    inv[j] = __uint_as_float((261u - eb) << 23); am[j] = 0.f;
                    if (qt == 0 && c8 == 0) (gu ? WSCGU + (size_t)e * 2048 : WSCD + (size_t)e * 1024)[n0 + n] = __uint_as_float((eb - 7u) << 23); }
                LDS_WAIT(); asm volatile("" ::: "memory");
                unsigned char* dstb = gu ? WGU8 + (size_t)e * 2048 * 1024 : WD8 + (size_t)e * 1024 * 1024;
#pragma unroll
                for (int st = 0; st < 4; ++st) {
                    const int k0 = 256 * qt + 64 * st;
                    if (st == 0) to_lds(rb); else if (st == 1) to_lds(rc); else if (st == 2) to_lds(rd); else to_lds(re);
#pragma unroll
                    for (int j = 0; j < 4; ++j) { const int n = r8 + 8 * j, c = n0 + n; const LAS float* sp = scr + (8 * c8) * 32 + (n ^ (4 * c8)); float v[8];
#pragma unroll
                        for (int i = 0; i < 8; ++i) { v[i] = sp[i * 32]; am[j] = fmaxf(am[j], fabsf(v[i])); v[i] *= inv[j]; }
                        const int drow = gu ? (((c & 1023) >> 7) * 256 + (c >> 10) * 128 + (c & 127)) : c;
                        v2u w; w.x = pk4_fp8(v[0], v[1], v[2], v[3]); w.y = pk4_fp8(v[4], v[5], v[6], v[7]);
                        *(v2u*)(dstb + (size_t)drow * 1024 + k0 + 8 * c8) = w; }
                    LDS_WAIT(); asm volatile("" ::: "memory");
                }
                bool ov = false;
#pragma unroll
                for (int j = 0; j < 4; ++j) ov = ov || (am[j] * inv[j] >= 448.0f);
                if (__any(ov) && lane == 0) __hip_atomic_store(ctl + CW_REDO + strip, 1u, __ATOMIC_RELAXED, __HIP_MEMORY_SCOPE_AGENT);
            }
        }
    };
    STAMP_AT(0);
    PHASE(0) {
        STAMP_AT(20);
        LAS float* scr = (LAS float*)(L + wave * 16384);
        constexpr int I_IN = 16 * 160, I_UP = 8 * 32, I_SQ = 16 * 32, I_KV = 16 * 64, I_GU1 = 16 * 64, I_GU = NE * I_GU1, I_D1 = 16 * 32, I_DN = NE * I_D1;
        constexpr int NITEMS = I_IN + 2 * I_UP + 3 * I_SQ + I_KV;
        for (int it = gw; it < NITEMS; it += NGW) {
            int r = it;
            if (r < I_IN) {
                const int kb = r / 160, nb = r % 160, n0 = 32 * nb;
                if (n0 >= C_DQ && n0 < C_DV) { const int o = n0 & 255;
                    p0_transpose_rope(w_in, WIN, (n0 & ~255), o, 64 * kb, n0, scr, lane); }
                else p0_transpose_item(w_in, 1024, NIN, WIN, n0, 64 * kb, n0, scr, lane);
                continue; } r -= I_IN;
            if (r < I_UP) { p0_plain(w_up_sb, 512, 1024, WUPSB, r, scr, lane); continue; } r -= I_UP;
            if (r < I_UP) { p0_plain(w_up_diff, 512, 1024, WUPDF, r, scr, lane); continue; } r -= I_UP;
            if (r < I_SQ) { p0_plain(w_out, 1024, 1024, WOUT, r, scr, lane); continue; } r -= I_SQ;
            if (r < I_SQ) { p0_plain(w_mem_q, 1024, 1024, WMQ, r, scr, lane, norm_mem_q); continue; } r -= I_SQ;
            if (r < I_SQ) { p0_plain(w_mem_o, 1024, 1024, WMO, r, scr, lane); continue; } r -= I_SQ;
            p0_plain(w_mem_kv, 1024, 2048, WMKV, r, scr, lane);
        }
        for (int i = blockIdx.x * NTHR + tid; i < D * NE; i += G * NTHR) WR[i] = w_router[i] * norm_ffn[i >> 5];
        STAMP_AT(21);
        STAMP_AT(22);
        for (int m = gw; m < M; m += NGW) rms_row_to_bf16(x_in + (size_t)m * D, norm_mix, XN + (size_t)m * D, lane);
        for (int m = gw; m < MM; m += NGW) rms_row_to_bf16(mem_in + (size_t)m * D, norm_mem_kv, HM + (size_t)m * D, lane);
        for (int i = blockIdx.x * NTHR + tid; i < M * 32; i += G * NTHR) {
            const int m = i >> 5, f = i & 31;
            const double inv = exp2(-(double)f * (13.287712379549449 / 32.0));
            const double ang = (double)positions[m] * inv;
            const double kk = rint(ang * 0.15915494309189535);
            const float rf = (float)(ang - kk * 6.283185307179586);
            ROPEC[i] = __cosf(rf); ROPES[i] = __sinf(rf);
        }
        STAMP_AT(23);
    }
    SEAM(0); STAMP_AT(24);

    if (IN(1)) {
        const int grp = (int)blockIdx.x % 3;
        pg8::Gemm g{XN, WIN, D, D, D}; pg8::DenseOrder S; S.init(M, NIN, G, (int)blockIdx.x, D, D);
        const pg8::EpiInProj E{PR, ROPEC, ROPES, VTSB, VTDF};
        if (grp == 0) { convert_experts(); __syncthreads(); }
        if (grp == 1) { S.i0 = 0; S.i1 = 2; pg8::gemm_phase<pg8::EpiInProj, pg8::DenseOrder, false>(L, g, S, E); convert_experts(); __syncthreads(); S.i0 = 2; S.i1 = 1 << 30; }
        pg8::gemm_phase<pg8::EpiInProj, pg8::DenseOrder, false>(L, g, S, E);
        if (grp == 2) convert_experts();
    }
    SEAM(1);

    if (IN(3)) {
        {
            LAS float* sw = (LAS float*)L; LAS float* red = (LAS float*)(L + 131072 + 4096);
            const int n = tid & 31, part = tid >> 5;
            for (int it = blockIdx.x; it < NE * 96; it += G) {
                if (__hip_atomic_load(ctl + CW_REDO + it, __ATOMIC_RELAXED, __HIP_MEMORY_SCOPE_AGENT) == 0u) continue;
                const bool gu = it < NE * 64; const int q = gu ? it : it - NE * 64, e = gu ? q >> 6 : q >> 5, n0 = (gu ? q & 63 : q & 31) * 32, N = gu ? 2048 : 1024;
                const float* W = (gu ? w_gate_up + (size_t)e * 1024 * 2048 : w_down + (size_t)e * 1024 * 1024) + n0 + n;
                __syncthreads();
#pragma unroll 16
                for (int i = 0; i < 64; ++i) { const int k = part + 16 * i; sw[k * 32 + n] = W[(size_t)k * N]; }
                __syncthreads();
                float am = 0.f;
#pragma unroll 16
                for (int i = 0; i < 64; ++i) am = fmaxf(am, fabsf(sw[(64 * part + i) * 32 + n]));
                red[part * 32 + n] = am;
                __syncthreads();
                if (tid < 32) { float a = red[tid];
#pragma unroll
                    for (int pp = 1; pp < 16; ++pp) a = fmaxf(a, red[pp * 32 + tid]);
                    unsigned eb = (__float_as_uint(a) >> 23) & 0xffu; eb = eb < 8u ? 8u : eb;
                    const float sc = __uint_as_float((eb - 7u) << 23), inv = __uint_as_float((261u - eb) << 23);
                    red[512 + tid] = inv; (gu ? WSCGU + (size_t)e * 2048 : WSCD + (size_t)e * 1024)[n0 + tid] = sc; }
                __syncthreads();
                { const float inv = red[512 + n]; const int c = n0 + n;
                  const int drow = gu ? (((c & 1023) >> 7) * 256 + (c >> 10) * 128 + (c & 127)) : c;
                  unsigned char* dst = (gu ? WGU8 + ((size_t)e * 2048 + drow) * 1024 : WD8 + ((size_t)e * 1024 + drow) * 1024) + 64 * part;
#pragma unroll
                  for (int qd = 0; qd < 4; ++qd) { v4u w;
                      const LAS float* sp = sw + (64 * part + 16 * qd) * 32 + n;
                      w.x = pk4_fp8(sp[0] * inv, sp[32] * inv, sp[64] * inv, sp[96] * inv); w.y = pk4_fp8(sp[128] * inv, sp[160] * inv, sp[192] * inv, sp[224] * inv);
                      w.z = pk4_fp8(sp[256] * inv, sp[288] * inv, sp[320] * inv, sp[352] * inv); w.w = pk4_fp8(sp[384] * inv, sp[416] * inv, sp[448] * inv, sp[480] * inv);
                      *(v4u*)(dst + 16 * qd) = w; } }
            }
            __syncthreads();
        }
    }
    PHASE(3) {
        volatile LAS unsigned* fl = (volatile LAS unsigned*)(L + 131072 + 2048);
        STAMP_AT(30);
        const float lam = expf(wave_sum(lam_q1[lane] * lam_k1[lane])) - expf(wave_sum(lam_q2[lane] * lam_k2[lane])) + 0.2f;
        const int nkv = (G >= 64) ? 32 : 0;
        if ((int)blockIdx.x < nkv) { pg8::Gemm g{HM, WMKV, D, D, D}; pg8::OneUnitOrder S{(int)blockIdx.x, D, D};
            pg8::gemm_phase<pg8::EpiKV, pg8::OneUnitOrder, false>(L, g, S, pg8::EpiKV{KVM, VTM}); }
        if (nkv == 0) { pg8::Gemm g{HM, WMKV, D, D, D}; pg8::DenseOrder S; S.init(MM, 2048, G, (int)blockIdx.x, D, D); pg8::gemm_phase<pg8::EpiKV, pg8::DenseOrder, false>(L, g, S, pg8::EpiKV{KVM, VTM}); }
        for (int pr = blockIdx.x; pr < 256; pr += G) { const int sb_ = pr & 15, h = (pr >> 4) & 3, b = pr >> 6;
            attn_diff_block(PR, VTDF, OAT, diff_subln, lam, b, h, 31 - sb_, L, tid, wave, lane); attn_diff_block(PR, VTDF, OAT, diff_subln, lam, b, h, sb_, L, tid, wave, lane); }
        STAMP_AT(31);
        for (;;) {
            if (tid == 0) fl[4] = __hip_atomic_fetch_add(ctl + CW_SBQ, 1u, __ATOMIC_RELAXED, __HIP_MEMORY_SCOPE_AGENT);
            __syncthreads();
            const int bu = (int)fl[4];
            __syncthreads();
            if (bu >= 512) break;
            const int qb = 15 - (bu & 15), h = (bu >> 4) & 7, b = bu >> 7;
            attn_sb_block(PR, VTSB, OAT, b, h, qb, L, fl, tid, wave, lane);
        }
        STAMP_AT(32);
    }
    SEAM(3); STAMP_AT(3); STAMP_AT(33);

    PHASE_L(5, {
        pg8::Gemm g{OAT, WUPSB, D, 512, 512}; pg8::TwoRoundOrder S{G, xcu, D, 512};
        pg8::gemm_phase<pg8::EpiGate, pg8::TwoRoundOrder, false>(L, g, S, pg8::EpiGate{PR, (bf16_t*)X1, MIX});
    });
    SEAM(5); STAMP_AT(5);

    PHASE_L(6, {
        pg8::Gemm g{MIX, WOUT, D, D, D}; pg8::DenseOrder S; S.init(M, D, G, (int)blockIdx.x, D, D);
        pg8::gemm_phase<pg8::EpiResidNorm, pg8::DenseOrder, false>(L, g, S, pg8::EpiResidNorm{x_in, X1, XN, SSQ});
    });
    if (IN(6) && IN(8)) GRID_BAR();
    STAMP_AT(7); STAMP_AT(8);

    PHASE_L(8, {
        pg8::Gemm g{XN, WMQ, D, D, D}; pg8::DenseOrder S; S.init(M, D, G, (int)blockIdx.x, D, D);
        pg8::gemm_phase<pg8::EpiBf16Rinv, pg8::DenseOrder, false>(L, g, S, pg8::EpiBf16Rinv{QM, SSQ, 0.0625f * 1.4426950408889634f});
    });
    SEAM(8);

    PHASE(9) { for (int bu = blockIdx.x; bu < 256; bu += G) { const int qb = bu & 15, h = (bu >> 4) & 3, b = bu >> 6; attn_mem_block(QM, KVM, VTM, OM, b, h, qb, L, tid, wave, lane); } }
    SEAM(9);

    PHASE_L(10, {
        pg8::Gemm g{OM, WMO, D, D, D}; pg8::DenseOrder S; S.init(M, D, G, (int)blockIdx.x, D, D);
        pg8::gemm_phase<pg8::EpiResidB, pg8::DenseOrder, false>(L, g, S, pg8::EpiResidB{XN, X2});
    });
    SEAM(10);

    if (IN(11)) {
        auto body11_ = [&]() __attribute__((always_inline)) {
        {
            const int i32 = lane & 31, kk = lane >> 5;
#pragma unroll
            for (int t2 = 0; t2 < 2; ++t2) {
                const int tile = t2 * G + (int)blockIdx.x, m0 = tile * 32;
                LAS float* P = smf + (t2 * 8 + wave) * 1056; LAS float* SSQ_ = smf + 16 * 1056 + (t2 * 8 + wave) * 32;
                f32x16 acc;
#pragma unroll
                for (int r = 0; r < 16; ++r) acc[r] = 0.f;
                float ss = 0.f;
                if (tile < M / 32) {
                    const float* xr = X2 + (size_t)(m0 + i32) * D + 128 * wave + 4 * kk; const float* wp = WR + (128 * wave + 4 * kk) * NE + i32;
#pragma unroll 8
                    for (int u = 0; u < 16; ++u) {
                        const f32x4 a = *(const f32x4*)(xr + 8 * u);
                        const float b0 = wp[(8 * u + 0) * NE], b1 = wp[(8 * u + 1) * NE], b2 = wp[(8 * u + 2) * NE], b3 = wp[(8 * u + 3) * NE];
                        acc = __builtin_amdgcn_mfma_f32_32x32x2f32(a.x, b0, acc, 0, 0, 0); acc = __builtin_amdgcn_mfma_f32_32x32x2f32(a.y, b1, acc, 0, 0, 0);
                        acc = __builtin_amdgcn_mfma_f32_32x32x2f32(a.z, b2, acc, 0, 0, 0); acc = __builtin_amdgcn_mfma_f32_32x32x2f32(a.w, b3, acc, 0, 0, 0);
                        ss += (a.x * a.x + a.y * a.y) + (a.z * a.z + a.w * a.w);
                    }
                }
                ss += xhalf(ss, kk);
#pragma unroll
                for (int r = 0; r < 16; ++r) P[((r & 3) + 8 * (r >> 2) + 4 * kk) * 33 + i32] = acc[r];
                if (kk == 0) SSQ_[i32] = ss;
            }
        }
        __syncthreads();
        if (wave < 2) {
            const int tile = wave * G + (int)blockIdx.x;
            if (tile < M / 32) {
                const int m0 = tile * 32;
                LAS float* T = smf + (wave * 8) * 1056;
#pragma unroll
                for (int r = 0; r < 16; ++r) { const int idx = lane + 64 * r, e_ = (idx >> 5) * 33 + (idx & 31); float v = T[e_];
#pragma unroll
                    for (int w2 = 1; w2 < 8; ++w2) v += T[w2 * 1056 + e_];
                    T[e_] = v; }
                float ss = 0.f;
#pragma unroll
                for (int w2 = 0; w2 < 8; ++w2) ss += smf[16 * 1056 + (wave * 8 + w2) * 32 + (lane & 31)];
                LDS_WAIT(); asm volatile("" ::: "memory");
                const float rinv = 1.0f / sqrtf(ss * (1.f / 1024.f) + NORM_EPS);
                if (lane < 32) {
                    float lg[32];
#pragma unroll
                    for (int j = 0; j < 32; ++j) lg[j] = T[lane * 33 + j] * rinv + b_router[j];
                    float tv[4]; int ti[4];
#pragma unroll
                    for (int k = 0; k < 4; ++k) { float bv = lg[0]; int bi = 0;
#pragma unroll
                        for (int j = 1; j < 32; ++j) if (lg[j] > bv) { bv = lg[j]; bi = j; }
                        tv[k] = bv; ti[k] = bi;
#pragma unroll
                        for (int j = 0; j < 32; ++j) if (j == bi) lg[j] = -INFINITY; }
                    const float e1 = __expf(tv[1] - tv[0]), e2 = __expf(tv[2] - tv[0]), e3 = __expf(tv[3] - tv[0]);
                    const float isum = 1.f / (1.f + e1 + e2 + e3);
                    const float gk[4] = {isum, e1 * isum, e2 * isum, e3 * isum};
                    LAS unsigned* H = (LAS unsigned*)(smf + 16 * 1056 + 512 + wave * 64);
                    H[lane] = 0u;
                    LDS_WAIT(); asm volatile("" ::: "memory");
                    int rk[4];
#pragma unroll
                    for (int k = 0; k < 4; ++k) rk[k] = (int)__hip_atomic_fetch_add(H + ti[k], 1u, __ATOMIC_RELAXED, __HIP_MEMORY_SCOPE_WAVEFRONT);
                    LDS_WAIT(); asm volatile("" ::: "memory");
                    const unsigned cnt_e = H[lane];
                    unsigned base_e = 0u; if (cnt_e) base_e = atomicAdd(&CNT[64 * lane], cnt_e);
                    H[32 + lane] = base_e;
                    LDS_WAIT(); asm volatile("" ::: "memory");
                    const int m = m0 + lane;
#pragma unroll
                    for (int k = 0; k < 4; ++k) { const int ek = ti[k]; const int pos = (int)H[32 + ek] + rk[k];
                        TLIST[ek * LISTCAP + pos] = m; GLIST[ek * LISTCAP + pos] = gk[k]; TK_E[m * 4 + k] = ek; TK_POS[m * 4 + k] = pos; TK_G[m * 4 + k] = gk[k]; }
                }
            }
        } else {
            for (int m = blockIdx.x * 6 + (wave - 2); m < M; m += G * 6) rms_row_to_fp8(X2 + (size_t)m * D, norm_ffn, XN8 + (size_t)m * D, lane);
        }
            };
        body11_();
        if ((PROBE_REP >> 11) & 1) { GRID_BAR(); if (blockIdx.x == 0 && tid < NE) CNT[64 * tid] = 0u; GRID_BAR(); body11_(); }
    }
    SEAM(11);

#define LOAD_BASES() do { __syncthreads(); if (tid == 0) { int b_ = 0; for (int e_ = 0; e_ < NE; ++e_) { const int c_ = (int)__hip_atomic_load(&CNT[64 * e_], __ATOMIC_RELAXED, __HIP_MEMORY_SCOPE_AGENT); \
        smi[8192 + e_] = b_; smi[8256 + e_] = c_; b_ += (c_ + 255) & ~255; } } __syncthreads(); } while (0)

    LAS int* tb = (LAS int*)(L + 131072 + 1024);
#define LOAD_TB(npn) do { __syncthreads(); if (tid == 0) { int b_ = 0, cu_ = 0; for (int e_ = 0; e_ < NE; ++e_) { const int c_ = (int)__hip_atomic_load(&CNT[64 * e_], __ATOMIC_RELAXED, __HIP_MEMORY_SCOPE_AGENT); \
        tb[e_] = b_; tb[32 + e_] = c_; tb[64 + e_] = cu_; b_ += (c_ + 255) & ~255; cu_ += ((c_ + 255) >> 8) * (npn); } tb[96] = cu_; } __syncthreads(); } while (0)
    PHASE_L(12, {
        LOAD_TB(8);
        pg8::Gemm g{(const bf16_t*)XN8, (const bf16_t*)WGU8, 512, 512, 512}; pg8::MoeOrder S{tb, TLIST, G, xcu, 8, 512, 512, 2048};
        pg8::gemm_phase<pg8::EpiMoeGU, pg8::MoeOrder, true, true>(L, g, S, pg8::EpiMoeGU{ACT8, b_gate_up, WSCGU});
    });
    SEAM(12);
    PHASE_L(13, {
        LOAD_TB(4);
        pg8::Gemm g{(const bf16_t*)ACT8, (const bf16_t*)WD8, 512, 512, 512}; pg8::MoeOrder S{tb, TLIST, G, xcu, 4, 512, 512, 1024};
        pg8::gemm_phase<pg8::EpiMoeDown, pg8::MoeOrder, false, true>(L, g, S, pg8::EpiMoeDown{YB, b_down, GLIST, tb, WSCD});
    });
    SEAM(13);

    PHASE(14) {
        LOAD_BASES();
        for (int mb = gw; mb < M; mb += 8 * NGW) {
            int slotv = 0;
            { const int i = lane >> 2, k = lane & 3, m = mb + NGW * i; if (lane < 32 && m < M) slotv = smi[8192 + TK_E[m * 4 + k]] + TK_POS[m * 4 + k]; }
#pragma unroll 2
            for (int i = 0; i < 8; ++i) {
                const int m = mb + NGW * i; if (m >= M) break;
                const f32x4* xr = (const f32x4*)(X2 + (size_t)m * D) + lane; const f32x4* gr = (const f32x4*)norm_final + lane;
                f32x4 v[4];
#pragma unroll
                for (int j = 0; j < 4; ++j) v[j] = xr[64 * j];
#pragma unroll
                for (int k = 0; k < 4; ++k) { const int slot = __builtin_amdgcn_readlane(slotv, 4 * i + k); const v2u* yr = (const v2u*)(YB + (size_t)slot * D) + lane;
#pragma unroll
                    for (int j = 0; j < 4; ++j) { const v2u w = yr[64 * j]; v[j].x += lo16(w.x); v[j].y += hi16(w.x); v[j].z += lo16(w.y); v[j].w += hi16(w.y); } }
                float ss = 0.f;
#pragma unroll
                for (int j = 0; j < 4; ++j) ss += (v[j].x * v[j].x + v[j].y * v[j].y) + (v[j].z * v[j].z + v[j].w * v[j].w);
                const float rinv = 1.0f / sqrtf(wave_sum(ss) * (1.f / 1024.f) + NORM_EPS);
                f32x4* orow = (f32x4*)(args.out + (size_t)m * D) + lane;
#pragma unroll
                for (int j = 0; j < 4; ++j) { const f32x4 gg = gr[64 * j]; orow[64 * j] = (f32x4){v[j].x * rinv * gg.x, v[j].y * rinv * gg.y, v[j].z * rinv * gg.z, v[j].w * rinv * gg.w}; }
            }
        }
    }
    if (PROBE_STAMP >= 0) { STAMP_AT(15); if (blockIdx.x == PROBE_BLOCK) { const unsigned long long t1_ = __builtin_amdgcn_s_memrealtime(); while (__builtin_amdgcn_s_memrealtime() - t1_ < st_dt_) __builtin_amdgcn_s_sleep(8); } }
#undef IN
#undef SEAM
}

extern "C" void kernel_launch(void* const* d_in, const int* in_sizes, int n_in, void* d_out, int out_size, void* d_ws, size_t ws_size, hipStream_t stream) {
    static int grid = 0;
    if (grid == 0) {
        if (n_in != 26 || out_size != M * D || ws_size < WS_END) { fprintf(stderr, "kernel_launch: unexpected sizes n_in %d out %d ws %zu\n", n_in, out_size, ws_size); grid = -1; return; }
        int dev = 0, cus = 0;
        if (hipGetDevice(&dev) != hipSuccess || hipDeviceGetAttribute(&cus, hipDeviceAttributeMultiprocessorCount, dev) != hipSuccess) { grid = -1; return; }
        if (hipFuncSetAttribute((const void*)fwd, hipFuncAttributeMaxDynamicSharedMemorySize, LDS_BYTES) != hipSuccess) { fprintf(stderr, "kernel_launch: hipFuncSetAttribute failed\n"); grid = -1; return; }
        int per_cu = 0;
        (void)hipOccupancyMaxActiveBlocksPerMultiprocessor(&per_cu, (const void*)fwd, NTHR, LDS_BYTES);
        (void)hipGetLastError();
        grid = cus;
    }
    if (grid < 0) return;
    (void)hipMemsetAsync((char*)d_ws + WS_CTL, 0, CTL_ZERO_BYTES, stream);
    Args a{};
    for (int i = 0; i < 26; ++i) a.in[i] = d_in[i];
    a.out = (float*)d_out; a.ws = (unsigned char*)d_ws;
#if MK_PER_PHASE
    for (int p = 0; p < NPHASE; ++p) { a.ph_lo = p; a.ph_hi = p + 1; hipLaunchKernelGGL(fwd, dim3(grid), dim3(NTHR), LDS_BYTES, stream, a); }
#else
    a.ph_lo = 0; a.ph_hi = NPHASE; hipLaunchKernelGGL(fwd, dim3(grid), dim3(NTHR), LDS_BYTES, stream, a);
#endif
}
```

```cpp
#include <hip/hip_runtime.h>
#include <cstdio>
#include <cstdint>

#ifndef MK_PER_PHASE
#define MK_PER_PHASE 0
#endif

#ifndef PROBE_STAMP
#define PROBE_STAMP -1
#endif
#ifndef PROBE_BLOCK
#define PROBE_BLOCK 0
#endif
#ifndef PROBE_REP
#define PROBE_REP 0
#endif
#define GAS __attribute__((address_space(1)))
#define LAS __attribute__((address_space(3)))
typedef unsigned short bf16_t;
typedef unsigned v4u __attribute__((ext_vector_type(4)));
typedef unsigned v2u __attribute__((ext_vector_type(2)));
typedef float f32x4 __attribute__((ext_vector_type(4)));
typedef short bf16x8 __attribute__((ext_vector_type(8)));

constexpr int BATCH = 4, SEQ = 4096, D = 1024, M = BATCH * SEQ, NIN = 5120;
constexpr int MEMLEN = 256, MM = BATCH * MEMLEN;
constexpr int NE = 32, TOPK = 4, DFF = 1024;
constexpr float NORM_EPS = 1e-6f;
constexpr int C_SBQ = 0, C_SBK = 512, C_SBV = 1024, C_DQ = 1536, C_DK = 2048, C_DV = 2560, C_GSB = 3072, C_GDF = 4096;
constexpr int LISTCAP = 16384;
constexpr int SLOTS = 65536 + NE * 256;
constexpr int NWAVES = 8, NTHR = 512;

constexpr size_t MiB = 1u << 20;
constexpr size_t WS_CTL = 0, CTL_ZERO_BYTES = 1 * MiB;
constexpr size_t WS_WIN = 2 * MiB;
constexpr size_t WS_WUPSB = 12 * MiB;
constexpr size_t WS_WUPDF = 13 * MiB;
constexpr size_t WS_WOUT = 14 * MiB;
constexpr size_t WS_WMQ = 16 * MiB;
constexpr size_t WS_WMKV = 18 * MiB;
constexpr size_t WS_WMO = 22 * MiB;
constexpr size_t WS_ROPE = 24 * MiB;
constexpr size_t WS_TK = 28 * MiB;
constexpr size_t WS_WR = 29 * MiB;
constexpr size_t WS_WSC = 30 * MiB;
constexpr size_t WS_WGU = 32 * MiB;
constexpr size_t WS_WD = 160 * MiB;
constexpr size_t WS_XN = 224 * MiB;
constexpr size_t WS_PR = 256 * MiB;
constexpr size_t WS_OAT = 416 * MiB;
constexpr size_t WS_ODR = 448 * MiB;
constexpr size_t WS_MIX = 512 * MiB;
constexpr size_t WS_X1 = 544 * MiB;
constexpr size_t WS_X2 = 608 * MiB;
constexpr size_t WS_HM = 672 * MiB;
constexpr size_t WS_KVM = 674 * MiB;
constexpr size_t WS_TLIST = 678 * MiB;
constexpr size_t WS_GLIST = 680 * MiB;
constexpr size_t WS_QM = 682 * MiB;
constexpr size_t WS_OM = 714 * MiB;
constexpr size_t WS_ACT = 256 * MiB;
constexpr size_t WS_YB = 746 * MiB;
constexpr size_t WS_VTSB = 890 * MiB;
constexpr size_t WS_VTDF = 906 * MiB;
constexpr size_t WS_VTM = 922 * MiB;
constexpr size_t WS_END = 924 * MiB;
static_assert(WS_ACT + (size_t)SLOTS * 1024 * 2 <= WS_OAT, "ACT overlay");
static_assert(WS_YB + (size_t)SLOTS * 1024 * 2 <= WS_VTSB, "YB");
constexpr int CW_REDO = 16384;
constexpr int CW_SBQ = 6144;
constexpr int CW_CNT = 8192;
constexpr int CW_BAR = 1024;

constexpr int LDS_BYTES = 147456;
constexpr int MISC_OFF = 131072 + 320;

__device__ __forceinline__ float bf2f(bf16_t b) { return __uint_as_float(((unsigned)b) << 16); }
__device__ __forceinline__ unsigned f2bf(float f) { unsigned u = __float_as_uint(f); return (u + 0x7fffu + ((u >> 16) & 1u)) >> 16; }
__device__ __forceinline__ unsigned pk2(float lo, float hi) { return f2bf(lo) | (f2bf(hi) << 16); }
__device__ __forceinline__ unsigned pk4_fp8(float a, float b, float c, float d) { int w = 0; w = __builtin_amdgcn_cvt_pk_fp8_f32(a, b, w, false); w = __builtin_amdgcn_cvt_pk_fp8_f32(c, d, w, true); return (unsigned)w; }
__device__ __forceinline__ float lo16(unsigned w) { return __uint_as_float(w << 16); }
__device__ __forceinline__ float hi16(unsigned w) { return __uint_as_float(w & 0xffff0000u); }
#define LDS_WAIT() asm volatile("s_waitcnt lgkmcnt(0)" ::: "memory")
__device__ __forceinline__ float wave_sum(float v) {
#pragma unroll
    for (int o = 1; o < 64; o <<= 1) v += __shfl_xor(v, o);
    return v;
}
__device__ __forceinline__ float wave_max(float v) {
#pragma unroll
    for (int o = 1; o < 64; o <<= 1) v = fmaxf(v, __shfl_xor(v, o));
    return v;
}

#define XB_TMO      128
#define XB_XCNT(j)  (256  + 64 * (j))
#define XB_XSUB(j)  (1280 + 64 * (j))
#define XB_XGEN(j)  (2304 + 64 * (j))
#define XB_TOP      3328
#define XB_TOPGEN   3392
#define XCD_BAR_WORDS 3456
#define XB_SPIN_CAP (1u << 18)
__device__ __forceinline__ unsigned xb_ld(unsigned* p)              { return __hip_atomic_load(p, __ATOMIC_RELAXED, __HIP_MEMORY_SCOPE_AGENT); }
__device__ __forceinline__ unsigned xb_add(unsigned* p, unsigned v) { return __hip_atomic_fetch_add(p, v, __ATOMIC_RELAXED, __HIP_MEMORY_SCOPE_AGENT); }
__device__ __forceinline__ unsigned xb_xcc_id() { return (unsigned)__builtin_amdgcn_s_getreg((3 << 11) | 20) & 0xFu; }
#define XB_SPIN(cond, bar) do { unsigned _sp = 0; while (cond) { __builtin_amdgcn_s_sleep(1); \
    if ((++_sp & 255u) == 0u) { if (xb_ld(&(bar)[XB_TMO])) break; if (_sp > XB_SPIN_CAP) { atomicAdd(&(bar)[XB_TMO], 1u); break; } } } } while (0)
struct XcdBarrier { unsigned* bar; unsigned x; volatile LAS unsigned* st; };
__device__ __forceinline__ XcdBarrier xcd_barrier_post(unsigned* bar, volatile LAS unsigned* st) {
    XcdBarrier b; b.bar = bar; b.x = xb_xcc_id(); b.st = st;
    if (threadIdx.x == 0) (void)xb_add(&bar[XB_XCNT(b.x)], 1u);
    return b;
}
__device__ __forceinline__ void xcd_barrier_complete(unsigned* bar, unsigned x, unsigned& nloc, unsigned& nx) {
    const unsigned G = gridDim.x * gridDim.y * gridDim.z;
    unsigned sum, cnt, mine, sp = 0u;
    for (;;) {
        sum = 0u; cnt = 0u; mine = 0u;
#pragma unroll
        for (unsigned j = 0; j < 16; ++j) { const unsigned c = xb_ld(&bar[XB_XCNT(j)]); sum += c; cnt += (c > 0u) ? 1u : 0u; mine = (j == x) ? c : mine; }
        if (sum == G) break;
        __builtin_amdgcn_s_sleep(1);
        if ((++sp & 255u) == 0u) { if (xb_ld(&bar[XB_TMO])) break; if (sp > XB_SPIN_CAP) { atomicAdd(&bar[XB_TMO], 1u); break; } }
    }
    nloc = mine > 0u ? mine : 1u; nx = cnt > 0u ? cnt : 1u;
}
__device__ __forceinline__ void xcd_barrier(const XcdBarrier& b) {
    asm volatile("s_waitcnt vmcnt(0)" ::: "memory");
    __syncthreads();
    if (threadIdx.x == 0) {
        unsigned* bar = b.bar;
        __builtin_amdgcn_s_waitcnt(0);
        unsigned nloc = b.st[0], nx = b.st[1];
        if (nloc == 0u) { xcd_barrier_complete(bar, b.x, nloc, nx); b.st[0] = nloc; b.st[1] = nx; }
        const unsigned old = xb_add(&bar[XB_XSUB(b.x)], 1u);
        const unsigned gen = old / nloc;
        if (old + 1u == (gen + 1u) * nloc) {
            __builtin_amdgcn_fence(__ATOMIC_RELEASE, "agent");
            asm volatile("s_waitcnt vmcnt(0)" ::: "memory");
            const unsigned og = xb_add(&bar[XB_TOP], 1u);
            const unsigned tg = og / nx;
            if (og + 1u == (tg + 1u) * nx) xb_add(&bar[XB_TOPGEN], 1u);
            else XB_SPIN(xb_ld(&bar[XB_TOPGEN]) == tg, bar);
            __builtin_amdgcn_fence(__ATOMIC_ACQUIRE, "agent");
            xb_add(&bar[XB_XGEN(b.x)], 1u);
            asm volatile("s_waitcnt vmcnt(0)" ::: "memory");
        } else {
            XB_SPIN(xb_ld(&bar[XB_XGEN(b.x)]) == gen, bar);
            __builtin_amdgcn_fence(__ATOMIC_ACQUIRE, "agent");
            asm volatile("s_waitcnt vmcnt(0)" ::: "memory");
        }
    }
    __syncthreads();
}

__device__ __forceinline__ void p0_transpose_item(const float* W, int K, int N, bf16_t* WT, int drow0, int k0, int n0, LAS float* scr, int lane, const float* gain = nullptr, int ldw = 0, int koff = 0) {
    if (ldw == 0) ldw = K;
#pragma unroll 8
    for (int i = 0; i < 32; ++i) { const int kk = 2 * i + (lane >> 5); float v = W[(size_t)(k0 + kk) * N + n0 + (lane & 31)]; if (gain) v *= gain[k0 + kk]; scr[kk * 33 + (lane & 31)] = v; }
    LDS_WAIT(); asm volatile("" ::: "memory");
    const int c = lane & 7;
#pragma unroll
    for (int j = 0; j < 4; ++j) { const int n = (lane >> 3) + 8 * j; const LAS float* s = scr + (8 * c) * 33 + n;
        v4u o; o.x = pk2(s[0 * 33], s[1 * 33]); o.y = pk2(s[2 * 33], s[3 * 33]); o.z = pk2(s[4 * 33], s[5 * 33]); o.w = pk2(s[6 * 33], s[7 * 33]);
        *(v4u*)(WT + (size_t)(drow0 + n) * ldw + koff + k0 + 8 * c) = o; }
    LDS_WAIT(); asm volatile("" ::: "memory");
}
__device__ __forceinline__ void p0_plain(const float* W, int K, int N, bf16_t* WT, int item, LAS float* scr, int lane, const float* gain = nullptr, int ldw = 0, int koff = 0) {
    const int nblk = N / 32, kb = item / nblk, nb = item % nblk;
    p0_transpose_item(W, K, N, WT, 32 * nb, 64 * kb, 32 * nb, scr, lane, gain, ldw, koff);
}
__device__ __forceinline__ void p0_transpose_rope(const float* W, bf16_t* WT, int tilebase, int o, int k0, int n0, LAS float* scr, int lane) {
    const int K = 1024, N = NIN;
#pragma unroll 8
    for (int i = 0; i < 32; ++i) { const int kk = 2 * i + (lane >> 5); scr[kk * 33 + (lane & 31)] = W[(size_t)(k0 + kk) * N + n0 + (lane & 31)]; }
    LDS_WAIT(); asm volatile("" ::: "memory");
    const int c = lane & 7;
#pragma unroll
    for (int j = 0; j < 4; ++j) { const int n = (lane >> 3) + 8 * j; const LAS float* s = scr + (8 * c) * 33 + n;
        const int oo = o + n, v = ((oo >> 6) << 6) | (((oo >> 4) & 1) << 5) | (((oo >> 2) & 3) << 3) | (((oo >> 5) & 1) << 2) | (oo & 3);
        v4u w; w.x = pk2(s[0 * 33], s[1 * 33]); w.y = pk2(s[2 * 33], s[3 * 33]); w.z = pk2(s[4 * 33], s[5 * 33]); w.w = pk2(s[6 * 33], s[7 * 33]);
        *(v4u*)(WT + (size_t)(tilebase + v) * K + k0 + 8 * c) = w; }
    LDS_WAIT(); asm volatile("" ::: "memory");
}
__device__ __forceinline__ void rms_row_to_bf16(const float* xrow, const float* g, bf16_t* orow, int lane) {
    const f32x4* xr = (const f32x4*)xrow + lane; const f32x4* gr = (const f32x4*)g + lane;
    f32x4 v[4]; float s = 0.f;
#pragma unroll
    for (int j = 0; j < 4; ++j) { v[j] = xr[64 * j]; s += (v[j].x * v[j].x + v[j].y * v[j].y) + (v[j].z * v[j].z + v[j].w * v[j].w); }
    const float rinv = 1.0f / sqrtf(wave_sum(s) * (1.f / 1024.f) + NORM_EPS);
    v2u* o8 = (v2u*)orow + lane;
#pragma unroll
    for (int j = 0; j < 4; ++j) { const f32x4 gg = gr[64 * j]; v2u w; w.x = pk2(v[j].x * rinv * gg.x, v[j].y * rinv * gg.y); w.y = pk2(v[j].z * rinv * gg.z, v[j].w * rinv * gg.w); o8[64 * j] = w; }
}

template <bool FP8>
__device__ __forceinline__ void rms_rows2(const float* xa, const float* xb, bool hasb, const float* g, void* oa, void* ob, int lane) {
    const f32x4* ra = (const f32x4*)xa + lane; const f32x4* rb = (const f32x4*)(hasb ? xb : xa) + lane; const f32x4* gr = (const f32x4*)g + lane;
    f32x4 va[4], vb[4]; float sa = 0.f, sb = 0.f;
#pragma unroll
    for (int j = 0; j < 4; ++j) { va[j] = ra[64 * j]; vb[j] = rb[64 * j]; }
#pragma unroll
    for (int j = 0; j < 4; ++j) { sa += (va[j].x * va[j].x + va[j].y * va[j].y) + (va[j].z * va[j].z + va[j].w * va[j].w); sb += (vb[j].x * vb[j].x + vb[j].y * vb[j].y) + (vb[j].z * vb[j].z + vb[j].w * vb[j].w); }
    const float ia = 1.0f / sqrtf(wave_sum(sa) * (1.f / 1024.f) + NORM_EPS), ib = 1.0f / sqrtf(wave_sum(sb) * (1.f / 1024.f) + NORM_EPS);
#pragma unroll
    for (int j = 0; j < 4; ++j) { const f32x4 gg = gr[64 * j];
        if (FP8) { ((unsigned*)oa)[lane + 64 * j] = pk4_fp8(va[j].x * ia * gg.x, va[j].y * ia * gg.y, va[j].z * ia * gg.z, va[j].w * ia * gg.w);
                   if (hasb) ((unsigned*)ob)[lane + 64 * j] = pk4_fp8(vb[j].x * ib * gg.x, vb[j].y * ib * gg.y, vb[j].z * ib * gg.z, vb[j].w * ib * gg.w); }
        else { v2u w; w.x = pk2(va[j].x * ia * gg.x, va[j].y * ia * gg.y); w.y = pk2(va[j].z * ia * gg.z, va[j].w * ia * gg.w); ((v2u*)oa)[lane + 64 * j] = w;
               if (hasb) { v2u w2; w2.x = pk2(vb[j].x * ib * gg.x, vb[j].y * ib * gg.y); w2.y = pk2(vb[j].z * ib * gg.z, vb[j].w * ib * gg.w); ((v2u*)ob)[lane + 64 * j] = w2; } } }
}
__device__ __forceinline__ void rms_row_to_fp8(const float* xrow, const float* g, unsigned char* orow, int lane) {
    const f32x4* xr = (const f32x4*)xrow + lane; const f32x4* gr = (const f32x4*)g + lane;
    f32x4 v[4]; float s = 0.f;
#pragma unroll
    for (int j = 0; j < 4; ++j) { v[j] = xr[64 * j]; s += (v[j].x * v[j].x + v[j].y * v[j].y) + (v[j].z * v[j].z + v[j].w * v[j].w); }
    const float rinv = 1.0f / sqrtf(wave_sum(s) * (1.f / 1024.f) + NORM_EPS);
    unsigned* o4 = (unsigned*)orow + lane;
#pragma unroll
    for (int j = 0; j < 4; ++j) { const f32x4 gg = gr[64 * j]; o4[64 * j] = pk4_fp8(v[j].x * rinv * gg.x, v[j].y * rinv * gg.y, v[j].z * rinv * gg.z, v[j].w * rinv * gg.w); }
}
namespace pg8 {
constexpr int BM = 256, BK = 64, HALF = 128, HTB = HALF * BK * 2, STAGE_BYTES = 8 * HTB;
__host__ __device__ __forceinline__ int lds_byte(int r, int c) { const int st = (r >> 4) * 2 + (c >> 5), rr = r & 15, cc = c & 31, ob = rr * 64 + cc * 2; return st * 1024 + (ob ^ (((ob >> 9) & 1) << 5)); }
__host__ __device__ __forceinline__ void stage_rc(int b, int& R, int& C) { const int st = b / 1024, sb = b % 1024, swz = sb ^ (((sb >> 9) & 1) << 5); R = (st >> 1) * 16 + swz / 64; C = (st & 1) * 32 + (swz % 64) / 2; }
__host__ __device__ __forceinline__ int perm32(int rho) { const int n = rho >> 4, i = rho & 15; return 8 * (i >> 2) + 4 * n + (i & 3); }
struct Unit { int pm, pn, e; };
struct Gemm { const bf16_t* A; const bf16_t* Bt; int lda, ldb, K; };
typedef float f32x2 __attribute__((ext_vector_type(2))); typedef __bf16 bf16x2_t __attribute__((ext_vector_type(2)));
__device__ __forceinline__ unsigned cvt_pk_bf16(float lo, float hi) { f32x2 v = {lo, hi}; bf16x2_t b = __builtin_convertvector(v, bf16x2_t); return __builtin_bit_cast(unsigned, b); }

typedef int v8i __attribute__((ext_vector_type(8))); typedef int v4i __attribute__((ext_vector_type(4)));
__device__ __forceinline__ v8i cat8(bf16x8 a, bf16x8 b) { return __builtin_shufflevector(__builtin_bit_cast(v4i, a), __builtin_bit_cast(v4i, b), 0, 1, 2, 3, 4, 5, 6, 7); }
template <class Epi, class Sched, bool GATHER, bool FP8 = false>
__device__ __forceinline__ void gemm_phase(LAS unsigned char* lds, const Gemm g, const Sched& S, const Epi& E) {
    const int tid = threadIdx.x, wid = __builtin_amdgcn_readfirstlane(tid >> 6), lane = tid & 63, wr = wid >> 2, wc = wid & 3, fr = lane & 15, fq = lane >> 4;
    const int K = g.K, nt = K / BK;
    unsigned voffB[2], cva[2][2], nva[2][2];
#pragma unroll
    for (int i = 0; i < 2; ++i) { int R, C; stage_rc(tid * 16 + i * 8192, R, C); const int Rb = (R & ~31) + perm32(R & 31);
        voffB[i] = (unsigned)(Rb * g.ldb + C) * 2u;
#pragma unroll
        for (int h = 0; h < 2; ++h) { cva[h][i] = (unsigned)((h * HALF + R) * g.lda + C) * 2u; nva[h][i] = cva[h][i]; } }
    const unsigned kstep = (unsigned)(BK * 2);
    const unsigned hstepB = (unsigned)(HALF * g.ldb * 2);
    auto uni_ptr = [](const void* p_) { const unsigned long long v_ = (unsigned long long)p_; return (void*)(((unsigned long long)(unsigned)__builtin_amdgcn_readfirstlane((int)(v_ >> 32)) << 32) | (unsigned)__builtin_amdgcn_readfirstlane((int)v_)); };
    const auto rA = __builtin_amdgcn_make_buffer_rsrc(uni_ptr(g.A), 0, 0x7fffffff, 0x00020000), rB = __builtin_amdgcn_make_buffer_rsrc(uni_ptr(g.Bt), 0, 0x7fffffff, 0x00020000);
    const unsigned ldsw = (unsigned)wid * 1024u;
    const int aoff = lds_byte(wr * 64 + fr, fq * 8), boff = lds_byte(wc * 32 + fr, fq * 8);
#define PG8_SA(b, h) (((b) * 2 + (h)) * HTB)
#define PG8_SB(b, h) ((4 + (b) * 2 + (h)) * HTB)
#define PG8_STAGE(bufoff, rs, soff, voff) do { _Pragma("unroll") for (int _i = 0; _i < 2; ++_i) \
        __builtin_amdgcn_raw_ptr_buffer_load_lds(rs, (LAS unsigned*)(lds + (bufoff) + ldsw + _i * 8192), 16, (int)(voff)[_i], (int)(soff), 0, 0); } while (0)
#define PG8_LDA(dst, b, h) do { _Pragma("unroll") for (int m = 0; m < 4; ++m) _Pragma("unroll") for (int k = 0; k < 2; ++k) dst[m][k] = *(const LAS bf16x8*)(lds + PG8_SA(b, h) + aoff + m * 2048 + k * 1024); } while (0)
#define PG8_LDB(dst, b, h) do { _Pragma("unroll") for (int n = 0; n < 2; ++n) _Pragma("unroll") for (int k = 0; k < 2; ++k) dst[n][k] = *(const LAS bf16x8*)(lds + PG8_SB(b, h) + boff + n * 2048 + k * 1024); } while (0)
#define PG8_MMA(ai, bj, At, Bt) do { __builtin_amdgcn_s_setprio(1); _Pragma("unroll") for (int m = 0; m < 4; ++m) _Pragma("unroll") for (int n = 0; n < 2; ++n) { \
        if constexpr (FP8) { const v8i b8_ = cat8(Bt[n][0], Bt[n][1]), a8_ = cat8(At[m][0], At[m][1]); \
            asm volatile("s_nop 1\n\tv_mfma_scale_f32_16x16x128_f8f6f4 %0, %1, %2, %0, %3, %3 op_sel_hi:[0,0,0]" : "+v"(acc[ai][bj][m][n]) : "v"(b8_), "v"(a8_), "v"(one_scale)); } \
        else { _Pragma("unroll") for (int k = 0; k < 2; ++k) acc[ai][bj][m][n] = __builtin_amdgcn_mfma_f32_16x16x32_bf16(Bt[n][k], At[m][k], acc[ai][bj][m][n], 0, 0, 0); } } __builtin_amdgcn_s_setprio(0); } while (0)
#define PG8_WAIT_V(n) asm volatile("s_waitcnt vmcnt(" #n ")" ::: "memory")
#define PG8_WAIT_L(n) asm volatile("s_waitcnt lgkmcnt(" #n ")" ::: "memory")
#define PG8_BAR __builtin_amdgcn_s_barrier()
#define PG8_SCHED __builtin_amdgcn_sched_barrier(0)
    Unit cur, nxt; int ui = 0;
    if (!S.next(0, cur)) return;
    if constexpr (GATHER) {
#pragma unroll
        for (int i = 0; i < 2; ++i) { int R, C; stage_rc(tid * 16 + i * 8192, R, C);
#pragma unroll
            for (int h = 0; h < 2; ++h) cva[h][i] = (unsigned)(S.tok(cur, h * HALF + R) * g.lda + C) * 2u; }
    }
    const int one_scale = 0x7f7f7f7f;
    (void)one_scale;
    f32x4 acc[2][2][4][2];
#pragma unroll
    for (int a = 0; a < 2; ++a)
#pragma unroll
        for (int b = 0; b < 2; ++b)
#pragma unroll
            for (int m = 0; m < 4; ++m)
#pragma unroll
                for (int n = 0; n < 2; ++n) acc[a][b][m][n] = (f32x4){0.f, 0.f, 0.f, 0.f};
    bf16x8 At[4][2], B0[2][2], B1[2][2];
    unsigned cA = GATHER ? 0u : (unsigned)S.a_off(cur), cB = (unsigned)S.b_off(cur);
    PG8_STAGE(PG8_SB(0, 0), rB, cB, voffB); PG8_STAGE(PG8_SB(0, 1), rB, cB + hstepB, voffB); PG8_STAGE(PG8_SA(0, 0), rA, cA, cva[0]); PG8_STAGE(PG8_SA(0, 1), rA, cA, cva[1]);
    if (wr == 1) PG8_BAR;
    PG8_WAIT_V(2); PG8_BAR;
    PG8_STAGE(PG8_SB(1, 0), rB, cB + kstep, voffB); PG8_STAGE(PG8_SA(1, 0), rA, cA + kstep, cva[0]); PG8_STAGE(PG8_SB(1, 1), rB, cB + hstepB + kstep, voffB);
    PG8_WAIT_V(6); PG8_BAR;
    for (;;) {
        const bool has_next = S.next(ui + 1, nxt);
        const unsigned nA = (has_next && !GATHER) ? (unsigned)S.a_off(nxt) : cA, nB = has_next ? (unsigned)S.b_off(nxt) : cB;
        if constexpr (GATHER) {
#pragma unroll
            for (int i = 0; i < 2; ++i) { int R, C; stage_rc(tid * 16 + i * 8192, R, C);
#pragma unroll
                for (int h = 0; h < 2; ++h) nva[h][i] = has_next ? (unsigned)(S.tok(nxt, h * HALF + R) * g.lda + C) * 2u : cva[h][i]; }
        }
#pragma nounroll
        for (int t = 0; t < nt; t += 2) {
            const bool last = (t == nt - 2);
            const unsigned a1 = cA + (unsigned)(t + 1) * kstep;
            const unsigned a2 = last ? nA : cA + (unsigned)(t + 2) * kstep, b2 = last ? nB : cB + (unsigned)(t + 2) * kstep;
            const unsigned a3 = a2 + kstep, b3 = b2 + kstep;
            PG8_LDB(B0, 0, 0); PG8_LDB(B1, 0, 1); PG8_SCHED; PG8_LDA(At, 0, 0); PG8_STAGE(PG8_SA(1, 1), rA, a1, cva[1]);
            if constexpr (GATHER) { if (last) {
#pragma unroll
                for (int h = 0; h < 2; ++h)
#pragma unroll
                    for (int i = 0; i < 2; ++i) cva[h][i] = nva[h][i]; } }
            PG8_WAIT_V(8); PG8_WAIT_L(0); PG8_BAR; PG8_MMA(0, 0, At, B0); PG8_MMA(0, 1, At, B1); PG8_BAR; PG8_SCHED;
            PG8_LDA(At, 0, 1); PG8_STAGE(PG8_SB(0, 0), rB, b2, voffB); PG8_STAGE(PG8_SB(0, 1), rB, b2 + hstepB, voffB); PG8_STAGE(PG8_SA(0, 0), rA, a2, cva[0]);
            PG8_WAIT_V(8); PG8_WAIT_L(0); PG8_BAR; PG8_MMA(1, 0, At, B0); PG8_MMA(1, 1, At, B1); PG8_BAR; PG8_SCHED;
            PG8_LDB(B0, 1, 0); PG8_LDB(B1, 1, 1); PG8_SCHED; PG8_LDA(At, 1, 0); PG8_STAGE(PG8_SA(0, 1), rA, a2, cva[1]);
            PG8_WAIT_V(8); PG8_WAIT_L(0); PG8_BAR; PG8_MMA(0, 0, At, B0); PG8_MMA(0, 1, At, B1); PG8_BAR; PG8_SCHED;
            PG8_LDA(At, 1, 1); PG8_STAGE(PG8_SB(1, 0), rB, b3, voffB); PG8_STAGE(PG8_SB(1, 1), rB, b3 + hstepB, voffB); PG8_STAGE(PG8_SA(1, 0), rA, a3, cva[0]);
            PG8_WAIT_V(8); PG8_WAIT_L(0); PG8_BAR; PG8_MMA(1, 0, At, B0); PG8_MMA(1, 1, At, B1); PG8_BAR; PG8_SCHED;
        }
        if (wr == 0) PG8_BAR;
        if constexpr (FP8) asm volatile("s_nop 15\n\ts_nop 7" ::: "memory");
        E(acc, cur, wr, wc, fr, fq);
        if (!has_next) break;
#pragma unroll
        for (int a = 0; a < 2; ++a)
#pragma unroll
            for (int b = 0; b < 2; ++b)
#pragma unroll
                for (int m = 0; m < 4; ++m)
#pragma unroll
                    for (int n = 0; n < 2; ++n) acc[a][b][m][n] = (f32x4){0.f, 0.f, 0.f, 0.f};
        cur = nxt; cA = nA; cB = nB; ++ui;
        if constexpr (GATHER) {
#pragma unroll
            for (int i = 0; i < 2; ++i)
#pragma unroll
                for (int h = 0; h < 2; ++h) cva[h][i] = nva[h][i];
        }
        if (wr == 1) PG8_BAR;
    }
    PG8_WAIT_V(0);
    PG8_BAR;
#undef PG8_SA
#undef PG8_SB
#undef PG8_STAGE
#undef PG8_LDA
#undef PG8_LDB
#undef PG8_MMA
#undef PG8_WAIT_V
#undef PG8_WAIT_L
#undef PG8_BAR
#undef PG8_SCHED
}

struct DenseOrder {
    int nM, nN, nwg, G, c, lda, ldb, i0 = 0, i1 = 1 << 30;
    __device__ __forceinline__ void init(int M_, int N_, int G_, int c_, int lda_, int ldb_) { nM = M_ / BM; nN = N_ / BM; nwg = nM * nN; G = G_; c = c_; lda = lda_; ldb = ldb_; }
    __device__ __forceinline__ bool next(int i, Unit& u) const {
        if (i + i0 >= i1) return false;
        const long L = (long)(i + i0) * G + c; if (L >= nwg) return false;
        int wgid = (int)L; { const int q = nwg / 8, r = nwg % 8, xcd = wgid % 8, off = wgid / 8; wgid = (xcd < r ? xcd * (q + 1) : r * (q + 1) + (xcd - r) * q) + off; }
        const int nig = 8 * nN, gid = wgid / nig, fm = gid * 8, gsz = (nM - fm) < 8 ? (nM - fm) : 8;
        u.pm = fm + ((wgid % nig) % gsz); u.pn = (wgid % nig) / gsz; u.e = 0; return true;
    }
    __device__ __forceinline__ size_t a_off(const Unit& u) const { return (size_t)u.pm * BM * lda * 2; }
    __device__ __forceinline__ size_t b_off(const Unit& u) const { return (size_t)u.pn * BM * ldb * 2; }
    __device__ __forceinline__ int tok(const Unit&, int) const { return 0; }
};
struct TwoRoundOrder {
    int G, c, lda, ldb;
    __device__ __forceinline__ bool next(int i, Unit& u) const { const int L = i * G + c; if (L >= 512) return false; const int tile = L & 255; u.pm = tile >> 2; u.pn = tile & 3; u.e = L >> 8; return true; }
    __device__ __forceinline__ size_t a_off(const Unit& u) const { return (size_t)u.pm * BM * lda * 2 + (size_t)u.e * 1024; }
    __device__ __forceinline__ size_t b_off(const Unit& u) const { return (size_t)(u.e * 1024 + u.pn * BM) * ldb * 2; }
    __device__ __forceinline__ int tok(const Unit&, int) const { return 0; }
};
struct MoeOrder {
    const LAS int* tb; const int* tlist; int G, c, npn, lda, ldb, nexp;
    __device__ __forceinline__ bool next(int i, Unit& u) const {
        const int L = i * G + c; if (L >= tb[96]) return false;
        int e = 0; while (tb[65 + e] <= L) ++e;
        const int loc = L - tb[64 + e]; u.e = __builtin_amdgcn_readfirstlane(e); u.pn = __builtin_amdgcn_readfirstlane(loc % npn); u.pm = __builtin_amdgcn_readfirstlane((tb[e] >> 8) + loc / npn); return true;
    }
    __device__ __forceinline__ size_t a_off(const Unit& u) const { return (size_t)u.pm * BM * lda * 2; }
    __device__ __forceinline__ size_t b_off(const Unit& u) const { return (size_t)(u.e * nexp + u.pn * BM) * ldb * 2; }
    __device__ __forceinline__ int tok(const Unit& u, int row) const { const int r = u.pm * BM - tb[u.e] + row; return r < tb[32 + u.e] ? tlist[u.e * LISTCAP + r] : 0; }
};

#define EPI_ARGS const f32x4 (&acc)[2][2][4][2], const Unit& u, int wr, int wc, int fr, int fq
#define EPI_FOR_ROWS for (int ai = 0; ai < 2; ++ai) _Pragma("unroll") for (int m = 0; m < 4; ++m)
__device__ __forceinline__ v4u pack8(const f32x4 a, const f32x4 b) { v4u w; w.x = cvt_pk_bf16(a[0], a[1]); w.y = cvt_pk_bf16(a[2], a[3]); w.z = cvt_pk_bf16(b[0], b[1]); w.w = cvt_pk_bf16(b[2], b[3]); return w; }
__device__ __forceinline__ void unpack8(const v4u w, f32x4& a, f32x4& b) { a = (f32x4){lo16(w.x), hi16(w.x), lo16(w.y), hi16(w.y)}; b = (f32x4){lo16(w.z), hi16(w.z), lo16(w.w), hi16(w.w)}; }
__device__ __forceinline__ float sigm(float v) { return __builtin_amdgcn_rcpf(1.f + __expf(-v)); }

__device__ __forceinline__ void store_tile_T(const f32x4 (&acc)[2][2][4][2], bf16_t* VT, int vrow0, int s0, int pitch) {
#pragma unroll
    for (int bj = 0; bj < 2; ++bj)
#pragma unroll
        for (int n = 0; n < 2; ++n)
#pragma unroll
            for (int e = 0; e < 4; ++e) { bf16_t* vp = VT + (size_t)(vrow0 + 128 * bj + 4 * n + e) * pitch + ((s0 & ~12) | ((s0 & 8) >> 1) | ((s0 & 4) << 1));
#pragma unroll
                for (int ai = 0; ai < 2; ++ai)
#pragma unroll
                    for (int m = 0; m < 4; ++m) vp[128 * ai + 16 * m] = (bf16_t)(cvt_pk_bf16(acc[ai][bj][m][n][e], 0.f) & 0xffffu); }
}
struct EpiKV { static constexpr bool MIDHOOK = false; bf16_t* KVM; bf16_t* VTM;
    __device__ __forceinline__ void operator()(EPI_ARGS) const {
        const int row0 = u.pm * BM + wr * 64 + fr, col0 = u.pn * BM + wc * 32 + 8 * fq;
#pragma unroll
        EPI_FOR_ROWS { bf16_t* rowp = KVM + (size_t)(row0 + ai * HALF + m * 16) * 2048 + col0;
#pragma unroll
            for (int bj = 0; bj < 2; ++bj) *(v4u*)(rowp + bj * HALF) = pack8(acc[ai][bj][m][0], acc[ai][bj][m][1]); }
        if (u.pn >= 4) store_tile_T(acc, VTM, u.pm * 1024 + (u.pn - 4) * BM + wc * 32 + 8 * fq, wr * 64 + fr, MEMLEN);
    } };
struct EpiResidNorm { static constexpr bool MIDHOOK = false; const float* base; float* out; bf16_t* XB; float* SSQ;
    __device__ __forceinline__ void operator()(EPI_ARGS) const {
        const int row0 = u.pm * BM + wr * 64 + fr, col0 = u.pn * BM + wc * 32 + 8 * fq;
#pragma unroll
        EPI_FOR_ROWS { const int row = row0 + ai * HALF + m * 16; const size_t off = (size_t)row * D + col0; float ss = 0.f;
#pragma unroll
            for (int bj = 0; bj < 2; ++bj) { f32x4 v[2];
#pragma unroll
                for (int n = 0; n < 2; ++n) { v[n] = *(const f32x4*)(base + off + bj * HALF + 4 * n) + acc[ai][bj][m][n];
                    ss += (v[n][0] * v[n][0] + v[n][1] * v[n][1]) + (v[n][2] * v[n][2] + v[n][3] * v[n][3]); }
                *(v4u*)(XB + off + bj * HALF) = pack8(v[0], v[1]); }
            ss += __shfl_xor(ss, 16); ss += __shfl_xor(ss, 32);
            if (fq == 0) SSQ[(size_t)row * 16 + u.pn * 4 + wc] = ss; }
    } };
struct EpiBf16Rinv { static constexpr bool MIDHOOK = false; bf16_t* O; const float* SSQ; float qscale;
    __device__ __forceinline__ void operator()(EPI_ARGS) const {
        const int row0 = u.pm * BM + wr * 64 + fr, col0 = u.pn * BM + wc * 32 + 8 * fq;
#pragma unroll
        EPI_FOR_ROWS { const int row = row0 + ai * HALF + m * 16; const f32x4* sp = (const f32x4*)(SSQ + (size_t)row * 16);
            const f32x4 s0 = sp[0], s1 = sp[1], s2 = sp[2], s3 = sp[3];
            const float tot = (((s0[0] + s0[1]) + (s0[2] + s0[3])) + ((s1[0] + s1[1]) + (s1[2] + s1[3]))) + (((s2[0] + s2[1]) + (s2[2] + s2[3])) + ((s3[0] + s3[1]) + (s3[2] + s3[3])));
            const float rinv = qscale / sqrtf(tot * (1.f / 1024.f) + NORM_EPS);
            bf16_t* rowp = O + (size_t)row * D + col0;
#pragma unroll
            for (int bj = 0; bj < 2; ++bj) *(v4u*)(rowp + bj * HALF) = pack8(acc[ai][bj][m][0] * rinv, acc[ai][bj][m][1] * rinv); }
    } };
struct OneUnitOrder {
    int idx, lda, ldb;
    __device__ __forceinline__ bool next(int i, Unit& u) const { if (i > 0) return false; u.pm = idx >> 3; u.pn = idx & 7; u.e = 0; return true; }
    __device__ __forceinline__ size_t a_off(const Unit& u) const { return (size_t)u.pm * BM * lda * 2; }
    __device__ __forceinline__ size_t b_off(const Unit& u) const { return (size_t)u.pn * BM * ldb * 2; }
    __device__ __forceinline__ int tok(const Unit&, int) const { return 0; }
};
struct EpiResidB { static constexpr bool MIDHOOK = false; const bf16_t* base; float* out;
    __device__ __forceinline__ void operator()(EPI_ARGS) const {
        const int row0 = u.pm * BM + wr * 64 + fr, col0 = u.pn * BM + wc * 32 + 8 * fq;
#pragma unroll
        EPI_FOR_ROWS { const size_t off = (size_t)(row0 + ai * HALF + m * 16) * D + col0;
#pragma unroll
            for (int bj = 0; bj < 2; ++bj) { f32x4 b0, b1; unpack8(*(const v4u*)(base + off + bj * HALF), b0, b1);
                *(f32x4*)(out + off + bj * HALF) = b0 + acc[ai][bj][m][0]; *(f32x4*)(out + off + bj * HALF + 4) = b1 + acc[ai][bj][m][1]; } }
    } };
struct EpiGate { static constexpr bool MIDHOOK = false; const bf16_t* PR; bf16_t* T; bf16_t* MIX;
    __device__ __forceinline__ void operator()(EPI_ARGS) const {
        const int row0 = u.pm * BM + wr * 64 + fr, col0 = u.pn * BM + wc * 32 + 8 * fq;
#pragma unroll
        EPI_FOR_ROWS { const int row = row0 + ai * HALF + m * 16;
#pragma unroll
            for (int bj = 0; bj < 2; ++bj) { const int col = col0 + bj * HALF; f32x4 g0, g1;
                unpack8(*(const v4u*)(PR + (size_t)row * NIN + (u.e ? C_GDF : C_GSB) + col), g0, g1);
                bf16_t* tp = T + (size_t)row * D + col;
                if (u.e == 0) *(v4u*)tp = pack8(g0 * acc[ai][bj][m][0], g1 * acc[ai][bj][m][1]);
                else { f32x4 t0, t1; unpack8(*(const v4u*)tp, t0, t1); *(v4u*)(MIX + (size_t)row * D + col) = pack8(t0 + g0 * acc[ai][bj][m][0], t1 + g1 * acc[ai][bj][m][1]); } } }
    } };
struct EpiInProj { static constexpr bool MIDHOOK = false; bf16_t* PR; const float* rc; const float* rs; bf16_t* VTSB; bf16_t* VTDF;
    __device__ __forceinline__ void operator()(EPI_ARGS) const {
        const int row0 = u.pm * BM + wr * 64 + fr, pn = u.pn;
        if (pn >= 6 && pn < 10) {
            const float sc = pn < 8 ? 0.125f * 1.4426950408889634f : 1.0f; const int i0 = 16 * (wc & 1) + 4 * fq;
#pragma unroll
            EPI_FOR_ROWS { const int row = row0 + ai * HALF + m * 16; const f32x4 cs = *(const f32x4*)(rc + (size_t)row * 32 + i0), sn = *(const f32x4*)(rs + (size_t)row * 32 + i0);
#pragma unroll
                for (int bj = 0; bj < 2; ++bj) { const f32x4 lo = acc[ai][bj][m][0], hi = acc[ai][bj][m][1];
                    const f32x4 olo = (lo * cs - hi * sn) * sc, ohi = (hi * cs + lo * sn) * sc;
                    bf16_t* p = PR + (size_t)row * NIN + pn * BM + 64 * (2 * bj + (wc >> 1)) + i0;
                    v2u a, b; a.x = cvt_pk_bf16(olo[0], olo[1]); a.y = cvt_pk_bf16(olo[2], olo[3]); b.x = cvt_pk_bf16(ohi[0], ohi[1]); b.y = cvt_pk_bf16(ohi[2], ohi[3]);
                    *(v2u*)p = a; *(v2u*)(p + 32) = b; } }
        } else {
            const int col0 = pn * BM + wc * 32 + 8 * fq; const float sc = pn < 2 ? 0.125f * 1.4426950408889634f : 1.0f; const bool sg = pn >= 12;
            const bool vt = (pn == 4 || pn == 5 || pn == 10 || pn == 11);
            if (!vt) {
#pragma unroll
            EPI_FOR_ROWS { bf16_t* rowp = PR + (size_t)(row0 + ai * HALF + m * 16) * NIN + col0;
#pragma unroll
                for (int bj = 0; bj < 2; ++bj) { f32x4 v0 = acc[ai][bj][m][0] * sc, v1 = acc[ai][bj][m][1] * sc;
                    if (sg) { v0 = (f32x4){sigm(v0[0]), sigm(v0[1]), sigm(v0[2]), sigm(v0[3])}; v1 = (f32x4){sigm(v1[0]), sigm(v1[1]), sigm(v1[2]), sigm(v1[3])}; }
                    *(v4u*)(rowp + bj * HALF) = pack8(v0, v1); } }
            } else {
                const int bb = u.pm >> 4, s0 = (u.pm & 15) * BM + wr * 64 + fr, hd0 = (pn < 6 ? (pn - 4) : (pn - 10)) * BM + wc * 32 + 8 * fq;
                store_tile_T(acc, pn < 6 ? VTSB : VTDF, bb * 512 + hd0, s0, SEQ);
            }
        }
    } };
struct EpiMoeGU { static constexpr bool MIDHOOK = false; unsigned char* ACT8; const float* bgu; const float* wsc;
    __device__ __forceinline__ void operator()(EPI_ARGS) const {
        const int row0 = u.pm * BM + wr * 64 + fr, j0 = u.pn * 128 + wc * 32 + 8 * fq; const float* bg = bgu + (size_t)u.e * 2048 + j0; const float* sg = wsc + (size_t)u.e * 2048 + j0;
#pragma unroll
        EPI_FOR_ROWS { f32x4 o[2];
#pragma unroll
            for (int n = 0; n < 2; ++n) { const f32x4 gv = acc[ai][0][m][n] * *(const f32x4*)(sg + 4 * n) + *(const f32x4*)(bg + 4 * n), lv = acc[ai][1][m][n] * *(const f32x4*)(sg + 1024 + 4 * n) + *(const f32x4*)(bg + 1024 + 4 * n);
#pragma unroll
                for (int c = 0; c < 4; ++c) { const float gl = fminf(gv[c], 7.0f), li = fminf(fmaxf(lv[c], -7.0f), 7.0f); o[n][c] = gl * sigm(1.702f * gl) * (li + 1.0f); } }
            v2u w; w.x = pk4_fp8(o[0][0], o[0][1], o[0][2], o[0][3]); w.y = pk4_fp8(o[1][0], o[1][1], o[1][2], o[1][3]);
            *(v2u*)(ACT8 + (size_t)(row0 + ai * HALF + m * 16) * DFF + j0) = w; }
    } };
struct EpiMoeDown { static constexpr bool MIDHOOK = false; bf16_t* YB; const float* bd; const float* glist; const LAS int* tb; const float* wsc;
    __device__ __forceinline__ void operator()(EPI_ARGS) const {
        const int row0 = u.pm * BM + wr * 64 + fr, col0 = u.pn * BM + wc * 32 + 8 * fq; const float* bp = bd + (size_t)u.e * D + col0; const float* sp = wsc + (size_t)u.e * D + col0;
        const float* gl = glist + (size_t)u.e * LISTCAP - tb[u.e];
        f32x4 bv[2][2], sv[2][2];
#pragma unroll
        for (int bj = 0; bj < 2; ++bj)
#pragma unroll
            for (int n = 0; n < 2; ++n) { bv[bj][n] = *(const f32x4*)(bp + bj * HALF + 4 * n); sv[bj][n] = *(const f32x4*)(sp + bj * HALF + 4 * n); }
#pragma unroll
        EPI_FOR_ROWS { const int row = row0 + ai * HALF + m * 16; const float gt = gl[row];
#pragma unroll
            for (int bj = 0; bj < 2; ++bj) *(v4u*)(YB + (size_t)row * D + col0 + bj * HALF) = pack8((acc[ai][bj][m][0] * sv[bj][0] + bv[bj][0]) * gt, (acc[ai][bj][m][1] * sv[bj][1] + bv[bj][1]) * gt); }
    } };
}


typedef float f32x16 __attribute__((ext_vector_type(16)));
typedef short s16x4 __attribute__((ext_vector_type(4)));
__device__ __forceinline__ f32x16 mfma32(bf16x8 a, bf16x8 b, f32x16 c) { return __builtin_amdgcn_mfma_f32_32x32x16_bf16(a, b, c, 0, 0, 0); }
__device__ __forceinline__ float xhalf(float v, int hh) { auto rr = __builtin_amdgcn_permlane32_swap(__float_as_uint(v), __float_as_uint(v), false, false); return __uint_as_float(hh ? rr[0] : rr[1]); }
__device__ __forceinline__ bf16x8 pack_p(const f32x16& p, int s) { v4u w; w.x = pg8::cvt_pk_bf16(p[8 * s + 0], p[8 * s + 1]); w.y = pg8::cvt_pk_bf16(p[8 * s + 2], p[8 * s + 3]); w.z = pg8::cvt_pk_bf16(p[8 * s + 4], p[8 * s + 5]); w.w = pg8::cvt_pk_bf16(p[8 * s + 6], p[8 * s + 7]); return __builtin_bit_cast(bf16x8, w); }
constexpr float LOG2E = 1.4426950408889634f;

constexpr int VSTR = 136;
template <int NCH> __device__ __forceinline__ void stage_load(v4u (&r)[NCH], const bf16_t* g0, int chunks_per_row, size_t gpitch, int tid) {
#pragma unroll
    for (int i = 0; i < NCH; ++i) { const int c = tid + NTHR * i, row = c / chunks_per_row, ch = c % chunks_per_row; r[i] = *(const v4u*)(g0 + (size_t)row * gpitch + ch * 8); }
}
template <int NCH> __device__ __forceinline__ void stage_store_k(const v4u (&r)[NCH], LAS unsigned char* dst, int chunks_per_row, int lstride, int tid) {
#pragma unroll
    for (int i = 0; i < NCH; ++i) { const int c = tid + NTHR * i, row = c / chunks_per_row, ch = c % chunks_per_row; *(LAS v4u*)(dst + row * lstride + ch * 16) = r[i]; }
}
__device__ __forceinline__ bf16x8 lds_vfrag16(const LAS unsigned char* p) { return *(const LAS bf16x8*)p; }

constexpr float SM_THR = 8.0f;
template <int NO>
__device__ __forceinline__ void softmax_def2(f32x16& S0, f32x16& S1, bool first, float& mref, float& l, f32x16 (&O)[NO], int hh) {
    float mx = fmaxf(fmaxf(S0[0], S0[1]), fmaxf(S1[0], S1[1]));
#pragma unroll
    for (int i = 2; i < 16; i += 2) mx = fmaxf(mx, fmaxf(fmaxf(S0[i], S0[i + 1]), fmaxf(S1[i], S1[i + 1])));
    mx = fmaxf(mx, xhalf(mx, hh));
    if (first || __any(mx > SM_THR)) {
        const float dl = first ? mx : fmaxf(mx, 0.f), f = first ? 0.f : __builtin_amdgcn_exp2f(-dl);
        mref += dl; l *= f;
#pragma unroll
        for (int o = 0; o < NO; ++o) O[o] = O[o] * f;
#pragma unroll
        for (int i = 0; i < 16; ++i) { S0[i] -= dl; S1[i] -= dl; }
    }
    float ps = 0.f;
#pragma unroll
    for (int i = 0; i < 16; ++i) { S0[i] = __builtin_amdgcn_exp2f(S0[i]); S1[i] = __builtin_amdgcn_exp2f(S1[i]); ps += S0[i] + S1[i]; }
    l += ps;
}
template <int NO>
__device__ __forceinline__ void softmax_def1(f32x16& S, bool first, float& mref, float& l, f32x16 (&O)[NO], int hh) {
    float mx = fmaxf(fmaxf(S[0], S[1]), fmaxf(S[2], S[3]));
#pragma unroll
    for (int i = 4; i < 16; i += 4) mx = fmaxf(mx, fmaxf(fmaxf(S[i], S[i + 1]), fmaxf(S[i + 2], S[i + 3])));
    mx = fmaxf(mx, xhalf(mx, hh));
    if (first || __any(mx > SM_THR)) {
        const float dl = first ? mx : fmaxf(mx, 0.f), f = first ? 0.f : __builtin_amdgcn_exp2f(-dl);
        mref += dl; l *= f;
#pragma unroll
        for (int o = 0; o < NO; ++o) O[o] = O[o] * f;
#pragma unroll
        for (int i = 0; i < 16; ++i) S[i] -= dl;
    }
    float ps = 0.f;
#pragma unroll
    for (int i = 0; i < 16; ++i) { S[i] = __builtin_amdgcn_exp2f(S[i]); ps += S[i]; }
    l += ps;
}
__device__ __forceinline__ void attn_diff_block(const bf16_t* PR, const bf16_t* VT, bf16_t* OAT, const float* subln, float lam, int b, int h, int qb, LAS unsigned char* lds, int tid, int wave, int lane) {
    constexpr int KB = 8192, BUF = 2 * KB + 16384, QOFF = 3 * BUF;
    const int r32 = lane & 31, hh = lane >> 5, j = wave >> 2, w4 = wave & 3, q0 = qb * 128 + w4 * 32;
    const bf16_t* qrow = PR + (size_t)(b * SEQ + q0 + r32) * NIN + C_DQ + h * 128 + j * 64 + 8 * hh;
    LAS unsigned char* qs = lds + QOFF + wave * 4096 + lane * 16;
#pragma unroll
    for (int d0 = 0; d0 < 4; ++d0) *(LAS bf16x8*)(qs + d0 * 1024) = *(const bf16x8*)(qrow + 16 * d0);
    asm volatile("s_waitcnt vmcnt(0) lgkmcnt(0)" ::: "memory");
    const bf16_t* kg = PR + (size_t)(b * SEQ) * NIN + C_DK + h * 128;
    const bf16_t* vg = VT + (size_t)(b * 512 + h * 128) * SEQ;
    auto uni_ptr = [](const void* p_) __attribute__((always_inline)) { const unsigned long long v_ = (unsigned long long)p_; return (void*)(((unsigned long long)(unsigned)__builtin_amdgcn_readfirstlane((int)(v_ >> 32)) << 32) | (unsigned)__builtin_amdgcn_readfirstlane((int)v_)); };
    const auto rK = __builtin_amdgcn_make_buffer_rsrc(uni_ptr(kg), 0, 0x7fffffff, 0x00020000), rV = __builtin_amdgcn_make_buffer_rsrc(uni_ptr(vg), 0, 0x7fffffff, 0x00020000);
    const int prow = lane >> 3, pch = lane & 7;
    const int krow = 8 * wave + prow;
    const int kvoff = (krow * NIN + ((pch ^ (krow & 7)) << 3)) * 2;
    int vvoff[2];
#pragma unroll
    for (int pp = 0; pp < 2; ++pp) { const int vrow = 16 * wave + 8 * pp + prow; vvoff[pp] = (vrow * SEQ + ((pch ^ ((vrow ^ (vrow >> 3)) & 7)) << 3)) * 2; }
    auto dma = [&](int t_, int slot) __attribute__((always_inline)) {
        LAS unsigned char* sb_ = lds + slot;
        __builtin_amdgcn_raw_ptr_buffer_load_lds(rK, (LAS unsigned*)(sb_ + wave * 1024), 16, kvoff, t_ * (64 * NIN * 2), 0, 0);
        __builtin_amdgcn_raw_ptr_buffer_load_lds(rK, (LAS unsigned*)(sb_ + KB + wave * 1024), 16, kvoff + 128, t_ * (64 * NIN * 2), 0, 0);
        __builtin_amdgcn_raw_ptr_buffer_load_lds(rV, (LAS unsigned*)(sb_ + 2 * KB + wave * 2048), 16, vvoff[0], t_ * 128, 0, 0);
        __builtin_amdgcn_raw_ptr_buffer_load_lds(rV, (LAS unsigned*)(sb_ + 2 * KB + wave * 2048 + 1024), 16, vvoff[1], t_ * 128, 0, 0); };
    f32x16 O[4];
#pragma unroll
    for (int o = 0; o < 4; ++o)
#pragma unroll
        for (int i = 0; i < 16; ++i) O[o][i] = 0.f;
    float m = 0.f, l = 0.f;
    const int nsteps = 2 * qb + 2, my_last = 2 * qb + (w4 >> 1);
    const int xr = r32 & 7;
    bf16x8 p00, p01, p10, p11;
    f32x16 negm;
#pragma unroll
    for (int i = 0; i < 16; ++i) negm[i] = 0.f;
    auto qk_softmax = [&](int t, int slot) __attribute__((always_inline)) {
        if (t <= my_last) {
            const LAS unsigned char* kb = lds + slot + j * KB + r32 * 128;
            f32x16 S0, S1;
#pragma unroll
            for (int d0 = 0; d0 < 4; ++d0) { const int co = ((2 * d0 + hh) ^ xr) << 4; const bf16x8 qd = *(const LAS bf16x8*)(qs + d0 * 1024);
                S0 = mfma32(*(const LAS bf16x8*)(kb + co), qd, d0 == 0 ? negm : S0); S1 = mfma32(*(const LAS bf16x8*)(kb + 32 * 128 + co), qd, d0 == 0 ? negm : S1); }
            const float m_before = m;
            softmax_def2<4>(S0, S1, t == 0, m, l, O, hh);
            if (m != m_before) {
#pragma unroll
                for (int i = 0; i < 16; ++i) negm[i] = -m; }
            p00 = pack_p(S0, 0); p01 = pack_p(S0, 1); p10 = pack_p(S1, 0); p11 = pack_p(S1, 1);
        } };
    auto vfrag = [&](const LAS unsigned char* rowp, int c16, int sw) __attribute__((always_inline)) -> bf16x8 {
        return *(const LAS bf16x8*)(rowp + (((c16 + hh) ^ sw) << 4)); };
    auto pv = [&](int t, int slot) __attribute__((always_inline)) {
        if (t <= my_last) {
#pragma unroll
            for (int o = 0; o < 4; ++o) { const int d = 32 * o + r32, sw = (d ^ (d >> 3)) & 7; const LAS unsigned char* rowp = lds + slot + 2 * KB + d * 128;
                O[o] = mfma32(vfrag(rowp, 0, sw), p00, O[o]); O[o] = mfma32(vfrag(rowp, 2, sw), p01, O[o]); O[o] = mfma32(vfrag(rowp, 4, sw), p10, O[o]); O[o] = mfma32(vfrag(rowp, 6, sw), p11, O[o]); }
        } };
#define DIFF_BAR() do { asm volatile("s_waitcnt lgkmcnt(0)" ::: "memory"); __builtin_amdgcn_s_barrier(); asm volatile("" ::: "memory"); } while (0)
    dma(0, 0); dma(1, BUF);
    asm volatile("s_waitcnt vmcnt(4)" ::: "memory");
    DIFF_BAR();
#define DIFF_STEPS(H1, H2) { int sl = 0, slp = 2 * BUF, sln = BUF; \
    for (int t = 0; t < nsteps; ++t) { \
        H1(t, sl, slp); DIFF_BAR(); \
        const bool more = t + 2 < nsteps; \
        if (more) dma(t + 2, slp); \
        H2(t, sl); \
        if (more) asm volatile("s_waitcnt vmcnt(4)" ::: "memory"); else asm volatile("s_waitcnt vmcnt(0)" ::: "memory"); \
        DIFF_BAR(); \
        const int tmp_ = slp; slp = sl; sl = sln; sln = tmp_; } }
#define LEAD_H1(t, sl, slp) qk_softmax(t, sl)
#define LEAD_H2(t, sl) pv(t, sl)
#define LAG_H1(t, sl, slp) do { if ((t) > 0) pv((t) - 1, slp); } while (0)
#define LAG_H2(t, sl) qk_softmax(t, sl)
    if (j == 0) { DIFF_STEPS(LEAD_H1, LEAD_H2) } else { DIFF_STEPS(LAG_H1, LAG_H2) }
#undef DIFF_STEPS
#undef LEAD_H1
#undef LEAD_H2
#undef LAG_H1
#undef LAG_H2
    if (j == 1) pv(nsteps - 1, ((nsteps - 1) % 3) * BUF);
    DIFF_BAR();
#undef DIFF_BAR
    l += xhalf(l, hh);
    const float il = 1.f / l;
    LAS float* X = (LAS float*)lds + (size_t)(w4 * 32 + r32) * 132 + 4 * hh;
    if (j == 1) {
#pragma unroll
        for (int o = 0; o < 4; ++o)
#pragma unroll
            for (int g = 0; g < 4; ++g) *(LAS f32x4*)(X + 32 * o + 8 * g) = (f32x4){O[o][4 * g] * il, O[o][4 * g + 1] * il, O[o][4 * g + 2] * il, O[o][4 * g + 3] * il};
    }
    __syncthreads();
    if (j == 0) {
        float ss = 0.f;
#pragma unroll
        for (int o = 0; o < 4; ++o)
#pragma unroll
            for (int g = 0; g < 4; ++g) { const f32x4 o2 = *(const LAS f32x4*)(X + 32 * o + 8 * g);
#pragma unroll
                for (int c = 0; c < 4; ++c) { const float d = O[o][4 * g + c] * il - lam * o2[c]; O[o][4 * g + c] = d; ss += d * d; } }
        ss += xhalf(ss, hh);
        const float rinv = 0.8f / sqrtf(ss * (1.f / 128.f) + NORM_EPS);
        bf16_t* orow = OAT + (size_t)(b * SEQ + q0 + r32) * D + 512 + h * 128 + 4 * hh; const float* sl = subln + 4 * hh;
#pragma unroll
        for (int o = 0; o < 4; ++o)
#pragma unroll
            for (int g = 0; g < 4; ++g) { const f32x4 sg_ = *(const f32x4*)(sl + 32 * o + 8 * g); v2u w;
                w.x = pg8::cvt_pk_bf16(O[o][4 * g] * rinv * sg_[0], O[o][4 * g + 1] * rinv * sg_[1]); w.y = pg8::cvt_pk_bf16(O[o][4 * g + 2] * rinv * sg_[2], O[o][4 * g + 3] * rinv * sg_[3]); *(v2u*)(orow + 32 * o + 8 * g) = w; }
    }
    __syncthreads();
}

__device__ __forceinline__ void sb_subtile(f32x16& S, bool diag, float& R, f32x16 (&O)[2], const LAS unsigned char* vp, int r32, int hh) {
    f32x16 lr;
#pragma unroll
    for (int i = 0; i < 16; ++i) { const float z2 = S[i]; const float sp = fmaxf(z2, 0.f) + __builtin_amdgcn_logf(1.f + __builtin_amdgcn_exp2f(-fabsf(z2))); lr[i] = -sp; S[i] = z2 - sp; }
    if (diag) {
#pragma unroll
        for (int i = 0; i < 16; ++i) { const int kvl = (i & 3) + 8 * (i >> 2) + 4 * hh; if (kvl >= r32) { lr[i] = 0.f; S[i] = -INFINITY; } }
    }
    float tot[4], pt[4], off[4]; f32x16 ex;
#pragma unroll
    for (int g = 0; g < 4; ++g) { ex[4 * g + 3] = 0.f; ex[4 * g + 2] = lr[4 * g + 3]; ex[4 * g + 1] = lr[4 * g + 3] + lr[4 * g + 2]; ex[4 * g] = ex[4 * g + 1] + lr[4 * g + 1]; tot[g] = ex[4 * g] + lr[4 * g]; }
#pragma unroll
    for (int g = 0; g < 4; ++g) pt[g] = xhalf(tot[g], hh);
    const float own0 = hh ? 0.f : 1.f;
    float sp_ = 0.f;
#pragma unroll
    for (int g = 3; g >= 0; --g) { off[g] = sp_ + own0 * pt[g] + R; sp_ += tot[g] + pt[g]; }
#pragma unroll
    for (int i = 0; i < 16; ++i) S[i] = __builtin_amdgcn_exp2f(S[i] + ex[i] + off[i >> 2]);
    R += sp_;
    const bf16x8 p0 = pack_p(S, 0), p1 = pack_p(S, 1);
#pragma unroll
    for (int o = 0; o < 2; ++o) { O[o] = mfma32(lds_vfrag16(vp + 32 * o * 144), p0, O[o]); O[o] = mfma32(lds_vfrag16(vp + 32 * o * 144 + 32), p1, O[o]); }
}
__device__ __forceinline__ void attn_sb_block(const bf16_t* PR, const bf16_t* VT, bf16_t* OAT, int b, int h, int qb, LAS unsigned char* lds, volatile LAS unsigned* fl, int tid, int wave, int lane) {
    constexpr int KSTR = 144, KB = 64 * KSTR, BUF = KB + 64 * 144;
    const int r32 = lane & 31, hh = lane >> 5, q0 = qb * 256 + wave * 32;
    const bf16_t* qrow = PR + (size_t)(b * SEQ + q0 + r32) * NIN + C_SBQ + h * 64 + 8 * hh;
    bf16x8 qf[4];
#pragma unroll
    for (int d0 = 0; d0 < 4; ++d0) qf[d0] = *(const bf16x8*)(qrow + 16 * d0);
    const bf16_t* kg = PR + (size_t)(b * SEQ) * NIN + C_SBK + h * 64;
    const bf16_t* vg = VT + (size_t)(b * 512 + h * 64) * SEQ;
    f32x16 O[2];
#pragma unroll
    for (int o = 0; o < 2; ++o)
#pragma unroll
        for (int i = 0; i < 16; ++i) O[o][i] = 0.f;
    float R = 0.f; bool done = false;
    const int ttop = 4 * qb + 3, my_diag = 4 * qb + (wave >> 1), odd = wave & 1;
    v4u kr[1], vr[1];
    if (tid < 3) fl[tid] = 0u;
    stage_load<1>(kr, kg + (size_t)(64 * ttop) * NIN, 8, NIN, tid); stage_load<1>(vr, vg + 64 * ttop, 8, SEQ, tid);
    stage_store_k<1>(kr, lds, 8, KSTR, tid); stage_store_k<1>(vr, lds + KB, 8, 144, tid);
    __syncthreads();
    int it = 0;
    for (int t = ttop; t >= 0; --t, ++it) {
        const bool more = t > 0;
        if (more) { stage_load<1>(kr, kg + (size_t)(64 * (t - 1)) * NIN, 8, NIN, tid); stage_load<1>(vr, vg + 64 * (t - 1), 8, SEQ, tid); }
        const int fcur = it % 3;
        if (tid == 0) fl[(it + 1) % 3] = 0u;
        if (t <= my_diag && !done) {
            const LAS unsigned char* kb = lds + (it & 1) * BUF + r32 * KSTR + 16 * hh; const LAS unsigned char* vb = lds + (it & 1) * BUF + KB + r32 * 144 + 16 * hh;
            const bool isd = (t == my_diag);
            if (!isd || odd) {
                f32x16 S;
#pragma unroll
                for (int i = 0; i < 16; ++i) S[i] = 0.f;
#pragma unroll
                for (int d0 = 0; d0 < 4; ++d0) S = mfma32(*(const LAS bf16x8*)(kb + 32 * KSTR + 32 * d0), qf[d0], S);
                sb_subtile(S, isd, R, O, vb + 64, r32, hh);
            }
            {
                f32x16 S;
#pragma unroll
                for (int i = 0; i < 16; ++i) S[i] = 0.f;
#pragma unroll
                for (int d0 = 0; d0 < 4; ++d0) S = mfma32(*(const LAS bf16x8*)(kb + 32 * d0), qf[d0], S);
                sb_subtile(S, isd && !odd, R, O, vb, r32, hh);
            }
            done = __all(R < -160.f);
        }
        if (done && lane == 0) __hip_atomic_fetch_or((LAS unsigned*)(fl + fcur), 1u << wave, __ATOMIC_RELAXED, __HIP_MEMORY_SCOPE_WORKGROUP);
        if (more) { LAS unsigned char* nb = lds + ((it + 1) & 1) * BUF; stage_store_k<1>(kr, nb, 8, KSTR, tid); stage_store_k<1>(vr, nb + KB, 8, 144, tid); }
        __syncthreads();
        if (fl[fcur] == 0xffu) break;
    }
    bf16_t* orow = OAT + (size_t)(b * SEQ + q0 + r32) * D + h * 64 + 4 * hh;
#pragma unroll
    for (int o = 0; o < 2; ++o)
#pragma unroll
        for (int g = 0; g < 4; ++g) { v2u w; w.x = pg8::cvt_pk_bf16(O[o][4 * g], O[o][4 * g + 1]); w.y = pg8::cvt_pk_bf16(O[o][4 * g + 2], O[o][4 * g + 3]); *(v2u*)(orow + 32 * o + 8 * g) = w; }
    __syncthreads();
}

__device__ __forceinline__ void attn_mem_block(const bf16_t* QM, const bf16_t* KVM, const bf16_t* VT, bf16_t* OM, int b, int h, int qb, LAS unsigned char* lds, int tid, int wave, int lane) {
    constexpr int KSTR = 528, KB = 32 * KSTR, VS = 80, BUF = KB + 128 * VS;
    const int r32 = lane & 31, hh = lane >> 5, q0 = qb * 256 + wave * 32;
    const bf16_t* qrow = QM + (size_t)(b * SEQ + q0 + r32) * D + h * 256 + 8 * hh;
    bf16x8 qf[8];
    LAS unsigned char* qs = lds + 57344 + wave * 8192 + lane * 16;
#pragma unroll
    for (int d0 = 0; d0 < 8; ++d0) { qf[d0] = *(const bf16x8*)(qrow + 16 * d0); *(LAS bf16x8*)(qs + d0 * 1024) = *(const bf16x8*)(qrow + 128 + 16 * d0); }
    const bf16_t* kg = KVM + (size_t)(b * MEMLEN) * 2048 + h * 256;
    const int vrow = tid >> 2, vch = tid & 3;
    for (int dh = 0; dh < 2; ++dh) {
        const bf16_t* vg = VT + (size_t)(b * 1024 + h * 256 + dh * 128 + vrow) * MEMLEN + vch * 8;
        f32x16 O[4];
#pragma unroll
        for (int o = 0; o < 4; ++o)
#pragma unroll
            for (int i = 0; i < 16; ++i) O[o][i] = 0.f;
        float m = 0.f, l = 0.f;
        v4u kr[2], vr;
        stage_load<2>(kr, kg, 32, 2048, tid); vr = *(const v4u*)vg;
        stage_store_k<2>(kr, lds, 32, KSTR, tid); *(LAS v4u*)(lds + KB + vrow * VS + vch * 16) = vr;
        __syncthreads();
        for (int t = 0; t < 8; ++t) {
            const bool more = t < 7;
            if (more) { stage_load<2>(kr, kg + (size_t)(32 * (t + 1)) * 2048, 32, 2048, tid); vr = *(const v4u*)(vg + 32 * (t + 1)); }
            {
                const LAS unsigned char* kb = lds + (t & 1) * BUF + r32 * KSTR + 16 * hh; const LAS unsigned char* vb = lds + (t & 1) * BUF + KB + r32 * VS + 16 * hh;
                f32x16 S;
#pragma unroll
                for (int i = 0; i < 16; ++i) S[i] = -m;
#pragma unroll
                for (int d0 = 0; d0 < 8; ++d0) S = mfma32(*(const LAS bf16x8*)(kb + 32 * d0), qf[d0], S);
#pragma unroll
                for (int d0 = 0; d0 < 8; ++d0) S = mfma32(*(const LAS bf16x8*)(kb + 256 + 32 * d0), *(const LAS bf16x8*)(qs + d0 * 1024), S);
                softmax_def1<4>(S, t == 0, m, l, O, hh);
                const bf16x8 p0 = pack_p(S, 0), p1 = pack_p(S, 1);
#pragma unroll
                for (int o = 0; o < 4; ++o) { const LAS unsigned char* vp = vb + 32 * o * VS; O[o] = mfma32(lds_vfrag16(vp), p0, O[o]); O[o] = mfma32(lds_vfrag16(vp + 32), p1, O[o]); }
            }
            if (more) { LAS unsigned char* nb = lds + ((t + 1) & 1) * BUF; stage_store_k<2>(kr, nb, 32, KSTR, tid); *(LAS v4u*)(nb + KB + vrow * VS + vch * 16) = vr; }
            __syncthreads();
        }
        l += xhalf(l, hh);
        const float il = 1.f / l;
        bf16_t* orow = OM + (size_t)(b * SEQ + q0 + r32) * D + h * 256 + dh * 128 + 4 * hh;
#pragma unroll
        for (int o = 0; o < 4; ++o)
#pragma unroll
            for (int g = 0; g < 4; ++g) { v2u w; w.x = pg8::cvt_pk_bf16(O[o][4 * g] * il, O[o][4 * g + 1] * il); w.y = pg8::cvt_pk_bf16(O[o][4 * g + 2] * il, O[o][4 * g + 3] * il); *(v2u*)(orow + 32 * o + 8 * g) = w; }
    }
}

struct Args { const void* in[26]; float* out; unsigned char* ws; int ph_lo, ph_hi; };
constexpr int NPHASE = 15;

__global__ void __launch_bounds__(NTHR, 2) fwd(Args args) {
    extern __shared__ __attribute__((aligned(16))) unsigned char lds[];
    LAS unsigned char* L = (LAS unsigned char*)lds;
    volatile LAS unsigned* MISC = (volatile LAS unsigned*)(L + MISC_OFF);
    const int tid = threadIdx.x, lane = tid & 63, wave = __builtin_amdgcn_readfirstlane(tid >> 6);
    const int G = gridDim.x;
    unsigned char* ws = args.ws;
    unsigned* ctl = (unsigned*)(ws + WS_CTL);
#define x_in ((const float*)args.in[0])
#define mem_in ((const float*)args.in[1])
#define positions ((const int*)args.in[2])
#define norm_mix ((const float*)args.in[3])
#define w_in ((const float*)args.in[4])
#define lam_q1 ((const float*)args.in[5])
#define lam_k1 ((const float*)args.in[6])
#define lam_q2 ((const float*)args.in[7])
#define lam_k2 ((const float*)args.in[8])
#define diff_subln ((const float*)args.in[9])
#define w_up_sb ((const float*)args.in[10])
#define w_up_diff ((const float*)args.in[11])
#define w_out ((const float*)args.in[12])
#define norm_mem_q ((const float*)args.in[13])
#define norm_mem_kv ((const float*)args.in[14])
#define w_mem_q ((const float*)args.in[15])
#define w_mem_kv ((const float*)args.in[16])
#define w_mem_o ((const float*)args.in[17])
#define norm_ffn ((const float*)args.in[18])
#define w_router ((const float*)args.in[19])
#define b_router ((const float*)args.in[20])
#define w_gate_up ((const float*)args.in[21])
#define b_gate_up ((const float*)args.in[22])
#define w_down ((const float*)args.in[23])
#define b_down ((const float*)args.in[24])
#define norm_final ((const float*)args.in[25])
    bf16_t* WIN = (bf16_t*)(ws + WS_WIN); bf16_t* WUPSB = (bf16_t*)(ws + WS_WUPSB); bf16_t* WUPDF = (bf16_t*)(ws + WS_WUPDF); bf16_t* WOUT = (bf16_t*)(ws + WS_WOUT);
    bf16_t* WMQ = (bf16_t*)(ws + WS_WMQ); bf16_t* WMKV = (bf16_t*)(ws + WS_WMKV); bf16_t* WMO = (bf16_t*)(ws + WS_WMO);
    bf16_t* WGU = (bf16_t*)(ws + WS_WGU); bf16_t* WD = (bf16_t*)(ws + WS_WD);
    float* ROPEC = (float*)(ws + WS_ROPE); float* ROPES = ROPEC + (size_t)M * 32;
    int* TK_E = (int*)(ws + WS_TK); int* TK_POS = TK_E + (size_t)M * 4; float* TK_G = (float*)(TK_POS + (size_t)M * 4);
    bf16_t* XN = (bf16_t*)(ws + WS_XN); bf16_t* PR = (bf16_t*)(ws + WS_PR); bf16_t* OAT = (bf16_t*)(ws + WS_OAT); float* SSQ = (float*)(ws + WS_ODR);
    bf16_t* MIX = (bf16_t*)(ws + WS_MIX); float* X1 = (float*)(ws + WS_X1); float* X2 = (float*)(ws + WS_X2);
    bf16_t* HM = (bf16_t*)(ws + WS_HM); bf16_t* KVM = (bf16_t*)(ws + WS_KVM); int* TLIST = (int*)(ws + WS_TLIST); float* GLIST = (float*)(ws + WS_GLIST);
    bf16_t* QM = (bf16_t*)(ws + WS_QM); bf16_t* OM = (bf16_t*)(ws + WS_OM); bf16_t* ACT = (bf16_t*)(ws + WS_ACT); bf16_t* YB = (bf16_t*)(ws + WS_YB);
    bf16_t* VTSB = (bf16_t*)(ws + WS_VTSB); bf16_t* VTDF = (bf16_t*)(ws + WS_VTDF); bf16_t* VTM = (bf16_t*)(ws + WS_VTM);
    float* WR = (float*)(ws + WS_WR); float* WSCGU = (float*)(ws + WS_WSC); float* WSCD = WSCGU + NE * 2048;
    unsigned char* WGU8 = ws + WS_WGU; unsigned char* WD8 = ws + WS_WD; unsigned char* XN8 = ws + WS_XN; unsigned char* ACT8 = ws + WS_ACT;
    unsigned* CNT = ctl + CW_CNT;
    LAS float* smf = (LAS float*)L;
    LAS int* smi = (LAS int*)L;

    for (int u = tid; u < (LDS_BYTES - 131072) / 4; u += NTHR) ((LAS unsigned*)(L + 131072))[u] = 0u;
    __syncthreads();
#if !MK_PER_PHASE
    XcdBarrier bar = xcd_barrier_post(ctl + CW_BAR, MISC + 8);
#define GRID_BAR() xcd_barrier(bar)
#else
#define GRID_BAR() do {} while (0)
#endif
    const int lo = args.ph_lo, hi = args.ph_hi;
#define IN(k) (lo <= (k) && (k) < hi)
#define PHASE_L(k, ...) do { if (IN(k)) { auto body_ = [&]() __attribute__((always_inline)) __VA_ARGS__; body_(); if ((PROBE_REP >> (k)) & 1) { GRID_BAR(); body_(); } } } while (0)
#if !MK_PER_PHASE
#define PHASE(k) for (int rep_ = 0, nrep_ = IN(k) ? 1 + ((PROBE_REP >> (k)) & 1) : 0; rep_ < nrep_; ++rep_, (rep_ < nrep_ ? (xcd_barrier(bar), 0) : 0))
#else
#define PHASE(k) if (IN(k))
#endif
    unsigned long long st_t0_ = 0ull, st_dt_ = 0ull;
#define STAMP_AT(k) do { if (PROBE_STAMP >= 0) { const unsigned long long now_ = __builtin_amdgcn_s_memrealtime(); if ((k) == PROBE_STAMP || (PROBE_STAMP == 100 && (k) == 0)) st_t0_ = now_; if ((k) == PROBE_STAMP + 1 || (PROBE_STAMP == 100 && (k) == 15)) st_dt_ = now_ - st_t0_; } } while (0)
#define SEAM(k) do { if (IN(k) && IN((k) + 1)) GRID_BAR(); STAMP_AT((k) + 1); } while (0)
    const int gw = blockIdx.x * NWAVES + wave, NGW = G * NWAVES;
    const int xcu = (G % 8 == 0) ? ((int)blockIdx.x % 8) * (G / 8) + (int)blockIdx.x / 8 : (int)blockIdx.x;

    auto convert_experts = [&]() __attribute__((always_inline)) {
        const int hw = tid >> 5, n8 = tid & 7, cch = (tid >> 3) & 3;
        f32x4 ra[8], rb[8];
        auto tile_load = [&](const float* Wl, int N, int k0, f32x4 (&r)[8]) __attribute__((always_inline)) {
#pragma unroll
            for (int i = 0; i < 8; ++i) r[i] = *(const f32x4*)(Wl + (size_t)(k0 + 8 * i + wave) * N); };
        auto tile_to_lds = [&](const f32x4 (&r)[8], LAS float* buf) __attribute__((always_inline)) {
#pragma unroll
            for (int i = 0; i < 8; ++i) { const int k = 8 * i + wave; *(LAS f32x4*)(buf + k * 256 + ((4 * lane) ^ (8 * (k >> 4)))) = r[i]; } };
        for (int it = blockIdx.x; it < NE * 12 * 2; it += G) {
            const int cs = it % (NE * 12), kh = it / (NE * 12);
            const bool gu = cs < NE * 8; const int q = gu ? cs : cs - NE * 8, e = gu ? q >> 3 : q >> 2, n0 = (gu ? q & 7 : q & 3) * 256, N = gu ? 2048 : 1024;
            const float* Wl = (gu ? w_gate_up + (size_t)e * 1024 * 2048 : w_down + (size_t)e * 1024 * 1024) + n0 + 4 * lane;
            unsigned char* dstb = gu ? WGU8 + (size_t)e * 2048 * 1024 : WD8 + (size_t)e * 1024 * 1024;
            float inv[2] = {0.f, 0.f}, am[2] = {0.f, 0.f};
            tile_load(Wl, N, 0, ra); tile_load(Wl, N, 512 * kh, rb);
            __syncthreads();
#pragma unroll
            for (int ti = 0; ti < 9; ++ti) {
                LAS float* buf = (LAS float*)L + (ti & 1) * 16384;
                if (ti & 1) { tile_to_lds(rb, buf); if (ti + 2 < 9) tile_load(Wl, N, 512 * kh + 64 * (ti + 1), rb); }
                else        { tile_to_lds(ra, buf); if (ti + 2 < 9) tile_load(Wl, N, 512 * kh + 64 * (ti + 1), ra); }
                __syncthreads();
                const int k0 = 512 * kh + 64 * (ti - 1);
#pragma unroll
                for (int pp = 0; pp < 2; ++pp) { const int n = 8 * hw + n8 + 128 * pp; const LAS float* sp = buf + (16 * cch) * 256 + (n ^ (8 * cch)); float v[16]; float a0 = 0.f;
#pragma unroll
                    for (int i = 0; i < 16; ++i) { v[i] = sp[i * 256]; a0 = fmaxf(a0, fabsf(v[i])); }
                    if (ti == 0) {
                        a0 = fmaxf(a0, __shfl_xor(a0, 8)); a0 = fmaxf(a0, __shfl_xor(a0, 16));
                        unsigned eb = ((__float_as_uint(a0) >> 23) & 0xffu) + 4u; eb = eb < 8u ? 8u : (eb > 250u ? 250u : eb);
                        inv[pp] = __uint_as_float((261u - eb) << 23);
                        if (kh == 0 && cch == 0) (gu ? WSCGU + (size_t)e * 2048 : WSCD + (size_t)e * 1024)[n0 + n] = __uint_as_float((eb - 7u) << 23);
                    } else {
                        am[pp] = fmaxf(am[pp], a0);
                        const int c = n0 + n, drow = gu ? (((c & 1023) >> 7) * 256 + (c >> 10) * 128 + (c & 127)) : c; const float iv = inv[pp];
                        v4u w; w.x = pk4_fp8(v[0] * iv, v[1] * iv, v[2] * iv, v[3] * iv); w.y = pk4_fp8(v[4] * iv, v[5] * iv, v[6] * iv, v[7] * iv);
                        w.z = pk4_fp8(v[8] * iv, v[9] * iv, v[10] * iv, v[11] * iv); w.w = pk4_fp8(v[12] * iv, v[13] * iv, v[14] * iv, v[15] * iv);
                        *(v4u*)(dstb + (size_t)drow * 1024 + k0 + 16 * cch) = w; } }
            }
            const bool ov = (am[0] * inv[0] >= 448.0f) || (am[1] * inv[1] >= 448.0f);
            if (__any(ov) && lane == 0) __hip_atomic_store(ctl + CW_REDO + cs, 1u, __ATOMIC_RELAXED, __HIP_MEMORY_SCOPE_AGENT);
        }
        __syncthreads();
    };
    STAMP_AT(0);
    PHASE(0) {
        STAMP_AT(20);
        LAS float* scr = (LAS float*)(L + wave * 16384);
        constexpr int I_IN = 16 * 160, I_UP = 8 * 32, I_SQ = 16 * 32, I_KV = 16 * 64, I_GU1 = 16 * 64, I_GU = NE * I_GU1, I_D1 = 16 * 32, I_DN = NE * I_D1;
        constexpr int NITEMS = I_IN + 2 * I_UP + 3 * I_SQ + I_KV;
        for (int it = gw; it < NITEMS; it += NGW) {
            int r = it;
            if (r < I_IN) {
                const int kb = r / 160, nb = r % 160, n0 = 32 * nb;
                if (n0 >= C_DQ && n0 < C_DV) { const int o = n0 & 255;
                    p0_transpose_rope(w_in, WIN, (n0 & ~255), o, 64 * kb, n0, scr, lane); }
                else p0_transpose_item(w_in, 1024, NIN, WIN, n0, 64 * kb, n0, scr, lane);
                continue; } r -= I_IN;
            if (r < I_UP) { p0_plain(w_up_sb, 512, 1024, WUPSB, r, scr, lane); continue; } r -= I_UP;
            if (r < I_UP) { p0_plain(w_up_diff, 512, 1024, WUPDF, r, scr, lane); continue; } r -= I_UP;
            if (r < I_SQ) { p0_plain(w_out, 1024, 1024, WOUT, r, scr, lane); continue; } r -= I_SQ;
            if (r < I_SQ) { p0_plain(w_mem_q, 1024, 1024, WMQ, r, scr, lane, norm_mem_q); continue; } r -= I_SQ;
            if (r < I_SQ) { p0_plain(w_mem_o, 1024, 1024, WMO, r, scr, lane); continue; } r -= I_SQ;
            p0_plain(w_mem_kv, 1024, 2048, WMKV, r, scr, lane);
        }
        for (int i = blockIdx.x * NTHR + tid; i < D * NE; i += G * NTHR) WR[i] = w_router[i] * norm_ffn[i >> 5];
        STAMP_AT(21);
        STAMP_AT(22);
        for (int m = gw; m < M; m += 2 * NGW) { const int m2 = m + NGW; rms_rows2<false>(x_in + (size_t)m * D, x_in + (size_t)m2 * D, m2 < M, norm_mix, XN + (size_t)m * D, XN + (size_t)m2 * D, lane); }
        for (int m = gw; m < MM; m += NGW) rms_row_to_bf16(mem_in + (size_t)m * D, norm_mem_kv, HM + (size_t)m * D, lane);
        for (int i = blockIdx.x * NTHR + tid; i < M * 32; i += G * NTHR) {
            const int m = i >> 5, f = i & 31;
            const double inv = exp2(-(double)f * (13.287712379549449 / 32.0));
            const double ang = (double)positions[m] * inv;
            const double kk = rint(ang * 0.15915494309189535);
            const float rf = (float)(ang - kk * 6.283185307179586);
            ROPEC[i] = __cosf(rf); ROPES[i] = __sinf(rf);
        }
        STAMP_AT(23);
    }
    SEAM(0); STAMP_AT(24);

    if (IN(1)) {
        const int grp = (int)blockIdx.x % 3;
        pg8::Gemm g{XN, WIN, D, D, D}; pg8::DenseOrder S; S.init(M, NIN, G, (int)blockIdx.x, D, D);
        const pg8::EpiInProj E{PR, ROPEC, ROPES, VTSB, VTDF};
        STAMP_AT(40);
        if (grp == 0) { convert_experts(); __syncthreads(); }
        STAMP_AT(41);
        if (grp == 1) { S.i0 = 0; S.i1 = 2; pg8::gemm_phase<pg8::EpiInProj, pg8::DenseOrder, false>(L, g, S, E); convert_experts(); __syncthreads(); S.i0 = 2; S.i1 = 1 << 30; }
        pg8::gemm_phase<pg8::EpiInProj, pg8::DenseOrder, false>(L, g, S, E);
        STAMP_AT(42);
        if (grp == 2) convert_experts();
        STAMP_AT(43);
    }
    SEAM(1);

    if (IN(3)) {
        {
            LAS float* sw = (LAS float*)L; LAS float* red = (LAS float*)(L + 131072 + 4096);
            const int n = tid & 31, part = tid >> 5;
            for (int it = blockIdx.x; it < NE * 96; it += G) {
                { const int cs_ = it < NE * 64 ? ((it >> 6) * 8 + ((it & 63) >> 3)) : (NE * 8 + ((it - NE * 64) >> 5) * 4 + (((it - NE * 64) & 31) >> 3));
                  if (__hip_atomic_load(ctl + CW_REDO + cs_, __ATOMIC_RELAXED, __HIP_MEMORY_SCOPE_AGENT) == 0u) continue; }
                const bool gu = it < NE * 64; const int q = gu ? it : it - NE * 64, e = gu ? q >> 6 : q >> 5, n0 = (gu ? q & 63 : q & 31) * 32, N = gu ? 2048 : 1024;
                const float* W = (gu ? w_gate_up + (size_t)e * 1024 * 2048 : w_down + (size_t)e * 1024 * 1024) + n0 + n;
                __syncthreads();
#pragma unroll 16
                for (int i = 0; i < 64; ++i) { const int k = part + 16 * i; sw[k * 32 + n] = W[(size_t)k * N]; }
                __syncthreads();
                float am = 0.f;
#pragma unroll 16
                for (int i = 0; i < 64; ++i) am = fmaxf(am, fabsf(sw[(64 * part + i) * 32 + n]));
                red[part * 32 + n] = am;
                __syncthreads();
                if (tid < 32) { float a = red[tid];
#pragma unroll
                    for (int pp = 1; pp < 16; ++pp) a = fmaxf(a, red[pp * 32 + tid]);
                    unsigned eb = (__float_as_uint(a) >> 23) & 0xffu; eb = eb < 8u ? 8u : eb;
                    const float sc = __uint_as_float((eb - 7u) << 23), inv = __uint_as_float((261u - eb) << 23);
                    red[512 + tid] = inv; (gu ? WSCGU + (size_t)e * 2048 : WSCD + (size_t)e * 1024)[n0 + tid] = sc; }
                __syncthreads();
                { const float inv = red[512 + n]; const int c = n0 + n;
                  const int drow = gu ? (((c & 1023) >> 7) * 256 + (c >> 10) * 128 + (c & 127)) : c;
                  unsigned char* dst = (gu ? WGU8 + ((size_t)e * 2048 + drow) * 1024 : WD8 + ((size_t)e * 1024 + drow) * 1024) + 64 * part;
#pragma unroll
                  for (int qd = 0; qd < 4; ++qd) { v4u w;
                      const LAS float* sp = sw + (64 * part + 16 * qd) * 32 + n;
                      w.x = pk4_fp8(sp[0] * inv, sp[32] * inv, sp[64] * inv, sp[96] * inv); w.y = pk4_fp8(sp[128] * inv, sp[160] * inv, sp[192] * inv, sp[224] * inv);
                      w.z = pk4_fp8(sp[256] * inv, sp[288] * inv, sp[320] * inv, sp[352] * inv); w.w = pk4_fp8(sp[384] * inv, sp[416] * inv, sp[448] * inv, sp[480] * inv);
                      *(v4u*)(dst + 16 * qd) = w; } }
            }
            __syncthreads();
        }
    }
    PHASE(3) {
        volatile LAS unsigned* fl = (volatile LAS unsigned*)(L + 131072 + 2048);
        STAMP_AT(30);
        const float lam = expf(wave_sum(lam_q1[lane] * lam_k1[lane])) - expf(wave_sum(lam_q2[lane] * lam_k2[lane])) + 0.2f;
        const int nkv = (G >= 64) ? 32 : 0;
        if ((int)blockIdx.x < nkv) { pg8::Gemm g{HM, WMKV, D, D, D}; pg8::OneUnitOrder S{(int)blockIdx.x, D, D};
            pg8::gemm_phase<pg8::EpiKV, pg8::OneUnitOrder, false>(L, g, S, pg8::EpiKV{KVM, VTM}); }
        if (nkv == 0) { pg8::Gemm g{HM, WMKV, D, D, D}; pg8::DenseOrder S; S.init(MM, 2048, G, (int)blockIdx.x, D, D); pg8::gemm_phase<pg8::EpiKV, pg8::DenseOrder, false>(L, g, S, pg8::EpiKV{KVM, VTM}); }
        for (int pr = blockIdx.x; pr < 256; pr += G) { const int sb_ = pr & 15, h = (pr >> 4) & 3, b = pr >> 6;
            attn_diff_block(PR, VTDF, OAT, diff_subln, lam, b, h, 31 - sb_, L, tid, wave, lane); attn_diff_block(PR, VTDF, OAT, diff_subln, lam, b, h, sb_, L, tid, wave, lane); }
        STAMP_AT(31);
        for (;;) {
            if (tid == 0) fl[4] = __hip_atomic_fetch_add(ctl + CW_SBQ, 1u, __ATOMIC_RELAXED, __HIP_MEMORY_SCOPE_AGENT);
            __syncthreads();
            const int bu = (int)fl[4];
            __syncthreads();
            if (bu >= 512) break;
            const int qb = 15 - (bu & 15), h = (bu >> 4) & 7, b = bu >> 7;
            attn_sb_block(PR, VTSB, OAT, b, h, qb, L, fl, tid, wave, lane);
        }
        STAMP_AT(32);
    }
    SEAM(3); STAMP_AT(3); STAMP_AT(33);

    PHASE_L(5, {
        pg8::Gemm g{OAT, WUPSB, D, 512, 512}; pg8::TwoRoundOrder S{G, xcu, D, 512};
        pg8::gemm_phase<pg8::EpiGate, pg8::TwoRoundOrder, false>(L, g, S, pg8::EpiGate{PR, (bf16_t*)X1, MIX});
    });
    SEAM(5); STAMP_AT(5);

    PHASE_L(6, {
        pg8::Gemm g{MIX, WOUT, D, D, D}; pg8::DenseOrder S; S.init(M, D, G, (int)blockIdx.x, D, D);
        pg8::gemm_phase<pg8::EpiResidNorm, pg8::DenseOrder, false>(L, g, S, pg8::EpiResidNorm{x_in, X1, XN, SSQ});
    });
    if (IN(6) && IN(8)) GRID_BAR();
    STAMP_AT(7); STAMP_AT(8);

    if (IN(8)) {
        pg8::Gemm g{XN, WMQ, D, D, D}; pg8::DenseOrder S; S.init(M, D, G, (int)blockIdx.x, D, D);
        pg8::gemm_phase<pg8::EpiBf16Rinv, pg8::DenseOrder, false>(L, g, S, pg8::EpiBf16Rinv{QM, SSQ, 0.0625f * 1.4426950408889634f});
        asm volatile("s_waitcnt vmcnt(0)" ::: "memory");
        __syncthreads();
        pg8::Unit u;
        for (int i = 0; S.next(i, u); ++i) attn_mem_block(QM, KVM, VTM, OM, u.pm >> 4, u.pn, u.pm & 15, L, tid, wave, lane);
    }
    STAMP_AT(9);
    SEAM(9);

    PHASE_L(10, {
        pg8::Gemm g{OM, WMO, D, D, D}; pg8::DenseOrder S; S.init(M, D, G, (int)blockIdx.x, D, D);
        pg8::gemm_phase<pg8::EpiResidB, pg8::DenseOrder, false>(L, g, S, pg8::EpiResidB{XN, X2});
    });
    SEAM(10);

    if (IN(11)) {
        auto body11_ = [&]() __attribute__((always_inline)) {
        {
            const int i32 = lane & 31, kk = lane >> 5;
#pragma unroll
            for (int t2 = 0; t2 < 2; ++t2) {
                const int tile = t2 * G + (int)blockIdx.x, m0 = tile * 32;
                LAS float* P = smf + (t2 * 8 + wave) * 1056; LAS float* SSQ_ = smf + 16 * 1056 + (t2 * 8 + wave) * 32;
                f32x16 acc;
#pragma unroll
                for (int r = 0; r < 16; ++r) acc[r] = 0.f;
                float ss = 0.f;
                if (tile < M / 32) {
                    const float* xr = X2 + (size_t)(m0 + i32) * D + 128 * wave + 4 * kk; const float* wp = WR + (128 * wave + 4 * kk) * NE + i32;
#pragma unroll 8
                    for (int u = 0; u < 16; ++u) {
                        const f32x4 a = *(const f32x4*)(xr + 8 * u);
                        const float b0 = wp[(8 * u + 0) * NE], b1 = wp[(8 * u + 1) * NE], b2 = wp[(8 * u + 2) * NE], b3 = wp[(8 * u + 3) * NE];
                        acc = __builtin_amdgcn_mfma_f32_32x32x2f32(a.x, b0, acc, 0, 0, 0); acc = __builtin_amdgcn_mfma_f32_32x32x2f32(a.y, b1, acc, 0, 0, 0);
                        acc = __builtin_amdgcn_mfma_f32_32x32x2f32(a.z, b2, acc, 0, 0, 0); acc = __builtin_amdgcn_mfma_f32_32x32x2f32(a.w, b3, acc, 0, 0, 0);
                        ss += (a.x * a.x + a.y * a.y) + (a.z * a.z + a.w * a.w);
                    }
                }
                ss += xhalf(ss, kk);
#pragma unroll
                for (int r = 0; r < 16; ++r) P[((r & 3) + 8 * (r >> 2) + 4 * kk) * 33 + i32] = acc[r];
                if (kk == 0) SSQ_[i32] = ss;
            }
        }
        __syncthreads();
        if (wave < 2) {
            const int tile = wave * G + (int)blockIdx.x;
            if (tile < M / 32) {
                const int m0 = tile * 32;
                LAS float* T = smf + (wave * 8) * 1056;
#pragma unroll
                for (int r = 0; r < 16; ++r) { const int idx = lane + 64 * r, e_ = (idx >> 5) * 33 + (idx & 31); float v = T[e_];
#pragma unroll
                    for (int w2 = 1; w2 < 8; ++w2) v += T[w2 * 1056 + e_];
                    T[e_] = v; }
                float ss = 0.f;
#pragma unroll
                for (int w2 = 0; w2 < 8; ++w2) ss += smf[16 * 1056 + (wave * 8 + w2) * 32 + (lane & 31)];
                LDS_WAIT(); asm volatile("" ::: "memory");
                const float rinv = 1.0f / sqrtf(ss * (1.f / 1024.f) + NORM_EPS);
                if (lane < 32) {
                    float lg[32];
#pragma unroll
                    for (int j = 0; j < 32; ++j) lg[j] = T[lane * 33 + j] * rinv + b_router[j];
                    float tv[4]; int ti[4];
#pragma unroll
                    for (int k = 0; k < 4; ++k) { float bv = lg[0]; int bi = 0;
#pragma unroll
                        for (int j = 1; j < 32; ++j) if (lg[j] > bv) { bv = lg[j]; bi = j; }
                        tv[k] = bv; ti[k] = bi;
#pragma unroll
                        for (int j = 0; j < 32; ++j) if (j == bi) lg[j] = -INFINITY; }
                    const float e1 = __expf(tv[1] - tv[0]), e2 = __expf(tv[2] - tv[0]), e3 = __expf(tv[3] - tv[0]);
                    const float isum = 1.f / (1.f + e1 + e2 + e3);
                    const float gk[4] = {isum, e1 * isum, e2 * isum, e3 * isum};
                    LAS unsigned* H = (LAS unsigned*)(smf + 16 * 1056 + 512 + wave * 64);
                    H[lane] = 0u;
                    LDS_WAIT(); asm volatile("" ::: "memory");
                    int rk[4];
#pragma unroll
                    for (int k = 0; k < 4; ++k) rk[k] = (int)__hip_atomic_fetch_add(H + ti[k], 1u, __ATOMIC_RELAXED, __HIP_MEMORY_SCOPE_WAVEFRONT);
                    LDS_WAIT(); asm volatile("" ::: "memory");
                    const unsigned cnt_e = H[lane];
                    unsigned base_e = 0u; if (cnt_e) base_e = atomicAdd(&CNT[64 * lane], cnt_e);
                    H[32 + lane] = base_e;
                    LDS_WAIT(); asm volatile("" ::: "memory");
                    const int m = m0 + lane;
#pragma unroll
                    for (int k = 0; k < 4; ++k) { const int ek = ti[k]; const int pos = (int)H[32 + ek] + rk[k];
                        TLIST[ek * LISTCAP + pos] = m; GLIST[ek * LISTCAP + pos] = gk[k]; TK_E[m * 4 + k] = ek; TK_POS[m * 4 + k] = pos; TK_G[m * 4 + k] = gk[k]; }
                }
            }
        } else {
            for (int m = blockIdx.x * 6 + (wave - 2); m < M; m += 2 * G * 6) { const int m2 = m + G * 6; rms_rows2<true>(X2 + (size_t)m * D, X2 + (size_t)m2 * D, m2 < M, norm_ffn, XN8 + (size_t)m * D, XN8 + (size_t)m2 * D, lane); }
        }
            };
        body11_();
        if ((PROBE_REP >> 11) & 1) { GRID_BAR(); if (blockIdx.x == 0 && tid < NE) CNT[64 * tid] = 0u; GRID_BAR(); body11_(); }
    }
    SEAM(11);

#define LOAD_BASES() do { __syncthreads(); if (tid == 0) { int b_ = 0; for (int e_ = 0; e_ < NE; ++e_) { const int c_ = (int)__hip_atomic_load(&CNT[64 * e_], __ATOMIC_RELAXED, __HIP_MEMORY_SCOPE_AGENT); \
        smi[8192 + e_] = b_; smi[8256 + e_] = c_; b_ += (c_ + 255) & ~255; } } __syncthreads(); } while (0)

    LAS int* tb = (LAS int*)(L + 131072 + 1024);
#define LOAD_TB(npn) do { __syncthreads(); if (tid == 0) { int b_ = 0, cu_ = 0; for (int e_ = 0; e_ < NE; ++e_) { const int c_ = (int)__hip_atomic_load(&CNT[64 * e_], __ATOMIC_RELAXED, __HIP_MEMORY_SCOPE_AGENT); \
        tb[e_] = b_; tb[32 + e_] = c_; tb[64 + e_] = cu_; b_ += (c_ + 255) & ~255; cu_ += ((c_ + 255) >> 8) * (npn); } tb[96] = cu_; } __syncthreads(); } while (0)
    PHASE_L(12, {
        LOAD_TB(8);
        pg8::Gemm g{(const bf16_t*)XN8, (const bf16_t*)WGU8, 512, 512, 512}; pg8::MoeOrder S{tb, TLIST, G, xcu, 8, 512, 512, 2048};
        pg8::gemm_phase<pg8::EpiMoeGU, pg8::MoeOrder, true, true>(L, g, S, pg8::EpiMoeGU{ACT8, b_gate_up, WSCGU});
    });
    SEAM(12);
    PHASE_L(13, {
        LOAD_TB(4);
        pg8::Gemm g{(const bf16_t*)ACT8, (const bf16_t*)WD8, 512, 512, 512}; pg8::MoeOrder S{tb, TLIST, G, xcu, 4, 512, 512, 1024};
        pg8::gemm_phase<pg8::EpiMoeDown, pg8::MoeOrder, false, true>(L, g, S, pg8::EpiMoeDown{YB, b_down, GLIST, tb, WSCD});
    });
    SEAM(13);

    PHASE(14) {
        LOAD_BASES();
        for (int mb = gw; mb < M; mb += 8 * NGW) {
            int slotv = 0;
            { const int i = lane >> 2, k = lane & 3, m = mb + NGW * i; if (lane < 32 && m < M) slotv = smi[8192 + TK_E[m * 4 + k]] + TK_POS[m * 4 + k]; }
#pragma unroll 2
            for (int i = 0; i < 8; ++i) {
                const int m = mb + NGW * i; if (m >= M) break;
                const f32x4* xr = (const f32x4*)(X2 + (size_t)m * D) + lane; const f32x4* gr = (const f32x4*)norm_final + lane;
                f32x4 v[4];
#pragma unroll
                for (int j = 0; j < 4; ++j) v[j] = xr[64 * j];
#pragma unroll
                for (int k = 0; k < 4; ++k) { const int slot = __builtin_amdgcn_readlane(slotv, 4 * i + k); const v2u* yr = (const v2u*)(YB + (size_t)slot * D) + lane;
#pragma unroll
                    for (int j = 0; j < 4; ++j) { const v2u w = yr[64 * j]; v[j].x += lo16(w.x); v[j].y += hi16(w.x); v[j].z += lo16(w.y); v[j].w += hi16(w.y); } }
                float ss = 0.f;
#pragma unroll
                for (int j = 0; j < 4; ++j) ss += (v[j].x * v[j].x + v[j].y * v[j].y) + (v[j].z * v[j].z + v[j].w * v[j].w);
                const float rinv = 1.0f / sqrtf(wave_sum(ss) * (1.f / 1024.f) + NORM_EPS);
                f32x4* orow = (f32x4*)(args.out + (size_t)m * D) + lane;
#pragma unroll
                for (int j = 0; j < 4; ++j) { const f32x4 gg = gr[64 * j]; orow[64 * j] = (f32x4){v[j].x * rinv * gg.x, v[j].y * rinv * gg.y, v[j].z * rinv * gg.z, v[j].w * rinv * gg.w}; }
            }
        }
    }
    if (PROBE_STAMP >= 0) { STAMP_AT(15); if (blockIdx.x == PROBE_BLOCK) { const unsigned long long t1_ = __builtin_amdgcn_s_memrealtime(); while (__builtin_amdgcn_s_memrealtime() - t1_ < st_dt_) __builtin_amdgcn_s_sleep(8); } }
#undef IN
#undef SEAM
}

extern "C" void kernel_launch(void* const* d_in, const int* in_sizes, int n_in, void* d_out, int out_size, void* d_ws, size_t ws_size, hipStream_t stream) {
    static int grid = 0;
    if (grid == 0) {
        if (n_in != 26 || out_size != M * D || ws_size < WS_END) { fprintf(stderr, "kernel_launch: unexpected sizes n_in %d out %d ws %zu\n", n_in, out_size, ws_size); grid = -1; return; }
        int dev = 0, cus = 0;
        if (hipGetDevice(&dev) != hipSuccess || hipDeviceGetAttribute(&cus, hipDeviceAttributeMultiprocessorCount, dev) != hipSuccess) { grid = -1; return; }
        if (hipFuncSetAttribute((const void*)fwd, hipFuncAttributeMaxDynamicSharedMemorySize, LDS_BYTES) != hipSuccess) { fprintf(stderr, "kernel_launch: hipFuncSetAttribute failed\n"); grid = -1; return; }
        int per_cu = 0;
        (void)hipOccupancyMaxActiveBlocksPerMultiprocessor(&per_cu, (const void*)fwd, NTHR, LDS_BYTES);
        (void)hipGetLastError();
        grid = cus;
    }
    if (grid < 0) return;
    (void)hipMemsetAsync((char*)d_ws + WS_CTL, 0, CTL_ZERO_BYTES, stream);
    Args a{};
    for (int i = 0; i < 26; ++i) a.in[i] = d_in[i];
    a.out = (float*)d_out; a.ws = (unsigned char*)d_ws;
#if MK_PER_PHASE
    for (int p = 0; p < NPHASE; ++p) { a.ph_lo = p; a.ph_hi = p + 1; hipLaunchKernelGGL(fwd, dim3(grid), dim3(NTHR), LDS_BYTES, stream, a); }
#else
    a.ph_lo = 0; a.ph_hi = NPHASE; hipLaunchKernelGGL(fwd, dim3(grid), dim3(NTHR), LDS_BYTES, stream, a);
#endif
}
```

```cpp
#include <hip/hip_runtime.h>
#include <cstdio>
#include <cstdint>

#ifndef MK_PER_PHASE
#define MK_PER_PHASE 0
#endif

#ifndef PROBE_STAMP
#define PROBE_STAMP -1
#endif
#ifndef PROBE_BLOCK
#define PROBE_BLOCK 0
#endif
#ifndef PROBE_REP
#define PROBE_REP 0
#endif
#define GAS __attribute__((address_space(1)))
#define LAS __attribute__((address_space(3)))
typedef unsigned short bf16_t;
typedef unsigned v4u __attribute__((ext_vector_type(4)));
typedef unsigned v2u __attribute__((ext_vector_type(2)));
typedef float f32x4 __attribute__((ext_vector_type(4)));
typedef short bf16x8 __attribute__((ext_vector_type(8)));

constexpr int BATCH = 4, SEQ = 4096, D = 1024, M = BATCH * SEQ, NIN = 5120;
constexpr int MEMLEN = 256, MM = BATCH * MEMLEN;
constexpr int NE = 32, TOPK = 4, DFF = 1024;
constexpr float NORM_EPS = 1e-6f;
constexpr int C_SBQ = 0, C_SBK = 512, C_SBV = 1024, C_DQ = 1536, C_DK = 2048, C_DV = 2560, C_GSB = 3072, C_GDF = 4096;
constexpr int LISTCAP = 16384;
constexpr int SLOTS = 65536 + NE * 256;
constexpr int NWAVES = 8, NTHR = 512;

constexpr size_t MiB = 1u << 20;
constexpr size_t WS_CTL = 0, CTL_ZERO_BYTES = 1 * MiB;
constexpr size_t WS_WIN = 2 * MiB;
constexpr size_t WS_WUPSB = 12 * MiB;
constexpr size_t WS_WUPDF = 13 * MiB;
constexpr size_t WS_WOUT = 14 * MiB;
constexpr size_t WS_WMQ = 16 * MiB;
constexpr size_t WS_WMKV = 18 * MiB;
constexpr size_t WS_WMO = 22 * MiB;
constexpr size_t WS_ROPE = 24 * MiB;
constexpr size_t WS_TK = 28 * MiB;
constexpr size_t WS_WR = 29 * MiB;
constexpr size_t WS_WSC = 30 * MiB;
constexpr size_t WS_WGU = 32 * MiB;
constexpr size_t WS_WD = 160 * MiB;
constexpr size_t WS_XN = 224 * MiB;
constexpr size_t WS_PR = 256 * MiB;
constexpr size_t WS_OAT = 416 * MiB;
constexpr size_t WS_ODR = 448 * MiB;
constexpr size_t WS_MIX = 512 * MiB;
constexpr size_t WS_X1 = 544 * MiB;
constexpr size_t WS_X2 = 608 * MiB;
constexpr size_t WS_HM = 672 * MiB;
constexpr size_t WS_KVM = 674 * MiB;
constexpr size_t WS_TLIST = 678 * MiB;
constexpr size_t WS_GLIST = 680 * MiB;
constexpr size_t WS_QM = 682 * MiB;
constexpr size_t WS_OM = 714 * MiB;
constexpr size_t WS_ACT = 256 * MiB;
constexpr size_t WS_YB = 746 * MiB;
constexpr size_t WS_VTSB = 890 * MiB;
constexpr size_t WS_VTDF = 906 * MiB;
constexpr size_t WS_VTM = 922 * MiB;
constexpr size_t WS_END = 924 * MiB;
static_assert(WS_ACT + (size_t)SLOTS * 1024 * 2 <= WS_OAT, "ACT overlay");
static_assert(WS_YB + (size_t)SLOTS * 1024 * 2 <= WS_VTSB, "YB");
constexpr int CW_REDO = 16384;
constexpr int CW_SBQ = 6144;
constexpr int CW_CNT = 8192;
constexpr int CW_BAR = 1024;

constexpr int LDS_BYTES = 147456;
constexpr int MISC_OFF = 131072 + 320;

__device__ __forceinline__ float bf2f(bf16_t b) { return __uint_as_float(((unsigned)b) << 16); }
__device__ __forceinline__ unsigned f2bf(float f) { unsigned u = __float_as_uint(f); return (u + 0x7fffu + ((u >> 16) & 1u)) >> 16; }
__device__ __forceinline__ unsigned pk2(float lo, float hi) { return f2bf(lo) | (f2bf(hi) << 16); }
__device__ __forceinline__ unsigned pk4_fp8(float a, float b, float c, float d) { int w = 0; w = __builtin_amdgcn_cvt_pk_fp8_f32(a, b, w, false); w = __builtin_amdgcn_cvt_pk_fp8_f32(c, d, w, true); return (unsigned)w; }
__device__ __forceinline__ float lo16(unsigned w) { return __uint_as_float(w << 16); }
__device__ __forceinline__ float hi16(unsigned w) { return __uint_as_float(w & 0xffff0000u); }
#define LDS_WAIT() asm volatile("s_waitcnt lgkmcnt(0)" ::: "memory")
__device__ __forceinline__ float wave_sum(float v) {
#pragma unroll
    for (int o = 1; o < 64; o <<= 1) v += __shfl_xor(v, o);
    return v;
}
__device__ __forceinline__ float wave_max(float v) {
#pragma unroll
    for (int o = 1; o < 64; o <<= 1) v = fmaxf(v, __shfl_xor(v, o));
    return v;
}

#define XB_TMO      128
#define XB_XCNT(j)  (256  + 64 * (j))
#define XB_XSUB(j)  (1280 + 64 * (j))
#define XB_XGEN(j)  (2304 + 64 * (j))
#define XB_TOP      3328
#define XB_TOPGEN   3392
#define XCD_BAR_WORDS 3456
#define XB_SPIN_CAP (1u << 18)
__device__ __forceinline__ unsigned xb_ld(unsigned* p)              { return __hip_atomic_load(p, __ATOMIC_RELAXED, __HIP_MEMORY_SCOPE_AGENT); }
__device__ __forceinline__ unsigned xb_add(unsigned* p, unsigned v) { return __hip_atomic_fetch_add(p, v, __ATOMIC_RELAXED, __HIP_MEMORY_SCOPE_AGENT); }
__device__ __forceinline__ unsigned xb_xcc_id() { return (unsigned)__builtin_amdgcn_s_getreg((3 << 11) | 20) & 0xFu; }
#define XB_SPIN(cond, bar) do { unsigned _sp = 0; while (cond) { __builtin_amdgcn_s_sleep(1); \
    if ((++_sp & 255u) == 0u) { if (xb_ld(&(bar)[XB_TMO])) break; if (_sp > XB_SPIN_CAP) { atomicAdd(&(bar)[XB_TMO], 1u); break; } } } } while (0)
struct XcdBarrier { unsigned* bar; unsigned x; volatile LAS unsigned* st; };
__device__ __forceinline__ XcdBarrier xcd_barrier_post(unsigned* bar, volatile LAS unsigned* st) {
    XcdBarrier b; b.bar = bar; b.x = xb_xcc_id(); b.st = st;
    if (threadIdx.x == 0) (void)xb_add(&bar[XB_XCNT(b.x)], 1u);
    return b;
}
__device__ __forceinline__ void xcd_barrier_complete(unsigned* bar, unsigned x, unsigned& nloc, unsigned& nx) {
    const unsigned G = gridDim.x * gridDim.y * gridDim.z;
    unsigned sum, cnt, mine, sp = 0u;
    for (;;) {
        sum = 0u; cnt = 0u; mine = 0u;
#pragma unroll
        for (unsigned j = 0; j < 16; ++j) { const unsigned c = xb_ld(&bar[XB_XCNT(j)]); sum += c; cnt += (c > 0u) ? 1u : 0u; mine = (j == x) ? c : mine; }
        if (sum == G) break;
        __builtin_amdgcn_s_sleep(1);
        if ((++sp & 255u) == 0u) { if (xb_ld(&bar[XB_TMO])) break; if (sp > XB_SPIN_CAP) { atomicAdd(&bar[XB_TMO], 1u); break; } }
    }
    nloc = mine > 0u ? mine : 1u; nx = cnt > 0u ? cnt : 1u;
}
__device__ __forceinline__ void xcd_barrier(const XcdBarrier& b) {
    asm volatile("s_waitcnt vmcnt(0)" ::: "memory");
    __syncthreads();
    if (threadIdx.x == 0) {
        unsigned* bar = b.bar;
        __builtin_amdgcn_s_waitcnt(0);
        unsigned nloc = b.st[0], nx = b.st[1];
        if (nloc == 0u) { xcd_barrier_complete(bar, b.x, nloc, nx); b.st[0] = nloc; b.st[1] = nx; }
        const unsigned old = xb_add(&bar[XB_XSUB(b.x)], 1u);
        const unsigned gen = old / nloc;
        if (old + 1u == (gen + 1u) * nloc) {
            __builtin_amdgcn_fence(__ATOMIC_RELEASE, "agent");
            asm volatile("s_waitcnt vmcnt(0)" ::: "memory");
            const unsigned og = xb_add(&bar[XB_TOP], 1u);
            const unsigned tg = og / nx;
            if (og + 1u == (tg + 1u) * nx) xb_add(&bar[XB_TOPGEN], 1u);
            else XB_SPIN(xb_ld(&bar[XB_TOPGEN]) == tg, bar);
            __builtin_amdgcn_fence(__ATOMIC_ACQUIRE, "agent");
            xb_add(&bar[XB_XGEN(b.x)], 1u);
            asm volatile("s_waitcnt vmcnt(0)" ::: "memory");
        } else {
            XB_SPIN(xb_ld(&bar[XB_XGEN(b.x)]) == gen, bar);
            __builtin_amdgcn_fence(__ATOMIC_ACQUIRE, "agent");
            asm volatile("s_waitcnt vmcnt(0)" ::: "memory");
        }
    }
    __syncthreads();
}

__device__ __forceinline__ void p0_transpose_item(const float* W, int K, int N, bf16_t* WT, int drow0, int k0, int n0, LAS float* scr, int lane, const float* gain = nullptr, int ldw = 0, int koff = 0) {
    if (ldw == 0) ldw = K;
#pragma unroll 8
    for (int i = 0; i < 32; ++i) { const int kk = 2 * i + (lane >> 5); float v = W[(size_t)(k0 + kk) * N + n0 + (lane & 31)]; if (gain) v *= gain[k0 + kk]; scr[kk * 33 + (lane & 31)] = v; }
    LDS_WAIT(); asm volatile("" ::: "memory");
    const int c = lane & 7;
#pragma unroll
    for (int j = 0; j < 4; ++j) { const int n = (lane >> 3) + 8 * j; const LAS float* s = scr + (8 * c) * 33 + n;
        v4u o; o.x = pk2(s[0 * 33], s[1 * 33]); o.y = pk2(s[2 * 33], s[3 * 33]); o.z = pk2(s[4 * 33], s[5 * 33]); o.w = pk2(s[6 * 33], s[7 * 33]);
        *(v4u*)(WT + (size_t)(drow0 + n) * ldw + koff + k0 + 8 * c) = o; }
    LDS_WAIT(); asm volatile("" ::: "memory");
}
__device__ __forceinline__ void p0_plain(const float* W, int K, int N, bf16_t* WT, int item, LAS float* scr, int lane, const float* gain = nullptr, int ldw = 0, int koff = 0) {
    const int nblk = N / 32, kb = item / nblk, nb = item % nblk;
    p0_transpose_item(W, K, N, WT, 32 * nb, 64 * kb, 32 * nb, scr, lane, gain, ldw, koff);
}
__device__ __forceinline__ void p0_transpose_rope(const float* W, bf16_t* WT, int tilebase, int o, int k0, int n0, LAS float* scr, int lane) {
    const int K = 1024, N = NIN;
#pragma unroll 8
    for (int i = 0; i < 32; ++i) { const int kk = 2 * i + (lane >> 5); scr[kk * 33 + (lane & 31)] = W[(size_t)(k0 + kk) * N + n0 + (lane & 31)]; }
    LDS_WAIT(); asm volatile("" ::: "memory");
    const int c = lane & 7;
#pragma unroll
    for (int j = 0; j < 4; ++j) { const int n = (lane >> 3) + 8 * j; const LAS float* s = scr + (8 * c) * 33 + n;
        const int oo = o + n, v = ((oo >> 6) << 6) | (((oo >> 4) & 1) << 5) | (((oo >> 2) & 3) << 3) | (((oo >> 5) & 1) << 2) | (oo & 3);
        v4u w; w.x = pk2(s[0 * 33], s[1 * 33]); w.y = pk2(s[2 * 33], s[3 * 33]); w.z = pk2(s[4 * 33], s[5 * 33]); w.w = pk2(s[6 * 33], s[7 * 33]);
        *(v4u*)(WT + (size_t)(tilebase + v) * K + k0 + 8 * c) = w; }
    LDS_WAIT(); asm volatile("" ::: "memory");
}
__device__ __forceinline__ void rms_row_to_bf16(const float* xrow, const float* g, bf16_t* orow, int lane) {
    const f32x4* xr = (const f32x4*)xrow + lane; const f32x4* gr = (const f32x4*)g + lane;
    f32x4 v[4]; float s = 0.f;
#pragma unroll
    for (int j = 0; j < 4; ++j) { v[j] = xr[64 * j]; s += (v[j].x * v[j].x + v[j].y * v[j].y) + (v[j].z * v[j].z + v[j].w * v[j].w); }
    const float rinv = 1.0f / sqrtf(wave_sum(s) * (1.f / 1024.f) + NORM_EPS);
    v2u* o8 = (v2u*)orow + lane;
#pragma unroll
    for (int j = 0; j < 4; ++j) { const f32x4 gg = gr[64 * j]; v2u w; w.x = pk2(v[j].x * rinv * gg.x, v[j].y * rinv * gg.y); w.y = pk2(v[j].z * rinv * gg.z, v[j].w * rinv * gg.w); o8[64 * j] = w; }
}

template <bool FP8>
__device__ __forceinline__ void rms_rows2(const float* xa, const float* xb, bool hasb, const float* g, void* oa, void* ob, int lane) {
    const f32x4* ra = (const f32x4*)xa + lane; const f32x4* rb = (const f32x4*)(hasb ? xb : xa) + lane; const f32x4* gr = (const f32x4*)g + lane;
    f32x4 va[4], vb[4]; float sa = 0.f, sb = 0.f;
#pragma unroll
    for (int j = 0; j < 4; ++j) { va[j] = ra[64 * j]; vb[j] = rb[64 * j]; }
#pragma unroll
    for (int j = 0; j < 4; ++j) { sa += (va[j].x * va[j].x + va[j].y * va[j].y) + (va[j].z * va[j].z + va[j].w * va[j].w); sb += (vb[j].x * vb[j].x + vb[j].y * vb[j].y) + (vb[j].z * vb[j].z + vb[j].w * vb[j].w); }
    const float ia = 1.0f / sqrtf(wave_sum(sa) * (1.f / 1024.f) + NORM_EPS), ib = 1.0f / sqrtf(wave_sum(sb) * (1.f / 1024.f) + NORM_EPS);
#pragma unroll
    for (int j = 0; j < 4; ++j) { const f32x4 gg = gr[64 * j];
        if (FP8) { ((unsigned*)oa)[lane + 64 * j] = pk4_fp8(va[j].x * ia * gg.x, va[j].y * ia * gg.y, va[j].z * ia * gg.z, va[j].w * ia * gg.w);
                   if (hasb) ((unsigned*)ob)[lane + 64 * j] = pk4_fp8(vb[j].x * ib * gg.x, vb[j].y * ib * gg.y, vb[j].z * ib * gg.z, vb[j].w * ib * gg.w); }
        else { v2u w; w.x = pk2(va[j].x * ia * gg.x, va[j].y * ia * gg.y); w.y = pk2(va[j].z * ia * gg.z, va[j].w * ia * gg.w); ((v2u*)oa)[lane + 64 * j] = w;
               if (hasb) { v2u w2; w2.x = pk2(vb[j].x * ib * gg.x, vb[j].y * ib * gg.y); w2.y = pk2(vb[j].z * ib * gg.z, vb[j].w * ib * gg.w); ((v2u*)ob)[lane + 64 * j] = w2; } } }
}
__device__ __forceinline__ void rms_row_to_fp8(const float* xrow, const float* g, unsigned char* orow, int lane) {
    const f32x4* xr = (const f32x4*)xrow + lane; const f32x4* gr = (const f32x4*)g + lane;
    f32x4 v[4]; float s = 0.f;
#pragma unroll
    for (int j = 0; j < 4; ++j) { v[j] = xr[64 * j]; s += (v[j].x * v[j].x + v[j].y * v[j].y) + (v[j].z * v[j].z + v[j].w * v[j].w); }
    const float rinv = 1.0f / sqrtf(wave_sum(s) * (1.f / 1024.f) + NORM_EPS);
    unsigned* o4 = (unsigned*)orow + lane;
#pragma unroll
    for (int j = 0; j < 4; ++j) { const f32x4 gg = gr[64 * j]; o4[64 * j] = pk4_fp8(v[j].x * rinv * gg.x, v[j].y * rinv * gg.y, v[j].z * rinv * gg.z, v[j].w * rinv * gg.w); }
}
namespace pg8 {
constexpr int BM = 256, BK = 64, HALF = 128, HTB = HALF * BK * 2, STAGE_BYTES = 8 * HTB;
__host__ __device__ __forceinline__ int lds_byte(int r, int c) { const int st = (r >> 4) * 2 + (c >> 5), rr = r & 15, cc = c & 31, ob = rr * 64 + cc * 2; return st * 1024 + (ob ^ (((ob >> 9) & 1) << 5)); }
__host__ __device__ __forceinline__ void stage_rc(int b, int& R, int& C) { const int st = b / 1024, sb = b % 1024, swz = sb ^ (((sb >> 9) & 1) << 5); R = (st >> 1) * 16 + swz / 64; C = (st & 1) * 32 + (swz % 64) / 2; }
__host__ __device__ __forceinline__ int perm32(int rho) { const int n = rho >> 4, i = rho & 15; return 8 * (i >> 2) + 4 * n + (i & 3); }
struct Unit { int pm, pn, e; };
struct Gemm { const bf16_t* A; const bf16_t* Bt; int lda, ldb, K; };
typedef float f32x2 __attribute__((ext_vector_type(2))); typedef __bf16 bf16x2_t __attribute__((ext_vector_type(2)));
__device__ __forceinline__ unsigned cvt_pk_bf16(float lo, float hi) { f32x2 v = {lo, hi}; bf16x2_t b = __builtin_convertvector(v, bf16x2_t); return __builtin_bit_cast(unsigned, b); }

typedef int v8i __attribute__((ext_vector_type(8))); typedef int v4i __attribute__((ext_vector_type(4)));
__device__ __forceinline__ v8i cat8(bf16x8 a, bf16x8 b) { return __builtin_shufflevector(__builtin_bit_cast(v4i, a), __builtin_bit_cast(v4i, b), 0, 1, 2, 3, 4, 5, 6, 7); }
template <class Epi, class Sched, bool GATHER, bool FP8 = false>
__device__ __forceinline__ void gemm_phase(LAS unsigned char* lds, const Gemm g, const Sched& S, const Epi& E) {
    const int tid = threadIdx.x, wid = __builtin_amdgcn_readfirstlane(tid >> 6), lane = tid & 63, wr = wid >> 2, wc = wid & 3, fr = lane & 15, fq = lane >> 4;
    const int K = g.K, nt = K / BK;
    unsigned voffB[2], cva[2][2], nva[2][2];
#pragma unroll
    for (int i = 0; i < 2; ++i) { int R, C; stage_rc(tid * 16 + i * 8192, R, C); const int Rb = (R & ~31) + perm32(R & 31);
        voffB[i] = (unsigned)(Rb * g.ldb + C) * 2u;
#pragma unroll
        for (int h = 0; h < 2; ++h) { cva[h][i] = (unsigned)((h * HALF + R) * g.lda + C) * 2u; nva[h][i] = cva[h][i]; } }
    const unsigned kstep = (unsigned)(BK * 2);
    const unsigned hstepB = (unsigned)(HALF * g.ldb * 2);
    auto uni_ptr = [](const void* p_) { const unsigned long long v_ = (unsigned long long)p_; return (void*)(((unsigned long long)(unsigned)__builtin_amdgcn_readfirstlane((int)(v_ >> 32)) << 32) | (unsigned)__builtin_amdgcn_readfirstlane((int)v_)); };
    const auto rA = __builtin_amdgcn_make_buffer_rsrc(uni_ptr(g.A), 0, 0x7fffffff, 0x00020000), rB = __builtin_amdgcn_make_buffer_rsrc(uni_ptr(g.Bt), 0, 0x7fffffff, 0x00020000);
    const unsigned ldsw = (unsigned)wid * 1024u;
    const int aoff = lds_byte(wr * 64 + fr, fq * 8), boff = lds_byte(wc * 32 + fr, fq * 8);
#define PG8_SA(b, h) (((b) * 2 + (h)) * HTB)
#define PG8_SB(b, h) ((4 + (b) * 2 + (h)) * HTB)
#define PG8_STAGE(bufoff, rs, soff, voff) do { _Pragma("unroll") for (int _i = 0; _i < 2; ++_i) \
        __builtin_amdgcn_raw_ptr_buffer_load_lds(rs, (LAS unsigned*)(lds + (bufoff) + ldsw + _i * 8192), 16, (int)(voff)[_i], (int)(soff), 0, 0); } while (0)
#define PG8_LDA(dst, b, h) do { _Pragma("unroll") for (int m = 0; m < 4; ++m) _Pragma("unroll") for (int k = 0; k < 2; ++k) dst[m][k] = *(const LAS bf16x8*)(lds + PG8_SA(b, h) + aoff + m * 2048 + k * 1024); } while (0)
#define PG8_LDB(dst, b, h) do { _Pragma("unroll") for (int n = 0; n < 2; ++n) _Pragma("unroll") for (int k = 0; k < 2; ++k) dst[n][k] = *(const LAS bf16x8*)(lds + PG8_SB(b, h) + boff + n * 2048 + k * 1024); } while (0)
#define PG8_MMA(ai, bj, At, Bt) do { __builtin_amdgcn_s_setprio(1); _Pragma("unroll") for (int m = 0; m < 4; ++m) _Pragma("unroll") for (int n = 0; n < 2; ++n) { \
        if constexpr (FP8) { const v8i b8_ = cat8(Bt[n][0], Bt[n][1]), a8_ = cat8(At[m][0], At[m][1]); \
            asm volatile("s_nop 1\n\tv_mfma_scale_f32_16x16x128_f8f6f4 %0, %1, %2, %0, %3, %3 op_sel_hi:[0,0,0]" : "+v"(acc[ai][bj][m][n]) : "v"(b8_), "v"(a8_), "v"(one_scale)); } \
        else { _Pragma("unroll") for (int k = 0; k < 2; ++k) acc[ai][bj][m][n] = __builtin_amdgcn_mfma_f32_16x16x32_bf16(Bt[n][k], At[m][k], acc[ai][bj][m][n], 0, 0, 0); } } __builtin_amdgcn_s_setprio(0); } while (0)
#define PG8_WAIT_V(n) asm volatile("s_waitcnt vmcnt(" #n ")" ::: "memory")
#define PG8_WAIT_L(n) asm volatile("s_waitcnt lgkmcnt(" #n ")" ::: "memory")
#define PG8_BAR __builtin_amdgcn_s_barrier()
#define PG8_SCHED __builtin_amdgcn_sched_barrier(0)
    Unit cur, nxt; int ui = 0;
    if (!S.next(0, cur)) return;
    if constexpr (GATHER) {
#pragma unroll
        for (int i = 0; i < 2; ++i) { int R, C; stage_rc(tid * 16 + i * 8192, R, C);
#pragma unroll
            for (int h = 0; h < 2; ++h) cva[h][i] = (unsigned)(S.tok(cur, h * HALF + R) * g.lda + C) * 2u; }
    }
    const int one_scale = 0x7f7f7f7f;
    (void)one_scale;
    f32x4 acc[2][2][4][2];
#pragma unroll
    for (int a = 0; a < 2; ++a)
#pragma unroll
        for (int b = 0; b < 2; ++b)
#pragma unroll
            for (int m = 0; m < 4; ++m)
#pragma unroll
                for (int n = 0; n < 2; ++n) acc[a][b][m][n] = (f32x4){0.f, 0.f, 0.f, 0.f};
    bf16x8 At[4][2], B0[2][2], B1[2][2];
    unsigned cA = GATHER ? 0u : (unsigned)S.a_off(cur), cB = (unsigned)S.b_off(cur);
    PG8_STAGE(PG8_SB(0, 0), rB, cB, voffB); PG8_STAGE(PG8_SB(0, 1), rB, cB + hstepB, voffB); PG8_STAGE(PG8_SA(0, 0), rA, cA, cva[0]); PG8_STAGE(PG8_SA(0, 1), rA, cA, cva[1]);
    if (wr == 1) PG8_BAR;
    PG8_WAIT_V(2); PG8_BAR;
    PG8_STAGE(PG8_SB(1, 0), rB, cB + kstep, voffB); PG8_STAGE(PG8_SA(1, 0), rA, cA + kstep, cva[0]); PG8_STAGE(PG8_SB(1, 1), rB, cB + hstepB + kstep, voffB);
    PG8_WAIT_V(6); PG8_BAR;
    for (;;) {
        const bool has_next = S.next(ui + 1, nxt);
        const unsigned nA = (has_next && !GATHER) ? (unsigned)S.a_off(nxt) : cA, nB = has_next ? (unsigned)S.b_off(nxt) : cB;
        if constexpr (GATHER) {
#pragma unroll
            for (int i = 0; i < 2; ++i) { int R, C; stage_rc(tid * 16 + i * 8192, R, C);
#pragma unroll
                for (int h = 0; h < 2; ++h) nva[h][i] = has_next ? (unsigned)(S.tok(nxt, h * HALF + R) * g.lda + C) * 2u : cva[h][i]; }
        }
#pragma nounroll
        for (int t = 0; t < nt; t += 2) {
            const bool last = (t == nt - 2);
            const unsigned a1 = cA + (unsigned)(t + 1) * kstep;
            const unsigned a2 = last ? nA : cA + (unsigned)(t + 2) * kstep, b2 = last ? nB : cB + (unsigned)(t + 2) * kstep;
            const unsigned a3 = a2 + kstep, b3 = b2 + kstep;
            PG8_LDB(B0, 0, 0); PG8_LDB(B1, 0, 1); PG8_SCHED; PG8_LDA(At, 0, 0); PG8_STAGE(PG8_SA(1, 1), rA, a1, cva[1]);
            if constexpr (GATHER) { if (last) {
#pragma unroll
                for (int h = 0; h < 2; ++h)
#pragma unroll
                    for (int i = 0; i < 2; ++i) cva[h][i] = nva[h][i]; } }
            PG8_WAIT_V(8); PG8_WAIT_L(0); PG8_BAR; PG8_MMA(0, 0, At, B0); PG8_MMA(0, 1, At, B1); PG8_BAR; PG8_SCHED;
            PG8_LDA(At, 0, 1); PG8_STAGE(PG8_SB(0, 0), rB, b2, voffB); PG8_STAGE(PG8_SB(0, 1), rB, b2 + hstepB, voffB); PG8_STAGE(PG8_SA(0, 0), rA, a2, cva[0]);
            PG8_WAIT_V(8); PG8_WAIT_L(0); PG8_BAR; PG8_MMA(1, 0, At, B0); PG8_MMA(1, 1, At, B1); PG8_BAR; PG8_SCHED;
            PG8_LDB(B0, 1, 0); PG8_LDB(B1, 1, 1); PG8_SCHED; PG8_LDA(At, 1, 0); PG8_STAGE(PG8_SA(0, 1), rA, a2, cva[1]);
            PG8_WAIT_V(8); PG8_WAIT_L(0); PG8_BAR; PG8_MMA(0, 0, At, B0); PG8_MMA(0, 1, At, B1); PG8_BAR; PG8_SCHED;
            PG8_LDA(At, 1, 1); PG8_STAGE(PG8_SB(1, 0), rB, b3, voffB); PG8_STAGE(PG8_SB(1, 1), rB, b3 + hstepB, voffB); PG8_STAGE(PG8_SA(1, 0), rA, a3, cva[0]);
            PG8_WAIT_V(8); PG8_WAIT_L(0); PG8_BAR; PG8_MMA(1, 0, At, B0); PG8_MMA(1, 1, At, B1); PG8_BAR; PG8_SCHED;
        }
        if (wr == 0) PG8_BAR;
        if constexpr (FP8) asm volatile("s_nop 15\n\ts_nop 7" ::: "memory");
        E(acc, cur, wr, wc, fr, fq);
        if (!has_next) break;
#pragma unroll
        for (int a = 0; a < 2; ++a)
#pragma unroll
            for (int b = 0; b < 2; ++b)
#pragma unroll
                for (int m = 0; m < 4; ++m)
#pragma unroll
                    for (int n = 0; n < 2; ++n) acc[a][b][m][n] = (f32x4){0.f, 0.f, 0.f, 0.f};
        cur = nxt; cA = nA; cB = nB; ++ui;
        if constexpr (GATHER) {
#pragma unroll
            for (int i = 0; i < 2; ++i)
#pragma unroll
                for (int h = 0; h < 2; ++h) cva[h][i] = nva[h][i];
        }
        if (wr == 1) PG8_BAR;
    }
    PG8_WAIT_V(0);
    PG8_BAR;
#undef PG8_SA
#undef PG8_SB
#undef PG8_STAGE
#undef PG8_LDA
#undef PG8_LDB
#undef PG8_MMA
#undef PG8_WAIT_V
#undef PG8_WAIT_L
#undef PG8_BAR
#undef PG8_SCHED
}

struct DenseOrder {
    int nM, nN, nwg, G, c, lda, ldb, i0 = 0, i1 = 1 << 30;
    __device__ __forceinline__ void init(int M_, int N_, int G_, int c_, int lda_, int ldb_) { nM = M_ / BM; nN = N_ / BM; nwg = nM * nN; G = G_; c = c_; lda = lda_; ldb = ldb_; }
    __device__ __forceinline__ bool next(int i, Unit& u) const {
        if (i + i0 >= i1) return false;
        const long L = (long)(i + i0) * G + c; if (L >= nwg) return false;
        int wgid = (int)L; { const int q = nwg / 8, r = nwg % 8, xcd = wgid % 8, off = wgid / 8; wgid = (xcd < r ? xcd * (q + 1) : r * (q + 1) + (xcd - r) * q) + off; }
        const int nig = 8 * nN, gid = wgid / nig, fm = gid * 8, gsz = (nM - fm) < 8 ? (nM - fm) : 8;
        u.pm = fm + ((wgid % nig) % gsz); u.pn = (wgid % nig) / gsz; u.e = 0; return true;
    }
    __device__ __forceinline__ size_t a_off(const Unit& u) const { return (size_t)u.pm * BM * lda * 2; }
    __device__ __forceinline__ size_t b_off(const Unit& u) const { return (size_t)u.pn * BM * ldb * 2; }
    __device__ __forceinline__ int tok(const Unit&, int) const { return 0; }
};
struct TwoRoundOrder {
    int G, c, lda, ldb;
    __device__ __forceinline__ bool next(int i, Unit& u) const { const int L = i * G + c; if (L >= 512) return false; const int tile = L & 255; u.pm = tile >> 2; u.pn = tile & 3; u.e = L >> 8; return true; }
    __device__ __forceinline__ size_t a_off(const Unit& u) const { return (size_t)u.pm * BM * lda * 2 + (size_t)u.e * 1024; }
    __device__ __forceinline__ size_t b_off(const Unit& u) const { return (size_t)(u.e * 1024 + u.pn * BM) * ldb * 2; }
    __device__ __forceinline__ int tok(const Unit&, int) const { return 0; }
};
struct MoeOrder {
    const LAS int* tb; const int* tlist; int G, c, npn, lda, ldb, nexp;
    __device__ __forceinline__ bool next(int i, Unit& u) const {
        const int L = i * G + c; if (L >= tb[96]) return false;
        int e = 0; while (tb[65 + e] <= L) ++e;
        const int loc = L - tb[64 + e]; u.e = __builtin_amdgcn_readfirstlane(e); u.pn = __builtin_amdgcn_readfirstlane(loc % npn); u.pm = __builtin_amdgcn_readfirstlane((tb[e] >> 8) + loc / npn); return true;
    }
    __device__ __forceinline__ size_t a_off(const Unit& u) const { return (size_t)u.pm * BM * lda * 2; }
    __device__ __forceinline__ size_t b_off(const Unit& u) const { return (size_t)(u.e * nexp + u.pn * BM) * ldb * 2; }
    __device__ __forceinline__ int tok(const Unit& u, int row) const { const int r = u.pm * BM - tb[u.e] + row; return r < tb[32 + u.e] ? tlist[u.e * LISTCAP + r] : 0; }
};

#define EPI_ARGS const f32x4 (&acc)[2][2][4][2], const Unit& u, int wr, int wc, int fr, int fq
#define EPI_FOR_ROWS for (int ai = 0; ai < 2; ++ai) _Pragma("unroll") for (int m = 0; m < 4; ++m)
__device__ __forceinline__ v4u pack8(const f32x4 a, const f32x4 b) { v4u w; w.x = cvt_pk_bf16(a[0], a[1]); w.y = cvt_pk_bf16(a[2], a[3]); w.z = cvt_pk_bf16(b[0], b[1]); w.w = cvt_pk_bf16(b[2], b[3]); return w; }
__device__ __forceinline__ void unpack8(const v4u w, f32x4& a, f32x4& b) { a = (f32x4){lo16(w.x), hi16(w.x), lo16(w.y), hi16(w.y)}; b = (f32x4){lo16(w.z), hi16(w.z), lo16(w.w), hi16(w.w)}; }
__device__ __forceinline__ float sigm(float v) { return __builtin_amdgcn_rcpf(1.f + __expf(-v)); }

__device__ __forceinline__ void store_tile_T(const f32x4 (&acc)[2][2][4][2], bf16_t* VT, int vrow0, int s0, int pitch) {
#pragma unroll
    for (int bj = 0; bj < 2; ++bj)
#pragma unroll
        for (int n = 0; n < 2; ++n)
#pragma unroll
            for (int e = 0; e < 4; ++e) { bf16_t* vp = VT + (size_t)(vrow0 + 128 * bj + 4 * n + e) * pitch + ((s0 & ~12) | ((s0 & 8) >> 1) | ((s0 & 4) << 1));
#pragma unroll
                for (int ai = 0; ai < 2; ++ai)
#pragma unroll
                    for (int m = 0; m < 4; ++m) vp[128 * ai + 16 * m] = (bf16_t)(cvt_pk_bf16(acc[ai][bj][m][n][e], 0.f) & 0xffffu); }
}
struct EpiKV { static constexpr bool MIDHOOK = false; bf16_t* KVM; bf16_t* VTM;
    __device__ __forceinline__ void operator()(EPI_ARGS) const {
        const int row0 = u.pm * BM + wr * 64 + fr, col0 = u.pn * BM + wc * 32 + 8 * fq;
#pragma unroll
        EPI_FOR_ROWS { bf16_t* rowp = KVM + (size_t)(row0 + ai * HALF + m * 16) * 2048 + col0;
#pragma unroll
            for (int bj = 0; bj < 2; ++bj) *(v4u*)(rowp + bj * HALF) = pack8(acc[ai][bj][m][0], acc[ai][bj][m][1]); }
        if (u.pn >= 4) store_tile_T(acc, VTM, u.pm * 1024 + (u.pn - 4) * BM + wc * 32 + 8 * fq, wr * 64 + fr, MEMLEN);
    } };
struct EpiResidNorm { static constexpr bool MIDHOOK = false; const float* base; float* out; bf16_t* XB; float* SSQ;
    __device__ __forceinline__ void operator()(EPI_ARGS) const {
        const int row0 = u.pm * BM + wr * 64 + fr, col0 = u.pn * BM + wc * 32 + 8 * fq;
#pragma unroll
        EPI_FOR_ROWS { const int row = row0 + ai * HALF + m * 16; const size_t off = (size_t)row * D + col0; float ss = 0.f;
#pragma unroll
            for (int bj = 0; bj < 2; ++bj) { f32x4 v[2];
#pragma unroll
                for (int n = 0; n < 2; ++n) { v[n] = *(const f32x4*)(base + off + bj * HALF + 4 * n) + acc[ai][bj][m][n];
                    ss += (v[n][0] * v[n][0] + v[n][1] * v[n][1]) + (v[n][2] * v[n][2] + v[n][3] * v[n][3]); }
                *(v4u*)(XB + off + bj * HALF) = pack8(v[0], v[1]); }
            ss += __shfl_xor(ss, 16); ss += __shfl_xor(ss, 32);
            if (fq == 0) SSQ[(size_t)row * 16 + u.pn * 4 + wc] = ss; }
    } };
struct EpiBf16Rinv { static constexpr bool MIDHOOK = false; bf16_t* O; const float* SSQ; float qscale;
    __device__ __forceinline__ void operator()(EPI_ARGS) const {
        const int row0 = u.pm * BM + wr * 64 + fr, col0 = u.pn * BM + wc * 32 + 8 * fq;
#pragma unroll
        EPI_FOR_ROWS { const int row = row0 + ai * HALF + m * 16; const f32x4* sp = (const f32x4*)(SSQ + (size_t)row * 16);
            const f32x4 s0 = sp[0], s1 = sp[1], s2 = sp[2], s3 = sp[3];
            const float tot = (((s0[0] + s0[1]) + (s0[2] + s0[3])) + ((s1[0] + s1[1]) + (s1[2] + s1[3]))) + (((s2[0] + s2[1]) + (s2[2] + s2[3])) + ((s3[0] + s3[1]) + (s3[2] + s3[3])));
            const float rinv = qscale / sqrtf(tot * (1.f / 1024.f) + NORM_EPS);
            bf16_t* rowp = O + (size_t)row * D + col0;
#pragma unroll
            for (int bj = 0; bj < 2; ++bj) *(v4u*)(rowp + bj * HALF) = pack8(acc[ai][bj][m][0] * rinv, acc[ai][bj][m][1] * rinv); }
    } };
struct OneUnitOrder {
    int idx, lda, ldb;
    __device__ __forceinline__ bool next(int i, Unit& u) const { if (i > 0) return false; u.pm = idx >> 3; u.pn = idx & 7; u.e = 0; return true; }
    __device__ __forceinline__ size_t a_off(const Unit& u) const { return (size_t)u.pm * BM * lda * 2; }
    __device__ __forceinline__ size_t b_off(const Unit& u) const { return (size_t)u.pn * BM * ldb * 2; }
    __device__ __forceinline__ int tok(const Unit&, int) const { return 0; }
};
struct EpiResidB { static constexpr bool MIDHOOK = false; const bf16_t* base; float* out;
    __device__ __forceinline__ void operator()(EPI_ARGS) const {
        const int row0 = u.pm * BM + wr * 64 + fr, col0 = u.pn * BM + wc * 32 + 8 * fq;
#pragma unroll
        EPI_FOR_ROWS { const size_t off = (size_t)(row0 + ai * HALF + m * 16) * D + col0;
#pragma unroll
            for (int bj = 0; bj < 2; ++bj) { f32x4 b0, b1; unpack8(*(const v4u*)(base + off + bj * HALF), b0, b1);
                *(f32x4*)(out + off + bj * HALF) = b0 + acc[ai][bj][m][0]; *(f32x4*)(out + off + bj * HALF + 4) = b1 + acc[ai][bj][m][1]; } }
    } };
struct EpiGate { static constexpr bool MIDHOOK = false; const bf16_t* PR; bf16_t* T; bf16_t* MIX;
    __device__ __forceinline__ void operator()(EPI_ARGS) const {
        const int row0 = u.pm * BM + wr * 64 + fr, col0 = u.pn * BM + wc * 32 + 8 * fq;
#pragma unroll
        EPI_FOR_ROWS { const int row = row0 + ai * HALF + m * 16;
#pragma unroll
            for (int bj = 0; bj < 2; ++bj) { const int col = col0 + bj * HALF; f32x4 g0, g1;
                unpack8(*(const v4u*)(PR + (size_t)row * NIN + (u.e ? C_GDF : C_GSB) + col), g0, g1);
                bf16_t* tp = T + (size_t)row * D + col;
                if (u.e == 0) *(v4u*)tp = pack8(g0 * acc[ai][bj][m][0], g1 * acc[ai][bj][m][1]);
                else { f32x4 t0, t1; unpack8(*(const v4u*)tp, t0, t1); *(v4u*)(MIX + (size_t)row * D + col) = pack8(t0 + g0 * acc[ai][bj][m][0], t1 + g1 * acc[ai][bj][m][1]); } } }
    } };
struct EpiInProj { static constexpr bool MIDHOOK = false; bf16_t* PR; const float* rc; const float* rs; bf16_t* VTSB; bf16_t* VTDF;
    __device__ __forceinline__ void operator()(EPI_ARGS) const {
        const int row0 = u.pm * BM + wr * 64 + fr, pn = u.pn;
        if (pn >= 6 && pn < 10) {
            const float sc = pn < 8 ? 0.125f * 1.4426950408889634f : 1.0f; const int i0 = 16 * (wc & 1) + 4 * fq;
#pragma unroll
            EPI_FOR_ROWS { const int row = row0 + ai * HALF + m * 16; const f32x4 cs = *(const f32x4*)(rc + (size_t)row * 32 + i0), sn = *(const f32x4*)(rs + (size_t)row * 32 + i0);
#pragma unroll
                for (int bj = 0; bj < 2; ++bj) { const f32x4 lo = acc[ai][bj][m][0], hi = acc[ai][bj][m][1];
                    const f32x4 olo = (lo * cs - hi * sn) * sc, ohi = (hi * cs + lo * sn) * sc;
                    bf16_t* p = PR + (size_t)row * NIN + pn * BM + 64 * (2 * bj + (wc >> 1)) + i0;
                    v2u a, b; a.x = cvt_pk_bf16(olo[0], olo[1]); a.y = cvt_pk_bf16(olo[2], olo[3]); b.x = cvt_pk_bf16(ohi[0], ohi[1]); b.y = cvt_pk_bf16(ohi[2], ohi[3]);
                    *(v2u*)p = a; *(v2u*)(p + 32) = b; } }
        } else {
            const int col0 = pn * BM + wc * 32 + 8 * fq; const float sc = pn < 2 ? 0.125f * 1.4426950408889634f : 1.0f; const bool sg = pn >= 12;
            const bool vt = (pn == 4 || pn == 5 || pn == 10 || pn == 11);
            if (!vt) {
#pragma unroll
            EPI_FOR_ROWS { bf16_t* rowp = PR + (size_t)(row0 + ai * HALF + m * 16) * NIN + col0;
#pragma unroll
                for (int bj = 0; bj < 2; ++bj) { f32x4 v0 = acc[ai][bj][m][0] * sc, v1 = acc[ai][bj][m][1] * sc;
                    if (sg) { v0 = (f32x4){sigm(v0[0]), sigm(v0[1]), sigm(v0[2]), sigm(v0[3])}; v1 = (f32x4){sigm(v1[0]), sigm(v1[1]), sigm(v1[2]), sigm(v1[3])}; }
                    *(v4u*)(rowp + bj * HALF) = pack8(v0, v1); } }
            } else {
                const int bb = u.pm >> 4, s0 = (u.pm & 15) * BM + wr * 64 + fr, hd0 = (pn < 6 ? (pn - 4) : (pn - 10)) * BM + wc * 32 + 8 * fq;
                store_tile_T(acc, pn < 6 ? VTSB : VTDF, bb * 512 + hd0, s0, SEQ);
            }
        }
    } };
struct EpiMoeGU { static constexpr bool MIDHOOK = false; unsigned char* ACT8; const float* bgu; const float* wsc;
    __device__ __forceinline__ void operator()(EPI_ARGS) const {
        const int row0 = u.pm * BM + wr * 64 + fr, j0 = u.pn * 128 + wc * 32 + 8 * fq; const float* bg = bgu + (size_t)u.e * 2048 + j0; const float* sg = wsc + (size_t)u.e * 2048 + j0;
#pragma unroll
        EPI_FOR_ROWS { f32x4 o[2];
#pragma unroll
            for (int n = 0; n < 2; ++n) { const f32x4 gv = acc[ai][0][m][n] * *(const f32x4*)(sg + 4 * n) + *(const f32x4*)(bg + 4 * n), lv = acc[ai][1][m][n] * *(const f32x4*)(sg + 1024 + 4 * n) + *(const f32x4*)(bg + 1024 + 4 * n);
#pragma unroll
                for (int c = 0; c < 4; ++c) { const float gl = fminf(gv[c], 7.0f), li = fminf(fmaxf(lv[c], -7.0f), 7.0f); o[n][c] = gl * sigm(1.702f * gl) * (li + 1.0f); } }
            v2u w; w.x = pk4_fp8(o[0][0], o[0][1], o[0][2], o[0][3]); w.y = pk4_fp8(o[1][0], o[1][1], o[1][2], o[1][3]);
            *(v2u*)(ACT8 + (size_t)(row0 + ai * HALF + m * 16) * DFF + j0) = w; }
    } };
struct EpiMoeDown { static constexpr bool MIDHOOK = false; bf16_t* YB; const float* bd; const float* glist; const LAS int* tb; const float* wsc;
    __device__ __forceinline__ void operator()(EPI_ARGS) const {
        const int row0 = u.pm * BM + wr * 64 + fr, col0 = u.pn * BM + wc * 32 + 8 * fq; const float* bp = bd + (size_t)u.e * D + col0; const float* sp = wsc + (size_t)u.e * D + col0;
        const float* gl = glist + (size_t)u.e * LISTCAP - tb[u.e];
        f32x4 bv[2][2], sv[2][2];
#pragma unroll
        for (int bj = 0; bj < 2; ++bj)
#pragma unroll
            for (int n = 0; n < 2; ++n) { bv[bj][n] = *(const f32x4*)(bp + bj * HALF + 4 * n); sv[bj][n] = *(const f32x4*)(sp + bj * HALF + 4 * n); }
#pragma unroll
        EPI_FOR_ROWS { const int row = row0 + ai * HALF + m * 16; const float gt = gl[row];
#pragma unroll
            for (int bj = 0; bj < 2; ++bj) *(v4u*)(YB + (size_t)row * D + col0 + bj * HALF) = pack8((acc[ai][bj][m][0] * sv[bj][0] + bv[bj][0]) * gt, (acc[ai][bj][m][1] * sv[bj][1] + bv[bj][1]) * gt); }
    } };
}


typedef float f32x16 __attribute__((ext_vector_type(16)));
typedef short s16x4 __attribute__((ext_vector_type(4)));
__device__ __forceinline__ f32x16 mfma32(bf16x8 a, bf16x8 b, f32x16 c) { return __builtin_amdgcn_mfma_f32_32x32x16_bf16(a, b, c, 0, 0, 0); }
__device__ __forceinline__ float xhalf(float v, int hh) { auto rr = __builtin_amdgcn_permlane32_swap(__float_as_uint(v), __float_as_uint(v), false, false); return __uint_as_float(hh ? rr[0] : rr[1]); }
__device__ __forceinline__ bf16x8 pack_p(const f32x16& p, int s) { v4u w; w.x = pg8::cvt_pk_bf16(p[8 * s + 0], p[8 * s + 1]); w.y = pg8::cvt_pk_bf16(p[8 * s + 2], p[8 * s + 3]); w.z = pg8::cvt_pk_bf16(p[8 * s + 4], p[8 * s + 5]); w.w = pg8::cvt_pk_bf16(p[8 * s + 6], p[8 * s + 7]); return __builtin_bit_cast(bf16x8, w); }
constexpr float LOG2E = 1.4426950408889634f;

constexpr int VSTR = 136;
template <int NCH> __device__ __forceinline__ void stage_load(v4u (&r)[NCH], const bf16_t* g0, int chunks_per_row, size_t gpitch, int tid) {
#pragma unroll
    for (int i = 0; i < NCH; ++i) { const int c = tid + NTHR * i, row = c / chunks_per_row, ch = c % chunks_per_row; r[i] = *(const v4u*)(g0 + (size_t)row * gpitch + ch * 8); }
}
template <int NCH> __device__ __forceinline__ void stage_store_k(const v4u (&r)[NCH], LAS unsigned char* dst, int chunks_per_row, int lstride, int tid) {
#pragma unroll
    for (int i = 0; i < NCH; ++i) { const int c = tid + NTHR * i, row = c / chunks_per_row, ch = c % chunks_per_row; *(LAS v4u*)(dst + row * lstride + ch * 16) = r[i]; }
}
__device__ __forceinline__ bf16x8 lds_vfrag16(const LAS unsigned char* p) { return *(const LAS bf16x8*)p; }

constexpr float SM_THR = 8.0f;
template <int NO>
__device__ __forceinline__ void softmax_def2(f32x16& S0, f32x16& S1, bool first, float& mref, float& l, f32x16 (&O)[NO], int hh) {
    float mx = fmaxf(fmaxf(S0[0], S0[1]), fmaxf(S1[0], S1[1]));
#pragma unroll
    for (int i = 2; i < 16; i += 2) mx = fmaxf(mx, fmaxf(fmaxf(S0[i], S0[i + 1]), fmaxf(S1[i], S1[i + 1])));
    mx = fmaxf(mx, xhalf(mx, hh));
    if (first || __any(mx > SM_THR)) {
        const float dl = first ? mx : fmaxf(mx, 0.f), f = first ? 0.f : __builtin_amdgcn_exp2f(-dl);
        mref += dl; l *= f;
#pragma unroll
        for (int o = 0; o < NO; ++o) O[o] = O[o] * f;
#pragma unroll
        for (int i = 0; i < 16; ++i) { S0[i] -= dl; S1[i] -= dl; }
    }
    float ps = 0.f;
#pragma unroll
    for (int i = 0; i < 16; ++i) { S0[i] = __builtin_amdgcn_exp2f(S0[i]); S1[i] = __builtin_amdgcn_exp2f(S1[i]); ps += S0[i] + S1[i]; }
    l += ps;
}
template <int NO>
__device__ __forceinline__ void softmax_def1(f32x16& S, bool first, float& mref, float& l, f32x16 (&O)[NO], int hh) {
    float mx = fmaxf(fmaxf(S[0], S[1]), fmaxf(S[2], S[3]));
#pragma unroll
    for (int i = 4; i < 16; i += 4) mx = fmaxf(mx, fmaxf(fmaxf(S[i], S[i + 1]), fmaxf(S[i + 2], S[i + 3])));
    mx = fmaxf(mx, xhalf(mx, hh));
    if (first || __any(mx > SM_THR)) {
        const float dl = first ? mx : fmaxf(mx, 0.f), f = first ? 0.f : __builtin_amdgcn_exp2f(-dl);
        mref += dl; l *= f;
#pragma unroll
        for (int o = 0; o < NO; ++o) O[o] = O[o] * f;
#pragma unroll
        for (int i = 0; i < 16; ++i) S[i] -= dl;
    }
    float ps = 0.f;
#pragma unroll
    for (int i = 0; i < 16; ++i) { S[i] = __builtin_amdgcn_exp2f(S[i]); ps += S[i]; }
    l += ps;
}
__device__ __forceinline__ void attn_diff_block(const bf16_t* PR, const bf16_t* VT, bf16_t* OAT, const float* subln, float lam, int b, int h, int qb, LAS unsigned char* lds, int tid, int wave, int lane) {
    constexpr int KB = 8192, BUF = 2 * KB + 16384, QOFF = 3 * BUF;
    const int r32 = lane & 31, hh = lane >> 5, j = wave >> 2, w4 = wave & 3, q0 = qb * 128 + w4 * 32;
    const bf16_t* qrow = PR + (size_t)(b * SEQ + q0 + r32) * NIN + C_DQ + h * 128 + j * 64 + 8 * hh;
    LAS unsigned char* qs = lds + QOFF + wave * 4096 + lane * 16;
#pragma unroll
    for (int d0 = 0; d0 < 4; ++d0) *(LAS bf16x8*)(qs + d0 * 1024) = *(const bf16x8*)(qrow + 16 * d0);
    asm volatile("s_waitcnt vmcnt(0) lgkmcnt(0)" ::: "memory");
    const bf16_t* kg = PR + (size_t)(b * SEQ) * NIN + C_DK + h * 128;
    const bf16_t* vg = VT + (size_t)(b * 512 + h * 128) * SEQ;
    auto uni_ptr = [](const void* p_) __attribute__((always_inline)) { const unsigned long long v_ = (unsigned long long)p_; return (void*)(((unsigned long long)(unsigned)__builtin_amdgcn_readfirstlane((int)(v_ >> 32)) << 32) | (unsigned)__builtin_amdgcn_readfirstlane((int)v_)); };
    const auto rK = __builtin_amdgcn_make_buffer_rsrc(uni_ptr(kg), 0, 0x7fffffff, 0x00020000), rV = __builtin_amdgcn_make_buffer_rsrc(uni_ptr(vg), 0, 0x7fffffff, 0x00020000);
    const int prow = lane >> 3, pch = lane & 7;
    const int krow = 8 * wave + prow;
    const int kvoff = (krow * NIN + ((pch ^ (krow & 7)) << 3)) * 2;
    int vvoff[2];
#pragma unroll
    for (int pp = 0; pp < 2; ++pp) { const int vrow = 16 * wave + 8 * pp + prow; vvoff[pp] = (vrow * SEQ + ((pch ^ ((vrow ^ (vrow >> 3)) & 7)) << 3)) * 2; }
    auto dma = [&](int t_, int slot) __attribute__((always_inline)) {
        LAS unsigned char* sb_ = lds + slot;
        __builtin_amdgcn_raw_ptr_buffer_load_lds(rK, (LAS unsigned*)(sb_ + wave * 1024), 16, kvoff, t_ * (64 * NIN * 2), 0, 0);
        __builtin_amdgcn_raw_ptr_buffer_load_lds(rK, (LAS unsigned*)(sb_ + KB + wave * 1024), 16, kvoff + 128, t_ * (64 * NIN * 2), 0, 0);
        __builtin_amdgcn_raw_ptr_buffer_load_lds(rV, (LAS unsigned*)(sb_ + 2 * KB + wave * 2048), 16, vvoff[0], t_ * 128, 0, 0);
        __builtin_amdgcn_raw_ptr_buffer_load_lds(rV, (LAS unsigned*)(sb_ + 2 * KB + wave * 2048 + 1024), 16, vvoff[1], t_ * 128, 0, 0); };
    f32x16 O[4];
#pragma unroll
    for (int o = 0; o < 4; ++o)
#pragma unroll
        for (int i = 0; i < 16; ++i) O[o][i] = 0.f;
    float m = 0.f, l = 0.f;
    const int nsteps = 2 * qb + 2, my_last = 2 * qb + (w4 >> 1);
    const int xr = r32 & 7;
    bf16x8 p00, p01, p10, p11;
    f32x16 negm;
#pragma unroll
    for (int i = 0; i < 16; ++i) negm[i] = 0.f;
    auto qk_softmax = [&](int t, int slot) __attribute__((always_inline)) {
        if (t <= my_last) {
            const LAS unsigned char* kb = lds + slot + j * KB + r32 * 128;
            f32x16 S0, S1;
#pragma unroll
            for (int d0 = 0; d0 < 4; ++d0) { const int co = ((2 * d0 + hh) ^ xr) << 4; const bf16x8 qd = *(const LAS bf16x8*)(qs + d0 * 1024);
                S0 = mfma32(*(const LAS bf16x8*)(kb + co), qd, d0 == 0 ? negm : S0); S1 = mfma32(*(const LAS bf16x8*)(kb + 32 * 128 + co), qd, d0 == 0 ? negm : S1); }
            const float m_before = m;
            softmax_def2<4>(S0, S1, t == 0, m, l, O, hh);
            if (m != m_before) {
#pragma unroll
                for (int i = 0; i < 16; ++i) negm[i] = -m; }
            p00 = pack_p(S0, 0); p01 = pack_p(S0, 1); p10 = pack_p(S1, 0); p11 = pack_p(S1, 1);
        } };
    auto vfrag = [&](const LAS unsigned char* rowp, int c16, int sw) __attribute__((always_inline)) -> bf16x8 {
        return *(const LAS bf16x8*)(rowp + (((c16 + hh) ^ sw) << 4)); };
    auto pv = [&](int t, int slot) __attribute__((always_inline)) {
        if (t <= my_last) {
#pragma unroll
            for (int o = 0; o < 4; ++o) { const int d = 32 * o + r32, sw = (d ^ (d >> 3)) & 7; const LAS unsigned char* rowp = lds + slot + 2 * KB + d * 128;
                O[o] = mfma32(vfrag(rowp, 0, sw), p00, O[o]); O[o] = mfma32(vfrag(rowp, 2, sw), p01, O[o]); O[o] = mfma32(vfrag(rowp, 4, sw), p10, O[o]); O[o] = mfma32(vfrag(rowp, 6, sw), p11, O[o]); }
        } };
#define DIFF_BAR() do { asm volatile("s_waitcnt lgkmcnt(0)" ::: "memory"); __builtin_amdgcn_s_barrier(); asm volatile("" ::: "memory"); } while (0)
    dma(0, 0); dma(1, BUF);
    asm volatile("s_waitcnt vmcnt(4)" ::: "memory");
    DIFF_BAR();
#define DIFF_STEPS(H1, H2) { int sl = 0, slp = 2 * BUF, sln = BUF; \
    for (int t = 0; t < nsteps; ++t) { \
        H1(t, sl, slp); DIFF_BAR(); \
        const bool more = t + 2 < nsteps; \
        if (more) dma(t + 2, slp); \
        H2(t, sl); \
        if (more) asm volatile("s_waitcnt vmcnt(4)" ::: "memory"); else asm volatile("s_waitcnt vmcnt(0)" ::: "memory"); \
        DIFF_BAR(); \
        const int tmp_ = slp; slp = sl; sl = sln; sln = tmp_; } }
#define LEAD_H1(t, sl, slp) qk_softmax(t, sl)
#define LEAD_H2(t, sl) pv(t, sl)
#define LAG_H1(t, sl, slp) do { if ((t) > 0) pv((t) - 1, slp); } while (0)
#define LAG_H2(t, sl) qk_softmax(t, sl)
    if (j == 0) { DIFF_STEPS(LEAD_H1, LEAD_H2) } else { DIFF_STEPS(LAG_H1, LAG_H2) }
#undef DIFF_STEPS
#undef LEAD_H1
#undef LEAD_H2
#undef LAG_H1
#undef LAG_H2
    if (j == 1) pv(nsteps - 1, ((nsteps - 1) % 3) * BUF);
    DIFF_BAR();
#undef DIFF_BAR
    l += xhalf(l, hh);
    const float il = 1.f / l;
    LAS float* X = (LAS float*)lds + (size_t)(w4 * 32 + r32) * 132 + 4 * hh;
    if (j == 1) {
#pragma unroll
        for (int o = 0; o < 4; ++o)
#pragma unroll
            for (int g = 0; g < 4; ++g) *(LAS f32x4*)(X + 32 * o + 8 * g) = (f32x4){O[o][4 * g] * il, O[o][4 * g + 1] * il, O[o][4 * g + 2] * il, O[o][4 * g + 3] * il};
    }
    __syncthreads();
    if (j == 0) {
        float ss = 0.f;
#pragma unroll
        for (int o = 0; o < 4; ++o)
#pragma unroll
            for (int g = 0; g < 4; ++g) { const f32x4 o2 = *(const LAS f32x4*)(X + 32 * o + 8 * g);
#pragma unroll
                for (int c = 0; c < 4; ++c) { const float d = O[o][4 * g + c] * il - lam * o2[c]; O[o][4 * g + c] = d; ss += d * d; } }
        ss += xhalf(ss, hh);
        const float rinv = 0.8f / sqrtf(ss * (1.f / 128.f) + NORM_EPS);
        bf16_t* orow = OAT + (size_t)(b * SEQ + q0 + r32) * D + 512 + h * 128 + 4 * hh; const float* sl = subln + 4 * hh;
#pragma unroll
        for (int o = 0; o < 4; ++o)
#pragma unroll
            for (int g = 0; g < 4; ++g) { const f32x4 sg_ = *(const f32x4*)(sl + 32 * o + 8 * g); v2u w;
                w.x = pg8::cvt_pk_bf16(O[o][4 * g] * rinv * sg_[0], O[o][4 * g + 1] * rinv * sg_[1]); w.y = pg8::cvt_pk_bf16(O[o][4 * g + 2] * rinv * sg_[2], O[o][4 * g + 3] * rinv * sg_[3]); *(v2u*)(orow + 32 * o + 8 * g) = w; }
    }
    __syncthreads();
}

__device__ __forceinline__ void sb_tile(const bf16x8 (&kf)[4], const bf16x8 (&vf)[4], const bf16x8 (&qf)[4], bool diag, float& R, f32x16 (&O)[2], int r32, int hh) {
    f32x16 S;
#pragma unroll
    for (int i = 0; i < 16; ++i) S[i] = 0.f;
#pragma unroll
    for (int d0 = 0; d0 < 4; ++d0) S = mfma32(kf[d0], qf[d0], S);
    f32x16 lr;
#pragma unroll
    for (int i = 0; i < 16; ++i) { const float z2 = S[i]; const float sp = fmaxf(z2, 0.f) + __builtin_amdgcn_logf(1.f + __builtin_amdgcn_exp2f(-fabsf(z2))); lr[i] = -sp; S[i] = z2 - sp; }
    if (diag) {
#pragma unroll
        for (int i = 0; i < 16; ++i) { const int kvl = (i & 3) + 8 * (i >> 2) + 4 * hh; if (kvl >= r32) { lr[i] = 0.f; S[i] = -INFINITY; } }
    }
    float tot[4], pt[4], off[4]; f32x16 ex;
#pragma unroll
    for (int g = 0; g < 4; ++g) { ex[4 * g + 3] = 0.f; ex[4 * g + 2] = lr[4 * g + 3]; ex[4 * g + 1] = lr[4 * g + 3] + lr[4 * g + 2]; ex[4 * g] = ex[4 * g + 1] + lr[4 * g + 1]; tot[g] = ex[4 * g] + lr[4 * g]; }
#pragma unroll
    for (int g = 0; g < 4; ++g) pt[g] = xhalf(tot[g], hh);
    const float own0 = hh ? 0.f : 1.f;
    float sp_ = 0.f;
#pragma unroll
    for (int g = 3; g >= 0; --g) { off[g] = sp_ + own0 * pt[g] + R; sp_ += tot[g] + pt[g]; }
#pragma unroll
    for (int i = 0; i < 16; ++i) S[i] = __builtin_amdgcn_exp2f(S[i] + ex[i] + off[i >> 2]);
    R += sp_;
    const bf16x8 p0 = pack_p(S, 0), p1 = pack_p(S, 1);
#pragma unroll
    for (int o = 0; o < 2; ++o) { O[o] = mfma32(vf[2 * o], p0, O[o]); O[o] = mfma32(vf[2 * o + 1], p1, O[o]); }
}
__device__ __forceinline__ void sb_load(bf16x8 (&kf)[4], bf16x8 (&vf)[4], const bf16_t* kbase, const bf16_t* vbase, int t) {
    const bf16_t* kp = kbase + (size_t)(32 * t) * NIN; const bf16_t* vp = vbase + 32 * t;
#pragma unroll
    for (int d0 = 0; d0 < 4; ++d0) kf[d0] = *(const bf16x8*)(kp + 16 * d0);
#pragma unroll
    for (int o = 0; o < 2; ++o) { vf[2 * o] = *(const bf16x8*)(vp + (size_t)(32 * o) * SEQ); vf[2 * o + 1] = *(const bf16x8*)(vp + (size_t)(32 * o) * SEQ + 16); }
}
__device__ __forceinline__ void attn_sb_wave(const bf16_t* PR, const bf16_t* VT, bf16_t* OAT, int b, int h, int q0, int lane) {
    const int r32 = lane & 31, hh = lane >> 5;
    const bf16_t* qrow = PR + (size_t)(b * SEQ + q0 + r32) * NIN + C_SBQ + h * 64 + 8 * hh;
    bf16x8 qf[4];
#pragma unroll
    for (int d0 = 0; d0 < 4; ++d0) qf[d0] = *(const bf16x8*)(qrow + 16 * d0);
    const bf16_t* kbase = PR + (size_t)(b * SEQ + r32) * NIN + C_SBK + h * 64 + 8 * hh;
    const bf16_t* vbase = VT + (size_t)(b * 512 + h * 64 + r32) * SEQ + 8 * hh;
    f32x16 O[2];
#pragma unroll
    for (int o = 0; o < 2; ++o)
#pragma unroll
        for (int i = 0; i < 16; ++i) O[o][i] = 0.f;
    float R = 0.f;
    const int td = q0 >> 5;
    bf16x8 ck[4], cv[4], nk[4], nv[4];
    sb_load(ck, cv, kbase, vbase, td);
    for (int t = td; t >= 0; --t) {
        sb_load(nk, nv, kbase, vbase, t > 0 ? t - 1 : 0);
        sb_tile(ck, cv, qf, t == td, R, O, r32, hh);
        if (__all(R < -160.f)) break;
#pragma unroll
        for (int i = 0; i < 4; ++i) { ck[i] = nk[i]; cv[i] = nv[i]; }
    }
    bf16_t* orow = OAT + (size_t)(b * SEQ + q0 + r32) * D + h * 64 + 4 * hh;
#pragma unroll
    for (int o = 0; o < 2; ++o)
#pragma unroll
        for (int g = 0; g < 4; ++g) { v2u w; w.x = pg8::cvt_pk_bf16(O[o][4 * g], O[o][4 * g + 1]); w.y = pg8::cvt_pk_bf16(O[o][4 * g + 2], O[o][4 * g + 3]); *(v2u*)(orow + 32 * o + 8 * g) = w; }
}

__device__ __forceinline__ void attn_mem_block(const bf16_t* QM, const bf16_t* KVM, const bf16_t* VT, bf16_t* OM, int b, int h, int qb, LAS unsigned char* lds, int tid, int wave, int lane) {
    constexpr int KSTR = 528, KB = 32 * KSTR, VS = 80, BUF = KB + 128 * VS;
    const int r32 = lane & 31, hh = lane >> 5, q0 = qb * 256 + wave * 32;
    const bf16_t* qrow = QM + (size_t)(b * SEQ + q0 + r32) * D + h * 256 + 8 * hh;
    bf16x8 qf[8];
    LAS unsigned char* qs = lds + 57344 + wave * 8192 + lane * 16;
#pragma unroll
    for (int d0 = 0; d0 < 8; ++d0) { qf[d0] = *(const bf16x8*)(qrow + 16 * d0); *(LAS bf16x8*)(qs + d0 * 1024) = *(const bf16x8*)(qrow + 128 + 16 * d0); }
    const bf16_t* kg = KVM + (size_t)(b * MEMLEN) * 2048 + h * 256;
    const int vrow = tid >> 2, vch = tid & 3;
    for (int dh = 0; dh < 2; ++dh) {
        const bf16_t* vg = VT + (size_t)(b * 1024 + h * 256 + dh * 128 + vrow) * MEMLEN + vch * 8;
        f32x16 O[4];
#pragma unroll
        for (int o = 0; o < 4; ++o)
#pragma unroll
            for (int i = 0; i < 16; ++i) O[o][i] = 0.f;
        float m = 0.f, l = 0.f;
        v4u kr[2], vr;
        stage_load<2>(kr, kg, 32, 2048, tid); vr = *(const v4u*)vg;
        stage_store_k<2>(kr, lds, 32, KSTR, tid); *(LAS v4u*)(lds + KB + vrow * VS + vch * 16) = vr;
        __syncthreads();
        for (int t = 0; t < 8; ++t) {
            const bool more = t < 7;
            if (more) { stage_load<2>(kr, kg + (size_t)(32 * (t + 1)) * 2048, 32, 2048, tid); vr = *(const v4u*)(vg + 32 * (t + 1)); }
            {
                const LAS unsigned char* kb = lds + (t & 1) * BUF + r32 * KSTR + 16 * hh; const LAS unsigned char* vb = lds + (t & 1) * BUF + KB + r32 * VS + 16 * hh;
                f32x16 S;
#pragma unroll
                for (int i = 0; i < 16; ++i) S[i] = -m;
#pragma unroll
                for (int d0 = 0; d0 < 8; ++d0) S = mfma32(*(const LAS bf16x8*)(kb + 32 * d0), qf[d0], S);
#pragma unroll
                for (int d0 = 0; d0 < 8; ++d0) S = mfma32(*(const LAS bf16x8*)(kb + 256 + 32 * d0), *(const LAS bf16x8*)(qs + d0 * 1024), S);
                softmax_def1<4>(S, t == 0, m, l, O, hh);
                const bf16x8 p0 = pack_p(S, 0), p1 = pack_p(S, 1);
#pragma unroll
                for (int o = 0; o < 4; ++o) { const LAS unsigned char* vp = vb + 32 * o * VS; O[o] = mfma32(lds_vfrag16(vp), p0, O[o]); O[o] = mfma32(lds_vfrag16(vp + 32), p1, O[o]); }
            }
            if (more) { LAS unsigned char* nb = lds + ((t + 1) & 1) * BUF; stage_store_k<2>(kr, nb, 32, KSTR, tid); *(LAS v4u*)(nb + KB + vrow * VS + vch * 16) = vr; }
            __syncthreads();
        }
        l += xhalf(l, hh);
        const float il = 1.f / l;
        bf16_t* orow = OM + (size_t)(b * SEQ + q0 + r32) * D + h * 256 + dh * 128 + 4 * hh;
#pragma unroll
        for (int o = 0; o < 4; ++o)
#pragma unroll
            for (int g = 0; g < 4; ++g) { v2u w; w.x = pg8::cvt_pk_bf16(O[o][4 * g] * il, O[o][4 * g + 1] * il); w.y = pg8::cvt_pk_bf16(O[o][4 * g + 2] * il, O[o][4 * g + 3] * il); *(v2u*)(orow + 32 * o + 8 * g) = w; }
    }
}

struct Args { const void* in[26]; float* out; unsigned char* ws; int ph_lo, ph_hi; };
constexpr int NPHASE = 15;

__global__ void __launch_bounds__(NTHR, 2) fwd(Args args) {
    extern __shared__ __attribute__((aligned(16))) unsigned char lds[];
    LAS unsigned char* L = (LAS unsigned char*)lds;
    volatile LAS unsigned* MISC = (volatile LAS unsigned*)(L + MISC_OFF);
    const int tid = threadIdx.x, lane = tid & 63, wave = __builtin_amdgcn_readfirstlane(tid >> 6);
    const int G = gridDim.x;
    unsigned char* ws = args.ws;
    unsigned* ctl = (unsigned*)(ws + WS_CTL);
#define x_in ((const float*)args.in[0])
#define mem_in ((const float*)args.in[1])
#define positions ((const int*)args.in[2])
#define norm_mix ((const float*)args.in[3])
#define w_in ((const float*)args.in[4])
#define lam_q1 ((const float*)args.in[5])
#define lam_k1 ((const float*)args.in[6])
#define lam_q2 ((const float*)args.in[7])
#define lam_k2 ((const float*)args.in[8])
#define diff_subln ((const float*)args.in[9])
#define w_up_sb ((const float*)args.in[10])
#define w_up_diff ((const float*)args.in[11])
#define w_out ((const float*)args.in[12])
#define norm_mem_q ((const float*)args.in[13])
#define norm_mem_kv ((const float*)args.in[14])
#define w_mem_q ((const float*)args.in[15])
#define w_mem_kv ((const float*)args.in[16])
#define w_mem_o ((const float*)args.in[17])
#define norm_ffn ((const float*)args.in[18])
#define w_router ((const float*)args.in[19])
#define b_router ((const float*)args.in[20])
#define w_gate_up ((const float*)args.in[21])
#define b_gate_up ((const float*)args.in[22])
#define w_down ((const float*)args.in[23])
#define b_down ((const float*)args.in[24])
#define norm_final ((const float*)args.in[25])
    bf16_t* WIN = (bf16_t*)(ws + WS_WIN); bf16_t* WUPSB = (bf16_t*)(ws + WS_WUPSB); bf16_t* WUPDF = (bf16_t*)(ws + WS_WUPDF); bf16_t* WOUT = (bf16_t*)(ws + WS_WOUT);
    bf16_t* WMQ = (bf16_t*)(ws + WS_WMQ); bf16_t* WMKV = (bf16_t*)(ws + WS_WMKV); bf16_t* WMO = (bf16_t*)(ws + WS_WMO);
    bf16_t* WGU = (bf16_t*)(ws + WS_WGU); bf16_t* WD = (bf16_t*)(ws + WS_WD);
    float* ROPEC = (float*)(ws + WS_ROPE); float* ROPES = ROPEC + (size_t)M * 32;
    int* TK_E = (int*)(ws + WS_TK); int* TK_POS = TK_E + (size_t)M * 4; float* TK_G = (float*)(TK_POS + (size_t)M * 4);
    bf16_t* XN = (bf16_t*)(ws + WS_XN); bf16_t* PR = (bf16_t*)(ws + WS_PR); bf16_t* OAT = (bf16_t*)(ws + WS_OAT); float* SSQ = (float*)(ws + WS_ODR);
    bf16_t* MIX = (bf16_t*)(ws + WS_MIX); float* X1 = (float*)(ws + WS_X1); float* X2 = (float*)(ws + WS_X2);
    bf16_t* HM = (bf16_t*)(ws + WS_HM); bf16_t* KVM = (bf16_t*)(ws + WS_KVM); int* TLIST = (int*)(ws + WS_TLIST); float* GLIST = (float*)(ws + WS_GLIST);
    bf16_t* QM = (bf16_t*)(ws + WS_QM); bf16_t* OM = (bf16_t*)(ws + WS_OM); bf16_t* ACT = (bf16_t*)(ws + WS_ACT); bf16_t* YB = (bf16_t*)(ws + WS_YB);
    bf16_t* VTSB = (bf16_t*)(ws + WS_VTSB); bf16_t* VTDF = (bf16_t*)(ws + WS_VTDF); bf16_t* VTM = (bf16_t*)(ws + WS_VTM);
    float* WR = (float*)(ws + WS_WR); float* WSCGU = (float*)(ws + WS_WSC); float* WSCD = WSCGU + NE * 2048;
    unsigned char* WGU8 = ws + WS_WGU; unsigned char* WD8 = ws + WS_WD; unsigned char* XN8 = ws + WS_XN; unsigned char* ACT8 = ws + WS_ACT;
    unsigned* CNT = ctl + CW_CNT;
    LAS float* smf = (LAS float*)L;
    LAS int* smi = (LAS int*)L;

    for (int u = tid; u < (LDS_BYTES - 131072) / 4; u += NTHR) ((LAS unsigned*)(L + 131072))[u] = 0u;
    __syncthreads();
#if !MK_PER_PHASE
    XcdBarrier bar = xcd_barrier_post(ctl + CW_BAR, MISC + 8);
#define GRID_BAR() xcd_barrier(bar)
#else
#define GRID_BAR() do {} while (0)
#endif
    const int lo = args.ph_lo, hi = args.ph_hi;
#define IN(k) (lo <= (k) && (k) < hi)
#define PHASE_L(k, ...) do { if (IN(k)) { auto body_ = [&]() __attribute__((always_inline)) __VA_ARGS__; body_(); if ((PROBE_REP >> (k)) & 1) { GRID_BAR(); body_(); } } } while (0)
#if !MK_PER_PHASE
#define PHASE(k) for (int rep_ = 0, nrep_ = IN(k) ? 1 + ((PROBE_REP >> (k)) & 1) : 0; rep_ < nrep_; ++rep_, (rep_ < nrep_ ? (xcd_barrier(bar), 0) : 0))
#else
#define PHASE(k) if (IN(k))
#endif
    unsigned long long st_t0_ = 0ull, st_dt_ = 0ull;
#define STAMP_AT(k) do { if (PROBE_STAMP >= 0) { const unsigned long long now_ = __builtin_amdgcn_s_memrealtime(); if ((k) == PROBE_STAMP || (PROBE_STAMP == 100 && (k) == 0)) st_t0_ = now_; if ((k) == PROBE_STAMP + 1 || (PROBE_STAMP == 100 && (k) == 15)) st_dt_ = now_ - st_t0_; } } while (0)
#define SEAM(k) do { if (IN(k) && IN((k) + 1)) GRID_BAR(); STAMP_AT((k) + 1); } while (0)
    const int gw = blockIdx.x * NWAVES + wave, NGW = G * NWAVES;
    const int xcu = (G % 8 == 0) ? ((int)blockIdx.x % 8) * (G / 8) + (int)blockIdx.x / 8 : (int)blockIdx.x;

    auto convert_experts = [&]() __attribute__((always_inline)) {
        const int hw = tid >> 5, n8 = tid & 7, cch = (tid >> 3) & 3;
        f32x4 ra[8], rb[8];
        auto tile_load = [&](const float* Wl, int N, int k0, f32x4 (&r)[8]) __attribute__((always_inline)) {
#pragma unroll
            for (int i = 0; i < 8; ++i) r[i] = *(const f32x4*)(Wl + (size_t)(k0 + 8 * i + wave) * N); };
        auto tile_to_lds = [&](const f32x4 (&r)[8], LAS float* buf) __attribute__((always_inline)) {
#pragma unroll
            for (int i = 0; i < 8; ++i) { const int k = 8 * i + wave; *(LAS f32x4*)(buf + k * 256 + ((4 * lane) ^ (8 * (k >> 4)))) = r[i]; } };
        for (int it = blockIdx.x; it < NE * 12 * 2; it += G) {
            const int cs = it % (NE * 12), kh = it / (NE * 12);
            const bool gu = cs < NE * 8; const int q = gu ? cs : cs - NE * 8, e = gu ? q >> 3 : q >> 2, n0 = (gu ? q & 7 : q & 3) * 256, N = gu ? 2048 : 1024;
            const float* Wl = (gu ? w_gate_up + (size_t)e * 1024 * 2048 : w_down + (size_t)e * 1024 * 1024) + n0 + 4 * lane;
            unsigned char* dstb = gu ? WGU8 + (size_t)e * 2048 * 1024 : WD8 + (size_t)e * 1024 * 1024;
            float inv[2] = {0.f, 0.f}, am[2] = {0.f, 0.f};
            tile_load(Wl, N, 0, ra); tile_load(Wl, N, 512 * kh, rb);
            __syncthreads();
#pragma unroll
            for (int ti = 0; ti < 9; ++ti) {
                LAS float* buf = (LAS float*)L + (ti & 1) * 16384;
                if (ti & 1) { tile_to_lds(rb, buf); if (ti + 2 < 9) tile_load(Wl, N, 512 * kh + 64 * (ti + 1), rb); }
                else        { tile_to_lds(ra, buf); if (ti + 2 < 9) tile_load(Wl, N, 512 * kh + 64 * (ti + 1), ra); }
                __syncthreads();
                const int k0 = 512 * kh + 64 * (ti - 1);
#pragma unroll
                for (int pp = 0; pp < 2; ++pp) { const int n = 8 * hw + n8 + 128 * pp; const LAS float* sp = buf + (16 * cch) * 256 + (n ^ (8 * cch)); float v[16]; float a0 = 0.f;
#pragma unroll
                    for (int i = 0; i < 16; ++i) { v[i] = sp[i * 256]; a0 = fmaxf(a0, fabsf(v[i])); }
                    if (ti == 0) {
                        a0 = fmaxf(a0, __shfl_xor(a0, 8)); a0 = fmaxf(a0, __shfl_xor(a0, 16));
                        unsigned eb = ((__float_as_uint(a0) >> 23) & 0xffu) + 4u; eb = eb < 8u ? 8u : (eb > 250u ? 250u : eb);
                        inv[pp] = __uint_as_float((261u - eb) << 23);
                        if (kh == 0 && cch == 0) (gu ? WSCGU + (size_t)e * 2048 : WSCD + (size_t)e * 1024)[n0 + n] = __uint_as_float((eb - 7u) << 23);
                    } else {
                        am[pp] = fmaxf(am[pp], a0);
                        const int c = n0 + n, drow = gu ? (((c & 1023) >> 7) * 256 + (c >> 10) * 128 + (c & 127)) : c; const float iv = inv[pp];
                        v4u w; w.x = pk4_fp8(v[0] * iv, v[1] * iv, v[2] * iv, v[3] * iv); w.y = pk4_fp8(v[4] * iv, v[5] * iv, v[6] * iv, v[7] * iv);
                        w.z = pk4_fp8(v[8] * iv, v[9] * iv, v[10] * iv, v[11] * iv); w.w = pk4_fp8(v[12] * iv, v[13] * iv, v[14] * iv, v[15] * iv);
                        *(v4u*)(dstb + (size_t)drow * 1024 + k0 + 16 * cch) = w; } }
            }
            const bool ov = (am[0] * inv[0] >= 448.0f) || (am[1] * inv[1] >= 448.0f);
            if (__any(ov) && lane == 0) __hip_atomic_store(ctl + CW_REDO + cs, 1u, __ATOMIC_RELAXED, __HIP_MEMORY_SCOPE_AGENT);
        }
        __syncthreads();
    };
    STAMP_AT(0);
    PHASE(0) {
        STAMP_AT(20);
        LAS float* scr = (LAS float*)(L + wave * 16384);
        constexpr int I_IN = 16 * 160, I_UP = 8 * 32, I_SQ = 16 * 32, I_KV = 16 * 64, I_GU1 = 16 * 64, I_GU = NE * I_GU1, I_D1 = 16 * 32, I_DN = NE * I_D1;
        constexpr int NITEMS = I_IN + 2 * I_UP + 3 * I_SQ + I_KV;
        for (int it = gw; it < NITEMS; it += NGW) {
            int r = it;
            if (r < I_IN) {
                const int kb = r / 160, nb = r % 160, n0 = 32 * nb;
                if (n0 >= C_DQ && n0 < C_DV) { const int o = n0 & 255;
                    p0_transpose_rope(w_in, WIN, (n0 & ~255), o, 64 * kb, n0, scr, lane); }
                else p0_transpose_item(w_in, 1024, NIN, WIN, n0, 64 * kb, n0, scr, lane);
                continue; } r -= I_IN;
            if (r < I_UP) { p0_plain(w_up_sb, 512, 1024, WUPSB, r, scr, lane); continue; } r -= I_UP;
            if (r < I_UP) { p0_plain(w_up_diff, 512, 1024, WUPDF, r, scr, lane); continue; } r -= I_UP;
            if (r < I_SQ) { p0_plain(w_out, 1024, 1024, WOUT, r, scr, lane); continue; } r -= I_SQ;
            if (r < I_SQ) { p0_plain(w_mem_q, 1024, 1024, WMQ, r, scr, lane, norm_mem_q); continue; } r -= I_SQ;
            if (r < I_SQ) { p0_plain(w_mem_o, 1024, 1024, WMO, r, scr, lane); continue; } r -= I_SQ;
            p0_plain(w_mem_kv, 1024, 2048, WMKV, r, scr, lane);
        }
        for (int i = blockIdx.x * NTHR + tid; i < D * NE; i += G * NTHR) WR[i] = w_router[i] * norm_ffn[i >> 5];
        STAMP_AT(21);
        STAMP_AT(22);
        for (int m = gw; m < M; m += 2 * NGW) { const int m2 = m + NGW; rms_rows2<false>(x_in + (size_t)m * D, x_in + (size_t)m2 * D, m2 < M, norm_mix, XN + (size_t)m * D, XN + (size_t)m2 * D, lane); }
        for (int m = gw; m < MM; m += NGW) rms_row_to_bf16(mem_in + (size_t)m * D, norm_mem_kv, HM + (size_t)m * D, lane);
        for (int i = blockIdx.x * NTHR + tid; i < M * 32; i += G * NTHR) {
            const int m = i >> 5, f = i & 31;
            const double inv = exp2(-(double)f * (13.287712379549449 / 32.0));
            const double ang = (double)positions[m] * inv;
            const double kk = rint(ang * 0.15915494309189535);
            const float rf = (float)(ang - kk * 6.283185307179586);
            ROPEC[i] = __cosf(rf); ROPES[i] = __sinf(rf);
        }
        STAMP_AT(23);
    }
    SEAM(0); STAMP_AT(24);

    if (IN(1)) {
        const int grp = (int)blockIdx.x % 3;
        pg8::Gemm g{XN, WIN, D, D, D}; pg8::DenseOrder S; S.init(M, NIN, G, (int)blockIdx.x, D, D);
        const pg8::EpiInProj E{PR, ROPEC, ROPES, VTSB, VTDF};
        STAMP_AT(40);
        if (grp == 0) { convert_experts(); __syncthreads(); }
        STAMP_AT(41);
        if (grp == 1) { S.i0 = 0; S.i1 = 2; pg8::gemm_phase<pg8::EpiInProj, pg8::DenseOrder, false>(L, g, S, E); convert_experts(); __syncthreads(); S.i0 = 2; S.i1 = 1 << 30; }
        pg8::gemm_phase<pg8::EpiInProj, pg8::DenseOrder, false>(L, g, S, E);
        STAMP_AT(42);
        if (grp == 2) convert_experts();
        STAMP_AT(43);
    }
    SEAM(1);

    if (IN(3)) {
        {
            LAS float* sw = (LAS float*)L; LAS float* red = (LAS float*)(L + 131072 + 4096);
            const int n = tid & 31, part = tid >> 5;
            for (int it = blockIdx.x; it < NE * 96; it += G) {
                { const int cs_ = it < NE * 64 ? ((it >> 6) * 8 + ((it & 63) >> 3)) : (NE * 8 + ((it - NE * 64) >> 5) * 4 + (((it - NE * 64) & 31) >> 3));
                  if (__hip_atomic_load(ctl + CW_REDO + cs_, __ATOMIC_RELAXED, __HIP_MEMORY_SCOPE_AGENT) == 0u) continue; }
                const bool gu = it < NE * 64; const int q = gu ? it : it - NE * 64, e = gu ? q >> 6 : q >> 5, n0 = (gu ? q & 63 : q & 31) * 32, N = gu ? 2048 : 1024;
                const float* W = (gu ? w_gate_up + (size_t)e * 1024 * 2048 : w_down + (size_t)e * 1024 * 1024) + n0 + n;
                __syncthreads();
#pragma unroll 16
                for (int i = 0; i < 64; ++i) { const int k = part + 16 * i; sw[k * 32 + n] = W[(size_t)k * N]; }
                __syncthreads();
                float am = 0.f;
#pragma unroll 16
                for (int i = 0; i < 64; ++i) am = fmaxf(am, fabsf(sw[(64 * part + i) * 32 + n]));
                red[part * 32 + n] = am;
                __syncthreads();
                if (tid < 32) { float a = red[tid];
#pragma unroll
                    for (int pp = 1; pp < 16; ++pp) a = fmaxf(a, red[pp * 32 + tid]);
                    unsigned eb = (__float_as_uint(a) >> 23) & 0xffu; eb = eb < 8u ? 8u : eb;
                    const float sc = __uint_as_float((eb - 7u) << 23), inv = __uint_as_float((261u - eb) << 23);
                    red[512 + tid] = inv; (gu ? WSCGU + (size_t)e * 2048 : WSCD + (size_t)e * 1024)[n0 + tid] = sc; }
                __syncthreads();
                { const float inv = red[512 + n]; const int c = n0 + n;
                  const int drow = gu ? (((c & 1023) >> 7) * 256 + (c >> 10) * 128 + (c & 127)) : c;
                  unsigned char* dst = (gu ? WGU8 + ((size_t)e * 2048 + drow) * 1024 : WD8 + ((size_t)e * 1024 + drow) * 1024) + 64 * part;
#pragma unroll
                  for (int qd = 0; qd < 4; ++qd) { v4u w;
                      const LAS float* sp = sw + (64 * part + 16 * qd) * 32 + n;
                      w.x = pk4_fp8(sp[0] * inv, sp[32] * inv, sp[64] * inv, sp[96] * inv); w.y = pk4_fp8(sp[128] * inv, sp[160] * inv, sp[192] * inv, sp[224] * inv);
                      w.z = pk4_fp8(sp[256] * inv, sp[288] * inv, sp[320] * inv, sp[352] * inv); w.w = pk4_fp8(sp[384] * inv, sp[416] * inv, sp[448] * inv, sp[480] * inv);
                      *(v4u*)(dst + 16 * qd) = w; } }
            }
            __syncthreads();
        }
    }
    PHASE(3) {
        volatile LAS unsigned* fl = (volatile LAS unsigned*)(L + 131072 + 2048);
        STAMP_AT(30);
        const float lam = expf(wave_sum(lam_q1[lane] * lam_k1[lane])) - expf(wave_sum(lam_q2[lane] * lam_k2[lane])) + 0.2f;
        const int nkv = (G >= 64) ? 32 : 0;
        if ((int)blockIdx.x < nkv) { pg8::Gemm g{HM, WMKV, D, D, D}; pg8::OneUnitOrder S{(int)blockIdx.x, D, D};
            pg8::gemm_phase<pg8::EpiKV, pg8::OneUnitOrder, false>(L, g, S, pg8::EpiKV{KVM, VTM}); }
        if (nkv == 0) { pg8::Gemm g{HM, WMKV, D, D, D}; pg8::DenseOrder S; S.init(MM, 2048, G, (int)blockIdx.x, D, D); pg8::gemm_phase<pg8::EpiKV, pg8::DenseOrder, false>(L, g, S, pg8::EpiKV{KVM, VTM}); }
        for (int pr = blockIdx.x; pr < 256; pr += G) { const int sb_ = pr & 15, h = (pr >> 4) & 3, b = pr >> 6;
            attn_diff_block(PR, VTDF, OAT, diff_subln, lam, b, h, 31 - sb_, L, tid, wave, lane); attn_diff_block(PR, VTDF, OAT, diff_subln, lam, b, h, sb_, L, tid, wave, lane); }
        STAMP_AT(31);
        for (;;) {
            if (tid == 0) fl[4] = __hip_atomic_fetch_add(ctl + CW_SBQ, 1u, __ATOMIC_RELAXED, __HIP_MEMORY_SCOPE_AGENT);
            __syncthreads();
            const int bu = (int)fl[4];
            __syncthreads();
            if (bu >= 512) break;
            const int qb = 15 - (bu & 15), h = (bu >> 4) & 7, b = bu >> 7;
            attn_sb_wave(PR, VTSB, OAT, b, h, qb * 256 + wave * 32, lane);
        }
        STAMP_AT(32);
    }
    SEAM(3); STAMP_AT(3); STAMP_AT(33);

    PHASE_L(5, {
        pg8::Gemm g{OAT, WUPSB, D, 512, 512}; pg8::TwoRoundOrder S{G, xcu, D, 512};
        pg8::gemm_phase<pg8::EpiGate, pg8::TwoRoundOrder, false>(L, g, S, pg8::EpiGate{PR, (bf16_t*)X1, MIX});
    });
    SEAM(5); STAMP_AT(5);

    PHASE_L(6, {
        pg8::Gemm g{MIX, WOUT, D, D, D}; pg8::DenseOrder S; S.init(M, D, G, (int)blockIdx.x, D, D);
        pg8::gemm_phase<pg8::EpiResidNorm, pg8::DenseOrder, false>(L, g, S, pg8::EpiResidNorm{x_in, X1, XN, SSQ});
    });
    if (IN(6) && IN(8)) GRID_BAR();
    STAMP_AT(7); STAMP_AT(8);

    if (IN(8)) {
        pg8::Gemm g{XN, WMQ, D, D, D}; pg8::DenseOrder S; S.init(M, D, G, (int)blockIdx.x, D, D);
        pg8::gemm_phase<pg8::EpiBf16Rinv, pg8::DenseOrder, false>(L, g, S, pg8::EpiBf16Rinv{QM, SSQ, 0.0625f * 1.4426950408889634f});
        asm volatile("s_waitcnt vmcnt(0)" ::: "memory");
        __syncthreads();
        pg8::Unit u;
        for (int i = 0; S.next(i, u); ++i) attn_mem_block(QM, KVM, VTM, OM, u.pm >> 4, u.pn, u.pm & 15, L, tid, wave, lane);
    }
    STAMP_AT(9);
    SEAM(9);

    PHASE_L(10, {
        pg8::Gemm g{OM, WMO, D, D, D}; pg8::DenseOrder S; S.init(M, D, G, (int)blockIdx.x, D, D);
        pg8::gemm_phase<pg8::EpiResidB, pg8::DenseOrder, false>(L, g, S, pg8::EpiResidB{XN, X2});
    });
    SEAM(10);

    if (IN(11)) {
        auto body11_ = [&]() __attribute__((always_inline)) {
        {
            const int i32 = lane & 31, kk = lane >> 5;
#pragma unroll
            for (int t2 = 0; t2 < 2; ++t2) {
                const int tile = t2 * G + (int)blockIdx.x, m0 = tile * 32;
                LAS float* P = smf + (t2 * 8 + wave) * 1056; LAS float* SSQ_ = smf + 16 * 1056 + (t2 * 8 + wave) * 32;
                f32x16 acc;
#pragma unroll
                for (int r = 0; r < 16; ++r) acc[r] = 0.f;
                float ss = 0.f;
                if (tile < M / 32) {
                    const float* xr = X2 + (size_t)(m0 + i32) * D + 128 * wave + 4 * kk; const float* wp = WR + (128 * wave + 4 * kk) * NE + i32;
#pragma unroll 8
                    for (int u = 0; u < 16; ++u) {
                        const f32x4 a = *(const f32x4*)(xr + 8 * u);
                        const float b0 = wp[(8 * u + 0) * NE], b1 = wp[(8 * u + 1) * NE], b2 = wp[(8 * u + 2) * NE], b3 = wp[(8 * u + 3) * NE];
                        acc = __builtin_amdgcn_mfma_f32_32x32x2f32(a.x, b0, acc, 0, 0, 0); acc = __builtin_amdgcn_mfma_f32_32x32x2f32(a.y, b1, acc, 0, 0, 0);
                        acc = __builtin_amdgcn_mfma_f32_32x32x2f32(a.z, b2, acc, 0, 0, 0); acc = __builtin_amdgcn_mfma_f32_32x32x2f32(a.w, b3, acc, 0, 0, 0);
                        ss += (a.x * a.x + a.y * a.y) + (a.z * a.z + a.w * a.w);
                    }
                }
                ss += xhalf(ss, kk);
#pragma unroll
                for (int r = 0; r < 16; ++r) P[((r & 3) + 8 * (r >> 2) + 4 * kk) * 33 + i32] = acc[r];
                if (kk == 0) SSQ_[i32] = ss;
            }
        }
        __syncthreads();
        if (wave < 2) {
            const int tile = wave * G + (int)blockIdx.x;
            if (tile < M / 32) {
                const int m0 = tile * 32;
                LAS float* T = smf + (wave * 8) * 1056;
#pragma unroll
                for (int r = 0; r < 16; ++r) { const int idx = lane + 64 * r, e_ = (idx >> 5) * 33 + (idx & 31); float v = T[e_];
#pragma unroll
                    for (int w2 = 1; w2 < 8; ++w2) v += T[w2 * 1056 + e_];
                    T[e_] = v; }
                float ss = 0.f;
#pragma unroll
                for (int w2 = 0; w2 < 8; ++w2) ss += smf[16 * 1056 + (wave * 8 + w2) * 32 + (lane & 31)];
                LDS_WAIT(); asm volatile("" ::: "memory");
                const float rinv = 1.0f / sqrtf(ss * (1.f / 1024.f) + NORM_EPS);
                if (lane < 32) {
                    float lg[32];
#pragma unroll
                    for (int j = 0; j < 32; ++j) lg[j] = T[lane * 33 + j] * rinv + b_router[j];
                    float tv[4]; int ti[4];
#pragma unroll
                    for (int k = 0; k < 4; ++k) { float bv = lg[0]; int bi = 0;
#pragma unroll
                        for (int j = 1; j < 32; ++j) if (lg[j] > bv) { bv = lg[j]; bi = j; }
                        tv[k] = bv; ti[k] = bi;
#pragma unroll
                        for (int j = 0; j < 32; ++j) if (j == bi) lg[j] = -INFINITY; }
                    const float e1 = __expf(tv[1] - tv[0]), e2 = __expf(tv[2] - tv[0]), e3 = __expf(tv[3] - tv[0]);
                    const float isum = 1.f / (1.f + e1 + e2 + e3);
                    const float gk[4] = {isum, e1 * isum, e2 * isum, e3 * isum};
                    LAS unsigned* H = (LAS unsigned*)(smf + 16 * 1056 + 512 + wave * 64);
                    H[lane] = 0u;
                    LDS_WAIT(); asm volatile("" ::: "memory");
                    int rk[4];
#pragma unroll
                    for (int k = 0; k < 4; ++k) rk[k] = (int)__hip_atomic_fetch_add(H + ti[k], 1u, __ATOMIC_RELAXED, __HIP_MEMORY_SCOPE_WAVEFRONT);
                    LDS_WAIT(); asm volatile("" ::: "memory");
                    const unsigned cnt_e = H[lane];
                    unsigned base_e = 0u; if (cnt_e) base_e = atomicAdd(&CNT[64 * lane], cnt_e);
                    H[32 + lane] = base_e;
                    LDS_WAIT(); asm volatile("" ::: "memory");
                    const int m = m0 + lane;
#pragma unroll
                    for (int k = 0; k < 4; ++k) { const int ek = ti[k]; const int pos = (int)H[32 + ek] + rk[k];
                        TLIST[ek * LISTCAP + pos] = m; GLIST[ek * LISTCAP + pos] = gk[k]; TK_E[m * 4 + k] = ek; TK_POS[m * 4 + k] = pos; TK_G[m * 4 + k] = gk[k]; }
                }
            }
        } else {
            for (int m = blockIdx.x * 6 + (wave - 2); m < M; m += 2 * G * 6) { const int m2 = m + G * 6; rms_rows2<true>(X2 + (size_t)m * D, X2 + (size_t)m2 * D, m2 < M, norm_ffn, XN8 + (size_t)m * D, XN8 + (size_t)m2 * D, lane); }
        }
            };
        body11_();
        if ((PROBE_REP >> 11) & 1) { GRID_BAR(); if (blockIdx.x == 0 && tid < NE) CNT[64 * tid] = 0u; GRID_BAR(); body11_(); }
    }
    SEAM(11);

#define LOAD_BASES() do { __syncthreads(); if (tid == 0) { int b_ = 0; for (int e_ = 0; e_ < NE; ++e_) { const int c_ = (int)__hip_atomic_load(&CNT[64 * e_], __ATOMIC_RELAXED, __HIP_MEMORY_SCOPE_AGENT); \
        smi[8192 + e_] = b_; smi[8256 + e_] = c_; b_ += (c_ + 255) & ~255; } } __syncthreads(); } while (0)

    LAS int* tb = (LAS int*)(L + 131072 + 1024);
#define LOAD_TB(npn) do { __syncthreads(); if (tid == 0) { int b_ = 0, cu_ = 0; for (int e_ = 0; e_ < NE; ++e_) { const int c_ = (int)__hip_atomic_load(&CNT[64 * e_], __ATOMIC_RELAXED, __HIP_MEMORY_SCOPE_AGENT); \
        tb[e_] = b_; tb[32 + e_] = c_; tb[64 + e_] = cu_; b_ += (c_ + 255) & ~255; cu_ += ((c_ + 255) >> 8) * (npn); } tb[96] = cu_; } __syncthreads(); } while (0)
    PHASE_L(12, {
        LOAD_TB(8);
        pg8::Gemm g{(const bf16_t*)XN8, (const bf16_t*)WGU8, 512, 512, 512}; pg8::MoeOrder S{tb, TLIST, G, xcu, 8, 512, 512, 2048};
        pg8::gemm_phase<pg8::EpiMoeGU, pg8::MoeOrder, true, true>(L, g, S, pg8::EpiMoeGU{ACT8, b_gate_up, WSCGU});
    });
    SEAM(12);
    PHASE_L(13, {
        LOAD_TB(4);
        pg8::Gemm g{(const bf16_t*)ACT8, (const bf16_t*)WD8, 512, 512, 512}; pg8::MoeOrder S{tb, TLIST, G, xcu, 4, 512, 512, 1024};
        pg8::gemm_phase<pg8::EpiMoeDown, pg8::MoeOrder, false, true>(L, g, S, pg8::EpiMoeDown{YB, b_down, GLIST, tb, WSCD});
    });
    SEAM(13);

    PHASE(14) {
        LOAD_BASES();
        for (int mb = gw; mb < M; mb += 8 * NGW) {
            int slotv = 0;
            { const int i = lane >> 2, k = lane & 3, m = mb + NGW * i; if (lane < 32 && m < M) slotv = smi[8192 + TK_E[m * 4 + k]] + TK_POS[m * 4 + k]; }
#pragma unroll 2
            for (int i = 0; i < 8; ++i) {
                const int m = mb + NGW * i; if (m >= M) break;
                const f32x4* xr = (const f32x4*)(X2 + (size_t)m * D) + lane; const f32x4* gr = (const f32x4*)norm_final + lane;
                f32x4 v[4];
#pragma unroll
                for (int j = 0; j < 4; ++j) v[j] = xr[64 * j];
#pragma unroll
                for (int k = 0; k < 4; ++k) { const int slot = __builtin_amdgcn_readlane(slotv, 4 * i + k); const v2u* yr = (const v2u*)(YB + (size_t)slot * D) + lane;
#pragma unroll
                    for (int j = 0; j < 4; ++j) { const v2u w = yr[64 * j]; v[j].x += lo16(w.x); v[j].y += hi16(w.x); v[j].z += lo16(w.y); v[j].w += hi16(w.y); } }
                float ss = 0.f;
#pragma unroll
                for (int j = 0; j < 4; ++j) ss += (v[j].x * v[j].x + v[j].y * v[j].y) + (v[j].z * v[j].z + v[j].w * v[j].w);
                const float rinv = 1.0f / sqrtf(wave_sum(ss) * (1.f / 1024.f) + NORM_EPS);
                f32x4* orow = (f32x4*)(args.out + (size_t)m * D) + lane;
#pragma unroll
                for (int j = 0; j < 4; ++j) { const f32x4 gg = gr[64 * j]; orow[64 * j] = (f32x4){v[j].x * rinv * gg.x, v[j].y * rinv * gg.y, v[j].z * rinv * gg.z, v[j].w * rinv * gg.w}; }
            }
        }
    }
    if (PROBE_STAMP >= 0) { STAMP_AT(15); if (blockIdx.x == PROBE_BLOCK) { const unsigned long long t1_ = __builtin_amdgcn_s_memrealtime(); while (__builtin_amdgcn_s_memrealtime() - t1_ < st_dt_) __builtin_amdgcn_s_sleep(8); } }
#undef IN
#undef SEAM
}

extern "C" void kernel_launch(void* const* d_in, const int* in_sizes, int n_in, void* d_out, int out_size, void* d_ws, size_t ws_size, hipStream_t stream) {
    static int grid = 0;
    if (grid == 0) {
        if (n_in != 26 || out_size != M * D || ws_size < WS_END) { fprintf(stderr, "kernel_launch: unexpected sizes n_in %d out %d ws %zu\n", n_in, out_size, ws_size); grid = -1; return; }
        int dev = 0, cus = 0;
        if (hipGetDevice(&dev) != hipSuccess || hipDeviceGetAttribute(&cus, hipDeviceAttributeMultiprocessorCount, dev) != hipSuccess) { grid = -1; return; }
        if (hipFuncSetAttribute((const void*)fwd, hipFuncAttributeMaxDynamicSharedMemorySize, LDS_BYTES) != hipSuccess) { fprintf(stderr, "kernel_launch: hipFuncSetAttribute failed\n"); grid = -1; return; }
        int per_cu = 0;
        (void)hipOccupancyMaxActiveBlocksPerMultiprocessor(&per_cu, (const void*)fwd, NTHR, LDS_BYTES);
        (void)hipGetLastError();
        grid = cus;
    }
    if (grid < 0) return;
    (void)hipMemsetAsync((char*)d_ws + WS_CTL, 0, CTL_ZERO_BYTES, stream);
    Args a{};
    for (int i = 0; i < 26; ++i) a.in[i] = d_in[i];
    a.out = (float*)d_out; a.ws = (unsigned char*)d_ws;
#if MK_PER_PHASE
    for (int p = 0; p < NPHASE; ++p) { a.ph_lo = p; a.ph_hi = p + 1; hipLaunchKernelGGL(fwd, dim3(grid), dim3(NTHR), LDS_BYTES, stream, a); }
#else
    a.ph_lo = 0; a.ph_hi = NPHASE; hipLaunchKernelGGL(fwd, dim3(grid), dim3(NTHR), LDS_BYTES, stream, a);
#endif
}
```

```cpp
#include <hip/hip_runtime.h>
#include <cstdio>
#include <cstdint>

#ifndef MK_PER_PHASE
#define MK_PER_PHASE 0
#endif

#ifndef PROBE_STAMP
#define PROBE_STAMP -1
#endif
#ifndef PROBE_BLOCK
#define PROBE_BLOCK 0
#endif
#ifndef PROBE_REP
#define PROBE_REP 0
#endif
#define GAS __attribute__((address_space(1)))
#define LAS __attribute__((address_space(3)))
typedef unsigned short bf16_t;
typedef unsigned v4u __attribute__((ext_vector_type(4)));
typedef unsigned v2u __attribute__((ext_vector_type(2)));
typedef float f32x4 __attribute__((ext_vector_type(4)));
typedef short bf16x8 __attribute__((ext_vector_type(8)));

constexpr int BATCH = 4, SEQ = 4096, D = 1024, M = BATCH * SEQ, NIN = 5120;
constexpr int MEMLEN = 256, MM = BATCH * MEMLEN;
constexpr int NE = 32, TOPK = 4, DFF = 1024;
constexpr float NORM_EPS = 1e-6f;
constexpr int C_SBQ = 0, C_SBK = 512, C_SBV = 1024, C_DQ = 1536, C_DK = 2048, C_DV = 2560, C_GSB = 3072, C_GDF = 4096;
constexpr int LISTCAP = 16384;
constexpr int SLOTS = 65536 + NE * 256;
constexpr int NWAVES = 8, NTHR = 512;

constexpr size_t MiB = 1u << 20;
constexpr size_t WS_CTL = 0, CTL_ZERO_BYTES = 1 * MiB;
constexpr size_t WS_WIN = 2 * MiB;
constexpr size_t WS_WUPSB = 12 * MiB;
constexpr size_t WS_WUPDF = 13 * MiB;
constexpr size_t WS_WOUT = 14 * MiB;
constexpr size_t WS_WMQ = 16 * MiB;
constexpr size_t WS_WMKV = 18 * MiB;
constexpr size_t WS_WMO = 22 * MiB;
constexpr size_t WS_ROPE = 24 * MiB;
constexpr size_t WS_TK = 28 * MiB;
constexpr size_t WS_WR = 29 * MiB;
constexpr size_t WS_WSC = 30 * MiB;
constexpr size_t WS_WGU = 32 * MiB;
constexpr size_t WS_WD = 160 * MiB;
constexpr size_t WS_XN = 224 * MiB;
constexpr size_t WS_PR = 256 * MiB;
constexpr size_t WS_OAT = 416 * MiB;
constexpr size_t WS_ODR = 448 * MiB;
constexpr size_t WS_MIX = 512 * MiB;
constexpr size_t WS_X1 = 544 * MiB;
constexpr size_t WS_X2 = 608 * MiB;
constexpr size_t WS_HM = 672 * MiB;
constexpr size_t WS_KVM = 674 * MiB;
constexpr size_t WS_TLIST = 678 * MiB;
constexpr size_t WS_GLIST = 680 * MiB;
constexpr size_t WS_QM = 682 * MiB;
constexpr size_t WS_OM = 714 * MiB;
constexpr size_t WS_ACT = 256 * MiB;
constexpr size_t WS_YB = 746 * MiB;
constexpr size_t WS_VTSB = 890 * MiB;
constexpr size_t WS_VTDF = 906 * MiB;
constexpr size_t WS_VTM = 922 * MiB;
constexpr size_t WS_END = 924 * MiB;
static_assert(WS_ACT + (size_t)SLOTS * 1024 * 2 <= WS_OAT, "ACT overlay");
static_assert(WS_YB + (size_t)SLOTS * 1024 * 2 <= WS_VTSB, "YB");
constexpr int CW_REDO = 16384;
constexpr int CW_SBQ = 6144;
constexpr int CW_CNT = 8192;
constexpr int CW_BAR = 1024;

constexpr int LDS_BYTES = 147456;
constexpr int MISC_OFF = 131072 + 320;

__device__ __forceinline__ float bf2f(bf16_t b) { return __uint_as_float(((unsigned)b) << 16); }
__device__ __forceinline__ unsigned f2bf(float f) { unsigned u = __float_as_uint(f); return (u + 0x7fffu + ((u >> 16) & 1u)) >> 16; }
__device__ __forceinline__ unsigned pk2(float lo, float hi) { return f2bf(lo) | (f2bf(hi) << 16); }
__device__ __forceinline__ unsigned pk4_fp8(float a, float b, float c, float d) { int w = 0; w = __builtin_amdgcn_cvt_pk_fp8_f32(a, b, w, false); w = __builtin_amdgcn_cvt_pk_fp8_f32(c, d, w, true); return (unsigned)w; }
__device__ __forceinline__ float lo16(unsigned w) { return __uint_as_float(w << 16); }
__device__ __forceinline__ float hi16(unsigned w) { return __uint_as_float(w & 0xffff0000u); }
#define LDS_WAIT() asm volatile("s_waitcnt lgkmcnt(0)" ::: "memory")
__device__ __forceinline__ float wave_sum(float v) {
#pragma unroll
    for (int o = 1; o < 64; o <<= 1) v += __shfl_xor(v, o);
    return v;
}
__device__ __forceinline__ float wave_max(float v) {
#pragma unroll
    for (int o = 1; o < 64; o <<= 1) v = fmaxf(v, __shfl_xor(v, o));
    return v;
}

#define XB_TMO      128
#define XB_XCNT(j)  (256  + 64 * (j))
#define XB_XSUB(j)  (1280 + 64 * (j))
#define XB_XGEN(j)  (2304 + 64 * (j))
#define XB_TOP      3328
#define XB_TOPGEN   3392
#define XCD_BAR_WORDS 3456
#define XB_SPIN_CAP (1u << 18)
__device__ __forceinline__ unsigned xb_ld(unsigned* p)              { return __hip_atomic_load(p, __ATOMIC_RELAXED, __HIP_MEMORY_SCOPE_AGENT); }
__device__ __forceinline__ unsigned xb_add(unsigned* p, unsigned v) { return __hip_atomic_fetch_add(p, v, __ATOMIC_RELAXED, __HIP_MEMORY_SCOPE_AGENT); }
__device__ __forceinline__ unsigned xb_xcc_id() { return (unsigned)__builtin_amdgcn_s_getreg((3 << 11) | 20) & 0xFu; }
#define XB_SPIN(cond, bar) do { unsigned _sp = 0; while (cond) { __builtin_amdgcn_s_sleep(1); \
    if ((++_sp & 255u) == 0u) { if (xb_ld(&(bar)[XB_TMO])) break; if (_sp > XB_SPIN_CAP) { atomicAdd(&(bar)[XB_TMO], 1u); break; } } } } while (0)
struct XcdBarrier { unsigned* bar; unsigned x; volatile LAS unsigned* st; };
__device__ __forceinline__ XcdBarrier xcd_barrier_post(unsigned* bar, volatile LAS unsigned* st) {
    XcdBarrier b; b.bar = bar; b.x = xb_xcc_id(); b.st = st;
    if (threadIdx.x == 0) (void)xb_add(&bar[XB_XCNT(b.x)], 1u);
    return b;
}
__device__ __forceinline__ void xcd_barrier_complete(unsigned* bar, unsigned x, unsigned& nloc, unsigned& nx) {
    const unsigned G = gridDim.x * gridDim.y * gridDim.z;
    unsigned sum, cnt, mine, sp = 0u;
    for (;;) {
        sum = 0u; cnt = 0u; mine = 0u;
#pragma unroll
        for (unsigned j = 0; j < 16; ++j) { const unsigned c = xb_ld(&bar[XB_XCNT(j)]); sum += c; cnt += (c > 0u) ? 1u : 0u; mine = (j == x) ? c : mine; }
        if (sum == G) break;
        __builtin_amdgcn_s_sleep(1);
        if ((++sp & 255u) == 0u) { if (xb_ld(&bar[XB_TMO])) break; if (sp > XB_SPIN_CAP) { atomicAdd(&bar[XB_TMO], 1u); break; } }
    }
    nloc = mine > 0u ? mine : 1u; nx = cnt > 0u ? cnt : 1u;
}
__device__ __forceinline__ void xcd_barrier(const XcdBarrier& b) {
    asm volatile("s_waitcnt vmcnt(0)" ::: "memory");
    __syncthreads();
    if (threadIdx.x == 0) {
        unsigned* bar = b.bar;
        __builtin_amdgcn_s_waitcnt(0);
        unsigned nloc = b.st[0], nx = b.st[1];
        if (nloc == 0u) { xcd_barrier_complete(bar, b.x, nloc, nx); b.st[0] = nloc; b.st[1] = nx; }
        const unsigned old = xb_add(&bar[XB_XSUB(b.x)], 1u);
        const unsigned gen = old / nloc;
        if (old + 1u == (gen + 1u) * nloc) {
            __builtin_amdgcn_fence(__ATOMIC_RELEASE, "agent");
            asm volatile("s_waitcnt vmcnt(0)" ::: "memory");
            const unsigned og = xb_add(&bar[XB_TOP], 1u);
            const unsigned tg = og / nx;
            if (og + 1u == (tg + 1u) * nx) xb_add(&bar[XB_TOPGEN], 1u);
            else XB_SPIN(xb_ld(&bar[XB_TOPGEN]) == tg, bar);
            __builtin_amdgcn_fence(__ATOMIC_ACQUIRE, "agent");
            xb_add(&bar[XB_XGEN(b.x)], 1u);
            asm volatile("s_waitcnt vmcnt(0)" ::: "memory");
        } else {
            XB_SPIN(xb_ld(&bar[XB_XGEN(b.x)]) == gen, bar);
            __builtin_amdgcn_fence(__ATOMIC_ACQUIRE, "agent");
            asm volatile("s_waitcnt vmcnt(0)" ::: "memory");
        }
    }
    __syncthreads();
}

__device__ __forceinline__ void p0_transpose_item(const float* W, int K, int N, bf16_t* WT, int drow0, int k0, int n0, LAS float* scr, int lane, const float* gain = nullptr, int ldw = 0, int koff = 0) {
    if (ldw == 0) ldw = K;
#pragma unroll
    for (int i = 0; i < 32; ++i) { const int kk = 2 * i + (lane >> 5); float v = W[(size_t)(k0 + kk) * N + n0 + (lane & 31)]; if (gain) v *= gain[k0 + kk]; scr[kk * 33 + (lane & 31)] = v; }
    LDS_WAIT(); asm volatile("" ::: "memory");
    const int c = lane & 7;
#pragma unroll
    for (int j = 0; j < 4; ++j) { const int n = (lane >> 3) + 8 * j; const LAS float* s = scr + (8 * c) * 33 + n;
        v4u o; o.x = pk2(s[0 * 33], s[1 * 33]); o.y = pk2(s[2 * 33], s[3 * 33]); o.z = pk2(s[4 * 33], s[5 * 33]); o.w = pk2(s[6 * 33], s[7 * 33]);
        *(v4u*)(WT + (size_t)(drow0 + n) * ldw + koff + k0 + 8 * c) = o; }
    LDS_WAIT(); asm volatile("" ::: "memory");
}
__device__ __forceinline__ void p0_plain(const float* W, int K, int N, bf16_t* WT, int item, LAS float* scr, int lane, const float* gain = nullptr, int ldw = 0, int koff = 0) {
    const int nblk = N / 32, kb = item / nblk, nb = item % nblk;
    p0_transpose_item(W, K, N, WT, 32 * nb, 64 * kb, 32 * nb, scr, lane, gain, ldw, koff);
}
__device__ __forceinline__ void p0_transpose_rope(const float* W, bf16_t* WT, int tilebase, int o, int k0, int n0, LAS float* scr, int lane) {
    const int K = 1024, N = NIN;
#pragma unroll
    for (int i = 0; i < 32; ++i) { const int kk = 2 * i + (lane >> 5); scr[kk * 33 + (lane & 31)] = W[(size_t)(k0 + kk) * N + n0 + (lane & 31)]; }
    LDS_WAIT(); asm volatile("" ::: "memory");
    const int c = lane & 7;
#pragma unroll
    for (int j = 0; j < 4; ++j) { const int n = (lane >> 3) + 8 * j; const LAS float* s = scr + (8 * c) * 33 + n;
        const int oo = o + n, v = ((oo >> 6) << 6) | (((oo >> 4) & 1) << 5) | (((oo >> 2) & 3) << 3) | (((oo >> 5) & 1) << 2) | (oo & 3);
        v4u w; w.x = pk2(s[0 * 33], s[1 * 33]); w.y = pk2(s[2 * 33], s[3 * 33]); w.z = pk2(s[4 * 33], s[5 * 33]); w.w = pk2(s[6 * 33], s[7 * 33]);
        *(v4u*)(WT + (size_t)(tilebase + v) * K + k0 + 8 * c) = w; }
    LDS_WAIT(); asm volatile("" ::: "memory");
}
__device__ __forceinline__ void rms_row_to_bf16(const float* xrow, const float* g, bf16_t* orow, int lane) {
    const f32x4* xr = (const f32x4*)xrow + lane; const f32x4* gr = (const f32x4*)g + lane;
    f32x4 v[4]; float s = 0.f;
#pragma unroll
    for (int j = 0; j < 4; ++j) { v[j] = xr[64 * j]; s += (v[j].x * v[j].x + v[j].y * v[j].y) + (v[j].z * v[j].z + v[j].w * v[j].w); }
    const float rinv = 1.0f / sqrtf(wave_sum(s) * (1.f / 1024.f) + NORM_EPS);
    v2u* o8 = (v2u*)orow + lane;
#pragma unroll
    for (int j = 0; j < 4; ++j) { const f32x4 gg = gr[64 * j]; v2u w; w.x = pk2(v[j].x * rinv * gg.x, v[j].y * rinv * gg.y); w.y = pk2(v[j].z * rinv * gg.z, v[j].w * rinv * gg.w); o8[64 * j] = w; }
}

template <bool FP8>
__device__ __forceinline__ void rms_rows2(const float* xa, const float* xb, bool hasb, const float* g, void* oa, void* ob, int lane) {
    const f32x4* ra = (const f32x4*)xa + lane; const f32x4* rb = (const f32x4*)(hasb ? xb : xa) + lane; const f32x4* gr = (const f32x4*)g + lane;
    f32x4 va[4], vb[4]; float sa = 0.f, sb = 0.f;
#pragma unroll
    for (int j = 0; j < 4; ++j) { va[j] = ra[64 * j]; vb[j] = rb[64 * j]; }
#pragma unroll
    for (int j = 0; j < 4; ++j) { sa += (va[j].x * va[j].x + va[j].y * va[j].y) + (va[j].z * va[j].z + va[j].w * va[j].w); sb += (vb[j].x * vb[j].x + vb[j].y * vb[j].y) + (vb[j].z * vb[j].z + vb[j].w * vb[j].w); }
    const float ia = 1.0f / sqrtf(wave_sum(sa) * (1.f / 1024.f) + NORM_EPS), ib = 1.0f / sqrtf(wave_sum(sb) * (1.f / 1024.f) + NORM_EPS);
#pragma unroll
    for (int j = 0; j < 4; ++j) { const f32x4 gg = gr[64 * j];
        if (FP8) { ((unsigned*)oa)[lane + 64 * j] = pk4_fp8(va[j].x * ia * gg.x, va[j].y * ia * gg.y, va[j].z * ia * gg.z, va[j].w * ia * gg.w);
                   if (hasb) ((unsigned*)ob)[lane + 64 * j] = pk4_fp8(vb[j].x * ib * gg.x, vb[j].y * ib * gg.y, vb[j].z * ib * gg.z, vb[j].w * ib * gg.w); }
        else { v2u w; w.x = pk2(va[j].x * ia * gg.x, va[j].y * ia * gg.y); w.y = pk2(va[j].z * ia * gg.z, va[j].w * ia * gg.w); ((v2u*)oa)[lane + 64 * j] = w;
               if (hasb) { v2u w2; w2.x = pk2(vb[j].x * ib * gg.x, vb[j].y * ib * gg.y); w2.y = pk2(vb[j].z * ib * gg.z, vb[j].w * ib * gg.w); ((v2u*)ob)[lane + 64 * j] = w2; } } }
}
__device__ __forceinline__ void rms_row_to_fp8(const float* xrow, const float* g, unsigned char* orow, int lane) {
    const f32x4* xr = (const f32x4*)xrow + lane; const f32x4* gr = (const f32x4*)g + lane;
    f32x4 v[4]; float s = 0.f;
#pragma unroll
    for (int j = 0; j < 4; ++j) { v[j] = xr[64 * j]; s += (v[j].x * v[j].x + v[j].y * v[j].y) + (v[j].z * v[j].z + v[j].w * v[j].w); }
    const float rinv = 1.0f / sqrtf(wave_sum(s) * (1.f / 1024.f) + NORM_EPS);
    unsigned* o4 = (unsigned*)orow + lane;
#pragma unroll
    for (int j = 0; j < 4; ++j) { const f32x4 gg = gr[64 * j]; o4[64 * j] = pk4_fp8(v[j].x * rinv * gg.x, v[j].y * rinv * gg.y, v[j].z * rinv * gg.z, v[j].w * rinv * gg.w); }
}
namespace pg8 {
constexpr int BM = 256, BK = 64, HALF = 128, HTB = HALF * BK * 2, STAGE_BYTES = 8 * HTB;
__host__ __device__ __forceinline__ int lds_byte(int r, int c) { const int st = (r >> 4) * 2 + (c >> 5), rr = r & 15, cc = c & 31, ob = rr * 64 + cc * 2; return st * 1024 + (ob ^ (((ob >> 9) & 1) << 5)); }
__host__ __device__ __forceinline__ void stage_rc(int b, int& R, int& C) { const int st = b / 1024, sb = b % 1024, swz = sb ^ (((sb >> 9) & 1) << 5); R = (st >> 1) * 16 + swz / 64; C = (st & 1) * 32 + (swz % 64) / 2; }
__host__ __device__ __forceinline__ int perm32(int rho) { const int n = rho >> 4, i = rho & 15; return 8 * (i >> 2) + 4 * n + (i & 3); }
struct Unit { int pm, pn, e; };
struct Gemm { const bf16_t* A; const bf16_t* Bt; int lda, ldb, K; };
typedef float f32x2 __attribute__((ext_vector_type(2))); typedef __bf16 bf16x2_t __attribute__((ext_vector_type(2)));
__device__ __forceinline__ unsigned cvt_pk_bf16(float lo, float hi) { f32x2 v = {lo, hi}; bf16x2_t b = __builtin_convertvector(v, bf16x2_t); return __builtin_bit_cast(unsigned, b); }

typedef int v8i __attribute__((ext_vector_type(8))); typedef int v4i __attribute__((ext_vector_type(4)));
__device__ __forceinline__ v8i cat8(bf16x8 a, bf16x8 b) { return __builtin_shufflevector(__builtin_bit_cast(v4i, a), __builtin_bit_cast(v4i, b), 0, 1, 2, 3, 4, 5, 6, 7); }
template <class Epi, class Sched, bool GATHER, bool FP8 = false>
__device__ __forceinline__ void gemm_phase(LAS unsigned char* lds, const Gemm g, const Sched& S, const Epi& E) {
    const int tid = threadIdx.x, wid = __builtin_amdgcn_readfirstlane(tid >> 6), lane = tid & 63, wr = wid >> 2, wc = wid & 3, fr = lane & 15, fq = lane >> 4;
    const int K = g.K, nt = K / BK;
    unsigned voffB[2], cva[2][2], nva[2][2];
#pragma unroll
    for (int i = 0; i < 2; ++i) { int R, C; stage_rc(tid * 16 + i * 8192, R, C); const int Rb = (R & ~31) + perm32(R & 31);
        voffB[i] = (unsigned)(Rb * g.ldb + C) * 2u;
#pragma unroll
        for (int h = 0; h < 2; ++h) { cva[h][i] = (unsigned)((h * HALF + R) * g.lda + C) * 2u; nva[h][i] = cva[h][i]; } }
    const unsigned kstep = (unsigned)(BK * 2);
    const unsigned hstepB = (unsigned)(HALF * g.ldb * 2);
    auto uni_ptr = [](const void* p_) { const unsigned long long v_ = (unsigned long long)p_; return (void*)(((unsigned long long)(unsigned)__builtin_amdgcn_readfirstlane((int)(v_ >> 32)) << 32) | (unsigned)__builtin_amdgcn_readfirstlane((int)v_)); };
    const auto rA = __builtin_amdgcn_make_buffer_rsrc(uni_ptr(g.A), 0, 0x7fffffff, 0x00020000), rB = __builtin_amdgcn_make_buffer_rsrc(uni_ptr(g.Bt), 0, 0x7fffffff, 0x00020000);
    const unsigned ldsw = (unsigned)wid * 1024u;
    const int aoff = lds_byte(wr * 64 + fr, fq * 8), boff = lds_byte(wc * 32 + fr, fq * 8);
#define PG8_SA(b, h) (((b) * 2 + (h)) * HTB)
#define PG8_SB(b, h) ((4 + (b) * 2 + (h)) * HTB)
#define PG8_STAGE(bufoff, rs, soff, voff) do { _Pragma("unroll") for (int _i = 0; _i < 2; ++_i) \
        __builtin_amdgcn_raw_ptr_buffer_load_lds(rs, (LAS unsigned*)(lds + (bufoff) + ldsw + _i * 8192), 16, (int)(voff)[_i], (int)(soff), 0, 0); } while (0)
#define PG8_LDA(dst, b, h) do { _Pragma("unroll") for (int m = 0; m < 4; ++m) _Pragma("unroll") for (int k = 0; k < 2; ++k) dst[m][k] = *(const LAS bf16x8*)(lds + PG8_SA(b, h) + aoff + m * 2048 + k * 1024); } while (0)
#define PG8_LDB(dst, b, h) do { _Pragma("unroll") for (int n = 0; n < 2; ++n) _Pragma("unroll") for (int k = 0; k < 2; ++k) dst[n][k] = *(const LAS bf16x8*)(lds + PG8_SB(b, h) + boff + n * 2048 + k * 1024); } while (0)
#define PG8_MMA(ai, bj, At, Bt) do { __builtin_amdgcn_s_setprio(1); _Pragma("unroll") for (int m = 0; m < 4; ++m) _Pragma("unroll") for (int n = 0; n < 2; ++n) { \
        if constexpr (FP8) { const v8i b8_ = cat8(Bt[n][0], Bt[n][1]), a8_ = cat8(At[m][0], At[m][1]); \
            asm volatile("s_nop 1\n\tv_mfma_scale_f32_16x16x128_f8f6f4 %0, %1, %2, %0, %3, %3 op_sel_hi:[0,0,0]" : "+v"(acc[ai][bj][m][n]) : "v"(b8_), "v"(a8_), "v"(one_scale)); } \
        else { _Pragma("unroll") for (int k = 0; k < 2; ++k) acc[ai][bj][m][n] = __builtin_amdgcn_mfma_f32_16x16x32_bf16(Bt[n][k], At[m][k], acc[ai][bj][m][n], 0, 0, 0); } } __builtin_amdgcn_s_setprio(0); } while (0)
#define PG8_WAIT_V(n) asm volatile("s_waitcnt vmcnt(" #n ")" ::: "memory")
#define PG8_WAIT_L(n) asm volatile("s_waitcnt lgkmcnt(" #n ")" ::: "memory")
#define PG8_BAR __builtin_amdgcn_s_barrier()
#define PG8_SCHED __builtin_amdgcn_sched_barrier(0)
    Unit cur, nxt; int ui = 0;
    if (!S.next(0, cur)) return;
    if constexpr (GATHER) {
#pragma unroll
        for (int i = 0; i < 2; ++i) { int R, C; stage_rc(tid * 16 + i * 8192, R, C);
#pragma unroll
            for (int h = 0; h < 2; ++h) cva[h][i] = (unsigned)(S.tok(cur, h * HALF + R) * g.lda + C) * 2u; }
    }
    const int one_scale = 0x7f7f7f7f;
    (void)one_scale;
    f32x4 acc[2][2][4][2];
#pragma unroll
    for (int a = 0; a < 2; ++a)
#pragma unroll
        for (int b = 0; b < 2; ++b)
#pragma unroll
            for (int m = 0; m < 4; ++m)
#pragma unroll
                for (int n = 0; n < 2; ++n) acc[a][b][m][n] = (f32x4){0.f, 0.f, 0.f, 0.f};
    bf16x8 At[4][2], B0[2][2], B1[2][2];
    unsigned cA = GATHER ? 0u : (unsigned)S.a_off(cur), cB = (unsigned)S.b_off(cur);
    PG8_STAGE(PG8_SB(0, 0), rB, cB, voffB); PG8_STAGE(PG8_SB(0, 1), rB, cB + hstepB, voffB); PG8_STAGE(PG8_SA(0, 0), rA, cA, cva[0]); PG8_STAGE(PG8_SA(0, 1), rA, cA, cva[1]);
    if (wr == 1) PG8_BAR;
    PG8_WAIT_V(2); PG8_BAR;
    PG8_STAGE(PG8_SB(1, 0), rB, cB + kstep, voffB); PG8_STAGE(PG8_SA(1, 0), rA, cA + kstep, cva[0]); PG8_STAGE(PG8_SB(1, 1), rB, cB + hstepB + kstep, voffB);
    PG8_WAIT_V(6); PG8_BAR;
    for (;;) {
        const bool has_next = S.next(ui + 1, nxt);
        const unsigned nA = (has_next && !GATHER) ? (unsigned)S.a_off(nxt) : cA, nB = has_next ? (unsigned)S.b_off(nxt) : cB;
        if constexpr (GATHER) {
#pragma unroll
            for (int i = 0; i < 2; ++i) { int R, C; stage_rc(tid * 16 + i * 8192, R, C);
#pragma unroll
                for (int h = 0; h < 2; ++h) nva[h][i] = has_next ? (unsigned)(S.tok(nxt, h * HALF + R) * g.lda + C) * 2u : cva[h][i]; }
        }
#pragma nounroll
        for (int t = 0; t < nt; t += 2) {
            const bool last = (t == nt - 2);
            const unsigned a1 = cA + (unsigned)(t + 1) * kstep;
            const unsigned a2 = last ? nA : cA + (unsigned)(t + 2) * kstep, b2 = last ? nB : cB + (unsigned)(t + 2) * kstep;
            const unsigned a3 = a2 + kstep, b3 = b2 + kstep;
            PG8_LDB(B0, 0, 0); PG8_LDB(B1, 0, 1); PG8_SCHED; PG8_LDA(At, 0, 0); PG8_STAGE(PG8_SA(1, 1), rA, a1, cva[1]);
            if constexpr (GATHER) { if (last) {
#pragma unroll
                for (int h = 0; h < 2; ++h)
#pragma unroll
                    for (int i = 0; i < 2; ++i) cva[h][i] = nva[h][i]; } }
            PG8_WAIT_V(8); PG8_WAIT_L(0); PG8_BAR; PG8_MMA(0, 0, At, B0); PG8_MMA(0, 1, At, B1); PG8_BAR; PG8_SCHED;
            PG8_LDA(At, 0, 1); PG8_STAGE(PG8_SB(0, 0), rB, b2, voffB); PG8_STAGE(PG8_SB(0, 1), rB, b2 + hstepB, voffB); PG8_STAGE(PG8_SA(0, 0), rA, a2, cva[0]);
            PG8_WAIT_V(8); PG8_WAIT_L(0); PG8_BAR; PG8_MMA(1, 0, At, B0); PG8_MMA(1, 1, At, B1); PG8_BAR; PG8_SCHED;
            PG8_LDB(B0, 1, 0); PG8_LDB(B1, 1, 1); PG8_SCHED; PG8_LDA(At, 1, 0); PG8_STAGE(PG8_SA(0, 1), rA, a2, cva[1]);
            PG8_WAIT_V(8); PG8_WAIT_L(0); PG8_BAR; PG8_MMA(0, 0, At, B0); PG8_MMA(0, 1, At, B1); PG8_BAR; PG8_SCHED;
            PG8_LDA(At, 1, 1); PG8_STAGE(PG8_SB(1, 0), rB, b3, voffB); PG8_STAGE(PG8_SB(1, 1), rB, b3 + hstepB, voffB); PG8_STAGE(PG8_SA(1, 0), rA, a3, cva[0]);
            PG8_WAIT_V(8); PG8_WAIT_L(0); PG8_BAR; PG8_MMA(1, 0, At, B0); PG8_MMA(1, 1, At, B1); PG8_BAR; PG8_SCHED;
        }
        if (wr == 0) PG8_BAR;
        if constexpr (FP8) asm volatile("s_nop 15\n\ts_nop 7" ::: "memory");
        E(acc, cur, wr, wc, fr, fq);
        if (!has_next) break;
#pragma unroll
        for (int a = 0; a < 2; ++a)
#pragma unroll
            for (int b = 0; b < 2; ++b)
#pragma unroll
                for (int m = 0; m < 4; ++m)
#pragma unroll
                    for (int n = 0; n < 2; ++n) acc[a][b][m][n] = (f32x4){0.f, 0.f, 0.f, 0.f};
        cur = nxt; cA = nA; cB = nB; ++ui;
        if constexpr (GATHER) {
#pragma unroll
            for (int i = 0; i < 2; ++i)
#pragma unroll
                for (int h = 0; h < 2; ++h) cva[h][i] = nva[h][i];
        }
        if (wr == 1) PG8_BAR;
    }
    PG8_WAIT_V(0);
    PG8_BAR;
#undef PG8_SA
#undef PG8_SB
#undef PG8_STAGE
#undef PG8_LDA
#undef PG8_LDB
#undef PG8_MMA
#undef PG8_WAIT_V
#undef PG8_WAIT_L
#undef PG8_BAR
#undef PG8_SCHED
}

struct DenseOrder {
    int nM, nN, nwg, G, c, lda, ldb, i0 = 0, i1 = 1 << 30;
    __device__ __forceinline__ void init(int M_, int N_, int G_, int c_, int lda_, int ldb_) { nM = M_ / BM; nN = N_ / BM; nwg = nM * nN; G = G_; c = c_; lda = lda_; ldb = ldb_; }
    __device__ __forceinline__ bool next(int i, Unit& u) const {
        if (i + i0 >= i1) return false;
        const long L = (long)(i + i0) * G + c; if (L >= nwg) return false;
        int wgid = (int)L; { const int q = nwg / 8, r = nwg % 8, xcd = wgid % 8, off = wgid / 8; wgid = (xcd < r ? xcd * (q + 1) : r * (q + 1) + (xcd - r) * q) + off; }
        const int nig = 8 * nN, gid = wgid / nig, fm = gid * 8, gsz = (nM - fm) < 8 ? (nM - fm) : 8;
        u.pm = fm + ((wgid % nig) % gsz); u.pn = (wgid % nig) / gsz; u.e = 0; return true;
    }
    __device__ __forceinline__ size_t a_off(const Unit& u) const { return (size_t)u.pm * BM * lda * 2; }
    __device__ __forceinline__ size_t b_off(const Unit& u) const { return (size_t)u.pn * BM * ldb * 2; }
    __device__ __forceinline__ int tok(const Unit&, int) const { return 0; }
};
struct TwoRoundOrder {
    int G, c, lda, ldb;
    __device__ __forceinline__ bool next(int i, Unit& u) const { const int L = i * G + c; if (L >= 512) return false; const int tile = L & 255; u.pm = tile >> 2; u.pn = tile & 3; u.e = L >> 8; return true; }
    __device__ __forceinline__ size_t a_off(const Unit& u) const { return (size_t)u.pm * BM * lda * 2 + (size_t)u.e * 1024; }
    __device__ __forceinline__ size_t b_off(const Unit& u) const { return (size_t)(u.e * 1024 + u.pn * BM) * ldb * 2; }
    __device__ __forceinline__ int tok(const Unit&, int) const { return 0; }
};
struct MoeOrder {
    const LAS int* tb; const int* tlist; int G, c, npn, lda, ldb, nexp;
    __device__ __forceinline__ bool next(int i, Unit& u) const {
        const int L = i * G + c; if (L >= tb[96]) return false;
        int e = 0; while (tb[65 + e] <= L) ++e;
        const int loc = L - tb[64 + e]; u.e = __builtin_amdgcn_readfirstlane(e); u.pn = __builtin_amdgcn_readfirstlane(loc % npn); u.pm = __builtin_amdgcn_readfirstlane((tb[e] >> 8) + loc / npn); return true;
    }
    __device__ __forceinline__ size_t a_off(const Unit& u) const { return (size_t)u.pm * BM * lda * 2; }
    __device__ __forceinline__ size_t b_off(const Unit& u) const { return (size_t)(u.e * nexp + u.pn * BM) * ldb * 2; }
    __device__ __forceinline__ int tok(const Unit& u, int row) const { const int r = u.pm * BM - tb[u.e] + row; return r < tb[32 + u.e] ? tlist[u.e * LISTCAP + r] : 0; }
};

#define EPI_ARGS const f32x4 (&acc)[2][2][4][2], const Unit& u, int wr, int wc, int fr, int fq
#define EPI_FOR_ROWS for (int ai = 0; ai < 2; ++ai) _Pragma("unroll") for (int m = 0; m < 4; ++m)
__device__ __forceinline__ v4u pack8(const f32x4 a, const f32x4 b) { v4u w; w.x = cvt_pk_bf16(a[0], a[1]); w.y = cvt_pk_bf16(a[2], a[3]); w.z = cvt_pk_bf16(b[0], b[1]); w.w = cvt_pk_bf16(b[2], b[3]); return w; }
__device__ __forceinline__ void unpack8(const v4u w, f32x4& a, f32x4& b) { a = (f32x4){lo16(w.x), hi16(w.x), lo16(w.y), hi16(w.y)}; b = (f32x4){lo16(w.z), hi16(w.z), lo16(w.w), hi16(w.w)}; }
__device__ __forceinline__ float sigm(float v) { return __builtin_amdgcn_rcpf(1.f + __expf(-v)); }

__device__ __forceinline__ void store_tile_T(const f32x4 (&acc)[2][2][4][2], bf16_t* VT, int vrow0, int s0, int pitch) {
#pragma unroll
    for (int bj = 0; bj < 2; ++bj)
#pragma unroll
        for (int n = 0; n < 2; ++n)
#pragma unroll
            for (int e = 0; e < 4; ++e) { bf16_t* vp = VT + (size_t)(vrow0 + 128 * bj + 4 * n + e) * pitch + ((s0 & ~12) | ((s0 & 8) >> 1) | ((s0 & 4) << 1));
#pragma unroll
                for (int ai = 0; ai < 2; ++ai)
#pragma unroll
                    for (int m = 0; m < 4; ++m) vp[128 * ai + 16 * m] = (bf16_t)(cvt_pk_bf16(acc[ai][bj][m][n][e], 0.f) & 0xffffu); }
}
struct EpiKV { static constexpr bool MIDHOOK = false; bf16_t* KVM; bf16_t* VTM;
    __device__ __forceinline__ void operator()(EPI_ARGS) const {
        const int row0 = u.pm * BM + wr * 64 + fr, col0 = u.pn * BM + wc * 32 + 8 * fq;
#pragma unroll
        EPI_FOR_ROWS { bf16_t* rowp = KVM + (size_t)(row0 + ai * HALF + m * 16) * 2048 + col0;
#pragma unroll
            for (int bj = 0; bj < 2; ++bj) *(v4u*)(rowp + bj * HALF) = pack8(acc[ai][bj][m][0], acc[ai][bj][m][1]); }
        if (u.pn >= 4) store_tile_T(acc, VTM, u.pm * 1024 + (u.pn - 4) * BM + wc * 32 + 8 * fq, wr * 64 + fr, MEMLEN);
    } };
struct EpiResidNorm { static constexpr bool MIDHOOK = false; const float* base; float* out; bf16_t* XB; float* SSQ;
    __device__ __forceinline__ void operator()(EPI_ARGS) const {
        const int row0 = u.pm * BM + wr * 64 + fr, col0 = u.pn * BM + wc * 32 + 8 * fq;
#pragma unroll
        EPI_FOR_ROWS { const int row = row0 + ai * HALF + m * 16; const size_t off = (size_t)row * D + col0; float ss = 0.f;
#pragma unroll
            for (int bj = 0; bj < 2; ++bj) { f32x4 v[2];
#pragma unroll
                for (int n = 0; n < 2; ++n) { v[n] = *(const f32x4*)(base + off + bj * HALF + 4 * n) + acc[ai][bj][m][n];
                    ss += (v[n][0] * v[n][0] + v[n][1] * v[n][1]) + (v[n][2] * v[n][2] + v[n][3] * v[n][3]); }
                *(v4u*)(XB + off + bj * HALF) = pack8(v[0], v[1]); }
            ss += __shfl_xor(ss, 16); ss += __shfl_xor(ss, 32);
            if (fq == 0) SSQ[(size_t)row * 16 + u.pn * 4 + wc] = ss; }
    } };
struct EpiBf16Rinv { static constexpr bool MIDHOOK = false; bf16_t* O; const float* SSQ; float qscale;
    __device__ __forceinline__ void operator()(EPI_ARGS) const {
        const int row0 = u.pm * BM + wr * 64 + fr, col0 = u.pn * BM + wc * 32 + 8 * fq;
#pragma unroll
        EPI_FOR_ROWS { const int row = row0 + ai * HALF + m * 16; const f32x4* sp = (const f32x4*)(SSQ + (size_t)row * 16);
            const f32x4 s0 = sp[0], s1 = sp[1], s2 = sp[2], s3 = sp[3];
            const float tot = (((s0[0] + s0[1]) + (s0[2] + s0[3])) + ((s1[0] + s1[1]) + (s1[2] + s1[3]))) + (((s2[0] + s2[1]) + (s2[2] + s2[3])) + ((s3[0] + s3[1]) + (s3[2] + s3[3])));
            const float rinv = qscale / sqrtf(tot * (1.f / 1024.f) + NORM_EPS);
            bf16_t* rowp = O + (size_t)row * D + col0;
#pragma unroll
            for (int bj = 0; bj < 2; ++bj) *(v4u*)(rowp + bj * HALF) = pack8(acc[ai][bj][m][0] * rinv, acc[ai][bj][m][1] * rinv); }
    } };
struct OneUnitOrder {
    int idx, lda, ldb;
    __device__ __forceinline__ bool next(int i, Unit& u) const { if (i > 0) return false; u.pm = idx >> 3; u.pn = idx & 7; u.e = 0; return true; }
    __device__ __forceinline__ size_t a_off(const Unit& u) const { return (size_t)u.pm * BM * lda * 2; }
    __device__ __forceinline__ size_t b_off(const Unit& u) const { return (size_t)u.pn * BM * ldb * 2; }
    __device__ __forceinline__ int tok(const Unit&, int) const { return 0; }
};
struct EpiResidB { static constexpr bool MIDHOOK = false; const bf16_t* base; float* out;
    __device__ __forceinline__ void operator()(EPI_ARGS) const {
        const int row0 = u.pm * BM + wr * 64 + fr, col0 = u.pn * BM + wc * 32 + 8 * fq;
#pragma unroll
        EPI_FOR_ROWS { const size_t off = (size_t)(row0 + ai * HALF + m * 16) * D + col0;
#pragma unroll
            for (int bj = 0; bj < 2; ++bj) { f32x4 b0, b1; unpack8(*(const v4u*)(base + off + bj * HALF), b0, b1);
                *(f32x4*)(out + off + bj * HALF) = b0 + acc[ai][bj][m][0]; *(f32x4*)(out + off + bj * HALF + 4) = b1 + acc[ai][bj][m][1]; } }
    } };
struct EpiGate { static constexpr bool MIDHOOK = false; const bf16_t* PR; bf16_t* T; bf16_t* MIX;
    __device__ __forceinline__ void operator()(EPI_ARGS) const {
        const int row0 = u.pm * BM + wr * 64 + fr, col0 = u.pn * BM + wc * 32 + 8 * fq;
#pragma unroll
        EPI_FOR_ROWS { const int row = row0 + ai * HALF + m * 16;
#pragma unroll
            for (int bj = 0; bj < 2; ++bj) { const int col = col0 + bj * HALF; f32x4 g0, g1;
                unpack8(*(const v4u*)(PR + (size_t)row * NIN + (u.e ? C_GDF : C_GSB) + col), g0, g1);
                bf16_t* tp = T + (size_t)row * D + col;
                if (u.e == 0) *(v4u*)tp = pack8(g0 * acc[ai][bj][m][0], g1 * acc[ai][bj][m][1]);
                else { f32x4 t0, t1; unpack8(*(const v4u*)tp, t0, t1); *(v4u*)(MIX + (size_t)row * D + col) = pack8(t0 + g0 * acc[ai][bj][m][0], t1 + g1 * acc[ai][bj][m][1]); } } }
    } };
struct EpiInProj { static constexpr bool MIDHOOK = false; bf16_t* PR; const float* rc; const float* rs; bf16_t* VTSB; bf16_t* VTDF;
    __device__ __forceinline__ void operator()(EPI_ARGS) const {
        const int row0 = u.pm * BM + wr * 64 + fr, pn = u.pn;
        if (pn >= 6 && pn < 10) {
            const float sc = pn < 8 ? 0.125f * 1.4426950408889634f : 1.0f; const int i0 = 16 * (wc & 1) + 4 * fq;
#pragma unroll
            EPI_FOR_ROWS { const int row = row0 + ai * HALF + m * 16; const f32x4 cs = *(const f32x4*)(rc + (size_t)row * 32 + i0), sn = *(const f32x4*)(rs + (size_t)row * 32 + i0);
#pragma unroll
                for (int bj = 0; bj < 2; ++bj) { const f32x4 lo = acc[ai][bj][m][0], hi = acc[ai][bj][m][1];
                    const f32x4 olo = (lo * cs - hi * sn) * sc, ohi = (hi * cs + lo * sn) * sc;
                    bf16_t* p = PR + (size_t)row * NIN + pn * BM + 64 * (2 * bj + (wc >> 1)) + i0;
                    v2u a, b; a.x = cvt_pk_bf16(olo[0], olo[1]); a.y = cvt_pk_bf16(olo[2], olo[3]); b.x = cvt_pk_bf16(ohi[0], ohi[1]); b.y = cvt_pk_bf16(ohi[2], ohi[3]);
                    *(v2u*)p = a; *(v2u*)(p + 32) = b; } }
        } else {
            const int col0 = pn * BM + wc * 32 + 8 * fq; const float sc = pn < 2 ? 0.125f * 1.4426950408889634f : 1.0f; const bool sg = pn >= 12;
            const bool vt = (pn == 4 || pn == 5 || pn == 10 || pn == 11);
            if (!vt) {
#pragma unroll
            EPI_FOR_ROWS { bf16_t* rowp = PR + (size_t)(row0 + ai * HALF + m * 16) * NIN + col0;
#pragma unroll
                for (int bj = 0; bj < 2; ++bj) { f32x4 v0 = acc[ai][bj][m][0] * sc, v1 = acc[ai][bj][m][1] * sc;
                    if (sg) { v0 = (f32x4){sigm(v0[0]), sigm(v0[1]), sigm(v0[2]), sigm(v0[3])}; v1 = (f32x4){sigm(v1[0]), sigm(v1[1]), sigm(v1[2]), sigm(v1[3])}; }
                    *(v4u*)(rowp + bj * HALF) = pack8(v0, v1); } }
            } else {
                const int bb = u.pm >> 4, s0 = (u.pm & 15) * BM + wr * 64 + fr, hd0 = (pn < 6 ? (pn - 4) : (pn - 10)) * BM + wc * 32 + 8 * fq;
                store_tile_T(acc, pn < 6 ? VTSB : VTDF, bb * 512 + hd0, s0, SEQ);
            }
        }
    } };
struct EpiMoeGU { static constexpr bool MIDHOOK = false; unsigned char* ACT8; const float* bgu; const float* wsc;
    __device__ __forceinline__ void operator()(EPI_ARGS) const {
        const int row0 = u.pm * BM + wr * 64 + fr, j0 = u.pn * 128 + wc * 32 + 8 * fq; const float* bg = bgu + (size_t)u.e * 2048 + j0; const float* sg = wsc + (size_t)u.e * 2048 + j0;
#pragma unroll
        EPI_FOR_ROWS { f32x4 o[2];
#pragma unroll
            for (int n = 0; n < 2; ++n) { const f32x4 gv = acc[ai][0][m][n] * *(const f32x4*)(sg + 4 * n) + *(const f32x4*)(bg + 4 * n), lv = acc[ai][1][m][n] * *(const f32x4*)(sg + 1024 + 4 * n) + *(const f32x4*)(bg + 1024 + 4 * n);
#pragma unroll
                for (int c = 0; c < 4; ++c) { const float gl = fminf(gv[c], 7.0f), li = fminf(fmaxf(lv[c], -7.0f), 7.0f); o[n][c] = gl * sigm(1.702f * gl) * (li + 1.0f); } }
            v2u w; w.x = pk4_fp8(o[0][0], o[0][1], o[0][2], o[0][3]); w.y = pk4_fp8(o[1][0], o[1][1], o[1][2], o[1][3]);
            *(v2u*)(ACT8 + (size_t)(row0 + ai * HALF + m * 16) * DFF + j0) = w; }
    } };
struct EpiMoeDown { static constexpr bool MIDHOOK = false; bf16_t* YB; const float* bd; const float* glist; const LAS int* tb; const float* wsc;
    __device__ __forceinline__ void operator()(EPI_ARGS) const {
        const int row0 = u.pm * BM + wr * 64 + fr, col0 = u.pn * BM + wc * 32 + 8 * fq; const float* bp = bd + (size_t)u.e * D + col0; const float* sp = wsc + (size_t)u.e * D + col0;
        const float* gl = glist + (size_t)u.e * LISTCAP - tb[u.e];
        f32x4 bv[2][2], sv[2][2];
#pragma unroll
        for (int bj = 0; bj < 2; ++bj)
#pragma unroll
            for (int n = 0; n < 2; ++n) { bv[bj][n] = *(const f32x4*)(bp + bj * HALF + 4 * n); sv[bj][n] = *(const f32x4*)(sp + bj * HALF + 4 * n); }
#pragma unroll
        EPI_FOR_ROWS { const int row = row0 + ai * HALF + m * 16; const float gt = gl[row];
#pragma unroll
            for (int bj = 0; bj < 2; ++bj) *(v4u*)(YB + (size_t)row * D + col0 + bj * HALF) = pack8((acc[ai][bj][m][0] * sv[bj][0] + bv[bj][0]) * gt, (acc[ai][bj][m][1] * sv[bj][1] + bv[bj][1]) * gt); }
    } };
}


typedef float f32x16 __attribute__((ext_vector_type(16)));
typedef short s16x4 __attribute__((ext_vector_type(4)));
__device__ __forceinline__ f32x16 mfma32(bf16x8 a, bf16x8 b, f32x16 c) { return __builtin_amdgcn_mfma_f32_32x32x16_bf16(a, b, c, 0, 0, 0); }
__device__ __forceinline__ float xhalf(float v, int hh) { auto rr = __builtin_amdgcn_permlane32_swap(__float_as_uint(v), __float_as_uint(v), false, false); return __uint_as_float(hh ? rr[0] : rr[1]); }
__device__ __forceinline__ bf16x8 pack_p(const f32x16& p, int s) { v4u w; w.x = pg8::cvt_pk_bf16(p[8 * s + 0], p[8 * s + 1]); w.y = pg8::cvt_pk_bf16(p[8 * s + 2], p[8 * s + 3]); w.z = pg8::cvt_pk_bf16(p[8 * s + 4], p[8 * s + 5]); w.w = pg8::cvt_pk_bf16(p[8 * s + 6], p[8 * s + 7]); return __builtin_bit_cast(bf16x8, w); }
constexpr float LOG2E = 1.4426950408889634f;

constexpr int VSTR = 136;
template <int NCH> __device__ __forceinline__ void stage_load(v4u (&r)[NCH], const bf16_t* g0, int chunks_per_row, size_t gpitch, int tid) {
#pragma unroll
    for (int i = 0; i < NCH; ++i) { const int c = tid + NTHR * i, row = c / chunks_per_row, ch = c % chunks_per_row; r[i] = *(const v4u*)(g0 + (size_t)row * gpitch + ch * 8); }
}
template <int NCH> __device__ __forceinline__ void stage_store_k(const v4u (&r)[NCH], LAS unsigned char* dst, int chunks_per_row, int lstride, int tid) {
#pragma unroll
    for (int i = 0; i < NCH; ++i) { const int c = tid + NTHR * i, row = c / chunks_per_row, ch = c % chunks_per_row; *(LAS v4u*)(dst + row * lstride + ch * 16) = r[i]; }
}
__device__ __forceinline__ bf16x8 lds_vfrag16(const LAS unsigned char* p) { return *(const LAS bf16x8*)p; }

constexpr float SM_THR = 8.0f;
template <int NO>
__device__ __forceinline__ void softmax_def2(f32x16& S0, f32x16& S1, bool first, float& mref, float& l, f32x16 (&O)[NO], int hh) {
    float mx = fmaxf(fmaxf(S0[0], S0[1]), fmaxf(S1[0], S1[1]));
#pragma unroll
    for (int i = 2; i < 16; i += 2) mx = fmaxf(mx, fmaxf(fmaxf(S0[i], S0[i + 1]), fmaxf(S1[i], S1[i + 1])));
    mx = fmaxf(mx, xhalf(mx, hh));
    if (first || __any(mx > SM_THR)) {
        const float dl = first ? mx : fmaxf(mx, 0.f), f = first ? 0.f : __builtin_amdgcn_exp2f(-dl);
        mref += dl; l *= f;
#pragma unroll
        for (int o = 0; o < NO; ++o) O[o] = O[o] * f;
#pragma unroll
        for (int i = 0; i < 16; ++i) { S0[i] -= dl; S1[i] -= dl; }
    }
    float ps = 0.f;
#pragma unroll
    for (int i = 0; i < 16; ++i) { S0[i] = __builtin_amdgcn_exp2f(S0[i]); S1[i] = __builtin_amdgcn_exp2f(S1[i]); ps += S0[i] + S1[i]; }
    l += ps;
}
template <int NO>
__device__ __forceinline__ void softmax_def1(f32x16& S, bool first, float& mref, float& l, f32x16 (&O)[NO], int hh) {
    float mx = fmaxf(fmaxf(S[0], S[1]), fmaxf(S[2], S[3]));
#pragma unroll
    for (int i = 4; i < 16; i += 4) mx = fmaxf(mx, fmaxf(fmaxf(S[i], S[i + 1]), fmaxf(S[i + 2], S[i + 3])));
    mx = fmaxf(mx, xhalf(mx, hh));
    if (first || __any(mx > SM_THR)) {
        const float dl = first ? mx : fmaxf(mx, 0.f), f = first ? 0.f : __builtin_amdgcn_exp2f(-dl);
        mref += dl; l *= f;
#pragma unroll
        for (int o = 0; o < NO; ++o) O[o] = O[o] * f;
#pragma unroll
        for (int i = 0; i < 16; ++i) S[i] -= dl;
    }
    float ps = 0.f;
#pragma unroll
    for (int i = 0; i < 16; ++i) { S[i] = __builtin_amdgcn_exp2f(S[i]); ps += S[i]; }
    l += ps;
}
__device__ __forceinline__ void attn_diff_block(const bf16_t* PR, const bf16_t* VT, bf16_t* OAT, const float* subln, float lam, int b, int h, int qb, LAS unsigned char* lds, int tid, int wave, int lane) {
    constexpr int KB = 8192, BUF = 2 * KB + 16384, QOFF = 3 * BUF;
    const int r32 = lane & 31, hh = lane >> 5, j = wave >> 2, w4 = wave & 3, q0 = qb * 128 + w4 * 32;
    const bf16_t* qrow = PR + (size_t)(b * SEQ + q0 + r32) * NIN + C_DQ + h * 128 + j * 64 + 8 * hh;
    LAS unsigned char* qs = lds + QOFF + wave * 4096 + lane * 16;
#pragma unroll
    for (int d0 = 0; d0 < 4; ++d0) *(LAS bf16x8*)(qs + d0 * 1024) = *(const bf16x8*)(qrow + 16 * d0);
    asm volatile("s_waitcnt vmcnt(0) lgkmcnt(0)" ::: "memory");
    const bf16_t* kg = PR + (size_t)(b * SEQ) * NIN + C_DK + h * 128;
    const bf16_t* vg = VT + (size_t)(b * 512 + h * 128) * SEQ;
    auto uni_ptr = [](const void* p_) __attribute__((always_inline)) { const unsigned long long v_ = (unsigned long long)p_; return (void*)(((unsigned long long)(unsigned)__builtin_amdgcn_readfirstlane((int)(v_ >> 32)) << 32) | (unsigned)__builtin_amdgcn_readfirstlane((int)v_)); };
    const auto rK = __builtin_amdgcn_make_buffer_rsrc(uni_ptr(kg), 0, 0x7fffffff, 0x00020000), rV = __builtin_amdgcn_make_buffer_rsrc(uni_ptr(vg), 0, 0x7fffffff, 0x00020000);
    const int prow = lane >> 3, pch = lane & 7;
    const int krow = 8 * wave + prow;
    const int kvoff = (krow * NIN + ((pch ^ (krow & 7)) << 3)) * 2;
    int vvoff[2];
#pragma unroll
    for (int pp = 0; pp < 2; ++pp) { const int vrow = 16 * wave + 8 * pp + prow; vvoff[pp] = (vrow * SEQ + ((pch ^ ((vrow ^ (vrow >> 3)) & 7)) << 3)) * 2; }
    auto dma = [&](int t_, int slot) __attribute__((always_inline)) {
        LAS unsigned char* sb_ = lds + slot;
        __builtin_amdgcn_raw_ptr_buffer_load_lds(rK, (LAS unsigned*)(sb_ + wave * 1024), 16, kvoff, t_ * (64 * NIN * 2), 0, 0);
        __builtin_amdgcn_raw_ptr_buffer_load_lds(rK, (LAS unsigned*)(sb_ + KB + wave * 1024), 16, kvoff + 128, t_ * (64 * NIN * 2), 0, 0);
        __builtin_amdgcn_raw_ptr_buffer_load_lds(rV, (LAS unsigned*)(sb_ + 2 * KB + wave * 2048), 16, vvoff[0], t_ * 128, 0, 0);
        __builtin_amdgcn_raw_ptr_buffer_load_lds(rV, (LAS unsigned*)(sb_ + 2 * KB + wave * 2048 + 1024), 16, vvoff[1], t_ * 128, 0, 0); };
    f32x16 O[4];
#pragma unroll
    for (int o = 0; o < 4; ++o)
#pragma unroll
        for (int i = 0; i < 16; ++i) O[o][i] = 0.f;
    float m = 0.f, l = 0.f;
    const int nsteps = 2 * qb + 2, my_last = 2 * qb + (w4 >> 1);
    const int xr = r32 & 7;
    bf16x8 p00, p01, p10, p11;
    f32x16 negm;
#pragma unroll
    for (int i = 0; i < 16; ++i) negm[i] = 0.f;
    auto qk_softmax = [&](int t, int slot) __attribute__((always_inline)) {
        if (t <= my_last) {
            const LAS unsigned char* kb = lds + slot + j * KB + r32 * 128;
            f32x16 S0, S1;
#pragma unroll
            for (int d0 = 0; d0 < 4; ++d0) { const int co = ((2 * d0 + hh) ^ xr) << 4; const bf16x8 qd = *(const LAS bf16x8*)(qs + d0 * 1024);
                S0 = mfma32(*(const LAS bf16x8*)(kb + co), qd, d0 == 0 ? negm : S0); S1 = mfma32(*(const LAS bf16x8*)(kb + 32 * 128 + co), qd, d0 == 0 ? negm : S1); }
            const float m_before = m;
            softmax_def2<4>(S0, S1, t == 0, m, l, O, hh);
            if (m != m_before) {
#pragma unroll
                for (int i = 0; i < 16; ++i) negm[i] = -m; }
            p00 = pack_p(S0, 0); p01 = pack_p(S0, 1); p10 = pack_p(S1, 0); p11 = pack_p(S1, 1);
        } };
    auto vfrag = [&](const LAS unsigned char* rowp, int c16, int sw) __attribute__((always_inline)) -> bf16x8 {
        return *(const LAS bf16x8*)(rowp + (((c16 + hh) ^ sw) << 4)); };
    auto pv = [&](int t, int slot) __attribute__((always_inline)) {
        if (t <= my_last) {
#pragma unroll
            for (int o = 0; o < 4; ++o) { const int d = 32 * o + r32, sw = (d ^ (d >> 3)) & 7; const LAS unsigned char* rowp = lds + slot + 2 * KB + d * 128;
                O[o] = mfma32(vfrag(rowp, 0, sw), p00, O[o]); O[o] = mfma32(vfrag(rowp, 2, sw), p01, O[o]); O[o] = mfma32(vfrag(rowp, 4, sw), p10, O[o]); O[o] = mfma32(vfrag(rowp, 6, sw), p11, O[o]); }
        } };
#define DIFF_BAR() do { asm volatile("s_waitcnt lgkmcnt(0)" ::: "memory"); __builtin_amdgcn_s_barrier(); asm volatile("" ::: "memory"); } while (0)
    dma(0, 0); dma(1, BUF);
    asm volatile("s_waitcnt vmcnt(4)" ::: "memory");
    DIFF_BAR();
#define DIFF_STEPS(H1, H2) { int sl = 0, slp = 2 * BUF, sln = BUF; \
    for (int t = 0; t < nsteps; ++t) { \
        H1(t, sl, slp); DIFF_BAR(); \
        const bool more = t + 2 < nsteps; \
        if (more) dma(t + 2, slp); \
        H2(t, sl); \
        if (more) asm volatile("s_waitcnt vmcnt(4)" ::: "memory"); else asm volatile("s_waitcnt vmcnt(0)" ::: "memory"); \
        DIFF_BAR(); \
        const int tmp_ = slp; slp = sl; sl = sln; sln = tmp_; } }
#define LEAD_H1(t, sl, slp) qk_softmax(t, sl)
#define LEAD_H2(t, sl) pv(t, sl)
#define LAG_H1(t, sl, slp) do { if ((t) > 0) pv((t) - 1, slp); } while (0)
#define LAG_H2(t, sl) qk_softmax(t, sl)
    if (j == 0) { DIFF_STEPS(LEAD_H1, LEAD_H2) } else { DIFF_STEPS(LAG_H1, LAG_H2) }
#undef DIFF_STEPS
#undef LEAD_H1
#undef LEAD_H2
#undef LAG_H1
#undef LAG_H2
    if (j == 1) pv(nsteps - 1, ((nsteps - 1) % 3) * BUF);
    DIFF_BAR();
#undef DIFF_BAR
    l += xhalf(l, hh);
    const float il = 1.f / l;
    LAS float* X = (LAS float*)lds + (size_t)(w4 * 32 + r32) * 132 + 4 * hh;
    if (j == 1) {
#pragma unroll
        for (int o = 0; o < 4; ++o)
#pragma unroll
            for (int g = 0; g < 4; ++g) *(LAS f32x4*)(X + 32 * o + 8 * g) = (f32x4){O[o][4 * g] * il, O[o][4 * g + 1] * il, O[o][4 * g + 2] * il, O[o][4 * g + 3] * il};
    }
    __syncthreads();
    if (j == 0) {
        float ss = 0.f;
#pragma unroll
        for (int o = 0; o < 4; ++o)
#pragma unroll
            for (int g = 0; g < 4; ++g) { const f32x4 o2 = *(const LAS f32x4*)(X + 32 * o + 8 * g);
#pragma unroll
                for (int c = 0; c < 4; ++c) { const float d = O[o][4 * g + c] * il - lam * o2[c]; O[o][4 * g + c] = d; ss += d * d; } }
        ss += xhalf(ss, hh);
        const float rinv = 0.8f / sqrtf(ss * (1.f / 128.f) + NORM_EPS);
        bf16_t* orow = OAT + (size_t)(b * SEQ + q0 + r32) * D + 512 + h * 128 + 4 * hh; const float* sl = subln + 4 * hh;
#pragma unroll
        for (int o = 0; o < 4; ++o)
#pragma unroll
            for (int g = 0; g < 4; ++g) { const f32x4 sg_ = *(const f32x4*)(sl + 32 * o + 8 * g); v2u w;
                w.x = pg8::cvt_pk_bf16(O[o][4 * g] * rinv * sg_[0], O[o][4 * g + 1] * rinv * sg_[1]); w.y = pg8::cvt_pk_bf16(O[o][4 * g + 2] * rinv * sg_[2], O[o][4 * g + 3] * rinv * sg_[3]); *(v2u*)(orow + 32 * o + 8 * g) = w; }
    }
    __syncthreads();
}

__device__ __forceinline__ void sb_tile(const bf16x8 (&kf)[4], const bf16x8 (&vf)[4], const bf16x8 (&qf)[4], bool diag, float& R, f32x16 (&O)[2], int r32, int hh) {
    f32x16 S;
#pragma unroll
    for (int i = 0; i < 16; ++i) S[i] = 0.f;
#pragma unroll
    for (int d0 = 0; d0 < 4; ++d0) S = mfma32(kf[d0], qf[d0], S);
    f32x16 lr;
#pragma unroll
    for (int i = 0; i < 16; ++i) { const float z2 = S[i]; const float sp = fmaxf(z2, 0.f) + __builtin_amdgcn_logf(1.f + __builtin_amdgcn_exp2f(-fabsf(z2))); lr[i] = -sp; S[i] = z2 - sp; }
    if (diag) {
#pragma unroll
        for (int i = 0; i < 16; ++i) { const int kvl = (i & 3) + 8 * (i >> 2) + 4 * hh; if (kvl >= r32) { lr[i] = 0.f; S[i] = -INFINITY; } }
    }
    float tot[4], pt[4], off[4]; f32x16 ex;
#pragma unroll
    for (int g = 0; g < 4; ++g) { ex[4 * g + 3] = 0.f; ex[4 * g + 2] = lr[4 * g + 3]; ex[4 * g + 1] = lr[4 * g + 3] + lr[4 * g + 2]; ex[4 * g] = ex[4 * g + 1] + lr[4 * g + 1]; tot[g] = ex[4 * g] + lr[4 * g]; }
#pragma unroll
    for (int g = 0; g < 4; ++g) pt[g] = xhalf(tot[g], hh);
    const float own0 = hh ? 0.f : 1.f;
    float sp_ = 0.f;
#pragma unroll
    for (int g = 3; g >= 0; --g) { off[g] = sp_ + own0 * pt[g] + R; sp_ += tot[g] + pt[g]; }
#pragma unroll
    for (int i = 0; i < 16; ++i) S[i] = __builtin_amdgcn_exp2f(S[i] + ex[i] + off[i >> 2]);
    R += sp_;
    const bf16x8 p0 = pack_p(S, 0), p1 = pack_p(S, 1);
#pragma unroll
    for (int o = 0; o < 2; ++o) { O[o] = mfma32(vf[2 * o], p0, O[o]); O[o] = mfma32(vf[2 * o + 1], p1, O[o]); }
}
__device__ __forceinline__ void sb_load(bf16x8 (&kf)[4], bf16x8 (&vf)[4], const bf16_t* kbase, const bf16_t* vbase, int t) {
    const bf16_t* kp = kbase + (size_t)(32 * t) * NIN; const bf16_t* vp = vbase + 32 * t;
#pragma unroll
    for (int d0 = 0; d0 < 4; ++d0) kf[d0] = *(const bf16x8*)(kp + 16 * d0);
#pragma unroll
    for (int o = 0; o < 2; ++o) { vf[2 * o] = *(const bf16x8*)(vp + (size_t)(32 * o) * SEQ); vf[2 * o + 1] = *(const bf16x8*)(vp + (size_t)(32 * o) * SEQ + 16); }
}
__device__ __forceinline__ void attn_sb_wave(const bf16_t* PR, const bf16_t* VT, bf16_t* OAT, int b, int h, int q0, int lane) {
    const int r32 = lane & 31, hh = lane >> 5;
    const bf16_t* qrow = PR + (size_t)(b * SEQ + q0 + r32) * NIN + C_SBQ + h * 64 + 8 * hh;
    bf16x8 qf[4];
#pragma unroll
    for (int d0 = 0; d0 < 4; ++d0) qf[d0] = *(const bf16x8*)(qrow + 16 * d0);
    const bf16_t* kbase = PR + (size_t)(b * SEQ + r32) * NIN + C_SBK + h * 64 + 8 * hh;
    const bf16_t* vbase = VT + (size_t)(b * 512 + h * 64 + r32) * SEQ + 8 * hh;
    f32x16 O[2];
#pragma unroll
    for (int o = 0; o < 2; ++o)
#pragma unroll
        for (int i = 0; i < 16; ++i) O[o][i] = 0.f;
    float R = 0.f;
    const int td = q0 >> 5;
    bf16x8 ck[4], cv[4], nk[4], nv[4];
    sb_load(ck, cv, kbase, vbase, td);
    for (int t = td; t >= 0; --t) {
        sb_load(nk, nv, kbase, vbase, t > 0 ? t - 1 : 0);
        sb_tile(ck, cv, qf, t == td, R, O, r32, hh);
        if (__all(R < -160.f)) break;
#pragma unroll
        for (int i = 0; i < 4; ++i) { ck[i] = nk[i]; cv[i] = nv[i]; }
    }
    bf16_t* orow = OAT + (size_t)(b * SEQ + q0 + r32) * D + h * 64 + 4 * hh;
#pragma unroll
    for (int o = 0; o < 2; ++o)
#pragma unroll
        for (int g = 0; g < 4; ++g) { v2u w; w.x = pg8::cvt_pk_bf16(O[o][4 * g], O[o][4 * g + 1]); w.y = pg8::cvt_pk_bf16(O[o][4 * g + 2], O[o][4 * g + 3]); *(v2u*)(orow + 32 * o + 8 * g) = w; }
}

__device__ __forceinline__ void attn_mem_block(const bf16_t* QM, const bf16_t* KVM, const bf16_t* VT, bf16_t* OM, int b, int h, int qb, LAS unsigned char* lds, int tid, int wave, int lane) {
    constexpr int KSTR = 528, KB = 32 * KSTR, VS = 80, BUF = KB + 128 * VS;
    const int r32 = lane & 31, hh = lane >> 5, q0 = qb * 256 + wave * 32;
    const bf16_t* qrow = QM + (size_t)(b * SEQ + q0 + r32) * D + h * 256 + 8 * hh;
    bf16x8 qf[8];
    LAS unsigned char* qs = lds + 57344 + wave * 8192 + lane * 16;
#pragma unroll
    for (int d0 = 0; d0 < 8; ++d0) { qf[d0] = *(const bf16x8*)(qrow + 16 * d0); *(LAS bf16x8*)(qs + d0 * 1024) = *(const bf16x8*)(qrow + 128 + 16 * d0); }
    const bf16_t* kg = KVM + (size_t)(b * MEMLEN) * 2048 + h * 256;
    const int vrow = tid >> 2, vch = tid & 3;
    for (int dh = 0; dh < 2; ++dh) {
        const bf16_t* vg = VT + (size_t)(b * 1024 + h * 256 + dh * 128 + vrow) * MEMLEN + vch * 8;
        f32x16 O[4];
#pragma unroll
        for (int o = 0; o < 4; ++o)
#pragma unroll
            for (int i = 0; i < 16; ++i) O[o][i] = 0.f;
        float m = 0.f, l = 0.f;
        v4u kr[2], vr;
        stage_load<2>(kr, kg, 32, 2048, tid); vr = *(const v4u*)vg;
        stage_store_k<2>(kr, lds, 32, KSTR, tid); *(LAS v4u*)(lds + KB + vrow * VS + vch * 16) = vr;
        __syncthreads();
        for (int t = 0; t < 8; ++t) {
            const bool more = t < 7;
            if (more) { stage_load<2>(kr, kg + (size_t)(32 * (t + 1)) * 2048, 32, 2048, tid); vr = *(const v4u*)(vg + 32 * (t + 1)); }
            {
                const LAS unsigned char* kb = lds + (t & 1) * BUF + r32 * KSTR + 16 * hh; const LAS unsigned char* vb = lds + (t & 1) * BUF + KB + r32 * VS + 16 * hh;
                f32x16 S;
#pragma unroll
                for (int i = 0; i < 16; ++i) S[i] = -m;
#pragma unroll
                for (int d0 = 0; d0 < 8; ++d0) S = mfma32(*(const LAS bf16x8*)(kb + 32 * d0), qf[d0], S);
#pragma unroll
                for (int d0 = 0; d0 < 8; ++d0) S = mfma32(*(const LAS bf16x8*)(kb + 256 + 32 * d0), *(const LAS bf16x8*)(qs + d0 * 1024), S);
                softmax_def1<4>(S, t == 0, m, l, O, hh);
                const bf16x8 p0 = pack_p(S, 0), p1 = pack_p(S, 1);
#pragma unroll
                for (int o = 0; o < 4; ++o) { const LAS unsigned char* vp = vb + 32 * o * VS; O[o] = mfma32(lds_vfrag16(vp), p0, O[o]); O[o] = mfma32(lds_vfrag16(vp + 32), p1, O[o]); }
            }
            if (more) { LAS unsigned char* nb = lds + ((t + 1) & 1) * BUF; stage_store_k<2>(kr, nb, 32, KSTR, tid); *(LAS v4u*)(nb + KB + vrow * VS + vch * 16) = vr; }
            __syncthreads();
        }
        l += xhalf(l, hh);
        const float il = 1.f / l;
        bf16_t* orow = OM + (size_t)(b * SEQ + q0 + r32) * D + h * 256 + dh * 128 + 4 * hh;
#pragma unroll
        for (int o = 0; o < 4; ++o)
#pragma unroll
            for (int g = 0; g < 4; ++g) { v2u w; w.x = pg8::cvt_pk_bf16(O[o][4 * g] * il, O[o][4 * g + 1] * il); w.y = pg8::cvt_pk_bf16(O[o][4 * g + 2] * il, O[o][4 * g + 3] * il); *(v2u*)(orow + 32 * o + 8 * g) = w; }
    }
}

struct Args { const void* in[26]; float* out; unsigned char* ws; int ph_lo, ph_hi; };
constexpr int NPHASE = 15;

__global__ void __launch_bounds__(NTHR, 2) fwd(Args args) {
    extern __shared__ __attribute__((aligned(16))) unsigned char lds[];
    LAS unsigned char* L = (LAS unsigned char*)lds;
    volatile LAS unsigned* MISC = (volatile LAS unsigned*)(L + MISC_OFF);
    const int tid = threadIdx.x, lane = tid & 63, wave = __builtin_amdgcn_readfirstlane(tid >> 6);
    const int G = gridDim.x;
    unsigned char* ws = args.ws;
    unsigned* ctl = (unsigned*)(ws + WS_CTL);
#define x_in ((const float*)args.in[0])
#define mem_in ((const float*)args.in[1])
#define positions ((const int*)args.in[2])
#define norm_mix ((const float*)args.in[3])
#define w_in ((const float*)args.in[4])
#define lam_q1 ((const float*)args.in[5])
#define lam_k1 ((const float*)args.in[6])
#define lam_q2 ((const float*)args.in[7])
#define lam_k2 ((const float*)args.in[8])
#define diff_subln ((const float*)args.in[9])
#define w_up_sb ((const float*)args.in[10])
#define w_up_diff ((const float*)args.in[11])
#define w_out ((const float*)args.in[12])
#define norm_mem_q ((const float*)args.in[13])
#define norm_mem_kv ((const float*)args.in[14])
#define w_mem_q ((const float*)args.in[15])
#define w_mem_kv ((const float*)args.in[16])
#define w_mem_o ((const float*)args.in[17])
#define norm_ffn ((const float*)args.in[18])
#define w_router ((const float*)args.in[19])
#define b_router ((const float*)args.in[20])
#define w_gate_up ((const float*)args.in[21])
#define b_gate_up ((const float*)args.in[22])
#define w_down ((const float*)args.in[23])
#define b_down ((const float*)args.in[24])
#define norm_final ((const float*)args.in[25])
    bf16_t* WIN = (bf16_t*)(ws + WS_WIN); bf16_t* WUPSB = (bf16_t*)(ws + WS_WUPSB); bf16_t* WUPDF = (bf16_t*)(ws + WS_WUPDF); bf16_t* WOUT = (bf16_t*)(ws + WS_WOUT);
    bf16_t* WMQ = (bf16_t*)(ws + WS_WMQ); bf16_t* WMKV = (bf16_t*)(ws + WS_WMKV); bf16_t* WMO = (bf16_t*)(ws + WS_WMO);
    bf16_t* WGU = (bf16_t*)(ws + WS_WGU); bf16_t* WD = (bf16_t*)(ws + WS_WD);
    float* ROPEC = (float*)(ws + WS_ROPE); float* ROPES = ROPEC + (size_t)M * 32;
    int* TK_E = (int*)(ws + WS_TK); int* TK_POS = TK_E + (size_t)M * 4; float* TK_G = (float*)(TK_POS + (size_t)M * 4);
    bf16_t* XN = (bf16_t*)(ws + WS_XN); bf16_t* PR = (bf16_t*)(ws + WS_PR); bf16_t* OAT = (bf16_t*)(ws + WS_OAT); float* SSQ = (float*)(ws + WS_ODR);
    bf16_t* MIX = (bf16_t*)(ws + WS_MIX); float* X1 = (float*)(ws + WS_X1); float* X2 = (float*)(ws + WS_X2);
    bf16_t* HM = (bf16_t*)(ws + WS_HM); bf16_t* KVM = (bf16_t*)(ws + WS_KVM); int* TLIST = (int*)(ws + WS_TLIST); float* GLIST = (float*)(ws + WS_GLIST);
    bf16_t* QM = (bf16_t*)(ws + WS_QM); bf16_t* OM = (bf16_t*)(ws + WS_OM); bf16_t* ACT = (bf16_t*)(ws + WS_ACT); bf16_t* YB = (bf16_t*)(ws + WS_YB);
    bf16_t* VTSB = (bf16_t*)(ws + WS_VTSB); bf16_t* VTDF = (bf16_t*)(ws + WS_VTDF); bf16_t* VTM = (bf16_t*)(ws + WS_VTM);
    float* WR = (float*)(ws + WS_WR); float* WSCGU = (float*)(ws + WS_WSC); float* WSCD = WSCGU + NE * 2048;
    unsigned char* WGU8 = ws + WS_WGU; unsigned char* WD8 = ws + WS_WD; unsigned char* XN8 = ws + WS_XN; unsigned char* ACT8 = ws + WS_ACT;
    unsigned* CNT = ctl + CW_CNT;
    LAS float* smf = (LAS float*)L;
    LAS int* smi = (LAS int*)L;

    for (int u = tid; u < (LDS_BYTES - 131072) / 4; u += NTHR) ((LAS unsigned*)(L + 131072))[u] = 0u;
    __syncthreads();
#if !MK_PER_PHASE
    XcdBarrier bar = xcd_barrier_post(ctl + CW_BAR, MISC + 8);
#define GRID_BAR() xcd_barrier(bar)
#else
#define GRID_BAR() do {} while (0)
#endif
    const int lo = args.ph_lo, hi = args.ph_hi;
#define IN(k) (lo <= (k) && (k) < hi)
#define PHASE_L(k, ...) do { if (IN(k)) { auto body_ = [&]() __attribute__((always_inline)) __VA_ARGS__; body_(); if ((PROBE_REP >> (k)) & 1) { GRID_BAR(); body_(); } } } while (0)
#if !MK_PER_PHASE
#define PHASE(k) for (int rep_ = 0, nrep_ = IN(k) ? 1 + ((PROBE_REP >> (k)) & 1) : 0; rep_ < nrep_; ++rep_, (rep_ < nrep_ ? (xcd_barrier(bar), 0) : 0))
#else
#define PHASE(k) if (IN(k))
#endif
    unsigned long long st_t0_ = 0ull, st_dt_ = 0ull;
#define STAMP_AT(k) do { if (PROBE_STAMP >= 0) { const unsigned long long now_ = __builtin_amdgcn_s_memrealtime(); if ((k) == PROBE_STAMP || (PROBE_STAMP == 100 && (k) == 0)) st_t0_ = now_; if ((k) == PROBE_STAMP + 1 || (PROBE_STAMP == 100 && (k) == 15)) st_dt_ = now_ - st_t0_; } } while (0)
#define SEAM(k) do { if (IN(k) && IN((k) + 1)) GRID_BAR(); STAMP_AT((k) + 1); } while (0)
    const int gw = blockIdx.x * NWAVES + wave, NGW = G * NWAVES;
    const int xcu = (G % 8 == 0) ? ((int)blockIdx.x % 8) * (G / 8) + (int)blockIdx.x / 8 : (int)blockIdx.x;

    auto convert_experts = [&]() __attribute__((always_inline)) {
        const int hw = tid >> 5, n8 = tid & 7, cch = (tid >> 3) & 3;
        f32x4 ra[8], rb[8];
        auto tile_load = [&](const float* Wl, int N, int k0, f32x4 (&r)[8]) __attribute__((always_inline)) {
#pragma unroll
            for (int i = 0; i < 8; ++i) r[i] = *(const f32x4*)(Wl + (size_t)(k0 + 8 * i + wave) * N); };
        auto tile_to_lds = [&](const f32x4 (&r)[8], LAS float* buf) __attribute__((always_inline)) {
#pragma unroll
            for (int i = 0; i < 8; ++i) { const int k = 8 * i + wave; *(LAS f32x4*)(buf + k * 256 + ((4 * lane) ^ (8 * (k >> 4)))) = r[i]; } };
        for (int it = blockIdx.x; it < NE * 12 * 2; it += G) {
            const int cs = it % (NE * 12), kh = it / (NE * 12);
            const bool gu = cs < NE * 8; const int q = gu ? cs : cs - NE * 8, e = gu ? q >> 3 : q >> 2, n0 = (gu ? q & 7 : q & 3) * 256, N = gu ? 2048 : 1024;
            const float* Wl = (gu ? w_gate_up + (size_t)e * 1024 * 2048 : w_down + (size_t)e * 1024 * 1024) + n0 + 4 * lane;
            unsigned char* dstb = gu ? WGU8 + (size_t)e * 2048 * 1024 : WD8 + (size_t)e * 1024 * 1024;
            float inv[2] = {0.f, 0.f}, am[2] = {0.f, 0.f};
            tile_load(Wl, N, 0, ra); tile_load(Wl, N, 512 * kh, rb);
            __syncthreads();
#pragma unroll
            for (int ti = 0; ti < 9; ++ti) {
                LAS float* buf = (LAS float*)L + (ti & 1) * 16384;
                if (ti & 1) { tile_to_lds(rb, buf); if (ti + 2 < 9) tile_load(Wl, N, 512 * kh + 64 * (ti + 1), rb); }
                else        { tile_to_lds(ra, buf); if (ti + 2 < 9) tile_load(Wl, N, 512 * kh + 64 * (ti + 1), ra); }
                __syncthreads();
                const int k0 = 512 * kh + 64 * (ti - 1);
#pragma unroll
                for (int pp = 0; pp < 2; ++pp) { const int n = 8 * hw + n8 + 128 * pp; const LAS float* sp = buf + (16 * cch) * 256 + (n ^ (8 * cch)); float v[16]; float a0 = 0.f;
#pragma unroll
                    for (int i = 0; i < 16; ++i) { v[i] = sp[i * 256]; a0 = fmaxf(a0, fabsf(v[i])); }
                    if (ti == 0) {
                        a0 = fmaxf(a0, __shfl_xor(a0, 8)); a0 = fmaxf(a0, __shfl_xor(a0, 16));
                        unsigned eb = ((__float_as_uint(a0) >> 23) & 0xffu) + 4u; eb = eb < 8u ? 8u : (eb > 250u ? 250u : eb);
                        inv[pp] = __uint_as_float((261u - eb) << 23);
                        if (kh == 0 && cch == 0) (gu ? WSCGU + (size_t)e * 2048 : WSCD + (size_t)e * 1024)[n0 + n] = __uint_as_float((eb - 7u) << 23);
                    } else {
                        am[pp] = fmaxf(am[pp], a0);
                        const int c = n0 + n, drow = gu ? (((c & 1023) >> 7) * 256 + (c >> 10) * 128 + (c & 127)) : c; const float iv = inv[pp];
                        v4u w; w.x = pk4_fp8(v[0] * iv, v[1] * iv, v[2] * iv, v[3] * iv); w.y = pk4_fp8(v[4] * iv, v[5] * iv, v[6] * iv, v[7] * iv);
                        w.z = pk4_fp8(v[8] * iv, v[9] * iv, v[10] * iv, v[11] * iv); w.w = pk4_fp8(v[12] * iv, v[13] * iv, v[14] * iv, v[15] * iv);
                        *(v4u*)(dstb + (size_t)drow * 1024 + k0 + 16 * cch) = w; } }
            }
            const bool ov = (am[0] * inv[0] >= 448.0f) || (am[1] * inv[1] >= 448.0f);
            if (__any(ov) && lane == 0) __hip_atomic_store(ctl + CW_REDO + cs, 1u, __ATOMIC_RELAXED, __HIP_MEMORY_SCOPE_AGENT);
        }
        __syncthreads();
    };
    STAMP_AT(0);
    PHASE(0) {
        STAMP_AT(20);
        LAS float* scr = (LAS float*)(L + wave * 16384);
        constexpr int I_IN = 16 * 160, I_UP = 8 * 32, I_SQ = 16 * 32, I_KV = 16 * 64, I_GU1 = 16 * 64, I_GU = NE * I_GU1, I_D1 = 16 * 32, I_DN = NE * I_D1;
        constexpr int NITEMS = I_IN + 2 * I_UP + 3 * I_SQ + I_KV;
        for (int it = gw; it < NITEMS; it += NGW) {
            int r = it;
            if (r < I_IN) {
                const int kb = r / 160, nb = r % 160, n0 = 32 * nb;
                if (n0 >= C_DQ && n0 < C_DV) { const int o = n0 & 255;
                    p0_transpose_rope(w_in, WIN, (n0 & ~255), o, 64 * kb, n0, scr, lane); }
                else p0_transpose_item(w_in, 1024, NIN, WIN, n0, 64 * kb, n0, scr, lane);
                continue; } r -= I_IN;
            if (r < I_UP) { p0_plain(w_up_sb, 512, 1024, WUPSB, r, scr, lane); continue; } r -= I_UP;
            if (r < I_UP) { p0_plain(w_up_diff, 512, 1024, WUPDF, r, scr, lane); continue; } r -= I_UP;
            if (r < I_SQ) { p0_plain(w_out, 1024, 1024, WOUT, r, scr, lane); continue; } r -= I_SQ;
            if (r < I_SQ) { p0_plain(w_mem_q, 1024, 1024, WMQ, r, scr, lane, norm_mem_q); continue; } r -= I_SQ;
            if (r < I_SQ) { p0_plain(w_mem_o, 1024, 1024, WMO, r, scr, lane); continue; } r -= I_SQ;
            p0_plain(w_mem_kv, 1024, 2048, WMKV, r, scr, lane);
        }
        for (int i = blockIdx.x * NTHR + tid; i < D * NE; i += G * NTHR) WR[i] = w_router[i] * norm_ffn[i >> 5];
        STAMP_AT(21);
        STAMP_AT(22);
        for (int m = gw; m < M; m += 2 * NGW) { const int m2 = m + NGW; rms_rows2<false>(x_in + (size_t)m * D, x_in + (size_t)m2 * D, m2 < M, norm_mix, XN + (size_t)m * D, XN + (size_t)m2 * D, lane); }
        for (int m = gw; m < MM; m += NGW) rms_row_to_bf16(mem_in + (size_t)m * D, norm_mem_kv, HM + (size_t)m * D, lane);
        for (int i = blockIdx.x * NTHR + tid; i < M * 32; i += G * NTHR) {
            const int m = i >> 5, f = i & 31;
            const double inv = exp2(-(double)f * (13.287712379549449 / 32.0));
            const double ang = (double)positions[m] * inv;
            const double kk = rint(ang * 0.15915494309189535);
            const float rf = (float)(ang - kk * 6.283185307179586);
            ROPEC[i] = __cosf(rf); ROPES[i] = __sinf(rf);
        }
        STAMP_AT(23);
    }
    SEAM(0); STAMP_AT(24);

    if (IN(1)) {
        const int grp = (int)blockIdx.x % 3;
        pg8::Gemm g{XN, WIN, D, D, D}; pg8::DenseOrder S; S.init(M, NIN, G, (int)blockIdx.x, D, D);
        const pg8::EpiInProj E{PR, ROPEC, ROPES, VTSB, VTDF};
        STAMP_AT(40);
        if (grp == 0) { convert_experts(); __syncthreads(); }
        STAMP_AT(41);
        if (grp == 1) { S.i0 = 0; S.i1 = 2; pg8::gemm_phase<pg8::EpiInProj, pg8::DenseOrder, false>(L, g, S, E); convert_experts(); __syncthreads(); S.i0 = 2; S.i1 = 1 << 30; }
        pg8::gemm_phase<pg8::EpiInProj, pg8::DenseOrder, false>(L, g, S, E);
        STAMP_AT(42);
        if (grp == 2) convert_experts();
        STAMP_AT(43);
    }
    SEAM(1);

    if (IN(3)) {
        {
            LAS float* sw = (LAS float*)L; LAS float* red = (LAS float*)(L + 131072 + 4096);
            const int n = tid & 31, part = tid >> 5;
            for (int it = blockIdx.x; it < NE * 96; it += G) {
                { const int cs_ = it < NE * 64 ? ((it >> 6) * 8 + ((it & 63) >> 3)) : (NE * 8 + ((it - NE * 64) >> 5) * 4 + (((it - NE * 64) & 31) >> 3));
                  if (__hip_atomic_load(ctl + CW_REDO + cs_, __ATOMIC_RELAXED, __HIP_MEMORY_SCOPE_AGENT) == 0u) continue; }
                const bool gu = it < NE * 64; const int q = gu ? it : it - NE * 64, e = gu ? q >> 6 : q >> 5, n0 = (gu ? q & 63 : q & 31) * 32, N = gu ? 2048 : 1024;
                const float* W = (gu ? w_gate_up + (size_t)e * 1024 * 2048 : w_down + (size_t)e * 1024 * 1024) + n0 + n;
                __syncthreads();
#pragma unroll 16
                for (int i = 0; i < 64; ++i) { const int k = part + 16 * i; sw[k * 32 + n] = W[(size_t)k * N]; }
                __syncthreads();
                float am = 0.f;
#pragma unroll 16
                for (int i = 0; i < 64; ++i) am = fmaxf(am, fabsf(sw[(64 * part + i) * 32 + n]));
                red[part * 32 + n] = am;
                __syncthreads();
                if (tid < 32) { float a = red[tid];
#pragma unroll
                    for (int pp = 1; pp < 16; ++pp) a = fmaxf(a, red[pp * 32 + tid]);
                    unsigned eb = (__float_as_uint(a) >> 23) & 0xffu; eb = eb < 8u ? 8u : eb;
                    const float sc = __uint_as_float((eb - 7u) << 23), inv = __uint_as_float((261u - eb) << 23);
                    red[512 + tid] = inv; (gu ? WSCGU + (size_t)e * 2048 : WSCD + (size_t)e * 1024)[n0 + tid] = sc; }
                __syncthreads();
                { const float inv = red[512 + n]; const int c = n0 + n;
                  const int drow = gu ? (((c & 1023) >> 7) * 256 + (c >> 10) * 128 + (c & 127)) : c;
                  unsigned char* dst = (gu ? WGU8 + ((size_t)e * 2048 + drow) * 1024 : WD8 + ((size_t)e * 1024 + drow) * 1024) + 64 * part;
#pragma unroll
                  for (int qd = 0; qd < 4; ++qd) { v4u w;
                      const LAS float* sp = sw + (64 * part + 16 * qd) * 32 + n;
                      w.x = pk4_fp8(sp[0] * inv, sp[32] * inv, sp[64] * inv, sp[96] * inv); w.y = pk4_fp8(sp[128] * inv, sp[160] * inv, sp[192] * inv, sp[224] * inv);
                      w.z = pk4_fp8(sp[256] * inv, sp[288] * inv, sp[320] * inv, sp[352] * inv); w.w = pk4_fp8(sp[384] * inv, sp[416] * inv, sp[448] * inv, sp[480] * inv);
                      *(v4u*)(dst + 16 * qd) = w; } }
            }
            __syncthreads();
        }
    }
    PHASE(3) {
        volatile LAS unsigned* fl = (volatile LAS unsigned*)(L + 131072 + 2048);
        STAMP_AT(30);
        const float lam = expf(wave_sum(lam_q1[lane] * lam_k1[lane])) - expf(wave_sum(lam_q2[lane] * lam_k2[lane])) + 0.2f;
        const int nkv = (G >= 64) ? 32 : 0;
        if ((int)blockIdx.x < nkv) { pg8::Gemm g{HM, WMKV, D, D, D}; pg8::OneUnitOrder S{(int)blockIdx.x, D, D};
            pg8::gemm_phase<pg8::EpiKV, pg8::OneUnitOrder, false>(L, g, S, pg8::EpiKV{KVM, VTM}); }
        if (nkv == 0) { pg8::Gemm g{HM, WMKV, D, D, D}; pg8::DenseOrder S; S.init(MM, 2048, G, (int)blockIdx.x, D, D); pg8::gemm_phase<pg8::EpiKV, pg8::DenseOrder, false>(L, g, S, pg8::EpiKV{KVM, VTM}); }
        for (int pr = blockIdx.x; pr < 256; pr += G) { const int sb_ = pr & 15, h = (pr >> 4) & 3, b = pr >> 6;
            attn_diff_block(PR, VTDF, OAT, diff_subln, lam, b, h, 31 - sb_, L, tid, wave, lane); attn_diff_block(PR, VTDF, OAT, diff_subln, lam, b, h, sb_, L, tid, wave, lane); }
        STAMP_AT(31);
        for (;;) {
            if (tid == 0) fl[4] = __hip_atomic_fetch_add(ctl + CW_SBQ, 1u, __ATOMIC_RELAXED, __HIP_MEMORY_SCOPE_AGENT);
            __syncthreads();
            const int bu = (int)fl[4];
            __syncthreads();
            if (bu >= 512) break;
            const int qb = 15 - (bu & 15), h = (bu >> 4) & 7, b = bu >> 7;
            attn_sb_wave(PR, VTSB, OAT, b, h, qb * 256 + wave * 32, lane);
        }
        STAMP_AT(32);
    }
    SEAM(3); STAMP_AT(3); STAMP_AT(33);

    PHASE_L(5, {
        pg8::Gemm g{OAT, WUPSB, D, 512, 512}; pg8::TwoRoundOrder S{G, xcu, D, 512};
        pg8::gemm_phase<pg8::EpiGate, pg8::TwoRoundOrder, false>(L, g, S, pg8::EpiGate{PR, (bf16_t*)X1, MIX});
    });
    SEAM(5); STAMP_AT(5);

    PHASE_L(6, {
        pg8::Gemm g{MIX, WOUT, D, D, D}; pg8::DenseOrder S; S.init(M, D, G, (int)blockIdx.x, D, D);
        pg8::gemm_phase<pg8::EpiResidNorm, pg8::DenseOrder, false>(L, g, S, pg8::EpiResidNorm{x_in, X1, XN, SSQ});
    });
    if (IN(6) && IN(8)) GRID_BAR();
    STAMP_AT(7); STAMP_AT(8);

    if (IN(8)) {
        pg8::Gemm g{XN, WMQ, D, D, D}; pg8::DenseOrder S; S.init(M, D, G, (int)blockIdx.x, D, D);
        pg8::gemm_phase<pg8::EpiBf16Rinv, pg8::DenseOrder, false>(L, g, S, pg8::EpiBf16Rinv{QM, SSQ, 0.0625f * 1.4426950408889634f});
        asm volatile("s_waitcnt vmcnt(0)" ::: "memory");
        __syncthreads();
        pg8::Unit u;
        for (int i = 0; S.next(i, u); ++i) attn_mem_block(QM, KVM, VTM, OM, u.pm >> 4, u.pn, u.pm & 15, L, tid, wave, lane);
    }
    STAMP_AT(9);
    SEAM(9);

    PHASE_L(10, {
        pg8::Gemm g{OM, WMO, D, D, D}; pg8::DenseOrder S; S.init(M, D, G, (int)blockIdx.x, D, D);
        pg8::gemm_phase<pg8::EpiResidB, pg8::DenseOrder, false>(L, g, S, pg8::EpiResidB{XN, X2});
    });
    SEAM(10);

    if (IN(11)) {
        auto body11_ = [&]() __attribute__((always_inline)) {
        {
            const int i32 = lane & 31, kk = lane >> 5;
#pragma unroll
            for (int t2 = 0; t2 < 2; ++t2) {
                const int tile = t2 * G + (int)blockIdx.x, m0 = tile * 32;
                LAS float* P = smf + (t2 * 8 + wave) * 1056; LAS float* SSQ_ = smf + 16 * 1056 + (t2 * 8 + wave) * 32;
                f32x16 acc;
#pragma unroll
                for (int r = 0; r < 16; ++r) acc[r] = 0.f;
                float ss = 0.f;
                if (tile < M / 32) {
                    const float* xr = X2 + (size_t)(m0 + i32) * D + 128 * wave + 4 * kk; const float* wp = WR + (128 * wave + 4 * kk) * NE + i32;
#pragma unroll 8
                    for (int u = 0; u < 16; ++u) {
                        const f32x4 a = *(const f32x4*)(xr + 8 * u);
                        const float b0 = wp[(8 * u + 0) * NE], b1 = wp[(8 * u + 1) * NE], b2 = wp[(8 * u + 2) * NE], b3 = wp[(8 * u + 3) * NE];
                        acc = __builtin_amdgcn_mfma_f32_32x32x2f32(a.x, b0, acc, 0, 0, 0); acc = __builtin_amdgcn_mfma_f32_32x32x2f32(a.y, b1, acc, 0, 0, 0);
                        acc = __builtin_amdgcn_mfma_f32_32x32x2f32(a.z, b2, acc, 0, 0, 0); acc = __builtin_amdgcn_mfma_f32_32x32x2f32(a.w, b3, acc, 0, 0, 0);
                        ss += (a.x * a.x + a.y * a.y) + (a.z * a.z + a.w * a.w);
                    }
                }
                ss += xhalf(ss, kk);
#pragma unroll
                for (int r = 0; r < 16; ++r) P[((r & 3) + 8 * (r >> 2) + 4 * kk) * 33 + i32] = acc[r];
                if (kk == 0) SSQ_[i32] = ss;
            }
        }
        __syncthreads();
        if (wave < 2) {
            const int tile = wave * G + (int)blockIdx.x;
            if (tile < M / 32) {
                const int m0 = tile * 32;
                LAS float* T = smf + (wave * 8) * 1056;
#pragma unroll
                for (int r = 0; r < 16; ++r) { const int idx = lane + 64 * r, e_ = (idx >> 5) * 33 + (idx & 31); float v = T[e_];
#pragma unroll
                    for (int w2 = 1; w2 < 8; ++w2) v += T[w2 * 1056 + e_];
                    T[e_] = v; }
                float ss = 0.f;
#pragma unroll
                for (int w2 = 0; w2 < 8; ++w2) ss += smf[16 * 1056 + (wave * 8 + w2) * 32 + (lane & 31)];
                LDS_WAIT(); asm volatile("" ::: "memory");
                const float rinv = 1.0f / sqrtf(ss * (1.f / 1024.f) + NORM_EPS);
                if (lane < 32) {
                    float lg[32];
#pragma unroll
                    for (int j = 0; j < 32; ++j) lg[j] = T[lane * 33 + j] * rinv + b_router[j];
                    float tv[4]; int ti[4];
#pragma unroll
                    for (int k = 0; k < 4; ++k) { float bv = lg[0]; int bi = 0;
#pragma unroll
                        for (int j = 1; j < 32; ++j) if (lg[j] > bv) { bv = lg[j]; bi = j; }
                        tv[k] = bv; ti[k] = bi;
#pragma unroll
                        for (int j = 0; j < 32; ++j) if (j == bi) lg[j] = -INFINITY; }
                    const float e1 = __expf(tv[1] - tv[0]), e2 = __expf(tv[2] - tv[0]), e3 = __expf(tv[3] - tv[0]);
                    const float isum = 1.f / (1.f + e1 + e2 + e3);
                    const float gk[4] = {isum, e1 * isum, e2 * isum, e3 * isum};
                    LAS unsigned* H = (LAS unsigned*)(smf + 16 * 1056 + 512 + wave * 64);
                    H[lane] = 0u;
                    LDS_WAIT(); asm volatile("" ::: "memory");
                    int rk[4];
#pragma unroll
                    for (int k = 0; k < 4; ++k) rk[k] = (int)__hip_atomic_fetch_add(H + ti[k], 1u, __ATOMIC_RELAXED, __HIP_MEMORY_SCOPE_WAVEFRONT);
                    LDS_WAIT(); asm volatile("" ::: "memory");
                    const unsigned cnt_e = H[lane];
                    unsigned base_e = 0u; if (cnt_e) base_e = atomicAdd(&CNT[64 * lane], cnt_e);
                    H[32 + lane] = base_e;
                    LDS_WAIT(); asm volatile("" ::: "memory");
                    const int m = m0 + lane;
#pragma unroll
                    for (int k = 0; k < 4; ++k) { const int ek = ti[k]; const int pos = (int)H[32 + ek] + rk[k];
                        TLIST[ek * LISTCAP + pos] = m; GLIST[ek * LISTCAP + pos] = gk[k]; TK_E[m * 4 + k] = ek; TK_POS[m * 4 + k] = pos; TK_G[m * 4 + k] = gk[k]; }
                }
            }
        } else {
            for (int m = blockIdx.x * 6 + (wave - 2); m < M; m += 2 * G * 6) { const int m2 = m + G * 6; rms_rows2<true>(X2 + (size_t)m * D, X2 + (size_t)m2 * D, m2 < M, norm_ffn, XN8 + (size_t)m * D, XN8 + (size_t)m2 * D, lane); }
        }
            };
        body11_();
        if ((PROBE_REP >> 11) & 1) { GRID_BAR(); if (blockIdx.x == 0 && tid < NE) CNT[64 * tid] = 0u; GRID_BAR(); body11_(); }
    }
    SEAM(11);

#define LOAD_BASES() do { __syncthreads(); if (tid == 0) { int b_ = 0; for (int e_ = 0; e_ < NE; ++e_) { const int c_ = (int)__hip_atomic_load(&CNT[64 * e_], __ATOMIC_RELAXED, __HIP_MEMORY_SCOPE_AGENT); \
        smi[8192 + e_] = b_; smi[8256 + e_] = c_; b_ += (c_ + 255) & ~255; } } __syncthreads(); } while (0)

    LAS int* tb = (LAS int*)(L + 131072 + 1024);
#define LOAD_TB(npn) do { __syncthreads(); if (tid == 0) { int b_ = 0, cu_ = 0; for (int e_ = 0; e_ < NE; ++e_) { const int c_ = (int)__hip_atomic_load(&CNT[64 * e_], __ATOMIC_RELAXED, __HIP_MEMORY_SCOPE_AGENT); \
        tb[e_] = b_; tb[32 + e_] = c_; tb[64 + e_] = cu_; b_ += (c_ + 255) & ~255; cu_ += ((c_ + 255) >> 8) * (npn); } tb[96] = cu_; } __syncthreads(); } while (0)
    PHASE_L(12, {
        LOAD_TB(8);
        pg8::Gemm g{(const bf16_t*)XN8, (const bf16_t*)WGU8, 512, 512, 512}; pg8::MoeOrder S{tb, TLIST, G, xcu, 8, 512, 512, 2048};
        pg8::gemm_phase<pg8::EpiMoeGU, pg8::MoeOrder, true, true>(L, g, S, pg8::EpiMoeGU{ACT8, b_gate_up, WSCGU});
    });
    SEAM(12);
    PHASE_L(13, {
        LOAD_TB(4);
        pg8::Gemm g{(const bf16_t*)ACT8, (const bf16_t*)WD8, 512, 512, 512}; pg8::MoeOrder S{tb, TLIST, G, xcu, 4, 512, 512, 1024};
        pg8::gemm_phase<pg8::EpiMoeDown, pg8::MoeOrder, false, true>(L, g, S, pg8::EpiMoeDown{YB, b_down, GLIST, tb, WSCD});
    });
    SEAM(13);

    PHASE(14) {
        LOAD_BASES();
        for (int mb = gw; mb < M; mb += 8 * NGW) {
            int slotv = 0;
            { const int i = lane >> 2, k = lane & 3, m = mb + NGW * i; if (lane < 32 && m < M) slotv = smi[8192 + TK_E[m * 4 + k]] + TK_POS[m * 4 + k]; }
#pragma unroll 2
            for (int i = 0; i < 8; ++i) {
                const int m = mb + NGW * i; if (m >= M) break;
                const f32x4* xr = (const f32x4*)(X2 + (size_t)m * D) + lane; const f32x4* gr = (const f32x4*)norm_final + lane;
                f32x4 v[4];
#pragma unroll
                for (int j = 0; j < 4; ++j) v[j] = xr[64 * j];
#pragma unroll
                for (int k = 0; k < 4; ++k) { const int slot = __builtin_amdgcn_readlane(slotv, 4 * i + k); const v2u* yr = (const v2u*)(YB + (size_t)slot * D) + lane;
#pragma unroll
                    for (int j = 0; j < 4; ++j) { const v2u w = yr[64 * j]; v[j].x += lo16(w.x); v[j].y += hi16(w.x); v[j].z += lo16(w.y); v[j].w += hi16(w.y); } }
                float ss = 0.f;
#pragma unroll
                for (int j = 0; j < 4; ++j) ss += (v[j].x * v[j].x + v[j].y * v[j].y) + (v[j].z * v[j].z + v[j].w * v[j].w);
                const float rinv = 1.0f / sqrtf(wave_sum(ss) * (1.f / 1024.f) + NORM_EPS);
                f32x4* orow = (f32x4*)(args.out + (size_t)m * D) + lane;
#pragma unroll
                for (int j = 0; j < 4; ++j) { const f32x4 gg = gr[64 * j]; orow[64 * j] = (f32x4){v[j].x * rinv * gg.x, v[j].y * rinv * gg.y, v[j].z * rinv * gg.z, v[j].w * rinv * gg.w}; }
            }
        }
    }
    if (PROBE_STAMP >= 0) { STAMP_AT(15); if (blockIdx.x == PROBE_BLOCK) { const unsigned long long t1_ = __builtin_amdgcn_s_memrealtime(); while (__builtin_amdgcn_s_memrealtime() - t1_ < st_dt_) __builtin_amdgcn_s_sleep(8); } }
#undef IN
#undef SEAM
}

extern "C" void kernel_launch(void* const* d_in, const int* in_sizes, int n_in, void* d_out, int out_size, void* d_ws, size_t ws_size, hipStream_t stream) {
    static int grid = 0;
    if (grid == 0) {
        if (n_in != 26 || out_size != M * D || ws_size < WS_END) { fprintf(stderr, "kernel_launch: unexpected sizes n_in %d out %d ws %zu\n", n_in, out_size, ws_size); grid = -1; return; }
        int dev = 0, cus = 0;
        if (hipGetDevice(&dev) != hipSuccess || hipDeviceGetAttribute(&cus, hipDeviceAttributeMultiprocessorCount, dev) != hipSuccess) { grid = -1; return; }
        if (hipFuncSetAttribute((const void*)fwd, hipFuncAttributeMaxDynamicSharedMemorySize, LDS_BYTES) != hipSuccess) { fprintf(stderr, "kernel_launch: hipFuncSetAttribute failed\n"); grid = -1; return; }
        int per_cu = 0;
        (void)hipOccupancyMaxActiveBlocksPerMultiprocessor(&per_cu, (const void*)fwd, NTHR, LDS_BYTES);
        (void)hipGetLastError();
        grid = cus;
    }
    if (grid < 0) return;
    (void)hipMemsetAsync((char*)d_ws + WS_CTL, 0, CTL_ZERO_BYTES, stream);
    Args a{};
    for (int i = 0; i < 26; ++i) a.in[i] = d_in[i];
    a.out = (float*)d_out; a.ws = (unsigned char*)d_ws;
#if MK_PER_PHASE
    for (int p = 0; p < NPHASE; ++p) { a.ph_lo = p; a.ph_hi = p + 1; hipLaunchKernelGGL(fwd, dim3(grid), dim3(NTHR), LDS_BYTES, stream, a); }
#else
    a.ph_lo = 0; a.ph_hi = NPHASE; hipLaunchKernelGGL(fwd, dim3(grid), dim3(NTHR), LDS_BYTES, stream, a);
#endif
}
```
